# Optimizing an MI355X kernel written in HIP

```python
import jax, jax.numpy as jnp
from jax import lax
import numpy as np

D_MODEL = 1024
BATCH = 8
SEQ = 4096
DEPTH = 1

M_WIDTH = D_MODEL // 2
M_HEADS = 4
M_HEAD_DIM = M_WIDTH // M_HEADS
M_CHUNK = 64
M_CONV = 4
N_WIDTH = D_MODEL - M_WIDTH
N_HEADS = 8
N_KV_GROUPS = 2
N_HEAD_DIM = N_WIDTH // N_HEADS
KV_WIDTH = N_KV_GROUPS * N_HEAD_DIM
CMP_BLOCK = 32
CMP_STRIDE = 16
CMP_HIDDEN = 2 * N_HEAD_DIM
SLC_BLOCK = 64
SLC_TOPK = 16
WINDOW = 512
NSA_Q_BLOCK = 32
ROPE_THETA = 10000.0
MOE_GROUPS = 4
EXPERTS_PER_GROUP = 8
N_EXPERTS = MOE_GROUPS * EXPERTS_PER_GROUP
TOP_K_IN_GROUP = 2
EXPERT_FF = D_MODEL // 2
MOE_ROW_BLOCK = 128
RMS_EPS = 1e-6
IN_WIDTHS = (M_WIDTH, M_WIDTH, M_WIDTH, M_WIDTH, M_HEADS, M_HEADS, N_WIDTH, KV_WIDTH, KV_WIDTH, KV_WIDTH, KV_WIDTH, KV_WIDTH, KV_WIDTH, 3 * N_HEADS)
IN_WIDTH = sum(IN_WIDTHS)

kernel_name = 'hybrid_mlstm_nsa_hmoe_block'


def rms_norm(x, w):
    xf = x.astype(jnp.float32)
    y = xf * lax.rsqrt(jnp.mean(xf * xf, axis=-1, keepdims=True) + RMS_EPS)
    return (y * w.astype(jnp.float32)).astype(x.dtype)


def split_cols(z, widths):
    outs = []
    off = 0
    for w in widths:
        outs.append(z[..., off:off + w])
        off += w
    return outs


def rope(x, positions):
    half = x.shape[-1] // 2
    inv = ROPE_THETA ** (-jnp.arange(half, dtype=jnp.float32) / half)
    ang = positions.astype(jnp.float32)[..., None] * inv
    cos = jnp.cos(ang)[:, :, None, :].astype(x.dtype)
    sin = jnp.sin(ang)[:, :, None, :].astype(x.dtype)
    x1, x2 = x[..., :half], x[..., half:]
    return jnp.concatenate([x1 * cos - x2 * sin, x2 * cos + x1 * sin], axis=-1)


def causal_conv(x, w):
    K, C = w.shape
    return lax.conv_general_dilated(x, w[:, None, :].astype(x.dtype), window_strides=(1,), padding=[(K - 1, 0)], dimension_numbers=('NWC', 'WIO', 'NWC'), feature_group_count=C)


def mlstm_chunkwise(q, k, v, i_pre, f_pre):
    B, S, NH, DH = q.shape
    L = M_CHUNK
    NC = S // L
    f32 = jnp.float32

    def chunks(t):
        return jnp.moveaxis(t, 2, 1).reshape((B, NH, NC, L) + t.shape[3:])

    q = chunks(q).astype(f32)
    k = chunks(k).astype(f32) * (DH ** -0.5)
    v = chunks(v).astype(f32)
    ig = chunks(i_pre).astype(f32)
    lf = jax.nn.log_sigmoid(chunks(f_pre).astype(f32))
    b = jnp.cumsum(lf, axis=-1)
    g = b[..., -1]
    a = g[..., None] - b + ig
    m_loc = jnp.max(a, axis=-1)
    w = jnp.exp(a - m_loc[..., None])
    kv_c = jnp.einsum('bhcl,bhcld,bhcle->bhcde', w, k, v)
    n_c = jnp.einsum('bhcl,bhcld->bhcd', w, k)

    def step(carry, xs):
        C, n, m = carry
        kv_j, n_j, m_j, g_j = xs
        m_new = jnp.maximum(g_j + m, m_j)
        a_old = jnp.exp(g_j + m - m_new)
        a_new = jnp.exp(m_j - m_new)
        C_new = a_old[..., None, None] * C + a_new[..., None, None] * kv_j
        n_new = a_old[..., None] * n + a_new[..., None] * n_j
        return (C_new, n_new, m_new), (C, n, m)

    init = (jnp.zeros((B, NH, DH, DH), f32), jnp.zeros((B, NH, DH), f32), jnp.zeros((B, NH), f32))
    xs = (jnp.moveaxis(kv_c, 2, 0), jnp.moveaxis(n_c, 2, 0), jnp.moveaxis(m_loc, 2, 0), jnp.moveaxis(g, 2, 0))
    _, (C_prev, n_prev, m_prev) = lax.scan(step, init, xs)
    C_prev = jnp.moveaxis(C_prev, 0, 2)
    n_prev = jnp.moveaxis(n_prev, 0, 2)
    m_prev = jnp.moveaxis(m_prev, 0, 2)
    causal = jnp.tril(jnp.ones((L, L), dtype=bool))
    dlog = jnp.where(causal, b[..., :, None] - b[..., None, :] + ig[..., None, :], -jnp.inf)
    inter = b + m_prev[..., None]
    m_t = jnp.maximum(inter, jnp.max(dlog, axis=-1))
    wts = jnp.exp(dlog - m_t[..., None]) * jnp.einsum('bhcld,bhcsd->bhcls', q, k)
    dec = jnp.exp(inter - m_t)
    num = jnp.einsum('bhcls,bhcse->bhcle', wts, v) + dec[..., None] * jnp.einsum('bhcld,bhcde->bhcle', q, C_prev)
    den = jnp.sum(wts, axis=-1) + dec * jnp.einsum('bhcld,bhcd->bhcl', q, n_prev)
    h = num / jnp.maximum(jnp.abs(den), jnp.exp(-m_t))[..., None]
    return jnp.moveaxis(h.reshape(B, NH, S, DH), 1, 2)


def mlstm_mixer(q_pre, k_pre, v, o_pre, i_pre, f_pre, conv_w, gate_b, head_norm_w):
    B, S, _ = q_pre.shape
    qk = jax.nn.silu(causal_conv(jnp.concatenate([q_pre, k_pre], axis=-1), conv_w))
    q, k = qk[..., :M_WIDTH], qk[..., M_WIDTH:]
    shp = (B, S, M_HEADS, M_HEAD_DIM)
    h = mlstm_chunkwise(q.reshape(shp), k.reshape(shp), v.reshape(shp), i_pre + gate_b[:M_HEADS], f_pre + gate_b[M_HEADS:])
    h = rms_norm(h, head_norm_w.reshape(M_HEADS, M_HEAD_DIM)).reshape(B, S, M_WIDTH)
    return (jax.nn.sigmoid(o_pre.astype(jnp.float32)) * h).astype(q_pre.dtype)


def masked_softmax(s, mask):
    s = jnp.where(mask, s.astype(jnp.float32), -jnp.inf)
    m = jnp.max(s, axis=-1, keepdims=True)
    m = jnp.where(jnp.isfinite(m), m, 0.0)
    p = jnp.exp(s - m)
    return p / jnp.maximum(jnp.sum(p, axis=-1, keepdims=True), 1e-30)


def compress_kv(t, pe, w1, w2):
    B, S, G, Dh = t.shape
    n_cmp = (S - CMP_BLOCK) // CMP_STRIDE + 1
    idx = jnp.arange(n_cmp)[:, None] * CMP_STRIDE + jnp.arange(CMP_BLOCK)[None, :]
    blk = t[:, idx] + pe[None, None, :, None, :]
    blk = jnp.moveaxis(blk, 3, 2).reshape(B, n_cmp, G, CMP_BLOCK * Dh)
    return jax.nn.silu(blk @ w1) @ w2


def nsa_attention(q, k_cmp, v_cmp, k_slc, v_slc, k_win, v_win, gates):
    B, S, H, Dh = q.shape
    G = k_slc.shape[2]
    HPG = H // G
    QB = NSA_Q_BLOCK
    scale = Dh ** -0.5
    n_cmp = k_cmp.shape[1]
    n_slc = S // SLC_BLOCK
    n_top = min(SLC_TOPK, n_slc)
    cmp_end = jnp.arange(n_cmp) * CMP_STRIDE + CMP_BLOCK - 1
    js = np.arange(n_slc)[:, None] * SLC_BLOCK
    cs = np.arange(n_cmp)[None, :] * CMP_STRIDE
    ov = np.clip(np.minimum(js + SLC_BLOCK, cs + CMP_BLOCK) - np.maximum(js, cs), 0, None) / CMP_STRIDE
    ov = jnp.asarray(ov.astype(np.float32))
    ks_blk = k_slc.reshape(B, n_slc, SLC_BLOCK, G, Dh).transpose(0, 3, 1, 2, 4)
    vs_blk = v_slc.reshape(B, n_slc, SLC_BLOCK, G, Dh).transpose(0, 3, 1, 2, 4)
    kw_pad = jnp.pad(k_win, ((0, 0), (WINDOW, 0), (0, 0), (0, 0)))
    vw_pad = jnp.pad(v_win, ((0, 0), (WINDOW, 0), (0, 0), (0, 0)))
    b_idx = jnp.arange(B)[:, None, None, None]
    g_idx = jnp.arange(G)[None, :, None, None]
    j_ids = jnp.arange(n_slc)
    slc_start = j_ids * SLC_BLOCK
    n_qb = S // QB

    def block(args):
        qb, gb, q0 = args
        t = q0 + jnp.arange(QB)
        qg = qb.reshape(B, QB, G, HPG, Dh)
        s = jnp.einsum('bqghd,bngd->bqghn', qg, k_cmp) * scale
        p_c = masked_softmax(s, (cmp_end[None, :] <= t[:, None])[None, :, None, None, :])
        o_c = jnp.einsum('bqghn,bngd->bqghd', p_c.astype(v_cmp.dtype), v_cmp)
        imp = jnp.einsum('bqghn,jn->bqgj', p_c, ov)
        cur = t // SLC_BLOCK
        forced = (j_ids[None, :] == 0) | (j_ids[None, :] == cur[:, None]) | (j_ids[None, :] == cur[:, None] - 1)
        future = slc_start[None, :] > t[:, None]
        score = jnp.where(forced[None, :, None, :], jnp.inf, jnp.where(future[None, :, None, :], -jnp.inf, imp))
        _, sel = lax.top_k(score, n_top)
        sel = sel.transpose(0, 2, 1, 3)
        kg = ks_blk[b_idx, g_idx, sel].reshape(B, G, QB, n_top * SLC_BLOCK, Dh)
        vg = vs_blk[b_idx, g_idx, sel].reshape(B, G, QB, n_top * SLC_BLOCK, Dh)
        kpos = (sel[..., None] * SLC_BLOCK + jnp.arange(SLC_BLOCK)).reshape(B, G, QB, n_top * SLC_BLOCK)
        m_s = (kpos <= t[None, None, :, None]).transpose(0, 2, 1, 3)[:, :, :, None, :]
        s = jnp.einsum('bqghd,bgqkd->bqghk', qg, kg) * scale
        p_s = masked_softmax(s, m_s)
        o_s = jnp.einsum('bqghk,bgqkd->bqghd', p_s.astype(vg.dtype), vg)
        kw = lax.dynamic_slice_in_dim(kw_pad, q0, WINDOW + QB, axis=1)
        vw = lax.dynamic_slice_in_dim(vw_pad, q0, WINDOW + QB, axis=1)
        wpos = q0 - WINDOW + jnp.arange(WINDOW + QB)
        m_w = (wpos[None, :] <= t[:, None]) & (wpos[None, :] > t[:, None] - WINDOW) & (wpos[None, :] >= 0)
        s = jnp.einsum('bqghd,bkgd->bqghk', qg, kw) * scale
        p_w = masked_softmax(s, m_w[None, :, None, None, :])
        o_w = jnp.einsum('bqghk,bkgd->bqghd', p_w.astype(vw.dtype), vw)
        gb = gb.reshape(B, QB, G, HPG, 3)
        o = gb[..., 0:1] * o_c + gb[..., 1:2] * o_s + gb[..., 2:3] * o_w
        return o.reshape(B, QB, H * Dh)

    qs = q.reshape(B, n_qb, QB, H, Dh).swapaxes(0, 1)
    gs = gates.reshape(B, n_qb, QB, H, 3).swapaxes(0, 1)
    q0s = jnp.arange(n_qb, dtype=jnp.int32) * QB
    out = lax.map(block, (qs, gs, q0s))
    return out.swapaxes(0, 1).reshape(B, S, H * Dh)


def grouped_expert_ffn(hf, eidx, gate, w1, w3, w2):
    T, D = hf.shape
    E = w1.shape[0]
    R = MOE_ROW_BLOCK
    A = eidx.shape[0] * eidx.shape[1]
    e = eidx.reshape(A)
    g = gate.reshape(A)
    tok = jnp.repeat(jnp.arange(T, dtype=jnp.int32), eidx.shape[1])
    order = jnp.argsort(e)
    e_s, g_s, tok_s = e[order], g[order], tok[order]
    counts = jnp.zeros((E,), jnp.int32).at[e].add(1)
    padded = (counts + R - 1) // R * R
    starts = jnp.cumsum(counts) - counts
    pstarts = jnp.cumsum(padded) - padded
    dest = pstarts[e_s] + jnp.arange(A, dtype=jnp.int32) - starts[e_s]
    P = -(-A // R) * R + E * R
    row_tok = jnp.zeros((P,), jnp.int32).at[dest].set(tok_s)
    row_gate = jnp.zeros((P,), hf.dtype).at[dest].set(g_s)
    block_start = jnp.arange(P // R, dtype=jnp.int32) * R
    block_e = jnp.minimum(jnp.sum(block_start[:, None] >= (pstarts + padded)[None, :], axis=1), E - 1)

    def run_block(args):
        toks, gts, ei = args
        xb = hf[toks]
        hb = jax.nn.silu(xb @ w1[ei]) * (xb @ w3[ei])
        return (hb @ w2[ei]) * gts[:, None]

    ys = lax.map(run_block, (row_tok.reshape(-1, R), row_gate.reshape(-1, R), block_e))
    return jax.ops.segment_sum(ys.reshape(P, D), row_tok, num_segments=T)


def hier_moe(h, wg, bg, we, be, w1, w3, w2):
    B, S, D = h.shape
    T = B * S
    hf = h.reshape(T, D)
    p_grp = jax.nn.softmax((hf @ wg + bg).astype(jnp.float32), axis=-1)
    pg_top, grp = lax.top_k(p_grp, 1)
    grp = grp[:, 0]
    le = (hf @ we + be).astype(jnp.float32).reshape(T, MOE_GROUPS, EXPERTS_PER_GROUP)
    p_in = jax.nn.softmax(le[jnp.arange(T), grp], axis=-1)
    pe_top, e_in = lax.top_k(p_in, TOP_K_IN_GROUP)
    gate = pg_top * pe_top / jnp.sum(pe_top, axis=-1, keepdims=True)
    eidx = grp[:, None] * EXPERTS_PER_GROUP + e_in
    y = grouped_expert_ffn(hf, eidx, gate.astype(h.dtype), w1, w3, w2)
    return y.reshape(B, S, D)


def setup_inputs(seed: int = 0) -> dict:
    key = jax.random.key(seed)
    ks = jax.random.split(key, 32)
    f32 = jnp.float32
    L = DEPTH
    D = D_MODEL

    def nrm(k, shape, scale):
        return jax.random.normal(k, shape, f32) * scale

    f_bias = jnp.linspace(3.0, 6.0, M_HEADS, dtype=f32)
    return {
        'x': nrm(ks[0], (BATCH, SEQ, D), 1.0),
        'c': nrm(ks[1], (BATCH, D), 1.0),
        'positions': jnp.arange(SEQ, dtype=jnp.int32)[None, :] + jax.random.randint(ks[2], (BATCH, 1), 0, 1024, dtype=jnp.int32),
        'ada_w': nrm(ks[3], (L, D, 6 * D), 0.5 * D ** -0.5),
        'ada_b': nrm(ks[4], (L, 6 * D), 0.1),
        'norm_mix_pre': 1.0 + nrm(ks[5], (L, D), 0.05),
        'norm_mix_post': 1.0 + nrm(ks[6], (L, D), 0.05),
        'norm_ffn_pre': 1.0 + nrm(ks[7], (L, D), 0.05),
        'norm_ffn_post': 1.0 + nrm(ks[8], (L, D), 0.05),
        'w_in': nrm(ks[9], (L, D, IN_WIDTH), D ** -0.5),
        'mlstm_conv_w': nrm(ks[10], (L, M_CONV, 2 * M_WIDTH), M_CONV ** -0.5),
        'mlstm_gate_b': jnp.concatenate([nrm(ks[11], (L, M_HEADS), 0.1), f_bias[None, :] + nrm(ks[12], (L, M_HEADS), 0.1)], axis=-1),
        'mlstm_head_norm': 1.0 + nrm(ks[13], (L, M_WIDTH), 0.05),
        'cmp_pe_k': nrm(ks[14], (L, CMP_BLOCK, N_HEAD_DIM), 0.1),
        'cmp_w1_k': nrm(ks[15], (L, CMP_BLOCK * N_HEAD_DIM, CMP_HIDDEN), (CMP_BLOCK * N_HEAD_DIM) ** -0.5),
        'cmp_w2_k': nrm(ks[16], (L, CMP_HIDDEN, N_HEAD_DIM), CMP_HIDDEN ** -0.5),
        'cmp_pe_v': nrm(ks[17], (L, CMP_BLOCK, N_HEAD_DIM), 0.1),
        'cmp_w1_v': nrm(ks[18], (L, CMP_BLOCK * N_HEAD_DIM, CMP_HIDDEN), (CMP_BLOCK * N_HEAD_DIM) ** -0.5),
        'cmp_w2_v': nrm(ks[19], (L, CMP_HIDDEN, N_HEAD_DIM), CMP_HIDDEN ** -0.5),
        'w_out': nrm(ks[20], (L, D, D), D ** -0.5),
        'router_grp_w': nrm(ks[21], (L, D, MOE_GROUPS), D ** -0.5),
        'router_grp_b': nrm(ks[22], (L, MOE_GROUPS), 0.01),
        'router_exp_w': nrm(ks[23], (L, D, N_EXPERTS), D ** -0.5),
        'router_exp_b': nrm(ks[24], (L, N_EXPERTS), 0.01),
        'expert_w1': nrm(ks[25], (L, N_EXPERTS, D, EXPERT_FF), D ** -0.5),
        'expert_w3': nrm(ks[26], (L, N_EXPERTS, D, EXPERT_FF), D ** -0.5),
        'expert_w2': nrm(ks[27], (L, N_EXPERTS, EXPERT_FF, D), EXPERT_FF ** -0.5),
    }


def reference(x, c, positions, ada_w, ada_b, norm_mix_pre, norm_mix_post, norm_ffn_pre, norm_ffn_post, w_in, mlstm_conv_w, mlstm_gate_b, mlstm_head_norm, cmp_pe_k, cmp_w1_k, cmp_w2_k, cmp_pe_v, cmp_w1_v, cmp_w2_v, w_out, router_grp_w, router_grp_b, router_exp_w, router_exp_b, expert_w1, expert_w3, expert_w2):
    B, S, D = x.shape
    G, Dh = N_KV_GROUPS, N_HEAD_DIM

    def as_kv(t):
        return t.reshape(B, S, G, Dh)

    for l in range(DEPTH):
        mod = jax.nn.silu(c) @ ada_w[l] + ada_b[l]
        sh_m, sc_m, g_m, sh_f, sc_f, g_f = jnp.split(mod[:, None, :], 6, axis=-1)
        h = rms_norm(x, norm_mix_pre[l]) * (1.0 + sc_m) + sh_m
        (mq, mk, mv, mo, mi, mf, nq, kc, vc, ksl, vsl, kwn, vwn, ng) = split_cols(h @ w_in[l], IN_WIDTHS)
        y_m = mlstm_mixer(mq, mk, mv, mo, mi, mf, mlstm_conv_w[l], mlstm_gate_b[l], mlstm_head_norm[l])
        q = rope(nq.reshape(B, S, N_HEADS, Dh), positions)
        k_c = compress_kv(rope(as_kv(kc), positions), cmp_pe_k[l], cmp_w1_k[l], cmp_w2_k[l])
        v_c = compress_kv(as_kv(vc), cmp_pe_v[l], cmp_w1_v[l], cmp_w2_v[l])
        y_n = nsa_attention(q, k_c, v_c, rope(as_kv(ksl), positions), as_kv(vsl), rope(as_kv(kwn), positions), as_kv(vwn), jax.nn.sigmoid(ng.reshape(B, S, N_HEADS, 3)))
        y = jnp.concatenate([y_m, y_n], axis=-1) @ w_out[l]
        x = x + g_m * rms_norm(y, norm_mix_post[l])
        h = rms_norm(x, norm_ffn_pre[l]) * (1.0 + sc_f) + sh_f
        y = hier_moe(h, router_grp_w[l], router_grp_b[l], router_exp_w[l], router_exp_b[l], expert_w1[l], expert_w3[l], expert_w2[l])
        x = x + g_f * rms_norm(y, norm_ffn_post[l])
    return x
```

```cpp
#include <hip/hip_runtime.h>
#include <cstdio>
#include <cstdint>
#include <type_traits>

#define LAS __attribute__((address_space(3)))
typedef unsigned short bf16_t;
typedef short bf16x8 __attribute__((ext_vector_type(8)));
typedef short s16x4 __attribute__((ext_vector_type(4)));
typedef float f32x4 __attribute__((ext_vector_type(4)));
typedef float f32x16 __attribute__((ext_vector_type(16)));
typedef unsigned u32x4 __attribute__((ext_vector_type(4)));
typedef unsigned u32x2 __attribute__((ext_vector_type(2)));
typedef int i32x4 __attribute__((ext_vector_type(4)));
typedef _Float16 f16x8 __attribute__((ext_vector_type(8)));
typedef _Float16 f16x4 __attribute__((ext_vector_type(4)));

#ifndef MK_N_LAUNCHES
#define MK_N_LAUNCHES 1
#endif
#ifndef DBG_CHECK
#define DBG_CHECK 0
#endif
#ifndef REP_MASK
#define REP_MASK 0
#endif
#ifndef REP_SUB
#define REP_SUB 0
#endif
#ifndef NSA_DUP
#define NSA_DUP 0
#endif
#define NDUP(b) _Pragma("nounroll") for (int nd_ = 0; nd_ <= ((NSA_DUP >> (b)) & 1); ++nd_)
#define REPS(b) _Pragma("nounroll") for (int rs_ = 0; rs_ <= ((REP_SUB >> (b)) & 1); ++rs_)

constexpr int NB = 8, SEQ = 4096, DM = 1024, NTOK = NB * SEQ;
constexpr int MH = 4, MDH = 128;
constexpr int NHD = 8, NGRP = 2;
constexpr int INW = 3360, INWP = 3584;
constexpr int NEXP = 32, EFF = 512;
constexpr float RMS_EPS = 1e-6f;
constexpr float QSCALE = 0.125f * 1.4426950408889634f;
constexpr int NWAVES = 8, NTHR = 512;
constexpr int LDS_BYTES = 160 * 1024, MISC_OFF = 128 * 1024;
constexpr int MAXROWS = 73728;

constexpr size_t MiB = 1ull << 20, KiB = 1024;
constexpr size_t WS_CTL   = 0;
constexpr size_t WS_MOD   = 64 * KiB;
constexpr size_t WS_C1B   = WS_MOD + 192 * KiB;
constexpr size_t WS_GI    = WS_C1B + 4 * KiB;
constexpr size_t WS_GF    = WS_GI + 512 * KiB;
constexpr size_t WS_NGT   = WS_GF + 512 * KiB;
constexpr size_t WS_GSUM  = WS_NGT + 3 * MiB;
constexpr size_t WS_MLOC  = WS_GSUM + 8 * KiB;
constexpr size_t WS_MPREV = WS_MLOC + 8 * KiB;
constexpr size_t WS_NC    = WS_MPREV + 8 * KiB;
constexpr size_t WS_NPREV = WS_NC + 1 * MiB;
constexpr size_t WS_COS   = WS_NPREV + 1 * MiB;
constexpr size_t WS_SIN   = WS_COS + 4 * MiB;
constexpr size_t WS_WOUTT = WS_SIN + 4 * MiB;
constexpr size_t WS_CW1K  = WS_WOUTT + 2 * MiB;
constexpr size_t WS_CW1V  = WS_CW1K + 512 * KiB;
constexpr size_t WS_CW2K  = WS_CW1V + 512 * KiB;
constexpr size_t WS_CW2V  = WS_CW2K + 16 * KiB;
constexpr size_t WS_RWT   = WS_CW2V + 16 * KiB;
constexpr size_t WS_RWL   = WS_RWT + 96 * KiB;
constexpr size_t WS_KCMP  = WS_RWL + 96 * KiB;
constexpr size_t WS_VCMP  = WS_KCMP + 512 * KiB;
constexpr size_t WS_TOKE  = WS_VCMP + 512 * KiB;
constexpr size_t WS_TOKP  = WS_TOKE + 256 * KiB;
constexpr size_t WS_TOKG  = WS_TOKP + 256 * KiB;
constexpr size_t WS_LIST  = WS_TOKG + 256 * KiB;
constexpr size_t WS_SA    = WS_LIST + 8 * MiB;
constexpr size_t WS_SB13  = WS_SA + 128 * KiB;
constexpr size_t WS_SA1   = WS_SB13 + 128 * KiB;
constexpr size_t WS_SBW   = WS_SA1 + 128 * KiB;
constexpr size_t WS_SMALL_END = WS_SBW + 16 * KiB;
static_assert(WS_SMALL_END <= 32 * MiB, "small region overflow");
constexpr size_t WS_A     = 32 * MiB;
constexpr size_t WS_H1    = WS_A, WS_KVC = WS_A, WS_W13T = WS_A;
constexpr size_t WS_NQ    = 96 * MiB;
constexpr size_t WS_KC    = 128 * MiB, WS_VC = 136 * MiB, WS_KSL = 144 * MiB, WS_VSL = 152 * MiB, WS_KWN = 160 * MiB, WS_VWN = 168 * MiB;
constexpr size_t WS_W2T   = 96 * MiB;
constexpr size_t WS_MQ    = 176 * MiB, WS_MK = 208 * MiB, WS_MV = 240 * MiB, WS_MO = 272 * MiB;
constexpr size_t WS_Y     = 176 * MiB;
constexpr size_t WS_H2    = 240 * MiB;
constexpr size_t WS_CPREV = 304 * MiB;
constexpr size_t WS_WINT  = 304 * MiB;
constexpr size_t WS_HB    = 304 * MiB;
constexpr size_t WS_H2LO  = 304 * MiB;
constexpr size_t WS_YCAT  = 376 * MiB;
constexpr size_t WS_X1B   = 376 * MiB;
constexpr size_t WS_YB    = 128 * MiB;
constexpr size_t WS_H2Q   = 128 * MiB;
constexpr size_t WS_SAL   = 440 * MiB;
constexpr size_t WS_END   = 448 * MiB;

constexpr int CW_BAR = 0;
constexpr int CW_CNT = 4096;
constexpr int CW_DBG = 4200;

typedef __bf16 bf16x2_t __attribute__((ext_vector_type(2)));
typedef float f32x2_t __attribute__((ext_vector_type(2)));
__device__ __forceinline__ unsigned cvtpk(float lo, float hi) { const f32x2_t f = {lo, hi}; const bf16x2_t v = __builtin_convertvector(f, bf16x2_t); return __builtin_bit_cast(unsigned, v); }
__device__ __forceinline__ float bf2f(bf16_t b) { return __uint_as_float(((unsigned)b) << 16); }
__device__ __forceinline__ float bflo(unsigned w) { return __uint_as_float(w << 16); }
__device__ __forceinline__ float bfhi(unsigned w) { return __uint_as_float(w & 0xffff0000u); }
__device__ __forceinline__ bf16_t f2bf(float f) { return (bf16_t)(cvtpk(f, 0.f) & 0xffffu); }
__device__ __forceinline__ float wave_sum(float v) {
#pragma unroll
    for (int o = 1; o < 64; o <<= 1) v += __shfl_xor(v, o);
    return v;
}
__device__ __forceinline__ float wave_max(float v) {
#pragma unroll
    for (int o = 1; o < 64; o <<= 1) v = fmaxf(v, __shfl_xor(v, o));
    return v;
}
__device__ __forceinline__ float sigmoid_f(float x) { return __builtin_amdgcn_rcpf(1.f + __builtin_amdgcn_exp2f(-1.4426950408889634f * x)); }
__device__ __forceinline__ float silu_f(float x) { return x * __builtin_amdgcn_rcpf(1.f + __builtin_amdgcn_exp2f(-1.4426950408889634f * x)); }
__device__ __forceinline__ float logsigmoid_f(float x) { return fminf(x, 0.f) - log1pf(__expf(-fabsf(x))); }
__device__ __forceinline__ float ex2(float x) { return __builtin_amdgcn_exp2f(x); }
#define MFMA32(a, b, c) __builtin_amdgcn_mfma_f32_32x32x16_bf16(a, b, c, 0, 0, 0)
#define MFMA16(a, b, c) __builtin_amdgcn_mfma_f32_16x16x32_bf16(a, b, c, 0, 0, 0)
typedef short v4i16_t __attribute__((ext_vector_type(4)));
__device__ __forceinline__ s16x4 vtr(LAS const unsigned char* p) { return __builtin_bit_cast(s16x4, __builtin_amdgcn_ds_read_tr16_b64_v4i16((LAS v4i16_t*)p)); }
__device__ __forceinline__ int crow(int r, int hi) { return (r & 3) + 8 * (r >> 2) + 4 * hi; }
__device__ __forceinline__ u32x4 widen_pair(u32x2 A, u32x2 B) {
    const auto r0 = __builtin_amdgcn_permlane32_swap(A.x, B.x, false, false); const auto r1 = __builtin_amdgcn_permlane32_swap(A.y, B.y, false, false);
    return (u32x4){r0[0], r1[0], r0[1], r1[1]}; }
__device__ __forceinline__ u32x4 widen_rows16(u32x2 X, u32x2 Y) {
    const auto r0 = __builtin_amdgcn_permlane16_swap(X.x, Y.x, false, false); const auto r1 = __builtin_amdgcn_permlane16_swap(X.y, Y.y, false, false);
    return (u32x4){r0[0], r1[0], r0[1], r1[1]}; }
__device__ __forceinline__ bf16x8 mk8(s16x4 lo, s16x4 hi) { return (bf16x8){lo[0], lo[1], lo[2], lo[3], hi[0], hi[1], hi[2], hi[3]}; }

#define XB_TMO      128
#define XB_XCNT(j)  (256  + 64 * (j))
#define XB_XSUB(j)  (1280 + 64 * (j))
#define XB_XGEN(j)  (2304 + 64 * (j))
#define XB_TOP      3328
#define XB_TOPGEN   3392
#define XCD_BAR_WORDS 3456
#define XB_SPIN_CAP (1u << 18)
__device__ __forceinline__ unsigned xb_ld(unsigned* p)              { return __hip_atomic_load(p, __ATOMIC_RELAXED, __HIP_MEMORY_SCOPE_AGENT); }
__device__ __forceinline__ unsigned xb_add(unsigned* p, unsigned v) { return __hip_atomic_fetch_add(p, v, __ATOMIC_RELAXED, __HIP_MEMORY_SCOPE_AGENT); }
__device__ __forceinline__ unsigned xb_xcc_id() { return (unsigned)__builtin_amdgcn_s_getreg((3 << 11) | 20) & 0xFu; }
#define XB_SPIN(cond, bar) do { unsigned _sp = 0; while (cond) { __builtin_amdgcn_s_sleep(1); \
    if ((++_sp & 255u) == 0u) { if (xb_ld(&(bar)[XB_TMO])) break; if (_sp > XB_SPIN_CAP) { atomicAdd(&(bar)[XB_TMO], 1u); break; } } } } while (0)
struct XcdBarrier { unsigned* bar; unsigned x; volatile LAS unsigned* st; };
__device__ __forceinline__ XcdBarrier xcd_barrier_post(unsigned* bar, volatile LAS unsigned* st) {
    XcdBarrier b; b.bar = bar; b.x = xb_xcc_id(); b.st = st;
    if (threadIdx.x == 0) (void)xb_add(&bar[XB_XCNT(b.x)], 1u);
    return b;
}
__device__ __forceinline__ void xcd_barrier_complete(unsigned* bar, unsigned x, unsigned& nloc, unsigned& nx) {
    const unsigned G = gridDim.x * gridDim.y * gridDim.z;
    unsigned sum, cnt, mine, sp = 0u;
    for (;;) {
        sum = 0u; cnt = 0u; mine = 0u;
#pragma unroll
        for (unsigned j = 0; j < 16; ++j) { const unsigned c = xb_ld(&bar[XB_XCNT(j)]); sum += c; cnt += (c > 0u) ? 1u : 0u; mine = (j == x) ? c : mine; }
        if (sum == G) break;
        __builtin_amdgcn_s_sleep(1);
        if ((++sp & 255u) == 0u) { if (xb_ld(&bar[XB_TMO])) break; if (sp > XB_SPIN_CAP) { atomicAdd(&bar[XB_TMO], 1u); break; } }
    }
    nloc = mine > 0u ? mine : 1u; nx = cnt > 0u ? cnt : 1u;
}
__device__ __forceinline__ void xcd_barrier(const XcdBarrier& b) {
    asm volatile("s_waitcnt vmcnt(0)" ::: "memory");
    __syncthreads();
    if (threadIdx.x == 0) {
        unsigned* bar = b.bar;
        __builtin_amdgcn_s_waitcnt(0);
        unsigned nloc = b.st[0], nx = b.st[1];
        if (nloc == 0u) { xcd_barrier_complete(bar, b.x, nloc, nx); b.st[0] = nloc; b.st[1] = nx; }
        const unsigned old = xb_add(&bar[XB_XSUB(b.x)], 1u);
        const unsigned gen = old / nloc;
        if (old + 1u == (gen + 1u) * nloc) {
            __builtin_amdgcn_fence(__ATOMIC_RELEASE, "agent");
            asm volatile("s_waitcnt vmcnt(0)" ::: "memory");
            const unsigned og = xb_add(&bar[XB_TOP], 1u);
            const unsigned tg = og / nx;
            if (og + 1u == (tg + 1u) * nx) xb_add(&bar[XB_TOPGEN], 1u);
            else XB_SPIN(xb_ld(&bar[XB_TOPGEN]) == tg, bar);
            __builtin_amdgcn_fence(__ATOMIC_ACQUIRE, "agent");
            xb_add(&bar[XB_XGEN(b.x)], 1u);
            asm volatile("s_waitcnt vmcnt(0)" ::: "memory");
        } else {
            XB_SPIN(xb_ld(&bar[XB_XGEN(b.x)]) == gen, bar);
            __builtin_amdgcn_fence(__ATOMIC_ACQUIRE, "agent");
            asm volatile("s_waitcnt vmcnt(0)" ::: "memory");
        }
    }
    __syncthreads();
}

struct Args { const void* in[27]; float* out; unsigned char* ws; int ph_lo, ph_hi; };
struct Frame {
    LAS unsigned char* lds;
    const void* const* in; float* out; unsigned char* ws;
    int tid, lane, wave, vcu, G;
};
#define IN_F(k) ((const float*)F.in[k])
#define WSP(T, off) ((T*)(F.ws + (off)))

namespace pg8 {
constexpr int BM = 256, BK = 64, HALF = 128, HTB = HALF * BK * 2, STAGE_BYTES = 8 * HTB, NXCD = 8, WGM = 8;
__host__ __device__ __forceinline__ int lds_byte(int r, int c) { const int st = (r >> 4) * 2 + (c >> 5), rr = r & 15, cc = c & 31, ob = rr * 64 + cc * 2; return st * 1024 + (ob ^ (((ob >> 9) & 1) << 5)); }
__host__ __device__ __forceinline__ void stage_rc(int b, int& R, int& C) { const int st = b / 1024, sb = b % 1024, swz = sb ^ (((sb >> 9) & 1) << 5); R = (st >> 1) * 16 + swz / 64; C = (st & 1) * 32 + (swz % 64) / 2; }
__host__ __device__ __forceinline__ int perm32(int rho) { const int n = rho >> 4, i = rho & 15; return 8 * (i >> 2) + 4 * n + (i & 3); }
struct Unit { int pm, pn, e, nrow; };

template <bool I8, class Epi, class Sched>
__device__ __forceinline__ void gemm_phase(LAS unsigned char* lds, const void* Abase, const void* Bbase, const int K, const Sched& S, const Epi& E) {
    const int tid = threadIdx.x, wid = __builtin_amdgcn_readfirstlane(tid >> 6), lane = tid & 63, wr = wid >> 2, wc = wid & 3, fr = lane & 15, fq = lane >> 4;
    const int nt = K / BK;
    int Rr[2], Cc[2]; unsigned voffB[2];
#pragma unroll
    for (int i = 0; i < 2; ++i) { int R, C; stage_rc(tid * 16 + i * 8192, R, C); Rr[i] = R; Cc[i] = C; const int Rb = (R & ~31) + perm32(R & 31); voffB[i] = (unsigned)(Rb * K + C) * 2u; }
    const size_t kstep = (size_t)(BK * 2);
    const size_t hstepB = (size_t)HALF * K * 2;
    const unsigned ldsw = (unsigned)wid * 1024u;
    const int aoff = lds_byte(wr * 64 + fr, fq * 8), boff = lds_byte(wc * 32 + fr, fq * 8);
#define PG8_SA(b, h) (((b) * 2 + (h)) * HTB)
#define PG8_SB(b, h) ((4 + (b) * 2 + (h)) * HTB)
#define PG8_STAGEB(bufoff, gbase) do { _Pragma("unroll") for (int _i = 0; _i < 2; ++_i) \
        __builtin_amdgcn_global_load_lds((const unsigned*)((const char*)(gbase) + voffB[_i]), (LAS unsigned*)(lds + (bufoff) + ldsw + _i * 8192), 16, 0, 0); } while (0)
#define PG8_STAGEA(bufoff, o0, o1, ktb) do { const char* _p = (const char*)Abase + (ktb); \
        __builtin_amdgcn_global_load_lds((const unsigned*)(_p + (o0)), (LAS unsigned*)(lds + (bufoff) + ldsw), 16, 0, 0); \
        __builtin_amdgcn_global_load_lds((const unsigned*)(_p + (o1)), (LAS unsigned*)(lds + (bufoff) + ldsw + 8192), 16, 0, 0); } while (0)
#define PG8_LDA(dst, b, h) do { _Pragma("unroll") for (int m = 0; m < 4; ++m) _Pragma("unroll") for (int k = 0; k < 2; ++k) dst[m][k] = *(const LAS bf16x8*)(lds + PG8_SA(b, h) + aoff + m * 2048 + k * 1024); } while (0)
#define PG8_LDB(dst, b, h) do { _Pragma("unroll") for (int n = 0; n < 2; ++n) _Pragma("unroll") for (int k = 0; k < 2; ++k) dst[n][k] = *(const LAS bf16x8*)(lds + PG8_SB(b, h) + boff + n * 2048 + k * 1024); } while (0)
#define PG8_MMA(ai, bj, At, Bt) do { __builtin_amdgcn_s_setprio(1); _Pragma("unroll") for (int m = 0; m < 4; ++m) _Pragma("unroll") for (int n = 0; n < 2; ++n) _Pragma("unroll") for (int k = 0; k < 2; ++k) { \
        if constexpr (I8) acc[ai][bj][m][n] = __builtin_bit_cast(acc_t, __builtin_amdgcn_mfma_i32_16x16x64_i8(__builtin_bit_cast(i32x4, Bt[n][k]), __builtin_bit_cast(i32x4, At[m][k]), __builtin_bit_cast(i32x4, acc[ai][bj][m][n]), 0, 0, 0)); \
        else acc[ai][bj][m][n] = __builtin_bit_cast(acc_t, __builtin_amdgcn_mfma_f32_16x16x32_bf16(Bt[n][k], At[m][k], __builtin_bit_cast(f32x4, acc[ai][bj][m][n]), 0, 0, 0)); } __builtin_amdgcn_s_setprio(0); } while (0)
#define PG8_WAIT_V(n) asm volatile("s_waitcnt vmcnt(" #n ")" ::: "memory")
#define PG8_WAIT_L(n) asm volatile("s_waitcnt lgkmcnt(" #n ")" ::: "memory")
#define PG8_BAR __builtin_amdgcn_s_barrier()
#define PG8_SCHED __builtin_amdgcn_sched_barrier(0)
    Unit cur, nxt; int ui = 0;
    if (!S.next(0, cur)) return;
    using acc_t = typename std::conditional<I8, i32x4, f32x4>::type;
    acc_t acc[2][2][4][2];
#pragma unroll
    for (int a = 0; a < 2; ++a)
#pragma unroll
        for (int b = 0; b < 2; ++b)
#pragma unroll
            for (int m = 0; m < 4; ++m)
#pragma unroll
                for (int n = 0; n < 2; ++n) acc[a][b][m][n] = __builtin_bit_cast(acc_t, (u32x4){0u, 0u, 0u, 0u});
    bf16x8 At[4][2], B0[2][2], B1[2][2];
    unsigned oc00, oc01, oc10, oc11, on00, on01, on10, on11;
    oc00 = S.a_off(cur, Rr[0]) + Cc[0] * 2; oc01 = S.a_off(cur, Rr[1]) + Cc[1] * 2; oc10 = S.a_off(cur, HALF + Rr[0]) + Cc[0] * 2; oc11 = S.a_off(cur, HALF + Rr[1]) + Cc[1] * 2;
    const char* cB = (const char*)Bbase + S.b_off(cur);
    PG8_STAGEB(PG8_SB(0, 0), cB); PG8_STAGEA(PG8_SA(0, 0), oc00, oc01, 0); PG8_STAGEB(PG8_SB(0, 1), cB + hstepB); PG8_STAGEA(PG8_SA(0, 1), oc10, oc11, 0);
    if (wr == 1) PG8_BAR;
    PG8_WAIT_V(4); PG8_BAR;
    PG8_STAGEB(PG8_SB(1, 0), cB + kstep); PG8_STAGEA(PG8_SA(1, 0), oc00, oc01, kstep); PG8_STAGEB(PG8_SB(1, 1), cB + hstepB + kstep);
    PG8_WAIT_V(6); PG8_BAR;
    for (;;) {
        E.pre(cur, lds, wid, lane, ui & 1);
        const bool has_next = S.next(ui + 1, nxt);
        const char* nB = cB;
        if (has_next) { on00 = S.a_off(nxt, Rr[0]) + Cc[0] * 2; on01 = S.a_off(nxt, Rr[1]) + Cc[1] * 2; on10 = S.a_off(nxt, HALF + Rr[0]) + Cc[0] * 2; on11 = S.a_off(nxt, HALF + Rr[1]) + Cc[1] * 2; nB = (const char*)Bbase + S.b_off(nxt); }
        else { on00 = oc00; on01 = oc01; on10 = oc10; on11 = oc11; }
        for (int t = 0; t < nt; t += 2) {
            const bool last = (t == nt - 2);
            const size_t k1 = (size_t)(t + 1) * kstep;
            const size_t k2 = last ? 0 : (size_t)(t + 2) * kstep, k3 = k2 + kstep;
            const unsigned o200 = last ? on00 : oc00, o201 = last ? on01 : oc01, o210 = last ? on10 : oc10, o211 = last ? on11 : oc11;
            const char* b2 = last ? nB : cB + (size_t)(t + 2) * kstep; const char* b3 = b2 + kstep;
            PG8_LDB(B0, 0, 0); PG8_SCHED; PG8_LDA(At, 0, 0); PG8_STAGEA(PG8_SA(1, 1), oc10, oc11, k1);
            PG8_WAIT_L(8); PG8_BAR; PG8_WAIT_L(0); PG8_MMA(0, 0, At, B0); PG8_BAR; PG8_SCHED;
            PG8_LDB(B1, 0, 1); PG8_STAGEB(PG8_SB(0, 0), b2);
            PG8_BAR; PG8_WAIT_L(0); PG8_MMA(0, 1, At, B1); PG8_BAR;
            PG8_LDA(At, 0, 1); PG8_STAGEA(PG8_SA(0, 0), o200, o201, k2);
            PG8_BAR; PG8_WAIT_L(0); PG8_MMA(1, 0, At, B0); PG8_BAR; PG8_SCHED;
            PG8_STAGEB(PG8_SB(0, 1), b2 + hstepB);
            PG8_WAIT_V(6); PG8_BAR; PG8_MMA(1, 1, At, B1); PG8_BAR;
            PG8_LDB(B0, 1, 0); PG8_SCHED; PG8_LDA(At, 1, 0); PG8_STAGEA(PG8_SA(0, 1), o210, o211, k2);
            PG8_WAIT_L(8); PG8_BAR; PG8_WAIT_L(0); PG8_MMA(0, 0, At, B0); PG8_BAR; PG8_SCHED;
            PG8_LDB(B1, 1, 1); PG8_STAGEB(PG8_SB(1, 0), b3);
            PG8_BAR; PG8_WAIT_L(0); PG8_MMA(0, 1, At, B1); PG8_BAR;
            PG8_LDA(At, 1, 1); PG8_STAGEA(PG8_SA(1, 0), o200, o201, k3);
            PG8_BAR; PG8_WAIT_L(0); PG8_MMA(1, 0, At, B0); PG8_BAR; PG8_SCHED;
            PG8_STAGEB(PG8_SB(1, 1), b3 + hstepB);
            PG8_WAIT_V(6); PG8_BAR; PG8_MMA(1, 1, At, B1); PG8_BAR;
        }
        E(acc, cur, wr, wc, fr, fq, ui & 1);
        if (!has_next) break;
#pragma unroll
        for (int a = 0; a < 2; ++a)
#pragma unroll
            for (int b = 0; b < 2; ++b)
#pragma unroll
                for (int m = 0; m < 4; ++m)
#pragma unroll
                    for (int n = 0; n < 2; ++n) acc[a][b][m][n] = __builtin_bit_cast(acc_t, (u32x4){0u, 0u, 0u, 0u});
        cur = nxt; cB = nB; oc00 = on00; oc01 = on01; oc10 = on10; oc11 = on11; ++ui;
    }
    PG8_WAIT_V(0);
    if (wr == 0) PG8_BAR;
    PG8_BAR;
#undef PG8_SA
#undef PG8_SB
#undef PG8_STAGEA
#undef PG8_STAGEB
#undef PG8_LDA
#undef PG8_LDB
#undef PG8_MMA
#undef PG8_WAIT_V
#undef PG8_WAIT_L
#undef PG8_BAR
#undef PG8_SCHED
}

struct DenseOrder {
    int nM, nN, nwg, G, c, K;
    __device__ void init(int M, int N, int K_, int G_, int c_) { nM = M / BM; nN = N / BM; nwg = nM * nN; G = G_; c = c_; K = K_; }
    __device__ __forceinline__ bool next(int i, Unit& u) const {
        const long L = (long)i * G + c; if (L >= nwg) return false;
        int wgid = (int)L; { const int q = nwg / NXCD, r = nwg % NXCD, xcd = wgid % NXCD, off = wgid / NXCD; wgid = (xcd < r ? xcd * (q + 1) : r * (q + 1) + (xcd - r) * q) + off; }
        const int nig = WGM * nN, gid = wgid / nig, fm = gid * WGM, gsz = (nM - fm) < WGM ? (nM - fm) : WGM;
        u.pm = fm + ((wgid % nig) % gsz); u.pn = (wgid % nig) / gsz; u.e = 0; u.nrow = 256; return true;
    }
    __device__ __forceinline__ unsigned a_off(const Unit& u, int R) const { return (unsigned)((u.pm * BM + R) * K) * 2u; }
    __device__ __forceinline__ size_t b_off(const Unit& u) const { return (size_t)u.pn * BM * K * 2; }
};
struct MoeOrder {
    const LAS int* tstart; const LAS int* cnt; const int* list; int G, c, K, npn; bool gather;
    __device__ __forceinline__ bool next(int i, Unit& u) const {
        const int L = i * G + c; const int tt = tstart[32];
        if (L >= tt * npn) return false;
        const int tile = L / npn; u.pn = L % npn; u.pm = tile;
        int e = 0;
#pragma unroll 1
        for (int k = 1; k < 32; ++k) if (tstart[k] <= tile) e = k;
        u.e = e; u.nrow = cnt[e] - (tile - tstart[e]) * 256; return true;
    }
    __device__ __forceinline__ unsigned a_off(const Unit& u, int R) const {
        if (gather) { const int mt = u.pm - tstart[u.e]; const int r = mt * 256 + R; const int tok = list[(size_t)u.e * 65536 + (R < u.nrow ? r : 0)]; return (unsigned)(tok * K) * 2u; }
        return (unsigned)((u.pm * BM + R) * K) * 2u;
    }
    __device__ __forceinline__ size_t b_off(const Unit& u) const { return ((size_t)u.e * 1024 + (size_t)u.pn * BM) * K * 2; }
};
}

constexpr int EPI_SC = MISC_OFF + 24576;
struct EpiIn {
    unsigned char* ws; const float* gate_b;
    __device__ __forceinline__ void pre(const pg8::Unit& u, LAS unsigned char* lds, int wid, int lane, int par) const {
        if (wid == 0) { __builtin_amdgcn_global_load_lds((const unsigned*)((const float*)(ws + WS_SA1) + u.pm * 256 + lane * 4), (LAS unsigned*)(lds + EPI_SC + par * 2048), 16, 0, 0);
                        __builtin_amdgcn_global_load_lds((const unsigned*)((const float*)(ws + WS_SBW) + u.pn * 256 + lane * 4), (LAS unsigned*)(lds + EPI_SC + par * 2048 + 1024), 16, 0, 0); } }
    LAS unsigned char* lds;
    __device__ __forceinline__ void operator()(const i32x4 (&acc)[2][2][4][2], const pg8::Unit& u, int wr, int wc, int fr, int fq, int par) const {
        asm volatile("" : "+v"(fr), "+v"(fq));
        const int pn = u.pn, row0 = u.pm * 256 + wr * 64 + fr;
        float sa[2][4]; f32x4 sb[2][2];
        { LAS const float* SA1 = (LAS const float*)(lds + EPI_SC + par * 2048); LAS const float* SBW = SA1 + 256;
#pragma unroll
          for (int ai = 0; ai < 2; ++ai)
#pragma unroll
              for (int m = 0; m < 4; ++m) sa[ai][m] = SA1[wr * 64 + fr + ai * 128 + m * 16];
#pragma unroll
          for (int bj = 0; bj < 2; ++bj)
#pragma unroll
              for (int n = 0; n < 2; ++n) sb[bj][n] = *(LAS const f32x4*)(SBW + bj * 128 + wc * 32 + 8 * fq + 4 * n); }
#define ACCF(ai, bj, m, n) (__builtin_convertvector(acc[ai][bj][m][n], f32x4) * sa[ai][m] * sb[bj][n])
        if (pn < 8) {
            bf16_t* dst = (bf16_t*)(ws + (pn < 2 ? WS_MQ : pn < 4 ? WS_MK : pn < 6 ? WS_MV : WS_MO));
            const int col0 = (pn & 1) * 256 + wc * 32 + 8 * fq;
#pragma unroll
            for (int ai = 0; ai < 2; ++ai)
#pragma unroll
                for (int m = 0; m < 4; ++m) { bf16_t* rp = dst + (size_t)(row0 + ai * 128 + m * 16) * 512 + col0;
#pragma unroll
                    for (int bj = 0; bj < 2; ++bj) { const f32x4 v0 = ACCF(ai, bj, m, 0), v1 = ACCF(ai, bj, m, 1);
                        u32x4 w; w.x = cvtpk(v0[0], v0[1]); w.y = cvtpk(v0[2], v0[3]); w.z = cvtpk(v1[0], v1[1]); w.w = cvtpk(v1[2], v1[3]);
                        *(u32x4*)(rp + bj * 128) = w; } }
        } else if (pn < 10) {
            const int g8 = 4 * (wc & 1) + fq; const float* COS = (const float*)(ws + WS_COS); const float* SIN = (const float*)(ws + WS_SIN); bf16_t* NQ = (bf16_t*)(ws + WS_NQ);
#pragma unroll
            for (int ai = 0; ai < 2; ++ai)
#pragma unroll
                for (int m = 0; m < 4; ++m) { const int row = row0 + ai * 128 + m * 16;
                    const f32x4 cs = *(const f32x4*)(COS + (size_t)row * 32 + 4 * g8), sn = *(const f32x4*)(SIN + (size_t)row * 32 + 4 * g8);
#pragma unroll
                    for (int bj = 0; bj < 2; ++bj) { const int head = (pn - 8) * 4 + bj * 2 + (wc >> 1);
                        const f32x4 x1 = ACCF(ai, bj, m, 0), x2 = ACCF(ai, bj, m, 1);
                        const f32x4 o1 = (x1 * cs - x2 * sn) * QSCALE, o2 = (x2 * cs + x1 * sn) * QSCALE;
                        bf16_t* rp = NQ + (size_t)row * 512 + head * 64 + 4 * (g8 & ~1) + 32 * (fq & 1);
                        u32x2 a; a.x = cvtpk(o1[0], o1[1]); a.y = cvtpk(o1[2], o1[3]);
                        u32x2 b; b.x = cvtpk(o2[0], o2[1]); b.y = cvtpk(o2[2], o2[3]); *(u32x4*)rp = widen_rows16(a, b); } }
        } else if (pn < 13) {
            bf16_t* kd = (bf16_t*)(ws + (pn == 10 ? WS_KC : pn == 11 ? WS_KSL : WS_KWN)); bf16_t* vd = (bf16_t*)(ws + (pn == 10 ? WS_VC : pn == 11 ? WS_VSL : WS_VWN));
            const float* COS = (const float*)(ws + WS_COS); const float* SIN = (const float*)(ws + WS_SIN);
            const int g8 = 4 * (wc & 1) + fq, grp = wc >> 1;
#pragma unroll
            for (int ai = 0; ai < 2; ++ai)
#pragma unroll
                for (int m = 0; m < 4; ++m) { const int row = row0 + ai * 128 + m * 16; const int b = row >> 12, s = row & 4095;
                    const f32x4 cs = *(const f32x4*)(COS + (size_t)row * 32 + 4 * g8), sn = *(const f32x4*)(SIN + (size_t)row * 32 + 4 * g8);
                    const size_t rbase = ((size_t)(b * 2 + grp) * SEQ + s) * 64;
                    { const f32x4 x1 = ACCF(ai, 0, m, 0), x2 = ACCF(ai, 0, m, 1);
                      const f32x4 o1 = x1 * cs - x2 * sn, o2 = x2 * cs + x1 * sn;
                      bf16_t* rp = kd + rbase + 4 * (g8 & ~1) + 32 * (fq & 1);
                      u32x2 a; a.x = cvtpk(o1[0], o1[1]); a.y = cvtpk(o1[2], o1[3]);
                      u32x2 c; c.x = cvtpk(o2[0], o2[1]); c.y = cvtpk(o2[2], o2[3]); *(u32x4*)rp = widen_rows16(a, c); }
                    { const f32x4 v0 = ACCF(ai, 1, m, 0), v1 = ACCF(ai, 1, m, 1);
                      u32x4 w; w.x = cvtpk(v0[0], v0[1]); w.y = cvtpk(v0[2], v0[3]); w.z = cvtpk(v1[0], v1[1]); w.w = cvtpk(v1[2], v1[3]);
                      *(u32x4*)(vd + rbase + (wc & 1) * 32 + 8 * fq) = w; } }
        } else {
            if (wc == 0) { float* GI = (float*)(ws + WS_GI); float* GF = (float*)(ws + WS_GF); float* NGT = (float*)(ws + WS_NGT);
#pragma unroll
                for (int ai = 0; ai < 2; ++ai)
#pragma unroll
                    for (int m = 0; m < 4; ++m) { const int row = row0 + ai * 128 + m * 16; const int b = row >> 12, s = row & 4095;
#pragma unroll
                        for (int n = 0; n < 2; ++n) { const f32x4 v = ACCF(ai, 0, m, n);
                            if (fq == 0) {
#pragma unroll
                                for (int i = 0; i < 4; ++i) { const float z = v[i] + gate_b[4 * n + i];
                                    if (n == 0) GI[(size_t)(b * 4 + i) * SEQ + s] = z; else GF[(size_t)(b * 4 + i) * SEQ + s] = logsigmoid_f(z); }
                            } else {
                                f32x4 o; o[0] = sigmoid_f(v[0]); o[1] = sigmoid_f(v[1]); o[2] = sigmoid_f(v[2]); o[3] = sigmoid_f(v[3]);
                                *(f32x4*)(NGT + (size_t)row * 24 + 8 * fq + 4 * n - 8) = o; } } }
            }
        }
    }
};
#undef ACCF
struct EpiBf16 {
    bf16_t* O; int ldc;
    __device__ __forceinline__ void pre(const pg8::Unit&, LAS unsigned char*, int, int, int) const {}
    __device__ __forceinline__ void operator()(const f32x4 (&acc)[2][2][4][2], const pg8::Unit& u, int wr, int wc, int fr, int fq, int par) const {
        asm volatile("" : "+v"(fr), "+v"(fq));
        const int row0 = u.pm * 256 + wr * 64 + fr, col0 = u.pn * 256 + wc * 32 + 8 * fq;
#pragma unroll
        for (int ai = 0; ai < 2; ++ai)
#pragma unroll
            for (int m = 0; m < 4; ++m) { bf16_t* rp = O + (size_t)(row0 + ai * 128 + m * 16) * ldc + col0;
#pragma unroll
                for (int bj = 0; bj < 2; ++bj) { const f32x4 v0 = acc[ai][bj][m][0], v1 = acc[ai][bj][m][1];
                    u32x4 w; w.x = cvtpk(v0[0], v0[1]); w.y = cvtpk(v0[2], v0[3]); w.z = cvtpk(v1[0], v1[1]); w.w = cvtpk(v1[2], v1[3]);
                    *(u32x4*)(rp + bj * 128) = w; } }
    }
};
struct EpiUp {
    bf16_t* HB;
    __device__ __forceinline__ void pre(const pg8::Unit&, LAS unsigned char*, int, int, int) const {}
    __device__ __forceinline__ void operator()(const f32x4 (&acc)[2][2][4][2], const pg8::Unit& u, int wr, int wc, int fr, int fq, int par) const {
        asm volatile("" : "+v"(fr), "+v"(fq));
        const int row0 = u.pm * 256 + wr * 64 + fr, col0 = (u.pn * 256 + wc * 32 + 8 * fq) >> 1;
#pragma unroll
        for (int ai = 0; ai < 2; ++ai)
#pragma unroll
            for (int m = 0; m < 4; ++m) { bf16_t* rp = HB + (size_t)(row0 + ai * 128 + m * 16) * EFF + col0;
#pragma unroll
                for (int bj = 0; bj < 2; ++bj) { const f32x4 a1 = acc[ai][bj][m][0], a3 = acc[ai][bj][m][1];
                    u32x2 w; w.x = cvtpk(silu_f(a1[0]) * a3[0], silu_f(a1[1]) * a3[1]); w.y = cvtpk(silu_f(a1[2]) * a3[2], silu_f(a1[3]) * a3[3]);
                    *(u32x2*)(rp + bj * 64) = w; } }
    }
};

struct EpiUpI8 {
    bf16_t* HB; const float* SAL; const float* SB; const LAS int* tstart; LAS unsigned char* lds;
    __device__ __forceinline__ void pre(const pg8::Unit& u, LAS unsigned char* l, int wid, int lane, int par) const {
        if (wid == 0) { const int mt = u.pm - tstart[u.e];
            __builtin_amdgcn_global_load_lds((const unsigned*)(SAL + (size_t)u.e * 65536 + mt * 256 + lane * 4), (LAS unsigned*)(l + EPI_SC + par * 2048), 16, 0, 0);
            __builtin_amdgcn_global_load_lds((const unsigned*)(SB + (size_t)u.e * 1024 + u.pn * 256 + lane * 4), (LAS unsigned*)(l + EPI_SC + par * 2048 + 1024), 16, 0, 0); } }
    __device__ __forceinline__ void operator()(const i32x4 (&acc)[2][2][4][2], const pg8::Unit& u, int wr, int wc, int fr, int fq, int par) const {
        asm volatile("" : "+v"(fr), "+v"(fq));
        const int rl0 = wr * 64 + fr, row0 = u.pm * 256 + rl0, colp = u.pn * 256 + wc * 32 + 8 * fq, col0 = colp >> 1;
        LAS const float* LSA = (LAS const float*)(lds + EPI_SC + par * 2048); LAS const float* LSB = LSA + 256;
        f32x4 sb[2][2];
#pragma unroll
        for (int bj = 0; bj < 2; ++bj)
#pragma unroll
            for (int n = 0; n < 2; ++n) sb[bj][n] = *(LAS const f32x4*)(LSB + wc * 32 + 8 * fq + bj * 128 + 4 * n);
#pragma unroll
        for (int ai = 0; ai < 2; ++ai)
#pragma unroll
            for (int m = 0; m < 4; ++m) { const int R = rl0 + ai * 128 + m * 16; const float sa = LSA[R];
                bf16_t* rp = HB + (size_t)(row0 + ai * 128 + m * 16) * EFF + (col0 & ~7) + 64 * (fq & 1);
                u32x2 wv[2];
#pragma unroll
                for (int bj = 0; bj < 2; ++bj) { const i32x4 i1 = acc[ai][bj][m][0], i3 = acc[ai][bj][m][1];
                    f32x4 a1, a3;
#pragma unroll
                    for (int i = 0; i < 4; ++i) { a1[i] = (float)i1[i] * sa * sb[bj][0][i]; a3[i] = (float)i3[i] * sa * sb[bj][1][i]; }
                    wv[bj].x = cvtpk(silu_f(a1[0]) * a3[0], silu_f(a1[1]) * a3[1]); wv[bj].y = cvtpk(silu_f(a1[2]) * a3[2], silu_f(a1[3]) * a3[3]); }
                *(u32x4*)rp = widen_rows16(wv[0], wv[1]); }
    }
};

template <class RM>
__device__ __forceinline__ void transpose_item(const float* W, int N, bf16_t* WT, int Kd, LAS float* scr, int k0, int n0, int lane, const RM& rm) {
#pragma unroll 8
    for (int i = 0; i < 32; ++i) { const int kk = 2 * i + (lane >> 5); scr[kk * 33 + (lane & 31)] = W[(size_t)(k0 + kk) * N + n0 + (lane & 31)]; }
    asm volatile("s_waitcnt lgkmcnt(0)" ::: "memory");
    const int c = lane & 7;
#pragma unroll
    for (int j = 0; j < 4; ++j) { const int n = (lane >> 3) + 8 * j; const LAS float* s = scr + (8 * c) * 33 + n;
        u32x4 o; o.x = cvtpk(s[0 * 33], s[1 * 33]); o.y = cvtpk(s[2 * 33], s[3 * 33]); o.z = cvtpk(s[4 * 33], s[5 * 33]); o.w = cvtpk(s[6 * 33], s[7 * 33]);
        *(u32x4*)(WT + (size_t)rm(n0 + n) * Kd + k0 + 8 * c) = o; }
    asm volatile("s_waitcnt lgkmcnt(0)" ::: "memory");
}
struct RmId { int off; __device__ __forceinline__ int operator()(int n) const { return off + n; } };
__device__ __forceinline__ int rope_pl(int d) { return 8 * ((d & 31) >> 2) + 4 * (d >> 5) + (d & 3); }
struct RmWin {
    __device__ __forceinline__ int operator()(int c) const {
        if (c < 2048) return c;
        if (c < 2052) return 3328 + (c - 2048);
        if (c < 2056) return 3332 + (c - 2052);
        if (c < 2568) { const int x = c - 2056; return 2048 + (x & ~63) + rope_pl(x & 63); }
        if (c < 2696) { const int x = c - 2568; return 2560 + (x & ~63) + rope_pl(x & 63); }
        if (c < 2824) return 2688 + (c - 2696);
        if (c < 2952) { const int x = c - 2824; return 2816 + (x & ~63) + rope_pl(x & 63); }
        if (c < 3080) return 2944 + (c - 2952);
        if (c < 3208) { const int x = c - 3080; return 3072 + (x & ~63) + rope_pl(x & 63); }
        if (c < 3336) return 3200 + (c - 3208);
        return c;
    }
};
struct RmW13 { int sel; __device__ __forceinline__ int operator()(int j) const { return 8 * (j >> 2) + 4 * sel + (j & 3); } };

__device__ __forceinline__ void p0_phase(Frame& F) {
    const int tid = F.tid, lane = F.lane;
    const int NA = F.G > 64 ? 64 : F.G;
    const bool split = F.G > NA;
    if (F.vcu < NA) {
        LAS float* sc = (LAS float*)F.lds; LAS float* red = (LAS float*)(F.lds + 32768);
        const float* c = IN_F(1);
        for (int i = tid; i < 8192; i += NTHR) sc[i] = silu_f(c[i]);
        __syncthreads();
        const float* W = IN_F(3); const float* bia = IN_F(4); float* mod = WSP(float, WS_MOD);
        for (int cg = F.vcu; cg < 64; cg += NA) {
            const int col0 = cg * 96;
            const int kq = tid / 24, cq = tid % 24;
            f32x4 a[8];
#pragma unroll
            for (int b = 0; b < 8; ++b) a[b] = (f32x4){0.f, 0.f, 0.f, 0.f};
            if (tid < 504) {
#pragma unroll 4
                for (int k = kq; k < 1024; k += 21) { const f32x4 w = *(const f32x4*)(W + (size_t)k * 6144 + col0 + 4 * cq);
#pragma unroll
                    for (int b = 0; b < 8; ++b) a[b] += w * sc[b * 1024 + k]; }
#pragma unroll
                for (int b = 0; b < 8; ++b) *(LAS f32x4*)(red + (size_t)(tid * 8 + b) * 4) = a[b];
            }
            __syncthreads();
            for (int o = tid; o < 768; o += NTHR) { const int cq2 = o >> 5, bj = o & 31;
                float sacc = 0.f;
                for (int q = 0; q < 21; ++q) sacc += red[(size_t)((q * 24 + cq2) * 8) * 4 + bj];
                const int col = col0 + 4 * cq2 + (bj & 3);
                mod[(bj >> 2) * 6144 + col] = sacc + bia[col]; }
            __syncthreads();
        }
    }
    if (!split || F.vcu >= NA) {
        LAS float* scr = (LAS float*)(F.lds + F.wave * 8448);
        const int gw = (split ? F.vcu - NA : F.vcu) * NWAVES + F.wave, NGW = (split ? F.G - NA : F.G) * NWAVES;
        constexpr int I_WOUT = 16 * 32, I_C1 = 32 * 4, I_C2 = 2 * 2;
        constexpr int NITEMS = I_WOUT + 2 * I_C1 + 2 * I_C2;
        for (int it = gw; it < NITEMS; it += NGW) {
            int r = it;
            if (r < I_WOUT) { transpose_item(IN_F(19), 1024, WSP(bf16_t, WS_WOUTT), 1024, scr, (r / 32) * 64, (r % 32) * 32, lane, RmId{0}); continue; } r -= I_WOUT;
            if (r < I_C1) { transpose_item(IN_F(14), 128, WSP(bf16_t, WS_CW1K), 2048, scr, (r / 4) * 64, (r % 4) * 32, lane, RmId{0}); continue; } r -= I_C1;
            if (r < I_C1) { transpose_item(IN_F(17), 128, WSP(bf16_t, WS_CW1V), 2048, scr, (r / 4) * 64, (r % 4) * 32, lane, RmId{0}); continue; } r -= I_C1;
            if (r < I_C2) { transpose_item(IN_F(15), 64, WSP(bf16_t, WS_CW2K), 128, scr, (r / 2) * 64, (r % 2) * 32, lane, RmId{0}); continue; } r -= I_C2;
            transpose_item(IN_F(18), 64, WSP(bf16_t, WS_CW2V), 128, scr, (r / 2) * 64, (r % 2) * 32, lane, RmId{0});
        }
    }
    __syncthreads();
    {
        LAS unsigned* AM = (LAS unsigned*)F.lds; const int n = tid & 15, kq = tid >> 4; const RmWin rmw{};
        for (int it = (F.vcu + F.G - (split ? NA : 0)) % F.G; it < 210; it += F.G) {
            const int c = 16 * it + n; const float* W = IN_F(9) + (size_t)(32 * kq) * INW + c;
            if (tid < 16) AM[tid] = 0u;
            __syncthreads();
            float v[32]; float am = 0.f;
#pragma unroll
            for (int i = 0; i < 32; ++i) { v[i] = W[(size_t)i * INW]; am = fmaxf(am, fabsf(v[i])); }
            atomicMax((unsigned*)&AM[n], __float_as_uint(am));
            __syncthreads();
            const float amax = __uint_as_float(AM[n]); const float inv = amax > 0.f ? 127.f / amax : 0.f; const int prow = rmw(c);
            unsigned char* dst = (unsigned char*)(F.ws + WS_WINT) + (size_t)prow * 1024 + 32 * kq;
#pragma unroll
            for (int cc = 0; cc < 2; ++cc) { u32x4 o;
#pragma unroll
                for (int d = 0; d < 4; ++d) { const int b0 = 16 * cc + 4 * d;
                    const int q0 = (int)rintf(v[b0] * inv), q1 = (int)rintf(v[b0 + 1] * inv), q2 = (int)rintf(v[b0 + 2] * inv), q3 = (int)rintf(v[b0 + 3] * inv);
                    o[d] = (unsigned)(q0 & 0xff) | ((unsigned)(q1 & 0xff) << 8) | ((unsigned)(q2 & 0xff) << 16) | ((unsigned)(q3 & 0xff) << 24); }
                *(u32x4*)(dst + 16 * cc) = o; }
            if (kq == 0) WSP(float, WS_SBW)[prow] = amax * (1.f / 127.f);
            __syncthreads();
        }
    }
    {
        const size_t gt = (size_t)F.vcu * NTHR + tid, NGT_ = (size_t)F.G * NTHR;
        const int* pos = (const int*)F.in[2]; float* COS = WSP(float, WS_COS); float* SIN = WSP(float, WS_SIN);
        {
            const int d = (int)(gt & 31); const float inv = powf(10000.f, -(float)d / 32.f);
            for (size_t i = gt; i < (size_t)NTOK * 32; i += NGT_) { const int row = (int)(i >> 5);
                const float ang = (float)pos[row] * inv; const float kk = rintf(ang * 0.15915494309189535f);
                float r = fmaf(-kk, 6.28125f, ang); r = fmaf(-kk, 1.9353071795864769e-3f, r);
                float sn, cs; sincosf(r, &sn, &cs); COS[i] = cs; SIN[i] = sn; } }
        { unsigned* z = (unsigned*)(F.ws + WS_WINT + (size_t)3360 * 1024); for (size_t i = gt; i < (size_t)224 * 256; i += NGT_) z[i] = 0u;
          for (size_t i = gt; i < 224; i += NGT_) WSP(float, WS_SBW)[3360 + i] = 0.f; }
        { const float* wg = IN_F(20); const float* we = IN_F(22); _Float16* RWT = WSP(_Float16, WS_RWT);
          for (size_t i = gt; i < 48 * 1024; i += NGT_) { const int n = (int)(i >> 10), k = (int)(i & 1023);
              const float w = n < 4 ? wg[k * 4 + n] : n < 36 ? we[k * 32 + n - 4] : 0.f; RWT[i] = (_Float16)w; } }
        { bf16_t* kc = WSP(bf16_t, WS_KCMP); bf16_t* vc = WSP(bf16_t, WS_VCMP);
          for (size_t i = gt; i < 16 * 64; i += NGT_) { const size_t o = ((i >> 6) * 256 + 255) * 64 + (i & 63); kc[o] = 0; vc[o] = 0; } }
    }
    __syncthreads();
    if (F.vcu >= F.G - 16) {
        const int bi = F.vcu - (F.G - 16), kv = bi >> 3, cg = bi & 7;
        const float* pe = IN_F(kv == 0 ? 13 : 16); const float* w1 = IN_F(kv == 0 ? 14 : 17);
        LAS float* red = (LAS float*)F.lds;
        const int col = cg * 16 + (tid & 15), sl = tid >> 4; float sacc = 0.f;
#pragma unroll 8
        for (int k = sl * 64; k < sl * 64 + 64; ++k) sacc += pe[k] * w1[(size_t)k * 128 + col];
        red[tid] = sacc; __syncthreads();
        if (tid < 16) { float t2 = 0.f; for (int q = 0; q < 32; ++q) t2 += red[q * 16 + tid]; WSP(float, WS_C1B)[kv * 128 + cg * 16 + tid] = t2; }
    }
    __syncthreads();
}

__device__ __forceinline__ void p1a_phase(Frame& F) {
    const int gw = F.vcu * NWAVES + F.wave, NGW = F.G * NWAVES, lane = F.lane;
    const float* x = IN_F(0); const float* nw = IN_F(5); const float* mod = WSP(float, WS_MOD); signed char* H1Q = (signed char*)(F.ws + WS_H1);
    for (int row0 = gw * 4; row0 < NTOK; row0 += NGW * 4) {
        f32x4 v[4][4]; float ss[4];
#pragma unroll
        for (int r = 0; r < 4; ++r) { const f32x4* xr = (const f32x4*)(x + (size_t)(row0 + r) * DM) + lane;
#pragma unroll
            for (int j = 0; j < 4; ++j) v[r][j] = __builtin_nontemporal_load(xr + 64 * j); }
#pragma unroll
        for (int r = 0; r < 4; ++r) { float a = 0.f;
#pragma unroll
            for (int j = 0; j < 4; ++j) a += v[r][j][0] * v[r][j][0] + v[r][j][1] * v[r][j][1] + v[r][j][2] * v[r][j][2] + v[r][j][3] * v[r][j][3];
            ss[r] = a; }
#pragma unroll
        for (int o = 1; o < 64; o <<= 1) {
#pragma unroll
            for (int r = 0; r < 4; ++r) ss[r] += __shfl_xor(ss[r], o); }
        const int b = row0 >> 12; float am[4] = {0.f, 0.f, 0.f, 0.f};
#pragma unroll
        for (int j = 0; j < 4; ++j) { const int k = 4 * lane + 256 * j;
            const f32x4 w = *(const f32x4*)(nw + k), sh = *(const f32x4*)(mod + b * 6144 + k), sc = *(const f32x4*)(mod + b * 6144 + 1024 + k);
            const f32x4 ws = w * (sc + 1.f);
#pragma unroll
            for (int r = 0; r < 4; ++r) { const float rr = rsqrtf(ss[r] * (1.f / DM) + RMS_EPS);
                const f32x4 h = v[r][j] * rr * ws + sh; v[r][j] = h;
                am[r] = fmaxf(am[r], fmaxf(fmaxf(fabsf(h[0]), fabsf(h[1])), fmaxf(fabsf(h[2]), fabsf(h[3])))); } }
#pragma unroll
        for (int o = 1; o < 64; o <<= 1) {
#pragma unroll
            for (int r = 0; r < 4; ++r) am[r] = fmaxf(am[r], __shfl_xor(am[r], o)); }
#pragma unroll
        for (int r = 0; r < 4; ++r) { const float inv = am[r] > 0.f ? 127.f / am[r] : 0.f;
            if (lane == 0) WSP(float, WS_SA1)[row0 + r] = am[r] * (1.f / 127.f);
#pragma unroll
            for (int j = 0; j < 4; ++j) { const int k = 4 * lane + 256 * j; const f32x4 q = v[r][j] * inv;
                const int q0 = (int)rintf(q[0]), q1 = (int)rintf(q[1]), q2 = (int)rintf(q[2]), q3 = (int)rintf(q[3]);
                *(unsigned*)(H1Q + (size_t)(row0 + r) * DM + k) = (unsigned)(q0 & 0xff) | ((unsigned)(q1 & 0xff) << 8) | ((unsigned)(q2 & 0xff) << 16) | ((unsigned)(q3 & 0xff) << 24); } }
    }
}

__device__ __forceinline__ void conv_silu16(const bf16_t* src  , const float* cw  , int b, int s, int ch0  , float scale, float (&o)[16]) {
#pragma unroll
    for (int i = 0; i < 16; ++i) o[i] = 0.f;
#pragma unroll
    for (int j = 0; j < 4; ++j) { const int ss = s - 3 + j;
        if (ss >= 0) { const bf16_t* rp = src + ((size_t)b * SEQ + ss) * 512 + ch0;
            const u32x4 a = *(const u32x4*)rp, c = *(const u32x4*)(rp + 8);
            const float* w = cw + j * 1024;
            const f32x4 w0 = *(const f32x4*)w, w1 = *(const f32x4*)(w + 4), w2 = *(const f32x4*)(w + 8), w3 = *(const f32x4*)(w + 12);
            o[0] += bflo(a.x) * w0[0]; o[1] += bfhi(a.x) * w0[1]; o[2] += bflo(a.y) * w0[2]; o[3] += bfhi(a.y) * w0[3];
            o[4] += bflo(a.z) * w1[0]; o[5] += bfhi(a.z) * w1[1]; o[6] += bflo(a.w) * w1[2]; o[7] += bfhi(a.w) * w1[3];
            o[8] += bflo(c.x) * w2[0]; o[9] += bfhi(c.x) * w2[1]; o[10] += bflo(c.y) * w2[2]; o[11] += bfhi(c.y) * w2[3];
            o[12] += bflo(c.z) * w3[0]; o[13] += bfhi(c.z) * w3[1]; o[14] += bflo(c.w) * w3[2]; o[15] += bfhi(c.w) * w3[3]; } }
#pragma unroll
    for (int i = 0; i < 16; ++i) o[i] = silu_f(o[i]) * scale;
}
constexpr int RAWS = 272, RAWIMG = 67 * RAWS + 208;
__device__ __forceinline__ void stage_raw(const bf16_t* src, int b, int s0, int h, LAS unsigned char* RAW, int tid) {
    const int s = tid >> 3, chg = tid & 7;
    const bf16_t* rp = src + ((size_t)b * SEQ + s0 + s) * 512 + h * 128 + chg * 16;
    *(LAS u32x4*)(RAW + (s + 3) * RAWS + chg * 32) = *(const u32x4*)rp; *(LAS u32x4*)(RAW + (s + 3) * RAWS + chg * 32 + 16) = *(const u32x4*)(rp + 8);
    if (s < 3) { u32x4 a = {0u, 0u, 0u, 0u}, c = a; const int ss = s0 - 3 + s;
        if (ss >= 0) { const bf16_t* hp = src + ((size_t)b * SEQ + ss) * 512 + h * 128 + chg * 16; a = *(const u32x4*)hp; c = *(const u32x4*)(hp + 8); }
        *(LAS u32x4*)(RAW + s * RAWS + chg * 32) = a; *(LAS u32x4*)(RAW + s * RAWS + chg * 32 + 16) = c; }
}
__device__ __forceinline__ void conv_lds16(LAS const unsigned char* RAW, LAS const float* WL, int s, int ch0, float scale, float (&o)[16]) {
#pragma unroll
    for (int i = 0; i < 16; ++i) o[i] = 0.f;
#pragma unroll
    for (int j = 0; j < 4; ++j) { const u32x4 a = *(LAS const u32x4*)(RAW + (s + j) * RAWS + ch0 * 2), c = *(LAS const u32x4*)(RAW + (s + j) * RAWS + ch0 * 2 + 16);
        const LAS float* w = WL + j * 128 + ch0;
        const f32x4 w0 = *(LAS const f32x4*)w, w1 = *(LAS const f32x4*)(w + 4), w2 = *(LAS const f32x4*)(w + 8), w3 = *(LAS const f32x4*)(w + 12);
        o[0] += bflo(a.x) * w0[0]; o[1] += bfhi(a.x) * w0[1]; o[2] += bflo(a.y) * w0[2]; o[3] += bfhi(a.y) * w0[3];
        o[4] += bflo(a.z) * w1[0]; o[5] += bfhi(a.z) * w1[1]; o[6] += bflo(a.w) * w1[2]; o[7] += bfhi(a.w) * w1[3];
        o[8] += bflo(c.x) * w2[0]; o[9] += bfhi(c.x) * w2[1]; o[10] += bflo(c.y) * w2[2]; o[11] += bfhi(c.y) * w2[3];
        o[12] += bflo(c.z) * w3[0]; o[13] += bfhi(c.z) * w3[1]; o[14] += bflo(c.w) * w3[2]; o[15] += bfhi(c.w) * w3[3]; }
#pragma unroll
    for (int i = 0; i < 16; ++i) o[i] = silu_f(o[i]) * scale;
}
constexpr int TRT = 4096 + 64, RCH = 1024 + 16;
constexpr int TRIMG = 4 * TRT, ROWIMG = 16 * RCH;
__device__ __forceinline__ unsigned tr_lane_off(int lane) { const int hi = lane >> 5; return ((lane >> 4) & 1) * 32 + (lane & 3) * 8 + (4 * hi + ((lane & 15) >> 2)) * 64; }

#if DBG_CHECK == 2
#define DBGF(code, val) do { const float _v = (val); if ((__float_as_uint(_v) & 0x7f800000u) == 0x7f800000u) atomicMin((unsigned*)(F.ws + WS_CTL) + CW_DBG, (unsigned)(code)); } while (0)
#else
#define DBGF(code, val) do {} while (0)
#endif
struct MaPF { u32x4 k0, k1, v0, v1, hk0, hk1; float wk, g0, g1; };
__device__ __forceinline__ void mlstm_a_load(Frame& F, int job, int tid, MaPF& pf) {
    const int lane = tid & 63, w = F.wave;
    const int bh = job >> 6, c = job & 63, b = bh >> 2, h = bh & 3, s0 = c * 64, s = tid >> 3, chg = tid & 7;
    const size_t ro = ((size_t)b * SEQ + s0 + s) * 512 + h * 128 + chg * 16;
    const bf16_t* kp = WSP(bf16_t, WS_MK) + ro; const bf16_t* vp = WSP(bf16_t, WS_MV) + ro;
    pf.k0 = *(const u32x4*)kp; pf.k1 = *(const u32x4*)(kp + 8); pf.v0 = *(const u32x4*)vp; pf.v1 = *(const u32x4*)(vp + 8);
    pf.hk0 = (u32x4){0u, 0u, 0u, 0u}; pf.hk1 = pf.hk0;
    if (s < 3 && s0 - 3 + s >= 0) { const bf16_t* hp = WSP(bf16_t, WS_MK) + ((size_t)b * SEQ + s0 - 3 + s) * 512 + h * 128 + chg * 16; pf.hk0 = *(const u32x4*)hp; pf.hk1 = *(const u32x4*)(hp + 8); }
    pf.wk = IN_F(10)[(tid >> 7) * 1024 + 512 + h * 128 + (tid & 127)];
    pf.g0 = 0.f; pf.g1 = 0.f;
    if (w == 0) { pf.g0 = WSP(float, WS_GF)[(size_t)bh * SEQ + s0 + lane]; pf.g1 = WSP(float, WS_GI)[(size_t)bh * SEQ + s0 + lane]; }
}
__device__ __forceinline__ void mlstm_a_phase(Frame& F) {
    int tid = F.tid; asm volatile("" : "+v"(tid));
    const int lane = tid & 63, w = F.wave, r32 = lane & 31, hi = lane >> 5;
    LAS unsigned char* kimg = F.lds; LAS unsigned char* vimg = F.lds + TRIMG; LAS float* wS = (LAS float*)(F.lds + 2 * TRIMG);
    LAS unsigned char* RAWK = F.lds + 2 * TRIMG + 1024; LAS float* WLK = (LAS float*)(RAWK + RAWIMG);
    LAS bf16_t* OST = (LAS bf16_t*)(F.lds + 2 * TRIMG + 1024 + RAWIMG + 2048) + w * 2048;
    MaPF pf; int job = F.vcu;
    if (job < 2048) mlstm_a_load(F, job, tid, pf);
    for (; job < 2048; job += F.G) {
        {
            const int s = tid >> 3, chg = tid & 7;
            *(LAS u32x4*)(RAWK + (s + 3) * RAWS + chg * 32) = pf.k0; *(LAS u32x4*)(RAWK + (s + 3) * RAWS + chg * 32 + 16) = pf.k1;
            if (s < 3) { *(LAS u32x4*)(RAWK + s * RAWS + chg * 32) = pf.hk0; *(LAS u32x4*)(RAWK + s * RAWS + chg * 32 + 16) = pf.hk1; }
            WLK[tid] = pf.wk;
            if (w == 0) {
                float bs = pf.g0;
#pragma unroll
                for (int o = 1; o < 64; o <<= 1) { const float x = __shfl_up(bs, o); if (lane >= o) bs += x; }
                const float g = __shfl(bs, 63);
                const float a = g - bs + pf.g1; const float ml = wave_max(a);
                wS[lane] = __expf(a - ml);
                if (lane == 0) { WSP(float, WS_GSUM)[job] = g; WSP(float, WS_MLOC)[job] = ml; }
            }
        }
        const u32x4 va = pf.v0, vd = pf.v1;
        __syncthreads();
        if (job + F.G < 2048) mlstm_a_load(F, job + F.G, tid, pf);
        {
            const int s = tid >> 3, chg = tid & 7, ch0 = chg * 16;
            float kf[16]; conv_lds16(RAWK, WLK, s, ch0, 0.08838834764831845f, kf);
            const unsigned off = (ch0 >> 5) * TRT + s * 64 + (ch0 & 31) * 2;
            u32x4 k0, k1; k0.x = cvtpk(kf[0], kf[1]); k0.y = cvtpk(kf[2], kf[3]); k0.z = cvtpk(kf[4], kf[5]); k0.w = cvtpk(kf[6], kf[7]);
            k1.x = cvtpk(kf[8], kf[9]); k1.y = cvtpk(kf[10], kf[11]); k1.z = cvtpk(kf[12], kf[13]); k1.w = cvtpk(kf[14], kf[15]);
            *(LAS u32x4*)(kimg + off) = k0; *(LAS u32x4*)(kimg + off + 16) = k1;
            const float ws = wS[s];
            u32x4 v0, v1;
            v0.x = cvtpk(bflo(va.x) * ws, bfhi(va.x) * ws); v0.y = cvtpk(bflo(va.y) * ws, bfhi(va.y) * ws); v0.z = cvtpk(bflo(va.z) * ws, bfhi(va.z) * ws); v0.w = cvtpk(bflo(va.w) * ws, bfhi(va.w) * ws);
            v1.x = cvtpk(bflo(vd.x) * ws, bfhi(vd.x) * ws); v1.y = cvtpk(bflo(vd.y) * ws, bfhi(vd.y) * ws); v1.z = cvtpk(bflo(vd.z) * ws, bfhi(vd.z) * ws); v1.w = cvtpk(bflo(vd.w) * ws, bfhi(vd.w) * ws);
            *(LAS u32x4*)(vimg + off) = v0; *(LAS u32x4*)(vimg + off + 16) = v1;
        }
        __syncthreads();
        {
            const int et = w >> 1, dt0 = 2 * (w & 1); const unsigned lo = tr_lane_off(lane);
            f32x16 acc0 = {0}, acc1 = {0};
#pragma unroll
            for (int ks = 0; ks < 4; ++ks) {
                const bf16x8 a = mk8(vtr(vimg + et * TRT + ks * 1024 + lo), vtr(vimg + et * TRT + ks * 1024 + lo + 512));
                const bf16x8 b0 = mk8(vtr(kimg + dt0 * TRT + ks * 1024 + lo), vtr(kimg + dt0 * TRT + ks * 1024 + lo + 512));
                const bf16x8 b1 = mk8(vtr(kimg + (dt0 + 1) * TRT + ks * 1024 + lo), vtr(kimg + (dt0 + 1) * TRT + ks * 1024 + lo + 512));
                acc0 = MFMA32(a, b0, acc0); acc1 = MFMA32(a, b1, acc1);
            }
#pragma unroll
            for (int r = 0; r < 16; ++r) { const int el = crow(r, hi); OST[el * 64 + r32] = f2bf(acc0[r]); OST[el * 64 + 32 + r32] = f2bf(acc1[r]); }
            asm volatile("s_waitcnt lgkmcnt(0)" ::: "memory");
            bf16_t* dst = WSP(bf16_t, WS_KVC) + (size_t)job * 16384 + (size_t)(et * 32) * 128 + dt0 * 32;
#pragma unroll
            for (int i = 0; i < 4; ++i) { const int rw = i * 8 + (lane >> 3), ch = lane & 7; *(u32x4*)(dst + (size_t)rw * 128 + ch * 8) = *(LAS const u32x4*)(OST + rw * 64 + ch * 8); }
        }
        if (tid < 128) {
            float sacc = 0.f; const int d = tid;
            for (int ss = 0; ss < 64; ++ss) sacc += wS[ss] * bf2f(*(LAS const bf16_t*)(kimg + (d >> 5) * TRT + ss * 64 + (d & 31) * 2));
            WSP(float, WS_NC)[(size_t)job * 128 + d] = sacc;
        }
        __syncthreads();
    }
}

__device__ __forceinline__ void mlstm_scan_job(Frame& F, int job) {
    int tid = F.tid; asm volatile("" : "+v"(tid));
    const int bh = job >> 3, sl = job & 7;
    LAS float* aold = (LAS float*)F.lds; LAS float* anew = aold + 64;
    if (tid == 0) {
        float m = 0.f;
        for (int c = 0; c < 64; ++c) { const float g = WSP(float, WS_GSUM)[bh * 64 + c], ml = WSP(float, WS_MLOC)[bh * 64 + c];
            const float mn = fmaxf(g + m, ml); aold[c] = __expf(g + m - mn); anew[c] = __expf(ml - mn);
            if (sl == 0) WSP(float, WS_MPREV)[bh * 64 + c] = m;
            m = mn; }
    }
    __syncthreads();
    const size_t base = (size_t)bh * 64 * 16384 + (size_t)sl * 2048 + tid * 4;
    const bf16_t* kv = WSP(bf16_t, WS_KVC) + base; bf16_t* cp = WSP(bf16_t, WS_CPREV) + base;
    f32x4 C = {0.f, 0.f, 0.f, 0.f};
#pragma unroll 8
    for (int c = 0; c < 64; ++c) {
        const u32x2 k = *(const u32x2*)(kv + (size_t)c * 16384);
        u32x2 o; o.x = cvtpk(C[0], C[1]); o.y = cvtpk(C[2], C[3]); *(u32x2*)(cp + (size_t)c * 16384) = o;
        const float ao = aold[c], an = anew[c]; DBGF(22, ao); DBGF(23, an); DBGF(24, bflo(k.x)); DBGF(24, bfhi(k.x)); DBGF(24, bflo(k.y)); DBGF(24, bfhi(k.y)); DBGF(25, C[0]);
        C[0] = ao * C[0] + an * bflo(k.x); C[1] = ao * C[1] + an * bfhi(k.x); C[2] = ao * C[2] + an * bflo(k.y); C[3] = ao * C[3] + an * bfhi(k.y);
    }
    if (sl == 0 && tid < 128) {
        float n = 0.f;
        for (int c = 0; c < 64; ++c) { WSP(float, WS_NPREV)[(size_t)(bh * 64 + c) * 128 + tid] = n; n = aold[c] * n + anew[c] * WSP(float, WS_NC)[(size_t)(bh * 64 + c) * 128 + tid]; }
    }
    __syncthreads();
}

struct McPF { u32x4 q0, q1, k0, k1, v0, v1, hq0, hq1, hk0, hk1; float wq, wk, g0, g1, mprev; u32x2 mo[4]; };
__device__ __forceinline__ void mlstm_c_load(Frame& F, int job, int tid, McPF& pf) {
    const int lane = tid & 63, w = F.wave, r32 = lane & 31, hi = lane >> 5;
    const int bh = job >> 6, c = job & 63, b = bh >> 2, h = bh & 3, s0 = c * 64, s = tid >> 3, chg = tid & 7;
    const size_t ro = ((size_t)b * SEQ + s0 + s) * 512 + h * 128 + chg * 16;
    const bf16_t* qp = WSP(bf16_t, WS_MQ) + ro; const bf16_t* kp = WSP(bf16_t, WS_MK) + ro; const bf16_t* vp = WSP(bf16_t, WS_MV) + ro;
    pf.q0 = *(const u32x4*)qp; pf.q1 = *(const u32x4*)(qp + 8); pf.k0 = *(const u32x4*)kp; pf.k1 = *(const u32x4*)(kp + 8); pf.v0 = *(const u32x4*)vp; pf.v1 = *(const u32x4*)(vp + 8);
    pf.hq0 = (u32x4){0u, 0u, 0u, 0u}; pf.hq1 = pf.hq0; pf.hk0 = pf.hq0; pf.hk1 = pf.hq0;
    if (s < 3 && s0 - 3 + s >= 0) { const size_t ho = ((size_t)b * SEQ + s0 - 3 + s) * 512 + h * 128 + chg * 16;
        pf.hq0 = *(const u32x4*)(WSP(bf16_t, WS_MQ) + ho); pf.hq1 = *(const u32x4*)(WSP(bf16_t, WS_MQ) + ho + 8); pf.hk0 = *(const u32x4*)(WSP(bf16_t, WS_MK) + ho); pf.hk1 = *(const u32x4*)(WSP(bf16_t, WS_MK) + ho + 8); }
    pf.wq = IN_F(10)[(tid >> 7) * 1024 + h * 128 + (tid & 127)]; pf.wk = IN_F(10)[(tid >> 7) * 1024 + 512 + h * 128 + (tid & 127)];
    pf.g0 = 0.f; pf.g1 = 0.f;
    if (w == 0) { pf.g0 = WSP(float, WS_GF)[(size_t)bh * SEQ + s0 + lane]; pf.g1 = WSP(float, WS_GI)[(size_t)bh * SEQ + s0 + lane]; }
    if (w == 1) { pf.g0 = WSP(float, WS_NPREV)[(size_t)job * 128 + lane]; pf.g1 = WSP(float, WS_NPREV)[(size_t)job * 128 + 64 + lane]; }
    pf.mprev = WSP(float, WS_MPREV)[job];
    const int tw = w & 1, ew = w >> 1, t = 32 * tw + r32;
    const bf16_t* mo = WSP(bf16_t, WS_MO) + ((size_t)b * SEQ + s0 + t) * 512 + h * 128 + 32 * ew + 4 * hi;
#pragma unroll
    for (int q4 = 0; q4 < 4; ++q4) pf.mo[q4] = *(const u32x2*)(mo + 8 * q4);
}
__device__ __forceinline__ void mlstm_c_phase(Frame& F) {
    int tid = F.tid; asm volatile("" : "+v"(tid));
    const int lane = tid & 63, w = F.wave, r32 = lane & 31, hi = lane >> 5;
    LAS unsigned char* qimg = F.lds; LAS unsigned char* kimg = F.lds + ROWIMG; LAS unsigned char* vimg = F.lds + 2 * ROWIMG;
    LAS float* uS = (LAS float*)(F.lds + 2 * ROWIMG + TRIMG); LAS float* MS = uS + 64; LAS float* bS = uS + 128; LAS float* nS = uS + 192; LAS float* ssq = uS + 320;
    LAS unsigned char* RAWQ = F.lds + 2 * ROWIMG + TRIMG + 4096; LAS unsigned char* RAWK = RAWQ + RAWIMG; LAS float* WLQ = (LAS float*)(RAWK + RAWIMG); LAS float* WLK = WLQ + 512;
    LAS float* HNL = (LAS float*)(F.lds + MISC_OFF + 2048);
    HNL[tid] = IN_F(12)[tid];
    const int tw = w & 1, ew = w >> 1, t = 32 * tw + r32;
    McPF pf;
    int job = F.vcu;
    if (job < 2048) mlstm_c_load(F, job, tid, pf);
    for (; job < 2048; job += F.G) {
        const int bh = job >> 6, c = job & 63, b = bh >> 2, h = bh & 3, s0 = c * 64;
        const float mprev = pf.mprev; u32x2 moc[4];
#pragma unroll
        for (int q4 = 0; q4 < 4; ++q4) moc[q4] = pf.mo[q4];
        {
            const int s = tid >> 3, chg = tid & 7, ch0 = chg * 16;
            *(LAS u32x4*)(RAWQ + (s + 3) * RAWS + chg * 32) = pf.q0; *(LAS u32x4*)(RAWQ + (s + 3) * RAWS + chg * 32 + 16) = pf.q1;
            *(LAS u32x4*)(RAWK + (s + 3) * RAWS + chg * 32) = pf.k0; *(LAS u32x4*)(RAWK + (s + 3) * RAWS + chg * 32 + 16) = pf.k1;
            if (s < 3) { *(LAS u32x4*)(RAWQ + s * RAWS + chg * 32) = pf.hq0; *(LAS u32x4*)(RAWQ + s * RAWS + chg * 32 + 16) = pf.hq1;
                         *(LAS u32x4*)(RAWK + s * RAWS + chg * 32) = pf.hk0; *(LAS u32x4*)(RAWK + s * RAWS + chg * 32 + 16) = pf.hk1; }
            WLQ[tid] = pf.wq; WLK[tid] = pf.wk;
            const unsigned off = (ch0 >> 5) * TRT + s * 64 + (ch0 & 31) * 2;
            *(LAS u32x4*)(vimg + off) = pf.v0; *(LAS u32x4*)(vimg + off + 16) = pf.v1;
            if (w == 0) {
                float bs = pf.g0;
#pragma unroll
                for (int o = 1; o < 64; o <<= 1) { const float x = __shfl_up(bs, o); if (lane >= o) bs += x; }
                const float u = pf.g1 - bs; float cm = u;
#pragma unroll
                for (int o = 1; o < 64; o <<= 1) { const float x = __shfl_up(cm, o); if (lane >= o) cm = fmaxf(cm, x); }
                uS[lane] = u; MS[lane] = fmaxf(mprev, cm); bS[lane] = bs;
            }
            if (w == 1) { nS[lane] = pf.g0; nS[64 + lane] = pf.g1; }
        }
        __syncthreads();
        bf16x8 cf[8];
        { const bf16_t* cp = WSP(bf16_t, WS_CPREV) + (size_t)job * 16384 + (size_t)(32 * ew + r32) * 128 + 8 * hi;
#pragma unroll
          for (int ks = 0; ks < 8; ++ks) cf[ks] = *(const bf16x8*)(cp + 16 * ks); }
        if (job + F.G < 2048) mlstm_c_load(F, job + F.G, tid, pf);
        {
            const int s = tid >> 3, chg = tid & 7, ch0 = chg * 16;
            float qf[16]; conv_lds16(RAWQ, WLQ, s, ch0, 1.f, qf);
            u32x4 q0, q1; q0.x = cvtpk(qf[0], qf[1]); q0.y = cvtpk(qf[2], qf[3]); q0.z = cvtpk(qf[4], qf[5]); q0.w = cvtpk(qf[6], qf[7]);
            q1.x = cvtpk(qf[8], qf[9]); q1.y = cvtpk(qf[10], qf[11]); q1.z = cvtpk(qf[12], qf[13]); q1.w = cvtpk(qf[14], qf[15]);
            *(LAS u32x4*)(qimg + (2 * chg) * RCH + s * 16) = q0; *(LAS u32x4*)(qimg + (2 * chg + 1) * RCH + s * 16) = q1;
            float kf[16]; conv_lds16(RAWK, WLK, s, ch0, 0.08838834764831845f, kf);
            u32x4 k0, k1; k0.x = cvtpk(kf[0], kf[1]); k0.y = cvtpk(kf[2], kf[3]); k0.z = cvtpk(kf[4], kf[5]); k0.w = cvtpk(kf[6], kf[7]);
            k1.x = cvtpk(kf[8], kf[9]); k1.y = cvtpk(kf[10], kf[11]); k1.z = cvtpk(kf[12], kf[13]); k1.w = cvtpk(kf[14], kf[15]);
            *(LAS u32x4*)(kimg + (2 * chg) * RCH + s * 16) = k0; *(LAS u32x4*)(kimg + (2 * chg + 1) * RCH + s * 16) = k1;
        }
        __syncthreads();
        const float Mt = MS[t], bt = bS[t];
        const float dec = __expf(mprev - Mt), mt = bt + Mt;
        bf16x8 qf[8];
#pragma unroll
        for (int ks = 0; ks < 8; ++ks) qf[ks] = *(LAS const bf16x8*)(qimg + (2 * ks + hi) * RCH + t * 16);
        f32x16 p[2]; p[0] = (f32x16){0}; p[1] = (f32x16){0};
#pragma unroll
        for (int st = 0; st < 2; ++st) {
            if (st <= tw) {
#pragma unroll
                for (int ks = 0; ks < 8; ++ks) { const bf16x8 kf = *(LAS const bf16x8*)(kimg + (2 * ks + hi) * RCH + (32 * st + r32) * 16); p[st] = MFMA32(kf, qf[ks], p[st]); }
            }
        }
        float rs = 0.f;
#pragma unroll
        for (int st = 0; st < 2; ++st)
#pragma unroll
            for (int r = 0; r < 16; ++r) { const int s = 32 * st + crow(r, hi);
                const float wv = (s <= t) ? __expf(uS[s] - Mt) * p[st][r] : 0.f; p[st][r] = wv; rs += wv; }
        rs += __shfl_xor(rs, 32);
        float qn = 0.f;
#pragma unroll
        for (int ks = 0; ks < 8; ++ks)
#pragma unroll
            for (int j = 0; j < 8; ++j) qn += bf2f((bf16_t)qf[ks][j]) * nS[16 * ks + 8 * hi + j];
        qn += __shfl_xor(qn, 32);
        const float den = rs + dec * qn;
        const float hden = fmaxf(fabsf(den), __expf(-mt));
        f32x16 ai = {0}, ae = {0};
        const unsigned lo = tr_lane_off(lane);
#pragma unroll
        for (int st = 0; st < 2; ++st) {
            if (st <= tw) {
#pragma unroll
                for (int s2 = 0; s2 < 2; ++s2) { const int ks = 2 * st + s2;
                    const bf16x8 vf = mk8(vtr(vimg + ew * TRT + ks * 1024 + lo), vtr(vimg + ew * TRT + ks * 1024 + lo + 512));
                    u32x4 pw; pw.x = cvtpk(p[st][8 * s2 + 0], p[st][8 * s2 + 1]); pw.y = cvtpk(p[st][8 * s2 + 2], p[st][8 * s2 + 3]); pw.z = cvtpk(p[st][8 * s2 + 4], p[st][8 * s2 + 5]); pw.w = cvtpk(p[st][8 * s2 + 6], p[st][8 * s2 + 7]);
                    ai = MFMA32(vf, __builtin_bit_cast(bf16x8, pw), ai); }
            }
        }
#pragma unroll
        for (int ks = 0; ks < 8; ++ks) ae = MFMA32(cf[ks], qf[ks], ae);
        float hv[16]; float ss = 0.f; const float rden = 1.f / hden;
#pragma unroll
        for (int r = 0; r < 16; ++r) { hv[r] = (ai[r] + dec * ae[r]) * rden; ss += hv[r] * hv[r]; }
        ss += __shfl_xor(ss, 32);
        if (hi == 0) ssq[ew * 64 + t] = ss;
        __syncthreads();
        const float tot = ssq[t] + ssq[64 + t] + ssq[128 + t] + ssq[192 + t];
        const float rn = rsqrtf(tot * (1.f / 128.f) + RMS_EPS);
        LAS const float* hn = HNL + h * 128 + 32 * ew;
        bf16_t* yo = WSP(bf16_t, WS_YCAT) + ((size_t)b * SEQ + s0 + t) * 1024 + h * 128 + 32 * ew;
#pragma unroll
        for (int p2 = 0; p2 < 2; ++p2) { u32x2 ov[2];
#pragma unroll
            for (int e = 0; e < 2; ++e) { const int q4 = 2 * p2 + e; const int e0 = 8 * q4 + 4 * hi;
                const u32x2 om = moc[q4]; const f32x4 wn = *(LAS const f32x4*)(hn + e0);
                const float y0 = hv[4 * q4 + 0] * rn * wn[0] * sigmoid_f(bflo(om.x)), y1 = hv[4 * q4 + 1] * rn * wn[1] * sigmoid_f(bfhi(om.x));
                const float y2 = hv[4 * q4 + 2] * rn * wn[2] * sigmoid_f(bflo(om.y)), y3 = hv[4 * q4 + 3] * rn * wn[3] * sigmoid_f(bfhi(om.y));
                ov[e].x = cvtpk(y0, y1); ov[e].y = cvtpk(y2, y3); }
            *(u32x4*)(yo + 16 * p2 + 8 * hi) = widen_pair(ov[0], ov[1]); }
        __syncthreads();
    }
}

__device__ __forceinline__ void compress_job(Frame& F, int job) {
    int lane = F.lane; asm volatile("" : "+v"(lane));
    const int w = F.wave, r32 = lane & 31, hi = lane >> 5;
    const int kv = job >> 7, bg = (job >> 3) & 15, i0 = (job & 7) * 32;
    const bf16_t* X = WSP(bf16_t, kv ? WS_VC : WS_KC) + (size_t)bg * SEQ * 64;
    const bf16_t* W1 = WSP(bf16_t, kv ? WS_CW1V : WS_CW1K); const bf16_t* W2 = WSP(bf16_t, kv ? WS_CW2V : WS_CW2K);
    const float* c1 = WSP(float, WS_C1B) + kv * 128;
    bf16_t* O = WSP(bf16_t, kv ? WS_VCMP : WS_KCMP) + (size_t)bg * 256 * 64;
    LAS unsigned char* himg = F.lds;
    LAS float* part = (LAS float*)(F.lds + ROWIMG);
    const int nt = w & 3, kh = w >> 2;
    f32x16 acc = {0};
    {
        int i = i0 + r32; if (i > 254) i = 254;
        const bf16_t* ap = X + (size_t)i * 1024 + kh * 1024 + 8 * hi; const bf16_t* bp = W1 + (size_t)(32 * nt + r32) * 2048 + kh * 1024 + 8 * hi;
#pragma unroll 16
        for (int ks = 0; ks < 64; ++ks) { const bf16x8 a = *(const bf16x8*)(ap + 16 * ks), bb = *(const bf16x8*)(bp + 16 * ks); acc = MFMA32(a, bb, acc); }
    }
    if (kh == 1) {
#pragma unroll
        for (int r = 0; r < 16; ++r) part[(nt * 16 + r) * 64 + lane] = acc[r];
    }
    __syncthreads();
    if (kh == 0) {
        const int n = 32 * nt + r32; const float cb = c1[n];
#pragma unroll
        for (int r = 0; r < 16; ++r) { const int rowl = crow(r, hi); const float v = acc[r] + part[(nt * 16 + r) * 64 + lane] + cb;
            *(LAS bf16_t*)(himg + (n >> 3) * RCH + rowl * 16 + (n & 7) * 2) = f2bf(silu_f(v)); }
    }
    __syncthreads();
    if (w < 2) {
        f32x16 a2 = {0};
#pragma unroll
        for (int ks = 0; ks < 8; ++ks) { const bf16x8 a = *(LAS const bf16x8*)(himg + (2 * ks + hi) * RCH + r32 * 16);
            const bf16x8 bb = *(const bf16x8*)(W2 + (size_t)(32 * w + r32) * 128 + 16 * ks + 8 * hi); a2 = MFMA32(a, bb, a2); }
#pragma unroll
        for (int r = 0; r < 16; ++r) { const int i = i0 + crow(r, hi); if (i < 255) O[(size_t)i * 64 + 32 * w + r32] = f2bf(a2[r]); }
    }
    __syncthreads();
}

constexpr int NSA_KCH = 1024 + 16, NSA_VDH = 4096 + 64, NSA_KIMG = 8 * NSA_KCH, NSA_VIMG = 2 * NSA_VDH, NSA_BUF = NSA_KIMG + NSA_VIMG;
constexpr int NSA_IMP = 2 * NSA_BUF, NSA_IST = 65, NSA_TOT = NSA_IMP + 256 * NSA_IST * 4,
              NSA_SELB = MISC_OFF + 1024, NSA_UNI = NSA_SELB + 512;
constexpr int NSA_FAC = NSA_TOT + 64 * NSA_IST * 4;
constexpr int NSA_STASH = 96 * 1024;
static_assert(4 * NSA_BUF <= NSA_STASH && NSA_FAC + 4096 <= MISC_OFF && NSA_STASH + 8 * 4096 <= MISC_OFF, "NSA LDS map");

__device__ __forceinline__ void nsa_qk(LAS const unsigned char* kimg, const bf16x8 (&qr)[4], unsigned kfo, f32x16& p0, f32x16& p1) {
    bf16x8 kf[8];
#pragma unroll
    for (int d0 = 0; d0 < 4; ++d0) { kf[2 * d0] = *(LAS const bf16x8*)(kimg + kfo + d0 * (2 * NSA_KCH)); kf[2 * d0 + 1] = *(LAS const bf16x8*)(kimg + kfo + d0 * (2 * NSA_KCH) + 512); }
    __builtin_amdgcn_sched_barrier(0);
    p0 = (f32x16){0}; p1 = (f32x16){0};
#pragma unroll
    for (int d0 = 0; d0 < 4; ++d0) { p0 = MFMA32(kf[2 * d0], qr[d0], p0); p1 = MFMA32(kf[2 * d0 + 1], qr[d0], p1); }
}
constexpr float NSA_THR = 8.f;
template <int KIND>
__device__ __forceinline__ void nsa_tile(LAS const unsigned char* kimg, LAS const unsigned char* vimg, const bf16x8 (&qr)[4], int kbase, int t, bool edge, bool rowvalid,
                                         float& m, float& l, f32x16& o0, f32x16& o1, unsigned kfo, unsigned vfo, int hi) {
    f32x16 p0, p1; nsa_qk(kimg, qr, kfo, p0, p1);
    if (edge) {
#pragma unroll
        for (int r = 0; r < 16; ++r) { const int k0 = kbase + crow(r, hi), k1 = k0 + 32; bool v0, v1;
            if (KIND == 1) { v0 = k0 <= t; v1 = k1 <= t; } else { v0 = k0 <= t && k0 >= t - 511; v1 = k1 <= t && k1 >= t - 511; }
            p0[r] = v0 ? p0[r] : -INFINITY; p1[r] = v1 ? p1[r] : -INFINITY; }
    }
    float mx = fmaxf(p0[0], p1[0]);
#pragma unroll
    for (int r = 1; r < 16; ++r) mx = fmaxf(mx, fmaxf(p0[r], p1[r]));
    mx = rowvalid ? mx : -INFINITY;
    mx = fmaxf(mx, __shfl_xor(mx, 32));
    if (__any(mx - m > NSA_THR)) {
        const float mn = fmaxf(m, mx); const float alpha = ex2(m - mn); m = mn; l *= alpha;
#pragma unroll
        for (int r = 0; r < 16; ++r) { o0[r] *= alpha; o1[r] *= alpha; }
    }
    const float me = rowvalid ? m : INFINITY;
    float rs = 0.f;
#pragma unroll
    for (int r = 0; r < 16; ++r) { p0[r] = ex2(p0[r] - me); p1[r] = ex2(p1[r] - me); rs += p0[r] + p1[r]; }
    l += rs;
    u32x4 pw[4];
#pragma unroll
    for (int s = 0; s < 2; ++s) {
        pw[s].x = cvtpk(p0[8 * s + 0], p0[8 * s + 1]); pw[s].y = cvtpk(p0[8 * s + 2], p0[8 * s + 3]); pw[s].z = cvtpk(p0[8 * s + 4], p0[8 * s + 5]); pw[s].w = cvtpk(p0[8 * s + 6], p0[8 * s + 7]);
        pw[2 + s].x = cvtpk(p1[8 * s + 0], p1[8 * s + 1]); pw[2 + s].y = cvtpk(p1[8 * s + 2], p1[8 * s + 3]); pw[2 + s].z = cvtpk(p1[8 * s + 4], p1[8 * s + 5]); pw[2 + s].w = cvtpk(p1[8 * s + 6], p1[8 * s + 7]);
    }
    bf16x8 vf[8];
#pragma unroll
    for (int ks = 0; ks < 4; ++ks) { vf[2 * ks] = mk8(vtr(vimg + vfo + ks * 1024), vtr(vimg + vfo + ks * 1024 + 512)); vf[2 * ks + 1] = mk8(vtr(vimg + vfo + NSA_VDH + ks * 1024), vtr(vimg + vfo + NSA_VDH + ks * 1024 + 512)); }
    __builtin_amdgcn_sched_barrier(0);
#pragma unroll
    for (int ks = 0; ks < 4; ++ks) { o0 = MFMA32(vf[2 * ks], __builtin_bit_cast(bf16x8, pw[ks]), o0); o1 = MFMA32(vf[2 * ks + 1], __builtin_bit_cast(bf16x8, pw[ks]), o1); }
}

template <int KIND>
__device__ __forceinline__ void nsa_tile2(LAS const unsigned char* kA, LAS const unsigned char* vA, LAS const unsigned char* kB, LAS const unsigned char* vB, bool hasB,
                                          const bf16x8 (&qr)[4], int kbA, int kbB, int t, bool edgeA, bool edgeB, bool rvA, bool rvB,
                                          float& m, float& l, f32x16& o0, f32x16& o1, unsigned kfo, unsigned vfo, int hi) {
    f32x16 a0, a1, b0, b1;
    nsa_qk(kA, qr, kfo, a0, a1);
    __builtin_amdgcn_sched_barrier(0);
    if (hasB) nsa_qk(kB, qr, kfo, b0, b1);
    else {
#pragma unroll
        for (int r = 0; r < 16; ++r) { b0[r] = -INFINITY; b1[r] = -INFINITY; } }
    if (edgeA) {
#pragma unroll
        for (int r = 0; r < 16; ++r) { const int k0 = kbA + crow(r, hi), k1 = k0 + 32; bool v0, v1;
            if (KIND == 1) { v0 = k0 <= t; v1 = k1 <= t; } else { v0 = k0 <= t && k0 >= t - 511; v1 = k1 <= t && k1 >= t - 511; }
            a0[r] = v0 ? a0[r] : -INFINITY; a1[r] = v1 ? a1[r] : -INFINITY; } }
    if (edgeB) {
#pragma unroll
        for (int r = 0; r < 16; ++r) { const int k0 = kbB + crow(r, hi), k1 = k0 + 32; bool v0, v1;
            if (KIND == 1) { v0 = k0 <= t; v1 = k1 <= t; } else { v0 = k0 <= t && k0 >= t - 511; v1 = k1 <= t && k1 >= t - 511; }
            b0[r] = v0 ? b0[r] : -INFINITY; b1[r] = v1 ? b1[r] : -INFINITY; } }
    __builtin_amdgcn_sched_barrier(0);
    const bool fresh = m < -1e29f; const float mb = fresh ? 0.f : m;
    const float meA = rvA ? mb : INFINITY, meB = rvB ? mb : INFINITY;
#pragma unroll
    for (int r = 0; r < 16; ++r) { a0[r] -= meA; a1[r] -= meA; b0[r] -= meB; b1[r] -= meB; }
    float mx = fmaxf(fmaxf(a0[0], a1[0]), fmaxf(b0[0], b1[0]));
#pragma unroll
    for (int r = 1; r < 16; ++r) mx = fmaxf(mx, fmaxf(fmaxf(a0[r], a1[r]), fmaxf(b0[r], b1[r])));
    mx = fmaxf(mx, __shfl_xor(mx, 32));
    const bool has = mx > -INFINITY;
    const float delta = fresh ? (has ? mx : 0.f) : (mx > NSA_THR ? mx : 0.f);
    if (__any(delta != 0.f)) {
        const float alpha = fresh ? 1.f : ex2(-delta); l *= alpha;
#pragma unroll
        for (int r = 0; r < 16; ++r) { o0[r] *= alpha; o1[r] *= alpha; a0[r] -= delta; a1[r] -= delta; b0[r] -= delta; b1[r] -= delta; }
    }
    m = fresh ? (has ? mx : m) : m + delta;
    float rs = 0.f;
#pragma unroll
    for (int r = 0; r < 16; ++r) { a0[r] = ex2(a0[r]); a1[r] = ex2(a1[r]); b0[r] = ex2(b0[r]); b1[r] = ex2(b1[r]); rs += (a0[r] + a1[r]) + (b0[r] + b1[r]); }
    l += rs;
    __builtin_amdgcn_sched_barrier(0);
    {
        u32x4 pw[4];
#pragma unroll
        for (int s = 0; s < 2; ++s) {
            pw[s].x = cvtpk(a0[8 * s + 0], a0[8 * s + 1]); pw[s].y = cvtpk(a0[8 * s + 2], a0[8 * s + 3]); pw[s].z = cvtpk(a0[8 * s + 4], a0[8 * s + 5]); pw[s].w = cvtpk(a0[8 * s + 6], a0[8 * s + 7]);
            pw[2 + s].x = cvtpk(a1[8 * s + 0], a1[8 * s + 1]); pw[2 + s].y = cvtpk(a1[8 * s + 2], a1[8 * s + 3]); pw[2 + s].z = cvtpk(a1[8 * s + 4], a1[8 * s + 5]); pw[2 + s].w = cvtpk(a1[8 * s + 6], a1[8 * s + 7]); }
        bf16x8 vf[8];
#pragma unroll
        for (int ks = 0; ks < 4; ++ks) { vf[2 * ks] = mk8(vtr(vA + vfo + ks * 1024), vtr(vA + vfo + ks * 1024 + 512)); vf[2 * ks + 1] = mk8(vtr(vA + vfo + NSA_VDH + ks * 1024), vtr(vA + vfo + NSA_VDH + ks * 1024 + 512)); }
        __builtin_amdgcn_sched_barrier(0);
#pragma unroll
        for (int ks = 0; ks < 4; ++ks) { o0 = MFMA32(vf[2 * ks], __builtin_bit_cast(bf16x8, pw[ks]), o0); o1 = MFMA32(vf[2 * ks + 1], __builtin_bit_cast(bf16x8, pw[ks]), o1); }
    }
    __builtin_amdgcn_sched_barrier(0);
    if (hasB) {
        u32x4 pw[4];
#pragma unroll
        for (int s = 0; s < 2; ++s) {
            pw[s].x = cvtpk(b0[8 * s + 0], b0[8 * s + 1]); pw[s].y = cvtpk(b0[8 * s + 2], b0[8 * s + 3]); pw[s].z = cvtpk(b0[8 * s + 4], b0[8 * s + 5]); pw[s].w = cvtpk(b0[8 * s + 6], b0[8 * s + 7]);
            pw[2 + s].x = cvtpk(b1[8 * s + 0], b1[8 * s + 1]); pw[2 + s].y = cvtpk(b1[8 * s + 2], b1[8 * s + 3]); pw[2 + s].z = cvtpk(b1[8 * s + 4], b1[8 * s + 5]); pw[2 + s].w = cvtpk(b1[8 * s + 6], b1[8 * s + 7]); }
        bf16x8 vf[8];
#pragma unroll
        for (int ks = 0; ks < 4; ++ks) { vf[2 * ks] = mk8(vtr(vB + vfo + ks * 1024), vtr(vB + vfo + ks * 1024 + 512)); vf[2 * ks + 1] = mk8(vtr(vB + vfo + NSA_VDH + ks * 1024), vtr(vB + vfo + NSA_VDH + ks * 1024 + 512)); }
        __builtin_amdgcn_sched_barrier(0);
#pragma unroll
        for (int ks = 0; ks < 4; ++ks) { o0 = MFMA32(vf[2 * ks], __builtin_bit_cast(bf16x8, pw[ks]), o0); o1 = MFMA32(vf[2 * ks + 1], __builtin_bit_cast(bf16x8, pw[ks]), o1); }
    }
}

#define NPIN(x) asm volatile("" : "+v"(x))
__device__ __forceinline__ void glds16(const void* g, unsigned lds_base) {
    unsigned sv; asm volatile("s_mov_b32 %0, m0\n\ts_mov_b32 m0, %2\n\ts_nop 0\n\tglobal_load_lds_dwordx4 %1, off\n\ts_mov_b32 m0, %0" : "=&s"(sv) : "v"(g), "s"(lds_base) : "memory"); }
#define NSB() __builtin_amdgcn_sched_barrier(0)
#define NMX3(a, b, c) fmaxf(fmaxf((a), (b)), (c))
__device__ __forceinline__ float nsa_rowmax(const f32x16& p0, const f32x16& p1) {
    float a = NMX3(p0[0], p0[1], p1[0]), b = NMX3(p0[2], p0[3], p1[1]); a = NMX3(a, p1[2], p1[3]);
#pragma unroll
    for (int r = 4; r < 16; r += 4) { a = NMX3(a, p0[r], p0[r + 1]); b = NMX3(b, p0[r + 2], p0[r + 3]); a = NMX3(a, p1[r], p1[r + 1]); b = NMX3(b, p1[r + 2], p1[r + 3]); }
    const float m = fmaxf(a, b); const auto rr = __builtin_amdgcn_permlane32_swap(__float_as_uint(m), __float_as_uint(m), false, false);
    return fmaxf(__uint_as_float(rr[0]), __uint_as_float(rr[1])); }
template <int KIND>
__device__ __forceinline__ void nsa_mask(f32x16& p0, f32x16& p1, int kbase, int t, int hi) {
#pragma unroll
    for (int r = 0; r < 16; ++r) { const int k0 = kbase + crow(r, hi), k1 = k0 + 32; bool v0, v1;
        if (KIND == 1) { v0 = k0 <= t; v1 = k1 <= t; } else { v0 = k0 <= t && k0 >= t - 511; v1 = k1 <= t && k1 >= t - 511; }
        p0[r] = v0 ? p0[r] : -INFINITY; p1[r] = v1 ? p1[r] : -INFINITY; } }
template <int KIND>
__device__ __forceinline__ void nsa_pipe(LAS unsigned char* L, const bf16_t* Kp, const bf16_t* Vp, unsigned mlo, unsigned mhi, unsigned sel0, unsigned sel1,
                                         const bf16x8 (&qr)[4], int t, int lane, int w, int hi, unsigned kfo, unsigned vfo,
                                         float& lsum, f32x16& o0, f32x16& o1) {
    unsigned ulo = mlo, uhi = mhi;
    const bf16_t* ksrc = Kp + lane * 64 + w * 8; const bf16_t* vsrc = Vp + (16 * (w & 3) + (lane >> 2)) * 64 + (w >> 2) * 32 + (lane & 3) * 8;
    const unsigned kdst = (unsigned)(uintptr_t)L + w * NSA_KCH, vdst = (unsigned)(uintptr_t)L + NSA_KIMG + (w >> 2) * NSA_VDH + (w & 3) * 1024;
#define NP_DMA(j, sl) do { glds16(ksrc + (size_t)(j) * 4096, (unsigned)__builtin_amdgcn_readfirstlane(kdst + (sl) * NSA_BUF)); glds16(vsrc + (size_t)(j) * 4096, (unsigned)__builtin_amdgcn_readfirstlane(vdst + (sl) * NSA_BUF)); } while (0)
#define NP_DMAWAIT() asm volatile("s_waitcnt vmcnt(0)" ::: "memory")
    const int n = __builtin_popcount(ulo) + __builtin_popcount(uhi);
#define NP_NEXT(jv) do { jv = -1; if (ulo | uhi) { jv = ulo ? __builtin_ctz(ulo) : 32 + __builtin_ctz(uhi); if (ulo) ulo &= ulo - 1; else uhi &= uhi - 1; } } while (0)
#define NP_SELBIT(j) ((((j) < 32 ? (sel0 >> ((j) & 31)) : (sel1 >> (((j) - 32) & 31))) & 1u) != 0u)
#define NP_KIMG(sl) (L + (sl) * NSA_BUF)
#define NP_VIMG(sl) (L + (sl) * NSA_BUF + NSA_KIMG)
    int jc, jn1, jn2;
    NP_NEXT(jc); NP_NEXT(jn1); NP_NEXT(jn2);
    NP_DMA(jc, 0); if (jn1 >= 0) NP_DMA(jn1, 1); if (jn2 >= 0) NP_DMA(jn2, 2);
    NP_DMAWAIT();
    __syncthreads();
    float m = -1e30f, cin = 0.f, l = 0.f, fsc = 1.f; bool resc = false;
    o0 = (f32x16){0}; o1 = (f32x16){0};
    f32x16 pA0, pA1, pB0, pB1, ci16; bf16x8 kf[8]; s16x4 vlo[8], vhi[8]; u32x4 pw0, pw1, pw2, pw3;
#define NP_KLOAD2(sl, d0) do { kf[2 * (d0)] = *(LAS const bf16x8*)(NP_KIMG(sl) + kfo + (d0) * (2 * NSA_KCH)); kf[2 * (d0) + 1] = *(LAS const bf16x8*)(NP_KIMG(sl) + kfo + (d0) * (2 * NSA_KCH) + 512); } while (0)
#define NP_SPLAT(v) do { _Pragma("unroll") for (int r = 0; r < 16; ++r) ci16[r] = (v); } while (0)
#define NP_CINIT(jt) do { if (KIND == 1) { const float c_ = NP_SELBIT(jt) ? cin : -INFINITY; NP_SPLAT(c_); } } while (0)
#define NP_DECIDE(C0, C1) do { const float rm_ = nsa_rowmax(C0, C1); const bool fresh_ = m < -1e29f; \
        const bool grow_ = fresh_ ? (rm_ > -INFINITY) : (rm_ > NSA_THR); resc = false; \
        if (__any(grow_)) { const float dl_ = grow_ ? rm_ : 0.f; fsc = (grow_ && !fresh_) ? ex2(-rm_) : 1.f; m = grow_ ? (fresh_ ? rm_ : m + rm_) : m; cin = grow_ ? -m : cin; l *= fsc; resc = true; \
            _Pragma("unroll") for (int r = 0; r < 16; ++r) { C0[r] -= dl_; C1[r] -= dl_; } \
            if (KIND == 2) NP_SPLAT(cin); } } while (0)
    { _Pragma("unroll") for (int d0 = 0; d0 < 4; ++d0) NP_KLOAD2(0, d0);
      if (KIND == 2) NP_SPLAT(0.f); else NP_CINIT(jc);
      NSB();
      pA0 = MFMA32(kf[0], qr[0], ci16); pA1 = MFMA32(kf[1], qr[0], ci16);
      _Pragma("unroll") for (int d0 = 1; d0 < 4; ++d0) { pA0 = MFMA32(kf[2 * d0], qr[d0], pA0); pA1 = MFMA32(kf[2 * d0 + 1], qr[d0], pA1); }
      nsa_mask<KIND>(pA0, pA1, 64 * jc, t, hi);
      NP_DECIDE(pA0, pA1);
      _Pragma("unroll") for (int r = 0; r < 16; ++r) { pA0[r] = ex2(pA0[r]); pA1[r] = ex2(pA1[r]); }
      if (jn1 >= 0) { _Pragma("unroll") for (int d0 = 0; d0 < 4; ++d0) NP_KLOAD2(1, d0); }
      jc = jn1; jn1 = jn2; NP_NEXT(jn2); }
    int s = 1;
#define NP_PKW(P, i) cvtpk(P[i], P[(i) + 1])
#define NP_VFR(i) mk8(vlo[i], vhi[i])
#define NP_VRD(i) do { LAS const unsigned char* a_ = vp_ + ((i) >> 1) * 1024 + ((i) & 1) * NSA_VDH; vlo[i] = vtr(a_); vhi[i] = vtr(a_ + 512); } while (0)
#define NP_GAPA(MF, a0, a1, a2, a3, W0, W1, PW) do { MF; sacc += a0; sacc += a1; sacc += a2; sacc += a3; W0; W1; NPIN(PW); NPIN(sacc); NSB(); } while (0)
#define NP_GAPB(MF, X, i) do { MF; X[i] = ex2(X[i]); X[(i) + 1] = ex2(X[(i) + 1]); X[(i) + 2] = ex2(X[(i) + 2]); X[(i) + 3] = ex2(X[(i) + 3]); NPIN(X); NSB(); } while (0)
#define NP_KRD(GL, d0) do { if (GL) { NP_KLOAD2(sn_, d0); NSB(); } } while (0)
#define NP_STEP(C0, C1, P0, P1, LAST) do { NSB(); \
    const int sp_ = (s - 1) & 3, sn_ = (s + 1) & 3, sw_ = (s + 2) & 3; \
    if (!(LAST) && jn2 >= 0) NP_DMA(jn2, sw_);     \
    LAS const unsigned char* vp_ = NP_VIMG(sp_) + vfo; \
    NP_CINIT(jc); \
    float sacc = P0[0] + P0[1]; NSB(); \
    NP_GAPA(C0 = MFMA32(kf[0], qr[0], ci16), P0[2], P0[3], P0[4], P0[5],     pw0[0] = NP_PKW(P0, 0),  pw0[1] = NP_PKW(P0, 2),  pw0); \
    NP_GAPA(C1 = MFMA32(kf[1], qr[0], ci16), P0[6], P0[7], P0[8], P0[9],     pw0[2] = NP_PKW(P0, 4),  pw0[3] = NP_PKW(P0, 6),  pw0); \
    NP_GAPA(C0 = MFMA32(kf[2], qr[1], C0),            P0[10], P0[11], P0[12], P0[13], pw1[0] = NP_PKW(P0, 8),  pw1[1] = NP_PKW(P0, 10), pw1); \
    NP_GAPA(C1 = MFMA32(kf[3], qr[1], C1),            P0[14], P0[15], P1[0], P1[1],   pw1[2] = NP_PKW(P0, 12), pw1[3] = NP_PKW(P0, 14), pw1); \
    NP_GAPA(C0 = MFMA32(kf[4], qr[2], C0),            P1[2], P1[3], P1[4], P1[5],     pw2[0] = NP_PKW(P1, 0),  pw2[1] = NP_PKW(P1, 2),  pw2); \
    NP_GAPA(C1 = MFMA32(kf[5], qr[2], C1),            P1[6], P1[7], P1[8], P1[9],     pw2[2] = NP_PKW(P1, 4),  pw2[3] = NP_PKW(P1, 6),  pw2); \
    NP_GAPA(C0 = MFMA32(kf[6], qr[3], C0),            P1[10], P1[11], P1[12], P1[13], pw3[0] = NP_PKW(P1, 8),  pw3[1] = NP_PKW(P1, 10), pw3); \
    NP_GAPA(C1 = MFMA32(kf[7], qr[3], C1),            P1[14], P1[15], 0.f, 0.f,       pw3[2] = NP_PKW(P1, 12), pw3[3] = NP_PKW(P1, 14), pw3); \
    l += sacc; \
    NP_VRD(0); NP_VRD(1); NP_VRD(2); NP_VRD(3); NSB();     \
    if (LAST) nsa_mask<KIND>(C0, C1, 64 * jc, t, hi); \
    NP_DECIDE(C0, C1); NSB(); \
    NP_VRD(4); NSB(); NP_GAPB(o0 = MFMA32(NP_VFR(0), __builtin_bit_cast(bf16x8, pw0), o0), C0, 0); \
    NP_VRD(5); NSB(); NP_GAPB(o1 = MFMA32(NP_VFR(1), __builtin_bit_cast(bf16x8, pw0), o1), C0, 4); \
    NP_VRD(6); NSB(); NP_KRD(!(LAST), 0); NP_GAPB(o0 = MFMA32(NP_VFR(2), __builtin_bit_cast(bf16x8, pw1), o0), C0, 8); \
    NP_VRD(7); NSB(); NP_KRD(!(LAST), 1); NP_GAPB(o1 = MFMA32(NP_VFR(3), __builtin_bit_cast(bf16x8, pw1), o1), C0, 12); \
    NP_KRD(!(LAST), 2); NP_GAPB(o0 = MFMA32(NP_VFR(4), __builtin_bit_cast(bf16x8, pw2), o0), C1, 0); \
    NP_KRD(!(LAST), 3); NP_GAPB(o1 = MFMA32(NP_VFR(5), __builtin_bit_cast(bf16x8, pw2), o1), C1, 4); \
    NP_GAPB(o0 = MFMA32(NP_VFR(6), __builtin_bit_cast(bf16x8, pw3), o0), C1, 8);  NP_GAPB(o1 = MFMA32(NP_VFR(7), __builtin_bit_cast(bf16x8, pw3), o1), C1, 12); \
    NP_DMAWAIT(); \
    __syncthreads(); \
    if (resc) { _Pragma("unroll") for (int r = 0; r < 16; ++r) { o0[r] *= fsc; o1[r] *= fsc; } } \
    jc = jn1; jn1 = jn2; NP_NEXT(jn2); ++s; } while (0)
    int rem = n - 1;
    if (n & 1) { pB0 = pA0; pB1 = pA1; if (rem > 0) { NP_STEP(pA0, pA1, pB0, pB1, false); --rem; } }
    while (rem >= 3) { NP_STEP(pB0, pB1, pA0, pA1, false); NP_STEP(pA0, pA1, pB0, pB1, false); rem -= 2; }
    if (rem == 1) { NP_STEP(pB0, pB1, pA0, pA1, true); }
    { float sacc = pB0[0] + pB0[1];
      _Pragma("unroll") for (int r = 2; r < 16; ++r) sacc += pB0[r];
      _Pragma("unroll") for (int r = 0; r < 16; ++r) sacc += pB1[r];
      l += sacc;
      pw0 = (u32x4){NP_PKW(pB0, 0), NP_PKW(pB0, 2), NP_PKW(pB0, 4), NP_PKW(pB0, 6)}; pw1 = (u32x4){NP_PKW(pB0, 8), NP_PKW(pB0, 10), NP_PKW(pB0, 12), NP_PKW(pB0, 14)};
      pw2 = (u32x4){NP_PKW(pB1, 0), NP_PKW(pB1, 2), NP_PKW(pB1, 4), NP_PKW(pB1, 6)}; pw3 = (u32x4){NP_PKW(pB1, 8), NP_PKW(pB1, 10), NP_PKW(pB1, 12), NP_PKW(pB1, 14)};
      LAS const unsigned char* vp_ = NP_VIMG((n - 1) & 3) + vfo;
      _Pragma("unroll") for (int i = 0; i < 8; ++i) NP_VRD(i);
      NSB();
      o0 = MFMA32(NP_VFR(0), __builtin_bit_cast(bf16x8, pw0), o0); o1 = MFMA32(NP_VFR(1), __builtin_bit_cast(bf16x8, pw0), o1);
      o0 = MFMA32(NP_VFR(2), __builtin_bit_cast(bf16x8, pw1), o0); o1 = MFMA32(NP_VFR(3), __builtin_bit_cast(bf16x8, pw1), o1);
      o0 = MFMA32(NP_VFR(4), __builtin_bit_cast(bf16x8, pw2), o0); o1 = MFMA32(NP_VFR(5), __builtin_bit_cast(bf16x8, pw2), o1);
      o0 = MFMA32(NP_VFR(6), __builtin_bit_cast(bf16x8, pw3), o0); o1 = MFMA32(NP_VFR(7), __builtin_bit_cast(bf16x8, pw3), o1); }
    __syncthreads();
    lsum = l;
#undef NP_DMA
#undef NP_DMAWAIT
#undef NP_NEXT
#undef NP_SELBIT
#undef NP_KIMG
#undef NP_VIMG
#undef NP_KLOAD2
#undef NP_SPLAT
#undef NP_CINIT
#undef NP_DECIDE
#undef NP_PKW
#undef NP_VFR
#undef NP_VRD
#undef NP_GAPA
#undef NP_GAPB
#undef NP_KRD
#undef NP_STEP
}

__device__ __forceinline__ void nsa_unit(Frame& F, int b, int g, int qb) {
    int tid = F.tid; asm volatile("" : "+v"(tid));
    const int lane = tid & 63, w = F.wave, r32 = lane & 31, hi = lane >> 5;
    const int hh = 4 * g + (w & 3), th = w >> 2, cur = qb, T0 = qb * 64, tokl = 32 * th + r32, t = T0 + tokl;
    const size_t row = (size_t)b * SEQ + t; const int bg = b * 2 + g;
    LAS unsigned char* L = F.lds;
    bf16x8 qr[4];
    { const bf16_t* qp = WSP(bf16_t, WS_NQ) + row * 512 + hh * 64 + 8 * hi;
#pragma unroll
      for (int d0 = 0; d0 < 4; ++d0) qr[d0] = *(const bf16x8*)(qp + 16 * d0); }
    const float* gp = WSP(float, WS_NGT) + row * 24 + hh * 3; const float gate_c = gp[0], gate_s = gp[1], gate_w = gp[2];
    unsigned outp0[8], outp1[8];
    const unsigned kst = (tid & 7) * NSA_KCH + (tid >> 3) * 16, vst = ((tid & 7) >> 2) * NSA_VDH + (tid >> 3) * 64 + (tid & 3) * 16;
    const unsigned kfo = hi * NSA_KCH + r32 * 16, vfo = tr_lane_off(lane);
    float m, l; f32x16 o0, o1;
    u32x4 rk, rv;
#define NSA_LOAD(Kp, Vp, tile) do { rk = *(const u32x4*)((Kp) + (size_t)(tile) * 4096 + tid * 8); rv = *(const u32x4*)((Vp) + (size_t)(tile) * 4096 + tid * 8); } while (0)
#define NSA_WRITE(buf) do { *(LAS u32x4*)(L + (buf) * NSA_BUF + kst) = rk; *(LAS u32x4*)(L + (buf) * NSA_BUF + NSA_KIMG + vst) = rv; } while (0)
#define NSA_NEXT(jv) do { jv = -1; if (ulo | uhi) { jv = ulo ? __builtin_ctz(ulo) : 32 + __builtin_ctz(uhi); if (ulo) ulo &= ulo - 1; else uhi &= uhi - 1; } } while (0)
#define NSA_RUN(Kp, Vp, MLO, MHI, ...) do { unsigned ulo = (MLO), uhi = (MHI); int j, j1, j2; u32x4 rk2, rv2; \
        NSA_NEXT(j); NSA_LOAD(Kp, Vp, j); NSA_WRITE(0); NSA_NEXT(j1); if (j1 >= 0) NSA_LOAD(Kp, Vp, j1); __syncthreads(); int buf = 0; \
        for (;;) { NSA_NEXT(j2); if (j2 >= 0) { rk2 = *(const u32x4*)((Kp) + (size_t)j2 * 4096 + tid * 8); rv2 = *(const u32x4*)((Vp) + (size_t)j2 * 4096 + tid * 8); } \
            { LAS const unsigned char* KI = L + buf * NSA_BUF; LAS const unsigned char* VI = KI + NSA_KIMG; __VA_ARGS__ } \
            if (j1 >= 0) NSA_WRITE(buf ^ 1); __syncthreads(); if (j1 < 0) break; j = j1; j1 = j2; rk = rk2; rv = rv2; buf ^= 1; } } while (0)
#define NSA_LOAD2(Kp, Vp, ja, jb) do { rk = *(const u32x4*)((Kp) + (size_t)(ja) * 4096 + tid * 8); rv = *(const u32x4*)((Vp) + (size_t)(ja) * 4096 + tid * 8); \
        if ((jb) >= 0) { rkB = *(const u32x4*)((Kp) + (size_t)(jb) * 4096 + tid * 8); rvB = *(const u32x4*)((Vp) + (size_t)(jb) * 4096 + tid * 8); } } while (0)
#define NSA_WRITE2(pb, jb) do { LAS unsigned char* P_ = L + (pb) * (2 * NSA_BUF); *(LAS u32x4*)(P_ + kst) = rk; *(LAS u32x4*)(P_ + NSA_KIMG + vst) = rv; \
        if ((jb) >= 0) { *(LAS u32x4*)(P_ + NSA_BUF + kst) = rkB; *(LAS u32x4*)(P_ + NSA_BUF + NSA_KIMG + vst) = rvB; } } while (0)
#define NSA_RUN2(Kp, Vp, MLO, MHI, ...) do { unsigned ulo = (MLO), uhi = (MHI); int ja, jb, na, nb; u32x4 rkB, rvB; \
        NSA_NEXT(ja); NSA_NEXT(jb); NSA_LOAD2(Kp, Vp, ja, jb); NSA_WRITE2(0, jb); __syncthreads(); int pbuf = 0; \
        for (;;) { NSA_NEXT(na); NSA_NEXT(nb); if (na >= 0) NSA_LOAD2(Kp, Vp, na, nb); \
            { LAS const unsigned char* KA = L + pbuf * (2 * NSA_BUF); LAS const unsigned char* VA = KA + NSA_KIMG; LAS const unsigned char* KB = KA + NSA_BUF; LAS const unsigned char* VB = KB + NSA_KIMG; __VA_ARGS__ } \
            if (na >= 0) NSA_WRITE2(pbuf ^ 1, nb); __syncthreads(); if (na < 0) break; ja = na; jb = nb; pbuf ^= 1; } } while (0)
#define NSA_LT(lv) ({ const auto rr_ = __builtin_amdgcn_permlane32_swap(__float_as_uint(lv), __float_as_uint(lv), false, false); __uint_as_float(rr_[0]) + __uint_as_float(rr_[1]); })
#define NSA_RESET() do { m = -1e30f; l = 0.f; o0 = (f32x16){0}; o1 = (f32x16){0}; } while (0)

    const bf16_t* Kc = WSP(bf16_t, WS_KCMP) + (size_t)bg * 256 * 64; const bf16_t* Vc = WSP(bf16_t, WS_VCMP) + (size_t)bg * 256 * 64;
    const int ntc = ((4 * cur + 2) >> 6) + 1; const int lim = (t >= 31) ? ((t - 31) >> 4) : -1;
    const int tmin_w = T0 + 32 * th; const int lim_min = (tmin_w >= 31) ? ((tmin_w - 31) >> 4) : -1;
    unsigned sel0, sel1, un0, un1;
    {
        LAS float* IMP = (LAS float*)(L + NSA_IMP); LAS float* FAC = (LAS float*)(L + NSA_FAC);
        float carry = 0.f; const bool need_imp = cur >= 16;
        float mt0 = 0.f, mt1 = 0.f, mt2 = 0.f, mt3 = 0.f;
        m = -1e30f; l = 0.f; o0 = (f32x16){0}; o1 = (f32x16){0};
        NSA_RUN(Kc, Vc, (1u << ntc) - 1u, 0u, {
            f32x16 p0, p1; nsa_qk(KI, qr, kfo, p0, p1);
            if (64 * j + 63 > lim_min) {
                _Pragma("unroll") for (int r = 0; r < 16; ++r) { const int k0 = 64 * j + crow(r, hi);
                    p0[r] = (k0 <= lim) ? p0[r] : -INFINITY; p1[r] = (k0 + 32 <= lim) ? p1[r] : -INFINITY; } }
            { const float rm = nsa_rowmax(p0, p1); const bool fresh = m < -1e29f; const bool grow = fresh ? (rm > -INFINITY) : (rm - m > NSA_THR);
              if (__any(grow)) { const float mn = grow ? rm : m; const float f = (grow && !fresh) ? ex2(m - mn) : 1.f; m = mn; l *= f; carry *= f;
                  _Pragma("unroll") for (int r = 0; r < 16; ++r) { o0[r] *= f; o1[r] *= f; } } }
            if (j == 0) mt0 = m; else if (j == 1) mt1 = m; else if (j == 2) mt2 = m; else mt3 = m;
            { float rs = 0.f;
              _Pragma("unroll") for (int r = 0; r < 16; ++r) { p0[r] = ex2(p0[r] - m); p1[r] = ex2(p1[r] - m); rs += p0[r] + p1[r]; }
              l += rs; }
            if (need_imp) {
                _Pragma("unroll") for (int n = 0; n < 2; ++n) {
                    float a[4], bq[4], pb[4];
                    _Pragma("unroll") for (int q4 = 0; q4 < 4; ++q4) { const float x0 = n ? p1[4 * q4] : p0[4 * q4], x1 = n ? p1[4 * q4 + 1] : p0[4 * q4 + 1], x2 = n ? p1[4 * q4 + 2] : p0[4 * q4 + 2], x3 = n ? p1[4 * q4 + 3] : p0[4 * q4 + 3];
                        a[q4] = 2.f * (x0 + x1 + x2) + x3; bq[q4] = x3; }
                    _Pragma("unroll") for (int q4 = 0; q4 < 4; ++q4) pb[q4] = __shfl_xor(bq[q4], 32);
                    _Pragma("unroll") for (int q4 = 0; q4 < 4; ++q4) { const float prevb = hi ? pb[q4] : (q4 ? pb[q4 > 0 ? q4 - 1 : 0] : carry);
                        IMP[((w & 3) * 64 + tokl) * NSA_IST + 16 * j + 8 * n + 2 * q4 + hi] = a[q4] + prevb; }
                    carry = pb[3];
                } }
            u32x4 pw[4];
            _Pragma("unroll") for (int s = 0; s < 2; ++s) {
                pw[s].x = cvtpk(p0[8 * s + 0], p0[8 * s + 1]); pw[s].y = cvtpk(p0[8 * s + 2], p0[8 * s + 3]); pw[s].z = cvtpk(p0[8 * s + 4], p0[8 * s + 5]); pw[s].w = cvtpk(p0[8 * s + 6], p0[8 * s + 7]);
                pw[2 + s].x = cvtpk(p1[8 * s + 0], p1[8 * s + 1]); pw[2 + s].y = cvtpk(p1[8 * s + 2], p1[8 * s + 3]); pw[2 + s].z = cvtpk(p1[8 * s + 4], p1[8 * s + 5]); pw[2 + s].w = cvtpk(p1[8 * s + 6], p1[8 * s + 7]); }
            _Pragma("unroll") for (int ks = 0; ks < 4; ++ks) {
                const bf16x8 v0 = mk8(vtr(VI + vfo + ks * 1024), vtr(VI + vfo + ks * 1024 + 512));
                const bf16x8 v1 = mk8(vtr(VI + vfo + NSA_VDH + ks * 1024), vtr(VI + vfo + NSA_VDH + ks * 1024 + 512));
                o0 = MFMA32(v0, __builtin_bit_cast(bf16x8, pw[ks]), o0); o1 = MFMA32(v1, __builtin_bit_cast(bf16x8, pw[ks]), o1); } });
        const float inv_c = 1.f / fmaxf(NSA_LT(l), 1e-30f); const float gs_ = gate_c * inv_c;
        _Pragma("unroll") for (int r = 0; r < 8; ++r) { outp0[r] = cvtpk(gs_ * o0[2 * r], gs_ * o0[2 * r + 1]); outp1[r] = cvtpk(gs_ * o1[2 * r], gs_ * o1[2 * r + 1]); }
        if (need_imp) {
            if (hi == 0) { f32x4 fc; fc[0] = ex2(mt0 - m) * inv_c; fc[1] = ntc > 1 ? ex2(mt1 - m) * inv_c : 0.f; fc[2] = ntc > 2 ? ex2(mt2 - m) * inv_c : 0.f; fc[3] = ntc > 3 ? ex2(mt3 - m) * inv_c : 0.f;
                *(LAS f32x4*)(FAC + ((w & 3) * 64 + tokl) * 4) = fc; }
            __syncthreads(); }
    }
    if (cur >= 16) {
        LAS float* IMP = (LAS float*)(L + NSA_IMP);
        LAS unsigned* TOT = (LAS unsigned*)(L + NSA_TOT); LAS unsigned char* SELB = L + NSA_SELB; LAS unsigned* UNI = (LAS unsigned*)(L + NSA_UNI);
        { const int tk = tid >> 3, jg = tid & 7; LAS const float* FAC = (LAS const float*)(L + NSA_FAC);
          float fq[4];
#pragma unroll
          for (int h4 = 0; h4 < 4; ++h4) fq[h4] = FAC[(h4 * 64 + tk) * 4 + (jg >> 1)];
#pragma unroll
          for (int jj = 0; jj < 8; ++jj) { const int jx = 8 * jg + jj;
              const float tot = ((IMP[tk * NSA_IST + jx] * fq[0] + IMP[(64 + tk) * NSA_IST + jx] * fq[1]) + IMP[(128 + tk) * NSA_IST + jx] * fq[2]) + IMP[(192 + tk) * NSA_IST + jx] * fq[3];
              TOT[tk * NSA_IST + jx] = (__float_as_uint(tot) & ~63u) | (unsigned)(63 - jx); }
          if (tid < 2) UNI[tid] = 0u; }
        __syncthreads();
        { const int tk = tid >> 3, jg = tid & 7; unsigned bits = 0u;
          unsigned v[8]; int rank[8];
#pragma unroll
          for (int jj = 0; jj < 8; ++jj) { v[jj] = TOT[tk * NSA_IST + 8 * jg + jj]; rank[jj] = 0; }
#pragma unroll 4
          for (int k2 = 1; k2 <= cur - 2; ++k2) { const unsigned v2 = TOT[tk * NSA_IST + k2];
#pragma unroll
              for (int jj = 0; jj < 8; ++jj) rank[jj] += (int)(v2 > v[jj]); }
#pragma unroll
          for (int jj = 0; jj < 8; ++jj) { const int jx = 8 * jg + jj;
              const bool s = (jx == 0 || jx == cur || jx == cur - 1) || (jx < cur - 1 && rank[jj] < 13);
              bits |= s ? (1u << jj) : 0u; }
          SELB[tk * 8 + jg] = (unsigned char)bits;
          atomicOr((unsigned*)&UNI[jg >> 2], bits << (8 * (jg & 3))); }
        __syncthreads();
        sel0 = *(LAS const unsigned*)(SELB + tokl * 8); sel1 = *(LAS const unsigned*)(SELB + tokl * 8 + 4);
        un0 = __builtin_amdgcn_readfirstlane(UNI[0]); un1 = __builtin_amdgcn_readfirstlane(UNI[1]);
    } else {
        sel0 = (1u << (cur + 1)) - 1u; sel1 = 0u; un0 = sel0; un1 = 0u;
    }
    LAS unsigned* ST = (LAS unsigned*)(L + NSA_STASH + w * 4096) + lane;
#pragma unroll
    for (int r = 0; r < 8; ++r) { ST[r * 64] = outp0[r]; ST[(8 + r) * 64] = outp1[r]; }
    const bf16_t* Ks = WSP(bf16_t, WS_KSL) + (size_t)bg * SEQ * 64; const bf16_t* Vs = WSP(bf16_t, WS_VSL) + (size_t)bg * SEQ * 64;
    NDUP(3) nsa_pipe<1>(L, Ks, Vs, un0, un1, sel0, sel1, qr, t, lane, w, hi, kfo, vfo, l, o0, o1);
    { const float sc = gate_s / fmaxf(NSA_LT(l), 1e-30f);
#pragma unroll
      for (int r = 0; r < 8; ++r) { const unsigned a = ST[r * 64], c = ST[(8 + r) * 64];
          ST[r * 64] = cvtpk(bflo(a) + sc * o0[2 * r], bfhi(a) + sc * o0[2 * r + 1]); ST[(8 + r) * 64] = cvtpk(bflo(c) + sc * o1[2 * r], bfhi(c) + sc * o1[2 * r + 1]); } }
    const bf16_t* Kw = WSP(bf16_t, WS_KWN) + (size_t)bg * SEQ * 64; const bf16_t* Vw = WSP(bf16_t, WS_VWN) + (size_t)bg * SEQ * 64;
    { const int jlo = cur >= 8 ? cur - 8 : 0;
      const unsigned long long wm = ((cur == 63) ? ~0ull : ((1ull << (cur + 1)) - 1ull)) & ~((1ull << jlo) - 1ull);
      NDUP(4) nsa_pipe<2>(L, Kw, Vw, (unsigned)wm, (unsigned)(wm >> 32), 0u, 0u, qr, t, lane, w, hi, kfo, vfo, l, o0, o1); }
    { const float sc = gate_w / fmaxf(NSA_LT(l), 1e-30f);
      bf16_t* yo = WSP(bf16_t, WS_YCAT) + row * 1024 + 512 + hh * 64;
#pragma unroll
      for (int p2 = 0; p2 < 2; ++p2) { u32x2 av[2], cv[2];
#pragma unroll
          for (int e = 0; e < 2; ++e) { const int q4 = 2 * p2 + e;
              const unsigned a0 = ST[(2 * q4) * 64], a1 = ST[(2 * q4 + 1) * 64], c0 = ST[(8 + 2 * q4) * 64], c1 = ST[(9 + 2 * q4) * 64];
              av[e].x = cvtpk(bflo(a0) + sc * o0[4 * q4], bfhi(a0) + sc * o0[4 * q4 + 1]); av[e].y = cvtpk(bflo(a1) + sc * o0[4 * q4 + 2], bfhi(a1) + sc * o0[4 * q4 + 3]);
              cv[e].x = cvtpk(bflo(c0) + sc * o1[4 * q4], bfhi(c0) + sc * o1[4 * q4 + 1]); cv[e].y = cvtpk(bflo(c1) + sc * o1[4 * q4 + 2], bfhi(c1) + sc * o1[4 * q4 + 3]); }
          *(u32x4*)(yo + 16 * p2 + 8 * hi) = widen_pair(av[0], av[1]); *(u32x4*)(yo + 32 + 16 * p2 + 8 * hi) = widen_pair(cv[0], cv[1]); } }
#undef NSA_LOAD
#undef NSA_WRITE
#undef NSA_RUN
#undef NSA_RUN2
#undef NSA_LOAD2
#undef NSA_WRITE2
#undef NSA_LT
#undef NSA_RESET
}

__device__ __forceinline__ void s6_phase(Frame& F) {
    int tid = F.tid; asm volatile("" : "+v"(tid));
    const int lane = tid & 63, w = F.wave;
    LAS unsigned char* TILE = F.lds + w * 16384;
    LAS float* LG = (LAS float*)(F.lds + MISC_OFF + 4096) + w * (8 * 48);
    LAS int* REC_E = (LAS int*)(F.lds + MISC_OFF + 16384);
    LAS float* REC_G = (LAS float*)(F.lds + MISC_OFF + 16384 + 1024);
    LAS int* REC_P = (LAS int*)(F.lds + MISC_OFF + 16384 + 2048);
    LAS int* CNTL = (LAS int*)(F.lds + MISC_OFF + 16384 + 3072);
    LAS float* SAW = (LAS float*)(F.lds + MISC_OFF + 16384 + 3584);
    const float* x = IN_F(0); const float* wpost = IN_F(6); const float* wffn = IN_F(7); const float* mod = WSP(float, WS_MOD);
    const bf16_t* Y = WSP(bf16_t, WS_Y); bf16_t* X1B = WSP(bf16_t, WS_X1B); signed char* H2Q = (signed char*)(F.ws + WS_H2Q); float* SAv = WSP(float, WS_SA); const _Float16* RWT = WSP(_Float16, WS_RWT);
    const float* bgp = IN_F(21); const float* bep = IN_F(23);
    unsigned* cntg = (unsigned*)(F.ws + WS_CTL) + CW_CNT;
    for (int rb = F.vcu; rb < NTOK / 128; rb += F.G) {
        if (tid < 64) CNTL[tid] = 0;
        __syncthreads();
        const int rbase = rb * 128 + w * 16, b = rbase >> 12;
        f32x4 xv[4][4]; u32x2 yr[4][4];
#define S6_LOAD(g) do { _Pragma("unroll") for (int r = 0; r < 4; ++r) { const size_t ro_ = (size_t)(rbase + 4 * (g) + r) * DM + 4 * lane; \
            _Pragma("unroll") for (int j = 0; j < 4; ++j) { xv[r][j] = __builtin_nontemporal_load((const f32x4*)(x + ro_ + 256 * j)); yr[r][j] = __builtin_nontemporal_load((const u32x2*)(Y + ro_ + 256 * j)); } } } while (0)
#define S6_Y(r, j) ((f32x4){bflo(yr[r][j].x), bfhi(yr[r][j].x), bflo(yr[r][j].y), bfhi(yr[r][j].y)})
        S6_LOAD(0);
#pragma nounroll
        for (int g = 0; g < 4; ++g) {
            int l4 = 4 * lane; asm volatile("" : "+v"(l4));
            float ss[4];
#pragma unroll
            for (int r = 0; r < 4; ++r) { float a2 = 0.f;
#pragma unroll
                for (int j = 0; j < 4; ++j) { const f32x4 y = S6_Y(r, j); a2 += y[0] * y[0] + y[1] * y[1] + y[2] * y[2] + y[3] * y[3]; }
                ss[r] = a2; }
#pragma unroll
            for (int o = 1; o < 64; o <<= 1) {
#pragma unroll
                for (int r = 0; r < 4; ++r) ss[r] += __shfl_xor(ss[r], o); }
            float s2[4] = {0.f, 0.f, 0.f, 0.f};
#pragma unroll
            for (int j = 0; j < 4; ++j) { const int k = l4 + 256 * j;
                const f32x4 wp = *(const f32x4*)(wpost + k), gm = *(const f32x4*)(mod + b * 6144 + 2048 + k); const f32x4 gw2 = gm * wp;
#pragma unroll
                for (int r = 0; r < 4; ++r) { const float r1 = rsqrtf(ss[r] * (1.f / DM) + RMS_EPS);
                    xv[r][j] = xv[r][j] + gw2 * (S6_Y(r, j) * r1);
                    { u32x2 xo; xo.x = cvtpk(xv[r][j][0], xv[r][j][1]); xo.y = cvtpk(xv[r][j][2], xv[r][j][3]); __builtin_nontemporal_store(xo, (u32x2*)(X1B + (size_t)(rbase + 4 * g + r) * DM + k)); }
                    s2[r] += xv[r][j][0] * xv[r][j][0] + xv[r][j][1] * xv[r][j][1] + xv[r][j][2] * xv[r][j][2] + xv[r][j][3] * xv[r][j][3]; } }
#pragma unroll
            for (int o = 1; o < 64; o <<= 1) {
#pragma unroll
                for (int r = 0; r < 4; ++r) s2[r] += __shfl_xor(s2[r], o); }
#pragma unroll
            for (int j = 0; j < 4; ++j) { const int k = l4 + 256 * j;
                const f32x4 wf = *(const f32x4*)(wffn + k), sh = *(const f32x4*)(mod + b * 6144 + 3072 + k), sc = *(const f32x4*)(mod + b * 6144 + 4096 + k); const f32x4 ws = wf * (sc + 1.f);
#pragma unroll
                for (int r = 0; r < 4; ++r) { const float r2 = rsqrtf(s2[r] * (1.f / DM) + RMS_EPS);
                    const f32x4 h = xv[r][j] * r2 * ws + sh;
                    { const int rt = 4 * (g & 1) + r; const f16x4 hh = {(_Float16)h[0], (_Float16)h[1], (_Float16)h[2], (_Float16)h[3]};
                      *(LAS f16x4*)(TILE + rt * 2048 + (((lane >> 1) ^ rt) << 4) + (lane & 1) * 8 + 512 * j) = hh; }
                    xv[r][j] = h; } }
            float am[4];
#pragma unroll
            for (int r = 0; r < 4; ++r) { float a = 0.f;
#pragma unroll
                for (int j = 0; j < 4; ++j) a = fmaxf(a, fmaxf(fmaxf(fabsf(xv[r][j][0]), fabsf(xv[r][j][1])), fmaxf(fabsf(xv[r][j][2]), fabsf(xv[r][j][3]))));
                am[r] = a; }
#pragma unroll
            for (int o = 1; o < 64; o <<= 1) {
#pragma unroll
                for (int r = 0; r < 4; ++r) am[r] = fmaxf(am[r], __shfl_xor(am[r], o)); }
#pragma unroll
            for (int r = 0; r < 4; ++r) { const float inv = am[r] > 0.f ? 127.f / am[r] : 0.f; const size_t ro = (size_t)(rbase + 4 * g + r) * DM;
                if (lane == 0) { SAv[rbase + 4 * g + r] = am[r] * (1.f / 127.f); SAW[(w * 16 + 4 * g + r)] = am[r] * (1.f / 127.f); }
#pragma unroll
                for (int j = 0; j < 4; ++j) { const int k = 4 * lane + 256 * j; const f32x4 q = xv[r][j] * inv;
                    const int q0 = (int)rintf(q[0]), q1 = (int)rintf(q[1]), q2 = (int)rintf(q[2]), q3 = (int)rintf(q[3]);
                    *(unsigned*)(H2Q + ro + k) = (unsigned)(q0 & 0xff) | ((unsigned)(q1 & 0xff) << 8) | ((unsigned)(q2 & 0xff) << 16) | ((unsigned)(q3 & 0xff) << 24); } }
            __builtin_amdgcn_sched_barrier(0);
            if (g < 3) S6_LOAD(g + 1);
            __builtin_amdgcn_sched_barrier(0);
            if (g & 1) {
                const int r16 = lane & 15, q = lane >> 4, rt = r16 & 7;
                f32x4 a0 = {0.f, 0.f, 0.f, 0.f}, a1 = a0, a2 = a0;
                LAS const unsigned char* ae = TILE + rt * 2048 + ((q ^ rt) << 4); LAS const unsigned char* ao = TILE + rt * 2048 + (((q ^ rt) ^ 4) << 4);
                const _Float16* bp = RWT + (size_t)r16 * DM + 8 * q;
#pragma unroll 2
                for (int k2 = 0; k2 < 16; ++k2) {
                    const f16x8 ah0 = *(LAS const f16x8*)(ae + 128 * k2), ah1 = *(LAS const f16x8*)(ao + 128 * k2);
                    const f16x8 b00 = *(const f16x8*)(bp + 64 * k2), b01 = *(const f16x8*)(bp + 64 * k2 + 16 * DM), b02 = *(const f16x8*)(bp + 64 * k2 + 32 * DM);
                    const f16x8 b10 = *(const f16x8*)(bp + 64 * k2 + 32), b11 = *(const f16x8*)(bp + 64 * k2 + 32 + 16 * DM), b12 = *(const f16x8*)(bp + 64 * k2 + 32 + 32 * DM);
                    a0 = __builtin_amdgcn_mfma_f32_16x16x32_f16(ah0, b00, a0, 0, 0, 0); a1 = __builtin_amdgcn_mfma_f32_16x16x32_f16(ah0, b01, a1, 0, 0, 0); a2 = __builtin_amdgcn_mfma_f32_16x16x32_f16(ah0, b02, a2, 0, 0, 0);
                    a0 = __builtin_amdgcn_mfma_f32_16x16x32_f16(ah1, b10, a0, 0, 0, 0); a1 = __builtin_amdgcn_mfma_f32_16x16x32_f16(ah1, b11, a1, 0, 0, 0); a2 = __builtin_amdgcn_mfma_f32_16x16x32_f16(ah1, b12, a2, 0, 0, 0); }
                if (q < 2) {
#pragma unroll
                    for (int i = 0; i < 4; ++i) { LG[(4 * q + i) * 48 + r16] = a0[i]; LG[(4 * q + i) * 48 + 16 + r16] = a1[i]; LG[(4 * q + i) * 48 + 32 + r16] = a2[i]; } }
                asm volatile("s_waitcnt lgkmcnt(0)" ::: "memory");
                if (lane < 8) {
                    const LAS float* lg = LG + lane * 48;
                    float gl[4]; int gi = 0; float gmx = -INFINITY;
#pragma unroll
                    for (int i = 0; i < 4; ++i) { gl[i] = lg[i] + bgp[i]; if (gl[i] > gmx) { gmx = gl[i]; gi = i; } }
                    float gs = 0.f;
#pragma unroll
                    for (int i = 0; i < 4; ++i) gs += __expf(gl[i] - gmx);
                    const float pg = 1.f / gs;
                    float el[8]; float emx = -INFINITY;
#pragma unroll
                    for (int i = 0; i < 8; ++i) { el[i] = lg[4 + gi * 8 + i] + bep[gi * 8 + i]; emx = fmaxf(emx, el[i]); }
                    int e0 = 0; float v0 = -INFINITY;
#pragma unroll
                    for (int i = 0; i < 8; ++i) if (el[i] > v0) { v0 = el[i]; e0 = i; }
                    int e1 = 0; float v1 = -INFINITY;
#pragma unroll
                    for (int i = 0; i < 8; ++i) if (i != e0 && el[i] > v1) { v1 = el[i]; e1 = i; }
                    const float p0 = __expf(v0 - emx), p1 = __expf(v1 - emx);
                    const float g0 = pg * p0 / (p0 + p1), g1 = pg * p1 / (p0 + p1);
                    const int rl = w * 16 + 8 * (g >> 1) + lane; const int E0 = gi * 8 + e0, E1 = gi * 8 + e1;
                    REC_E[rl * 2] = E0; REC_E[rl * 2 + 1] = E1; REC_G[rl * 2] = g0; REC_G[rl * 2 + 1] = g1;
                    REC_P[rl * 2] = atomicAdd((int*)&CNTL[E0], 1); REC_P[rl * 2 + 1] = atomicAdd((int*)&CNTL[E1], 1);
                }
                asm volatile("s_waitcnt lgkmcnt(0)" ::: "memory");
            }
        }
#undef S6_LOAD
#undef S6_Y
        __syncthreads();
        if (tid < 32) { const int c = CNTL[tid]; CNTL[32 + tid] = c ? (int)__hip_atomic_fetch_add(cntg + tid, (unsigned)c, __ATOMIC_RELAXED, __HIP_MEMORY_SCOPE_AGENT) : 0; }
        __syncthreads();
        if (tid < 256) { const int rl = tid >> 1, k = tid & 1; const int row = rb * 128 + rl; const int e = REC_E[tid]; const int p = CNTL[32 + e] + REC_P[tid];
            WSP(int, WS_TOKE)[row * 2 + k] = e; WSP(int, WS_TOKP)[row * 2 + k] = p; WSP(float, WS_TOKG)[row * 2 + k] = REC_G[tid];
            WSP(int, WS_LIST)[(size_t)e * 65536 + p] = row; WSP(float, WS_SAL)[(size_t)e * 65536 + p] = SAW[rl]; }
        __syncthreads();
    }
}

__device__ __forceinline__ void expert_convert(Frame& F) {
    {
        int tid = F.tid; asm volatile("" : "+v"(tid));
        LAS unsigned* AM = (LAS unsigned*)F.lds;
        const int n = tid & 31, kq = tid >> 5;
        for (int it = F.vcu; it < 1024; it += F.G) {
            const int e = it >> 5, sel = (it >> 4) & 1, j0 = (it & 15) * 32;
            const float* W = IN_F(sel ? 25 : 24) + (size_t)e * 1024 * 512 + (size_t)(64 * kq) * 512 + j0 + n;
            if (tid < 32) AM[tid] = 0u;
            __syncthreads();
            float v[64]; float am = 0.f;
#pragma unroll
            for (int i = 0; i < 64; ++i) { v[i] = W[(size_t)i * 512]; am = fmaxf(am, fabsf(v[i])); }
            atomicMax((unsigned*)&AM[n], __float_as_uint(am));
            __syncthreads();
            const float amax = __uint_as_float(AM[n]); const float inv = amax > 0.f ? 127.f / amax : 0.f;
            const int j = j0 + n, prow = 8 * (j >> 2) + 4 * sel + (j & 3);
            unsigned char* dst = (unsigned char*)(F.ws + WS_W13T) + ((size_t)e * 1024 + prow) * 1024 + 64 * kq;
#pragma unroll
            for (int c = 0; c < 4; ++c) { u32x4 o;
#pragma unroll
                for (int d = 0; d < 4; ++d) { const int b0 = 16 * c + 4 * d;
                    const int q0 = (int)rintf(v[b0] * inv), q1 = (int)rintf(v[b0 + 1] * inv), q2 = (int)rintf(v[b0 + 2] * inv), q3 = (int)rintf(v[b0 + 3] * inv);
                    o[d] = (unsigned)(q0 & 0xff) | ((unsigned)(q1 & 0xff) << 8) | ((unsigned)(q2 & 0xff) << 16) | ((unsigned)(q3 & 0xff) << 24); }
                *(u32x4*)(dst + 16 * c) = o; }
            if (kq == 0) WSP(float, WS_SB13)[e * 1024 + prow] = amax * (1.f / 127.f);
            __syncthreads();
        }
    }
}
__device__ __forceinline__ void w2_convert(Frame& F, int rk, int nsh) {
    LAS float* scr = (LAS float*)(F.lds + F.wave * 8448);
    const int gw = rk * NWAVES + F.wave, NGW = nsh * NWAVES;
    for (int it = gw; it < 32 * 256; it += NGW) {
        const int e = it >> 8, r = it & 255;
        transpose_item(IN_F(26) + (size_t)e * 512 * 1024, 1024, WSP(bf16_t, WS_W2T) + (size_t)e * 1024 * 512, 512, scr, (r / 32) * 64, (r % 32) * 32, F.lane, RmId{0});
    }
    __syncthreads();
}

__device__ __forceinline__ void moe_tables(Frame& F, LAS int* tstart, LAS int* cnt) {
    if (F.tid == 0) { const unsigned* cg = (const unsigned*)(F.ws + WS_CTL) + CW_CNT; int acc = 0;
        for (int e = 0; e < 32; ++e) { const int c = (int)__hip_atomic_load(cg + e, __ATOMIC_RELAXED, __HIP_MEMORY_SCOPE_AGENT); cnt[e] = c; tstart[e] = acc; acc += (c + 255) >> 8; }
        tstart[32] = acc; }
    __syncthreads();
}

__device__ __forceinline__ void s10_phase(Frame& F, LAS int* tstart) {
    const int gw = F.vcu * NWAVES + F.wave, NGW = F.G * NWAVES, lane = F.lane;
    const float* wpost = IN_F(8); const float* mod = WSP(float, WS_MOD); const bf16_t* YB = WSP(bf16_t, WS_YB); const bf16_t* X1B = WSP(bf16_t, WS_X1B);
    int ne0[4], ne1[4], np0[4], np1[4]; float ng0[4], ng1[4];
#define S10_TAB(rw) do { _Pragma("unroll") for (int r = 0; r < 4; ++r) { const int row_ = (rw) + r; \
        ne0[r] = WSP(int, WS_TOKE)[row_ * 2]; ne1[r] = WSP(int, WS_TOKE)[row_ * 2 + 1]; np0[r] = WSP(int, WS_TOKP)[row_ * 2]; np1[r] = WSP(int, WS_TOKP)[row_ * 2 + 1]; \
        ng0[r] = WSP(float, WS_TOKG)[row_ * 2]; ng1[r] = WSP(float, WS_TOKG)[row_ * 2 + 1]; } } while (0)
    if (gw * 4 < NTOK) S10_TAB(gw * 4);
    for (int row0 = gw * 4; row0 < NTOK; row0 += NGW * 4) {
        const int b = row0 >> 12;
        size_t r0[4], r1[4]; float g0[4], g1[4];
#pragma unroll
        for (int r = 0; r < 4; ++r) { r0[r] = (size_t)tstart[ne0[r]] * 256 + np0[r]; r1[r] = (size_t)tstart[ne1[r]] * 256 + np1[r]; g0[r] = ng0[r]; g1[r] = ng1[r]; }
        if (row0 + NGW * 4 < NTOK) S10_TAB(row0 + NGW * 4);
        f32x4 yv[4][4]; float ss[4];
#pragma unroll
        for (int r = 0; r < 4; ++r) { float a2 = 0.f;
#pragma unroll
            for (int j = 0; j < 4; ++j) { const int k = 4 * lane + 256 * j;
                const u32x2 a = __builtin_nontemporal_load((const u32x2*)(YB + r0[r] * DM + k)), c = __builtin_nontemporal_load((const u32x2*)(YB + r1[r] * DM + k));
                yv[r][j] = (f32x4){bflo(a.x), bfhi(a.x), bflo(a.y), bfhi(a.y)} * g0[r] + (f32x4){bflo(c.x), bfhi(c.x), bflo(c.y), bfhi(c.y)} * g1[r];
                a2 += yv[r][j][0] * yv[r][j][0] + yv[r][j][1] * yv[r][j][1] + yv[r][j][2] * yv[r][j][2] + yv[r][j][3] * yv[r][j][3]; }
            ss[r] = a2; }
#pragma unroll
        for (int o = 1; o < 64; o <<= 1) {
#pragma unroll
            for (int r = 0; r < 4; ++r) ss[r] += __shfl_xor(ss[r], o); }
#pragma unroll
        for (int j = 0; j < 4; ++j) { const int k = 4 * lane + 256 * j;
            const f32x4 wp = *(const f32x4*)(wpost + k), gf = *(const f32x4*)(mod + b * 6144 + 5120 + k); const f32x4 gw2 = gf * wp;
#pragma unroll
            for (int r = 0; r < 4; ++r) { const float rr = rsqrtf(ss[r] * (1.f / DM) + RMS_EPS);
                const u32x2 xb = __builtin_nontemporal_load((const u32x2*)(X1B + (size_t)(row0 + r) * DM + k)); const f32x4 x1 = (f32x4){bflo(xb.x), bfhi(xb.x), bflo(xb.y), bfhi(xb.y)};
                __builtin_nontemporal_store(x1 + gw2 * (yv[r][j] * rr), (f32x4*)(F.out + (size_t)(row0 + r) * DM + k)); } }
    }
}

#undef S10_TAB
#ifndef DBG_STOP
#define DBG_STOP -1
#endif
#if DBG_STOP >= 0
struct DbgBuf { size_t off, n; int f32, ph; };
__device__ __forceinline__ void dbg_phase(Frame& F, const XcdBarrier& bar) {
    const DbgBuf bufs[] = {
        {WS_MOD, 8 * 6144, 1, 0}, {WS_COS, (size_t)NTOK * 32, 1, 0}, {WS_SIN, (size_t)NTOK * 32, 1, 0}, {WS_WINT, (size_t)INWP * 1024, 0, 0}, {WS_WOUTT, 1024 * 1024, 0, 0},
        {WS_CW1K, 128 * 2048, 0, 0}, {WS_CW2K, 64 * 128, 0, 0}, {WS_RWT, 48 * 1024, 0, 0}, {WS_C1B, 256, 1, 0},
        {WS_H1, (size_t)NTOK * 1024, 0, 1},
        {WS_MQ, (size_t)NTOK * 2048, 0, 2}, {WS_NQ, (size_t)NTOK * 512, 0, 2}, {WS_KC, (size_t)NTOK * 128 * 6, 0, 2}, {WS_GI, 2 * 8 * 4 * 4096, 1, 2}, {WS_NGT, (size_t)NTOK * 24, 1, 2},
        {WS_KVC, (size_t)2048 * 16384, 0, 3}, {WS_NC, 2048 * 128, 1, 3}, {WS_GSUM, 4096, 1, 3}, {WS_KCMP, 2 * 16 * 256 * 64, 0, 3},
        {WS_CPREV, (size_t)2048 * 16384, 0, 4}, {WS_NPREV, 2048 * 128, 1, 4}, {WS_MPREV, 2048, 1, 4},
        {WS_YCAT, (size_t)NTOK * 1024, 0, 5}, {WS_W13T, (size_t)32 * 1024 * 1024, 0, 5}, {WS_W2T, (size_t)32 * 1024 * 512, 0, 5},
        {WS_Y, (size_t)NTOK * 1024, 0, 6}, {WS_H2, (size_t)NTOK * 1024, 0, 7}, {WS_TOKG, (size_t)NTOK * 2, 1, 7},
        {WS_HB, (size_t)65536 * 512, 0, 8}, {WS_YB, (size_t)65536 * 1024, 0, 9} };
    constexpr int NBUF = sizeof(bufs) / sizeof(bufs[0]);
    unsigned* flag = (unsigned*)(F.ws + WS_CTL) + CW_DBG;
    const size_t gt = (size_t)blockIdx.x * NTHR + F.tid, NG = (size_t)F.G * NTHR;
    for (int i = 0; i < NBUF; ++i) {
        if (bufs[i].ph > DBG_STOP) continue;
        if ((bufs[i].off == WS_H1 && DBG_STOP >= 3) || (bufs[i].off == WS_WINT && DBG_STOP >= 4) || (bufs[i].off == WS_KVC && DBG_STOP >= 5) || (bufs[i].off == WS_NQ && DBG_STOP >= 5) || (bufs[i].off == WS_KC && DBG_STOP >= 9) ||
            (bufs[i].off == WS_MQ && DBG_STOP >= 6) || (bufs[i].off == WS_CPREV && DBG_STOP >= 8) || (bufs[i].off == WS_Y && DBG_STOP >= 9) || (bufs[i].off == WS_H2 && DBG_STOP >= 9) || (bufs[i].off == WS_W13T && DBG_STOP < 5)) continue;
        bool bad = false;
        if (bufs[i].f32) { const unsigned* p = (const unsigned*)(F.ws + bufs[i].off); for (size_t k = gt; k < bufs[i].n; k += NG) bad |= ((p[k] & 0x7f800000u) == 0x7f800000u); }
        else { const unsigned* p = (const unsigned*)(F.ws + bufs[i].off); for (size_t k = gt; k < bufs[i].n / 2; k += NG) { const unsigned v = p[k]; bad |= ((v & 0x7f80u) == 0x7f80u) || ((v & 0x7f800000u) == 0x7f800000u); } }
        if (bufs[i].off == WS_YCAT) { bool bm = false, bn = false; const unsigned* p = (const unsigned*)(F.ws + WS_YCAT);
            for (size_t k = gt; k < bufs[i].n / 2; k += NG) { const unsigned v = p[k]; const bool b2 = ((v & 0x7f80u) == 0x7f80u) || ((v & 0x7f800000u) == 0x7f800000u); if ((k & 511) < 256) bm |= b2; else bn |= b2; }
            if (__any(bm) && F.lane == 0) atomicMin(flag, 23u); if (__any(bn) && F.lane == 0) atomicMin(flag, 33u); continue; }
        if (__any(bad) && F.lane == 0) atomicMin(flag, (unsigned)(i + 1));
    }
    if (DBG_STOP >= 7) { bool bad = false; const unsigned* p = (const unsigned*)F.out; for (size_t k = gt; k < (size_t)NTOK * DM; k += NG) bad |= ((p[k] & 0x7f800000u) == 0x7f800000u); if (__any(bad) && F.lane == 0) atomicMin(flag, 40u); }
    xcd_barrier(bar);
    const unsigned id = __hip_atomic_load(flag, __ATOMIC_RELAXED, __HIP_MEMORY_SCOPE_AGENT);
    const float sc = (id >= 1000u) ? 1.f : 1.f + (float)id;
    const float* x = IN_F(0);
    for (size_t k = gt; k < (size_t)NTOK * DM; k += NG) F.out[k] = x[k] * sc;
}
#endif


#if DBG_STOP >= 0
__device__ __forceinline__ unsigned dbg_hash(unsigned x) { x ^= x >> 16; x *= 0x7feb352du; x ^= x >> 15; x *= 0x846ca68bu; x ^= x >> 16; return x; }
__device__ __forceinline__ float dbg_bfr(float f) { return bf2f(f2bf(f)); }
__device__ float dbg_z(Frame& F, int row, int c) { const signed char* h = (const signed char*)(F.ws + WS_H1) + (size_t)row * 1024; const float* w = IN_F(9); float am = 0.f;
    for (int k = 0; k < 1024; ++k) am = fmaxf(am, fabsf(w[(size_t)k * INW + c]));
    const float inv = am > 0.f ? 127.f / am : 0.f; float s = 0.f; for (int k = 0; k < 1024; ++k) s += (float)h[k] * rintf(w[(size_t)k * INW + c] * inv);
    return s * WSP(float, WS_SA1)[row] * (am * (1.f / 127.f)); }
__device__ __forceinline__ bool dbg_close(float a, float b) { return fabsf(a - b) <= 0.02f * fabsf(b) + 0.02f; }
__device__ void dbg_check_p1(Frame& F, unsigned* cnt) {
    const int gt = blockIdx.x * NTHR + F.tid; if (gt >= 8192) return;
    const int row = dbg_hash(gt * 2 + 1) % NTOK; int c = dbg_hash(gt * 2 + 2) % INW; if (gt < 64) c = 2048 + (gt & 7); if (gt >= 64 && gt < 256) c = 3336 + (gt % 24);
    const int b = row >> 12, sq = row & 4095; const float* COS = WSP(float, WS_COS); const float* SIN = WSP(float, WS_SIN);
    float ref, got;
    if (c < 2048) { ref = dbg_z(F, row, c); got = bf2f(WSP(bf16_t, c < 512 ? WS_MQ : c < 1024 ? WS_MK : c < 1536 ? WS_MV : WS_MO)[(size_t)row * 512 + (c & 511)]); }
    else if (c < 2052) { ref = dbg_z(F, row, c) + IN_F(11)[c - 2048]; got = WSP(float, WS_GI)[(size_t)(b * 4 + c - 2048) * SEQ + sq]; }
    else if (c < 2056) { ref = logsigmoid_f(dbg_z(F, row, c) + IN_F(11)[4 + c - 2052]); got = WSP(float, WS_GF)[(size_t)(b * 4 + c - 2052) * SEQ + sq]; }
    else if (c >= 3336) { ref = sigmoid_f(dbg_z(F, row, c)); got = WSP(float, WS_NGT)[(size_t)row * 24 + c - 3336]; }
    else {
        int base, x; size_t ws_off; bool rope, isq = false;
        if (c < 2568) { base = 2056; x = c - base; rope = true; isq = true; ws_off = WS_NQ; }
        else if (c < 2696) { base = 2568; x = c - base; rope = true; ws_off = WS_KC; }
        else if (c < 2824) { base = 2696; x = c - base; rope = false; ws_off = WS_VC; }
        else if (c < 2952) { base = 2824; x = c - base; rope = true; ws_off = WS_KSL; }
        else if (c < 3080) { base = 2952; x = c - base; rope = false; ws_off = WS_VSL; }
        else if (c < 3208) { base = 3080; x = c - base; rope = true; ws_off = WS_KWN; }
        else { base = 3208; x = c - base; rope = false; ws_off = WS_VWN; }
        const int hd = x >> 6, d = x & 63;
        if (rope) { const float z0 = dbg_z(F, row, c), z1 = dbg_z(F, row, base + hd * 64 + (d ^ 32)); const float cs = COS[(size_t)row * 32 + (d & 31)], sn = SIN[(size_t)row * 32 + (d & 31)];
            ref = d < 32 ? z0 * cs - z1 * sn : z0 * cs + z1 * sn; if (isq) ref *= QSCALE; }
        else ref = dbg_z(F, row, c);
        got = isq ? bf2f(WSP(bf16_t, ws_off)[(size_t)row * 512 + hd * 64 + d]) : bf2f(WSP(bf16_t, ws_off)[((size_t)(b * 2 + hd) * SEQ + sq) * 64 + d]);
    }
    if (!dbg_close(got, ref)) atomicAdd(cnt, 1u);
}
#endif


#if DBG_STOP >= 0
__device__ void dbg_check_nsa(Frame& F, unsigned* cnt) {
    const int lane = F.lane, gw = blockIdx.x * NWAVES + F.wave;
    LAS float* P = (LAS float*)(F.lds + F.wave * 2048);
    const unsigned hsh = dbg_hash(gw * 7 + 3);
    const int b = hsh & 7, hh = (hsh >> 3) & 7, g = hh >> 2;
    int t; { const int cls = gw & 7; const unsigned r = dbg_hash(gw * 13 + 5);
        t = cls == 0 ? (int)(r % 31) : cls == 1 ? 31 + (int)(r % 33) : cls == 2 ? 64 + (int)(r % 960) : cls == 3 ? 1024 + (int)(r % 64) : cls == 4 ? 4032 + (int)(r % 64) : 1024 + (int)(r % 3072); }
    const size_t row = (size_t)b * SEQ + t; const int bg = b * 2 + g, cur = t >> 6;
    const bf16_t* Kc = WSP(bf16_t, WS_KCMP) + (size_t)bg * 256 * 64; const bf16_t* Vc = WSP(bf16_t, WS_VCMP) + (size_t)bg * 256 * 64;
    const int lim = t >= 31 ? (t - 31) >> 4 : -1;
    float imp = 0.f, oc = 0.f;
    for (int hd = 0; hd < 4; ++hd) {
        const bf16_t* q = WSP(bf16_t, WS_NQ) + row * 512 + (4 * g + hd) * 64;
        float sc[4]; float mx = -INFINITY;
        for (int k = 0; k < 4; ++k) { const int i = lane + 64 * k; float s = 0.f; for (int d = 0; d < 64; ++d) s += bf2f(q[d]) * bf2f(Kc[(size_t)i * 64 + d]); sc[k] = (i <= lim) ? s : -INFINITY; mx = fmaxf(mx, sc[k]); }
        mx = wave_max(mx); const float mref = (mx == -INFINITY) ? 0.f : mx; float l = 0.f;
        for (int k = 0; k < 4; ++k) { sc[k] = ex2(sc[k] - mref); l += sc[k]; }
        l = wave_sum(l); const float il = 1.f / fmaxf(l, 1e-30f);
        for (int k = 0; k < 4; ++k) P[lane + 64 * k] = sc[k] * il;
        asm volatile("s_waitcnt lgkmcnt(0)" ::: "memory");
        { const int j = lane; float a = 0.f; for (int x = 0; x < 3; ++x) a += 2.f * P[4 * j + x]; a += P[4 * j + 3]; if (j > 0) a += P[4 * j - 1]; imp += a; }
        if (4 * g + hd == hh) { for (int i = 0; i < 255; ++i) oc += P[i] * bf2f(Vc[(size_t)i * 64 + lane]); }
        asm volatile("s_waitcnt lgkmcnt(0)" ::: "memory");
    }
    float score = imp; { const int j = lane; if (j == 0 || j == cur || j == cur - 1) score = INFINITY; else if (64 * j > t) score = -INFINITY; }
    int rank = 0; for (int j2 = 0; j2 < 64; ++j2) { const float s2 = __shfl(score, j2); rank += (s2 > score || (s2 == score && j2 < lane)) ? 1 : 0; }
    const unsigned long long selm = __ballot(rank < 16);
    const bf16_t* q = WSP(bf16_t, WS_NQ) + row * 512 + hh * 64;
    float os = 0.f, ow = 0.f;
    for (int br = 0; br < 2; ++br) {
        const bf16_t* K = WSP(bf16_t, br ? WS_KWN : WS_KSL) + (size_t)bg * SEQ * 64; const bf16_t* V = WSP(bf16_t, br ? WS_VWN : WS_VSL) + (size_t)bg * SEQ * 64;
        float m = -INFINITY, l = 0.f, o = 0.f;
        for (int j = 0; j < 64; ++j) {
            if (br == 0 && !((selm >> j) & 1ull)) continue;
            const int kp = 64 * j + lane; bool valid = kp <= t; if (br == 1) valid = valid && kp > t - 512;
            if (!__any(valid)) continue;
            float s = 0.f; for (int d = 0; d < 64; ++d) s += bf2f(q[d]) * bf2f(K[(size_t)kp * 64 + d]);
            s = valid ? s : -INFINITY;
            const float mn = fmaxf(m, wave_max(s)); const float alpha = (m == -INFINITY) ? 0.f : ex2(m - mn); const float pp = ex2(s - mn);
            l = l * alpha + wave_sum(pp); o *= alpha;
            for (int x = 0; x < 64; ++x) o += __shfl(pp, x) * bf2f(V[(size_t)(64 * j + x) * 64 + lane]);
            m = mn;
        }
        const float r = o / fmaxf(l, 1e-30f); if (br) ow = r; else os = r;
    }
    const float* gp = WSP(float, WS_NGT) + row * 24 + hh * 3;
    const float ref = gp[0] * oc + gp[1] * os + gp[2] * ow;
    const float got = bf2f(WSP(bf16_t, WS_YCAT)[row * 1024 + 512 + hh * 64 + lane]);
    const float sq = wave_sum(ref * ref); const float tol = 0.03f * fabsf(ref) + 0.03f * sqrtf(sq * (1.f / 64.f)) + 1e-4f;
    const bool bad = !(fabsf(got - ref) <= tol);
    if (__any(bad) && lane == 0) atomicAdd(cnt, 1u);
}
#endif


#if DBG_STOP >= 0
__device__ void dbg_check_mlstm(Frame& F, unsigned* cnt) {
    const int lane = F.lane, gw = blockIdx.x * NWAVES + F.wave;
    const unsigned hsh = dbg_hash(gw * 11 + 1);
    const int b = hsh & 7, h = (hsh >> 3) & 3;
    int t; { const int cls = gw & 7; const unsigned r = dbg_hash(gw * 17 + 9);
        t = cls == 0 ? (int)(r % 4) : cls == 1 ? 60 + (int)(r % 8) : cls == 2 ? 64 * (1 + (int)(r % 60)) + (int)((r >> 8) % 3) : cls == 3 ? 64 * (1 + (int)(r % 60)) + 63 : cls == 4 ? 4000 + (int)(r % 96) : (int)(r % 4096); }
    const int bh = b * 4 + h; const float* GI = WSP(float, WS_GI) + (size_t)bh * SEQ; const float* GF = WSP(float, WS_GF) + (size_t)bh * SEQ;
    const bf16_t* MQ = WSP(bf16_t, WS_MQ); const bf16_t* MK = WSP(bf16_t, WS_MK); const bf16_t* MV = WSP(bf16_t, WS_MV); const float* cw = IN_F(10);
    float carry = 0.f, M = 0.f, Bt = 0.f;
    for (int s0 = 0; s0 <= t; s0 += 64) { const int s = s0 + lane; float lf = (s <= t) ? GF[s] : 0.f;
        float bs = lf;
        for (int o = 1; o < 64; o <<= 1) { const float x = __shfl_up(bs, o); if (lane >= o) bs += x; }
        bs += carry; const float u = (s <= t) ? GI[s] - bs : -INFINITY; M = fmaxf(M, wave_max(u));
        if (s0 + 63 >= t) Bt = __shfl(bs, t - s0);
        carry = __shfl(bs, 63); }
    float q0 = 0.f, q1 = 0.f;
    for (int j = 0; j < 4; ++j) { const int ss = t - 3 + j; if (ss >= 0) { const bf16_t* rp = MQ + ((size_t)b * SEQ + ss) * 512 + h * 128;
        q0 += bf2f(rp[lane]) * cw[j * 1024 + h * 128 + lane]; q1 += bf2f(rp[64 + lane]) * cw[j * 1024 + h * 128 + 64 + lane]; } }
    q0 = dbg_bfr(silu_f(q0)); q1 = dbg_bfr(silu_f(q1));
    LAS float* QS = (LAS float*)(F.lds + F.wave * 2048); QS[lane] = q0; QS[64 + lane] = q1;
    asm volatile("s_waitcnt lgkmcnt(0)" ::: "memory");
    float n0 = 0.f, n1 = 0.f, den = 0.f; carry = 0.f;
    for (int s0 = 0; s0 <= t; s0 += 64) { const int s = s0 + lane; const bool act = s <= t; float lf = act ? GF[s] : 0.f;
        float bs = lf;
        for (int o = 1; o < 64; o <<= 1) { const float x = __shfl_up(bs, o); if (lane >= o) bs += x; }
        bs += carry; carry = __shfl(bs, 63);
        float c = 0.f;
        if (act) { float qk = 0.f;
            for (int ch = 0; ch < 128; ++ch) { float kc = 0.f;
                for (int j = 0; j < 4; ++j) { const int ss = s - 3 + j; if (ss >= 0) kc += bf2f(MK[((size_t)b * SEQ + ss) * 512 + h * 128 + ch]) * cw[j * 1024 + 512 + h * 128 + ch]; }
                qk += QS[ch] * dbg_bfr(silu_f(kc) * 0.08838834764831845f); }
            c = __expf(GI[s] - bs - M) * qk; }
        den += c;
        for (int x = 0; x < 64; ++x) { const float cx = __shfl(c, x); if (s0 + x <= t) { const bf16_t* vp = MV + ((size_t)b * SEQ + s0 + x) * 512 + h * 128; n0 += cx * bf2f(vp[lane]); n1 += cx * bf2f(vp[64 + lane]); } } }
    den = wave_sum(den);
    const float hd = fmaxf(fabsf(den), __expf(-(Bt + M)));
    const float h0 = n0 / hd, h1 = n1 / hd;
    const float rn = rsqrtf(wave_sum(h0 * h0 + h1 * h1) * (1.f / 128.f) + RMS_EPS);
    const size_t row = (size_t)b * SEQ + t; const bf16_t* mo = WSP(bf16_t, WS_MO) + row * 512 + h * 128; const float* hn = IN_F(12) + h * 128;
    const float r0 = h0 * rn * hn[lane] * sigmoid_f(bf2f(mo[lane])), r1 = h1 * rn * hn[64 + lane] * sigmoid_f(bf2f(mo[64 + lane]));
    const float g0 = bf2f(WSP(bf16_t, WS_YCAT)[row * 1024 + h * 128 + lane]), g1 = bf2f(WSP(bf16_t, WS_YCAT)[row * 1024 + h * 128 + 64 + lane]);
    const float rms = sqrtf(wave_sum(r0 * r0 + r1 * r1) * (1.f / 128.f));
    const bool bad = !(fabsf(g0 - r0) <= 0.04f * fabsf(r0) + 0.04f * rms + 1e-4f) || !(fabsf(g1 - r1) <= 0.04f * fabsf(r1) + 0.04f * rms + 1e-4f);
    if (__any(bad) && lane == 0) atomicAdd(cnt, 1u);
}
#endif


#if DBG_STOP >= 0
__device__ void dbg_check_cmp(Frame& F, unsigned* cnt) {
    const int lane = F.lane, gw = blockIdx.x * NWAVES + F.wave;
    const unsigned hsh = dbg_hash(gw * 5 + 2);
    const int kv = hsh & 1, bg = (hsh >> 1) & 15; int i = (hsh >> 5) % 255; if ((gw & 15) == 0) i = 254; if ((gw & 15) == 1) i = 0;
    const bf16_t* X = WSP(bf16_t, kv ? WS_VC : WS_KC) + (size_t)bg * SEQ * 64 + (size_t)i * 1024;
    const float* pe = IN_F(kv ? 16 : 13); const float* w1 = IN_F(kv ? 17 : 14); const float* w2 = IN_F(kv ? 18 : 15);
    float h0 = 0.f, h1 = 0.f;
    for (int k = 0; k < 2048; ++k) { const float xv = bf2f(X[k]) + pe[k]; h0 += xv * w1[(size_t)k * 128 + lane]; h1 += xv * w1[(size_t)k * 128 + 64 + lane]; }
    LAS float* H = (LAS float*)(F.lds + F.wave * 2048); H[lane] = silu_f(h0); H[64 + lane] = silu_f(h1);
    asm volatile("s_waitcnt lgkmcnt(0)" ::: "memory");
    float o = 0.f; for (int n = 0; n < 128; ++n) o += H[n] * w2[n * 64 + lane];
    const float got = bf2f(WSP(bf16_t, kv ? WS_VCMP : WS_KCMP)[((size_t)bg * 256 + i) * 64 + lane]);
    const float rms = sqrtf(wave_sum(o * o) * (1.f / 64.f));
    const bool bad = !(fabsf(got - o) <= 0.03f * fabsf(o) + 0.03f * rms + 1e-4f);
    if (__any(bad) && lane == 0) atomicAdd(cnt, 1u);
}
#endif

__device__ __forceinline__ bool phase_tid(Frame& F) { asm volatile("" : "+v"(F.tid)); F.lane = F.tid & 63; return true; }
constexpr int NPHASE = 11;
__global__ void __launch_bounds__(NTHR, 2) mega_fwd(Args args) {
    extern __shared__ __attribute__((aligned(16))) unsigned char lds_raw[];
    Frame F;
    F.lds = (LAS unsigned char*)lds_raw; F.in = args.in; F.out = args.out; F.ws = args.ws;
    F.tid = threadIdx.x; F.lane = F.tid & 63; F.wave = __builtin_amdgcn_readfirstlane(F.tid >> 6);
    F.G = gridDim.x; { const int bx = blockIdx.x; F.vcu = (F.G % 8 == 0) ? (bx % 8) * (F.G / 8) + bx / 8 : bx; }
    volatile LAS unsigned* MISC = (volatile LAS unsigned*)(F.lds + MISC_OFF);
    for (int u = F.tid; u < (LDS_BYTES - MISC_OFF) / 4; u += NTHR) ((LAS unsigned*)(F.lds + MISC_OFF))[u] = 0u;
    __syncthreads();
    unsigned* ctl = (unsigned*)(F.ws + WS_CTL);
    XcdBarrier bar; bar.bar = ctl + CW_BAR; bar.x = 0; bar.st = nullptr;
    const int lo = args.ph_lo, hi = args.ph_hi;
    if (hi - lo > 1) bar = xcd_barrier_post(ctl + CW_BAR, MISC + 8);
#ifndef PHASE_MASK
#define PHASE_MASK 0xFFFF
#endif
#define IN(k) (((PHASE_MASK >> (k)) & 1) && lo <= (k) && (k) < hi && (DBG_STOP < 0 || (k) <= DBG_STOP))
#define SEAM(k) do { if (IN(k) && IN((k) + 1)) xcd_barrier(bar); } while (0)
    LAS int* TST = (LAS int*)(F.lds + MISC_OFF + 256);
    LAS int* CNT = TST + 40;

#define PHASE_TID() if (phase_tid(F))
    if (IN(0)) PHASE_TID() _Pragma("nounroll") for (int rep = 0; rep <= ((REP_MASK >> 0) & 1); ++rep) { p0_phase(F); } SEAM(0);
    if (IN(1)) PHASE_TID() _Pragma("nounroll") for (int rep = 0; rep <= ((REP_MASK >> 1) & 1); ++rep) { p1a_phase(F); } SEAM(1);
    if (IN(2)) PHASE_TID() _Pragma("nounroll") for (int rep = 0; rep <= ((REP_MASK >> 2) & 1); ++rep) {
        pg8::DenseOrder S; S.init(NTOK, INWP, DM / 2, F.G, (int)blockIdx.x);
        EpiIn E{F.ws, IN_F(11), F.lds};
        pg8::gemm_phase<true>(F.lds, WSP(bf16_t, WS_H1), WSP(bf16_t, WS_WINT), DM / 2, S, E);
    } SEAM(2);
    if (IN(3)) PHASE_TID() _Pragma("nounroll") for (int rep = 0; rep <= ((REP_MASK >> 3) & 1); ++rep) {
        REPS(0) mlstm_a_phase(F);
        REPS(1) for (int j = F.vcu; j < 256; j += F.G) compress_job(F, j);
    } SEAM(3);
    if (IN(4)) PHASE_TID() _Pragma("nounroll") for (int rep = 0; rep <= ((REP_MASK >> 4) & 1); ++rep) {
        REPS(2) for (int j = F.vcu; j < 256; j += F.G) mlstm_scan_job(F, j);
        REPS(3) for (int u = F.vcu; u < 512; u += F.G) {
            const int bg = u >> 5, q = u & 31;
            _Pragma("nounroll") for (int hf = 0; hf < 2; ++hf) nsa_unit(F, bg >> 1, bg & 1, hf ? q : 63 - q);
        }
    } SEAM(4);
    if (IN(5)) PHASE_TID() _Pragma("nounroll") for (int rep = 0; rep <= ((REP_MASK >> 5) & 1); ++rep) {
        REPS(4) mlstm_c_phase(F);
        REPS(5) expert_convert(F);
    } SEAM(5);
    if (IN(6)) PHASE_TID() _Pragma("nounroll") for (int rep = 0; rep <= ((REP_MASK >> 6) & 1); ++rep) {
        pg8::DenseOrder S; S.init(NTOK, DM, DM, F.G, (int)blockIdx.x);
        EpiBf16 E{WSP(bf16_t, WS_Y), DM};
        pg8::gemm_phase<false>(F.lds, WSP(bf16_t, WS_YCAT), WSP(bf16_t, WS_WOUTT), DM, S, E);
    } SEAM(6);
    if (IN(7)) PHASE_TID() { s6_phase(F); } SEAM(7);
    if (IN(8)) PHASE_TID() _Pragma("nounroll") for (int rep = 0; rep <= ((REP_MASK >> 8) & 1); ++rep) {
        moe_tables(F, TST, CNT);
        pg8::MoeOrder S{TST, CNT, WSP(int, WS_LIST), F.G, F.vcu, DM / 2, 4, true};
        EpiUpI8 E{WSP(bf16_t, WS_HB), WSP(float, WS_SAL), WSP(float, WS_SB13), TST, F.lds};
        pg8::gemm_phase<true>(F.lds, WSP(bf16_t, WS_H2Q), WSP(bf16_t, WS_W13T), DM / 2, S, E);
        {
            const int U = TST[32] * 4, full = U / F.G, rem = U % F.G;
            if (rem == 0) w2_convert(F, F.vcu, F.G); else if (F.vcu >= rem) w2_convert(F, F.vcu - rem, F.G - rem);
            (void)full; }
    } SEAM(8);
    if (IN(9)) PHASE_TID() _Pragma("nounroll") for (int rep = 0; rep <= ((REP_MASK >> 9) & 1); ++rep) {
        moe_tables(F, TST, CNT);
        pg8::MoeOrder S{TST, CNT, WSP(int, WS_LIST), F.G, F.vcu, EFF, 4, false};
        EpiBf16 E{WSP(bf16_t, WS_YB), DM};
        pg8::gemm_phase<false>(F.lds, WSP(bf16_t, WS_HB), WSP(bf16_t, WS_W2T), EFF, S, E);
    } SEAM(9);
    if (IN(10)) PHASE_TID() { moe_tables(F, TST, CNT); s10_phase(F, TST); }
#if DBG_STOP >= 0
    xcd_barrier(bar);
#if DBG_CHECK == 1 || DBG_CHECK == 3 || DBG_CHECK == 4 || DBG_CHECK == 5
    { unsigned* cw = (unsigned*)(F.ws + WS_CTL) + CW_DBG + 1; if (DBG_CHECK == 1) dbg_check_p1(F, cw); else if (DBG_CHECK == 3) dbg_check_nsa(F, cw); else if (DBG_CHECK == 4) dbg_check_mlstm(F, cw); else dbg_check_cmp(F, cw); xcd_barrier(bar);
      const unsigned nb = __hip_atomic_load(cw, __ATOMIC_RELAXED, __HIP_MEMORY_SCOPE_AGENT);
      const float sc = nb == 0 ? 1.f : nb < 4 ? 2.f : nb < 16 ? 3.f : nb < 64 ? 4.f : nb < 256 ? 5.f : nb < 1024 ? 6.f : 7.f;
      const float* x = IN_F(0); for (size_t k = (size_t)blockIdx.x * NTHR + F.tid; k < (size_t)NTOK * DM; k += (size_t)F.G * NTHR) F.out[k] = x[k] * sc; }
#elif DBG_CHECK == 2
    { const unsigned id = __hip_atomic_load((unsigned*)(F.ws + WS_CTL) + CW_DBG, __ATOMIC_RELAXED, __HIP_MEMORY_SCOPE_AGENT);
      float sc = (id >= 1000u) ? 1.f : 1.f + (float)id;
      if (__hip_atomic_load((unsigned*)(F.ws + WS_CTL) + CW_BAR + XB_TMO, __ATOMIC_RELAXED, __HIP_MEMORY_SCOPE_AGENT) != 0u) sc = 61.f;
      const float* x = IN_F(0); for (size_t k = (size_t)blockIdx.x * NTHR + F.tid; k < (size_t)NTOK * DM; k += (size_t)F.G * NTHR) F.out[k] = x[k] * sc; }
#else
    dbg_phase(F, bar);
#endif
#endif
#undef IN
#undef SEAM
}

extern "C" void kernel_launch(void* const* d_in, const int* in_sizes, int n_in, void* d_out, int out_size, void* d_ws, size_t ws_size, hipStream_t stream) {
    static int grid = 0;
    if (grid == 0) {
        int dev = 0, cus = 0;
        if (hipGetDevice(&dev) != hipSuccess || hipDeviceGetAttribute(&cus, hipDeviceAttributeMultiprocessorCount, dev) != hipSuccess) cus = 256;
        if (hipFuncSetAttribute((const void*)mega_fwd, hipFuncAttributeMaxDynamicSharedMemorySize, LDS_BYTES) != hipSuccess) fprintf(stderr, "kernel_launch: hipFuncSetAttribute failed\n");
        (void)hipGetLastError();
        grid = cus > 0 ? cus : 256;
        if (n_in != 27 || ws_size < WS_END) fprintf(stderr, "kernel_launch: unexpected n_in %d / ws_size %zu (need %zu)\n", n_in, ws_size, (size_t)WS_END);
    }
    (void)hipMemsetAsync((char*)d_ws + WS_CTL, 0, 64 * 1024, stream);
#if DBG_STOP >= 0
    (void)hipMemsetAsync((char*)d_ws + WS_CTL + CW_DBG * 4, 0x7F, 4, stream);
#endif
    Args a{};
    for (int i = 0; i < 27; ++i) a.in[i] = d_in[i];
    a.out = (float*)d_out; a.ws = (unsigned char*)d_ws;
#if MK_N_LAUNCHES == 1
    a.ph_lo = 0; a.ph_hi = NPHASE;
    hipLaunchKernelGGL(mega_fwd, dim3(grid), dim3(NTHR), LDS_BYTES, stream, a);
#else
    for (int p = 0; p < NPHASE; ++p) { a.ph_lo = p; a.ph_hi = p + 1; hipLaunchKernelGGL(mega_fwd, dim3(grid), dim3(NTHR), LDS_BYTES, stream, a); }
#endif
}
```

```cpp
#include <hip/hip_runtime.h>
#include <cstdio>
#include <cstdint>
#include <type_traits>

#define LAS __attribute__((address_space(3)))
typedef unsigned short bf16_t;
typedef short bf16x8 __attribute__((ext_vector_type(8)));
typedef short s16x4 __attribute__((ext_vector_type(4)));
typedef float f32x4 __attribute__((ext_vector_type(4)));
typedef float f32x16 __attribute__((ext_vector_type(16)));
typedef unsigned u32x4 __attribute__((ext_vector_type(4)));
typedef unsigned u32x2 __attribute__((ext_vector_type(2)));
typedef int i32x4 __attribute__((ext_vector_type(4)));
typedef _Float16 f16x8 __attribute__((ext_vector_type(8)));
typedef _Float16 f16x4 __attribute__((ext_vector_type(4)));

#ifndef MK_N_LAUNCHES
#define MK_N_LAUNCHES 1
#endif
#ifndef DBG_CHECK
#define DBG_CHECK 0
#endif
#ifndef REP_MASK
#define REP_MASK 0
#endif
#ifndef REP_SUB
#define REP_SUB 0
#endif
#ifndef NSA_DUP
#define NSA_DUP 0
#endif
#define NDUP(b) _Pragma("nounroll") for (int nd_ = 0; nd_ <= ((NSA_DUP >> (b)) & 1); ++nd_)
#define REPS(b) _Pragma("nounroll") for (int rs_ = 0; rs_ <= ((REP_SUB >> (b)) & 1); ++rs_)

constexpr int NB = 8, SEQ = 4096, DM = 1024, NTOK = NB * SEQ;
constexpr int MH = 4, MDH = 128;
constexpr int NHD = 8, NGRP = 2;
constexpr int INW = 3360, INWP = 3584;
constexpr int NEXP = 32, EFF = 512;
constexpr float RMS_EPS = 1e-6f;
constexpr float QSCALE = 0.125f * 1.4426950408889634f;
constexpr int NWAVES = 8, NTHR = 512;
constexpr int LDS_BYTES = 160 * 1024, MISC_OFF = 128 * 1024;
constexpr int MAXROWS = 73728;

constexpr size_t MiB = 1ull << 20, KiB = 1024;
constexpr size_t WS_CTL   = 0;
constexpr size_t WS_MOD   = 64 * KiB;
constexpr size_t WS_C1B   = WS_MOD + 192 * KiB;
constexpr size_t WS_GI    = WS_C1B + 4 * KiB;
constexpr size_t WS_GF    = WS_GI + 512 * KiB;
constexpr size_t WS_NGT   = WS_GF + 512 * KiB;
constexpr size_t WS_GSUM  = WS_NGT + 3 * MiB;
constexpr size_t WS_MLOC  = WS_GSUM + 8 * KiB;
constexpr size_t WS_MPREV = WS_MLOC + 8 * KiB;
constexpr size_t WS_NC    = WS_MPREV + 8 * KiB;
constexpr size_t WS_NPREV = WS_NC + 1 * MiB;
constexpr size_t WS_COS   = WS_NPREV + 1 * MiB;
constexpr size_t WS_SIN   = WS_COS + 4 * MiB;
constexpr size_t WS_WOUTT = WS_SIN + 4 * MiB;
constexpr size_t WS_CW1K  = WS_WOUTT + 2 * MiB;
constexpr size_t WS_CW1V  = WS_CW1K + 512 * KiB;
constexpr size_t WS_CW2K  = WS_CW1V + 512 * KiB;
constexpr size_t WS_CW2V  = WS_CW2K + 16 * KiB;
constexpr size_t WS_RWT   = WS_CW2V + 16 * KiB;
constexpr size_t WS_RWL   = WS_RWT + 96 * KiB;
constexpr size_t WS_KCMP  = WS_RWL + 96 * KiB;
constexpr size_t WS_VCMP  = WS_KCMP + 512 * KiB;
constexpr size_t WS_TOKE  = WS_VCMP + 512 * KiB;
constexpr size_t WS_TOKP  = WS_TOKE + 256 * KiB;
constexpr size_t WS_TOKG  = WS_TOKP + 256 * KiB;
constexpr size_t WS_LIST  = WS_TOKG + 256 * KiB;
constexpr size_t WS_SA    = WS_LIST + 8 * MiB;
constexpr size_t WS_SB13  = WS_SA + 128 * KiB;
constexpr size_t WS_SA1   = WS_SB13 + 128 * KiB;
constexpr size_t WS_SBW   = WS_SA1 + 128 * KiB;
constexpr size_t WS_SMALL_END = WS_SBW + 16 * KiB;
static_assert(WS_SMALL_END <= 32 * MiB, "small region overflow");
constexpr size_t WS_A     = 32 * MiB;
constexpr size_t WS_H1    = WS_A, WS_KVC = WS_A, WS_W13T = WS_A;
constexpr size_t WS_NQ    = 96 * MiB;
constexpr size_t WS_KC    = 128 * MiB, WS_VC = 136 * MiB, WS_KSL = 144 * MiB, WS_VSL = 152 * MiB, WS_KWN = 160 * MiB, WS_VWN = 168 * MiB;
constexpr size_t WS_W2T   = 96 * MiB;
constexpr size_t WS_MQ    = 176 * MiB, WS_MK = 208 * MiB, WS_MV = 240 * MiB, WS_MO = 272 * MiB;
constexpr size_t WS_Y     = 176 * MiB;
constexpr size_t WS_H2    = 240 * MiB;
constexpr size_t WS_CPREV = 304 * MiB;
constexpr size_t WS_WINT  = 304 * MiB;
constexpr size_t WS_HB    = 304 * MiB;
constexpr size_t WS_H2LO  = 304 * MiB;
constexpr size_t WS_YCAT  = 376 * MiB;
constexpr size_t WS_X1B   = 376 * MiB;
constexpr size_t WS_YB    = 128 * MiB;
constexpr size_t WS_H2Q   = 128 * MiB;
constexpr size_t WS_SAL   = 440 * MiB;
constexpr size_t WS_END   = 448 * MiB;

constexpr int CW_BAR = 0;
constexpr int CW_CNT = 4096;
constexpr int CW_DBG = 4200;

typedef __bf16 bf16x2_t __attribute__((ext_vector_type(2)));
typedef float f32x2_t __attribute__((ext_vector_type(2)));
__device__ __forceinline__ unsigned cvtpk(float lo, float hi) { const f32x2_t f = {lo, hi}; const bf16x2_t v = __builtin_convertvector(f, bf16x2_t); return __builtin_bit_cast(unsigned, v); }
__device__ __forceinline__ float bf2f(bf16_t b) { return __uint_as_float(((unsigned)b) << 16); }
__device__ __forceinline__ float bflo(unsigned w) { return __uint_as_float(w << 16); }
__device__ __forceinline__ float bfhi(unsigned w) { return __uint_as_float(w & 0xffff0000u); }
__device__ __forceinline__ bf16_t f2bf(float f) { return (bf16_t)(cvtpk(f, 0.f) & 0xffffu); }
__device__ __forceinline__ float wave_sum(float v) {
#pragma unroll
    for (int o = 1; o < 64; o <<= 1) v += __shfl_xor(v, o);
    return v;
}
__device__ __forceinline__ float wave_max(float v) {
#pragma unroll
    for (int o = 1; o < 64; o <<= 1) v = fmaxf(v, __shfl_xor(v, o));
    return v;
}
__device__ __forceinline__ float sigmoid_f(float x) { return __builtin_amdgcn_rcpf(1.f + __builtin_amdgcn_exp2f(-1.4426950408889634f * x)); }
__device__ __forceinline__ float silu_f(float x) { return x * __builtin_amdgcn_rcpf(1.f + __builtin_amdgcn_exp2f(-1.4426950408889634f * x)); }
__device__ __forceinline__ float logsigmoid_f(float x) { return fminf(x, 0.f) - log1pf(__expf(-fabsf(x))); }
__device__ __forceinline__ float ex2(float x) { return __builtin_amdgcn_exp2f(x); }
#define MFMA32(a, b, c) __builtin_amdgcn_mfma_f32_32x32x16_bf16(a, b, c, 0, 0, 0)
#define MFMA16(a, b, c) __builtin_amdgcn_mfma_f32_16x16x32_bf16(a, b, c, 0, 0, 0)
typedef short v4i16_t __attribute__((ext_vector_type(4)));
__device__ __forceinline__ s16x4 vtr(LAS const unsigned char* p) { return __builtin_bit_cast(s16x4, __builtin_amdgcn_ds_read_tr16_b64_v4i16((LAS v4i16_t*)p)); }
__device__ __forceinline__ int crow(int r, int hi) { return (r & 3) + 8 * (r >> 2) + 4 * hi; }
__device__ __forceinline__ u32x4 widen_pair(u32x2 A, u32x2 B) {
    const auto r0 = __builtin_amdgcn_permlane32_swap(A.x, B.x, false, false); const auto r1 = __builtin_amdgcn_permlane32_swap(A.y, B.y, false, false);
    return (u32x4){r0[0], r1[0], r0[1], r1[1]}; }
__device__ __forceinline__ u32x4 widen_rows16(u32x2 X, u32x2 Y) {
    const auto r0 = __builtin_amdgcn_permlane16_swap(X.x, Y.x, false, false); const auto r1 = __builtin_amdgcn_permlane16_swap(X.y, Y.y, false, false);
    return (u32x4){r0[0], r1[0], r0[1], r1[1]}; }
__device__ __forceinline__ u32x4 quad_transpose(u32x4 d, int lane) {
    const bool b0 = lane & 1, b1 = lane & 2;
    { const unsigned t0 = b0 ? d.x : d.y, t1 = b0 ? d.z : d.w;
      const unsigned r0 = (unsigned)__builtin_amdgcn_mov_dpp((int)t0, 0xB1, 0xF, 0xF, true), r1 = (unsigned)__builtin_amdgcn_mov_dpp((int)t1, 0xB1, 0xF, 0xF, true);
      if (b0) { d.x = r0; d.z = r1; } else { d.y = r0; d.w = r1; } }
    { const unsigned t0 = b1 ? d.x : d.z, t1 = b1 ? d.y : d.w;
      const unsigned r0 = (unsigned)__builtin_amdgcn_mov_dpp((int)t0, 0x4E, 0xF, 0xF, true), r1 = (unsigned)__builtin_amdgcn_mov_dpp((int)t1, 0x4E, 0xF, 0xF, true);
      if (b1) { d.x = r0; d.y = r1; } else { d.z = r0; d.w = r1; } }
    return d; }
__device__ __forceinline__ u32x4 pair_widen(u32x2 A, u32x2 B, int lane) {
    const bool od = lane & 1; const u32x2 t = od ? A : B;
    u32x2 r; r.x = (unsigned)__builtin_amdgcn_mov_dpp((int)t.x, 0xB1, 0xF, 0xF, true); r.y = (unsigned)__builtin_amdgcn_mov_dpp((int)t.y, 0xB1, 0xF, 0xF, true);
    return od ? (u32x4){r.x, r.y, B.x, B.y} : (u32x4){A.x, A.y, r.x, r.y}; }
__device__ __forceinline__ void pair_narrow(u32x4 v, int lane, u32x2& A, u32x2& B) {
    const bool od = lane & 1; const u32x2 lo = {v.x, v.y}, hi = {v.z, v.w}; const u32x2 t = od ? lo : hi;
    u32x2 r; r.x = (unsigned)__builtin_amdgcn_mov_dpp((int)t.x, 0xB1, 0xF, 0xF, true); r.y = (unsigned)__builtin_amdgcn_mov_dpp((int)t.y, 0xB1, 0xF, 0xF, true);
    A = od ? r : lo; B = od ? hi : r; }
__device__ __forceinline__ bf16x8 mk8(s16x4 lo, s16x4 hi) { return (bf16x8){lo[0], lo[1], lo[2], lo[3], hi[0], hi[1], hi[2], hi[3]}; }

#define XB_TMO      128
#define XB_XCNT(j)  (256  + 64 * (j))
#define XB_XSUB(j)  (1280 + 64 * (j))
#define XB_XGEN(j)  (2304 + 64 * (j))
#define XB_TOP      3328
#define XB_TOPGEN   3392
#define XCD_BAR_WORDS 3456
#define XB_SPIN_CAP (1u << 18)
__device__ __forceinline__ unsigned xb_ld(unsigned* p)              { return __hip_atomic_load(p, __ATOMIC_RELAXED, __HIP_MEMORY_SCOPE_AGENT); }
__device__ __forceinline__ unsigned xb_add(unsigned* p, unsigned v) { return __hip_atomic_fetch_add(p, v, __ATOMIC_RELAXED, __HIP_MEMORY_SCOPE_AGENT); }
__device__ __forceinline__ unsigned xb_xcc_id() { return (unsigned)__builtin_amdgcn_s_getreg((3 << 11) | 20) & 0xFu; }
#define XB_SPIN(cond, bar) do { unsigned _sp = 0; while (cond) { __builtin_amdgcn_s_sleep(1); \
    if ((++_sp & 255u) == 0u) { if (xb_ld(&(bar)[XB_TMO])) break; if (_sp > XB_SPIN_CAP) { atomicAdd(&(bar)[XB_TMO], 1u); break; } } } } while (0)
struct XcdBarrier { unsigned* bar; unsigned x; volatile LAS unsigned* st; };
__device__ __forceinline__ XcdBarrier xcd_barrier_post(unsigned* bar, volatile LAS unsigned* st) {
    XcdBarrier b; b.bar = bar; b.x = xb_xcc_id(); b.st = st;
    if (threadIdx.x == 0) (void)xb_add(&bar[XB_XCNT(b.x)], 1u);
    return b;
}
__device__ __forceinline__ void xcd_barrier_complete(unsigned* bar, unsigned x, unsigned& nloc, unsigned& nx) {
    const unsigned G = gridDim.x * gridDim.y * gridDim.z;
    unsigned sum, cnt, mine, sp = 0u;
    for (;;) {
        sum = 0u; cnt = 0u; mine = 0u;
#pragma unroll
        for (unsigned j = 0; j < 16; ++j) { const unsigned c = xb_ld(&bar[XB_XCNT(j)]); sum += c; cnt += (c > 0u) ? 1u : 0u; mine = (j == x) ? c : mine; }
        if (sum == G) break;
        __builtin_amdgcn_s_sleep(1);
        if ((++sp & 255u) == 0u) { if (xb_ld(&bar[XB_TMO])) break; if (sp > XB_SPIN_CAP) { atomicAdd(&bar[XB_TMO], 1u); break; } }
    }
    nloc = mine > 0u ? mine : 1u; nx = cnt > 0u ? cnt : 1u;
}
__device__ __forceinline__ void xcd_barrier(const XcdBarrier& b) {
    asm volatile("s_waitcnt vmcnt(0)" ::: "memory");
    __syncthreads();
    if (threadIdx.x == 0) {
        unsigned* bar = b.bar;
        __builtin_amdgcn_s_waitcnt(0);
        unsigned nloc = b.st[0], nx = b.st[1];
        if (nloc == 0u) { xcd_barrier_complete(bar, b.x, nloc, nx); b.st[0] = nloc; b.st[1] = nx; }
        const unsigned old = xb_add(&bar[XB_XSUB(b.x)], 1u);
        const unsigned gen = old / nloc;
        if (old + 1u == (gen + 1u) * nloc) {
            __builtin_amdgcn_fence(__ATOMIC_RELEASE, "agent");
            asm volatile("s_waitcnt vmcnt(0)" ::: "memory");
            const unsigned og = xb_add(&bar[XB_TOP], 1u);
            const unsigned tg = og / nx;
            if (og + 1u == (tg + 1u) * nx) xb_add(&bar[XB_TOPGEN], 1u);
            else XB_SPIN(xb_ld(&bar[XB_TOPGEN]) == tg, bar);
            __builtin_amdgcn_fence(__ATOMIC_ACQUIRE, "agent");
            xb_add(&bar[XB_XGEN(b.x)], 1u);
            asm volatile("s_waitcnt vmcnt(0)" ::: "memory");
        } else {
            XB_SPIN(xb_ld(&bar[XB_XGEN(b.x)]) == gen, bar);
            __builtin_amdgcn_fence(__ATOMIC_ACQUIRE, "agent");
            asm volatile("s_waitcnt vmcnt(0)" ::: "memory");
        }
    }
    __syncthreads();
}

struct Args { const void* in[27]; float* out; unsigned char* ws; int ph_lo, ph_hi; };
struct Frame {
    LAS unsigned char* lds;
    const void* const* in; float* out; unsigned char* ws;
    int tid, lane, wave, vcu, G;
};
#define IN_F(k) ((const float*)F.in[k])
#define WSP(T, off) ((T*)(F.ws + (off)))

namespace pg8 {
constexpr int BM = 256, BK = 64, HALF = 128, HTB = HALF * BK * 2, STAGE_BYTES = 8 * HTB, NXCD = 8, WGM = 8;
__host__ __device__ __forceinline__ int lds_byte(int r, int c) { const int st = (r >> 4) * 2 + (c >> 5), rr = r & 15, cc = c & 31, ob = rr * 64 + cc * 2; return st * 1024 + (ob ^ (((ob >> 9) & 1) << 5)); }
__host__ __device__ __forceinline__ void stage_rc(int b, int& R, int& C) { const int st = b / 1024, sb = b % 1024, swz = sb ^ (((sb >> 9) & 1) << 5); R = (st >> 1) * 16 + swz / 64; C = (st & 1) * 32 + (swz % 64) / 2; }
__host__ __device__ __forceinline__ int perm32(int rho) { const int n = rho >> 4, i = rho & 15; return 8 * (i >> 2) + 4 * n + (i & 3); }
struct Unit { int pm, pn, e, nrow; };

template <bool I8, class Epi, class Sched>
__device__ __forceinline__ void gemm_phase(LAS unsigned char* lds, const void* Abase, const void* Bbase, const int K, const Sched& S, const Epi& E) {
    const int tid = threadIdx.x, wid = __builtin_amdgcn_readfirstlane(tid >> 6), lane = tid & 63, wr = wid >> 2, wc = wid & 3, fr = lane & 15, fq = lane >> 4;
    const int nt = K / BK;
    int Rr[2], Cc[2]; unsigned voffB[2];
#pragma unroll
    for (int i = 0; i < 2; ++i) { int R, C; stage_rc(tid * 16 + i * 8192, R, C); Rr[i] = R; Cc[i] = C; const int Rb = (R & ~31) + perm32(R & 31); voffB[i] = (unsigned)(Rb * K + C) * 2u; }
    const size_t kstep = (size_t)(BK * 2);
    const size_t hstepB = (size_t)HALF * K * 2;
    const unsigned ldsw = (unsigned)wid * 1024u;
    const int aoff = lds_byte(wr * 64 + fr, fq * 8), boff = lds_byte(wc * 32 + fr, fq * 8);
#define PG8_SA(b, h) (((b) * 2 + (h)) * HTB)
#define PG8_SB(b, h) ((4 + (b) * 2 + (h)) * HTB)
#define PG8_STAGEB(bufoff, gbase) do { _Pragma("unroll") for (int _i = 0; _i < 2; ++_i) \
        __builtin_amdgcn_global_load_lds((const unsigned*)((const char*)(gbase) + voffB[_i]), (LAS unsigned*)(lds + (bufoff) + ldsw + _i * 8192), 16, 0, 0); } while (0)
#define PG8_STAGEA(bufoff, o0, o1, ktb) do { const char* _p = (const char*)Abase + (ktb); \
        __builtin_amdgcn_global_load_lds((const unsigned*)(_p + (o0)), (LAS unsigned*)(lds + (bufoff) + ldsw), 16, 0, 0); \
        __builtin_amdgcn_global_load_lds((const unsigned*)(_p + (o1)), (LAS unsigned*)(lds + (bufoff) + ldsw + 8192), 16, 0, 0); } while (0)
#define PG8_LDA(dst, b, h) do { _Pragma("unroll") for (int m = 0; m < 4; ++m) _Pragma("unroll") for (int k = 0; k < 2; ++k) dst[m][k] = *(const LAS bf16x8*)(lds + PG8_SA(b, h) + aoff + m * 2048 + k * 1024); } while (0)
#define PG8_LDB(dst, b, h) do { _Pragma("unroll") for (int n = 0; n < 2; ++n) _Pragma("unroll") for (int k = 0; k < 2; ++k) dst[n][k] = *(const LAS bf16x8*)(lds + PG8_SB(b, h) + boff + n * 2048 + k * 1024); } while (0)
#define PG8_MMA(ai, bj, At, Bt) do { __builtin_amdgcn_s_setprio(1); _Pragma("unroll") for (int m = 0; m < 4; ++m) _Pragma("unroll") for (int n = 0; n < 2; ++n) _Pragma("unroll") for (int k = 0; k < 2; ++k) { \
        if constexpr (I8) acc[ai][bj][m][n] = __builtin_bit_cast(acc_t, __builtin_amdgcn_mfma_i32_16x16x64_i8(__builtin_bit_cast(i32x4, Bt[n][k]), __builtin_bit_cast(i32x4, At[m][k]), __builtin_bit_cast(i32x4, acc[ai][bj][m][n]), 0, 0, 0)); \
        else acc[ai][bj][m][n] = __builtin_bit_cast(acc_t, __builtin_amdgcn_mfma_f32_16x16x32_bf16(Bt[n][k], At[m][k], __builtin_bit_cast(f32x4, acc[ai][bj][m][n]), 0, 0, 0)); } __builtin_amdgcn_s_setprio(0); } while (0)
#define PG8_WAIT_V(n) asm volatile("s_waitcnt vmcnt(" #n ")" ::: "memory")
#define PG8_WAIT_L(n) asm volatile("s_waitcnt lgkmcnt(" #n ")" ::: "memory")
#define PG8_BAR __builtin_amdgcn_s_barrier()
#define PG8_SCHED __builtin_amdgcn_sched_barrier(0)
    Unit cur, nxt; int ui = 0;
    if (!S.next(0, cur)) return;
    using acc_t = typename std::conditional<I8, i32x4, f32x4>::type;
    acc_t acc[2][2][4][2];
#pragma unroll
    for (int a = 0; a < 2; ++a)
#pragma unroll
        for (int b = 0; b < 2; ++b)
#pragma unroll
            for (int m = 0; m < 4; ++m)
#pragma unroll
                for (int n = 0; n < 2; ++n) acc[a][b][m][n] = __builtin_bit_cast(acc_t, (u32x4){0u, 0u, 0u, 0u});
    bf16x8 At[4][2], B0[2][2], B1[2][2];
    unsigned oc00, oc01, oc10, oc11, on00, on01, on10, on11;
    oc00 = S.a_off(cur, Rr[0]) + Cc[0] * 2; oc01 = S.a_off(cur, Rr[1]) + Cc[1] * 2; oc10 = S.a_off(cur, HALF + Rr[0]) + Cc[0] * 2; oc11 = S.a_off(cur, HALF + Rr[1]) + Cc[1] * 2;
    const char* cB = (const char*)Bbase + S.b_off(cur);
    PG8_STAGEB(PG8_SB(0, 0), cB); PG8_STAGEA(PG8_SA(0, 0), oc00, oc01, 0); PG8_STAGEB(PG8_SB(0, 1), cB + hstepB); PG8_STAGEA(PG8_SA(0, 1), oc10, oc11, 0);
    if (wr == 1) PG8_BAR;
    PG8_WAIT_V(4); PG8_BAR;
    PG8_STAGEB(PG8_SB(1, 0), cB + kstep); PG8_STAGEA(PG8_SA(1, 0), oc00, oc01, kstep); PG8_STAGEB(PG8_SB(1, 1), cB + hstepB + kstep);
    PG8_WAIT_V(6); PG8_BAR;
    for (;;) {
        E.pre(cur, lds, wid, lane, ui & 1);
        const bool has_next = S.next(ui + 1, nxt);
        const char* nB = cB;
        if (has_next) { on00 = S.a_off(nxt, Rr[0]) + Cc[0] * 2; on01 = S.a_off(nxt, Rr[1]) + Cc[1] * 2; on10 = S.a_off(nxt, HALF + Rr[0]) + Cc[0] * 2; on11 = S.a_off(nxt, HALF + Rr[1]) + Cc[1] * 2; nB = (const char*)Bbase + S.b_off(nxt); }
        else { on00 = oc00; on01 = oc01; on10 = oc10; on11 = oc11; }
        for (int t = 0; t < nt; t += 2) {
            const bool last = (t == nt - 2);
            const size_t k1 = (size_t)(t + 1) * kstep;
            const size_t k2 = last ? 0 : (size_t)(t + 2) * kstep, k3 = k2 + kstep;
            const unsigned o200 = last ? on00 : oc00, o201 = last ? on01 : oc01, o210 = last ? on10 : oc10, o211 = last ? on11 : oc11;
            const char* b2 = last ? nB : cB + (size_t)(t + 2) * kstep; const char* b3 = b2 + kstep;
            PG8_LDB(B0, 0, 0); PG8_SCHED; PG8_LDA(At, 0, 0); PG8_STAGEA(PG8_SA(1, 1), oc10, oc11, k1);
            PG8_WAIT_L(8); PG8_BAR; PG8_WAIT_L(0); PG8_MMA(0, 0, At, B0); PG8_BAR; PG8_SCHED;
            PG8_LDB(B1, 0, 1); PG8_STAGEB(PG8_SB(0, 0), b2);
            PG8_BAR; PG8_WAIT_L(0); PG8_MMA(0, 1, At, B1); PG8_BAR;
            PG8_LDA(At, 0, 1); PG8_STAGEA(PG8_SA(0, 0), o200, o201, k2);
            PG8_BAR; PG8_WAIT_L(0); PG8_MMA(1, 0, At, B0); PG8_BAR; PG8_SCHED;
            PG8_STAGEB(PG8_SB(0, 1), b2 + hstepB);
            PG8_WAIT_V(6); PG8_BAR; PG8_MMA(1, 1, At, B1); PG8_BAR;
            PG8_LDB(B0, 1, 0); PG8_SCHED; PG8_LDA(At, 1, 0); PG8_STAGEA(PG8_SA(0, 1), o210, o211, k2);
            PG8_WAIT_L(8); PG8_BAR; PG8_WAIT_L(0); PG8_MMA(0, 0, At, B0); PG8_BAR; PG8_SCHED;
            PG8_LDB(B1, 1, 1); PG8_STAGEB(PG8_SB(1, 0), b3);
            PG8_BAR; PG8_WAIT_L(0); PG8_MMA(0, 1, At, B1); PG8_BAR;
            PG8_LDA(At, 1, 1); PG8_STAGEA(PG8_SA(1, 0), o200, o201, k3);
            PG8_BAR; PG8_WAIT_L(0); PG8_MMA(1, 0, At, B0); PG8_BAR; PG8_SCHED;
            PG8_STAGEB(PG8_SB(1, 1), b3 + hstepB);
            PG8_WAIT_V(6); PG8_BAR; PG8_MMA(1, 1, At, B1); PG8_BAR;
        }
        E(acc, cur, wr, wc, fr, fq, ui & 1);
        if (!has_next) break;
#pragma unroll
        for (int a = 0; a < 2; ++a)
#pragma unroll
            for (int b = 0; b < 2; ++b)
#pragma unroll
                for (int m = 0; m < 4; ++m)
#pragma unroll
                    for (int n = 0; n < 2; ++n) acc[a][b][m][n] = __builtin_bit_cast(acc_t, (u32x4){0u, 0u, 0u, 0u});
        cur = nxt; cB = nB; oc00 = on00; oc01 = on01; oc10 = on10; oc11 = on11; ++ui;
    }
    PG8_WAIT_V(0);
    if (wr == 0) PG8_BAR;
    PG8_BAR;
#undef PG8_SA
#undef PG8_SB
#undef PG8_STAGEA
#undef PG8_STAGEB
#undef PG8_LDA
#undef PG8_LDB
#undef PG8_MMA
#undef PG8_WAIT_V
#undef PG8_WAIT_L
#undef PG8_BAR
#undef PG8_SCHED
}

struct DenseOrder {
    int nM, nN, nwg, G, c, K;
    __device__ void init(int M, int N, int K_, int G_, int c_) { nM = M / BM; nN = N / BM; nwg = nM * nN; G = G_; c = c_; K = K_; }
    __device__ __forceinline__ bool next(int i, Unit& u) const {
        const long L = (long)i * G + c; if (L >= nwg) return false;
        int wgid = (int)L; { const int q = nwg / NXCD, r = nwg % NXCD, xcd = wgid % NXCD, off = wgid / NXCD; wgid = (xcd < r ? xcd * (q + 1) : r * (q + 1) + (xcd - r) * q) + off; }
        const int nig = WGM * nN, gid = wgid / nig, fm = gid * WGM, gsz = (nM - fm) < WGM ? (nM - fm) : WGM;
        u.pm = fm + ((wgid % nig) % gsz); u.pn = (wgid % nig) / gsz; u.e = 0; u.nrow = 256; return true;
    }
    __device__ __forceinline__ unsigned a_off(const Unit& u, int R) const { return (unsigned)((u.pm * BM + R) * K) * 2u; }
    __device__ __forceinline__ size_t b_off(const Unit& u) const { return (size_t)u.pn * BM * K * 2; }
};
struct MoeOrder {
    const LAS int* tstart; const LAS int* cnt; const int* list; int G, c, K, npn; bool gather;
    __device__ __forceinline__ bool next(int i, Unit& u) const {
        const int L = i * G + c; const int tt = tstart[32];
        if (L >= tt * npn) return false;
        const int tile = L / npn; u.pn = L % npn; u.pm = tile;
        int e = 0;
#pragma unroll 1
        for (int k = 1; k < 32; ++k) if (tstart[k] <= tile) e = k;
        u.e = e; u.nrow = cnt[e] - (tile - tstart[e]) * 256; return true;
    }
    __device__ __forceinline__ unsigned a_off(const Unit& u, int R) const {
        if (gather) { const int mt = u.pm - tstart[u.e]; const int r = mt * 256 + R; const int tok = list[(size_t)u.e * 65536 + (R < u.nrow ? r : 0)]; return (unsigned)(tok * K) * 2u; }
        return (unsigned)((u.pm * BM + R) * K) * 2u;
    }
    __device__ __forceinline__ size_t b_off(const Unit& u) const { return ((size_t)u.e * 1024 + (size_t)u.pn * BM) * K * 2; }
};
}

constexpr int EPI_SC = MISC_OFF + 24576;
struct EpiIn {
    unsigned char* ws; const float* gate_b;
    __device__ __forceinline__ void pre(const pg8::Unit& u, LAS unsigned char* lds, int wid, int lane, int par) const {
        if (wid == 0) { __builtin_amdgcn_global_load_lds((const unsigned*)((const float*)(ws + WS_SA1) + u.pm * 256 + lane * 4), (LAS unsigned*)(lds + EPI_SC + par * 2048), 16, 0, 0);
                        __builtin_amdgcn_global_load_lds((const unsigned*)((const float*)(ws + WS_SBW) + u.pn * 256 + lane * 4), (LAS unsigned*)(lds + EPI_SC + par * 2048 + 1024), 16, 0, 0); } }
    LAS unsigned char* lds;
    __device__ __forceinline__ void operator()(const i32x4 (&acc)[2][2][4][2], const pg8::Unit& u, int wr, int wc, int fr, int fq, int par) const {
        asm volatile("" : "+v"(fr), "+v"(fq));
        const int pn = u.pn, row0 = u.pm * 256 + wr * 64 + fr;
        float sa[2][4]; f32x4 sb[2][2];
        { LAS const float* SA1 = (LAS const float*)(lds + EPI_SC + par * 2048); LAS const float* SBW = SA1 + 256;
#pragma unroll
          for (int ai = 0; ai < 2; ++ai)
#pragma unroll
              for (int m = 0; m < 4; ++m) sa[ai][m] = SA1[wr * 64 + fr + ai * 128 + m * 16];
#pragma unroll
          for (int bj = 0; bj < 2; ++bj)
#pragma unroll
              for (int n = 0; n < 2; ++n) sb[bj][n] = *(LAS const f32x4*)(SBW + bj * 128 + wc * 32 + 8 * fq + 4 * n); }
#define ACCF(ai, bj, m, n) (__builtin_convertvector(acc[ai][bj][m][n], f32x4) * sa[ai][m] * sb[bj][n])
        if (pn < 8) {
            bf16_t* dst = (bf16_t*)(ws + (pn < 2 ? WS_MQ : pn < 4 ? WS_MK : pn < 6 ? WS_MV : WS_MO));
            const int col0 = (pn & 1) * 256 + wc * 32 + 8 * fq;
#pragma unroll
            for (int ai = 0; ai < 2; ++ai)
#pragma unroll
                for (int m = 0; m < 4; ++m) { bf16_t* rp = dst + (size_t)(row0 + ai * 128 + m * 16) * 512 + col0;
#pragma unroll
                    for (int bj = 0; bj < 2; ++bj) { const f32x4 v0 = ACCF(ai, bj, m, 0), v1 = ACCF(ai, bj, m, 1);
                        u32x4 w; w.x = cvtpk(v0[0], v0[1]); w.y = cvtpk(v0[2], v0[3]); w.z = cvtpk(v1[0], v1[1]); w.w = cvtpk(v1[2], v1[3]);
                        *(u32x4*)(rp + bj * 128) = w; } }
        } else if (pn < 10) {
            const int g8 = 4 * (wc & 1) + fq; const float* COS = (const float*)(ws + WS_COS); const float* SIN = (const float*)(ws + WS_SIN); bf16_t* NQ = (bf16_t*)(ws + WS_NQ);
#pragma unroll
            for (int ai = 0; ai < 2; ++ai)
#pragma unroll
                for (int m = 0; m < 4; ++m) { const int row = row0 + ai * 128 + m * 16;
                    const f32x4 cs = *(const f32x4*)(COS + (size_t)row * 32 + 4 * g8), sn = *(const f32x4*)(SIN + (size_t)row * 32 + 4 * g8);
#pragma unroll
                    for (int bj = 0; bj < 2; ++bj) { const int head = (pn - 8) * 4 + bj * 2 + (wc >> 1);
                        const f32x4 x1 = ACCF(ai, bj, m, 0), x2 = ACCF(ai, bj, m, 1);
                        const f32x4 o1 = (x1 * cs - x2 * sn) * QSCALE, o2 = (x2 * cs + x1 * sn) * QSCALE;
                        bf16_t* rp = NQ + (size_t)row * 512 + head * 64 + 4 * (g8 & ~1) + 32 * (fq & 1);
                        u32x2 a; a.x = cvtpk(o1[0], o1[1]); a.y = cvtpk(o1[2], o1[3]);
                        u32x2 b; b.x = cvtpk(o2[0], o2[1]); b.y = cvtpk(o2[2], o2[3]); *(u32x4*)rp = widen_rows16(a, b); } }
        } else if (pn < 13) {
            bf16_t* kd = (bf16_t*)(ws + (pn == 10 ? WS_KC : pn == 11 ? WS_KSL : WS_KWN)); bf16_t* vd = (bf16_t*)(ws + (pn == 10 ? WS_VC : pn == 11 ? WS_VSL : WS_VWN));
            const float* COS = (const float*)(ws + WS_COS); const float* SIN = (const float*)(ws + WS_SIN);
            const int g8 = 4 * (wc & 1) + fq, grp = wc >> 1;
#pragma unroll
            for (int ai = 0; ai < 2; ++ai)
#pragma unroll
                for (int m = 0; m < 4; ++m) { const int row = row0 + ai * 128 + m * 16; const int b = row >> 12, s = row & 4095;
                    const f32x4 cs = *(const f32x4*)(COS + (size_t)row * 32 + 4 * g8), sn = *(const f32x4*)(SIN + (size_t)row * 32 + 4 * g8);
                    const size_t rbase = ((size_t)(b * 2 + grp) * SEQ + s) * 64;
                    { const f32x4 x1 = ACCF(ai, 0, m, 0), x2 = ACCF(ai, 0, m, 1);
                      const f32x4 o1 = x1 * cs - x2 * sn, o2 = x2 * cs + x1 * sn;
                      bf16_t* rp = kd + rbase + 4 * (g8 & ~1) + 32 * (fq & 1);
                      u32x2 a; a.x = cvtpk(o1[0], o1[1]); a.y = cvtpk(o1[2], o1[3]);
                      u32x2 c; c.x = cvtpk(o2[0], o2[1]); c.y = cvtpk(o2[2], o2[3]); *(u32x4*)rp = widen_rows16(a, c); }
                    { const f32x4 v0 = ACCF(ai, 1, m, 0), v1 = ACCF(ai, 1, m, 1);
                      u32x4 w; w.x = cvtpk(v0[0], v0[1]); w.y = cvtpk(v0[2], v0[3]); w.z = cvtpk(v1[0], v1[1]); w.w = cvtpk(v1[2], v1[3]);
                      *(u32x4*)(vd + rbase + (wc & 1) * 32 + 8 * fq) = w; } }
        } else {
            if (wc == 0) { float* GI = (float*)(ws + WS_GI); float* GF = (float*)(ws + WS_GF); float* NGT = (float*)(ws + WS_NGT);
#pragma unroll
                for (int ai = 0; ai < 2; ++ai)
#pragma unroll
                    for (int m = 0; m < 4; ++m) { const int row = row0 + ai * 128 + m * 16; const int b = row >> 12, s = row & 4095;
#pragma unroll
                        for (int n = 0; n < 2; ++n) { const f32x4 v = ACCF(ai, 0, m, n);
                            if (fq == 0) {
#pragma unroll
                                for (int i = 0; i < 4; ++i) { const float z = v[i] + gate_b[4 * n + i];
                                    if (n == 0) GI[(size_t)(b * 4 + i) * SEQ + s] = z; else GF[(size_t)(b * 4 + i) * SEQ + s] = logsigmoid_f(z); }
                            } else {
                                f32x4 o; o[0] = sigmoid_f(v[0]); o[1] = sigmoid_f(v[1]); o[2] = sigmoid_f(v[2]); o[3] = sigmoid_f(v[3]);
                                *(f32x4*)(NGT + (size_t)row * 24 + 8 * fq + 4 * n - 8) = o; } } }
            }
        }
    }
};
#undef ACCF
struct EpiBf16 {
    bf16_t* O; int ldc;
    __device__ __forceinline__ void pre(const pg8::Unit&, LAS unsigned char*, int, int, int) const {}
    __device__ __forceinline__ void operator()(const f32x4 (&acc)[2][2][4][2], const pg8::Unit& u, int wr, int wc, int fr, int fq, int par) const {
        asm volatile("" : "+v"(fr), "+v"(fq));
        const int row0 = u.pm * 256 + wr * 64 + fr, col0 = u.pn * 256 + wc * 32 + 8 * fq;
#pragma unroll
        for (int ai = 0; ai < 2; ++ai)
#pragma unroll
            for (int m = 0; m < 4; ++m) { bf16_t* rp = O + (size_t)(row0 + ai * 128 + m * 16) * ldc + col0;
#pragma unroll
                for (int bj = 0; bj < 2; ++bj) { const f32x4 v0 = acc[ai][bj][m][0], v1 = acc[ai][bj][m][1];
                    u32x4 w; w.x = cvtpk(v0[0], v0[1]); w.y = cvtpk(v0[2], v0[3]); w.z = cvtpk(v1[0], v1[1]); w.w = cvtpk(v1[2], v1[3]);
                    *(u32x4*)(rp + bj * 128) = w; } }
    }
};
struct EpiUp {
    bf16_t* HB;
    __device__ __forceinline__ void pre(const pg8::Unit&, LAS unsigned char*, int, int, int) const {}
    __device__ __forceinline__ void operator()(const f32x4 (&acc)[2][2][4][2], const pg8::Unit& u, int wr, int wc, int fr, int fq, int par) const {
        asm volatile("" : "+v"(fr), "+v"(fq));
        const int row0 = u.pm * 256 + wr * 64 + fr, col0 = (u.pn * 256 + wc * 32 + 8 * fq) >> 1;
#pragma unroll
        for (int ai = 0; ai < 2; ++ai)
#pragma unroll
            for (int m = 0; m < 4; ++m) { bf16_t* rp = HB + (size_t)(row0 + ai * 128 + m * 16) * EFF + col0;
#pragma unroll
                for (int bj = 0; bj < 2; ++bj) { const f32x4 a1 = acc[ai][bj][m][0], a3 = acc[ai][bj][m][1];
                    u32x2 w; w.x = cvtpk(silu_f(a1[0]) * a3[0], silu_f(a1[1]) * a3[1]); w.y = cvtpk(silu_f(a1[2]) * a3[2], silu_f(a1[3]) * a3[3]);
                    *(u32x2*)(rp + bj * 64) = w; } }
    }
};

struct EpiUpI8 {
    bf16_t* HB; const float* SAL; const float* SB; const LAS int* tstart; LAS unsigned char* lds;
    __device__ __forceinline__ void pre(const pg8::Unit& u, LAS unsigned char* l, int wid, int lane, int par) const {
        if (wid == 0) { const int mt = u.pm - tstart[u.e];
            __builtin_amdgcn_global_load_lds((const unsigned*)(SAL + (size_t)u.e * 65536 + mt * 256 + lane * 4), (LAS unsigned*)(l + EPI_SC + par * 2048), 16, 0, 0);
            __builtin_amdgcn_global_load_lds((const unsigned*)(SB + (size_t)u.e * 1024 + u.pn * 256 + lane * 4), (LAS unsigned*)(l + EPI_SC + par * 2048 + 1024), 16, 0, 0); } }
    __device__ __forceinline__ void operator()(const i32x4 (&acc)[2][2][4][2], const pg8::Unit& u, int wr, int wc, int fr, int fq, int par) const {
        asm volatile("" : "+v"(fr), "+v"(fq));
        const int rl0 = wr * 64 + fr, row0 = u.pm * 256 + rl0, colp = u.pn * 256 + wc * 32 + 8 * fq, col0 = colp >> 1;
        LAS const float* LSA = (LAS const float*)(lds + EPI_SC + par * 2048); LAS const float* LSB = LSA + 256;
        f32x4 sb[2][2];
#pragma unroll
        for (int bj = 0; bj < 2; ++bj)
#pragma unroll
            for (int n = 0; n < 2; ++n) sb[bj][n] = *(LAS const f32x4*)(LSB + wc * 32 + 8 * fq + bj * 128 + 4 * n);
#pragma unroll
        for (int ai = 0; ai < 2; ++ai)
#pragma unroll
            for (int m = 0; m < 4; ++m) { const int R = rl0 + ai * 128 + m * 16; const float sa = LSA[R];
                bf16_t* rp = HB + (size_t)(row0 + ai * 128 + m * 16) * EFF + (col0 & ~7) + 64 * (fq & 1);
                u32x2 wv[2];
#pragma unroll
                for (int bj = 0; bj < 2; ++bj) { const i32x4 i1 = acc[ai][bj][m][0], i3 = acc[ai][bj][m][1];
                    f32x4 a1, a3;
#pragma unroll
                    for (int i = 0; i < 4; ++i) { a1[i] = (float)i1[i] * sa * sb[bj][0][i]; a3[i] = (float)i3[i] * sa * sb[bj][1][i]; }
                    wv[bj].x = cvtpk(silu_f(a1[0]) * a3[0], silu_f(a1[1]) * a3[1]); wv[bj].y = cvtpk(silu_f(a1[2]) * a3[2], silu_f(a1[3]) * a3[3]); }
                *(u32x4*)rp = widen_rows16(wv[0], wv[1]); }
    }
};

template <class RM>
__device__ __forceinline__ void transpose_item(const float* W, int N, bf16_t* WT, int Kd, LAS float* scr, int k0, int n0, int lane, const RM& rm) {
#pragma unroll 8
    for (int i = 0; i < 32; ++i) { const int kk = 2 * i + (lane >> 5); scr[kk * 33 + (lane & 31)] = W[(size_t)(k0 + kk) * N + n0 + (lane & 31)]; }
    asm volatile("s_waitcnt lgkmcnt(0)" ::: "memory");
    const int c = lane & 7;
#pragma unroll
    for (int j = 0; j < 4; ++j) { const int n = (lane >> 3) + 8 * j; const LAS float* s = scr + (8 * c) * 33 + n;
        u32x4 o; o.x = cvtpk(s[0 * 33], s[1 * 33]); o.y = cvtpk(s[2 * 33], s[3 * 33]); o.z = cvtpk(s[4 * 33], s[5 * 33]); o.w = cvtpk(s[6 * 33], s[7 * 33]);
        *(u32x4*)(WT + (size_t)rm(n0 + n) * Kd + k0 + 8 * c) = o; }
    asm volatile("s_waitcnt lgkmcnt(0)" ::: "memory");
}
struct RmId { int off; __device__ __forceinline__ int operator()(int n) const { return off + n; } };
__device__ __forceinline__ int rope_pl(int d) { return 8 * ((d & 31) >> 2) + 4 * (d >> 5) + (d & 3); }
struct RmWin {
    __device__ __forceinline__ int operator()(int c) const {
        if (c < 2048) return c;
        if (c < 2052) return 3328 + (c - 2048);
        if (c < 2056) return 3332 + (c - 2052);
        if (c < 2568) { const int x = c - 2056; return 2048 + (x & ~63) + rope_pl(x & 63); }
        if (c < 2696) { const int x = c - 2568; return 2560 + (x & ~63) + rope_pl(x & 63); }
        if (c < 2824) return 2688 + (c - 2696);
        if (c < 2952) { const int x = c - 2824; return 2816 + (x & ~63) + rope_pl(x & 63); }
        if (c < 3080) return 2944 + (c - 2952);
        if (c < 3208) { const int x = c - 3080; return 3072 + (x & ~63) + rope_pl(x & 63); }
        if (c < 3336) return 3200 + (c - 3208);
        return c;
    }
};
struct RmW13 { int sel; __device__ __forceinline__ int operator()(int j) const { return 8 * (j >> 2) + 4 * sel + (j & 3); } };

__device__ __forceinline__ void p0_phase(Frame& F) {
    const int tid = F.tid, lane = F.lane;
    const int NA = F.G > 64 ? 64 : F.G;
    const bool split = F.G > NA;
    if (F.vcu < NA) {
        LAS float* sc = (LAS float*)F.lds; LAS float* red = (LAS float*)(F.lds + 32768);
        const float* c = IN_F(1);
        for (int i = tid; i < 8192; i += NTHR) sc[i] = silu_f(c[i]);
        __syncthreads();
        const float* W = IN_F(3); const float* bia = IN_F(4); float* mod = WSP(float, WS_MOD);
        for (int cg = F.vcu; cg < 64; cg += NA) {
            const int col0 = cg * 96;
            const int kq = tid / 24, cq = tid % 24;
            f32x4 a[8];
#pragma unroll
            for (int b = 0; b < 8; ++b) a[b] = (f32x4){0.f, 0.f, 0.f, 0.f};
            if (tid < 504) {
#pragma unroll 4
                for (int k = kq; k < 1024; k += 21) { const f32x4 w = *(const f32x4*)(W + (size_t)k * 6144 + col0 + 4 * cq);
#pragma unroll
                    for (int b = 0; b < 8; ++b) a[b] += w * sc[b * 1024 + k]; }
#pragma unroll
                for (int b = 0; b < 8; ++b) *(LAS f32x4*)(red + (size_t)(tid * 8 + b) * 4) = a[b];
            }
            __syncthreads();
            for (int o = tid; o < 768; o += NTHR) { const int cq2 = o >> 5, bj = o & 31;
                float sacc = 0.f;
                for (int q = 0; q < 21; ++q) sacc += red[(size_t)((q * 24 + cq2) * 8) * 4 + bj];
                const int col = col0 + 4 * cq2 + (bj & 3);
                mod[(bj >> 2) * 6144 + col] = sacc + bia[col]; }
            __syncthreads();
        }
    }
    if (!split || F.vcu >= NA) {
        LAS float* scr = (LAS float*)(F.lds + F.wave * 8448);
        const int gw = (split ? F.vcu - NA : F.vcu) * NWAVES + F.wave, NGW = (split ? F.G - NA : F.G) * NWAVES;
        constexpr int I_WOUT = 16 * 32, I_C1 = 32 * 4, I_C2 = 2 * 2;
        constexpr int NITEMS = I_WOUT + 2 * I_C1 + 2 * I_C2;
        for (int it = gw; it < NITEMS; it += NGW) {
            int r = it;
            if (r < I_WOUT) { transpose_item(IN_F(19), 1024, WSP(bf16_t, WS_WOUTT), 1024, scr, (r / 32) * 64, (r % 32) * 32, lane, RmId{0}); continue; } r -= I_WOUT;
            if (r < I_C1) { transpose_item(IN_F(14), 128, WSP(bf16_t, WS_CW1K), 2048, scr, (r / 4) * 64, (r % 4) * 32, lane, RmId{0}); continue; } r -= I_C1;
            if (r < I_C1) { transpose_item(IN_F(17), 128, WSP(bf16_t, WS_CW1V), 2048, scr, (r / 4) * 64, (r % 4) * 32, lane, RmId{0}); continue; } r -= I_C1;
            if (r < I_C2) { transpose_item(IN_F(15), 64, WSP(bf16_t, WS_CW2K), 128, scr, (r / 2) * 64, (r % 2) * 32, lane, RmId{0}); continue; } r -= I_C2;
            transpose_item(IN_F(18), 64, WSP(bf16_t, WS_CW2V), 128, scr, (r / 2) * 64, (r % 2) * 32, lane, RmId{0});
        }
    }
    __syncthreads();
    {
        LAS unsigned* AM = (LAS unsigned*)F.lds; const int n = tid & 15, kq = tid >> 4; const RmWin rmw{};
        for (int it = (F.vcu + F.G - (split ? NA : 0)) % F.G; it < 210; it += F.G) {
            const int c = 16 * it + n; const float* W = IN_F(9) + (size_t)(32 * kq) * INW + c;
            if (tid < 16) AM[tid] = 0u;
            __syncthreads();
            float v[32]; float am = 0.f;
#pragma unroll
            for (int i = 0; i < 32; ++i) { v[i] = W[(size_t)i * INW]; am = fmaxf(am, fabsf(v[i])); }
            atomicMax((unsigned*)&AM[n], __float_as_uint(am));
            __syncthreads();
            const float amax = __uint_as_float(AM[n]); const float inv = amax > 0.f ? 127.f / amax : 0.f; const int prow = rmw(c);
            unsigned char* dst = (unsigned char*)(F.ws + WS_WINT) + (size_t)prow * 1024 + 32 * kq;
#pragma unroll
            for (int cc = 0; cc < 2; ++cc) { u32x4 o;
#pragma unroll
                for (int d = 0; d < 4; ++d) { const int b0 = 16 * cc + 4 * d;
                    const int q0 = (int)rintf(v[b0] * inv), q1 = (int)rintf(v[b0 + 1] * inv), q2 = (int)rintf(v[b0 + 2] * inv), q3 = (int)rintf(v[b0 + 3] * inv);
                    o[d] = (unsigned)(q0 & 0xff) | ((unsigned)(q1 & 0xff) << 8) | ((unsigned)(q2 & 0xff) << 16) | ((unsigned)(q3 & 0xff) << 24); }
                *(u32x4*)(dst + 16 * cc) = o; }
            if (kq == 0) WSP(float, WS_SBW)[prow] = amax * (1.f / 127.f);
            __syncthreads();
        }
    }
    {
        const size_t gt = (size_t)F.vcu * NTHR + tid, NGT_ = (size_t)F.G * NTHR;
        const int* pos = (const int*)F.in[2]; float* COS = WSP(float, WS_COS); float* SIN = WSP(float, WS_SIN);
        {
            const int d = (int)(gt & 31); const float inv = powf(10000.f, -(float)d / 32.f);
            for (size_t i = gt; i < (size_t)NTOK * 32; i += NGT_) { const int row = (int)(i >> 5);
                const float ang = (float)pos[row] * inv; const float kk = rintf(ang * 0.15915494309189535f);
                float r = fmaf(-kk, 6.28125f, ang); r = fmaf(-kk, 1.9353071795864769e-3f, r);
                float sn, cs; sincosf(r, &sn, &cs); COS[i] = cs; SIN[i] = sn; } }
        { unsigned* z = (unsigned*)(F.ws + WS_WINT + (size_t)3360 * 1024); for (size_t i = gt; i < (size_t)224 * 256; i += NGT_) z[i] = 0u;
          for (size_t i = gt; i < 224; i += NGT_) WSP(float, WS_SBW)[3360 + i] = 0.f; }
        { const float* wg = IN_F(20); const float* we = IN_F(22); _Float16* RWT = WSP(_Float16, WS_RWT);
          for (size_t i = gt; i < 48 * 1024; i += NGT_) { const int n = (int)(i >> 10), k = (int)(i & 1023);
              const float w = n < 4 ? wg[k * 4 + n] : n < 36 ? we[k * 32 + n - 4] : 0.f; RWT[i] = (_Float16)w; } }
        { bf16_t* kc = WSP(bf16_t, WS_KCMP); bf16_t* vc = WSP(bf16_t, WS_VCMP);
          for (size_t i = gt; i < 16 * 64; i += NGT_) { const size_t o = ((i >> 6) * 256 + 255) * 64 + (i & 63); kc[o] = 0; vc[o] = 0; } }
    }
    __syncthreads();
    if (F.vcu >= F.G - 16) {
        const int bi = F.vcu - (F.G - 16), kv = bi >> 3, cg = bi & 7;
        const float* pe = IN_F(kv == 0 ? 13 : 16); const float* w1 = IN_F(kv == 0 ? 14 : 17);
        LAS float* red = (LAS float*)F.lds;
        const int col = cg * 16 + (tid & 15), sl = tid >> 4; float sacc = 0.f;
#pragma unroll 8
        for (int k = sl * 64; k < sl * 64 + 64; ++k) sacc += pe[k] * w1[(size_t)k * 128 + col];
        red[tid] = sacc; __syncthreads();
        if (tid < 16) { float t2 = 0.f; for (int q = 0; q < 32; ++q) t2 += red[q * 16 + tid]; WSP(float, WS_C1B)[kv * 128 + cg * 16 + tid] = t2; }
    }
    __syncthreads();
}

__device__ __forceinline__ void p1a_phase(Frame& F) {
    const int gw = F.vcu * NWAVES + F.wave, NGW = F.G * NWAVES, lane = F.lane;
    const float* x = IN_F(0); const float* nw = IN_F(5); const float* mod = WSP(float, WS_MOD); signed char* H1Q = (signed char*)(F.ws + WS_H1);
    for (int row0 = gw * 4; row0 < NTOK; row0 += NGW * 4) {
        f32x4 v[4][4]; float ss[4];
#pragma unroll
        for (int r = 0; r < 4; ++r) { const f32x4* xr = (const f32x4*)(x + (size_t)(row0 + r) * DM) + lane;
#pragma unroll
            for (int j = 0; j < 4; ++j) v[r][j] = __builtin_nontemporal_load(xr + 64 * j); }
#pragma unroll
        for (int r = 0; r < 4; ++r) { float a = 0.f;
#pragma unroll
            for (int j = 0; j < 4; ++j) a += v[r][j][0] * v[r][j][0] + v[r][j][1] * v[r][j][1] + v[r][j][2] * v[r][j][2] + v[r][j][3] * v[r][j][3];
            ss[r] = a; }
#pragma unroll
        for (int o = 1; o < 64; o <<= 1) {
#pragma unroll
            for (int r = 0; r < 4; ++r) ss[r] += __shfl_xor(ss[r], o); }
        const int b = row0 >> 12; float am[4] = {0.f, 0.f, 0.f, 0.f};
#pragma unroll
        for (int j = 0; j < 4; ++j) { const int k = 4 * lane + 256 * j;
            const f32x4 w = *(const f32x4*)(nw + k), sh = *(const f32x4*)(mod + b * 6144 + k), sc = *(const f32x4*)(mod + b * 6144 + 1024 + k);
            const f32x4 ws = w * (sc + 1.f);
#pragma unroll
            for (int r = 0; r < 4; ++r) { const float rr = rsqrtf(ss[r] * (1.f / DM) + RMS_EPS);
                const f32x4 h = v[r][j] * rr * ws + sh; v[r][j] = h;
                am[r] = fmaxf(am[r], fmaxf(fmaxf(fabsf(h[0]), fabsf(h[1])), fmaxf(fabsf(h[2]), fabsf(h[3])))); } }
#pragma unroll
        for (int o = 1; o < 64; o <<= 1) {
#pragma unroll
            for (int r = 0; r < 4; ++r) am[r] = fmaxf(am[r], __shfl_xor(am[r], o)); }
#pragma unroll
        for (int r = 0; r < 4; ++r) { const float inv = am[r] > 0.f ? 127.f / am[r] : 0.f;
            if (lane == 0) WSP(float, WS_SA1)[row0 + r] = am[r] * (1.f / 127.f);
            u32x4 pk;
#pragma unroll
            for (int j = 0; j < 4; ++j) { const f32x4 q = v[r][j] * inv;
                const int q0 = (int)rintf(q[0]), q1 = (int)rintf(q[1]), q2 = (int)rintf(q[2]), q3 = (int)rintf(q[3]);
                pk[j] = (unsigned)(q0 & 0xff) | ((unsigned)(q1 & 0xff) << 8) | ((unsigned)(q2 & 0xff) << 16) | ((unsigned)(q3 & 0xff) << 24); }
            *(u32x4*)(H1Q + (size_t)(row0 + r) * DM + 256 * (lane & 3) + 16 * (lane >> 2)) = quad_transpose(pk, lane); }
    }
}

__device__ __forceinline__ void conv_silu16(const bf16_t* src  , const float* cw  , int b, int s, int ch0  , float scale, float (&o)[16]) {
#pragma unroll
    for (int i = 0; i < 16; ++i) o[i] = 0.f;
#pragma unroll
    for (int j = 0; j < 4; ++j) { const int ss = s - 3 + j;
        if (ss >= 0) { const bf16_t* rp = src + ((size_t)b * SEQ + ss) * 512 + ch0;
            const u32x4 a = *(const u32x4*)rp, c = *(const u32x4*)(rp + 8);
            const float* w = cw + j * 1024;
            const f32x4 w0 = *(const f32x4*)w, w1 = *(const f32x4*)(w + 4), w2 = *(const f32x4*)(w + 8), w3 = *(const f32x4*)(w + 12);
            o[0] += bflo(a.x) * w0[0]; o[1] += bfhi(a.x) * w0[1]; o[2] += bflo(a.y) * w0[2]; o[3] += bfhi(a.y) * w0[3];
            o[4] += bflo(a.z) * w1[0]; o[5] += bfhi(a.z) * w1[1]; o[6] += bflo(a.w) * w1[2]; o[7] += bfhi(a.w) * w1[3];
            o[8] += bflo(c.x) * w2[0]; o[9] += bfhi(c.x) * w2[1]; o[10] += bflo(c.y) * w2[2]; o[11] += bfhi(c.y) * w2[3];
            o[12] += bflo(c.z) * w3[0]; o[13] += bfhi(c.z) * w3[1]; o[14] += bflo(c.w) * w3[2]; o[15] += bfhi(c.w) * w3[3]; } }
#pragma unroll
    for (int i = 0; i < 16; ++i) o[i] = silu_f(o[i]) * scale;
}
constexpr int RAWS = 272, RAWIMG = 67 * RAWS + 208;
__device__ __forceinline__ void stage_raw(const bf16_t* src, int b, int s0, int h, LAS unsigned char* RAW, int tid) {
    const int s = tid >> 3, chg = tid & 7;
    const bf16_t* rp = src + ((size_t)b * SEQ + s0 + s) * 512 + h * 128 + chg * 16;
    *(LAS u32x4*)(RAW + (s + 3) * RAWS + chg * 32) = *(const u32x4*)rp; *(LAS u32x4*)(RAW + (s + 3) * RAWS + chg * 32 + 16) = *(const u32x4*)(rp + 8);
    if (s < 3) { u32x4 a = {0u, 0u, 0u, 0u}, c = a; const int ss = s0 - 3 + s;
        if (ss >= 0) { const bf16_t* hp = src + ((size_t)b * SEQ + ss) * 512 + h * 128 + chg * 16; a = *(const u32x4*)hp; c = *(const u32x4*)(hp + 8); }
        *(LAS u32x4*)(RAW + s * RAWS + chg * 32) = a; *(LAS u32x4*)(RAW + s * RAWS + chg * 32 + 16) = c; }
}
__device__ __forceinline__ void conv_lds16(LAS const unsigned char* RAW, LAS const float* WL, int s, int ch0, float scale, float (&o)[16]) {
#pragma unroll
    for (int i = 0; i < 16; ++i) o[i] = 0.f;
#pragma unroll
    for (int j = 0; j < 4; ++j) { const u32x4 a = *(LAS const u32x4*)(RAW + (s + j) * RAWS + ch0 * 2), c = *(LAS const u32x4*)(RAW + (s + j) * RAWS + ch0 * 2 + 16);
        const LAS float* w = WL + j * 128 + ch0;
        const f32x4 w0 = *(LAS const f32x4*)w, w1 = *(LAS const f32x4*)(w + 4), w2 = *(LAS const f32x4*)(w + 8), w3 = *(LAS const f32x4*)(w + 12);
        o[0] += bflo(a.x) * w0[0]; o[1] += bfhi(a.x) * w0[1]; o[2] += bflo(a.y) * w0[2]; o[3] += bfhi(a.y) * w0[3];
        o[4] += bflo(a.z) * w1[0]; o[5] += bfhi(a.z) * w1[1]; o[6] += bflo(a.w) * w1[2]; o[7] += bfhi(a.w) * w1[3];
        o[8] += bflo(c.x) * w2[0]; o[9] += bfhi(c.x) * w2[1]; o[10] += bflo(c.y) * w2[2]; o[11] += bfhi(c.y) * w2[3];
        o[12] += bflo(c.z) * w3[0]; o[13] += bfhi(c.z) * w3[1]; o[14] += bflo(c.w) * w3[2]; o[15] += bfhi(c.w) * w3[3]; }
#pragma unroll
    for (int i = 0; i < 16; ++i) o[i] = silu_f(o[i]) * scale;
}
constexpr int TRT = 4096 + 64, RCH = 1024 + 16;
constexpr int TRIMG = 4 * TRT, ROWIMG = 16 * RCH;
__device__ __forceinline__ unsigned tr_lane_off(int lane) { const int hi = lane >> 5; return ((lane >> 4) & 1) * 32 + (lane & 3) * 8 + (4 * hi + ((lane & 15) >> 2)) * 64; }

#if DBG_CHECK == 2
#define DBGF(code, val) do { const float _v = (val); if ((__float_as_uint(_v) & 0x7f800000u) == 0x7f800000u) atomicMin((unsigned*)(F.ws + WS_CTL) + CW_DBG, (unsigned)(code)); } while (0)
#else
#define DBGF(code, val) do {} while (0)
#endif
struct MaPF { u32x4 k0, k1, v0, v1, hk0, hk1; float wk, g0, g1; };
__device__ __forceinline__ void mlstm_a_load(Frame& F, int job, int tid, MaPF& pf) {
    const int lane = tid & 63, w = F.wave;
    const int bh = job >> 6, c = job & 63, b = bh >> 2, h = bh & 3, s0 = c * 64, s = tid >> 3, chg = tid & 7;
    const size_t ro = ((size_t)b * SEQ + s0 + s) * 512 + h * 128 + chg * 16;
    const bf16_t* kp = WSP(bf16_t, WS_MK) + ro; const bf16_t* vp = WSP(bf16_t, WS_MV) + ro;
    pf.k0 = *(const u32x4*)kp; pf.k1 = *(const u32x4*)(kp + 8); pf.v0 = *(const u32x4*)vp; pf.v1 = *(const u32x4*)(vp + 8);
    pf.hk0 = (u32x4){0u, 0u, 0u, 0u}; pf.hk1 = pf.hk0;
    if (s < 3 && s0 - 3 + s >= 0) { const bf16_t* hp = WSP(bf16_t, WS_MK) + ((size_t)b * SEQ + s0 - 3 + s) * 512 + h * 128 + chg * 16; pf.hk0 = *(const u32x4*)hp; pf.hk1 = *(const u32x4*)(hp + 8); }
    pf.wk = IN_F(10)[(tid >> 7) * 1024 + 512 + h * 128 + (tid & 127)];
    pf.g0 = 0.f; pf.g1 = 0.f;
    if (w == 0) { pf.g0 = WSP(float, WS_GF)[(size_t)bh * SEQ + s0 + lane]; pf.g1 = WSP(float, WS_GI)[(size_t)bh * SEQ + s0 + lane]; }
}
__device__ __forceinline__ void mlstm_a_phase(Frame& F) {
    int tid = F.tid; asm volatile("" : "+v"(tid));
    const int lane = tid & 63, w = F.wave, r32 = lane & 31, hi = lane >> 5;
    LAS unsigned char* kimg = F.lds; LAS unsigned char* vimg = F.lds + TRIMG; LAS float* wS = (LAS float*)(F.lds + 2 * TRIMG);
    LAS unsigned char* RAWK = F.lds + 2 * TRIMG + 1024; LAS float* WLK = (LAS float*)(RAWK + RAWIMG);
    LAS bf16_t* OST = (LAS bf16_t*)(F.lds + 2 * TRIMG + 1024 + RAWIMG + 2048) + w * 2048;
    MaPF pf; int job = F.vcu;
    if (job < 2048) mlstm_a_load(F, job, tid, pf);
    for (; job < 2048; job += F.G) {
        {
            const int s = tid >> 3, chg = tid & 7;
            *(LAS u32x4*)(RAWK + (s + 3) * RAWS + chg * 32) = pf.k0; *(LAS u32x4*)(RAWK + (s + 3) * RAWS + chg * 32 + 16) = pf.k1;
            if (s < 3) { *(LAS u32x4*)(RAWK + s * RAWS + chg * 32) = pf.hk0; *(LAS u32x4*)(RAWK + s * RAWS + chg * 32 + 16) = pf.hk1; }
            WLK[tid] = pf.wk;
            if (w == 0) {
                float bs = pf.g0;
#pragma unroll
                for (int o = 1; o < 64; o <<= 1) { const float x = __shfl_up(bs, o); if (lane >= o) bs += x; }
                const float g = __shfl(bs, 63);
                const float a = g - bs + pf.g1; const float ml = wave_max(a);
                wS[lane] = __expf(a - ml);
                if (lane == 0) { WSP(float, WS_GSUM)[job] = g; WSP(float, WS_MLOC)[job] = ml; }
            }
        }
        const u32x4 va = pf.v0, vd = pf.v1;
        __syncthreads();
        if (job + F.G < 2048) mlstm_a_load(F, job + F.G, tid, pf);
        {
            const int s = tid >> 3, chg = tid & 7, ch0 = chg * 16;
            float kf[16]; conv_lds16(RAWK, WLK, s, ch0, 0.08838834764831845f, kf);
            const unsigned off = (ch0 >> 5) * TRT + s * 64 + (ch0 & 31) * 2;
            u32x4 k0, k1; k0.x = cvtpk(kf[0], kf[1]); k0.y = cvtpk(kf[2], kf[3]); k0.z = cvtpk(kf[4], kf[5]); k0.w = cvtpk(kf[6], kf[7]);
            k1.x = cvtpk(kf[8], kf[9]); k1.y = cvtpk(kf[10], kf[11]); k1.z = cvtpk(kf[12], kf[13]); k1.w = cvtpk(kf[14], kf[15]);
            *(LAS u32x4*)(kimg + off) = k0; *(LAS u32x4*)(kimg + off + 16) = k1;
            const float ws = wS[s];
            u32x4 v0, v1;
            v0.x = cvtpk(bflo(va.x) * ws, bfhi(va.x) * ws); v0.y = cvtpk(bflo(va.y) * ws, bfhi(va.y) * ws); v0.z = cvtpk(bflo(va.z) * ws, bfhi(va.z) * ws); v0.w = cvtpk(bflo(va.w) * ws, bfhi(va.w) * ws);
            v1.x = cvtpk(bflo(vd.x) * ws, bfhi(vd.x) * ws); v1.y = cvtpk(bflo(vd.y) * ws, bfhi(vd.y) * ws); v1.z = cvtpk(bflo(vd.z) * ws, bfhi(vd.z) * ws); v1.w = cvtpk(bflo(vd.w) * ws, bfhi(vd.w) * ws);
            *(LAS u32x4*)(vimg + off) = v0; *(LAS u32x4*)(vimg + off + 16) = v1;
        }
        __syncthreads();
        {
            const int et = w >> 1, dt0 = 2 * (w & 1); const unsigned lo = tr_lane_off(lane);
            f32x16 acc0 = {0}, acc1 = {0};
#pragma unroll
            for (int ks = 0; ks < 4; ++ks) {
                const bf16x8 a = mk8(vtr(vimg + et * TRT + ks * 1024 + lo), vtr(vimg + et * TRT + ks * 1024 + lo + 512));
                const bf16x8 b0 = mk8(vtr(kimg + dt0 * TRT + ks * 1024 + lo), vtr(kimg + dt0 * TRT + ks * 1024 + lo + 512));
                const bf16x8 b1 = mk8(vtr(kimg + (dt0 + 1) * TRT + ks * 1024 + lo), vtr(kimg + (dt0 + 1) * TRT + ks * 1024 + lo + 512));
                acc0 = MFMA32(a, b0, acc0); acc1 = MFMA32(a, b1, acc1);
            }
#pragma unroll
            for (int r = 0; r < 16; ++r) { const int el = crow(r, hi); OST[el * 64 + r32] = f2bf(acc0[r]); OST[el * 64 + 32 + r32] = f2bf(acc1[r]); }
            asm volatile("s_waitcnt lgkmcnt(0)" ::: "memory");
            bf16_t* dst = WSP(bf16_t, WS_KVC) + (size_t)job * 16384 + (size_t)(et * 32) * 128 + dt0 * 32;
#pragma unroll
            for (int i = 0; i < 4; ++i) { const int rw = i * 8 + (lane >> 3), ch = lane & 7; *(u32x4*)(dst + (size_t)rw * 128 + ch * 8) = *(LAS const u32x4*)(OST + rw * 64 + ch * 8); }
        }
        if (tid < 128) {
            float sacc = 0.f; const int d = tid;
            for (int ss = 0; ss < 64; ++ss) sacc += wS[ss] * bf2f(*(LAS const bf16_t*)(kimg + (d >> 5) * TRT + ss * 64 + (d & 31) * 2));
            WSP(float, WS_NC)[(size_t)job * 128 + d] = sacc;
        }
        __syncthreads();
    }
}

__device__ __forceinline__ void mlstm_scan_job(Frame& F, int job) {
    int tid = F.tid; asm volatile("" : "+v"(tid));
    const int bh = job >> 3, sl = job & 7;
    LAS float* aold = (LAS float*)F.lds; LAS float* anew = aold + 64;
    if (tid == 0) {
        float m = 0.f;
        for (int c = 0; c < 64; ++c) { const float g = WSP(float, WS_GSUM)[bh * 64 + c], ml = WSP(float, WS_MLOC)[bh * 64 + c];
            const float mn = fmaxf(g + m, ml); aold[c] = __expf(g + m - mn); anew[c] = __expf(ml - mn);
            if (sl == 0) WSP(float, WS_MPREV)[bh * 64 + c] = m;
            m = mn; }
    }
    __syncthreads();
    const size_t base = (size_t)bh * 64 * 16384 + (size_t)sl * 2048 + tid * 4;
    const bf16_t* kv = WSP(bf16_t, WS_KVC) + base; bf16_t* cp = WSP(bf16_t, WS_CPREV) + base;
    f32x4 C = {0.f, 0.f, 0.f, 0.f};
#pragma unroll 8
    for (int c = 0; c < 64; ++c) {
        const u32x2 k = *(const u32x2*)(kv + (size_t)c * 16384);
        u32x2 o; o.x = cvtpk(C[0], C[1]); o.y = cvtpk(C[2], C[3]); *(u32x2*)(cp + (size_t)c * 16384) = o;
        const float ao = aold[c], an = anew[c]; DBGF(22, ao); DBGF(23, an); DBGF(24, bflo(k.x)); DBGF(24, bfhi(k.x)); DBGF(24, bflo(k.y)); DBGF(24, bfhi(k.y)); DBGF(25, C[0]);
        C[0] = ao * C[0] + an * bflo(k.x); C[1] = ao * C[1] + an * bfhi(k.x); C[2] = ao * C[2] + an * bflo(k.y); C[3] = ao * C[3] + an * bfhi(k.y);
    }
    if (sl == 0 && tid < 128) {
        float n = 0.f;
        for (int c = 0; c < 64; ++c) { WSP(float, WS_NPREV)[(size_t)(bh * 64 + c) * 128 + tid] = n; n = aold[c] * n + anew[c] * WSP(float, WS_NC)[(size_t)(bh * 64 + c) * 128 + tid]; }
    }
    __syncthreads();
}

struct McPF { u32x4 q0, q1, k0, k1, v0, v1, hq0, hq1, hk0, hk1; float wq, wk, g0, g1, mprev; u32x2 mo[4]; };
__device__ __forceinline__ void mlstm_c_load(Frame& F, int job, int tid, McPF& pf) {
    const int lane = tid & 63, w = F.wave, r32 = lane & 31, hi = lane >> 5;
    const int bh = job >> 6, c = job & 63, b = bh >> 2, h = bh & 3, s0 = c * 64, s = tid >> 3, chg = tid & 7;
    const size_t ro = ((size_t)b * SEQ + s0 + s) * 512 + h * 128 + chg * 16;
    const bf16_t* qp = WSP(bf16_t, WS_MQ) + ro; const bf16_t* kp = WSP(bf16_t, WS_MK) + ro; const bf16_t* vp = WSP(bf16_t, WS_MV) + ro;
    pf.q0 = *(const u32x4*)qp; pf.q1 = *(const u32x4*)(qp + 8); pf.k0 = *(const u32x4*)kp; pf.k1 = *(const u32x4*)(kp + 8); pf.v0 = *(const u32x4*)vp; pf.v1 = *(const u32x4*)(vp + 8);
    pf.hq0 = (u32x4){0u, 0u, 0u, 0u}; pf.hq1 = pf.hq0; pf.hk0 = pf.hq0; pf.hk1 = pf.hq0;
    if (s < 3 && s0 - 3 + s >= 0) { const size_t ho = ((size_t)b * SEQ + s0 - 3 + s) * 512 + h * 128 + chg * 16;
        pf.hq0 = *(const u32x4*)(WSP(bf16_t, WS_MQ) + ho); pf.hq1 = *(const u32x4*)(WSP(bf16_t, WS_MQ) + ho + 8); pf.hk0 = *(const u32x4*)(WSP(bf16_t, WS_MK) + ho); pf.hk1 = *(const u32x4*)(WSP(bf16_t, WS_MK) + ho + 8); }
    pf.wq = IN_F(10)[(tid >> 7) * 1024 + h * 128 + (tid & 127)]; pf.wk = IN_F(10)[(tid >> 7) * 1024 + 512 + h * 128 + (tid & 127)];
    pf.g0 = 0.f; pf.g1 = 0.f;
    if (w == 0) { pf.g0 = WSP(float, WS_GF)[(size_t)bh * SEQ + s0 + lane]; pf.g1 = WSP(float, WS_GI)[(size_t)bh * SEQ + s0 + lane]; }
    if (w == 1) { pf.g0 = WSP(float, WS_NPREV)[(size_t)job * 128 + lane]; pf.g1 = WSP(float, WS_NPREV)[(size_t)job * 128 + 64 + lane]; }
    pf.mprev = WSP(float, WS_MPREV)[job];
    const int tw = w & 1, ew = w >> 1, t = 32 * tw + r32;
    const bf16_t* mo = WSP(bf16_t, WS_MO) + ((size_t)b * SEQ + s0 + t) * 512 + h * 128 + 32 * ew + 4 * hi;
#pragma unroll
    for (int q4 = 0; q4 < 4; ++q4) pf.mo[q4] = *(const u32x2*)(mo + 8 * q4);
}
__device__ __forceinline__ void mlstm_c_phase(Frame& F) {
    int tid = F.tid; asm volatile("" : "+v"(tid));
    const int lane = tid & 63, w = F.wave, r32 = lane & 31, hi = lane >> 5;
    LAS unsigned char* qimg = F.lds; LAS unsigned char* kimg = F.lds + ROWIMG; LAS unsigned char* vimg = F.lds + 2 * ROWIMG;
    LAS float* uS = (LAS float*)(F.lds + 2 * ROWIMG + TRIMG); LAS float* MS = uS + 64; LAS float* bS = uS + 128; LAS float* nS = uS + 192; LAS float* ssq = uS + 320;
    LAS unsigned char* RAWQ = F.lds + 2 * ROWIMG + TRIMG + 4096; LAS unsigned char* RAWK = RAWQ + RAWIMG; LAS float* WLQ = (LAS float*)(RAWK + RAWIMG); LAS float* WLK = WLQ + 512;
    LAS float* HNL = (LAS float*)(F.lds + MISC_OFF + 2048);
    HNL[tid] = IN_F(12)[tid];
    const int tw = w & 1, ew = w >> 1, t = 32 * tw + r32;
    McPF pf;
    int job = F.vcu;
    if (job < 2048) mlstm_c_load(F, job, tid, pf);
    for (; job < 2048; job += F.G) {
        const int bh = job >> 6, c = job & 63, b = bh >> 2, h = bh & 3, s0 = c * 64;
        const float mprev = pf.mprev; u32x2 moc[4];
#pragma unroll
        for (int q4 = 0; q4 < 4; ++q4) moc[q4] = pf.mo[q4];
        {
            const int s = tid >> 3, chg = tid & 7, ch0 = chg * 16;
            *(LAS u32x4*)(RAWQ + (s + 3) * RAWS + chg * 32) = pf.q0; *(LAS u32x4*)(RAWQ + (s + 3) * RAWS + chg * 32 + 16) = pf.q1;
            *(LAS u32x4*)(RAWK + (s + 3) * RAWS + chg * 32) = pf.k0; *(LAS u32x4*)(RAWK + (s + 3) * RAWS + chg * 32 + 16) = pf.k1;
            if (s < 3) { *(LAS u32x4*)(RAWQ + s * RAWS + chg * 32) = pf.hq0; *(LAS u32x4*)(RAWQ + s * RAWS + chg * 32 + 16) = pf.hq1;
                         *(LAS u32x4*)(RAWK + s * RAWS + chg * 32) = pf.hk0; *(LAS u32x4*)(RAWK + s * RAWS + chg * 32 + 16) = pf.hk1; }
            WLQ[tid] = pf.wq; WLK[tid] = pf.wk;
            const unsigned off = (ch0 >> 5) * TRT + s * 64 + (ch0 & 31) * 2;
            *(LAS u32x4*)(vimg + off) = pf.v0; *(LAS u32x4*)(vimg + off + 16) = pf.v1;
            if (w == 0) {
                float bs = pf.g0;
#pragma unroll
                for (int o = 1; o < 64; o <<= 1) { const float x = __shfl_up(bs, o); if (lane >= o) bs += x; }
                const float u = pf.g1 - bs; float cm = u;
#pragma unroll
                for (int o = 1; o < 64; o <<= 1) { const float x = __shfl_up(cm, o); if (lane >= o) cm = fmaxf(cm, x); }
                uS[lane] = u; MS[lane] = fmaxf(mprev, cm); bS[lane] = bs;
            }
            if (w == 1) { nS[lane] = pf.g0; nS[64 + lane] = pf.g1; }
        }
        __syncthreads();
        bf16x8 cf[8];
        { const bf16_t* cp = WSP(bf16_t, WS_CPREV) + (size_t)job * 16384 + (size_t)(32 * ew + r32) * 128 + 8 * hi;
#pragma unroll
          for (int ks = 0; ks < 8; ++ks) cf[ks] = *(const bf16x8*)(cp + 16 * ks); }
        if (job + F.G < 2048) mlstm_c_load(F, job + F.G, tid, pf);
        {
            const int s = tid >> 3, chg = tid & 7, ch0 = chg * 16;
            float qf[16]; conv_lds16(RAWQ, WLQ, s, ch0, 1.f, qf);
            u32x4 q0, q1; q0.x = cvtpk(qf[0], qf[1]); q0.y = cvtpk(qf[2], qf[3]); q0.z = cvtpk(qf[4], qf[5]); q0.w = cvtpk(qf[6], qf[7]);
            q1.x = cvtpk(qf[8], qf[9]); q1.y = cvtpk(qf[10], qf[11]); q1.z = cvtpk(qf[12], qf[13]); q1.w = cvtpk(qf[14], qf[15]);
            *(LAS u32x4*)(qimg + (2 * chg) * RCH + s * 16) = q0; *(LAS u32x4*)(qimg + (2 * chg + 1) * RCH + s * 16) = q1;
            float kf[16]; conv_lds16(RAWK, WLK, s, ch0, 0.08838834764831845f, kf);
            u32x4 k0, k1; k0.x = cvtpk(kf[0], kf[1]); k0.y = cvtpk(kf[2], kf[3]); k0.z = cvtpk(kf[4], kf[5]); k0.w = cvtpk(kf[6], kf[7]);
            k1.x = cvtpk(kf[8], kf[9]); k1.y = cvtpk(kf[10], kf[11]); k1.z = cvtpk(kf[12], kf[13]); k1.w = cvtpk(kf[14], kf[15]);
            *(LAS u32x4*)(kimg + (2 * chg) * RCH + s * 16) = k0; *(LAS u32x4*)(kimg + (2 * chg + 1) * RCH + s * 16) = k1;
        }
        __syncthreads();
        const float Mt = MS[t], bt = bS[t];
        const float dec = __expf(mprev - Mt), mt = bt + Mt;
        bf16x8 qf[8];
#pragma unroll
        for (int ks = 0; ks < 8; ++ks) qf[ks] = *(LAS const bf16x8*)(qimg + (2 * ks + hi) * RCH + t * 16);
        f32x16 p[2]; p[0] = (f32x16){0}; p[1] = (f32x16){0};
#pragma unroll
        for (int st = 0; st < 2; ++st) {
            if (st <= tw) {
#pragma unroll
                for (int ks = 0; ks < 8; ++ks) { const bf16x8 kf = *(LAS const bf16x8*)(kimg + (2 * ks + hi) * RCH + (32 * st + r32) * 16); p[st] = MFMA32(kf, qf[ks], p[st]); }
            }
        }
        float rs = 0.f;
#pragma unroll
        for (int st = 0; st < 2; ++st)
#pragma unroll
            for (int r = 0; r < 16; ++r) { const int s = 32 * st + crow(r, hi);
                const float wv = (s <= t) ? __expf(uS[s] - Mt) * p[st][r] : 0.f; p[st][r] = wv; rs += wv; }
        rs += __shfl_xor(rs, 32);
        float qn = 0.f;
#pragma unroll
        for (int ks = 0; ks < 8; ++ks)
#pragma unroll
            for (int j = 0; j < 8; ++j) qn += bf2f((bf16_t)qf[ks][j]) * nS[16 * ks + 8 * hi + j];
        qn += __shfl_xor(qn, 32);
        const float den = rs + dec * qn;
        const float hden = fmaxf(fabsf(den), __expf(-mt));
        f32x16 ai = {0}, ae = {0};
        const unsigned lo = tr_lane_off(lane);
#pragma unroll
        for (int st = 0; st < 2; ++st) {
            if (st <= tw) {
#pragma unroll
                for (int s2 = 0; s2 < 2; ++s2) { const int ks = 2 * st + s2;
                    const bf16x8 vf = mk8(vtr(vimg + ew * TRT + ks * 1024 + lo), vtr(vimg + ew * TRT + ks * 1024 + lo + 512));
                    u32x4 pw; pw.x = cvtpk(p[st][8 * s2 + 0], p[st][8 * s2 + 1]); pw.y = cvtpk(p[st][8 * s2 + 2], p[st][8 * s2 + 3]); pw.z = cvtpk(p[st][8 * s2 + 4], p[st][8 * s2 + 5]); pw.w = cvtpk(p[st][8 * s2 + 6], p[st][8 * s2 + 7]);
                    ai = MFMA32(vf, __builtin_bit_cast(bf16x8, pw), ai); }
            }
        }
#pragma unroll
        for (int ks = 0; ks < 8; ++ks) ae = MFMA32(cf[ks], qf[ks], ae);
        float hv[16]; float ss = 0.f; const float rden = 1.f / hden;
#pragma unroll
        for (int r = 0; r < 16; ++r) { hv[r] = (ai[r] + dec * ae[r]) * rden; ss += hv[r] * hv[r]; }
        ss += __shfl_xor(ss, 32);
        if (hi == 0) ssq[ew * 64 + t] = ss;
        __syncthreads();
        const float tot = ssq[t] + ssq[64 + t] + ssq[128 + t] + ssq[192 + t];
        const float rn = rsqrtf(tot * (1.f / 128.f) + RMS_EPS);
        LAS const float* hn = HNL + h * 128 + 32 * ew;
        bf16_t* yo = WSP(bf16_t, WS_YCAT) + ((size_t)b * SEQ + s0 + t) * 1024 + h * 128 + 32 * ew;
#pragma unroll
        for (int p2 = 0; p2 < 2; ++p2) { u32x2 ov[2];
#pragma unroll
            for (int e = 0; e < 2; ++e) { const int q4 = 2 * p2 + e; const int e0 = 8 * q4 + 4 * hi;
                const u32x2 om = moc[q4]; const f32x4 wn = *(LAS const f32x4*)(hn + e0);
                const float y0 = hv[4 * q4 + 0] * rn * wn[0] * sigmoid_f(bflo(om.x)), y1 = hv[4 * q4 + 1] * rn * wn[1] * sigmoid_f(bfhi(om.x));
                const float y2 = hv[4 * q4 + 2] * rn * wn[2] * sigmoid_f(bflo(om.y)), y3 = hv[4 * q4 + 3] * rn * wn[3] * sigmoid_f(bfhi(om.y));
                ov[e].x = cvtpk(y0, y1); ov[e].y = cvtpk(y2, y3); }
            *(u32x4*)(yo + 16 * p2 + 8 * hi) = widen_pair(ov[0], ov[1]); }
        __syncthreads();
    }
}

__device__ __forceinline__ void compress_job(Frame& F, int job) {
    int lane = F.lane; asm volatile("" : "+v"(lane));
    const int w = F.wave, r32 = lane & 31, hi = lane >> 5;
    const int kv = job >> 7, bg = (job >> 3) & 15, i0 = (job & 7) * 32;
    const bf16_t* X = WSP(bf16_t, kv ? WS_VC : WS_KC) + (size_t)bg * SEQ * 64;
    const bf16_t* W1 = WSP(bf16_t, kv ? WS_CW1V : WS_CW1K); const bf16_t* W2 = WSP(bf16_t, kv ? WS_CW2V : WS_CW2K);
    const float* c1 = WSP(float, WS_C1B) + kv * 128;
    bf16_t* O = WSP(bf16_t, kv ? WS_VCMP : WS_KCMP) + (size_t)bg * 256 * 64;
    LAS unsigned char* himg = F.lds;
    LAS float* part = (LAS float*)(F.lds + ROWIMG);
    const int nt = w & 3, kh = w >> 2;
    f32x16 acc = {0};
    {
        int i = i0 + r32; if (i > 254) i = 254;
        const bf16_t* ap = X + (size_t)i * 1024 + kh * 1024 + 8 * hi; const bf16_t* bp = W1 + (size_t)(32 * nt + r32) * 2048 + kh * 1024 + 8 * hi;
#pragma unroll 16
        for (int ks = 0; ks < 64; ++ks) { const bf16x8 a = *(const bf16x8*)(ap + 16 * ks), bb = *(const bf16x8*)(bp + 16 * ks); acc = MFMA32(a, bb, acc); }
    }
    if (kh == 1) {
#pragma unroll
        for (int r = 0; r < 16; ++r) part[(nt * 16 + r) * 64 + lane] = acc[r];
    }
    __syncthreads();
    if (kh == 0) {
        const int n = 32 * nt + r32; const float cb = c1[n];
#pragma unroll
        for (int r = 0; r < 16; ++r) { const int rowl = crow(r, hi); const float v = acc[r] + part[(nt * 16 + r) * 64 + lane] + cb;
            *(LAS bf16_t*)(himg + (n >> 3) * RCH + rowl * 16 + (n & 7) * 2) = f2bf(silu_f(v)); }
    }
    __syncthreads();
    if (w < 2) {
        f32x16 a2 = {0};
#pragma unroll
        for (int ks = 0; ks < 8; ++ks) { const bf16x8 a = *(LAS const bf16x8*)(himg + (2 * ks + hi) * RCH + r32 * 16);
            const bf16x8 bb = *(const bf16x8*)(W2 + (size_t)(32 * w + r32) * 128 + 16 * ks + 8 * hi); a2 = MFMA32(a, bb, a2); }
#pragma unroll
        for (int r = 0; r < 16; ++r) { const int i = i0 + crow(r, hi); if (i < 255) O[(size_t)i * 64 + 32 * w + r32] = f2bf(a2[r]); }
    }
    __syncthreads();
}

constexpr int NSA_KCH = 1024 + 16, NSA_VDH = 4096 + 64, NSA_KIMG = 8 * NSA_KCH, NSA_VIMG = 2 * NSA_VDH, NSA_BUF = NSA_KIMG + NSA_VIMG;
constexpr int NSA_IMP = 2 * NSA_BUF, NSA_IST = 65, NSA_TOT = NSA_IMP + 256 * NSA_IST * 4,
              NSA_SELB = MISC_OFF + 1024, NSA_UNI = NSA_SELB + 512;
constexpr int NSA_FAC = NSA_TOT + 64 * NSA_IST * 4;
constexpr int NSA_STASH = 96 * 1024;
static_assert(4 * NSA_BUF <= NSA_STASH && NSA_FAC + 4096 <= MISC_OFF && NSA_STASH + 8 * 4096 <= MISC_OFF, "NSA LDS map");

__device__ __forceinline__ void nsa_qk(LAS const unsigned char* kimg, const bf16x8 (&qr)[4], unsigned kfo, f32x16& p0, f32x16& p1) {
    bf16x8 kf[8];
#pragma unroll
    for (int d0 = 0; d0 < 4; ++d0) { kf[2 * d0] = *(LAS const bf16x8*)(kimg + kfo + d0 * (2 * NSA_KCH)); kf[2 * d0 + 1] = *(LAS const bf16x8*)(kimg + kfo + d0 * (2 * NSA_KCH) + 512); }
    __builtin_amdgcn_sched_barrier(0);
    p0 = (f32x16){0}; p1 = (f32x16){0};
#pragma unroll
    for (int d0 = 0; d0 < 4; ++d0) { p0 = MFMA32(kf[2 * d0], qr[d0], p0); p1 = MFMA32(kf[2 * d0 + 1], qr[d0], p1); }
}
constexpr float NSA_THR = 8.f;
template <int KIND>
__device__ __forceinline__ void nsa_tile(LAS const unsigned char* kimg, LAS const unsigned char* vimg, const bf16x8 (&qr)[4], int kbase, int t, bool edge, bool rowvalid,
                                         float& m, float& l, f32x16& o0, f32x16& o1, unsigned kfo, unsigned vfo, int hi) {
    f32x16 p0, p1; nsa_qk(kimg, qr, kfo, p0, p1);
    if (edge) {
#pragma unroll
        for (int r = 0; r < 16; ++r) { const int k0 = kbase + crow(r, hi), k1 = k0 + 32; bool v0, v1;
            if (KIND == 1) { v0 = k0 <= t; v1 = k1 <= t; } else { v0 = k0 <= t && k0 >= t - 511; v1 = k1 <= t && k1 >= t - 511; }
            p0[r] = v0 ? p0[r] : -INFINITY; p1[r] = v1 ? p1[r] : -INFINITY; }
    }
    float mx = fmaxf(p0[0], p1[0]);
#pragma unroll
    for (int r = 1; r < 16; ++r) mx = fmaxf(mx, fmaxf(p0[r], p1[r]));
    mx = rowvalid ? mx : -INFINITY;
    mx = fmaxf(mx, __shfl_xor(mx, 32));
    if (__any(mx - m > NSA_THR)) {
        const float mn = fmaxf(m, mx); const float alpha = ex2(m - mn); m = mn; l *= alpha;
#pragma unroll
        for (int r = 0; r < 16; ++r) { o0[r] *= alpha; o1[r] *= alpha; }
    }
    const float me = rowvalid ? m : INFINITY;
    float rs = 0.f;
#pragma unroll
    for (int r = 0; r < 16; ++r) { p0[r] = ex2(p0[r] - me); p1[r] = ex2(p1[r] - me); rs += p0[r] + p1[r]; }
    l += rs;
    u32x4 pw[4];
#pragma unroll
    for (int s = 0; s < 2; ++s) {
        pw[s].x = cvtpk(p0[8 * s + 0], p0[8 * s + 1]); pw[s].y = cvtpk(p0[8 * s + 2], p0[8 * s + 3]); pw[s].z = cvtpk(p0[8 * s + 4], p0[8 * s + 5]); pw[s].w = cvtpk(p0[8 * s + 6], p0[8 * s + 7]);
        pw[2 + s].x = cvtpk(p1[8 * s + 0], p1[8 * s + 1]); pw[2 + s].y = cvtpk(p1[8 * s + 2], p1[8 * s + 3]); pw[2 + s].z = cvtpk(p1[8 * s + 4], p1[8 * s + 5]); pw[2 + s].w = cvtpk(p1[8 * s + 6], p1[8 * s + 7]);
    }
    bf16x8 vf[8];
#pragma unroll
    for (int ks = 0; ks < 4; ++ks) { vf[2 * ks] = mk8(vtr(vimg + vfo + ks * 1024), vtr(vimg + vfo + ks * 1024 + 512)); vf[2 * ks + 1] = mk8(vtr(vimg + vfo + NSA_VDH + ks * 1024), vtr(vimg + vfo + NSA_VDH + ks * 1024 + 512)); }
    __builtin_amdgcn_sched_barrier(0);
#pragma unroll
    for (int ks = 0; ks < 4; ++ks) { o0 = MFMA32(vf[2 * ks], __builtin_bit_cast(bf16x8, pw[ks]), o0); o1 = MFMA32(vf[2 * ks + 1], __builtin_bit_cast(bf16x8, pw[ks]), o1); }
}

template <int KIND>
__device__ __forceinline__ void nsa_tile2(LAS const unsigned char* kA, LAS const unsigned char* vA, LAS const unsigned char* kB, LAS const unsigned char* vB, bool hasB,
                                          const bf16x8 (&qr)[4], int kbA, int kbB, int t, bool edgeA, bool edgeB, bool rvA, bool rvB,
                                          float& m, float& l, f32x16& o0, f32x16& o1, unsigned kfo, unsigned vfo, int hi) {
    f32x16 a0, a1, b0, b1;
    nsa_qk(kA, qr, kfo, a0, a1);
    __builtin_amdgcn_sched_barrier(0);
    if (hasB) nsa_qk(kB, qr, kfo, b0, b1);
    else {
#pragma unroll
        for (int r = 0; r < 16; ++r) { b0[r] = -INFINITY; b1[r] = -INFINITY; } }
    if (edgeA) {
#pragma unroll
        for (int r = 0; r < 16; ++r) { const int k0 = kbA + crow(r, hi), k1 = k0 + 32; bool v0, v1;
            if (KIND == 1) { v0 = k0 <= t; v1 = k1 <= t; } else { v0 = k0 <= t && k0 >= t - 511; v1 = k1 <= t && k1 >= t - 511; }
            a0[r] = v0 ? a0[r] : -INFINITY; a1[r] = v1 ? a1[r] : -INFINITY; } }
    if (edgeB) {
#pragma unroll
        for (int r = 0; r < 16; ++r) { const int k0 = kbB + crow(r, hi), k1 = k0 + 32; bool v0, v1;
            if (KIND == 1) { v0 = k0 <= t; v1 = k1 <= t; } else { v0 = k0 <= t && k0 >= t - 511; v1 = k1 <= t && k1 >= t - 511; }
            b0[r] = v0 ? b0[r] : -INFINITY; b1[r] = v1 ? b1[r] : -INFINITY; } }
    __builtin_amdgcn_sched_barrier(0);
    const bool fresh = m < -1e29f; const float mb = fresh ? 0.f : m;
    const float meA = rvA ? mb : INFINITY, meB = rvB ? mb : INFINITY;
#pragma unroll
    for (int r = 0; r < 16; ++r) { a0[r] -= meA; a1[r] -= meA; b0[r] -= meB; b1[r] -= meB; }
    float mx = fmaxf(fmaxf(a0[0], a1[0]), fmaxf(b0[0], b1[0]));
#pragma unroll
    for (int r = 1; r < 16; ++r) mx = fmaxf(mx, fmaxf(fmaxf(a0[r], a1[r]), fmaxf(b0[r], b1[r])));
    mx = fmaxf(mx, __shfl_xor(mx, 32));
    const bool has = mx > -INFINITY;
    const float delta = fresh ? (has ? mx : 0.f) : (mx > NSA_THR ? mx : 0.f);
    if (__any(delta != 0.f)) {
        const float alpha = fresh ? 1.f : ex2(-delta); l *= alpha;
#pragma unroll
        for (int r = 0; r < 16; ++r) { o0[r] *= alpha; o1[r] *= alpha; a0[r] -= delta; a1[r] -= delta; b0[r] -= delta; b1[r] -= delta; }
    }
    m = fresh ? (has ? mx : m) : m + delta;
    float rs = 0.f;
#pragma unroll
    for (int r = 0; r < 16; ++r) { a0[r] = ex2(a0[r]); a1[r] = ex2(a1[r]); b0[r] = ex2(b0[r]); b1[r] = ex2(b1[r]); rs += (a0[r] + a1[r]) + (b0[r] + b1[r]); }
    l += rs;
    __builtin_amdgcn_sched_barrier(0);
    {
        u32x4 pw[4];
#pragma unroll
        for (int s = 0; s < 2; ++s) {
            pw[s].x = cvtpk(a0[8 * s + 0], a0[8 * s + 1]); pw[s].y = cvtpk(a0[8 * s + 2], a0[8 * s + 3]); pw[s].z = cvtpk(a0[8 * s + 4], a0[8 * s + 5]); pw[s].w = cvtpk(a0[8 * s + 6], a0[8 * s + 7]);
            pw[2 + s].x = cvtpk(a1[8 * s + 0], a1[8 * s + 1]); pw[2 + s].y = cvtpk(a1[8 * s + 2], a1[8 * s + 3]); pw[2 + s].z = cvtpk(a1[8 * s + 4], a1[8 * s + 5]); pw[2 + s].w = cvtpk(a1[8 * s + 6], a1[8 * s + 7]); }
        bf16x8 vf[8];
#pragma unroll
        for (int ks = 0; ks < 4; ++ks) { vf[2 * ks] = mk8(vtr(vA + vfo + ks * 1024), vtr(vA + vfo + ks * 1024 + 512)); vf[2 * ks + 1] = mk8(vtr(vA + vfo + NSA_VDH + ks * 1024), vtr(vA + vfo + NSA_VDH + ks * 1024 + 512)); }
        __builtin_amdgcn_sched_barrier(0);
#pragma unroll
        for (int ks = 0; ks < 4; ++ks) { o0 = MFMA32(vf[2 * ks], __builtin_bit_cast(bf16x8, pw[ks]), o0); o1 = MFMA32(vf[2 * ks + 1], __builtin_bit_cast(bf16x8, pw[ks]), o1); }
    }
    __builtin_amdgcn_sched_barrier(0);
    if (hasB) {
        u32x4 pw[4];
#pragma unroll
        for (int s = 0; s < 2; ++s) {
            pw[s].x = cvtpk(b0[8 * s + 0], b0[8 * s + 1]); pw[s].y = cvtpk(b0[8 * s + 2], b0[8 * s + 3]); pw[s].z = cvtpk(b0[8 * s + 4], b0[8 * s + 5]); pw[s].w = cvtpk(b0[8 * s + 6], b0[8 * s + 7]);
            pw[2 + s].x = cvtpk(b1[8 * s + 0], b1[8 * s + 1]); pw[2 + s].y = cvtpk(b1[8 * s + 2], b1[8 * s + 3]); pw[2 + s].z = cvtpk(b1[8 * s + 4], b1[8 * s + 5]); pw[2 + s].w = cvtpk(b1[8 * s + 6], b1[8 * s + 7]); }
        bf16x8 vf[8];
#pragma unroll
        for (int ks = 0; ks < 4; ++ks) { vf[2 * ks] = mk8(vtr(vB + vfo + ks * 1024), vtr(vB + vfo + ks * 1024 + 512)); vf[2 * ks + 1] = mk8(vtr(vB + vfo + NSA_VDH + ks * 1024), vtr(vB + vfo + NSA_VDH + ks * 1024 + 512)); }
        __builtin_amdgcn_sched_barrier(0);
#pragma unroll
        for (int ks = 0; ks < 4; ++ks) { o0 = MFMA32(vf[2 * ks], __builtin_bit_cast(bf16x8, pw[ks]), o0); o1 = MFMA32(vf[2 * ks + 1], __builtin_bit_cast(bf16x8, pw[ks]), o1); }
    }
}

#define NPIN(x) asm volatile("" : "+v"(x))
__device__ __forceinline__ void glds16(const void* g, unsigned lds_base) {
    unsigned sv; asm volatile("s_mov_b32 %0, m0\n\ts_mov_b32 m0, %2\n\ts_nop 0\n\tglobal_load_lds_dwordx4 %1, off\n\ts_mov_b32 m0, %0" : "=&s"(sv) : "v"(g), "s"(lds_base) : "memory"); }
#define NSB() __builtin_amdgcn_sched_barrier(0)
#define NMX3(a, b, c) fmaxf(fmaxf((a), (b)), (c))
__device__ __forceinline__ float nsa_rowmax(const f32x16& p0, const f32x16& p1) {
    float a = NMX3(p0[0], p0[1], p1[0]), b = NMX3(p0[2], p0[3], p1[1]); a = NMX3(a, p1[2], p1[3]);
#pragma unroll
    for (int r = 4; r < 16; r += 4) { a = NMX3(a, p0[r], p0[r + 1]); b = NMX3(b, p0[r + 2], p0[r + 3]); a = NMX3(a, p1[r], p1[r + 1]); b = NMX3(b, p1[r + 2], p1[r + 3]); }
    const float m = fmaxf(a, b); const auto rr = __builtin_amdgcn_permlane32_swap(__float_as_uint(m), __float_as_uint(m), false, false);
    return fmaxf(__uint_as_float(rr[0]), __uint_as_float(rr[1])); }
template <int KIND>
__device__ __forceinline__ void nsa_mask(f32x16& p0, f32x16& p1, int kbase, int t, int hi) {
#pragma unroll
    for (int r = 0; r < 16; ++r) { const int k0 = kbase + crow(r, hi), k1 = k0 + 32; bool v0, v1;
        if (KIND == 1) { v0 = k0 <= t; v1 = k1 <= t; } else { v0 = k0 <= t && k0 >= t - 511; v1 = k1 <= t && k1 >= t - 511; }
        p0[r] = v0 ? p0[r] : -INFINITY; p1[r] = v1 ? p1[r] : -INFINITY; } }
template <int KIND>
__device__ __forceinline__ void nsa_pipe(LAS unsigned char* L, const bf16_t* Kp, const bf16_t* Vp, unsigned mlo, unsigned mhi, unsigned sel0, unsigned sel1,
                                         const bf16x8 (&qr)[4], int t, int lane, int w, int hi, unsigned kfo, unsigned vfo,
                                         float& lsum, f32x16& o0, f32x16& o1) {
    unsigned ulo = mlo, uhi = mhi;
    const bf16_t* ksrc = Kp + lane * 64 + w * 8; const bf16_t* vsrc = Vp + (16 * (w & 3) + (lane >> 2)) * 64 + (w >> 2) * 32 + (lane & 3) * 8;
    const unsigned kdst = (unsigned)(uintptr_t)L + w * NSA_KCH, vdst = (unsigned)(uintptr_t)L + NSA_KIMG + (w >> 2) * NSA_VDH + (w & 3) * 1024;
#define NP_DMA(j, sl) do { glds16(ksrc + (size_t)(j) * 4096, (unsigned)__builtin_amdgcn_readfirstlane(kdst + (sl) * NSA_BUF)); glds16(vsrc + (size_t)(j) * 4096, (unsigned)__builtin_amdgcn_readfirstlane(vdst + (sl) * NSA_BUF)); } while (0)
#define NP_DMAWAIT() asm volatile("s_waitcnt vmcnt(0)" ::: "memory")
    const int n = __builtin_popcount(ulo) + __builtin_popcount(uhi);
#define NP_NEXT(jv) do { jv = -1; if (ulo | uhi) { jv = ulo ? __builtin_ctz(ulo) : 32 + __builtin_ctz(uhi); if (ulo) ulo &= ulo - 1; else uhi &= uhi - 1; } } while (0)
#define NP_SELBIT(j) ((((j) < 32 ? (sel0 >> ((j) & 31)) : (sel1 >> (((j) - 32) & 31))) & 1u) != 0u)
#define NP_KIMG(sl) (L + (sl) * NSA_BUF)
#define NP_VIMG(sl) (L + (sl) * NSA_BUF + NSA_KIMG)
    int jc, jn1, jn2;
    NP_NEXT(jc); NP_NEXT(jn1); NP_NEXT(jn2);
    NP_DMA(jc, 0); if (jn1 >= 0) NP_DMA(jn1, 1); if (jn2 >= 0) NP_DMA(jn2, 2);
    NP_DMAWAIT();
    __syncthreads();
    float m = -1e30f, cin = 0.f, l = 0.f, fsc = 1.f; bool resc = false;
    o0 = (f32x16){0}; o1 = (f32x16){0};
    f32x16 pA0, pA1, pB0, pB1, ci16; bf16x8 kf[8]; s16x4 vlo[8], vhi[8]; u32x4 pw0, pw1, pw2, pw3;
#define NP_KLOAD2(sl, d0) do { kf[2 * (d0)] = *(LAS const bf16x8*)(NP_KIMG(sl) + kfo + (d0) * (2 * NSA_KCH)); kf[2 * (d0) + 1] = *(LAS const bf16x8*)(NP_KIMG(sl) + kfo + (d0) * (2 * NSA_KCH) + 512); } while (0)
#define NP_SPLAT(v) do { _Pragma("unroll") for (int r = 0; r < 16; ++r) ci16[r] = (v); } while (0)
#define NP_CINIT(jt) do { if (KIND == 1) { const float c_ = NP_SELBIT(jt) ? cin : -INFINITY; NP_SPLAT(c_); } } while (0)
#define NP_DECIDE(C0, C1) do { const float rm_ = nsa_rowmax(C0, C1); const bool fresh_ = m < -1e29f; \
        const bool grow_ = fresh_ ? (rm_ > -INFINITY) : (rm_ > NSA_THR); resc = false; \
        if (__any(grow_)) { const float dl_ = grow_ ? rm_ : 0.f; fsc = (grow_ && !fresh_) ? ex2(-rm_) : 1.f; m = grow_ ? (fresh_ ? rm_ : m + rm_) : m; cin = grow_ ? -m : cin; l *= fsc; resc = true; \
            _Pragma("unroll") for (int r = 0; r < 16; ++r) { C0[r] -= dl_; C1[r] -= dl_; } \
            if (KIND == 2) NP_SPLAT(cin); } } while (0)
    { _Pragma("unroll") for (int d0 = 0; d0 < 4; ++d0) NP_KLOAD2(0, d0);
      if (KIND == 2) NP_SPLAT(0.f); else NP_CINIT(jc);
      NSB();
      pA0 = MFMA32(kf[0], qr[0], ci16); pA1 = MFMA32(kf[1], qr[0], ci16);
      _Pragma("unroll") for (int d0 = 1; d0 < 4; ++d0) { pA0 = MFMA32(kf[2 * d0], qr[d0], pA0); pA1 = MFMA32(kf[2 * d0 + 1], qr[d0], pA1); }
      nsa_mask<KIND>(pA0, pA1, 64 * jc, t, hi);
      NP_DECIDE(pA0, pA1);
      _Pragma("unroll") for (int r = 0; r < 16; ++r) { pA0[r] = ex2(pA0[r]); pA1[r] = ex2(pA1[r]); }
      if (jn1 >= 0) { _Pragma("unroll") for (int d0 = 0; d0 < 4; ++d0) NP_KLOAD2(1, d0); }
      jc = jn1; jn1 = jn2; NP_NEXT(jn2); }
    int s = 1;
#define NP_PKW(P, i) cvtpk(P[i], P[(i) + 1])
#define NP_VFR(i) mk8(vlo[i], vhi[i])
#define NP_VRD(i) do { LAS const unsigned char* a_ = vp_ + ((i) >> 1) * 1024 + ((i) & 1) * NSA_VDH; vlo[i] = vtr(a_); vhi[i] = vtr(a_ + 512); } while (0)
#define NP_GAPA(MF, a0, a1, a2, a3, W0, W1, PW) do { MF; sacc += a0; sacc += a1; sacc += a2; sacc += a3; W0; W1; NPIN(PW); NPIN(sacc); NSB(); } while (0)
#define NP_GAPB(MF, X, i) do { MF; X[i] = ex2(X[i]); X[(i) + 1] = ex2(X[(i) + 1]); X[(i) + 2] = ex2(X[(i) + 2]); X[(i) + 3] = ex2(X[(i) + 3]); NPIN(X); NSB(); } while (0)
#define NP_KRD(GL, d0) do { if (GL) { NP_KLOAD2(sn_, d0); NSB(); } } while (0)
#define NP_STEP(C0, C1, P0, P1, LAST) do { NSB(); \
    const int sp_ = (s - 1) & 3, sn_ = (s + 1) & 3, sw_ = (s + 2) & 3; \
    if (!(LAST) && jn2 >= 0) NP_DMA(jn2, sw_);     \
    LAS const unsigned char* vp_ = NP_VIMG(sp_) + vfo; \
    NP_CINIT(jc); \
    float sacc = P0[0] + P0[1]; NSB(); \
    NP_GAPA(C0 = MFMA32(kf[0], qr[0], ci16), P0[2], P0[3], P0[4], P0[5],     pw0[0] = NP_PKW(P0, 0),  pw0[1] = NP_PKW(P0, 2),  pw0); \
    NP_GAPA(C1 = MFMA32(kf[1], qr[0], ci16), P0[6], P0[7], P0[8], P0[9],     pw0[2] = NP_PKW(P0, 4),  pw0[3] = NP_PKW(P0, 6),  pw0); \
    NP_GAPA(C0 = MFMA32(kf[2], qr[1], C0),            P0[10], P0[11], P0[12], P0[13], pw1[0] = NP_PKW(P0, 8),  pw1[1] = NP_PKW(P0, 10), pw1); \
    NP_GAPA(C1 = MFMA32(kf[3], qr[1], C1),            P0[14], P0[15], P1[0], P1[1],   pw1[2] = NP_PKW(P0, 12), pw1[3] = NP_PKW(P0, 14), pw1); \
    NP_GAPA(C0 = MFMA32(kf[4], qr[2], C0),            P1[2], P1[3], P1[4], P1[5],     pw2[0] = NP_PKW(P1, 0),  pw2[1] = NP_PKW(P1, 2),  pw2); \
    NP_GAPA(C1 = MFMA32(kf[5], qr[2], C1),            P1[6], P1[7], P1[8], P1[9],     pw2[2] = NP_PKW(P1, 4),  pw2[3] = NP_PKW(P1, 6),  pw2); \
    NP_GAPA(C0 = MFMA32(kf[6], qr[3], C0),            P1[10], P1[11], P1[12], P1[13], pw3[0] = NP_PKW(P1, 8),  pw3[1] = NP_PKW(P1, 10), pw3); \
    NP_GAPA(C1 = MFMA32(kf[7], qr[3], C1),            P1[14], P1[15], 0.f, 0.f,       pw3[2] = NP_PKW(P1, 12), pw3[3] = NP_PKW(P1, 14), pw3); \
    l += sacc; \
    NP_VRD(0); NP_VRD(1); NP_VRD(2); NP_VRD(3); NSB();     \
    if (LAST) nsa_mask<KIND>(C0, C1, 64 * jc, t, hi); \
    NP_DECIDE(C0, C1); NSB(); \
    NP_VRD(4); NSB(); NP_GAPB(o0 = MFMA32(NP_VFR(0), __builtin_bit_cast(bf16x8, pw0), o0), C0, 0); \
    NP_VRD(5); NSB(); NP_GAPB(o1 = MFMA32(NP_VFR(1), __builtin_bit_cast(bf16x8, pw0), o1), C0, 4); \
    NP_VRD(6); NSB(); NP_KRD(!(LAST), 0); NP_GAPB(o0 = MFMA32(NP_VFR(2), __builtin_bit_cast(bf16x8, pw1), o0), C0, 8); \
    NP_VRD(7); NSB(); NP_KRD(!(LAST), 1); NP_GAPB(o1 = MFMA32(NP_VFR(3), __builtin_bit_cast(bf16x8, pw1), o1), C0, 12); \
    NP_KRD(!(LAST), 2); NP_GAPB(o0 = MFMA32(NP_VFR(4), __builtin_bit_cast(bf16x8, pw2), o0), C1, 0); \
    NP_KRD(!(LAST), 3); NP_GAPB(o1 = MFMA32(NP_VFR(5), __builtin_bit_cast(bf16x8, pw2), o1), C1, 4); \
    NP_GAPB(o0 = MFMA32(NP_VFR(6), __builtin_bit_cast(bf16x8, pw3), o0), C1, 8);  NP_GAPB(o1 = MFMA32(NP_VFR(7), __builtin_bit_cast(bf16x8, pw3), o1), C1, 12); \
    NP_DMAWAIT(); \
    __syncthreads(); \
    if (resc) { _Pragma("unroll") for (int r = 0; r < 16; ++r) { o0[r] *= fsc; o1[r] *= fsc; } } \
    jc = jn1; jn1 = jn2; NP_NEXT(jn2); ++s; } while (0)
    int rem = n - 1;
    if (n & 1) { pB0 = pA0; pB1 = pA1; if (rem > 0) { NP_STEP(pA0, pA1, pB0, pB1, false); --rem; } }
    while (rem >= 3) { NP_STEP(pB0, pB1, pA0, pA1, false); NP_STEP(pA0, pA1, pB0, pB1, false); rem -= 2; }
    if (rem == 1) { NP_STEP(pB0, pB1, pA0, pA1, true); }
    { float sacc = pB0[0] + pB0[1];
      _Pragma("unroll") for (int r = 2; r < 16; ++r) sacc += pB0[r];
      _Pragma("unroll") for (int r = 0; r < 16; ++r) sacc += pB1[r];
      l += sacc;
      pw0 = (u32x4){NP_PKW(pB0, 0), NP_PKW(pB0, 2), NP_PKW(pB0, 4), NP_PKW(pB0, 6)}; pw1 = (u32x4){NP_PKW(pB0, 8), NP_PKW(pB0, 10), NP_PKW(pB0, 12), NP_PKW(pB0, 14)};
      pw2 = (u32x4){NP_PKW(pB1, 0), NP_PKW(pB1, 2), NP_PKW(pB1, 4), NP_PKW(pB1, 6)}; pw3 = (u32x4){NP_PKW(pB1, 8), NP_PKW(pB1, 10), NP_PKW(pB1, 12), NP_PKW(pB1, 14)};
      LAS const unsigned char* vp_ = NP_VIMG((n - 1) & 3) + vfo;
      _Pragma("unroll") for (int i = 0; i < 8; ++i) NP_VRD(i);
      NSB();
      o0 = MFMA32(NP_VFR(0), __builtin_bit_cast(bf16x8, pw0), o0); o1 = MFMA32(NP_VFR(1), __builtin_bit_cast(bf16x8, pw0), o1);
      o0 = MFMA32(NP_VFR(2), __builtin_bit_cast(bf16x8, pw1), o0); o1 = MFMA32(NP_VFR(3), __builtin_bit_cast(bf16x8, pw1), o1);
      o0 = MFMA32(NP_VFR(4), __builtin_bit_cast(bf16x8, pw2), o0); o1 = MFMA32(NP_VFR(5), __builtin_bit_cast(bf16x8, pw2), o1);
      o0 = MFMA32(NP_VFR(6), __builtin_bit_cast(bf16x8, pw3), o0); o1 = MFMA32(NP_VFR(7), __builtin_bit_cast(bf16x8, pw3), o1); }
    __syncthreads();
    lsum = l;
#undef NP_DMA
#undef NP_DMAWAIT
#undef NP_NEXT
#undef NP_SELBIT
#undef NP_KIMG
#undef NP_VIMG
#undef NP_KLOAD2
#undef NP_SPLAT
#undef NP_CINIT
#undef NP_DECIDE
#undef NP_PKW
#undef NP_VFR
#undef NP_VRD
#undef NP_GAPA
#undef NP_GAPB
#undef NP_KRD
#undef NP_STEP
}

__device__ __forceinline__ void nsa_unit(Frame& F, int b, int g, int qb) {
    int tid = F.tid; asm volatile("" : "+v"(tid));
    const int lane = tid & 63, w = F.wave, r32 = lane & 31, hi = lane >> 5;
    const int hh = 4 * g + (w & 3), th = w >> 2, cur = qb, T0 = qb * 64, tokl = 32 * th + r32, t = T0 + tokl;
    const size_t row = (size_t)b * SEQ + t; const int bg = b * 2 + g;
    LAS unsigned char* L = F.lds;
    bf16x8 qr[4];
    { const bf16_t* qp = WSP(bf16_t, WS_NQ) + row * 512 + hh * 64 + 8 * hi;
#pragma unroll
      for (int d0 = 0; d0 < 4; ++d0) qr[d0] = *(const bf16x8*)(qp + 16 * d0); }
    const float* gp = WSP(float, WS_NGT) + row * 24 + hh * 3; const float gate_c = gp[0], gate_s = gp[1], gate_w = gp[2];
    unsigned outp0[8], outp1[8];
    const unsigned kst = (tid & 7) * NSA_KCH + (tid >> 3) * 16, vst = ((tid & 7) >> 2) * NSA_VDH + (tid >> 3) * 64 + (tid & 3) * 16;
    const unsigned kfo = hi * NSA_KCH + r32 * 16, vfo = tr_lane_off(lane);
    float m, l; f32x16 o0, o1;
    u32x4 rk, rv;
#define NSA_LOAD(Kp, Vp, tile) do { rk = *(const u32x4*)((Kp) + (size_t)(tile) * 4096 + tid * 8); rv = *(const u32x4*)((Vp) + (size_t)(tile) * 4096 + tid * 8); } while (0)
#define NSA_WRITE(buf) do { *(LAS u32x4*)(L + (buf) * NSA_BUF + kst) = rk; *(LAS u32x4*)(L + (buf) * NSA_BUF + NSA_KIMG + vst) = rv; } while (0)
#define NSA_NEXT(jv) do { jv = -1; if (ulo | uhi) { jv = ulo ? __builtin_ctz(ulo) : 32 + __builtin_ctz(uhi); if (ulo) ulo &= ulo - 1; else uhi &= uhi - 1; } } while (0)
#define NSA_RUN(Kp, Vp, MLO, MHI, ...) do { unsigned ulo = (MLO), uhi = (MHI); int j, j1, j2; u32x4 rk2, rv2; \
        NSA_NEXT(j); NSA_LOAD(Kp, Vp, j); NSA_WRITE(0); NSA_NEXT(j1); if (j1 >= 0) NSA_LOAD(Kp, Vp, j1); __syncthreads(); int buf = 0; \
        for (;;) { NSA_NEXT(j2); if (j2 >= 0) { rk2 = *(const u32x4*)((Kp) + (size_t)j2 * 4096 + tid * 8); rv2 = *(const u32x4*)((Vp) + (size_t)j2 * 4096 + tid * 8); } \
            { LAS const unsigned char* KI = L + buf * NSA_BUF; LAS const unsigned char* VI = KI + NSA_KIMG; __VA_ARGS__ } \
            if (j1 >= 0) NSA_WRITE(buf ^ 1); __syncthreads(); if (j1 < 0) break; j = j1; j1 = j2; rk = rk2; rv = rv2; buf ^= 1; } } while (0)
#define NSA_LOAD2(Kp, Vp, ja, jb) do { rk = *(const u32x4*)((Kp) + (size_t)(ja) * 4096 + tid * 8); rv = *(const u32x4*)((Vp) + (size_t)(ja) * 4096 + tid * 8); \
        if ((jb) >= 0) { rkB = *(const u32x4*)((Kp) + (size_t)(jb) * 4096 + tid * 8); rvB = *(const u32x4*)((Vp) + (size_t)(jb) * 4096 + tid * 8); } } while (0)
#define NSA_WRITE2(pb, jb) do { LAS unsigned char* P_ = L + (pb) * (2 * NSA_BUF); *(LAS u32x4*)(P_ + kst) = rk; *(LAS u32x4*)(P_ + NSA_KIMG + vst) = rv; \
        if ((jb) >= 0) { *(LAS u32x4*)(P_ + NSA_BUF + kst) = rkB; *(LAS u32x4*)(P_ + NSA_BUF + NSA_KIMG + vst) = rvB; } } while (0)
#define NSA_RUN2(Kp, Vp, MLO, MHI, ...) do { unsigned ulo = (MLO), uhi = (MHI); int ja, jb, na, nb; u32x4 rkB, rvB; \
        NSA_NEXT(ja); NSA_NEXT(jb); NSA_LOAD2(Kp, Vp, ja, jb); NSA_WRITE2(0, jb); __syncthreads(); int pbuf = 0; \
        for (;;) { NSA_NEXT(na); NSA_NEXT(nb); if (na >= 0) NSA_LOAD2(Kp, Vp, na, nb); \
            { LAS const unsigned char* KA = L + pbuf * (2 * NSA_BUF); LAS const unsigned char* VA = KA + NSA_KIMG; LAS const unsigned char* KB = KA + NSA_BUF; LAS const unsigned char* VB = KB + NSA_KIMG; __VA_ARGS__ } \
            if (na >= 0) NSA_WRITE2(pbuf ^ 1, nb); __syncthreads(); if (na < 0) break; ja = na; jb = nb; pbuf ^= 1; } } while (0)
#define NSA_LT(lv) ({ const auto rr_ = __builtin_amdgcn_permlane32_swap(__float_as_uint(lv), __float_as_uint(lv), false, false); __uint_as_float(rr_[0]) + __uint_as_float(rr_[1]); })
#define NSA_RESET() do { m = -1e30f; l = 0.f; o0 = (f32x16){0}; o1 = (f32x16){0}; } while (0)

    const bf16_t* Kc = WSP(bf16_t, WS_KCMP) + (size_t)bg * 256 * 64; const bf16_t* Vc = WSP(bf16_t, WS_VCMP) + (size_t)bg * 256 * 64;
    const int ntc = ((4 * cur + 2) >> 6) + 1; const int lim = (t >= 31) ? ((t - 31) >> 4) : -1;
    const int tmin_w = T0 + 32 * th; const int lim_min = (tmin_w >= 31) ? ((tmin_w - 31) >> 4) : -1;
    unsigned sel0, sel1, un0, un1;
    {
        LAS float* IMP = (LAS float*)(L + NSA_IMP); LAS float* FAC = (LAS float*)(L + NSA_FAC);
        float carry = 0.f; const bool need_imp = cur >= 16;
        float mt0 = 0.f, mt1 = 0.f, mt2 = 0.f, mt3 = 0.f;
        m = -1e30f; l = 0.f; o0 = (f32x16){0}; o1 = (f32x16){0};
        NSA_RUN(Kc, Vc, (1u << ntc) - 1u, 0u, {
            f32x16 p0, p1; nsa_qk(KI, qr, kfo, p0, p1);
            if (64 * j + 63 > lim_min) {
                _Pragma("unroll") for (int r = 0; r < 16; ++r) { const int k0 = 64 * j + crow(r, hi);
                    p0[r] = (k0 <= lim) ? p0[r] : -INFINITY; p1[r] = (k0 + 32 <= lim) ? p1[r] : -INFINITY; } }
            { const float rm = nsa_rowmax(p0, p1); const bool fresh = m < -1e29f; const bool grow = fresh ? (rm > -INFINITY) : (rm - m > NSA_THR);
              if (__any(grow)) { const float mn = grow ? rm : m; const float f = (grow && !fresh) ? ex2(m - mn) : 1.f; m = mn; l *= f; carry *= f;
                  _Pragma("unroll") for (int r = 0; r < 16; ++r) { o0[r] *= f; o1[r] *= f; } } }
            if (j == 0) mt0 = m; else if (j == 1) mt1 = m; else if (j == 2) mt2 = m; else mt3 = m;
            { float rs = 0.f;
              _Pragma("unroll") for (int r = 0; r < 16; ++r) { p0[r] = ex2(p0[r] - m); p1[r] = ex2(p1[r] - m); rs += p0[r] + p1[r]; }
              l += rs; }
            if (need_imp) {
                _Pragma("unroll") for (int n = 0; n < 2; ++n) {
                    float a[4], bq[4], pb[4];
                    _Pragma("unroll") for (int q4 = 0; q4 < 4; ++q4) { const float x0 = n ? p1[4 * q4] : p0[4 * q4], x1 = n ? p1[4 * q4 + 1] : p0[4 * q4 + 1], x2 = n ? p1[4 * q4 + 2] : p0[4 * q4 + 2], x3 = n ? p1[4 * q4 + 3] : p0[4 * q4 + 3];
                        a[q4] = 2.f * (x0 + x1 + x2) + x3; bq[q4] = x3; }
                    _Pragma("unroll") for (int q4 = 0; q4 < 4; ++q4) pb[q4] = __shfl_xor(bq[q4], 32);
                    _Pragma("unroll") for (int q4 = 0; q4 < 4; ++q4) { const float prevb = hi ? pb[q4] : (q4 ? pb[q4 > 0 ? q4 - 1 : 0] : carry);
                        IMP[((w & 3) * 64 + tokl) * NSA_IST + 16 * j + 8 * n + 2 * q4 + hi] = a[q4] + prevb; }
                    carry = pb[3];
                } }
            u32x4 pw[4];
            _Pragma("unroll") for (int s = 0; s < 2; ++s) {
                pw[s].x = cvtpk(p0[8 * s + 0], p0[8 * s + 1]); pw[s].y = cvtpk(p0[8 * s + 2], p0[8 * s + 3]); pw[s].z = cvtpk(p0[8 * s + 4], p0[8 * s + 5]); pw[s].w = cvtpk(p0[8 * s + 6], p0[8 * s + 7]);
                pw[2 + s].x = cvtpk(p1[8 * s + 0], p1[8 * s + 1]); pw[2 + s].y = cvtpk(p1[8 * s + 2], p1[8 * s + 3]); pw[2 + s].z = cvtpk(p1[8 * s + 4], p1[8 * s + 5]); pw[2 + s].w = cvtpk(p1[8 * s + 6], p1[8 * s + 7]); }
            _Pragma("unroll") for (int ks = 0; ks < 4; ++ks) {
                const bf16x8 v0 = mk8(vtr(VI + vfo + ks * 1024), vtr(VI + vfo + ks * 1024 + 512));
                const bf16x8 v1 = mk8(vtr(VI + vfo + NSA_VDH + ks * 1024), vtr(VI + vfo + NSA_VDH + ks * 1024 + 512));
                o0 = MFMA32(v0, __builtin_bit_cast(bf16x8, pw[ks]), o0); o1 = MFMA32(v1, __builtin_bit_cast(bf16x8, pw[ks]), o1); } });
        const float inv_c = 1.f / fmaxf(NSA_LT(l), 1e-30f); const float gs_ = gate_c * inv_c;
        _Pragma("unroll") for (int r = 0; r < 8; ++r) { outp0[r] = cvtpk(gs_ * o0[2 * r], gs_ * o0[2 * r + 1]); outp1[r] = cvtpk(gs_ * o1[2 * r], gs_ * o1[2 * r + 1]); }
        if (need_imp) {
            if (hi == 0) { f32x4 fc; fc[0] = ex2(mt0 - m) * inv_c; fc[1] = ntc > 1 ? ex2(mt1 - m) * inv_c : 0.f; fc[2] = ntc > 2 ? ex2(mt2 - m) * inv_c : 0.f; fc[3] = ntc > 3 ? ex2(mt3 - m) * inv_c : 0.f;
                *(LAS f32x4*)(FAC + ((w & 3) * 64 + tokl) * 4) = fc; }
            __syncthreads(); }
    }
    if (cur >= 16) {
        LAS float* IMP = (LAS float*)(L + NSA_IMP);
        LAS unsigned* TOT = (LAS unsigned*)(L + NSA_TOT); LAS unsigned char* SELB = L + NSA_SELB; LAS unsigned* UNI = (LAS unsigned*)(L + NSA_UNI);
        { const int tk = tid >> 3, jg = tid & 7; LAS const float* FAC = (LAS const float*)(L + NSA_FAC);
          float fq[4];
#pragma unroll
          for (int h4 = 0; h4 < 4; ++h4) fq[h4] = FAC[(h4 * 64 + tk) * 4 + (jg >> 1)];
#pragma unroll
          for (int jj = 0; jj < 8; ++jj) { const int jx = 8 * jg + jj;
              const float tot = ((IMP[tk * NSA_IST + jx] * fq[0] + IMP[(64 + tk) * NSA_IST + jx] * fq[1]) + IMP[(128 + tk) * NSA_IST + jx] * fq[2]) + IMP[(192 + tk) * NSA_IST + jx] * fq[3];
              TOT[tk * NSA_IST + jx] = (__float_as_uint(tot) & ~63u) | (unsigned)(63 - jx); }
          if (tid < 2) UNI[tid] = 0u; }
        __syncthreads();
        { const int tk = tid >> 3, jg = tid & 7; unsigned bits = 0u;
          unsigned v[8]; int rank[8];
#pragma unroll
          for (int jj = 0; jj < 8; ++jj) { v[jj] = TOT[tk * NSA_IST + 8 * jg + jj]; rank[jj] = 0; }
#pragma unroll 4
          for (int k2 = 1; k2 <= cur - 2; ++k2) { const unsigned v2 = TOT[tk * NSA_IST + k2];
#pragma unroll
              for (int jj = 0; jj < 8; ++jj) rank[jj] += (int)(v2 > v[jj]); }
#pragma unroll
          for (int jj = 0; jj < 8; ++jj) { const int jx = 8 * jg + jj;
              const bool s = (jx == 0 || jx == cur || jx == cur - 1) || (jx < cur - 1 && rank[jj] < 13);
              bits |= s ? (1u << jj) : 0u; }
          SELB[tk * 8 + jg] = (unsigned char)bits;
          atomicOr((unsigned*)&UNI[jg >> 2], bits << (8 * (jg & 3))); }
        __syncthreads();
        sel0 = *(LAS const unsigned*)(SELB + tokl * 8); sel1 = *(LAS const unsigned*)(SELB + tokl * 8 + 4);
        un0 = __builtin_amdgcn_readfirstlane(UNI[0]); un1 = __builtin_amdgcn_readfirstlane(UNI[1]);
    } else {
        sel0 = (1u << (cur + 1)) - 1u; sel1 = 0u; un0 = sel0; un1 = 0u;
    }
    LAS unsigned* ST = (LAS unsigned*)(L + NSA_STASH + w * 4096) + lane;
#pragma unroll
    for (int r = 0; r < 8; ++r) { ST[r * 64] = outp0[r]; ST[(8 + r) * 64] = outp1[r]; }
    const bf16_t* Ks = WSP(bf16_t, WS_KSL) + (size_t)bg * SEQ * 64; const bf16_t* Vs = WSP(bf16_t, WS_VSL) + (size_t)bg * SEQ * 64;
    NDUP(3) nsa_pipe<1>(L, Ks, Vs, un0, un1, sel0, sel1, qr, t, lane, w, hi, kfo, vfo, l, o0, o1);
    { const float sc = gate_s / fmaxf(NSA_LT(l), 1e-30f);
#pragma unroll
      for (int r = 0; r < 8; ++r) { const unsigned a = ST[r * 64], c = ST[(8 + r) * 64];
          ST[r * 64] = cvtpk(bflo(a) + sc * o0[2 * r], bfhi(a) + sc * o0[2 * r + 1]); ST[(8 + r) * 64] = cvtpk(bflo(c) + sc * o1[2 * r], bfhi(c) + sc * o1[2 * r + 1]); } }
    const bf16_t* Kw = WSP(bf16_t, WS_KWN) + (size_t)bg * SEQ * 64; const bf16_t* Vw = WSP(bf16_t, WS_VWN) + (size_t)bg * SEQ * 64;
    { const int jlo = cur >= 8 ? cur - 8 : 0;
      const unsigned long long wm = ((cur == 63) ? ~0ull : ((1ull << (cur + 1)) - 1ull)) & ~((1ull << jlo) - 1ull);
      NDUP(4) nsa_pipe<2>(L, Kw, Vw, (unsigned)wm, (unsigned)(wm >> 32), 0u, 0u, qr, t, lane, w, hi, kfo, vfo, l, o0, o1); }
    { const float sc = gate_w / fmaxf(NSA_LT(l), 1e-30f);
      bf16_t* yo = WSP(bf16_t, WS_YCAT) + row * 1024 + 512 + hh * 64;
#pragma unroll
      for (int p2 = 0; p2 < 2; ++p2) { u32x2 av[2], cv[2];
#pragma unroll
          for (int e = 0; e < 2; ++e) { const int q4 = 2 * p2 + e;
              const unsigned a0 = ST[(2 * q4) * 64], a1 = ST[(2 * q4 + 1) * 64], c0 = ST[(8 + 2 * q4) * 64], c1 = ST[(9 + 2 * q4) * 64];
              av[e].x = cvtpk(bflo(a0) + sc * o0[4 * q4], bfhi(a0) + sc * o0[4 * q4 + 1]); av[e].y = cvtpk(bflo(a1) + sc * o0[4 * q4 + 2], bfhi(a1) + sc * o0[4 * q4 + 3]);
              cv[e].x = cvtpk(bflo(c0) + sc * o1[4 * q4], bfhi(c0) + sc * o1[4 * q4 + 1]); cv[e].y = cvtpk(bflo(c1) + sc * o1[4 * q4 + 2], bfhi(c1) + sc * o1[4 * q4 + 3]); }
          *(u32x4*)(yo + 16 * p2 + 8 * hi) = widen_pair(av[0], av[1]); *(u32x4*)(yo + 32 + 16 * p2 + 8 * hi) = widen_pair(cv[0], cv[1]); } }
#undef NSA_LOAD
#undef NSA_WRITE
#undef NSA_RUN
#undef NSA_RUN2
#undef NSA_LOAD2
#undef NSA_WRITE2
#undef NSA_LT
#undef NSA_RESET
}

__device__ __forceinline__ void s6_phase(Frame& F) {
    int tid = F.tid; asm volatile("" : "+v"(tid));
    const int lane = tid & 63, w = F.wave;
    LAS unsigned char* TILE = F.lds + w * 16384;
    LAS float* LG = (LAS float*)(F.lds + MISC_OFF + 4096) + w * (8 * 48);
    LAS int* REC_E = (LAS int*)(F.lds + MISC_OFF + 16384);
    LAS float* REC_G = (LAS float*)(F.lds + MISC_OFF + 16384 + 1024);
    LAS int* REC_P = (LAS int*)(F.lds + MISC_OFF + 16384 + 2048);
    LAS int* CNTL = (LAS int*)(F.lds + MISC_OFF + 16384 + 3072);
    LAS float* SAW = (LAS float*)(F.lds + MISC_OFF + 16384 + 3584);
    const float* x = IN_F(0); const float* wpost = IN_F(6); const float* wffn = IN_F(7); const float* mod = WSP(float, WS_MOD);
    const bf16_t* Y = WSP(bf16_t, WS_Y); bf16_t* X1B = WSP(bf16_t, WS_X1B); signed char* H2Q = (signed char*)(F.ws + WS_H2Q); float* SAv = WSP(float, WS_SA); const _Float16* RWT = WSP(_Float16, WS_RWT);
    const float* bgp = IN_F(21); const float* bep = IN_F(23);
    unsigned* cntg = (unsigned*)(F.ws + WS_CTL) + CW_CNT;
    for (int rb = F.vcu; rb < NTOK / 128; rb += F.G) {
        if (tid < 64) CNTL[tid] = 0;
        __syncthreads();
        const int rbase = rb * 128 + w * 16, b = rbase >> 12;
        f32x4 xv[4][4]; u32x2 yr[4][4];
#define S6_LOAD(g) do { _Pragma("unroll") for (int r = 0; r < 4; ++r) { const size_t ro_ = (size_t)(rbase + 4 * (g) + r) * DM + 4 * lane; \
            _Pragma("unroll") for (int j = 0; j < 4; ++j) { xv[r][j] = __builtin_nontemporal_load((const f32x4*)(x + ro_ + 256 * j)); yr[r][j] = __builtin_nontemporal_load((const u32x2*)(Y + ro_ + 256 * j)); } } } while (0)
#define S6_Y(r, j) ((f32x4){bflo(yr[r][j].x), bfhi(yr[r][j].x), bflo(yr[r][j].y), bfhi(yr[r][j].y)})
        S6_LOAD(0);
#pragma nounroll
        for (int g = 0; g < 4; ++g) {
            int l4 = 4 * lane; asm volatile("" : "+v"(l4));
            float ss[4];
#pragma unroll
            for (int r = 0; r < 4; ++r) { float a2 = 0.f;
#pragma unroll
                for (int j = 0; j < 4; ++j) { const f32x4 y = S6_Y(r, j); a2 += y[0] * y[0] + y[1] * y[1] + y[2] * y[2] + y[3] * y[3]; }
                ss[r] = a2; }
#pragma unroll
            for (int o = 1; o < 64; o <<= 1) {
#pragma unroll
                for (int r = 0; r < 4; ++r) ss[r] += __shfl_xor(ss[r], o); }
            float s2[4] = {0.f, 0.f, 0.f, 0.f};
#pragma unroll
            for (int j = 0; j < 4; ++j) { const int k = l4 + 256 * j;
                const f32x4 wp = *(const f32x4*)(wpost + k), gm = *(const f32x4*)(mod + b * 6144 + 2048 + k); const f32x4 gw2 = gm * wp;
#pragma unroll
                for (int r = 0; r < 4; ++r) { const float r1 = rsqrtf(ss[r] * (1.f / DM) + RMS_EPS);
                    xv[r][j] = xv[r][j] + gw2 * (S6_Y(r, j) * r1);
                    s2[r] += xv[r][j][0] * xv[r][j][0] + xv[r][j][1] * xv[r][j][1] + xv[r][j][2] * xv[r][j][2] + xv[r][j][3] * xv[r][j][3]; } }
#pragma unroll
            for (int r = 0; r < 4; ++r)
#pragma unroll
                for (int jp = 0; jp < 2; ++jp) { u32x2 pa, pb; pa.x = cvtpk(xv[r][2 * jp][0], xv[r][2 * jp][1]); pa.y = cvtpk(xv[r][2 * jp][2], xv[r][2 * jp][3]);
                    pb.x = cvtpk(xv[r][2 * jp + 1][0], xv[r][2 * jp + 1][1]); pb.y = cvtpk(xv[r][2 * jp + 1][2], xv[r][2 * jp + 1][3]);
                    __builtin_nontemporal_store(pair_widen(pa, pb, lane), (u32x4*)(X1B + (size_t)(rbase + 4 * g + r) * DM + 4 * (lane & ~1) + 256 * (2 * jp + (lane & 1)))); }
#pragma unroll
            for (int o = 1; o < 64; o <<= 1) {
#pragma unroll
                for (int r = 0; r < 4; ++r) s2[r] += __shfl_xor(s2[r], o); }
#pragma unroll
            for (int j = 0; j < 4; ++j) { const int k = l4 + 256 * j;
                const f32x4 wf = *(const f32x4*)(wffn + k), sh = *(const f32x4*)(mod + b * 6144 + 3072 + k), sc = *(const f32x4*)(mod + b * 6144 + 4096 + k); const f32x4 ws = wf * (sc + 1.f);
#pragma unroll
                for (int r = 0; r < 4; ++r) { const float r2 = rsqrtf(s2[r] * (1.f / DM) + RMS_EPS);
                    const f32x4 h = xv[r][j] * r2 * ws + sh;
                    { const int rt = 4 * (g & 1) + r; const f16x4 hh = {(_Float16)h[0], (_Float16)h[1], (_Float16)h[2], (_Float16)h[3]};
                      *(LAS f16x4*)(TILE + rt * 2048 + (((lane >> 1) ^ rt) << 4) + (lane & 1) * 8 + 512 * j) = hh; }
                    xv[r][j] = h; } }
            float am[4];
#pragma unroll
            for (int r = 0; r < 4; ++r) { float a = 0.f;
#pragma unroll
                for (int j = 0; j < 4; ++j) a = fmaxf(a, fmaxf(fmaxf(fabsf(xv[r][j][0]), fabsf(xv[r][j][1])), fmaxf(fabsf(xv[r][j][2]), fabsf(xv[r][j][3]))));
                am[r] = a; }
#pragma unroll
            for (int o = 1; o < 64; o <<= 1) {
#pragma unroll
                for (int r = 0; r < 4; ++r) am[r] = fmaxf(am[r], __shfl_xor(am[r], o)); }
#pragma unroll
            for (int r = 0; r < 4; ++r) { const float inv = am[r] > 0.f ? 127.f / am[r] : 0.f; const size_t ro = (size_t)(rbase + 4 * g + r) * DM;
                if (lane == 0) { SAv[rbase + 4 * g + r] = am[r] * (1.f / 127.f); SAW[(w * 16 + 4 * g + r)] = am[r] * (1.f / 127.f); }
                u32x4 pk;
#pragma unroll
                for (int j = 0; j < 4; ++j) { const f32x4 q = xv[r][j] * inv;
                    const int q0 = (int)rintf(q[0]), q1 = (int)rintf(q[1]), q2 = (int)rintf(q[2]), q3 = (int)rintf(q[3]);
                    pk[j] = (unsigned)(q0 & 0xff) | ((unsigned)(q1 & 0xff) << 8) | ((unsigned)(q2 & 0xff) << 16) | ((unsigned)(q3 & 0xff) << 24); }
                *(u32x4*)(H2Q + ro + 256 * (lane & 3) + 16 * (lane >> 2)) = quad_transpose(pk, lane); }
            __builtin_amdgcn_sched_barrier(0);
            if (g < 3) S6_LOAD(g + 1);
            __builtin_amdgcn_sched_barrier(0);
            if (g & 1) {
                const int r16 = lane & 15, q = lane >> 4, rt = r16 & 7;
                f32x4 a0 = {0.f, 0.f, 0.f, 0.f}, a1 = a0, a2 = a0;
                LAS const unsigned char* ae = TILE + rt * 2048 + ((q ^ rt) << 4); LAS const unsigned char* ao = TILE + rt * 2048 + (((q ^ rt) ^ 4) << 4);
                const _Float16* bp = RWT + (size_t)r16 * DM + 8 * q;
#pragma unroll 2
                for (int k2 = 0; k2 < 16; ++k2) {
                    const f16x8 ah0 = *(LAS const f16x8*)(ae + 128 * k2), ah1 = *(LAS const f16x8*)(ao + 128 * k2);
                    const f16x8 b00 = *(const f16x8*)(bp + 64 * k2), b01 = *(const f16x8*)(bp + 64 * k2 + 16 * DM), b02 = *(const f16x8*)(bp + 64 * k2 + 32 * DM);
                    const f16x8 b10 = *(const f16x8*)(bp + 64 * k2 + 32), b11 = *(const f16x8*)(bp + 64 * k2 + 32 + 16 * DM), b12 = *(const f16x8*)(bp + 64 * k2 + 32 + 32 * DM);
                    a0 = __builtin_amdgcn_mfma_f32_16x16x32_f16(ah0, b00, a0, 0, 0, 0); a1 = __builtin_amdgcn_mfma_f32_16x16x32_f16(ah0, b01, a1, 0, 0, 0); a2 = __builtin_amdgcn_mfma_f32_16x16x32_f16(ah0, b02, a2, 0, 0, 0);
                    a0 = __builtin_amdgcn_mfma_f32_16x16x32_f16(ah1, b10, a0, 0, 0, 0); a1 = __builtin_amdgcn_mfma_f32_16x16x32_f16(ah1, b11, a1, 0, 0, 0); a2 = __builtin_amdgcn_mfma_f32_16x16x32_f16(ah1, b12, a2, 0, 0, 0); }
                if (q < 2) {
#pragma unroll
                    for (int i = 0; i < 4; ++i) { LG[(4 * q + i) * 48 + r16] = a0[i]; LG[(4 * q + i) * 48 + 16 + r16] = a1[i]; LG[(4 * q + i) * 48 + 32 + r16] = a2[i]; } }
                asm volatile("s_waitcnt lgkmcnt(0)" ::: "memory");
                if (lane < 8) {
                    const LAS float* lg = LG + lane * 48;
                    float gl[4]; int gi = 0; float gmx = -INFINITY;
#pragma unroll
                    for (int i = 0; i < 4; ++i) { gl[i] = lg[i] + bgp[i]; if (gl[i] > gmx) { gmx = gl[i]; gi = i; } }
                    float gs = 0.f;
#pragma unroll
                    for (int i = 0; i < 4; ++i) gs += __expf(gl[i] - gmx);
                    const float pg = 1.f / gs;
                    float el[8]; float emx = -INFINITY;
#pragma unroll
                    for (int i = 0; i < 8; ++i) { el[i] = lg[4 + gi * 8 + i] + bep[gi * 8 + i]; emx = fmaxf(emx, el[i]); }
                    int e0 = 0; float v0 = -INFINITY;
#pragma unroll
                    for (int i = 0; i < 8; ++i) if (el[i] > v0) { v0 = el[i]; e0 = i; }
                    int e1 = 0; float v1 = -INFINITY;
#pragma unroll
                    for (int i = 0; i < 8; ++i) if (i != e0 && el[i] > v1) { v1 = el[i]; e1 = i; }
                    const float p0 = __expf(v0 - emx), p1 = __expf(v1 - emx);
                    const float g0 = pg * p0 / (p0 + p1), g1 = pg * p1 / (p0 + p1);
                    const int rl = w * 16 + 8 * (g >> 1) + lane; const int E0 = gi * 8 + e0, E1 = gi * 8 + e1;
                    REC_E[rl * 2] = E0; REC_E[rl * 2 + 1] = E1; REC_G[rl * 2] = g0; REC_G[rl * 2 + 1] = g1;
                    REC_P[rl * 2] = atomicAdd((int*)&CNTL[E0], 1); REC_P[rl * 2 + 1] = atomicAdd((int*)&CNTL[E1], 1);
                }
                asm volatile("s_waitcnt lgkmcnt(0)" ::: "memory");
            }
        }
#undef S6_LOAD
#undef S6_Y
        __syncthreads();
        if (tid < 32) { const int c = CNTL[tid]; CNTL[32 + tid] = c ? (int)__hip_atomic_fetch_add(cntg + tid, (unsigned)c, __ATOMIC_RELAXED, __HIP_MEMORY_SCOPE_AGENT) : 0; }
        __syncthreads();
        if (tid < 256) { const int rl = tid >> 1, k = tid & 1; const int row = rb * 128 + rl; const int e = REC_E[tid]; const int p = CNTL[32 + e] + REC_P[tid];
            WSP(int, WS_TOKE)[row * 2 + k] = e; WSP(int, WS_TOKP)[row * 2 + k] = p; WSP(float, WS_TOKG)[row * 2 + k] = REC_G[tid];
            WSP(int, WS_LIST)[(size_t)e * 65536 + p] = row; WSP(float, WS_SAL)[(size_t)e * 65536 + p] = SAW[rl]; }
        __syncthreads();
    }
}

__device__ __forceinline__ void expert_convert(Frame& F) {
    {
        int tid = F.tid; asm volatile("" : "+v"(tid));
        LAS unsigned* AM = (LAS unsigned*)F.lds;
        const int n = tid & 31, kq = tid >> 5;
        for (int it = F.vcu; it < 1024; it += F.G) {
            const int e = it >> 5, sel = (it >> 4) & 1, j0 = (it & 15) * 32;
            const float* W = IN_F(sel ? 25 : 24) + (size_t)e * 1024 * 512 + (size_t)(64 * kq) * 512 + j0 + n;
            if (tid < 32) AM[tid] = 0u;
            __syncthreads();
            float v[64]; float am = 0.f;
#pragma unroll
            for (int i = 0; i < 64; ++i) { v[i] = W[(size_t)i * 512]; am = fmaxf(am, fabsf(v[i])); }
            atomicMax((unsigned*)&AM[n], __float_as_uint(am));
            __syncthreads();
            const float amax = __uint_as_float(AM[n]); const float inv = amax > 0.f ? 127.f / amax : 0.f;
            const int j = j0 + n, prow = 8 * (j >> 2) + 4 * sel + (j & 3);
            unsigned char* dst = (unsigned char*)(F.ws + WS_W13T) + ((size_t)e * 1024 + prow) * 1024 + 64 * kq;
#pragma unroll
            for (int c = 0; c < 4; ++c) { u32x4 o;
#pragma unroll
                for (int d = 0; d < 4; ++d) { const int b0 = 16 * c + 4 * d;
                    const int q0 = (int)rintf(v[b0] * inv), q1 = (int)rintf(v[b0 + 1] * inv), q2 = (int)rintf(v[b0 + 2] * inv), q3 = (int)rintf(v[b0 + 3] * inv);
                    o[d] = (unsigned)(q0 & 0xff) | ((unsigned)(q1 & 0xff) << 8) | ((unsigned)(q2 & 0xff) << 16) | ((unsigned)(q3 & 0xff) << 24); }
                *(u32x4*)(dst + 16 * c) = o; }
            if (kq == 0) WSP(float, WS_SB13)[e * 1024 + prow] = amax * (1.f / 127.f);
            __syncthreads();
        }
    }
}
__device__ __forceinline__ void w2_convert(Frame& F, int rk, int nsh) {
    LAS float* scr = (LAS float*)(F.lds + F.wave * 8448);
    const int gw = rk * NWAVES + F.wave, NGW = nsh * NWAVES;
    for (int it = gw; it < 32 * 256; it += NGW) {
        const int e = it >> 8, r = it & 255;
        transpose_item(IN_F(26) + (size_t)e * 512 * 1024, 1024, WSP(bf16_t, WS_W2T) + (size_t)e * 1024 * 512, 512, scr, (r / 32) * 64, (r % 32) * 32, F.lane, RmId{0});
    }
    __syncthreads();
}

__device__ __forceinline__ void moe_tables(Frame& F, LAS int* tstart, LAS int* cnt) {
    if (F.tid == 0) { const unsigned* cg = (const unsigned*)(F.ws + WS_CTL) + CW_CNT; int acc = 0;
        for (int e = 0; e < 32; ++e) { const int c = (int)__hip_atomic_load(cg + e, __ATOMIC_RELAXED, __HIP_MEMORY_SCOPE_AGENT); cnt[e] = c; tstart[e] = acc; acc += (c + 255) >> 8; }
        tstart[32] = acc; }
    __syncthreads();
}

__device__ __forceinline__ void s10_phase(Frame& F, LAS int* tstart) {
    const int gw = F.vcu * NWAVES + F.wave, NGW = F.G * NWAVES, lane = F.lane;
    const float* wpost = IN_F(8); const float* mod = WSP(float, WS_MOD); const bf16_t* YB = WSP(bf16_t, WS_YB); const bf16_t* X1B = WSP(bf16_t, WS_X1B);
    int ne0[4], ne1[4], np0[4], np1[4]; float ng0[4], ng1[4];
#define S10_TAB(rw) do { _Pragma("unroll") for (int r = 0; r < 4; ++r) { const int row_ = (rw) + r; \
        ne0[r] = WSP(int, WS_TOKE)[row_ * 2]; ne1[r] = WSP(int, WS_TOKE)[row_ * 2 + 1]; np0[r] = WSP(int, WS_TOKP)[row_ * 2]; np1[r] = WSP(int, WS_TOKP)[row_ * 2 + 1]; \
        ng0[r] = WSP(float, WS_TOKG)[row_ * 2]; ng1[r] = WSP(float, WS_TOKG)[row_ * 2 + 1]; } } while (0)
    if (gw * 4 < NTOK) S10_TAB(gw * 4);
    for (int row0 = gw * 4; row0 < NTOK; row0 += NGW * 4) {
        const int b = row0 >> 12;
        size_t r0[4], r1[4]; float g0[4], g1[4];
#pragma unroll
        for (int r = 0; r < 4; ++r) { r0[r] = (size_t)tstart[ne0[r]] * 256 + np0[r]; r1[r] = (size_t)tstart[ne1[r]] * 256 + np1[r]; g0[r] = ng0[r]; g1[r] = ng1[r]; }
        if (row0 + NGW * 4 < NTOK) S10_TAB(row0 + NGW * 4);
        f32x4 yv[4][4]; float ss[4];
        u32x4 xw[4][2];
#pragma unroll
        for (int r = 0; r < 4; ++r) { float a2 = 0.f;
            u32x4 wa[2], wc[2];
#pragma unroll
            for (int jp = 0; jp < 2; ++jp) { const int ko = 4 * (lane & ~1) + 256 * (2 * jp + (lane & 1));
                wa[jp] = __builtin_nontemporal_load((const u32x4*)(YB + r0[r] * DM + ko)); wc[jp] = __builtin_nontemporal_load((const u32x4*)(YB + r1[r] * DM + ko));
                xw[r][jp] = __builtin_nontemporal_load((const u32x4*)(X1B + (size_t)(row0 + r) * DM + ko)); }
#pragma unroll
            for (int jp = 0; jp < 2; ++jp) { u32x2 a[2], c[2]; pair_narrow(wa[jp], lane, a[0], a[1]); pair_narrow(wc[jp], lane, c[0], c[1]);
#pragma unroll
                for (int e = 0; e < 2; ++e) { const int j = 2 * jp + e;
                    yv[r][j] = (f32x4){bflo(a[e].x), bfhi(a[e].x), bflo(a[e].y), bfhi(a[e].y)} * g0[r] + (f32x4){bflo(c[e].x), bfhi(c[e].x), bflo(c[e].y), bfhi(c[e].y)} * g1[r];
                    a2 += yv[r][j][0] * yv[r][j][0] + yv[r][j][1] * yv[r][j][1] + yv[r][j][2] * yv[r][j][2] + yv[r][j][3] * yv[r][j][3]; } }
            ss[r] = a2; }
#pragma unroll
        for (int o = 1; o < 64; o <<= 1) {
#pragma unroll
            for (int r = 0; r < 4; ++r) ss[r] += __shfl_xor(ss[r], o); }
#pragma unroll
        for (int jp = 0; jp < 2; ++jp) {
#pragma unroll
            for (int r = 0; r < 4; ++r) { const float rr = rsqrtf(ss[r] * (1.f / DM) + RMS_EPS);
                u32x2 xb[2]; pair_narrow(xw[r][jp], lane, xb[0], xb[1]);
#pragma unroll
                for (int e = 0; e < 2; ++e) { const int j = 2 * jp + e, k = 4 * lane + 256 * j;
                    const f32x4 wp = *(const f32x4*)(wpost + k), gf = *(const f32x4*)(mod + b * 6144 + 5120 + k); const f32x4 gw2 = gf * wp;
                    const f32x4 x1 = (f32x4){bflo(xb[e].x), bfhi(xb[e].x), bflo(xb[e].y), bfhi(xb[e].y)};
                    __builtin_nontemporal_store(x1 + gw2 * (yv[r][j] * rr), (f32x4*)(F.out + (size_t)(row0 + r) * DM + k)); } } }
    }
}

#undef S10_TAB
#ifndef DBG_STOP
#define DBG_STOP -1
#endif
#if DBG_STOP >= 0
struct DbgBuf { size_t off, n; int f32, ph; };
__device__ __forceinline__ void dbg_phase(Frame& F, const XcdBarrier& bar) {
    const DbgBuf bufs[] = {
        {WS_MOD, 8 * 6144, 1, 0}, {WS_COS, (size_t)NTOK * 32, 1, 0}, {WS_SIN, (size_t)NTOK * 32, 1, 0}, {WS_WINT, (size_t)INWP * 1024, 0, 0}, {WS_WOUTT, 1024 * 1024, 0, 0},
        {WS_CW1K, 128 * 2048, 0, 0}, {WS_CW2K, 64 * 128, 0, 0}, {WS_RWT, 48 * 1024, 0, 0}, {WS_C1B, 256, 1, 0},
        {WS_H1, (size_t)NTOK * 1024, 0, 1},
        {WS_MQ, (size_t)NTOK * 2048, 0, 2}, {WS_NQ, (size_t)NTOK * 512, 0, 2}, {WS_KC, (size_t)NTOK * 128 * 6, 0, 2}, {WS_GI, 2 * 8 * 4 * 4096, 1, 2}, {WS_NGT, (size_t)NTOK * 24, 1, 2},
        {WS_KVC, (size_t)2048 * 16384, 0, 3}, {WS_NC, 2048 * 128, 1, 3}, {WS_GSUM, 4096, 1, 3}, {WS_KCMP, 2 * 16 * 256 * 64, 0, 3},
        {WS_CPREV, (size_t)2048 * 16384, 0, 4}, {WS_NPREV, 2048 * 128, 1, 4}, {WS_MPREV, 2048, 1, 4},
        {WS_YCAT, (size_t)NTOK * 1024, 0, 5}, {WS_W13T, (size_t)32 * 1024 * 1024, 0, 5}, {WS_W2T, (size_t)32 * 1024 * 512, 0, 5},
        {WS_Y, (size_t)NTOK * 1024, 0, 6}, {WS_H2, (size_t)NTOK * 1024, 0, 7}, {WS_TOKG, (size_t)NTOK * 2, 1, 7},
        {WS_HB, (size_t)65536 * 512, 0, 8}, {WS_YB, (size_t)65536 * 1024, 0, 9} };
    constexpr int NBUF = sizeof(bufs) / sizeof(bufs[0]);
    unsigned* flag = (unsigned*)(F.ws + WS_CTL) + CW_DBG;
    const size_t gt = (size_t)blockIdx.x * NTHR + F.tid, NG = (size_t)F.G * NTHR;
    for (int i = 0; i < NBUF; ++i) {
        if (bufs[i].ph > DBG_STOP) continue;
        if ((bufs[i].off == WS_H1 && DBG_STOP >= 3) || (bufs[i].off == WS_WINT && DBG_STOP >= 4) || (bufs[i].off == WS_KVC && DBG_STOP >= 5) || (bufs[i].off == WS_NQ && DBG_STOP >= 5) || (bufs[i].off == WS_KC && DBG_STOP >= 9) ||
            (bufs[i].off == WS_MQ && DBG_STOP >= 6) || (bufs[i].off == WS_CPREV && DBG_STOP >= 8) || (bufs[i].off == WS_Y && DBG_STOP >= 9) || (bufs[i].off == WS_H2 && DBG_STOP >= 9) || (bufs[i].off == WS_W13T && DBG_STOP < 5)) continue;
        bool bad = false;
        if (bufs[i].f32) { const unsigned* p = (const unsigned*)(F.ws + bufs[i].off); for (size_t k = gt; k < bufs[i].n; k += NG) bad |= ((p[k] & 0x7f800000u) == 0x7f800000u); }
        else { const unsigned* p = (const unsigned*)(F.ws + bufs[i].off); for (size_t k = gt; k < bufs[i].n / 2; k += NG) { const unsigned v = p[k]; bad |= ((v & 0x7f80u) == 0x7f80u) || ((v & 0x7f800000u) == 0x7f800000u); } }
        if (bufs[i].off == WS_YCAT) { bool bm = false, bn = false; const unsigned* p = (const unsigned*)(F.ws + WS_YCAT);
            for (size_t k = gt; k < bufs[i].n / 2; k += NG) { const unsigned v = p[k]; const bool b2 = ((v & 0x7f80u) == 0x7f80u) || ((v & 0x7f800000u) == 0x7f800000u); if ((k & 511) < 256) bm |= b2; else bn |= b2; }
            if (__any(bm) && F.lane == 0) atomicMin(flag, 23u); if (__any(bn) && F.lane == 0) atomicMin(flag, 33u); continue; }
        if (__any(bad) && F.lane == 0) atomicMin(flag, (unsigned)(i + 1));
    }
    if (DBG_STOP >= 7) { bool bad = false; const unsigned* p = (const unsigned*)F.out; for (size_t k = gt; k < (size_t)NTOK * DM; k += NG) bad |= ((p[k] & 0x7f800000u) == 0x7f800000u); if (__any(bad) && F.lane == 0) atomicMin(flag, 40u); }
    xcd_barrier(bar);
    const unsigned id = __hip_atomic_load(flag, __ATOMIC_RELAXED, __HIP_MEMORY_SCOPE_AGENT);
    const float sc = (id >= 1000u) ? 1.f : 1.f + (float)id;
    const float* x = IN_F(0);
    for (size_t k = gt; k < (size_t)NTOK * DM; k += NG) F.out[k] = x[k] * sc;
}
#endif


#if DBG_STOP >= 0
__device__ __forceinline__ unsigned dbg_hash(unsigned x) { x ^= x >> 16; x *= 0x7feb352du; x ^= x >> 15; x *= 0x846ca68bu; x ^= x >> 16; return x; }
__device__ __forceinline__ float dbg_bfr(float f) { return bf2f(f2bf(f)); }
__device__ float dbg_z(Frame& F, int row, int c) { const signed char* h = (const signed char*)(F.ws + WS_H1) + (size_t)row * 1024; const float* w = IN_F(9); float am = 0.f;
    for (int k = 0; k < 1024; ++k) am = fmaxf(am, fabsf(w[(size_t)k * INW + c]));
    const float inv = am > 0.f ? 127.f / am : 0.f; float s = 0.f; for (int k = 0; k < 1024; ++k) s += (float)h[k] * rintf(w[(size_t)k * INW + c] * inv);
    return s * WSP(float, WS_SA1)[row] * (am * (1.f / 127.f)); }
__device__ __forceinline__ bool dbg_close(float a, float b) { return fabsf(a - b) <= 0.02f * fabsf(b) + 0.02f; }
__device__ void dbg_check_p1(Frame& F, unsigned* cnt) {
    const int gt = blockIdx.x * NTHR + F.tid; if (gt >= 8192) return;
    const int row = dbg_hash(gt * 2 + 1) % NTOK; int c = dbg_hash(gt * 2 + 2) % INW; if (gt < 64) c = 2048 + (gt & 7); if (gt >= 64 && gt < 256) c = 3336 + (gt % 24);
    const int b = row >> 12, sq = row & 4095; const float* COS = WSP(float, WS_COS); const float* SIN = WSP(float, WS_SIN);
    float ref, got;
    if (c < 2048) { ref = dbg_z(F, row, c); got = bf2f(WSP(bf16_t, c < 512 ? WS_MQ : c < 1024 ? WS_MK : c < 1536 ? WS_MV : WS_MO)[(size_t)row * 512 + (c & 511)]); }
    else if (c < 2052) { ref = dbg_z(F, row, c) + IN_F(11)[c - 2048]; got = WSP(float, WS_GI)[(size_t)(b * 4 + c - 2048) * SEQ + sq]; }
    else if (c < 2056) { ref = logsigmoid_f(dbg_z(F, row, c) + IN_F(11)[4 + c - 2052]); got = WSP(float, WS_GF)[(size_t)(b * 4 + c - 2052) * SEQ + sq]; }
    else if (c >= 3336) { ref = sigmoid_f(dbg_z(F, row, c)); got = WSP(float, WS_NGT)[(size_t)row * 24 + c - 3336]; }
    else {
        int base, x; size_t ws_off; bool rope, isq = false;
        if (c < 2568) { base = 2056; x = c - base; rope = true; isq = true; ws_off = WS_NQ; }
        else if (c < 2696) { base = 2568; x = c - base; rope = true; ws_off = WS_KC; }
        else if (c < 2824) { base = 2696; x = c - base; rope = false; ws_off = WS_VC; }
        else if (c < 2952) { base = 2824; x = c - base; rope = true; ws_off = WS_KSL; }
        else if (c < 3080) { base = 2952; x = c - base; rope = false; ws_off = WS_VSL; }
        else if (c < 3208) { base = 3080; x = c - base; rope = true; ws_off = WS_KWN; }
        else { base = 3208; x = c - base; rope = false; ws_off = WS_VWN; }
        const int hd = x >> 6, d = x & 63;
        if (rope) { const float z0 = dbg_z(F, row, c), z1 = dbg_z(F, row, base + hd * 64 + (d ^ 32)); const float cs = COS[(size_t)row * 32 + (d & 31)], sn = SIN[(size_t)row * 32 + (d & 31)];
            ref = d < 32 ? z0 * cs - z1 * sn : z0 * cs + z1 * sn; if (isq) ref *= QSCALE; }
        else ref = dbg_z(F, row, c);
        got = isq ? bf2f(WSP(bf16_t, ws_off)[(size_t)row * 512 + hd * 64 + d]) : bf2f(WSP(bf16_t, ws_off)[((size_t)(b * 2 + hd) * SEQ + sq) * 64 + d]);
    }
    if (!dbg_close(got, ref)) atomicAdd(cnt, 1u);
}
#endif


#if DBG_STOP >= 0
__device__ void dbg_check_nsa(Frame& F, unsigned* cnt) {
    const int lane = F.lane, gw = blockIdx.x * NWAVES + F.wave;
    LAS float* P = (LAS float*)(F.lds + F.wave * 2048);
    const unsigned hsh = dbg_hash(gw * 7 + 3);
    const int b = hsh & 7, hh = (hsh >> 3) & 7, g = hh >> 2;
    int t; { const int cls = gw & 7; const unsigned r = dbg_hash(gw * 13 + 5);
        t = cls == 0 ? (int)(r % 31) : cls == 1 ? 31 + (int)(r % 33) : cls == 2 ? 64 + (int)(r % 960) : cls == 3 ? 1024 + (int)(r % 64) : cls == 4 ? 4032 + (int)(r % 64) : 1024 + (int)(r % 3072); }
    const size_t row = (size_t)b * SEQ + t; const int bg = b * 2 + g, cur = t >> 6;
    const bf16_t* Kc = WSP(bf16_t, WS_KCMP) + (size_t)bg * 256 * 64; const bf16_t* Vc = WSP(bf16_t, WS_VCMP) + (size_t)bg * 256 * 64;
    const int lim = t >= 31 ? (t - 31) >> 4 : -1;
    float imp = 0.f, oc = 0.f;
    for (int hd = 0; hd < 4; ++hd) {
        const bf16_t* q = WSP(bf16_t, WS_NQ) + row * 512 + (4 * g + hd) * 64;
        float sc[4]; float mx = -INFINITY;
        for (int k = 0; k < 4; ++k) { const int i = lane + 64 * k; float s = 0.f; for (int d = 0; d < 64; ++d) s += bf2f(q[d]) * bf2f(Kc[(size_t)i * 64 + d]); sc[k] = (i <= lim) ? s : -INFINITY; mx = fmaxf(mx, sc[k]); }
        mx = wave_max(mx); const float mref = (mx == -INFINITY) ? 0.f : mx; float l = 0.f;
        for (int k = 0; k < 4; ++k) { sc[k] = ex2(sc[k] - mref); l += sc[k]; }
        l = wave_sum(l); const float il = 1.f / fmaxf(l, 1e-30f);
        for (int k = 0; k < 4; ++k) P[lane + 64 * k] = sc[k] * il;
        asm volatile("s_waitcnt lgkmcnt(0)" ::: "memory");
        { const int j = lane; float a = 0.f; for (int x = 0; x < 3; ++x) a += 2.f * P[4 * j + x]; a += P[4 * j + 3]; if (j > 0) a += P[4 * j - 1]; imp += a; }
        if (4 * g + hd == hh) { for (int i = 0; i < 255; ++i) oc += P[i] * bf2f(Vc[(size_t)i * 64 + lane]); }
        asm volatile("s_waitcnt lgkmcnt(0)" ::: "memory");
    }
    float score = imp; { const int j = lane; if (j == 0 || j == cur || j == cur - 1) score = INFINITY; else if (64 * j > t) score = -INFINITY; }
    int rank = 0; for (int j2 = 0; j2 < 64; ++j2) { const float s2 = __shfl(score, j2); rank += (s2 > score || (s2 == score && j2 < lane)) ? 1 : 0; }
    const unsigned long long selm = __ballot(rank < 16);
    const bf16_t* q = WSP(bf16_t, WS_NQ) + row * 512 + hh * 64;
    float os = 0.f, ow = 0.f;
    for (int br = 0; br < 2; ++br) {
        const bf16_t* K = WSP(bf16_t, br ? WS_KWN : WS_KSL) + (size_t)bg * SEQ * 64; const bf16_t* V = WSP(bf16_t, br ? WS_VWN : WS_VSL) + (size_t)bg * SEQ * 64;
        float m = -INFINITY, l = 0.f, o = 0.f;
        for (int j = 0; j < 64; ++j) {
            if (br == 0 && !((selm >> j) & 1ull)) continue;
            const int kp = 64 * j + lane; bool valid = kp <= t; if (br == 1) valid = valid && kp > t - 512;
            if (!__any(valid)) continue;
            float s = 0.f; for (int d = 0; d < 64; ++d) s += bf2f(q[d]) * bf2f(K[(size_t)kp * 64 + d]);
            s = valid ? s : -INFINITY;
            const float mn = fmaxf(m, wave_max(s)); const float alpha = (m == -INFINITY) ? 0.f : ex2(m - mn); const float pp = ex2(s - mn);
            l = l * alpha + wave_sum(pp); o *= alpha;
            for (int x = 0; x < 64; ++x) o += __shfl(pp, x) * bf2f(V[(size_t)(64 * j + x) * 64 + lane]);
            m = mn;
        }
        const float r = o / fmaxf(l, 1e-30f); if (br) ow = r; else os = r;
    }
    const float* gp = WSP(float, WS_NGT) + row * 24 + hh * 3;
    const float ref = gp[0] * oc + gp[1] * os + gp[2] * ow;
    const float got = bf2f(WSP(bf16_t, WS_YCAT)[row * 1024 + 512 + hh * 64 + lane]);
    const float sq = wave_sum(ref * ref); const float tol = 0.03f * fabsf(ref) + 0.03f * sqrtf(sq * (1.f / 64.f)) + 1e-4f;
    const bool bad = !(fabsf(got - ref) <= tol);
    if (__any(bad) && lane == 0) atomicAdd(cnt, 1u);
}
#endif


#if DBG_STOP >= 0
__device__ void dbg_check_mlstm(Frame& F, unsigned* cnt) {
    const int lane = F.lane, gw = blockIdx.x * NWAVES + F.wave;
    const unsigned hsh = dbg_hash(gw * 11 + 1);
    const int b = hsh & 7, h = (hsh >> 3) & 3;
    int t; { const int cls = gw & 7; const unsigned r = dbg_hash(gw * 17 + 9);
        t = cls == 0 ? (int)(r % 4) : cls == 1 ? 60 + (int)(r % 8) : cls == 2 ? 64 * (1 + (int)(r % 60)) + (int)((r >> 8) % 3) : cls == 3 ? 64 * (1 + (int)(r % 60)) + 63 : cls == 4 ? 4000 + (int)(r % 96) : (int)(r % 4096); }
    const int bh = b * 4 + h; const float* GI = WSP(float, WS_GI) + (size_t)bh * SEQ; const float* GF = WSP(float, WS_GF) + (size_t)bh * SEQ;
    const bf16_t* MQ = WSP(bf16_t, WS_MQ); const bf16_t* MK = WSP(bf16_t, WS_MK); const bf16_t* MV = WSP(bf16_t, WS_MV); const float* cw = IN_F(10);
    float carry = 0.f, M = 0.f, Bt = 0.f;
    for (int s0 = 0; s0 <= t; s0 += 64) { const int s = s0 + lane; float lf = (s <= t) ? GF[s] : 0.f;
        float bs = lf;
        for (int o = 1; o < 64; o <<= 1) { const float x = __shfl_up(bs, o); if (lane >= o) bs += x; }
        bs += carry; const float u = (s <= t) ? GI[s] - bs : -INFINITY; M = fmaxf(M, wave_max(u));
        if (s0 + 63 >= t) Bt = __shfl(bs, t - s0);
        carry = __shfl(bs, 63); }
    float q0 = 0.f, q1 = 0.f;
    for (int j = 0; j < 4; ++j) { const int ss = t - 3 + j; if (ss >= 0) { const bf16_t* rp = MQ + ((size_t)b * SEQ + ss) * 512 + h * 128;
        q0 += bf2f(rp[lane]) * cw[j * 1024 + h * 128 + lane]; q1 += bf2f(rp[64 + lane]) * cw[j * 1024 + h * 128 + 64 + lane]; } }
    q0 = dbg_bfr(silu_f(q0)); q1 = dbg_bfr(silu_f(q1));
    LAS float* QS = (LAS float*)(F.lds + F.wave * 2048); QS[lane] = q0; QS[64 + lane] = q1;
    asm volatile("s_waitcnt lgkmcnt(0)" ::: "memory");
    float n0 = 0.f, n1 = 0.f, den = 0.f; carry = 0.f;
    for (int s0 = 0; s0 <= t; s0 += 64) { const int s = s0 + lane; const bool act = s <= t; float lf = act ? GF[s] : 0.f;
        float bs = lf;
        for (int o = 1; o < 64; o <<= 1) { const float x = __shfl_up(bs, o); if (lane >= o) bs += x; }
        bs += carry; carry = __shfl(bs, 63);
        float c = 0.f;
        if (act) { float qk = 0.f;
            for (int ch = 0; ch < 128; ++ch) { float kc = 0.f;
                for (int j = 0; j < 4; ++j) { const int ss = s - 3 + j; if (ss >= 0) kc += bf2f(MK[((size_t)b * SEQ + ss) * 512 + h * 128 + ch]) * cw[j * 1024 + 512 + h * 128 + ch]; }
                qk += QS[ch] * dbg_bfr(silu_f(kc) * 0.08838834764831845f); }
            c = __expf(GI[s] - bs - M) * qk; }
        den += c;
        for (int x = 0; x < 64; ++x) { const float cx = __shfl(c, x); if (s0 + x <= t) { const bf16_t* vp = MV + ((size_t)b * SEQ + s0 + x) * 512 + h * 128; n0 += cx * bf2f(vp[lane]); n1 += cx * bf2f(vp[64 + lane]); } } }
    den = wave_sum(den);
    const float hd = fmaxf(fabsf(den), __expf(-(Bt + M)));
    const float h0 = n0 / hd, h1 = n1 / hd;
    const float rn = rsqrtf(wave_sum(h0 * h0 + h1 * h1) * (1.f / 128.f) + RMS_EPS);
    const size_t row = (size_t)b * SEQ + t; const bf16_t* mo = WSP(bf16_t, WS_MO) + row * 512 + h * 128; const float* hn = IN_F(12) + h * 128;
    const float r0 = h0 * rn * hn[lane] * sigmoid_f(bf2f(mo[lane])), r1 = h1 * rn * hn[64 + lane] * sigmoid_f(bf2f(mo[64 + lane]));
    const float g0 = bf2f(WSP(bf16_t, WS_YCAT)[row * 1024 + h * 128 + lane]), g1 = bf2f(WSP(bf16_t, WS_YCAT)[row * 1024 + h * 128 + 64 + lane]);
    const float rms = sqrtf(wave_sum(r0 * r0 + r1 * r1) * (1.f / 128.f));
    const bool bad = !(fabsf(g0 - r0) <= 0.04f * fabsf(r0) + 0.04f * rms + 1e-4f) || !(fabsf(g1 - r1) <= 0.04f * fabsf(r1) + 0.04f * rms + 1e-4f);
    if (__any(bad) && lane == 0) atomicAdd(cnt, 1u);
}
#endif


#if DBG_STOP >= 0
__device__ void dbg_check_cmp(Frame& F, unsigned* cnt) {
    const int lane = F.lane, gw = blockIdx.x * NWAVES + F.wave;
    const unsigned hsh = dbg_hash(gw * 5 + 2);
    const int kv = hsh & 1, bg = (hsh >> 1) & 15; int i = (hsh >> 5) % 255; if ((gw & 15) == 0) i = 254; if ((gw & 15) == 1) i = 0;
    const bf16_t* X = WSP(bf16_t, kv ? WS_VC : WS_KC) + (size_t)bg * SEQ * 64 + (size_t)i * 1024;
    const float* pe = IN_F(kv ? 16 : 13); const float* w1 = IN_F(kv ? 17 : 14); const float* w2 = IN_F(kv ? 18 : 15);
    float h0 = 0.f, h1 = 0.f;
    for (int k = 0; k < 2048; ++k) { const float xv = bf2f(X[k]) + pe[k]; h0 += xv * w1[(size_t)k * 128 + lane]; h1 += xv * w1[(size_t)k * 128 + 64 + lane]; }
    LAS float* H = (LAS float*)(F.lds + F.wave * 2048); H[lane] = silu_f(h0); H[64 + lane] = silu_f(h1);
    asm volatile("s_waitcnt lgkmcnt(0)" ::: "memory");
    float o = 0.f; for (int n = 0; n < 128; ++n) o += H[n] * w2[n * 64 + lane];
    const float got = bf2f(WSP(bf16_t, kv ? WS_VCMP : WS_KCMP)[((size_t)bg * 256 + i) * 64 + lane]);
    const float rms = sqrtf(wave_sum(o * o) * (1.f / 64.f));
    const bool bad = !(fabsf(got - o) <= 0.03f * fabsf(o) + 0.03f * rms + 1e-4f);
    if (__any(bad) && lane == 0) atomicAdd(cnt, 1u);
}
#endif

__device__ __forceinline__ bool phase_tid(Frame& F) { asm volatile("" : "+v"(F.tid)); F.lane = F.tid & 63; return true; }
constexpr int NPHASE = 11;
__global__ void __launch_bounds__(NTHR, 2) mega_fwd(Args args) {
    extern __shared__ __attribute__((aligned(16))) unsigned char lds_raw[];
    Frame F;
    F.lds = (LAS unsigned char*)lds_raw; F.in = args.in; F.out = args.out; F.ws = args.ws;
    F.tid = threadIdx.x; F.lane = F.tid & 63; F.wave = __builtin_amdgcn_readfirstlane(F.tid >> 6);
    F.G = gridDim.x; { const int bx = blockIdx.x; F.vcu = (F.G % 8 == 0) ? (bx % 8) * (F.G / 8) + bx / 8 : bx; }
    volatile LAS unsigned* MISC = (volatile LAS unsigned*)(F.lds + MISC_OFF);
    for (int u = F.tid; u < (LDS_BYTES - MISC_OFF) / 4; u += NTHR) ((LAS unsigned*)(F.lds + MISC_OFF))[u] = 0u;
    __syncthreads();
    unsigned* ctl = (unsigned*)(F.ws + WS_CTL);
    XcdBarrier bar; bar.bar = ctl + CW_BAR; bar.x = 0; bar.st = nullptr;
    const int lo = args.ph_lo, hi = args.ph_hi;
    if (hi - lo > 1) bar = xcd_barrier_post(ctl + CW_BAR, MISC + 8);
#ifndef PHASE_MASK
#define PHASE_MASK 0xFFFF
#endif
#define IN(k) (((PHASE_MASK >> (k)) & 1) && lo <= (k) && (k) < hi && (DBG_STOP < 0 || (k) <= DBG_STOP))
#define SEAM(k) do { if (IN(k) && IN((k) + 1)) xcd_barrier(bar); } while (0)
    LAS int* TST = (LAS int*)(F.lds + MISC_OFF + 256);
    LAS int* CNT = TST + 40;

#define PHASE_TID() if (phase_tid(F))
    if (IN(0)) PHASE_TID() _Pragma("nounroll") for (int rep = 0; rep <= ((REP_MASK >> 0) & 1); ++rep) { p0_phase(F); } SEAM(0);
    if (IN(1)) PHASE_TID() _Pragma("nounroll") for (int rep = 0; rep <= ((REP_MASK >> 1) & 1); ++rep) { p1a_phase(F); } SEAM(1);
    if (IN(2)) PHASE_TID() _Pragma("nounroll") for (int rep = 0; rep <= ((REP_MASK >> 2) & 1); ++rep) {
        pg8::DenseOrder S; S.init(NTOK, INWP, DM / 2, F.G, (int)blockIdx.x);
        EpiIn E{F.ws, IN_F(11), F.lds};
        pg8::gemm_phase<true>(F.lds, WSP(bf16_t, WS_H1), WSP(bf16_t, WS_WINT), DM / 2, S, E);
    } SEAM(2);
    if (IN(3)) PHASE_TID() _Pragma("nounroll") for (int rep = 0; rep <= ((REP_MASK >> 3) & 1); ++rep) {
        REPS(0) mlstm_a_phase(F);
        REPS(1) for (int j = F.vcu; j < 256; j += F.G) compress_job(F, j);
    } SEAM(3);
    if (IN(4)) PHASE_TID() _Pragma("nounroll") for (int rep = 0; rep <= ((REP_MASK >> 4) & 1); ++rep) {
        REPS(2) for (int j = F.vcu; j < 256; j += F.G) mlstm_scan_job(F, j);
        REPS(3) for (int u = F.vcu; u < 512; u += F.G) {
            const int bg = u >> 5, q = u & 31;
            _Pragma("nounroll") for (int hf = 0; hf < 2; ++hf) nsa_unit(F, bg >> 1, bg & 1, hf ? q : 63 - q);
        }
    } SEAM(4);
    if (IN(5)) PHASE_TID() _Pragma("nounroll") for (int rep = 0; rep <= ((REP_MASK >> 5) & 1); ++rep) {
        REPS(4) mlstm_c_phase(F);
        REPS(5) expert_convert(F);
    } SEAM(5);
    if (IN(6)) PHASE_TID() _Pragma("nounroll") for (int rep = 0; rep <= ((REP_MASK >> 6) & 1); ++rep) {
        pg8::DenseOrder S; S.init(NTOK, DM, DM, F.G, (int)blockIdx.x);
        EpiBf16 E{WSP(bf16_t, WS_Y), DM};
        pg8::gemm_phase<false>(F.lds, WSP(bf16_t, WS_YCAT), WSP(bf16_t, WS_WOUTT), DM, S, E);
    } SEAM(6);
    if (IN(7)) PHASE_TID() { s6_phase(F); } SEAM(7);
    if (IN(8)) PHASE_TID() _Pragma("nounroll") for (int rep = 0; rep <= ((REP_MASK >> 8) & 1); ++rep) {
        moe_tables(F, TST, CNT);
        pg8::MoeOrder S{TST, CNT, WSP(int, WS_LIST), F.G, F.vcu, DM / 2, 4, true};
        EpiUpI8 E{WSP(bf16_t, WS_HB), WSP(float, WS_SAL), WSP(float, WS_SB13), TST, F.lds};
        pg8::gemm_phase<true>(F.lds, WSP(bf16_t, WS_H2Q), WSP(bf16_t, WS_W13T), DM / 2, S, E);
        {
            const int U = TST[32] * 4, full = U / F.G, rem = U % F.G;
            if (rem == 0) w2_convert(F, F.vcu, F.G); else if (F.vcu >= rem) w2_convert(F, F.vcu - rem, F.G - rem);
            (void)full; }
    } SEAM(8);
    if (IN(9)) PHASE_TID() _Pragma("nounroll") for (int rep = 0; rep <= ((REP_MASK >> 9) & 1); ++rep) {
        moe_tables(F, TST, CNT);
        pg8::MoeOrder S{TST, CNT, WSP(int, WS_LIST), F.G, F.vcu, EFF, 4, false};
        EpiBf16 E{WSP(bf16_t, WS_YB), DM};
        pg8::gemm_phase<false>(F.lds, WSP(bf16_t, WS_HB), WSP(bf16_t, WS_W2T), EFF, S, E);
    } SEAM(9);
    if (IN(10)) PHASE_TID() { moe_tables(F, TST, CNT); s10_phase(F, TST); }
#if DBG_STOP >= 0
    xcd_barrier(bar);
#if DBG_CHECK == 1 || DBG_CHECK == 3 || DBG_CHECK == 4 || DBG_CHECK == 5
    { unsigned* cw = (unsigned*)(F.ws + WS_CTL) + CW_DBG + 1; if (DBG_CHECK == 1) dbg_check_p1(F, cw); else if (DBG_CHECK == 3) dbg_check_nsa(F, cw); else if (DBG_CHECK == 4) dbg_check_mlstm(F, cw); else dbg_check_cmp(F, cw); xcd_barrier(bar);
      const unsigned nb = __hip_atomic_load(cw, __ATOMIC_RELAXED, __HIP_MEMORY_SCOPE_AGENT);
      const float sc = nb == 0 ? 1.f : nb < 4 ? 2.f : nb < 16 ? 3.f : nb < 64 ? 4.f : nb < 256 ? 5.f : nb < 1024 ? 6.f : 7.f;
      const float* x = IN_F(0); for (size_t k = (size_t)blockIdx.x * NTHR + F.tid; k < (size_t)NTOK * DM; k += (size_t)F.G * NTHR) F.out[k] = x[k] * sc; }
#elif DBG_CHECK == 2
    { const unsigned id = __hip_atomic_load((unsigned*)(F.ws + WS_CTL) + CW_DBG, __ATOMIC_RELAXED, __HIP_MEMORY_SCOPE_AGENT);
      float sc = (id >= 1000u) ? 1.f : 1.f + (float)id;
      if (__hip_atomic_load((unsigned*)(F.ws + WS_CTL) + CW_BAR + XB_TMO, __ATOMIC_RELAXED, __HIP_MEMORY_SCOPE_AGENT) != 0u) sc = 61.f;
      const float* x = IN_F(0); for (size_t k = (size_t)blockIdx.x * NTHR + F.tid; k < (size_t)NTOK * DM; k += (size_t)F.G * NTHR) F.out[k] = x[k] * sc; }
#else
    dbg_phase(F, bar);
#endif
#endif
#undef IN
#undef SEAM
}

extern "C" void kernel_launch(void* const* d_in, const int* in_sizes, int n_in, void* d_out, int out_size, void* d_ws, size_t ws_size, hipStream_t stream) {
    static int grid = 0;
    if (grid == 0) {
        int dev = 0, cus = 0;
        if (hipGetDevice(&dev) != hipSuccess || hipDeviceGetAttribute(&cus, hipDeviceAttributeMultiprocessorCount, dev) != hipSuccess) cus = 256;
        if (hipFuncSetAttribute((const void*)mega_fwd, hipFuncAttributeMaxDynamicSharedMemorySize, LDS_BYTES) != hipSuccess) fprintf(stderr, "kernel_launch: hipFuncSetAttribute failed\n");
        (void)hipGetLastError();
        grid = cus > 0 ? cus : 256;
        if (n_in != 27 || ws_size < WS_END) fprintf(stderr, "kernel_launch: unexpected n_in %d / ws_size %zu (need %zu)\n", n_in, ws_size, (size_t)WS_END);
    }
    (void)hipMemsetAsync((char*)d_ws + WS_CTL, 0, 64 * 1024, stream);
#if DBG_STOP >= 0
    (void)hipMemsetAsync((char*)d_ws + WS_CTL + CW_DBG * 4, 0x7F, 4, stream);
#endif
    Args a{};
    for (int i = 0; i < 27; ++i) a.in[i] = d_in[i];
    a.out = (float*)d_out; a.ws = (unsigned char*)d_ws;
#if MK_N_LAUNCHES == 1
    a.ph_lo = 0; a.ph_hi = NPHASE;
    hipLaunchKernelGGL(mega_fwd, dim3(grid), dim3(NTHR), LDS_BYTES, stream, a);
#else
    for (int p = 0; p < NPHASE; ++p) { a.ph_lo = p; a.ph_hi = p + 1; hipLaunchKernelGGL(mega_fwd, dim3(grid), dim3(NTHR), LDS_BYTES, stream, a); }
#endif
}
```

```cpp
#include <hip/hip_runtime.h>
#include <cstdio>
#include <cstdint>
#include <type_traits>

#define LAS __attribute__((address_space(3)))
typedef unsigned short bf16_t;
typedef short bf16x8 __attribute__((ext_vector_type(8)));
typedef short s16x4 __attribute__((ext_vector_type(4)));
typedef float f32x4 __attribute__((ext_vector_type(4)));
typedef float f32x16 __attribute__((ext_vector_type(16)));
typedef unsigned u32x4 __attribute__((ext_vector_type(4)));
typedef unsigned u32x2 __attribute__((ext_vector_type(2)));
typedef int i32x4 __attribute__((ext_vector_type(4)));
typedef _Float16 f16x8 __attribute__((ext_vector_type(8)));
typedef _Float16 f16x4 __attribute__((ext_vector_type(4)));

#ifndef MK_N_LAUNCHES
#define MK_N_LAUNCHES 1
#endif
#ifndef DBG_CHECK
#define DBG_CHECK 0
#endif
#ifndef REP_MASK
#define REP_MASK 0
#endif
#ifndef REP_SUB
#define REP_SUB 0
#endif
#ifndef NSA_DUP
#define NSA_DUP 0
#endif
#define NDUP(b) _Pragma("nounroll") for (int nd_ = 0; nd_ <= ((NSA_DUP >> (b)) & 1); ++nd_)
#define REPS(b) _Pragma("nounroll") for (int rs_ = 0; rs_ <= ((REP_SUB >> (b)) & 1); ++rs_)

constexpr int NB = 8, SEQ = 4096, DM = 1024, NTOK = NB * SEQ;
constexpr int MH = 4, MDH = 128;
constexpr int NHD = 8, NGRP = 2;
constexpr int INW = 3360, INWP = 3584;
constexpr int NEXP = 32, EFF = 512;
constexpr float RMS_EPS = 1e-6f;
constexpr float QSCALE = 0.125f * 1.4426950408889634f;
constexpr int NWAVES = 8, NTHR = 512;
constexpr int LDS_BYTES = 160 * 1024, MISC_OFF = 128 * 1024;
constexpr int MAXROWS = 73728;

constexpr size_t MiB = 1ull << 20, KiB = 1024;
constexpr size_t WS_CTL   = 0;
constexpr size_t WS_MOD   = 64 * KiB;
constexpr size_t WS_C1B   = WS_MOD + 192 * KiB;
constexpr size_t WS_GI    = WS_C1B + 4 * KiB;
constexpr size_t WS_GF    = WS_GI + 512 * KiB;
constexpr size_t WS_NGT   = WS_GF + 512 * KiB;
constexpr size_t WS_GSUM  = WS_NGT + 3 * MiB;
constexpr size_t WS_MLOC  = WS_GSUM + 8 * KiB;
constexpr size_t WS_MPREV = WS_MLOC + 8 * KiB;
constexpr size_t WS_NC    = WS_MPREV + 8 * KiB;
constexpr size_t WS_NPREV = WS_NC + 1 * MiB;
constexpr size_t WS_COS   = WS_NPREV + 1 * MiB;
constexpr size_t WS_SIN   = WS_COS + 4 * MiB;
constexpr size_t WS_WOUTT = WS_SIN + 4 * MiB;
constexpr size_t WS_CW1K  = WS_WOUTT + 2 * MiB;
constexpr size_t WS_CW1V  = WS_CW1K + 512 * KiB;
constexpr size_t WS_CW2K  = WS_CW1V + 512 * KiB;
constexpr size_t WS_CW2V  = WS_CW2K + 16 * KiB;
constexpr size_t WS_RWT   = WS_CW2V + 16 * KiB;
constexpr size_t WS_RWL   = WS_RWT + 96 * KiB;
constexpr size_t WS_KCMP  = WS_RWL + 96 * KiB;
constexpr size_t WS_VCMP  = WS_KCMP + 512 * KiB;
constexpr size_t WS_TOKE  = WS_VCMP + 512 * KiB;
constexpr size_t WS_TOKP  = WS_TOKE + 256 * KiB;
constexpr size_t WS_TOKG  = WS_TOKP + 256 * KiB;
constexpr size_t WS_LIST  = WS_TOKG + 256 * KiB;
constexpr size_t WS_SA    = WS_LIST + 8 * MiB;
constexpr size_t WS_SB13  = WS_SA + 128 * KiB;
constexpr size_t WS_SA1   = WS_SB13 + 128 * KiB;
constexpr size_t WS_SBW   = WS_SA1 + 128 * KiB;
constexpr size_t WS_SMALL_END = WS_SBW + 16 * KiB;
static_assert(WS_SMALL_END <= 32 * MiB, "small region overflow");
constexpr size_t WS_A     = 32 * MiB;
constexpr size_t WS_H1    = WS_A, WS_KVC = WS_A, WS_W13T = WS_A;
constexpr size_t WS_NQ    = 96 * MiB;
constexpr size_t WS_KC    = 128 * MiB, WS_VC = 136 * MiB, WS_KSL = 144 * MiB, WS_VSL = 152 * MiB, WS_KWN = 160 * MiB, WS_VWN = 168 * MiB;
constexpr size_t WS_W2T   = 96 * MiB;
constexpr size_t WS_MQ    = 176 * MiB, WS_MK = 208 * MiB, WS_MV = 240 * MiB, WS_MO = 272 * MiB;
constexpr size_t WS_Y     = 176 * MiB;
constexpr size_t WS_H2    = 240 * MiB;
constexpr size_t WS_CPREV = 304 * MiB;
constexpr size_t WS_WINT  = 304 * MiB;
constexpr size_t WS_HB    = 304 * MiB;
constexpr size_t WS_H2LO  = 304 * MiB;
constexpr size_t WS_YCAT  = 376 * MiB;
constexpr size_t WS_X1B   = 376 * MiB;
constexpr size_t WS_YB    = 128 * MiB;
constexpr size_t WS_H2Q   = 128 * MiB;
constexpr size_t WS_SAL   = 440 * MiB;
constexpr size_t WS_END   = 448 * MiB;

constexpr int CW_BAR = 0;
constexpr int CW_CNT = 4096;
constexpr int CW_DBG = 4200;

typedef __bf16 bf16x2_t __attribute__((ext_vector_type(2)));
typedef float f32x2_t __attribute__((ext_vector_type(2)));
__device__ __forceinline__ unsigned cvtpk(float lo, float hi) { const f32x2_t f = {lo, hi}; const bf16x2_t v = __builtin_convertvector(f, bf16x2_t); return __builtin_bit_cast(unsigned, v); }
__device__ __forceinline__ float bf2f(bf16_t b) { return __uint_as_float(((unsigned)b) << 16); }
__device__ __forceinline__ float bflo(unsigned w) { return __uint_as_float(w << 16); }
__device__ __forceinline__ float bfhi(unsigned w) { return __uint_as_float(w & 0xffff0000u); }
__device__ __forceinline__ bf16_t f2bf(float f) { return (bf16_t)(cvtpk(f, 0.f) & 0xffffu); }
__device__ __forceinline__ float wave_sum(float v) {
#pragma unroll
    for (int o = 1; o < 64; o <<= 1) v += __shfl_xor(v, o);
    return v;
}
__device__ __forceinline__ float wave_max(float v) {
#pragma unroll
    for (int o = 1; o < 64; o <<= 1) v = fmaxf(v, __shfl_xor(v, o));
    return v;
}
__device__ __forceinline__ float sigmoid_f(float x) { return __builtin_amdgcn_rcpf(1.f + __builtin_amdgcn_exp2f(-1.4426950408889634f * x)); }
__device__ __forceinline__ float silu_f(float x) { return x * __builtin_amdgcn_rcpf(1.f + __builtin_amdgcn_exp2f(-1.4426950408889634f * x)); }
__device__ __forceinline__ float logsigmoid_f(float x) { return fminf(x, 0.f) - log1pf(__expf(-fabsf(x))); }
__device__ __forceinline__ float ex2(float x) { return __builtin_amdgcn_exp2f(x); }
#define MFMA32(a, b, c) __builtin_amdgcn_mfma_f32_32x32x16_bf16(a, b, c, 0, 0, 0)
#define MFMA16(a, b, c) __builtin_amdgcn_mfma_f32_16x16x32_bf16(a, b, c, 0, 0, 0)
typedef short v4i16_t __attribute__((ext_vector_type(4)));
__device__ __forceinline__ s16x4 vtr(LAS const unsigned char* p) { return __builtin_bit_cast(s16x4, __builtin_amdgcn_ds_read_tr16_b64_v4i16((LAS v4i16_t*)p)); }
__device__ __forceinline__ int crow(int r, int hi) { return (r & 3) + 8 * (r >> 2) + 4 * hi; }
__device__ __forceinline__ u32x4 widen_pair(u32x2 A, u32x2 B) {
    const auto r0 = __builtin_amdgcn_permlane32_swap(A.x, B.x, false, false); const auto r1 = __builtin_amdgcn_permlane32_swap(A.y, B.y, false, false);
    return (u32x4){r0[0], r1[0], r0[1], r1[1]}; }
__device__ __forceinline__ u32x4 widen_rows16(u32x2 X, u32x2 Y) {
    const auto r0 = __builtin_amdgcn_permlane16_swap(X.x, Y.x, false, false); const auto r1 = __builtin_amdgcn_permlane16_swap(X.y, Y.y, false, false);
    return (u32x4){r0[0], r1[0], r0[1], r1[1]}; }
__device__ __forceinline__ u32x4 quad_transpose(u32x4 d, int lane) {
    const bool b0 = lane & 1, b1 = lane & 2;
    { const unsigned t0 = b0 ? d.x : d.y, t1 = b0 ? d.z : d.w;
      const unsigned r0 = (unsigned)__builtin_amdgcn_mov_dpp((int)t0, 0xB1, 0xF, 0xF, true), r1 = (unsigned)__builtin_amdgcn_mov_dpp((int)t1, 0xB1, 0xF, 0xF, true);
      if (b0) { d.x = r0; d.z = r1; } else { d.y = r0; d.w = r1; } }
    { const unsigned t0 = b1 ? d.x : d.z, t1 = b1 ? d.y : d.w;
      const unsigned r0 = (unsigned)__builtin_amdgcn_mov_dpp((int)t0, 0x4E, 0xF, 0xF, true), r1 = (unsigned)__builtin_amdgcn_mov_dpp((int)t1, 0x4E, 0xF, 0xF, true);
      if (b1) { d.x = r0; d.y = r1; } else { d.z = r0; d.w = r1; } }
    return d; }
__device__ __forceinline__ u32x4 pair_widen(u32x2 A, u32x2 B, int lane) {
    const bool od = lane & 1; const u32x2 t = od ? A : B;
    u32x2 r; r.x = (unsigned)__builtin_amdgcn_mov_dpp((int)t.x, 0xB1, 0xF, 0xF, true); r.y = (unsigned)__builtin_amdgcn_mov_dpp((int)t.y, 0xB1, 0xF, 0xF, true);
    return od ? (u32x4){r.x, r.y, B.x, B.y} : (u32x4){A.x, A.y, r.x, r.y}; }
__device__ __forceinline__ void pair_narrow(u32x4 v, int lane, u32x2& A, u32x2& B) {
    const bool od = lane & 1; const u32x2 lo = {v.x, v.y}, hi = {v.z, v.w}; const u32x2 t = od ? lo : hi;
    u32x2 r; r.x = (unsigned)__builtin_amdgcn_mov_dpp((int)t.x, 0xB1, 0xF, 0xF, true); r.y = (unsigned)__builtin_amdgcn_mov_dpp((int)t.y, 0xB1, 0xF, 0xF, true);
    A = od ? r : lo; B = od ? hi : r; }
__device__ __forceinline__ bf16x8 mk8(s16x4 lo, s16x4 hi) { return (bf16x8){lo[0], lo[1], lo[2], lo[3], hi[0], hi[1], hi[2], hi[3]}; }

#define XB_TMO      128
#define XB_XCNT(j)  (256  + 64 * (j))
#define XB_XSUB(j)  (1280 + 64 * (j))
#define XB_XGEN(j)  (2304 + 64 * (j))
#define XB_TOP      3328
#define XB_TOPGEN   3392
#define XCD_BAR_WORDS 3456
#define XB_SPIN_CAP (1u << 18)
__device__ __forceinline__ unsigned xb_ld(unsigned* p)              { return __hip_atomic_load(p, __ATOMIC_RELAXED, __HIP_MEMORY_SCOPE_AGENT); }
__device__ __forceinline__ unsigned xb_add(unsigned* p, unsigned v) { return __hip_atomic_fetch_add(p, v, __ATOMIC_RELAXED, __HIP_MEMORY_SCOPE_AGENT); }
__device__ __forceinline__ unsigned xb_xcc_id() { return (unsigned)__builtin_amdgcn_s_getreg((3 << 11) | 20) & 0xFu; }
#define XB_SPIN(cond, bar) do { unsigned _sp = 0; while (cond) { __builtin_amdgcn_s_sleep(1); \
    if ((++_sp & 255u) == 0u) { if (xb_ld(&(bar)[XB_TMO])) break; if (_sp > XB_SPIN_CAP) { atomicAdd(&(bar)[XB_TMO], 1u); break; } } } } while (0)
struct XcdBarrier { unsigned* bar; unsigned x; volatile LAS unsigned* st; };
__device__ __forceinline__ XcdBarrier xcd_barrier_post(unsigned* bar, volatile LAS unsigned* st) {
    XcdBarrier b; b.bar = bar; b.x = xb_xcc_id(); b.st = st;
    if (threadIdx.x == 0) (void)xb_add(&bar[XB_XCNT(b.x)], 1u);
    return b;
}
__device__ __forceinline__ void xcd_barrier_complete(unsigned* bar, unsigned x, unsigned& nloc, unsigned& nx) {
    const unsigned G = gridDim.x * gridDim.y * gridDim.z;
    unsigned sum, cnt, mine, sp = 0u;
    for (;;) {
        sum = 0u; cnt = 0u; mine = 0u;
#pragma unroll
        for (unsigned j = 0; j < 16; ++j) { const unsigned c = xb_ld(&bar[XB_XCNT(j)]); sum += c; cnt += (c > 0u) ? 1u : 0u; mine = (j == x) ? c : mine; }
        if (sum == G) break;
        __builtin_amdgcn_s_sleep(1);
        if ((++sp & 255u) == 0u) { if (xb_ld(&bar[XB_TMO])) break; if (sp > XB_SPIN_CAP) { atomicAdd(&bar[XB_TMO], 1u); break; } }
    }
    nloc = mine > 0u ? mine : 1u; nx = cnt > 0u ? cnt : 1u;
}
__device__ __forceinline__ void xcd_barrier(const XcdBarrier& b) {
    asm volatile("s_waitcnt vmcnt(0)" ::: "memory");
    __syncthreads();
    if (threadIdx.x == 0) {
        unsigned* bar = b.bar;
        __builtin_amdgcn_s_waitcnt(0);
        unsigned nloc = b.st[0], nx = b.st[1];
        if (nloc == 0u) { xcd_barrier_complete(bar, b.x, nloc, nx); b.st[0] = nloc; b.st[1] = nx; }
        const unsigned old = xb_add(&bar[XB_XSUB(b.x)], 1u);
        const unsigned gen = old / nloc;
        if (old + 1u == (gen + 1u) * nloc) {
            __builtin_amdgcn_fence(__ATOMIC_RELEASE, "agent");
            asm volatile("s_waitcnt vmcnt(0)" ::: "memory");
            const unsigned og = xb_add(&bar[XB_TOP], 1u);
            const unsigned tg = og / nx;
            if (og + 1u == (tg + 1u) * nx) xb_add(&bar[XB_TOPGEN], 1u);
            else XB_SPIN(xb_ld(&bar[XB_TOPGEN]) == tg, bar);
            __builtin_amdgcn_fence(__ATOMIC_ACQUIRE, "agent");
            xb_add(&bar[XB_XGEN(b.x)], 1u);
            asm volatile("s_waitcnt vmcnt(0)" ::: "memory");
        } else {
            XB_SPIN(xb_ld(&bar[XB_XGEN(b.x)]) == gen, bar);
            __builtin_amdgcn_fence(__ATOMIC_ACQUIRE, "agent");
            asm volatile("s_waitcnt vmcnt(0)" ::: "memory");
        }
    }
    __syncthreads();
}

struct Args { const void* in[27]; float* out; unsigned char* ws; int ph_lo, ph_hi; };
struct Frame {
    LAS unsigned char* lds;
    const void* const* in; float* out; unsigned char* ws;
    int tid, lane, wave, vcu, G;
};
#define IN_F(k) ((const float*)F.in[k])
#define WSP(T, off) ((T*)(F.ws + (off)))

namespace pg8 {
constexpr int BM = 256, BK = 64, HALF = 128, HTB = HALF * BK * 2, STAGE_BYTES = 8 * HTB, NXCD = 8, WGM = 8;
__host__ __device__ __forceinline__ int lds_byte(int r, int c) { const int st = (r >> 4) * 2 + (c >> 5), rr = r & 15, cc = c & 31, ob = rr * 64 + cc * 2; return st * 1024 + (ob ^ (((ob >> 9) & 1) << 5)); }
__host__ __device__ __forceinline__ void stage_rc(int b, int& R, int& C) { const int st = b / 1024, sb = b % 1024, swz = sb ^ (((sb >> 9) & 1) << 5); R = (st >> 1) * 16 + swz / 64; C = (st & 1) * 32 + (swz % 64) / 2; }
__host__ __device__ __forceinline__ int perm32(int rho) { const int n = rho >> 4, i = rho & 15; return 8 * (i >> 2) + 4 * n + (i & 3); }
struct Unit { int pm, pn, e, nrow; };

template <bool I8, class Epi, class Sched>
__device__ __forceinline__ void gemm_phase(LAS unsigned char* lds, const void* Abase, const void* Bbase, const int K, const Sched& S, const Epi& E) {
    const int tid = threadIdx.x, wid = __builtin_amdgcn_readfirstlane(tid >> 6), lane = tid & 63, wr = wid >> 2, wc = wid & 3, fr = lane & 15, fq = lane >> 4;
    const int nt = K / BK;
    int Rr[2], Cc[2]; unsigned voffB[2];
#pragma unroll
    for (int i = 0; i < 2; ++i) { int R, C; stage_rc(tid * 16 + i * 8192, R, C); Rr[i] = R; Cc[i] = C; const int Rb = (R & ~31) + perm32(R & 31); voffB[i] = (unsigned)(Rb * K + C) * 2u; }
    const size_t kstep = (size_t)(BK * 2);
    const size_t hstepB = (size_t)HALF * K * 2;
    const unsigned ldsw = (unsigned)wid * 1024u;
    const int aoff = lds_byte(wr * 64 + fr, fq * 8), boff = lds_byte(wc * 32 + fr, fq * 8);
#define PG8_SA(b, h) (((b) * 2 + (h)) * HTB)
#define PG8_SB(b, h) ((4 + (b) * 2 + (h)) * HTB)
#define PG8_STAGEB(bufoff, gbase) do { _Pragma("unroll") for (int _i = 0; _i < 2; ++_i) \
        __builtin_amdgcn_global_load_lds((const unsigned*)((const char*)(gbase) + voffB[_i]), (LAS unsigned*)(lds + (bufoff) + ldsw + _i * 8192), 16, 0, 0); } while (0)
#define PG8_STAGEA(bufoff, o0, o1, ktb) do { const char* _p = (const char*)Abase + (ktb); \
        __builtin_amdgcn_global_load_lds((const unsigned*)(_p + (o0)), (LAS unsigned*)(lds + (bufoff) + ldsw), 16, 0, 0); \
        __builtin_amdgcn_global_load_lds((const unsigned*)(_p + (o1)), (LAS unsigned*)(lds + (bufoff) + ldsw + 8192), 16, 0, 0); } while (0)
#define PG8_LDA(dst, b, h) do { _Pragma("unroll") for (int m = 0; m < 4; ++m) _Pragma("unroll") for (int k = 0; k < 2; ++k) dst[m][k] = *(const LAS bf16x8*)(lds + PG8_SA(b, h) + aoff + m * 2048 + k * 1024); } while (0)
#define PG8_LDB(dst, b, h) do { _Pragma("unroll") for (int n = 0; n < 2; ++n) _Pragma("unroll") for (int k = 0; k < 2; ++k) dst[n][k] = *(const LAS bf16x8*)(lds + PG8_SB(b, h) + boff + n * 2048 + k * 1024); } while (0)
#define PG8_MMA(ai, bj, At, Bt) do { __builtin_amdgcn_s_setprio(1); _Pragma("unroll") for (int m = 0; m < 4; ++m) _Pragma("unroll") for (int n = 0; n < 2; ++n) _Pragma("unroll") for (int k = 0; k < 2; ++k) { \
        if constexpr (I8) acc[ai][bj][m][n] = __builtin_bit_cast(acc_t, __builtin_amdgcn_mfma_i32_16x16x64_i8(__builtin_bit_cast(i32x4, Bt[n][k]), __builtin_bit_cast(i32x4, At[m][k]), __builtin_bit_cast(i32x4, acc[ai][bj][m][n]), 0, 0, 0)); \
        else acc[ai][bj][m][n] = __builtin_bit_cast(acc_t, __builtin_amdgcn_mfma_f32_16x16x32_bf16(Bt[n][k], At[m][k], __builtin_bit_cast(f32x4, acc[ai][bj][m][n]), 0, 0, 0)); } __builtin_amdgcn_s_setprio(0); } while (0)
#define PG8_WAIT_V(n) asm volatile("s_waitcnt vmcnt(" #n ")" ::: "memory")
#define PG8_WAIT_L(n) asm volatile("s_waitcnt lgkmcnt(" #n ")" ::: "memory")
#define PG8_BAR __builtin_amdgcn_s_barrier()
#define PG8_SCHED __builtin_amdgcn_sched_barrier(0)
    Unit cur, nxt; int ui = 0;
    if (!S.next(0, cur)) return;
    using acc_t = typename std::conditional<I8, i32x4, f32x4>::type;
    acc_t acc[2][2][4][2];
#pragma unroll
    for (int a = 0; a < 2; ++a)
#pragma unroll
        for (int b = 0; b < 2; ++b)
#pragma unroll
            for (int m = 0; m < 4; ++m)
#pragma unroll
                for (int n = 0; n < 2; ++n) acc[a][b][m][n] = __builtin_bit_cast(acc_t, (u32x4){0u, 0u, 0u, 0u});
    bf16x8 At[4][2], B0[2][2], B1[2][2];
    unsigned oc00, oc01, oc10, oc11, on00, on01, on10, on11;
    oc00 = S.a_off(cur, Rr[0]) + Cc[0] * 2; oc01 = S.a_off(cur, Rr[1]) + Cc[1] * 2; oc10 = S.a_off(cur, HALF + Rr[0]) + Cc[0] * 2; oc11 = S.a_off(cur, HALF + Rr[1]) + Cc[1] * 2;
    const char* cB = (const char*)Bbase + S.b_off(cur);
    PG8_STAGEB(PG8_SB(0, 0), cB); PG8_STAGEA(PG8_SA(0, 0), oc00, oc01, 0); PG8_STAGEB(PG8_SB(0, 1), cB + hstepB); PG8_STAGEA(PG8_SA(0, 1), oc10, oc11, 0);
    if (wr == 1) PG8_BAR;
    PG8_WAIT_V(4); PG8_BAR;
    PG8_STAGEB(PG8_SB(1, 0), cB + kstep); PG8_STAGEA(PG8_SA(1, 0), oc00, oc01, kstep); PG8_STAGEB(PG8_SB(1, 1), cB + hstepB + kstep);
    PG8_WAIT_V(6); PG8_BAR;
    for (;;) {
        E.pre(cur, lds, wid, lane, ui & 1);
        const bool has_next = S.next(ui + 1, nxt);
        const char* nB = cB;
        if (has_next) { on00 = S.a_off(nxt, Rr[0]) + Cc[0] * 2; on01 = S.a_off(nxt, Rr[1]) + Cc[1] * 2; on10 = S.a_off(nxt, HALF + Rr[0]) + Cc[0] * 2; on11 = S.a_off(nxt, HALF + Rr[1]) + Cc[1] * 2; nB = (const char*)Bbase + S.b_off(nxt); }
        else { on00 = oc00; on01 = oc01; on10 = oc10; on11 = oc11; }
        for (int t = 0; t < nt; t += 2) {
            const bool last = (t == nt - 2);
            const size_t k1 = (size_t)(t + 1) * kstep;
            const size_t k2 = last ? 0 : (size_t)(t + 2) * kstep, k3 = k2 + kstep;
            const unsigned o200 = last ? on00 : oc00, o201 = last ? on01 : oc01, o210 = last ? on10 : oc10, o211 = last ? on11 : oc11;
            const char* b2 = last ? nB : cB + (size_t)(t + 2) * kstep; const char* b3 = b2 + kstep;
            PG8_LDB(B0, 0, 0); PG8_SCHED; PG8_LDA(At, 0, 0); PG8_STAGEA(PG8_SA(1, 1), oc10, oc11, k1);
            PG8_WAIT_L(8); PG8_BAR; PG8_WAIT_L(0); PG8_MMA(0, 0, At, B0); PG8_BAR; PG8_SCHED;
            PG8_LDB(B1, 0, 1); PG8_STAGEB(PG8_SB(0, 0), b2);
            PG8_BAR; PG8_WAIT_L(0); PG8_MMA(0, 1, At, B1); PG8_BAR;
            PG8_LDA(At, 0, 1); PG8_STAGEA(PG8_SA(0, 0), o200, o201, k2);
            PG8_BAR; PG8_WAIT_L(0); PG8_MMA(1, 0, At, B0); PG8_BAR; PG8_SCHED;
            PG8_STAGEB(PG8_SB(0, 1), b2 + hstepB);
            PG8_WAIT_V(6); PG8_BAR; PG8_MMA(1, 1, At, B1); PG8_BAR;
            PG8_LDB(B0, 1, 0); PG8_SCHED; PG8_LDA(At, 1, 0); PG8_STAGEA(PG8_SA(0, 1), o210, o211, k2);
            PG8_WAIT_L(8); PG8_BAR; PG8_WAIT_L(0); PG8_MMA(0, 0, At, B0); PG8_BAR; PG8_SCHED;
            PG8_LDB(B1, 1, 1); PG8_STAGEB(PG8_SB(1, 0), b3);
            PG8_BAR; PG8_WAIT_L(0); PG8_MMA(0, 1, At, B1); PG8_BAR;
            PG8_LDA(At, 1, 1); PG8_STAGEA(PG8_SA(1, 0), o200, o201, k3);
            PG8_BAR; PG8_WAIT_L(0); PG8_MMA(1, 0, At, B0); PG8_BAR; PG8_SCHED;
            PG8_STAGEB(PG8_SB(1, 1), b3 + hstepB);
            PG8_WAIT_V(6); PG8_BAR; PG8_MMA(1, 1, At, B1); PG8_BAR;
        }
        E(acc, cur, wr, wc, fr, fq, ui & 1);
        if (!has_next) break;
#pragma unroll
        for (int a = 0; a < 2; ++a)
#pragma unroll
            for (int b = 0; b < 2; ++b)
#pragma unroll
                for (int m = 0; m < 4; ++m)
#pragma unroll
                    for (int n = 0; n < 2; ++n) acc[a][b][m][n] = __builtin_bit_cast(acc_t, (u32x4){0u, 0u, 0u, 0u});
        cur = nxt; cB = nB; oc00 = on00; oc01 = on01; oc10 = on10; oc11 = on11; ++ui;
    }
    PG8_WAIT_V(0);
    if (wr == 0) PG8_BAR;
    PG8_BAR;
#undef PG8_SA
#undef PG8_SB
#undef PG8_STAGEA
#undef PG8_STAGEB
#undef PG8_LDA
#undef PG8_LDB
#undef PG8_MMA
#undef PG8_WAIT_V
#undef PG8_WAIT_L
#undef PG8_BAR
#undef PG8_SCHED
}

struct DenseOrder {
    int nM, nN, nwg, G, c, K;
    __device__ void init(int M, int N, int K_, int G_, int c_) { nM = M / BM; nN = N / BM; nwg = nM * nN; G = G_; c = c_; K = K_; }
    __device__ __forceinline__ bool next(int i, Unit& u) const {
        const long L = (long)i * G + c; if (L >= nwg) return false;
        int wgid = (int)L; { const int q = nwg / NXCD, r = nwg % NXCD, xcd = wgid % NXCD, off = wgid / NXCD; wgid = (xcd < r ? xcd * (q + 1) : r * (q + 1) + (xcd - r) * q) + off; }
        const int nig = WGM * nN, gid = wgid / nig, fm = gid * WGM, gsz = (nM - fm) < WGM ? (nM - fm) : WGM;
        u.pm = fm + ((wgid % nig) % gsz); u.pn = (wgid % nig) / gsz; u.e = 0; u.nrow = 256; return true;
    }
    __device__ __forceinline__ unsigned a_off(const Unit& u, int R) const { return (unsigned)((u.pm * BM + R) * K) * 2u; }
    __device__ __forceinline__ size_t b_off(const Unit& u) const { return (size_t)u.pn * BM * K * 2; }
};
struct MoeOrder {
    const LAS int* tstart; const LAS int* cnt; const int* list; int G, c, K, npn; bool gather;
    __device__ __forceinline__ bool next(int i, Unit& u) const {
        const int L = i * G + c; const int tt = tstart[32];
        if (L >= tt * npn) return false;
        const int tile = L / npn; u.pn = L % npn; u.pm = tile;
        int e = 0;
#pragma unroll 1
        for (int k = 1; k < 32; ++k) if (tstart[k] <= tile) e = k;
        u.e = e; u.nrow = cnt[e] - (tile - tstart[e]) * 256; return true;
    }
    __device__ __forceinline__ unsigned a_off(const Unit& u, int R) const {
        if (gather) { const int mt = u.pm - tstart[u.e]; const int r = mt * 256 + R; const int tok = list[(size_t)u.e * 65536 + (R < u.nrow ? r : 0)]; return (unsigned)(tok * K) * 2u; }
        return (unsigned)((u.pm * BM + R) * K) * 2u;
    }
    __device__ __forceinline__ size_t b_off(const Unit& u) const { return ((size_t)u.e * 1024 + (size_t)u.pn * BM) * K * 2; }
};
}

constexpr int EPI_SC = MISC_OFF + 24576;
struct EpiIn {
    unsigned char* ws; const float* gate_b;
    __device__ __forceinline__ void pre(const pg8::Unit& u, LAS unsigned char* lds, int wid, int lane, int par) const {
        if (wid == 0) { __builtin_amdgcn_global_load_lds((const unsigned*)((const float*)(ws + WS_SA1) + u.pm * 256 + lane * 4), (LAS unsigned*)(lds + EPI_SC + par * 2048), 16, 0, 0);
                        __builtin_amdgcn_global_load_lds((const unsigned*)((const float*)(ws + WS_SBW) + u.pn * 256 + lane * 4), (LAS unsigned*)(lds + EPI_SC + par * 2048 + 1024), 16, 0, 0); } }
    LAS unsigned char* lds;
    __device__ __forceinline__ void operator()(const i32x4 (&acc)[2][2][4][2], const pg8::Unit& u, int wr, int wc, int fr, int fq, int par) const {
        asm volatile("" : "+v"(fr), "+v"(fq));
        const int pn = u.pn, row0 = u.pm * 256 + wr * 64 + fr;
        float sa[2][4]; f32x4 sb[2][2];
        { LAS const float* SA1 = (LAS const float*)(lds + EPI_SC + par * 2048); LAS const float* SBW = SA1 + 256;
#pragma unroll
          for (int ai = 0; ai < 2; ++ai)
#pragma unroll
              for (int m = 0; m < 4; ++m) sa[ai][m] = SA1[wr * 64 + fr + ai * 128 + m * 16];
#pragma unroll
          for (int bj = 0; bj < 2; ++bj)
#pragma unroll
              for (int n = 0; n < 2; ++n) sb[bj][n] = *(LAS const f32x4*)(SBW + bj * 128 + wc * 32 + 8 * fq + 4 * n); }
#define ACCF(ai, bj, m, n) (__builtin_convertvector(acc[ai][bj][m][n], f32x4) * sa[ai][m] * sb[bj][n])
        if (pn < 8) {
            bf16_t* dst = (bf16_t*)(ws + (pn < 2 ? WS_MQ : pn < 4 ? WS_MK : pn < 6 ? WS_MV : WS_MO));
            const int col0 = (pn & 1) * 256 + wc * 32 + 8 * fq;
#pragma unroll
            for (int ai = 0; ai < 2; ++ai)
#pragma unroll
                for (int m = 0; m < 4; ++m) { bf16_t* rp = dst + (size_t)(row0 + ai * 128 + m * 16) * 512 + col0;
#pragma unroll
                    for (int bj = 0; bj < 2; ++bj) { const f32x4 v0 = ACCF(ai, bj, m, 0), v1 = ACCF(ai, bj, m, 1);
                        u32x4 w; w.x = cvtpk(v0[0], v0[1]); w.y = cvtpk(v0[2], v0[3]); w.z = cvtpk(v1[0], v1[1]); w.w = cvtpk(v1[2], v1[3]);
                        *(u32x4*)(rp + bj * 128) = w; } }
        } else if (pn < 10) {
            const int g8 = 4 * (wc & 1) + fq; const float* COS = (const float*)(ws + WS_COS); const float* SIN = (const float*)(ws + WS_SIN); bf16_t* NQ = (bf16_t*)(ws + WS_NQ);
#pragma unroll
            for (int ai = 0; ai < 2; ++ai)
#pragma unroll
                for (int m = 0; m < 4; ++m) { const int row = row0 + ai * 128 + m * 16;
                    const f32x4 cs = *(const f32x4*)(COS + (size_t)row * 32 + 4 * g8), sn = *(const f32x4*)(SIN + (size_t)row * 32 + 4 * g8);
#pragma unroll
                    for (int bj = 0; bj < 2; ++bj) { const int head = (pn - 8) * 4 + bj * 2 + (wc >> 1);
                        const f32x4 x1 = ACCF(ai, bj, m, 0), x2 = ACCF(ai, bj, m, 1);
                        const f32x4 o1 = (x1 * cs - x2 * sn) * QSCALE, o2 = (x2 * cs + x1 * sn) * QSCALE;
                        bf16_t* rp = NQ + (size_t)row * 512 + head * 64 + 4 * (g8 & ~1) + 32 * (fq & 1);
                        u32x2 a; a.x = cvtpk(o1[0], o1[1]); a.y = cvtpk(o1[2], o1[3]);
                        u32x2 b; b.x = cvtpk(o2[0], o2[1]); b.y = cvtpk(o2[2], o2[3]); *(u32x4*)rp = widen_rows16(a, b); } }
        } else if (pn < 13) {
            bf16_t* kd = (bf16_t*)(ws + (pn == 10 ? WS_KC : pn == 11 ? WS_KSL : WS_KWN)); bf16_t* vd = (bf16_t*)(ws + (pn == 10 ? WS_VC : pn == 11 ? WS_VSL : WS_VWN));
            const float* COS = (const float*)(ws + WS_COS); const float* SIN = (const float*)(ws + WS_SIN);
            const int g8 = 4 * (wc & 1) + fq, grp = wc >> 1;
#pragma unroll
            for (int ai = 0; ai < 2; ++ai)
#pragma unroll
                for (int m = 0; m < 4; ++m) { const int row = row0 + ai * 128 + m * 16; const int b = row >> 12, s = row & 4095;
                    const f32x4 cs = *(const f32x4*)(COS + (size_t)row * 32 + 4 * g8), sn = *(const f32x4*)(SIN + (size_t)row * 32 + 4 * g8);
                    const size_t rbase = ((size_t)(b * 2 + grp) * SEQ + s) * 64;
                    { const f32x4 x1 = ACCF(ai, 0, m, 0), x2 = ACCF(ai, 0, m, 1);
                      const f32x4 o1 = x1 * cs - x2 * sn, o2 = x2 * cs + x1 * sn;
                      bf16_t* rp = kd + rbase + 4 * (g8 & ~1) + 32 * (fq & 1);
                      u32x2 a; a.x = cvtpk(o1[0], o1[1]); a.y = cvtpk(o1[2], o1[3]);
                      u32x2 c; c.x = cvtpk(o2[0], o2[1]); c.y = cvtpk(o2[2], o2[3]); *(u32x4*)rp = widen_rows16(a, c); }
                    { const f32x4 v0 = ACCF(ai, 1, m, 0), v1 = ACCF(ai, 1, m, 1);
                      u32x4 w; w.x = cvtpk(v0[0], v0[1]); w.y = cvtpk(v0[2], v0[3]); w.z = cvtpk(v1[0], v1[1]); w.w = cvtpk(v1[2], v1[3]);
                      *(u32x4*)(vd + rbase + (wc & 1) * 32 + 8 * fq) = w; } }
        } else {
            if (wc == 0) { float* GI = (float*)(ws + WS_GI); float* GF = (float*)(ws + WS_GF); float* NGT = (float*)(ws + WS_NGT);
#pragma unroll
                for (int ai = 0; ai < 2; ++ai)
#pragma unroll
                    for (int m = 0; m < 4; ++m) { const int row = row0 + ai * 128 + m * 16; const int b = row >> 12, s = row & 4095;
#pragma unroll
                        for (int n = 0; n < 2; ++n) { const f32x4 v = ACCF(ai, 0, m, n);
                            if (fq == 0) {
#pragma unroll
                                for (int i = 0; i < 4; ++i) { const float z = v[i] + gate_b[4 * n + i];
                                    if (n == 0) GI[(size_t)(b * 4 + i) * SEQ + s] = z; else GF[(size_t)(b * 4 + i) * SEQ + s] = logsigmoid_f(z); }
                            } else {
                                f32x4 o; o[0] = sigmoid_f(v[0]); o[1] = sigmoid_f(v[1]); o[2] = sigmoid_f(v[2]); o[3] = sigmoid_f(v[3]);
                                *(f32x4*)(NGT + (size_t)row * 24 + 8 * fq + 4 * n - 8) = o; } } }
            }
        }
    }
};
#undef ACCF
struct EpiBf16 {
    bf16_t* O; int ldc;
    __device__ __forceinline__ void pre(const pg8::Unit&, LAS unsigned char*, int, int, int) const {}
    __device__ __forceinline__ void operator()(const f32x4 (&acc)[2][2][4][2], const pg8::Unit& u, int wr, int wc, int fr, int fq, int par) const {
        asm volatile("" : "+v"(fr), "+v"(fq));
        const int row0 = u.pm * 256 + wr * 64 + fr, col0 = u.pn * 256 + wc * 32 + 8 * fq;
#pragma unroll
        for (int ai = 0; ai < 2; ++ai)
#pragma unroll
            for (int m = 0; m < 4; ++m) { bf16_t* rp = O + (size_t)(row0 + ai * 128 + m * 16) * ldc + col0;
#pragma unroll
                for (int bj = 0; bj < 2; ++bj) { const f32x4 v0 = acc[ai][bj][m][0], v1 = acc[ai][bj][m][1];
                    u32x4 w; w.x = cvtpk(v0[0], v0[1]); w.y = cvtpk(v0[2], v0[3]); w.z = cvtpk(v1[0], v1[1]); w.w = cvtpk(v1[2], v1[3]);
                    *(u32x4*)(rp + bj * 128) = w; } }
    }
};
struct EpiUp {
    bf16_t* HB;
    __device__ __forceinline__ void pre(const pg8::Unit&, LAS unsigned char*, int, int, int) const {}
    __device__ __forceinline__ void operator()(const f32x4 (&acc)[2][2][4][2], const pg8::Unit& u, int wr, int wc, int fr, int fq, int par) const {
        asm volatile("" : "+v"(fr), "+v"(fq));
        const int row0 = u.pm * 256 + wr * 64 + fr, col0 = (u.pn * 256 + wc * 32 + 8 * fq) >> 1;
#pragma unroll
        for (int ai = 0; ai < 2; ++ai)
#pragma unroll
            for (int m = 0; m < 4; ++m) { bf16_t* rp = HB + (size_t)(row0 + ai * 128 + m * 16) * EFF + col0;
#pragma unroll
                for (int bj = 0; bj < 2; ++bj) { const f32x4 a1 = acc[ai][bj][m][0], a3 = acc[ai][bj][m][1];
                    u32x2 w; w.x = cvtpk(silu_f(a1[0]) * a3[0], silu_f(a1[1]) * a3[1]); w.y = cvtpk(silu_f(a1[2]) * a3[2], silu_f(a1[3]) * a3[3]);
                    *(u32x2*)(rp + bj * 64) = w; } }
    }
};

struct EpiUpI8 {
    bf16_t* HB; const float* SAL; const float* SB; const LAS int* tstart; LAS unsigned char* lds;
    __device__ __forceinline__ void pre(const pg8::Unit& u, LAS unsigned char* l, int wid, int lane, int par) const {
        if (wid == 0) { const int mt = u.pm - tstart[u.e];
            __builtin_amdgcn_global_load_lds((const unsigned*)(SAL + (size_t)u.e * 65536 + mt * 256 + lane * 4), (LAS unsigned*)(l + EPI_SC + par * 2048), 16, 0, 0);
            __builtin_amdgcn_global_load_lds((const unsigned*)(SB + (size_t)u.e * 1024 + u.pn * 256 + lane * 4), (LAS unsigned*)(l + EPI_SC + par * 2048 + 1024), 16, 0, 0); } }
    __device__ __forceinline__ void operator()(const i32x4 (&acc)[2][2][4][2], const pg8::Unit& u, int wr, int wc, int fr, int fq, int par) const {
        asm volatile("" : "+v"(fr), "+v"(fq));
        const int rl0 = wr * 64 + fr, row0 = u.pm * 256 + rl0, colp = u.pn * 256 + wc * 32 + 8 * fq, col0 = colp >> 1;
        LAS const float* LSA = (LAS const float*)(lds + EPI_SC + par * 2048); LAS const float* LSB = LSA + 256;
        f32x4 sb[2][2];
#pragma unroll
        for (int bj = 0; bj < 2; ++bj)
#pragma unroll
            for (int n = 0; n < 2; ++n) sb[bj][n] = *(LAS const f32x4*)(LSB + wc * 32 + 8 * fq + bj * 128 + 4 * n);
#pragma unroll
        for (int ai = 0; ai < 2; ++ai)
#pragma unroll
            for (int m = 0; m < 4; ++m) { const int R = rl0 + ai * 128 + m * 16; const float sa = LSA[R];
                bf16_t* rp = HB + (size_t)(row0 + ai * 128 + m * 16) * EFF + (col0 & ~7) + 64 * (fq & 1);
                u32x2 wv[2];
#pragma unroll
                for (int bj = 0; bj < 2; ++bj) { const i32x4 i1 = acc[ai][bj][m][0], i3 = acc[ai][bj][m][1];
                    f32x4 a1, a3;
#pragma unroll
                    for (int i = 0; i < 4; ++i) { a1[i] = (float)i1[i] * sa * sb[bj][0][i]; a3[i] = (float)i3[i] * sa * sb[bj][1][i]; }
                    wv[bj].x = cvtpk(silu_f(a1[0]) * a3[0], silu_f(a1[1]) * a3[1]); wv[bj].y = cvtpk(silu_f(a1[2]) * a3[2], silu_f(a1[3]) * a3[3]); }
                *(u32x4*)rp = widen_rows16(wv[0], wv[1]); }
    }
};

template <class RM>
__device__ __forceinline__ void transpose_item(const float* W, int N, bf16_t* WT, int Kd, LAS float* scr, int k0, int n0, int lane, const RM& rm) {
#pragma unroll
    for (int i = 0; i < 8; ++i) { const int kk = 8 * i + (lane >> 3); const f32x4 w4 = *(const f32x4*)(W + (size_t)(k0 + kk) * N + n0 + 4 * (lane & 7));
        LAS float* d = scr + kk * 33 + 4 * (lane & 7); d[0] = w4[0]; d[1] = w4[1]; d[2] = w4[2]; d[3] = w4[3]; }
    asm volatile("s_waitcnt lgkmcnt(0)" ::: "memory");
    const int c = lane & 7;
#pragma unroll
    for (int j = 0; j < 4; ++j) { const int n = (lane >> 3) + 8 * j; const LAS float* s = scr + (8 * c) * 33 + n;
        u32x4 o; o.x = cvtpk(s[0 * 33], s[1 * 33]); o.y = cvtpk(s[2 * 33], s[3 * 33]); o.z = cvtpk(s[4 * 33], s[5 * 33]); o.w = cvtpk(s[6 * 33], s[7 * 33]);
        *(u32x4*)(WT + (size_t)rm(n0 + n) * Kd + k0 + 8 * c) = o; }
    asm volatile("s_waitcnt lgkmcnt(0)" ::: "memory");
}
struct RmId { int off; __device__ __forceinline__ int operator()(int n) const { return off + n; } };
__device__ __forceinline__ int rope_pl(int d) { return 8 * ((d & 31) >> 2) + 4 * (d >> 5) + (d & 3); }
struct RmWin {
    __device__ __forceinline__ int operator()(int c) const {
        if (c < 2048) return c;
        if (c < 2052) return 3328 + (c - 2048);
        if (c < 2056) return 3332 + (c - 2052);
        if (c < 2568) { const int x = c - 2056; return 2048 + (x & ~63) + rope_pl(x & 63); }
        if (c < 2696) { const int x = c - 2568; return 2560 + (x & ~63) + rope_pl(x & 63); }
        if (c < 2824) return 2688 + (c - 2696);
        if (c < 2952) { const int x = c - 2824; return 2816 + (x & ~63) + rope_pl(x & 63); }
        if (c < 3080) return 2944 + (c - 2952);
        if (c < 3208) { const int x = c - 3080; return 3072 + (x & ~63) + rope_pl(x & 63); }
        if (c < 3336) return 3200 + (c - 3208);
        return c;
    }
};
struct RmW13 { int sel; __device__ __forceinline__ int operator()(int j) const { return 8 * (j >> 2) + 4 * sel + (j & 3); } };

__device__ __forceinline__ void p0_phase(Frame& F) {
    const int tid = F.tid, lane = F.lane;
    const int NA = F.G > 64 ? 64 : F.G;
    const bool split = F.G > NA;
    if (F.vcu < NA) {
        LAS float* sc = (LAS float*)F.lds; LAS float* red = (LAS float*)(F.lds + 32768);
        const float* c = IN_F(1);
        for (int i = tid; i < 8192; i += NTHR) sc[i] = silu_f(c[i]);
        __syncthreads();
        const float* W = IN_F(3); const float* bia = IN_F(4); float* mod = WSP(float, WS_MOD);
        for (int cg = F.vcu; cg < 64; cg += NA) {
            const int col0 = cg * 96;
            const int kq = tid / 24, cq = tid % 24;
            f32x4 a[8];
#pragma unroll
            for (int b = 0; b < 8; ++b) a[b] = (f32x4){0.f, 0.f, 0.f, 0.f};
            if (tid < 504) {
#pragma unroll 4
                for (int k = kq; k < 1024; k += 21) { const f32x4 w = *(const f32x4*)(W + (size_t)k * 6144 + col0 + 4 * cq);
#pragma unroll
                    for (int b = 0; b < 8; ++b) a[b] += w * sc[b * 1024 + k]; }
#pragma unroll
                for (int b = 0; b < 8; ++b) *(LAS f32x4*)(red + (size_t)(tid * 8 + b) * 4) = a[b];
            }
            __syncthreads();
            for (int o = tid; o < 768; o += NTHR) { const int cq2 = o >> 5, bj = o & 31;
                float sacc = 0.f;
                for (int q = 0; q < 21; ++q) sacc += red[(size_t)((q * 24 + cq2) * 8) * 4 + bj];
                const int col = col0 + 4 * cq2 + (bj & 3);
                mod[(bj >> 2) * 6144 + col] = sacc + bia[col]; }
            __syncthreads();
        }
    }
    if (!split || F.vcu >= NA) {
        LAS float* scr = (LAS float*)(F.lds + F.wave * 8448);
        const int gw = (split ? F.vcu - NA : F.vcu) * NWAVES + F.wave, NGW = (split ? F.G - NA : F.G) * NWAVES;
        constexpr int I_WOUT = 16 * 32, I_C1 = 32 * 4, I_C2 = 2 * 2;
        constexpr int NITEMS = I_WOUT + 2 * I_C1 + 2 * I_C2;
        for (int it = gw; it < NITEMS; it += NGW) {
            int r = it;
            if (r < I_WOUT) { transpose_item(IN_F(19), 1024, WSP(bf16_t, WS_WOUTT), 1024, scr, (r / 32) * 64, (r % 32) * 32, lane, RmId{0}); continue; } r -= I_WOUT;
            if (r < I_C1) { transpose_item(IN_F(14), 128, WSP(bf16_t, WS_CW1K), 2048, scr, (r / 4) * 64, (r % 4) * 32, lane, RmId{0}); continue; } r -= I_C1;
            if (r < I_C1) { transpose_item(IN_F(17), 128, WSP(bf16_t, WS_CW1V), 2048, scr, (r / 4) * 64, (r % 4) * 32, lane, RmId{0}); continue; } r -= I_C1;
            if (r < I_C2) { transpose_item(IN_F(15), 64, WSP(bf16_t, WS_CW2K), 128, scr, (r / 2) * 64, (r % 2) * 32, lane, RmId{0}); continue; } r -= I_C2;
            transpose_item(IN_F(18), 64, WSP(bf16_t, WS_CW2V), 128, scr, (r / 2) * 64, (r % 2) * 32, lane, RmId{0});
        }
    }
    __syncthreads();
    {
        LAS unsigned* AM = (LAS unsigned*)F.lds; const int n4 = tid & 7, kq = tid >> 3; const RmWin rmw{};
        for (int it = (F.vcu + F.G - (split ? NA : 0)) % F.G; it < 105; it += F.G) {
            const int c0 = 32 * it + 4 * n4; const float* W = IN_F(9) + (size_t)(16 * kq) * INW + c0;
            if (tid < 32) AM[tid] = 0u;
            __syncthreads();
            f32x4 v[16]; f32x4 am = {0.f, 0.f, 0.f, 0.f};
#pragma unroll
            for (int i = 0; i < 16; ++i) { v[i] = *(const f32x4*)(W + (size_t)i * INW);
#pragma unroll
                for (int c = 0; c < 4; ++c) am[c] = fmaxf(am[c], fabsf(v[i][c])); }
#pragma unroll
            for (int o = 8; o < 64; o <<= 1) {
#pragma unroll
                for (int c = 0; c < 4; ++c) am[c] = fmaxf(am[c], __shfl_xor(am[c], o)); }
            if ((tid & 63) < 8) {
#pragma unroll
                for (int c = 0; c < 4; ++c) atomicMax((unsigned*)&AM[4 * n4 + c], __float_as_uint(am[c])); }
            __syncthreads();
            const f32x4 amax = *(LAS const f32x4*)((LAS const float*)AM + 4 * n4);
#pragma unroll
            for (int c = 0; c < 4; ++c) { const float inv = amax[c] > 0.f ? 127.f / amax[c] : 0.f; const int prow = rmw(c0 + c); u32x4 o;
#pragma unroll
                for (int d = 0; d < 4; ++d) {
                    const int q0 = (int)rintf(v[4 * d][c] * inv), q1 = (int)rintf(v[4 * d + 1][c] * inv), q2 = (int)rintf(v[4 * d + 2][c] * inv), q3 = (int)rintf(v[4 * d + 3][c] * inv);
                    o[d] = (unsigned)(q0 & 0xff) | ((unsigned)(q1 & 0xff) << 8) | ((unsigned)(q2 & 0xff) << 16) | ((unsigned)(q3 & 0xff) << 24); }
                *(u32x4*)((unsigned char*)(F.ws + WS_WINT) + (size_t)prow * 1024 + 16 * kq) = o;
                if (kq == 0) WSP(float, WS_SBW)[prow] = amax[c] * (1.f / 127.f); }
            __syncthreads();
        }
    }
    {
        const size_t gt = (size_t)F.vcu * NTHR + tid, NGT_ = (size_t)F.G * NTHR;
        const int* pos = (const int*)F.in[2]; float* COS = WSP(float, WS_COS); float* SIN = WSP(float, WS_SIN);
        {
            const int d = (int)(gt & 31); const float inv = powf(10000.f, -(float)d / 32.f);
            for (size_t i = gt; i < (size_t)NTOK * 32; i += NGT_) { const int row = (int)(i >> 5);
                const float ang = (float)pos[row] * inv; const float kk = rintf(ang * 0.15915494309189535f);
                float r = fmaf(-kk, 6.28125f, ang); r = fmaf(-kk, 1.9353071795864769e-3f, r);
                float sn, cs; sincosf(r, &sn, &cs); COS[i] = cs; SIN[i] = sn; } }
        { unsigned* z = (unsigned*)(F.ws + WS_WINT + (size_t)3360 * 1024); for (size_t i = gt; i < (size_t)224 * 256; i += NGT_) z[i] = 0u;
          for (size_t i = gt; i < 224; i += NGT_) WSP(float, WS_SBW)[3360 + i] = 0.f; }
        { const float* wg = IN_F(20); const float* we = IN_F(22); _Float16* RWT = WSP(_Float16, WS_RWT);
          for (size_t i = gt; i < 48 * 1024; i += NGT_) { const int n = (int)(i >> 10), k = (int)(i & 1023);
              const float w = n < 4 ? wg[k * 4 + n] : n < 36 ? we[k * 32 + n - 4] : 0.f; RWT[i] = (_Float16)w; } }
        { bf16_t* kc = WSP(bf16_t, WS_KCMP); bf16_t* vc = WSP(bf16_t, WS_VCMP);
          for (size_t i = gt; i < 16 * 64; i += NGT_) { const size_t o = ((i >> 6) * 256 + 255) * 64 + (i & 63); kc[o] = 0; vc[o] = 0; } }
    }
    __syncthreads();
    if (F.vcu >= F.G - 16) {
        const int bi = F.vcu - (F.G - 16), kv = bi >> 3, cg = bi & 7;
        const float* pe = IN_F(kv == 0 ? 13 : 16); const float* w1 = IN_F(kv == 0 ? 14 : 17);
        LAS float* red = (LAS float*)F.lds;
        const int col = cg * 16 + (tid & 15), sl = tid >> 4; float sacc = 0.f;
#pragma unroll 8
        for (int k = sl * 64; k < sl * 64 + 64; ++k) sacc += pe[k] * w1[(size_t)k * 128 + col];
        red[tid] = sacc; __syncthreads();
        if (tid < 16) { float t2 = 0.f; for (int q = 0; q < 32; ++q) t2 += red[q * 16 + tid]; WSP(float, WS_C1B)[kv * 128 + cg * 16 + tid] = t2; }
    }
    __syncthreads();
}

__device__ __forceinline__ void p1a_phase(Frame& F) {
    const int gw = F.vcu * NWAVES + F.wave, NGW = F.G * NWAVES, lane = F.lane;
    const float* x = IN_F(0); const float* nw = IN_F(5); const float* mod = WSP(float, WS_MOD); signed char* H1Q = (signed char*)(F.ws + WS_H1);
    for (int row0 = gw * 4; row0 < NTOK; row0 += NGW * 4) {
        f32x4 v[4][4]; float ss[4];
#pragma unroll
        for (int r = 0; r < 4; ++r) { const f32x4* xr = (const f32x4*)(x + (size_t)(row0 + r) * DM) + lane;
#pragma unroll
            for (int j = 0; j < 4; ++j) v[r][j] = __builtin_nontemporal_load(xr + 64 * j); }
#pragma unroll
        for (int r = 0; r < 4; ++r) { float a = 0.f;
#pragma unroll
            for (int j = 0; j < 4; ++j) a += v[r][j][0] * v[r][j][0] + v[r][j][1] * v[r][j][1] + v[r][j][2] * v[r][j][2] + v[r][j][3] * v[r][j][3];
            ss[r] = a; }
#pragma unroll
        for (int o = 1; o < 64; o <<= 1) {
#pragma unroll
            for (int r = 0; r < 4; ++r) ss[r] += __shfl_xor(ss[r], o); }
        const int b = row0 >> 12; float am[4] = {0.f, 0.f, 0.f, 0.f};
#pragma unroll
        for (int j = 0; j < 4; ++j) { const int k = 4 * lane + 256 * j;
            const f32x4 w = *(const f32x4*)(nw + k), sh = *(const f32x4*)(mod + b * 6144 + k), sc = *(const f32x4*)(mod + b * 6144 + 1024 + k);
            const f32x4 ws = w * (sc + 1.f);
#pragma unroll
            for (int r = 0; r < 4; ++r) { const float rr = rsqrtf(ss[r] * (1.f / DM) + RMS_EPS);
                const f32x4 h = v[r][j] * rr * ws + sh; v[r][j] = h;
                am[r] = fmaxf(am[r], fmaxf(fmaxf(fabsf(h[0]), fabsf(h[1])), fmaxf(fabsf(h[2]), fabsf(h[3])))); } }
#pragma unroll
        for (int o = 1; o < 64; o <<= 1) {
#pragma unroll
            for (int r = 0; r < 4; ++r) am[r] = fmaxf(am[r], __shfl_xor(am[r], o)); }
#pragma unroll
        for (int r = 0; r < 4; ++r) { const float inv = am[r] > 0.f ? 127.f / am[r] : 0.f;
            if (lane == 0) WSP(float, WS_SA1)[row0 + r] = am[r] * (1.f / 127.f);
            u32x4 pk;
#pragma unroll
            for (int j = 0; j < 4; ++j) { const f32x4 q = v[r][j] * inv;
                const int q0 = (int)rintf(q[0]), q1 = (int)rintf(q[1]), q2 = (int)rintf(q[2]), q3 = (int)rintf(q[3]);
                pk[j] = (unsigned)(q0 & 0xff) | ((unsigned)(q1 & 0xff) << 8) | ((unsigned)(q2 & 0xff) << 16) | ((unsigned)(q3 & 0xff) << 24); }
            *(u32x4*)(H1Q + (size_t)(row0 + r) * DM + 256 * (lane & 3) + 16 * (lane >> 2)) = quad_transpose(pk, lane); }
    }
}

__device__ __forceinline__ void conv_silu16(const bf16_t* src  , const float* cw  , int b, int s, int ch0  , float scale, float (&o)[16]) {
#pragma unroll
    for (int i = 0; i < 16; ++i) o[i] = 0.f;
#pragma unroll
    for (int j = 0; j < 4; ++j) { const int ss = s - 3 + j;
        if (ss >= 0) { const bf16_t* rp = src + ((size_t)b * SEQ + ss) * 512 + ch0;
            const u32x4 a = *(const u32x4*)rp, c = *(const u32x4*)(rp + 8);
            const float* w = cw + j * 1024;
            const f32x4 w0 = *(const f32x4*)w, w1 = *(const f32x4*)(w + 4), w2 = *(const f32x4*)(w + 8), w3 = *(const f32x4*)(w + 12);
            o[0] += bflo(a.x) * w0[0]; o[1] += bfhi(a.x) * w0[1]; o[2] += bflo(a.y) * w0[2]; o[3] += bfhi(a.y) * w0[3];
            o[4] += bflo(a.z) * w1[0]; o[5] += bfhi(a.z) * w1[1]; o[6] += bflo(a.w) * w1[2]; o[7] += bfhi(a.w) * w1[3];
            o[8] += bflo(c.x) * w2[0]; o[9] += bfhi(c.x) * w2[1]; o[10] += bflo(c.y) * w2[2]; o[11] += bfhi(c.y) * w2[3];
            o[12] += bflo(c.z) * w3[0]; o[13] += bfhi(c.z) * w3[1]; o[14] += bflo(c.w) * w3[2]; o[15] += bfhi(c.w) * w3[3]; } }
#pragma unroll
    for (int i = 0; i < 16; ++i) o[i] = silu_f(o[i]) * scale;
}
constexpr int RAWS = 272, RAWIMG = 67 * RAWS + 208;
__device__ __forceinline__ void stage_raw(const bf16_t* src, int b, int s0, int h, LAS unsigned char* RAW, int tid) {
    const int s = tid >> 3, chg = tid & 7;
    const bf16_t* rp = src + ((size_t)b * SEQ + s0 + s) * 512 + h * 128 + chg * 16;
    *(LAS u32x4*)(RAW + (s + 3) * RAWS + chg * 32) = *(const u32x4*)rp; *(LAS u32x4*)(RAW + (s + 3) * RAWS + chg * 32 + 16) = *(const u32x4*)(rp + 8);
    if (s < 3) { u32x4 a = {0u, 0u, 0u, 0u}, c = a; const int ss = s0 - 3 + s;
        if (ss >= 0) { const bf16_t* hp = src + ((size_t)b * SEQ + ss) * 512 + h * 128 + chg * 16; a = *(const u32x4*)hp; c = *(const u32x4*)(hp + 8); }
        *(LAS u32x4*)(RAW + s * RAWS + chg * 32) = a; *(LAS u32x4*)(RAW + s * RAWS + chg * 32 + 16) = c; }
}
__device__ __forceinline__ void conv_lds16(LAS const unsigned char* RAW, LAS const float* WL, int s, int ch0, float scale, float (&o)[16]) {
#pragma unroll
    for (int i = 0; i < 16; ++i) o[i] = 0.f;
#pragma unroll
    for (int j = 0; j < 4; ++j) { const u32x4 a = *(LAS const u32x4*)(RAW + (s + j) * RAWS + ch0 * 2), c = *(LAS const u32x4*)(RAW + (s + j) * RAWS + ch0 * 2 + 16);
        const LAS float* w = WL + j * 128 + ch0;
        const f32x4 w0 = *(LAS const f32x4*)w, w1 = *(LAS const f32x4*)(w + 4), w2 = *(LAS const f32x4*)(w + 8), w3 = *(LAS const f32x4*)(w + 12);
        o[0] += bflo(a.x) * w0[0]; o[1] += bfhi(a.x) * w0[1]; o[2] += bflo(a.y) * w0[2]; o[3] += bfhi(a.y) * w0[3];
        o[4] += bflo(a.z) * w1[0]; o[5] += bfhi(a.z) * w1[1]; o[6] += bflo(a.w) * w1[2]; o[7] += bfhi(a.w) * w1[3];
        o[8] += bflo(c.x) * w2[0]; o[9] += bfhi(c.x) * w2[1]; o[10] += bflo(c.y) * w2[2]; o[11] += bfhi(c.y) * w2[3];
        o[12] += bflo(c.z) * w3[0]; o[13] += bfhi(c.z) * w3[1]; o[14] += bflo(c.w) * w3[2]; o[15] += bfhi(c.w) * w3[3]; }
#pragma unroll
    for (int i = 0; i < 16; ++i) o[i] = silu_f(o[i]) * scale;
}
constexpr int TRT = 4096 + 64, RCH = 1024 + 16;
constexpr int TRIMG = 4 * TRT, ROWIMG = 16 * RCH;
__device__ __forceinline__ unsigned tr_lane_off(int lane) { const int hi = lane >> 5; return ((lane >> 4) & 1) * 32 + (lane & 3) * 8 + (4 * hi + ((lane & 15) >> 2)) * 64; }

#if DBG_CHECK == 2
#define DBGF(code, val) do { const float _v = (val); if ((__float_as_uint(_v) & 0x7f800000u) == 0x7f800000u) atomicMin((unsigned*)(F.ws + WS_CTL) + CW_DBG, (unsigned)(code)); } while (0)
#else
#define DBGF(code, val) do {} while (0)
#endif
struct MaPF { u32x4 k0, k1, v0, v1, hk0, hk1; float wk, g0, g1; };
__device__ __forceinline__ void mlstm_a_load(Frame& F, int job, int tid, MaPF& pf) {
    const int lane = tid & 63, w = F.wave;
    const int bh = job >> 6, c = job & 63, b = bh >> 2, h = bh & 3, s0 = c * 64, s = tid >> 3, chg = tid & 7;
    const size_t ro = ((size_t)b * SEQ + s0 + s) * 512 + h * 128 + chg * 16;
    const bf16_t* kp = WSP(bf16_t, WS_MK) + ro; const bf16_t* vp = WSP(bf16_t, WS_MV) + ro;
    pf.k0 = *(const u32x4*)kp; pf.k1 = *(const u32x4*)(kp + 8); pf.v0 = *(const u32x4*)vp; pf.v1 = *(const u32x4*)(vp + 8);
    pf.hk0 = (u32x4){0u, 0u, 0u, 0u}; pf.hk1 = pf.hk0;
    if (s < 3 && s0 - 3 + s >= 0) { const bf16_t* hp = WSP(bf16_t, WS_MK) + ((size_t)b * SEQ + s0 - 3 + s) * 512 + h * 128 + chg * 16; pf.hk0 = *(const u32x4*)hp; pf.hk1 = *(const u32x4*)(hp + 8); }
    pf.wk = IN_F(10)[(tid >> 7) * 1024 + 512 + h * 128 + (tid & 127)];
    pf.g0 = 0.f; pf.g1 = 0.f;
    if (w == 0) { pf.g0 = WSP(float, WS_GF)[(size_t)bh * SEQ + s0 + lane]; pf.g1 = WSP(float, WS_GI)[(size_t)bh * SEQ + s0 + lane]; }
}
__device__ __forceinline__ void mlstm_a_phase(Frame& F) {
    int tid = F.tid; asm volatile("" : "+v"(tid));
    const int lane = tid & 63, w = F.wave, r32 = lane & 31, hi = lane >> 5;
    LAS unsigned char* kimg = F.lds; LAS unsigned char* vimg = F.lds + TRIMG; LAS float* wS = (LAS float*)(F.lds + 2 * TRIMG);
    LAS unsigned char* RAWK = F.lds + 2 * TRIMG + 1024; LAS float* WLK = (LAS float*)(RAWK + RAWIMG);
    LAS bf16_t* OST = (LAS bf16_t*)(F.lds + 2 * TRIMG + 1024 + RAWIMG + 2048) + w * 2048;
    MaPF pf; int job = F.vcu;
    if (job < 2048) mlstm_a_load(F, job, tid, pf);
    for (; job < 2048; job += F.G) {
        {
            const int s = tid >> 3, chg = tid & 7;
            *(LAS u32x4*)(RAWK + (s + 3) * RAWS + chg * 32) = pf.k0; *(LAS u32x4*)(RAWK + (s + 3) * RAWS + chg * 32 + 16) = pf.k1;
            if (s < 3) { *(LAS u32x4*)(RAWK + s * RAWS + chg * 32) = pf.hk0; *(LAS u32x4*)(RAWK + s * RAWS + chg * 32 + 16) = pf.hk1; }
            WLK[tid] = pf.wk;
            if (w == 0) {
                float bs = pf.g0;
#pragma unroll
                for (int o = 1; o < 64; o <<= 1) { const float x = __shfl_up(bs, o); if (lane >= o) bs += x; }
                const float g = __shfl(bs, 63);
                const float a = g - bs + pf.g1; const float ml = wave_max(a);
                wS[lane] = __expf(a - ml);
                if (lane == 0) { WSP(float, WS_GSUM)[job] = g; WSP(float, WS_MLOC)[job] = ml; }
            }
        }
        const u32x4 va = pf.v0, vd = pf.v1;
        __syncthreads();
        if (job + F.G < 2048) mlstm_a_load(F, job + F.G, tid, pf);
        {
            const int s = tid >> 3, chg = tid & 7, ch0 = chg * 16;
            float kf[16]; conv_lds16(RAWK, WLK, s, ch0, 0.08838834764831845f, kf);
            const unsigned off = (ch0 >> 5) * TRT + s * 64 + (ch0 & 31) * 2;
            u32x4 k0, k1; k0.x = cvtpk(kf[0], kf[1]); k0.y = cvtpk(kf[2], kf[3]); k0.z = cvtpk(kf[4], kf[5]); k0.w = cvtpk(kf[6], kf[7]);
            k1.x = cvtpk(kf[8], kf[9]); k1.y = cvtpk(kf[10], kf[11]); k1.z = cvtpk(kf[12], kf[13]); k1.w = cvtpk(kf[14], kf[15]);
            *(LAS u32x4*)(kimg + off) = k0; *(LAS u32x4*)(kimg + off + 16) = k1;
            const float ws = wS[s];
            u32x4 v0, v1;
            v0.x = cvtpk(bflo(va.x) * ws, bfhi(va.x) * ws); v0.y = cvtpk(bflo(va.y) * ws, bfhi(va.y) * ws); v0.z = cvtpk(bflo(va.z) * ws, bfhi(va.z) * ws); v0.w = cvtpk(bflo(va.w) * ws, bfhi(va.w) * ws);
            v1.x = cvtpk(bflo(vd.x) * ws, bfhi(vd.x) * ws); v1.y = cvtpk(bflo(vd.y) * ws, bfhi(vd.y) * ws); v1.z = cvtpk(bflo(vd.z) * ws, bfhi(vd.z) * ws); v1.w = cvtpk(bflo(vd.w) * ws, bfhi(vd.w) * ws);
            *(LAS u32x4*)(vimg + off) = v0; *(LAS u32x4*)(vimg + off + 16) = v1;
        }
        __syncthreads();
        {
            const int et = w >> 1, dt0 = 2 * (w & 1); const unsigned lo = tr_lane_off(lane);
            f32x16 acc0 = {0}, acc1 = {0};
#pragma unroll
            for (int ks = 0; ks < 4; ++ks) {
                const bf16x8 a = mk8(vtr(vimg + et * TRT + ks * 1024 + lo), vtr(vimg + et * TRT + ks * 1024 + lo + 512));
                const bf16x8 b0 = mk8(vtr(kimg + dt0 * TRT + ks * 1024 + lo), vtr(kimg + dt0 * TRT + ks * 1024 + lo + 512));
                const bf16x8 b1 = mk8(vtr(kimg + (dt0 + 1) * TRT + ks * 1024 + lo), vtr(kimg + (dt0 + 1) * TRT + ks * 1024 + lo + 512));
                acc0 = MFMA32(a, b0, acc0); acc1 = MFMA32(a, b1, acc1);
            }
#pragma unroll
            for (int r = 0; r < 16; ++r) { const int el = crow(r, hi); OST[el * 64 + r32] = f2bf(acc0[r]); OST[el * 64 + 32 + r32] = f2bf(acc1[r]); }
            asm volatile("s_waitcnt lgkmcnt(0)" ::: "memory");
            bf16_t* dst = WSP(bf16_t, WS_KVC) + (size_t)job * 16384 + (size_t)(et * 32) * 128 + dt0 * 32;
#pragma unroll
            for (int i = 0; i < 4; ++i) { const int rw = i * 8 + (lane >> 3), ch = lane & 7; *(u32x4*)(dst + (size_t)rw * 128 + ch * 8) = *(LAS const u32x4*)(OST + rw * 64 + ch * 8); }
        }
        if (tid < 128) {
            float sacc = 0.f; const int d = tid;
            for (int ss = 0; ss < 64; ++ss) sacc += wS[ss] * bf2f(*(LAS const bf16_t*)(kimg + (d >> 5) * TRT + ss * 64 + (d & 31) * 2));
            WSP(float, WS_NC)[(size_t)job * 128 + d] = sacc;
        }
        __syncthreads();
    }
}

__device__ __forceinline__ void mlstm_scan_job(Frame& F, int job) {
    int tid = F.tid; asm volatile("" : "+v"(tid));
    const int bh = job >> 3, sl = job & 7;
    LAS float* aold = (LAS float*)F.lds; LAS float* anew = aold + 64; LAS float* gS = aold + 128; LAS float* mS = aold + 192;
    if (tid < 64) { gS[tid] = WSP(float, WS_GSUM)[bh * 64 + tid]; mS[tid] = WSP(float, WS_MLOC)[bh * 64 + tid]; }
    __syncthreads();
    if (tid == 0) {
        float m = 0.f;
        for (int c = 0; c < 64; ++c) { const float g = gS[c], ml = mS[c];
            const float mn = fmaxf(g + m, ml); aold[c] = __expf(g + m - mn); anew[c] = __expf(ml - mn);
            gS[c] = m;
            m = mn; }
    }
    __syncthreads();
    if (sl == 0 && tid < 64) WSP(float, WS_MPREV)[bh * 64 + tid] = gS[tid];
    const size_t base = (size_t)bh * 64 * 16384 + (size_t)sl * 2048 + tid * 4;
    const bf16_t* kv = WSP(bf16_t, WS_KVC) + base; bf16_t* cp = WSP(bf16_t, WS_CPREV) + base;
    f32x4 C = {0.f, 0.f, 0.f, 0.f};
#pragma unroll 8
    for (int c = 0; c < 64; ++c) {
        const u32x2 k = *(const u32x2*)(kv + (size_t)c * 16384);
        u32x2 o; o.x = cvtpk(C[0], C[1]); o.y = cvtpk(C[2], C[3]); *(u32x2*)(cp + (size_t)c * 16384) = o;
        const float ao = aold[c], an = anew[c]; DBGF(22, ao); DBGF(23, an); DBGF(24, bflo(k.x)); DBGF(24, bfhi(k.x)); DBGF(24, bflo(k.y)); DBGF(24, bfhi(k.y)); DBGF(25, C[0]);
        C[0] = ao * C[0] + an * bflo(k.x); C[1] = ao * C[1] + an * bfhi(k.x); C[2] = ao * C[2] + an * bflo(k.y); C[3] = ao * C[3] + an * bfhi(k.y);
    }
    if (sl == 0 && tid < 128) {
        float n = 0.f;
        for (int c0 = 0; c0 < 64; c0 += 16) { float nc[16];
#pragma unroll
            for (int i = 0; i < 16; ++i) nc[i] = WSP(float, WS_NC)[(size_t)(bh * 64 + c0 + i) * 128 + tid];
#pragma unroll
            for (int i = 0; i < 16; ++i) { WSP(float, WS_NPREV)[(size_t)(bh * 64 + c0 + i) * 128 + tid] = n; n = aold[c0 + i] * n + anew[c0 + i] * nc[i]; } }
    }
    __syncthreads();
}

struct McPF { u32x4 q0, q1, k0, k1, v0, v1, hq0, hq1, hk0, hk1; float wq, wk, g0, g1, mprev; u32x2 mo[4]; };
__device__ __forceinline__ void mlstm_c_load(Frame& F, int job, int tid, McPF& pf) {
    const int lane = tid & 63, w = F.wave, r32 = lane & 31, hi = lane >> 5;
    const int bh = job >> 6, c = job & 63, b = bh >> 2, h = bh & 3, s0 = c * 64, s = tid >> 3, chg = tid & 7;
    const size_t ro = ((size_t)b * SEQ + s0 + s) * 512 + h * 128 + chg * 16;
    const bf16_t* qp = WSP(bf16_t, WS_MQ) + ro; const bf16_t* kp = WSP(bf16_t, WS_MK) + ro; const bf16_t* vp = WSP(bf16_t, WS_MV) + ro;
    pf.q0 = *(const u32x4*)qp; pf.q1 = *(const u32x4*)(qp + 8); pf.k0 = *(const u32x4*)kp; pf.k1 = *(const u32x4*)(kp + 8); pf.v0 = *(const u32x4*)vp; pf.v1 = *(const u32x4*)(vp + 8);
    pf.hq0 = (u32x4){0u, 0u, 0u, 0u}; pf.hq1 = pf.hq0; pf.hk0 = pf.hq0; pf.hk1 = pf.hq0;
    if (s < 3 && s0 - 3 + s >= 0) { const size_t ho = ((size_t)b * SEQ + s0 - 3 + s) * 512 + h * 128 + chg * 16;
        pf.hq0 = *(const u32x4*)(WSP(bf16_t, WS_MQ) + ho); pf.hq1 = *(const u32x4*)(WSP(bf16_t, WS_MQ) + ho + 8); pf.hk0 = *(const u32x4*)(WSP(bf16_t, WS_MK) + ho); pf.hk1 = *(const u32x4*)(WSP(bf16_t, WS_MK) + ho + 8); }
    pf.wq = IN_F(10)[(tid >> 7) * 1024 + h * 128 + (tid & 127)]; pf.wk = IN_F(10)[(tid >> 7) * 1024 + 512 + h * 128 + (tid & 127)];
    pf.g0 = 0.f; pf.g1 = 0.f;
    if (w == 0) { pf.g0 = WSP(float, WS_GF)[(size_t)bh * SEQ + s0 + lane]; pf.g1 = WSP(float, WS_GI)[(size_t)bh * SEQ + s0 + lane]; }
    if (w == 1) { pf.g0 = WSP(float, WS_NPREV)[(size_t)job * 128 + lane]; pf.g1 = WSP(float, WS_NPREV)[(size_t)job * 128 + 64 + lane]; }
    pf.mprev = WSP(float, WS_MPREV)[job];
    const int tw = w & 1, ew = w >> 1, t = 32 * tw + r32;
    const bf16_t* mo = WSP(bf16_t, WS_MO) + ((size_t)b * SEQ + s0 + t) * 512 + h * 128 + 32 * ew + 4 * hi;
#pragma unroll
    for (int q4 = 0; q4 < 4; ++q4) pf.mo[q4] = *(const u32x2*)(mo + 8 * q4);
}
__device__ __forceinline__ void mlstm_c_phase(Frame& F) {
    int tid = F.tid; asm volatile("" : "+v"(tid));
    const int lane = tid & 63, w = F.wave, r32 = lane & 31, hi = lane >> 5;
    LAS unsigned char* qimg = F.lds; LAS unsigned char* kimg = F.lds + ROWIMG; LAS unsigned char* vimg = F.lds + 2 * ROWIMG;
    LAS float* uS = (LAS float*)(F.lds + 2 * ROWIMG + TRIMG); LAS float* MS = uS + 64; LAS float* bS = uS + 128; LAS float* nS = uS + 192; LAS float* ssq = uS + 320;
    LAS unsigned char* RAWQ = F.lds + 2 * ROWIMG + TRIMG + 4096; LAS unsigned char* RAWK = RAWQ + RAWIMG; LAS float* WLQ = (LAS float*)(RAWK + RAWIMG); LAS float* WLK = WLQ + 512;
    LAS float* HNL = (LAS float*)(F.lds + MISC_OFF + 2048);
    HNL[tid] = IN_F(12)[tid];
    const int tw = w & 1, ew = w >> 1, t = 32 * tw + r32;
    McPF pf;
    int job = F.vcu;
    if (job < 2048) mlstm_c_load(F, job, tid, pf);
    for (; job < 2048; job += F.G) {
        const int bh = job >> 6, c = job & 63, b = bh >> 2, h = bh & 3, s0 = c * 64;
        const float mprev = pf.mprev; u32x2 moc[4];
#pragma unroll
        for (int q4 = 0; q4 < 4; ++q4) moc[q4] = pf.mo[q4];
        {
            const int s = tid >> 3, chg = tid & 7, ch0 = chg * 16;
            *(LAS u32x4*)(RAWQ + (s + 3) * RAWS + chg * 32) = pf.q0; *(LAS u32x4*)(RAWQ + (s + 3) * RAWS + chg * 32 + 16) = pf.q1;
            *(LAS u32x4*)(RAWK + (s + 3) * RAWS + chg * 32) = pf.k0; *(LAS u32x4*)(RAWK + (s + 3) * RAWS + chg * 32 + 16) = pf.k1;
            if (s < 3) { *(LAS u32x4*)(RAWQ + s * RAWS + chg * 32) = pf.hq0; *(LAS u32x4*)(RAWQ + s * RAWS + chg * 32 + 16) = pf.hq1;
                         *(LAS u32x4*)(RAWK + s * RAWS + chg * 32) = pf.hk0; *(LAS u32x4*)(RAWK + s * RAWS + chg * 32 + 16) = pf.hk1; }
            WLQ[tid] = pf.wq; WLK[tid] = pf.wk;
            const unsigned off = (ch0 >> 5) * TRT + s * 64 + (ch0 & 31) * 2;
            *(LAS u32x4*)(vimg + off) = pf.v0; *(LAS u32x4*)(vimg + off + 16) = pf.v1;
            if (w == 0) {
                float bs = pf.g0;
#pragma unroll
                for (int o = 1; o < 64; o <<= 1) { const float x = __shfl_up(bs, o); if (lane >= o) bs += x; }
                const float u = pf.g1 - bs; float cm = u;
#pragma unroll
                for (int o = 1; o < 64; o <<= 1) { const float x = __shfl_up(cm, o); if (lane >= o) cm = fmaxf(cm, x); }
                uS[lane] = u; MS[lane] = fmaxf(mprev, cm); bS[lane] = bs;
            }
            if (w == 1) { nS[lane] = pf.g0; nS[64 + lane] = pf.g1; }
        }
        __syncthreads();
        bf16x8 cf[8];
        { const bf16_t* cp = WSP(bf16_t, WS_CPREV) + (size_t)job * 16384 + (size_t)(32 * ew + r32) * 128 + 8 * hi;
#pragma unroll
          for (int ks = 0; ks < 8; ++ks) cf[ks] = *(const bf16x8*)(cp + 16 * ks); }
        if (job + F.G < 2048) mlstm_c_load(F, job + F.G, tid, pf);
        {
            const int s = tid >> 3, chg = tid & 7, ch0 = chg * 16;
            float qf[16]; conv_lds16(RAWQ, WLQ, s, ch0, 1.f, qf);
            u32x4 q0, q1; q0.x = cvtpk(qf[0], qf[1]); q0.y = cvtpk(qf[2], qf[3]); q0.z = cvtpk(qf[4], qf[5]); q0.w = cvtpk(qf[6], qf[7]);
            q1.x = cvtpk(qf[8], qf[9]); q1.y = cvtpk(qf[10], qf[11]); q1.z = cvtpk(qf[12], qf[13]); q1.w = cvtpk(qf[14], qf[15]);
            *(LAS u32x4*)(qimg + (2 * chg) * RCH + s * 16) = q0; *(LAS u32x4*)(qimg + (2 * chg + 1) * RCH + s * 16) = q1;
            float kf[16]; conv_lds16(RAWK, WLK, s, ch0, 0.08838834764831845f, kf);
            u32x4 k0, k1; k0.x = cvtpk(kf[0], kf[1]); k0.y = cvtpk(kf[2], kf[3]); k0.z = cvtpk(kf[4], kf[5]); k0.w = cvtpk(kf[6], kf[7]);
            k1.x = cvtpk(kf[8], kf[9]); k1.y = cvtpk(kf[10], kf[11]); k1.z = cvtpk(kf[12], kf[13]); k1.w = cvtpk(kf[14], kf[15]);
            *(LAS u32x4*)(kimg + (2 * chg) * RCH + s * 16) = k0; *(LAS u32x4*)(kimg + (2 * chg + 1) * RCH + s * 16) = k1;
        }
        __syncthreads();
        const float Mt = MS[t], bt = bS[t];
        const float dec = __expf(mprev - Mt), mt = bt + Mt;
        bf16x8 qf[8];
#pragma unroll
        for (int ks = 0; ks < 8; ++ks) qf[ks] = *(LAS const bf16x8*)(qimg + (2 * ks + hi) * RCH + t * 16);
        f32x16 p[2]; p[0] = (f32x16){0}; p[1] = (f32x16){0};
#pragma unroll
        for (int st = 0; st < 2; ++st) {
            if (st <= tw) {
#pragma unroll
                for (int ks = 0; ks < 8; ++ks) { const bf16x8 kf = *(LAS const bf16x8*)(kimg + (2 * ks + hi) * RCH + (32 * st + r32) * 16); p[st] = MFMA32(kf, qf[ks], p[st]); }
            }
        }
        float rs = 0.f;
#pragma unroll
        for (int st = 0; st < 2; ++st)
#pragma unroll
            for (int r = 0; r < 16; ++r) { const int s = 32 * st + crow(r, hi);
                const float wv = (s <= t) ? __expf(uS[s] - Mt) * p[st][r] : 0.f; p[st][r] = wv; rs += wv; }
        rs += __shfl_xor(rs, 32);
        float qn = 0.f;
#pragma unroll
        for (int ks = 0; ks < 8; ++ks)
#pragma unroll
            for (int j = 0; j < 8; ++j) qn += bf2f((bf16_t)qf[ks][j]) * nS[16 * ks + 8 * hi + j];
        qn += __shfl_xor(qn, 32);
        const float den = rs + dec * qn;
        const float hden = fmaxf(fabsf(den), __expf(-mt));
        f32x16 ai = {0}, ae = {0};
        const unsigned lo = tr_lane_off(lane);
#pragma unroll
        for (int st = 0; st < 2; ++st) {
            if (st <= tw) {
#pragma unroll
                for (int s2 = 0; s2 < 2; ++s2) { const int ks = 2 * st + s2;
                    const bf16x8 vf = mk8(vtr(vimg + ew * TRT + ks * 1024 + lo), vtr(vimg + ew * TRT + ks * 1024 + lo + 512));
                    u32x4 pw; pw.x = cvtpk(p[st][8 * s2 + 0], p[st][8 * s2 + 1]); pw.y = cvtpk(p[st][8 * s2 + 2], p[st][8 * s2 + 3]); pw.z = cvtpk(p[st][8 * s2 + 4], p[st][8 * s2 + 5]); pw.w = cvtpk(p[st][8 * s2 + 6], p[st][8 * s2 + 7]);
                    ai = MFMA32(vf, __builtin_bit_cast(bf16x8, pw), ai); }
            }
        }
#pragma unroll
        for (int ks = 0; ks < 8; ++ks) ae = MFMA32(cf[ks], qf[ks], ae);
        float hv[16]; float ss = 0.f; const float rden = 1.f / hden;
#pragma unroll
        for (int r = 0; r < 16; ++r) { hv[r] = (ai[r] + dec * ae[r]) * rden; ss += hv[r] * hv[r]; }
        ss += __shfl_xor(ss, 32);
        if (hi == 0) ssq[ew * 64 + t] = ss;
        __syncthreads();
        const float tot = ssq[t] + ssq[64 + t] + ssq[128 + t] + ssq[192 + t];
        const float rn = rsqrtf(tot * (1.f / 128.f) + RMS_EPS);
        LAS const float* hn = HNL + h * 128 + 32 * ew;
        bf16_t* yo = WSP(bf16_t, WS_YCAT) + ((size_t)b * SEQ + s0 + t) * 1024 + h * 128 + 32 * ew;
#pragma unroll
        for (int p2 = 0; p2 < 2; ++p2) { u32x2 ov[2];
#pragma unroll
            for (int e = 0; e < 2; ++e) { const int q4 = 2 * p2 + e; const int e0 = 8 * q4 + 4 * hi;
                const u32x2 om = moc[q4]; const f32x4 wn = *(LAS const f32x4*)(hn + e0);
                const float y0 = hv[4 * q4 + 0] * rn * wn[0] * sigmoid_f(bflo(om.x)), y1 = hv[4 * q4 + 1] * rn * wn[1] * sigmoid_f(bfhi(om.x));
                const float y2 = hv[4 * q4 + 2] * rn * wn[2] * sigmoid_f(bflo(om.y)), y3 = hv[4 * q4 + 3] * rn * wn[3] * sigmoid_f(bfhi(om.y));
                ov[e].x = cvtpk(y0, y1); ov[e].y = cvtpk(y2, y3); }
            *(u32x4*)(yo + 16 * p2 + 8 * hi) = widen_pair(ov[0], ov[1]); }
        __syncthreads();
    }
}

__device__ __forceinline__ void compress_job(Frame& F, int job) {
    int lane = F.lane; asm volatile("" : "+v"(lane));
    const int w = F.wave, r32 = lane & 31, hi = lane >> 5;
    const int kv = job >> 7, bg = (job >> 3) & 15, i0 = (job & 7) * 32;
    const bf16_t* X = WSP(bf16_t, kv ? WS_VC : WS_KC) + (size_t)bg * SEQ * 64;
    const bf16_t* W1 = WSP(bf16_t, kv ? WS_CW1V : WS_CW1K); const bf16_t* W2 = WSP(bf16_t, kv ? WS_CW2V : WS_CW2K);
    const float* c1 = WSP(float, WS_C1B) + kv * 128;
    bf16_t* O = WSP(bf16_t, kv ? WS_VCMP : WS_KCMP) + (size_t)bg * 256 * 64;
    LAS unsigned char* himg = F.lds;
    LAS float* part = (LAS float*)(F.lds + ROWIMG);
    const int nt = w & 3, kh = w >> 2;
    f32x16 acc = {0};
    {
        int i = i0 + r32; if (i > 254) i = 254;
        const bf16_t* ap = X + (size_t)i * 1024 + kh * 1024 + 8 * hi; const bf16_t* bp = W1 + (size_t)(32 * nt + r32) * 2048 + kh * 1024 + 8 * hi;
#pragma unroll 16
        for (int ks = 0; ks < 64; ++ks) { const bf16x8 a = *(const bf16x8*)(ap + 16 * ks), bb = *(const bf16x8*)(bp + 16 * ks); acc = MFMA32(a, bb, acc); }
    }
    if (kh == 1) {
#pragma unroll
        for (int r = 0; r < 16; ++r) part[(nt * 16 + r) * 64 + lane] = acc[r];
    }
    __syncthreads();
    if (kh == 0) {
        const int n = 32 * nt + r32; const float cb = c1[n];
#pragma unroll
        for (int r = 0; r < 16; ++r) { const int rowl = crow(r, hi); const float v = acc[r] + part[(nt * 16 + r) * 64 + lane] + cb;
            *(LAS bf16_t*)(himg + (n >> 3) * RCH + rowl * 16 + (n & 7) * 2) = f2bf(silu_f(v)); }
    }
    __syncthreads();
    if (w < 2) {
        f32x16 a2 = {0};
#pragma unroll
        for (int ks = 0; ks < 8; ++ks) { const bf16x8 a = *(LAS const bf16x8*)(himg + (2 * ks + hi) * RCH + r32 * 16);
            const bf16x8 bb = *(const bf16x8*)(W2 + (size_t)(32 * w + r32) * 128 + 16 * ks + 8 * hi); a2 = MFMA32(a, bb, a2); }
#pragma unroll
        for (int r = 0; r < 16; ++r) { const int i = i0 + crow(r, hi); if (i < 255) O[(size_t)i * 64 + 32 * w + r32] = f2bf(a2[r]); }
    }
    __syncthreads();
}

constexpr int NSA_KCH = 1024 + 16, NSA_VDH = 4096 + 64, NSA_KIMG = 8 * NSA_KCH, NSA_VIMG = 2 * NSA_VDH, NSA_BUF = NSA_KIMG + NSA_VIMG;
constexpr int NSA_IMP = 2 * NSA_BUF, NSA_IST = 65, NSA_TOT = NSA_IMP + 256 * NSA_IST * 4,
              NSA_SELB = MISC_OFF + 1024, NSA_UNI = NSA_SELB + 512;
constexpr int NSA_FAC = NSA_TOT + 64 * NSA_IST * 4;
constexpr int NSA_STASH = 96 * 1024;
static_assert(4 * NSA_BUF <= NSA_STASH && NSA_FAC + 4096 <= MISC_OFF && NSA_STASH + 8 * 4096 <= MISC_OFF, "NSA LDS map");

__device__ __forceinline__ void nsa_qk(LAS const unsigned char* kimg, const bf16x8 (&qr)[4], unsigned kfo, f32x16& p0, f32x16& p1) {
    bf16x8 kf[8];
#pragma unroll
    for (int d0 = 0; d0 < 4; ++d0) { kf[2 * d0] = *(LAS const bf16x8*)(kimg + kfo + d0 * (2 * NSA_KCH)); kf[2 * d0 + 1] = *(LAS const bf16x8*)(kimg + kfo + d0 * (2 * NSA_KCH) + 512); }
    __builtin_amdgcn_sched_barrier(0);
    p0 = (f32x16){0}; p1 = (f32x16){0};
#pragma unroll
    for (int d0 = 0; d0 < 4; ++d0) { p0 = MFMA32(kf[2 * d0], qr[d0], p0); p1 = MFMA32(kf[2 * d0 + 1], qr[d0], p1); }
}
constexpr float NSA_THR = 8.f;
template <int KIND>
__device__ __forceinline__ void nsa_tile(LAS const unsigned char* kimg, LAS const unsigned char* vimg, const bf16x8 (&qr)[4], int kbase, int t, bool edge, bool rowvalid,
                                         float& m, float& l, f32x16& o0, f32x16& o1, unsigned kfo, unsigned vfo, int hi) {
    f32x16 p0, p1; nsa_qk(kimg, qr, kfo, p0, p1);
    if (edge) {
#pragma unroll
        for (int r = 0; r < 16; ++r) { const int k0 = kbase + crow(r, hi), k1 = k0 + 32; bool v0, v1;
            if (KIND == 1) { v0 = k0 <= t; v1 = k1 <= t; } else { v0 = k0 <= t && k0 >= t - 511; v1 = k1 <= t && k1 >= t - 511; }
            p0[r] = v0 ? p0[r] : -INFINITY; p1[r] = v1 ? p1[r] : -INFINITY; }
    }
    float mx = fmaxf(p0[0], p1[0]);
#pragma unroll
    for (int r = 1; r < 16; ++r) mx = fmaxf(mx, fmaxf(p0[r], p1[r]));
    mx = rowvalid ? mx : -INFINITY;
    mx = fmaxf(mx, __shfl_xor(mx, 32));
    if (__any(mx - m > NSA_THR)) {
        const float mn = fmaxf(m, mx); const float alpha = ex2(m - mn); m = mn; l *= alpha;
#pragma unroll
        for (int r = 0; r < 16; ++r) { o0[r] *= alpha; o1[r] *= alpha; }
    }
    const float me = rowvalid ? m : INFINITY;
    float rs = 0.f;
#pragma unroll
    for (int r = 0; r < 16; ++r) { p0[r] = ex2(p0[r] - me); p1[r] = ex2(p1[r] - me); rs += p0[r] + p1[r]; }
    l += rs;
    u32x4 pw[4];
#pragma unroll
    for (int s = 0; s < 2; ++s) {
        pw[s].x = cvtpk(p0[8 * s + 0], p0[8 * s + 1]); pw[s].y = cvtpk(p0[8 * s + 2], p0[8 * s + 3]); pw[s].z = cvtpk(p0[8 * s + 4], p0[8 * s + 5]); pw[s].w = cvtpk(p0[8 * s + 6], p0[8 * s + 7]);
        pw[2 + s].x = cvtpk(p1[8 * s + 0], p1[8 * s + 1]); pw[2 + s].y = cvtpk(p1[8 * s + 2], p1[8 * s + 3]); pw[2 + s].z = cvtpk(p1[8 * s + 4], p1[8 * s + 5]); pw[2 + s].w = cvtpk(p1[8 * s + 6], p1[8 * s + 7]);
    }
    bf16x8 vf[8];
#pragma unroll
    for (int ks = 0; ks < 4; ++ks) { vf[2 * ks] = mk8(vtr(vimg + vfo + ks * 1024), vtr(vimg + vfo + ks * 1024 + 512)); vf[2 * ks + 1] = mk8(vtr(vimg + vfo + NSA_VDH + ks * 1024), vtr(vimg + vfo + NSA_VDH + ks * 1024 + 512)); }
    __builtin_amdgcn_sched_barrier(0);
#pragma unroll
    for (int ks = 0; ks < 4; ++ks) { o0 = MFMA32(vf[2 * ks], __builtin_bit_cast(bf16x8, pw[ks]), o0); o1 = MFMA32(vf[2 * ks + 1], __builtin_bit_cast(bf16x8, pw[ks]), o1); }
}

template <int KIND>
__device__ __forceinline__ void nsa_tile2(LAS const unsigned char* kA, LAS const unsigned char* vA, LAS const unsigned char* kB, LAS const unsigned char* vB, bool hasB,
                                          const bf16x8 (&qr)[4], int kbA, int kbB, int t, bool edgeA, bool edgeB, bool rvA, bool rvB,
                                          float& m, float& l, f32x16& o0, f32x16& o1, unsigned kfo, unsigned vfo, int hi) {
    f32x16 a0, a1, b0, b1;
    nsa_qk(kA, qr, kfo, a0, a1);
    __builtin_amdgcn_sched_barrier(0);
    if (hasB) nsa_qk(kB, qr, kfo, b0, b1);
    else {
#pragma unroll
        for (int r = 0; r < 16; ++r) { b0[r] = -INFINITY; b1[r] = -INFINITY; } }
    if (edgeA) {
#pragma unroll
        for (int r = 0; r < 16; ++r) { const int k0 = kbA + crow(r, hi), k1 = k0 + 32; bool v0, v1;
            if (KIND == 1) { v0 = k0 <= t; v1 = k1 <= t; } else { v0 = k0 <= t && k0 >= t - 511; v1 = k1 <= t && k1 >= t - 511; }
            a0[r] = v0 ? a0[r] : -INFINITY; a1[r] = v1 ? a1[r] : -INFINITY; } }
    if (edgeB) {
#pragma unroll
        for (int r = 0; r < 16; ++r) { const int k0 = kbB + crow(r, hi), k1 = k0 + 32; bool v0, v1;
            if (KIND == 1) { v0 = k0 <= t; v1 = k1 <= t; } else { v0 = k0 <= t && k0 >= t - 511; v1 = k1 <= t && k1 >= t - 511; }
            b0[r] = v0 ? b0[r] : -INFINITY; b1[r] = v1 ? b1[r] : -INFINITY; } }
    __builtin_amdgcn_sched_barrier(0);
    const bool fresh = m < -1e29f; const float mb = fresh ? 0.f : m;
    const float meA = rvA ? mb : INFINITY, meB = rvB ? mb : INFINITY;
#pragma unroll
    for (int r = 0; r < 16; ++r) { a0[r] -= meA; a1[r] -= meA; b0[r] -= meB; b1[r] -= meB; }
    float mx = fmaxf(fmaxf(a0[0], a1[0]), fmaxf(b0[0], b1[0]));
#pragma unroll
    for (int r = 1; r < 16; ++r) mx = fmaxf(mx, fmaxf(fmaxf(a0[r], a1[r]), fmaxf(b0[r], b1[r])));
    mx = fmaxf(mx, __shfl_xor(mx, 32));
    const bool has = mx > -INFINITY;
    const float delta = fresh ? (has ? mx : 0.f) : (mx > NSA_THR ? mx : 0.f);
    if (__any(delta != 0.f)) {
        const float alpha = fresh ? 1.f : ex2(-delta); l *= alpha;
#pragma unroll
        for (int r = 0; r < 16; ++r) { o0[r] *= alpha; o1[r] *= alpha; a0[r] -= delta; a1[r] -= delta; b0[r] -= delta; b1[r] -= delta; }
    }
    m = fresh ? (has ? mx : m) : m + delta;
    float rs = 0.f;
#pragma unroll
    for (int r = 0; r < 16; ++r) { a0[r] = ex2(a0[r]); a1[r] = ex2(a1[r]); b0[r] = ex2(b0[r]); b1[r] = ex2(b1[r]); rs += (a0[r] + a1[r]) + (b0[r] + b1[r]); }
    l += rs;
    __builtin_amdgcn_sched_barrier(0);
    {
        u32x4 pw[4];
#pragma unroll
        for (int s = 0; s < 2; ++s) {
            pw[s].x = cvtpk(a0[8 * s + 0], a0[8 * s + 1]); pw[s].y = cvtpk(a0[8 * s + 2], a0[8 * s + 3]); pw[s].z = cvtpk(a0[8 * s + 4], a0[8 * s + 5]); pw[s].w = cvtpk(a0[8 * s + 6], a0[8 * s + 7]);
            pw[2 + s].x = cvtpk(a1[8 * s + 0], a1[8 * s + 1]); pw[2 + s].y = cvtpk(a1[8 * s + 2], a1[8 * s + 3]); pw[2 + s].z = cvtpk(a1[8 * s + 4], a1[8 * s + 5]); pw[2 + s].w = cvtpk(a1[8 * s + 6], a1[8 * s + 7]); }
        bf16x8 vf[8];
#pragma unroll
        for (int ks = 0; ks < 4; ++ks) { vf[2 * ks] = mk8(vtr(vA + vfo + ks * 1024), vtr(vA + vfo + ks * 1024 + 512)); vf[2 * ks + 1] = mk8(vtr(vA + vfo + NSA_VDH + ks * 1024), vtr(vA + vfo + NSA_VDH + ks * 1024 + 512)); }
        __builtin_amdgcn_sched_barrier(0);
#pragma unroll
        for (int ks = 0; ks < 4; ++ks) { o0 = MFMA32(vf[2 * ks], __builtin_bit_cast(bf16x8, pw[ks]), o0); o1 = MFMA32(vf[2 * ks + 1], __builtin_bit_cast(bf16x8, pw[ks]), o1); }
    }
    __builtin_amdgcn_sched_barrier(0);
    if (hasB) {
        u32x4 pw[4];
#pragma unroll
        for (int s = 0; s < 2; ++s) {
            pw[s].x = cvtpk(b0[8 * s + 0], b0[8 * s + 1]); pw[s].y = cvtpk(b0[8 * s + 2], b0[8 * s + 3]); pw[s].z = cvtpk(b0[8 * s + 4], b0[8 * s + 5]); pw[s].w = cvtpk(b0[8 * s + 6], b0[8 * s + 7]);
            pw[2 + s].x = cvtpk(b1[8 * s + 0], b1[8 * s + 1]); pw[2 + s].y = cvtpk(b1[8 * s + 2], b1[8 * s + 3]); pw[2 + s].z = cvtpk(b1[8 * s + 4], b1[8 * s + 5]); pw[2 + s].w = cvtpk(b1[8 * s + 6], b1[8 * s + 7]); }
        bf16x8 vf[8];
#pragma unroll
        for (int ks = 0; ks < 4; ++ks) { vf[2 * ks] = mk8(vtr(vB + vfo + ks * 1024), vtr(vB + vfo + ks * 1024 + 512)); vf[2 * ks + 1] = mk8(vtr(vB + vfo + NSA_VDH + ks * 1024), vtr(vB + vfo + NSA_VDH + ks * 1024 + 512)); }
        __builtin_amdgcn_sched_barrier(0);
#pragma unroll
        for (int ks = 0; ks < 4; ++ks) { o0 = MFMA32(vf[2 * ks], __builtin_bit_cast(bf16x8, pw[ks]), o0); o1 = MFMA32(vf[2 * ks + 1], __builtin_bit_cast(bf16x8, pw[ks]), o1); }
    }
}

#define NPIN(x) asm volatile("" : "+v"(x))
__device__ __forceinline__ void glds16(const void* g, unsigned lds_base) {
    unsigned sv; asm volatile("s_mov_b32 %0, m0\n\ts_mov_b32 m0, %2\n\ts_nop 0\n\tglobal_load_lds_dwordx4 %1, off\n\ts_mov_b32 m0, %0" : "=&s"(sv) : "v"(g), "s"(lds_base) : "memory"); }
#define NSB() __builtin_amdgcn_sched_barrier(0)
#define NMX3(a, b, c) fmaxf(fmaxf((a), (b)), (c))
__device__ __forceinline__ float nsa_rowmax(const f32x16& p0, const f32x16& p1) {
    float a = NMX3(p0[0], p0[1], p1[0]), b = NMX3(p0[2], p0[3], p1[1]); a = NMX3(a, p1[2], p1[3]);
#pragma unroll
    for (int r = 4; r < 16; r += 4) { a = NMX3(a, p0[r], p0[r + 1]); b = NMX3(b, p0[r + 2], p0[r + 3]); a = NMX3(a, p1[r], p1[r + 1]); b = NMX3(b, p1[r + 2], p1[r + 3]); }
    const float m = fmaxf(a, b); const auto rr = __builtin_amdgcn_permlane32_swap(__float_as_uint(m), __float_as_uint(m), false, false);
    return fmaxf(__uint_as_float(rr[0]), __uint_as_float(rr[1])); }
template <int KIND>
__device__ __forceinline__ void nsa_mask(f32x16& p0, f32x16& p1, int kbase, int t, int hi) {
#pragma unroll
    for (int r = 0; r < 16; ++r) { const int k0 = kbase + crow(r, hi), k1 = k0 + 32; bool v0, v1;
        if (KIND == 1) { v0 = k0 <= t; v1 = k1 <= t; } else { v0 = k0 <= t && k0 >= t - 511; v1 = k1 <= t && k1 >= t - 511; }
        p0[r] = v0 ? p0[r] : -INFINITY; p1[r] = v1 ? p1[r] : -INFINITY; } }
template <int KIND>
__device__ __forceinline__ void nsa_pipe(LAS unsigned char* L, const bf16_t* Kp, const bf16_t* Vp, unsigned mlo, unsigned mhi, unsigned sel0, unsigned sel1,
                                         const bf16x8 (&qr)[4], int t, int lane, int w, int hi, unsigned kfo, unsigned vfo,
                                         float& lsum, f32x16& o0, f32x16& o1) {
    unsigned ulo = mlo, uhi = mhi;
    const bf16_t* ksrc = Kp + lane * 64 + w * 8; const bf16_t* vsrc = Vp + (16 * (w & 3) + (lane >> 2)) * 64 + (w >> 2) * 32 + (lane & 3) * 8;
    const unsigned kdst = (unsigned)(uintptr_t)L + w * NSA_KCH, vdst = (unsigned)(uintptr_t)L + NSA_KIMG + (w >> 2) * NSA_VDH + (w & 3) * 1024;
#define NP_DMA(j, sl) do { glds16(ksrc + (size_t)(j) * 4096, (unsigned)__builtin_amdgcn_readfirstlane(kdst + (sl) * NSA_BUF)); glds16(vsrc + (size_t)(j) * 4096, (unsigned)__builtin_amdgcn_readfirstlane(vdst + (sl) * NSA_BUF)); } while (0)
#define NP_DMAWAIT() asm volatile("s_waitcnt vmcnt(0)" ::: "memory")
    const int n = __builtin_popcount(ulo) + __builtin_popcount(uhi);
#define NP_NEXT(jv) do { jv = -1; if (ulo | uhi) { jv = ulo ? __builtin_ctz(ulo) : 32 + __builtin_ctz(uhi); if (ulo) ulo &= ulo - 1; else uhi &= uhi - 1; } } while (0)
#define NP_SELBIT(j) ((((j) < 32 ? (sel0 >> ((j) & 31)) : (sel1 >> (((j) - 32) & 31))) & 1u) != 0u)
#define NP_KIMG(sl) (L + (sl) * NSA_BUF)
#define NP_VIMG(sl) (L + (sl) * NSA_BUF + NSA_KIMG)
    int jc, jn1, jn2;
    NP_NEXT(jc); NP_NEXT(jn1); NP_NEXT(jn2);
    NP_DMA(jc, 0); if (jn1 >= 0) NP_DMA(jn1, 1); if (jn2 >= 0) NP_DMA(jn2, 2);
    NP_DMAWAIT();
    __syncthreads();
    float m = -1e30f, cin = 0.f, l = 0.f, fsc = 1.f; bool resc = false;
    o0 = (f32x16){0}; o1 = (f32x16){0};
    f32x16 pA0, pA1, pB0, pB1, ci16; bf16x8 kf[8]; s16x4 vlo[8], vhi[8]; u32x4 pw0, pw1, pw2, pw3;
#define NP_KLOAD2(sl, d0) do { kf[2 * (d0)] = *(LAS const bf16x8*)(NP_KIMG(sl) + kfo + (d0) * (2 * NSA_KCH)); kf[2 * (d0) + 1] = *(LAS const bf16x8*)(NP_KIMG(sl) + kfo + (d0) * (2 * NSA_KCH) + 512); } while (0)
#define NP_SPLAT(v) do { _Pragma("unroll") for (int r = 0; r < 16; ++r) ci16[r] = (v); } while (0)
#define NP_CINIT(jt) do { if (KIND == 1) { const float c_ = NP_SELBIT(jt) ? cin : -INFINITY; NP_SPLAT(c_); } } while (0)
#define NP_DECIDE(C0, C1) do { const float rm_ = nsa_rowmax(C0, C1); const bool fresh_ = m < -1e29f; \
        const bool grow_ = fresh_ ? (rm_ > -INFINITY) : (rm_ > NSA_THR); resc = false; \
        if (__any(grow_)) { const float dl_ = grow_ ? rm_ : 0.f; fsc = (grow_ && !fresh_) ? ex2(-rm_) : 1.f; m = grow_ ? (fresh_ ? rm_ : m + rm_) : m; cin = grow_ ? -m : cin; l *= fsc; resc = true; \
            _Pragma("unroll") for (int r = 0; r < 16; ++r) { C0[r] -= dl_; C1[r] -= dl_; } \
            if (KIND == 2) NP_SPLAT(cin); } } while (0)
    { _Pragma("unroll") for (int d0 = 0; d0 < 4; ++d0) NP_KLOAD2(0, d0);
      if (KIND == 2) NP_SPLAT(0.f); else NP_CINIT(jc);
      NSB();
      pA0 = MFMA32(kf[0], qr[0], ci16); pA1 = MFMA32(kf[1], qr[0], ci16);
      _Pragma("unroll") for (int d0 = 1; d0 < 4; ++d0) { pA0 = MFMA32(kf[2 * d0], qr[d0], pA0); pA1 = MFMA32(kf[2 * d0 + 1], qr[d0], pA1); }
      nsa_mask<KIND>(pA0, pA1, 64 * jc, t, hi);
      NP_DECIDE(pA0, pA1);
      _Pragma("unroll") for (int r = 0; r < 16; ++r) { pA0[r] = ex2(pA0[r]); pA1[r] = ex2(pA1[r]); }
      if (jn1 >= 0) { _Pragma("unroll") for (int d0 = 0; d0 < 4; ++d0) NP_KLOAD2(1, d0); }
      jc = jn1; jn1 = jn2; NP_NEXT(jn2); }
    int s = 1;
#define NP_PKW(P, i) cvtpk(P[i], P[(i) + 1])
#define NP_VFR(i) mk8(vlo[i], vhi[i])
#define NP_VRD(i) do { LAS const unsigned char* a_ = vp_ + ((i) >> 1) * 1024 + ((i) & 1) * NSA_VDH; vlo[i] = vtr(a_); vhi[i] = vtr(a_ + 512); } while (0)
#define NP_GAPA(MF, a0, a1, a2, a3, W0, W1, PW) do { MF; sacc += a0; sacc += a1; sacc += a2; sacc += a3; W0; W1; NPIN(PW); NPIN(sacc); NSB(); } while (0)
#define NP_GAPB(MF, X, i) do { MF; X[i] = ex2(X[i]); X[(i) + 1] = ex2(X[(i) + 1]); X[(i) + 2] = ex2(X[(i) + 2]); X[(i) + 3] = ex2(X[(i) + 3]); NPIN(X); NSB(); } while (0)
#define NP_KRD(GL, d0) do { if (GL) { NP_KLOAD2(sn_, d0); NSB(); } } while (0)
#define NP_STEP(C0, C1, P0, P1, LAST) do { NSB(); \
    const int sp_ = (s - 1) & 3, sn_ = (s + 1) & 3, sw_ = (s + 2) & 3; \
    if (!(LAST) && jn2 >= 0) NP_DMA(jn2, sw_);     \
    LAS const unsigned char* vp_ = NP_VIMG(sp_) + vfo; \
    NP_CINIT(jc); \
    float sacc = P0[0] + P0[1]; NSB(); \
    NP_GAPA(C0 = MFMA32(kf[0], qr[0], ci16), P0[2], P0[3], P0[4], P0[5],     pw0[0] = NP_PKW(P0, 0),  pw0[1] = NP_PKW(P0, 2),  pw0); \
    NP_GAPA(C1 = MFMA32(kf[1], qr[0], ci16), P0[6], P0[7], P0[8], P0[9],     pw0[2] = NP_PKW(P0, 4),  pw0[3] = NP_PKW(P0, 6),  pw0); \
    NP_GAPA(C0 = MFMA32(kf[2], qr[1], C0),            P0[10], P0[11], P0[12], P0[13], pw1[0] = NP_PKW(P0, 8),  pw1[1] = NP_PKW(P0, 10), pw1); \
    NP_GAPA(C1 = MFMA32(kf[3], qr[1], C1),            P0[14], P0[15], P1[0], P1[1],   pw1[2] = NP_PKW(P0, 12), pw1[3] = NP_PKW(P0, 14), pw1); \
    NP_GAPA(C0 = MFMA32(kf[4], qr[2], C0),            P1[2], P1[3], P1[4], P1[5],     pw2[0] = NP_PKW(P1, 0),  pw2[1] = NP_PKW(P1, 2),  pw2); \
    NP_GAPA(C1 = MFMA32(kf[5], qr[2], C1),            P1[6], P1[7], P1[8], P1[9],     pw2[2] = NP_PKW(P1, 4),  pw2[3] = NP_PKW(P1, 6),  pw2); \
    NP_GAPA(C0 = MFMA32(kf[6], qr[3], C0),            P1[10], P1[11], P1[12], P1[13], pw3[0] = NP_PKW(P1, 8),  pw3[1] = NP_PKW(P1, 10), pw3); \
    NP_GAPA(C1 = MFMA32(kf[7], qr[3], C1),            P1[14], P1[15], 0.f, 0.f,       pw3[2] = NP_PKW(P1, 12), pw3[3] = NP_PKW(P1, 14), pw3); \
    l += sacc; \
    NP_VRD(0); NP_VRD(1); NP_VRD(2); NP_VRD(3); NSB();     \
    if (LAST) nsa_mask<KIND>(C0, C1, 64 * jc, t, hi); \
    NP_DECIDE(C0, C1); NSB(); \
    NP_VRD(4); NSB(); NP_GAPB(o0 = MFMA32(NP_VFR(0), __builtin_bit_cast(bf16x8, pw0), o0), C0, 0); \
    NP_VRD(5); NSB(); NP_GAPB(o1 = MFMA32(NP_VFR(1), __builtin_bit_cast(bf16x8, pw0), o1), C0, 4); \
    NP_VRD(6); NSB(); NP_KRD(!(LAST), 0); NP_GAPB(o0 = MFMA32(NP_VFR(2), __builtin_bit_cast(bf16x8, pw1), o0), C0, 8); \
    NP_VRD(7); NSB(); NP_KRD(!(LAST), 1); NP_GAPB(o1 = MFMA32(NP_VFR(3), __builtin_bit_cast(bf16x8, pw1), o1), C0, 12); \
    NP_KRD(!(LAST), 2); NP_GAPB(o0 = MFMA32(NP_VFR(4), __builtin_bit_cast(bf16x8, pw2), o0), C1, 0); \
    NP_KRD(!(LAST), 3); NP_GAPB(o1 = MFMA32(NP_VFR(5), __builtin_bit_cast(bf16x8, pw2), o1), C1, 4); \
    NP_GAPB(o0 = MFMA32(NP_VFR(6), __builtin_bit_cast(bf16x8, pw3), o0), C1, 8);  NP_GAPB(o1 = MFMA32(NP_VFR(7), __builtin_bit_cast(bf16x8, pw3), o1), C1, 12); \
    NP_DMAWAIT(); \
    __syncthreads(); \
    if (resc) { _Pragma("unroll") for (int r = 0; r < 16; ++r) { o0[r] *= fsc; o1[r] *= fsc; } } \
    jc = jn1; jn1 = jn2; NP_NEXT(jn2); ++s; } while (0)
    int rem = n - 1;
    if (n & 1) { pB0 = pA0; pB1 = pA1; if (rem > 0) { NP_STEP(pA0, pA1, pB0, pB1, false); --rem; } }
    while (rem >= 3) { NP_STEP(pB0, pB1, pA0, pA1, false); NP_STEP(pA0, pA1, pB0, pB1, false); rem -= 2; }
    if (rem == 1) { NP_STEP(pB0, pB1, pA0, pA1, true); }
    { float sacc = pB0[0] + pB0[1];
      _Pragma("unroll") for (int r = 2; r < 16; ++r) sacc += pB0[r];
      _Pragma("unroll") for (int r = 0; r < 16; ++r) sacc += pB1[r];
      l += sacc;
      pw0 = (u32x4){NP_PKW(pB0, 0), NP_PKW(pB0, 2), NP_PKW(pB0, 4), NP_PKW(pB0, 6)}; pw1 = (u32x4){NP_PKW(pB0, 8), NP_PKW(pB0, 10), NP_PKW(pB0, 12), NP_PKW(pB0, 14)};
      pw2 = (u32x4){NP_PKW(pB1, 0), NP_PKW(pB1, 2), NP_PKW(pB1, 4), NP_PKW(pB1, 6)}; pw3 = (u32x4){NP_PKW(pB1, 8), NP_PKW(pB1, 10), NP_PKW(pB1, 12), NP_PKW(pB1, 14)};
      LAS const unsigned char* vp_ = NP_VIMG((n - 1) & 3) + vfo;
      _Pragma("unroll") for (int i = 0; i < 8; ++i) NP_VRD(i);
      NSB();
      o0 = MFMA32(NP_VFR(0), __builtin_bit_cast(bf16x8, pw0), o0); o1 = MFMA32(NP_VFR(1), __builtin_bit_cast(bf16x8, pw0), o1);
      o0 = MFMA32(NP_VFR(2), __builtin_bit_cast(bf16x8, pw1), o0); o1 = MFMA32(NP_VFR(3), __builtin_bit_cast(bf16x8, pw1), o1);
      o0 = MFMA32(NP_VFR(4), __builtin_bit_cast(bf16x8, pw2), o0); o1 = MFMA32(NP_VFR(5), __builtin_bit_cast(bf16x8, pw2), o1);
      o0 = MFMA32(NP_VFR(6), __builtin_bit_cast(bf16x8, pw3), o0); o1 = MFMA32(NP_VFR(7), __builtin_bit_cast(bf16x8, pw3), o1); }
    __syncthreads();
    lsum = l;
#undef NP_DMA
#undef NP_DMAWAIT
#undef NP_NEXT
#undef NP_SELBIT
#undef NP_KIMG
#undef NP_VIMG
#undef NP_KLOAD2
#undef NP_SPLAT
#undef NP_CINIT
#undef NP_DECIDE
#undef NP_PKW
#undef NP_VFR
#undef NP_VRD
#undef NP_GAPA
#undef NP_GAPB
#undef NP_KRD
#undef NP_STEP
}

__device__ __forceinline__ void nsa_unit(Frame& F, int b, int g, int qb) {
    int tid = F.tid; asm volatile("" : "+v"(tid));
    const int lane = tid & 63, w = F.wave, r32 = lane & 31, hi = lane >> 5;
    const int hh = 4 * g + (w & 3), th = w >> 2, cur = qb, T0 = qb * 64, tokl = 32 * th + r32, t = T0 + tokl;
    const size_t row = (size_t)b * SEQ + t; const int bg = b * 2 + g;
    LAS unsigned char* L = F.lds;
    bf16x8 qr[4];
    { const bf16_t* qp = WSP(bf16_t, WS_NQ) + row * 512 + hh * 64 + 8 * hi;
#pragma unroll
      for (int d0 = 0; d0 < 4; ++d0) qr[d0] = *(const bf16x8*)(qp + 16 * d0); }
    const float* gp = WSP(float, WS_NGT) + row * 24 + hh * 3; const float gate_c = gp[0], gate_s = gp[1], gate_w = gp[2];
    unsigned outp0[8], outp1[8];
    const unsigned kst = (tid & 7) * NSA_KCH + (tid >> 3) * 16, vst = ((tid & 7) >> 2) * NSA_VDH + (tid >> 3) * 64 + (tid & 3) * 16;
    const unsigned kfo = hi * NSA_KCH + r32 * 16, vfo = tr_lane_off(lane);
    float m, l; f32x16 o0, o1;
    u32x4 rk, rv;
#define NSA_LOAD(Kp, Vp, tile) do { rk = *(const u32x4*)((Kp) + (size_t)(tile) * 4096 + tid * 8); rv = *(const u32x4*)((Vp) + (size_t)(tile) * 4096 + tid * 8); } while (0)
#define NSA_WRITE(buf) do { *(LAS u32x4*)(L + (buf) * NSA_BUF + kst) = rk; *(LAS u32x4*)(L + (buf) * NSA_BUF + NSA_KIMG + vst) = rv; } while (0)
#define NSA_NEXT(jv) do { jv = -1; if (ulo | uhi) { jv = ulo ? __builtin_ctz(ulo) : 32 + __builtin_ctz(uhi); if (ulo) ulo &= ulo - 1; else uhi &= uhi - 1; } } while (0)
#define NSA_RUN(Kp, Vp, MLO, MHI, ...) do { unsigned ulo = (MLO), uhi = (MHI); int j, j1, j2; u32x4 rk2, rv2; \
        NSA_NEXT(j); NSA_LOAD(Kp, Vp, j); NSA_WRITE(0); NSA_NEXT(j1); if (j1 >= 0) NSA_LOAD(Kp, Vp, j1); __syncthreads(); int buf = 0; \
        for (;;) { NSA_NEXT(j2); if (j2 >= 0) { rk2 = *(const u32x4*)((Kp) + (size_t)j2 * 4096 + tid * 8); rv2 = *(const u32x4*)((Vp) + (size_t)j2 * 4096 + tid * 8); } \
            { LAS const unsigned char* KI = L + buf * NSA_BUF; LAS const unsigned char* VI = KI + NSA_KIMG; __VA_ARGS__ } \
            if (j1 >= 0) NSA_WRITE(buf ^ 1); __syncthreads(); if (j1 < 0) break; j = j1; j1 = j2; rk = rk2; rv = rv2; buf ^= 1; } } while (0)
#define NSA_LOAD2(Kp, Vp, ja, jb) do { rk = *(const u32x4*)((Kp) + (size_t)(ja) * 4096 + tid * 8); rv = *(const u32x4*)((Vp) + (size_t)(ja) * 4096 + tid * 8); \
        if ((jb) >= 0) { rkB = *(const u32x4*)((Kp) + (size_t)(jb) * 4096 + tid * 8); rvB = *(const u32x4*)((Vp) + (size_t)(jb) * 4096 + tid * 8); } } while (0)
#define NSA_WRITE2(pb, jb) do { LAS unsigned char* P_ = L + (pb) * (2 * NSA_BUF); *(LAS u32x4*)(P_ + kst) = rk; *(LAS u32x4*)(P_ + NSA_KIMG + vst) = rv; \
        if ((jb) >= 0) { *(LAS u32x4*)(P_ + NSA_BUF + kst) = rkB; *(LAS u32x4*)(P_ + NSA_BUF + NSA_KIMG + vst) = rvB; } } while (0)
#define NSA_RUN2(Kp, Vp, MLO, MHI, ...) do { unsigned ulo = (MLO), uhi = (MHI); int ja, jb, na, nb; u32x4 rkB, rvB; \
        NSA_NEXT(ja); NSA_NEXT(jb); NSA_LOAD2(Kp, Vp, ja, jb); NSA_WRITE2(0, jb); __syncthreads(); int pbuf = 0; \
        for (;;) { NSA_NEXT(na); NSA_NEXT(nb); if (na >= 0) NSA_LOAD2(Kp, Vp, na, nb); \
            { LAS const unsigned char* KA = L + pbuf * (2 * NSA_BUF); LAS const unsigned char* VA = KA + NSA_KIMG; LAS const unsigned char* KB = KA + NSA_BUF; LAS const unsigned char* VB = KB + NSA_KIMG; __VA_ARGS__ } \
            if (na >= 0) NSA_WRITE2(pbuf ^ 1, nb); __syncthreads(); if (na < 0) break; ja = na; jb = nb; pbuf ^= 1; } } while (0)
#define NSA_LT(lv) ({ const auto rr_ = __builtin_amdgcn_permlane32_swap(__float_as_uint(lv), __float_as_uint(lv), false, false); __uint_as_float(rr_[0]) + __uint_as_float(rr_[1]); })
#define NSA_RESET() do { m = -1e30f; l = 0.f; o0 = (f32x16){0}; o1 = (f32x16){0}; } while (0)

    const bf16_t* Kc = WSP(bf16_t, WS_KCMP) + (size_t)bg * 256 * 64; const bf16_t* Vc = WSP(bf16_t, WS_VCMP) + (size_t)bg * 256 * 64;
    const int ntc = ((4 * cur + 2) >> 6) + 1; const int lim = (t >= 31) ? ((t - 31) >> 4) : -1;
    const int tmin_w = T0 + 32 * th; const int lim_min = (tmin_w >= 31) ? ((tmin_w - 31) >> 4) : -1;
    unsigned sel0, sel1, un0, un1;
    {
        LAS float* IMP = (LAS float*)(L + NSA_IMP); LAS float* FAC = (LAS float*)(L + NSA_FAC);
        float carry = 0.f; const bool need_imp = cur >= 16;
        float mt0 = 0.f, mt1 = 0.f, mt2 = 0.f, mt3 = 0.f;
        m = -1e30f; l = 0.f; o0 = (f32x16){0}; o1 = (f32x16){0};
        NSA_RUN(Kc, Vc, (1u << ntc) - 1u, 0u, {
            f32x16 p0, p1; nsa_qk(KI, qr, kfo, p0, p1);
            if (64 * j + 63 > lim_min) {
                _Pragma("unroll") for (int r = 0; r < 16; ++r) { const int k0 = 64 * j + crow(r, hi);
                    p0[r] = (k0 <= lim) ? p0[r] : -INFINITY; p1[r] = (k0 + 32 <= lim) ? p1[r] : -INFINITY; } }
            { const float rm = nsa_rowmax(p0, p1); const bool fresh = m < -1e29f; const bool grow = fresh ? (rm > -INFINITY) : (rm - m > NSA_THR);
              if (__any(grow)) { const float mn = grow ? rm : m; const float f = (grow && !fresh) ? ex2(m - mn) : 1.f; m = mn; l *= f; carry *= f;
                  _Pragma("unroll") for (int r = 0; r < 16; ++r) { o0[r] *= f; o1[r] *= f; } } }
            if (j == 0) mt0 = m; else if (j == 1) mt1 = m; else if (j == 2) mt2 = m; else mt3 = m;
            { float rs = 0.f;
              _Pragma("unroll") for (int r = 0; r < 16; ++r) { p0[r] = ex2(p0[r] - m); p1[r] = ex2(p1[r] - m); rs += p0[r] + p1[r]; }
              l += rs; }
            if (need_imp) {
                _Pragma("unroll") for (int n = 0; n < 2; ++n) {
                    float a[4], bq[4], pb[4];
                    _Pragma("unroll") for (int q4 = 0; q4 < 4; ++q4) { const float x0 = n ? p1[4 * q4] : p0[4 * q4], x1 = n ? p1[4 * q4 + 1] : p0[4 * q4 + 1], x2 = n ? p1[4 * q4 + 2] : p0[4 * q4 + 2], x3 = n ? p1[4 * q4 + 3] : p0[4 * q4 + 3];
                        a[q4] = 2.f * (x0 + x1 + x2) + x3; bq[q4] = x3; }
                    _Pragma("unroll") for (int q4 = 0; q4 < 4; ++q4) pb[q4] = __shfl_xor(bq[q4], 32);
                    _Pragma("unroll") for (int q4 = 0; q4 < 4; ++q4) { const float prevb = hi ? pb[q4] : (q4 ? pb[q4 > 0 ? q4 - 1 : 0] : carry);
                        IMP[((w & 3) * 64 + tokl) * NSA_IST + 16 * j + 8 * n + 2 * q4 + hi] = a[q4] + prevb; }
                    carry = pb[3];
                } }
            u32x4 pw[4];
            _Pragma("unroll") for (int s = 0; s < 2; ++s) {
                pw[s].x = cvtpk(p0[8 * s + 0], p0[8 * s + 1]); pw[s].y = cvtpk(p0[8 * s + 2], p0[8 * s + 3]); pw[s].z = cvtpk(p0[8 * s + 4], p0[8 * s + 5]); pw[s].w = cvtpk(p0[8 * s + 6], p0[8 * s + 7]);
                pw[2 + s].x = cvtpk(p1[8 * s + 0], p1[8 * s + 1]); pw[2 + s].y = cvtpk(p1[8 * s + 2], p1[8 * s + 3]); pw[2 + s].z = cvtpk(p1[8 * s + 4], p1[8 * s + 5]); pw[2 + s].w = cvtpk(p1[8 * s + 6], p1[8 * s + 7]); }
            _Pragma("unroll") for (int ks = 0; ks < 4; ++ks) {
                const bf16x8 v0 = mk8(vtr(VI + vfo + ks * 1024), vtr(VI + vfo + ks * 1024 + 512));
                const bf16x8 v1 = mk8(vtr(VI + vfo + NSA_VDH + ks * 1024), vtr(VI + vfo + NSA_VDH + ks * 1024 + 512));
                o0 = MFMA32(v0, __builtin_bit_cast(bf16x8, pw[ks]), o0); o1 = MFMA32(v1, __builtin_bit_cast(bf16x8, pw[ks]), o1); } });
        const float inv_c = 1.f / fmaxf(NSA_LT(l), 1e-30f); const float gs_ = gate_c * inv_c;
        _Pragma("unroll") for (int r = 0; r < 8; ++r) { outp0[r] = cvtpk(gs_ * o0[2 * r], gs_ * o0[2 * r + 1]); outp1[r] = cvtpk(gs_ * o1[2 * r], gs_ * o1[2 * r + 1]); }
        if (need_imp) {
            if (hi == 0) { f32x4 fc; fc[0] = ex2(mt0 - m) * inv_c; fc[1] = ntc > 1 ? ex2(mt1 - m) * inv_c : 0.f; fc[2] = ntc > 2 ? ex2(mt2 - m) * inv_c : 0.f; fc[3] = ntc > 3 ? ex2(mt3 - m) * inv_c : 0.f;
                *(LAS f32x4*)(FAC + ((w & 3) * 64 + tokl) * 4) = fc; }
            __syncthreads(); }
    }
    if (cur >= 16) {
        LAS float* IMP = (LAS float*)(L + NSA_IMP);
        LAS unsigned* TOT = (LAS unsigned*)(L + NSA_TOT); LAS unsigned char* SELB = L + NSA_SELB; LAS unsigned* UNI = (LAS unsigned*)(L + NSA_UNI);
        { const int tk = tid >> 3, jg = tid & 7; LAS const float* FAC = (LAS const float*)(L + NSA_FAC);
          float fq[4];
#pragma unroll
          for (int h4 = 0; h4 < 4; ++h4) fq[h4] = FAC[(h4 * 64 + tk) * 4 + (jg >> 1)];
#pragma unroll
          for (int jj = 0; jj < 8; ++jj) { const int jx = 8 * jg + jj;
              const float tot = ((IMP[tk * NSA_IST + jx] * fq[0] + IMP[(64 + tk) * NSA_IST + jx] * fq[1]) + IMP[(128 + tk) * NSA_IST + jx] * fq[2]) + IMP[(192 + tk) * NSA_IST + jx] * fq[3];
              TOT[tk * NSA_IST + jx] = (__float_as_uint(tot) & ~63u) | (unsigned)(63 - jx); }
          if (tid < 2) UNI[tid] = 0u; }
        __syncthreads();
        { const int tk = tid >> 3, jg = tid & 7; unsigned bits = 0u;
          unsigned v[8]; int rank[8];
#pragma unroll
          for (int jj = 0; jj < 8; ++jj) { v[jj] = TOT[tk * NSA_IST + 8 * jg + jj]; rank[jj] = 0; }
#pragma unroll 4
          for (int k2 = 1; k2 <= cur - 2; ++k2) { const unsigned v2 = TOT[tk * NSA_IST + k2];
#pragma unroll
              for (int jj = 0; jj < 8; ++jj) rank[jj] += (int)(v2 > v[jj]); }
#pragma unroll
          for (int jj = 0; jj < 8; ++jj) { const int jx = 8 * jg + jj;
              const bool s = (jx == 0 || jx == cur || jx == cur - 1) || (jx < cur - 1 && rank[jj] < 13);
              bits |= s ? (1u << jj) : 0u; }
          SELB[tk * 8 + jg] = (unsigned char)bits;
          atomicOr((unsigned*)&UNI[jg >> 2], bits << (8 * (jg & 3))); }
        __syncthreads();
        sel0 = *(LAS const unsigned*)(SELB + tokl * 8); sel1 = *(LAS const unsigned*)(SELB + tokl * 8 + 4);
        un0 = __builtin_amdgcn_readfirstlane(UNI[0]); un1 = __builtin_amdgcn_readfirstlane(UNI[1]);
    } else {
        sel0 = (1u << (cur + 1)) - 1u; sel1 = 0u; un0 = sel0; un1 = 0u;
    }
    LAS unsigned* ST = (LAS unsigned*)(L + NSA_STASH + w * 4096) + lane;
#pragma unroll
    for (int r = 0; r < 8; ++r) { ST[r * 64] = outp0[r]; ST[(8 + r) * 64] = outp1[r]; }
    const bf16_t* Ks = WSP(bf16_t, WS_KSL) + (size_t)bg * SEQ * 64; const bf16_t* Vs = WSP(bf16_t, WS_VSL) + (size_t)bg * SEQ * 64;
    NDUP(3) nsa_pipe<1>(L, Ks, Vs, un0, un1, sel0, sel1, qr, t, lane, w, hi, kfo, vfo, l, o0, o1);
    { const float sc = gate_s / fmaxf(NSA_LT(l), 1e-30f);
#pragma unroll
      for (int r = 0; r < 8; ++r) { const unsigned a = ST[r * 64], c = ST[(8 + r) * 64];
          ST[r * 64] = cvtpk(bflo(a) + sc * o0[2 * r], bfhi(a) + sc * o0[2 * r + 1]); ST[(8 + r) * 64] = cvtpk(bflo(c) + sc * o1[2 * r], bfhi(c) + sc * o1[2 * r + 1]); } }
    const bf16_t* Kw = WSP(bf16_t, WS_KWN) + (size_t)bg * SEQ * 64; const bf16_t* Vw = WSP(bf16_t, WS_VWN) + (size_t)bg * SEQ * 64;
    { const int jlo = cur >= 8 ? cur - 8 : 0;
      const unsigned long long wm = ((cur == 63) ? ~0ull : ((1ull << (cur + 1)) - 1ull)) & ~((1ull << jlo) - 1ull);
      NDUP(4) nsa_pipe<2>(L, Kw, Vw, (unsigned)wm, (unsigned)(wm >> 32), 0u, 0u, qr, t, lane, w, hi, kfo, vfo, l, o0, o1); }
    { const float sc = gate_w / fmaxf(NSA_LT(l), 1e-30f);
      bf16_t* yo = WSP(bf16_t, WS_YCAT) + row * 1024 + 512 + hh * 64;
#pragma unroll
      for (int p2 = 0; p2 < 2; ++p2) { u32x2 av[2], cv[2];
#pragma unroll
          for (int e = 0; e < 2; ++e) { const int q4 = 2 * p2 + e;
              const unsigned a0 = ST[(2 * q4) * 64], a1 = ST[(2 * q4 + 1) * 64], c0 = ST[(8 + 2 * q4) * 64], c1 = ST[(9 + 2 * q4) * 64];
              av[e].x = cvtpk(bflo(a0) + sc * o0[4 * q4], bfhi(a0) + sc * o0[4 * q4 + 1]); av[e].y = cvtpk(bflo(a1) + sc * o0[4 * q4 + 2], bfhi(a1) + sc * o0[4 * q4 + 3]);
              cv[e].x = cvtpk(bflo(c0) + sc * o1[4 * q4], bfhi(c0) + sc * o1[4 * q4 + 1]); cv[e].y = cvtpk(bflo(c1) + sc * o1[4 * q4 + 2], bfhi(c1) + sc * o1[4 * q4 + 3]); }
          *(u32x4*)(yo + 16 * p2 + 8 * hi) = widen_pair(av[0], av[1]); *(u32x4*)(yo + 32 + 16 * p2 + 8 * hi) = widen_pair(cv[0], cv[1]); } }
#undef NSA_LOAD
#undef NSA_WRITE
#undef NSA_RUN
#undef NSA_RUN2
#undef NSA_LOAD2
#undef NSA_WRITE2
#undef NSA_LT
#undef NSA_RESET
}

__device__ __forceinline__ void s6_phase(Frame& F) {
    int tid = F.tid; asm volatile("" : "+v"(tid));
    const int lane = tid & 63, w = F.wave;
    LAS unsigned char* TILE = F.lds + w * 16384;
    LAS float* LG = (LAS float*)(F.lds + MISC_OFF + 4096) + w * (8 * 48);
    LAS int* REC_E = (LAS int*)(F.lds + MISC_OFF + 16384);
    LAS float* REC_G = (LAS float*)(F.lds + MISC_OFF + 16384 + 1024);
    LAS int* REC_P = (LAS int*)(F.lds + MISC_OFF + 16384 + 2048);
    LAS int* CNTL = (LAS int*)(F.lds + MISC_OFF + 16384 + 3072);
    LAS float* SAW = (LAS float*)(F.lds + MISC_OFF + 16384 + 3584);
    const float* x = IN_F(0); const float* wpost = IN_F(6); const float* wffn = IN_F(7); const float* mod = WSP(float, WS_MOD);
    const bf16_t* Y = WSP(bf16_t, WS_Y); bf16_t* X1B = WSP(bf16_t, WS_X1B); signed char* H2Q = (signed char*)(F.ws + WS_H2Q); float* SAv = WSP(float, WS_SA); const _Float16* RWT = WSP(_Float16, WS_RWT);
    const float* bgp = IN_F(21); const float* bep = IN_F(23);
    unsigned* cntg = (unsigned*)(F.ws + WS_CTL) + CW_CNT;
    for (int rb = F.vcu; rb < NTOK / 128; rb += F.G) {
        if (tid < 64) CNTL[tid] = 0;
        __syncthreads();
        const int rbase = rb * 128 + w * 16, b = rbase >> 12;
        f32x4 xv[4][4]; u32x4 yw[4][2];
#define S6_LOAD(g) do { _Pragma("unroll") for (int r = 0; r < 4; ++r) { const size_t ro_ = (size_t)(rbase + 4 * (g) + r) * DM; \
            _Pragma("unroll") for (int j = 0; j < 4; ++j) xv[r][j] = __builtin_nontemporal_load((const f32x4*)(x + ro_ + 4 * lane + 256 * j)); \
            _Pragma("unroll") for (int jp = 0; jp < 2; ++jp) yw[r][jp] = __builtin_nontemporal_load((const u32x4*)(Y + ro_ + 4 * (lane & ~1) + 256 * (2 * jp + (lane & 1)))); } } while (0)
#define S6_Y(r, j) ((f32x4){bflo(yr[r][j].x), bfhi(yr[r][j].x), bflo(yr[r][j].y), bfhi(yr[r][j].y)})
        S6_LOAD(0);
#pragma nounroll
        for (int g = 0; g < 4; ++g) {
            u32x2 yr[4][4];
#pragma unroll
            for (int r = 0; r < 4; ++r)
#pragma unroll
                for (int jp = 0; jp < 2; ++jp) pair_narrow(yw[r][jp], lane, yr[r][2 * jp], yr[r][2 * jp + 1]);
            int l4 = 4 * lane; asm volatile("" : "+v"(l4));
            float ss[4];
#pragma unroll
            for (int r = 0; r < 4; ++r) { float a2 = 0.f;
#pragma unroll
                for (int j = 0; j < 4; ++j) { const f32x4 y = S6_Y(r, j); a2 += y[0] * y[0] + y[1] * y[1] + y[2] * y[2] + y[3] * y[3]; }
                ss[r] = a2; }
#pragma unroll
            for (int o = 1; o < 64; o <<= 1) {
#pragma unroll
                for (int r = 0; r < 4; ++r) ss[r] += __shfl_xor(ss[r], o); }
            float s2[4] = {0.f, 0.f, 0.f, 0.f};
#pragma unroll
            for (int j = 0; j < 4; ++j) { const int k = l4 + 256 * j;
                const f32x4 wp = *(const f32x4*)(wpost + k), gm = *(const f32x4*)(mod + b * 6144 + 2048 + k); const f32x4 gw2 = gm * wp;
#pragma unroll
                for (int r = 0; r < 4; ++r) { const float r1 = rsqrtf(ss[r] * (1.f / DM) + RMS_EPS);
                    xv[r][j] = xv[r][j] + gw2 * (S6_Y(r, j) * r1);
                    s2[r] += xv[r][j][0] * xv[r][j][0] + xv[r][j][1] * xv[r][j][1] + xv[r][j][2] * xv[r][j][2] + xv[r][j][3] * xv[r][j][3]; } }
#pragma unroll
            for (int r = 0; r < 4; ++r)
#pragma unroll
                for (int jp = 0; jp < 2; ++jp) { u32x2 pa, pb; pa.x = cvtpk(xv[r][2 * jp][0], xv[r][2 * jp][1]); pa.y = cvtpk(xv[r][2 * jp][2], xv[r][2 * jp][3]);
                    pb.x = cvtpk(xv[r][2 * jp + 1][0], xv[r][2 * jp + 1][1]); pb.y = cvtpk(xv[r][2 * jp + 1][2], xv[r][2 * jp + 1][3]);
                    __builtin_nontemporal_store(pair_widen(pa, pb, lane), (u32x4*)(X1B + (size_t)(rbase + 4 * g + r) * DM + 4 * (lane & ~1) + 256 * (2 * jp + (lane & 1)))); }
#pragma unroll
            for (int o = 1; o < 64; o <<= 1) {
#pragma unroll
                for (int r = 0; r < 4; ++r) s2[r] += __shfl_xor(s2[r], o); }
#pragma unroll
            for (int j = 0; j < 4; ++j) { const int k = l4 + 256 * j;
                const f32x4 wf = *(const f32x4*)(wffn + k), sh = *(const f32x4*)(mod + b * 6144 + 3072 + k), sc = *(const f32x4*)(mod + b * 6144 + 4096 + k); const f32x4 ws = wf * (sc + 1.f);
#pragma unroll
                for (int r = 0; r < 4; ++r) { const float r2 = rsqrtf(s2[r] * (1.f / DM) + RMS_EPS);
                    const f32x4 h = xv[r][j] * r2 * ws + sh;
                    { const int rt = 4 * (g & 1) + r; const f16x4 hh = {(_Float16)h[0], (_Float16)h[1], (_Float16)h[2], (_Float16)h[3]};
                      *(LAS f16x4*)(TILE + rt * 2048 + (((lane >> 1) ^ rt) << 4) + (lane & 1) * 8 + 512 * j) = hh; }
                    xv[r][j] = h; } }
            float am[4];
#pragma unroll
            for (int r = 0; r < 4; ++r) { float a = 0.f;
#pragma unroll
                for (int j = 0; j < 4; ++j) a = fmaxf(a, fmaxf(fmaxf(fabsf(xv[r][j][0]), fabsf(xv[r][j][1])), fmaxf(fabsf(xv[r][j][2]), fabsf(xv[r][j][3]))));
                am[r] = a; }
#pragma unroll
            for (int o = 1; o < 64; o <<= 1) {
#pragma unroll
                for (int r = 0; r < 4; ++r) am[r] = fmaxf(am[r], __shfl_xor(am[r], o)); }
#pragma unroll
            for (int r = 0; r < 4; ++r) { const float inv = am[r] > 0.f ? 127.f / am[r] : 0.f; const size_t ro = (size_t)(rbase + 4 * g + r) * DM;
                if (lane == 0) { SAv[rbase + 4 * g + r] = am[r] * (1.f / 127.f); SAW[(w * 16 + 4 * g + r)] = am[r] * (1.f / 127.f); }
                u32x4 pk;
#pragma unroll
                for (int j = 0; j < 4; ++j) { const f32x4 q = xv[r][j] * inv;
                    const int q0 = (int)rintf(q[0]), q1 = (int)rintf(q[1]), q2 = (int)rintf(q[2]), q3 = (int)rintf(q[3]);
                    pk[j] = (unsigned)(q0 & 0xff) | ((unsigned)(q1 & 0xff) << 8) | ((unsigned)(q2 & 0xff) << 16) | ((unsigned)(q3 & 0xff) << 24); }
                *(u32x4*)(H2Q + ro + 256 * (lane & 3) + 16 * (lane >> 2)) = quad_transpose(pk, lane); }
            __builtin_amdgcn_sched_barrier(0);
            if (g < 3) S6_LOAD(g + 1);
            __builtin_amdgcn_sched_barrier(0);
            if (g & 1) {
                const int r16 = lane & 15, q = lane >> 4, rt = r16 & 7;
                f32x4 a0 = {0.f, 0.f, 0.f, 0.f}, a1 = a0, a2 = a0;
                LAS const unsigned char* ae = TILE + rt * 2048 + ((q ^ rt) << 4); LAS const unsigned char* ao = TILE + rt * 2048 + (((q ^ rt) ^ 4) << 4);
                const _Float16* bp = RWT + (size_t)r16 * DM + 8 * q;
#pragma unroll 2
                for (int k2 = 0; k2 < 16; ++k2) {
                    const f16x8 ah0 = *(LAS const f16x8*)(ae + 128 * k2), ah1 = *(LAS const f16x8*)(ao + 128 * k2);
                    const f16x8 b00 = *(const f16x8*)(bp + 64 * k2), b01 = *(const f16x8*)(bp + 64 * k2 + 16 * DM), b02 = *(const f16x8*)(bp + 64 * k2 + 32 * DM);
                    const f16x8 b10 = *(const f16x8*)(bp + 64 * k2 + 32), b11 = *(const f16x8*)(bp + 64 * k2 + 32 + 16 * DM), b12 = *(const f16x8*)(bp + 64 * k2 + 32 + 32 * DM);
                    a0 = __builtin_amdgcn_mfma_f32_16x16x32_f16(ah0, b00, a0, 0, 0, 0); a1 = __builtin_amdgcn_mfma_f32_16x16x32_f16(ah0, b01, a1, 0, 0, 0); a2 = __builtin_amdgcn_mfma_f32_16x16x32_f16(ah0, b02, a2, 0, 0, 0);
                    a0 = __builtin_amdgcn_mfma_f32_16x16x32_f16(ah1, b10, a0, 0, 0, 0); a1 = __builtin_amdgcn_mfma_f32_16x16x32_f16(ah1, b11, a1, 0, 0, 0); a2 = __builtin_amdgcn_mfma_f32_16x16x32_f16(ah1, b12, a2, 0, 0, 0); }
                if (q < 2) {
#pragma unroll
                    for (int i = 0; i < 4; ++i) { LG[(4 * q + i) * 48 + r16] = a0[i]; LG[(4 * q + i) * 48 + 16 + r16] = a1[i]; LG[(4 * q + i) * 48 + 32 + r16] = a2[i]; } }
                asm volatile("s_waitcnt lgkmcnt(0)" ::: "memory");
                if (lane < 8) {
                    const LAS float* lg = LG + lane * 48;
                    float gl[4]; int gi = 0; float gmx = -INFINITY;
#pragma unroll
                    for (int i = 0; i < 4; ++i) { gl[i] = lg[i] + bgp[i]; if (gl[i] > gmx) { gmx = gl[i]; gi = i; } }
                    float gs = 0.f;
#pragma unroll
                    for (int i = 0; i < 4; ++i) gs += __expf(gl[i] - gmx);
                    const float pg = 1.f / gs;
                    float el[8]; float emx = -INFINITY;
#pragma unroll
                    for (int i = 0; i < 8; ++i) { el[i] = lg[4 + gi * 8 + i] + bep[gi * 8 + i]; emx = fmaxf(emx, el[i]); }
                    int e0 = 0; float v0 = -INFINITY;
#pragma unroll
                    for (int i = 0; i < 8; ++i) if (el[i] > v0) { v0 = el[i]; e0 = i; }
                    int e1 = 0; float v1 = -INFINITY;
#pragma unroll
                    for (int i = 0; i < 8; ++i) if (i != e0 && el[i] > v1) { v1 = el[i]; e1 = i; }
                    const float p0 = __expf(v0 - emx), p1 = __expf(v1 - emx);
                    const float g0 = pg * p0 / (p0 + p1), g1 = pg * p1 / (p0 + p1);
                    const int rl = w * 16 + 8 * (g >> 1) + lane; const int E0 = gi * 8 + e0, E1 = gi * 8 + e1;
                    REC_E[rl * 2] = E0; REC_E[rl * 2 + 1] = E1; REC_G[rl * 2] = g0; REC_G[rl * 2 + 1] = g1;
                    REC_P[rl * 2] = atomicAdd((int*)&CNTL[E0], 1); REC_P[rl * 2 + 1] = atomicAdd((int*)&CNTL[E1], 1);
                }
                asm volatile("s_waitcnt lgkmcnt(0)" ::: "memory");
            }
        }
#undef S6_LOAD
#undef S6_Y
        __syncthreads();
        if (tid < 32) { const int c = CNTL[tid]; CNTL[32 + tid] = c ? (int)__hip_atomic_fetch_add(cntg + tid, (unsigned)c, __ATOMIC_RELAXED, __HIP_MEMORY_SCOPE_AGENT) : 0; }
        __syncthreads();
        if (tid < 256) { const int rl = tid >> 1, k = tid & 1; const int row = rb * 128 + rl; const int e = REC_E[tid]; const int p = CNTL[32 + e] + REC_P[tid];
            WSP(int, WS_TOKE)[row * 2 + k] = e; WSP(int, WS_TOKP)[row * 2 + k] = p; WSP(float, WS_TOKG)[row * 2 + k] = REC_G[tid];
            WSP(int, WS_LIST)[(size_t)e * 65536 + p] = row; WSP(float, WS_SAL)[(size_t)e * 65536 + p] = SAW[rl]; }
        __syncthreads();
    }
}

__device__ __forceinline__ void expert_convert(Frame& F) {
    {
        int tid = F.tid; asm volatile("" : "+v"(tid));
        LAS unsigned* AM = (LAS unsigned*)F.lds;
        const int n4 = tid & 7, kq = tid >> 3;
        for (int it = F.vcu; it < 1024; it += F.G) {
            const int e = it >> 5, sel = (it >> 4) & 1, j0 = (it & 15) * 32;
            const float* W = IN_F(sel ? 25 : 24) + (size_t)e * 1024 * 512 + (size_t)(16 * kq) * 512 + j0 + 4 * n4;
            if (tid < 32) AM[tid] = 0u;
            __syncthreads();
            f32x4 v[16]; f32x4 am = {0.f, 0.f, 0.f, 0.f};
#pragma unroll
            for (int i = 0; i < 16; ++i) { v[i] = *(const f32x4*)(W + (size_t)i * 512);
#pragma unroll
                for (int c = 0; c < 4; ++c) am[c] = fmaxf(am[c], fabsf(v[i][c])); }
#pragma unroll
            for (int o = 8; o < 64; o <<= 1) {
#pragma unroll
                for (int c = 0; c < 4; ++c) am[c] = fmaxf(am[c], __shfl_xor(am[c], o)); }
            if ((tid & 63) < 8) {
#pragma unroll
                for (int c = 0; c < 4; ++c) atomicMax((unsigned*)&AM[4 * n4 + c], __float_as_uint(am[c])); }
            __syncthreads();
            const f32x4 amax = *(LAS const f32x4*)((LAS const float*)AM + 4 * n4);
            unsigned char* dst = (unsigned char*)(F.ws + WS_W13T) + ((size_t)e * 1024 + 8 * ((j0 >> 2) + n4) + 4 * sel) * 1024 + 16 * kq;
#pragma unroll
            for (int c = 0; c < 4; ++c) { const float inv = amax[c] > 0.f ? 127.f / amax[c] : 0.f; u32x4 o;
#pragma unroll
                for (int d = 0; d < 4; ++d) {
                    const int q0 = (int)rintf(v[4 * d][c] * inv), q1 = (int)rintf(v[4 * d + 1][c] * inv), q2 = (int)rintf(v[4 * d + 2][c] * inv), q3 = (int)rintf(v[4 * d + 3][c] * inv);
                    o[d] = (unsigned)(q0 & 0xff) | ((unsigned)(q1 & 0xff) << 8) | ((unsigned)(q2 & 0xff) << 16) | ((unsigned)(q3 & 0xff) << 24); }
                *(u32x4*)(dst + (size_t)c * 1024) = o;
                if (kq == 0) WSP(float, WS_SB13)[e * 1024 + 8 * ((j0 >> 2) + n4) + 4 * sel + c] = amax[c] * (1.f / 127.f); }
            __syncthreads();
        }
    }
}
__device__ __forceinline__ void w2_convert(Frame& F, int rk, int nsh) {
    LAS float* scr = (LAS float*)(F.lds + F.wave * 8448);
    const int gw = rk * NWAVES + F.wave, NGW = nsh * NWAVES;
    for (int it = gw; it < 32 * 256; it += NGW) {
        const int e = it >> 8, r = it & 255;
        transpose_item(IN_F(26) + (size_t)e * 512 * 1024, 1024, WSP(bf16_t, WS_W2T) + (size_t)e * 1024 * 512, 512, scr, (r / 32) * 64, (r % 32) * 32, F.lane, RmId{0});
    }
    __syncthreads();
}

__device__ __forceinline__ void moe_tables(Frame& F, LAS int* tstart, LAS int* cnt) {
    if (F.tid < 64) {
        const int lane = F.tid; const unsigned* cg = (const unsigned*)(F.ws + WS_CTL) + CW_CNT;
        const int c = lane < 32 ? (int)__hip_atomic_load(cg + lane, __ATOMIC_RELAXED, __HIP_MEMORY_SCOPE_AGENT) : 0;
        const int tl = (c + 255) >> 8; int incl = tl;
#pragma unroll
        for (int o = 1; o < 32; o <<= 1) { const int x = __shfl_up(incl, o); if (lane >= o) incl += x; }
        if (lane < 32) { cnt[lane] = c; tstart[lane] = incl - tl; }
        if (lane == 31) tstart[32] = incl; }
    __syncthreads();
}

__device__ __forceinline__ void s10_phase(Frame& F, LAS int* tstart) {
    const int gw = F.vcu * NWAVES + F.wave, NGW = F.G * NWAVES, lane = F.lane;
    const float* wpost = IN_F(8); const float* mod = WSP(float, WS_MOD); const bf16_t* YB = WSP(bf16_t, WS_YB); const bf16_t* X1B = WSP(bf16_t, WS_X1B);
    int ne0[4], ne1[4], np0[4], np1[4]; float ng0[4], ng1[4];
#define S10_TAB(rw) do { _Pragma("unroll") for (int r = 0; r < 4; ++r) { const int row_ = (rw) + r; \
        ne0[r] = WSP(int, WS_TOKE)[row_ * 2]; ne1[r] = WSP(int, WS_TOKE)[row_ * 2 + 1]; np0[r] = WSP(int, WS_TOKP)[row_ * 2]; np1[r] = WSP(int, WS_TOKP)[row_ * 2 + 1]; \
        ng0[r] = WSP(float, WS_TOKG)[row_ * 2]; ng1[r] = WSP(float, WS_TOKG)[row_ * 2 + 1]; } } while (0)
    if (gw * 4 < NTOK) S10_TAB(gw * 4);
    for (int row0 = gw * 4; row0 < NTOK; row0 += NGW * 4) {
        const int b = row0 >> 12;
        size_t r0[4], r1[4]; float g0[4], g1[4];
#pragma unroll
        for (int r = 0; r < 4; ++r) { r0[r] = (size_t)tstart[ne0[r]] * 256 + np0[r]; r1[r] = (size_t)tstart[ne1[r]] * 256 + np1[r]; g0[r] = ng0[r]; g1[r] = ng1[r]; }
        if (row0 + NGW * 4 < NTOK) S10_TAB(row0 + NGW * 4);
        f32x4 yv[4][4]; float ss[4];
        u32x4 xw[4][2];
#pragma unroll
        for (int r = 0; r < 4; ++r) { float a2 = 0.f;
            u32x4 wa[2], wc[2];
#pragma unroll
            for (int jp = 0; jp < 2; ++jp) { const int ko = 4 * (lane & ~1) + 256 * (2 * jp + (lane & 1));
                wa[jp] = __builtin_nontemporal_load((const u32x4*)(YB + r0[r] * DM + ko)); wc[jp] = __builtin_nontemporal_load((const u32x4*)(YB + r1[r] * DM + ko));
                xw[r][jp] = __builtin_nontemporal_load((const u32x4*)(X1B + (size_t)(row0 + r) * DM + ko)); }
#pragma unroll
            for (int jp = 0; jp < 2; ++jp) { u32x2 a[2], c[2]; pair_narrow(wa[jp], lane, a[0], a[1]); pair_narrow(wc[jp], lane, c[0], c[1]);
#pragma unroll
                for (int e = 0; e < 2; ++e) { const int j = 2 * jp + e;
                    yv[r][j] = (f32x4){bflo(a[e].x), bfhi(a[e].x), bflo(a[e].y), bfhi(a[e].y)} * g0[r] + (f32x4){bflo(c[e].x), bfhi(c[e].x), bflo(c[e].y), bfhi(c[e].y)} * g1[r];
                    a2 += yv[r][j][0] * yv[r][j][0] + yv[r][j][1] * yv[r][j][1] + yv[r][j][2] * yv[r][j][2] + yv[r][j][3] * yv[r][j][3]; } }
            ss[r] = a2; }
#pragma unroll
        for (int o = 1; o < 64; o <<= 1) {
#pragma unroll
            for (int r = 0; r < 4; ++r) ss[r] += __shfl_xor(ss[r], o); }
#pragma unroll
        for (int jp = 0; jp < 2; ++jp) {
#pragma unroll
            for (int r = 0; r < 4; ++r) { const float rr = rsqrtf(ss[r] * (1.f / DM) + RMS_EPS);
                u32x2 xb[2]; pair_narrow(xw[r][jp], lane, xb[0], xb[1]);
#pragma unroll
                for (int e = 0; e < 2; ++e) { const int j = 2 * jp + e, k = 4 * lane + 256 * j;
                    const f32x4 wp = *(const f32x4*)(wpost + k), gf = *(const f32x4*)(mod + b * 6144 + 5120 + k); const f32x4 gw2 = gf * wp;
                    const f32x4 x1 = (f32x4){bflo(xb[e].x), bfhi(xb[e].x), bflo(xb[e].y), bfhi(xb[e].y)};
                    __builtin_nontemporal_store(x1 + gw2 * (yv[r][j] * rr), (f32x4*)(F.out + (size_t)(row0 + r) * DM + k)); } } }
    }
}

#undef S10_TAB
#ifndef DBG_STOP
#define DBG_STOP -1
#endif
#if DBG_STOP >= 0
struct DbgBuf { size_t off, n; int f32, ph; };
__device__ __forceinline__ void dbg_phase(Frame& F, const XcdBarrier& bar) {
    const DbgBuf bufs[] = {
        {WS_MOD, 8 * 6144, 1, 0}, {WS_COS, (size_t)NTOK * 32, 1, 0}, {WS_SIN, (size_t)NTOK * 32, 1, 0}, {WS_WINT, (size_t)INWP * 1024, 0, 0}, {WS_WOUTT, 1024 * 1024, 0, 0},
        {WS_CW1K, 128 * 2048, 0, 0}, {WS_CW2K, 64 * 128, 0, 0}, {WS_RWT, 48 * 1024, 0, 0}, {WS_C1B, 256, 1, 0},
        {WS_H1, (size_t)NTOK * 1024, 0, 1},
        {WS_MQ, (size_t)NTOK * 2048, 0, 2}, {WS_NQ, (size_t)NTOK * 512, 0, 2}, {WS_KC, (size_t)NTOK * 128 * 6, 0, 2}, {WS_GI, 2 * 8 * 4 * 4096, 1, 2}, {WS_NGT, (size_t)NTOK * 24, 1, 2},
        {WS_KVC, (size_t)2048 * 16384, 0, 3}, {WS_NC, 2048 * 128, 1, 3}, {WS_GSUM, 4096, 1, 3}, {WS_KCMP, 2 * 16 * 256 * 64, 0, 3},
        {WS_CPREV, (size_t)2048 * 16384, 0, 4}, {WS_NPREV, 2048 * 128, 1, 4}, {WS_MPREV, 2048, 1, 4},
        {WS_YCAT, (size_t)NTOK * 1024, 0, 5}, {WS_W13T, (size_t)32 * 1024 * 1024, 0, 5}, {WS_W2T, (size_t)32 * 1024 * 512, 0, 5},
        {WS_Y, (size_t)NTOK * 1024, 0, 6}, {WS_H2, (size_t)NTOK * 1024, 0, 7}, {WS_TOKG, (size_t)NTOK * 2, 1, 7},
        {WS_HB, (size_t)65536 * 512, 0, 8}, {WS_YB, (size_t)65536 * 1024, 0, 9} };
    constexpr int NBUF = sizeof(bufs) / sizeof(bufs[0]);
    unsigned* flag = (unsigned*)(F.ws + WS_CTL) + CW_DBG;
    const size_t gt = (size_t)blockIdx.x * NTHR + F.tid, NG = (size_t)F.G * NTHR;
    for (int i = 0; i < NBUF; ++i) {
        if (bufs[i].ph > DBG_STOP) continue;
        if ((bufs[i].off == WS_H1 && DBG_STOP >= 3) || (bufs[i].off == WS_WINT && DBG_STOP >= 4) || (bufs[i].off == WS_KVC && DBG_STOP >= 5) || (bufs[i].off == WS_NQ && DBG_STOP >= 5) || (bufs[i].off == WS_KC && DBG_STOP >= 9) ||
            (bufs[i].off == WS_MQ && DBG_STOP >= 6) || (bufs[i].off == WS_CPREV && DBG_STOP >= 8) || (bufs[i].off == WS_Y && DBG_STOP >= 9) || (bufs[i].off == WS_H2 && DBG_STOP >= 9) || (bufs[i].off == WS_W13T && DBG_STOP < 5)) continue;
        bool bad = false;
        if (bufs[i].f32) { const unsigned* p = (const unsigned*)(F.ws + bufs[i].off); for (size_t k = gt; k < bufs[i].n; k += NG) bad |= ((p[k] & 0x7f800000u) == 0x7f800000u); }
        else { const unsigned* p = (const unsigned*)(F.ws + bufs[i].off); for (size_t k = gt; k < bufs[i].n / 2; k += NG) { const unsigned v = p[k]; bad |= ((v & 0x7f80u) == 0x7f80u) || ((v & 0x7f800000u) == 0x7f800000u); } }
        if (bufs[i].off == WS_YCAT) { bool bm = false, bn = false; const unsigned* p = (const unsigned*)(F.ws + WS_YCAT);
            for (size_t k = gt; k < bufs[i].n / 2; k += NG) { const unsigned v = p[k]; const bool b2 = ((v & 0x7f80u) == 0x7f80u) || ((v & 0x7f800000u) == 0x7f800000u); if ((k & 511) < 256) bm |= b2; else bn |= b2; }
            if (__any(bm) && F.lane == 0) atomicMin(flag, 23u); if (__any(bn) && F.lane == 0) atomicMin(flag, 33u); continue; }
        if (__any(bad) && F.lane == 0) atomicMin(flag, (unsigned)(i + 1));
    }
    if (DBG_STOP >= 7) { bool bad = false; const unsigned* p = (const unsigned*)F.out; for (size_t k = gt; k < (size_t)NTOK * DM; k += NG) bad |= ((p[k] & 0x7f800000u) == 0x7f800000u); if (__any(bad) && F.lane == 0) atomicMin(flag, 40u); }
    xcd_barrier(bar);
    const unsigned id = __hip_atomic_load(flag, __ATOMIC_RELAXED, __HIP_MEMORY_SCOPE_AGENT);
    const float sc = (id >= 1000u) ? 1.f : 1.f + (float)id;
    const float* x = IN_F(0);
    for (size_t k = gt; k < (size_t)NTOK * DM; k += NG) F.out[k] = x[k] * sc;
}
#endif


#if DBG_STOP >= 0
__device__ __forceinline__ unsigned dbg_hash(unsigned x) { x ^= x >> 16; x *= 0x7feb352du; x ^= x >> 15; x *= 0x846ca68bu; x ^= x >> 16; return x; }
__device__ __forceinline__ float dbg_bfr(float f) { return bf2f(f2bf(f)); }
__device__ float dbg_z(Frame& F, int row, int c) { const signed char* h = (const signed char*)(F.ws + WS_H1) + (size_t)row * 1024; const float* w = IN_F(9); float am = 0.f;
    for (int k = 0; k < 1024; ++k) am = fmaxf(am, fabsf(w[(size_t)k * INW + c]));
    const float inv = am > 0.f ? 127.f / am : 0.f; float s = 0.f; for (int k = 0; k < 1024; ++k) s += (float)h[k] * rintf(w[(size_t)k * INW + c] * inv);
    return s * WSP(float, WS_SA1)[row] * (am * (1.f / 127.f)); }
__device__ __forceinline__ bool dbg_close(float a, float b) { return fabsf(a - b) <= 0.02f * fabsf(b) + 0.02f; }
__device__ void dbg_check_p1(Frame& F, unsigned* cnt) {
    const int gt = blockIdx.x * NTHR + F.tid; if (gt >= 8192) return;
    const int row = dbg_hash(gt * 2 + 1) % NTOK; int c = dbg_hash(gt * 2 + 2) % INW; if (gt < 64) c = 2048 + (gt & 7); if (gt >= 64 && gt < 256) c = 3336 + (gt % 24);
    const int b = row >> 12, sq = row & 4095; const float* COS = WSP(float, WS_COS); const float* SIN = WSP(float, WS_SIN);
    float ref, got;
    if (c < 2048) { ref = dbg_z(F, row, c); got = bf2f(WSP(bf16_t, c < 512 ? WS_MQ : c < 1024 ? WS_MK : c < 1536 ? WS_MV : WS_MO)[(size_t)row * 512 + (c & 511)]); }
    else if (c < 2052) { ref = dbg_z(F, row, c) + IN_F(11)[c - 2048]; got = WSP(float, WS_GI)[(size_t)(b * 4 + c - 2048) * SEQ + sq]; }
    else if (c < 2056) { ref = logsigmoid_f(dbg_z(F, row, c) + IN_F(11)[4 + c - 2052]); got = WSP(float, WS_GF)[(size_t)(b * 4 + c - 2052) * SEQ + sq]; }
    else if (c >= 3336) { ref = sigmoid_f(dbg_z(F, row, c)); got = WSP(float, WS_NGT)[(size_t)row * 24 + c - 3336]; }
    else {
        int base, x; size_t ws_off; bool rope, isq = false;
        if (c < 2568) { base = 2056; x = c - base; rope = true; isq = true; ws_off = WS_NQ; }
        else if (c < 2696) { base = 2568; x = c - base; rope = true; ws_off = WS_KC; }
        else if (c < 2824) { base = 2696; x = c - base; rope = false; ws_off = WS_VC; }
        else if (c < 2952) { base = 2824; x = c - base; rope = true; ws_off = WS_KSL; }
        else if (c < 3080) { base = 2952; x = c - base; rope = false; ws_off = WS_VSL; }
        else if (c < 3208) { base = 3080; x = c - base; rope = true; ws_off = WS_KWN; }
        else { base = 3208; x = c - base; rope = false; ws_off = WS_VWN; }
        const int hd = x >> 6, d = x & 63;
        if (rope) { const float z0 = dbg_z(F, row, c), z1 = dbg_z(F, row, base + hd * 64 + (d ^ 32)); const float cs = COS[(size_t)row * 32 + (d & 31)], sn = SIN[(size_t)row * 32 + (d & 31)];
            ref = d < 32 ? z0 * cs - z1 * sn : z0 * cs + z1 * sn; if (isq) ref *= QSCALE; }
        else ref = dbg_z(F, row, c);
        got = isq ? bf2f(WSP(bf16_t, ws_off)[(size_t)row * 512 + hd * 64 + d]) : bf2f(WSP(bf16_t, ws_off)[((size_t)(b * 2 + hd) * SEQ + sq) * 64 + d]);
    }
    if (!dbg_close(got, ref)) atomicAdd(cnt, 1u);
}
#endif


#if DBG_STOP >= 0
__device__ void dbg_check_nsa(Frame& F, unsigned* cnt) {
    const int lane = F.lane, gw = blockIdx.x * NWAVES + F.wave;
    LAS float* P = (LAS float*)(F.lds + F.wave * 2048);
    const unsigned hsh = dbg_hash(gw * 7 + 3);
    const int b = hsh & 7, hh = (hsh >> 3) & 7, g = hh >> 2;
    int t; { const int cls = gw & 7; const unsigned r = dbg_hash(gw * 13 + 5);
        t = cls == 0 ? (int)(r % 31) : cls == 1 ? 31 + (int)(r % 33) : cls == 2 ? 64 + (int)(r % 960) : cls == 3 ? 1024 + (int)(r % 64) : cls == 4 ? 4032 + (int)(r % 64) : 1024 + (int)(r % 3072); }
    const size_t row = (size_t)b * SEQ + t; const int bg = b * 2 + g, cur = t >> 6;
    const bf16_t* Kc = WSP(bf16_t, WS_KCMP) + (size_t)bg * 256 * 64; const bf16_t* Vc = WSP(bf16_t, WS_VCMP) + (size_t)bg * 256 * 64;
    const int lim = t >= 31 ? (t - 31) >> 4 : -1;
    float imp = 0.f, oc = 0.f;
    for (int hd = 0; hd < 4; ++hd) {
        const bf16_t* q = WSP(bf16_t, WS_NQ) + row * 512 + (4 * g + hd) * 64;
        float sc[4]; float mx = -INFINITY;
        for (int k = 0; k < 4; ++k) { const int i = lane + 64 * k; float s = 0.f; for (int d = 0; d < 64; ++d) s += bf2f(q[d]) * bf2f(Kc[(size_t)i * 64 + d]); sc[k] = (i <= lim) ? s : -INFINITY; mx = fmaxf(mx, sc[k]); }
        mx = wave_max(mx); const float mref = (mx == -INFINITY) ? 0.f : mx; float l = 0.f;
        for (int k = 0; k < 4; ++k) { sc[k] = ex2(sc[k] - mref); l += sc[k]; }
        l = wave_sum(l); const float il = 1.f / fmaxf(l, 1e-30f);
        for (int k = 0; k < 4; ++k) P[lane + 64 * k] = sc[k] * il;
        asm volatile("s_waitcnt lgkmcnt(0)" ::: "memory");
        { const int j = lane; float a = 0.f; for (int x = 0; x < 3; ++x) a += 2.f * P[4 * j + x]; a += P[4 * j + 3]; if (j > 0) a += P[4 * j - 1]; imp += a; }
        if (4 * g + hd == hh) { for (int i = 0; i < 255; ++i) oc += P[i] * bf2f(Vc[(size_t)i * 64 + lane]); }
        asm volatile("s_waitcnt lgkmcnt(0)" ::: "memory");
    }
    float score = imp; { const int j = lane; if (j == 0 || j == cur || j == cur - 1) score = INFINITY; else if (64 * j > t) score = -INFINITY; }
    int rank = 0; for (int j2 = 0; j2 < 64; ++j2) { const float s2 = __shfl(score, j2); rank += (s2 > score || (s2 == score && j2 < lane)) ? 1 : 0; }
    const unsigned long long selm = __ballot(rank < 16);
    const bf16_t* q = WSP(bf16_t, WS_NQ) + row * 512 + hh * 64;
    float os = 0.f, ow = 0.f;
    for (int br = 0; br < 2; ++br) {
        const bf16_t* K = WSP(bf16_t, br ? WS_KWN : WS_KSL) + (size_t)bg * SEQ * 64; const bf16_t* V = WSP(bf16_t, br ? WS_VWN : WS_VSL) + (size_t)bg * SEQ * 64;
        float m = -INFINITY, l = 0.f, o = 0.f;
        for (int j = 0; j < 64; ++j) {
            if (br == 0 && !((selm >> j) & 1ull)) continue;
            const int kp = 64 * j + lane; bool valid = kp <= t; if (br == 1) valid = valid && kp > t - 512;
            if (!__any(valid)) continue;
            float s = 0.f; for (int d = 0; d < 64; ++d) s += bf2f(q[d]) * bf2f(K[(size_t)kp * 64 + d]);
            s = valid ? s : -INFINITY;
            const float mn = fmaxf(m, wave_max(s)); const float alpha = (m == -INFINITY) ? 0.f : ex2(m - mn); const float pp = ex2(s - mn);
            l = l * alpha + wave_sum(pp); o *= alpha;
            for (int x = 0; x < 64; ++x) o += __shfl(pp, x) * bf2f(V[(size_t)(64 * j + x) * 64 + lane]);
            m = mn;
        }
        const float r = o / fmaxf(l, 1e-30f); if (br) ow = r; else os = r;
    }
    const float* gp = WSP(float, WS_NGT) + row * 24 + hh * 3;
    const float ref = gp[0] * oc + gp[1] * os + gp[2] * ow;
    const float got = bf2f(WSP(bf16_t, WS_YCAT)[row * 1024 + 512 + hh * 64 + lane]);
    const float sq = wave_sum(ref * ref); const float tol = 0.03f * fabsf(ref) + 0.03f * sqrtf(sq * (1.f / 64.f)) + 1e-4f;
    const bool bad = !(fabsf(got - ref) <= tol);
    if (__any(bad) && lane == 0) atomicAdd(cnt, 1u);
}
#endif


#if DBG_STOP >= 0
__device__ void dbg_check_mlstm(Frame& F, unsigned* cnt) {
    const int lane = F.lane, gw = blockIdx.x * NWAVES + F.wave;
    const unsigned hsh = dbg_hash(gw * 11 + 1);
    const int b = hsh & 7, h = (hsh >> 3) & 3;
    int t; { const int cls = gw & 7; const unsigned r = dbg_hash(gw * 17 + 9);
        t = cls == 0 ? (int)(r % 4) : cls == 1 ? 60 + (int)(r % 8) : cls == 2 ? 64 * (1 + (int)(r % 60)) + (int)((r >> 8) % 3) : cls == 3 ? 64 * (1 + (int)(r % 60)) + 63 : cls == 4 ? 4000 + (int)(r % 96) : (int)(r % 4096); }
    const int bh = b * 4 + h; const float* GI = WSP(float, WS_GI) + (size_t)bh * SEQ; const float* GF = WSP(float, WS_GF) + (size_t)bh * SEQ;
    const bf16_t* MQ = WSP(bf16_t, WS_MQ); const bf16_t* MK = WSP(bf16_t, WS_MK); const bf16_t* MV = WSP(bf16_t, WS_MV); const float* cw = IN_F(10);
    float carry = 0.f, M = 0.f, Bt = 0.f;
    for (int s0 = 0; s0 <= t; s0 += 64) { const int s = s0 + lane; float lf = (s <= t) ? GF[s] : 0.f;
        float bs = lf;
        for (int o = 1; o < 64; o <<= 1) { const float x = __shfl_up(bs, o); if (lane >= o) bs += x; }
        bs += carry; const float u = (s <= t) ? GI[s] - bs : -INFINITY; M = fmaxf(M, wave_max(u));
        if (s0 + 63 >= t) Bt = __shfl(bs, t - s0);
        carry = __shfl(bs, 63); }
    float q0 = 0.f, q1 = 0.f;
    for (int j = 0; j < 4; ++j) { const int ss = t - 3 + j; if (ss >= 0) { const bf16_t* rp = MQ + ((size_t)b * SEQ + ss) * 512 + h * 128;
        q0 += bf2f(rp[lane]) * cw[j * 1024 + h * 128 + lane]; q1 += bf2f(rp[64 + lane]) * cw[j * 1024 + h * 128 + 64 + lane]; } }
    q0 = dbg_bfr(silu_f(q0)); q1 = dbg_bfr(silu_f(q1));
    LAS float* QS = (LAS float*)(F.lds + F.wave * 2048); QS[lane] = q0; QS[64 + lane] = q1;
    asm volatile("s_waitcnt lgkmcnt(0)" ::: "memory");
    float n0 = 0.f, n1 = 0.f, den = 0.f; carry = 0.f;
    for (int s0 = 0; s0 <= t; s0 += 64) { const int s = s0 + lane; const bool act = s <= t; float lf = act ? GF[s] : 0.f;
        float bs = lf;
        for (int o = 1; o < 64; o <<= 1) { const float x = __shfl_up(bs, o); if (lane >= o) bs += x; }
        bs += carry; carry = __shfl(bs, 63);
        float c = 0.f;
        if (act) { float qk = 0.f;
            for (int ch = 0; ch < 128; ++ch) { float kc = 0.f;
                for (int j = 0; j < 4; ++j) { const int ss = s - 3 + j; if (ss >= 0) kc += bf2f(MK[((size_t)b * SEQ + ss) * 512 + h * 128 + ch]) * cw[j * 1024 + 512 + h * 128 + ch]; }
                qk += QS[ch] * dbg_bfr(silu_f(kc) * 0.08838834764831845f); }
            c = __expf(GI[s] - bs - M) * qk; }
        den += c;
        for (int x = 0; x < 64; ++x) { const float cx = __shfl(c, x); if (s0 + x <= t) { const bf16_t* vp = MV + ((size_t)b * SEQ + s0 + x) * 512 + h * 128; n0 += cx * bf2f(vp[lane]); n1 += cx * bf2f(vp[64 + lane]); } } }
    den = wave_sum(den);
    const float hd = fmaxf(fabsf(den), __expf(-(Bt + M)));
    const float h0 = n0 / hd, h1 = n1 / hd;
    const float rn = rsqrtf(wave_sum(h0 * h0 + h1 * h1) * (1.f / 128.f) + RMS_EPS);
    const size_t row = (size_t)b * SEQ + t; const bf16_t* mo = WSP(bf16_t, WS_MO) + row * 512 + h * 128; const float* hn = IN_F(12) + h * 128;
    const float r0 = h0 * rn * hn[lane] * sigmoid_f(bf2f(mo[lane])), r1 = h1 * rn * hn[64 + lane] * sigmoid_f(bf2f(mo[64 + lane]));
    const float g0 = bf2f(WSP(bf16_t, WS_YCAT)[row * 1024 + h * 128 + lane]), g1 = bf2f(WSP(bf16_t, WS_YCAT)[row * 1024 + h * 128 + 64 + lane]);
    const float rms = sqrtf(wave_sum(r0 * r0 + r1 * r1) * (1.f / 128.f));
    const bool bad = !(fabsf(g0 - r0) <= 0.04f * fabsf(r0) + 0.04f * rms + 1e-4f) || !(fabsf(g1 - r1) <= 0.04f * fabsf(r1) + 0.04f * rms + 1e-4f);
    if (__any(bad) && lane == 0) atomicAdd(cnt, 1u);
}
#endif


#if DBG_STOP >= 0
__device__ void dbg_check_cmp(Frame& F, unsigned* cnt) {
    const int lane = F.lane, gw = blockIdx.x * NWAVES + F.wave;
    const unsigned hsh = dbg_hash(gw * 5 + 2);
    const int kv = hsh & 1, bg = (hsh >> 1) & 15; int i = (hsh >> 5) % 255; if ((gw & 15) == 0) i = 254; if ((gw & 15) == 1) i = 0;
    const bf16_t* X = WSP(bf16_t, kv ? WS_VC : WS_KC) + (size_t)bg * SEQ * 64 + (size_t)i * 1024;
    const float* pe = IN_F(kv ? 16 : 13); const float* w1 = IN_F(kv ? 17 : 14); const float* w2 = IN_F(kv ? 18 : 15);
    float h0 = 0.f, h1 = 0.f;
    for (int k = 0; k < 2048; ++k) { const float xv = bf2f(X[k]) + pe[k]; h0 += xv * w1[(size_t)k * 128 + lane]; h1 += xv * w1[(size_t)k * 128 + 64 + lane]; }
    LAS float* H = (LAS float*)(F.lds + F.wave * 2048); H[lane] = silu_f(h0); H[64 + lane] = silu_f(h1);
    asm volatile("s_waitcnt lgkmcnt(0)" ::: "memory");
    float o = 0.f; for (int n = 0; n < 128; ++n) o += H[n] * w2[n * 64 + lane];
    const float got = bf2f(WSP(bf16_t, kv ? WS_VCMP : WS_KCMP)[((size_t)bg * 256 + i) * 64 + lane]);
    const float rms = sqrtf(wave_sum(o * o) * (1.f / 64.f));
    const bool bad = !(fabsf(got - o) <= 0.03f * fabsf(o) + 0.03f * rms + 1e-4f);
    if (__any(bad) && lane == 0) atomicAdd(cnt, 1u);
}
#endif

__device__ __forceinline__ bool phase_tid(Frame& F) { asm volatile("" : "+v"(F.tid)); F.lane = F.tid & 63; return true; }
constexpr int NPHASE = 11;
__global__ void __launch_bounds__(NTHR, 2) mega_fwd(Args args) {
    extern __shared__ __attribute__((aligned(16))) unsigned char lds_raw[];
    Frame F;
    F.lds = (LAS unsigned char*)lds_raw; F.in = args.in; F.out = args.out; F.ws = args.ws;
    F.tid = threadIdx.x; F.lane = F.tid & 63; F.wave = __builtin_amdgcn_readfirstlane(F.tid >> 6);
    F.G = gridDim.x; { const int bx = blockIdx.x; F.vcu = (F.G % 8 == 0) ? (bx % 8) * (F.G / 8) + bx / 8 : bx; }
    volatile LAS unsigned* MISC = (volatile LAS unsigned*)(F.lds + MISC_OFF);
    for (int u = F.tid; u < (LDS_BYTES - MISC_OFF) / 4; u += NTHR) ((LAS unsigned*)(F.lds + MISC_OFF))[u] = 0u;
    __syncthreads();
    unsigned* ctl = (unsigned*)(F.ws + WS_CTL);
    XcdBarrier bar; bar.bar = ctl + CW_BAR; bar.x = 0; bar.st = nullptr;
    const int lo = args.ph_lo, hi = args.ph_hi;
    if (hi - lo > 1) bar = xcd_barrier_post(ctl + CW_BAR, MISC + 8);
#ifndef PHASE_MASK
#define PHASE_MASK 0xFFFF
#endif
#define IN(k) (((PHASE_MASK >> (k)) & 1) && lo <= (k) && (k) < hi && (DBG_STOP < 0 || (k) <= DBG_STOP))
#define SEAM(k) do { if (IN(k) && IN((k) + 1)) xcd_barrier(bar); } while (0)
    LAS int* TST = (LAS int*)(F.lds + MISC_OFF + 256);
    LAS int* CNT = TST + 40;

#define PHASE_TID() if (phase_tid(F))
    if (IN(0)) PHASE_TID() _Pragma("nounroll") for (int rep = 0; rep <= ((REP_MASK >> 0) & 1); ++rep) { p0_phase(F); } SEAM(0);
    if (IN(1)) PHASE_TID() _Pragma("nounroll") for (int rep = 0; rep <= ((REP_MASK >> 1) & 1); ++rep) { p1a_phase(F); } SEAM(1);
    if (IN(2)) PHASE_TID() _Pragma("nounroll") for (int rep = 0; rep <= ((REP_MASK >> 2) & 1); ++rep) {
        pg8::DenseOrder S; S.init(NTOK, INWP, DM / 2, F.G, (int)blockIdx.x);
        EpiIn E{F.ws, IN_F(11), F.lds};
        pg8::gemm_phase<true>(F.lds, WSP(bf16_t, WS_H1), WSP(bf16_t, WS_WINT), DM / 2, S, E);
    } SEAM(2);
    if (IN(3)) PHASE_TID() _Pragma("nounroll") for (int rep = 0; rep <= ((REP_MASK >> 3) & 1); ++rep) {
        REPS(0) mlstm_a_phase(F);
        REPS(1) for (int j = F.vcu; j < 256; j += F.G) compress_job(F, j);
    } SEAM(3);
    if (IN(4)) PHASE_TID() _Pragma("nounroll") for (int rep = 0; rep <= ((REP_MASK >> 4) & 1); ++rep) {
        REPS(2) for (int j = F.vcu; j < 256; j += F.G) mlstm_scan_job(F, j);
        REPS(3) for (int u = F.vcu; u < 512; u += F.G) {
            const int bg = u >> 5, q = u & 31;
            _Pragma("nounroll") for (int hf = 0; hf < 2; ++hf) nsa_unit(F, bg >> 1, bg & 1, hf ? q : 63 - q);
        }
    } SEAM(4);
    if (IN(5)) PHASE_TID() _Pragma("nounroll") for (int rep = 0; rep <= ((REP_MASK >> 5) & 1); ++rep) {
        REPS(4) mlstm_c_phase(F);
        REPS(5) expert_convert(F);
    } SEAM(5);
    if (IN(6)) PHASE_TID() _Pragma("nounroll") for (int rep = 0; rep <= ((REP_MASK >> 6) & 1); ++rep) {
        pg8::DenseOrder S; S.init(NTOK, DM, DM, F.G, (int)blockIdx.x);
        EpiBf16 E{WSP(bf16_t, WS_Y), DM};
        pg8::gemm_phase<false>(F.lds, WSP(bf16_t, WS_YCAT), WSP(bf16_t, WS_WOUTT), DM, S, E);
    } SEAM(6);
    if (IN(7)) PHASE_TID() { s6_phase(F); } SEAM(7);
    if (IN(8)) PHASE_TID() _Pragma("nounroll") for (int rep = 0; rep <= ((REP_MASK >> 8) & 1); ++rep) {
        moe_tables(F, TST, CNT);
        pg8::MoeOrder S{TST, CNT, WSP(int, WS_LIST), F.G, F.vcu, DM / 2, 4, true};
        EpiUpI8 E{WSP(bf16_t, WS_HB), WSP(float, WS_SAL), WSP(float, WS_SB13), TST, F.lds};
        pg8::gemm_phase<true>(F.lds, WSP(bf16_t, WS_H2Q), WSP(bf16_t, WS_W13T), DM / 2, S, E);
        {
            const int U = TST[32] * 4, full = U / F.G, rem = U % F.G;
            if (rem == 0) w2_convert(F, F.vcu, F.G); else if (F.vcu >= rem) w2_convert(F, F.vcu - rem, F.G - rem);
            (void)full; }
    } SEAM(8);
    if (IN(9)) PHASE_TID() _Pragma("nounroll") for (int rep = 0; rep <= ((REP_MASK >> 9) & 1); ++rep) {
        moe_tables(F, TST, CNT);
        pg8::MoeOrder S{TST, CNT, WSP(int, WS_LIST), F.G, F.vcu, EFF, 4, false};
        EpiBf16 E{WSP(bf16_t, WS_YB), DM};
        pg8::gemm_phase<false>(F.lds, WSP(bf16_t, WS_HB), WSP(bf16_t, WS_W2T), EFF, S, E);
    } SEAM(9);
    if (IN(10)) PHASE_TID() { moe_tables(F, TST, CNT); s10_phase(F, TST); }
#if DBG_STOP >= 0
    xcd_barrier(bar);
#if DBG_CHECK == 1 || DBG_CHECK == 3 || DBG_CHECK == 4 || DBG_CHECK == 5
    { unsigned* cw = (unsigned*)(F.ws + WS_CTL) + CW_DBG + 1; if (DBG_CHECK == 1) dbg_check_p1(F, cw); else if (DBG_CHECK == 3) dbg_check_nsa(F, cw); else if (DBG_CHECK == 4) dbg_check_mlstm(F, cw); else dbg_check_cmp(F, cw); xcd_barrier(bar);
      const unsigned nb = __hip_atomic_load(cw, __ATOMIC_RELAXED, __HIP_MEMORY_SCOPE_AGENT);
      const float sc = nb == 0 ? 1.f : nb < 4 ? 2.f : nb < 16 ? 3.f : nb < 64 ? 4.f : nb < 256 ? 5.f : nb < 1024 ? 6.f : 7.f;
      const float* x = IN_F(0); for (size_t k = (size_t)blockIdx.x * NTHR + F.tid; k < (size_t)NTOK * DM; k += (size_t)F.G * NTHR) F.out[k] = x[k] * sc; }
#elif DBG_CHECK == 2
    { const unsigned id = __hip_atomic_load((unsigned*)(F.ws + WS_CTL) + CW_DBG, __ATOMIC_RELAXED, __HIP_MEMORY_SCOPE_AGENT);
      float sc = (id >= 1000u) ? 1.f : 1.f + (float)id;
      if (__hip_atomic_load((unsigned*)(F.ws + WS_CTL) + CW_BAR + XB_TMO, __ATOMIC_RELAXED, __HIP_MEMORY_SCOPE_AGENT) != 0u) sc = 61.f;
      const float* x = IN_F(0); for (size_t k = (size_t)blockIdx.x * NTHR + F.tid; k < (size_t)NTOK * DM; k += (size_t)F.G * NTHR) F.out[k] = x[k] * sc; }
#else
    dbg_phase(F, bar);
#endif
#endif
#undef IN
#undef SEAM
}

extern "C" void kernel_launch(void* const* d_in, const int* in_sizes, int n_in, void* d_out, int out_size, void* d_ws, size_t ws_size, hipStream_t stream) {
    static int grid = 0;
    if (grid == 0) {
        int dev = 0, cus = 0;
        if (hipGetDevice(&dev) != hipSuccess || hipDeviceGetAttribute(&cus, hipDeviceAttributeMultiprocessorCount, dev) != hipSuccess) cus = 256;
        if (hipFuncSetAttribute((const void*)mega_fwd, hipFuncAttributeMaxDynamicSharedMemorySize, LDS_BYTES) != hipSuccess) fprintf(stderr, "kernel_launch: hipFuncSetAttribute failed\n");
        (void)hipGetLastError();
        grid = cus > 0 ? cus : 256;
        if (n_in != 27 || ws_size < WS_END) fprintf(stderr, "kernel_launch: unexpected n_in %d / ws_size %zu (need %zu)\n", n_in, ws_size, (size_t)WS_END);
    }
    (void)hipMemsetAsync((char*)d_ws + WS_CTL, 0, 64 * 1024, stream);
#if DBG_STOP >= 0
    (void)hipMemsetAsync((char*)d_ws + WS_CTL + CW_DBG * 4, 0x7F, 4, stream);
#endif
    Args a{};
    for (int i = 0; i < 27; ++i) a.in[i] = d_in[i];
    a.out = (float*)d_out; a.ws = (unsigned char*)d_ws;
#if MK_N_LAUNCHES == 1
    a.ph_lo = 0; a.ph_hi = NPHASE;
    hipLaunchKernelGGL(mega_fwd, dim3(grid), dim3(NTHR), LDS_BYTES, stream, a);
#else
    for (int p = 0; p < NPHASE; ++p) { a.ph_lo = p; a.ph_hi = p + 1; hipLaunchKernelGGL(mega_fwd, dim3(grid), dim3(NTHR), LDS_BYTES, stream, a); }
#endif
}
```

```cpp
#include <hip/hip_runtime.h>
#include <cstdio>
#include <cstdint>
#include <type_traits>

#define LAS __attribute__((address_space(3)))
typedef unsigned short bf16_t;
typedef short bf16x8 __attribute__((ext_vector_type(8)));
typedef short s16x4 __attribute__((ext_vector_type(4)));
typedef float f32x4 __attribute__((ext_vector_type(4)));
typedef float f32x16 __attribute__((ext_vector_type(16)));
typedef unsigned u32x4 __attribute__((ext_vector_type(4)));
typedef unsigned u32x2 __attribute__((ext_vector_type(2)));
typedef int i32x4 __attribute__((ext_vector_type(4)));
typedef _Float16 f16x8 __attribute__((ext_vector_type(8)));
typedef _Float16 f16x4 __attribute__((ext_vector_type(4)));

#ifndef MK_N_LAUNCHES
#define MK_N_LAUNCHES 1
#endif
#ifndef DBG_CHECK
#define DBG_CHECK 0
#endif
#ifndef REP_MASK
#define REP_MASK 0
#endif
#ifndef REP_SUB
#define REP_SUB 0
#endif
#ifndef NSA_DUP
#define NSA_DUP 0
#endif
#define NDUP(b) _Pragma("nounroll") for (int nd_ = 0; nd_ <= ((NSA_DUP >> (b)) & 1); ++nd_)
#define REPS(b) _Pragma("nounroll") for (int rs_ = 0; rs_ <= ((REP_SUB >> (b)) & 1); ++rs_)

constexpr int NB = 8, SEQ = 4096, DM = 1024, NTOK = NB * SEQ;
constexpr int MH = 4, MDH = 128;
constexpr int NHD = 8, NGRP = 2;
constexpr int INW = 3360, INWP = 3584;
constexpr int NEXP = 32, EFF = 512;
constexpr float RMS_EPS = 1e-6f;
constexpr float QSCALE = 0.125f * 1.4426950408889634f;
constexpr int NWAVES = 8, NTHR = 512;
constexpr int LDS_BYTES = 160 * 1024, MISC_OFF = 128 * 1024;
constexpr int MAXROWS = 73728;

constexpr size_t MiB = 1ull << 20, KiB = 1024;
constexpr size_t WS_CTL   = 0;
constexpr size_t WS_MOD   = 64 * KiB;
constexpr size_t WS_C1B   = WS_MOD + 192 * KiB;
constexpr size_t WS_GI    = WS_C1B + 4 * KiB;
constexpr size_t WS_GF    = WS_GI + 512 * KiB;
constexpr size_t WS_NGT   = WS_GF + 512 * KiB;
constexpr size_t WS_GSUM  = WS_NGT + 3 * MiB;
constexpr size_t WS_MLOC  = WS_GSUM + 8 * KiB;
constexpr size_t WS_MPREV = WS_MLOC + 8 * KiB;
constexpr size_t WS_NC    = WS_MPREV + 8 * KiB;
constexpr size_t WS_NPREV = WS_NC + 1 * MiB;
constexpr size_t WS_COS   = WS_NPREV + 1 * MiB;
constexpr size_t WS_SIN   = WS_COS + 4 * MiB;
constexpr size_t WS_WOUTT = WS_SIN + 4 * MiB;
constexpr size_t WS_CW1K  = WS_WOUTT + 2 * MiB;
constexpr size_t WS_CW1V  = WS_CW1K + 512 * KiB;
constexpr size_t WS_CW2K  = WS_CW1V + 512 * KiB;
constexpr size_t WS_CW2V  = WS_CW2K + 16 * KiB;
constexpr size_t WS_RWT   = WS_CW2V + 16 * KiB;
constexpr size_t WS_RWL   = WS_RWT + 96 * KiB;
constexpr size_t WS_KCMP  = WS_RWL + 96 * KiB;
constexpr size_t WS_VCMP  = WS_KCMP + 512 * KiB;
constexpr size_t WS_TOKE  = WS_VCMP + 512 * KiB;
constexpr size_t WS_TOKP  = WS_TOKE + 256 * KiB;
constexpr size_t WS_TOKG  = WS_TOKP + 256 * KiB;
constexpr size_t WS_LIST  = WS_TOKG + 256 * KiB;
constexpr size_t WS_SA    = WS_LIST + 8 * MiB;
constexpr size_t WS_SB13  = WS_SA + 128 * KiB;
constexpr size_t WS_SA1   = WS_SB13 + 128 * KiB;
constexpr size_t WS_SBW   = WS_SA1 + 128 * KiB;
constexpr size_t WS_SMALL_END = WS_SBW + 16 * KiB;
static_assert(WS_SMALL_END <= 32 * MiB, "small region overflow");
constexpr size_t WS_A     = 32 * MiB;
constexpr size_t WS_H1    = WS_A, WS_KVC = WS_A, WS_W13T = WS_A;
constexpr size_t WS_NQ    = 96 * MiB;
constexpr size_t WS_KC    = 128 * MiB, WS_VC = 136 * MiB, WS_KSL = 144 * MiB, WS_VSL = 152 * MiB, WS_KWN = 160 * MiB, WS_VWN = 168 * MiB;
constexpr size_t WS_W2T   = 96 * MiB;
constexpr size_t WS_MQ    = 176 * MiB, WS_MK = 208 * MiB, WS_MV = 240 * MiB, WS_MO = 272 * MiB;
constexpr size_t WS_Y     = 176 * MiB;
constexpr size_t WS_H2    = 240 * MiB;
constexpr size_t WS_CPREV = 304 * MiB;
constexpr size_t WS_WINT  = 304 * MiB;
constexpr size_t WS_HB    = 304 * MiB;
constexpr size_t WS_H2LO  = 304 * MiB;
constexpr size_t WS_YCAT  = 376 * MiB;
constexpr size_t WS_X1B   = 376 * MiB;
constexpr size_t WS_YB    = 128 * MiB;
constexpr size_t WS_H2Q   = 128 * MiB;
constexpr size_t WS_SAL   = 440 * MiB;
constexpr size_t WS_END   = 448 * MiB;

constexpr int CW_BAR = 0;
constexpr int CW_CNT = 4096;
constexpr int CW_DBG = 4200;

typedef __bf16 bf16x2_t __attribute__((ext_vector_type(2)));
typedef float f32x2_t __attribute__((ext_vector_type(2)));
__device__ __forceinline__ unsigned cvtpk(float lo, float hi) { const f32x2_t f = {lo, hi}; const bf16x2_t v = __builtin_convertvector(f, bf16x2_t); return __builtin_bit_cast(unsigned, v); }
__device__ __forceinline__ float bf2f(bf16_t b) { return __uint_as_float(((unsigned)b) << 16); }
__device__ __forceinline__ float bflo(unsigned w) { return __uint_as_float(w << 16); }
__device__ __forceinline__ float bfhi(unsigned w) { return __uint_as_float(w & 0xffff0000u); }
__device__ __forceinline__ bf16_t f2bf(float f) { return (bf16_t)(cvtpk(f, 0.f) & 0xffffu); }
__device__ __forceinline__ float wave_sum(float v) {
#pragma unroll
    for (int o = 1; o < 64; o <<= 1) v += __shfl_xor(v, o);
    return v;
}
__device__ __forceinline__ float wave_max(float v) {
#pragma unroll
    for (int o = 1; o < 64; o <<= 1) v = fmaxf(v, __shfl_xor(v, o));
    return v;
}
__device__ __forceinline__ float sigmoid_f(float x) { return __builtin_amdgcn_rcpf(1.f + __builtin_amdgcn_exp2f(-1.4426950408889634f * x)); }
__device__ __forceinline__ float silu_f(float x) { return x * __builtin_amdgcn_rcpf(1.f + __builtin_amdgcn_exp2f(-1.4426950408889634f * x)); }
__device__ __forceinline__ float logsigmoid_f(float x) { return fminf(x, 0.f) - log1pf(__expf(-fabsf(x))); }
__device__ __forceinline__ float ex2(float x) { return __builtin_amdgcn_exp2f(x); }
#define MFMA32(a, b, c) __builtin_amdgcn_mfma_f32_32x32x16_bf16(a, b, c, 0, 0, 0)
#define MFMA16(a, b, c) __builtin_amdgcn_mfma_f32_16x16x32_bf16(a, b, c, 0, 0, 0)
typedef short v4i16_t __attribute__((ext_vector_type(4)));
__device__ __forceinline__ s16x4 vtr(LAS const unsigned char* p) { return __builtin_bit_cast(s16x4, __builtin_amdgcn_ds_read_tr16_b64_v4i16((LAS v4i16_t*)p)); }
__device__ __forceinline__ int crow(int r, int hi) { return (r & 3) + 8 * (r >> 2) + 4 * hi; }
__device__ __forceinline__ u32x4 widen_pair(u32x2 A, u32x2 B) {
    const auto r0 = __builtin_amdgcn_permlane32_swap(A.x, B.x, false, false); const auto r1 = __builtin_amdgcn_permlane32_swap(A.y, B.y, false, false);
    return (u32x4){r0[0], r1[0], r0[1], r1[1]}; }
__device__ __forceinline__ u32x4 widen_rows16(u32x2 X, u32x2 Y) {
    const auto r0 = __builtin_amdgcn_permlane16_swap(X.x, Y.x, false, false); const auto r1 = __builtin_amdgcn_permlane16_swap(X.y, Y.y, false, false);
    return (u32x4){r0[0], r1[0], r0[1], r1[1]}; }
__device__ __forceinline__ u32x4 quad_transpose(u32x4 d, int lane) {
    const bool b0 = lane & 1, b1 = lane & 2;
    { const unsigned t0 = b0 ? d.x : d.y, t1 = b0 ? d.z : d.w;
      const unsigned r0 = (unsigned)__builtin_amdgcn_mov_dpp((int)t0, 0xB1, 0xF, 0xF, true), r1 = (unsigned)__builtin_amdgcn_mov_dpp((int)t1, 0xB1, 0xF, 0xF, true);
      if (b0) { d.x = r0; d.z = r1; } else { d.y = r0; d.w = r1; } }
    { const unsigned t0 = b1 ? d.x : d.z, t1 = b1 ? d.y : d.w;
      const unsigned r0 = (unsigned)__builtin_amdgcn_mov_dpp((int)t0, 0x4E, 0xF, 0xF, true), r1 = (unsigned)__builtin_amdgcn_mov_dpp((int)t1, 0x4E, 0xF, 0xF, true);
      if (b1) { d.x = r0; d.y = r1; } else { d.z = r0; d.w = r1; } }
    return d; }
__device__ __forceinline__ u32x4 pair_widen(u32x2 A, u32x2 B, int lane) {
    const bool od = lane & 1; const u32x2 t = od ? A : B;
    u32x2 r; r.x = (unsigned)__builtin_amdgcn_mov_dpp((int)t.x, 0xB1, 0xF, 0xF, true); r.y = (unsigned)__builtin_amdgcn_mov_dpp((int)t.y, 0xB1, 0xF, 0xF, true);
    return od ? (u32x4){r.x, r.y, B.x, B.y} : (u32x4){A.x, A.y, r.x, r.y}; }
__device__ __forceinline__ void pair_narrow(u32x4 v, int lane, u32x2& A, u32x2& B) {
    const bool od = lane & 1; const u32x2 lo = {v.x, v.y}, hi = {v.z, v.w}; const u32x2 t = od ? lo : hi;
    u32x2 r; r.x = (unsigned)__builtin_amdgcn_mov_dpp((int)t.x, 0xB1, 0xF, 0xF, true); r.y = (unsigned)__builtin_amdgcn_mov_dpp((int)t.y, 0xB1, 0xF, 0xF, true);
    A = od ? r : lo; B = od ? hi : r; }
__device__ __forceinline__ bf16x8 mk8(s16x4 lo, s16x4 hi) { return (bf16x8){lo[0], lo[1], lo[2], lo[3], hi[0], hi[1], hi[2], hi[3]}; }

#define XB_TMO      128
#define XB_XCNT(j)  (256  + 64 * (j))
#define XB_XSUB(j)  (1280 + 64 * (j))
#define XB_XGEN(j)  (2304 + 64 * (j))
#define XB_TOP      3328
#define XB_TOPGEN   3392
#define XCD_BAR_WORDS 3456
#define XB_SPIN_CAP (1u << 18)
__device__ __forceinline__ unsigned xb_ld(unsigned* p)              { return __hip_atomic_load(p, __ATOMIC_RELAXED, __HIP_MEMORY_SCOPE_AGENT); }
__device__ __forceinline__ unsigned xb_add(unsigned* p, unsigned v) { return __hip_atomic_fetch_add(p, v, __ATOMIC_RELAXED, __HIP_MEMORY_SCOPE_AGENT); }
__device__ __forceinline__ unsigned xb_xcc_id() { return (unsigned)__builtin_amdgcn_s_getreg((3 << 11) | 20) & 0xFu; }
#define XB_SPIN(cond, bar) do { unsigned _sp = 0; while (cond) { __builtin_amdgcn_s_sleep(1); \
    if ((++_sp & 255u) == 0u) { if (xb_ld(&(bar)[XB_TMO])) break; if (_sp > XB_SPIN_CAP) { atomicAdd(&(bar)[XB_TMO], 1u); break; } } } } while (0)
struct XcdBarrier { unsigned* bar; unsigned x; volatile LAS unsigned* st; };
__device__ __forceinline__ XcdBarrier xcd_barrier_post(unsigned* bar, volatile LAS unsigned* st) {
    XcdBarrier b; b.bar = bar; b.x = xb_xcc_id(); b.st = st;
    if (threadIdx.x == 0) (void)xb_add(&bar[XB_XCNT(b.x)], 1u);
    return b;
}
__device__ __forceinline__ void xcd_barrier_complete(unsigned* bar, unsigned x, unsigned& nloc, unsigned& nx) {
    const unsigned G = gridDim.x * gridDim.y * gridDim.z;
    unsigned sum, cnt, mine, sp = 0u;
    for (;;) {
        sum = 0u; cnt = 0u; mine = 0u;
#pragma unroll
        for (unsigned j = 0; j < 16; ++j) { const unsigned c = xb_ld(&bar[XB_XCNT(j)]); sum += c; cnt += (c > 0u) ? 1u : 0u; mine = (j == x) ? c : mine; }
        if (sum == G) break;
        __builtin_amdgcn_s_sleep(1);
        if ((++sp & 255u) == 0u) { if (xb_ld(&bar[XB_TMO])) break; if (sp > XB_SPIN_CAP) { atomicAdd(&bar[XB_TMO], 1u); break; } }
    }
    nloc = mine > 0u ? mine : 1u; nx = cnt > 0u ? cnt : 1u;
}
__device__ __forceinline__ void xcd_barrier(const XcdBarrier& b) {
    asm volatile("s_waitcnt vmcnt(0)" ::: "memory");
    __syncthreads();
    if (threadIdx.x == 0) {
        unsigned* bar = b.bar;
        __builtin_amdgcn_s_waitcnt(0);
        unsigned nloc = b.st[0], nx = b.st[1];
        if (nloc == 0u) { xcd_barrier_complete(bar, b.x, nloc, nx); b.st[0] = nloc; b.st[1] = nx; }
        const unsigned old = xb_add(&bar[XB_XSUB(b.x)], 1u);
        const unsigned gen = old / nloc;
        if (old + 1u == (gen + 1u) * nloc) {
            __builtin_amdgcn_fence(__ATOMIC_RELEASE, "agent");
            asm volatile("s_waitcnt vmcnt(0)" ::: "memory");
            const unsigned og = xb_add(&bar[XB_TOP], 1u);
            const unsigned tg = og / nx;
            if (og + 1u == (tg + 1u) * nx) xb_add(&bar[XB_TOPGEN], 1u);
            else XB_SPIN(xb_ld(&bar[XB_TOPGEN]) == tg, bar);
            __builtin_amdgcn_fence(__ATOMIC_ACQUIRE, "agent");
            xb_add(&bar[XB_XGEN(b.x)], 1u);
            asm volatile("s_waitcnt vmcnt(0)" ::: "memory");
        } else {
            XB_SPIN(xb_ld(&bar[XB_XGEN(b.x)]) == gen, bar);
            __builtin_amdgcn_fence(__ATOMIC_ACQUIRE, "agent");
            asm volatile("s_waitcnt vmcnt(0)" ::: "memory");
        }
    }
    __syncthreads();
}

struct Args { const void* in[27]; float* out; unsigned char* ws; int ph_lo, ph_hi; };
struct Frame {
    LAS unsigned char* lds;
    const void* const* in; float* out; unsigned char* ws;
    int tid, lane, wave, vcu, G;
};
#define IN_F(k) ((const float*)F.in[k])
#define WSP(T, off) ((T*)(F.ws + (off)))

namespace pg8 {
constexpr int BM = 256, BK = 64, HALF = 128, HTB = HALF * BK * 2, STAGE_BYTES = 8 * HTB, NXCD = 8, WGM = 8;
__host__ __device__ __forceinline__ int lds_byte(int r, int c) { const int st = (r >> 4) * 2 + (c >> 5), rr = r & 15, cc = c & 31, ob = rr * 64 + cc * 2; return st * 1024 + (ob ^ (((ob >> 9) & 1) << 5)); }
__host__ __device__ __forceinline__ void stage_rc(int b, int& R, int& C) { const int st = b / 1024, sb = b % 1024, swz = sb ^ (((sb >> 9) & 1) << 5); R = (st >> 1) * 16 + swz / 64; C = (st & 1) * 32 + (swz % 64) / 2; }
__host__ __device__ __forceinline__ int perm32(int rho) { const int n = rho >> 4, i = rho & 15; return 8 * (i >> 2) + 4 * n + (i & 3); }
struct Unit { int pm, pn, e, nrow; };

template <bool I8, class Epi, class Sched>
__device__ __forceinline__ void gemm_phase(LAS unsigned char* lds, const void* Abase, const void* Bbase, const int K, const Sched& S, const Epi& E) {
    const int tid = threadIdx.x, wid = __builtin_amdgcn_readfirstlane(tid >> 6), lane = tid & 63, wr = wid >> 2, wc = wid & 3, fr = lane & 15, fq = lane >> 4;
    const int nt = K / BK;
    int Rr[2], Cc[2]; unsigned voffB[2];
#pragma unroll
    for (int i = 0; i < 2; ++i) { int R, C; stage_rc(tid * 16 + i * 8192, R, C); Rr[i] = R; Cc[i] = C; const int Rb = (R & ~31) + perm32(R & 31); voffB[i] = (unsigned)(Rb * K + C) * 2u; }
    const size_t kstep = (size_t)(BK * 2);
    const size_t hstepB = (size_t)HALF * K * 2;
    const unsigned ldsw = (unsigned)wid * 1024u;
    const int aoff = lds_byte(wr * 64 + fr, fq * 8), boff = lds_byte(wc * 32 + fr, fq * 8);
#define PG8_SA(b, h) (((b) * 2 + (h)) * HTB)
#define PG8_SB(b, h) ((4 + (b) * 2 + (h)) * HTB)
#define PG8_STAGEB(bufoff, gbase) do { _Pragma("unroll") for (int _i = 0; _i < 2; ++_i) \
        __builtin_amdgcn_global_load_lds((const unsigned*)((const char*)(gbase) + voffB[_i]), (LAS unsigned*)(lds + (bufoff) + ldsw + _i * 8192), 16, 0, 0); } while (0)
#define PG8_STAGEA(bufoff, o0, o1, ktb) do { const char* _p = (const char*)Abase + (ktb); \
        __builtin_amdgcn_global_load_lds((const unsigned*)(_p + (o0)), (LAS unsigned*)(lds + (bufoff) + ldsw), 16, 0, 0); \
        __builtin_amdgcn_global_load_lds((const unsigned*)(_p + (o1)), (LAS unsigned*)(lds + (bufoff) + ldsw + 8192), 16, 0, 0); } while (0)
#define PG8_LDA(dst, b, h) do { _Pragma("unroll") for (int m = 0; m < 4; ++m) _Pragma("unroll") for (int k = 0; k < 2; ++k) dst[m][k] = *(const LAS bf16x8*)(lds + PG8_SA(b, h) + aoff + m * 2048 + k * 1024); } while (0)
#define PG8_LDB(dst, b, h) do { _Pragma("unroll") for (int n = 0; n < 2; ++n) _Pragma("unroll") for (int k = 0; k < 2; ++k) dst[n][k] = *(const LAS bf16x8*)(lds + PG8_SB(b, h) + boff + n * 2048 + k * 1024); } while (0)
#define PG8_MMA(ai, bj, At, Bt) do { __builtin_amdgcn_s_setprio(1); _Pragma("unroll") for (int m = 0; m < 4; ++m) _Pragma("unroll") for (int n = 0; n < 2; ++n) _Pragma("unroll") for (int k = 0; k < 2; ++k) { \
        if constexpr (I8) acc[ai][bj][m][n] = __builtin_bit_cast(acc_t, __builtin_amdgcn_mfma_i32_16x16x64_i8(__builtin_bit_cast(i32x4, Bt[n][k]), __builtin_bit_cast(i32x4, At[m][k]), __builtin_bit_cast(i32x4, acc[ai][bj][m][n]), 0, 0, 0)); \
        else acc[ai][bj][m][n] = __builtin_bit_cast(acc_t, __builtin_amdgcn_mfma_f32_16x16x32_bf16(Bt[n][k], At[m][k], __builtin_bit_cast(f32x4, acc[ai][bj][m][n]), 0, 0, 0)); } __builtin_amdgcn_s_setprio(0); } while (0)
#define PG8_WAIT_V(n) asm volatile("s_waitcnt vmcnt(" #n ")" ::: "memory")
#define PG8_WAIT_L(n) asm volatile("s_waitcnt lgkmcnt(" #n ")" ::: "memory")
#define PG8_BAR __builtin_amdgcn_s_barrier()
#define PG8_SCHED __builtin_amdgcn_sched_barrier(0)
    Unit cur, nxt; int ui = 0;
    if (!S.next(0, cur)) return;
    using acc_t = typename std::conditional<I8, i32x4, f32x4>::type;
    acc_t acc[2][2][4][2];
#pragma unroll
    for (int a = 0; a < 2; ++a)
#pragma unroll
        for (int b = 0; b < 2; ++b)
#pragma unroll
            for (int m = 0; m < 4; ++m)
#pragma unroll
                for (int n = 0; n < 2; ++n) acc[a][b][m][n] = __builtin_bit_cast(acc_t, (u32x4){0u, 0u, 0u, 0u});
    bf16x8 At[4][2], B0[2][2], B1[2][2];
    unsigned oc00, oc01, oc10, oc11; int kn00, kn01, kn10, kn11;
    oc00 = S.a_conv(S.a_key(cur, Rr[0])) + Cc[0] * 2; oc01 = S.a_conv(S.a_key(cur, Rr[1])) + Cc[1] * 2; oc10 = S.a_conv(S.a_key(cur, HALF + Rr[0])) + Cc[0] * 2; oc11 = S.a_conv(S.a_key(cur, HALF + Rr[1])) + Cc[1] * 2;
    const char* cB = (const char*)Bbase + S.b_off(cur);
    PG8_STAGEB(PG8_SB(0, 0), cB); PG8_STAGEA(PG8_SA(0, 0), oc00, oc01, 0); PG8_STAGEB(PG8_SB(0, 1), cB + hstepB); PG8_STAGEA(PG8_SA(0, 1), oc10, oc11, 0);
    if (wr == 1) PG8_BAR;
    PG8_WAIT_V(4); PG8_BAR;
    PG8_STAGEB(PG8_SB(1, 0), cB + kstep); PG8_STAGEA(PG8_SA(1, 0), oc00, oc01, kstep); PG8_STAGEB(PG8_SB(1, 1), cB + hstepB + kstep);
    PG8_WAIT_V(6); PG8_BAR;
    for (;;) {
        E.pre(cur, lds, wid, lane, ui & 1);
        const bool has_next = S.next(ui + 1, nxt);
        const char* nB = cB;
        if (has_next) { kn00 = S.a_key(nxt, Rr[0]); kn01 = S.a_key(nxt, Rr[1]); kn10 = S.a_key(nxt, HALF + Rr[0]); kn11 = S.a_key(nxt, HALF + Rr[1]); nB = (const char*)Bbase + S.b_off(nxt); }
        else { kn00 = 0; kn01 = 0; kn10 = 0; kn11 = 0; }
        for (int t = 0; t < nt; t += 2) {
            const bool last = (t == nt - 2);
            const size_t k1 = (size_t)(t + 1) * kstep;
            const size_t k2 = last ? 0 : (size_t)(t + 2) * kstep, k3 = k2 + kstep;
            const unsigned o200 = (last && has_next) ? S.a_conv(kn00) + Cc[0] * 2 : oc00, o201 = (last && has_next) ? S.a_conv(kn01) + Cc[1] * 2 : oc01, o210 = (last && has_next) ? S.a_conv(kn10) + Cc[0] * 2 : oc10, o211 = (last && has_next) ? S.a_conv(kn11) + Cc[1] * 2 : oc11;
            const char* b2 = last ? nB : cB + (size_t)(t + 2) * kstep; const char* b3 = b2 + kstep;
            PG8_LDB(B0, 0, 0); PG8_SCHED; PG8_LDA(At, 0, 0); PG8_STAGEA(PG8_SA(1, 1), oc10, oc11, k1);
            PG8_WAIT_L(8); PG8_BAR; PG8_WAIT_L(0); PG8_MMA(0, 0, At, B0); PG8_BAR; PG8_SCHED;
            PG8_LDB(B1, 0, 1); PG8_STAGEB(PG8_SB(0, 0), b2);
            PG8_BAR; PG8_WAIT_L(0); PG8_MMA(0, 1, At, B1); PG8_BAR;
            PG8_LDA(At, 0, 1); PG8_STAGEA(PG8_SA(0, 0), o200, o201, k2);
            PG8_BAR; PG8_WAIT_L(0); PG8_MMA(1, 0, At, B0); PG8_BAR; PG8_SCHED;
            PG8_STAGEB(PG8_SB(0, 1), b2 + hstepB);
            PG8_WAIT_V(6); PG8_BAR; PG8_MMA(1, 1, At, B1); PG8_BAR;
            PG8_LDB(B0, 1, 0); PG8_SCHED; PG8_LDA(At, 1, 0); PG8_STAGEA(PG8_SA(0, 1), o210, o211, k2);
            PG8_WAIT_L(8); PG8_BAR; PG8_WAIT_L(0); PG8_MMA(0, 0, At, B0); PG8_BAR; PG8_SCHED;
            PG8_LDB(B1, 1, 1); PG8_STAGEB(PG8_SB(1, 0), b3);
            PG8_BAR; PG8_WAIT_L(0); PG8_MMA(0, 1, At, B1); PG8_BAR;
            PG8_LDA(At, 1, 1); PG8_STAGEA(PG8_SA(1, 0), o200, o201, k3);
            PG8_BAR; PG8_WAIT_L(0); PG8_MMA(1, 0, At, B0); PG8_BAR; PG8_SCHED;
            PG8_STAGEB(PG8_SB(1, 1), b3 + hstepB);
            PG8_WAIT_V(6); PG8_BAR; PG8_MMA(1, 1, At, B1); PG8_BAR;
        }
        E(acc, cur, wr, wc, fr, fq, ui & 1);
        if (!has_next) break;
#pragma unroll
        for (int a = 0; a < 2; ++a)
#pragma unroll
            for (int b = 0; b < 2; ++b)
#pragma unroll
                for (int m = 0; m < 4; ++m)
#pragma unroll
                    for (int n = 0; n < 2; ++n) acc[a][b][m][n] = __builtin_bit_cast(acc_t, (u32x4){0u, 0u, 0u, 0u});
        cur = nxt; cB = nB; oc00 = S.a_conv(kn00) + Cc[0] * 2; oc01 = S.a_conv(kn01) + Cc[1] * 2; oc10 = S.a_conv(kn10) + Cc[0] * 2; oc11 = S.a_conv(kn11) + Cc[1] * 2; ++ui;
    }
    PG8_WAIT_V(0);
    if (wr == 0) PG8_BAR;
    PG8_BAR;
#undef PG8_SA
#undef PG8_SB
#undef PG8_STAGEA
#undef PG8_STAGEB
#undef PG8_LDA
#undef PG8_LDB
#undef PG8_MMA
#undef PG8_WAIT_V
#undef PG8_WAIT_L
#undef PG8_BAR
#undef PG8_SCHED
}

struct DenseOrder {
    int nM, nN, nwg, G, c, K;
    __device__ void init(int M, int N, int K_, int G_, int c_) { nM = M / BM; nN = N / BM; nwg = nM * nN; G = G_; c = c_; K = K_; }
    __device__ __forceinline__ bool next(int i, Unit& u) const {
        const long L = (long)i * G + c; if (L >= nwg) return false;
        int wgid = (int)L; { const int q = nwg / NXCD, r = nwg % NXCD, xcd = wgid % NXCD, off = wgid / NXCD; wgid = (xcd < r ? xcd * (q + 1) : r * (q + 1) + (xcd - r) * q) + off; }
        const int nig = WGM * nN, gid = wgid / nig, fm = gid * WGM, gsz = (nM - fm) < WGM ? (nM - fm) : WGM;
        u.pm = fm + ((wgid % nig) % gsz); u.pn = (wgid % nig) / gsz; u.e = 0; u.nrow = 256; return true;
    }
    __device__ __forceinline__ int a_key(const Unit& u, int R) const { return u.pm * BM + R; }
    __device__ __forceinline__ unsigned a_conv(int key) const { return (unsigned)(key * K) * 2u; }
    __device__ __forceinline__ size_t b_off(const Unit& u) const { return (size_t)u.pn * BM * K * 2; }
};
struct MoeOrder {
    const LAS int* tstart; const LAS int* cnt; const LAS unsigned char* etile; const int* list; int G, c, K; bool gather;
    static constexpr int npn = 4;
    __device__ __forceinline__ bool next(int i, Unit& u) const {
        const int L = i * G + c; const int tt = tstart[32];
        if (L >= tt * npn) return false;
        const int tile = L / npn; u.pn = L % npn; u.pm = tile;
        const int e = etile[tile];
        u.e = e; u.nrow = cnt[e] - (tile - tstart[e]) * 256; return true;
    }
    __device__ __forceinline__ int a_key(const Unit& u, int R) const {
        if (gather) { const int mt = u.pm - tstart[u.e]; const int r = mt * 256 + R; return list[(size_t)u.e * 65536 + (R < u.nrow ? r : 0)]; }
        return u.pm * BM + R;
    }
    __device__ __forceinline__ unsigned a_conv(int key) const { return (unsigned)(key * K) * 2u; }
    __device__ __forceinline__ size_t b_off(const Unit& u) const { return ((size_t)u.e * 1024 + (size_t)u.pn * BM) * K * 2; }
};
}

constexpr int EPI_SC = MISC_OFF + 24576;
struct EpiIn {
    unsigned char* ws; const float* gate_b;
    __device__ __forceinline__ void pre(const pg8::Unit& u, LAS unsigned char* lds, int wid, int lane, int par) const {
        if (wid == 0) { __builtin_amdgcn_global_load_lds((const unsigned*)((const float*)(ws + WS_SA1) + u.pm * 256 + lane * 4), (LAS unsigned*)(lds + EPI_SC + par * 2048), 16, 0, 0);
                        __builtin_amdgcn_global_load_lds((const unsigned*)((const float*)(ws + WS_SBW) + u.pn * 256 + lane * 4), (LAS unsigned*)(lds + EPI_SC + par * 2048 + 1024), 16, 0, 0); } }
    LAS unsigned char* lds;
    __device__ __forceinline__ void operator()(const i32x4 (&acc)[2][2][4][2], const pg8::Unit& u, int wr, int wc, int fr, int fq, int par) const {
        asm volatile("" : "+v"(fr), "+v"(fq));
        const int pn = u.pn, row0 = u.pm * 256 + wr * 64 + fr;
        float sa[2][4]; f32x4 sb[2][2];
        { LAS const float* SA1 = (LAS const float*)(lds + EPI_SC + par * 2048); LAS const float* SBW = SA1 + 256;
#pragma unroll
          for (int ai = 0; ai < 2; ++ai)
#pragma unroll
              for (int m = 0; m < 4; ++m) sa[ai][m] = SA1[wr * 64 + fr + ai * 128 + m * 16];
#pragma unroll
          for (int bj = 0; bj < 2; ++bj)
#pragma unroll
              for (int n = 0; n < 2; ++n) sb[bj][n] = *(LAS const f32x4*)(SBW + bj * 128 + wc * 32 + 8 * fq + 4 * n); }
#define ACCF(ai, bj, m, n) (__builtin_convertvector(acc[ai][bj][m][n], f32x4) * sa[ai][m] * sb[bj][n])
        if (pn < 8) {
            bf16_t* dst = (bf16_t*)(ws + (pn < 2 ? WS_MQ : pn < 4 ? WS_MK : pn < 6 ? WS_MV : WS_MO));
            const int col0 = (pn & 1) * 256 + wc * 32 + 8 * fq;
#pragma unroll
            for (int ai = 0; ai < 2; ++ai)
#pragma unroll
                for (int m = 0; m < 4; ++m) { bf16_t* rp = dst + (size_t)(row0 + ai * 128 + m * 16) * 512 + col0;
#pragma unroll
                    for (int bj = 0; bj < 2; ++bj) { const f32x4 v0 = ACCF(ai, bj, m, 0), v1 = ACCF(ai, bj, m, 1);
                        u32x4 w; w.x = cvtpk(v0[0], v0[1]); w.y = cvtpk(v0[2], v0[3]); w.z = cvtpk(v1[0], v1[1]); w.w = cvtpk(v1[2], v1[3]);
                        *(u32x4*)(rp + bj * 128) = w; } }
        } else if (pn < 10) {
            const int g8 = 4 * (wc & 1) + fq; const float* COS = (const float*)(ws + WS_COS); const float* SIN = (const float*)(ws + WS_SIN); bf16_t* NQ = (bf16_t*)(ws + WS_NQ);
#pragma unroll
            for (int ai = 0; ai < 2; ++ai)
#pragma unroll
                for (int m = 0; m < 4; ++m) { const int row = row0 + ai * 128 + m * 16;
                    const f32x4 cs = *(const f32x4*)(COS + (size_t)row * 32 + 4 * g8), sn = *(const f32x4*)(SIN + (size_t)row * 32 + 4 * g8);
#pragma unroll
                    for (int bj = 0; bj < 2; ++bj) { const int head = (pn - 8) * 4 + bj * 2 + (wc >> 1);
                        const f32x4 x1 = ACCF(ai, bj, m, 0), x2 = ACCF(ai, bj, m, 1);
                        const f32x4 o1 = (x1 * cs - x2 * sn) * QSCALE, o2 = (x2 * cs + x1 * sn) * QSCALE;
                        bf16_t* rp = NQ + (size_t)row * 512 + head * 64 + 4 * (g8 & ~1) + 32 * (fq & 1);
                        u32x2 a; a.x = cvtpk(o1[0], o1[1]); a.y = cvtpk(o1[2], o1[3]);
                        u32x2 b; b.x = cvtpk(o2[0], o2[1]); b.y = cvtpk(o2[2], o2[3]); *(u32x4*)rp = widen_rows16(a, b); } }
        } else if (pn < 13) {
            bf16_t* kd = (bf16_t*)(ws + (pn == 10 ? WS_KC : pn == 11 ? WS_KSL : WS_KWN)); bf16_t* vd = (bf16_t*)(ws + (pn == 10 ? WS_VC : pn == 11 ? WS_VSL : WS_VWN));
            const float* COS = (const float*)(ws + WS_COS); const float* SIN = (const float*)(ws + WS_SIN);
            const int g8 = 4 * (wc & 1) + fq, grp = wc >> 1;
#pragma unroll
            for (int ai = 0; ai < 2; ++ai)
#pragma unroll
                for (int m = 0; m < 4; ++m) { const int row = row0 + ai * 128 + m * 16; const int b = row >> 12, s = row & 4095;
                    const f32x4 cs = *(const f32x4*)(COS + (size_t)row * 32 + 4 * g8), sn = *(const f32x4*)(SIN + (size_t)row * 32 + 4 * g8);
                    const size_t rbase = ((size_t)(b * 2 + grp) * SEQ + s) * 64;
                    { const f32x4 x1 = ACCF(ai, 0, m, 0), x2 = ACCF(ai, 0, m, 1);
                      const f32x4 o1 = x1 * cs - x2 * sn, o2 = x2 * cs + x1 * sn;
                      bf16_t* rp = kd + rbase + 4 * (g8 & ~1) + 32 * (fq & 1);
                      u32x2 a; a.x = cvtpk(o1[0], o1[1]); a.y = cvtpk(o1[2], o1[3]);
                      u32x2 c; c.x = cvtpk(o2[0], o2[1]); c.y = cvtpk(o2[2], o2[3]); *(u32x4*)rp = widen_rows16(a, c); }
                    { const f32x4 v0 = ACCF(ai, 1, m, 0), v1 = ACCF(ai, 1, m, 1);
                      u32x4 w; w.x = cvtpk(v0[0], v0[1]); w.y = cvtpk(v0[2], v0[3]); w.z = cvtpk(v1[0], v1[1]); w.w = cvtpk(v1[2], v1[3]);
                      *(u32x4*)(vd + rbase + (wc & 1) * 32 + 8 * fq) = w; } }
        } else {
            if (wc == 0) { float* GI = (float*)(ws + WS_GI); float* GF = (float*)(ws + WS_GF); float* NGT = (float*)(ws + WS_NGT);
#pragma unroll
                for (int ai = 0; ai < 2; ++ai)
#pragma unroll
                    for (int m = 0; m < 4; ++m) { const int row = row0 + ai * 128 + m * 16; const int b = row >> 12, s = row & 4095;
#pragma unroll
                        for (int n = 0; n < 2; ++n) { const f32x4 v = ACCF(ai, 0, m, n);
                            if (fq == 0) {
#pragma unroll
                                for (int i = 0; i < 4; ++i) { const float z = v[i] + gate_b[4 * n + i];
                                    if (n == 0) GI[(size_t)(b * 4 + i) * SEQ + s] = z; else GF[(size_t)(b * 4 + i) * SEQ + s] = logsigmoid_f(z); }
                            } else {
                                f32x4 o; o[0] = sigmoid_f(v[0]); o[1] = sigmoid_f(v[1]); o[2] = sigmoid_f(v[2]); o[3] = sigmoid_f(v[3]);
                                *(f32x4*)(NGT + (size_t)row * 24 + 8 * fq + 4 * n - 8) = o; } } }
            }
        }
    }
};
#undef ACCF
struct EpiBf16 {
    bf16_t* O; int ldc;
    __device__ __forceinline__ void pre(const pg8::Unit&, LAS unsigned char*, int, int, int) const {}
    __device__ __forceinline__ void operator()(const f32x4 (&acc)[2][2][4][2], const pg8::Unit& u, int wr, int wc, int fr, int fq, int par) const {
        asm volatile("" : "+v"(fr), "+v"(fq));
        const int row0 = u.pm * 256 + wr * 64 + fr, col0 = u.pn * 256 + wc * 32 + 8 * fq;
#pragma unroll
        for (int ai = 0; ai < 2; ++ai)
#pragma unroll
            for (int m = 0; m < 4; ++m) { bf16_t* rp = O + (size_t)(row0 + ai * 128 + m * 16) * ldc + col0;
#pragma unroll
                for (int bj = 0; bj < 2; ++bj) { const f32x4 v0 = acc[ai][bj][m][0], v1 = acc[ai][bj][m][1];
                    u32x4 w; w.x = cvtpk(v0[0], v0[1]); w.y = cvtpk(v0[2], v0[3]); w.z = cvtpk(v1[0], v1[1]); w.w = cvtpk(v1[2], v1[3]);
                    *(u32x4*)(rp + bj * 128) = w; } }
    }
};
struct EpiUp {
    bf16_t* HB;
    __device__ __forceinline__ void pre(const pg8::Unit&, LAS unsigned char*, int, int, int) const {}
    __device__ __forceinline__ void operator()(const f32x4 (&acc)[2][2][4][2], const pg8::Unit& u, int wr, int wc, int fr, int fq, int par) const {
        asm volatile("" : "+v"(fr), "+v"(fq));
        const int row0 = u.pm * 256 + wr * 64 + fr, col0 = (u.pn * 256 + wc * 32 + 8 * fq) >> 1;
#pragma unroll
        for (int ai = 0; ai < 2; ++ai)
#pragma unroll
            for (int m = 0; m < 4; ++m) { bf16_t* rp = HB + (size_t)(row0 + ai * 128 + m * 16) * EFF + col0;
#pragma unroll
                for (int bj = 0; bj < 2; ++bj) { const f32x4 a1 = acc[ai][bj][m][0], a3 = acc[ai][bj][m][1];
                    u32x2 w; w.x = cvtpk(silu_f(a1[0]) * a3[0], silu_f(a1[1]) * a3[1]); w.y = cvtpk(silu_f(a1[2]) * a3[2], silu_f(a1[3]) * a3[3]);
                    *(u32x2*)(rp + bj * 64) = w; } }
    }
};

struct EpiUpI8 {
    bf16_t* HB; const float* SAL; const float* SB; const LAS int* tstart; LAS unsigned char* lds;
    __device__ __forceinline__ void pre(const pg8::Unit& u, LAS unsigned char* l, int wid, int lane, int par) const {
        if (wid == 0) { const int mt = u.pm - tstart[u.e];
            __builtin_amdgcn_global_load_lds((const unsigned*)(SAL + (size_t)u.e * 65536 + mt * 256 + lane * 4), (LAS unsigned*)(l + EPI_SC + par * 2048), 16, 0, 0);
            __builtin_amdgcn_global_load_lds((const unsigned*)(SB + (size_t)u.e * 1024 + u.pn * 256 + lane * 4), (LAS unsigned*)(l + EPI_SC + par * 2048 + 1024), 16, 0, 0); } }
    __device__ __forceinline__ void operator()(const i32x4 (&acc)[2][2][4][2], const pg8::Unit& u, int wr, int wc, int fr, int fq, int par) const {
        asm volatile("" : "+v"(fr), "+v"(fq));
        const int rl0 = wr * 64 + fr, row0 = u.pm * 256 + rl0, colp = u.pn * 256 + wc * 32 + 8 * fq, col0 = colp >> 1;
        LAS const float* LSA = (LAS const float*)(lds + EPI_SC + par * 2048); LAS const float* LSB = LSA + 256;
        f32x4 sb[2][2];
#pragma unroll
        for (int bj = 0; bj < 2; ++bj)
#pragma unroll
            for (int n = 0; n < 2; ++n) sb[bj][n] = *(LAS const f32x4*)(LSB + wc * 32 + 8 * fq + bj * 128 + 4 * n);
#pragma unroll
        for (int ai = 0; ai < 2; ++ai)
#pragma unroll
            for (int m = 0; m < 4; ++m) { const int R = rl0 + ai * 128 + m * 16; const float sa = LSA[R];
                bf16_t* rp = HB + (size_t)(row0 + ai * 128 + m * 16) * EFF + (col0 & ~7) + 64 * (fq & 1);
                u32x2 wv[2];
#pragma unroll
                for (int bj = 0; bj < 2; ++bj) { const i32x4 i1 = acc[ai][bj][m][0], i3 = acc[ai][bj][m][1];
                    f32x4 a1, a3;
#pragma unroll
                    for (int i = 0; i < 4; ++i) { a1[i] = (float)i1[i] * sa * sb[bj][0][i]; a3[i] = (float)i3[i] * sa * sb[bj][1][i]; }
                    wv[bj].x = cvtpk(silu_f(a1[0]) * a3[0], silu_f(a1[1]) * a3[1]); wv[bj].y = cvtpk(silu_f(a1[2]) * a3[2], silu_f(a1[3]) * a3[3]); }
                *(u32x4*)rp = widen_rows16(wv[0], wv[1]); }
    }
};

template <class RM>
__device__ __forceinline__ void transpose_item(const float* W, int N, bf16_t* WT, int Kd, LAS float* scr, int k0, int n0, int lane, const RM& rm) {
#pragma unroll
    for (int i = 0; i < 8; ++i) { const int kk = 8 * i + (lane >> 3); const f32x4 w4 = *(const f32x4*)(W + (size_t)(k0 + kk) * N + n0 + 4 * (lane & 7));
        LAS float* d = scr + kk * 33 + 4 * (lane & 7); d[0] = w4[0]; d[1] = w4[1]; d[2] = w4[2]; d[3] = w4[3]; }
    asm volatile("s_waitcnt lgkmcnt(0)" ::: "memory");
    const int c = lane & 7;
#pragma unroll
    for (int j = 0; j < 4; ++j) { const int n = (lane >> 3) + 8 * j; const LAS float* s = scr + (8 * c) * 33 + n;
        u32x4 o; o.x = cvtpk(s[0 * 33], s[1 * 33]); o.y = cvtpk(s[2 * 33], s[3 * 33]); o.z = cvtpk(s[4 * 33], s[5 * 33]); o.w = cvtpk(s[6 * 33], s[7 * 33]);
        *(u32x4*)(WT + (size_t)rm(n0 + n) * Kd + k0 + 8 * c) = o; }
    asm volatile("s_waitcnt lgkmcnt(0)" ::: "memory");
}
struct RmId { int off; __device__ __forceinline__ int operator()(int n) const { return off + n; } };
__device__ __forceinline__ int rope_pl(int d) { return 8 * ((d & 31) >> 2) + 4 * (d >> 5) + (d & 3); }
struct RmWin {
    __device__ __forceinline__ int operator()(int c) const {
        if (c < 2048) return c;
        if (c < 2052) return 3328 + (c - 2048);
        if (c < 2056) return 3332 + (c - 2052);
        if (c < 2568) { const int x = c - 2056; return 2048 + (x & ~63) + rope_pl(x & 63); }
        if (c < 2696) { const int x = c - 2568; return 2560 + (x & ~63) + rope_pl(x & 63); }
        if (c < 2824) return 2688 + (c - 2696);
        if (c < 2952) { const int x = c - 2824; return 2816 + (x & ~63) + rope_pl(x & 63); }
        if (c < 3080) return 2944 + (c - 2952);
        if (c < 3208) { const int x = c - 3080; return 3072 + (x & ~63) + rope_pl(x & 63); }
        if (c < 3336) return 3200 + (c - 3208);
        return c;
    }
};
struct RmW13 { int sel; __device__ __forceinline__ int operator()(int j) const { return 8 * (j >> 2) + 4 * sel + (j & 3); } };

__device__ __forceinline__ void p0_phase(Frame& F) {
    const int tid = F.tid, lane = F.lane;
    const int NA = F.G > 64 ? 64 : F.G;
    const bool split = F.G > NA;
    if (F.vcu < NA) {
        LAS float* sc = (LAS float*)F.lds; LAS float* red = (LAS float*)(F.lds + 32768);
        const float* c = IN_F(1);
        for (int i = tid; i < 8192; i += NTHR) sc[i] = silu_f(c[i]);
        __syncthreads();
        const float* W = IN_F(3); const float* bia = IN_F(4); float* mod = WSP(float, WS_MOD);
        for (int cg = F.vcu; cg < 64; cg += NA) {
            const int col0 = cg * 96;
            const int kq = tid / 24, cq = tid % 24;
            f32x4 a[8];
#pragma unroll
            for (int b = 0; b < 8; ++b) a[b] = (f32x4){0.f, 0.f, 0.f, 0.f};
            if (tid < 504) {
#pragma unroll 4
                for (int k = kq; k < 1024; k += 21) { const f32x4 w = *(const f32x4*)(W + (size_t)k * 6144 + col0 + 4 * cq);
#pragma unroll
                    for (int b = 0; b < 8; ++b) a[b] += w * sc[b * 1024 + k]; }
#pragma unroll
                for (int b = 0; b < 8; ++b) *(LAS f32x4*)(red + (size_t)(tid * 8 + b) * 4) = a[b];
            }
            __syncthreads();
            for (int o = tid; o < 768; o += NTHR) { const int cq2 = o >> 5, bj = o & 31;
                float sacc = 0.f;
                for (int q = 0; q < 21; ++q) sacc += red[(size_t)((q * 24 + cq2) * 8) * 4 + bj];
                const int col = col0 + 4 * cq2 + (bj & 3);
                mod[(bj >> 2) * 6144 + col] = sacc + bia[col]; }
            __syncthreads();
        }
    }
    if (!split || F.vcu >= NA) {
        LAS float* scr = (LAS float*)(F.lds + F.wave * 8448);
        const int gw = (split ? F.vcu - NA : F.vcu) * NWAVES + F.wave, NGW = (split ? F.G - NA : F.G) * NWAVES;
        constexpr int I_WOUT = 16 * 32, I_C1 = 32 * 4, I_C2 = 2 * 2;
        constexpr int NITEMS = I_WOUT + 2 * I_C1 + 2 * I_C2;
        for (int it = gw; it < NITEMS; it += NGW) {
            int r = it;
            if (r < I_WOUT) { transpose_item(IN_F(19), 1024, WSP(bf16_t, WS_WOUTT), 1024, scr, (r / 32) * 64, (r % 32) * 32, lane, RmId{0}); continue; } r -= I_WOUT;
            if (r < I_C1) { transpose_item(IN_F(14), 128, WSP(bf16_t, WS_CW1K), 2048, scr, (r / 4) * 64, (r % 4) * 32, lane, RmId{0}); continue; } r -= I_C1;
            if (r < I_C1) { transpose_item(IN_F(17), 128, WSP(bf16_t, WS_CW1V), 2048, scr, (r / 4) * 64, (r % 4) * 32, lane, RmId{0}); continue; } r -= I_C1;
            if (r < I_C2) { transpose_item(IN_F(15), 64, WSP(bf16_t, WS_CW2K), 128, scr, (r / 2) * 64, (r % 2) * 32, lane, RmId{0}); continue; } r -= I_C2;
            transpose_item(IN_F(18), 64, WSP(bf16_t, WS_CW2V), 128, scr, (r / 2) * 64, (r % 2) * 32, lane, RmId{0});
        }
    }
    __syncthreads();
    {
        LAS unsigned* AM = (LAS unsigned*)F.lds; const int n4 = tid & 7, kq = tid >> 3; const RmWin rmw{};
        for (int it = (F.vcu + F.G - (split ? NA : 0)) % F.G; it < 105; it += F.G) {
            const int c0 = 32 * it + 4 * n4; const float* W = IN_F(9) + (size_t)(16 * kq) * INW + c0;
            if (tid < 32) AM[tid] = 0u;
            __syncthreads();
            f32x4 v[16]; f32x4 am = {0.f, 0.f, 0.f, 0.f};
#pragma unroll
            for (int i = 0; i < 16; ++i) { v[i] = *(const f32x4*)(W + (size_t)i * INW);
#pragma unroll
                for (int c = 0; c < 4; ++c) am[c] = fmaxf(am[c], fabsf(v[i][c])); }
#pragma unroll
            for (int o = 8; o < 64; o <<= 1) {
#pragma unroll
                for (int c = 0; c < 4; ++c) am[c] = fmaxf(am[c], __shfl_xor(am[c], o)); }
            if ((tid & 63) < 8) {
#pragma unroll
                for (int c = 0; c < 4; ++c) atomicMax((unsigned*)&AM[4 * n4 + c], __float_as_uint(am[c])); }
            __syncthreads();
            const f32x4 amax = *(LAS const f32x4*)((LAS const float*)AM + 4 * n4);
#pragma unroll
            for (int c = 0; c < 4; ++c) { const float inv = amax[c] > 0.f ? 127.f / amax[c] : 0.f; const int prow = rmw(c0 + c); u32x4 o;
#pragma unroll
                for (int d = 0; d < 4; ++d) {
                    const int q0 = (int)rintf(v[4 * d][c] * inv), q1 = (int)rintf(v[4 * d + 1][c] * inv), q2 = (int)rintf(v[4 * d + 2][c] * inv), q3 = (int)rintf(v[4 * d + 3][c] * inv);
                    o[d] = (unsigned)(q0 & 0xff) | ((unsigned)(q1 & 0xff) << 8) | ((unsigned)(q2 & 0xff) << 16) | ((unsigned)(q3 & 0xff) << 24); }
                *(u32x4*)((unsigned char*)(F.ws + WS_WINT) + (size_t)prow * 1024 + 16 * kq) = o;
                if (kq == 0) WSP(float, WS_SBW)[prow] = amax[c] * (1.f / 127.f); }
            __syncthreads();
        }
    }
    {
        const size_t gt = (size_t)F.vcu * NTHR + tid, NGT_ = (size_t)F.G * NTHR;
        const int* pos = (const int*)F.in[2]; float* COS = WSP(float, WS_COS); float* SIN = WSP(float, WS_SIN);
        {
            const int d = (int)(gt & 31); const float inv = powf(10000.f, -(float)d / 32.f);
            for (size_t i = gt; i < (size_t)NTOK * 32; i += NGT_) { const int row = (int)(i >> 5);
                const float ang = (float)pos[row] * inv; const float kk = rintf(ang * 0.15915494309189535f);
                float r = fmaf(-kk, 6.28125f, ang); r = fmaf(-kk, 1.9353071795864769e-3f, r);
                float sn, cs; sincosf(r, &sn, &cs); COS[i] = cs; SIN[i] = sn; } }
        { unsigned* z = (unsigned*)(F.ws + WS_WINT + (size_t)3360 * 1024); for (size_t i = gt; i < (size_t)224 * 256; i += NGT_) z[i] = 0u;
          for (size_t i = gt; i < 224; i += NGT_) WSP(float, WS_SBW)[3360 + i] = 0.f; }
        { const float* wg = IN_F(20); const float* we = IN_F(22); _Float16* RWT = WSP(_Float16, WS_RWT);
          for (size_t i = gt; i < 48 * 1024; i += NGT_) { const int n = (int)(i >> 10), k = (int)(i & 1023);
              const float w = n < 4 ? wg[k * 4 + n] : n < 36 ? we[k * 32 + n - 4] : 0.f; RWT[i] = (_Float16)w; } }
        { bf16_t* kc = WSP(bf16_t, WS_KCMP); bf16_t* vc = WSP(bf16_t, WS_VCMP);
          for (size_t i = gt; i < 16 * 64; i += NGT_) { const size_t o = ((i >> 6) * 256 + 255) * 64 + (i & 63); kc[o] = 0; vc[o] = 0; } }
    }
    __syncthreads();
    if (F.vcu >= F.G - 16) {
        const int bi = F.vcu - (F.G - 16), kv = bi >> 3, cg = bi & 7;
        const float* pe = IN_F(kv == 0 ? 13 : 16); const float* w1 = IN_F(kv == 0 ? 14 : 17);
        LAS float* red = (LAS float*)F.lds;
        const int col = cg * 16 + (tid & 15), sl = tid >> 4; float sacc = 0.f;
#pragma unroll 8
        for (int k = sl * 64; k < sl * 64 + 64; ++k) sacc += pe[k] * w1[(size_t)k * 128 + col];
        red[tid] = sacc; __syncthreads();
        if (tid < 16) { float t2 = 0.f; for (int q = 0; q < 32; ++q) t2 += red[q * 16 + tid]; WSP(float, WS_C1B)[kv * 128 + cg * 16 + tid] = t2; }
    }
    __syncthreads();
}

__device__ __forceinline__ void p1a_phase(Frame& F) {
    const int gw = F.vcu * NWAVES + F.wave, NGW = F.G * NWAVES, lane = F.lane;
    const float* x = IN_F(0); const float* nw = IN_F(5); const float* mod = WSP(float, WS_MOD); signed char* H1Q = (signed char*)(F.ws + WS_H1);
    for (int row0 = gw * 4; row0 < NTOK; row0 += NGW * 4) {
        f32x4 v[4][4]; float ss[4];
#pragma unroll
        for (int r = 0; r < 4; ++r) { const f32x4* xr = (const f32x4*)(x + (size_t)(row0 + r) * DM) + lane;
#pragma unroll
            for (int j = 0; j < 4; ++j) v[r][j] = __builtin_nontemporal_load(xr + 64 * j); }
#pragma unroll
        for (int r = 0; r < 4; ++r) { float a = 0.f;
#pragma unroll
            for (int j = 0; j < 4; ++j) a += v[r][j][0] * v[r][j][0] + v[r][j][1] * v[r][j][1] + v[r][j][2] * v[r][j][2] + v[r][j][3] * v[r][j][3];
            ss[r] = a; }
#pragma unroll
        for (int o = 1; o < 64; o <<= 1) {
#pragma unroll
            for (int r = 0; r < 4; ++r) ss[r] += __shfl_xor(ss[r], o); }
        const int b = row0 >> 12; float am[4] = {0.f, 0.f, 0.f, 0.f};
#pragma unroll
        for (int j = 0; j < 4; ++j) { const int k = 4 * lane + 256 * j;
            const f32x4 w = *(const f32x4*)(nw + k), sh = *(const f32x4*)(mod + b * 6144 + k), sc = *(const f32x4*)(mod + b * 6144 + 1024 + k);
            const f32x4 ws = w * (sc + 1.f);
#pragma unroll
            for (int r = 0; r < 4; ++r) { const float rr = rsqrtf(ss[r] * (1.f / DM) + RMS_EPS);
                const f32x4 h = v[r][j] * rr * ws + sh; v[r][j] = h;
                am[r] = fmaxf(am[r], fmaxf(fmaxf(fabsf(h[0]), fabsf(h[1])), fmaxf(fabsf(h[2]), fabsf(h[3])))); } }
#pragma unroll
        for (int o = 1; o < 64; o <<= 1) {
#pragma unroll
            for (int r = 0; r < 4; ++r) am[r] = fmaxf(am[r], __shfl_xor(am[r], o)); }
#pragma unroll
        for (int r = 0; r < 4; ++r) { const float inv = am[r] > 0.f ? 127.f / am[r] : 0.f;
            if (lane == 0) WSP(float, WS_SA1)[row0 + r] = am[r] * (1.f / 127.f);
            u32x4 pk;
#pragma unroll
            for (int j = 0; j < 4; ++j) { const f32x4 q = v[r][j] * inv;
                const int q0 = (int)rintf(q[0]), q1 = (int)rintf(q[1]), q2 = (int)rintf(q[2]), q3 = (int)rintf(q[3]);
                pk[j] = (unsigned)(q0 & 0xff) | ((unsigned)(q1 & 0xff) << 8) | ((unsigned)(q2 & 0xff) << 16) | ((unsigned)(q3 & 0xff) << 24); }
            *(u32x4*)(H1Q + (size_t)(row0 + r) * DM + 256 * (lane & 3) + 16 * (lane >> 2)) = quad_transpose(pk, lane); }
    }
}

__device__ __forceinline__ void conv_silu16(const bf16_t* src  , const float* cw  , int b, int s, int ch0  , float scale, float (&o)[16]) {
#pragma unroll
    for (int i = 0; i < 16; ++i) o[i] = 0.f;
#pragma unroll
    for (int j = 0; j < 4; ++j) { const int ss = s - 3 + j;
        if (ss >= 0) { const bf16_t* rp = src + ((size_t)b * SEQ + ss) * 512 + ch0;
            const u32x4 a = *(const u32x4*)rp, c = *(const u32x4*)(rp + 8);
            const float* w = cw + j * 1024;
            const f32x4 w0 = *(const f32x4*)w, w1 = *(const f32x4*)(w + 4), w2 = *(const f32x4*)(w + 8), w3 = *(const f32x4*)(w + 12);
            o[0] += bflo(a.x) * w0[0]; o[1] += bfhi(a.x) * w0[1]; o[2] += bflo(a.y) * w0[2]; o[3] += bfhi(a.y) * w0[3];
            o[4] += bflo(a.z) * w1[0]; o[5] += bfhi(a.z) * w1[1]; o[6] += bflo(a.w) * w1[2]; o[7] += bfhi(a.w) * w1[3];
            o[8] += bflo(c.x) * w2[0]; o[9] += bfhi(c.x) * w2[1]; o[10] += bflo(c.y) * w2[2]; o[11] += bfhi(c.y) * w2[3];
            o[12] += bflo(c.z) * w3[0]; o[13] += bfhi(c.z) * w3[1]; o[14] += bflo(c.w) * w3[2]; o[15] += bfhi(c.w) * w3[3]; } }
#pragma unroll
    for (int i = 0; i < 16; ++i) o[i] = silu_f(o[i]) * scale;
}
constexpr int RAWS = 272, RAWIMG = 67 * RAWS + 208;
__device__ __forceinline__ void stage_raw(const bf16_t* src, int b, int s0, int h, LAS unsigned char* RAW, int tid) {
    const int s = tid >> 3, chg = tid & 7;
    const bf16_t* rp = src + ((size_t)b * SEQ + s0 + s) * 512 + h * 128 + chg * 16;
    *(LAS u32x4*)(RAW + (s + 3) * RAWS + chg * 32) = *(const u32x4*)rp; *(LAS u32x4*)(RAW + (s + 3) * RAWS + chg * 32 + 16) = *(const u32x4*)(rp + 8);
    if (s < 3) { u32x4 a = {0u, 0u, 0u, 0u}, c = a; const int ss = s0 - 3 + s;
        if (ss >= 0) { const bf16_t* hp = src + ((size_t)b * SEQ + ss) * 512 + h * 128 + chg * 16; a = *(const u32x4*)hp; c = *(const u32x4*)(hp + 8); }
        *(LAS u32x4*)(RAW + s * RAWS + chg * 32) = a; *(LAS u32x4*)(RAW + s * RAWS + chg * 32 + 16) = c; }
}
__device__ __forceinline__ void conv_lds16(LAS const unsigned char* RAW, LAS const float* WL, int s, int ch0, float scale, float (&o)[16]) {
#pragma unroll
    for (int i = 0; i < 16; ++i) o[i] = 0.f;
#pragma unroll
    for (int j = 0; j < 4; ++j) { const u32x4 a = *(LAS const u32x4*)(RAW + (s + j) * RAWS + ch0 * 2), c = *(LAS const u32x4*)(RAW + (s + j) * RAWS + ch0 * 2 + 16);
        const LAS float* w = WL + j * 128 + ch0;
        const f32x4 w0 = *(LAS const f32x4*)w, w1 = *(LAS const f32x4*)(w + 4), w2 = *(LAS const f32x4*)(w + 8), w3 = *(LAS const f32x4*)(w + 12);
        o[0] += bflo(a.x) * w0[0]; o[1] += bfhi(a.x) * w0[1]; o[2] += bflo(a.y) * w0[2]; o[3] += bfhi(a.y) * w0[3];
        o[4] += bflo(a.z) * w1[0]; o[5] += bfhi(a.z) * w1[1]; o[6] += bflo(a.w) * w1[2]; o[7] += bfhi(a.w) * w1[3];
        o[8] += bflo(c.x) * w2[0]; o[9] += bfhi(c.x) * w2[1]; o[10] += bflo(c.y) * w2[2]; o[11] += bfhi(c.y) * w2[3];
        o[12] += bflo(c.z) * w3[0]; o[13] += bfhi(c.z) * w3[1]; o[14] += bflo(c.w) * w3[2]; o[15] += bfhi(c.w) * w3[3]; }
#pragma unroll
    for (int i = 0; i < 16; ++i) o[i] = silu_f(o[i]) * scale;
}
constexpr int TRT = 4096 + 64, RCH = 1024 + 16;
constexpr int TRIMG = 4 * TRT, ROWIMG = 16 * RCH;
__device__ __forceinline__ unsigned tr_lane_off(int lane) { const int hi = lane >> 5; return ((lane >> 4) & 1) * 32 + (lane & 3) * 8 + (4 * hi + ((lane & 15) >> 2)) * 64; }

#if DBG_CHECK == 2
#define DBGF(code, val) do { const float _v = (val); if ((__float_as_uint(_v) & 0x7f800000u) == 0x7f800000u) atomicMin((unsigned*)(F.ws + WS_CTL) + CW_DBG, (unsigned)(code)); } while (0)
#else
#define DBGF(code, val) do {} while (0)
#endif
struct MaPF { u32x4 k0, k1, v0, v1, hk0, hk1; float wk, g0, g1; };
__device__ __forceinline__ void mlstm_a_load(Frame& F, int job, int tid, MaPF& pf) {
    const int lane = tid & 63, w = F.wave;
    const int bh = job >> 6, c = job & 63, b = bh >> 2, h = bh & 3, s0 = c * 64, s = tid >> 3, chg = tid & 7;
    const size_t ro = ((size_t)b * SEQ + s0 + s) * 512 + h * 128 + chg * 16;
    const bf16_t* kp = WSP(bf16_t, WS_MK) + ro; const bf16_t* vp = WSP(bf16_t, WS_MV) + ro;
    pf.k0 = *(const u32x4*)kp; pf.k1 = *(const u32x4*)(kp + 8); pf.v0 = *(const u32x4*)vp; pf.v1 = *(const u32x4*)(vp + 8);
    pf.hk0 = (u32x4){0u, 0u, 0u, 0u}; pf.hk1 = pf.hk0;
    if (s < 3 && s0 - 3 + s >= 0) { const bf16_t* hp = WSP(bf16_t, WS_MK) + ((size_t)b * SEQ + s0 - 3 + s) * 512 + h * 128 + chg * 16; pf.hk0 = *(const u32x4*)hp; pf.hk1 = *(const u32x4*)(hp + 8); }
    pf.wk = IN_F(10)[(tid >> 7) * 1024 + 512 + h * 128 + (tid & 127)];
    pf.g0 = 0.f; pf.g1 = 0.f;
    if (w == 0) { pf.g0 = WSP(float, WS_GF)[(size_t)bh * SEQ + s0 + lane]; pf.g1 = WSP(float, WS_GI)[(size_t)bh * SEQ + s0 + lane]; }
}
__device__ __forceinline__ void mlstm_a_phase(Frame& F) {
    int tid = F.tid; asm volatile("" : "+v"(tid));
    const int lane = tid & 63, w = F.wave, r32 = lane & 31, hi = lane >> 5;
    LAS unsigned char* kimg = F.lds; LAS unsigned char* vimg = F.lds + TRIMG; LAS float* wS = (LAS float*)(F.lds + 2 * TRIMG);
    LAS unsigned char* RAWK = F.lds + 2 * TRIMG + 1024; LAS float* WLK = (LAS float*)(RAWK + RAWIMG);
    LAS bf16_t* OST = (LAS bf16_t*)(F.lds + 2 * TRIMG + 1024 + RAWIMG + 2048) + w * 2048;
    MaPF pf; int job = F.vcu;
    if (job < 2048) mlstm_a_load(F, job, tid, pf);
    for (; job < 2048; job += F.G) {
        {
            const int s = tid >> 3, chg = tid & 7;
            *(LAS u32x4*)(RAWK + (s + 3) * RAWS + chg * 32) = pf.k0; *(LAS u32x4*)(RAWK + (s + 3) * RAWS + chg * 32 + 16) = pf.k1;
            if (s < 3) { *(LAS u32x4*)(RAWK + s * RAWS + chg * 32) = pf.hk0; *(LAS u32x4*)(RAWK + s * RAWS + chg * 32 + 16) = pf.hk1; }
            WLK[tid] = pf.wk;
            if (w == 0) {
                float bs = pf.g0;
#pragma unroll
                for (int o = 1; o < 64; o <<= 1) { const float x = __shfl_up(bs, o); if (lane >= o) bs += x; }
                const float g = __shfl(bs, 63);
                const float a = g - bs + pf.g1; const float ml = wave_max(a);
                wS[lane] = __expf(a - ml);
                if (lane == 0) { WSP(float, WS_GSUM)[job] = g; WSP(float, WS_MLOC)[job] = ml; }
            }
        }
        const u32x4 va = pf.v0, vd = pf.v1;
        __syncthreads();
        if (job + F.G < 2048) mlstm_a_load(F, job + F.G, tid, pf);
        {
            const int s = tid >> 3, chg = tid & 7, ch0 = chg * 16;
            float kf[16]; conv_lds16(RAWK, WLK, s, ch0, 0.08838834764831845f, kf);
            const unsigned off = (ch0 >> 5) * TRT + s * 64 + (ch0 & 31) * 2;
            u32x4 k0, k1; k0.x = cvtpk(kf[0], kf[1]); k0.y = cvtpk(kf[2], kf[3]); k0.z = cvtpk(kf[4], kf[5]); k0.w = cvtpk(kf[6], kf[7]);
            k1.x = cvtpk(kf[8], kf[9]); k1.y = cvtpk(kf[10], kf[11]); k1.z = cvtpk(kf[12], kf[13]); k1.w = cvtpk(kf[14], kf[15]);
            *(LAS u32x4*)(kimg + off) = k0; *(LAS u32x4*)(kimg + off + 16) = k1;
            const float ws = wS[s];
            u32x4 v0, v1;
            v0.x = cvtpk(bflo(va.x) * ws, bfhi(va.x) * ws); v0.y = cvtpk(bflo(va.y) * ws, bfhi(va.y) * ws); v0.z = cvtpk(bflo(va.z) * ws, bfhi(va.z) * ws); v0.w = cvtpk(bflo(va.w) * ws, bfhi(va.w) * ws);
            v1.x = cvtpk(bflo(vd.x) * ws, bfhi(vd.x) * ws); v1.y = cvtpk(bflo(vd.y) * ws, bfhi(vd.y) * ws); v1.z = cvtpk(bflo(vd.z) * ws, bfhi(vd.z) * ws); v1.w = cvtpk(bflo(vd.w) * ws, bfhi(vd.w) * ws);
            *(LAS u32x4*)(vimg + off) = v0; *(LAS u32x4*)(vimg + off + 16) = v1;
        }
        __syncthreads();
        {
            const int et = w >> 1, dt0 = 2 * (w & 1); const unsigned lo = tr_lane_off(lane);
            f32x16 acc0 = {0}, acc1 = {0};
#pragma unroll
            for (int ks = 0; ks < 4; ++ks) {
                const bf16x8 a = mk8(vtr(vimg + et * TRT + ks * 1024 + lo), vtr(vimg + et * TRT + ks * 1024 + lo + 512));
                const bf16x8 b0 = mk8(vtr(kimg + dt0 * TRT + ks * 1024 + lo), vtr(kimg + dt0 * TRT + ks * 1024 + lo + 512));
                const bf16x8 b1 = mk8(vtr(kimg + (dt0 + 1) * TRT + ks * 1024 + lo), vtr(kimg + (dt0 + 1) * TRT + ks * 1024 + lo + 512));
                acc0 = MFMA32(a, b0, acc0); acc1 = MFMA32(a, b1, acc1);
            }
#pragma unroll
            for (int r = 0; r < 16; ++r) { const int el = crow(r, hi); OST[el * 64 + r32] = f2bf(acc0[r]); OST[el * 64 + 32 + r32] = f2bf(acc1[r]); }
            asm volatile("s_waitcnt lgkmcnt(0)" ::: "memory");
            bf16_t* dst = WSP(bf16_t, WS_KVC) + (size_t)job * 16384 + (size_t)(et * 32) * 128 + dt0 * 32;
#pragma unroll
            for (int i = 0; i < 4; ++i) { const int rw = i * 8 + (lane >> 3), ch = lane & 7; *(u32x4*)(dst + (size_t)rw * 128 + ch * 8) = *(LAS const u32x4*)(OST + rw * 64 + ch * 8); }
        }
        if (tid < 128) {
            float sacc = 0.f; const int d = tid;
            for (int ss = 0; ss < 64; ++ss) sacc += wS[ss] * bf2f(*(LAS const bf16_t*)(kimg + (d >> 5) * TRT + ss * 64 + (d & 31) * 2));
            WSP(float, WS_NC)[(size_t)job * 128 + d] = sacc;
        }
        __syncthreads();
    }
}

__device__ __forceinline__ void mlstm_scan_job(Frame& F, int job) {
    int tid = F.tid; asm volatile("" : "+v"(tid));
    const int bh = job >> 3, sl = job & 7;
    LAS float* aold = (LAS float*)F.lds; LAS float* anew = aold + 64; LAS float* gS = aold + 128; LAS float* mS = aold + 192;
    if (tid < 64) { gS[tid] = WSP(float, WS_GSUM)[bh * 64 + tid]; mS[tid] = WSP(float, WS_MLOC)[bh * 64 + tid]; }
    __syncthreads();
    if (tid == 0) {
        float m = 0.f;
        for (int c = 0; c < 64; ++c) { const float g = gS[c], ml = mS[c];
            const float mn = fmaxf(g + m, ml); aold[c] = __expf(g + m - mn); anew[c] = __expf(ml - mn);
            gS[c] = m;
            m = mn; }
    }
    __syncthreads();
    if (sl == 0 && tid < 64) WSP(float, WS_MPREV)[bh * 64 + tid] = gS[tid];
    const size_t base = (size_t)bh * 64 * 16384 + (size_t)sl * 2048 + tid * 4;
    const bf16_t* kv = WSP(bf16_t, WS_KVC) + base; bf16_t* cp = WSP(bf16_t, WS_CPREV) + base;
    f32x4 C = {0.f, 0.f, 0.f, 0.f};
#pragma unroll 8
    for (int c = 0; c < 64; ++c) {
        const u32x2 k = *(const u32x2*)(kv + (size_t)c * 16384);
        u32x2 o; o.x = cvtpk(C[0], C[1]); o.y = cvtpk(C[2], C[3]); *(u32x2*)(cp + (size_t)c * 16384) = o;
        const float ao = aold[c], an = anew[c]; DBGF(22, ao); DBGF(23, an); DBGF(24, bflo(k.x)); DBGF(24, bfhi(k.x)); DBGF(24, bflo(k.y)); DBGF(24, bfhi(k.y)); DBGF(25, C[0]);
        C[0] = ao * C[0] + an * bflo(k.x); C[1] = ao * C[1] + an * bfhi(k.x); C[2] = ao * C[2] + an * bflo(k.y); C[3] = ao * C[3] + an * bfhi(k.y);
    }
    if (sl == 0 && tid < 128) {
        float n = 0.f;
        for (int c0 = 0; c0 < 64; c0 += 16) { float nc[16];
#pragma unroll
            for (int i = 0; i < 16; ++i) nc[i] = WSP(float, WS_NC)[(size_t)(bh * 64 + c0 + i) * 128 + tid];
#pragma unroll
            for (int i = 0; i < 16; ++i) { WSP(float, WS_NPREV)[(size_t)(bh * 64 + c0 + i) * 128 + tid] = n; n = aold[c0 + i] * n + anew[c0 + i] * nc[i]; } }
    }
    __syncthreads();
}

struct McPF { u32x4 q0, q1, k0, k1, v0, v1, hq0, hq1, hk0, hk1; float wq, wk, g0, g1, mprev; u32x2 mo[4]; };
__device__ __forceinline__ void mlstm_c_load(Frame& F, int job, int tid, McPF& pf) {
    const int lane = tid & 63, w = F.wave, r32 = lane & 31, hi = lane >> 5;
    const int bh = job >> 6, c = job & 63, b = bh >> 2, h = bh & 3, s0 = c * 64, s = tid >> 3, chg = tid & 7;
    const size_t ro = ((size_t)b * SEQ + s0 + s) * 512 + h * 128 + chg * 16;
    const bf16_t* qp = WSP(bf16_t, WS_MQ) + ro; const bf16_t* kp = WSP(bf16_t, WS_MK) + ro; const bf16_t* vp = WSP(bf16_t, WS_MV) + ro;
    pf.q0 = *(const u32x4*)qp; pf.q1 = *(const u32x4*)(qp + 8); pf.k0 = *(const u32x4*)kp; pf.k1 = *(const u32x4*)(kp + 8); pf.v0 = *(const u32x4*)vp; pf.v1 = *(const u32x4*)(vp + 8);
    pf.hq0 = (u32x4){0u, 0u, 0u, 0u}; pf.hq1 = pf.hq0; pf.hk0 = pf.hq0; pf.hk1 = pf.hq0;
    if (s < 3 && s0 - 3 + s >= 0) { const size_t ho = ((size_t)b * SEQ + s0 - 3 + s) * 512 + h * 128 + chg * 16;
        pf.hq0 = *(const u32x4*)(WSP(bf16_t, WS_MQ) + ho); pf.hq1 = *(const u32x4*)(WSP(bf16_t, WS_MQ) + ho + 8); pf.hk0 = *(const u32x4*)(WSP(bf16_t, WS_MK) + ho); pf.hk1 = *(const u32x4*)(WSP(bf16_t, WS_MK) + ho + 8); }
    pf.wq = IN_F(10)[(tid >> 7) * 1024 + h * 128 + (tid & 127)]; pf.wk = IN_F(10)[(tid >> 7) * 1024 + 512 + h * 128 + (tid & 127)];
    pf.g0 = 0.f; pf.g1 = 0.f;
    if (w == 0) { pf.g0 = WSP(float, WS_GF)[(size_t)bh * SEQ + s0 + lane]; pf.g1 = WSP(float, WS_GI)[(size_t)bh * SEQ + s0 + lane]; }
    if (w == 1) { pf.g0 = WSP(float, WS_NPREV)[(size_t)job * 128 + lane]; pf.g1 = WSP(float, WS_NPREV)[(size_t)job * 128 + 64 + lane]; }
    pf.mprev = WSP(float, WS_MPREV)[job];
    const int tw = w & 1, ew = w >> 1, t = 32 * tw + r32;
    const bf16_t* mo = WSP(bf16_t, WS_MO) + ((size_t)b * SEQ + s0 + t) * 512 + h * 128 + 32 * ew + 4 * hi;
#pragma unroll
    for (int q4 = 0; q4 < 4; ++q4) pf.mo[q4] = *(const u32x2*)(mo + 8 * q4);
}
__device__ __forceinline__ void mlstm_c_phase(Frame& F) {
    int tid = F.tid; asm volatile("" : "+v"(tid));
    const int lane = tid & 63, w = F.wave, r32 = lane & 31, hi = lane >> 5;
    LAS unsigned char* qimg = F.lds; LAS unsigned char* kimg = F.lds + ROWIMG; LAS unsigned char* vimg = F.lds + 2 * ROWIMG;
    LAS float* uS = (LAS float*)(F.lds + 2 * ROWIMG + TRIMG); LAS float* MS = uS + 64; LAS float* bS = uS + 128; LAS float* nS = uS + 192; LAS float* ssq = uS + 320;
    LAS unsigned char* RAWQ = F.lds + 2 * ROWIMG + TRIMG + 4096; LAS unsigned char* RAWK = RAWQ + RAWIMG; LAS float* WLQ = (LAS float*)(RAWK + RAWIMG); LAS float* WLK = WLQ + 512;
    LAS float* HNL = (LAS float*)(F.lds + MISC_OFF + 2048);
    HNL[tid] = IN_F(12)[tid];
    const int tw = w & 1, ew = w >> 1, t = 32 * tw + r32;
    McPF pf;
    int job = F.vcu;
    if (job < 2048) mlstm_c_load(F, job, tid, pf);
    for (; job < 2048; job += F.G) {
        const int bh = job >> 6, c = job & 63, b = bh >> 2, h = bh & 3, s0 = c * 64;
        const float mprev = pf.mprev; u32x2 moc[4];
#pragma unroll
        for (int q4 = 0; q4 < 4; ++q4) moc[q4] = pf.mo[q4];
        {
            const int s = tid >> 3, chg = tid & 7, ch0 = chg * 16;
            *(LAS u32x4*)(RAWQ + (s + 3) * RAWS + chg * 32) = pf.q0; *(LAS u32x4*)(RAWQ + (s + 3) * RAWS + chg * 32 + 16) = pf.q1;
            *(LAS u32x4*)(RAWK + (s + 3) * RAWS + chg * 32) = pf.k0; *(LAS u32x4*)(RAWK + (s + 3) * RAWS + chg * 32 + 16) = pf.k1;
            if (s < 3) { *(LAS u32x4*)(RAWQ + s * RAWS + chg * 32) = pf.hq0; *(LAS u32x4*)(RAWQ + s * RAWS + chg * 32 + 16) = pf.hq1;
                         *(LAS u32x4*)(RAWK + s * RAWS + chg * 32) = pf.hk0; *(LAS u32x4*)(RAWK + s * RAWS + chg * 32 + 16) = pf.hk1; }
            WLQ[tid] = pf.wq; WLK[tid] = pf.wk;
            const unsigned off = (ch0 >> 5) * TRT + s * 64 + (ch0 & 31) * 2;
            *(LAS u32x4*)(vimg + off) = pf.v0; *(LAS u32x4*)(vimg + off + 16) = pf.v1;
            if (w == 0) {
                float bs = pf.g0;
#pragma unroll
                for (int o = 1; o < 64; o <<= 1) { const float x = __shfl_up(bs, o); if (lane >= o) bs += x; }
                const float u = pf.g1 - bs; float cm = u;
#pragma unroll
                for (int o = 1; o < 64; o <<= 1) { const float x = __shfl_up(cm, o); if (lane >= o) cm = fmaxf(cm, x); }
                uS[lane] = u; MS[lane] = fmaxf(mprev, cm); bS[lane] = bs;
            }
            if (w == 1) { nS[lane] = pf.g0; nS[64 + lane] = pf.g1; }
        }
        __syncthreads();
        bf16x8 cf[8];
        { const bf16_t* cp = WSP(bf16_t, WS_CPREV) + (size_t)job * 16384 + (size_t)(32 * ew + r32) * 128 + 8 * hi;
#pragma unroll
          for (int ks = 0; ks < 8; ++ks) cf[ks] = *(const bf16x8*)(cp + 16 * ks); }
        if (job + F.G < 2048) mlstm_c_load(F, job + F.G, tid, pf);
        {
            const int s = tid >> 3, chg = tid & 7, ch0 = chg * 16;
            float qf[16]; conv_lds16(RAWQ, WLQ, s, ch0, 1.f, qf);
            u32x4 q0, q1; q0.x = cvtpk(qf[0], qf[1]); q0.y = cvtpk(qf[2], qf[3]); q0.z = cvtpk(qf[4], qf[5]); q0.w = cvtpk(qf[6], qf[7]);
            q1.x = cvtpk(qf[8], qf[9]); q1.y = cvtpk(qf[10], qf[11]); q1.z = cvtpk(qf[12], qf[13]); q1.w = cvtpk(qf[14], qf[15]);
            *(LAS u32x4*)(qimg + (2 * chg) * RCH + s * 16) = q0; *(LAS u32x4*)(qimg + (2 * chg + 1) * RCH + s * 16) = q1;
            float kf[16]; conv_lds16(RAWK, WLK, s, ch0, 0.08838834764831845f, kf);
            u32x4 k0, k1; k0.x = cvtpk(kf[0], kf[1]); k0.y = cvtpk(kf[2], kf[3]); k0.z = cvtpk(kf[4], kf[5]); k0.w = cvtpk(kf[6], kf[7]);
            k1.x = cvtpk(kf[8], kf[9]); k1.y = cvtpk(kf[10], kf[11]); k1.z = cvtpk(kf[12], kf[13]); k1.w = cvtpk(kf[14], kf[15]);
            *(LAS u32x4*)(kimg + (2 * chg) * RCH + s * 16) = k0; *(LAS u32x4*)(kimg + (2 * chg + 1) * RCH + s * 16) = k1;
        }
        __syncthreads();
        const float Mt = MS[t], bt = bS[t];
        const float dec = __expf(mprev - Mt), mt = bt + Mt;
        bf16x8 qf[8];
#pragma unroll
        for (int ks = 0; ks < 8; ++ks) qf[ks] = *(LAS const bf16x8*)(qimg + (2 * ks + hi) * RCH + t * 16);
        f32x16 p[2]; p[0] = (f32x16){0}; p[1] = (f32x16){0};
#pragma unroll
        for (int st = 0; st < 2; ++st) {
            if (st <= tw) {
#pragma unroll
                for (int ks = 0; ks < 8; ++ks) { const bf16x8 kf = *(LAS const bf16x8*)(kimg + (2 * ks + hi) * RCH + (32 * st + r32) * 16); p[st] = MFMA32(kf, qf[ks], p[st]); }
            }
        }
        float rs = 0.f;
#pragma unroll
        for (int st = 0; st < 2; ++st)
#pragma unroll
            for (int r = 0; r < 16; ++r) { const int s = 32 * st + crow(r, hi);
                const float wv = (s <= t) ? __expf(uS[s] - Mt) * p[st][r] : 0.f; p[st][r] = wv; rs += wv; }
        rs += __shfl_xor(rs, 32);
        float qn = 0.f;
#pragma unroll
        for (int ks = 0; ks < 8; ++ks)
#pragma unroll
            for (int j = 0; j < 8; ++j) qn += bf2f((bf16_t)qf[ks][j]) * nS[16 * ks + 8 * hi + j];
        qn += __shfl_xor(qn, 32);
        const float den = rs + dec * qn;
        const float hden = fmaxf(fabsf(den), __expf(-mt));
        f32x16 ai = {0}, ae = {0};
        const unsigned lo = tr_lane_off(lane);
#pragma unroll
        for (int st = 0; st < 2; ++st) {
            if (st <= tw) {
#pragma unroll
                for (int s2 = 0; s2 < 2; ++s2) { const int ks = 2 * st + s2;
                    const bf16x8 vf = mk8(vtr(vimg + ew * TRT + ks * 1024 + lo), vtr(vimg + ew * TRT + ks * 1024 + lo + 512));
                    u32x4 pw; pw.x = cvtpk(p[st][8 * s2 + 0], p[st][8 * s2 + 1]); pw.y = cvtpk(p[st][8 * s2 + 2], p[st][8 * s2 + 3]); pw.z = cvtpk(p[st][8 * s2 + 4], p[st][8 * s2 + 5]); pw.w = cvtpk(p[st][8 * s2 + 6], p[st][8 * s2 + 7]);
                    ai = MFMA32(vf, __builtin_bit_cast(bf16x8, pw), ai); }
            }
        }
#pragma unroll
        for (int ks = 0; ks < 8; ++ks) ae = MFMA32(cf[ks], qf[ks], ae);
        float hv[16]; float ss = 0.f; const float rden = 1.f / hden;
#pragma unroll
        for (int r = 0; r < 16; ++r) { hv[r] = (ai[r] + dec * ae[r]) * rden; ss += hv[r] * hv[r]; }
        ss += __shfl_xor(ss, 32);
        if (hi == 0) ssq[ew * 64 + t] = ss;
        __syncthreads();
        const float tot = ssq[t] + ssq[64 + t] + ssq[128 + t] + ssq[192 + t];
        const float rn = rsqrtf(tot * (1.f / 128.f) + RMS_EPS);
        LAS const float* hn = HNL + h * 128 + 32 * ew;
        bf16_t* yo = WSP(bf16_t, WS_YCAT) + ((size_t)b * SEQ + s0 + t) * 1024 + h * 128 + 32 * ew;
#pragma unroll
        for (int p2 = 0; p2 < 2; ++p2) { u32x2 ov[2];
#pragma unroll
            for (int e = 0; e < 2; ++e) { const int q4 = 2 * p2 + e; const int e0 = 8 * q4 + 4 * hi;
                const u32x2 om = moc[q4]; const f32x4 wn = *(LAS const f32x4*)(hn + e0);
                const float y0 = hv[4 * q4 + 0] * rn * wn[0] * sigmoid_f(bflo(om.x)), y1 = hv[4 * q4 + 1] * rn * wn[1] * sigmoid_f(bfhi(om.x));
                const float y2 = hv[4 * q4 + 2] * rn * wn[2] * sigmoid_f(bflo(om.y)), y3 = hv[4 * q4 + 3] * rn * wn[3] * sigmoid_f(bfhi(om.y));
                ov[e].x = cvtpk(y0, y1); ov[e].y = cvtpk(y2, y3); }
            *(u32x4*)(yo + 16 * p2 + 8 * hi) = widen_pair(ov[0], ov[1]); }
        __syncthreads();
    }
}

__device__ __forceinline__ void compress_job(Frame& F, int job) {
    int lane = F.lane; asm volatile("" : "+v"(lane));
    const int w = F.wave, r32 = lane & 31, hi = lane >> 5;
    const int kv = job >> 7, bg = (job >> 3) & 15, i0 = (job & 7) * 32;
    const bf16_t* X = WSP(bf16_t, kv ? WS_VC : WS_KC) + (size_t)bg * SEQ * 64;
    const bf16_t* W1 = WSP(bf16_t, kv ? WS_CW1V : WS_CW1K); const bf16_t* W2 = WSP(bf16_t, kv ? WS_CW2V : WS_CW2K);
    const float* c1 = WSP(float, WS_C1B) + kv * 128;
    bf16_t* O = WSP(bf16_t, kv ? WS_VCMP : WS_KCMP) + (size_t)bg * 256 * 64;
    LAS unsigned char* himg = F.lds;
    LAS float* part = (LAS float*)(F.lds + ROWIMG);
    const int nt = w & 3, kh = w >> 2;
    f32x16 acc = {0};
    {
        int i = i0 + r32; if (i > 254) i = 254;
        const bf16_t* ap = X + (size_t)i * 1024 + kh * 1024 + 8 * hi; const bf16_t* bp = W1 + (size_t)(32 * nt + r32) * 2048 + kh * 1024 + 8 * hi;
#pragma unroll 16
        for (int ks = 0; ks < 64; ++ks) { const bf16x8 a = *(const bf16x8*)(ap + 16 * ks), bb = *(const bf16x8*)(bp + 16 * ks); acc = MFMA32(a, bb, acc); }
    }
    if (kh == 1) {
#pragma unroll
        for (int r = 0; r < 16; ++r) part[(nt * 16 + r) * 64 + lane] = acc[r];
    }
    __syncthreads();
    if (kh == 0) {
        const int n = 32 * nt + r32; const float cb = c1[n];
#pragma unroll
        for (int r = 0; r < 16; ++r) { const int rowl = crow(r, hi); const float v = acc[r] + part[(nt * 16 + r) * 64 + lane] + cb;
            *(LAS bf16_t*)(himg + (n >> 3) * RCH + rowl * 16 + (n & 7) * 2) = f2bf(silu_f(v)); }
    }
    __syncthreads();
    if (w < 2) {
        f32x16 a2 = {0};
#pragma unroll
        for (int ks = 0; ks < 8; ++ks) { const bf16x8 a = *(LAS const bf16x8*)(himg + (2 * ks + hi) * RCH + r32 * 16);
            const bf16x8 bb = *(const bf16x8*)(W2 + (size_t)(32 * w + r32) * 128 + 16 * ks + 8 * hi); a2 = MFMA32(a, bb, a2); }
#pragma unroll
        for (int r = 0; r < 16; ++r) { const int i = i0 + crow(r, hi); if (i < 255) O[(size_t)i * 64 + 32 * w + r32] = f2bf(a2[r]); }
    }
    __syncthreads();
}

constexpr int NSA_KCH = 1024 + 16, NSA_VDH = 4096 + 64, NSA_KIMG = 8 * NSA_KCH, NSA_VIMG = 2 * NSA_VDH, NSA_BUF = NSA_KIMG + NSA_VIMG;
constexpr int NSA_IMP = 2 * NSA_BUF, NSA_IST = 65, NSA_TOT = NSA_IMP + 256 * NSA_IST * 4,
              NSA_SELB = MISC_OFF + 1024, NSA_UNI = NSA_SELB + 512;
constexpr int NSA_FAC = NSA_TOT + 64 * NSA_IST * 4;
constexpr int NSA_STASH = 96 * 1024;
static_assert(4 * NSA_BUF <= NSA_STASH && NSA_FAC + 4096 <= MISC_OFF && NSA_STASH + 8 * 4096 <= MISC_OFF, "NSA LDS map");

__device__ __forceinline__ void nsa_qk(LAS const unsigned char* kimg, const bf16x8 (&qr)[4], unsigned kfo, f32x16& p0, f32x16& p1) {
    bf16x8 kf[8];
#pragma unroll
    for (int d0 = 0; d0 < 4; ++d0) { kf[2 * d0] = *(LAS const bf16x8*)(kimg + kfo + d0 * (2 * NSA_KCH)); kf[2 * d0 + 1] = *(LAS const bf16x8*)(kimg + kfo + d0 * (2 * NSA_KCH) + 512); }
    __builtin_amdgcn_sched_barrier(0);
    p0 = (f32x16){0}; p1 = (f32x16){0};
#pragma unroll
    for (int d0 = 0; d0 < 4; ++d0) { p0 = MFMA32(kf[2 * d0], qr[d0], p0); p1 = MFMA32(kf[2 * d0 + 1], qr[d0], p1); }
}
constexpr float NSA_THR = 8.f;
template <int KIND>
__device__ __forceinline__ void nsa_tile(LAS const unsigned char* kimg, LAS const unsigned char* vimg, const bf16x8 (&qr)[4], int kbase, int t, bool edge, bool rowvalid,
                                         float& m, float& l, f32x16& o0, f32x16& o1, unsigned kfo, unsigned vfo, int hi) {
    f32x16 p0, p1; nsa_qk(kimg, qr, kfo, p0, p1);
    if (edge) {
#pragma unroll
        for (int r = 0; r < 16; ++r) { const int k0 = kbase + crow(r, hi), k1 = k0 + 32; bool v0, v1;
            if (KIND == 1) { v0 = k0 <= t; v1 = k1 <= t; } else { v0 = k0 <= t && k0 >= t - 511; v1 = k1 <= t && k1 >= t - 511; }
            p0[r] = v0 ? p0[r] : -INFINITY; p1[r] = v1 ? p1[r] : -INFINITY; }
    }
    float mx = fmaxf(p0[0], p1[0]);
#pragma unroll
    for (int r = 1; r < 16; ++r) mx = fmaxf(mx, fmaxf(p0[r], p1[r]));
    mx = rowvalid ? mx : -INFINITY;
    mx = fmaxf(mx, __shfl_xor(mx, 32));
    if (__any(mx - m > NSA_THR)) {
        const float mn = fmaxf(m, mx); const float alpha = ex2(m - mn); m = mn; l *= alpha;
#pragma unroll
        for (int r = 0; r < 16; ++r) { o0[r] *= alpha; o1[r] *= alpha; }
    }
    const float me = rowvalid ? m : INFINITY;
    float rs = 0.f;
#pragma unroll
    for (int r = 0; r < 16; ++r) { p0[r] = ex2(p0[r] - me); p1[r] = ex2(p1[r] - me); rs += p0[r] + p1[r]; }
    l += rs;
    u32x4 pw[4];
#pragma unroll
    for (int s = 0; s < 2; ++s) {
        pw[s].x = cvtpk(p0[8 * s + 0], p0[8 * s + 1]); pw[s].y = cvtpk(p0[8 * s + 2], p0[8 * s + 3]); pw[s].z = cvtpk(p0[8 * s + 4], p0[8 * s + 5]); pw[s].w = cvtpk(p0[8 * s + 6], p0[8 * s + 7]);
        pw[2 + s].x = cvtpk(p1[8 * s + 0], p1[8 * s + 1]); pw[2 + s].y = cvtpk(p1[8 * s + 2], p1[8 * s + 3]); pw[2 + s].z = cvtpk(p1[8 * s + 4], p1[8 * s + 5]); pw[2 + s].w = cvtpk(p1[8 * s + 6], p1[8 * s + 7]);
    }
    bf16x8 vf[8];
#pragma unroll
    for (int ks = 0; ks < 4; ++ks) { vf[2 * ks] = mk8(vtr(vimg + vfo + ks * 1024), vtr(vimg + vfo + ks * 1024 + 512)); vf[2 * ks + 1] = mk8(vtr(vimg + vfo + NSA_VDH + ks * 1024), vtr(vimg + vfo + NSA_VDH + ks * 1024 + 512)); }
    __builtin_amdgcn_sched_barrier(0);
#pragma unroll
    for (int ks = 0; ks < 4; ++ks) { o0 = MFMA32(vf[2 * ks], __builtin_bit_cast(bf16x8, pw[ks]), o0); o1 = MFMA32(vf[2 * ks + 1], __builtin_bit_cast(bf16x8, pw[ks]), o1); }
}

template <int KIND>
__device__ __forceinline__ void nsa_tile2(LAS const unsigned char* kA, LAS const unsigned char* vA, LAS const unsigned char* kB, LAS const unsigned char* vB, bool hasB,
                                          const bf16x8 (&qr)[4], int kbA, int kbB, int t, bool edgeA, bool edgeB, bool rvA, bool rvB,
                                          float& m, float& l, f32x16& o0, f32x16& o1, unsigned kfo, unsigned vfo, int hi) {
    f32x16 a0, a1, b0, b1;
    nsa_qk(kA, qr, kfo, a0, a1);
    __builtin_amdgcn_sched_barrier(0);
    if (hasB) nsa_qk(kB, qr, kfo, b0, b1);
    else {
#pragma unroll
        for (int r = 0; r < 16; ++r) { b0[r] = -INFINITY; b1[r] = -INFINITY; } }
    if (edgeA) {
#pragma unroll
        for (int r = 0; r < 16; ++r) { const int k0 = kbA + crow(r, hi), k1 = k0 + 32; bool v0, v1;
            if (KIND == 1) { v0 = k0 <= t; v1 = k1 <= t; } else { v0 = k0 <= t && k0 >= t - 511; v1 = k1 <= t && k1 >= t - 511; }
            a0[r] = v0 ? a0[r] : -INFINITY; a1[r] = v1 ? a1[r] : -INFINITY; } }
    if (edgeB) {
#pragma unroll
        for (int r = 0; r < 16; ++r) { const int k0 = kbB + crow(r, hi), k1 = k0 + 32; bool v0, v1;
            if (KIND == 1) { v0 = k0 <= t; v1 = k1 <= t; } else { v0 = k0 <= t && k0 >= t - 511; v1 = k1 <= t && k1 >= t - 511; }
            b0[r] = v0 ? b0[r] : -INFINITY; b1[r] = v1 ? b1[r] : -INFINITY; } }
    __builtin_amdgcn_sched_barrier(0);
    const bool fresh = m < -1e29f; const float mb = fresh ? 0.f : m;
    const float meA = rvA ? mb : INFINITY, meB = rvB ? mb : INFINITY;
#pragma unroll
    for (int r = 0; r < 16; ++r) { a0[r] -= meA; a1[r] -= meA; b0[r] -= meB; b1[r] -= meB; }
    float mx = fmaxf(fmaxf(a0[0], a1[0]), fmaxf(b0[0], b1[0]));
#pragma unroll
    for (int r = 1; r < 16; ++r) mx = fmaxf(mx, fmaxf(fmaxf(a0[r], a1[r]), fmaxf(b0[r], b1[r])));
    mx = fmaxf(mx, __shfl_xor(mx, 32));
    const bool has = mx > -INFINITY;
    const float delta = fresh ? (has ? mx : 0.f) : (mx > NSA_THR ? mx : 0.f);
    if (__any(delta != 0.f)) {
        const float alpha = fresh ? 1.f : ex2(-delta); l *= alpha;
#pragma unroll
        for (int r = 0; r < 16; ++r) { o0[r] *= alpha; o1[r] *= alpha; a0[r] -= delta; a1[r] -= delta; b0[r] -= delta; b1[r] -= delta; }
    }
    m = fresh ? (has ? mx : m) : m + delta;
    float rs = 0.f;
#pragma unroll
    for (int r = 0; r < 16; ++r) { a0[r] = ex2(a0[r]); a1[r] = ex2(a1[r]); b0[r] = ex2(b0[r]); b1[r] = ex2(b1[r]); rs += (a0[r] + a1[r]) + (b0[r] + b1[r]); }
    l += rs;
    __builtin_amdgcn_sched_barrier(0);
    {
        u32x4 pw[4];
#pragma unroll
        for (int s = 0; s < 2; ++s) {
            pw[s].x = cvtpk(a0[8 * s + 0], a0[8 * s + 1]); pw[s].y = cvtpk(a0[8 * s + 2], a0[8 * s + 3]); pw[s].z = cvtpk(a0[8 * s + 4], a0[8 * s + 5]); pw[s].w = cvtpk(a0[8 * s + 6], a0[8 * s + 7]);
            pw[2 + s].x = cvtpk(a1[8 * s + 0], a1[8 * s + 1]); pw[2 + s].y = cvtpk(a1[8 * s + 2], a1[8 * s + 3]); pw[2 + s].z = cvtpk(a1[8 * s + 4], a1[8 * s + 5]); pw[2 + s].w = cvtpk(a1[8 * s + 6], a1[8 * s + 7]); }
        bf16x8 vf[8];
#pragma unroll
        for (int ks = 0; ks < 4; ++ks) { vf[2 * ks] = mk8(vtr(vA + vfo + ks * 1024), vtr(vA + vfo + ks * 1024 + 512)); vf[2 * ks + 1] = mk8(vtr(vA + vfo + NSA_VDH + ks * 1024), vtr(vA + vfo + NSA_VDH + ks * 1024 + 512)); }
        __builtin_amdgcn_sched_barrier(0);
#pragma unroll
        for (int ks = 0; ks < 4; ++ks) { o0 = MFMA32(vf[2 * ks], __builtin_bit_cast(bf16x8, pw[ks]), o0); o1 = MFMA32(vf[2 * ks + 1], __builtin_bit_cast(bf16x8, pw[ks]), o1); }
    }
    __builtin_amdgcn_sched_barrier(0);
    if (hasB) {
        u32x4 pw[4];
#pragma unroll
        for (int s = 0; s < 2; ++s) {
            pw[s].x = cvtpk(b0[8 * s + 0], b0[8 * s + 1]); pw[s].y = cvtpk(b0[8 * s + 2], b0[8 * s + 3]); pw[s].z = cvtpk(b0[8 * s + 4], b0[8 * s + 5]); pw[s].w = cvtpk(b0[8 * s + 6], b0[8 * s + 7]);
            pw[2 + s].x = cvtpk(b1[8 * s + 0], b1[8 * s + 1]); pw[2 + s].y = cvtpk(b1[8 * s + 2], b1[8 * s + 3]); pw[2 + s].z = cvtpk(b1[8 * s + 4], b1[8 * s + 5]); pw[2 + s].w = cvtpk(b1[8 * s + 6], b1[8 * s + 7]); }
        bf16x8 vf[8];
#pragma unroll
        for (int ks = 0; ks < 4; ++ks) { vf[2 * ks] = mk8(vtr(vB + vfo + ks * 1024), vtr(vB + vfo + ks * 1024 + 512)); vf[2 * ks + 1] = mk8(vtr(vB + vfo + NSA_VDH + ks * 1024), vtr(vB + vfo + NSA_VDH + ks * 1024 + 512)); }
        __builtin_amdgcn_sched_barrier(0);
#pragma unroll
        for (int ks = 0; ks < 4; ++ks) { o0 = MFMA32(vf[2 * ks], __builtin_bit_cast(bf16x8, pw[ks]), o0); o1 = MFMA32(vf[2 * ks + 1], __builtin_bit_cast(bf16x8, pw[ks]), o1); }
    }
}

#define NPIN(x) asm volatile("" : "+v"(x))
__device__ __forceinline__ void glds16(const void* g, unsigned lds_base) {
    unsigned sv; asm volatile("s_mov_b32 %0, m0\n\ts_mov_b32 m0, %2\n\ts_nop 0\n\tglobal_load_lds_dwordx4 %1, off\n\ts_mov_b32 m0, %0" : "=&s"(sv) : "v"(g), "s"(lds_base) : "memory"); }
#define NSB() __builtin_amdgcn_sched_barrier(0)
#define NMX3(a, b, c) fmaxf(fmaxf((a), (b)), (c))
__device__ __forceinline__ float nsa_rowmax(const f32x16& p0, const f32x16& p1) {
    float a = NMX3(p0[0], p0[1], p1[0]), b = NMX3(p0[2], p0[3], p1[1]); a = NMX3(a, p1[2], p1[3]);
#pragma unroll
    for (int r = 4; r < 16; r += 4) { a = NMX3(a, p0[r], p0[r + 1]); b = NMX3(b, p0[r + 2], p0[r + 3]); a = NMX3(a, p1[r], p1[r + 1]); b = NMX3(b, p1[r + 2], p1[r + 3]); }
    const float m = fmaxf(a, b); const auto rr = __builtin_amdgcn_permlane32_swap(__float_as_uint(m), __float_as_uint(m), false, false);
    return fmaxf(__uint_as_float(rr[0]), __uint_as_float(rr[1])); }
template <int KIND>
__device__ __forceinline__ void nsa_mask(f32x16& p0, f32x16& p1, int kbase, int t, int hi) {
#pragma unroll
    for (int r = 0; r < 16; ++r) { const int k0 = kbase + crow(r, hi), k1 = k0 + 32; bool v0, v1;
        if (KIND == 1) { v0 = k0 <= t; v1 = k1 <= t; } else { v0 = k0 <= t && k0 >= t - 511; v1 = k1 <= t && k1 >= t - 511; }
        p0[r] = v0 ? p0[r] : -INFINITY; p1[r] = v1 ? p1[r] : -INFINITY; } }
template <int KIND>
__device__ __forceinline__ void nsa_pipe(LAS unsigned char* L, const bf16_t* Kp, const bf16_t* Vp, unsigned mlo, unsigned mhi, unsigned sel0, unsigned sel1,
                                         const bf16x8 (&qr)[4], int t, int lane, int w, int hi, unsigned kfo, unsigned vfo,
                                         float& lsum, f32x16& o0, f32x16& o1) {
    unsigned ulo = mlo, uhi = mhi;
    const bf16_t* ksrc = Kp + lane * 64 + w * 8; const bf16_t* vsrc = Vp + (16 * (w & 3) + (lane >> 2)) * 64 + (w >> 2) * 32 + (lane & 3) * 8;
    const unsigned kdst = (unsigned)(uintptr_t)L + w * NSA_KCH, vdst = (unsigned)(uintptr_t)L + NSA_KIMG + (w >> 2) * NSA_VDH + (w & 3) * 1024;
#define NP_DMA(j, sl) do { glds16(ksrc + (size_t)(j) * 4096, (unsigned)__builtin_amdgcn_readfirstlane(kdst + (sl) * NSA_BUF)); glds16(vsrc + (size_t)(j) * 4096, (unsigned)__builtin_amdgcn_readfirstlane(vdst + (sl) * NSA_BUF)); } while (0)
#define NP_DMAWAIT() asm volatile("s_waitcnt vmcnt(0)" ::: "memory")
    const int n = __builtin_popcount(ulo) + __builtin_popcount(uhi);
#define NP_NEXT(jv) do { jv = -1; if (ulo | uhi) { jv = ulo ? __builtin_ctz(ulo) : 32 + __builtin_ctz(uhi); if (ulo) ulo &= ulo - 1; else uhi &= uhi - 1; } } while (0)
#define NP_SELBIT(j) ((((j) < 32 ? (sel0 >> ((j) & 31)) : (sel1 >> (((j) - 32) & 31))) & 1u) != 0u)
#define NP_KIMG(sl) (L + (sl) * NSA_BUF)
#define NP_VIMG(sl) (L + (sl) * NSA_BUF + NSA_KIMG)
    int jc, jn1, jn2;
    NP_NEXT(jc); NP_NEXT(jn1); NP_NEXT(jn2);
    NP_DMA(jc, 0); if (jn1 >= 0) NP_DMA(jn1, 1); if (jn2 >= 0) NP_DMA(jn2, 2);
    NP_DMAWAIT();
    __syncthreads();
    float m = -1e30f, cin = 0.f, l = 0.f, fsc = 1.f; bool resc = false;
    o0 = (f32x16){0}; o1 = (f32x16){0};
    f32x16 pA0, pA1, pB0, pB1, ci16; bf16x8 kf[8]; s16x4 vlo[8], vhi[8]; u32x4 pw0, pw1, pw2, pw3;
#define NP_KLOAD2(sl, d0) do { kf[2 * (d0)] = *(LAS const bf16x8*)(NP_KIMG(sl) + kfo + (d0) * (2 * NSA_KCH)); kf[2 * (d0) + 1] = *(LAS const bf16x8*)(NP_KIMG(sl) + kfo + (d0) * (2 * NSA_KCH) + 512); } while (0)
#define NP_SPLAT(v) do { _Pragma("unroll") for (int r = 0; r < 16; ++r) ci16[r] = (v); } while (0)
#define NP_CINIT(jt) do { if (KIND == 1) { const float c_ = NP_SELBIT(jt) ? cin : -INFINITY; NP_SPLAT(c_); } } while (0)
#define NP_DECIDE(C0, C1) do { const float rm_ = nsa_rowmax(C0, C1); const bool fresh_ = m < -1e29f; \
        const bool grow_ = fresh_ ? (rm_ > -INFINITY) : (rm_ > NSA_THR); resc = false; \
        if (__any(grow_)) { const float dl_ = grow_ ? rm_ : 0.f; fsc = (grow_ && !fresh_) ? ex2(-rm_) : 1.f; m = grow_ ? (fresh_ ? rm_ : m + rm_) : m; cin = grow_ ? -m : cin; l *= fsc; resc = true; \
            _Pragma("unroll") for (int r = 0; r < 16; ++r) { C0[r] -= dl_; C1[r] -= dl_; } \
            if (KIND == 2) NP_SPLAT(cin); } } while (0)
    { _Pragma("unroll") for (int d0 = 0; d0 < 4; ++d0) NP_KLOAD2(0, d0);
      if (KIND == 2) NP_SPLAT(0.f); else NP_CINIT(jc);
      NSB();
      pA0 = MFMA32(kf[0], qr[0], ci16); pA1 = MFMA32(kf[1], qr[0], ci16);
      _Pragma("unroll") for (int d0 = 1; d0 < 4; ++d0) { pA0 = MFMA32(kf[2 * d0], qr[d0], pA0); pA1 = MFMA32(kf[2 * d0 + 1], qr[d0], pA1); }
      nsa_mask<KIND>(pA0, pA1, 64 * jc, t, hi);
      NP_DECIDE(pA0, pA1);
      _Pragma("unroll") for (int r = 0; r < 16; ++r) { pA0[r] = ex2(pA0[r]); pA1[r] = ex2(pA1[r]); }
      if (jn1 >= 0) { _Pragma("unroll") for (int d0 = 0; d0 < 4; ++d0) NP_KLOAD2(1, d0); }
      jc = jn1; jn1 = jn2; NP_NEXT(jn2); }
    int s = 1;
#define NP_PKW(P, i) cvtpk(P[i], P[(i) + 1])
#define NP_VFR(i) mk8(vlo[i], vhi[i])
#define NP_VRD(i) do { LAS const unsigned char* a_ = vp_ + ((i) >> 1) * 1024 + ((i) & 1) * NSA_VDH; vlo[i] = vtr(a_); vhi[i] = vtr(a_ + 512); } while (0)
#define NP_GAPA(MF, a0, a1, a2, a3, W0, W1, PW) do { MF; sacc += a0; sacc += a1; sacc += a2; sacc += a3; W0; W1; NPIN(PW); NPIN(sacc); NSB(); } while (0)
#define NP_GAPB(MF, X, i) do { MF; X[i] = ex2(X[i]); X[(i) + 1] = ex2(X[(i) + 1]); X[(i) + 2] = ex2(X[(i) + 2]); X[(i) + 3] = ex2(X[(i) + 3]); NPIN(X); NSB(); } while (0)
#define NP_KRD(GL, d0) do { if (GL) { NP_KLOAD2(sn_, d0); NSB(); } } while (0)
#define NP_STEP(C0, C1, P0, P1, LAST) do { NSB(); \
    const int sp_ = (s - 1) & 3, sn_ = (s + 1) & 3, sw_ = (s + 2) & 3; \
    if (!(LAST) && jn2 >= 0) NP_DMA(jn2, sw_);     \
    LAS const unsigned char* vp_ = NP_VIMG(sp_) + vfo; \
    NP_CINIT(jc); \
    float sacc = P0[0] + P0[1]; NSB(); \
    NP_GAPA(C0 = MFMA32(kf[0], qr[0], ci16), P0[2], P0[3], P0[4], P0[5],     pw0[0] = NP_PKW(P0, 0),  pw0[1] = NP_PKW(P0, 2),  pw0); \
    NP_GAPA(C1 = MFMA32(kf[1], qr[0], ci16), P0[6], P0[7], P0[8], P0[9],     pw0[2] = NP_PKW(P0, 4),  pw0[3] = NP_PKW(P0, 6),  pw0); \
    NP_GAPA(C0 = MFMA32(kf[2], qr[1], C0),            P0[10], P0[11], P0[12], P0[13], pw1[0] = NP_PKW(P0, 8),  pw1[1] = NP_PKW(P0, 10), pw1); \
    NP_GAPA(C1 = MFMA32(kf[3], qr[1], C1),            P0[14], P0[15], P1[0], P1[1],   pw1[2] = NP_PKW(P0, 12), pw1[3] = NP_PKW(P0, 14), pw1); \
    NP_GAPA(C0 = MFMA32(kf[4], qr[2], C0),            P1[2], P1[3], P1[4], P1[5],     pw2[0] = NP_PKW(P1, 0),  pw2[1] = NP_PKW(P1, 2),  pw2); \
    NP_GAPA(C1 = MFMA32(kf[5], qr[2], C1),            P1[6], P1[7], P1[8], P1[9],     pw2[2] = NP_PKW(P1, 4),  pw2[3] = NP_PKW(P1, 6),  pw2); \
    NP_GAPA(C0 = MFMA32(kf[6], qr[3], C0),            P1[10], P1[11], P1[12], P1[13], pw3[0] = NP_PKW(P1, 8),  pw3[1] = NP_PKW(P1, 10), pw3); \
    NP_GAPA(C1 = MFMA32(kf[7], qr[3], C1),            P1[14], P1[15], 0.f, 0.f,       pw3[2] = NP_PKW(P1, 12), pw3[3] = NP_PKW(P1, 14), pw3); \
    l += sacc; \
    NP_VRD(0); NP_VRD(1); NP_VRD(2); NP_VRD(3); NSB();     \
    if (LAST) nsa_mask<KIND>(C0, C1, 64 * jc, t, hi); \
    NP_DECIDE(C0, C1); NSB(); \
    NP_VRD(4); NSB(); NP_GAPB(o0 = MFMA32(NP_VFR(0), __builtin_bit_cast(bf16x8, pw0), o0), C0, 0); \
    NP_VRD(5); NSB(); NP_GAPB(o1 = MFMA32(NP_VFR(1), __builtin_bit_cast(bf16x8, pw0), o1), C0, 4); \
    NP_VRD(6); NSB(); NP_KRD(!(LAST), 0); NP_GAPB(o0 = MFMA32(NP_VFR(2), __builtin_bit_cast(bf16x8, pw1), o0), C0, 8); \
    NP_VRD(7); NSB(); NP_KRD(!(LAST), 1); NP_GAPB(o1 = MFMA32(NP_VFR(3), __builtin_bit_cast(bf16x8, pw1), o1), C0, 12); \
    NP_KRD(!(LAST), 2); NP_GAPB(o0 = MFMA32(NP_VFR(4), __builtin_bit_cast(bf16x8, pw2), o0), C1, 0); \
    NP_KRD(!(LAST), 3); NP_GAPB(o1 = MFMA32(NP_VFR(5), __builtin_bit_cast(bf16x8, pw2), o1), C1, 4); \
    NP_GAPB(o0 = MFMA32(NP_VFR(6), __builtin_bit_cast(bf16x8, pw3), o0), C1, 8);  NP_GAPB(o1 = MFMA32(NP_VFR(7), __builtin_bit_cast(bf16x8, pw3), o1), C1, 12); \
    NP_DMAWAIT(); \
    __syncthreads(); \
    if (resc) { _Pragma("unroll") for (int r = 0; r < 16; ++r) { o0[r] *= fsc; o1[r] *= fsc; } } \
    jc = jn1; jn1 = jn2; NP_NEXT(jn2); ++s; } while (0)
    int rem = n - 1;
    if (n & 1) { pB0 = pA0; pB1 = pA1; if (rem > 0) { NP_STEP(pA0, pA1, pB0, pB1, false); --rem; } }
    while (rem >= 3) { NP_STEP(pB0, pB1, pA0, pA1, false); NP_STEP(pA0, pA1, pB0, pB1, false); rem -= 2; }
    if (rem == 1) { NP_STEP(pB0, pB1, pA0, pA1, true); }
    { float sacc = pB0[0] + pB0[1];
      _Pragma("unroll") for (int r = 2; r < 16; ++r) sacc += pB0[r];
      _Pragma("unroll") for (int r = 0; r < 16; ++r) sacc += pB1[r];
      l += sacc;
      pw0 = (u32x4){NP_PKW(pB0, 0), NP_PKW(pB0, 2), NP_PKW(pB0, 4), NP_PKW(pB0, 6)}; pw1 = (u32x4){NP_PKW(pB0, 8), NP_PKW(pB0, 10), NP_PKW(pB0, 12), NP_PKW(pB0, 14)};
      pw2 = (u32x4){NP_PKW(pB1, 0), NP_PKW(pB1, 2), NP_PKW(pB1, 4), NP_PKW(pB1, 6)}; pw3 = (u32x4){NP_PKW(pB1, 8), NP_PKW(pB1, 10), NP_PKW(pB1, 12), NP_PKW(pB1, 14)};
      LAS const unsigned char* vp_ = NP_VIMG((n - 1) & 3) + vfo;
      _Pragma("unroll") for (int i = 0; i < 8; ++i) NP_VRD(i);
      NSB();
      o0 = MFMA32(NP_VFR(0), __builtin_bit_cast(bf16x8, pw0), o0); o1 = MFMA32(NP_VFR(1), __builtin_bit_cast(bf16x8, pw0), o1);
      o0 = MFMA32(NP_VFR(2), __builtin_bit_cast(bf16x8, pw1), o0); o1 = MFMA32(NP_VFR(3), __builtin_bit_cast(bf16x8, pw1), o1);
      o0 = MFMA32(NP_VFR(4), __builtin_bit_cast(bf16x8, pw2), o0); o1 = MFMA32(NP_VFR(5), __builtin_bit_cast(bf16x8, pw2), o1);
      o0 = MFMA32(NP_VFR(6), __builtin_bit_cast(bf16x8, pw3), o0); o1 = MFMA32(NP_VFR(7), __builtin_bit_cast(bf16x8, pw3), o1); }
    __syncthreads();
    lsum = l;
#undef NP_DMA
#undef NP_DMAWAIT
#undef NP_NEXT
#undef NP_SELBIT
#undef NP_KIMG
#undef NP_VIMG
#undef NP_KLOAD2
#undef NP_SPLAT
#undef NP_CINIT
#undef NP_DECIDE
#undef NP_PKW
#undef NP_VFR
#undef NP_VRD
#undef NP_GAPA
#undef NP_GAPB
#undef NP_KRD
#undef NP_STEP
}

__device__ __forceinline__ void nsa_unit(Frame& F, int b, int g, int qb) {
    int tid = F.tid; asm volatile("" : "+v"(tid));
    const int lane = tid & 63, w = F.wave, r32 = lane & 31, hi = lane >> 5;
    const int hh = 4 * g + (w & 3), th = w >> 2, cur = qb, T0 = qb * 64, tokl = 32 * th + r32, t = T0 + tokl;
    const size_t row = (size_t)b * SEQ + t; const int bg = b * 2 + g;
    LAS unsigned char* L = F.lds;
    bf16x8 qr[4];
    { const bf16_t* qp = WSP(bf16_t, WS_NQ) + row * 512 + hh * 64 + 8 * hi;
#pragma unroll
      for (int d0 = 0; d0 < 4; ++d0) qr[d0] = *(const bf16x8*)(qp + 16 * d0); }
    const float* gp = WSP(float, WS_NGT) + row * 24 + hh * 3; const float gate_c = gp[0], gate_s = gp[1], gate_w = gp[2];
    unsigned outp0[8], outp1[8];
    const unsigned kst = (tid & 7) * NSA_KCH + (tid >> 3) * 16, vst = ((tid & 7) >> 2) * NSA_VDH + (tid >> 3) * 64 + (tid & 3) * 16;
    const unsigned kfo = hi * NSA_KCH + r32 * 16, vfo = tr_lane_off(lane);
    float m, l; f32x16 o0, o1;
    u32x4 rk, rv;
#define NSA_LOAD(Kp, Vp, tile) do { rk = *(const u32x4*)((Kp) + (size_t)(tile) * 4096 + tid * 8); rv = *(const u32x4*)((Vp) + (size_t)(tile) * 4096 + tid * 8); } while (0)
#define NSA_WRITE(buf) do { *(LAS u32x4*)(L + (buf) * NSA_BUF + kst) = rk; *(LAS u32x4*)(L + (buf) * NSA_BUF + NSA_KIMG + vst) = rv; } while (0)
#define NSA_NEXT(jv) do { jv = -1; if (ulo | uhi) { jv = ulo ? __builtin_ctz(ulo) : 32 + __builtin_ctz(uhi); if (ulo) ulo &= ulo - 1; else uhi &= uhi - 1; } } while (0)
#define NSA_RUN(Kp, Vp, MLO, MHI, ...) do { unsigned ulo = (MLO), uhi = (MHI); int j, j1, j2; u32x4 rk2, rv2; \
        NSA_NEXT(j); NSA_LOAD(Kp, Vp, j); NSA_WRITE(0); NSA_NEXT(j1); if (j1 >= 0) NSA_LOAD(Kp, Vp, j1); __syncthreads(); int buf = 0; \
        for (;;) { NSA_NEXT(j2); if (j2 >= 0) { rk2 = *(const u32x4*)((Kp) + (size_t)j2 * 4096 + tid * 8); rv2 = *(const u32x4*)((Vp) + (size_t)j2 * 4096 + tid * 8); } \
            { LAS const unsigned char* KI = L + buf * NSA_BUF; LAS const unsigned char* VI = KI + NSA_KIMG; __VA_ARGS__ } \
            if (j1 >= 0) NSA_WRITE(buf ^ 1); __syncthreads(); if (j1 < 0) break; j = j1; j1 = j2; rk = rk2; rv = rv2; buf ^= 1; } } while (0)
#define NSA_LOAD2(Kp, Vp, ja, jb) do { rk = *(const u32x4*)((Kp) + (size_t)(ja) * 4096 + tid * 8); rv = *(const u32x4*)((Vp) + (size_t)(ja) * 4096 + tid * 8); \
        if ((jb) >= 0) { rkB = *(const u32x4*)((Kp) + (size_t)(jb) * 4096 + tid * 8); rvB = *(const u32x4*)((Vp) + (size_t)(jb) * 4096 + tid * 8); } } while (0)
#define NSA_WRITE2(pb, jb) do { LAS unsigned char* P_ = L + (pb) * (2 * NSA_BUF); *(LAS u32x4*)(P_ + kst) = rk; *(LAS u32x4*)(P_ + NSA_KIMG + vst) = rv; \
        if ((jb) >= 0) { *(LAS u32x4*)(P_ + NSA_BUF + kst) = rkB; *(LAS u32x4*)(P_ + NSA_BUF + NSA_KIMG + vst) = rvB; } } while (0)
#define NSA_RUN2(Kp, Vp, MLO, MHI, ...) do { unsigned ulo = (MLO), uhi = (MHI); int ja, jb, na, nb; u32x4 rkB, rvB; \
        NSA_NEXT(ja); NSA_NEXT(jb); NSA_LOAD2(Kp, Vp, ja, jb); NSA_WRITE2(0, jb); __syncthreads(); int pbuf = 0; \
        for (;;) { NSA_NEXT(na); NSA_NEXT(nb); if (na >= 0) NSA_LOAD2(Kp, Vp, na, nb); \
            { LAS const unsigned char* KA = L + pbuf * (2 * NSA_BUF); LAS const unsigned char* VA = KA + NSA_KIMG; LAS const unsigned char* KB = KA + NSA_BUF; LAS const unsigned char* VB = KB + NSA_KIMG; __VA_ARGS__ } \
            if (na >= 0) NSA_WRITE2(pbuf ^ 1, nb); __syncthreads(); if (na < 0) break; ja = na; jb = nb; pbuf ^= 1; } } while (0)
#define NSA_LT(lv) ({ const auto rr_ = __builtin_amdgcn_permlane32_swap(__float_as_uint(lv), __float_as_uint(lv), false, false); __uint_as_float(rr_[0]) + __uint_as_float(rr_[1]); })
#define NSA_RESET() do { m = -1e30f; l = 0.f; o0 = (f32x16){0}; o1 = (f32x16){0}; } while (0)

    const bf16_t* Kc = WSP(bf16_t, WS_KCMP) + (size_t)bg * 256 * 64; const bf16_t* Vc = WSP(bf16_t, WS_VCMP) + (size_t)bg * 256 * 64;
    const int ntc = ((4 * cur + 2) >> 6) + 1; const int lim = (t >= 31) ? ((t - 31) >> 4) : -1;
    const int tmin_w = T0 + 32 * th; const int lim_min = (tmin_w >= 31) ? ((tmin_w - 31) >> 4) : -1;
    unsigned sel0, sel1, un0, un1;
    {
        LAS float* IMP = (LAS float*)(L + NSA_IMP); LAS float* FAC = (LAS float*)(L + NSA_FAC);
        float carry = 0.f; const bool need_imp = cur >= 16;
        float mt0 = 0.f, mt1 = 0.f, mt2 = 0.f, mt3 = 0.f;
        m = -1e30f; l = 0.f; o0 = (f32x16){0}; o1 = (f32x16){0};
        NSA_RUN(Kc, Vc, (1u << ntc) - 1u, 0u, {
            f32x16 p0, p1; nsa_qk(KI, qr, kfo, p0, p1);
            if (64 * j + 63 > lim_min) {
                _Pragma("unroll") for (int r = 0; r < 16; ++r) { const int k0 = 64 * j + crow(r, hi);
                    p0[r] = (k0 <= lim) ? p0[r] : -INFINITY; p1[r] = (k0 + 32 <= lim) ? p1[r] : -INFINITY; } }
            { const float rm = nsa_rowmax(p0, p1); const bool fresh = m < -1e29f; const bool grow = fresh ? (rm > -INFINITY) : (rm - m > NSA_THR);
              if (__any(grow)) { const float mn = grow ? rm : m; const float f = (grow && !fresh) ? ex2(m - mn) : 1.f; m = mn; l *= f; carry *= f;
                  _Pragma("unroll") for (int r = 0; r < 16; ++r) { o0[r] *= f; o1[r] *= f; } } }
            if (j == 0) mt0 = m; else if (j == 1) mt1 = m; else if (j == 2) mt2 = m; else mt3 = m;
            { float rs = 0.f;
              _Pragma("unroll") for (int r = 0; r < 16; ++r) { p0[r] = ex2(p0[r] - m); p1[r] = ex2(p1[r] - m); rs += p0[r] + p1[r]; }
              l += rs; }
            if (need_imp) {
                _Pragma("unroll") for (int n = 0; n < 2; ++n) {
                    float a[4], bq[4], pb[4];
                    _Pragma("unroll") for (int q4 = 0; q4 < 4; ++q4) { const float x0 = n ? p1[4 * q4] : p0[4 * q4], x1 = n ? p1[4 * q4 + 1] : p0[4 * q4 + 1], x2 = n ? p1[4 * q4 + 2] : p0[4 * q4 + 2], x3 = n ? p1[4 * q4 + 3] : p0[4 * q4 + 3];
                        a[q4] = 2.f * (x0 + x1 + x2) + x3; bq[q4] = x3; }
                    _Pragma("unroll") for (int q4 = 0; q4 < 4; ++q4) pb[q4] = __shfl_xor(bq[q4], 32);
                    _Pragma("unroll") for (int q4 = 0; q4 < 4; ++q4) { const float prevb = hi ? pb[q4] : (q4 ? pb[q4 > 0 ? q4 - 1 : 0] : carry);
                        IMP[((w & 3) * 64 + tokl) * NSA_IST + 16 * j + 8 * n + 2 * q4 + hi] = a[q4] + prevb; }
                    carry = pb[3];
                } }
            u32x4 pw[4];
            _Pragma("unroll") for (int s = 0; s < 2; ++s) {
                pw[s].x = cvtpk(p0[8 * s + 0], p0[8 * s + 1]); pw[s].y = cvtpk(p0[8 * s + 2], p0[8 * s + 3]); pw[s].z = cvtpk(p0[8 * s + 4], p0[8 * s + 5]); pw[s].w = cvtpk(p0[8 * s + 6], p0[8 * s + 7]);
                pw[2 + s].x = cvtpk(p1[8 * s + 0], p1[8 * s + 1]); pw[2 + s].y = cvtpk(p1[8 * s + 2], p1[8 * s + 3]); pw[2 + s].z = cvtpk(p1[8 * s + 4], p1[8 * s + 5]); pw[2 + s].w = cvtpk(p1[8 * s + 6], p1[8 * s + 7]); }
            _Pragma("unroll") for (int ks = 0; ks < 4; ++ks) {
                const bf16x8 v0 = mk8(vtr(VI + vfo + ks * 1024), vtr(VI + vfo + ks * 1024 + 512));
                const bf16x8 v1 = mk8(vtr(VI + vfo + NSA_VDH + ks * 1024), vtr(VI + vfo + NSA_VDH + ks * 1024 + 512));
                o0 = MFMA32(v0, __builtin_bit_cast(bf16x8, pw[ks]), o0); o1 = MFMA32(v1, __builtin_bit_cast(bf16x8, pw[ks]), o1); } });
        const float inv_c = 1.f / fmaxf(NSA_LT(l), 1e-30f); const float gs_ = gate_c * inv_c;
        _Pragma("unroll") for (int r = 0; r < 8; ++r) { outp0[r] = cvtpk(gs_ * o0[2 * r], gs_ * o0[2 * r + 1]); outp1[r] = cvtpk(gs_ * o1[2 * r], gs_ * o1[2 * r + 1]); }
        if (need_imp) {
            if (hi == 0) { f32x4 fc; fc[0] = ex2(mt0 - m) * inv_c; fc[1] = ntc > 1 ? ex2(mt1 - m) * inv_c : 0.f; fc[2] = ntc > 2 ? ex2(mt2 - m) * inv_c : 0.f; fc[3] = ntc > 3 ? ex2(mt3 - m) * inv_c : 0.f;
                *(LAS f32x4*)(FAC + ((w & 3) * 64 + tokl) * 4) = fc; }
            __syncthreads(); }
    }
    if (cur >= 16) {
        LAS float* IMP = (LAS float*)(L + NSA_IMP);
        LAS unsigned* TOT = (LAS unsigned*)(L + NSA_TOT); LAS unsigned char* SELB = L + NSA_SELB; LAS unsigned* UNI = (LAS unsigned*)(L + NSA_UNI);
        { const int tk = tid >> 3, jg = tid & 7; LAS const float* FAC = (LAS const float*)(L + NSA_FAC);
          float fq[4];
#pragma unroll
          for (int h4 = 0; h4 < 4; ++h4) fq[h4] = FAC[(h4 * 64 + tk) * 4 + (jg >> 1)];
#pragma unroll
          for (int jj = 0; jj < 8; ++jj) { const int jx = 8 * jg + jj;
              const float tot = ((IMP[tk * NSA_IST + jx] * fq[0] + IMP[(64 + tk) * NSA_IST + jx] * fq[1]) + IMP[(128 + tk) * NSA_IST + jx] * fq[2]) + IMP[(192 + tk) * NSA_IST + jx] * fq[3];
              TOT[tk * NSA_IST + jx] = (__float_as_uint(tot) & ~63u) | (unsigned)(63 - jx); }
          if (tid < 2) UNI[tid] = 0u; }
        __syncthreads();
        { const int tk = tid >> 3, jg = tid & 7; unsigned bits = 0u;
          unsigned v[8]; int rank[8];
#pragma unroll
          for (int jj = 0; jj < 8; ++jj) { v[jj] = TOT[tk * NSA_IST + 8 * jg + jj]; rank[jj] = 0; }
#pragma unroll 4
          for (int k2 = 1; k2 <= cur - 2; ++k2) { const unsigned v2 = TOT[tk * NSA_IST + k2];
#pragma unroll
              for (int jj = 0; jj < 8; ++jj) rank[jj] += (int)(v2 > v[jj]); }
#pragma unroll
          for (int jj = 0; jj < 8; ++jj) { const int jx = 8 * jg + jj;
              const bool s = (jx == 0 || jx == cur || jx == cur - 1) || (jx < cur - 1 && rank[jj] < 13);
              bits |= s ? (1u << jj) : 0u; }
          SELB[tk * 8 + jg] = (unsigned char)bits;
          atomicOr((unsigned*)&UNI[jg >> 2], bits << (8 * (jg & 3))); }
        __syncthreads();
        sel0 = *(LAS const unsigned*)(SELB + tokl * 8); sel1 = *(LAS const unsigned*)(SELB + tokl * 8 + 4);
        un0 = __builtin_amdgcn_readfirstlane(UNI[0]); un1 = __builtin_amdgcn_readfirstlane(UNI[1]);
    } else {
        sel0 = (1u << (cur + 1)) - 1u; sel1 = 0u; un0 = sel0; un1 = 0u;
    }
    LAS unsigned* ST = (LAS unsigned*)(L + NSA_STASH + w * 4096) + lane;
#pragma unroll
    for (int r = 0; r < 8; ++r) { ST[r * 64] = outp0[r]; ST[(8 + r) * 64] = outp1[r]; }
    const bf16_t* Ks = WSP(bf16_t, WS_KSL) + (size_t)bg * SEQ * 64; const bf16_t* Vs = WSP(bf16_t, WS_VSL) + (size_t)bg * SEQ * 64;
    NDUP(3) nsa_pipe<1>(L, Ks, Vs, un0, un1, sel0, sel1, qr, t, lane, w, hi, kfo, vfo, l, o0, o1);
    { const float sc = gate_s / fmaxf(NSA_LT(l), 1e-30f);
#pragma unroll
      for (int r = 0; r < 8; ++r) { const unsigned a = ST[r * 64], c = ST[(8 + r) * 64];
          ST[r * 64] = cvtpk(bflo(a) + sc * o0[2 * r], bfhi(a) + sc * o0[2 * r + 1]); ST[(8 + r) * 64] = cvtpk(bflo(c) + sc * o1[2 * r], bfhi(c) + sc * o1[2 * r + 1]); } }
    const bf16_t* Kw = WSP(bf16_t, WS_KWN) + (size_t)bg * SEQ * 64; const bf16_t* Vw = WSP(bf16_t, WS_VWN) + (size_t)bg * SEQ * 64;
    { const int jlo = cur >= 8 ? cur - 8 : 0;
      const unsigned long long wm = ((cur == 63) ? ~0ull : ((1ull << (cur + 1)) - 1ull)) & ~((1ull << jlo) - 1ull);
      NDUP(4) nsa_pipe<2>(L, Kw, Vw, (unsigned)wm, (unsigned)(wm >> 32), 0u, 0u, qr, t, lane, w, hi, kfo, vfo, l, o0, o1); }
    { const float sc = gate_w / fmaxf(NSA_LT(l), 1e-30f);
      bf16_t* yo = WSP(bf16_t, WS_YCAT) + row * 1024 + 512 + hh * 64;
#pragma unroll
      for (int p2 = 0; p2 < 2; ++p2) { u32x2 av[2], cv[2];
#pragma unroll
          for (int e = 0; e < 2; ++e) { const int q4 = 2 * p2 + e;
              const unsigned a0 = ST[(2 * q4) * 64], a1 = ST[(2 * q4 + 1) * 64], c0 = ST[(8 + 2 * q4) * 64], c1 = ST[(9 + 2 * q4) * 64];
              av[e].x = cvtpk(bflo(a0) + sc * o0[4 * q4], bfhi(a0) + sc * o0[4 * q4 + 1]); av[e].y = cvtpk(bflo(a1) + sc * o0[4 * q4 + 2], bfhi(a1) + sc * o0[4 * q4 + 3]);
              cv[e].x = cvtpk(bflo(c0) + sc * o1[4 * q4], bfhi(c0) + sc * o1[4 * q4 + 1]); cv[e].y = cvtpk(bflo(c1) + sc * o1[4 * q4 + 2], bfhi(c1) + sc * o1[4 * q4 + 3]); }
          *(u32x4*)(yo + 16 * p2 + 8 * hi) = widen_pair(av[0], av[1]); *(u32x4*)(yo + 32 + 16 * p2 + 8 * hi) = widen_pair(cv[0], cv[1]); } }
#undef NSA_LOAD
#undef NSA_WRITE
#undef NSA_RUN
#undef NSA_RUN2
#undef NSA_LOAD2
#undef NSA_WRITE2
#undef NSA_LT
#undef NSA_RESET
}

__device__ __forceinline__ void s6_phase(Frame& F) {
    int tid = F.tid; asm volatile("" : "+v"(tid));
    const int lane = tid & 63, w = F.wave;
    LAS unsigned char* TILE = F.lds + w * 16384;
    LAS float* LG = (LAS float*)(F.lds + MISC_OFF + 4096) + w * (8 * 48);
    LAS int* REC_E = (LAS int*)(F.lds + MISC_OFF + 16384);
    LAS float* REC_G = (LAS float*)(F.lds + MISC_OFF + 16384 + 1024);
    LAS int* REC_P = (LAS int*)(F.lds + MISC_OFF + 16384 + 2048);
    LAS int* CNTL = (LAS int*)(F.lds + MISC_OFF + 16384 + 3072);
    LAS float* SAW = (LAS float*)(F.lds + MISC_OFF + 16384 + 3584);
    const float* x = IN_F(0); const float* wpost = IN_F(6); const float* wffn = IN_F(7); const float* mod = WSP(float, WS_MOD);
    const bf16_t* Y = WSP(bf16_t, WS_Y); bf16_t* X1B = WSP(bf16_t, WS_X1B); signed char* H2Q = (signed char*)(F.ws + WS_H2Q); float* SAv = WSP(float, WS_SA); const _Float16* RWT = WSP(_Float16, WS_RWT);
    const float* bgp = IN_F(21); const float* bep = IN_F(23);
    unsigned* cntg = (unsigned*)(F.ws + WS_CTL) + CW_CNT;
    for (int rb = F.vcu; rb < NTOK / 128; rb += F.G) {
        if (tid < 64) CNTL[tid] = 0;
        __syncthreads();
        const int rbase = rb * 128 + w * 16, b = rbase >> 12;
        f32x4 xv[4][4]; u32x4 yw[4][2];
#define S6_LOAD(g) do { _Pragma("unroll") for (int r = 0; r < 4; ++r) { const size_t ro_ = (size_t)(rbase + 4 * (g) + r) * DM; \
            _Pragma("unroll") for (int j = 0; j < 4; ++j) xv[r][j] = __builtin_nontemporal_load((const f32x4*)(x + ro_ + 4 * lane + 256 * j)); \
            _Pragma("unroll") for (int jp = 0; jp < 2; ++jp) yw[r][jp] = __builtin_nontemporal_load((const u32x4*)(Y + ro_ + 4 * (lane & ~1) + 256 * (2 * jp + (lane & 1)))); } } while (0)
#define S6_Y(r, j) ((f32x4){bflo(yr[r][j].x), bfhi(yr[r][j].x), bflo(yr[r][j].y), bfhi(yr[r][j].y)})
        S6_LOAD(0);
#pragma nounroll
        for (int g = 0; g < 4; ++g) {
            u32x2 yr[4][4];
#pragma unroll
            for (int r = 0; r < 4; ++r)
#pragma unroll
                for (int jp = 0; jp < 2; ++jp) pair_narrow(yw[r][jp], lane, yr[r][2 * jp], yr[r][2 * jp + 1]);
            int l4 = 4 * lane; asm volatile("" : "+v"(l4));
            float ss[4];
#pragma unroll
            for (int r = 0; r < 4; ++r) { float a2 = 0.f;
#pragma unroll
                for (int j = 0; j < 4; ++j) { const f32x4 y = S6_Y(r, j); a2 += y[0] * y[0] + y[1] * y[1] + y[2] * y[2] + y[3] * y[3]; }
                ss[r] = a2; }
#pragma unroll
            for (int o = 1; o < 64; o <<= 1) {
#pragma unroll
                for (int r = 0; r < 4; ++r) ss[r] += __shfl_xor(ss[r], o); }
            float s2[4] = {0.f, 0.f, 0.f, 0.f};
#pragma unroll
            for (int j = 0; j < 4; ++j) { const int k = l4 + 256 * j;
                const f32x4 wp = *(const f32x4*)(wpost + k), gm = *(const f32x4*)(mod + b * 6144 + 2048 + k); const f32x4 gw2 = gm * wp;
#pragma unroll
                for (int r = 0; r < 4; ++r) { const float r1 = rsqrtf(ss[r] * (1.f / DM) + RMS_EPS);
                    xv[r][j] = xv[r][j] + gw2 * (S6_Y(r, j) * r1);
                    s2[r] += xv[r][j][0] * xv[r][j][0] + xv[r][j][1] * xv[r][j][1] + xv[r][j][2] * xv[r][j][2] + xv[r][j][3] * xv[r][j][3]; } }
#pragma unroll
            for (int r = 0; r < 4; ++r)
#pragma unroll
                for (int jp = 0; jp < 2; ++jp) { u32x2 pa, pb; pa.x = cvtpk(xv[r][2 * jp][0], xv[r][2 * jp][1]); pa.y = cvtpk(xv[r][2 * jp][2], xv[r][2 * jp][3]);
                    pb.x = cvtpk(xv[r][2 * jp + 1][0], xv[r][2 * jp + 1][1]); pb.y = cvtpk(xv[r][2 * jp + 1][2], xv[r][2 * jp + 1][3]);
                    __builtin_nontemporal_store(pair_widen(pa, pb, lane), (u32x4*)(X1B + (size_t)(rbase + 4 * g + r) * DM + 4 * (lane & ~1) + 256 * (2 * jp + (lane & 1)))); }
#pragma unroll
            for (int o = 1; o < 64; o <<= 1) {
#pragma unroll
                for (int r = 0; r < 4; ++r) s2[r] += __shfl_xor(s2[r], o); }
#pragma unroll
            for (int j = 0; j < 4; ++j) { const int k = l4 + 256 * j;
                const f32x4 wf = *(const f32x4*)(wffn + k), sh = *(const f32x4*)(mod + b * 6144 + 3072 + k), sc = *(const f32x4*)(mod + b * 6144 + 4096 + k); const f32x4 ws = wf * (sc + 1.f);
#pragma unroll
                for (int r = 0; r < 4; ++r) { const float r2 = rsqrtf(s2[r] * (1.f / DM) + RMS_EPS);
                    const f32x4 h = xv[r][j] * r2 * ws + sh;
                    { const int rt = 4 * (g & 1) + r; const f16x4 hh = {(_Float16)h[0], (_Float16)h[1], (_Float16)h[2], (_Float16)h[3]};
                      *(LAS f16x4*)(TILE + rt * 2048 + (((lane >> 1) ^ rt) << 4) + (lane & 1) * 8 + 512 * j) = hh; }
                    xv[r][j] = h; } }
            float am[4];
#pragma unroll
            for (int r = 0; r < 4; ++r) { float a = 0.f;
#pragma unroll
                for (int j = 0; j < 4; ++j) a = fmaxf(a, fmaxf(fmaxf(fabsf(xv[r][j][0]), fabsf(xv[r][j][1])), fmaxf(fabsf(xv[r][j][2]), fabsf(xv[r][j][3]))));
                am[r] = a; }
#pragma unroll
            for (int o = 1; o < 64; o <<= 1) {
#pragma unroll
                for (int r = 0; r < 4; ++r) am[r] = fmaxf(am[r], __shfl_xor(am[r], o)); }
#pragma unroll
            for (int r = 0; r < 4; ++r) { const float inv = am[r] > 0.f ? 127.f / am[r] : 0.f; const size_t ro = (size_t)(rbase + 4 * g + r) * DM;
                if (lane == 0) { SAv[rbase + 4 * g + r] = am[r] * (1.f / 127.f); SAW[(w * 16 + 4 * g + r)] = am[r] * (1.f / 127.f); }
                u32x4 pk;
#pragma unroll
                for (int j = 0; j < 4; ++j) { const f32x4 q = xv[r][j] * inv;
                    const int q0 = (int)rintf(q[0]), q1 = (int)rintf(q[1]), q2 = (int)rintf(q[2]), q3 = (int)rintf(q[3]);
                    pk[j] = (unsigned)(q0 & 0xff) | ((unsigned)(q1 & 0xff) << 8) | ((unsigned)(q2 & 0xff) << 16) | ((unsigned)(q3 & 0xff) << 24); }
                *(u32x4*)(H2Q + ro + 256 * (lane & 3) + 16 * (lane >> 2)) = quad_transpose(pk, lane); }
            __builtin_amdgcn_sched_barrier(0);
            if (g < 3) S6_LOAD(g + 1);
            __builtin_amdgcn_sched_barrier(0);
            if (g & 1) {
                const int r16 = lane & 15, q = lane >> 4, rt = r16 & 7;
                f32x4 a0 = {0.f, 0.f, 0.f, 0.f}, a1 = a0, a2 = a0;
                LAS const unsigned char* ae = TILE + rt * 2048 + ((q ^ rt) << 4); LAS const unsigned char* ao = TILE + rt * 2048 + (((q ^ rt) ^ 4) << 4);
                const _Float16* bp = RWT + (size_t)r16 * DM + 8 * q;
#pragma unroll 2
                for (int k2 = 0; k2 < 16; ++k2) {
                    const f16x8 ah0 = *(LAS const f16x8*)(ae + 128 * k2), ah1 = *(LAS const f16x8*)(ao + 128 * k2);
                    const f16x8 b00 = *(const f16x8*)(bp + 64 * k2), b01 = *(const f16x8*)(bp + 64 * k2 + 16 * DM), b02 = *(const f16x8*)(bp + 64 * k2 + 32 * DM);
                    const f16x8 b10 = *(const f16x8*)(bp + 64 * k2 + 32), b11 = *(const f16x8*)(bp + 64 * k2 + 32 + 16 * DM), b12 = *(const f16x8*)(bp + 64 * k2 + 32 + 32 * DM);
                    a0 = __builtin_amdgcn_mfma_f32_16x16x32_f16(ah0, b00, a0, 0, 0, 0); a1 = __builtin_amdgcn_mfma_f32_16x16x32_f16(ah0, b01, a1, 0, 0, 0); a2 = __builtin_amdgcn_mfma_f32_16x16x32_f16(ah0, b02, a2, 0, 0, 0);
                    a0 = __builtin_amdgcn_mfma_f32_16x16x32_f16(ah1, b10, a0, 0, 0, 0); a1 = __builtin_amdgcn_mfma_f32_16x16x32_f16(ah1, b11, a1, 0, 0, 0); a2 = __builtin_amdgcn_mfma_f32_16x16x32_f16(ah1, b12, a2, 0, 0, 0); }
                if (q < 2) {
#pragma unroll
                    for (int i = 0; i < 4; ++i) { LG[(4 * q + i) * 48 + r16] = a0[i]; LG[(4 * q + i) * 48 + 16 + r16] = a1[i]; LG[(4 * q + i) * 48 + 32 + r16] = a2[i]; } }
                asm volatile("s_waitcnt lgkmcnt(0)" ::: "memory");
                if (lane < 8) {
                    const LAS float* lg = LG + lane * 48;
                    float gl[4]; int gi = 0; float gmx = -INFINITY;
#pragma unroll
                    for (int i = 0; i < 4; ++i) { gl[i] = lg[i] + bgp[i]; if (gl[i] > gmx) { gmx = gl[i]; gi = i; } }
                    float gs = 0.f;
#pragma unroll
                    for (int i = 0; i < 4; ++i) gs += __expf(gl[i] - gmx);
                    const float pg = 1.f / gs;
                    float el[8]; float emx = -INFINITY;
#pragma unroll
                    for (int i = 0; i < 8; ++i) { el[i] = lg[4 + gi * 8 + i] + bep[gi * 8 + i]; emx = fmaxf(emx, el[i]); }
                    int e0 = 0; float v0 = -INFINITY;
#pragma unroll
                    for (int i = 0; i < 8; ++i) if (el[i] > v0) { v0 = el[i]; e0 = i; }
                    int e1 = 0; float v1 = -INFINITY;
#pragma unroll
                    for (int i = 0; i < 8; ++i) if (i != e0 && el[i] > v1) { v1 = el[i]; e1 = i; }
                    const float p0 = __expf(v0 - emx), p1 = __expf(v1 - emx);
                    const float g0 = pg * p0 / (p0 + p1), g1 = pg * p1 / (p0 + p1);
                    const int rl = w * 16 + 8 * (g >> 1) + lane; const int E0 = gi * 8 + e0, E1 = gi * 8 + e1;
                    REC_E[rl * 2] = E0; REC_E[rl * 2 + 1] = E1; REC_G[rl * 2] = g0; REC_G[rl * 2 + 1] = g1;
                    REC_P[rl * 2] = atomicAdd((int*)&CNTL[E0], 1); REC_P[rl * 2 + 1] = atomicAdd((int*)&CNTL[E1], 1);
                }
                asm volatile("s_waitcnt lgkmcnt(0)" ::: "memory");
            }
        }
#undef S6_LOAD
#undef S6_Y
        __syncthreads();
        if (tid < 32) { const int c = CNTL[tid]; CNTL[32 + tid] = c ? (int)__hip_atomic_fetch_add(cntg + tid, (unsigned)c, __ATOMIC_RELAXED, __HIP_MEMORY_SCOPE_AGENT) : 0; }
        __syncthreads();
        if (tid < 256) { const int rl = tid >> 1, k = tid & 1; const int row = rb * 128 + rl; const int e = REC_E[tid]; const int p = CNTL[32 + e] + REC_P[tid];
            WSP(int, WS_TOKE)[row * 2 + k] = e; WSP(int, WS_TOKP)[row * 2 + k] = p; WSP(float, WS_TOKG)[row * 2 + k] = REC_G[tid];
            WSP(int, WS_LIST)[(size_t)e * 65536 + p] = row; WSP(float, WS_SAL)[(size_t)e * 65536 + p] = SAW[rl]; }
        __syncthreads();
    }
}

__device__ __forceinline__ void expert_convert(Frame& F) {
    {
        int tid = F.tid; asm volatile("" : "+v"(tid));
        LAS unsigned* AM = (LAS unsigned*)F.lds;
        const int n4 = tid & 7, kq = tid >> 3;
        for (int it = F.vcu; it < 1024; it += F.G) {
            const int e = it >> 5, sel = (it >> 4) & 1, j0 = (it & 15) * 32;
            const float* W = IN_F(sel ? 25 : 24) + (size_t)e * 1024 * 512 + (size_t)(16 * kq) * 512 + j0 + 4 * n4;
            if (tid < 32) AM[tid] = 0u;
            __syncthreads();
            f32x4 v[16]; f32x4 am = {0.f, 0.f, 0.f, 0.f};
#pragma unroll
            for (int i = 0; i < 16; ++i) { v[i] = *(const f32x4*)(W + (size_t)i * 512);
#pragma unroll
                for (int c = 0; c < 4; ++c) am[c] = fmaxf(am[c], fabsf(v[i][c])); }
#pragma unroll
            for (int o = 8; o < 64; o <<= 1) {
#pragma unroll
                for (int c = 0; c < 4; ++c) am[c] = fmaxf(am[c], __shfl_xor(am[c], o)); }
            if ((tid & 63) < 8) {
#pragma unroll
                for (int c = 0; c < 4; ++c) atomicMax((unsigned*)&AM[4 * n4 + c], __float_as_uint(am[c])); }
            __syncthreads();
            const f32x4 amax = *(LAS const f32x4*)((LAS const float*)AM + 4 * n4);
            unsigned char* dst = (unsigned char*)(F.ws + WS_W13T) + ((size_t)e * 1024 + 8 * ((j0 >> 2) + n4) + 4 * sel) * 1024 + 16 * kq;
#pragma unroll
            for (int c = 0; c < 4; ++c) { const float inv = amax[c] > 0.f ? 127.f / amax[c] : 0.f; u32x4 o;
#pragma unroll
                for (int d = 0; d < 4; ++d) {
                    const int q0 = (int)rintf(v[4 * d][c] * inv), q1 = (int)rintf(v[4 * d + 1][c] * inv), q2 = (int)rintf(v[4 * d + 2][c] * inv), q3 = (int)rintf(v[4 * d + 3][c] * inv);
                    o[d] = (unsigned)(q0 & 0xff) | ((unsigned)(q1 & 0xff) << 8) | ((unsigned)(q2 & 0xff) << 16) | ((unsigned)(q3 & 0xff) << 24); }
                *(u32x4*)(dst + (size_t)c * 1024) = o;
                if (kq == 0) WSP(float, WS_SB13)[e * 1024 + 8 * ((j0 >> 2) + n4) + 4 * sel + c] = amax[c] * (1.f / 127.f); }
            __syncthreads();
        }
    }
}
__device__ __forceinline__ void w2_convert(Frame& F, int rk, int nsh) {
    LAS float* scr = (LAS float*)(F.lds + F.wave * 8448);
    const int gw = rk * NWAVES + F.wave, NGW = nsh * NWAVES;
    for (int it = gw; it < 32 * 256; it += NGW) {
        const int e = it >> 8, r = it & 255;
        transpose_item(IN_F(26) + (size_t)e * 512 * 1024, 1024, WSP(bf16_t, WS_W2T) + (size_t)e * 1024 * 512, 512, scr, (r / 32) * 64, (r % 32) * 32, F.lane, RmId{0});
    }
    __syncthreads();
}

__device__ __forceinline__ void moe_tables(Frame& F, LAS int* tstart, LAS int* cnt) {
    if (F.tid < 64) {
        const int lane = F.tid; const unsigned* cg = (const unsigned*)(F.ws + WS_CTL) + CW_CNT;
        const int c = lane < 32 ? (int)__hip_atomic_load(cg + lane, __ATOMIC_RELAXED, __HIP_MEMORY_SCOPE_AGENT) : 0;
        const int tl = (c + 255) >> 8; int incl = tl;
#pragma unroll
        for (int o = 1; o < 32; o <<= 1) { const int x = __shfl_up(incl, o); if (lane >= o) incl += x; }
        if (lane < 32) { cnt[lane] = c; tstart[lane] = incl - tl; LAS unsigned char* et = (LAS unsigned char*)(tstart + 96);
            for (int t2 = incl - tl; t2 < incl; ++t2) et[t2] = (unsigned char)lane; }
        if (lane == 31) tstart[32] = incl; }
    __syncthreads();
}

__device__ __forceinline__ void s10_phase(Frame& F, LAS int* tstart) {
    const int gw = F.vcu * NWAVES + F.wave, NGW = F.G * NWAVES, lane = F.lane;
    const float* wpost = IN_F(8); const float* mod = WSP(float, WS_MOD); const bf16_t* YB = WSP(bf16_t, WS_YB); const bf16_t* X1B = WSP(bf16_t, WS_X1B);
    int ne0[4], ne1[4], np0[4], np1[4]; float ng0[4], ng1[4];
#define S10_TAB(rw) do { _Pragma("unroll") for (int r = 0; r < 4; ++r) { const int row_ = (rw) + r; \
        ne0[r] = WSP(int, WS_TOKE)[row_ * 2]; ne1[r] = WSP(int, WS_TOKE)[row_ * 2 + 1]; np0[r] = WSP(int, WS_TOKP)[row_ * 2]; np1[r] = WSP(int, WS_TOKP)[row_ * 2 + 1]; \
        ng0[r] = WSP(float, WS_TOKG)[row_ * 2]; ng1[r] = WSP(float, WS_TOKG)[row_ * 2 + 1]; } } while (0)
    if (gw * 4 < NTOK) S10_TAB(gw * 4);
    for (int row0 = gw * 4; row0 < NTOK; row0 += NGW * 4) {
        const int b = row0 >> 12;
        size_t r0[4], r1[4]; float g0[4], g1[4];
#pragma unroll
        for (int r = 0; r < 4; ++r) { r0[r] = (size_t)tstart[ne0[r]] * 256 + np0[r]; r1[r] = (size_t)tstart[ne1[r]] * 256 + np1[r]; g0[r] = ng0[r]; g1[r] = ng1[r]; }
        if (row0 + NGW * 4 < NTOK) S10_TAB(row0 + NGW * 4);
        f32x4 yv[4][4]; float ss[4];
        u32x4 xw[4][2];
#pragma unroll
        for (int r = 0; r < 4; ++r) { float a2 = 0.f;
            u32x4 wa[2], wc[2];
#pragma unroll
            for (int jp = 0; jp < 2; ++jp) { const int ko = 4 * (lane & ~1) + 256 * (2 * jp + (lane & 1));
                wa[jp] = __builtin_nontemporal_load((const u32x4*)(YB + r0[r] * DM + ko)); wc[jp] = __builtin_nontemporal_load((const u32x4*)(YB + r1[r] * DM + ko));
                xw[r][jp] = __builtin_nontemporal_load((const u32x4*)(X1B + (size_t)(row0 + r) * DM + ko)); }
#pragma unroll
            for (int jp = 0; jp < 2; ++jp) { u32x2 a[2], c[2]; pair_narrow(wa[jp], lane, a[0], a[1]); pair_narrow(wc[jp], lane, c[0], c[1]);
#pragma unroll
                for (int e = 0; e < 2; ++e) { const int j = 2 * jp + e;
                    yv[r][j] = (f32x4){bflo(a[e].x), bfhi(a[e].x), bflo(a[e].y), bfhi(a[e].y)} * g0[r] + (f32x4){bflo(c[e].x), bfhi(c[e].x), bflo(c[e].y), bfhi(c[e].y)} * g1[r];
                    a2 += yv[r][j][0] * yv[r][j][0] + yv[r][j][1] * yv[r][j][1] + yv[r][j][2] * yv[r][j][2] + yv[r][j][3] * yv[r][j][3]; } }
            ss[r] = a2; }
#pragma unroll
        for (int o = 1; o < 64; o <<= 1) {
#pragma unroll
            for (int r = 0; r < 4; ++r) ss[r] += __shfl_xor(ss[r], o); }
#pragma unroll
        for (int jp = 0; jp < 2; ++jp) {
#pragma unroll
            for (int r = 0; r < 4; ++r) { const float rr = rsqrtf(ss[r] * (1.f / DM) + RMS_EPS);
                u32x2 xb[2]; pair_narrow(xw[r][jp], lane, xb[0], xb[1]);
#pragma unroll
                for (int e = 0; e < 2; ++e) { const int j = 2 * jp + e, k = 4 * lane + 256 * j;
                    const f32x4 wp = *(const f32x4*)(wpost + k), gf = *(const f32x4*)(mod + b * 6144 + 5120 + k); const f32x4 gw2 = gf * wp;
                    const f32x4 x1 = (f32x4){bflo(xb[e].x), bfhi(xb[e].x), bflo(xb[e].y), bfhi(xb[e].y)};
                    __builtin_nontemporal_store(x1 + gw2 * (yv[r][j] * rr), (f32x4*)(F.out + (size_t)(row0 + r) * DM + k)); } } }
    }
}

#undef S10_TAB
#ifndef DBG_STOP
#define DBG_STOP -1
#endif
#if DBG_STOP >= 0
struct DbgBuf { size_t off, n; int f32, ph; };
__device__ __forceinline__ void dbg_phase(Frame& F, const XcdBarrier& bar) {
    const DbgBuf bufs[] = {
        {WS_MOD, 8 * 6144, 1, 0}, {WS_COS, (size_t)NTOK * 32, 1, 0}, {WS_SIN, (size_t)NTOK * 32, 1, 0}, {WS_WINT, (size_t)INWP * 1024, 0, 0}, {WS_WOUTT, 1024 * 1024, 0, 0},
        {WS_CW1K, 128 * 2048, 0, 0}, {WS_CW2K, 64 * 128, 0, 0}, {WS_RWT, 48 * 1024, 0, 0}, {WS_C1B, 256, 1, 0},
        {WS_H1, (size_t)NTOK * 1024, 0, 1},
        {WS_MQ, (size_t)NTOK * 2048, 0, 2}, {WS_NQ, (size_t)NTOK * 512, 0, 2}, {WS_KC, (size_t)NTOK * 128 * 6, 0, 2}, {WS_GI, 2 * 8 * 4 * 4096, 1, 2}, {WS_NGT, (size_t)NTOK * 24, 1, 2},
        {WS_KVC, (size_t)2048 * 16384, 0, 3}, {WS_NC, 2048 * 128, 1, 3}, {WS_GSUM, 4096, 1, 3}, {WS_KCMP, 2 * 16 * 256 * 64, 0, 3},
        {WS_CPREV, (size_t)2048 * 16384, 0, 4}, {WS_NPREV, 2048 * 128, 1, 4}, {WS_MPREV, 2048, 1, 4},
        {WS_YCAT, (size_t)NTOK * 1024, 0, 5}, {WS_W13T, (size_t)32 * 1024 * 1024, 0, 5}, {WS_W2T, (size_t)32 * 1024 * 512, 0, 5},
        {WS_Y, (size_t)NTOK * 1024, 0, 6}, {WS_H2, (size_t)NTOK * 1024, 0, 7}, {WS_TOKG, (size_t)NTOK * 2, 1, 7},
        {WS_HB, (size_t)65536 * 512, 0, 8}, {WS_YB, (size_t)65536 * 1024, 0, 9} };
    constexpr int NBUF = sizeof(bufs) / sizeof(bufs[0]);
    unsigned* flag = (unsigned*)(F.ws + WS_CTL) + CW_DBG;
    const size_t gt = (size_t)blockIdx.x * NTHR + F.tid, NG = (size_t)F.G * NTHR;
    for (int i = 0; i < NBUF; ++i) {
        if (bufs[i].ph > DBG_STOP) continue;
        if ((bufs[i].off == WS_H1 && DBG_STOP >= 3) || (bufs[i].off == WS_WINT && DBG_STOP >= 4) || (bufs[i].off == WS_KVC && DBG_STOP >= 5) || (bufs[i].off == WS_NQ && DBG_STOP >= 5) || (bufs[i].off == WS_KC && DBG_STOP >= 9) ||
            (bufs[i].off == WS_MQ && DBG_STOP >= 6) || (bufs[i].off == WS_CPREV && DBG_STOP >= 8) || (bufs[i].off == WS_Y && DBG_STOP >= 9) || (bufs[i].off == WS_H2 && DBG_STOP >= 9) || (bufs[i].off == WS_W13T && DBG_STOP < 5)) continue;
        bool bad = false;
        if (bufs[i].f32) { const unsigned* p = (const unsigned*)(F.ws + bufs[i].off); for (size_t k = gt; k < bufs[i].n; k += NG) bad |= ((p[k] & 0x7f800000u) == 0x7f800000u); }
        else { const unsigned* p = (const unsigned*)(F.ws + bufs[i].off); for (size_t k = gt; k < bufs[i].n / 2; k += NG) { const unsigned v = p[k]; bad |= ((v & 0x7f80u) == 0x7f80u) || ((v & 0x7f800000u) == 0x7f800000u); } }
        if (bufs[i].off == WS_YCAT) { bool bm = false, bn = false; const unsigned* p = (const unsigned*)(F.ws + WS_YCAT);
            for (size_t k = gt; k < bufs[i].n / 2; k += NG) { const unsigned v = p[k]; const bool b2 = ((v & 0x7f80u) == 0x7f80u) || ((v & 0x7f800000u) == 0x7f800000u); if ((k & 511) < 256) bm |= b2; else bn |= b2; }
            if (__any(bm) && F.lane == 0) atomicMin(flag, 23u); if (__any(bn) && F.lane == 0) atomicMin(flag, 33u); continue; }
        if (__any(bad) && F.lane == 0) atomicMin(flag, (unsigned)(i + 1));
    }
    if (DBG_STOP >= 7) { bool bad = false; const unsigned* p = (const unsigned*)F.out; for (size_t k = gt; k < (size_t)NTOK * DM; k += NG) bad |= ((p[k] & 0x7f800000u) == 0x7f800000u); if (__any(bad) && F.lane == 0) atomicMin(flag, 40u); }
    xcd_barrier(bar);
    const unsigned id = __hip_atomic_load(flag, __ATOMIC_RELAXED, __HIP_MEMORY_SCOPE_AGENT);
    const float sc = (id >= 1000u) ? 1.f : 1.f + (float)id;
    const float* x = IN_F(0);
    for (size_t k = gt; k < (size_t)NTOK * DM; k += NG) F.out[k] = x[k] * sc;
}
#endif


#if DBG_STOP >= 0
__device__ __forceinline__ unsigned dbg_hash(unsigned x) { x ^= x >> 16; x *= 0x7feb352du; x ^= x >> 15; x *= 0x846ca68bu; x ^= x >> 16; return x; }
__device__ __forceinline__ float dbg_bfr(float f) { return bf2f(f2bf(f)); }
__device__ float dbg_z(Frame& F, int row, int c) { const signed char* h = (const signed char*)(F.ws + WS_H1) + (size_t)row * 1024; const float* w = IN_F(9); float am = 0.f;
    for (int k = 0; k < 1024; ++k) am = fmaxf(am, fabsf(w[(size_t)k * INW + c]));
    const float inv = am > 0.f ? 127.f / am : 0.f; float s = 0.f; for (int k = 0; k < 1024; ++k) s += (float)h[k] * rintf(w[(size_t)k * INW + c] * inv);
    return s * WSP(float, WS_SA1)[row] * (am * (1.f / 127.f)); }
__device__ __forceinline__ bool dbg_close(float a, float b) { return fabsf(a - b) <= 0.02f * fabsf(b) + 0.02f; }
__device__ void dbg_check_p1(Frame& F, unsigned* cnt) {
    const int gt = blockIdx.x * NTHR + F.tid; if (gt >= 8192) return;
    const int row = dbg_hash(gt * 2 + 1) % NTOK; int c = dbg_hash(gt * 2 + 2) % INW; if (gt < 64) c = 2048 + (gt & 7); if (gt >= 64 && gt < 256) c = 3336 + (gt % 24);
    const int b = row >> 12, sq = row & 4095; const float* COS = WSP(float, WS_COS); const float* SIN = WSP(float, WS_SIN);
    float ref, got;
    if (c < 2048) { ref = dbg_z(F, row, c); got = bf2f(WSP(bf16_t, c < 512 ? WS_MQ : c < 1024 ? WS_MK : c < 1536 ? WS_MV : WS_MO)[(size_t)row * 512 + (c & 511)]); }
    else if (c < 2052) { ref = dbg_z(F, row, c) + IN_F(11)[c - 2048]; got = WSP(float, WS_GI)[(size_t)(b * 4 + c - 2048) * SEQ + sq]; }
    else if (c < 2056) { ref = logsigmoid_f(dbg_z(F, row, c) + IN_F(11)[4 + c - 2052]); got = WSP(float, WS_GF)[(size_t)(b * 4 + c - 2052) * SEQ + sq]; }
    else if (c >= 3336) { ref = sigmoid_f(dbg_z(F, row, c)); got = WSP(float, WS_NGT)[(size_t)row * 24 + c - 3336]; }
    else {
        int base, x; size_t ws_off; bool rope, isq = false;
        if (c < 2568) { base = 2056; x = c - base; rope = true; isq = true; ws_off = WS_NQ; }
        else if (c < 2696) { base = 2568; x = c - base; rope = true; ws_off = WS_KC; }
        else if (c < 2824) { base = 2696; x = c - base; rope = false; ws_off = WS_VC; }
        else if (c < 2952) { base = 2824; x = c - base; rope = true; ws_off = WS_KSL; }
        else if (c < 3080) { base = 2952; x = c - base; rope = false; ws_off = WS_VSL; }
        else if (c < 3208) { base = 3080; x = c - base; rope = true; ws_off = WS_KWN; }
        else { base = 3208; x = c - base; rope = false; ws_off = WS_VWN; }
        const int hd = x >> 6, d = x & 63;
        if (rope) { const float z0 = dbg_z(F, row, c), z1 = dbg_z(F, row, base + hd * 64 + (d ^ 32)); const float cs = COS[(size_t)row * 32 + (d & 31)], sn = SIN[(size_t)row * 32 + (d & 31)];
            ref = d < 32 ? z0 * cs - z1 * sn : z0 * cs + z1 * sn; if (isq) ref *= QSCALE; }
        else ref = dbg_z(F, row, c);
        got = isq ? bf2f(WSP(bf16_t, ws_off)[(size_t)row * 512 + hd * 64 + d]) : bf2f(WSP(bf16_t, ws_off)[((size_t)(b * 2 + hd) * SEQ + sq) * 64 + d]);
    }
    if (!dbg_close(got, ref)) atomicAdd(cnt, 1u);
}
#endif


#if DBG_STOP >= 0
__device__ void dbg_check_nsa(Frame& F, unsigned* cnt) {
    const int lane = F.lane, gw = blockIdx.x * NWAVES + F.wave;
    LAS float* P = (LAS float*)(F.lds + F.wave * 2048);
    const unsigned hsh = dbg_hash(gw * 7 + 3);
    const int b = hsh & 7, hh = (hsh >> 3) & 7, g = hh >> 2;
    int t; { const int cls = gw & 7; const unsigned r = dbg_hash(gw * 13 + 5);
        t = cls == 0 ? (int)(r % 31) : cls == 1 ? 31 + (int)(r % 33) : cls == 2 ? 64 + (int)(r % 960) : cls == 3 ? 1024 + (int)(r % 64) : cls == 4 ? 4032 + (int)(r % 64) : 1024 + (int)(r % 3072); }
    const size_t row = (size_t)b * SEQ + t; const int bg = b * 2 + g, cur = t >> 6;
    const bf16_t* Kc = WSP(bf16_t, WS_KCMP) + (size_t)bg * 256 * 64; const bf16_t* Vc = WSP(bf16_t, WS_VCMP) + (size_t)bg * 256 * 64;
    const int lim = t >= 31 ? (t - 31) >> 4 : -1;
    float imp = 0.f, oc = 0.f;
    for (int hd = 0; hd < 4; ++hd) {
        const bf16_t* q = WSP(bf16_t, WS_NQ) + row * 512 + (4 * g + hd) * 64;
        float sc[4]; float mx = -INFINITY;
        for (int k = 0; k < 4; ++k) { const int i = lane + 64 * k; float s = 0.f; for (int d = 0; d < 64; ++d) s += bf2f(q[d]) * bf2f(Kc[(size_t)i * 64 + d]); sc[k] = (i <= lim) ? s : -INFINITY; mx = fmaxf(mx, sc[k]); }
        mx = wave_max(mx); const float mref = (mx == -INFINITY) ? 0.f : mx; float l = 0.f;
        for (int k = 0; k < 4; ++k) { sc[k] = ex2(sc[k] - mref); l += sc[k]; }
        l = wave_sum(l); const float il = 1.f / fmaxf(l, 1e-30f);
        for (int k = 0; k < 4; ++k) P[lane + 64 * k] = sc[k] * il;
        asm volatile("s_waitcnt lgkmcnt(0)" ::: "memory");
        { const int j = lane; float a = 0.f; for (int x = 0; x < 3; ++x) a += 2.f * P[4 * j + x]; a += P[4 * j + 3]; if (j > 0) a += P[4 * j - 1]; imp += a; }
        if (4 * g + hd == hh) { for (int i = 0; i < 255; ++i) oc += P[i] * bf2f(Vc[(size_t)i * 64 + lane]); }
        asm volatile("s_waitcnt lgkmcnt(0)" ::: "memory");
    }
    float score = imp; { const int j = lane; if (j == 0 || j == cur || j == cur - 1) score = INFINITY; else if (64 * j > t) score = -INFINITY; }
    int rank = 0; for (int j2 = 0; j2 < 64; ++j2) { const float s2 = __shfl(score, j2); rank += (s2 > score || (s2 == score && j2 < lane)) ? 1 : 0; }
    const unsigned long long selm = __ballot(rank < 16);
    const bf16_t* q = WSP(bf16_t, WS_NQ) + row * 512 + hh * 64;
    float os = 0.f, ow = 0.f;
    for (int br = 0; br < 2; ++br) {
        const bf16_t* K = WSP(bf16_t, br ? WS_KWN : WS_KSL) + (size_t)bg * SEQ * 64; const bf16_t* V = WSP(bf16_t, br ? WS_VWN : WS_VSL) + (size_t)bg * SEQ * 64;
        float m = -INFINITY, l = 0.f, o = 0.f;
        for (int j = 0; j < 64; ++j) {
            if (br == 0 && !((selm >> j) & 1ull)) continue;
            const int kp = 64 * j + lane; bool valid = kp <= t; if (br == 1) valid = valid && kp > t - 512;
            if (!__any(valid)) continue;
            float s = 0.f; for (int d = 0; d < 64; ++d) s += bf2f(q[d]) * bf2f(K[(size_t)kp * 64 + d]);
            s = valid ? s : -INFINITY;
            const float mn = fmaxf(m, wave_max(s)); const float alpha = (m == -INFINITY) ? 0.f : ex2(m - mn); const float pp = ex2(s - mn);
            l = l * alpha + wave_sum(pp); o *= alpha;
            for (int x = 0; x < 64; ++x) o += __shfl(pp, x) * bf2f(V[(size_t)(64 * j + x) * 64 + lane]);
            m = mn;
        }
        const float r = o / fmaxf(l, 1e-30f); if (br) ow = r; else os = r;
    }
    const float* gp = WSP(float, WS_NGT) + row * 24 + hh * 3;
    const float ref = gp[0] * oc + gp[1] * os + gp[2] * ow;
    const float got = bf2f(WSP(bf16_t, WS_YCAT)[row * 1024 + 512 + hh * 64 + lane]);
    const float sq = wave_sum(ref * ref); const float tol = 0.03f * fabsf(ref) + 0.03f * sqrtf(sq * (1.f / 64.f)) + 1e-4f;
    const bool bad = !(fabsf(got - ref) <= tol);
    if (__any(bad) && lane == 0) atomicAdd(cnt, 1u);
}
#endif


#if DBG_STOP >= 0
__device__ void dbg_check_mlstm(Frame& F, unsigned* cnt) {
    const int lane = F.lane, gw = blockIdx.x * NWAVES + F.wave;
    const unsigned hsh = dbg_hash(gw * 11 + 1);
    const int b = hsh & 7, h = (hsh >> 3) & 3;
    int t; { const int cls = gw & 7; const unsigned r = dbg_hash(gw * 17 + 9);
        t = cls == 0 ? (int)(r % 4) : cls == 1 ? 60 + (int)(r % 8) : cls == 2 ? 64 * (1 + (int)(r % 60)) + (int)((r >> 8) % 3) : cls == 3 ? 64 * (1 + (int)(r % 60)) + 63 : cls == 4 ? 4000 + (int)(r % 96) : (int)(r % 4096); }
    const int bh = b * 4 + h; const float* GI = WSP(float, WS_GI) + (size_t)bh * SEQ; const float* GF = WSP(float, WS_GF) + (size_t)bh * SEQ;
    const bf16_t* MQ = WSP(bf16_t, WS_MQ); const bf16_t* MK = WSP(bf16_t, WS_MK); const bf16_t* MV = WSP(bf16_t, WS_MV); const float* cw = IN_F(10);
    float carry = 0.f, M = 0.f, Bt = 0.f;
    for (int s0 = 0; s0 <= t; s0 += 64) { const int s = s0 + lane; float lf = (s <= t) ? GF[s] : 0.f;
        float bs = lf;
        for (int o = 1; o < 64; o <<= 1) { const float x = __shfl_up(bs, o); if (lane >= o) bs += x; }
        bs += carry; const float u = (s <= t) ? GI[s] - bs : -INFINITY; M = fmaxf(M, wave_max(u));
        if (s0 + 63 >= t) Bt = __shfl(bs, t - s0);
        carry = __shfl(bs, 63); }
    float q0 = 0.f, q1 = 0.f;
    for (int j = 0; j < 4; ++j) { const int ss = t - 3 + j; if (ss >= 0) { const bf16_t* rp = MQ + ((size_t)b * SEQ + ss) * 512 + h * 128;
        q0 += bf2f(rp[lane]) * cw[j * 1024 + h * 128 + lane]; q1 += bf2f(rp[64 + lane]) * cw[j * 1024 + h * 128 + 64 + lane]; } }
    q0 = dbg_bfr(silu_f(q0)); q1 = dbg_bfr(silu_f(q1));
    LAS float* QS = (LAS float*)(F.lds + F.wave * 2048); QS[lane] = q0; QS[64 + lane] = q1;
    asm volatile("s_waitcnt lgkmcnt(0)" ::: "memory");
    float n0 = 0.f, n1 = 0.f, den = 0.f; carry = 0.f;
    for (int s0 = 0; s0 <= t; s0 += 64) { const int s = s0 + lane; const bool act = s <= t; float lf = act ? GF[s] : 0.f;
        float bs = lf;
        for (int o = 1; o < 64; o <<= 1) { const float x = __shfl_up(bs, o); if (lane >= o) bs += x; }
        bs += carry; carry = __shfl(bs, 63);
        float c = 0.f;
        if (act) { float qk = 0.f;
            for (int ch = 0; ch < 128; ++ch) { float kc = 0.f;
                for (int j = 0; j < 4; ++j) { const int ss = s - 3 + j; if (ss >= 0) kc += bf2f(MK[((size_t)b * SEQ + ss) * 512 + h * 128 + ch]) * cw[j * 1024 + 512 + h * 128 + ch]; }
                qk += QS[ch] * dbg_bfr(silu_f(kc) * 0.08838834764831845f); }
            c = __expf(GI[s] - bs - M) * qk; }
        den += c;
        for (int x = 0; x < 64; ++x) { const float cx = __shfl(c, x); if (s0 + x <= t) { const bf16_t* vp = MV + ((size_t)b * SEQ + s0 + x) * 512 + h * 128; n0 += cx * bf2f(vp[lane]); n1 += cx * bf2f(vp[64 + lane]); } } }
    den = wave_sum(den);
    const float hd = fmaxf(fabsf(den), __expf(-(Bt + M)));
    const float h0 = n0 / hd, h1 = n1 / hd;
    const float rn = rsqrtf(wave_sum(h0 * h0 + h1 * h1) * (1.f / 128.f) + RMS_EPS);
    const size_t row = (size_t)b * SEQ + t; const bf16_t* mo = WSP(bf16_t, WS_MO) + row * 512 + h * 128; const float* hn = IN_F(12) + h * 128;
    const float r0 = h0 * rn * hn[lane] * sigmoid_f(bf2f(mo[lane])), r1 = h1 * rn * hn[64 + lane] * sigmoid_f(bf2f(mo[64 + lane]));
    const float g0 = bf2f(WSP(bf16_t, WS_YCAT)[row * 1024 + h * 128 + lane]), g1 = bf2f(WSP(bf16_t, WS_YCAT)[row * 1024 + h * 128 + 64 + lane]);
    const float rms = sqrtf(wave_sum(r0 * r0 + r1 * r1) * (1.f / 128.f));
    const bool bad = !(fabsf(g0 - r0) <= 0.04f * fabsf(r0) + 0.04f * rms + 1e-4f) || !(fabsf(g1 - r1) <= 0.04f * fabsf(r1) + 0.04f * rms + 1e-4f);
    if (__any(bad) && lane == 0) atomicAdd(cnt, 1u);
}
#endif


#if DBG_STOP >= 0
__device__ void dbg_check_cmp(Frame& F, unsigned* cnt) {
    const int lane = F.lane, gw = blockIdx.x * NWAVES + F.wave;
    const unsigned hsh = dbg_hash(gw * 5 + 2);
    const int kv = hsh & 1, bg = (hsh >> 1) & 15; int i = (hsh >> 5) % 255; if ((gw & 15) == 0) i = 254; if ((gw & 15) == 1) i = 0;
    const bf16_t* X = WSP(bf16_t, kv ? WS_VC : WS_KC) + (size_t)bg * SEQ * 64 + (size_t)i * 1024;
    const float* pe = IN_F(kv ? 16 : 13); const float* w1 = IN_F(kv ? 17 : 14); const float* w2 = IN_F(kv ? 18 : 15);
    float h0 = 0.f, h1 = 0.f;
    for (int k = 0; k < 2048; ++k) { const float xv = bf2f(X[k]) + pe[k]; h0 += xv * w1[(size_t)k * 128 + lane]; h1 += xv * w1[(size_t)k * 128 + 64 + lane]; }
    LAS float* H = (LAS float*)(F.lds + F.wave * 2048); H[lane] = silu_f(h0); H[64 + lane] = silu_f(h1);
    asm volatile("s_waitcnt lgkmcnt(0)" ::: "memory");
    float o = 0.f; for (int n = 0; n < 128; ++n) o += H[n] * w2[n * 64 + lane];
    const float got = bf2f(WSP(bf16_t, kv ? WS_VCMP : WS_KCMP)[((size_t)bg * 256 + i) * 64 + lane]);
    const float rms = sqrtf(wave_sum(o * o) * (1.f / 64.f));
    const bool bad = !(fabsf(got - o) <= 0.03f * fabsf(o) + 0.03f * rms + 1e-4f);
    if (__any(bad) && lane == 0) atomicAdd(cnt, 1u);
}
#endif

__device__ __forceinline__ bool phase_tid(Frame& F) { asm volatile("" : "+v"(F.tid)); F.lane = F.tid & 63; return true; }
constexpr int NPHASE = 11;
__global__ void __launch_bounds__(NTHR, 2) mega_fwd(Args args) {
    extern __shared__ __attribute__((aligned(16))) unsigned char lds_raw[];
    Frame F;
    F.lds = (LAS unsigned char*)lds_raw; F.in = args.in; F.out = args.out; F.ws = args.ws;
    F.tid = threadIdx.x; F.lane = F.tid & 63; F.wave = __builtin_amdgcn_readfirstlane(F.tid >> 6);
    F.G = gridDim.x; { const int bx = blockIdx.x; F.vcu = (F.G % 8 == 0) ? (bx % 8) * (F.G / 8) + bx / 8 : bx; }
    volatile LAS unsigned* MISC = (volatile LAS unsigned*)(F.lds + MISC_OFF);
    for (int u = F.tid; u < (LDS_BYTES - MISC_OFF) / 4; u += NTHR) ((LAS unsigned*)(F.lds + MISC_OFF))[u] = 0u;
    __syncthreads();
    unsigned* ctl = (unsigned*)(F.ws + WS_CTL);
    XcdBarrier bar; bar.bar = ctl + CW_BAR; bar.x = 0; bar.st = nullptr;
    const int lo = args.ph_lo, hi = args.ph_hi;
    if (hi - lo > 1) bar = xcd_barrier_post(ctl + CW_BAR, MISC + 8);
#ifndef PHASE_MASK
#define PHASE_MASK 0xFFFF
#endif
#define IN(k) (((PHASE_MASK >> (k)) & 1) && lo <= (k) && (k) < hi && (DBG_STOP < 0 || (k) <= DBG_STOP))
#define SEAM(k) do { if (IN(k) && IN((k) + 1)) xcd_barrier(bar); } while (0)
    LAS int* TST = (LAS int*)(F.lds + MISC_OFF + 256);
    LAS int* CNT = TST + 40;

#define PHASE_TID() if (phase_tid(F))
    if (IN(0)) PHASE_TID() _Pragma("nounroll") for (int rep = 0; rep <= ((REP_MASK >> 0) & 1); ++rep) { p0_phase(F); } SEAM(0);
    if (IN(1)) PHASE_TID() _Pragma("nounroll") for (int rep = 0; rep <= ((REP_MASK >> 1) & 1); ++rep) { p1a_phase(F); } SEAM(1);
    if (IN(2)) PHASE_TID() _Pragma("nounroll") for (int rep = 0; rep <= ((REP_MASK >> 2) & 1); ++rep) {
        pg8::DenseOrder S; S.init(NTOK, INWP, DM / 2, F.G, (int)blockIdx.x);
        EpiIn E{F.ws, IN_F(11), F.lds};
        pg8::gemm_phase<true>(F.lds, WSP(bf16_t, WS_H1), WSP(bf16_t, WS_WINT), DM / 2, S, E);
    } SEAM(2);
    if (IN(3)) PHASE_TID() _Pragma("nounroll") for (int rep = 0; rep <= ((REP_MASK >> 3) & 1); ++rep) {
        REPS(0) mlstm_a_phase(F);
        REPS(1) for (int j = F.vcu; j < 256; j += F.G) compress_job(F, j);
    } SEAM(3);
    if (IN(4)) PHASE_TID() _Pragma("nounroll") for (int rep = 0; rep <= ((REP_MASK >> 4) & 1); ++rep) {
        REPS(2) for (int j = F.vcu; j < 256; j += F.G) mlstm_scan_job(F, j);
        REPS(3) for (int u = F.vcu; u < 512; u += F.G) {
            const int bg = u >> 5, q = u & 31;
            _Pragma("nounroll") for (int hf = 0; hf < 2; ++hf) nsa_unit(F, bg >> 1, bg & 1, hf ? q : 63 - q);
        }
    } SEAM(4);
    if (IN(5)) PHASE_TID() _Pragma("nounroll") for (int rep = 0; rep <= ((REP_MASK >> 5) & 1); ++rep) {
        REPS(4) mlstm_c_phase(F);
        REPS(5) expert_convert(F);
    } SEAM(5);
    if (IN(6)) PHASE_TID() _Pragma("nounroll") for (int rep = 0; rep <= ((REP_MASK >> 6) & 1); ++rep) {
        pg8::DenseOrder S; S.init(NTOK, DM, DM, F.G, (int)blockIdx.x);
        EpiBf16 E{WSP(bf16_t, WS_Y), DM};
        pg8::gemm_phase<false>(F.lds, WSP(bf16_t, WS_YCAT), WSP(bf16_t, WS_WOUTT), DM, S, E);
    } SEAM(6);
    if (IN(7)) PHASE_TID() { s6_phase(F); } SEAM(7);
    if (IN(8)) PHASE_TID() _Pragma("nounroll") for (int rep = 0; rep <= ((REP_MASK >> 8) & 1); ++rep) {
        moe_tables(F, TST, CNT);
        pg8::MoeOrder S{TST, CNT, (const LAS unsigned char*)(TST + 96), WSP(int, WS_LIST), F.G, F.vcu, DM / 2, true};
        EpiUpI8 E{WSP(bf16_t, WS_HB), WSP(float, WS_SAL), WSP(float, WS_SB13), TST, F.lds};
        pg8::gemm_phase<true>(F.lds, WSP(bf16_t, WS_H2Q), WSP(bf16_t, WS_W13T), DM / 2, S, E);
        {
            const int U = TST[32] * 4, full = U / F.G, rem = U % F.G;
            if (rem == 0) w2_convert(F, F.vcu, F.G); else if (F.vcu >= rem) w2_convert(F, F.vcu - rem, F.G - rem);
            (void)full; }
    } SEAM(8);
    if (IN(9)) PHASE_TID() _Pragma("nounroll") for (int rep = 0; rep <= ((REP_MASK >> 9) & 1); ++rep) {
        moe_tables(F, TST, CNT);
        pg8::MoeOrder S{TST, CNT, (const LAS unsigned char*)(TST + 96), WSP(int, WS_LIST), F.G, F.vcu, EFF, false};
        EpiBf16 E{WSP(bf16_t, WS_YB), DM};
        pg8::gemm_phase<false>(F.lds, WSP(bf16_t, WS_HB), WSP(bf16_t, WS_W2T), EFF, S, E);
    } SEAM(9);
    if (IN(10)) PHASE_TID() { moe_tables(F, TST, CNT); s10_phase(F, TST); }
#if DBG_STOP >= 0
    xcd_barrier(bar);
#if DBG_CHECK == 1 || DBG_CHECK == 3 || DBG_CHECK == 4 || DBG_CHECK == 5
    { unsigned* cw = (unsigned*)(F.ws + WS_CTL) + CW_DBG + 1; if (DBG_CHECK == 1) dbg_check_p1(F, cw); else if (DBG_CHECK == 3) dbg_check_nsa(F, cw); else if (DBG_CHECK == 4) dbg_check_mlstm(F, cw); else dbg_check_cmp(F, cw); xcd_barrier(bar);
      const unsigned nb = __hip_atomic_load(cw, __ATOMIC_RELAXED, __HIP_MEMORY_SCOPE_AGENT);
      const float sc = nb == 0 ? 1.f : nb < 4 ? 2.f : nb < 16 ? 3.f : nb < 64 ? 4.f : nb < 256 ? 5.f : nb < 1024 ? 6.f : 7.f;
      const float* x = IN_F(0); for (size_t k = (size_t)blockIdx.x * NTHR + F.tid; k < (size_t)NTOK * DM; k += (size_t)F.G * NTHR) F.out[k] = x[k] * sc; }
#elif DBG_CHECK == 2
    { const unsigned id = __hip_atomic_load((unsigned*)(F.ws + WS_CTL) + CW_DBG, __ATOMIC_RELAXED, __HIP_MEMORY_SCOPE_AGENT);
      float sc = (id >= 1000u) ? 1.f : 1.f + (float)id;
      if (__hip_atomic_load((unsigned*)(F.ws + WS_CTL) + CW_BAR + XB_TMO, __ATOMIC_RELAXED, __HIP_MEMORY_SCOPE_AGENT) != 0u) sc = 61.f;
      const float* x = IN_F(0); for (size_t k = (size_t)blockIdx.x * NTHR + F.tid; k < (size_t)NTOK * DM; k += (size_t)F.G * NTHR) F.out[k] = x[k] * sc; }
#else
    dbg_phase(F, bar);
#endif
#endif
#undef IN
#undef SEAM
}

extern "C" void kernel_launch(void* const* d_in, const int* in_sizes, int n_in, void* d_out, int out_size, void* d_ws, size_t ws_size, hipStream_t stream) {
    static int grid = 0;
    if (grid == 0) {
        int dev = 0, cus = 0;
        if (hipGetDevice(&dev) != hipSuccess || hipDeviceGetAttribute(&cus, hipDeviceAttributeMultiprocessorCount, dev) != hipSuccess) cus = 256;
        if (hipFuncSetAttribute((const void*)mega_fwd, hipFuncAttributeMaxDynamicSharedMemorySize, LDS_BYTES) != hipSuccess) fprintf(stderr, "kernel_launch: hipFuncSetAttribute failed\n");
        (void)hipGetLastError();
        grid = cus > 0 ? cus : 256;
        if (n_in != 27 || ws_size < WS_END) fprintf(stderr, "kernel_launch: unexpected n_in %d / ws_size %zu (need %zu)\n", n_in, ws_size, (size_t)WS_END);
    }
    (void)hipMemsetAsync((char*)d_ws + WS_CTL, 0, 64 * 1024, stream);
#if DBG_STOP >= 0
    (void)hipMemsetAsync((char*)d_ws + WS_CTL + CW_DBG * 4, 0x7F, 4, stream);
#endif
    Args a{};
    for (int i = 0; i < 27; ++i) a.in[i] = d_in[i];
    a.out = (float*)d_out; a.ws = (unsigned char*)d_ws;
#if MK_N_LAUNCHES == 1
    a.ph_lo = 0; a.ph_hi = NPHASE;
    hipLaunchKernelGGL(mega_fwd, dim3(grid), dim3(NTHR), LDS_BYTES, stream, a);
#else
    for (int p = 0; p < NPHASE; ++p) { a.ph_lo = p; a.ph_hi = p + 1; hipLaunchKernelGGL(mega_fwd, dim3(grid), dim3(NTHR), LDS_BYTES, stream, a); }
#endif
}
```

```cpp
#include <hip/hip_runtime.h>
#include <cstdio>
#include <cstdint>
#include <type_traits>

#define LAS __attribute__((address_space(3)))
typedef unsigned short bf16_t;
typedef short bf16x8 __attribute__((ext_vector_type(8)));
typedef short s16x4 __attribute__((ext_vector_type(4)));
typedef float f32x4 __attribute__((ext_vector_type(4)));
typedef float f32x16 __attribute__((ext_vector_type(16)));
typedef unsigned u32x4 __attribute__((ext_vector_type(4)));
typedef unsigned u32x2 __attribute__((ext_vector_type(2)));
typedef int i32x4 __attribute__((ext_vector_type(4)));
typedef _Float16 f16x8 __attribute__((ext_vector_type(8)));
typedef _Float16 f16x4 __attribute__((ext_vector_type(4)));

#ifndef MK_N_LAUNCHES
#define MK_N_LAUNCHES 1
#endif
#ifndef DBG_CHECK
#define DBG_CHECK 0
#endif
#ifndef REP_MASK
#define REP_MASK 0
#endif
#ifndef REP_SUB
#define REP_SUB 0
#endif
#ifndef NSA_DUP
#define NSA_DUP 0
#endif
#define NDUP(b) _Pragma("nounroll") for (int nd_ = 0; nd_ <= ((NSA_DUP >> (b)) & 1); ++nd_)
#define REPS(b) _Pragma("nounroll") for (int rs_ = 0; rs_ <= ((REP_SUB >> (b)) & 1); ++rs_)

constexpr int NB = 8, SEQ = 4096, DM = 1024, NTOK = NB * SEQ;
constexpr int MH = 4, MDH = 128;
constexpr int NHD = 8, NGRP = 2;
constexpr int INW = 3360, INWP = 3584;
constexpr int NEXP = 32, EFF = 512;
constexpr float RMS_EPS = 1e-6f;
constexpr float QSCALE = 0.125f * 1.4426950408889634f;
constexpr int NWAVES = 8, NTHR = 512;
constexpr int LDS_BYTES = 160 * 1024, MISC_OFF = 128 * 1024;
constexpr int MAXROWS = 73728;

constexpr size_t MiB = 1ull << 20, KiB = 1024;
constexpr size_t WS_CTL   = 0;
constexpr size_t WS_MOD   = 64 * KiB;
constexpr size_t WS_C1B   = WS_MOD + 192 * KiB;
constexpr size_t WS_GI    = WS_C1B + 4 * KiB;
constexpr size_t WS_GF    = WS_GI + 512 * KiB;
constexpr size_t WS_NGT   = WS_GF + 512 * KiB;
constexpr size_t WS_GSUM  = WS_NGT + 3 * MiB;
constexpr size_t WS_MLOC  = WS_GSUM + 8 * KiB;
constexpr size_t WS_MPREV = WS_MLOC + 8 * KiB;
constexpr size_t WS_NC    = WS_MPREV + 8 * KiB;
constexpr size_t WS_NPREV = WS_NC + 1 * MiB;
constexpr size_t WS_COS   = WS_NPREV + 1 * MiB;
constexpr size_t WS_SIN   = WS_COS + 4 * MiB;
constexpr size_t WS_WOUTT = WS_SIN + 4 * MiB;
constexpr size_t WS_CW1K  = WS_WOUTT + 2 * MiB;
constexpr size_t WS_CW1V  = WS_CW1K + 512 * KiB;
constexpr size_t WS_CW2K  = WS_CW1V + 512 * KiB;
constexpr size_t WS_CW2V  = WS_CW2K + 16 * KiB;
constexpr size_t WS_RWT   = WS_CW2V + 16 * KiB;
constexpr size_t WS_RWL   = WS_RWT + 96 * KiB;
constexpr size_t WS_KCMP  = WS_RWL + 96 * KiB;
constexpr size_t WS_VCMP  = WS_KCMP + 512 * KiB;
constexpr size_t WS_TOKE  = WS_VCMP + 512 * KiB;
constexpr size_t WS_TOKP  = WS_TOKE + 256 * KiB;
constexpr size_t WS_TOKG  = WS_TOKP + 256 * KiB;
constexpr size_t WS_LIST  = WS_TOKG + 256 * KiB;
constexpr size_t WS_SA    = WS_LIST + 8 * MiB;
constexpr size_t WS_SB13  = WS_SA + 128 * KiB;
constexpr size_t WS_SA1   = WS_SB13 + 128 * KiB;
constexpr size_t WS_SBW   = WS_SA1 + 128 * KiB;
constexpr size_t WS_SMALL_END = WS_SBW + 16 * KiB;
static_assert(WS_SMALL_END <= 32 * MiB, "small region overflow");
constexpr size_t WS_A     = 32 * MiB;
constexpr size_t WS_H1    = WS_A, WS_KVC = WS_A, WS_W13T = WS_A;
constexpr size_t WS_NQ    = 96 * MiB;
constexpr size_t WS_KC    = 128 * MiB, WS_VC = 136 * MiB, WS_KSL = 144 * MiB, WS_VSL = 152 * MiB, WS_KWN = 160 * MiB, WS_VWN = 168 * MiB;
constexpr size_t WS_W2T   = 96 * MiB;
constexpr size_t WS_MQ    = 176 * MiB, WS_MK = 208 * MiB, WS_MV = 240 * MiB, WS_MO = 272 * MiB;
constexpr size_t WS_Y     = 176 * MiB;
constexpr size_t WS_H2    = 240 * MiB;
constexpr size_t WS_CPREV = 304 * MiB;
constexpr size_t WS_WINT  = 304 * MiB;
constexpr size_t WS_HB    = 304 * MiB;
constexpr size_t WS_H2LO  = 304 * MiB;
constexpr size_t WS_YCAT  = 376 * MiB;
constexpr size_t WS_X1B   = 376 * MiB;
constexpr size_t WS_YB    = 128 * MiB;
constexpr size_t WS_H2Q   = 128 * MiB;
constexpr size_t WS_SAL   = 440 * MiB;
constexpr size_t WS_END   = 448 * MiB;

constexpr int CW_BAR = 0;
constexpr int CW_CNT = 4096;
constexpr int CW_DBG = 4200;

typedef __bf16 bf16x2_t __attribute__((ext_vector_type(2)));
typedef float f32x2_t __attribute__((ext_vector_type(2)));
__device__ __forceinline__ unsigned cvtpk(float lo, float hi) { const f32x2_t f = {lo, hi}; const bf16x2_t v = __builtin_convertvector(f, bf16x2_t); return __builtin_bit_cast(unsigned, v); }
__device__ __forceinline__ float bf2f(bf16_t b) { return __uint_as_float(((unsigned)b) << 16); }
__device__ __forceinline__ float bflo(unsigned w) { return __uint_as_float(w << 16); }
__device__ __forceinline__ float bfhi(unsigned w) { return __uint_as_float(w & 0xffff0000u); }
__device__ __forceinline__ bf16_t f2bf(float f) { return (bf16_t)(cvtpk(f, 0.f) & 0xffffu); }
__device__ __forceinline__ float wave_sum(float v) {
#pragma unroll
    for (int o = 1; o < 64; o <<= 1) v += __shfl_xor(v, o);
    return v;
}
__device__ __forceinline__ float wave_max(float v) {
#pragma unroll
    for (int o = 1; o < 64; o <<= 1) v = fmaxf(v, __shfl_xor(v, o));
    return v;
}
__device__ __forceinline__ float sigmoid_f(float x) { return __builtin_amdgcn_rcpf(1.f + __builtin_amdgcn_exp2f(-1.4426950408889634f * x)); }
__device__ __forceinline__ float silu_f(float x) { return x * __builtin_amdgcn_rcpf(1.f + __builtin_amdgcn_exp2f(-1.4426950408889634f * x)); }
__device__ __forceinline__ float logsigmoid_f(float x) { return fminf(x, 0.f) - log1pf(__expf(-fabsf(x))); }
__device__ __forceinline__ float ex2(float x) { return __builtin_amdgcn_exp2f(x); }
#define MFMA32(a, b, c) __builtin_amdgcn_mfma_f32_32x32x16_bf16(a, b, c, 0, 0, 0)
#define MFMA16(a, b, c) __builtin_amdgcn_mfma_f32_16x16x32_bf16(a, b, c, 0, 0, 0)
typedef short v4i16_t __attribute__((ext_vector_type(4)));
__device__ __forceinline__ s16x4 vtr(LAS const unsigned char* p) { return __builtin_bit_cast(s16x4, __builtin_amdgcn_ds_read_tr16_b64_v4i16((LAS v4i16_t*)p)); }
__device__ __forceinline__ int crow(int r, int hi) { return (r & 3) + 8 * (r >> 2) + 4 * hi; }
__device__ __forceinline__ u32x4 widen_pair(u32x2 A, u32x2 B) {
    const auto r0 = __builtin_amdgcn_permlane32_swap(A.x, B.x, false, false); const auto r1 = __builtin_amdgcn_permlane32_swap(A.y, B.y, false, false);
    return (u32x4){r0[0], r1[0], r0[1], r1[1]}; }
__device__ __forceinline__ u32x4 widen_rows16(u32x2 X, u32x2 Y) {
    const auto r0 = __builtin_amdgcn_permlane16_swap(X.x, Y.x, false, false); const auto r1 = __builtin_amdgcn_permlane16_swap(X.y, Y.y, false, false);
    return (u32x4){r0[0], r1[0], r0[1], r1[1]}; }
__device__ __forceinline__ u32x4 quad_transpose(u32x4 d, int lane) {
    const bool b0 = lane & 1, b1 = lane & 2;
    { const unsigned t0 = b0 ? d.x : d.y, t1 = b0 ? d.z : d.w;
      const unsigned r0 = (unsigned)__builtin_amdgcn_mov_dpp((int)t0, 0xB1, 0xF, 0xF, true), r1 = (unsigned)__builtin_amdgcn_mov_dpp((int)t1, 0xB1, 0xF, 0xF, true);
      if (b0) { d.x = r0; d.z = r1; } else { d.y = r0; d.w = r1; } }
    { const unsigned t0 = b1 ? d.x : d.z, t1 = b1 ? d.y : d.w;
      const unsigned r0 = (unsigned)__builtin_amdgcn_mov_dpp((int)t0, 0x4E, 0xF, 0xF, true), r1 = (unsigned)__builtin_amdgcn_mov_dpp((int)t1, 0x4E, 0xF, 0xF, true);
      if (b1) { d.x = r0; d.y = r1; } else { d.z = r0; d.w = r1; } }
    return d; }
__device__ __forceinline__ u32x4 pair_widen(u32x2 A, u32x2 B, int lane) {
    const bool od = lane & 1; const u32x2 t = od ? A : B;
    u32x2 r; r.x = (unsigned)__builtin_amdgcn_mov_dpp((int)t.x, 0xB1, 0xF, 0xF, true); r.y = (unsigned)__builtin_amdgcn_mov_dpp((int)t.y, 0xB1, 0xF, 0xF, true);
    return od ? (u32x4){r.x, r.y, B.x, B.y} : (u32x4){A.x, A.y, r.x, r.y}; }
__device__ __forceinline__ void pair_narrow(u32x4 v, int lane, u32x2& A, u32x2& B) {
    const bool od = lane & 1; const u32x2 lo = {v.x, v.y}, hi = {v.z, v.w}; const u32x2 t = od ? lo : hi;
    u32x2 r; r.x = (unsigned)__builtin_amdgcn_mov_dpp((int)t.x, 0xB1, 0xF, 0xF, true); r.y = (unsigned)__builtin_amdgcn_mov_dpp((int)t.y, 0xB1, 0xF, 0xF, true);
    A = od ? r : lo; B = od ? hi : r; }
__device__ __forceinline__ bf16x8 mk8(s16x4 lo, s16x4 hi) { return (bf16x8){lo[0], lo[1], lo[2], lo[3], hi[0], hi[1], hi[2], hi[3]}; }

#define XB_TMO      128
#define XB_XCNT(j)  (256  + 64 * (j))
#define XB_XSUB(j)  (1280 + 64 * (j))
#define XB_XGEN(j)  (2304 + 64 * (j))
#define XB_TOP      3328
#define XB_TOPGEN   3392
#define XCD_BAR_WORDS 3456
#define XB_SPIN_CAP (1u << 18)
__device__ __forceinline__ unsigned xb_ld(unsigned* p)              { return __hip_atomic_load(p, __ATOMIC_RELAXED, __HIP_MEMORY_SCOPE_AGENT); }
__device__ __forceinline__ unsigned xb_add(unsigned* p, unsigned v) { return __hip_atomic_fetch_add(p, v, __ATOMIC_RELAXED, __HIP_MEMORY_SCOPE_AGENT); }
__device__ __forceinline__ unsigned xb_xcc_id() { return (unsigned)__builtin_amdgcn_s_getreg((3 << 11) | 20) & 0xFu; }
#define XB_SPIN(cond, bar) do { unsigned _sp = 0; while (cond) { __builtin_amdgcn_s_sleep(1); \
    if ((++_sp & 255u) == 0u) { if (xb_ld(&(bar)[XB_TMO])) break; if (_sp > XB_SPIN_CAP) { atomicAdd(&(bar)[XB_TMO], 1u); break; } } } } while (0)
struct XcdBarrier { unsigned* bar; unsigned x; volatile LAS unsigned* st; };
__device__ __forceinline__ XcdBarrier xcd_barrier_post(unsigned* bar, volatile LAS unsigned* st) {
    XcdBarrier b; b.bar = bar; b.x = xb_xcc_id(); b.st = st;
    if (threadIdx.x == 0) (void)xb_add(&bar[XB_XCNT(b.x)], 1u);
    return b;
}
__device__ __forceinline__ void xcd_barrier_complete(unsigned* bar, unsigned x, unsigned& nloc, unsigned& nx) {
    const unsigned G = gridDim.x * gridDim.y * gridDim.z;
    unsigned sum, cnt, mine, sp = 0u;
    for (;;) {
        sum = 0u; cnt = 0u; mine = 0u;
#pragma unroll
        for (unsigned j = 0; j < 16; ++j) { const unsigned c = xb_ld(&bar[XB_XCNT(j)]); sum += c; cnt += (c > 0u) ? 1u : 0u; mine = (j == x) ? c : mine; }
        if (sum == G) break;
        __builtin_amdgcn_s_sleep(1);
        if ((++sp & 255u) == 0u) { if (xb_ld(&bar[XB_TMO])) break; if (sp > XB_SPIN_CAP) { atomicAdd(&bar[XB_TMO], 1u); break; } }
    }
    nloc = mine > 0u ? mine : 1u; nx = cnt > 0u ? cnt : 1u;
}
__device__ __forceinline__ void xcd_barrier(const XcdBarrier& b) {
    asm volatile("s_waitcnt vmcnt(0)" ::: "memory");
    __syncthreads();
    if (threadIdx.x == 0) {
        unsigned* bar = b.bar;
        __builtin_amdgcn_s_waitcnt(0);
        unsigned nloc = b.st[0], nx = b.st[1];
        if (nloc == 0u) { xcd_barrier_complete(bar, b.x, nloc, nx); b.st[0] = nloc; b.st[1] = nx; }
        const unsigned old = xb_add(&bar[XB_XSUB(b.x)], 1u);
        const unsigned gen = old / nloc;
        if (old + 1u == (gen + 1u) * nloc) {
            __builtin_amdgcn_fence(__ATOMIC_RELEASE, "agent");
            asm volatile("s_waitcnt vmcnt(0)" ::: "memory");
            const unsigned og = xb_add(&bar[XB_TOP], 1u);
            const unsigned tg = og / nx;
            if (og + 1u == (tg + 1u) * nx) xb_add(&bar[XB_TOPGEN], 1u);
            else XB_SPIN(xb_ld(&bar[XB_TOPGEN]) == tg, bar);
            __builtin_amdgcn_fence(__ATOMIC_ACQUIRE, "agent");
            xb_add(&bar[XB_XGEN(b.x)], 1u);
            asm volatile("s_waitcnt vmcnt(0)" ::: "memory");
        } else {
            XB_SPIN(xb_ld(&bar[XB_XGEN(b.x)]) == gen, bar);
            __builtin_amdgcn_fence(__ATOMIC_ACQUIRE, "agent");
            asm volatile("s_waitcnt vmcnt(0)" ::: "memory");
        }
    }
    __syncthreads();
}

struct Args { const void* in[27]; float* out; unsigned char* ws; int ph_lo, ph_hi; };
struct Frame {
    LAS unsigned char* lds;
    const void* const* in; float* out; unsigned char* ws;
    int tid, lane, wave, vcu, G;
};
#define IN_F(k) ((const float*)F.in[k])
#define WSP(T, off) ((T*)(F.ws + (off)))

namespace pg8 {
constexpr int BM = 256, BK = 64, HALF = 128, HTB = HALF * BK * 2, STAGE_BYTES = 8 * HTB, NXCD = 8, WGM = 8;
__host__ __device__ __forceinline__ int lds_byte(int r, int c) { const int st = (r >> 4) * 2 + (c >> 5), rr = r & 15, cc = c & 31, ob = rr * 64 + cc * 2; return st * 1024 + (ob ^ (((ob >> 9) & 1) << 5)); }
__host__ __device__ __forceinline__ void stage_rc(int b, int& R, int& C) { const int st = b / 1024, sb = b % 1024, swz = sb ^ (((sb >> 9) & 1) << 5); R = (st >> 1) * 16 + swz / 64; C = (st & 1) * 32 + (swz % 64) / 2; }
__host__ __device__ __forceinline__ int perm32(int rho) { const int n = rho >> 4, i = rho & 15; return 8 * (i >> 2) + 4 * n + (i & 3); }
struct Unit { int pm, pn, e, nrow; };

template <bool I8, class Epi, class Sched>
__device__ __forceinline__ void gemm_phase(LAS unsigned char* lds, const void* Abase, const void* Bbase, const int K, const Sched& S, const Epi& E) {
    const int tid = threadIdx.x, wid = __builtin_amdgcn_readfirstlane(tid >> 6), lane = tid & 63, wr = wid >> 2, wc = wid & 3, fr = lane & 15, fq = lane >> 4;
    const int nt = K / BK;
    int Rr[2], Cc[2]; unsigned voffB[2];
#pragma unroll
    for (int i = 0; i < 2; ++i) { int R, C; stage_rc(tid * 16 + i * 8192, R, C); Rr[i] = R; Cc[i] = C; const int Rb = (R & ~31) + perm32(R & 31); voffB[i] = (unsigned)(Rb * K + C) * 2u; }
    const size_t kstep = (size_t)(BK * 2);
    const size_t hstepB = (size_t)HALF * K * 2;
    const unsigned ldsw = (unsigned)wid * 1024u;
    const int aoff = lds_byte(wr * 64 + fr, fq * 8), boff = lds_byte(wc * 32 + fr, fq * 8);
#define PG8_SA(b, h) (((b) * 2 + (h)) * HTB)
#define PG8_SB(b, h) ((4 + (b) * 2 + (h)) * HTB)
#define PG8_STAGEB(bufoff, gbase) do { _Pragma("unroll") for (int _i = 0; _i < 2; ++_i) \
        __builtin_amdgcn_global_load_lds((const unsigned*)((const char*)(gbase) + voffB[_i]), (LAS unsigned*)(lds + (bufoff) + ldsw + _i * 8192), 16, 0, 0); } while (0)
#define PG8_STAGEA(bufoff, o0, o1, ktb) do { const char* _p = (const char*)Abase + (ktb); \
        __builtin_amdgcn_global_load_lds((const unsigned*)(_p + (o0)), (LAS unsigned*)(lds + (bufoff) + ldsw), 16, 0, 0); \
        __builtin_amdgcn_global_load_lds((const unsigned*)(_p + (o1)), (LAS unsigned*)(lds + (bufoff) + ldsw + 8192), 16, 0, 0); } while (0)
#define PG8_LDA(dst, b, h) do { _Pragma("unroll") for (int m = 0; m < 4; ++m) _Pragma("unroll") for (int k = 0; k < 2; ++k) dst[m][k] = *(const LAS bf16x8*)(lds + PG8_SA(b, h) + aoff + m * 2048 + k * 1024); } while (0)
#define PG8_LDB(dst, b, h) do { _Pragma("unroll") for (int n = 0; n < 2; ++n) _Pragma("unroll") for (int k = 0; k < 2; ++k) dst[n][k] = *(const LAS bf16x8*)(lds + PG8_SB(b, h) + boff + n * 2048 + k * 1024); } while (0)
#define PG8_MMA(ai, bj, At, Bt) do { __builtin_amdgcn_s_setprio(1); _Pragma("unroll") for (int m = 0; m < 4; ++m) _Pragma("unroll") for (int n = 0; n < 2; ++n) _Pragma("unroll") for (int k = 0; k < 2; ++k) { \
        if constexpr (I8) acc[ai][bj][m][n] = __builtin_bit_cast(acc_t, __builtin_amdgcn_mfma_i32_16x16x64_i8(__builtin_bit_cast(i32x4, Bt[n][k]), __builtin_bit_cast(i32x4, At[m][k]), __builtin_bit_cast(i32x4, acc[ai][bj][m][n]), 0, 0, 0)); \
        else acc[ai][bj][m][n] = __builtin_bit_cast(acc_t, __builtin_amdgcn_mfma_f32_16x16x32_bf16(Bt[n][k], At[m][k], __builtin_bit_cast(f32x4, acc[ai][bj][m][n]), 0, 0, 0)); } __builtin_amdgcn_s_setprio(0); } while (0)
#define PG8_WAIT_V(n) asm volatile("s_waitcnt vmcnt(" #n ")" ::: "memory")
#define PG8_WAIT_L(n) asm volatile("s_waitcnt lgkmcnt(" #n ")" ::: "memory")
#define PG8_BAR __builtin_amdgcn_s_barrier()
#define PG8_SCHED __builtin_amdgcn_sched_barrier(0)
    Unit cur, nxt; int ui = 0;
    if (!S.next(0, cur)) return;
    using acc_t = typename std::conditional<I8, i32x4, f32x4>::type;
    acc_t acc[2][2][4][2];
#pragma unroll
    for (int a = 0; a < 2; ++a)
#pragma unroll
        for (int b = 0; b < 2; ++b)
#pragma unroll
            for (int m = 0; m < 4; ++m)
#pragma unroll
                for (int n = 0; n < 2; ++n) acc[a][b][m][n] = __builtin_bit_cast(acc_t, (u32x4){0u, 0u, 0u, 0u});
    bf16x8 At[4][2], B0[2][2], B1[2][2];
    unsigned oc00, oc01, oc10, oc11; int kn00, kn01, kn10, kn11;
    oc00 = S.a_conv(S.a_key(cur, Rr[0])) + Cc[0] * 2; oc01 = S.a_conv(S.a_key(cur, Rr[1])) + Cc[1] * 2; oc10 = S.a_conv(S.a_key(cur, HALF + Rr[0])) + Cc[0] * 2; oc11 = S.a_conv(S.a_key(cur, HALF + Rr[1])) + Cc[1] * 2;
    const char* cB = (const char*)Bbase + S.b_off(cur);
    PG8_STAGEB(PG8_SB(0, 0), cB); PG8_STAGEA(PG8_SA(0, 0), oc00, oc01, 0); PG8_STAGEB(PG8_SB(0, 1), cB + hstepB); PG8_STAGEA(PG8_SA(0, 1), oc10, oc11, 0);
    if (wr == 1) PG8_BAR;
    PG8_WAIT_V(4); PG8_BAR;
    PG8_STAGEB(PG8_SB(1, 0), cB + kstep); PG8_STAGEA(PG8_SA(1, 0), oc00, oc01, kstep); PG8_STAGEB(PG8_SB(1, 1), cB + hstepB + kstep);
    PG8_WAIT_V(6); PG8_BAR;
    for (;;) {
        E.pre(cur, lds, wid, lane, ui & 1);
        const bool has_next = S.next(ui + 1, nxt);
        const char* nB = cB;
        if (has_next) { kn00 = S.a_key(nxt, Rr[0]); kn01 = S.a_key(nxt, Rr[1]); kn10 = S.a_key(nxt, HALF + Rr[0]); kn11 = S.a_key(nxt, HALF + Rr[1]); nB = (const char*)Bbase + S.b_off(nxt); }
        else { kn00 = 0; kn01 = 0; kn10 = 0; kn11 = 0; }
        for (int t = 0; t < nt; t += 2) {
            const bool last = (t == nt - 2);
            const size_t k1 = (size_t)(t + 1) * kstep;
            const size_t k2 = last ? 0 : (size_t)(t + 2) * kstep, k3 = k2 + kstep;
            const unsigned o200 = (last && has_next) ? S.a_conv(kn00) + Cc[0] * 2 : oc00, o201 = (last && has_next) ? S.a_conv(kn01) + Cc[1] * 2 : oc01, o210 = (last && has_next) ? S.a_conv(kn10) + Cc[0] * 2 : oc10, o211 = (last && has_next) ? S.a_conv(kn11) + Cc[1] * 2 : oc11;
            const char* b2 = last ? nB : cB + (size_t)(t + 2) * kstep; const char* b3 = b2 + kstep;
            PG8_LDB(B0, 0, 0); PG8_SCHED; PG8_LDA(At, 0, 0); PG8_STAGEA(PG8_SA(1, 1), oc10, oc11, k1);
            PG8_WAIT_L(8); PG8_BAR; PG8_WAIT_L(0); PG8_MMA(0, 0, At, B0); PG8_BAR; PG8_SCHED;
            PG8_LDB(B1, 0, 1); PG8_STAGEB(PG8_SB(0, 0), b2);
            PG8_BAR; PG8_WAIT_L(0); PG8_MMA(0, 1, At, B1); PG8_BAR;
            PG8_LDA(At, 0, 1); PG8_STAGEA(PG8_SA(0, 0), o200, o201, k2);
            PG8_BAR; PG8_WAIT_L(0); PG8_MMA(1, 0, At, B0); PG8_BAR; PG8_SCHED;
            PG8_STAGEB(PG8_SB(0, 1), b2 + hstepB);
            PG8_WAIT_V(6); PG8_BAR; PG8_MMA(1, 1, At, B1); PG8_BAR;
            PG8_LDB(B0, 1, 0); PG8_SCHED; PG8_LDA(At, 1, 0); PG8_STAGEA(PG8_SA(0, 1), o210, o211, k2);
            PG8_WAIT_L(8); PG8_BAR; PG8_WAIT_L(0); PG8_MMA(0, 0, At, B0); PG8_BAR; PG8_SCHED;
            PG8_LDB(B1, 1, 1); PG8_STAGEB(PG8_SB(1, 0), b3);
            PG8_BAR; PG8_WAIT_L(0); PG8_MMA(0, 1, At, B1); PG8_BAR;
            PG8_LDA(At, 1, 1); PG8_STAGEA(PG8_SA(1, 0), o200, o201, k3);
            PG8_BAR; PG8_WAIT_L(0); PG8_MMA(1, 0, At, B0); PG8_BAR; PG8_SCHED;
            PG8_STAGEB(PG8_SB(1, 1), b3 + hstepB);
            PG8_WAIT_V(6); PG8_BAR; PG8_MMA(1, 1, At, B1); PG8_BAR;
        }
        E(acc, cur, wr, wc, fr, fq, ui & 1);
        if (!has_next) break;
#pragma unroll
        for (int a = 0; a < 2; ++a)
#pragma unroll
            for (int b = 0; b < 2; ++b)
#pragma unroll
                for (int m = 0; m < 4; ++m)
#pragma unroll
                    for (int n = 0; n < 2; ++n) acc[a][b][m][n] = __builtin_bit_cast(acc_t, (u32x4){0u, 0u, 0u, 0u});
        cur = nxt; cB = nB; oc00 = S.a_conv(kn00) + Cc[0] * 2; oc01 = S.a_conv(kn01) + Cc[1] * 2; oc10 = S.a_conv(kn10) + Cc[0] * 2; oc11 = S.a_conv(kn11) + Cc[1] * 2; ++ui;
    }
    PG8_WAIT_V(0);
    if (wr == 0) PG8_BAR;
    PG8_BAR;
#undef PG8_SA
#undef PG8_SB
#undef PG8_STAGEA
#undef PG8_STAGEB
#undef PG8_LDA
#undef PG8_LDB
#undef PG8_MMA
#undef PG8_WAIT_V
#undef PG8_WAIT_L
#undef PG8_BAR
#undef PG8_SCHED
}

struct DenseOrder {
    int nM, nN, nwg, G, c, K;
    __device__ void init(int M, int N, int K_, int G_, int c_) { nM = M / BM; nN = N / BM; nwg = nM * nN; G = G_; c = c_; K = K_; }
    __device__ __forceinline__ bool next(int i, Unit& u) const {
        const long L = (long)i * G + c; if (L >= nwg) return false;
        int wgid = (int)L; { const int q = nwg / NXCD, r = nwg % NXCD, xcd = wgid % NXCD, off = wgid / NXCD; wgid = (xcd < r ? xcd * (q + 1) : r * (q + 1) + (xcd - r) * q) + off; }
        const int nig = WGM * nN, gid = wgid / nig, fm = gid * WGM, gsz = (nM - fm) < WGM ? (nM - fm) : WGM;
        u.pm = fm + ((wgid % nig) % gsz); u.pn = (wgid % nig) / gsz; u.e = 0; u.nrow = 256; return true;
    }
    __device__ __forceinline__ int a_key(const Unit& u, int R) const { return u.pm * BM + R; }
    __device__ __forceinline__ unsigned a_conv(int key) const { return (unsigned)(key * K) * 2u; }
    __device__ __forceinline__ size_t b_off(const Unit& u) const { return (size_t)u.pn * BM * K * 2; }
};
struct MoeOrder {
    const LAS int* tstart; const LAS int* cnt; const LAS unsigned char* etile; const int* list; int G, c, K; bool gather;
    static constexpr int npn = 4;
    __device__ __forceinline__ bool next(int i, Unit& u) const {
        const int L = i * G + c; const int tt = tstart[32];
        if (L >= tt * npn) return false;
        const int tile = L / npn; u.pn = L % npn; u.pm = tile;
        const int e = etile[tile];
        u.e = e; u.nrow = cnt[e] - (tile - tstart[e]) * 256; return true;
    }
    __device__ __forceinline__ int a_key(const Unit& u, int R) const {
        if (gather) { const int mt = u.pm - tstart[u.e]; const int r = mt * 256 + R; return list[(size_t)u.e * 65536 + (R < u.nrow ? r : 0)]; }
        return u.pm * BM + R;
    }
    __device__ __forceinline__ unsigned a_conv(int key) const { return (unsigned)(key * K) * 2u; }
    __device__ __forceinline__ size_t b_off(const Unit& u) const { return ((size_t)u.e * 1024 + (size_t)u.pn * BM) * K * 2; }
};
}

constexpr int EPI_SC = MISC_OFF + 24576;
struct EpiIn {
    unsigned char* ws; const float* gate_b;
    __device__ __forceinline__ void pre(const pg8::Unit& u, LAS unsigned char* lds, int wid, int lane, int par) const {
        if (wid == 0) { __builtin_amdgcn_global_load_lds((const unsigned*)((const float*)(ws + WS_SA1) + u.pm * 256 + lane * 4), (LAS unsigned*)(lds + EPI_SC + par * 2048), 16, 0, 0);
                        __builtin_amdgcn_global_load_lds((const unsigned*)((const float*)(ws + WS_SBW) + u.pn * 256 + lane * 4), (LAS unsigned*)(lds + EPI_SC + par * 2048 + 1024), 16, 0, 0); } }
    LAS unsigned char* lds;
    __device__ __forceinline__ void operator()(const i32x4 (&acc)[2][2][4][2], const pg8::Unit& u, int wr, int wc, int fr, int fq, int par) const {
        asm volatile("" : "+v"(fr), "+v"(fq));
        const int pn = u.pn, row0 = u.pm * 256 + wr * 64 + fr;
        float sa[2][4]; f32x4 sb[2][2];
        { LAS const float* SA1 = (LAS const float*)(lds + EPI_SC + par * 2048); LAS const float* SBW = SA1 + 256;
#pragma unroll
          for (int ai = 0; ai < 2; ++ai)
#pragma unroll
              for (int m = 0; m < 4; ++m) sa[ai][m] = SA1[wr * 64 + fr + ai * 128 + m * 16];
#pragma unroll
          for (int bj = 0; bj < 2; ++bj)
#pragma unroll
              for (int n = 0; n < 2; ++n) sb[bj][n] = *(LAS const f32x4*)(SBW + bj * 128 + wc * 32 + 8 * fq + 4 * n); }
#define ACCF(ai, bj, m, n) (__builtin_convertvector(acc[ai][bj][m][n], f32x4) * sa[ai][m] * sb[bj][n])
        if (pn < 8) {
            bf16_t* dst = (bf16_t*)(ws + (pn < 2 ? WS_MQ : pn < 4 ? WS_MK : pn < 6 ? WS_MV : WS_MO));
            const int col0 = (pn & 1) * 256 + wc * 32 + 8 * fq;
#pragma unroll
            for (int ai = 0; ai < 2; ++ai)
#pragma unroll
                for (int m = 0; m < 4; ++m) { bf16_t* rp = dst + (size_t)(row0 + ai * 128 + m * 16) * 512 + col0;
#pragma unroll
                    for (int bj = 0; bj < 2; ++bj) { const f32x4 v0 = ACCF(ai, bj, m, 0), v1 = ACCF(ai, bj, m, 1);
                        u32x4 w; w.x = cvtpk(v0[0], v0[1]); w.y = cvtpk(v0[2], v0[3]); w.z = cvtpk(v1[0], v1[1]); w.w = cvtpk(v1[2], v1[3]);
                        *(u32x4*)(rp + bj * 128) = w; } }
        } else if (pn < 10) {
            const int g8 = 4 * (wc & 1) + fq; const float* COS = (const float*)(ws + WS_COS); const float* SIN = (const float*)(ws + WS_SIN); bf16_t* NQ = (bf16_t*)(ws + WS_NQ);
#pragma unroll
            for (int ai = 0; ai < 2; ++ai)
#pragma unroll
                for (int m = 0; m < 4; ++m) { const int row = row0 + ai * 128 + m * 16;
                    const f32x4 cs = *(const f32x4*)(COS + (size_t)row * 32 + 4 * g8), sn = *(const f32x4*)(SIN + (size_t)row * 32 + 4 * g8);
#pragma unroll
                    for (int bj = 0; bj < 2; ++bj) { const int head = (pn - 8) * 4 + bj * 2 + (wc >> 1);
                        const f32x4 x1 = ACCF(ai, bj, m, 0), x2 = ACCF(ai, bj, m, 1);
                        const f32x4 o1 = (x1 * cs - x2 * sn) * QSCALE, o2 = (x2 * cs + x1 * sn) * QSCALE;
                        bf16_t* rp = NQ + (size_t)row * 512 + head * 64 + 4 * (g8 & ~1) + 32 * (fq & 1);
                        u32x2 a; a.x = cvtpk(o1[0], o1[1]); a.y = cvtpk(o1[2], o1[3]);
                        u32x2 b; b.x = cvtpk(o2[0], o2[1]); b.y = cvtpk(o2[2], o2[3]); *(u32x4*)rp = widen_rows16(a, b); } }
        } else if (pn < 13) {
            bf16_t* kd = (bf16_t*)(ws + (pn == 10 ? WS_KC : pn == 11 ? WS_KSL : WS_KWN)); bf16_t* vd = (bf16_t*)(ws + (pn == 10 ? WS_VC : pn == 11 ? WS_VSL : WS_VWN));
            const float* COS = (const float*)(ws + WS_COS); const float* SIN = (const float*)(ws + WS_SIN);
            const int g8 = 4 * (wc & 1) + fq, grp = wc >> 1;
#pragma unroll
            for (int ai = 0; ai < 2; ++ai)
#pragma unroll
                for (int m = 0; m < 4; ++m) { const int row = row0 + ai * 128 + m * 16; const int b = row >> 12, s = row & 4095;
                    const f32x4 cs = *(const f32x4*)(COS + (size_t)row * 32 + 4 * g8), sn = *(const f32x4*)(SIN + (size_t)row * 32 + 4 * g8);
                    const size_t rbase = ((size_t)(b * 2 + grp) * SEQ + s) * 64;
                    { const f32x4 x1 = ACCF(ai, 0, m, 0), x2 = ACCF(ai, 0, m, 1);
                      const f32x4 o1 = x1 * cs - x2 * sn, o2 = x2 * cs + x1 * sn;
                      bf16_t* rp = kd + rbase + 4 * (g8 & ~1) + 32 * (fq & 1);
                      u32x2 a; a.x = cvtpk(o1[0], o1[1]); a.y = cvtpk(o1[2], o1[3]);
                      u32x2 c; c.x = cvtpk(o2[0], o2[1]); c.y = cvtpk(o2[2], o2[3]); *(u32x4*)rp = widen_rows16(a, c); }
                    { const f32x4 v0 = ACCF(ai, 1, m, 0), v1 = ACCF(ai, 1, m, 1);
                      u32x4 w; w.x = cvtpk(v0[0], v0[1]); w.y = cvtpk(v0[2], v0[3]); w.z = cvtpk(v1[0], v1[1]); w.w = cvtpk(v1[2], v1[3]);
                      *(u32x4*)(vd + rbase + (wc & 1) * 32 + 8 * fq) = w; } }
        } else {
            if (wc == 0) { float* GI = (float*)(ws + WS_GI); float* GF = (float*)(ws + WS_GF); float* NGT = (float*)(ws + WS_NGT);
#pragma unroll
                for (int ai = 0; ai < 2; ++ai)
#pragma unroll
                    for (int m = 0; m < 4; ++m) { const int row = row0 + ai * 128 + m * 16; const int b = row >> 12, s = row & 4095;
#pragma unroll
                        for (int n = 0; n < 2; ++n) { const f32x4 v = ACCF(ai, 0, m, n);
                            if (fq == 0) {
#pragma unroll
                                for (int i = 0; i < 4; ++i) { const float z = v[i] + gate_b[4 * n + i];
                                    if (n == 0) GI[(size_t)(b * 4 + i) * SEQ + s] = z; else GF[(size_t)(b * 4 + i) * SEQ + s] = logsigmoid_f(z); }
                            } else {
                                f32x4 o; o[0] = sigmoid_f(v[0]); o[1] = sigmoid_f(v[1]); o[2] = sigmoid_f(v[2]); o[3] = sigmoid_f(v[3]);
                                *(f32x4*)(NGT + (size_t)row * 24 + 8 * fq + 4 * n - 8) = o; } } }
            }
        }
    }
};
#undef ACCF
struct EpiBf16 {
    bf16_t* O; int ldc;
    __device__ __forceinline__ void pre(const pg8::Unit&, LAS unsigned char*, int, int, int) const {}
    __device__ __forceinline__ void operator()(const f32x4 (&acc)[2][2][4][2], const pg8::Unit& u, int wr, int wc, int fr, int fq, int par) const {
        asm volatile("" : "+v"(fr), "+v"(fq));
        const int row0 = u.pm * 256 + wr * 64 + fr, col0 = u.pn * 256 + wc * 32 + 8 * fq;
#pragma unroll
        for (int ai = 0; ai < 2; ++ai)
#pragma unroll
            for (int m = 0; m < 4; ++m) { bf16_t* rp = O + (size_t)(row0 + ai * 128 + m * 16) * ldc + col0;
#pragma unroll
                for (int bj = 0; bj < 2; ++bj) { const f32x4 v0 = acc[ai][bj][m][0], v1 = acc[ai][bj][m][1];
                    u32x4 w; w.x = cvtpk(v0[0], v0[1]); w.y = cvtpk(v0[2], v0[3]); w.z = cvtpk(v1[0], v1[1]); w.w = cvtpk(v1[2], v1[3]);
                    *(u32x4*)(rp + bj * 128) = w; } }
    }
};
struct EpiUp {
    bf16_t* HB;
    __device__ __forceinline__ void pre(const pg8::Unit&, LAS unsigned char*, int, int, int) const {}
    __device__ __forceinline__ void operator()(const f32x4 (&acc)[2][2][4][2], const pg8::Unit& u, int wr, int wc, int fr, int fq, int par) const {
        asm volatile("" : "+v"(fr), "+v"(fq));
        const int row0 = u.pm * 256 + wr * 64 + fr, col0 = (u.pn * 256 + wc * 32 + 8 * fq) >> 1;
#pragma unroll
        for (int ai = 0; ai < 2; ++ai)
#pragma unroll
            for (int m = 0; m < 4; ++m) { bf16_t* rp = HB + (size_t)(row0 + ai * 128 + m * 16) * EFF + col0;
#pragma unroll
                for (int bj = 0; bj < 2; ++bj) { const f32x4 a1 = acc[ai][bj][m][0], a3 = acc[ai][bj][m][1];
                    u32x2 w; w.x = cvtpk(silu_f(a1[0]) * a3[0], silu_f(a1[1]) * a3[1]); w.y = cvtpk(silu_f(a1[2]) * a3[2], silu_f(a1[3]) * a3[3]);
                    *(u32x2*)(rp + bj * 64) = w; } }
    }
};

struct EpiUpI8 {
    bf16_t* HB; const float* SAL; const float* SB; const LAS int* tstart; LAS unsigned char* lds;
    __device__ __forceinline__ void pre(const pg8::Unit& u, LAS unsigned char* l, int wid, int lane, int par) const {
        if (wid == 0) { const int mt = u.pm - tstart[u.e];
            __builtin_amdgcn_global_load_lds((const unsigned*)(SAL + (size_t)u.e * 65536 + mt * 256 + lane * 4), (LAS unsigned*)(l + EPI_SC + par * 2048), 16, 0, 0);
            __builtin_amdgcn_global_load_lds((const unsigned*)(SB + (size_t)u.e * 1024 + u.pn * 256 + lane * 4), (LAS unsigned*)(l + EPI_SC + par * 2048 + 1024), 16, 0, 0); } }
    __device__ __forceinline__ void operator()(const i32x4 (&acc)[2][2][4][2], const pg8::Unit& u, int wr, int wc, int fr, int fq, int par) const {
        asm volatile("" : "+v"(fr), "+v"(fq));
        const int rl0 = wr * 64 + fr, row0 = u.pm * 256 + rl0, colp = u.pn * 256 + wc * 32 + 8 * fq, col0 = colp >> 1;
        LAS const float* LSA = (LAS const float*)(lds + EPI_SC + par * 2048); LAS const float* LSB = LSA + 256;
        f32x4 sb[2][2];
#pragma unroll
        for (int bj = 0; bj < 2; ++bj)
#pragma unroll
            for (int n = 0; n < 2; ++n) sb[bj][n] = *(LAS const f32x4*)(LSB + wc * 32 + 8 * fq + bj * 128 + 4 * n);
#pragma unroll
        for (int ai = 0; ai < 2; ++ai)
#pragma unroll
            for (int m = 0; m < 4; ++m) { const int R = rl0 + ai * 128 + m * 16; const float sa = LSA[R];
                bf16_t* rp = HB + (size_t)(row0 + ai * 128 + m * 16) * EFF + (col0 & ~7) + 64 * (fq & 1);
                u32x2 wv[2];
#pragma unroll
                for (int bj = 0; bj < 2; ++bj) { const i32x4 i1 = acc[ai][bj][m][0], i3 = acc[ai][bj][m][1];
                    f32x4 a1, a3;
#pragma unroll
                    for (int i = 0; i < 4; ++i) { a1[i] = (float)i1[i] * sa * sb[bj][0][i]; a3[i] = (float)i3[i] * sa * sb[bj][1][i]; }
                    wv[bj].x = cvtpk(silu_f(a1[0]) * a3[0], silu_f(a1[1]) * a3[1]); wv[bj].y = cvtpk(silu_f(a1[2]) * a3[2], silu_f(a1[3]) * a3[3]); }
                *(u32x4*)rp = widen_rows16(wv[0], wv[1]); }
    }
};

template <class RM>
__device__ __forceinline__ void transpose_item(const float* W, int N, bf16_t* WT, int Kd, LAS float* scr, int k0, int n0, int lane, const RM& rm) {
#pragma unroll
    for (int i = 0; i < 8; ++i) { const int kk = 8 * i + (lane >> 3); const f32x4 w4 = *(const f32x4*)(W + (size_t)(k0 + kk) * N + n0 + 4 * (lane & 7));
        LAS float* d = scr + kk * 33 + 4 * (lane & 7); d[0] = w4[0]; d[1] = w4[1]; d[2] = w4[2]; d[3] = w4[3]; }
    asm volatile("s_waitcnt lgkmcnt(0)" ::: "memory");
    const int c = lane & 7;
#pragma unroll
    for (int j = 0; j < 4; ++j) { const int n = (lane >> 3) + 8 * j; const LAS float* s = scr + (8 * c) * 33 + n;
        u32x4 o; o.x = cvtpk(s[0 * 33], s[1 * 33]); o.y = cvtpk(s[2 * 33], s[3 * 33]); o.z = cvtpk(s[4 * 33], s[5 * 33]); o.w = cvtpk(s[6 * 33], s[7 * 33]);
        *(u32x4*)(WT + (size_t)rm(n0 + n) * Kd + k0 + 8 * c) = o; }
    asm volatile("s_waitcnt lgkmcnt(0)" ::: "memory");
}
struct RmId { int off; __device__ __forceinline__ int operator()(int n) const { return off + n; } };
__device__ __forceinline__ int rope_pl(int d) { return 8 * ((d & 31) >> 2) + 4 * (d >> 5) + (d & 3); }
struct RmWin {
    __device__ __forceinline__ int operator()(int c) const {
        if (c < 2048) return c;
        if (c < 2052) return 3328 + (c - 2048);
        if (c < 2056) return 3332 + (c - 2052);
        if (c < 2568) { const int x = c - 2056; return 2048 + (x & ~63) + rope_pl(x & 63); }
        if (c < 2696) { const int x = c - 2568; return 2560 + (x & ~63) + rope_pl(x & 63); }
        if (c < 2824) return 2688 + (c - 2696);
        if (c < 2952) { const int x = c - 2824; return 2816 + (x & ~63) + rope_pl(x & 63); }
        if (c < 3080) return 2944 + (c - 2952);
        if (c < 3208) { const int x = c - 3080; return 3072 + (x & ~63) + rope_pl(x & 63); }
        if (c < 3336) return 3200 + (c - 3208);
        return c;
    }
};
struct RmW13 { int sel; __device__ __forceinline__ int operator()(int j) const { return 8 * (j >> 2) + 4 * sel + (j & 3); } };

__device__ __forceinline__ void p0_phase(Frame& F) {
    const int tid = F.tid, lane = F.lane;
    const int NA = F.G > 64 ? 64 : F.G;
    const bool split = F.G > NA;
    if (F.vcu < NA) {
        LAS float* sc = (LAS float*)F.lds; LAS float* red = (LAS float*)(F.lds + 32768);
        const float* c = IN_F(1);
        for (int i = tid; i < 8192; i += NTHR) sc[i] = silu_f(c[i]);
        __syncthreads();
        const float* W = IN_F(3); const float* bia = IN_F(4); float* mod = WSP(float, WS_MOD);
        for (int cg = F.vcu; cg < 64; cg += NA) {
            const int col0 = cg * 96;
            const int kq = tid / 24, cq = tid % 24;
            f32x4 a[8];
#pragma unroll
            for (int b = 0; b < 8; ++b) a[b] = (f32x4){0.f, 0.f, 0.f, 0.f};
            if (tid < 504) {
#pragma unroll 4
                for (int k = kq; k < 1024; k += 21) { const f32x4 w = *(const f32x4*)(W + (size_t)k * 6144 + col0 + 4 * cq);
#pragma unroll
                    for (int b = 0; b < 8; ++b) a[b] += w * sc[b * 1024 + k]; }
#pragma unroll
                for (int b = 0; b < 8; ++b) *(LAS f32x4*)(red + (size_t)(tid * 8 + b) * 4) = a[b];
            }
            __syncthreads();
            for (int o = tid; o < 768; o += NTHR) { const int cq2 = o >> 5, bj = o & 31;
                float sacc = 0.f;
                for (int q = 0; q < 21; ++q) sacc += red[(size_t)((q * 24 + cq2) * 8) * 4 + bj];
                const int col = col0 + 4 * cq2 + (bj & 3);
                mod[(bj >> 2) * 6144 + col] = sacc + bia[col]; }
            __syncthreads();
        }
    }
    if (!split || F.vcu >= NA) {
        LAS float* scr = (LAS float*)(F.lds + F.wave * 8448);
        const int gw = (split ? F.vcu - NA : F.vcu) * NWAVES + F.wave, NGW = (split ? F.G - NA : F.G) * NWAVES;
        constexpr int I_WOUT = 16 * 32, I_C1 = 32 * 4, I_C2 = 2 * 2;
        constexpr int NITEMS = I_WOUT + 2 * I_C1 + 2 * I_C2;
        for (int it = gw; it < NITEMS; it += NGW) {
            int r = it;
            if (r < I_WOUT) { transpose_item(IN_F(19), 1024, WSP(bf16_t, WS_WOUTT), 1024, scr, (r / 32) * 64, (r % 32) * 32, lane, RmId{0}); continue; } r -= I_WOUT;
            if (r < I_C1) { transpose_item(IN_F(14), 128, WSP(bf16_t, WS_CW1K), 2048, scr, (r / 4) * 64, (r % 4) * 32, lane, RmId{0}); continue; } r -= I_C1;
            if (r < I_C1) { transpose_item(IN_F(17), 128, WSP(bf16_t, WS_CW1V), 2048, scr, (r / 4) * 64, (r % 4) * 32, lane, RmId{0}); continue; } r -= I_C1;
            if (r < I_C2) { transpose_item(IN_F(15), 64, WSP(bf16_t, WS_CW2K), 128, scr, (r / 2) * 64, (r % 2) * 32, lane, RmId{0}); continue; } r -= I_C2;
            transpose_item(IN_F(18), 64, WSP(bf16_t, WS_CW2V), 128, scr, (r / 2) * 64, (r % 2) * 32, lane, RmId{0});
        }
    }
    __syncthreads();
    {
        LAS unsigned* AM = (LAS unsigned*)F.lds; const int n4 = tid & 7, kq = tid >> 3; const RmWin rmw{};
        for (int it = (F.vcu + F.G - (split ? NA : 0)) % F.G; it < 105; it += F.G) {
            const int c0 = 32 * it + 4 * n4; const float* W = IN_F(9) + (size_t)(16 * kq) * INW + c0;
            if (tid < 32) AM[tid] = 0u;
            __syncthreads();
            f32x4 v[16]; f32x4 am = {0.f, 0.f, 0.f, 0.f};
#pragma unroll
            for (int i = 0; i < 16; ++i) { v[i] = *(const f32x4*)(W + (size_t)i * INW);
#pragma unroll
                for (int c = 0; c < 4; ++c) am[c] = fmaxf(am[c], fabsf(v[i][c])); }
#pragma unroll
            for (int o = 8; o < 64; o <<= 1) {
#pragma unroll
                for (int c = 0; c < 4; ++c) am[c] = fmaxf(am[c], __shfl_xor(am[c], o)); }
            if ((tid & 63) < 8) {
#pragma unroll
                for (int c = 0; c < 4; ++c) atomicMax((unsigned*)&AM[4 * n4 + c], __float_as_uint(am[c])); }
            __syncthreads();
            const f32x4 amax = *(LAS const f32x4*)((LAS const float*)AM + 4 * n4);
#pragma unroll
            for (int c = 0; c < 4; ++c) { const float inv = amax[c] > 0.f ? 127.f / amax[c] : 0.f; const int prow = rmw(c0 + c); u32x4 o;
#pragma unroll
                for (int d = 0; d < 4; ++d) {
                    const int q0 = (int)rintf(v[4 * d][c] * inv), q1 = (int)rintf(v[4 * d + 1][c] * inv), q2 = (int)rintf(v[4 * d + 2][c] * inv), q3 = (int)rintf(v[4 * d + 3][c] * inv);
                    o[d] = (unsigned)(q0 & 0xff) | ((unsigned)(q1 & 0xff) << 8) | ((unsigned)(q2 & 0xff) << 16) | ((unsigned)(q3 & 0xff) << 24); }
                *(u32x4*)((unsigned char*)(F.ws + WS_WINT) + (size_t)prow * 1024 + 16 * kq) = o;
                if (kq == 0) WSP(float, WS_SBW)[prow] = amax[c] * (1.f / 127.f); }
            __syncthreads();
        }
    }
    {
        const size_t gt = (size_t)F.vcu * NTHR + tid, NGT_ = (size_t)F.G * NTHR;
        const int* pos = (const int*)F.in[2]; float* COS = WSP(float, WS_COS); float* SIN = WSP(float, WS_SIN);
        {
            const int d = (int)(gt & 31); const float inv = powf(10000.f, -(float)d / 32.f);
            for (size_t i = gt; i < (size_t)NTOK * 32; i += NGT_) { const int row = (int)(i >> 5);
                const float ang = (float)pos[row] * inv; const float kk = rintf(ang * 0.15915494309189535f);
                float r = fmaf(-kk, 6.28125f, ang); r = fmaf(-kk, 1.9353071795864769e-3f, r);
                float sn, cs; sincosf(r, &sn, &cs); COS[i] = cs; SIN[i] = sn; } }
        { unsigned* z = (unsigned*)(F.ws + WS_WINT + (size_t)3360 * 1024); for (size_t i = gt; i < (size_t)224 * 256; i += NGT_) z[i] = 0u;
          for (size_t i = gt; i < 224; i += NGT_) WSP(float, WS_SBW)[3360 + i] = 0.f; }
        { const float* wg = IN_F(20); const float* we = IN_F(22); _Float16* RWT = WSP(_Float16, WS_RWT);
          for (size_t i = gt; i < 48 * 1024; i += NGT_) { const int n = (int)(i >> 10), k = (int)(i & 1023);
              const float w = n < 4 ? wg[k * 4 + n] : n < 36 ? we[k * 32 + n - 4] : 0.f; RWT[i] = (_Float16)w; } }
        { bf16_t* kc = WSP(bf16_t, WS_KCMP); bf16_t* vc = WSP(bf16_t, WS_VCMP);
          for (size_t i = gt; i < 16 * 64; i += NGT_) { const size_t o = ((i >> 6) * 256 + 255) * 64 + (i & 63); kc[o] = 0; vc[o] = 0; } }
    }
    __syncthreads();
    if (F.vcu >= F.G - 16) {
        const int bi = F.vcu - (F.G - 16), kv = bi >> 3, cg = bi & 7;
        const float* pe = IN_F(kv == 0 ? 13 : 16); const float* w1 = IN_F(kv == 0 ? 14 : 17);
        LAS float* red = (LAS float*)F.lds;
        const int col = cg * 16 + (tid & 15), sl = tid >> 4; float sacc = 0.f;
#pragma unroll 8
        for (int k = sl * 64; k < sl * 64 + 64; ++k) sacc += pe[k] * w1[(size_t)k * 128 + col];
        red[tid] = sacc; __syncthreads();
        if (tid < 16) { float t2 = 0.f; for (int q = 0; q < 32; ++q) t2 += red[q * 16 + tid]; WSP(float, WS_C1B)[kv * 128 + cg * 16 + tid] = t2; }
    }
    __syncthreads();
}

__device__ __forceinline__ void p1a_phase(Frame& F) {
    const int gw = F.vcu * NWAVES + F.wave, NGW = F.G * NWAVES, lane = F.lane;
    const float* x = IN_F(0); const float* nw = IN_F(5); const float* mod = WSP(float, WS_MOD); signed char* H1Q = (signed char*)(F.ws + WS_H1);
    for (int row0 = gw * 4; row0 < NTOK; row0 += NGW * 4) {
        f32x4 v[4][4]; float ss[4];
#pragma unroll
        for (int r = 0; r < 4; ++r) { const f32x4* xr = (const f32x4*)(x + (size_t)(row0 + r) * DM) + lane;
#pragma unroll
            for (int j = 0; j < 4; ++j) v[r][j] = __builtin_nontemporal_load(xr + 64 * j); }
#pragma unroll
        for (int r = 0; r < 4; ++r) { float a = 0.f;
#pragma unroll
            for (int j = 0; j < 4; ++j) a += v[r][j][0] * v[r][j][0] + v[r][j][1] * v[r][j][1] + v[r][j][2] * v[r][j][2] + v[r][j][3] * v[r][j][3];
            ss[r] = a; }
#pragma unroll
        for (int o = 1; o < 64; o <<= 1) {
#pragma unroll
            for (int r = 0; r < 4; ++r) ss[r] += __shfl_xor(ss[r], o); }
        const int b = row0 >> 12; float am[4] = {0.f, 0.f, 0.f, 0.f};
#pragma unroll
        for (int j = 0; j < 4; ++j) { const int k = 4 * lane + 256 * j;
            const f32x4 w = *(const f32x4*)(nw + k), sh = *(const f32x4*)(mod + b * 6144 + k), sc = *(const f32x4*)(mod + b * 6144 + 1024 + k);
            const f32x4 ws = w * (sc + 1.f);
#pragma unroll
            for (int r = 0; r < 4; ++r) { const float rr = rsqrtf(ss[r] * (1.f / DM) + RMS_EPS);
                const f32x4 h = v[r][j] * rr * ws + sh; v[r][j] = h;
                am[r] = fmaxf(am[r], fmaxf(fmaxf(fabsf(h[0]), fabsf(h[1])), fmaxf(fabsf(h[2]), fabsf(h[3])))); } }
#pragma unroll
        for (int o = 1; o < 64; o <<= 1) {
#pragma unroll
            for (int r = 0; r < 4; ++r) am[r] = fmaxf(am[r], __shfl_xor(am[r], o)); }
#pragma unroll
        for (int r = 0; r < 4; ++r) { const float inv = am[r] > 0.f ? 127.f / am[r] : 0.f;
            if (lane == 0) WSP(float, WS_SA1)[row0 + r] = am[r] * (1.f / 127.f);
            u32x4 pk;
#pragma unroll
            for (int j = 0; j < 4; ++j) { const f32x4 q = v[r][j] * inv;
                const int q0 = (int)rintf(q[0]), q1 = (int)rintf(q[1]), q2 = (int)rintf(q[2]), q3 = (int)rintf(q[3]);
                pk[j] = (unsigned)(q0 & 0xff) | ((unsigned)(q1 & 0xff) << 8) | ((unsigned)(q2 & 0xff) << 16) | ((unsigned)(q3 & 0xff) << 24); }
            *(u32x4*)(H1Q + (size_t)(row0 + r) * DM + 256 * (lane & 3) + 16 * (lane >> 2)) = quad_transpose(pk, lane); }
    }
}

__device__ __forceinline__ void conv_silu16(const bf16_t* src  , const float* cw  , int b, int s, int ch0  , float scale, float (&o)[16]) {
#pragma unroll
    for (int i = 0; i < 16; ++i) o[i] = 0.f;
#pragma unroll
    for (int j = 0; j < 4; ++j) { const int ss = s - 3 + j;
        if (ss >= 0) { const bf16_t* rp = src + ((size_t)b * SEQ + ss) * 512 + ch0;
            const u32x4 a = *(const u32x4*)rp, c = *(const u32x4*)(rp + 8);
            const float* w = cw + j * 1024;
            const f32x4 w0 = *(const f32x4*)w, w1 = *(const f32x4*)(w + 4), w2 = *(const f32x4*)(w + 8), w3 = *(const f32x4*)(w + 12);
            o[0] += bflo(a.x) * w0[0]; o[1] += bfhi(a.x) * w0[1]; o[2] += bflo(a.y) * w0[2]; o[3] += bfhi(a.y) * w0[3];
            o[4] += bflo(a.z) * w1[0]; o[5] += bfhi(a.z) * w1[1]; o[6] += bflo(a.w) * w1[2]; o[7] += bfhi(a.w) * w1[3];
            o[8] += bflo(c.x) * w2[0]; o[9] += bfhi(c.x) * w2[1]; o[10] += bflo(c.y) * w2[2]; o[11] += bfhi(c.y) * w2[3];
            o[12] += bflo(c.z) * w3[0]; o[13] += bfhi(c.z) * w3[1]; o[14] += bflo(c.w) * w3[2]; o[15] += bfhi(c.w) * w3[3]; } }
#pragma unroll
    for (int i = 0; i < 16; ++i) o[i] = silu_f(o[i]) * scale;
}
constexpr int RAWS = 272, RAWIMG = 67 * RAWS + 208;
__device__ __forceinline__ void stage_raw(const bf16_t* src, int b, int s0, int h, LAS unsigned char* RAW, int tid) {
    const int s = tid >> 3, chg = tid & 7;
    const bf16_t* rp = src + ((size_t)b * SEQ + s0 + s) * 512 + h * 128 + chg * 16;
    *(LAS u32x4*)(RAW + (s + 3) * RAWS + chg * 32) = *(const u32x4*)rp; *(LAS u32x4*)(RAW + (s + 3) * RAWS + chg * 32 + 16) = *(const u32x4*)(rp + 8);
    if (s < 3) { u32x4 a = {0u, 0u, 0u, 0u}, c = a; const int ss = s0 - 3 + s;
        if (ss >= 0) { const bf16_t* hp = src + ((size_t)b * SEQ + ss) * 512 + h * 128 + chg * 16; a = *(const u32x4*)hp; c = *(const u32x4*)(hp + 8); }
        *(LAS u32x4*)(RAW + s * RAWS + chg * 32) = a; *(LAS u32x4*)(RAW + s * RAWS + chg * 32 + 16) = c; }
}
__device__ __forceinline__ void conv_lds16(LAS const unsigned char* RAW, LAS const float* WL, int s, int ch0, float scale, float (&o)[16]) {
#pragma unroll
    for (int i = 0; i < 16; ++i) o[i] = 0.f;
#pragma unroll
    for (int j = 0; j < 4; ++j) { const u32x4 a = *(LAS const u32x4*)(RAW + (s + j) * RAWS + ch0 * 2), c = *(LAS const u32x4*)(RAW + (s + j) * RAWS + ch0 * 2 + 16);
        const LAS float* w = WL + j * 128 + ch0;
        const f32x4 w0 = *(LAS const f32x4*)w, w1 = *(LAS const f32x4*)(w + 4), w2 = *(LAS const f32x4*)(w + 8), w3 = *(LAS const f32x4*)(w + 12);
        o[0] += bflo(a.x) * w0[0]; o[1] += bfhi(a.x) * w0[1]; o[2] += bflo(a.y) * w0[2]; o[3] += bfhi(a.y) * w0[3];
        o[4] += bflo(a.z) * w1[0]; o[5] += bfhi(a.z) * w1[1]; o[6] += bflo(a.w) * w1[2]; o[7] += bfhi(a.w) * w1[3];
        o[8] += bflo(c.x) * w2[0]; o[9] += bfhi(c.x) * w2[1]; o[10] += bflo(c.y) * w2[2]; o[11] += bfhi(c.y) * w2[3];
        o[12] += bflo(c.z) * w3[0]; o[13] += bfhi(c.z) * w3[1]; o[14] += bflo(c.w) * w3[2]; o[15] += bfhi(c.w) * w3[3]; }
#pragma unroll
    for (int i = 0; i < 16; ++i) o[i] = silu_f(o[i]) * scale;
}
constexpr int TRT = 4096 + 64, RCH = 1024 + 16;
constexpr int TRIMG = 4 * TRT, ROWIMG = 16 * RCH;
__device__ __forceinline__ unsigned tr_lane_off(int lane) { const int hi = lane >> 5; return ((lane >> 4) & 1) * 32 + (lane & 3) * 8 + (4 * hi + ((lane & 15) >> 2)) * 64; }

#if DBG_CHECK == 2
#define DBGF(code, val) do { const float _v = (val); if ((__float_as_uint(_v) & 0x7f800000u) == 0x7f800000u) atomicMin((unsigned*)(F.ws + WS_CTL) + CW_DBG, (unsigned)(code)); } while (0)
#else
#define DBGF(code, val) do {} while (0)
#endif
struct MaPF { u32x4 k0, k1, v0, v1, hk0, hk1; float wk, g0, g1; };
__device__ __forceinline__ void mlstm_a_load(Frame& F, int job, int tid, MaPF& pf) {
    const int lane = tid & 63, w = F.wave;
    const int bh = job >> 6, c = job & 63, b = bh >> 2, h = bh & 3, s0 = c * 64, s = tid >> 3, chg = tid & 7;
    const size_t ro = ((size_t)b * SEQ + s0 + s) * 512 + h * 128 + chg * 16;
    const bf16_t* kp = WSP(bf16_t, WS_MK) + ro; const bf16_t* vp = WSP(bf16_t, WS_MV) + ro;
    pf.k0 = *(const u32x4*)kp; pf.k1 = *(const u32x4*)(kp + 8); pf.v0 = *(const u32x4*)vp; pf.v1 = *(const u32x4*)(vp + 8);
    pf.hk0 = (u32x4){0u, 0u, 0u, 0u}; pf.hk1 = pf.hk0;
    if (s < 3 && s0 - 3 + s >= 0) { const bf16_t* hp = WSP(bf16_t, WS_MK) + ((size_t)b * SEQ + s0 - 3 + s) * 512 + h * 128 + chg * 16; pf.hk0 = *(const u32x4*)hp; pf.hk1 = *(const u32x4*)(hp + 8); }
    pf.wk = IN_F(10)[(tid >> 7) * 1024 + 512 + h * 128 + (tid & 127)];
    pf.g0 = 0.f; pf.g1 = 0.f;
    if (w == 0) { pf.g0 = WSP(float, WS_GF)[(size_t)bh * SEQ + s0 + lane]; pf.g1 = WSP(float, WS_GI)[(size_t)bh * SEQ + s0 + lane]; }
}
__device__ __forceinline__ void mlstm_a_phase(Frame& F) {
    int tid = F.tid; asm volatile("" : "+v"(tid));
    const int lane = tid & 63, w = F.wave, r32 = lane & 31, hi = lane >> 5;
    LAS unsigned char* kimg = F.lds; LAS unsigned char* vimg = F.lds + TRIMG; LAS float* wS = (LAS float*)(F.lds + 2 * TRIMG);
    LAS unsigned char* RAWK = F.lds + 2 * TRIMG + 1024; LAS float* WLK = (LAS float*)(RAWK + RAWIMG);
    LAS bf16_t* OST = (LAS bf16_t*)(F.lds + 2 * TRIMG + 1024 + RAWIMG + 2048) + w * 2048;
    MaPF pf; int job = F.vcu;
    if (job < 2048) mlstm_a_load(F, job, tid, pf);
    for (; job < 2048; job += F.G) {
        {
            const int s = tid >> 3, chg = tid & 7;
            *(LAS u32x4*)(RAWK + (s + 3) * RAWS + chg * 32) = pf.k0; *(LAS u32x4*)(RAWK + (s + 3) * RAWS + chg * 32 + 16) = pf.k1;
            if (s < 3) { *(LAS u32x4*)(RAWK + s * RAWS + chg * 32) = pf.hk0; *(LAS u32x4*)(RAWK + s * RAWS + chg * 32 + 16) = pf.hk1; }
            WLK[tid] = pf.wk;
            if (w == 0) {
                float bs = pf.g0;
#pragma unroll
                for (int o = 1; o < 64; o <<= 1) { const float x = __shfl_up(bs, o); if (lane >= o) bs += x; }
                const float g = __shfl(bs, 63);
                const float a = g - bs + pf.g1; const float ml = wave_max(a);
                wS[lane] = __expf(a - ml);
                if (lane == 0) { WSP(float, WS_GSUM)[job] = g; WSP(float, WS_MLOC)[job] = ml; }
            }
        }
        const u32x4 va = pf.v0, vd = pf.v1;
        __syncthreads();
        if (job + F.G < 2048) mlstm_a_load(F, job + F.G, tid, pf);
        {
            const int s = tid >> 3, chg = tid & 7, ch0 = chg * 16;
            float kf[16]; conv_lds16(RAWK, WLK, s, ch0, 0.08838834764831845f, kf);
            const unsigned off = (ch0 >> 5) * TRT + s * 64 + (ch0 & 31) * 2;
            u32x4 k0, k1; k0.x = cvtpk(kf[0], kf[1]); k0.y = cvtpk(kf[2], kf[3]); k0.z = cvtpk(kf[4], kf[5]); k0.w = cvtpk(kf[6], kf[7]);
            k1.x = cvtpk(kf[8], kf[9]); k1.y = cvtpk(kf[10], kf[11]); k1.z = cvtpk(kf[12], kf[13]); k1.w = cvtpk(kf[14], kf[15]);
            *(LAS u32x4*)(kimg + off) = k0; *(LAS u32x4*)(kimg + off + 16) = k1;
            const float ws = wS[s];
            u32x4 v0, v1;
            v0.x = cvtpk(bflo(va.x) * ws, bfhi(va.x) * ws); v0.y = cvtpk(bflo(va.y) * ws, bfhi(va.y) * ws); v0.z = cvtpk(bflo(va.z) * ws, bfhi(va.z) * ws); v0.w = cvtpk(bflo(va.w) * ws, bfhi(va.w) * ws);
            v1.x = cvtpk(bflo(vd.x) * ws, bfhi(vd.x) * ws); v1.y = cvtpk(bflo(vd.y) * ws, bfhi(vd.y) * ws); v1.z = cvtpk(bflo(vd.z) * ws, bfhi(vd.z) * ws); v1.w = cvtpk(bflo(vd.w) * ws, bfhi(vd.w) * ws);
            *(LAS u32x4*)(vimg + off) = v0; *(LAS u32x4*)(vimg + off + 16) = v1;
        }
        __syncthreads();
        {
            const int et = w >> 1, dt0 = 2 * (w & 1); const unsigned lo = tr_lane_off(lane);
            f32x16 acc0 = {0}, acc1 = {0};
#pragma unroll
            for (int ks = 0; ks < 4; ++ks) {
                const bf16x8 a = mk8(vtr(vimg + et * TRT + ks * 1024 + lo), vtr(vimg + et * TRT + ks * 1024 + lo + 512));
                const bf16x8 b0 = mk8(vtr(kimg + dt0 * TRT + ks * 1024 + lo), vtr(kimg + dt0 * TRT + ks * 1024 + lo + 512));
                const bf16x8 b1 = mk8(vtr(kimg + (dt0 + 1) * TRT + ks * 1024 + lo), vtr(kimg + (dt0 + 1) * TRT + ks * 1024 + lo + 512));
                acc0 = MFMA32(a, b0, acc0); acc1 = MFMA32(a, b1, acc1);
            }
#pragma unroll
            for (int r = 0; r < 16; ++r) { const int el = crow(r, hi); OST[el * 64 + r32] = f2bf(acc0[r]); OST[el * 64 + 32 + r32] = f2bf(acc1[r]); }
            asm volatile("s_waitcnt lgkmcnt(0)" ::: "memory");
            bf16_t* dst = WSP(bf16_t, WS_KVC) + (size_t)job * 16384 + (size_t)(et * 32) * 128 + dt0 * 32;
#pragma unroll
            for (int i = 0; i < 4; ++i) { const int rw = i * 8 + (lane >> 3), ch = lane & 7; *(u32x4*)(dst + (size_t)rw * 128 + ch * 8) = *(LAS const u32x4*)(OST + rw * 64 + ch * 8); }
        }
        if (tid < 128) {
            float sacc = 0.f; const int d = tid;
            for (int ss = 0; ss < 64; ++ss) sacc += wS[ss] * bf2f(*(LAS const bf16_t*)(kimg + (d >> 5) * TRT + ss * 64 + (d & 31) * 2));
            WSP(float, WS_NC)[(size_t)job * 128 + d] = sacc;
        }
        __syncthreads();
    }
}

__device__ __forceinline__ void mlstm_scan_job(Frame& F, int job) {
    int tid = F.tid; asm volatile("" : "+v"(tid));
    const int bh = job >> 3, sl = job & 7;
    LAS float* aold = (LAS float*)F.lds; LAS float* anew = aold + 64; LAS float* gS = aold + 128; LAS float* mS = aold + 192;
    if (tid < 64) { gS[tid] = WSP(float, WS_GSUM)[bh * 64 + tid]; mS[tid] = WSP(float, WS_MLOC)[bh * 64 + tid]; }
    __syncthreads();
    if (tid == 0) {
        float m = 0.f;
        for (int c = 0; c < 64; ++c) { const float g = gS[c], ml = mS[c];
            const float mn = fmaxf(g + m, ml); aold[c] = __expf(g + m - mn); anew[c] = __expf(ml - mn);
            gS[c] = m;
            m = mn; }
    }
    __syncthreads();
    if (sl == 0 && tid < 64) WSP(float, WS_MPREV)[bh * 64 + tid] = gS[tid];
    const size_t base = (size_t)bh * 64 * 16384 + (size_t)sl * 2048 + tid * 4;
    const bf16_t* kv = WSP(bf16_t, WS_KVC) + base; bf16_t* cp = WSP(bf16_t, WS_CPREV) + base;
    f32x4 C = {0.f, 0.f, 0.f, 0.f};
#pragma unroll 8
    for (int c = 0; c < 64; ++c) {
        const u32x2 k = *(const u32x2*)(kv + (size_t)c * 16384);
        u32x2 o; o.x = cvtpk(C[0], C[1]); o.y = cvtpk(C[2], C[3]); *(u32x2*)(cp + (size_t)c * 16384) = o;
        const float ao = aold[c], an = anew[c]; DBGF(22, ao); DBGF(23, an); DBGF(24, bflo(k.x)); DBGF(24, bfhi(k.x)); DBGF(24, bflo(k.y)); DBGF(24, bfhi(k.y)); DBGF(25, C[0]);
        C[0] = ao * C[0] + an * bflo(k.x); C[1] = ao * C[1] + an * bfhi(k.x); C[2] = ao * C[2] + an * bflo(k.y); C[3] = ao * C[3] + an * bfhi(k.y);
    }
    if (sl == 0 && tid < 128) {
        float n = 0.f;
        for (int c0 = 0; c0 < 64; c0 += 16) { float nc[16];
#pragma unroll
            for (int i = 0; i < 16; ++i) nc[i] = WSP(float, WS_NC)[(size_t)(bh * 64 + c0 + i) * 128 + tid];
#pragma unroll
            for (int i = 0; i < 16; ++i) { WSP(float, WS_NPREV)[(size_t)(bh * 64 + c0 + i) * 128 + tid] = n; n = aold[c0 + i] * n + anew[c0 + i] * nc[i]; } }
    }
    __syncthreads();
}

struct McPF { u32x4 q0, q1, k0, k1, v0, v1, hq0, hq1, hk0, hk1; float wq, wk, g0, g1, mprev; u32x2 mo[4]; };
__device__ __forceinline__ void mlstm_c_load(Frame& F, int job, int tid, McPF& pf) {
    const int lane = tid & 63, w = F.wave, r32 = lane & 31, hi = lane >> 5;
    const int bh = job >> 6, c = job & 63, b = bh >> 2, h = bh & 3, s0 = c * 64, s = tid >> 3, chg = tid & 7;
    const size_t ro = ((size_t)b * SEQ + s0 + s) * 512 + h * 128 + chg * 16;
    const bf16_t* qp = WSP(bf16_t, WS_MQ) + ro; const bf16_t* kp = WSP(bf16_t, WS_MK) + ro; const bf16_t* vp = WSP(bf16_t, WS_MV) + ro;
    pf.q0 = *(const u32x4*)qp; pf.q1 = *(const u32x4*)(qp + 8); pf.k0 = *(const u32x4*)kp; pf.k1 = *(const u32x4*)(kp + 8); pf.v0 = *(const u32x4*)vp; pf.v1 = *(const u32x4*)(vp + 8);
    pf.hq0 = (u32x4){0u, 0u, 0u, 0u}; pf.hq1 = pf.hq0; pf.hk0 = pf.hq0; pf.hk1 = pf.hq0;
    if (s < 3 && s0 - 3 + s >= 0) { const size_t ho = ((size_t)b * SEQ + s0 - 3 + s) * 512 + h * 128 + chg * 16;
        pf.hq0 = *(const u32x4*)(WSP(bf16_t, WS_MQ) + ho); pf.hq1 = *(const u32x4*)(WSP(bf16_t, WS_MQ) + ho + 8); pf.hk0 = *(const u32x4*)(WSP(bf16_t, WS_MK) + ho); pf.hk1 = *(const u32x4*)(WSP(bf16_t, WS_MK) + ho + 8); }
    pf.wq = IN_F(10)[(tid >> 7) * 1024 + h * 128 + (tid & 127)]; pf.wk = IN_F(10)[(tid >> 7) * 1024 + 512 + h * 128 + (tid & 127)];
    pf.g0 = 0.f; pf.g1 = 0.f;
    if (w == 0) { pf.g0 = WSP(float, WS_GF)[(size_t)bh * SEQ + s0 + lane]; pf.g1 = WSP(float, WS_GI)[(size_t)bh * SEQ + s0 + lane]; }
    if (w == 1) { pf.g0 = WSP(float, WS_NPREV)[(size_t)job * 128 + lane]; pf.g1 = WSP(float, WS_NPREV)[(size_t)job * 128 + 64 + lane]; }
    pf.mprev = WSP(float, WS_MPREV)[job];
    const int tw = w & 1, ew = w >> 1, t = 32 * tw + r32;
    const bf16_t* mo = WSP(bf16_t, WS_MO) + ((size_t)b * SEQ + s0 + t) * 512 + h * 128 + 32 * ew + 4 * hi;
#pragma unroll
    for (int q4 = 0; q4 < 4; ++q4) pf.mo[q4] = *(const u32x2*)(mo + 8 * q4);
}
__device__ __forceinline__ void mlstm_c_phase(Frame& F) {
    int tid = F.tid; asm volatile("" : "+v"(tid));
    const int lane = tid & 63, w = F.wave, r32 = lane & 31, hi = lane >> 5;
    LAS unsigned char* qimg = F.lds; LAS unsigned char* kimg = F.lds + ROWIMG; LAS unsigned char* vimg = F.lds + 2 * ROWIMG;
    LAS float* uS = (LAS float*)(F.lds + 2 * ROWIMG + TRIMG); LAS float* MS = uS + 64; LAS float* bS = uS + 128; LAS float* nS = uS + 192; LAS float* ssq = uS + 320;
    LAS unsigned char* RAWQ = F.lds + 2 * ROWIMG + TRIMG + 4096; LAS unsigned char* RAWK = RAWQ + RAWIMG; LAS float* WLQ = (LAS float*)(RAWK + RAWIMG); LAS float* WLK = WLQ + 512;
    LAS float* HNL = (LAS float*)(F.lds + MISC_OFF + 2048);
    HNL[tid] = IN_F(12)[tid];
    const int tw = w & 1, ew = w >> 1, t = 32 * tw + r32;
    McPF pf;
    int job = F.vcu;
    if (job < 2048) mlstm_c_load(F, job, tid, pf);
    for (; job < 2048; job += F.G) {
        const int bh = job >> 6, c = job & 63, b = bh >> 2, h = bh & 3, s0 = c * 64;
        const float mprev = pf.mprev; u32x2 moc[4];
#pragma unroll
        for (int q4 = 0; q4 < 4; ++q4) moc[q4] = pf.mo[q4];
        {
            const int s = tid >> 3, chg = tid & 7, ch0 = chg * 16;
            *(LAS u32x4*)(RAWQ + (s + 3) * RAWS + chg * 32) = pf.q0; *(LAS u32x4*)(RAWQ + (s + 3) * RAWS + chg * 32 + 16) = pf.q1;
            *(LAS u32x4*)(RAWK + (s + 3) * RAWS + chg * 32) = pf.k0; *(LAS u32x4*)(RAWK + (s + 3) * RAWS + chg * 32 + 16) = pf.k1;
            if (s < 3) { *(LAS u32x4*)(RAWQ + s * RAWS + chg * 32) = pf.hq0; *(LAS u32x4*)(RAWQ + s * RAWS + chg * 32 + 16) = pf.hq1;
                         *(LAS u32x4*)(RAWK + s * RAWS + chg * 32) = pf.hk0; *(LAS u32x4*)(RAWK + s * RAWS + chg * 32 + 16) = pf.hk1; }
            WLQ[tid] = pf.wq; WLK[tid] = pf.wk;
            const unsigned off = (ch0 >> 5) * TRT + s * 64 + (ch0 & 31) * 2;
            *(LAS u32x4*)(vimg + off) = pf.v0; *(LAS u32x4*)(vimg + off + 16) = pf.v1;
            if (w == 0) {
                float bs = pf.g0;
#pragma unroll
                for (int o = 1; o < 64; o <<= 1) { const float x = __shfl_up(bs, o); if (lane >= o) bs += x; }
                const float u = pf.g1 - bs; float cm = u;
#pragma unroll
                for (int o = 1; o < 64; o <<= 1) { const float x = __shfl_up(cm, o); if (lane >= o) cm = fmaxf(cm, x); }
                uS[lane] = u; MS[lane] = fmaxf(mprev, cm); bS[lane] = bs;
            }
            if (w == 1) { nS[lane] = pf.g0; nS[64 + lane] = pf.g1; }
        }
        __syncthreads();
        bf16x8 cf[8];
        { const bf16_t* cp = WSP(bf16_t, WS_CPREV) + (size_t)job * 16384 + (size_t)(32 * ew + r32) * 128 + 8 * hi;
#pragma unroll
          for (int ks = 0; ks < 8; ++ks) cf[ks] = *(const bf16x8*)(cp + 16 * ks); }
        if (job + F.G < 2048) mlstm_c_load(F, job + F.G, tid, pf);
        {
            const int s = tid >> 3, chg = tid & 7, ch0 = chg * 16;
            float qf[16]; conv_lds16(RAWQ, WLQ, s, ch0, 1.f, qf);
            u32x4 q0, q1; q0.x = cvtpk(qf[0], qf[1]); q0.y = cvtpk(qf[2], qf[3]); q0.z = cvtpk(qf[4], qf[5]); q0.w = cvtpk(qf[6], qf[7]);
            q1.x = cvtpk(qf[8], qf[9]); q1.y = cvtpk(qf[10], qf[11]); q1.z = cvtpk(qf[12], qf[13]); q1.w = cvtpk(qf[14], qf[15]);
            *(LAS u32x4*)(qimg + (2 * chg) * RCH + s * 16) = q0; *(LAS u32x4*)(qimg + (2 * chg + 1) * RCH + s * 16) = q1;
            float kf[16]; conv_lds16(RAWK, WLK, s, ch0, 0.08838834764831845f, kf);
            u32x4 k0, k1; k0.x = cvtpk(kf[0], kf[1]); k0.y = cvtpk(kf[2], kf[3]); k0.z = cvtpk(kf[4], kf[5]); k0.w = cvtpk(kf[6], kf[7]);
            k1.x = cvtpk(kf[8], kf[9]); k1.y = cvtpk(kf[10], kf[11]); k1.z = cvtpk(kf[12], kf[13]); k1.w = cvtpk(kf[14], kf[15]);
            *(LAS u32x4*)(kimg + (2 * chg) * RCH + s * 16) = k0; *(LAS u32x4*)(kimg + (2 * chg + 1) * RCH + s * 16) = k1;
        }
        __syncthreads();
        const float Mt = MS[t], bt = bS[t];
        const float dec = __expf(mprev - Mt), mt = bt + Mt;
        bf16x8 qf[8];
#pragma unroll
        for (int ks = 0; ks < 8; ++ks) qf[ks] = *(LAS const bf16x8*)(qimg + (2 * ks + hi) * RCH + t * 16);
        f32x16 p[2]; p[0] = (f32x16){0}; p[1] = (f32x16){0};
#pragma unroll
        for (int st = 0; st < 2; ++st) {
            if (st <= tw) {
#pragma unroll
                for (int ks = 0; ks < 8; ++ks) { const bf16x8 kf = *(LAS const bf16x8*)(kimg + (2 * ks + hi) * RCH + (32 * st + r32) * 16); p[st] = MFMA32(kf, qf[ks], p[st]); }
            }
        }
        float rs = 0.f;
#pragma unroll
        for (int st = 0; st < 2; ++st)
#pragma unroll
            for (int r = 0; r < 16; ++r) { const int s = 32 * st + crow(r, hi);
                const float wv = (s <= t) ? __expf(uS[s] - Mt) * p[st][r] : 0.f; p[st][r] = wv; rs += wv; }
        rs += __shfl_xor(rs, 32);
        float qn = 0.f;
#pragma unroll
        for (int ks = 0; ks < 8; ++ks)
#pragma unroll
            for (int j = 0; j < 8; ++j) qn += bf2f((bf16_t)qf[ks][j]) * nS[16 * ks + 8 * hi + j];
        qn += __shfl_xor(qn, 32);
        const float den = rs + dec * qn;
        const float hden = fmaxf(fabsf(den), __expf(-mt));
        f32x16 ai = {0}, ae = {0};
        const unsigned lo = tr_lane_off(lane);
#pragma unroll
        for (int st = 0; st < 2; ++st) {
            if (st <= tw) {
#pragma unroll
                for (int s2 = 0; s2 < 2; ++s2) { const int ks = 2 * st + s2;
                    const bf16x8 vf = mk8(vtr(vimg + ew * TRT + ks * 1024 + lo), vtr(vimg + ew * TRT + ks * 1024 + lo + 512));
                    u32x4 pw; pw.x = cvtpk(p[st][8 * s2 + 0], p[st][8 * s2 + 1]); pw.y = cvtpk(p[st][8 * s2 + 2], p[st][8 * s2 + 3]); pw.z = cvtpk(p[st][8 * s2 + 4], p[st][8 * s2 + 5]); pw.w = cvtpk(p[st][8 * s2 + 6], p[st][8 * s2 + 7]);
                    ai = MFMA32(vf, __builtin_bit_cast(bf16x8, pw), ai); }
            }
        }
#pragma unroll
        for (int ks = 0; ks < 8; ++ks) ae = MFMA32(cf[ks], qf[ks], ae);
        float hv[16]; float ss = 0.f; const float rden = 1.f / hden;
#pragma unroll
        for (int r = 0; r < 16; ++r) { hv[r] = (ai[r] + dec * ae[r]) * rden; ss += hv[r] * hv[r]; }
        ss += __shfl_xor(ss, 32);
        if (hi == 0) ssq[ew * 64 + t] = ss;
        __syncthreads();
        const float tot = ssq[t] + ssq[64 + t] + ssq[128 + t] + ssq[192 + t];
        const float rn = rsqrtf(tot * (1.f / 128.f) + RMS_EPS);
        LAS const float* hn = HNL + h * 128 + 32 * ew;
        bf16_t* yo = WSP(bf16_t, WS_YCAT) + ((size_t)b * SEQ + s0 + t) * 1024 + h * 128 + 32 * ew;
#pragma unroll
        for (int p2 = 0; p2 < 2; ++p2) { u32x2 ov[2];
#pragma unroll
            for (int e = 0; e < 2; ++e) { const int q4 = 2 * p2 + e; const int e0 = 8 * q4 + 4 * hi;
                const u32x2 om = moc[q4]; const f32x4 wn = *(LAS const f32x4*)(hn + e0);
                const float y0 = hv[4 * q4 + 0] * rn * wn[0] * sigmoid_f(bflo(om.x)), y1 = hv[4 * q4 + 1] * rn * wn[1] * sigmoid_f(bfhi(om.x));
                const float y2 = hv[4 * q4 + 2] * rn * wn[2] * sigmoid_f(bflo(om.y)), y3 = hv[4 * q4 + 3] * rn * wn[3] * sigmoid_f(bfhi(om.y));
                ov[e].x = cvtpk(y0, y1); ov[e].y = cvtpk(y2, y3); }
            *(u32x4*)(yo + 16 * p2 + 8 * hi) = widen_pair(ov[0], ov[1]); }
        __syncthreads();
    }
}

__device__ __forceinline__ void compress_job(Frame& F, int job) {
    int lane = F.lane; asm volatile("" : "+v"(lane));
    const int w = F.wave, r32 = lane & 31, hi = lane >> 5;
    const int kv = job >> 7, bg = (job >> 3) & 15, i0 = (job & 7) * 32;
    const bf16_t* X = WSP(bf16_t, kv ? WS_VC : WS_KC) + (size_t)bg * SEQ * 64;
    const bf16_t* W1 = WSP(bf16_t, kv ? WS_CW1V : WS_CW1K); const bf16_t* W2 = WSP(bf16_t, kv ? WS_CW2V : WS_CW2K);
    const float* c1 = WSP(float, WS_C1B) + kv * 128;
    bf16_t* O = WSP(bf16_t, kv ? WS_VCMP : WS_KCMP) + (size_t)bg * 256 * 64;
    LAS unsigned char* himg = F.lds;
    LAS float* part = (LAS float*)(F.lds + ROWIMG);
    const int nt = w & 3, kh = w >> 2;
    f32x16 acc = {0};
    {
        int i = i0 + r32; if (i > 254) i = 254;
        const bf16_t* ap = X + (size_t)i * 1024 + kh * 1024 + 8 * hi; const bf16_t* bp = W1 + (size_t)(32 * nt + r32) * 2048 + kh * 1024 + 8 * hi;
#pragma unroll 16
        for (int ks = 0; ks < 64; ++ks) { const bf16x8 a = *(const bf16x8*)(ap + 16 * ks), bb = *(const bf16x8*)(bp + 16 * ks); acc = MFMA32(a, bb, acc); }
    }
    if (kh == 1) {
#pragma unroll
        for (int r = 0; r < 16; ++r) part[(nt * 16 + r) * 64 + lane] = acc[r];
    }
    __syncthreads();
    if (kh == 0) {
        const int n = 32 * nt + r32; const float cb = c1[n];
#pragma unroll
        for (int r = 0; r < 16; ++r) { const int rowl = crow(r, hi); const float v = acc[r] + part[(nt * 16 + r) * 64 + lane] + cb;
            *(LAS bf16_t*)(himg + (n >> 3) * RCH + rowl * 16 + (n & 7) * 2) = f2bf(silu_f(v)); }
    }
    __syncthreads();
    if (w < 2) {
        f32x16 a2 = {0};
#pragma unroll
        for (int ks = 0; ks < 8; ++ks) { const bf16x8 a = *(LAS const bf16x8*)(himg + (2 * ks + hi) * RCH + r32 * 16);
            const bf16x8 bb = *(const bf16x8*)(W2 + (size_t)(32 * w + r32) * 128 + 16 * ks + 8 * hi); a2 = MFMA32(a, bb, a2); }
#pragma unroll
        for (int r = 0; r < 16; ++r) { const int i = i0 + crow(r, hi); if (i < 255) O[(size_t)i * 64 + 32 * w + r32] = f2bf(a2[r]); }
    }
    __syncthreads();
}

constexpr int NSA_KCH = 1024 + 16, NSA_VDH = 4096 + 64, NSA_KIMG = 8 * NSA_KCH, NSA_VIMG = 2 * NSA_VDH, NSA_BUF = NSA_KIMG + NSA_VIMG;
constexpr int NSA_IMP = 2 * NSA_BUF, NSA_IST = 65, NSA_TOT = NSA_IMP + 256 * NSA_IST * 4,
              NSA_SELB = MISC_OFF + 1024, NSA_UNI = NSA_SELB + 512;
constexpr int NSA_FAC = NSA_TOT + 64 * NSA_IST * 4;
constexpr int NSA_STASH = 96 * 1024;
static_assert(4 * NSA_BUF <= NSA_STASH && NSA_FAC + 4096 <= MISC_OFF && NSA_STASH + 8 * 4096 <= MISC_OFF, "NSA LDS map");

__device__ __forceinline__ void nsa_qk(LAS const unsigned char* kimg, const bf16x8 (&qr)[4], unsigned kfo, f32x16& p0, f32x16& p1) {
    bf16x8 kf[8];
#pragma unroll
    for (int d0 = 0; d0 < 4; ++d0) { kf[2 * d0] = *(LAS const bf16x8*)(kimg + kfo + d0 * (2 * NSA_KCH)); kf[2 * d0 + 1] = *(LAS const bf16x8*)(kimg + kfo + d0 * (2 * NSA_KCH) + 512); }
    __builtin_amdgcn_sched_barrier(0);
    p0 = (f32x16){0}; p1 = (f32x16){0};
#pragma unroll
    for (int d0 = 0; d0 < 4; ++d0) { p0 = MFMA32(kf[2 * d0], qr[d0], p0); p1 = MFMA32(kf[2 * d0 + 1], qr[d0], p1); }
}
constexpr float NSA_THR = 8.f;
template <int KIND>
__device__ __forceinline__ void nsa_tile(LAS const unsigned char* kimg, LAS const unsigned char* vimg, const bf16x8 (&qr)[4], int kbase, int t, bool edge, bool rowvalid,
                                         float& m, float& l, f32x16& o0, f32x16& o1, unsigned kfo, unsigned vfo, int hi) {
    f32x16 p0, p1; nsa_qk(kimg, qr, kfo, p0, p1);
    if (edge) {
#pragma unroll
        for (int r = 0; r < 16; ++r) { const int k0 = kbase + crow(r, hi), k1 = k0 + 32; bool v0, v1;
            if (KIND == 1) { v0 = k0 <= t; v1 = k1 <= t; } else { v0 = k0 <= t && k0 >= t - 511; v1 = k1 <= t && k1 >= t - 511; }
            p0[r] = v0 ? p0[r] : -INFINITY; p1[r] = v1 ? p1[r] : -INFINITY; }
    }
    float mx = fmaxf(p0[0], p1[0]);
#pragma unroll
    for (int r = 1; r < 16; ++r) mx = fmaxf(mx, fmaxf(p0[r], p1[r]));
    mx = rowvalid ? mx : -INFINITY;
    mx = fmaxf(mx, __shfl_xor(mx, 32));
    if (__any(mx - m > NSA_THR)) {
        const float mn = fmaxf(m, mx); const float alpha = ex2(m - mn); m = mn; l *= alpha;
#pragma unroll
        for (int r = 0; r < 16; ++r) { o0[r] *= alpha; o1[r] *= alpha; }
    }
    const float me = rowvalid ? m : INFINITY;
    float rs = 0.f;
#pragma unroll
    for (int r = 0; r < 16; ++r) { p0[r] = ex2(p0[r] - me); p1[r] = ex2(p1[r] - me); rs += p0[r] + p1[r]; }
    l += rs;
    u32x4 pw[4];
#pragma unroll
    for (int s = 0; s < 2; ++s) {
        pw[s].x = cvtpk(p0[8 * s + 0], p0[8 * s + 1]); pw[s].y = cvtpk(p0[8 * s + 2], p0[8 * s + 3]); pw[s].z = cvtpk(p0[8 * s + 4], p0[8 * s + 5]); pw[s].w = cvtpk(p0[8 * s + 6], p0[8 * s + 7]);
        pw[2 + s].x = cvtpk(p1[8 * s + 0], p1[8 * s + 1]); pw[2 + s].y = cvtpk(p1[8 * s + 2], p1[8 * s + 3]); pw[2 + s].z = cvtpk(p1[8 * s + 4], p1[8 * s + 5]); pw[2 + s].w = cvtpk(p1[8 * s + 6], p1[8 * s + 7]);
    }
    bf16x8 vf[8];
#pragma unroll
    for (int ks = 0; ks < 4; ++ks) { vf[2 * ks] = mk8(vtr(vimg + vfo + ks * 1024), vtr(vimg + vfo + ks * 1024 + 512)); vf[2 * ks + 1] = mk8(vtr(vimg + vfo + NSA_VDH + ks * 1024), vtr(vimg + vfo + NSA_VDH + ks * 1024 + 512)); }
    __builtin_amdgcn_sched_barrier(0);
#pragma unroll
    for (int ks = 0; ks < 4; ++ks) { o0 = MFMA32(vf[2 * ks], __builtin_bit_cast(bf16x8, pw[ks]), o0); o1 = MFMA32(vf[2 * ks + 1], __builtin_bit_cast(bf16x8, pw[ks]), o1); }
}

template <int KIND>
__device__ __forceinline__ void nsa_tile2(LAS const unsigned char* kA, LAS const unsigned char* vA, LAS const unsigned char* kB, LAS const unsigned char* vB, bool hasB,
                                          const bf16x8 (&qr)[4], int kbA, int kbB, int t, bool edgeA, bool edgeB, bool rvA, bool rvB,
                                          float& m, float& l, f32x16& o0, f32x16& o1, unsigned kfo, unsigned vfo, int hi) {
    f32x16 a0, a1, b0, b1;
    nsa_qk(kA, qr, kfo, a0, a1);
    __builtin_amdgcn_sched_barrier(0);
    if (hasB) nsa_qk(kB, qr, kfo, b0, b1);
    else {
#pragma unroll
        for (int r = 0; r < 16; ++r) { b0[r] = -INFINITY; b1[r] = -INFINITY; } }
    if (edgeA) {
#pragma unroll
        for (int r = 0; r < 16; ++r) { const int k0 = kbA + crow(r, hi), k1 = k0 + 32; bool v0, v1;
            if (KIND == 1) { v0 = k0 <= t; v1 = k1 <= t; } else { v0 = k0 <= t && k0 >= t - 511; v1 = k1 <= t && k1 >= t - 511; }
            a0[r] = v0 ? a0[r] : -INFINITY; a1[r] = v1 ? a1[r] : -INFINITY; } }
    if (edgeB) {
#pragma unroll
        for (int r = 0; r < 16; ++r) { const int k0 = kbB + crow(r, hi), k1 = k0 + 32; bool v0, v1;
            if (KIND == 1) { v0 = k0 <= t; v1 = k1 <= t; } else { v0 = k0 <= t && k0 >= t - 511; v1 = k1 <= t && k1 >= t - 511; }
            b0[r] = v0 ? b0[r] : -INFINITY; b1[r] = v1 ? b1[r] : -INFINITY; } }
    __builtin_amdgcn_sched_barrier(0);
    const bool fresh = m < -1e29f; const float mb = fresh ? 0.f : m;
    const float meA = rvA ? mb : INFINITY, meB = rvB ? mb : INFINITY;
#pragma unroll
    for (int r = 0; r < 16; ++r) { a0[r] -= meA; a1[r] -= meA; b0[r] -= meB; b1[r] -= meB; }
    float mx = fmaxf(fmaxf(a0[0], a1[0]), fmaxf(b0[0], b1[0]));
#pragma unroll
    for (int r = 1; r < 16; ++r) mx = fmaxf(mx, fmaxf(fmaxf(a0[r], a1[r]), fmaxf(b0[r], b1[r])));
    mx = fmaxf(mx, __shfl_xor(mx, 32));
    const bool has = mx > -INFINITY;
    const float delta = fresh ? (has ? mx : 0.f) : (mx > NSA_THR ? mx : 0.f);
    if (__any(delta != 0.f)) {
        const float alpha = fresh ? 1.f : ex2(-delta); l *= alpha;
#pragma unroll
        for (int r = 0; r < 16; ++r) { o0[r] *= alpha; o1[r] *= alpha; a0[r] -= delta; a1[r] -= delta; b0[r] -= delta; b1[r] -= delta; }
    }
    m = fresh ? (has ? mx : m) : m + delta;
    float rs = 0.f;
#pragma unroll
    for (int r = 0; r < 16; ++r) { a0[r] = ex2(a0[r]); a1[r] = ex2(a1[r]); b0[r] = ex2(b0[r]); b1[r] = ex2(b1[r]); rs += (a0[r] + a1[r]) + (b0[r] + b1[r]); }
    l += rs;
    __builtin_amdgcn_sched_barrier(0);
    {
        u32x4 pw[4];
#pragma unroll
        for (int s = 0; s < 2; ++s) {
            pw[s].x = cvtpk(a0[8 * s + 0], a0[8 * s + 1]); pw[s].y = cvtpk(a0[8 * s + 2], a0[8 * s + 3]); pw[s].z = cvtpk(a0[8 * s + 4], a0[8 * s + 5]); pw[s].w = cvtpk(a0[8 * s + 6], a0[8 * s + 7]);
            pw[2 + s].x = cvtpk(a1[8 * s + 0], a1[8 * s + 1]); pw[2 + s].y = cvtpk(a1[8 * s + 2], a1[8 * s + 3]); pw[2 + s].z = cvtpk(a1[8 * s + 4], a1[8 * s + 5]); pw[2 + s].w = cvtpk(a1[8 * s + 6], a1[8 * s + 7]); }
        bf16x8 vf[8];
#pragma unroll
        for (int ks = 0; ks < 4; ++ks) { vf[2 * ks] = mk8(vtr(vA + vfo + ks * 1024), vtr(vA + vfo + ks * 1024 + 512)); vf[2 * ks + 1] = mk8(vtr(vA + vfo + NSA_VDH + ks * 1024), vtr(vA + vfo + NSA_VDH + ks * 1024 + 512)); }
        __builtin_amdgcn_sched_barrier(0);
#pragma unroll
        for (int ks = 0; ks < 4; ++ks) { o0 = MFMA32(vf[2 * ks], __builtin_bit_cast(bf16x8, pw[ks]), o0); o1 = MFMA32(vf[2 * ks + 1], __builtin_bit_cast(bf16x8, pw[ks]), o1); }
    }
    __builtin_amdgcn_sched_barrier(0);
    if (hasB) {
        u32x4 pw[4];
#pragma unroll
        for (int s = 0; s < 2; ++s) {
            pw[s].x = cvtpk(b0[8 * s + 0], b0[8 * s + 1]); pw[s].y = cvtpk(b0[8 * s + 2], b0[8 * s + 3]); pw[s].z = cvtpk(b0[8 * s + 4], b0[8 * s + 5]); pw[s].w = cvtpk(b0[8 * s + 6], b0[8 * s + 7]);
            pw[2 + s].x = cvtpk(b1[8 * s + 0], b1[8 * s + 1]); pw[2 + s].y = cvtpk(b1[8 * s + 2], b1[8 * s + 3]); pw[2 + s].z = cvtpk(b1[8 * s + 4], b1[8 * s + 5]); pw[2 + s].w = cvtpk(b1[8 * s + 6], b1[8 * s + 7]); }
        bf16x8 vf[8];
#pragma unroll
        for (int ks = 0; ks < 4; ++ks) { vf[2 * ks] = mk8(vtr(vB + vfo + ks * 1024), vtr(vB + vfo + ks * 1024 + 512)); vf[2 * ks + 1] = mk8(vtr(vB + vfo + NSA_VDH + ks * 1024), vtr(vB + vfo + NSA_VDH + ks * 1024 + 512)); }
        __builtin_amdgcn_sched_barrier(0);
#pragma unroll
        for (int ks = 0; ks < 4; ++ks) { o0 = MFMA32(vf[2 * ks], __builtin_bit_cast(bf16x8, pw[ks]), o0); o1 = MFMA32(vf[2 * ks + 1], __builtin_bit_cast(bf16x8, pw[ks]), o1); }
    }
}

#define NPIN(x) asm volatile("" : "+v"(x))
__device__ __forceinline__ void glds16(const void* g, unsigned lds_base) {
    unsigned sv; asm volatile("s_mov_b32 %0, m0\n\ts_mov_b32 m0, %2\n\ts_nop 0\n\tglobal_load_lds_dwordx4 %1, off\n\ts_mov_b32 m0, %0" : "=&s"(sv) : "v"(g), "s"(lds_base) : "memory"); }
#define NSB() __builtin_amdgcn_sched_barrier(0)
#define NMX3(a, b, c) fmaxf(fmaxf((a), (b)), (c))
__device__ __forceinline__ float nsa_rowmax(const f32x16& p0, const f32x16& p1) {
    float a = NMX3(p0[0], p0[1], p1[0]), b = NMX3(p0[2], p0[3], p1[1]); a = NMX3(a, p1[2], p1[3]);
#pragma unroll
    for (int r = 4; r < 16; r += 4) { a = NMX3(a, p0[r], p0[r + 1]); b = NMX3(b, p0[r + 2], p0[r + 3]); a = NMX3(a, p1[r], p1[r + 1]); b = NMX3(b, p1[r + 2], p1[r + 3]); }
    const float m = fmaxf(a, b); const auto rr = __builtin_amdgcn_permlane32_swap(__float_as_uint(m), __float_as_uint(m), false, false);
    return fmaxf(__uint_as_float(rr[0]), __uint_as_float(rr[1])); }
template <int KIND>
__device__ __forceinline__ void nsa_mask(f32x16& p0, f32x16& p1, int kbase, int t, int hi) {
#pragma unroll
    for (int r = 0; r < 16; ++r) { const int k0 = kbase + crow(r, hi), k1 = k0 + 32; bool v0, v1;
        if (KIND == 1) { v0 = k0 <= t; v1 = k1 <= t; } else { v0 = k0 <= t && k0 >= t - 511; v1 = k1 <= t && k1 >= t - 511; }
        p0[r] = v0 ? p0[r] : -INFINITY; p1[r] = v1 ? p1[r] : -INFINITY; } }
template <int KIND>
__device__ __forceinline__ void nsa_pipe(LAS unsigned char* L, const bf16_t* Kp, const bf16_t* Vp, unsigned mlo, unsigned mhi, unsigned sel0, unsigned sel1,
                                         const bf16x8 (&qr)[4], int t, int lane, int w, int hi, unsigned kfo, unsigned vfo,
                                         float& lsum, f32x16& o0, f32x16& o1,
                                         int& sbase, bool pre, const bf16_t* Kn, const bf16_t* Vn, unsigned nlo, unsigned nhi) {
    unsigned ulo = mlo, uhi = mhi;
    const bf16_t* ksrc = Kp + lane * 64 + w * 8; const bf16_t* vsrc = Vp + (16 * (w & 3) + (lane >> 2)) * 64 + (w >> 2) * 32 + (lane & 3) * 8;
    const unsigned kdst = (unsigned)(uintptr_t)L + w * NSA_KCH, vdst = (unsigned)(uintptr_t)L + NSA_KIMG + (w >> 2) * NSA_VDH + (w & 3) * 1024;
#define NP_DMAS(KS, VS, j, sl) do { const int ps_ = ((sl) + sbase) & 3; glds16((KS) + (size_t)(j) * 4096, (unsigned)__builtin_amdgcn_readfirstlane(kdst + ps_ * NSA_BUF)); glds16((VS) + (size_t)(j) * 4096, (unsigned)__builtin_amdgcn_readfirstlane(vdst + ps_ * NSA_BUF)); } while (0)
#define NP_DMA(j, sl) NP_DMAS(ksrc, vsrc, j, sl)
#define NP_DMAWAIT() asm volatile("s_waitcnt vmcnt(0)" ::: "memory")
    const int n = __builtin_popcount(ulo) + __builtin_popcount(uhi);
#define NP_NEXT(jv) do { jv = -1; if (ulo | uhi) { jv = ulo ? __builtin_ctz(ulo) : 32 + __builtin_ctz(uhi); if (ulo) ulo &= ulo - 1; else uhi &= uhi - 1; } } while (0)
#define NP_SELBIT(j) ((((j) < 32 ? (sel0 >> ((j) & 31)) : (sel1 >> (((j) - 32) & 31))) & 1u) != 0u)
#define NP_KIMG(sl) (L + (((sl) + sbase) & 3) * NSA_BUF)
#define NP_VIMG(sl) (L + (((sl) + sbase) & 3) * NSA_BUF + NSA_KIMG)
    int jc, jn1, jn2;
    NP_NEXT(jc); NP_NEXT(jn1); NP_NEXT(jn2);
    if (!pre) { NP_DMA(jc, 0); if (jn1 >= 0) NP_DMA(jn1, 1); if (jn2 >= 0) NP_DMA(jn2, 2); }
    NP_DMAWAIT();
    __syncthreads();
    float m = -1e30f, cin = 0.f, l = 0.f, fsc = 1.f; bool resc = false;
    o0 = (f32x16){0}; o1 = (f32x16){0};
    f32x16 pA0, pA1, pB0, pB1, ci16; bf16x8 kf[8]; s16x4 vlo[8], vhi[8]; u32x4 pw0, pw1, pw2, pw3;
#define NP_KLOAD2(sl, d0) do { kf[2 * (d0)] = *(LAS const bf16x8*)(NP_KIMG(sl) + kfo + (d0) * (2 * NSA_KCH)); kf[2 * (d0) + 1] = *(LAS const bf16x8*)(NP_KIMG(sl) + kfo + (d0) * (2 * NSA_KCH) + 512); } while (0)
#define NP_SPLAT(v) do { _Pragma("unroll") for (int r = 0; r < 16; ++r) ci16[r] = (v); } while (0)
#define NP_CINIT(jt) do { if (KIND == 1) { const float c_ = NP_SELBIT(jt) ? cin : -INFINITY; NP_SPLAT(c_); } } while (0)
#define NP_DECIDE(C0, C1) do { const float rm_ = nsa_rowmax(C0, C1); const bool fresh_ = m < -1e29f; \
        const bool grow_ = fresh_ ? (rm_ > -INFINITY) : (rm_ > NSA_THR); resc = false; \
        if (__any(grow_)) { const float dl_ = grow_ ? rm_ : 0.f; fsc = (grow_ && !fresh_) ? ex2(-rm_) : 1.f; m = grow_ ? (fresh_ ? rm_ : m + rm_) : m; cin = grow_ ? -m : cin; l *= fsc; resc = true; \
            _Pragma("unroll") for (int r = 0; r < 16; ++r) { C0[r] -= dl_; C1[r] -= dl_; } \
            if (KIND == 2) NP_SPLAT(cin); } } while (0)
    { _Pragma("unroll") for (int d0 = 0; d0 < 4; ++d0) NP_KLOAD2(0, d0);
      if (KIND == 2) NP_SPLAT(0.f); else NP_CINIT(jc);
      NSB();
      pA0 = MFMA32(kf[0], qr[0], ci16); pA1 = MFMA32(kf[1], qr[0], ci16);
      _Pragma("unroll") for (int d0 = 1; d0 < 4; ++d0) { pA0 = MFMA32(kf[2 * d0], qr[d0], pA0); pA1 = MFMA32(kf[2 * d0 + 1], qr[d0], pA1); }
      nsa_mask<KIND>(pA0, pA1, 64 * jc, t, hi);
      NP_DECIDE(pA0, pA1);
      _Pragma("unroll") for (int r = 0; r < 16; ++r) { pA0[r] = ex2(pA0[r]); pA1[r] = ex2(pA1[r]); }
      if (jn1 >= 0) { _Pragma("unroll") for (int d0 = 0; d0 < 4; ++d0) NP_KLOAD2(1, d0); }
      jc = jn1; jn1 = jn2; NP_NEXT(jn2); }
    int s = 1;
#define NP_PKW(P, i) cvtpk(P[i], P[(i) + 1])
#define NP_VFR(i) mk8(vlo[i], vhi[i])
#define NP_VRD(i) do { LAS const unsigned char* a_ = vp_ + ((i) >> 1) * 1024 + ((i) & 1) * NSA_VDH; vlo[i] = vtr(a_); vhi[i] = vtr(a_ + 512); } while (0)
#define NP_GAPA(MF, a0, a1, a2, a3, W0, W1, PW) do { MF; sacc += a0; sacc += a1; sacc += a2; sacc += a3; W0; W1; NPIN(PW); NPIN(sacc); NSB(); } while (0)
#define NP_GAPB(MF, X, i) do { MF; X[i] = ex2(X[i]); X[(i) + 1] = ex2(X[(i) + 1]); X[(i) + 2] = ex2(X[(i) + 2]); X[(i) + 3] = ex2(X[(i) + 3]); NPIN(X); NSB(); } while (0)
#define NP_KRD(GL, d0) do { if (GL) { NP_KLOAD2(sn_, d0); NSB(); } } while (0)
#define NP_STEP(C0, C1, P0, P1, LAST) do { NSB(); \
    const int sp_ = (s - 1) & 3, sn_ = (s + 1) & 3, sw_ = (s + 2) & 3; \
    if (!(LAST) && jn2 >= 0) NP_DMA(jn2, sw_);     \
    LAS const unsigned char* vp_ = NP_VIMG(sp_) + vfo; \
    NP_CINIT(jc); \
    float sacc = P0[0] + P0[1]; NSB(); \
    NP_GAPA(C0 = MFMA32(kf[0], qr[0], ci16), P0[2], P0[3], P0[4], P0[5],     pw0[0] = NP_PKW(P0, 0),  pw0[1] = NP_PKW(P0, 2),  pw0); \
    NP_GAPA(C1 = MFMA32(kf[1], qr[0], ci16), P0[6], P0[7], P0[8], P0[9],     pw0[2] = NP_PKW(P0, 4),  pw0[3] = NP_PKW(P0, 6),  pw0); \
    NP_GAPA(C0 = MFMA32(kf[2], qr[1], C0),            P0[10], P0[11], P0[12], P0[13], pw1[0] = NP_PKW(P0, 8),  pw1[1] = NP_PKW(P0, 10), pw1); \
    NP_GAPA(C1 = MFMA32(kf[3], qr[1], C1),            P0[14], P0[15], P1[0], P1[1],   pw1[2] = NP_PKW(P0, 12), pw1[3] = NP_PKW(P0, 14), pw1); \
    NP_GAPA(C0 = MFMA32(kf[4], qr[2], C0),            P1[2], P1[3], P1[4], P1[5],     pw2[0] = NP_PKW(P1, 0),  pw2[1] = NP_PKW(P1, 2),  pw2); \
    NP_GAPA(C1 = MFMA32(kf[5], qr[2], C1),            P1[6], P1[7], P1[8], P1[9],     pw2[2] = NP_PKW(P1, 4),  pw2[3] = NP_PKW(P1, 6),  pw2); \
    NP_GAPA(C0 = MFMA32(kf[6], qr[3], C0),            P1[10], P1[11], P1[12], P1[13], pw3[0] = NP_PKW(P1, 8),  pw3[1] = NP_PKW(P1, 10), pw3); \
    NP_GAPA(C1 = MFMA32(kf[7], qr[3], C1),            P1[14], P1[15], 0.f, 0.f,       pw3[2] = NP_PKW(P1, 12), pw3[3] = NP_PKW(P1, 14), pw3); \
    l += sacc; \
    NP_VRD(0); NP_VRD(1); NP_VRD(2); NP_VRD(3); NSB();     \
    if (LAST) nsa_mask<KIND>(C0, C1, 64 * jc, t, hi); \
    NP_DECIDE(C0, C1); NSB(); \
    NP_VRD(4); NSB(); NP_GAPB(o0 = MFMA32(NP_VFR(0), __builtin_bit_cast(bf16x8, pw0), o0), C0, 0); \
    NP_VRD(5); NSB(); NP_GAPB(o1 = MFMA32(NP_VFR(1), __builtin_bit_cast(bf16x8, pw0), o1), C0, 4); \
    NP_VRD(6); NSB(); NP_KRD(!(LAST), 0); NP_GAPB(o0 = MFMA32(NP_VFR(2), __builtin_bit_cast(bf16x8, pw1), o0), C0, 8); \
    NP_VRD(7); NSB(); NP_KRD(!(LAST), 1); NP_GAPB(o1 = MFMA32(NP_VFR(3), __builtin_bit_cast(bf16x8, pw1), o1), C0, 12); \
    NP_KRD(!(LAST), 2); NP_GAPB(o0 = MFMA32(NP_VFR(4), __builtin_bit_cast(bf16x8, pw2), o0), C1, 0); \
    NP_KRD(!(LAST), 3); NP_GAPB(o1 = MFMA32(NP_VFR(5), __builtin_bit_cast(bf16x8, pw2), o1), C1, 4); \
    NP_GAPB(o0 = MFMA32(NP_VFR(6), __builtin_bit_cast(bf16x8, pw3), o0), C1, 8);  NP_GAPB(o1 = MFMA32(NP_VFR(7), __builtin_bit_cast(bf16x8, pw3), o1), C1, 12); \
    NP_DMAWAIT(); \
    __syncthreads(); \
    if (resc) { _Pragma("unroll") for (int r = 0; r < 16; ++r) { o0[r] *= fsc; o1[r] *= fsc; } } \
    jc = jn1; jn1 = jn2; NP_NEXT(jn2); ++s; } while (0)
    int rem = n - 1;
    if (n & 1) { pB0 = pA0; pB1 = pA1; if (rem > 0) { NP_STEP(pA0, pA1, pB0, pB1, false); --rem; } }
    while (rem >= 3) { NP_STEP(pB0, pB1, pA0, pA1, false); NP_STEP(pA0, pA1, pB0, pB1, false); rem -= 2; }
    if (rem == 1) { NP_STEP(pB0, pB1, pA0, pA1, true); }
    if (Kn) {
        unsigned vlo_ = nlo, vhi_ = nhi; const bf16_t* ks2 = Kn + lane * 64 + w * 8; const bf16_t* vs2 = Vn + (16 * (w & 3) + (lane >> 2)) * 64 + (w >> 2) * 32 + (lane & 3) * 8;
        _Pragma("unroll") for (int i = 0; i < 3; ++i) { if (vlo_ | vhi_) { const int j2 = vlo_ ? __builtin_ctz(vlo_) : 32 + __builtin_ctz(vhi_); if (vlo_) vlo_ &= vlo_ - 1; else vhi_ &= vhi_ - 1;
            NP_DMAS(ks2, vs2, j2, n + i); } } }
    { float sacc = pB0[0] + pB0[1];
      _Pragma("unroll") for (int r = 2; r < 16; ++r) sacc += pB0[r];
      _Pragma("unroll") for (int r = 0; r < 16; ++r) sacc += pB1[r];
      l += sacc;
      pw0 = (u32x4){NP_PKW(pB0, 0), NP_PKW(pB0, 2), NP_PKW(pB0, 4), NP_PKW(pB0, 6)}; pw1 = (u32x4){NP_PKW(pB0, 8), NP_PKW(pB0, 10), NP_PKW(pB0, 12), NP_PKW(pB0, 14)};
      pw2 = (u32x4){NP_PKW(pB1, 0), NP_PKW(pB1, 2), NP_PKW(pB1, 4), NP_PKW(pB1, 6)}; pw3 = (u32x4){NP_PKW(pB1, 8), NP_PKW(pB1, 10), NP_PKW(pB1, 12), NP_PKW(pB1, 14)};
      LAS const unsigned char* vp_ = NP_VIMG((n - 1) & 3) + vfo;
      _Pragma("unroll") for (int i = 0; i < 8; ++i) NP_VRD(i);
      NSB();
      o0 = MFMA32(NP_VFR(0), __builtin_bit_cast(bf16x8, pw0), o0); o1 = MFMA32(NP_VFR(1), __builtin_bit_cast(bf16x8, pw0), o1);
      o0 = MFMA32(NP_VFR(2), __builtin_bit_cast(bf16x8, pw1), o0); o1 = MFMA32(NP_VFR(3), __builtin_bit_cast(bf16x8, pw1), o1);
      o0 = MFMA32(NP_VFR(4), __builtin_bit_cast(bf16x8, pw2), o0); o1 = MFMA32(NP_VFR(5), __builtin_bit_cast(bf16x8, pw2), o1);
      o0 = MFMA32(NP_VFR(6), __builtin_bit_cast(bf16x8, pw3), o0); o1 = MFMA32(NP_VFR(7), __builtin_bit_cast(bf16x8, pw3), o1); }
    __syncthreads();
    lsum = l; sbase = (sbase + n) & 3;
#undef NP_DMA
#undef NP_DMAS
#undef NP_DMAWAIT
#undef NP_NEXT
#undef NP_SELBIT
#undef NP_KIMG
#undef NP_VIMG
#undef NP_KLOAD2
#undef NP_SPLAT
#undef NP_CINIT
#undef NP_DECIDE
#undef NP_PKW
#undef NP_VFR
#undef NP_VRD
#undef NP_GAPA
#undef NP_GAPB
#undef NP_KRD
#undef NP_STEP
}

__device__ __forceinline__ void nsa_unit(Frame& F, int b, int g, int qb) {
    int tid = F.tid; asm volatile("" : "+v"(tid));
    const int lane = tid & 63, w = F.wave, r32 = lane & 31, hi = lane >> 5;
    const int hh = 4 * g + (w & 3), th = w >> 2, cur = qb, T0 = qb * 64, tokl = 32 * th + r32, t = T0 + tokl;
    const size_t row = (size_t)b * SEQ + t; const int bg = b * 2 + g;
    LAS unsigned char* L = F.lds;
    bf16x8 qr[4];
    { const bf16_t* qp = WSP(bf16_t, WS_NQ) + row * 512 + hh * 64 + 8 * hi;
#pragma unroll
      for (int d0 = 0; d0 < 4; ++d0) qr[d0] = *(const bf16x8*)(qp + 16 * d0); }
    const float* gp = WSP(float, WS_NGT) + row * 24 + hh * 3; const float gate_c = gp[0], gate_s = gp[1], gate_w = gp[2];
    unsigned outp0[8], outp1[8];
    const unsigned kst = (tid & 7) * NSA_KCH + (tid >> 3) * 16, vst = ((tid & 7) >> 2) * NSA_VDH + (tid >> 3) * 64 + (tid & 3) * 16;
    const unsigned kfo = hi * NSA_KCH + r32 * 16, vfo = tr_lane_off(lane);
    float m, l; f32x16 o0, o1;
    u32x4 rk, rv;
#define NSA_LOAD(Kp, Vp, tile) do { rk = *(const u32x4*)((Kp) + (size_t)(tile) * 4096 + tid * 8); rv = *(const u32x4*)((Vp) + (size_t)(tile) * 4096 + tid * 8); } while (0)
#define NSA_WRITE(buf) do { *(LAS u32x4*)(L + (buf) * NSA_BUF + kst) = rk; *(LAS u32x4*)(L + (buf) * NSA_BUF + NSA_KIMG + vst) = rv; } while (0)
#define NSA_NEXT(jv) do { jv = -1; if (ulo | uhi) { jv = ulo ? __builtin_ctz(ulo) : 32 + __builtin_ctz(uhi); if (ulo) ulo &= ulo - 1; else uhi &= uhi - 1; } } while (0)
#define NSA_RUN(Kp, Vp, MLO, MHI, ...) do { unsigned ulo = (MLO), uhi = (MHI); int j, j1, j2; u32x4 rk2, rv2; \
        NSA_NEXT(j); NSA_LOAD(Kp, Vp, j); NSA_WRITE(0); NSA_NEXT(j1); if (j1 >= 0) NSA_LOAD(Kp, Vp, j1); __syncthreads(); int buf = 0; \
        for (;;) { NSA_NEXT(j2); if (j2 >= 0) { rk2 = *(const u32x4*)((Kp) + (size_t)j2 * 4096 + tid * 8); rv2 = *(const u32x4*)((Vp) + (size_t)j2 * 4096 + tid * 8); } \
            { LAS const unsigned char* KI = L + buf * NSA_BUF; LAS const unsigned char* VI = KI + NSA_KIMG; __VA_ARGS__ } \
            if (j1 >= 0) NSA_WRITE(buf ^ 1); __syncthreads(); if (j1 < 0) break; j = j1; j1 = j2; rk = rk2; rv = rv2; buf ^= 1; } } while (0)
#define NSA_LOAD2(Kp, Vp, ja, jb) do { rk = *(const u32x4*)((Kp) + (size_t)(ja) * 4096 + tid * 8); rv = *(const u32x4*)((Vp) + (size_t)(ja) * 4096 + tid * 8); \
        if ((jb) >= 0) { rkB = *(const u32x4*)((Kp) + (size_t)(jb) * 4096 + tid * 8); rvB = *(const u32x4*)((Vp) + (size_t)(jb) * 4096 + tid * 8); } } while (0)
#define NSA_WRITE2(pb, jb) do { LAS unsigned char* P_ = L + (pb) * (2 * NSA_BUF); *(LAS u32x4*)(P_ + kst) = rk; *(LAS u32x4*)(P_ + NSA_KIMG + vst) = rv; \
        if ((jb) >= 0) { *(LAS u32x4*)(P_ + NSA_BUF + kst) = rkB; *(LAS u32x4*)(P_ + NSA_BUF + NSA_KIMG + vst) = rvB; } } while (0)
#define NSA_RUN2(Kp, Vp, MLO, MHI, ...) do { unsigned ulo = (MLO), uhi = (MHI); int ja, jb, na, nb; u32x4 rkB, rvB; \
        NSA_NEXT(ja); NSA_NEXT(jb); NSA_LOAD2(Kp, Vp, ja, jb); NSA_WRITE2(0, jb); __syncthreads(); int pbuf = 0; \
        for (;;) { NSA_NEXT(na); NSA_NEXT(nb); if (na >= 0) NSA_LOAD2(Kp, Vp, na, nb); \
            { LAS const unsigned char* KA = L + pbuf * (2 * NSA_BUF); LAS const unsigned char* VA = KA + NSA_KIMG; LAS const unsigned char* KB = KA + NSA_BUF; LAS const unsigned char* VB = KB + NSA_KIMG; __VA_ARGS__ } \
            if (na >= 0) NSA_WRITE2(pbuf ^ 1, nb); __syncthreads(); if (na < 0) break; ja = na; jb = nb; pbuf ^= 1; } } while (0)
#define NSA_LT(lv) ({ const auto rr_ = __builtin_amdgcn_permlane32_swap(__float_as_uint(lv), __float_as_uint(lv), false, false); __uint_as_float(rr_[0]) + __uint_as_float(rr_[1]); })
#define NSA_RESET() do { m = -1e30f; l = 0.f; o0 = (f32x16){0}; o1 = (f32x16){0}; } while (0)

    const bf16_t* Kc = WSP(bf16_t, WS_KCMP) + (size_t)bg * 256 * 64; const bf16_t* Vc = WSP(bf16_t, WS_VCMP) + (size_t)bg * 256 * 64;
    const int ntc = ((4 * cur + 2) >> 6) + 1; const int lim = (t >= 31) ? ((t - 31) >> 4) : -1;
    const int tmin_w = T0 + 32 * th; const int lim_min = (tmin_w >= 31) ? ((tmin_w - 31) >> 4) : -1;
    unsigned sel0, sel1, un0, un1;
    {
        LAS float* IMP = (LAS float*)(L + NSA_IMP); LAS float* FAC = (LAS float*)(L + NSA_FAC);
        float carry = 0.f; const bool need_imp = cur >= 16;
        float mt0 = 0.f, mt1 = 0.f, mt2 = 0.f, mt3 = 0.f;
        m = -1e30f; l = 0.f; o0 = (f32x16){0}; o1 = (f32x16){0};
        NSA_RUN(Kc, Vc, (1u << ntc) - 1u, 0u, {
            f32x16 p0, p1; nsa_qk(KI, qr, kfo, p0, p1);
            if (64 * j + 63 > lim_min) {
                _Pragma("unroll") for (int r = 0; r < 16; ++r) { const int k0 = 64 * j + crow(r, hi);
                    p0[r] = (k0 <= lim) ? p0[r] : -INFINITY; p1[r] = (k0 + 32 <= lim) ? p1[r] : -INFINITY; } }
            { const float rm = nsa_rowmax(p0, p1); const bool fresh = m < -1e29f; const bool grow = fresh ? (rm > -INFINITY) : (rm - m > NSA_THR);
              if (__any(grow)) { const float mn = grow ? rm : m; const float f = (grow && !fresh) ? ex2(m - mn) : 1.f; m = mn; l *= f; carry *= f;
                  _Pragma("unroll") for (int r = 0; r < 16; ++r) { o0[r] *= f; o1[r] *= f; } } }
            if (j == 0) mt0 = m; else if (j == 1) mt1 = m; else if (j == 2) mt2 = m; else mt3 = m;
            { float rs = 0.f;
              _Pragma("unroll") for (int r = 0; r < 16; ++r) { p0[r] = ex2(p0[r] - m); p1[r] = ex2(p1[r] - m); rs += p0[r] + p1[r]; }
              l += rs; }
            if (need_imp) {
                _Pragma("unroll") for (int n = 0; n < 2; ++n) {
                    float a[4], bq[4], pb[4];
                    _Pragma("unroll") for (int q4 = 0; q4 < 4; ++q4) { const float x0 = n ? p1[4 * q4] : p0[4 * q4], x1 = n ? p1[4 * q4 + 1] : p0[4 * q4 + 1], x2 = n ? p1[4 * q4 + 2] : p0[4 * q4 + 2], x3 = n ? p1[4 * q4 + 3] : p0[4 * q4 + 3];
                        a[q4] = 2.f * (x0 + x1 + x2) + x3; bq[q4] = x3; }
                    _Pragma("unroll") for (int q4 = 0; q4 < 4; ++q4) pb[q4] = __shfl_xor(bq[q4], 32);
                    _Pragma("unroll") for (int q4 = 0; q4 < 4; ++q4) { const float prevb = hi ? pb[q4] : (q4 ? pb[q4 > 0 ? q4 - 1 : 0] : carry);
                        IMP[((w & 3) * 64 + tokl) * NSA_IST + 16 * j + 8 * n + 2 * q4 + hi] = a[q4] + prevb; }
                    carry = pb[3];
                } }
            u32x4 pw[4];
            _Pragma("unroll") for (int s = 0; s < 2; ++s) {
                pw[s].x = cvtpk(p0[8 * s + 0], p0[8 * s + 1]); pw[s].y = cvtpk(p0[8 * s + 2], p0[8 * s + 3]); pw[s].z = cvtpk(p0[8 * s + 4], p0[8 * s + 5]); pw[s].w = cvtpk(p0[8 * s + 6], p0[8 * s + 7]);
                pw[2 + s].x = cvtpk(p1[8 * s + 0], p1[8 * s + 1]); pw[2 + s].y = cvtpk(p1[8 * s + 2], p1[8 * s + 3]); pw[2 + s].z = cvtpk(p1[8 * s + 4], p1[8 * s + 5]); pw[2 + s].w = cvtpk(p1[8 * s + 6], p1[8 * s + 7]); }
            _Pragma("unroll") for (int ks = 0; ks < 4; ++ks) {
                const bf16x8 v0 = mk8(vtr(VI + vfo + ks * 1024), vtr(VI + vfo + ks * 1024 + 512));
                const bf16x8 v1 = mk8(vtr(VI + vfo + NSA_VDH + ks * 1024), vtr(VI + vfo + NSA_VDH + ks * 1024 + 512));
                o0 = MFMA32(v0, __builtin_bit_cast(bf16x8, pw[ks]), o0); o1 = MFMA32(v1, __builtin_bit_cast(bf16x8, pw[ks]), o1); } });
        const float inv_c = 1.f / fmaxf(NSA_LT(l), 1e-30f); const float gs_ = gate_c * inv_c;
        _Pragma("unroll") for (int r = 0; r < 8; ++r) { outp0[r] = cvtpk(gs_ * o0[2 * r], gs_ * o0[2 * r + 1]); outp1[r] = cvtpk(gs_ * o1[2 * r], gs_ * o1[2 * r + 1]); }
        if (need_imp) {
            if (hi == 0) { f32x4 fc; fc[0] = ex2(mt0 - m) * inv_c; fc[1] = ntc > 1 ? ex2(mt1 - m) * inv_c : 0.f; fc[2] = ntc > 2 ? ex2(mt2 - m) * inv_c : 0.f; fc[3] = ntc > 3 ? ex2(mt3 - m) * inv_c : 0.f;
                *(LAS f32x4*)(FAC + ((w & 3) * 64 + tokl) * 4) = fc; }
            __syncthreads(); }
    }
    if (cur >= 16) {
        LAS float* IMP = (LAS float*)(L + NSA_IMP);
        LAS unsigned* TOT = (LAS unsigned*)(L + NSA_TOT); LAS unsigned char* SELB = L + NSA_SELB; LAS unsigned* UNI = (LAS unsigned*)(L + NSA_UNI);
        { const int tk = tid >> 3, jg = tid & 7; LAS const float* FAC = (LAS const float*)(L + NSA_FAC);
          float fq[4];
#pragma unroll
          for (int h4 = 0; h4 < 4; ++h4) fq[h4] = FAC[(h4 * 64 + tk) * 4 + (jg >> 1)];
#pragma unroll
          for (int jj = 0; jj < 8; ++jj) { const int jx = 8 * jg + jj;
              const float tot = ((IMP[tk * NSA_IST + jx] * fq[0] + IMP[(64 + tk) * NSA_IST + jx] * fq[1]) + IMP[(128 + tk) * NSA_IST + jx] * fq[2]) + IMP[(192 + tk) * NSA_IST + jx] * fq[3];
              TOT[tk * NSA_IST + jx] = (__float_as_uint(tot) & ~63u) | (unsigned)(63 - jx); }
          if (tid < 2) UNI[tid] = 0u; }
        __syncthreads();
        { const int tk = tid >> 3, jg = tid & 7; unsigned bits = 0u;
          unsigned v[8]; int rank[8];
#pragma unroll
          for (int jj = 0; jj < 8; ++jj) { v[jj] = TOT[tk * NSA_IST + 8 * jg + jj]; rank[jj] = 0; }
#pragma unroll 4
          for (int k2 = 1; k2 <= cur - 2; ++k2) { const unsigned v2 = TOT[tk * NSA_IST + k2];
#pragma unroll
              for (int jj = 0; jj < 8; ++jj) rank[jj] += (int)(v2 > v[jj]); }
#pragma unroll
          for (int jj = 0; jj < 8; ++jj) { const int jx = 8 * jg + jj;
              const bool s = (jx == 0 || jx == cur || jx == cur - 1) || (jx < cur - 1 && rank[jj] < 13);
              bits |= s ? (1u << jj) : 0u; }
          SELB[tk * 8 + jg] = (unsigned char)bits;
          atomicOr((unsigned*)&UNI[jg >> 2], bits << (8 * (jg & 3))); }
        __syncthreads();
        sel0 = *(LAS const unsigned*)(SELB + tokl * 8); sel1 = *(LAS const unsigned*)(SELB + tokl * 8 + 4);
        un0 = __builtin_amdgcn_readfirstlane(UNI[0]); un1 = __builtin_amdgcn_readfirstlane(UNI[1]);
    } else {
        sel0 = (1u << (cur + 1)) - 1u; sel1 = 0u; un0 = sel0; un1 = 0u;
    }
    LAS unsigned* ST = (LAS unsigned*)(L + NSA_STASH + w * 4096) + lane;
#pragma unroll
    for (int r = 0; r < 8; ++r) { ST[r * 64] = outp0[r]; ST[(8 + r) * 64] = outp1[r]; }
    const bf16_t* Ks = WSP(bf16_t, WS_KSL) + (size_t)bg * SEQ * 64; const bf16_t* Vs = WSP(bf16_t, WS_VSL) + (size_t)bg * SEQ * 64;
    const bf16_t* Kw = WSP(bf16_t, WS_KWN) + (size_t)bg * SEQ * 64; const bf16_t* Vw = WSP(bf16_t, WS_VWN) + (size_t)bg * SEQ * 64;
    const int jlo = cur >= 8 ? cur - 8 : 0;
    const unsigned long long wm = ((cur == 63) ? ~0ull : ((1ull << (cur + 1)) - 1ull)) & ~((1ull << jlo) - 1ull);
    int sbase = 0;
    nsa_pipe<1>(L, Ks, Vs, un0, un1, sel0, sel1, qr, t, lane, w, hi, kfo, vfo, l, o0, o1, sbase, false, Kw, Vw, (unsigned)wm, (unsigned)(wm >> 32));
    { const float sc = gate_s / fmaxf(NSA_LT(l), 1e-30f);
#pragma unroll
      for (int r = 0; r < 8; ++r) { const unsigned a = ST[r * 64], c = ST[(8 + r) * 64];
          ST[r * 64] = cvtpk(bflo(a) + sc * o0[2 * r], bfhi(a) + sc * o0[2 * r + 1]); ST[(8 + r) * 64] = cvtpk(bflo(c) + sc * o1[2 * r], bfhi(c) + sc * o1[2 * r + 1]); } }
    nsa_pipe<2>(L, Kw, Vw, (unsigned)wm, (unsigned)(wm >> 32), 0u, 0u, qr, t, lane, w, hi, kfo, vfo, l, o0, o1, sbase, true, nullptr, nullptr, 0u, 0u);
    { const float sc = gate_w / fmaxf(NSA_LT(l), 1e-30f);
      bf16_t* yo = WSP(bf16_t, WS_YCAT) + row * 1024 + 512 + hh * 64;
#pragma unroll
      for (int p2 = 0; p2 < 2; ++p2) { u32x2 av[2], cv[2];
#pragma unroll
          for (int e = 0; e < 2; ++e) { const int q4 = 2 * p2 + e;
              const unsigned a0 = ST[(2 * q4) * 64], a1 = ST[(2 * q4 + 1) * 64], c0 = ST[(8 + 2 * q4) * 64], c1 = ST[(9 + 2 * q4) * 64];
              av[e].x = cvtpk(bflo(a0) + sc * o0[4 * q4], bfhi(a0) + sc * o0[4 * q4 + 1]); av[e].y = cvtpk(bflo(a1) + sc * o0[4 * q4 + 2], bfhi(a1) + sc * o0[4 * q4 + 3]);
              cv[e].x = cvtpk(bflo(c0) + sc * o1[4 * q4], bfhi(c0) + sc * o1[4 * q4 + 1]); cv[e].y = cvtpk(bflo(c1) + sc * o1[4 * q4 + 2], bfhi(c1) + sc * o1[4 * q4 + 3]); }
          *(u32x4*)(yo + 16 * p2 + 8 * hi) = widen_pair(av[0], av[1]); *(u32x4*)(yo + 32 + 16 * p2 + 8 * hi) = widen_pair(cv[0], cv[1]); } }
#undef NSA_LOAD
#undef NSA_WRITE
#undef NSA_RUN
#undef NSA_RUN2
#undef NSA_LOAD2
#undef NSA_WRITE2
#undef NSA_LT
#undef NSA_RESET
}

__device__ __forceinline__ void s6_phase(Frame& F) {
    int tid = F.tid; asm volatile("" : "+v"(tid));
    const int lane = tid & 63, w = F.wave;
    LAS unsigned char* TILE = F.lds + w * 16384;
    LAS float* LG = (LAS float*)(F.lds + MISC_OFF + 4096) + w * (8 * 48);
    LAS int* REC_E = (LAS int*)(F.lds + MISC_OFF + 16384);
    LAS float* REC_G = (LAS float*)(F.lds + MISC_OFF + 16384 + 1024);
    LAS int* REC_P = (LAS int*)(F.lds + MISC_OFF + 16384 + 2048);
    LAS int* CNTL = (LAS int*)(F.lds + MISC_OFF + 16384 + 3072);
    LAS float* SAW = (LAS float*)(F.lds + MISC_OFF + 16384 + 3584);
    const float* x = IN_F(0); const float* wpost = IN_F(6); const float* wffn = IN_F(7); const float* mod = WSP(float, WS_MOD);
    const bf16_t* Y = WSP(bf16_t, WS_Y); bf16_t* X1B = WSP(bf16_t, WS_X1B); signed char* H2Q = (signed char*)(F.ws + WS_H2Q); float* SAv = WSP(float, WS_SA); const _Float16* RWT = WSP(_Float16, WS_RWT);
    const float* bgp = IN_F(21); const float* bep = IN_F(23);
    unsigned* cntg = (unsigned*)(F.ws + WS_CTL) + CW_CNT;
    for (int rb = F.vcu; rb < NTOK / 128; rb += F.G) {
        if (tid < 64) CNTL[tid] = 0;
        __syncthreads();
        const int rbase = rb * 128 + w * 16, b = rbase >> 12;
        f32x4 xv[4][4]; u32x4 yw[4][2];
#define S6_LOAD(g) do { _Pragma("unroll") for (int r = 0; r < 4; ++r) { const size_t ro_ = (size_t)(rbase + 4 * (g) + r) * DM; \
            _Pragma("unroll") for (int j = 0; j < 4; ++j) xv[r][j] = __builtin_nontemporal_load((const f32x4*)(x + ro_ + 4 * lane + 256 * j)); \
            _Pragma("unroll") for (int jp = 0; jp < 2; ++jp) yw[r][jp] = __builtin_nontemporal_load((const u32x4*)(Y + ro_ + 4 * (lane & ~1) + 256 * (2 * jp + (lane & 1)))); } } while (0)
#define S6_Y(r, j) ((f32x4){bflo(yr[r][j].x), bfhi(yr[r][j].x), bflo(yr[r][j].y), bfhi(yr[r][j].y)})
        S6_LOAD(0);
#pragma nounroll
        for (int g = 0; g < 4; ++g) {
            u32x2 yr[4][4];
#pragma unroll
            for (int r = 0; r < 4; ++r)
#pragma unroll
                for (int jp = 0; jp < 2; ++jp) pair_narrow(yw[r][jp], lane, yr[r][2 * jp], yr[r][2 * jp + 1]);
            int l4 = 4 * lane; asm volatile("" : "+v"(l4));
            float ss[4];
#pragma unroll
            for (int r = 0; r < 4; ++r) { float a2 = 0.f;
#pragma unroll
                for (int j = 0; j < 4; ++j) { const f32x4 y = S6_Y(r, j); a2 += y[0] * y[0] + y[1] * y[1] + y[2] * y[2] + y[3] * y[3]; }
                ss[r] = a2; }
#pragma unroll
            for (int o = 1; o < 64; o <<= 1) {
#pragma unroll
                for (int r = 0; r < 4; ++r) ss[r] += __shfl_xor(ss[r], o); }
            float s2[4] = {0.f, 0.f, 0.f, 0.f};
#pragma unroll
            for (int j = 0; j < 4; ++j) { const int k = l4 + 256 * j;
                const f32x4 wp = *(const f32x4*)(wpost + k), gm = *(const f32x4*)(mod + b * 6144 + 2048 + k); const f32x4 gw2 = gm * wp;
#pragma unroll
                for (int r = 0; r < 4; ++r) { const float r1 = rsqrtf(ss[r] * (1.f / DM) + RMS_EPS);
                    xv[r][j] = xv[r][j] + gw2 * (S6_Y(r, j) * r1);
                    s2[r] += xv[r][j][0] * xv[r][j][0] + xv[r][j][1] * xv[r][j][1] + xv[r][j][2] * xv[r][j][2] + xv[r][j][3] * xv[r][j][3]; } }
#pragma unroll
            for (int r = 0; r < 4; ++r)
#pragma unroll
                for (int jp = 0; jp < 2; ++jp) { u32x2 pa, pb; pa.x = cvtpk(xv[r][2 * jp][0], xv[r][2 * jp][1]); pa.y = cvtpk(xv[r][2 * jp][2], xv[r][2 * jp][3]);
                    pb.x = cvtpk(xv[r][2 * jp + 1][0], xv[r][2 * jp + 1][1]); pb.y = cvtpk(xv[r][2 * jp + 1][2], xv[r][2 * jp + 1][3]);
                    __builtin_nontemporal_store(pair_widen(pa, pb, lane), (u32x4*)(X1B + (size_t)(rbase + 4 * g + r) * DM + 4 * (lane & ~1) + 256 * (2 * jp + (lane & 1)))); }
#pragma unroll
            for (int o = 1; o < 64; o <<= 1) {
#pragma unroll
                for (int r = 0; r < 4; ++r) s2[r] += __shfl_xor(s2[r], o); }
#pragma unroll
            for (int j = 0; j < 4; ++j) { const int k = l4 + 256 * j;
                const f32x4 wf = *(const f32x4*)(wffn + k), sh = *(const f32x4*)(mod + b * 6144 + 3072 + k), sc = *(const f32x4*)(mod + b * 6144 + 4096 + k); const f32x4 ws = wf * (sc + 1.f);
#pragma unroll
                for (int r = 0; r < 4; ++r) { const float r2 = rsqrtf(s2[r] * (1.f / DM) + RMS_EPS);
                    const f32x4 h = xv[r][j] * r2 * ws + sh;
                    { const int rt = 4 * (g & 1) + r; const f16x4 hh = {(_Float16)h[0], (_Float16)h[1], (_Float16)h[2], (_Float16)h[3]};
                      *(LAS f16x4*)(TILE + rt * 2048 + (((lane >> 1) ^ rt) << 4) + (lane & 1) * 8 + 512 * j) = hh; }
                    xv[r][j] = h; } }
            float am[4];
#pragma unroll
            for (int r = 0; r < 4; ++r) { float a = 0.f;
#pragma unroll
                for (int j = 0; j < 4; ++j) a = fmaxf(a, fmaxf(fmaxf(fabsf(xv[r][j][0]), fabsf(xv[r][j][1])), fmaxf(fabsf(xv[r][j][2]), fabsf(xv[r][j][3]))));
                am[r] = a; }
#pragma unroll
            for (int o = 1; o < 64; o <<= 1) {
#pragma unroll
                for (int r = 0; r < 4; ++r) am[r] = fmaxf(am[r], __shfl_xor(am[r], o)); }
#pragma unroll
            for (int r = 0; r < 4; ++r) { const float inv = am[r] > 0.f ? 127.f / am[r] : 0.f; const size_t ro = (size_t)(rbase + 4 * g + r) * DM;
                if (lane == 0) { SAv[rbase + 4 * g + r] = am[r] * (1.f / 127.f); SAW[(w * 16 + 4 * g + r)] = am[r] * (1.f / 127.f); }
                u32x4 pk;
#pragma unroll
                for (int j = 0; j < 4; ++j) { const f32x4 q = xv[r][j] * inv;
                    const int q0 = (int)rintf(q[0]), q1 = (int)rintf(q[1]), q2 = (int)rintf(q[2]), q3 = (int)rintf(q[3]);
                    pk[j] = (unsigned)(q0 & 0xff) | ((unsigned)(q1 & 0xff) << 8) | ((unsigned)(q2 & 0xff) << 16) | ((unsigned)(q3 & 0xff) << 24); }
                *(u32x4*)(H2Q + ro + 256 * (lane & 3) + 16 * (lane >> 2)) = quad_transpose(pk, lane); }
            __builtin_amdgcn_sched_barrier(0);
            if (g < 3) S6_LOAD(g + 1);
            __builtin_amdgcn_sched_barrier(0);
            if (g & 1) {
                const int r16 = lane & 15, q = lane >> 4, rt = r16 & 7;
                f32x4 a0 = {0.f, 0.f, 0.f, 0.f}, a1 = a0, a2 = a0;
                LAS const unsigned char* ae = TILE + rt * 2048 + ((q ^ rt) << 4); LAS const unsigned char* ao = TILE + rt * 2048 + (((q ^ rt) ^ 4) << 4);
                const _Float16* bp = RWT + (size_t)r16 * DM + 8 * q;
#pragma unroll 4
                for (int k2 = 0; k2 < 16; ++k2) {
                    const f16x8 ah0 = *(LAS const f16x8*)(ae + 128 * k2), ah1 = *(LAS const f16x8*)(ao + 128 * k2);
                    const f16x8 b00 = *(const f16x8*)(bp + 64 * k2), b01 = *(const f16x8*)(bp + 64 * k2 + 16 * DM), b02 = *(const f16x8*)(bp + 64 * k2 + 32 * DM);
                    const f16x8 b10 = *(const f16x8*)(bp + 64 * k2 + 32), b11 = *(const f16x8*)(bp + 64 * k2 + 32 + 16 * DM), b12 = *(const f16x8*)(bp + 64 * k2 + 32 + 32 * DM);
                    a0 = __builtin_amdgcn_mfma_f32_16x16x32_f16(ah0, b00, a0, 0, 0, 0); a1 = __builtin_amdgcn_mfma_f32_16x16x32_f16(ah0, b01, a1, 0, 0, 0); a2 = __builtin_amdgcn_mfma_f32_16x16x32_f16(ah0, b02, a2, 0, 0, 0);
                    a0 = __builtin_amdgcn_mfma_f32_16x16x32_f16(ah1, b10, a0, 0, 0, 0); a1 = __builtin_amdgcn_mfma_f32_16x16x32_f16(ah1, b11, a1, 0, 0, 0); a2 = __builtin_amdgcn_mfma_f32_16x16x32_f16(ah1, b12, a2, 0, 0, 0); }
                if (q < 2) {
#pragma unroll
                    for (int i = 0; i < 4; ++i) { LG[(4 * q + i) * 48 + r16] = a0[i]; LG[(4 * q + i) * 48 + 16 + r16] = a1[i]; LG[(4 * q + i) * 48 + 32 + r16] = a2[i]; } }
                asm volatile("s_waitcnt lgkmcnt(0)" ::: "memory");
                if (lane < 8) {
                    const LAS float* lg = LG + lane * 48;
                    float gl[4]; int gi = 0; float gmx = -INFINITY;
#pragma unroll
                    for (int i = 0; i < 4; ++i) { gl[i] = lg[i] + bgp[i]; if (gl[i] > gmx) { gmx = gl[i]; gi = i; } }
                    float gs = 0.f;
#pragma unroll
                    for (int i = 0; i < 4; ++i) gs += __expf(gl[i] - gmx);
                    const float pg = 1.f / gs;
                    float el[8]; float emx = -INFINITY;
#pragma unroll
                    for (int i = 0; i < 8; ++i) { el[i] = lg[4 + gi * 8 + i] + bep[gi * 8 + i]; emx = fmaxf(emx, el[i]); }
                    int e0 = 0; float v0 = -INFINITY;
#pragma unroll
                    for (int i = 0; i < 8; ++i) if (el[i] > v0) { v0 = el[i]; e0 = i; }
                    int e1 = 0; float v1 = -INFINITY;
#pragma unroll
                    for (int i = 0; i < 8; ++i) if (i != e0 && el[i] > v1) { v1 = el[i]; e1 = i; }
                    const float p0 = __expf(v0 - emx), p1 = __expf(v1 - emx);
                    const float g0 = pg * p0 / (p0 + p1), g1 = pg * p1 / (p0 + p1);
                    const int rl = w * 16 + 8 * (g >> 1) + lane; const int E0 = gi * 8 + e0, E1 = gi * 8 + e1;
                    REC_E[rl * 2] = E0; REC_E[rl * 2 + 1] = E1; REC_G[rl * 2] = g0; REC_G[rl * 2 + 1] = g1;
                    REC_P[rl * 2] = atomicAdd((int*)&CNTL[E0], 1); REC_P[rl * 2 + 1] = atomicAdd((int*)&CNTL[E1], 1);
                }
                asm volatile("s_waitcnt lgkmcnt(0)" ::: "memory");
            }
        }
#undef S6_LOAD
#undef S6_Y
        __syncthreads();
        if (tid < 32) { const int c = CNTL[tid]; CNTL[32 + tid] = c ? (int)__hip_atomic_fetch_add(cntg + tid, (unsigned)c, __ATOMIC_RELAXED, __HIP_MEMORY_SCOPE_AGENT) : 0; }
        __syncthreads();
        if (tid < 256) { const int rl = tid >> 1, k = tid & 1; const int row = rb * 128 + rl; const int e = REC_E[tid]; const int p = CNTL[32 + e] + REC_P[tid];
            WSP(int, WS_TOKE)[row * 2 + k] = e; WSP(int, WS_TOKP)[row * 2 + k] = p; WSP(float, WS_TOKG)[row * 2 + k] = REC_G[tid];
            WSP(int, WS_LIST)[(size_t)e * 65536 + p] = row; WSP(float, WS_SAL)[(size_t)e * 65536 + p] = SAW[rl]; }
        __syncthreads();
    }
}

__device__ __forceinline__ void expert_convert(Frame& F) {
    {
        int tid = F.tid; asm volatile("" : "+v"(tid));
        LAS unsigned* AM = (LAS unsigned*)F.lds;
        const int n4 = tid & 7, kq = tid >> 3;
        for (int it = F.vcu; it < 1024; it += F.G) {
            const int e = it >> 5, sel = (it >> 4) & 1, j0 = (it & 15) * 32;
            const float* W = IN_F(sel ? 25 : 24) + (size_t)e * 1024 * 512 + (size_t)(16 * kq) * 512 + j0 + 4 * n4;
            if (tid < 32) AM[tid] = 0u;
            __syncthreads();
            f32x4 v[16]; f32x4 am = {0.f, 0.f, 0.f, 0.f};
#pragma unroll
            for (int i = 0; i < 16; ++i) { v[i] = *(const f32x4*)(W + (size_t)i * 512);
#pragma unroll
                for (int c = 0; c < 4; ++c) am[c] = fmaxf(am[c], fabsf(v[i][c])); }
#pragma unroll
            for (int o = 8; o < 64; o <<= 1) {
#pragma unroll
                for (int c = 0; c < 4; ++c) am[c] = fmaxf(am[c], __shfl_xor(am[c], o)); }
            if ((tid & 63) < 8) {
#pragma unroll
                for (int c = 0; c < 4; ++c) atomicMax((unsigned*)&AM[4 * n4 + c], __float_as_uint(am[c])); }
            __syncthreads();
            const f32x4 amax = *(LAS const f32x4*)((LAS const float*)AM + 4 * n4);
            unsigned char* dst = (unsigned char*)(F.ws + WS_W13T) + ((size_t)e * 1024 + 8 * ((j0 >> 2) + n4) + 4 * sel) * 1024 + 16 * kq;
#pragma unroll
            for (int c = 0; c < 4; ++c) { const float inv = amax[c] > 0.f ? 127.f / amax[c] : 0.f; u32x4 o;
#pragma unroll
                for (int d = 0; d < 4; ++d) {
                    const int q0 = (int)rintf(v[4 * d][c] * inv), q1 = (int)rintf(v[4 * d + 1][c] * inv), q2 = (int)rintf(v[4 * d + 2][c] * inv), q3 = (int)rintf(v[4 * d + 3][c] * inv);
                    o[d] = (unsigned)(q0 & 0xff) | ((unsigned)(q1 & 0xff) << 8) | ((unsigned)(q2 & 0xff) << 16) | ((unsigned)(q3 & 0xff) << 24); }
                *(u32x4*)(dst + (size_t)c * 1024) = o;
                if (kq == 0) WSP(float, WS_SB13)[e * 1024 + 8 * ((j0 >> 2) + n4) + 4 * sel + c] = amax[c] * (1.f / 127.f); }
            __syncthreads();
        }
    }
}
__device__ __forceinline__ void w2_convert(Frame& F, int rk, int nsh) {
    LAS float* scr = (LAS float*)(F.lds + F.wave * 8448);
    const int gw = rk * NWAVES + F.wave, NGW = nsh * NWAVES;
    for (int it = gw; it < 32 * 256; it += NGW) {
        const int e = it >> 8, r = it & 255;
        transpose_item(IN_F(26) + (size_t)e * 512 * 1024, 1024, WSP(bf16_t, WS_W2T) + (size_t)e * 1024 * 512, 512, scr, (r / 32) * 64, (r % 32) * 32, F.lane, RmId{0});
    }
    __syncthreads();
}

__device__ __forceinline__ void moe_tables(Frame& F, LAS int* tstart, LAS int* cnt) {
    if (F.tid < 64) {
        const int lane = F.tid; const unsigned* cg = (const unsigned*)(F.ws + WS_CTL) + CW_CNT;
        const int c = lane < 32 ? (int)__hip_atomic_load(cg + lane, __ATOMIC_RELAXED, __HIP_MEMORY_SCOPE_AGENT) : 0;
        const int tl = (c + 255) >> 8; int incl = tl;
#pragma unroll
        for (int o = 1; o < 32; o <<= 1) { const int x = __shfl_up(incl, o); if (lane >= o) incl += x; }
        if (lane < 32) { cnt[lane] = c; tstart[lane] = incl - tl; LAS unsigned char* et = (LAS unsigned char*)(tstart + 96);
            for (int t2 = incl - tl; t2 < incl; ++t2) et[t2] = (unsigned char)lane; }
        if (lane == 31) tstart[32] = incl; }
    __syncthreads();
}

__device__ __forceinline__ void s10_phase(Frame& F, LAS int* tstart) {
    const int gw = F.vcu * NWAVES + F.wave, NGW = F.G * NWAVES, lane = F.lane;
    const float* wpost = IN_F(8); const float* mod = WSP(float, WS_MOD); const bf16_t* YB = WSP(bf16_t, WS_YB); const bf16_t* X1B = WSP(bf16_t, WS_X1B);
    int ne0[4], ne1[4], np0[4], np1[4]; float ng0[4], ng1[4];
#define S10_TAB(rw) do { _Pragma("unroll") for (int r = 0; r < 4; ++r) { const int row_ = (rw) + r; \
        ne0[r] = WSP(int, WS_TOKE)[row_ * 2]; ne1[r] = WSP(int, WS_TOKE)[row_ * 2 + 1]; np0[r] = WSP(int, WS_TOKP)[row_ * 2]; np1[r] = WSP(int, WS_TOKP)[row_ * 2 + 1]; \
        ng0[r] = WSP(float, WS_TOKG)[row_ * 2]; ng1[r] = WSP(float, WS_TOKG)[row_ * 2 + 1]; } } while (0)
    if (gw * 4 < NTOK) S10_TAB(gw * 4);
    for (int row0 = gw * 4; row0 < NTOK; row0 += NGW * 4) {
        const int b = row0 >> 12;
        size_t r0[4], r1[4]; float g0[4], g1[4];
#pragma unroll
        for (int r = 0; r < 4; ++r) { r0[r] = (size_t)tstart[ne0[r]] * 256 + np0[r]; r1[r] = (size_t)tstart[ne1[r]] * 256 + np1[r]; g0[r] = ng0[r]; g1[r] = ng1[r]; }
        if (row0 + NGW * 4 < NTOK) S10_TAB(row0 + NGW * 4);
        f32x4 yv[4][4]; float ss[4];
        u32x4 xw[4][2];
#pragma unroll
        for (int r = 0; r < 4; ++r) { float a2 = 0.f;
            u32x4 wa[2], wc[2];
#pragma unroll
            for (int jp = 0; jp < 2; ++jp) { const int ko = 4 * (lane & ~1) + 256 * (2 * jp + (lane & 1));
                wa[jp] = __builtin_nontemporal_load((const u32x4*)(YB + r0[r] * DM + ko)); wc[jp] = __builtin_nontemporal_load((const u32x4*)(YB + r1[r] * DM + ko));
                xw[r][jp] = __builtin_nontemporal_load((const u32x4*)(X1B + (size_t)(row0 + r) * DM + ko)); }
#pragma unroll
            for (int jp = 0; jp < 2; ++jp) { u32x2 a[2], c[2]; pair_narrow(wa[jp], lane, a[0], a[1]); pair_narrow(wc[jp], lane, c[0], c[1]);
#pragma unroll
                for (int e = 0; e < 2; ++e) { const int j = 2 * jp + e;
                    yv[r][j] = (f32x4){bflo(a[e].x), bfhi(a[e].x), bflo(a[e].y), bfhi(a[e].y)} * g0[r] + (f32x4){bflo(c[e].x), bfhi(c[e].x), bflo(c[e].y), bfhi(c[e].y)} * g1[r];
                    a2 += yv[r][j][0] * yv[r][j][0] + yv[r][j][1] * yv[r][j][1] + yv[r][j][2] * yv[r][j][2] + yv[r][j][3] * yv[r][j][3]; } }
            ss[r] = a2; }
#pragma unroll
        for (int o = 1; o < 64; o <<= 1) {
#pragma unroll
            for (int r = 0; r < 4; ++r) ss[r] += __shfl_xor(ss[r], o); }
#pragma unroll
        for (int jp = 0; jp < 2; ++jp) {
#pragma unroll
            for (int r = 0; r < 4; ++r) { const float rr = rsqrtf(ss[r] * (1.f / DM) + RMS_EPS);
                u32x2 xb[2]; pair_narrow(xw[r][jp], lane, xb[0], xb[1]);
#pragma unroll
                for (int e = 0; e < 2; ++e) { const int j = 2 * jp + e, k = 4 * lane + 256 * j;
                    const f32x4 wp = *(const f32x4*)(wpost + k), gf = *(const f32x4*)(mod + b * 6144 + 5120 + k); const f32x4 gw2 = gf * wp;
                    const f32x4 x1 = (f32x4){bflo(xb[e].x), bfhi(xb[e].x), bflo(xb[e].y), bfhi(xb[e].y)};
                    __builtin_nontemporal_store(x1 + gw2 * (yv[r][j] * rr), (f32x4*)(F.out + (size_t)(row0 + r) * DM + k)); } } }
    }
}

#undef S10_TAB
#ifndef DBG_STOP
#define DBG_STOP -1
#endif
#if DBG_STOP >= 0
struct DbgBuf { size_t off, n; int f32, ph; };
__device__ __forceinline__ void dbg_phase(Frame& F, const XcdBarrier& bar) {
    const DbgBuf bufs[] = {
        {WS_MOD, 8 * 6144, 1, 0}, {WS_COS, (size_t)NTOK * 32, 1, 0}, {WS_SIN, (size_t)NTOK * 32, 1, 0}, {WS_WINT, (size_t)INWP * 1024, 0, 0}, {WS_WOUTT, 1024 * 1024, 0, 0},
        {WS_CW1K, 128 * 2048, 0, 0}, {WS_CW2K, 64 * 128, 0, 0}, {WS_RWT, 48 * 1024, 0, 0}, {WS_C1B, 256, 1, 0},
        {WS_H1, (size_t)NTOK * 1024, 0, 1},
        {WS_MQ, (size_t)NTOK * 2048, 0, 2}, {WS_NQ, (size_t)NTOK * 512, 0, 2}, {WS_KC, (size_t)NTOK * 128 * 6, 0, 2}, {WS_GI, 2 * 8 * 4 * 4096, 1, 2}, {WS_NGT, (size_t)NTOK * 24, 1, 2},
        {WS_KVC, (size_t)2048 * 16384, 0, 3}, {WS_NC, 2048 * 128, 1, 3}, {WS_GSUM, 4096, 1, 3}, {WS_KCMP, 2 * 16 * 256 * 64, 0, 3},
        {WS_CPREV, (size_t)2048 * 16384, 0, 4}, {WS_NPREV, 2048 * 128, 1, 4}, {WS_MPREV, 2048, 1, 4},
        {WS_YCAT, (size_t)NTOK * 1024, 0, 5}, {WS_W13T, (size_t)32 * 1024 * 1024, 0, 5}, {WS_W2T, (size_t)32 * 1024 * 512, 0, 5},
        {WS_Y, (size_t)NTOK * 1024, 0, 6}, {WS_H2, (size_t)NTOK * 1024, 0, 7}, {WS_TOKG, (size_t)NTOK * 2, 1, 7},
        {WS_HB, (size_t)65536 * 512, 0, 8}, {WS_YB, (size_t)65536 * 1024, 0, 9} };
    constexpr int NBUF = sizeof(bufs) / sizeof(bufs[0]);
    unsigned* flag = (unsigned*)(F.ws + WS_CTL) + CW_DBG;
    const size_t gt = (size_t)blockIdx.x * NTHR + F.tid, NG = (size_t)F.G * NTHR;
    for (int i = 0; i < NBUF; ++i) {
        if (bufs[i].ph > DBG_STOP) continue;
        if ((bufs[i].off == WS_H1 && DBG_STOP >= 3) || (bufs[i].off == WS_WINT && DBG_STOP >= 4) || (bufs[i].off == WS_KVC && DBG_STOP >= 5) || (bufs[i].off == WS_NQ && DBG_STOP >= 5) || (bufs[i].off == WS_KC && DBG_STOP >= 9) ||
            (bufs[i].off == WS_MQ && DBG_STOP >= 6) || (bufs[i].off == WS_CPREV && DBG_STOP >= 8) || (bufs[i].off == WS_Y && DBG_STOP >= 9) || (bufs[i].off == WS_H2 && DBG_STOP >= 9) || (bufs[i].off == WS_W13T && DBG_STOP < 5)) continue;
        bool bad = false;
        if (bufs[i].f32) { const unsigned* p = (const unsigned*)(F.ws + bufs[i].off); for (size_t k = gt; k < bufs[i].n; k += NG) bad |= ((p[k] & 0x7f800000u) == 0x7f800000u); }
        else { const unsigned* p = (const unsigned*)(F.ws + bufs[i].off); for (size_t k = gt; k < bufs[i].n / 2; k += NG) { const unsigned v = p[k]; bad |= ((v & 0x7f80u) == 0x7f80u) || ((v & 0x7f800000u) == 0x7f800000u); } }
        if (bufs[i].off == WS_YCAT) { bool bm = false, bn = false; const unsigned* p = (const unsigned*)(F.ws + WS_YCAT);
            for (size_t k = gt; k < bufs[i].n / 2; k += NG) { const unsigned v = p[k]; const bool b2 = ((v & 0x7f80u) == 0x7f80u) || ((v & 0x7f800000u) == 0x7f800000u); if ((k & 511) < 256) bm |= b2; else bn |= b2; }
            if (__any(bm) && F.lane == 0) atomicMin(flag, 23u); if (__any(bn) && F.lane == 0) atomicMin(flag, 33u); continue; }
        if (__any(bad) && F.lane == 0) atomicMin(flag, (unsigned)(i + 1));
    }
    if (DBG_STOP >= 7) { bool bad = false; const unsigned* p = (const unsigned*)F.out; for (size_t k = gt; k < (size_t)NTOK * DM; k += NG) bad |= ((p[k] & 0x7f800000u) == 0x7f800000u); if (__any(bad) && F.lane == 0) atomicMin(flag, 40u); }
    xcd_barrier(bar);
    const unsigned id = __hip_atomic_load(flag, __ATOMIC_RELAXED, __HIP_MEMORY_SCOPE_AGENT);
    const float sc = (id >= 1000u) ? 1.f : 1.f + (float)id;
    const float* x = IN_F(0);
    for (size_t k = gt; k < (size_t)NTOK * DM; k += NG) F.out[k] = x[k] * sc;
}
#endif


#if DBG_STOP >= 0
__device__ __forceinline__ unsigned dbg_hash(unsigned x) { x ^= x >> 16; x *= 0x7feb352du; x ^= x >> 15; x *= 0x846ca68bu; x ^= x >> 16; return x; }
__device__ __forceinline__ float dbg_bfr(float f) { return bf2f(f2bf(f)); }
__device__ float dbg_z(Frame& F, int row, int c) { const signed char* h = (const signed char*)(F.ws + WS_H1) + (size_t)row * 1024; const float* w = IN_F(9); float am = 0.f;
    for (int k = 0; k < 1024; ++k) am = fmaxf(am, fabsf(w[(size_t)k * INW + c]));
    const float inv = am > 0.f ? 127.f / am : 0.f; float s = 0.f; for (int k = 0; k < 1024; ++k) s += (float)h[k] * rintf(w[(size_t)k * INW + c] * inv);
    return s * WSP(float, WS_SA1)[row] * (am * (1.f / 127.f)); }
__device__ __forceinline__ bool dbg_close(float a, float b) { return fabsf(a - b) <= 0.02f * fabsf(b) + 0.02f; }
__device__ void dbg_check_p1(Frame& F, unsigned* cnt) {
    const int gt = blockIdx.x * NTHR + F.tid; if (gt >= 8192) return;
    const int row = dbg_hash(gt * 2 + 1) % NTOK; int c = dbg_hash(gt * 2 + 2) % INW; if (gt < 64) c = 2048 + (gt & 7); if (gt >= 64 && gt < 256) c = 3336 + (gt % 24);
    const int b = row >> 12, sq = row & 4095; const float* COS = WSP(float, WS_COS); const float* SIN = WSP(float, WS_SIN);
    float ref, got;
    if (c < 2048) { ref = dbg_z(F, row, c); got = bf2f(WSP(bf16_t, c < 512 ? WS_MQ : c < 1024 ? WS_MK : c < 1536 ? WS_MV : WS_MO)[(size_t)row * 512 + (c & 511)]); }
    else if (c < 2052) { ref = dbg_z(F, row, c) + IN_F(11)[c - 2048]; got = WSP(float, WS_GI)[(size_t)(b * 4 + c - 2048) * SEQ + sq]; }
    else if (c < 2056) { ref = logsigmoid_f(dbg_z(F, row, c) + IN_F(11)[4 + c - 2052]); got = WSP(float, WS_GF)[(size_t)(b * 4 + c - 2052) * SEQ + sq]; }
    else if (c >= 3336) { ref = sigmoid_f(dbg_z(F, row, c)); got = WSP(float, WS_NGT)[(size_t)row * 24 + c - 3336]; }
    else {
        int base, x; size_t ws_off; bool rope, isq = false;
        if (c < 2568) { base = 2056; x = c - base; rope = true; isq = true; ws_off = WS_NQ; }
        else if (c < 2696) { base = 2568; x = c - base; rope = true; ws_off = WS_KC; }
        else if (c < 2824) { base = 2696; x = c - base; rope = false; ws_off = WS_VC; }
        else if (c < 2952) { base = 2824; x = c - base; rope = true; ws_off = WS_KSL; }
        else if (c < 3080) { base = 2952; x = c - base; rope = false; ws_off = WS_VSL; }
        else if (c < 3208) { base = 3080; x = c - base; rope = true; ws_off = WS_KWN; }
        else { base = 3208; x = c - base; rope = false; ws_off = WS_VWN; }
        const int hd = x >> 6, d = x & 63;
        if (rope) { const float z0 = dbg_z(F, row, c), z1 = dbg_z(F, row, base + hd * 64 + (d ^ 32)); const float cs = COS[(size_t)row * 32 + (d & 31)], sn = SIN[(size_t)row * 32 + (d & 31)];
            ref = d < 32 ? z0 * cs - z1 * sn : z0 * cs + z1 * sn; if (isq) ref *= QSCALE; }
        else ref = dbg_z(F, row, c);
        got = isq ? bf2f(WSP(bf16_t, ws_off)[(size_t)row * 512 + hd * 64 + d]) : bf2f(WSP(bf16_t, ws_off)[((size_t)(b * 2 + hd) * SEQ + sq) * 64 + d]);
    }
    if (!dbg_close(got, ref)) atomicAdd(cnt, 1u);
}
#endif


#if DBG_STOP >= 0
__device__ void dbg_check_nsa(Frame& F, unsigned* cnt) {
    const int lane = F.lane, gw = blockIdx.x * NWAVES + F.wave;
    LAS float* P = (LAS float*)(F.lds + F.wave * 2048);
    const unsigned hsh = dbg_hash(gw * 7 + 3);
    const int b = hsh & 7, hh = (hsh >> 3) & 7, g = hh >> 2;
    int t; { const int cls = gw & 7; const unsigned r = dbg_hash(gw * 13 + 5);
        t = cls == 0 ? (int)(r % 31) : cls == 1 ? 31 + (int)(r % 33) : cls == 2 ? 64 + (int)(r % 960) : cls == 3 ? 1024 + (int)(r % 64) : cls == 4 ? 4032 + (int)(r % 64) : 1024 + (int)(r % 3072); }
    const size_t row = (size_t)b * SEQ + t; const int bg = b * 2 + g, cur = t >> 6;
    const bf16_t* Kc = WSP(bf16_t, WS_KCMP) + (size_t)bg * 256 * 64; const bf16_t* Vc = WSP(bf16_t, WS_VCMP) + (size_t)bg * 256 * 64;
    const int lim = t >= 31 ? (t - 31) >> 4 : -1;
    float imp = 0.f, oc = 0.f;
    for (int hd = 0; hd < 4; ++hd) {
        const bf16_t* q = WSP(bf16_t, WS_NQ) + row * 512 + (4 * g + hd) * 64;
        float sc[4]; float mx = -INFINITY;
        for (int k = 0; k < 4; ++k) { const int i = lane + 64 * k; float s = 0.f; for (int d = 0; d < 64; ++d) s += bf2f(q[d]) * bf2f(Kc[(size_t)i * 64 + d]); sc[k] = (i <= lim) ? s : -INFINITY; mx = fmaxf(mx, sc[k]); }
        mx = wave_max(mx); const float mref = (mx == -INFINITY) ? 0.f : mx; float l = 0.f;
        for (int k = 0; k < 4; ++k) { sc[k] = ex2(sc[k] - mref); l += sc[k]; }
        l = wave_sum(l); const float il = 1.f / fmaxf(l, 1e-30f);
        for (int k = 0; k < 4; ++k) P[lane + 64 * k] = sc[k] * il;
        asm volatile("s_waitcnt lgkmcnt(0)" ::: "memory");
        { const int j = lane; float a = 0.f; for (int x = 0; x < 3; ++x) a += 2.f * P[4 * j + x]; a += P[4 * j + 3]; if (j > 0) a += P[4 * j - 1]; imp += a; }
        if (4 * g + hd == hh) { for (int i = 0; i < 255; ++i) oc += P[i] * bf2f(Vc[(size_t)i * 64 + lane]); }
        asm volatile("s_waitcnt lgkmcnt(0)" ::: "memory");
    }
    float score = imp; { const int j = lane; if (j == 0 || j == cur || j == cur - 1) score = INFINITY; else if (64 * j > t) score = -INFINITY; }
    int rank = 0; for (int j2 = 0; j2 < 64; ++j2) { const float s2 = __shfl(score, j2); rank += (s2 > score || (s2 == score && j2 < lane)) ? 1 : 0; }
    const unsigned long long selm = __ballot(rank < 16);
    const bf16_t* q = WSP(bf16_t, WS_NQ) + row * 512 + hh * 64;
    float os = 0.f, ow = 0.f;
    for (int br = 0; br < 2; ++br) {
        const bf16_t* K = WSP(bf16_t, br ? WS_KWN : WS_KSL) + (size_t)bg * SEQ * 64; const bf16_t* V = WSP(bf16_t, br ? WS_VWN : WS_VSL) + (size_t)bg * SEQ * 64;
        float m = -INFINITY, l = 0.f, o = 0.f;
        for (int j = 0; j < 64; ++j) {
            if (br == 0 && !((selm >> j) & 1ull)) continue;
            const int kp = 64 * j + lane; bool valid = kp <= t; if (br == 1) valid = valid && kp > t - 512;
            if (!__any(valid)) continue;
            float s = 0.f; for (int d = 0; d < 64; ++d) s += bf2f(q[d]) * bf2f(K[(size_t)kp * 64 + d]);
            s = valid ? s : -INFINITY;
            const float mn = fmaxf(m, wave_max(s)); const float alpha = (m == -INFINITY) ? 0.f : ex2(m - mn); const float pp = ex2(s - mn);
            l = l * alpha + wave_sum(pp); o *= alpha;
            for (int x = 0; x < 64; ++x) o += __shfl(pp, x) * bf2f(V[(size_t)(64 * j + x) * 64 + lane]);
            m = mn;
        }
        const float r = o / fmaxf(l, 1e-30f); if (br) ow = r; else os = r;
    }
    const float* gp = WSP(float, WS_NGT) + row * 24 + hh * 3;
    const float ref = gp[0] * oc + gp[1] * os + gp[2] * ow;
    const float got = bf2f(WSP(bf16_t, WS_YCAT)[row * 1024 + 512 + hh * 64 + lane]);
    const float sq = wave_sum(ref * ref); const float tol = 0.03f * fabsf(ref) + 0.03f * sqrtf(sq * (1.f / 64.f)) + 1e-4f;
    const bool bad = !(fabsf(got - ref) <= tol);
    if (__any(bad) && lane == 0) atomicAdd(cnt, 1u);
}
#endif


#if DBG_STOP >= 0
__device__ void dbg_check_mlstm(Frame& F, unsigned* cnt) {
    const int lane = F.lane, gw = blockIdx.x * NWAVES + F.wave;
    const unsigned hsh = dbg_hash(gw * 11 + 1);
    const int b = hsh & 7, h = (hsh >> 3) & 3;
    int t; { const int cls = gw & 7; const unsigned r = dbg_hash(gw * 17 + 9);
        t = cls == 0 ? (int)(r % 4) : cls == 1 ? 60 + (int)(r % 8) : cls == 2 ? 64 * (1 + (int)(r % 60)) + (int)((r >> 8) % 3) : cls == 3 ? 64 * (1 + (int)(r % 60)) + 63 : cls == 4 ? 4000 + (int)(r % 96) : (int)(r % 4096); }
    const int bh = b * 4 + h; const float* GI = WSP(float, WS_GI) + (size_t)bh * SEQ; const float* GF = WSP(float, WS_GF) + (size_t)bh * SEQ;
    const bf16_t* MQ = WSP(bf16_t, WS_MQ); const bf16_t* MK = WSP(bf16_t, WS_MK); const bf16_t* MV = WSP(bf16_t, WS_MV); const float* cw = IN_F(10);
    float carry = 0.f, M = 0.f, Bt = 0.f;
    for (int s0 = 0; s0 <= t; s0 += 64) { const int s = s0 + lane; float lf = (s <= t) ? GF[s] : 0.f;
        float bs = lf;
        for (int o = 1; o < 64; o <<= 1) { const float x = __shfl_up(bs, o); if (lane >= o) bs += x; }
        bs += carry; const float u = (s <= t) ? GI[s] - bs : -INFINITY; M = fmaxf(M, wave_max(u));
        if (s0 + 63 >= t) Bt = __shfl(bs, t - s0);
        carry = __shfl(bs, 63); }
    float q0 = 0.f, q1 = 0.f;
    for (int j = 0; j < 4; ++j) { const int ss = t - 3 + j; if (ss >= 0) { const bf16_t* rp = MQ + ((size_t)b * SEQ + ss) * 512 + h * 128;
        q0 += bf2f(rp[lane]) * cw[j * 1024 + h * 128 + lane]; q1 += bf2f(rp[64 + lane]) * cw[j * 1024 + h * 128 + 64 + lane]; } }
    q0 = dbg_bfr(silu_f(q0)); q1 = dbg_bfr(silu_f(q1));
    LAS float* QS = (LAS float*)(F.lds + F.wave * 2048); QS[lane] = q0; QS[64 + lane] = q1;
    asm volatile("s_waitcnt lgkmcnt(0)" ::: "memory");
    float n0 = 0.f, n1 = 0.f, den = 0.f; carry = 0.f;
    for (int s0 = 0; s0 <= t; s0 += 64) { const int s = s0 + lane; const bool act = s <= t; float lf = act ? GF[s] : 0.f;
        float bs = lf;
        for (int o = 1; o < 64; o <<= 1) { const float x = __shfl_up(bs, o); if (lane >= o) bs += x; }
        bs += carry; carry = __shfl(bs, 63);
        float c = 0.f;
        if (act) { float qk = 0.f;
            for (int ch = 0; ch < 128; ++ch) { float kc = 0.f;
                for (int j = 0; j < 4; ++j) { const int ss = s - 3 + j; if (ss >= 0) kc += bf2f(MK[((size_t)b * SEQ + ss) * 512 + h * 128 + ch]) * cw[j * 1024 + 512 + h * 128 + ch]; }
                qk += QS[ch] * dbg_bfr(silu_f(kc) * 0.08838834764831845f); }
            c = __expf(GI[s] - bs - M) * qk; }
        den += c;
        for (int x = 0; x < 64; ++x) { const float cx = __shfl(c, x); if (s0 + x <= t) { const bf16_t* vp = MV + ((size_t)b * SEQ + s0 + x) * 512 + h * 128; n0 += cx * bf2f(vp[lane]); n1 += cx * bf2f(vp[64 + lane]); } } }
    den = wave_sum(den);
    const float hd = fmaxf(fabsf(den), __expf(-(Bt + M)));
    const float h0 = n0 / hd, h1 = n1 / hd;
    const float rn = rsqrtf(wave_sum(h0 * h0 + h1 * h1) * (1.f / 128.f) + RMS_EPS);
    const size_t row = (size_t)b * SEQ + t; const bf16_t* mo = WSP(bf16_t, WS_MO) + row * 512 + h * 128; const float* hn = IN_F(12) + h * 128;
    const float r0 = h0 * rn * hn[lane] * sigmoid_f(bf2f(mo[lane])), r1 = h1 * rn * hn[64 + lane] * sigmoid_f(bf2f(mo[64 + lane]));
    const float g0 = bf2f(WSP(bf16_t, WS_YCAT)[row * 1024 + h * 128 + lane]), g1 = bf2f(WSP(bf16_t, WS_YCAT)[row * 1024 + h * 128 + 64 + lane]);
    const float rms = sqrtf(wave_sum(r0 * r0 + r1 * r1) * (1.f / 128.f));
    const bool bad = !(fabsf(g0 - r0) <= 0.04f * fabsf(r0) + 0.04f * rms + 1e-4f) || !(fabsf(g1 - r1) <= 0.04f * fabsf(r1) + 0.04f * rms + 1e-4f);
    if (__any(bad) && lane == 0) atomicAdd(cnt, 1u);
}
#endif


#if DBG_STOP >= 0
__device__ void dbg_check_cmp(Frame& F, unsigned* cnt) {
    const int lane = F.lane, gw = blockIdx.x * NWAVES + F.wave;
    const unsigned hsh = dbg_hash(gw * 5 + 2);
    const int kv = hsh & 1, bg = (hsh >> 1) & 15; int i = (hsh >> 5) % 255; if ((gw & 15) == 0) i = 254; if ((gw & 15) == 1) i = 0;
    const bf16_t* X = WSP(bf16_t, kv ? WS_VC : WS_KC) + (size_t)bg * SEQ * 64 + (size_t)i * 1024;
    const float* pe = IN_F(kv ? 16 : 13); const float* w1 = IN_F(kv ? 17 : 14); const float* w2 = IN_F(kv ? 18 : 15);
    float h0 = 0.f, h1 = 0.f;
    for (int k = 0; k < 2048; ++k) { const float xv = bf2f(X[k]) + pe[k]; h0 += xv * w1[(size_t)k * 128 + lane]; h1 += xv * w1[(size_t)k * 128 + 64 + lane]; }
    LAS float* H = (LAS float*)(F.lds + F.wave * 2048); H[lane] = silu_f(h0); H[64 + lane] = silu_f(h1);
    asm volatile("s_waitcnt lgkmcnt(0)" ::: "memory");
    float o = 0.f; for (int n = 0; n < 128; ++n) o += H[n] * w2[n * 64 + lane];
    const float got = bf2f(WSP(bf16_t, kv ? WS_VCMP : WS_KCMP)[((size_t)bg * 256 + i) * 64 + lane]);
    const float rms = sqrtf(wave_sum(o * o) * (1.f / 64.f));
    const bool bad = !(fabsf(got - o) <= 0.03f * fabsf(o) + 0.03f * rms + 1e-4f);
    if (__any(bad) && lane == 0) atomicAdd(cnt, 1u);
}
#endif

__device__ __forceinline__ bool phase_tid(Frame& F) { asm volatile("" : "+v"(F.tid)); F.lane = F.tid & 63; return true; }
constexpr int NPHASE = 11;
__global__ void __launch_bounds__(NTHR, 2) mega_fwd(Args args) {
    extern __shared__ __attribute__((aligned(16))) unsigned char lds_raw[];
    Frame F;
    F.lds = (LAS unsigned char*)lds_raw; F.in = args.in; F.out = args.out; F.ws = args.ws;
    F.tid = threadIdx.x; F.lane = F.tid & 63; F.wave = __builtin_amdgcn_readfirstlane(F.tid >> 6);
    F.G = gridDim.x; { const int bx = blockIdx.x; F.vcu = (F.G % 8 == 0) ? (bx % 8) * (F.G / 8) + bx / 8 : bx; }
    volatile LAS unsigned* MISC = (volatile LAS unsigned*)(F.lds + MISC_OFF);
    for (int u = F.tid; u < (LDS_BYTES - MISC_OFF) / 4; u += NTHR) ((LAS unsigned*)(F.lds + MISC_OFF))[u] = 0u;
    __syncthreads();
    unsigned* ctl = (unsigned*)(F.ws + WS_CTL);
    XcdBarrier bar; bar.bar = ctl + CW_BAR; bar.x = 0; bar.st = nullptr;
    const int lo = args.ph_lo, hi = args.ph_hi;
    if (hi - lo > 1) bar = xcd_barrier_post(ctl + CW_BAR, MISC + 8);
#ifndef PHASE_MASK
#define PHASE_MASK 0xFFFF
#endif
#define IN(k) (((PHASE_MASK >> (k)) & 1) && lo <= (k) && (k) < hi && (DBG_STOP < 0 || (k) <= DBG_STOP))
#define SEAM(k) do { if (IN(k) && IN((k) + 1)) xcd_barrier(bar); } while (0)
    LAS int* TST = (LAS int*)(F.lds + MISC_OFF + 256);
    LAS int* CNT = TST + 40;

#define PHASE_TID() if (phase_tid(F))
    if (IN(0)) PHASE_TID() _Pragma("nounroll") for (int rep = 0; rep <= ((REP_MASK >> 0) & 1); ++rep) { p0_phase(F); } SEAM(0);
    if (IN(1)) PHASE_TID() _Pragma("nounroll") for (int rep = 0; rep <= ((REP_MASK >> 1) & 1); ++rep) { p1a_phase(F); } SEAM(1);
    if (IN(2)) PHASE_TID() _Pragma("nounroll") for (int rep = 0; rep <= ((REP_MASK >> 2) & 1); ++rep) {
        pg8::DenseOrder S; S.init(NTOK, INWP, DM / 2, F.G, (int)blockIdx.x);
        EpiIn E{F.ws, IN_F(11), F.lds};
        pg8::gemm_phase<true>(F.lds, WSP(bf16_t, WS_H1), WSP(bf16_t, WS_WINT), DM / 2, S, E);
    } SEAM(2);
    if (IN(3)) PHASE_TID() _Pragma("nounroll") for (int rep = 0; rep <= ((REP_MASK >> 3) & 1); ++rep) {
        REPS(0) mlstm_a_phase(F);
        REPS(1) for (int j = F.vcu; j < 256; j += F.G) compress_job(F, j);
    } SEAM(3);
    if (IN(4)) PHASE_TID() _Pragma("nounroll") for (int rep = 0; rep <= ((REP_MASK >> 4) & 1); ++rep) {
        REPS(2) for (int j = F.vcu; j < 256; j += F.G) mlstm_scan_job(F, j);
        REPS(3) for (int u = F.vcu; u < 512; u += F.G) {
            const int bg = u >> 5, q = u & 31;
            _Pragma("nounroll") for (int hf = 0; hf < 2; ++hf) nsa_unit(F, bg >> 1, bg & 1, hf ? q : 63 - q);
        }
    } SEAM(4);
    if (IN(5)) PHASE_TID() _Pragma("nounroll") for (int rep = 0; rep <= ((REP_MASK >> 5) & 1); ++rep) {
        REPS(4) mlstm_c_phase(F);
        REPS(5) expert_convert(F);
    } SEAM(5);
    if (IN(6)) PHASE_TID() _Pragma("nounroll") for (int rep = 0; rep <= ((REP_MASK >> 6) & 1); ++rep) {
        pg8::DenseOrder S; S.init(NTOK, DM, DM, F.G, (int)blockIdx.x);
        EpiBf16 E{WSP(bf16_t, WS_Y), DM};
        pg8::gemm_phase<false>(F.lds, WSP(bf16_t, WS_YCAT), WSP(bf16_t, WS_WOUTT), DM, S, E);
    } SEAM(6);
    if (IN(7)) PHASE_TID() { s6_phase(F); } SEAM(7);
    if (IN(8)) PHASE_TID() _Pragma("nounroll") for (int rep = 0; rep <= ((REP_MASK >> 8) & 1); ++rep) {
        moe_tables(F, TST, CNT);
        pg8::MoeOrder S{TST, CNT, (const LAS unsigned char*)(TST + 96), WSP(int, WS_LIST), F.G, F.vcu, DM / 2, true};
        EpiUpI8 E{WSP(bf16_t, WS_HB), WSP(float, WS_SAL), WSP(float, WS_SB13), TST, F.lds};
        pg8::gemm_phase<true>(F.lds, WSP(bf16_t, WS_H2Q), WSP(bf16_t, WS_W13T), DM / 2, S, E);
        {
            const int U = TST[32] * 4, full = U / F.G, rem = U % F.G;
            if (rem == 0) w2_convert(F, F.vcu, F.G); else if (F.vcu >= rem) w2_convert(F, F.vcu - rem, F.G - rem);
            (void)full; }
    } SEAM(8);
    if (IN(9)) PHASE_TID() _Pragma("nounroll") for (int rep = 0; rep <= ((REP_MASK >> 9) & 1); ++rep) {
        moe_tables(F, TST, CNT);
        pg8::MoeOrder S{TST, CNT, (const LAS unsigned char*)(TST + 96), WSP(int, WS_LIST), F.G, F.vcu, EFF, false};
        EpiBf16 E{WSP(bf16_t, WS_YB), DM};
        pg8::gemm_phase<false>(F.lds, WSP(bf16_t, WS_HB), WSP(bf16_t, WS_W2T), EFF, S, E);
    } SEAM(9);
    if (IN(10)) PHASE_TID() { moe_tables(F, TST, CNT); s10_phase(F, TST); }
#if DBG_STOP >= 0
    xcd_barrier(bar);
#if DBG_CHECK == 1 || DBG_CHECK == 3 || DBG_CHECK == 4 || DBG_CHECK == 5
    { unsigned* cw = (unsigned*)(F.ws + WS_CTL) + CW_DBG + 1; if (DBG_CHECK == 1) dbg_check_p1(F, cw); else if (DBG_CHECK == 3) dbg_check_nsa(F, cw); else if (DBG_CHECK == 4) dbg_check_mlstm(F, cw); else dbg_check_cmp(F, cw); xcd_barrier(bar);
      const unsigned nb = __hip_atomic_load(cw, __ATOMIC_RELAXED, __HIP_MEMORY_SCOPE_AGENT);
      const float sc = nb == 0 ? 1.f : nb < 4 ? 2.f : nb < 16 ? 3.f : nb < 64 ? 4.f : nb < 256 ? 5.f : nb < 1024 ? 6.f : 7.f;
      const float* x = IN_F(0); for (size_t k = (size_t)blockIdx.x * NTHR + F.tid; k < (size_t)NTOK * DM; k += (size_t)F.G * NTHR) F.out[k] = x[k] * sc; }
#elif DBG_CHECK == 2
    { const unsigned id = __hip_atomic_load((unsigned*)(F.ws + WS_CTL) + CW_DBG, __ATOMIC_RELAXED, __HIP_MEMORY_SCOPE_AGENT);
      float sc = (id >= 1000u) ? 1.f : 1.f + (float)id;
      if (__hip_atomic_load((unsigned*)(F.ws + WS_CTL) + CW_BAR + XB_TMO, __ATOMIC_RELAXED, __HIP_MEMORY_SCOPE_AGENT) != 0u) sc = 61.f;
      const float* x = IN_F(0); for (size_t k = (size_t)blockIdx.x * NTHR + F.tid; k < (size_t)NTOK * DM; k += (size_t)F.G * NTHR) F.out[k] = x[k] * sc; }
#else
    dbg_phase(F, bar);
#endif
#endif
#undef IN
#undef SEAM
}

extern "C" void kernel_launch(void* const* d_in, const int* in_sizes, int n_in, void* d_out, int out_size, void* d_ws, size_t ws_size, hipStream_t stream) {
    static int grid = 0;
    if (grid == 0) {
        int dev = 0, cus = 0;
        if (hipGetDevice(&dev) != hipSuccess || hipDeviceGetAttribute(&cus, hipDeviceAttributeMultiprocessorCount, dev) != hipSuccess) cus = 256;
        if (hipFuncSetAttribute((const void*)mega_fwd, hipFuncAttributeMaxDynamicSharedMemorySize, LDS_BYTES) != hipSuccess) fprintf(stderr, "kernel_launch: hipFuncSetAttribute failed\n");
        (void)hipGetLastError();
        grid = cus > 0 ? cus : 256;
        if (n_in != 27 || ws_size < WS_END) fprintf(stderr, "kernel_launch: unexpected n_in %d / ws_size %zu (need %zu)\n", n_in, ws_size, (size_t)WS_END);
    }
    (void)hipMemsetAsync((char*)d_ws + WS_CTL, 0, 64 * 1024, stream);
#if DBG_STOP >= 0
    (void)hipMemsetAsync((char*)d_ws + WS_CTL + CW_DBG * 4, 0x7F, 4, stream);
#endif
    Args a{};
    for (int i = 0; i < 27; ++i) a.in[i] = d_in[i];
    a.out = (float*)d_out; a.ws = (unsigned char*)d_ws;
#if MK_N_LAUNCHES == 1
    a.ph_lo = 0; a.ph_hi = NPHASE;
    hipLaunchKernelGGL(mega_fwd, dim3(grid), dim3(NTHR), LDS_BYTES, stream, a);
#else
    for (int p = 0; p < NPHASE; ++p) { a.ph_lo = p; a.ph_hi = p + 1; hipLaunchKernelGGL(mega_fwd, dim3(grid), dim3(NTHR), LDS_BYTES, stream, a); }
#endif
}
```

```cpp
#include <hip/hip_runtime.h>
#include <cstdio>
#include <cstdint>
#include <type_traits>

#define LAS __attribute__((address_space(3)))
typedef unsigned short bf16_t;
typedef short bf16x8 __attribute__((ext_vector_type(8)));
typedef short s16x4 __attribute__((ext_vector_type(4)));
typedef float f32x4 __attribute__((ext_vector_type(4)));
typedef float f32x16 __attribute__((ext_vector_type(16)));
typedef unsigned u32x4 __attribute__((ext_vector_type(4)));
typedef unsigned u32x2 __attribute__((ext_vector_type(2)));
typedef int i32x4 __attribute__((ext_vector_type(4)));
typedef _Float16 f16x8 __attribute__((ext_vector_type(8)));
typedef _Float16 f16x4 __attribute__((ext_vector_type(4)));

#ifndef MK_N_LAUNCHES
#define MK_N_LAUNCHES 1
#endif
#ifndef DBG_CHECK
#define DBG_CHECK 0
#endif
#ifndef REP_MASK
#define REP_MASK 0
#endif
#ifndef REP_SUB
#define REP_SUB 0
#endif
#ifndef NSA_DUP
#define NSA_DUP 0
#endif
#define NDUP(b) _Pragma("nounroll") for (int nd_ = 0; nd_ <= ((NSA_DUP >> (b)) & 1); ++nd_)
#define REPS(b) _Pragma("nounroll") for (int rs_ = 0; rs_ <= ((REP_SUB >> (b)) & 1); ++rs_)

constexpr int NB = 8, SEQ = 4096, DM = 1024, NTOK = NB * SEQ;
constexpr int MH = 4, MDH = 128;
constexpr int NHD = 8, NGRP = 2;
constexpr int INW = 3360, INWP = 3584;
constexpr int NEXP = 32, EFF = 512;
constexpr float RMS_EPS = 1e-6f;
constexpr float QSCALE = 0.125f * 1.4426950408889634f;
constexpr int NWAVES = 8, NTHR = 512;
constexpr int LDS_BYTES = 160 * 1024, MISC_OFF = 128 * 1024;
constexpr int MAXROWS = 73728;

constexpr size_t MiB = 1ull << 20, KiB = 1024;
constexpr size_t WS_CTL   = 0;
constexpr size_t WS_MOD   = 64 * KiB;
constexpr size_t WS_C1B   = WS_MOD + 192 * KiB;
constexpr size_t WS_GI    = WS_C1B + 4 * KiB;
constexpr size_t WS_GF    = WS_GI + 512 * KiB;
constexpr size_t WS_NGT   = WS_GF + 512 * KiB;
constexpr size_t WS_GSUM  = WS_NGT + 3 * MiB;
constexpr size_t WS_MLOC  = WS_GSUM + 8 * KiB;
constexpr size_t WS_MPREV = WS_MLOC + 8 * KiB;
constexpr size_t WS_NC    = WS_MPREV + 8 * KiB;
constexpr size_t WS_NPREV = WS_NC + 1 * MiB;
constexpr size_t WS_COS   = WS_NPREV + 1 * MiB;
constexpr size_t WS_SIN   = WS_COS + 4 * MiB;
constexpr size_t WS_WOUTT = WS_SIN + 4 * MiB;
constexpr size_t WS_CW1K  = WS_WOUTT + 2 * MiB;
constexpr size_t WS_CW1V  = WS_CW1K + 512 * KiB;
constexpr size_t WS_CW2K  = WS_CW1V + 512 * KiB;
constexpr size_t WS_CW2V  = WS_CW2K + 16 * KiB;
constexpr size_t WS_RWT   = WS_CW2V + 16 * KiB;
constexpr size_t WS_RWL   = WS_RWT + 96 * KiB;
constexpr size_t WS_KCMP  = WS_RWL + 96 * KiB;
constexpr size_t WS_VCMP  = WS_KCMP + 512 * KiB;
constexpr size_t WS_TOKE  = WS_VCMP + 512 * KiB;
constexpr size_t WS_TOKP  = WS_TOKE + 256 * KiB;
constexpr size_t WS_TOKG  = WS_TOKP + 256 * KiB;
constexpr size_t WS_LIST  = WS_TOKG + 256 * KiB;
constexpr size_t WS_SA    = WS_LIST + 8 * MiB;
constexpr size_t WS_SB13  = WS_SA + 128 * KiB;
constexpr size_t WS_SA1   = WS_SB13 + 128 * KiB;
constexpr size_t WS_SBW   = WS_SA1 + 128 * KiB;
constexpr size_t WS_SMALL_END = WS_SBW + 16 * KiB;
static_assert(WS_SMALL_END <= 32 * MiB, "small region overflow");
constexpr size_t WS_A     = 32 * MiB;
constexpr size_t WS_H1    = WS_A, WS_KVC = WS_A, WS_W13T = WS_A;
constexpr size_t WS_NQ    = 96 * MiB;
constexpr size_t WS_KC    = 128 * MiB, WS_VC = 136 * MiB, WS_KSL = 144 * MiB, WS_VSL = 152 * MiB, WS_KWN = 160 * MiB, WS_VWN = 168 * MiB;
constexpr size_t WS_W2T   = 96 * MiB;
constexpr size_t WS_MQ    = 176 * MiB, WS_MK = 208 * MiB, WS_MV = 240 * MiB, WS_MO = 272 * MiB;
constexpr size_t WS_Y     = 176 * MiB;
constexpr size_t WS_H2    = 240 * MiB;
constexpr size_t WS_CPREV = 304 * MiB;
constexpr size_t WS_WINT  = 304 * MiB;
constexpr size_t WS_HB    = 304 * MiB;
constexpr size_t WS_H2LO  = 304 * MiB;
constexpr size_t WS_YCAT  = 376 * MiB;
constexpr size_t WS_X1B   = 376 * MiB;
constexpr size_t WS_YB    = 128 * MiB;
constexpr size_t WS_H2Q   = 128 * MiB;
constexpr size_t WS_SAL   = 440 * MiB;
constexpr size_t WS_END   = 448 * MiB;

constexpr int CW_BAR = 0;
constexpr int CW_CNT = 4096;
constexpr int CW_DBG = 4200;

typedef __bf16 bf16x2_t __attribute__((ext_vector_type(2)));
typedef float f32x2_t __attribute__((ext_vector_type(2)));
__device__ __forceinline__ unsigned cvtpk(float lo, float hi) { const f32x2_t f = {lo, hi}; const bf16x2_t v = __builtin_convertvector(f, bf16x2_t); return __builtin_bit_cast(unsigned, v); }
__device__ __forceinline__ float bf2f(bf16_t b) { return __uint_as_float(((unsigned)b) << 16); }
__device__ __forceinline__ float bflo(unsigned w) { return __uint_as_float(w << 16); }
__device__ __forceinline__ float bfhi(unsigned w) { return __uint_as_float(w & 0xffff0000u); }
__device__ __forceinline__ bf16_t f2bf(float f) { return (bf16_t)(cvtpk(f, 0.f) & 0xffffu); }
__device__ __forceinline__ float wave_sum(float v) {
#pragma unroll
    for (int o = 1; o < 64; o <<= 1) v += __shfl_xor(v, o);
    return v;
}
__device__ __forceinline__ float wave_max(float v) {
#pragma unroll
    for (int o = 1; o < 64; o <<= 1) v = fmaxf(v, __shfl_xor(v, o));
    return v;
}
__device__ __forceinline__ float sigmoid_f(float x) { return __builtin_amdgcn_rcpf(1.f + __builtin_amdgcn_exp2f(-1.4426950408889634f * x)); }
__device__ __forceinline__ float silu_f(float x) { return x * __builtin_amdgcn_rcpf(1.f + __builtin_amdgcn_exp2f(-1.4426950408889634f * x)); }
__device__ __forceinline__ float logsigmoid_f(float x) { return fminf(x, 0.f) - log1pf(__expf(-fabsf(x))); }
__device__ __forceinline__ float ex2(float x) { return __builtin_amdgcn_exp2f(x); }
#define MFMA32(a, b, c) __builtin_amdgcn_mfma_f32_32x32x16_bf16(a, b, c, 0, 0, 0)
#define MFMA16(a, b, c) __builtin_amdgcn_mfma_f32_16x16x32_bf16(a, b, c, 0, 0, 0)
typedef short v4i16_t __attribute__((ext_vector_type(4)));
__device__ __forceinline__ s16x4 vtr(LAS const unsigned char* p) { return __builtin_bit_cast(s16x4, __builtin_amdgcn_ds_read_tr16_b64_v4i16((LAS v4i16_t*)p)); }
__device__ __forceinline__ int crow(int r, int hi) { return (r & 3) + 8 * (r >> 2) + 4 * hi; }
__device__ __forceinline__ u32x4 widen_pair(u32x2 A, u32x2 B) {
    const auto r0 = __builtin_amdgcn_permlane32_swap(A.x, B.x, false, false); const auto r1 = __builtin_amdgcn_permlane32_swap(A.y, B.y, false, false);
    return (u32x4){r0[0], r1[0], r0[1], r1[1]}; }
__device__ __forceinline__ u32x4 widen_rows16(u32x2 X, u32x2 Y) {
    const auto r0 = __builtin_amdgcn_permlane16_swap(X.x, Y.x, false, false); const auto r1 = __builtin_amdgcn_permlane16_swap(X.y, Y.y, false, false);
    return (u32x4){r0[0], r1[0], r0[1], r1[1]}; }
__device__ __forceinline__ u32x4 quad_transpose(u32x4 d, int lane) {
    const bool b0 = lane & 1, b1 = lane & 2;
    { const unsigned t0 = b0 ? d.x : d.y, t1 = b0 ? d.z : d.w;
      const unsigned r0 = (unsigned)__builtin_amdgcn_mov_dpp((int)t0, 0xB1, 0xF, 0xF, true), r1 = (unsigned)__builtin_amdgcn_mov_dpp((int)t1, 0xB1, 0xF, 0xF, true);
      if (b0) { d.x = r0; d.z = r1; } else { d.y = r0; d.w = r1; } }
    { const unsigned t0 = b1 ? d.x : d.z, t1 = b1 ? d.y : d.w;
      const unsigned r0 = (unsigned)__builtin_amdgcn_mov_dpp((int)t0, 0x4E, 0xF, 0xF, true), r1 = (unsigned)__builtin_amdgcn_mov_dpp((int)t1, 0x4E, 0xF, 0xF, true);
      if (b1) { d.x = r0; d.y = r1; } else { d.z = r0; d.w = r1; } }
    return d; }
__device__ __forceinline__ u32x4 pair_widen(u32x2 A, u32x2 B, int lane) {
    const bool od = lane & 1; const u32x2 t = od ? A : B;
    u32x2 r; r.x = (unsigned)__builtin_amdgcn_mov_dpp((int)t.x, 0xB1, 0xF, 0xF, true); r.y = (unsigned)__builtin_amdgcn_mov_dpp((int)t.y, 0xB1, 0xF, 0xF, true);
    return od ? (u32x4){r.x, r.y, B.x, B.y} : (u32x4){A.x, A.y, r.x, r.y}; }
__device__ __forceinline__ void pair_narrow(u32x4 v, int lane, u32x2& A, u32x2& B) {
    const bool od = lane & 1; const u32x2 lo = {v.x, v.y}, hi = {v.z, v.w}; const u32x2 t = od ? lo : hi;
    u32x2 r; r.x = (unsigned)__builtin_amdgcn_mov_dpp((int)t.x, 0xB1, 0xF, 0xF, true); r.y = (unsigned)__builtin_amdgcn_mov_dpp((int)t.y, 0xB1, 0xF, 0xF, true);
    A = od ? r : lo; B = od ? hi : r; }
__device__ __forceinline__ bf16x8 mk8(s16x4 lo, s16x4 hi) { return (bf16x8){lo[0], lo[1], lo[2], lo[3], hi[0], hi[1], hi[2], hi[3]}; }

#define XB_TMO      128
#define XB_XCNT(j)  (256  + 64 * (j))
#define XB_XSUB(j)  (1280 + 64 * (j))
#define XB_XGEN(j)  (2304 + 64 * (j))
#define XB_TOP      3328
#define XB_TOPGEN   3392
#define XCD_BAR_WORDS 3456
#define XB_SPIN_CAP (1u << 18)
__device__ __forceinline__ unsigned xb_ld(unsigned* p)              { return __hip_atomic_load(p, __ATOMIC_RELAXED, __HIP_MEMORY_SCOPE_AGENT); }
__device__ __forceinline__ unsigned xb_add(unsigned* p, unsigned v) { return __hip_atomic_fetch_add(p, v, __ATOMIC_RELAXED, __HIP_MEMORY_SCOPE_AGENT); }
__device__ __forceinline__ unsigned xb_xcc_id() { return (unsigned)__builtin_amdgcn_s_getreg((3 << 11) | 20) & 0xFu; }
#define XB_SPIN(cond, bar) do { unsigned _sp = 0; while (cond) { __builtin_amdgcn_s_sleep(1); \
    if ((++_sp & 255u) == 0u) { if (xb_ld(&(bar)[XB_TMO])) break; if (_sp > XB_SPIN_CAP) { atomicAdd(&(bar)[XB_TMO], 1u); break; } } } } while (0)
struct XcdBarrier { unsigned* bar; unsigned x; volatile LAS unsigned* st; };
__device__ __forceinline__ XcdBarrier xcd_barrier_post(unsigned* bar, volatile LAS unsigned* st) {
    XcdBarrier b; b.bar = bar; b.x = xb_xcc_id(); b.st = st;
    if (threadIdx.x == 0) (void)xb_add(&bar[XB_XCNT(b.x)], 1u);
    return b;
}
__device__ __forceinline__ void xcd_barrier_complete(unsigned* bar, unsigned x, unsigned& nloc, unsigned& nx) {
    const unsigned G = gridDim.x * gridDim.y * gridDim.z;
    unsigned sum, cnt, mine, sp = 0u;
    for (;;) {
        sum = 0u; cnt = 0u; mine = 0u;
#pragma unroll
        for (unsigned j = 0; j < 16; ++j) { const unsigned c = xb_ld(&bar[XB_XCNT(j)]); sum += c; cnt += (c > 0u) ? 1u : 0u; mine = (j == x) ? c : mine; }
        if (sum == G) break;
        __builtin_amdgcn_s_sleep(1);
        if ((++sp & 255u) == 0u) { if (xb_ld(&bar[XB_TMO])) break; if (sp > XB_SPIN_CAP) { atomicAdd(&bar[XB_TMO], 1u); break; } }
    }
    nloc = mine > 0u ? mine : 1u; nx = cnt > 0u ? cnt : 1u;
}
__device__ __forceinline__ void xcd_barrier(const XcdBarrier& b) {
    asm volatile("s_waitcnt vmcnt(0)" ::: "memory");
    __syncthreads();
    if (threadIdx.x == 0) {
        unsigned* bar = b.bar;
        __builtin_amdgcn_s_waitcnt(0);
        unsigned nloc = b.st[0], nx = b.st[1];
        if (nloc == 0u) { xcd_barrier_complete(bar, b.x, nloc, nx); b.st[0] = nloc; b.st[1] = nx; }
        const unsigned old = xb_add(&bar[XB_XSUB(b.x)], 1u);
        const unsigned gen = old / nloc;
        if (old + 1u == (gen + 1u) * nloc) {
            __builtin_amdgcn_fence(__ATOMIC_RELEASE, "agent");
            asm volatile("s_waitcnt vmcnt(0)" ::: "memory");
            const unsigned og = xb_add(&bar[XB_TOP], 1u);
            const unsigned tg = og / nx;
            if (og + 1u == (tg + 1u) * nx) xb_add(&bar[XB_TOPGEN], 1u);
            else XB_SPIN(xb_ld(&bar[XB_TOPGEN]) == tg, bar);
            __builtin_amdgcn_fence(__ATOMIC_ACQUIRE, "agent");
            xb_add(&bar[XB_XGEN(b.x)], 1u);
            asm volatile("s_waitcnt vmcnt(0)" ::: "memory");
        } else {
            XB_SPIN(xb_ld(&bar[XB_XGEN(b.x)]) == gen, bar);
            __builtin_amdgcn_fence(__ATOMIC_ACQUIRE, "agent");
            asm volatile("s_waitcnt vmcnt(0)" ::: "memory");
        }
    }
    __syncthreads();
}

struct Args { const void* in[27]; float* out; unsigned char* ws; int ph_lo, ph_hi; };
struct Frame {
    LAS unsigned char* lds;
    const void* const* in; float* out; unsigned char* ws;
    int tid, lane, wave, vcu, G;
};
#define IN_F(k) ((const float*)F.in[k])
#define WSP(T, off) ((T*)(F.ws + (off)))

namespace pg8 {
constexpr int BM = 256, BK = 64, HALF = 128, HTB = HALF * BK * 2, STAGE_BYTES = 8 * HTB, NXCD = 8, WGM = 8;
__host__ __device__ __forceinline__ int lds_byte(int r, int c) { const int st = (r >> 4) * 2 + (c >> 5), rr = r & 15, cc = c & 31, ob = rr * 64 + cc * 2; return st * 1024 + (ob ^ (((ob >> 9) & 1) << 5)); }
__host__ __device__ __forceinline__ void stage_rc(int b, int& R, int& C) { const int st = b / 1024, sb = b % 1024, swz = sb ^ (((sb >> 9) & 1) << 5); R = (st >> 1) * 16 + swz / 64; C = (st & 1) * 32 + (swz % 64) / 2; }
__host__ __device__ __forceinline__ int perm32(int rho) { const int n = rho >> 4, i = rho & 15; return 8 * (i >> 2) + 4 * n + (i & 3); }
struct Unit { int pm, pn, e, nrow; };

template <bool I8, class Epi, class Sched>
__device__ __forceinline__ void gemm_phase(LAS unsigned char* lds, const void* Abase, const void* Bbase, const int K, const Sched& S, const Epi& E) {
    const int tid = threadIdx.x, wid = __builtin_amdgcn_readfirstlane(tid >> 6), lane = tid & 63, wr = wid >> 2, wc = wid & 3, fr = lane & 15, fq = lane >> 4;
    const int nt = K / BK;
    int Rr[2], Cc[2]; unsigned voffB[2];
#pragma unroll
    for (int i = 0; i < 2; ++i) { int R, C; stage_rc(tid * 16 + i * 8192, R, C); Rr[i] = R; Cc[i] = C; const int Rb = (R & ~31) + perm32(R & 31); voffB[i] = (unsigned)(Rb * K + C) * 2u; }
    const size_t kstep = (size_t)(BK * 2);
    const size_t hstepB = (size_t)HALF * K * 2;
    const unsigned ldsw = (unsigned)wid * 1024u;
    const int aoff = lds_byte(wr * 64 + fr, fq * 8), boff = lds_byte(wc * 32 + fr, fq * 8);
#define PG8_SA(b, h) (((b) * 2 + (h)) * HTB)
#define PG8_SB(b, h) ((4 + (b) * 2 + (h)) * HTB)
#define PG8_STAGEB(bufoff, gbase) do { _Pragma("unroll") for (int _i = 0; _i < 2; ++_i) \
        __builtin_amdgcn_global_load_lds((const unsigned*)((const char*)(gbase) + voffB[_i]), (LAS unsigned*)(lds + (bufoff) + ldsw + _i * 8192), 16, 0, 0); } while (0)
#define PG8_STAGEA(bufoff, o0, o1, ktb) do { const char* _p = (const char*)Abase + (ktb); \
        __builtin_amdgcn_global_load_lds((const unsigned*)(_p + (o0)), (LAS unsigned*)(lds + (bufoff) + ldsw), 16, 0, 0); \
        __builtin_amdgcn_global_load_lds((const unsigned*)(_p + (o1)), (LAS unsigned*)(lds + (bufoff) + ldsw + 8192), 16, 0, 0); } while (0)
#define PG8_LDA(dst, b, h) do { _Pragma("unroll") for (int m = 0; m < 4; ++m) _Pragma("unroll") for (int k = 0; k < 2; ++k) dst[m][k] = *(const LAS bf16x8*)(lds + PG8_SA(b, h) + aoff + m * 2048 + k * 1024); } while (0)
#define PG8_LDB(dst, b, h) do { _Pragma("unroll") for (int n = 0; n < 2; ++n) _Pragma("unroll") for (int k = 0; k < 2; ++k) dst[n][k] = *(const LAS bf16x8*)(lds + PG8_SB(b, h) + boff + n * 2048 + k * 1024); } while (0)
#define PG8_MMA(ai, bj, At, Bt) do { __builtin_amdgcn_s_setprio(1); _Pragma("unroll") for (int m = 0; m < 4; ++m) _Pragma("unroll") for (int n = 0; n < 2; ++n) _Pragma("unroll") for (int k = 0; k < 2; ++k) { \
        if constexpr (I8) acc[ai][bj][m][n] = __builtin_bit_cast(acc_t, __builtin_amdgcn_mfma_i32_16x16x64_i8(__builtin_bit_cast(i32x4, Bt[n][k]), __builtin_bit_cast(i32x4, At[m][k]), __builtin_bit_cast(i32x4, acc[ai][bj][m][n]), 0, 0, 0)); \
        else acc[ai][bj][m][n] = __builtin_bit_cast(acc_t, __builtin_amdgcn_mfma_f32_16x16x32_bf16(Bt[n][k], At[m][k], __builtin_bit_cast(f32x4, acc[ai][bj][m][n]), 0, 0, 0)); } __builtin_amdgcn_s_setprio(0); } while (0)
#define PG8_WAIT_V(n) asm volatile("s_waitcnt vmcnt(" #n ")" ::: "memory")
#define PG8_WAIT_L(n) asm volatile("s_waitcnt lgkmcnt(" #n ")" ::: "memory")
#define PG8_BAR __builtin_amdgcn_s_barrier()
#define PG8_SCHED __builtin_amdgcn_sched_barrier(0)
    Unit cur, nxt; int ui = 0;
    if (!S.next(0, cur)) return;
    using acc_t = typename std::conditional<I8, i32x4, f32x4>::type;
    acc_t acc[2][2][4][2];
#pragma unroll
    for (int a = 0; a < 2; ++a)
#pragma unroll
        for (int b = 0; b < 2; ++b)
#pragma unroll
            for (int m = 0; m < 4; ++m)
#pragma unroll
                for (int n = 0; n < 2; ++n) acc[a][b][m][n] = __builtin_bit_cast(acc_t, (u32x4){0u, 0u, 0u, 0u});
    bf16x8 At[4][2], B0[2][2], B1[2][2];
    unsigned oc00, oc01, oc10, oc11; int kn00, kn01, kn10, kn11;
    oc00 = S.a_conv(S.a_key(cur, Rr[0])) + Cc[0] * 2; oc01 = S.a_conv(S.a_key(cur, Rr[1])) + Cc[1] * 2; oc10 = S.a_conv(S.a_key(cur, HALF + Rr[0])) + Cc[0] * 2; oc11 = S.a_conv(S.a_key(cur, HALF + Rr[1])) + Cc[1] * 2;
    const char* cB = (const char*)Bbase + S.b_off(cur);
    PG8_STAGEB(PG8_SB(0, 0), cB); PG8_STAGEA(PG8_SA(0, 0), oc00, oc01, 0); PG8_STAGEB(PG8_SB(0, 1), cB + hstepB); PG8_STAGEA(PG8_SA(0, 1), oc10, oc11, 0);
    if (wr == 1) PG8_BAR;
    PG8_WAIT_V(4); PG8_BAR;
    PG8_STAGEB(PG8_SB(1, 0), cB + kstep); PG8_STAGEA(PG8_SA(1, 0), oc00, oc01, kstep); PG8_STAGEB(PG8_SB(1, 1), cB + hstepB + kstep);
    PG8_WAIT_V(6); PG8_BAR;
    for (;;) {
        E.pre(cur, lds, wid, lane, ui & 1);
        const bool has_next = S.next(ui + 1, nxt);
        const char* nB = cB;
        if (has_next) { kn00 = S.a_key(nxt, Rr[0]); kn01 = S.a_key(nxt, Rr[1]); kn10 = S.a_key(nxt, HALF + Rr[0]); kn11 = S.a_key(nxt, HALF + Rr[1]); nB = (const char*)Bbase + S.b_off(nxt); }
        else { kn00 = 0; kn01 = 0; kn10 = 0; kn11 = 0; }
        for (int t = 0; t < nt; t += 2) {
            const bool last = (t == nt - 2);
            const size_t k1 = (size_t)(t + 1) * kstep;
            const size_t k2 = last ? 0 : (size_t)(t + 2) * kstep, k3 = k2 + kstep;
            const unsigned o200 = (last && has_next) ? S.a_conv(kn00) + Cc[0] * 2 : oc00, o201 = (last && has_next) ? S.a_conv(kn01) + Cc[1] * 2 : oc01, o210 = (last && has_next) ? S.a_conv(kn10) + Cc[0] * 2 : oc10, o211 = (last && has_next) ? S.a_conv(kn11) + Cc[1] * 2 : oc11;
            const char* b2 = last ? nB : cB + (size_t)(t + 2) * kstep; const char* b3 = b2 + kstep;
            PG8_LDB(B0, 0, 0); PG8_SCHED; PG8_LDA(At, 0, 0); PG8_STAGEA(PG8_SA(1, 1), oc10, oc11, k1);
            PG8_WAIT_L(8); PG8_BAR; PG8_WAIT_L(0); PG8_MMA(0, 0, At, B0); PG8_BAR; PG8_SCHED;
            PG8_LDB(B1, 0, 1); PG8_STAGEB(PG8_SB(0, 0), b2);
            PG8_BAR; PG8_WAIT_L(0); PG8_MMA(0, 1, At, B1); PG8_BAR;
            PG8_LDA(At, 0, 1); PG8_STAGEA(PG8_SA(0, 0), o200, o201, k2);
            PG8_BAR; PG8_WAIT_L(0); PG8_MMA(1, 0, At, B0); PG8_BAR; PG8_SCHED;
            PG8_STAGEB(PG8_SB(0, 1), b2 + hstepB);
            PG8_WAIT_V(6); PG8_BAR; PG8_MMA(1, 1, At, B1); PG8_BAR;
            PG8_LDB(B0, 1, 0); PG8_SCHED; PG8_LDA(At, 1, 0); PG8_STAGEA(PG8_SA(0, 1), o210, o211, k2);
            PG8_WAIT_L(8); PG8_BAR; PG8_WAIT_L(0); PG8_MMA(0, 0, At, B0); PG8_BAR; PG8_SCHED;
            PG8_LDB(B1, 1, 1); PG8_STAGEB(PG8_SB(1, 0), b3);
            PG8_BAR; PG8_WAIT_L(0); PG8_MMA(0, 1, At, B1); PG8_BAR;
            PG8_LDA(At, 1, 1); PG8_STAGEA(PG8_SA(1, 0), o200, o201, k3);
            PG8_BAR; PG8_WAIT_L(0); PG8_MMA(1, 0, At, B0); PG8_BAR; PG8_SCHED;
            PG8_STAGEB(PG8_SB(1, 1), b3 + hstepB);
            PG8_WAIT_V(6); PG8_BAR; PG8_MMA(1, 1, At, B1); PG8_BAR;
        }
        E(acc, cur, wr, wc, fr, fq, ui & 1);
        if (!has_next) break;
#pragma unroll
        for (int a = 0; a < 2; ++a)
#pragma unroll
            for (int b = 0; b < 2; ++b)
#pragma unroll
                for (int m = 0; m < 4; ++m)
#pragma unroll
                    for (int n = 0; n < 2; ++n) acc[a][b][m][n] = __builtin_bit_cast(acc_t, (u32x4){0u, 0u, 0u, 0u});
        cur = nxt; cB = nB; oc00 = S.a_conv(kn00) + Cc[0] * 2; oc01 = S.a_conv(kn01) + Cc[1] * 2; oc10 = S.a_conv(kn10) + Cc[0] * 2; oc11 = S.a_conv(kn11) + Cc[1] * 2; ++ui;
    }
    PG8_WAIT_V(0);
    if (wr == 0) PG8_BAR;
    PG8_BAR;
#undef PG8_SA
#undef PG8_SB
#undef PG8_STAGEA
#undef PG8_STAGEB
#undef PG8_LDA
#undef PG8_LDB
#undef PG8_MMA
#undef PG8_WAIT_V
#undef PG8_WAIT_L
#undef PG8_BAR
#undef PG8_SCHED
}

struct DenseOrder {
    int nM, nN, nwg, G, c, K;
    __device__ void init(int M, int N, int K_, int G_, int c_) { nM = M / BM; nN = N / BM; nwg = nM * nN; G = G_; c = c_; K = K_; }
    __device__ __forceinline__ bool next(int i, Unit& u) const {
        const long L = (long)i * G + c; if (L >= nwg) return false;
        int wgid = (int)L; { const int q = nwg / NXCD, r = nwg % NXCD, xcd = wgid % NXCD, off = wgid / NXCD; wgid = (xcd < r ? xcd * (q + 1) : r * (q + 1) + (xcd - r) * q) + off; }
        const int nig = WGM * nN, gid = wgid / nig, fm = gid * WGM, gsz = (nM - fm) < WGM ? (nM - fm) : WGM;
        u.pm = fm + ((wgid % nig) % gsz); u.pn = (wgid % nig) / gsz; u.e = 0; u.nrow = 256; return true;
    }
    __device__ __forceinline__ int a_key(const Unit& u, int R) const { return u.pm * BM + R; }
    __device__ __forceinline__ unsigned a_conv(int key) const { return (unsigned)(key * K) * 2u; }
    __device__ __forceinline__ size_t b_off(const Unit& u) const { return (size_t)u.pn * BM * K * 2; }
};
struct MoeOrder {
    const LAS int* tstart; const LAS int* cnt; const LAS unsigned char* etile; const int* list; int G, c, K; bool gather;
    static constexpr int npn = 4;
    __device__ __forceinline__ bool next(int i, Unit& u) const {
        const int L = i * G + c; const int tt = tstart[32];
        if (L >= tt * npn) return false;
        const int tile = L / npn; u.pn = L % npn; u.pm = tile;
        const int e = etile[tile];
        u.e = e; u.nrow = cnt[e] - (tile - tstart[e]) * 256; return true;
    }
    __device__ __forceinline__ int a_key(const Unit& u, int R) const {
        if (gather) { const int mt = u.pm - tstart[u.e]; const int r = mt * 256 + R; return list[(size_t)u.e * 65536 + (R < u.nrow ? r : 0)]; }
        return u.pm * BM + R;
    }
    __device__ __forceinline__ unsigned a_conv(int key) const { return (unsigned)(key * K) * 2u; }
    __device__ __forceinline__ size_t b_off(const Unit& u) const { return ((size_t)u.e * 1024 + (size_t)u.pn * BM) * K * 2; }
};
}

constexpr int EPI_SC = MISC_OFF + 24576;
struct EpiIn {
    unsigned char* ws; const float* gate_b;
    __device__ __forceinline__ void pre(const pg8::Unit& u, LAS unsigned char* lds, int wid, int lane, int par) const {
        if (wid == 0) { __builtin_amdgcn_global_load_lds((const unsigned*)((const float*)(ws + WS_SA1) + u.pm * 256 + lane * 4), (LAS unsigned*)(lds + EPI_SC + par * 2048), 16, 0, 0);
                        __builtin_amdgcn_global_load_lds((const unsigned*)((const float*)(ws + WS_SBW) + u.pn * 256 + lane * 4), (LAS unsigned*)(lds + EPI_SC + par * 2048 + 1024), 16, 0, 0); } }
    LAS unsigned char* lds;
    __device__ __forceinline__ void operator()(const i32x4 (&acc)[2][2][4][2], const pg8::Unit& u, int wr, int wc, int fr, int fq, int par) const {
        asm volatile("" : "+v"(fr), "+v"(fq));
        const int pn = u.pn, row0 = u.pm * 256 + wr * 64 + fr;
        float sa[2][4]; f32x4 sb[2][2];
        { LAS const float* SA1 = (LAS const float*)(lds + EPI_SC + par * 2048); LAS const float* SBW = SA1 + 256;
#pragma unroll
          for (int ai = 0; ai < 2; ++ai)
#pragma unroll
              for (int m = 0; m < 4; ++m) sa[ai][m] = SA1[wr * 64 + fr + ai * 128 + m * 16];
#pragma unroll
          for (int bj = 0; bj < 2; ++bj)
#pragma unroll
              for (int n = 0; n < 2; ++n) sb[bj][n] = *(LAS const f32x4*)(SBW + bj * 128 + wc * 32 + 8 * fq + 4 * n); }
#define ACCF(ai, bj, m, n) (__builtin_convertvector(acc[ai][bj][m][n], f32x4) * sa[ai][m] * sb[bj][n])
        if (pn < 8) {
            bf16_t* dst = (bf16_t*)(ws + (pn < 2 ? WS_MQ : pn < 4 ? WS_MK : pn < 6 ? WS_MV : WS_MO));
            const int col0 = (pn & 1) * 256 + wc * 32 + 8 * fq;
#pragma unroll
            for (int ai = 0; ai < 2; ++ai)
#pragma unroll
                for (int m = 0; m < 4; ++m) { bf16_t* rp = dst + (size_t)(row0 + ai * 128 + m * 16) * 512 + col0;
#pragma unroll
                    for (int bj = 0; bj < 2; ++bj) { const f32x4 v0 = ACCF(ai, bj, m, 0), v1 = ACCF(ai, bj, m, 1);
                        u32x4 w; w.x = cvtpk(v0[0], v0[1]); w.y = cvtpk(v0[2], v0[3]); w.z = cvtpk(v1[0], v1[1]); w.w = cvtpk(v1[2], v1[3]);
                        *(u32x4*)(rp + bj * 128) = w; } }
        } else if (pn < 10) {
            const int g8 = 4 * (wc & 1) + fq; const float* COS = (const float*)(ws + WS_COS); const float* SIN = (const float*)(ws + WS_SIN); bf16_t* NQ = (bf16_t*)(ws + WS_NQ);
#pragma unroll
            for (int ai = 0; ai < 2; ++ai)
#pragma unroll
                for (int m = 0; m < 4; ++m) { const int row = row0 + ai * 128 + m * 16;
                    const f32x4 cs = *(const f32x4*)(COS + (size_t)row * 32 + 4 * g8), sn = *(const f32x4*)(SIN + (size_t)row * 32 + 4 * g8);
#pragma unroll
                    for (int bj = 0; bj < 2; ++bj) { const int head = (pn - 8) * 4 + bj * 2 + (wc >> 1);
                        const f32x4 x1 = ACCF(ai, bj, m, 0), x2 = ACCF(ai, bj, m, 1);
                        const f32x4 o1 = (x1 * cs - x2 * sn) * QSCALE, o2 = (x2 * cs + x1 * sn) * QSCALE;
                        bf16_t* rp = NQ + (size_t)row * 512 + head * 64 + 4 * (g8 & ~1) + 32 * (fq & 1);
                        u32x2 a; a.x = cvtpk(o1[0], o1[1]); a.y = cvtpk(o1[2], o1[3]);
                        u32x2 b; b.x = cvtpk(o2[0], o2[1]); b.y = cvtpk(o2[2], o2[3]); *(u32x4*)rp = widen_rows16(a, b); } }
        } else if (pn < 13) {
            bf16_t* kd = (bf16_t*)(ws + (pn == 10 ? WS_KC : pn == 11 ? WS_KSL : WS_KWN)); bf16_t* vd = (bf16_t*)(ws + (pn == 10 ? WS_VC : pn == 11 ? WS_VSL : WS_VWN));
            const float* COS = (const float*)(ws + WS_COS); const float* SIN = (const float*)(ws + WS_SIN);
            const int g8 = 4 * (wc & 1) + fq, grp = wc >> 1;
#pragma unroll
            for (int ai = 0; ai < 2; ++ai)
#pragma unroll
                for (int m = 0; m < 4; ++m) { const int row = row0 + ai * 128 + m * 16; const int b = row >> 12, s = row & 4095;
                    const f32x4 cs = *(const f32x4*)(COS + (size_t)row * 32 + 4 * g8), sn = *(const f32x4*)(SIN + (size_t)row * 32 + 4 * g8);
                    const size_t rbase = ((size_t)(b * 2 + grp) * SEQ + s) * 64;
                    { const f32x4 x1 = ACCF(ai, 0, m, 0), x2 = ACCF(ai, 0, m, 1);
                      const f32x4 o1 = x1 * cs - x2 * sn, o2 = x2 * cs + x1 * sn;
                      bf16_t* rp = kd + rbase + 4 * (g8 & ~1) + 32 * (fq & 1);
                      u32x2 a; a.x = cvtpk(o1[0], o1[1]); a.y = cvtpk(o1[2], o1[3]);
                      u32x2 c; c.x = cvtpk(o2[0], o2[1]); c.y = cvtpk(o2[2], o2[3]); *(u32x4*)rp = widen_rows16(a, c); }
                    { const f32x4 v0 = ACCF(ai, 1, m, 0), v1 = ACCF(ai, 1, m, 1);
                      u32x4 w; w.x = cvtpk(v0[0], v0[1]); w.y = cvtpk(v0[2], v0[3]); w.z = cvtpk(v1[0], v1[1]); w.w = cvtpk(v1[2], v1[3]);
                      *(u32x4*)(vd + rbase + (wc & 1) * 32 + 8 * fq) = w; } }
        } else {
            if (wc == 0) { float* GI = (float*)(ws + WS_GI); float* GF = (float*)(ws + WS_GF); float* NGT = (float*)(ws + WS_NGT);
#pragma unroll
                for (int ai = 0; ai < 2; ++ai)
#pragma unroll
                    for (int m = 0; m < 4; ++m) { const int row = row0 + ai * 128 + m * 16; const int b = row >> 12, s = row & 4095;
#pragma unroll
                        for (int n = 0; n < 2; ++n) { const f32x4 v = ACCF(ai, 0, m, n);
                            if (fq == 0) {
#pragma unroll
                                for (int i = 0; i < 4; ++i) { const float z = v[i] + gate_b[4 * n + i];
                                    if (n == 0) GI[(size_t)(b * 4 + i) * SEQ + s] = z; else GF[(size_t)(b * 4 + i) * SEQ + s] = logsigmoid_f(z); }
                            } else {
                                f32x4 o; o[0] = sigmoid_f(v[0]); o[1] = sigmoid_f(v[1]); o[2] = sigmoid_f(v[2]); o[3] = sigmoid_f(v[3]);
                                *(f32x4*)(NGT + (size_t)row * 24 + 8 * fq + 4 * n - 8) = o; } } }
            }
        }
    }
};
#undef ACCF
struct EpiBf16 {
    bf16_t* O; int ldc;
    __device__ __forceinline__ void pre(const pg8::Unit&, LAS unsigned char*, int, int, int) const {}
    __device__ __forceinline__ void operator()(const f32x4 (&acc)[2][2][4][2], const pg8::Unit& u, int wr, int wc, int fr, int fq, int par) const {
        asm volatile("" : "+v"(fr), "+v"(fq));
        const int row0 = u.pm * 256 + wr * 64 + fr, col0 = u.pn * 256 + wc * 32 + 8 * fq;
#pragma unroll
        for (int ai = 0; ai < 2; ++ai)
#pragma unroll
            for (int m = 0; m < 4; ++m) { bf16_t* rp = O + (size_t)(row0 + ai * 128 + m * 16) * ldc + col0;
#pragma unroll
                for (int bj = 0; bj < 2; ++bj) { const f32x4 v0 = acc[ai][bj][m][0], v1 = acc[ai][bj][m][1];
                    u32x4 w; w.x = cvtpk(v0[0], v0[1]); w.y = cvtpk(v0[2], v0[3]); w.z = cvtpk(v1[0], v1[1]); w.w = cvtpk(v1[2], v1[3]);
                    *(u32x4*)(rp + bj * 128) = w; } }
    }
};
struct EpiUp {
    bf16_t* HB;
    __device__ __forceinline__ void pre(const pg8::Unit&, LAS unsigned char*, int, int, int) const {}
    __device__ __forceinline__ void operator()(const f32x4 (&acc)[2][2][4][2], const pg8::Unit& u, int wr, int wc, int fr, int fq, int par) const {
        asm volatile("" : "+v"(fr), "+v"(fq));
        const int row0 = u.pm * 256 + wr * 64 + fr, col0 = (u.pn * 256 + wc * 32 + 8 * fq) >> 1;
#pragma unroll
        for (int ai = 0; ai < 2; ++ai)
#pragma unroll
            for (int m = 0; m < 4; ++m) { bf16_t* rp = HB + (size_t)(row0 + ai * 128 + m * 16) * EFF + col0;
#pragma unroll
                for (int bj = 0; bj < 2; ++bj) { const f32x4 a1 = acc[ai][bj][m][0], a3 = acc[ai][bj][m][1];
                    u32x2 w; w.x = cvtpk(silu_f(a1[0]) * a3[0], silu_f(a1[1]) * a3[1]); w.y = cvtpk(silu_f(a1[2]) * a3[2], silu_f(a1[3]) * a3[3]);
                    *(u32x2*)(rp + bj * 64) = w; } }
    }
};

struct EpiUpI8 {
    bf16_t* HB; const float* SAL; const float* SB; const LAS int* tstart; LAS unsigned char* lds;
    __device__ __forceinline__ void pre(const pg8::Unit& u, LAS unsigned char* l, int wid, int lane, int par) const {
        if (wid == 0) { const int mt = u.pm - tstart[u.e];
            __builtin_amdgcn_global_load_lds((const unsigned*)(SAL + (size_t)u.e * 65536 + mt * 256 + lane * 4), (LAS unsigned*)(l + EPI_SC + par * 2048), 16, 0, 0);
            __builtin_amdgcn_global_load_lds((const unsigned*)(SB + (size_t)u.e * 1024 + u.pn * 256 + lane * 4), (LAS unsigned*)(l + EPI_SC + par * 2048 + 1024), 16, 0, 0); } }
    __device__ __forceinline__ void operator()(const i32x4 (&acc)[2][2][4][2], const pg8::Unit& u, int wr, int wc, int fr, int fq, int par) const {
        asm volatile("" : "+v"(fr), "+v"(fq));
        const int rl0 = wr * 64 + fr, row0 = u.pm * 256 + rl0, colp = u.pn * 256 + wc * 32 + 8 * fq, col0 = colp >> 1;
        LAS const float* LSA = (LAS const float*)(lds + EPI_SC + par * 2048); LAS const float* LSB = LSA + 256;
        f32x4 sb[2][2];
#pragma unroll
        for (int bj = 0; bj < 2; ++bj)
#pragma unroll
            for (int n = 0; n < 2; ++n) sb[bj][n] = *(LAS const f32x4*)(LSB + wc * 32 + 8 * fq + bj * 128 + 4 * n);
#pragma unroll
        for (int ai = 0; ai < 2; ++ai)
#pragma unroll
            for (int m = 0; m < 4; ++m) { const int R = rl0 + ai * 128 + m * 16; const float sa = LSA[R];
                bf16_t* rp = HB + (size_t)(row0 + ai * 128 + m * 16) * EFF + (col0 & ~7) + 64 * (fq & 1);
                u32x2 wv[2];
#pragma unroll
                for (int bj = 0; bj < 2; ++bj) { const i32x4 i1 = acc[ai][bj][m][0], i3 = acc[ai][bj][m][1];
                    f32x4 a1, a3;
#pragma unroll
                    for (int i = 0; i < 4; ++i) { a1[i] = (float)i1[i] * sa * sb[bj][0][i]; a3[i] = (float)i3[i] * sa * sb[bj][1][i]; }
                    wv[bj].x = cvtpk(silu_f(a1[0]) * a3[0], silu_f(a1[1]) * a3[1]); wv[bj].y = cvtpk(silu_f(a1[2]) * a3[2], silu_f(a1[3]) * a3[3]); }
                *(u32x4*)rp = widen_rows16(wv[0], wv[1]); }
    }
};

template <class RM>
__device__ __forceinline__ void transpose_item(const float* W, int N, bf16_t* WT, int Kd, LAS float* scr, int k0, int n0, int lane, const RM& rm) {
#pragma unroll
    for (int i = 0; i < 8; ++i) { const int kk = 8 * i + (lane >> 3); const f32x4 w4 = *(const f32x4*)(W + (size_t)(k0 + kk) * N + n0 + 4 * (lane & 7));
        LAS float* d = scr + kk * 33 + 4 * (lane & 7); d[0] = w4[0]; d[1] = w4[1]; d[2] = w4[2]; d[3] = w4[3]; }
    asm volatile("s_waitcnt lgkmcnt(0)" ::: "memory");
    const int c = lane & 7;
#pragma unroll
    for (int j = 0; j < 4; ++j) { const int n = (lane >> 3) + 8 * j; const LAS float* s = scr + (8 * c) * 33 + n;
        u32x4 o; o.x = cvtpk(s[0 * 33], s[1 * 33]); o.y = cvtpk(s[2 * 33], s[3 * 33]); o.z = cvtpk(s[4 * 33], s[5 * 33]); o.w = cvtpk(s[6 * 33], s[7 * 33]);
        *(u32x4*)(WT + (size_t)rm(n0 + n) * Kd + k0 + 8 * c) = o; }
    asm volatile("s_waitcnt lgkmcnt(0)" ::: "memory");
}
struct RmId { int off; __device__ __forceinline__ int operator()(int n) const { return off + n; } };
__device__ __forceinline__ int rope_pl(int d) { return 8 * ((d & 31) >> 2) + 4 * (d >> 5) + (d & 3); }
struct RmWin {
    __device__ __forceinline__ int operator()(int c) const {
        if (c < 2048) return c;
        if (c < 2052) return 3328 + (c - 2048);
        if (c < 2056) return 3332 + (c - 2052);
        if (c < 2568) { const int x = c - 2056; return 2048 + (x & ~63) + rope_pl(x & 63); }
        if (c < 2696) { const int x = c - 2568; return 2560 + (x & ~63) + rope_pl(x & 63); }
        if (c < 2824) return 2688 + (c - 2696);
        if (c < 2952) { const int x = c - 2824; return 2816 + (x & ~63) + rope_pl(x & 63); }
        if (c < 3080) return 2944 + (c - 2952);
        if (c < 3208) { const int x = c - 3080; return 3072 + (x & ~63) + rope_pl(x & 63); }
        if (c < 3336) return 3200 + (c - 3208);
        return c;
    }
};
struct RmW13 { int sel; __device__ __forceinline__ int operator()(int j) const { return 8 * (j >> 2) + 4 * sel + (j & 3); } };

__device__ __forceinline__ void p0_phase(Frame& F) {
    const int tid = F.tid, lane = F.lane;
    const int NA = F.G > 64 ? 64 : F.G;
    const bool split = F.G > NA;
    if (F.vcu < NA) {
        LAS float* sc = (LAS float*)F.lds; LAS float* red = (LAS float*)(F.lds + 32768);
        const float* c = IN_F(1);
        for (int i = tid; i < 8192; i += NTHR) sc[i] = silu_f(c[i]);
        __syncthreads();
        const float* W = IN_F(3); const float* bia = IN_F(4); float* mod = WSP(float, WS_MOD);
        for (int cg = F.vcu; cg < 64; cg += NA) {
            const int col0 = cg * 96;
            const int kq = tid / 24, cq = tid % 24;
            f32x4 a[8];
#pragma unroll
            for (int b = 0; b < 8; ++b) a[b] = (f32x4){0.f, 0.f, 0.f, 0.f};
            if (tid < 504) {
#pragma unroll 4
                for (int k = kq; k < 1024; k += 21) { const f32x4 w = *(const f32x4*)(W + (size_t)k * 6144 + col0 + 4 * cq);
#pragma unroll
                    for (int b = 0; b < 8; ++b) a[b] += w * sc[b * 1024 + k]; }
#pragma unroll
                for (int b = 0; b < 8; ++b) *(LAS f32x4*)(red + (size_t)(tid * 8 + b) * 4) = a[b];
            }
            __syncthreads();
            for (int o = tid; o < 768; o += NTHR) { const int cq2 = o >> 5, bj = o & 31;
                float sacc = 0.f;
                for (int q = 0; q < 21; ++q) sacc += red[(size_t)((q * 24 + cq2) * 8) * 4 + bj];
                const int col = col0 + 4 * cq2 + (bj & 3);
                mod[(bj >> 2) * 6144 + col] = sacc + bia[col]; }
            __syncthreads();
        }
    }
    if (!split || F.vcu >= NA) {
        LAS float* scr = (LAS float*)(F.lds + F.wave * 8448);
        const int gw = (split ? F.vcu - NA : F.vcu) * NWAVES + F.wave, NGW = (split ? F.G - NA : F.G) * NWAVES;
        constexpr int I_WOUT = 16 * 32, I_C1 = 32 * 4, I_C2 = 2 * 2;
        constexpr int NITEMS = I_WOUT + 2 * I_C1 + 2 * I_C2;
        for (int it = gw; it < NITEMS; it += NGW) {
            int r = it;
            if (r < I_WOUT) { transpose_item(IN_F(19), 1024, WSP(bf16_t, WS_WOUTT), 1024, scr, (r / 32) * 64, (r % 32) * 32, lane, RmId{0}); continue; } r -= I_WOUT;
            if (r < I_C1) { transpose_item(IN_F(14), 128, WSP(bf16_t, WS_CW1K), 2048, scr, (r / 4) * 64, (r % 4) * 32, lane, RmId{0}); continue; } r -= I_C1;
            if (r < I_C1) { transpose_item(IN_F(17), 128, WSP(bf16_t, WS_CW1V), 2048, scr, (r / 4) * 64, (r % 4) * 32, lane, RmId{0}); continue; } r -= I_C1;
            if (r < I_C2) { transpose_item(IN_F(15), 64, WSP(bf16_t, WS_CW2K), 128, scr, (r / 2) * 64, (r % 2) * 32, lane, RmId{0}); continue; } r -= I_C2;
            transpose_item(IN_F(18), 64, WSP(bf16_t, WS_CW2V), 128, scr, (r / 2) * 64, (r % 2) * 32, lane, RmId{0});
        }
    }
    __syncthreads();
    {
        LAS unsigned* AM = (LAS unsigned*)F.lds; const int n4 = tid & 7, kq = tid >> 3; const RmWin rmw{};
        for (int it = (F.vcu + F.G - (split ? NA : 0)) % F.G; it < 105; it += F.G) {
            const int c0 = 32 * it + 4 * n4; const float* W = IN_F(9) + (size_t)(16 * kq) * INW + c0;
            if (tid < 32) AM[tid] = 0u;
            __syncthreads();
            f32x4 v[16]; f32x4 am = {0.f, 0.f, 0.f, 0.f};
#pragma unroll
            for (int i = 0; i < 16; ++i) { v[i] = *(const f32x4*)(W + (size_t)i * INW);
#pragma unroll
                for (int c = 0; c < 4; ++c) am[c] = fmaxf(am[c], fabsf(v[i][c])); }
#pragma unroll
            for (int o = 8; o < 64; o <<= 1) {
#pragma unroll
                for (int c = 0; c < 4; ++c) am[c] = fmaxf(am[c], __shfl_xor(am[c], o)); }
            if ((tid & 63) < 8) {
#pragma unroll
                for (int c = 0; c < 4; ++c) atomicMax((unsigned*)&AM[4 * n4 + c], __float_as_uint(am[c])); }
            __syncthreads();
            const f32x4 amax = *(LAS const f32x4*)((LAS const float*)AM + 4 * n4);
#pragma unroll
            for (int c = 0; c < 4; ++c) { const float inv = amax[c] > 0.f ? 127.f / amax[c] : 0.f; const int prow = rmw(c0 + c); u32x4 o;
#pragma unroll
                for (int d = 0; d < 4; ++d) {
                    const int q0 = (int)rintf(v[4 * d][c] * inv), q1 = (int)rintf(v[4 * d + 1][c] * inv), q2 = (int)rintf(v[4 * d + 2][c] * inv), q3 = (int)rintf(v[4 * d + 3][c] * inv);
                    o[d] = (unsigned)(q0 & 0xff) | ((unsigned)(q1 & 0xff) << 8) | ((unsigned)(q2 & 0xff) << 16) | ((unsigned)(q3 & 0xff) << 24); }
                *(u32x4*)((unsigned char*)(F.ws + WS_WINT) + (size_t)prow * 1024 + 16 * kq) = o;
                if (kq == 0) WSP(float, WS_SBW)[prow] = amax[c] * (1.f / 127.f); }
            __syncthreads();
        }
    }
    if (!split || F.vcu >= NA) {
        const size_t gt = (size_t)(split ? F.vcu - NA : F.vcu) * NTHR + tid, NGT_ = (size_t)(split ? F.G - NA : F.G) * NTHR;
        const int* pos = (const int*)F.in[2]; float* COS = WSP(float, WS_COS); float* SIN = WSP(float, WS_SIN);
        {
            const int d = (int)(gt & 31); const float inv = powf(10000.f, -(float)d / 32.f);
            for (size_t i = gt; i < (size_t)NTOK * 32; i += NGT_) { const int row = (int)(i >> 5);
                const float ang = (float)pos[row] * inv; const float kk = rintf(ang * 0.15915494309189535f);
                float r = fmaf(-kk, 6.28125f, ang); r = fmaf(-kk, 1.9353071795864769e-3f, r);
                const float sn = __sinf(r), cs = __cosf(r); COS[i] = cs; SIN[i] = sn; } }
        { unsigned* z = (unsigned*)(F.ws + WS_WINT + (size_t)3360 * 1024); for (size_t i = gt; i < (size_t)224 * 256; i += NGT_) z[i] = 0u;
          for (size_t i = gt; i < 224; i += NGT_) WSP(float, WS_SBW)[3360 + i] = 0.f; }
        { const float* wg = IN_F(20); const float* we = IN_F(22); _Float16* RWT = WSP(_Float16, WS_RWT);
          for (size_t i = gt; i < 48 * 1024; i += NGT_) { const int n = (int)(i >> 10), k = (int)(i & 1023);
              const float w = n < 4 ? wg[k * 4 + n] : n < 36 ? we[k * 32 + n - 4] : 0.f; RWT[i] = (_Float16)w; } }
        { bf16_t* kc = WSP(bf16_t, WS_KCMP); bf16_t* vc = WSP(bf16_t, WS_VCMP);
          for (size_t i = gt; i < 16 * 64; i += NGT_) { const size_t o = ((i >> 6) * 256 + 255) * 64 + (i & 63); kc[o] = 0; vc[o] = 0; } }
    }
    __syncthreads();
    if (F.vcu >= F.G - 16) {
        const int bi = F.vcu - (F.G - 16), kv = bi >> 3, cg = bi & 7;
        const float* pe = IN_F(kv == 0 ? 13 : 16); const float* w1 = IN_F(kv == 0 ? 14 : 17);
        LAS float* red = (LAS float*)F.lds;
        const int col = cg * 16 + (tid & 15), sl = tid >> 4; float sacc = 0.f;
#pragma unroll 8
        for (int k = sl * 64; k < sl * 64 + 64; ++k) sacc += pe[k] * w1[(size_t)k * 128 + col];
        red[tid] = sacc; __syncthreads();
        if (tid < 16) { float t2 = 0.f; for (int q = 0; q < 32; ++q) t2 += red[q * 16 + tid]; WSP(float, WS_C1B)[kv * 128 + cg * 16 + tid] = t2; }
    }
    __syncthreads();
}

__device__ __forceinline__ void p1a_phase(Frame& F) {
    const int gw = F.vcu * NWAVES + F.wave, NGW = F.G * NWAVES, lane = F.lane;
    const float* x = IN_F(0); const float* nw = IN_F(5); const float* mod = WSP(float, WS_MOD); signed char* H1Q = (signed char*)(F.ws + WS_H1);
    for (int row0 = gw * 4; row0 < NTOK; row0 += NGW * 4) {
        f32x4 v[4][4]; float ss[4];
#pragma unroll
        for (int r = 0; r < 4; ++r) { const f32x4* xr = (const f32x4*)(x + (size_t)(row0 + r) * DM) + lane;
#pragma unroll
            for (int j = 0; j < 4; ++j) v[r][j] = __builtin_nontemporal_load(xr + 64 * j); }
#pragma unroll
        for (int r = 0; r < 4; ++r) { float a = 0.f;
#pragma unroll
            for (int j = 0; j < 4; ++j) a += v[r][j][0] * v[r][j][0] + v[r][j][1] * v[r][j][1] + v[r][j][2] * v[r][j][2] + v[r][j][3] * v[r][j][3];
            ss[r] = a; }
#pragma unroll
        for (int o = 1; o < 64; o <<= 1) {
#pragma unroll
            for (int r = 0; r < 4; ++r) ss[r] += __shfl_xor(ss[r], o); }
        const int b = row0 >> 12; float am[4] = {0.f, 0.f, 0.f, 0.f};
#pragma unroll
        for (int j = 0; j < 4; ++j) { const int k = 4 * lane + 256 * j;
            const f32x4 w = *(const f32x4*)(nw + k), sh = *(const f32x4*)(mod + b * 6144 + k), sc = *(const f32x4*)(mod + b * 6144 + 1024 + k);
            const f32x4 ws = w * (sc + 1.f);
#pragma unroll
            for (int r = 0; r < 4; ++r) { const float rr = rsqrtf(ss[r] * (1.f / DM) + RMS_EPS);
                const f32x4 h = v[r][j] * rr * ws + sh; v[r][j] = h;
                am[r] = fmaxf(am[r], fmaxf(fmaxf(fabsf(h[0]), fabsf(h[1])), fmaxf(fabsf(h[2]), fabsf(h[3])))); } }
#pragma unroll
        for (int o = 1; o < 64; o <<= 1) {
#pragma unroll
            for (int r = 0; r < 4; ++r) am[r] = fmaxf(am[r], __shfl_xor(am[r], o)); }
#pragma unroll
        for (int r = 0; r < 4; ++r) { const float inv = am[r] > 0.f ? 127.f / am[r] : 0.f;
            if (lane == 0) WSP(float, WS_SA1)[row0 + r] = am[r] * (1.f / 127.f);
            u32x4 pk;
#pragma unroll
            for (int j = 0; j < 4; ++j) { const f32x4 q = v[r][j] * inv;
                const int q0 = (int)rintf(q[0]), q1 = (int)rintf(q[1]), q2 = (int)rintf(q[2]), q3 = (int)rintf(q[3]);
                pk[j] = (unsigned)(q0 & 0xff) | ((unsigned)(q1 & 0xff) << 8) | ((unsigned)(q2 & 0xff) << 16) | ((unsigned)(q3 & 0xff) << 24); }
            *(u32x4*)(H1Q + (size_t)(row0 + r) * DM + 256 * (lane & 3) + 16 * (lane >> 2)) = quad_transpose(pk, lane); }
    }
}

__device__ __forceinline__ void conv_silu16(const bf16_t* src  , const float* cw  , int b, int s, int ch0  , float scale, float (&o)[16]) {
#pragma unroll
    for (int i = 0; i < 16; ++i) o[i] = 0.f;
#pragma unroll
    for (int j = 0; j < 4; ++j) { const int ss = s - 3 + j;
        if (ss >= 0) { const bf16_t* rp = src + ((size_t)b * SEQ + ss) * 512 + ch0;
            const u32x4 a = *(const u32x4*)rp, c = *(const u32x4*)(rp + 8);
            const float* w = cw + j * 1024;
            const f32x4 w0 = *(const f32x4*)w, w1 = *(const f32x4*)(w + 4), w2 = *(const f32x4*)(w + 8), w3 = *(const f32x4*)(w + 12);
            o[0] += bflo(a.x) * w0[0]; o[1] += bfhi(a.x) * w0[1]; o[2] += bflo(a.y) * w0[2]; o[3] += bfhi(a.y) * w0[3];
            o[4] += bflo(a.z) * w1[0]; o[5] += bfhi(a.z) * w1[1]; o[6] += bflo(a.w) * w1[2]; o[7] += bfhi(a.w) * w1[3];
            o[8] += bflo(c.x) * w2[0]; o[9] += bfhi(c.x) * w2[1]; o[10] += bflo(c.y) * w2[2]; o[11] += bfhi(c.y) * w2[3];
            o[12] += bflo(c.z) * w3[0]; o[13] += bfhi(c.z) * w3[1]; o[14] += bflo(c.w) * w3[2]; o[15] += bfhi(c.w) * w3[3]; } }
#pragma unroll
    for (int i = 0; i < 16; ++i) o[i] = silu_f(o[i]) * scale;
}
constexpr int RAWS = 272, RAWIMG = 67 * RAWS + 208;
__device__ __forceinline__ void stage_raw(const bf16_t* src, int b, int s0, int h, LAS unsigned char* RAW, int tid) {
    const int s = tid >> 3, chg = tid & 7;
    const bf16_t* rp = src + ((size_t)b * SEQ + s0 + s) * 512 + h * 128 + chg * 16;
    *(LAS u32x4*)(RAW + (s + 3) * RAWS + chg * 32) = *(const u32x4*)rp; *(LAS u32x4*)(RAW + (s + 3) * RAWS + chg * 32 + 16) = *(const u32x4*)(rp + 8);
    if (s < 3) { u32x4 a = {0u, 0u, 0u, 0u}, c = a; const int ss = s0 - 3 + s;
        if (ss >= 0) { const bf16_t* hp = src + ((size_t)b * SEQ + ss) * 512 + h * 128 + chg * 16; a = *(const u32x4*)hp; c = *(const u32x4*)(hp + 8); }
        *(LAS u32x4*)(RAW + s * RAWS + chg * 32) = a; *(LAS u32x4*)(RAW + s * RAWS + chg * 32 + 16) = c; }
}
__device__ __forceinline__ void conv_lds16(LAS const unsigned char* RAW, LAS const float* WL, int s, int ch0, float scale, float (&o)[16]) {
#pragma unroll
    for (int i = 0; i < 16; ++i) o[i] = 0.f;
#pragma unroll
    for (int j = 0; j < 4; ++j) { const u32x4 a = *(LAS const u32x4*)(RAW + (s + j) * RAWS + ch0 * 2), c = *(LAS const u32x4*)(RAW + (s + j) * RAWS + ch0 * 2 + 16);
        const LAS float* w = WL + j * 128 + ch0;
        const f32x4 w0 = *(LAS const f32x4*)w, w1 = *(LAS const f32x4*)(w + 4), w2 = *(LAS const f32x4*)(w + 8), w3 = *(LAS const f32x4*)(w + 12);
        o[0] += bflo(a.x) * w0[0]; o[1] += bfhi(a.x) * w0[1]; o[2] += bflo(a.y) * w0[2]; o[3] += bfhi(a.y) * w0[3];
        o[4] += bflo(a.z) * w1[0]; o[5] += bfhi(a.z) * w1[1]; o[6] += bflo(a.w) * w1[2]; o[7] += bfhi(a.w) * w1[3];
        o[8] += bflo(c.x) * w2[0]; o[9] += bfhi(c.x) * w2[1]; o[10] += bflo(c.y) * w2[2]; o[11] += bfhi(c.y) * w2[3];
        o[12] += bflo(c.z) * w3[0]; o[13] += bfhi(c.z) * w3[1]; o[14] += bflo(c.w) * w3[2]; o[15] += bfhi(c.w) * w3[3]; }
#pragma unroll
    for (int i = 0; i < 16; ++i) o[i] = silu_f(o[i]) * scale;
}
constexpr int TRT = 4096 + 64, RCH = 1024 + 16;
constexpr int TRIMG = 4 * TRT, ROWIMG = 16 * RCH;
__device__ __forceinline__ unsigned tr_lane_off(int lane) { const int hi = lane >> 5; return ((lane >> 4) & 1) * 32 + (lane & 3) * 8 + (4 * hi + ((lane & 15) >> 2)) * 64; }

#if DBG_CHECK == 2
#define DBGF(code, val) do { const float _v = (val); if ((__float_as_uint(_v) & 0x7f800000u) == 0x7f800000u) atomicMin((unsigned*)(F.ws + WS_CTL) + CW_DBG, (unsigned)(code)); } while (0)
#else
#define DBGF(code, val) do {} while (0)
#endif
struct MaPF { u32x4 k0, k1, v0, v1, hk0, hk1; float wk, g0, g1; };
__device__ __forceinline__ void mlstm_a_load(Frame& F, int job, int tid, MaPF& pf) {
    const int lane = tid & 63, w = F.wave;
    const int bh = job >> 6, c = job & 63, b = bh >> 2, h = bh & 3, s0 = c * 64, s = tid >> 3, chg = tid & 7;
    const size_t ro = ((size_t)b * SEQ + s0 + s) * 512 + h * 128 + chg * 16;
    const bf16_t* kp = WSP(bf16_t, WS_MK) + ro; const bf16_t* vp = WSP(bf16_t, WS_MV) + ro;
    pf.k0 = *(const u32x4*)kp; pf.k1 = *(const u32x4*)(kp + 8); pf.v0 = *(const u32x4*)vp; pf.v1 = *(const u32x4*)(vp + 8);
    pf.hk0 = (u32x4){0u, 0u, 0u, 0u}; pf.hk1 = pf.hk0;
    if (s < 3 && s0 - 3 + s >= 0) { const bf16_t* hp = WSP(bf16_t, WS_MK) + ((size_t)b * SEQ + s0 - 3 + s) * 512 + h * 128 + chg * 16; pf.hk0 = *(const u32x4*)hp; pf.hk1 = *(const u32x4*)(hp + 8); }
    pf.wk = IN_F(10)[(tid >> 7) * 1024 + 512 + h * 128 + (tid & 127)];
    pf.g0 = 0.f; pf.g1 = 0.f;
    if (w == 0) { pf.g0 = WSP(float, WS_GF)[(size_t)bh * SEQ + s0 + lane]; pf.g1 = WSP(float, WS_GI)[(size_t)bh * SEQ + s0 + lane]; }
}
__device__ __forceinline__ void mlstm_a_phase(Frame& F) {
    int tid = F.tid; asm volatile("" : "+v"(tid));
    const int lane = tid & 63, w = F.wave, r32 = lane & 31, hi = lane >> 5;
    LAS unsigned char* kimg = F.lds; LAS unsigned char* vimg = F.lds + TRIMG; LAS float* wS = (LAS float*)(F.lds + 2 * TRIMG);
    LAS unsigned char* RAWK = F.lds + 2 * TRIMG + 1024; LAS float* WLK = (LAS float*)(RAWK + RAWIMG);
    LAS bf16_t* OST = (LAS bf16_t*)(F.lds + 2 * TRIMG + 1024 + RAWIMG + 2048) + w * 2048;
    MaPF pf; int job = F.vcu;
    if (job < 2048) mlstm_a_load(F, job, tid, pf);
    for (; job < 2048; job += F.G) {
        {
            const int s = tid >> 3, chg = tid & 7;
            *(LAS u32x4*)(RAWK + (s + 3) * RAWS + chg * 32) = pf.k0; *(LAS u32x4*)(RAWK + (s + 3) * RAWS + chg * 32 + 16) = pf.k1;
            if (s < 3) { *(LAS u32x4*)(RAWK + s * RAWS + chg * 32) = pf.hk0; *(LAS u32x4*)(RAWK + s * RAWS + chg * 32 + 16) = pf.hk1; }
            WLK[tid] = pf.wk;
            if (w == 0) {
                float bs = pf.g0;
#pragma unroll
                for (int o = 1; o < 64; o <<= 1) { const float x = __shfl_up(bs, o); if (lane >= o) bs += x; }
                const float g = __shfl(bs, 63);
                const float a = g - bs + pf.g1; const float ml = wave_max(a);
                wS[lane] = __expf(a - ml);
                if (lane == 0) { WSP(float, WS_GSUM)[job] = g; WSP(float, WS_MLOC)[job] = ml; }
            }
        }
        const u32x4 va = pf.v0, vd = pf.v1;
        __syncthreads();
        if (job + F.G < 2048) mlstm_a_load(F, job + F.G, tid, pf);
        {
            const int s = tid >> 3, chg = tid & 7, ch0 = chg * 16;
            float kf[16]; conv_lds16(RAWK, WLK, s, ch0, 0.08838834764831845f, kf);
            const unsigned off = (ch0 >> 5) * TRT + s * 64 + (ch0 & 31) * 2;
            u32x4 k0, k1; k0.x = cvtpk(kf[0], kf[1]); k0.y = cvtpk(kf[2], kf[3]); k0.z = cvtpk(kf[4], kf[5]); k0.w = cvtpk(kf[6], kf[7]);
            k1.x = cvtpk(kf[8], kf[9]); k1.y = cvtpk(kf[10], kf[11]); k1.z = cvtpk(kf[12], kf[13]); k1.w = cvtpk(kf[14], kf[15]);
            *(LAS u32x4*)(kimg + off) = k0; *(LAS u32x4*)(kimg + off + 16) = k1;
            const float ws = wS[s];
            u32x4 v0, v1;
            v0.x = cvtpk(bflo(va.x) * ws, bfhi(va.x) * ws); v0.y = cvtpk(bflo(va.y) * ws, bfhi(va.y) * ws); v0.z = cvtpk(bflo(va.z) * ws, bfhi(va.z) * ws); v0.w = cvtpk(bflo(va.w) * ws, bfhi(va.w) * ws);
            v1.x = cvtpk(bflo(vd.x) * ws, bfhi(vd.x) * ws); v1.y = cvtpk(bflo(vd.y) * ws, bfhi(vd.y) * ws); v1.z = cvtpk(bflo(vd.z) * ws, bfhi(vd.z) * ws); v1.w = cvtpk(bflo(vd.w) * ws, bfhi(vd.w) * ws);
            *(LAS u32x4*)(vimg + off) = v0; *(LAS u32x4*)(vimg + off + 16) = v1;
        }
        __syncthreads();
        {
            const int et = w >> 1, dt0 = 2 * (w & 1); const unsigned lo = tr_lane_off(lane);
            f32x16 acc0 = {0}, acc1 = {0};
#pragma unroll
            for (int ks = 0; ks < 4; ++ks) {
                const bf16x8 a = mk8(vtr(vimg + et * TRT + ks * 1024 + lo), vtr(vimg + et * TRT + ks * 1024 + lo + 512));
                const bf16x8 b0 = mk8(vtr(kimg + dt0 * TRT + ks * 1024 + lo), vtr(kimg + dt0 * TRT + ks * 1024 + lo + 512));
                const bf16x8 b1 = mk8(vtr(kimg + (dt0 + 1) * TRT + ks * 1024 + lo), vtr(kimg + (dt0 + 1) * TRT + ks * 1024 + lo + 512));
                acc0 = MFMA32(a, b0, acc0); acc1 = MFMA32(a, b1, acc1);
            }
#pragma unroll
            for (int r = 0; r < 16; ++r) { const int el = crow(r, hi); OST[el * 64 + r32] = f2bf(acc0[r]); OST[el * 64 + 32 + r32] = f2bf(acc1[r]); }
            asm volatile("s_waitcnt lgkmcnt(0)" ::: "memory");
            bf16_t* dst = WSP(bf16_t, WS_KVC) + (size_t)job * 16384 + (size_t)(et * 32) * 128 + dt0 * 32;
#pragma unroll
            for (int i = 0; i < 4; ++i) { const int rw = i * 8 + (lane >> 3), ch = lane & 7; *(u32x4*)(dst + (size_t)rw * 128 + ch * 8) = *(LAS const u32x4*)(OST + rw * 64 + ch * 8); }
        }
        if (tid < 128) {
            float sacc = 0.f; const int d = tid;
            for (int ss = 0; ss < 64; ++ss) sacc += wS[ss] * bf2f(*(LAS const bf16_t*)(kimg + (d >> 5) * TRT + ss * 64 + (d & 31) * 2));
            WSP(float, WS_NC)[(size_t)job * 128 + d] = sacc;
        }
        __syncthreads();
    }
}

__device__ __forceinline__ void mlstm_scan_job(Frame& F, int job) {
    int tid = F.tid; asm volatile("" : "+v"(tid));
    const int bh = job >> 3, sl = job & 7;
    LAS float* aold = (LAS float*)F.lds; LAS float* anew = aold + 64; LAS float* gS = aold + 128; LAS float* mS = aold + 192;
    if (tid < 64) { gS[tid] = WSP(float, WS_GSUM)[bh * 64 + tid]; mS[tid] = WSP(float, WS_MLOC)[bh * 64 + tid]; }
    __syncthreads();
    if (tid == 0) {
        float m = 0.f;
        for (int c = 0; c < 64; ++c) { const float g = gS[c], ml = mS[c];
            const float mn = fmaxf(g + m, ml); aold[c] = __expf(g + m - mn); anew[c] = __expf(ml - mn);
            gS[c] = m;
            m = mn; }
    }
    __syncthreads();
    if (sl == 0 && tid < 64) WSP(float, WS_MPREV)[bh * 64 + tid] = gS[tid];
    const size_t base = (size_t)bh * 64 * 16384 + (size_t)sl * 2048 + tid * 4;
    const bf16_t* kv = WSP(bf16_t, WS_KVC) + base; bf16_t* cp = WSP(bf16_t, WS_CPREV) + base;
    f32x4 C = {0.f, 0.f, 0.f, 0.f};
#pragma unroll 8
    for (int c = 0; c < 64; ++c) {
        const u32x2 k = *(const u32x2*)(kv + (size_t)c * 16384);
        u32x2 o; o.x = cvtpk(C[0], C[1]); o.y = cvtpk(C[2], C[3]); *(u32x2*)(cp + (size_t)c * 16384) = o;
        const float ao = aold[c], an = anew[c]; DBGF(22, ao); DBGF(23, an); DBGF(24, bflo(k.x)); DBGF(24, bfhi(k.x)); DBGF(24, bflo(k.y)); DBGF(24, bfhi(k.y)); DBGF(25, C[0]);
        C[0] = ao * C[0] + an * bflo(k.x); C[1] = ao * C[1] + an * bfhi(k.x); C[2] = ao * C[2] + an * bflo(k.y); C[3] = ao * C[3] + an * bfhi(k.y);
    }
    if (sl == 0 && tid < 128) {
        float n = 0.f;
        for (int c0 = 0; c0 < 64; c0 += 16) { float nc[16];
#pragma unroll
            for (int i = 0; i < 16; ++i) nc[i] = WSP(float, WS_NC)[(size_t)(bh * 64 + c0 + i) * 128 + tid];
#pragma unroll
            for (int i = 0; i < 16; ++i) { WSP(float, WS_NPREV)[(size_t)(bh * 64 + c0 + i) * 128 + tid] = n; n = aold[c0 + i] * n + anew[c0 + i] * nc[i]; } }
    }
    __syncthreads();
}

struct McPF { u32x4 q0, q1, k0, k1, v0, v1, hq0, hq1, hk0, hk1; float wq, wk, g0, g1, mprev; u32x2 mo[4]; };
__device__ __forceinline__ void mlstm_c_load(Frame& F, int job, int tid, McPF& pf) {
    const int lane = tid & 63, w = F.wave, r32 = lane & 31, hi = lane >> 5;
    const int bh = job >> 6, c = job & 63, b = bh >> 2, h = bh & 3, s0 = c * 64, s = tid >> 3, chg = tid & 7;
    const size_t ro = ((size_t)b * SEQ + s0 + s) * 512 + h * 128 + chg * 16;
    const bf16_t* qp = WSP(bf16_t, WS_MQ) + ro; const bf16_t* kp = WSP(bf16_t, WS_MK) + ro; const bf16_t* vp = WSP(bf16_t, WS_MV) + ro;
    pf.q0 = *(const u32x4*)qp; pf.q1 = *(const u32x4*)(qp + 8); pf.k0 = *(const u32x4*)kp; pf.k1 = *(const u32x4*)(kp + 8); pf.v0 = *(const u32x4*)vp; pf.v1 = *(const u32x4*)(vp + 8);
    pf.hq0 = (u32x4){0u, 0u, 0u, 0u}; pf.hq1 = pf.hq0; pf.hk0 = pf.hq0; pf.hk1 = pf.hq0;
    if (s < 3 && s0 - 3 + s >= 0) { const size_t ho = ((size_t)b * SEQ + s0 - 3 + s) * 512 + h * 128 + chg * 16;
        pf.hq0 = *(const u32x4*)(WSP(bf16_t, WS_MQ) + ho); pf.hq1 = *(const u32x4*)(WSP(bf16_t, WS_MQ) + ho + 8); pf.hk0 = *(const u32x4*)(WSP(bf16_t, WS_MK) + ho); pf.hk1 = *(const u32x4*)(WSP(bf16_t, WS_MK) + ho + 8); }
    pf.wq = IN_F(10)[(tid >> 7) * 1024 + h * 128 + (tid & 127)]; pf.wk = IN_F(10)[(tid >> 7) * 1024 + 512 + h * 128 + (tid & 127)];
    pf.g0 = 0.f; pf.g1 = 0.f;
    if (w == 0) { pf.g0 = WSP(float, WS_GF)[(size_t)bh * SEQ + s0 + lane]; pf.g1 = WSP(float, WS_GI)[(size_t)bh * SEQ + s0 + lane]; }
    if (w == 1) { pf.g0 = WSP(float, WS_NPREV)[(size_t)job * 128 + lane]; pf.g1 = WSP(float, WS_NPREV)[(size_t)job * 128 + 64 + lane]; }
    pf.mprev = WSP(float, WS_MPREV)[job];
    const int tw = w & 1, ew = w >> 1, t = 32 * tw + r32;
    const bf16_t* mo = WSP(bf16_t, WS_MO) + ((size_t)b * SEQ + s0 + t) * 512 + h * 128 + 32 * ew + 4 * hi;
#pragma unroll
    for (int q4 = 0; q4 < 4; ++q4) pf.mo[q4] = *(const u32x2*)(mo + 8 * q4);
}
__device__ __forceinline__ void mlstm_c_phase(Frame& F) {
    int tid = F.tid; asm volatile("" : "+v"(tid));
    const int lane = tid & 63, w = F.wave, r32 = lane & 31, hi = lane >> 5;
    LAS unsigned char* qimg = F.lds; LAS unsigned char* kimg = F.lds + ROWIMG; LAS unsigned char* vimg = F.lds + 2 * ROWIMG;
    LAS float* uS = (LAS float*)(F.lds + 2 * ROWIMG + TRIMG); LAS float* MS = uS + 64; LAS float* bS = uS + 128; LAS float* nS = uS + 192; LAS float* ssq = uS + 320;
    LAS unsigned char* RAWQ = F.lds + 2 * ROWIMG + TRIMG + 4096; LAS unsigned char* RAWK = RAWQ + RAWIMG; LAS float* WLQ = (LAS float*)(RAWK + RAWIMG); LAS float* WLK = WLQ + 512;
    LAS float* HNL = (LAS float*)(F.lds + MISC_OFF + 2048);
    HNL[tid] = IN_F(12)[tid];
    const int tw = w & 1, ew = w >> 1, t = 32 * tw + r32;
    McPF pf;
    int job = F.vcu;
    if (job < 2048) mlstm_c_load(F, job, tid, pf);
    for (; job < 2048; job += F.G) {
        const int bh = job >> 6, c = job & 63, b = bh >> 2, h = bh & 3, s0 = c * 64;
        const float mprev = pf.mprev; u32x2 moc[4];
#pragma unroll
        for (int q4 = 0; q4 < 4; ++q4) moc[q4] = pf.mo[q4];
        {
            const int s = tid >> 3, chg = tid & 7, ch0 = chg * 16;
            *(LAS u32x4*)(RAWQ + (s + 3) * RAWS + chg * 32) = pf.q0; *(LAS u32x4*)(RAWQ + (s + 3) * RAWS + chg * 32 + 16) = pf.q1;
            *(LAS u32x4*)(RAWK + (s + 3) * RAWS + chg * 32) = pf.k0; *(LAS u32x4*)(RAWK + (s + 3) * RAWS + chg * 32 + 16) = pf.k1;
            if (s < 3) { *(LAS u32x4*)(RAWQ + s * RAWS + chg * 32) = pf.hq0; *(LAS u32x4*)(RAWQ + s * RAWS + chg * 32 + 16) = pf.hq1;
                         *(LAS u32x4*)(RAWK + s * RAWS + chg * 32) = pf.hk0; *(LAS u32x4*)(RAWK + s * RAWS + chg * 32 + 16) = pf.hk1; }
            WLQ[tid] = pf.wq; WLK[tid] = pf.wk;
            const unsigned off = (ch0 >> 5) * TRT + s * 64 + (ch0 & 31) * 2;
            *(LAS u32x4*)(vimg + off) = pf.v0; *(LAS u32x4*)(vimg + off + 16) = pf.v1;
            if (w == 0) {
                float bs = pf.g0;
#pragma unroll
                for (int o = 1; o < 64; o <<= 1) { const float x = __shfl_up(bs, o); if (lane >= o) bs += x; }
                const float u = pf.g1 - bs; float cm = u;
#pragma unroll
                for (int o = 1; o < 64; o <<= 1) { const float x = __shfl_up(cm, o); if (lane >= o) cm = fmaxf(cm, x); }
                uS[lane] = u; MS[lane] = fmaxf(mprev, cm); bS[lane] = bs;
            }
            if (w == 1) { nS[lane] = pf.g0; nS[64 + lane] = pf.g1; }
        }
        __syncthreads();
        bf16x8 cf[8];
        { const bf16_t* cp = WSP(bf16_t, WS_CPREV) + (size_t)job * 16384 + (size_t)(32 * ew + r32) * 128 + 8 * hi;
#pragma unroll
          for (int ks = 0; ks < 8; ++ks) cf[ks] = *(const bf16x8*)(cp + 16 * ks); }
        if (job + F.G < 2048) mlstm_c_load(F, job + F.G, tid, pf);
        {
            const int s = tid >> 3, chg = tid & 7, ch0 = chg * 16;
            float qf[16]; conv_lds16(RAWQ, WLQ, s, ch0, 1.f, qf);
            u32x4 q0, q1; q0.x = cvtpk(qf[0], qf[1]); q0.y = cvtpk(qf[2], qf[3]); q0.z = cvtpk(qf[4], qf[5]); q0.w = cvtpk(qf[6], qf[7]);
            q1.x = cvtpk(qf[8], qf[9]); q1.y = cvtpk(qf[10], qf[11]); q1.z = cvtpk(qf[12], qf[13]); q1.w = cvtpk(qf[14], qf[15]);
            *(LAS u32x4*)(qimg + (2 * chg) * RCH + s * 16) = q0; *(LAS u32x4*)(qimg + (2 * chg + 1) * RCH + s * 16) = q1;
            float kf[16]; conv_lds16(RAWK, WLK, s, ch0, 0.08838834764831845f, kf);
            u32x4 k0, k1; k0.x = cvtpk(kf[0], kf[1]); k0.y = cvtpk(kf[2], kf[3]); k0.z = cvtpk(kf[4], kf[5]); k0.w = cvtpk(kf[6], kf[7]);
            k1.x = cvtpk(kf[8], kf[9]); k1.y = cvtpk(kf[10], kf[11]); k1.z = cvtpk(kf[12], kf[13]); k1.w = cvtpk(kf[14], kf[15]);
            *(LAS u32x4*)(kimg + (2 * chg) * RCH + s * 16) = k0; *(LAS u32x4*)(kimg + (2 * chg + 1) * RCH + s * 16) = k1;
        }
        __syncthreads();
        const float Mt = MS[t], bt = bS[t];
        const float dec = __expf(mprev - Mt), mt = bt + Mt;
        bf16x8 qf[8];
#pragma unroll
        for (int ks = 0; ks < 8; ++ks) qf[ks] = *(LAS const bf16x8*)(qimg + (2 * ks + hi) * RCH + t * 16);
        f32x16 p[2]; p[0] = (f32x16){0}; p[1] = (f32x16){0};
#pragma unroll
        for (int st = 0; st < 2; ++st) {
            if (st <= tw) {
#pragma unroll
                for (int ks = 0; ks < 8; ++ks) { const bf16x8 kf = *(LAS const bf16x8*)(kimg + (2 * ks + hi) * RCH + (32 * st + r32) * 16); p[st] = MFMA32(kf, qf[ks], p[st]); }
            }
        }
        float rs = 0.f;
#pragma unroll
        for (int st = 0; st < 2; ++st)
#pragma unroll
            for (int r = 0; r < 16; ++r) { const int s = 32 * st + crow(r, hi);
                const float wv = (s <= t) ? __expf(uS[s] - Mt) * p[st][r] : 0.f; p[st][r] = wv; rs += wv; }
        rs += __shfl_xor(rs, 32);
        float qn = 0.f;
#pragma unroll
        for (int ks = 0; ks < 8; ++ks)
#pragma unroll
            for (int j = 0; j < 8; ++j) qn += bf2f((bf16_t)qf[ks][j]) * nS[16 * ks + 8 * hi + j];
        qn += __shfl_xor(qn, 32);
        const float den = rs + dec * qn;
        const float hden = fmaxf(fabsf(den), __expf(-mt));
        f32x16 ai = {0}, ae = {0};
        const unsigned lo = tr_lane_off(lane);
#pragma unroll
        for (int st = 0; st < 2; ++st) {
            if (st <= tw) {
#pragma unroll
                for (int s2 = 0; s2 < 2; ++s2) { const int ks = 2 * st + s2;
                    const bf16x8 vf = mk8(vtr(vimg + ew * TRT + ks * 1024 + lo), vtr(vimg + ew * TRT + ks * 1024 + lo + 512));
                    u32x4 pw; pw.x = cvtpk(p[st][8 * s2 + 0], p[st][8 * s2 + 1]); pw.y = cvtpk(p[st][8 * s2 + 2], p[st][8 * s2 + 3]); pw.z = cvtpk(p[st][8 * s2 + 4], p[st][8 * s2 + 5]); pw.w = cvtpk(p[st][8 * s2 + 6], p[st][8 * s2 + 7]);
                    ai = MFMA32(vf, __builtin_bit_cast(bf16x8, pw), ai); }
            }
        }
#pragma unroll
        for (int ks = 0; ks < 8; ++ks) ae = MFMA32(cf[ks], qf[ks], ae);
        float hv[16]; float ss = 0.f; const float rden = 1.f / hden;
#pragma unroll
        for (int r = 0; r < 16; ++r) { hv[r] = (ai[r] + dec * ae[r]) * rden; ss += hv[r] * hv[r]; }
        ss += __shfl_xor(ss, 32);
        if (hi == 0) ssq[ew * 64 + t] = ss;
        __syncthreads();
        const float tot = ssq[t] + ssq[64 + t] + ssq[128 + t] + ssq[192 + t];
        const float rn = rsqrtf(tot * (1.f / 128.f) + RMS_EPS);
        LAS const float* hn = HNL + h * 128 + 32 * ew;
        bf16_t* yo = WSP(bf16_t, WS_YCAT) + ((size_t)b * SEQ + s0 + t) * 1024 + h * 128 + 32 * ew;
#pragma unroll
        for (int p2 = 0; p2 < 2; ++p2) { u32x2 ov[2];
#pragma unroll
            for (int e = 0; e < 2; ++e) { const int q4 = 2 * p2 + e; const int e0 = 8 * q4 + 4 * hi;
                const u32x2 om = moc[q4]; const f32x4 wn = *(LAS const f32x4*)(hn + e0);
                const float y0 = hv[4 * q4 + 0] * rn * wn[0] * sigmoid_f(bflo(om.x)), y1 = hv[4 * q4 + 1] * rn * wn[1] * sigmoid_f(bfhi(om.x));
                const float y2 = hv[4 * q4 + 2] * rn * wn[2] * sigmoid_f(bflo(om.y)), y3 = hv[4 * q4 + 3] * rn * wn[3] * sigmoid_f(bfhi(om.y));
                ov[e].x = cvtpk(y0, y1); ov[e].y = cvtpk(y2, y3); }
            *(u32x4*)(yo + 16 * p2 + 8 * hi) = widen_pair(ov[0], ov[1]); }
        __syncthreads();
    }
}

__device__ __forceinline__ void compress_job(Frame& F, int job) {
    int lane = F.lane; asm volatile("" : "+v"(lane));
    const int w = F.wave, r32 = lane & 31, hi = lane >> 5;
    const int kv = job >> 7, bg = (job >> 3) & 15, i0 = (job & 7) * 32;
    const bf16_t* X = WSP(bf16_t, kv ? WS_VC : WS_KC) + (size_t)bg * SEQ * 64;
    const bf16_t* W1 = WSP(bf16_t, kv ? WS_CW1V : WS_CW1K); const bf16_t* W2 = WSP(bf16_t, kv ? WS_CW2V : WS_CW2K);
    const float* c1 = WSP(float, WS_C1B) + kv * 128;
    bf16_t* O = WSP(bf16_t, kv ? WS_VCMP : WS_KCMP) + (size_t)bg * 256 * 64;
    LAS unsigned char* himg = F.lds;
    LAS float* part = (LAS float*)(F.lds + ROWIMG);
    const int nt = w & 3, kh = w >> 2;
    f32x16 acc = {0};
    {
        int i = i0 + r32; if (i > 254) i = 254;
        const bf16_t* ap = X + (size_t)i * 1024 + kh * 1024 + 8 * hi; const bf16_t* bp = W1 + (size_t)(32 * nt + r32) * 2048 + kh * 1024 + 8 * hi;
#pragma unroll 16
        for (int ks = 0; ks < 64; ++ks) { const bf16x8 a = *(const bf16x8*)(ap + 16 * ks), bb = *(const bf16x8*)(bp + 16 * ks); acc = MFMA32(a, bb, acc); }
    }
    if (kh == 1) {
#pragma unroll
        for (int r = 0; r < 16; ++r) part[(nt * 16 + r) * 64 + lane] = acc[r];
    }
    __syncthreads();
    if (kh == 0) {
        const int n = 32 * nt + r32; const float cb = c1[n];
#pragma unroll
        for (int r = 0; r < 16; ++r) { const int rowl = crow(r, hi); const float v = acc[r] + part[(nt * 16 + r) * 64 + lane] + cb;
            *(LAS bf16_t*)(himg + (n >> 3) * RCH + rowl * 16 + (n & 7) * 2) = f2bf(silu_f(v)); }
    }
    __syncthreads();
    if (w < 2) {
        f32x16 a2 = {0};
#pragma unroll
        for (int ks = 0; ks < 8; ++ks) { const bf16x8 a = *(LAS const bf16x8*)(himg + (2 * ks + hi) * RCH + r32 * 16);
            const bf16x8 bb = *(const bf16x8*)(W2 + (size_t)(32 * w + r32) * 128 + 16 * ks + 8 * hi); a2 = MFMA32(a, bb, a2); }
#pragma unroll
        for (int r = 0; r < 16; ++r) { const int i = i0 + crow(r, hi); if (i < 255) O[(size_t)i * 64 + 32 * w + r32] = f2bf(a2[r]); }
    }
    __syncthreads();
}

constexpr int NSA_KCH = 1024 + 16, NSA_VDH = 4096 + 64, NSA_KIMG = 8 * NSA_KCH, NSA_VIMG = 2 * NSA_VDH, NSA_BUF = NSA_KIMG + NSA_VIMG;
constexpr int NSA_IMP = 2 * NSA_BUF, NSA_IST = 65, NSA_TOT = NSA_IMP + 256 * NSA_IST * 4,
              NSA_SELB = MISC_OFF + 1024, NSA_UNI = NSA_SELB + 512;
constexpr int NSA_FAC = NSA_TOT + 64 * NSA_IST * 4;
constexpr int NSA_STASH = 96 * 1024;
static_assert(4 * NSA_BUF <= NSA_STASH && NSA_FAC + 4096 <= MISC_OFF && NSA_STASH + 8 * 4096 <= MISC_OFF, "NSA LDS map");

__device__ __forceinline__ void nsa_qk(LAS const unsigned char* kimg, const bf16x8 (&qr)[4], unsigned kfo, f32x16& p0, f32x16& p1) {
    bf16x8 kf[8];
#pragma unroll
    for (int d0 = 0; d0 < 4; ++d0) { kf[2 * d0] = *(LAS const bf16x8*)(kimg + kfo + d0 * (2 * NSA_KCH)); kf[2 * d0 + 1] = *(LAS const bf16x8*)(kimg + kfo + d0 * (2 * NSA_KCH) + 512); }
    __builtin_amdgcn_sched_barrier(0);
    p0 = (f32x16){0}; p1 = (f32x16){0};
#pragma unroll
    for (int d0 = 0; d0 < 4; ++d0) { p0 = MFMA32(kf[2 * d0], qr[d0], p0); p1 = MFMA32(kf[2 * d0 + 1], qr[d0], p1); }
}
constexpr float NSA_THR = 8.f;
template <int KIND>
__device__ __forceinline__ void nsa_tile(LAS const unsigned char* kimg, LAS const unsigned char* vimg, const bf16x8 (&qr)[4], int kbase, int t, bool edge, bool rowvalid,
                                         float& m, float& l, f32x16& o0, f32x16& o1, unsigned kfo, unsigned vfo, int hi) {
    f32x16 p0, p1; nsa_qk(kimg, qr, kfo, p0, p1);
    if (edge) {
#pragma unroll
        for (int r = 0; r < 16; ++r) { const int k0 = kbase + crow(r, hi), k1 = k0 + 32; bool v0, v1;
            if (KIND == 1) { v0 = k0 <= t; v1 = k1 <= t; } else { v0 = k0 <= t && k0 >= t - 511; v1 = k1 <= t && k1 >= t - 511; }
            p0[r] = v0 ? p0[r] : -INFINITY; p1[r] = v1 ? p1[r] : -INFINITY; }
    }
    float mx = fmaxf(p0[0], p1[0]);
#pragma unroll
    for (int r = 1; r < 16; ++r) mx = fmaxf(mx, fmaxf(p0[r], p1[r]));
    mx = rowvalid ? mx : -INFINITY;
    mx = fmaxf(mx, __shfl_xor(mx, 32));
    if (__any(mx - m > NSA_THR)) {
        const float mn = fmaxf(m, mx); const float alpha = ex2(m - mn); m = mn; l *= alpha;
#pragma unroll
        for (int r = 0; r < 16; ++r) { o0[r] *= alpha; o1[r] *= alpha; }
    }
    const float me = rowvalid ? m : INFINITY;
    float rs = 0.f;
#pragma unroll
    for (int r = 0; r < 16; ++r) { p0[r] = ex2(p0[r] - me); p1[r] = ex2(p1[r] - me); rs += p0[r] + p1[r]; }
    l += rs;
    u32x4 pw[4];
#pragma unroll
    for (int s = 0; s < 2; ++s) {
        pw[s].x = cvtpk(p0[8 * s + 0], p0[8 * s + 1]); pw[s].y = cvtpk(p0[8 * s + 2], p0[8 * s + 3]); pw[s].z = cvtpk(p0[8 * s + 4], p0[8 * s + 5]); pw[s].w = cvtpk(p0[8 * s + 6], p0[8 * s + 7]);
        pw[2 + s].x = cvtpk(p1[8 * s + 0], p1[8 * s + 1]); pw[2 + s].y = cvtpk(p1[8 * s + 2], p1[8 * s + 3]); pw[2 + s].z = cvtpk(p1[8 * s + 4], p1[8 * s + 5]); pw[2 + s].w = cvtpk(p1[8 * s + 6], p1[8 * s + 7]);
    }
    bf16x8 vf[8];
#pragma unroll
    for (int ks = 0; ks < 4; ++ks) { vf[2 * ks] = mk8(vtr(vimg + vfo + ks * 1024), vtr(vimg + vfo + ks * 1024 + 512)); vf[2 * ks + 1] = mk8(vtr(vimg + vfo + NSA_VDH + ks * 1024), vtr(vimg + vfo + NSA_VDH + ks * 1024 + 512)); }
    __builtin_amdgcn_sched_barrier(0);
#pragma unroll
    for (int ks = 0; ks < 4; ++ks) { o0 = MFMA32(vf[2 * ks], __builtin_bit_cast(bf16x8, pw[ks]), o0); o1 = MFMA32(vf[2 * ks + 1], __builtin_bit_cast(bf16x8, pw[ks]), o1); }
}

template <int KIND>
__device__ __forceinline__ void nsa_tile2(LAS const unsigned char* kA, LAS const unsigned char* vA, LAS const unsigned char* kB, LAS const unsigned char* vB, bool hasB,
                                          const bf16x8 (&qr)[4], int kbA, int kbB, int t, bool edgeA, bool edgeB, bool rvA, bool rvB,
                                          float& m, float& l, f32x16& o0, f32x16& o1, unsigned kfo, unsigned vfo, int hi) {
    f32x16 a0, a1, b0, b1;
    nsa_qk(kA, qr, kfo, a0, a1);
    __builtin_amdgcn_sched_barrier(0);
    if (hasB) nsa_qk(kB, qr, kfo, b0, b1);
    else {
#pragma unroll
        for (int r = 0; r < 16; ++r) { b0[r] = -INFINITY; b1[r] = -INFINITY; } }
    if (edgeA) {
#pragma unroll
        for (int r = 0; r < 16; ++r) { const int k0 = kbA + crow(r, hi), k1 = k0 + 32; bool v0, v1;
            if (KIND == 1) { v0 = k0 <= t; v1 = k1 <= t; } else { v0 = k0 <= t && k0 >= t - 511; v1 = k1 <= t && k1 >= t - 511; }
            a0[r] = v0 ? a0[r] : -INFINITY; a1[r] = v1 ? a1[r] : -INFINITY; } }
    if (edgeB) {
#pragma unroll
        for (int r = 0; r < 16; ++r) { const int k0 = kbB + crow(r, hi), k1 = k0 + 32; bool v0, v1;
            if (KIND == 1) { v0 = k0 <= t; v1 = k1 <= t; } else { v0 = k0 <= t && k0 >= t - 511; v1 = k1 <= t && k1 >= t - 511; }
            b0[r] = v0 ? b0[r] : -INFINITY; b1[r] = v1 ? b1[r] : -INFINITY; } }
    __builtin_amdgcn_sched_barrier(0);
    const bool fresh = m < -1e29f; const float mb = fresh ? 0.f : m;
    const float meA = rvA ? mb : INFINITY, meB = rvB ? mb : INFINITY;
#pragma unroll
    for (int r = 0; r < 16; ++r) { a0[r] -= meA; a1[r] -= meA; b0[r] -= meB; b1[r] -= meB; }
    float mx = fmaxf(fmaxf(a0[0], a1[0]), fmaxf(b0[0], b1[0]));
#pragma unroll
    for (int r = 1; r < 16; ++r) mx = fmaxf(mx, fmaxf(fmaxf(a0[r], a1[r]), fmaxf(b0[r], b1[r])));
    mx = fmaxf(mx, __shfl_xor(mx, 32));
    const bool has = mx > -INFINITY;
    const float delta = fresh ? (has ? mx : 0.f) : (mx > NSA_THR ? mx : 0.f);
    if (__any(delta != 0.f)) {
        const float alpha = fresh ? 1.f : ex2(-delta); l *= alpha;
#pragma unroll
        for (int r = 0; r < 16; ++r) { o0[r] *= alpha; o1[r] *= alpha; a0[r] -= delta; a1[r] -= delta; b0[r] -= delta; b1[r] -= delta; }
    }
    m = fresh ? (has ? mx : m) : m + delta;
    float rs = 0.f;
#pragma unroll
    for (int r = 0; r < 16; ++r) { a0[r] = ex2(a0[r]); a1[r] = ex2(a1[r]); b0[r] = ex2(b0[r]); b1[r] = ex2(b1[r]); rs += (a0[r] + a1[r]) + (b0[r] + b1[r]); }
    l += rs;
    __builtin_amdgcn_sched_barrier(0);
    {
        u32x4 pw[4];
#pragma unroll
        for (int s = 0; s < 2; ++s) {
            pw[s].x = cvtpk(a0[8 * s + 0], a0[8 * s + 1]); pw[s].y = cvtpk(a0[8 * s + 2], a0[8 * s + 3]); pw[s].z = cvtpk(a0[8 * s + 4], a0[8 * s + 5]); pw[s].w = cvtpk(a0[8 * s + 6], a0[8 * s + 7]);
            pw[2 + s].x = cvtpk(a1[8 * s + 0], a1[8 * s + 1]); pw[2 + s].y = cvtpk(a1[8 * s + 2], a1[8 * s + 3]); pw[2 + s].z = cvtpk(a1[8 * s + 4], a1[8 * s + 5]); pw[2 + s].w = cvtpk(a1[8 * s + 6], a1[8 * s + 7]); }
        bf16x8 vf[8];
#pragma unroll
        for (int ks = 0; ks < 4; ++ks) { vf[2 * ks] = mk8(vtr(vA + vfo + ks * 1024), vtr(vA + vfo + ks * 1024 + 512)); vf[2 * ks + 1] = mk8(vtr(vA + vfo + NSA_VDH + ks * 1024), vtr(vA + vfo + NSA_VDH + ks * 1024 + 512)); }
        __builtin_amdgcn_sched_barrier(0);
#pragma unroll
        for (int ks = 0; ks < 4; ++ks) { o0 = MFMA32(vf[2 * ks], __builtin_bit_cast(bf16x8, pw[ks]), o0); o1 = MFMA32(vf[2 * ks + 1], __builtin_bit_cast(bf16x8, pw[ks]), o1); }
    }
    __builtin_amdgcn_sched_barrier(0);
    if (hasB) {
        u32x4 pw[4];
#pragma unroll
        for (int s = 0; s < 2; ++s) {
            pw[s].x = cvtpk(b0[8 * s + 0], b0[8 * s + 1]); pw[s].y = cvtpk(b0[8 * s + 2], b0[8 * s + 3]); pw[s].z = cvtpk(b0[8 * s + 4], b0[8 * s + 5]); pw[s].w = cvtpk(b0[8 * s + 6], b0[8 * s + 7]);
            pw[2 + s].x = cvtpk(b1[8 * s + 0], b1[8 * s + 1]); pw[2 + s].y = cvtpk(b1[8 * s + 2], b1[8 * s + 3]); pw[2 + s].z = cvtpk(b1[8 * s + 4], b1[8 * s + 5]); pw[2 + s].w = cvtpk(b1[8 * s + 6], b1[8 * s + 7]); }
        bf16x8 vf[8];
#pragma unroll
        for (int ks = 0; ks < 4; ++ks) { vf[2 * ks] = mk8(vtr(vB + vfo + ks * 1024), vtr(vB + vfo + ks * 1024 + 512)); vf[2 * ks + 1] = mk8(vtr(vB + vfo + NSA_VDH + ks * 1024), vtr(vB + vfo + NSA_VDH + ks * 1024 + 512)); }
        __builtin_amdgcn_sched_barrier(0);
#pragma unroll
        for (int ks = 0; ks < 4; ++ks) { o0 = MFMA32(vf[2 * ks], __builtin_bit_cast(bf16x8, pw[ks]), o0); o1 = MFMA32(vf[2 * ks + 1], __builtin_bit_cast(bf16x8, pw[ks]), o1); }
    }
}

#define NPIN(x) asm volatile("" : "+v"(x))
__device__ __forceinline__ void glds16(const void* g, unsigned lds_base) {
    unsigned sv; asm volatile("s_mov_b32 %0, m0\n\ts_mov_b32 m0, %2\n\ts_nop 0\n\tglobal_load_lds_dwordx4 %1, off\n\ts_mov_b32 m0, %0" : "=&s"(sv) : "v"(g), "s"(lds_base) : "memory"); }
#define NSB() __builtin_amdgcn_sched_barrier(0)
#define NMX3(a, b, c) fmaxf(fmaxf((a), (b)), (c))
__device__ __forceinline__ float nsa_rowmax(const f32x16& p0, const f32x16& p1) {
    float a = NMX3(p0[0], p0[1], p1[0]), b = NMX3(p0[2], p0[3], p1[1]); a = NMX3(a, p1[2], p1[3]);
#pragma unroll
    for (int r = 4; r < 16; r += 4) { a = NMX3(a, p0[r], p0[r + 1]); b = NMX3(b, p0[r + 2], p0[r + 3]); a = NMX3(a, p1[r], p1[r + 1]); b = NMX3(b, p1[r + 2], p1[r + 3]); }
    const float m = fmaxf(a, b); const auto rr = __builtin_amdgcn_permlane32_swap(__float_as_uint(m), __float_as_uint(m), false, false);
    return fmaxf(__uint_as_float(rr[0]), __uint_as_float(rr[1])); }
template <int KIND>
__device__ __forceinline__ void nsa_mask(f32x16& p0, f32x16& p1, int kbase, int t, int hi) {
#pragma unroll
    for (int r = 0; r < 16; ++r) { const int k0 = kbase + crow(r, hi), k1 = k0 + 32; bool v0, v1;
        if (KIND == 1) { v0 = k0 <= t; v1 = k1 <= t; } else { v0 = k0 <= t && k0 >= t - 511; v1 = k1 <= t && k1 >= t - 511; }
        p0[r] = v0 ? p0[r] : -INFINITY; p1[r] = v1 ? p1[r] : -INFINITY; } }
template <int KIND>
__device__ __forceinline__ void nsa_pipe(LAS unsigned char* L, const bf16_t* Kp, const bf16_t* Vp, unsigned mlo, unsigned mhi, unsigned sel0, unsigned sel1,
                                         const bf16x8 (&qr)[4], int t, int lane, int w, int hi, unsigned kfo, unsigned vfo,
                                         float& lsum, f32x16& o0, f32x16& o1,
                                         int& sbase, bool pre, const bf16_t* Kn, const bf16_t* Vn, unsigned nlo, unsigned nhi) {
    unsigned ulo = mlo, uhi = mhi;
    const bf16_t* ksrc = Kp + lane * 64 + w * 8; const bf16_t* vsrc = Vp + (16 * (w & 3) + (lane >> 2)) * 64 + (w >> 2) * 32 + (lane & 3) * 8;
    const unsigned kdst = (unsigned)(uintptr_t)L + w * NSA_KCH, vdst = (unsigned)(uintptr_t)L + NSA_KIMG + (w >> 2) * NSA_VDH + (w & 3) * 1024;
#define NP_DMAS(KS, VS, j, sl) do { const int ps_ = ((sl) + sbase) & 3; glds16((KS) + (size_t)(j) * 4096, (unsigned)__builtin_amdgcn_readfirstlane(kdst + ps_ * NSA_BUF)); glds16((VS) + (size_t)(j) * 4096, (unsigned)__builtin_amdgcn_readfirstlane(vdst + ps_ * NSA_BUF)); } while (0)
#define NP_DMA(j, sl) NP_DMAS(ksrc, vsrc, j, sl)
#define NP_DMAWAIT() asm volatile("s_waitcnt vmcnt(0)" ::: "memory")
    const int n = __builtin_popcount(ulo) + __builtin_popcount(uhi);
#define NP_NEXT(jv) do { jv = -1; if (ulo | uhi) { jv = ulo ? __builtin_ctz(ulo) : 32 + __builtin_ctz(uhi); if (ulo) ulo &= ulo - 1; else uhi &= uhi - 1; } } while (0)
#define NP_SELBIT(j) ((((j) < 32 ? (sel0 >> ((j) & 31)) : (sel1 >> (((j) - 32) & 31))) & 1u) != 0u)
#define NP_KIMG(sl) (L + (((sl) + sbase) & 3) * NSA_BUF)
#define NP_VIMG(sl) (L + (((sl) + sbase) & 3) * NSA_BUF + NSA_KIMG)
    int jc, jn1, jn2;
    NP_NEXT(jc); NP_NEXT(jn1); NP_NEXT(jn2);
    if (!pre) { NP_DMA(jc, 0); if (jn1 >= 0) NP_DMA(jn1, 1); if (jn2 >= 0) NP_DMA(jn2, 2); }
    NP_DMAWAIT();
    __syncthreads();
    float m = -1e30f, cin = 0.f, l = 0.f, fsc = 1.f; bool resc = false;
    o0 = (f32x16){0}; o1 = (f32x16){0};
    f32x16 pA0, pA1, pB0, pB1, ci16; bf16x8 kf[8]; s16x4 vlo[8], vhi[8]; u32x4 pw0, pw1, pw2, pw3;
#define NP_KLOAD2(sl, d0) do { kf[2 * (d0)] = *(LAS const bf16x8*)(NP_KIMG(sl) + kfo + (d0) * (2 * NSA_KCH)); kf[2 * (d0) + 1] = *(LAS const bf16x8*)(NP_KIMG(sl) + kfo + (d0) * (2 * NSA_KCH) + 512); } while (0)
#define NP_SPLAT(v) do { _Pragma("unroll") for (int r = 0; r < 16; ++r) ci16[r] = (v); } while (0)
#define NP_CINIT(jt) do { if (KIND == 1) { const float c_ = NP_SELBIT(jt) ? cin : -INFINITY; NP_SPLAT(c_); } } while (0)
#define NP_DECIDE(C0, C1) do { const float rm_ = nsa_rowmax(C0, C1); const bool fresh_ = m < -1e29f; \
        const bool grow_ = fresh_ ? (rm_ > -INFINITY) : (rm_ > NSA_THR); resc = false; \
        if (__any(grow_)) { const float dl_ = grow_ ? rm_ : 0.f; fsc = (grow_ && !fresh_) ? ex2(-rm_) : 1.f; m = grow_ ? (fresh_ ? rm_ : m + rm_) : m; cin = grow_ ? -m : cin; l *= fsc; resc = true; \
            _Pragma("unroll") for (int r = 0; r < 16; ++r) { C0[r] -= dl_; C1[r] -= dl_; } \
            if (KIND == 2) NP_SPLAT(cin); } } while (0)
    { _Pragma("unroll") for (int d0 = 0; d0 < 4; ++d0) NP_KLOAD2(0, d0);
      if (KIND == 2) NP_SPLAT(0.f); else NP_CINIT(jc);
      NSB();
      pA0 = MFMA32(kf[0], qr[0], ci16); pA1 = MFMA32(kf[1], qr[0], ci16);
      _Pragma("unroll") for (int d0 = 1; d0 < 4; ++d0) { pA0 = MFMA32(kf[2 * d0], qr[d0], pA0); pA1 = MFMA32(kf[2 * d0 + 1], qr[d0], pA1); }
      nsa_mask<KIND>(pA0, pA1, 64 * jc, t, hi);
      NP_DECIDE(pA0, pA1);
      _Pragma("unroll") for (int r = 0; r < 16; ++r) { pA0[r] = ex2(pA0[r]); pA1[r] = ex2(pA1[r]); }
      if (jn1 >= 0) { _Pragma("unroll") for (int d0 = 0; d0 < 4; ++d0) NP_KLOAD2(1, d0); }
      jc = jn1; jn1 = jn2; NP_NEXT(jn2); }
    int s = 1;
#define NP_PKW(P, i) cvtpk(P[i], P[(i) + 1])
#define NP_VFR(i) mk8(vlo[i], vhi[i])
#define NP_VRD(i) do { LAS const unsigned char* a_ = vp_ + ((i) >> 1) * 1024 + ((i) & 1) * NSA_VDH; vlo[i] = vtr(a_); vhi[i] = vtr(a_ + 512); } while (0)
#define NP_GAPA(MF, a0, a1, a2, a3, W0, W1, PW) do { MF; sacc += a0; sacc += a1; sacc += a2; sacc += a3; W0; W1; NPIN(PW); NPIN(sacc); NSB(); } while (0)
#define NP_GAPB(MF, X, i) do { MF; X[i] = ex2(X[i]); X[(i) + 1] = ex2(X[(i) + 1]); X[(i) + 2] = ex2(X[(i) + 2]); X[(i) + 3] = ex2(X[(i) + 3]); NPIN(X); NSB(); } while (0)
#define NP_KRD(GL, d0) do { if (GL) { NP_KLOAD2(sn_, d0); NSB(); } } while (0)
#define NP_STEP(C0, C1, P0, P1, LAST) do { NSB(); \
    const int sp_ = (s - 1) & 3, sn_ = (s + 1) & 3, sw_ = (s + 2) & 3; \
    if (!(LAST) && jn2 >= 0) NP_DMA(jn2, sw_);     \
    LAS const unsigned char* vp_ = NP_VIMG(sp_) + vfo; \
    NP_CINIT(jc); \
    float sacc = P0[0] + P0[1]; NSB(); \
    NP_GAPA(C0 = MFMA32(kf[0], qr[0], ci16), P0[2], P0[3], P0[4], P0[5],     pw0[0] = NP_PKW(P0, 0),  pw0[1] = NP_PKW(P0, 2),  pw0); \
    NP_GAPA(C1 = MFMA32(kf[1], qr[0], ci16), P0[6], P0[7], P0[8], P0[9],     pw0[2] = NP_PKW(P0, 4),  pw0[3] = NP_PKW(P0, 6),  pw0); \
    NP_GAPA(C0 = MFMA32(kf[2], qr[1], C0),            P0[10], P0[11], P0[12], P0[13], pw1[0] = NP_PKW(P0, 8),  pw1[1] = NP_PKW(P0, 10), pw1); \
    NP_GAPA(C1 = MFMA32(kf[3], qr[1], C1),            P0[14], P0[15], P1[0], P1[1],   pw1[2] = NP_PKW(P0, 12), pw1[3] = NP_PKW(P0, 14), pw1); \
    NP_GAPA(C0 = MFMA32(kf[4], qr[2], C0),            P1[2], P1[3], P1[4], P1[5],     pw2[0] = NP_PKW(P1, 0),  pw2[1] = NP_PKW(P1, 2),  pw2); \
    NP_GAPA(C1 = MFMA32(kf[5], qr[2], C1),            P1[6], P1[7], P1[8], P1[9],     pw2[2] = NP_PKW(P1, 4),  pw2[3] = NP_PKW(P1, 6),  pw2); \
    NP_GAPA(C0 = MFMA32(kf[6], qr[3], C0),            P1[10], P1[11], P1[12], P1[13], pw3[0] = NP_PKW(P1, 8),  pw3[1] = NP_PKW(P1, 10), pw3); \
    NP_GAPA(C1 = MFMA32(kf[7], qr[3], C1),            P1[14], P1[15], 0.f, 0.f,       pw3[2] = NP_PKW(P1, 12), pw3[3] = NP_PKW(P1, 14), pw3); \
    l += sacc; \
    NP_VRD(0); NP_VRD(1); NP_VRD(2); NP_VRD(3); NSB();     \
    if (LAST) nsa_mask<KIND>(C0, C1, 64 * jc, t, hi); \
    NP_DECIDE(C0, C1); NSB(); \
    NP_VRD(4); NSB(); NP_GAPB(o0 = MFMA32(NP_VFR(0), __builtin_bit_cast(bf16x8, pw0), o0), C0, 0); \
    NP_VRD(5); NSB(); NP_GAPB(o1 = MFMA32(NP_VFR(1), __builtin_bit_cast(bf16x8, pw0), o1), C0, 4); \
    NP_VRD(6); NSB(); NP_KRD(!(LAST), 0); NP_GAPB(o0 = MFMA32(NP_VFR(2), __builtin_bit_cast(bf16x8, pw1), o0), C0, 8); \
    NP_VRD(7); NSB(); NP_KRD(!(LAST), 1); NP_GAPB(o1 = MFMA32(NP_VFR(3), __builtin_bit_cast(bf16x8, pw1), o1), C0, 12); \
    NP_KRD(!(LAST), 2); NP_GAPB(o0 = MFMA32(NP_VFR(4), __builtin_bit_cast(bf16x8, pw2), o0), C1, 0); \
    NP_KRD(!(LAST), 3); NP_GAPB(o1 = MFMA32(NP_VFR(5), __builtin_bit_cast(bf16x8, pw2), o1), C1, 4); \
    NP_GAPB(o0 = MFMA32(NP_VFR(6), __builtin_bit_cast(bf16x8, pw3), o0), C1, 8);  NP_GAPB(o1 = MFMA32(NP_VFR(7), __builtin_bit_cast(bf16x8, pw3), o1), C1, 12); \
    NP_DMAWAIT(); \
    __syncthreads(); \
    if (resc) { _Pragma("unroll") for (int r = 0; r < 16; ++r) { o0[r] *= fsc; o1[r] *= fsc; } } \
    jc = jn1; jn1 = jn2; NP_NEXT(jn2); ++s; } while (0)
    int rem = n - 1;
    if (n & 1) { pB0 = pA0; pB1 = pA1; if (rem > 0) { NP_STEP(pA0, pA1, pB0, pB1, false); --rem; } }
    while (rem >= 3) { NP_STEP(pB0, pB1, pA0, pA1, false); NP_STEP(pA0, pA1, pB0, pB1, false); rem -= 2; }
    if (rem == 1) { NP_STEP(pB0, pB1, pA0, pA1, true); }
    if (Kn) {
        unsigned vlo_ = nlo, vhi_ = nhi; const bf16_t* ks2 = Kn + lane * 64 + w * 8; const bf16_t* vs2 = Vn + (16 * (w & 3) + (lane >> 2)) * 64 + (w >> 2) * 32 + (lane & 3) * 8;
        _Pragma("unroll") for (int i = 0; i < 3; ++i) { if (vlo_ | vhi_) { const int j2 = vlo_ ? __builtin_ctz(vlo_) : 32 + __builtin_ctz(vhi_); if (vlo_) vlo_ &= vlo_ - 1; else vhi_ &= vhi_ - 1;
            NP_DMAS(ks2, vs2, j2, n + i); } } }
    { float sacc = pB0[0] + pB0[1];
      _Pragma("unroll") for (int r = 2; r < 16; ++r) sacc += pB0[r];
      _Pragma("unroll") for (int r = 0; r < 16; ++r) sacc += pB1[r];
      l += sacc;
      pw0 = (u32x4){NP_PKW(pB0, 0), NP_PKW(pB0, 2), NP_PKW(pB0, 4), NP_PKW(pB0, 6)}; pw1 = (u32x4){NP_PKW(pB0, 8), NP_PKW(pB0, 10), NP_PKW(pB0, 12), NP_PKW(pB0, 14)};
      pw2 = (u32x4){NP_PKW(pB1, 0), NP_PKW(pB1, 2), NP_PKW(pB1, 4), NP_PKW(pB1, 6)}; pw3 = (u32x4){NP_PKW(pB1, 8), NP_PKW(pB1, 10), NP_PKW(pB1, 12), NP_PKW(pB1, 14)};
      LAS const unsigned char* vp_ = NP_VIMG((n - 1) & 3) + vfo;
      _Pragma("unroll") for (int i = 0; i < 8; ++i) NP_VRD(i);
      NSB();
      o0 = MFMA32(NP_VFR(0), __builtin_bit_cast(bf16x8, pw0), o0); o1 = MFMA32(NP_VFR(1), __builtin_bit_cast(bf16x8, pw0), o1);
      o0 = MFMA32(NP_VFR(2), __builtin_bit_cast(bf16x8, pw1), o0); o1 = MFMA32(NP_VFR(3), __builtin_bit_cast(bf16x8, pw1), o1);
      o0 = MFMA32(NP_VFR(4), __builtin_bit_cast(bf16x8, pw2), o0); o1 = MFMA32(NP_VFR(5), __builtin_bit_cast(bf16x8, pw2), o1);
      o0 = MFMA32(NP_VFR(6), __builtin_bit_cast(bf16x8, pw3), o0); o1 = MFMA32(NP_VFR(7), __builtin_bit_cast(bf16x8, pw3), o1); }
    __syncthreads();
    lsum = l; sbase = (sbase + n) & 3;
#undef NP_DMA
#undef NP_DMAS
#undef NP_DMAWAIT
#undef NP_NEXT
#undef NP_SELBIT
#undef NP_KIMG
#undef NP_VIMG
#undef NP_KLOAD2
#undef NP_SPLAT
#undef NP_CINIT
#undef NP_DECIDE
#undef NP_PKW
#undef NP_VFR
#undef NP_VRD
#undef NP_GAPA
#undef NP_GAPB
#undef NP_KRD
#undef NP_STEP
}

__device__ __forceinline__ void nsa_unit(Frame& F, int b, int g, int qb) {
    int tid = F.tid; asm volatile("" : "+v"(tid));
    const int lane = tid & 63, w = F.wave, r32 = lane & 31, hi = lane >> 5;
    const int hh = 4 * g + (w & 3), th = w >> 2, cur = qb, T0 = qb * 64, tokl = 32 * th + r32, t = T0 + tokl;
    const size_t row = (size_t)b * SEQ + t; const int bg = b * 2 + g;
    LAS unsigned char* L = F.lds;
    bf16x8 qr[4];
    { const bf16_t* qp = WSP(bf16_t, WS_NQ) + row * 512 + hh * 64 + 8 * hi;
#pragma unroll
      for (int d0 = 0; d0 < 4; ++d0) qr[d0] = *(const bf16x8*)(qp + 16 * d0); }
    const float* gp = WSP(float, WS_NGT) + row * 24 + hh * 3; const float gate_c = gp[0], gate_s = gp[1], gate_w = gp[2];
    unsigned outp0[8], outp1[8];
    const unsigned kst = (tid & 7) * NSA_KCH + (tid >> 3) * 16, vst = ((tid & 7) >> 2) * NSA_VDH + (tid >> 3) * 64 + (tid & 3) * 16;
    const unsigned kfo = hi * NSA_KCH + r32 * 16, vfo = tr_lane_off(lane);
    float m, l; f32x16 o0, o1;
    u32x4 rk, rv;
#define NSA_LOAD(Kp, Vp, tile) do { rk = *(const u32x4*)((Kp) + (size_t)(tile) * 4096 + tid * 8); rv = *(const u32x4*)((Vp) + (size_t)(tile) * 4096 + tid * 8); } while (0)
#define NSA_WRITE(buf) do { *(LAS u32x4*)(L + (buf) * NSA_BUF + kst) = rk; *(LAS u32x4*)(L + (buf) * NSA_BUF + NSA_KIMG + vst) = rv; } while (0)
#define NSA_NEXT(jv) do { jv = -1; if (ulo | uhi) { jv = ulo ? __builtin_ctz(ulo) : 32 + __builtin_ctz(uhi); if (ulo) ulo &= ulo - 1; else uhi &= uhi - 1; } } while (0)
#define NSA_RUN(Kp, Vp, MLO, MHI, ...) do { unsigned ulo = (MLO), uhi = (MHI); int j, j1, j2; u32x4 rk2, rv2; \
        NSA_NEXT(j); NSA_LOAD(Kp, Vp, j); NSA_WRITE(0); NSA_NEXT(j1); if (j1 >= 0) NSA_LOAD(Kp, Vp, j1); __syncthreads(); int buf = 0; \
        for (;;) { NSA_NEXT(j2); if (j2 >= 0) { rk2 = *(const u32x4*)((Kp) + (size_t)j2 * 4096 + tid * 8); rv2 = *(const u32x4*)((Vp) + (size_t)j2 * 4096 + tid * 8); } \
            { LAS const unsigned char* KI = L + buf * NSA_BUF; LAS const unsigned char* VI = KI + NSA_KIMG; __VA_ARGS__ } \
            if (j1 >= 0) NSA_WRITE(buf ^ 1); __syncthreads(); if (j1 < 0) break; j = j1; j1 = j2; rk = rk2; rv = rv2; buf ^= 1; } } while (0)
#define NSA_LOAD2(Kp, Vp, ja, jb) do { rk = *(const u32x4*)((Kp) + (size_t)(ja) * 4096 + tid * 8); rv = *(const u32x4*)((Vp) + (size_t)(ja) * 4096 + tid * 8); \
        if ((jb) >= 0) { rkB = *(const u32x4*)((Kp) + (size_t)(jb) * 4096 + tid * 8); rvB = *(const u32x4*)((Vp) + (size_t)(jb) * 4096 + tid * 8); } } while (0)
#define NSA_WRITE2(pb, jb) do { LAS unsigned char* P_ = L + (pb) * (2 * NSA_BUF); *(LAS u32x4*)(P_ + kst) = rk; *(LAS u32x4*)(P_ + NSA_KIMG + vst) = rv; \
        if ((jb) >= 0) { *(LAS u32x4*)(P_ + NSA_BUF + kst) = rkB; *(LAS u32x4*)(P_ + NSA_BUF + NSA_KIMG + vst) = rvB; } } while (0)
#define NSA_RUN2(Kp, Vp, MLO, MHI, ...) do { unsigned ulo = (MLO), uhi = (MHI); int ja, jb, na, nb; u32x4 rkB, rvB; \
        NSA_NEXT(ja); NSA_NEXT(jb); NSA_LOAD2(Kp, Vp, ja, jb); NSA_WRITE2(0, jb); __syncthreads(); int pbuf = 0; \
        for (;;) { NSA_NEXT(na); NSA_NEXT(nb); if (na >= 0) NSA_LOAD2(Kp, Vp, na, nb); \
            { LAS const unsigned char* KA = L + pbuf * (2 * NSA_BUF); LAS const unsigned char* VA = KA + NSA_KIMG; LAS const unsigned char* KB = KA + NSA_BUF; LAS const unsigned char* VB = KB + NSA_KIMG; __VA_ARGS__ } \
            if (na >= 0) NSA_WRITE2(pbuf ^ 1, nb); __syncthreads(); if (na < 0) break; ja = na; jb = nb; pbuf ^= 1; } } while (0)
#define NSA_LT(lv) ({ const auto rr_ = __builtin_amdgcn_permlane32_swap(__float_as_uint(lv), __float_as_uint(lv), false, false); __uint_as_float(rr_[0]) + __uint_as_float(rr_[1]); })
#define NSA_RESET() do { m = -1e30f; l = 0.f; o0 = (f32x16){0}; o1 = (f32x16){0}; } while (0)

    const bf16_t* Kc = WSP(bf16_t, WS_KCMP) + (size_t)bg * 256 * 64; const bf16_t* Vc = WSP(bf16_t, WS_VCMP) + (size_t)bg * 256 * 64;
    const int ntc = ((4 * cur + 2) >> 6) + 1; const int lim = (t >= 31) ? ((t - 31) >> 4) : -1;
    const int tmin_w = T0 + 32 * th; const int lim_min = (tmin_w >= 31) ? ((tmin_w - 31) >> 4) : -1;
    unsigned sel0, sel1, un0, un1;
    {
        LAS float* IMP = (LAS float*)(L + NSA_IMP); LAS float* FAC = (LAS float*)(L + NSA_FAC);
        float carry = 0.f; const bool need_imp = cur >= 16;
        float mt0 = 0.f, mt1 = 0.f, mt2 = 0.f, mt3 = 0.f;
        m = -1e30f; l = 0.f; o0 = (f32x16){0}; o1 = (f32x16){0};
        NSA_RUN(Kc, Vc, (1u << ntc) - 1u, 0u, {
            f32x16 p0, p1; nsa_qk(KI, qr, kfo, p0, p1);
            if (64 * j + 63 > lim_min) {
                _Pragma("unroll") for (int r = 0; r < 16; ++r) { const int k0 = 64 * j + crow(r, hi);
                    p0[r] = (k0 <= lim) ? p0[r] : -INFINITY; p1[r] = (k0 + 32 <= lim) ? p1[r] : -INFINITY; } }
            { const float rm = nsa_rowmax(p0, p1); const bool fresh = m < -1e29f; const bool grow = fresh ? (rm > -INFINITY) : (rm - m > NSA_THR);
              if (__any(grow)) { const float mn = grow ? rm : m; const float f = (grow && !fresh) ? ex2(m - mn) : 1.f; m = mn; l *= f; carry *= f;
                  _Pragma("unroll") for (int r = 0; r < 16; ++r) { o0[r] *= f; o1[r] *= f; } } }
            if (j == 0) mt0 = m; else if (j == 1) mt1 = m; else if (j == 2) mt2 = m; else mt3 = m;
            { float rs = 0.f;
              _Pragma("unroll") for (int r = 0; r < 16; ++r) { p0[r] = ex2(p0[r] - m); p1[r] = ex2(p1[r] - m); rs += p0[r] + p1[r]; }
              l += rs; }
            if (need_imp) {
                _Pragma("unroll") for (int n = 0; n < 2; ++n) {
                    float a[4], bq[4], pb[4];
                    _Pragma("unroll") for (int q4 = 0; q4 < 4; ++q4) { const float x0 = n ? p1[4 * q4] : p0[4 * q4], x1 = n ? p1[4 * q4 + 1] : p0[4 * q4 + 1], x2 = n ? p1[4 * q4 + 2] : p0[4 * q4 + 2], x3 = n ? p1[4 * q4 + 3] : p0[4 * q4 + 3];
                        a[q4] = 2.f * (x0 + x1 + x2) + x3; bq[q4] = x3; }
                    _Pragma("unroll") for (int q4 = 0; q4 < 4; ++q4) pb[q4] = __shfl_xor(bq[q4], 32);
                    _Pragma("unroll") for (int q4 = 0; q4 < 4; ++q4) { const float prevb = hi ? pb[q4] : (q4 ? pb[q4 > 0 ? q4 - 1 : 0] : carry);
                        IMP[((w & 3) * 64 + tokl) * NSA_IST + 16 * j + 8 * n + 2 * q4 + hi] = a[q4] + prevb; }
                    carry = pb[3];
                } }
            u32x4 pw[4];
            _Pragma("unroll") for (int s = 0; s < 2; ++s) {
                pw[s].x = cvtpk(p0[8 * s + 0], p0[8 * s + 1]); pw[s].y = cvtpk(p0[8 * s + 2], p0[8 * s + 3]); pw[s].z = cvtpk(p0[8 * s + 4], p0[8 * s + 5]); pw[s].w = cvtpk(p0[8 * s + 6], p0[8 * s + 7]);
                pw[2 + s].x = cvtpk(p1[8 * s + 0], p1[8 * s + 1]); pw[2 + s].y = cvtpk(p1[8 * s + 2], p1[8 * s + 3]); pw[2 + s].z = cvtpk(p1[8 * s + 4], p1[8 * s + 5]); pw[2 + s].w = cvtpk(p1[8 * s + 6], p1[8 * s + 7]); }
            _Pragma("unroll") for (int ks = 0; ks < 4; ++ks) {
                const bf16x8 v0 = mk8(vtr(VI + vfo + ks * 1024), vtr(VI + vfo + ks * 1024 + 512));
                const bf16x8 v1 = mk8(vtr(VI + vfo + NSA_VDH + ks * 1024), vtr(VI + vfo + NSA_VDH + ks * 1024 + 512));
                o0 = MFMA32(v0, __builtin_bit_cast(bf16x8, pw[ks]), o0); o1 = MFMA32(v1, __builtin_bit_cast(bf16x8, pw[ks]), o1); } });
        const float inv_c = 1.f / fmaxf(NSA_LT(l), 1e-30f); const float gs_ = gate_c * inv_c;
        _Pragma("unroll") for (int r = 0; r < 8; ++r) { outp0[r] = cvtpk(gs_ * o0[2 * r], gs_ * o0[2 * r + 1]); outp1[r] = cvtpk(gs_ * o1[2 * r], gs_ * o1[2 * r + 1]); }
        if (need_imp) {
            if (hi == 0) { f32x4 fc; fc[0] = ex2(mt0 - m) * inv_c; fc[1] = ntc > 1 ? ex2(mt1 - m) * inv_c : 0.f; fc[2] = ntc > 2 ? ex2(mt2 - m) * inv_c : 0.f; fc[3] = ntc > 3 ? ex2(mt3 - m) * inv_c : 0.f;
                *(LAS f32x4*)(FAC + ((w & 3) * 64 + tokl) * 4) = fc; }
            __syncthreads(); }
    }
    if (cur >= 16) {
        LAS float* IMP = (LAS float*)(L + NSA_IMP);
        LAS unsigned* TOT = (LAS unsigned*)(L + NSA_TOT); LAS unsigned char* SELB = L + NSA_SELB; LAS unsigned* UNI = (LAS unsigned*)(L + NSA_UNI);
        { const int tk = tid >> 3, jg = tid & 7; LAS const float* FAC = (LAS const float*)(L + NSA_FAC);
          float fq[4];
#pragma unroll
          for (int h4 = 0; h4 < 4; ++h4) fq[h4] = FAC[(h4 * 64 + tk) * 4 + (jg >> 1)];
#pragma unroll
          for (int jj = 0; jj < 8; ++jj) { const int jx = 8 * jg + jj;
              const float tot = ((IMP[tk * NSA_IST + jx] * fq[0] + IMP[(64 + tk) * NSA_IST + jx] * fq[1]) + IMP[(128 + tk) * NSA_IST + jx] * fq[2]) + IMP[(192 + tk) * NSA_IST + jx] * fq[3];
              TOT[tk * NSA_IST + jx] = (__float_as_uint(tot) & ~63u) | (unsigned)(63 - jx); }
          if (tid < 2) UNI[tid] = 0u; }
        __syncthreads();
        { const int tk = tid >> 3, jg = tid & 7; unsigned bits = 0u;
          unsigned v[8]; int rank[8];
#pragma unroll
          for (int jj = 0; jj < 8; ++jj) { v[jj] = TOT[tk * NSA_IST + 8 * jg + jj]; rank[jj] = 0; }
#pragma unroll 4
          for (int k2 = 1; k2 <= cur - 2; ++k2) { const unsigned v2 = TOT[tk * NSA_IST + k2];
#pragma unroll
              for (int jj = 0; jj < 8; ++jj) rank[jj] += (int)(v2 > v[jj]); }
#pragma unroll
          for (int jj = 0; jj < 8; ++jj) { const int jx = 8 * jg + jj;
              const bool s = (jx == 0 || jx == cur || jx == cur - 1) || (jx < cur - 1 && rank[jj] < 13);
              bits |= s ? (1u << jj) : 0u; }
          SELB[tk * 8 + jg] = (unsigned char)bits;
          atomicOr((unsigned*)&UNI[jg >> 2], bits << (8 * (jg & 3))); }
        __syncthreads();
        sel0 = *(LAS const unsigned*)(SELB + tokl * 8); sel1 = *(LAS const unsigned*)(SELB + tokl * 8 + 4);
        un0 = __builtin_amdgcn_readfirstlane(UNI[0]); un1 = __builtin_amdgcn_readfirstlane(UNI[1]);
    } else {
        sel0 = (1u << (cur + 1)) - 1u; sel1 = 0u; un0 = sel0; un1 = 0u;
    }
    LAS unsigned* ST = (LAS unsigned*)(L + NSA_STASH + w * 4096) + lane;
#pragma unroll
    for (int r = 0; r < 8; ++r) { ST[r * 64] = outp0[r]; ST[(8 + r) * 64] = outp1[r]; }
    const bf16_t* Ks = WSP(bf16_t, WS_KSL) + (size_t)bg * SEQ * 64; const bf16_t* Vs = WSP(bf16_t, WS_VSL) + (size_t)bg * SEQ * 64;
    const bf16_t* Kw = WSP(bf16_t, WS_KWN) + (size_t)bg * SEQ * 64; const bf16_t* Vw = WSP(bf16_t, WS_VWN) + (size_t)bg * SEQ * 64;
    const int jlo = cur >= 8 ? cur - 8 : 0;
    const unsigned long long wm = ((cur == 63) ? ~0ull : ((1ull << (cur + 1)) - 1ull)) & ~((1ull << jlo) - 1ull);
    int sbase = 0;
    nsa_pipe<1>(L, Ks, Vs, un0, un1, sel0, sel1, qr, t, lane, w, hi, kfo, vfo, l, o0, o1, sbase, false, Kw, Vw, (unsigned)wm, (unsigned)(wm >> 32));
    { const float sc = gate_s / fmaxf(NSA_LT(l), 1e-30f);
#pragma unroll
      for (int r = 0; r < 8; ++r) { const unsigned a = ST[r * 64], c = ST[(8 + r) * 64];
          ST[r * 64] = cvtpk(bflo(a) + sc * o0[2 * r], bfhi(a) + sc * o0[2 * r + 1]); ST[(8 + r) * 64] = cvtpk(bflo(c) + sc * o1[2 * r], bfhi(c) + sc * o1[2 * r + 1]); } }
    nsa_pipe<2>(L, Kw, Vw, (unsigned)wm, (unsigned)(wm >> 32), 0u, 0u, qr, t, lane, w, hi, kfo, vfo, l, o0, o1, sbase, true, nullptr, nullptr, 0u, 0u);
    { const float sc = gate_w / fmaxf(NSA_LT(l), 1e-30f);
      bf16_t* yo = WSP(bf16_t, WS_YCAT) + row * 1024 + 512 + hh * 64;
#pragma unroll
      for (int p2 = 0; p2 < 2; ++p2) { u32x2 av[2], cv[2];
#pragma unroll
          for (int e = 0; e < 2; ++e) { const int q4 = 2 * p2 + e;
              const unsigned a0 = ST[(2 * q4) * 64], a1 = ST[(2 * q4 + 1) * 64], c0 = ST[(8 + 2 * q4) * 64], c1 = ST[(9 + 2 * q4) * 64];
              av[e].x = cvtpk(bflo(a0) + sc * o0[4 * q4], bfhi(a0) + sc * o0[4 * q4 + 1]); av[e].y = cvtpk(bflo(a1) + sc * o0[4 * q4 + 2], bfhi(a1) + sc * o0[4 * q4 + 3]);
              cv[e].x = cvtpk(bflo(c0) + sc * o1[4 * q4], bfhi(c0) + sc * o1[4 * q4 + 1]); cv[e].y = cvtpk(bflo(c1) + sc * o1[4 * q4 + 2], bfhi(c1) + sc * o1[4 * q4 + 3]); }
          *(u32x4*)(yo + 16 * p2 + 8 * hi) = widen_pair(av[0], av[1]); *(u32x4*)(yo + 32 + 16 * p2 + 8 * hi) = widen_pair(cv[0], cv[1]); } }
#undef NSA_LOAD
#undef NSA_WRITE
#undef NSA_RUN
#undef NSA_RUN2
#undef NSA_LOAD2
#undef NSA_WRITE2
#undef NSA_LT
#undef NSA_RESET
}

__device__ __forceinline__ void s6_phase(Frame& F) {
    int tid = F.tid; asm volatile("" : "+v"(tid));
    const int lane = tid & 63, w = F.wave;
    LAS unsigned char* TILE = F.lds + w * 16384;
    LAS float* LG = (LAS float*)(F.lds + MISC_OFF + 4096) + w * (8 * 48);
    LAS int* REC_E = (LAS int*)(F.lds + MISC_OFF + 16384);
    LAS float* REC_G = (LAS float*)(F.lds + MISC_OFF + 16384 + 1024);
    LAS int* REC_P = (LAS int*)(F.lds + MISC_OFF + 16384 + 2048);
    LAS int* CNTL = (LAS int*)(F.lds + MISC_OFF + 16384 + 3072);
    LAS float* SAW = (LAS float*)(F.lds + MISC_OFF + 16384 + 3584);
    const float* x = IN_F(0); const float* wpost = IN_F(6); const float* wffn = IN_F(7); const float* mod = WSP(float, WS_MOD);
    const bf16_t* Y = WSP(bf16_t, WS_Y); bf16_t* X1B = WSP(bf16_t, WS_X1B); signed char* H2Q = (signed char*)(F.ws + WS_H2Q); float* SAv = WSP(float, WS_SA); const _Float16* RWT = WSP(_Float16, WS_RWT);
    const float* bgp = IN_F(21); const float* bep = IN_F(23);
    unsigned* cntg = (unsigned*)(F.ws + WS_CTL) + CW_CNT;
    for (int rb = F.vcu; rb < NTOK / 128; rb += F.G) {
        if (tid < 64) CNTL[tid] = 0;
        __syncthreads();
        const int rbase = rb * 128 + w * 16, b = rbase >> 12;
        f32x4 xv[4][4]; u32x4 yw[4][2];
#define S6_LOAD(g) do { _Pragma("unroll") for (int r = 0; r < 4; ++r) { const size_t ro_ = (size_t)(rbase + 4 * (g) + r) * DM; \
            _Pragma("unroll") for (int j = 0; j < 4; ++j) xv[r][j] = __builtin_nontemporal_load((const f32x4*)(x + ro_ + 4 * lane + 256 * j)); \
            _Pragma("unroll") for (int jp = 0; jp < 2; ++jp) yw[r][jp] = __builtin_nontemporal_load((const u32x4*)(Y + ro_ + 4 * (lane & ~1) + 256 * (2 * jp + (lane & 1)))); } } while (0)
#define S6_Y(r, j) ((f32x4){bflo(yr[r][j].x), bfhi(yr[r][j].x), bflo(yr[r][j].y), bfhi(yr[r][j].y)})
        S6_LOAD(0);
#pragma nounroll
        for (int g = 0; g < 4; ++g) {
            u32x2 yr[4][4];
#pragma unroll
            for (int r = 0; r < 4; ++r)
#pragma unroll
                for (int jp = 0; jp < 2; ++jp) pair_narrow(yw[r][jp], lane, yr[r][2 * jp], yr[r][2 * jp + 1]);
            int l4 = 4 * lane; asm volatile("" : "+v"(l4));
            float ss[4];
#pragma unroll
            for (int r = 0; r < 4; ++r) { float a2 = 0.f;
#pragma unroll
                for (int j = 0; j < 4; ++j) { const f32x4 y = S6_Y(r, j); a2 += y[0] * y[0] + y[1] * y[1] + y[2] * y[2] + y[3] * y[3]; }
                ss[r] = a2; }
#pragma unroll
            for (int o = 1; o < 64; o <<= 1) {
#pragma unroll
                for (int r = 0; r < 4; ++r) ss[r] += __shfl_xor(ss[r], o); }
            float s2[4] = {0.f, 0.f, 0.f, 0.f};
#pragma unroll
            for (int j = 0; j < 4; ++j) { const int k = l4 + 256 * j;
                const f32x4 wp = *(const f32x4*)(wpost + k), gm = *(const f32x4*)(mod + b * 6144 + 2048 + k); const f32x4 gw2 = gm * wp;
#pragma unroll
                for (int r = 0; r < 4; ++r) { const float r1 = rsqrtf(ss[r] * (1.f / DM) + RMS_EPS);
                    xv[r][j] = xv[r][j] + gw2 * (S6_Y(r, j) * r1);
                    s2[r] += xv[r][j][0] * xv[r][j][0] + xv[r][j][1] * xv[r][j][1] + xv[r][j][2] * xv[r][j][2] + xv[r][j][3] * xv[r][j][3]; } }
#pragma unroll
            for (int r = 0; r < 4; ++r)
#pragma unroll
                for (int jp = 0; jp < 2; ++jp) { u32x2 pa, pb; pa.x = cvtpk(xv[r][2 * jp][0], xv[r][2 * jp][1]); pa.y = cvtpk(xv[r][2 * jp][2], xv[r][2 * jp][3]);
                    pb.x = cvtpk(xv[r][2 * jp + 1][0], xv[r][2 * jp + 1][1]); pb.y = cvtpk(xv[r][2 * jp + 1][2], xv[r][2 * jp + 1][3]);
                    __builtin_nontemporal_store(pair_widen(pa, pb, lane), (u32x4*)(X1B + (size_t)(rbase + 4 * g + r) * DM + 4 * (lane & ~1) + 256 * (2 * jp + (lane & 1)))); }
#pragma unroll
            for (int o = 1; o < 64; o <<= 1) {
#pragma unroll
                for (int r = 0; r < 4; ++r) s2[r] += __shfl_xor(s2[r], o); }
#pragma unroll
            for (int j = 0; j < 4; ++j) { const int k = l4 + 256 * j;
                const f32x4 wf = *(const f32x4*)(wffn + k), sh = *(const f32x4*)(mod + b * 6144 + 3072 + k), sc = *(const f32x4*)(mod + b * 6144 + 4096 + k); const f32x4 ws = wf * (sc + 1.f);
#pragma unroll
                for (int r = 0; r < 4; ++r) { const float r2 = rsqrtf(s2[r] * (1.f / DM) + RMS_EPS);
                    const f32x4 h = xv[r][j] * r2 * ws + sh;
                    { const int rt = 4 * (g & 1) + r; const f16x4 hh = {(_Float16)h[0], (_Float16)h[1], (_Float16)h[2], (_Float16)h[3]};
                      *(LAS f16x4*)(TILE + rt * 2048 + (((lane >> 1) ^ rt) << 4) + (lane & 1) * 8 + 512 * j) = hh; }
                    xv[r][j] = h; } }
            float am[4];
#pragma unroll
            for (int r = 0; r < 4; ++r) { float a = 0.f;
#pragma unroll
                for (int j = 0; j < 4; ++j) a = fmaxf(a, fmaxf(fmaxf(fabsf(xv[r][j][0]), fabsf(xv[r][j][1])), fmaxf(fabsf(xv[r][j][2]), fabsf(xv[r][j][3]))));
                am[r] = a; }
#pragma unroll
            for (int o = 1; o < 64; o <<= 1) {
#pragma unroll
                for (int r = 0; r < 4; ++r) am[r] = fmaxf(am[r], __shfl_xor(am[r], o)); }
#pragma unroll
            for (int r = 0; r < 4; ++r) { const float inv = am[r] > 0.f ? 127.f / am[r] : 0.f; const size_t ro = (size_t)(rbase + 4 * g + r) * DM;
                if (lane == 0) { SAv[rbase + 4 * g + r] = am[r] * (1.f / 127.f); SAW[(w * 16 + 4 * g + r)] = am[r] * (1.f / 127.f); }
                u32x4 pk;
#pragma unroll
                for (int j = 0; j < 4; ++j) { const f32x4 q = xv[r][j] * inv;
                    const int q0 = (int)rintf(q[0]), q1 = (int)rintf(q[1]), q2 = (int)rintf(q[2]), q3 = (int)rintf(q[3]);
                    pk[j] = (unsigned)(q0 & 0xff) | ((unsigned)(q1 & 0xff) << 8) | ((unsigned)(q2 & 0xff) << 16) | ((unsigned)(q3 & 0xff) << 24); }
                *(u32x4*)(H2Q + ro + 256 * (lane & 3) + 16 * (lane >> 2)) = quad_transpose(pk, lane); }
            __builtin_amdgcn_sched_barrier(0);
            if (g < 3) S6_LOAD(g + 1);
            __builtin_amdgcn_sched_barrier(0);
            if (g & 1) {
                const int r16 = lane & 15, q = lane >> 4, rt = r16 & 7;
                f32x4 a0 = {0.f, 0.f, 0.f, 0.f}, a1 = a0, a2 = a0;
                LAS const unsigned char* ae = TILE + rt * 2048 + ((q ^ rt) << 4); LAS const unsigned char* ao = TILE + rt * 2048 + (((q ^ rt) ^ 4) << 4);
                const _Float16* bp = RWT + (size_t)r16 * DM + 8 * q;
#pragma unroll 4
                for (int k2 = 0; k2 < 16; ++k2) {
                    const f16x8 ah0 = *(LAS const f16x8*)(ae + 128 * k2), ah1 = *(LAS const f16x8*)(ao + 128 * k2);
                    const f16x8 b00 = *(const f16x8*)(bp + 64 * k2), b01 = *(const f16x8*)(bp + 64 * k2 + 16 * DM), b02 = *(const f16x8*)(bp + 64 * k2 + 32 * DM);
                    const f16x8 b10 = *(const f16x8*)(bp + 64 * k2 + 32), b11 = *(const f16x8*)(bp + 64 * k2 + 32 + 16 * DM), b12 = *(const f16x8*)(bp + 64 * k2 + 32 + 32 * DM);
                    a0 = __builtin_amdgcn_mfma_f32_16x16x32_f16(ah0, b00, a0, 0, 0, 0); a1 = __builtin_amdgcn_mfma_f32_16x16x32_f16(ah0, b01, a1, 0, 0, 0); a2 = __builtin_amdgcn_mfma_f32_16x16x32_f16(ah0, b02, a2, 0, 0, 0);
                    a0 = __builtin_amdgcn_mfma_f32_16x16x32_f16(ah1, b10, a0, 0, 0, 0); a1 = __builtin_amdgcn_mfma_f32_16x16x32_f16(ah1, b11, a1, 0, 0, 0); a2 = __builtin_amdgcn_mfma_f32_16x16x32_f16(ah1, b12, a2, 0, 0, 0); }
                if (q < 2) {
#pragma unroll
                    for (int i = 0; i < 4; ++i) { LG[(4 * q + i) * 48 + r16] = a0[i]; LG[(4 * q + i) * 48 + 16 + r16] = a1[i]; LG[(4 * q + i) * 48 + 32 + r16] = a2[i]; } }
                asm volatile("s_waitcnt lgkmcnt(0)" ::: "memory");
                if (lane < 8) {
                    const LAS float* lg = LG + lane * 48;
                    float gl[4]; int gi = 0; float gmx = -INFINITY;
#pragma unroll
                    for (int i = 0; i < 4; ++i) { gl[i] = lg[i] + bgp[i]; if (gl[i] > gmx) { gmx = gl[i]; gi = i; } }
                    float gs = 0.f;
#pragma unroll
                    for (int i = 0; i < 4; ++i) gs += __expf(gl[i] - gmx);
                    const float pg = 1.f / gs;
                    float el[8]; float emx = -INFINITY;
#pragma unroll
                    for (int i = 0; i < 8; ++i) { el[i] = lg[4 + gi * 8 + i] + bep[gi * 8 + i]; emx = fmaxf(emx, el[i]); }
                    int e0 = 0; float v0 = -INFINITY;
#pragma unroll
                    for (int i = 0; i < 8; ++i) if (el[i] > v0) { v0 = el[i]; e0 = i; }
                    int e1 = 0; float v1 = -INFINITY;
#pragma unroll
                    for (int i = 0; i < 8; ++i) if (i != e0 && el[i] > v1) { v1 = el[i]; e1 = i; }
                    const float p0 = __expf(v0 - emx), p1 = __expf(v1 - emx);
                    const float g0 = pg * p0 / (p0 + p1), g1 = pg * p1 / (p0 + p1);
                    const int rl = w * 16 + 8 * (g >> 1) + lane; const int E0 = gi * 8 + e0, E1 = gi * 8 + e1;
                    REC_E[rl * 2] = E0; REC_E[rl * 2 + 1] = E1; REC_G[rl * 2] = g0; REC_G[rl * 2 + 1] = g1;
                    REC_P[rl * 2] = atomicAdd((int*)&CNTL[E0], 1); REC_P[rl * 2 + 1] = atomicAdd((int*)&CNTL[E1], 1);
                }
                asm volatile("s_waitcnt lgkmcnt(0)" ::: "memory");
            }
        }
#undef S6_LOAD
#undef S6_Y
        __syncthreads();
        if (tid < 32) { const int c = CNTL[tid]; CNTL[32 + tid] = c ? (int)__hip_atomic_fetch_add(cntg + tid, (unsigned)c, __ATOMIC_RELAXED, __HIP_MEMORY_SCOPE_AGENT) : 0; }
        __syncthreads();
        if (tid < 256) { const int rl = tid >> 1, k = tid & 1; const int row = rb * 128 + rl; const int e = REC_E[tid]; const int p = CNTL[32 + e] + REC_P[tid];
            WSP(int, WS_TOKE)[row * 2 + k] = e; WSP(int, WS_TOKP)[row * 2 + k] = p; WSP(float, WS_TOKG)[row * 2 + k] = REC_G[tid];
            WSP(int, WS_LIST)[(size_t)e * 65536 + p] = row; WSP(float, WS_SAL)[(size_t)e * 65536 + p] = SAW[rl]; }
        __syncthreads();
    }
}

__device__ __forceinline__ void expert_convert(Frame& F) {
    {
        int tid = F.tid; asm volatile("" : "+v"(tid));
        LAS unsigned* AM = (LAS unsigned*)F.lds;
        const int n4 = tid & 7, kq = tid >> 3;
        for (int it = F.vcu; it < 1024; it += F.G) {
            const int e = it >> 5, sel = (it >> 4) & 1, j0 = (it & 15) * 32;
            const float* W = IN_F(sel ? 25 : 24) + (size_t)e * 1024 * 512 + (size_t)(16 * kq) * 512 + j0 + 4 * n4;
            if (tid < 32) AM[tid] = 0u;
            __syncthreads();
            f32x4 v[16]; f32x4 am = {0.f, 0.f, 0.f, 0.f};
#pragma unroll
            for (int i = 0; i < 16; ++i) { v[i] = *(const f32x4*)(W + (size_t)i * 512);
#pragma unroll
                for (int c = 0; c < 4; ++c) am[c] = fmaxf(am[c], fabsf(v[i][c])); }
#pragma unroll
            for (int o = 8; o < 64; o <<= 1) {
#pragma unroll
                for (int c = 0; c < 4; ++c) am[c] = fmaxf(am[c], __shfl_xor(am[c], o)); }
            if ((tid & 63) < 8) {
#pragma unroll
                for (int c = 0; c < 4; ++c) atomicMax((unsigned*)&AM[4 * n4 + c], __float_as_uint(am[c])); }
            __syncthreads();
            const f32x4 amax = *(LAS const f32x4*)((LAS const float*)AM + 4 * n4);
            unsigned char* dst = (unsigned char*)(F.ws + WS_W13T) + ((size_t)e * 1024 + 8 * ((j0 >> 2) + n4) + 4 * sel) * 1024 + 16 * kq;
#pragma unroll
            for (int c = 0; c < 4; ++c) { const float inv = amax[c] > 0.f ? 127.f / amax[c] : 0.f; u32x4 o;
#pragma unroll
                for (int d = 0; d < 4; ++d) {
                    const int q0 = (int)rintf(v[4 * d][c] * inv), q1 = (int)rintf(v[4 * d + 1][c] * inv), q2 = (int)rintf(v[4 * d + 2][c] * inv), q3 = (int)rintf(v[4 * d + 3][c] * inv);
                    o[d] = (unsigned)(q0 & 0xff) | ((unsigned)(q1 & 0xff) << 8) | ((unsigned)(q2 & 0xff) << 16) | ((unsigned)(q3 & 0xff) << 24); }
                *(u32x4*)(dst + (size_t)c * 1024) = o;
                if (kq == 0) WSP(float, WS_SB13)[e * 1024 + 8 * ((j0 >> 2) + n4) + 4 * sel + c] = amax[c] * (1.f / 127.f); }
            __syncthreads();
        }
    }
}
__device__ __forceinline__ void w2_convert(Frame& F, int rk, int nsh) {
    LAS float* scr = (LAS float*)(F.lds + F.wave * 8448);
    const int gw = rk * NWAVES + F.wave, NGW = nsh * NWAVES;
    for (int it = gw; it < 32 * 256; it += NGW) {
        const int e = it >> 8, r = it & 255;
        transpose_item(IN_F(26) + (size_t)e * 512 * 1024, 1024, WSP(bf16_t, WS_W2T) + (size_t)e * 1024 * 512, 512, scr, (r / 32) * 64, (r % 32) * 32, F.lane, RmId{0});
    }
    __syncthreads();
}

__device__ __forceinline__ void moe_tables(Frame& F, LAS int* tstart, LAS int* cnt) {
    if (F.tid < 64) {
        const int lane = F.tid; const unsigned* cg = (const unsigned*)(F.ws + WS_CTL) + CW_CNT;
        const int c = lane < 32 ? (int)__hip_atomic_load(cg + lane, __ATOMIC_RELAXED, __HIP_MEMORY_SCOPE_AGENT) : 0;
        const int tl = (c + 255) >> 8; int incl = tl;
#pragma unroll
        for (int o = 1; o < 32; o <<= 1) { const int x = __shfl_up(incl, o); if (lane >= o) incl += x; }
        if (lane < 32) { cnt[lane] = c; tstart[lane] = incl - tl; LAS unsigned char* et = (LAS unsigned char*)(tstart + 96);
            for (int t2 = incl - tl; t2 < incl; ++t2) et[t2] = (unsigned char)lane; }
        if (lane == 31) tstart[32] = incl; }
    __syncthreads();
}

__device__ __forceinline__ void s10_phase(Frame& F, LAS int* tstart) {
    const int gw = F.vcu * NWAVES + F.wave, NGW = F.G * NWAVES, lane = F.lane;
    const float* wpost = IN_F(8); const float* mod = WSP(float, WS_MOD); const bf16_t* YB = WSP(bf16_t, WS_YB); const bf16_t* X1B = WSP(bf16_t, WS_X1B);
    int ne0[4], ne1[4], np0[4], np1[4]; float ng0[4], ng1[4];
#define S10_TAB(rw) do { _Pragma("unroll") for (int r = 0; r < 4; ++r) { const int row_ = (rw) + r; \
        ne0[r] = WSP(int, WS_TOKE)[row_ * 2]; ne1[r] = WSP(int, WS_TOKE)[row_ * 2 + 1]; np0[r] = WSP(int, WS_TOKP)[row_ * 2]; np1[r] = WSP(int, WS_TOKP)[row_ * 2 + 1]; \
        ng0[r] = WSP(float, WS_TOKG)[row_ * 2]; ng1[r] = WSP(float, WS_TOKG)[row_ * 2 + 1]; } } while (0)
    if (gw * 4 < NTOK) S10_TAB(gw * 4);
    for (int row0 = gw * 4; row0 < NTOK; row0 += NGW * 4) {
        const int b = row0 >> 12;
        size_t r0[4], r1[4]; float g0[4], g1[4];
#pragma unroll
        for (int r = 0; r < 4; ++r) { r0[r] = (size_t)tstart[ne0[r]] * 256 + np0[r]; r1[r] = (size_t)tstart[ne1[r]] * 256 + np1[r]; g0[r] = ng0[r]; g1[r] = ng1[r]; }
        if (row0 + NGW * 4 < NTOK) S10_TAB(row0 + NGW * 4);
        f32x4 yv[4][4]; float ss[4];
        u32x4 xw[4][2];
#pragma unroll
        for (int r = 0; r < 4; ++r) { float a2 = 0.f;
            u32x4 wa[2], wc[2];
#pragma unroll
            for (int jp = 0; jp < 2; ++jp) { const int ko = 4 * (lane & ~1) + 256 * (2 * jp + (lane & 1));
                wa[jp] = __builtin_nontemporal_load((const u32x4*)(YB + r0[r] * DM + ko)); wc[jp] = __builtin_nontemporal_load((const u32x4*)(YB + r1[r] * DM + ko));
                xw[r][jp] = __builtin_nontemporal_load((const u32x4*)(X1B + (size_t)(row0 + r) * DM + ko)); }
#pragma unroll
            for (int jp = 0; jp < 2; ++jp) { u32x2 a[2], c[2]; pair_narrow(wa[jp], lane, a[0], a[1]); pair_narrow(wc[jp], lane, c[0], c[1]);
#pragma unroll
                for (int e = 0; e < 2; ++e) { const int j = 2 * jp + e;
                    yv[r][j] = (f32x4){bflo(a[e].x), bfhi(a[e].x), bflo(a[e].y), bfhi(a[e].y)} * g0[r] + (f32x4){bflo(c[e].x), bfhi(c[e].x), bflo(c[e].y), bfhi(c[e].y)} * g1[r];
                    a2 += yv[r][j][0] * yv[r][j][0] + yv[r][j][1] * yv[r][j][1] + yv[r][j][2] * yv[r][j][2] + yv[r][j][3] * yv[r][j][3]; } }
            ss[r] = a2; }
#pragma unroll
        for (int o = 1; o < 64; o <<= 1) {
#pragma unroll
            for (int r = 0; r < 4; ++r) ss[r] += __shfl_xor(ss[r], o); }
#pragma unroll
        for (int jp = 0; jp < 2; ++jp) {
#pragma unroll
            for (int r = 0; r < 4; ++r) { const float rr = rsqrtf(ss[r] * (1.f / DM) + RMS_EPS);
                u32x2 xb[2]; pair_narrow(xw[r][jp], lane, xb[0], xb[1]);
#pragma unroll
                for (int e = 0; e < 2; ++e) { const int j = 2 * jp + e, k = 4 * lane + 256 * j;
                    const f32x4 wp = *(const f32x4*)(wpost + k), gf = *(const f32x4*)(mod + b * 6144 + 5120 + k); const f32x4 gw2 = gf * wp;
                    const f32x4 x1 = (f32x4){bflo(xb[e].x), bfhi(xb[e].x), bflo(xb[e].y), bfhi(xb[e].y)};
                    __builtin_nontemporal_store(x1 + gw2 * (yv[r][j] * rr), (f32x4*)(F.out + (size_t)(row0 + r) * DM + k)); } } }
    }
}

#undef S10_TAB
#ifndef DBG_STOP
#define DBG_STOP -1
#endif
#if DBG_STOP >= 0
struct DbgBuf { size_t off, n; int f32, ph; };
__device__ __forceinline__ void dbg_phase(Frame& F, const XcdBarrier& bar) {
    const DbgBuf bufs[] = {
        {WS_MOD, 8 * 6144, 1, 0}, {WS_COS, (size_t)NTOK * 32, 1, 0}, {WS_SIN, (size_t)NTOK * 32, 1, 0}, {WS_WINT, (size_t)INWP * 1024, 0, 0}, {WS_WOUTT, 1024 * 1024, 0, 0},
        {WS_CW1K, 128 * 2048, 0, 0}, {WS_CW2K, 64 * 128, 0, 0}, {WS_RWT, 48 * 1024, 0, 0}, {WS_C1B, 256, 1, 0},
        {WS_H1, (size_t)NTOK * 1024, 0, 1},
        {WS_MQ, (size_t)NTOK * 2048, 0, 2}, {WS_NQ, (size_t)NTOK * 512, 0, 2}, {WS_KC, (size_t)NTOK * 128 * 6, 0, 2}, {WS_GI, 2 * 8 * 4 * 4096, 1, 2}, {WS_NGT, (size_t)NTOK * 24, 1, 2},
        {WS_KVC, (size_t)2048 * 16384, 0, 3}, {WS_NC, 2048 * 128, 1, 3}, {WS_GSUM, 4096, 1, 3}, {WS_KCMP, 2 * 16 * 256 * 64, 0, 3},
        {WS_CPREV, (size_t)2048 * 16384, 0, 4}, {WS_NPREV, 2048 * 128, 1, 4}, {WS_MPREV, 2048, 1, 4},
        {WS_YCAT, (size_t)NTOK * 1024, 0, 5}, {WS_W13T, (size_t)32 * 1024 * 1024, 0, 5}, {WS_W2T, (size_t)32 * 1024 * 512, 0, 5},
        {WS_Y, (size_t)NTOK * 1024, 0, 6}, {WS_H2, (size_t)NTOK * 1024, 0, 7}, {WS_TOKG, (size_t)NTOK * 2, 1, 7},
        {WS_HB, (size_t)65536 * 512, 0, 8}, {WS_YB, (size_t)65536 * 1024, 0, 9} };
    constexpr int NBUF = sizeof(bufs) / sizeof(bufs[0]);
    unsigned* flag = (unsigned*)(F.ws + WS_CTL) + CW_DBG;
    const size_t gt = (size_t)blockIdx.x * NTHR + F.tid, NG = (size_t)F.G * NTHR;
    for (int i = 0; i < NBUF; ++i) {
        if (bufs[i].ph > DBG_STOP) continue;
        if ((bufs[i].off == WS_H1 && DBG_STOP >= 3) || (bufs[i].off == WS_WINT && DBG_STOP >= 4) || (bufs[i].off == WS_KVC && DBG_STOP >= 5) || (bufs[i].off == WS_NQ && DBG_STOP >= 5) || (bufs[i].off == WS_KC && DBG_STOP >= 9) ||
            (bufs[i].off == WS_MQ && DBG_STOP >= 6) || (bufs[i].off == WS_CPREV && DBG_STOP >= 8) || (bufs[i].off == WS_Y && DBG_STOP >= 9) || (bufs[i].off == WS_H2 && DBG_STOP >= 9) || (bufs[i].off == WS_W13T && DBG_STOP < 5)) continue;
        bool bad = false;
        if (bufs[i].f32) { const unsigned* p = (const unsigned*)(F.ws + bufs[i].off); for (size_t k = gt; k < bufs[i].n; k += NG) bad |= ((p[k] & 0x7f800000u) == 0x7f800000u); }
        else { const unsigned* p = (const unsigned*)(F.ws + bufs[i].off); for (size_t k = gt; k < bufs[i].n / 2; k += NG) { const unsigned v = p[k]; bad |= ((v & 0x7f80u) == 0x7f80u) || ((v & 0x7f800000u) == 0x7f800000u); } }
        if (bufs[i].off == WS_YCAT) { bool bm = false, bn = false; const unsigned* p = (const unsigned*)(F.ws + WS_YCAT);
            for (size_t k = gt; k < bufs[i].n / 2; k += NG) { const unsigned v = p[k]; const bool b2 = ((v & 0x7f80u) == 0x7f80u) || ((v & 0x7f800000u) == 0x7f800000u); if ((k & 511) < 256) bm |= b2; else bn |= b2; }
            if (__any(bm) && F.lane == 0) atomicMin(flag, 23u); if (__any(bn) && F.lane == 0) atomicMin(flag, 33u); continue; }
        if (__any(bad) && F.lane == 0) atomicMin(flag, (unsigned)(i + 1));
    }
    if (DBG_STOP >= 7) { bool bad = false; const unsigned* p = (const unsigned*)F.out; for (size_t k = gt; k < (size_t)NTOK * DM; k += NG) bad |= ((p[k] & 0x7f800000u) == 0x7f800000u); if (__any(bad) && F.lane == 0) atomicMin(flag, 40u); }
    xcd_barrier(bar);
    const unsigned id = __hip_atomic_load(flag, __ATOMIC_RELAXED, __HIP_MEMORY_SCOPE_AGENT);
    const float sc = (id >= 1000u) ? 1.f : 1.f + (float)id;
    const float* x = IN_F(0);
    for (size_t k = gt; k < (size_t)NTOK * DM; k += NG) F.out[k] = x[k] * sc;
}
#endif


#if DBG_STOP >= 0
__device__ __forceinline__ unsigned dbg_hash(unsigned x) { x ^= x >> 16; x *= 0x7feb352du; x ^= x >> 15; x *= 0x846ca68bu; x ^= x >> 16; return x; }
__device__ __forceinline__ float dbg_bfr(float f) { return bf2f(f2bf(f)); }
__device__ float dbg_z(Frame& F, int row, int c) { const signed char* h = (const signed char*)(F.ws + WS_H1) + (size_t)row * 1024; const float* w = IN_F(9); float am = 0.f;
    for (int k = 0; k < 1024; ++k) am = fmaxf(am, fabsf(w[(size_t)k * INW + c]));
    const float inv = am > 0.f ? 127.f / am : 0.f; float s = 0.f; for (int k = 0; k < 1024; ++k) s += (float)h[k] * rintf(w[(size_t)k * INW + c] * inv);
    return s * WSP(float, WS_SA1)[row] * (am * (1.f / 127.f)); }
__device__ __forceinline__ bool dbg_close(float a, float b) { return fabsf(a - b) <= 0.02f * fabsf(b) + 0.02f; }
__device__ void dbg_check_p1(Frame& F, unsigned* cnt) {
    const int gt = blockIdx.x * NTHR + F.tid; if (gt >= 8192) return;
    const int row = dbg_hash(gt * 2 + 1) % NTOK; int c = dbg_hash(gt * 2 + 2) % INW; if (gt < 64) c = 2048 + (gt & 7); if (gt >= 64 && gt < 256) c = 3336 + (gt % 24);
    const int b = row >> 12, sq = row & 4095; const float* COS = WSP(float, WS_COS); const float* SIN = WSP(float, WS_SIN);
    float ref, got;
    if (c < 2048) { ref = dbg_z(F, row, c); got = bf2f(WSP(bf16_t, c < 512 ? WS_MQ : c < 1024 ? WS_MK : c < 1536 ? WS_MV : WS_MO)[(size_t)row * 512 + (c & 511)]); }
    else if (c < 2052) { ref = dbg_z(F, row, c) + IN_F(11)[c - 2048]; got = WSP(float, WS_GI)[(size_t)(b * 4 + c - 2048) * SEQ + sq]; }
    else if (c < 2056) { ref = logsigmoid_f(dbg_z(F, row, c) + IN_F(11)[4 + c - 2052]); got = WSP(float, WS_GF)[(size_t)(b * 4 + c - 2052) * SEQ + sq]; }
    else if (c >= 3336) { ref = sigmoid_f(dbg_z(F, row, c)); got = WSP(float, WS_NGT)[(size_t)row * 24 + c - 3336]; }
    else {
        int base, x; size_t ws_off; bool rope, isq = false;
        if (c < 2568) { base = 2056; x = c - base; rope = true; isq = true; ws_off = WS_NQ; }
        else if (c < 2696) { base = 2568; x = c - base; rope = true; ws_off = WS_KC; }
        else if (c < 2824) { base = 2696; x = c - base; rope = false; ws_off = WS_VC; }
        else if (c < 2952) { base = 2824; x = c - base; rope = true; ws_off = WS_KSL; }
        else if (c < 3080) { base = 2952; x = c - base; rope = false; ws_off = WS_VSL; }
        else if (c < 3208) { base = 3080; x = c - base; rope = true; ws_off = WS_KWN; }
        else { base = 3208; x = c - base; rope = false; ws_off = WS_VWN; }
        const int hd = x >> 6, d = x & 63;
        if (rope) { const float z0 = dbg_z(F, row, c), z1 = dbg_z(F, row, base + hd * 64 + (d ^ 32)); const float cs = COS[(size_t)row * 32 + (d & 31)], sn = SIN[(size_t)row * 32 + (d & 31)];
            ref = d < 32 ? z0 * cs - z1 * sn : z0 * cs + z1 * sn; if (isq) ref *= QSCALE; }
        else ref = dbg_z(F, row, c);
        got = isq ? bf2f(WSP(bf16_t, ws_off)[(size_t)row * 512 + hd * 64 + d]) : bf2f(WSP(bf16_t, ws_off)[((size_t)(b * 2 + hd) * SEQ + sq) * 64 + d]);
    }
    if (!dbg_close(got, ref)) atomicAdd(cnt, 1u);
}
#endif


#if DBG_STOP >= 0
__device__ void dbg_check_nsa(Frame& F, unsigned* cnt) {
    const int lane = F.lane, gw = blockIdx.x * NWAVES + F.wave;
    LAS float* P = (LAS float*)(F.lds + F.wave * 2048);
    const unsigned hsh = dbg_hash(gw * 7 + 3);
    const int b = hsh & 7, hh = (hsh >> 3) & 7, g = hh >> 2;
    int t; { const int cls = gw & 7; const unsigned r = dbg_hash(gw * 13 + 5);
        t = cls == 0 ? (int)(r % 31) : cls == 1 ? 31 + (int)(r % 33) : cls == 2 ? 64 + (int)(r % 960) : cls == 3 ? 1024 + (int)(r % 64) : cls == 4 ? 4032 + (int)(r % 64) : 1024 + (int)(r % 3072); }
    const size_t row = (size_t)b * SEQ + t; const int bg = b * 2 + g, cur = t >> 6;
    const bf16_t* Kc = WSP(bf16_t, WS_KCMP) + (size_t)bg * 256 * 64; const bf16_t* Vc = WSP(bf16_t, WS_VCMP) + (size_t)bg * 256 * 64;
    const int lim = t >= 31 ? (t - 31) >> 4 : -1;
    float imp = 0.f, oc = 0.f;
    for (int hd = 0; hd < 4; ++hd) {
        const bf16_t* q = WSP(bf16_t, WS_NQ) + row * 512 + (4 * g + hd) * 64;
        float sc[4]; float mx = -INFINITY;
        for (int k = 0; k < 4; ++k) { const int i = lane + 64 * k; float s = 0.f; for (int d = 0; d < 64; ++d) s += bf2f(q[d]) * bf2f(Kc[(size_t)i * 64 + d]); sc[k] = (i <= lim) ? s : -INFINITY; mx = fmaxf(mx, sc[k]); }
        mx = wave_max(mx); const float mref = (mx == -INFINITY) ? 0.f : mx; float l = 0.f;
        for (int k = 0; k < 4; ++k) { sc[k] = ex2(sc[k] - mref); l += sc[k]; }
        l = wave_sum(l); const float il = 1.f / fmaxf(l, 1e-30f);
        for (int k = 0; k < 4; ++k) P[lane + 64 * k] = sc[k] * il;
        asm volatile("s_waitcnt lgkmcnt(0)" ::: "memory");
        { const int j = lane; float a = 0.f; for (int x = 0; x < 3; ++x) a += 2.f * P[4 * j + x]; a += P[4 * j + 3]; if (j > 0) a += P[4 * j - 1]; imp += a; }
        if (4 * g + hd == hh) { for (int i = 0; i < 255; ++i) oc += P[i] * bf2f(Vc[(size_t)i * 64 + lane]); }
        asm volatile("s_waitcnt lgkmcnt(0)" ::: "memory");
    }
    float score = imp; { const int j = lane; if (j == 0 || j == cur || j == cur - 1) score = INFINITY; else if (64 * j > t) score = -INFINITY; }
    int rank = 0; for (int j2 = 0; j2 < 64; ++j2) { const float s2 = __shfl(score, j2); rank += (s2 > score || (s2 == score && j2 < lane)) ? 1 : 0; }
    const unsigned long long selm = __ballot(rank < 16);
    const bf16_t* q = WSP(bf16_t, WS_NQ) + row * 512 + hh * 64;
    float os = 0.f, ow = 0.f;
    for (int br = 0; br < 2; ++br) {
        const bf16_t* K = WSP(bf16_t, br ? WS_KWN : WS_KSL) + (size_t)bg * SEQ * 64; const bf16_t* V = WSP(bf16_t, br ? WS_VWN : WS_VSL) + (size_t)bg * SEQ * 64;
        float m = -INFINITY, l = 0.f, o = 0.f;
        for (int j = 0; j < 64; ++j) {
            if (br == 0 && !((selm >> j) & 1ull)) continue;
            const int kp = 64 * j + lane; bool valid = kp <= t; if (br == 1) valid = valid && kp > t - 512;
            if (!__any(valid)) continue;
            float s = 0.f; for (int d = 0; d < 64; ++d) s += bf2f(q[d]) * bf2f(K[(size_t)kp * 64 + d]);
            s = valid ? s : -INFINITY;
            const float mn = fmaxf(m, wave_max(s)); const float alpha = (m == -INFINITY) ? 0.f : ex2(m - mn); const float pp = ex2(s - mn);
            l = l * alpha + wave_sum(pp); o *= alpha;
            for (int x = 0; x < 64; ++x) o += __shfl(pp, x) * bf2f(V[(size_t)(64 * j + x) * 64 + lane]);
            m = mn;
        }
        const float r = o / fmaxf(l, 1e-30f); if (br) ow = r; else os = r;
    }
    const float* gp = WSP(float, WS_NGT) + row * 24 + hh * 3;
    const float ref = gp[0] * oc + gp[1] * os + gp[2] * ow;
    const float got = bf2f(WSP(bf16_t, WS_YCAT)[row * 1024 + 512 + hh * 64 + lane]);
    const float sq = wave_sum(ref * ref); const float tol = 0.03f * fabsf(ref) + 0.03f * sqrtf(sq * (1.f / 64.f)) + 1e-4f;
    const bool bad = !(fabsf(got - ref) <= tol);
    if (__any(bad) && lane == 0) atomicAdd(cnt, 1u);
}
#endif


#if DBG_STOP >= 0
__device__ void dbg_check_mlstm(Frame& F, unsigned* cnt) {
    const int lane = F.lane, gw = blockIdx.x * NWAVES + F.wave;
    const unsigned hsh = dbg_hash(gw * 11 + 1);
    const int b = hsh & 7, h = (hsh >> 3) & 3;
    int t; { const int cls = gw & 7; const unsigned r = dbg_hash(gw * 17 + 9);
        t = cls == 0 ? (int)(r % 4) : cls == 1 ? 60 + (int)(r % 8) : cls == 2 ? 64 * (1 + (int)(r % 60)) + (int)((r >> 8) % 3) : cls == 3 ? 64 * (1 + (int)(r % 60)) + 63 : cls == 4 ? 4000 + (int)(r % 96) : (int)(r % 4096); }
    const int bh = b * 4 + h; const float* GI = WSP(float, WS_GI) + (size_t)bh * SEQ; const float* GF = WSP(float, WS_GF) + (size_t)bh * SEQ;
    const bf16_t* MQ = WSP(bf16_t, WS_MQ); const bf16_t* MK = WSP(bf16_t, WS_MK); const bf16_t* MV = WSP(bf16_t, WS_MV); const float* cw = IN_F(10);
    float carry = 0.f, M = 0.f, Bt = 0.f;
    for (int s0 = 0; s0 <= t; s0 += 64) { const int s = s0 + lane; float lf = (s <= t) ? GF[s] : 0.f;
        float bs = lf;
        for (int o = 1; o < 64; o <<= 1) { const float x = __shfl_up(bs, o); if (lane >= o) bs += x; }
        bs += carry; const float u = (s <= t) ? GI[s] - bs : -INFINITY; M = fmaxf(M, wave_max(u));
        if (s0 + 63 >= t) Bt = __shfl(bs, t - s0);
        carry = __shfl(bs, 63); }
    float q0 = 0.f, q1 = 0.f;
    for (int j = 0; j < 4; ++j) { const int ss = t - 3 + j; if (ss >= 0) { const bf16_t* rp = MQ + ((size_t)b * SEQ + ss) * 512 + h * 128;
        q0 += bf2f(rp[lane]) * cw[j * 1024 + h * 128 + lane]; q1 += bf2f(rp[64 + lane]) * cw[j * 1024 + h * 128 + 64 + lane]; } }
    q0 = dbg_bfr(silu_f(q0)); q1 = dbg_bfr(silu_f(q1));
    LAS float* QS = (LAS float*)(F.lds + F.wave * 2048); QS[lane] = q0; QS[64 + lane] = q1;
    asm volatile("s_waitcnt lgkmcnt(0)" ::: "memory");
    float n0 = 0.f, n1 = 0.f, den = 0.f; carry = 0.f;
    for (int s0 = 0; s0 <= t; s0 += 64) { const int s = s0 + lane; const bool act = s <= t; float lf = act ? GF[s] : 0.f;
        float bs = lf;
        for (int o = 1; o < 64; o <<= 1) { const float x = __shfl_up(bs, o); if (lane >= o) bs += x; }
        bs += carry; carry = __shfl(bs, 63);
        float c = 0.f;
        if (act) { float qk = 0.f;
            for (int ch = 0; ch < 128; ++ch) { float kc = 0.f;
                for (int j = 0; j < 4; ++j) { const int ss = s - 3 + j; if (ss >= 0) kc += bf2f(MK[((size_t)b * SEQ + ss) * 512 + h * 128 + ch]) * cw[j * 1024 + 512 + h * 128 + ch]; }
                qk += QS[ch] * dbg_bfr(silu_f(kc) * 0.08838834764831845f); }
            c = __expf(GI[s] - bs - M) * qk; }
        den += c;
        for (int x = 0; x < 64; ++x) { const float cx = __shfl(c, x); if (s0 + x <= t) { const bf16_t* vp = MV + ((size_t)b * SEQ + s0 + x) * 512 + h * 128; n0 += cx * bf2f(vp[lane]); n1 += cx * bf2f(vp[64 + lane]); } } }
    den = wave_sum(den);
    const float hd = fmaxf(fabsf(den), __expf(-(Bt + M)));
    const float h0 = n0 / hd, h1 = n1 / hd;
    const float rn = rsqrtf(wave_sum(h0 * h0 + h1 * h1) * (1.f / 128.f) + RMS_EPS);
    const size_t row = (size_t)b * SEQ + t; const bf16_t* mo = WSP(bf16_t, WS_MO) + row * 512 + h * 128; const float* hn = IN_F(12) + h * 128;
    const float r0 = h0 * rn * hn[lane] * sigmoid_f(bf2f(mo[lane])), r1 = h1 * rn * hn[64 + lane] * sigmoid_f(bf2f(mo[64 + lane]));
    const float g0 = bf2f(WSP(bf16_t, WS_YCAT)[row * 1024 + h * 128 + lane]), g1 = bf2f(WSP(bf16_t, WS_YCAT)[row * 1024 + h * 128 + 64 + lane]);
    const float rms = sqrtf(wave_sum(r0 * r0 + r1 * r1) * (1.f / 128.f));
    const bool bad = !(fabsf(g0 - r0) <= 0.04f * fabsf(r0) + 0.04f * rms + 1e-4f) || !(fabsf(g1 - r1) <= 0.04f * fabsf(r1) + 0.04f * rms + 1e-4f);
    if (__any(bad) && lane == 0) atomicAdd(cnt, 1u);
}
#endif


#if DBG_STOP >= 0
__device__ void dbg_check_cmp(Frame& F, unsigned* cnt) {
    const int lane = F.lane, gw = blockIdx.x * NWAVES + F.wave;
    const unsigned hsh = dbg_hash(gw * 5 + 2);
    const int kv = hsh & 1, bg = (hsh >> 1) & 15; int i = (hsh >> 5) % 255; if ((gw & 15) == 0) i = 254; if ((gw & 15) == 1) i = 0;
    const bf16_t* X = WSP(bf16_t, kv ? WS_VC : WS_KC) + (size_t)bg * SEQ * 64 + (size_t)i * 1024;
    const float* pe = IN_F(kv ? 16 : 13); const float* w1 = IN_F(kv ? 17 : 14); const float* w2 = IN_F(kv ? 18 : 15);
    float h0 = 0.f, h1 = 0.f;
    for (int k = 0; k < 2048; ++k) { const float xv = bf2f(X[k]) + pe[k]; h0 += xv * w1[(size_t)k * 128 + lane]; h1 += xv * w1[(size_t)k * 128 + 64 + lane]; }
    LAS float* H = (LAS float*)(F.lds + F.wave * 2048); H[lane] = silu_f(h0); H[64 + lane] = silu_f(h1);
    asm volatile("s_waitcnt lgkmcnt(0)" ::: "memory");
    float o = 0.f; for (int n = 0; n < 128; ++n) o += H[n] * w2[n * 64 + lane];
    const float got = bf2f(WSP(bf16_t, kv ? WS_VCMP : WS_KCMP)[((size_t)bg * 256 + i) * 64 + lane]);
    const float rms = sqrtf(wave_sum(o * o) * (1.f / 64.f));
    const bool bad = !(fabsf(got - o) <= 0.03f * fabsf(o) + 0.03f * rms + 1e-4f);
    if (__any(bad) && lane == 0) atomicAdd(cnt, 1u);
}
#endif

__device__ __forceinline__ bool phase_tid(Frame& F) { asm volatile("" : "+v"(F.tid)); F.lane = F.tid & 63; return true; }
constexpr int NPHASE = 11;
__global__ void __launch_bounds__(NTHR, 2) mega_fwd(Args args) {
    extern __shared__ __attribute__((aligned(16))) unsigned char lds_raw[];
    Frame F;
    F.lds = (LAS unsigned char*)lds_raw; F.in = args.in; F.out = args.out; F.ws = args.ws;
    F.tid = threadIdx.x; F.lane = F.tid & 63; F.wave = __builtin_amdgcn_readfirstlane(F.tid >> 6);
    F.G = gridDim.x; { const int bx = blockIdx.x; F.vcu = (F.G % 8 == 0) ? (bx % 8) * (F.G / 8) + bx / 8 : bx; }
    volatile LAS unsigned* MISC = (volatile LAS unsigned*)(F.lds + MISC_OFF);
    for (int u = F.tid; u < (LDS_BYTES - MISC_OFF) / 4; u += NTHR) ((LAS unsigned*)(F.lds + MISC_OFF))[u] = 0u;
    __syncthreads();
    unsigned* ctl = (unsigned*)(F.ws + WS_CTL);
    XcdBarrier bar; bar.bar = ctl + CW_BAR; bar.x = 0; bar.st = nullptr;
    const int lo = args.ph_lo, hi = args.ph_hi;
    if (hi - lo > 1) bar = xcd_barrier_post(ctl + CW_BAR, MISC + 8);
#ifndef PHASE_MASK
#define PHASE_MASK 0xFFFF
#endif
#define IN(k) (((PHASE_MASK >> (k)) & 1) && lo <= (k) && (k) < hi && (DBG_STOP < 0 || (k) <= DBG_STOP))
#define SEAM(k) do { if (IN(k) && IN((k) + 1)) xcd_barrier(bar); } while (0)
    LAS int* TST = (LAS int*)(F.lds + MISC_OFF + 256);
    LAS int* CNT = TST + 40;

#define PHASE_TID() if (phase_tid(F))
    if (IN(0)) PHASE_TID() _Pragma("nounroll") for (int rep = 0; rep <= ((REP_MASK >> 0) & 1); ++rep) { p0_phase(F); } SEAM(0);
    if (IN(1)) PHASE_TID() _Pragma("nounroll") for (int rep = 0; rep <= ((REP_MASK >> 1) & 1); ++rep) { p1a_phase(F); } SEAM(1);
    if (IN(2)) PHASE_TID() _Pragma("nounroll") for (int rep = 0; rep <= ((REP_MASK >> 2) & 1); ++rep) {
        pg8::DenseOrder S; S.init(NTOK, INWP, DM / 2, F.G, (int)blockIdx.x);
        EpiIn E{F.ws, IN_F(11), F.lds};
        pg8::gemm_phase<true>(F.lds, WSP(bf16_t, WS_H1), WSP(bf16_t, WS_WINT), DM / 2, S, E);
    } SEAM(2);
    if (IN(3)) PHASE_TID() _Pragma("nounroll") for (int rep = 0; rep <= ((REP_MASK >> 3) & 1); ++rep) {
        REPS(0) mlstm_a_phase(F);
        REPS(1) for (int j = F.vcu; j < 256; j += F.G) compress_job(F, j);
    } SEAM(3);
    if (IN(4)) PHASE_TID() _Pragma("nounroll") for (int rep = 0; rep <= ((REP_MASK >> 4) & 1); ++rep) {
        REPS(2) for (int j = F.vcu; j < 256; j += F.G) mlstm_scan_job(F, j);
        REPS(3) for (int u = F.vcu; u < 512; u += F.G) {
            const int bg = u >> 5, q = u & 31;
            _Pragma("nounroll") for (int hf = 0; hf < 2; ++hf) nsa_unit(F, bg >> 1, bg & 1, hf ? q : 63 - q);
        }
    } SEAM(4);
    if (IN(5)) PHASE_TID() _Pragma("nounroll") for (int rep = 0; rep <= ((REP_MASK >> 5) & 1); ++rep) {
        REPS(4) mlstm_c_phase(F);
        REPS(5) expert_convert(F);
    } SEAM(5);
    if (IN(6)) PHASE_TID() _Pragma("nounroll") for (int rep = 0; rep <= ((REP_MASK >> 6) & 1); ++rep) {
        pg8::DenseOrder S; S.init(NTOK, DM, DM, F.G, (int)blockIdx.x);
        EpiBf16 E{WSP(bf16_t, WS_Y), DM};
        pg8::gemm_phase<false>(F.lds, WSP(bf16_t, WS_YCAT), WSP(bf16_t, WS_WOUTT), DM, S, E);
    } SEAM(6);
    if (IN(7)) PHASE_TID() { s6_phase(F); } SEAM(7);
    if (IN(8)) PHASE_TID() _Pragma("nounroll") for (int rep = 0; rep <= ((REP_MASK >> 8) & 1); ++rep) {
        moe_tables(F, TST, CNT);
        pg8::MoeOrder S{TST, CNT, (const LAS unsigned char*)(TST + 96), WSP(int, WS_LIST), F.G, F.vcu, DM / 2, true};
        EpiUpI8 E{WSP(bf16_t, WS_HB), WSP(float, WS_SAL), WSP(float, WS_SB13), TST, F.lds};
        pg8::gemm_phase<true>(F.lds, WSP(bf16_t, WS_H2Q), WSP(bf16_t, WS_W13T), DM / 2, S, E);
        {
            const int U = TST[32] * 4, full = U / F.G, rem = U % F.G;
            if (rem == 0) w2_convert(F, F.vcu, F.G); else if (F.vcu >= rem) w2_convert(F, F.vcu - rem, F.G - rem);
            (void)full; }
    } SEAM(8);
    if (IN(9)) PHASE_TID() _Pragma("nounroll") for (int rep = 0; rep <= ((REP_MASK >> 9) & 1); ++rep) {
        moe_tables(F, TST, CNT);
        pg8::MoeOrder S{TST, CNT, (const LAS unsigned char*)(TST + 96), WSP(int, WS_LIST), F.G, F.vcu, EFF, false};
        EpiBf16 E{WSP(bf16_t, WS_YB), DM};
        pg8::gemm_phase<false>(F.lds, WSP(bf16_t, WS_HB), WSP(bf16_t, WS_W2T), EFF, S, E);
    } SEAM(9);
    if (IN(10)) PHASE_TID() { moe_tables(F, TST, CNT); s10_phase(F, TST); }
#if DBG_STOP >= 0
    xcd_barrier(bar);
#if DBG_CHECK == 1 || DBG_CHECK == 3 || DBG_CHECK == 4 || DBG_CHECK == 5
    { unsigned* cw = (unsigned*)(F.ws + WS_CTL) + CW_DBG + 1; if (DBG_CHECK == 1) dbg_check_p1(F, cw); else if (DBG_CHECK == 3) dbg_check_nsa(F, cw); else if (DBG_CHECK == 4) dbg_check_mlstm(F, cw); else dbg_check_cmp(F, cw); xcd_barrier(bar);
      const unsigned nb = __hip_atomic_load(cw, __ATOMIC_RELAXED, __HIP_MEMORY_SCOPE_AGENT);
      const float sc = nb == 0 ? 1.f : nb < 4 ? 2.f : nb < 16 ? 3.f : nb < 64 ? 4.f : nb < 256 ? 5.f : nb < 1024 ? 6.f : 7.f;
      const float* x = IN_F(0); for (size_t k = (size_t)blockIdx.x * NTHR + F.tid; k < (size_t)NTOK * DM; k += (size_t)F.G * NTHR) F.out[k] = x[k] * sc; }
#elif DBG_CHECK == 2
    { const unsigned id = __hip_atomic_load((unsigned*)(F.ws + WS_CTL) + CW_DBG, __ATOMIC_RELAXED, __HIP_MEMORY_SCOPE_AGENT);
      float sc = (id >= 1000u) ? 1.f : 1.f + (float)id;
      if (__hip_atomic_load((unsigned*)(F.ws + WS_CTL) + CW_BAR + XB_TMO, __ATOMIC_RELAXED, __HIP_MEMORY_SCOPE_AGENT) != 0u) sc = 61.f;
      const float* x = IN_F(0); for (size_t k = (size_t)blockIdx.x * NTHR + F.tid; k < (size_t)NTOK * DM; k += (size_t)F.G * NTHR) F.out[k] = x[k] * sc; }
#else
    dbg_phase(F, bar);
#endif
#endif
#undef IN
#undef SEAM
}

extern "C" void kernel_launch(void* const* d_in, const int* in_sizes, int n_in, void* d_out, int out_size, void* d_ws, size_t ws_size, hipStream_t stream) {
    static int grid = 0;
    if (grid == 0) {
        int dev = 0, cus = 0;
        if (hipGetDevice(&dev) != hipSuccess || hipDeviceGetAttribute(&cus, hipDeviceAttributeMultiprocessorCount, dev) != hipSuccess) cus = 256;
        if (hipFuncSetAttribute((const void*)mega_fwd, hipFuncAttributeMaxDynamicSharedMemorySize, LDS_BYTES) != hipSuccess) fprintf(stderr, "kernel_launch: hipFuncSetAttribute failed\n");
        (void)hipGetLastError();
        grid = cus > 0 ? cus : 256;
        if (n_in != 27 || ws_size < WS_END) fprintf(stderr, "kernel_launch: unexpected n_in %d / ws_size %zu (need %zu)\n", n_in, ws_size, (size_t)WS_END);
    }
    (void)hipMemsetAsync((char*)d_ws + WS_CTL, 0, 64 * 1024, stream);
#if DBG_STOP >= 0
    (void)hipMemsetAsync((char*)d_ws + WS_CTL + CW_DBG * 4, 0x7F, 4, stream);
#endif
    Args a{};
    for (int i = 0; i < 27; ++i) a.in[i] = d_in[i];
    a.out = (float*)d_out; a.ws = (unsigned char*)d_ws;
#if MK_N_LAUNCHES == 1
    a.ph_lo = 0; a.ph_hi = NPHASE;
    hipLaunchKernelGGL(mega_fwd, dim3(grid), dim3(NTHR), LDS_BYTES, stream, a);
#else
    for (int p = 0; p < NPHASE; ++p) { a.ph_lo = p; a.ph_hi = p + 1; hipLaunchKernelGGL(mega_fwd, dim3(grid), dim3(NTHR), LDS_BYTES, stream, a); }
#endif
}
```

```cpp
#include <hip/hip_runtime.h>
#include <cstdio>
#include <cstdint>
#include <type_traits>

#define LAS __attribute__((address_space(3)))
typedef unsigned short bf16_t;
typedef short bf16x8 __attribute__((ext_vector_type(8)));
typedef short s16x4 __attribute__((ext_vector_type(4)));
typedef float f32x4 __attribute__((ext_vector_type(4)));
typedef float f32x16 __attribute__((ext_vector_type(16)));
typedef unsigned u32x4 __attribute__((ext_vector_type(4)));
typedef unsigned u32x2 __attribute__((ext_vector_type(2)));
typedef int i32x4 __attribute__((ext_vector_type(4)));
typedef _Float16 f16x8 __attribute__((ext_vector_type(8)));
typedef _Float16 f16x4 __attribute__((ext_vector_type(4)));

#ifndef MK_N_LAUNCHES
#define MK_N_LAUNCHES 1
#endif
#ifndef DBG_CHECK
#define DBG_CHECK 0
#endif
#ifndef REP_MASK
#define REP_MASK 0
#endif
#ifndef REP_SUB
#define REP_SUB 0
#endif
#ifndef NSA_DUP
#define NSA_DUP 0
#endif
#define NDUP(b) _Pragma("nounroll") for (int nd_ = 0; nd_ <= ((NSA_DUP >> (b)) & 1); ++nd_)
#define REPS(b) _Pragma("nounroll") for (int rs_ = 0; rs_ <= ((REP_SUB >> (b)) & 1); ++rs_)

constexpr int NB = 8, SEQ = 4096, DM = 1024, NTOK = NB * SEQ;
constexpr int MH = 4, MDH = 128;
constexpr int NHD = 8, NGRP = 2;
constexpr int INW = 3360, INWP = 3584;
constexpr int NEXP = 32, EFF = 512;
constexpr float RMS_EPS = 1e-6f;
constexpr float QSCALE = 0.125f * 1.4426950408889634f;
constexpr int NWAVES = 8, NTHR = 512;
constexpr int LDS_BYTES = 160 * 1024, MISC_OFF = 128 * 1024;
constexpr int MAXROWS = 73728;

constexpr size_t MiB = 1ull << 20, KiB = 1024;
constexpr size_t WS_CTL   = 0;
constexpr size_t WS_MOD   = 64 * KiB;
constexpr size_t WS_C1B   = WS_MOD + 192 * KiB;
constexpr size_t WS_GI    = WS_C1B + 4 * KiB;
constexpr size_t WS_GF    = WS_GI + 512 * KiB;
constexpr size_t WS_NGT   = WS_GF + 512 * KiB;
constexpr size_t WS_GSUM  = WS_NGT + 3 * MiB;
constexpr size_t WS_MLOC  = WS_GSUM + 8 * KiB;
constexpr size_t WS_MPREV = WS_MLOC + 8 * KiB;
constexpr size_t WS_NC    = WS_MPREV + 8 * KiB;
constexpr size_t WS_NPREV = WS_NC + 1 * MiB;
constexpr size_t WS_COS   = WS_NPREV + 1 * MiB;
constexpr size_t WS_SIN   = WS_COS + 4 * MiB;
constexpr size_t WS_WOUTT = WS_SIN + 4 * MiB;
constexpr size_t WS_CW1K  = WS_WOUTT + 2 * MiB;
constexpr size_t WS_CW1V  = WS_CW1K + 512 * KiB;
constexpr size_t WS_CW2K  = WS_CW1V + 512 * KiB;
constexpr size_t WS_CW2V  = WS_CW2K + 16 * KiB;
constexpr size_t WS_RWT   = WS_CW2V + 16 * KiB;
constexpr size_t WS_RWL   = WS_RWT + 96 * KiB;
constexpr size_t WS_KCMP  = WS_RWL + 96 * KiB;
constexpr size_t WS_VCMP  = WS_KCMP + 512 * KiB;
constexpr size_t WS_TOKE  = WS_VCMP + 512 * KiB;
constexpr size_t WS_TOKP  = WS_TOKE + 256 * KiB;
constexpr size_t WS_TOKG  = WS_TOKP + 256 * KiB;
constexpr size_t WS_LIST  = WS_TOKG + 256 * KiB;
constexpr size_t WS_SA    = WS_LIST + 8 * MiB;
constexpr size_t WS_SB13  = WS_SA + 128 * KiB;
constexpr size_t WS_SA1   = WS_SB13 + 128 * KiB;
constexpr size_t WS_SBW   = WS_SA1 + 128 * KiB;
constexpr size_t WS_SMALL_END = WS_SBW + 16 * KiB;
static_assert(WS_SMALL_END <= 32 * MiB, "small region overflow");
constexpr size_t WS_A     = 32 * MiB;
constexpr size_t WS_H1    = WS_A, WS_KVC = WS_A, WS_W13T = WS_A;
constexpr size_t WS_NQ    = 96 * MiB;
constexpr size_t WS_KC    = 128 * MiB, WS_VC = 136 * MiB, WS_KSL = 144 * MiB, WS_VSL = 152 * MiB, WS_KWN = 160 * MiB, WS_VWN = 168 * MiB;
constexpr size_t WS_W2T   = 96 * MiB;
constexpr size_t WS_MQ    = 176 * MiB, WS_MK = 208 * MiB, WS_MV = 240 * MiB, WS_MO = 272 * MiB;
constexpr size_t WS_Y     = 176 * MiB;
constexpr size_t WS_H2    = 240 * MiB;
constexpr size_t WS_CPREV = 304 * MiB;
constexpr size_t WS_WINT  = 304 * MiB;
constexpr size_t WS_HB    = 304 * MiB;
constexpr size_t WS_H2LO  = 304 * MiB;
constexpr size_t WS_YCAT  = 376 * MiB;
constexpr size_t WS_X1B   = 376 * MiB;
constexpr size_t WS_YB    = 128 * MiB;
constexpr size_t WS_H2Q   = 128 * MiB;
constexpr size_t WS_SAL   = 440 * MiB;
constexpr size_t WS_END   = 448 * MiB;

constexpr int CW_BAR = 0;
constexpr int CW_CNT = 4096;
constexpr int CW_DBG = 4200;

typedef __bf16 bf16x2_t __attribute__((ext_vector_type(2)));
typedef float f32x2_t __attribute__((ext_vector_type(2)));
__device__ __forceinline__ unsigned cvtpk(float lo, float hi) { const f32x2_t f = {lo, hi}; const bf16x2_t v = __builtin_convertvector(f, bf16x2_t); return __builtin_bit_cast(unsigned, v); }
__device__ __forceinline__ float bf2f(bf16_t b) { return __uint_as_float(((unsigned)b) << 16); }
__device__ __forceinline__ float bflo(unsigned w) { return __uint_as_float(w << 16); }
__device__ __forceinline__ float bfhi(unsigned w) { return __uint_as_float(w & 0xffff0000u); }
__device__ __forceinline__ bf16_t f2bf(float f) { return (bf16_t)(cvtpk(f, 0.f) & 0xffffu); }
__device__ __forceinline__ float wave_sum(float v) {
#pragma unroll
    for (int o = 1; o < 64; o <<= 1) v += __shfl_xor(v, o);
    return v;
}
__device__ __forceinline__ float wave_max(float v) {
#pragma unroll
    for (int o = 1; o < 64; o <<= 1) v = fmaxf(v, __shfl_xor(v, o));
    return v;
}
__device__ __forceinline__ float sigmoid_f(float x) { return __builtin_amdgcn_rcpf(1.f + __builtin_amdgcn_exp2f(-1.4426950408889634f * x)); }
__device__ __forceinline__ float silu_f(float x) { return x * __builtin_amdgcn_rcpf(1.f + __builtin_amdgcn_exp2f(-1.4426950408889634f * x)); }
__device__ __forceinline__ float logsigmoid_f(float x) { return fminf(x, 0.f) - __logf(1.f + __expf(-fabsf(x))); }
__device__ __forceinline__ float ex2(float x) { return __builtin_amdgcn_exp2f(x); }
#define MFMA32(a, b, c) __builtin_amdgcn_mfma_f32_32x32x16_bf16(a, b, c, 0, 0, 0)
#define MFMA16(a, b, c) __builtin_amdgcn_mfma_f32_16x16x32_bf16(a, b, c, 0, 0, 0)
typedef short v4i16_t __attribute__((ext_vector_type(4)));
__device__ __forceinline__ s16x4 vtr(LAS const unsigned char* p) { return __builtin_bit_cast(s16x4, __builtin_amdgcn_ds_read_tr16_b64_v4i16((LAS v4i16_t*)p)); }
__device__ __forceinline__ int crow(int r, int hi) { return (r & 3) + 8 * (r >> 2) + 4 * hi; }
__device__ __forceinline__ u32x4 widen_pair(u32x2 A, u32x2 B) {
    const auto r0 = __builtin_amdgcn_permlane32_swap(A.x, B.x, false, false); const auto r1 = __builtin_amdgcn_permlane32_swap(A.y, B.y, false, false);
    return (u32x4){r0[0], r1[0], r0[1], r1[1]}; }
__device__ __forceinline__ u32x4 widen_rows16(u32x2 X, u32x2 Y) {
    const auto r0 = __builtin_amdgcn_permlane16_swap(X.x, Y.x, false, false); const auto r1 = __builtin_amdgcn_permlane16_swap(X.y, Y.y, false, false);
    return (u32x4){r0[0], r1[0], r0[1], r1[1]}; }
__device__ __forceinline__ u32x4 quad_transpose(u32x4 d, int lane) {
    const bool b0 = lane & 1, b1 = lane & 2;
    { const unsigned t0 = b0 ? d.x : d.y, t1 = b0 ? d.z : d.w;
      const unsigned r0 = (unsigned)__builtin_amdgcn_mov_dpp((int)t0, 0xB1, 0xF, 0xF, true), r1 = (unsigned)__builtin_amdgcn_mov_dpp((int)t1, 0xB1, 0xF, 0xF, true);
      if (b0) { d.x = r0; d.z = r1; } else { d.y = r0; d.w = r1; } }
    { const unsigned t0 = b1 ? d.x : d.z, t1 = b1 ? d.y : d.w;
      const unsigned r0 = (unsigned)__builtin_amdgcn_mov_dpp((int)t0, 0x4E, 0xF, 0xF, true), r1 = (unsigned)__builtin_amdgcn_mov_dpp((int)t1, 0x4E, 0xF, 0xF, true);
      if (b1) { d.x = r0; d.y = r1; } else { d.z = r0; d.w = r1; } }
    return d; }
__device__ __forceinline__ u32x4 pair_widen(u32x2 A, u32x2 B, int lane) {
    const bool od = lane & 1; const u32x2 t = od ? A : B;
    u32x2 r; r.x = (unsigned)__builtin_amdgcn_mov_dpp((int)t.x, 0xB1, 0xF, 0xF, true); r.y = (unsigned)__builtin_amdgcn_mov_dpp((int)t.y, 0xB1, 0xF, 0xF, true);
    return od ? (u32x4){r.x, r.y, B.x, B.y} : (u32x4){A.x, A.y, r.x, r.y}; }
__device__ __forceinline__ void pair_narrow(u32x4 v, int lane, u32x2& A, u32x2& B) {
    const bool od = lane & 1; const u32x2 lo = {v.x, v.y}, hi = {v.z, v.w}; const u32x2 t = od ? lo : hi;
    u32x2 r; r.x = (unsigned)__builtin_amdgcn_mov_dpp((int)t.x, 0xB1, 0xF, 0xF, true); r.y = (unsigned)__builtin_amdgcn_mov_dpp((int)t.y, 0xB1, 0xF, 0xF, true);
    A = od ? r : lo; B = od ? hi : r; }
__device__ __forceinline__ bf16x8 mk8(s16x4 lo, s16x4 hi) { return (bf16x8){lo[0], lo[1], lo[2], lo[3], hi[0], hi[1], hi[2], hi[3]}; }

#define XB_TMO      128
#define XB_XCNT(j)  (256  + 64 * (j))
#define XB_XSUB(j)  (1280 + 64 * (j))
#define XB_XGEN(j)  (2304 + 64 * (j))
#define XB_TOP      3328
#define XB_TOPGEN   3392
#define XCD_BAR_WORDS 3456
#define XB_SPIN_CAP (1u << 18)
__device__ __forceinline__ unsigned xb_ld(unsigned* p)              { return __hip_atomic_load(p, __ATOMIC_RELAXED, __HIP_MEMORY_SCOPE_AGENT); }
__device__ __forceinline__ unsigned xb_add(unsigned* p, unsigned v) { return __hip_atomic_fetch_add(p, v, __ATOMIC_RELAXED, __HIP_MEMORY_SCOPE_AGENT); }
__device__ __forceinline__ unsigned xb_xcc_id() { return (unsigned)__builtin_amdgcn_s_getreg((3 << 11) | 20) & 0xFu; }
#define XB_SPIN(cond, bar) do { unsigned _sp = 0; while (cond) { __builtin_amdgcn_s_sleep(1); \
    if ((++_sp & 255u) == 0u) { if (xb_ld(&(bar)[XB_TMO])) break; if (_sp > XB_SPIN_CAP) { atomicAdd(&(bar)[XB_TMO], 1u); break; } } } } while (0)
struct XcdBarrier { unsigned* bar; unsigned x; volatile LAS unsigned* st; };
__device__ __forceinline__ XcdBarrier xcd_barrier_post(unsigned* bar, volatile LAS unsigned* st) {
    XcdBarrier b; b.bar = bar; b.x = xb_xcc_id(); b.st = st;
    if (threadIdx.x == 0) (void)xb_add(&bar[XB_XCNT(b.x)], 1u);
    return b;
}
__device__ __forceinline__ void xcd_barrier_complete(unsigned* bar, unsigned x, unsigned& nloc, unsigned& nx) {
    const unsigned G = gridDim.x * gridDim.y * gridDim.z;
    unsigned sum, cnt, mine, sp = 0u;
    for (;;) {
        sum = 0u; cnt = 0u; mine = 0u;
#pragma unroll
        for (unsigned j = 0; j < 16; ++j) { const unsigned c = xb_ld(&bar[XB_XCNT(j)]); sum += c; cnt += (c > 0u) ? 1u : 0u; mine = (j == x) ? c : mine; }
        if (sum == G) break;
        __builtin_amdgcn_s_sleep(1);
        if ((++sp & 255u) == 0u) { if (xb_ld(&bar[XB_TMO])) break; if (sp > XB_SPIN_CAP) { atomicAdd(&bar[XB_TMO], 1u); break; } }
    }
    nloc = mine > 0u ? mine : 1u; nx = cnt > 0u ? cnt : 1u;
}
__device__ __forceinline__ void xcd_barrier(const XcdBarrier& b) {
    asm volatile("s_waitcnt vmcnt(0)" ::: "memory");
    __syncthreads();
    if (threadIdx.x == 0) {
        unsigned* bar = b.bar;
        __builtin_amdgcn_s_waitcnt(0);
        unsigned nloc = b.st[0], nx = b.st[1];
        if (nloc == 0u) { xcd_barrier_complete(bar, b.x, nloc, nx); b.st[0] = nloc; b.st[1] = nx; }
        const unsigned old = xb_add(&bar[XB_XSUB(b.x)], 1u);
        const unsigned gen = old / nloc;
        if (old + 1u == (gen + 1u) * nloc) {
            __builtin_amdgcn_fence(__ATOMIC_RELEASE, "agent");
            asm volatile("s_waitcnt vmcnt(0)" ::: "memory");
            const unsigned og = xb_add(&bar[XB_TOP], 1u);
            const unsigned tg = og / nx;
            if (og + 1u == (tg + 1u) * nx) xb_add(&bar[XB_TOPGEN], 1u);
            else XB_SPIN(xb_ld(&bar[XB_TOPGEN]) == tg, bar);
            __builtin_amdgcn_fence(__ATOMIC_ACQUIRE, "agent");
            xb_add(&bar[XB_XGEN(b.x)], 1u);
            asm volatile("s_waitcnt vmcnt(0)" ::: "memory");
        } else {
            XB_SPIN(xb_ld(&bar[XB_XGEN(b.x)]) == gen, bar);
            __builtin_amdgcn_fence(__ATOMIC_ACQUIRE, "agent");
            asm volatile("s_waitcnt vmcnt(0)" ::: "memory");
        }
    }
    __syncthreads();
}

struct Args { const void* in[27]; float* out; unsigned char* ws; int ph_lo, ph_hi; };
struct Frame {
    LAS unsigned char* lds;
    const void* const* in; float* out; unsigned char* ws;
    int tid, lane, wave, vcu, G;
};
#define IN_F(k) ((const float*)F.in[k])
#define WSP(T, off) ((T*)(F.ws + (off)))

namespace pg8 {
constexpr int BM = 256, BK = 64, HALF = 128, HTB = HALF * BK * 2, STAGE_BYTES = 8 * HTB, NXCD = 8, WGM = 8;
__host__ __device__ __forceinline__ int lds_byte(int r, int c) { const int st = (r >> 4) * 2 + (c >> 5), rr = r & 15, cc = c & 31, ob = rr * 64 + cc * 2; return st * 1024 + (ob ^ (((ob >> 9) & 1) << 5)); }
__host__ __device__ __forceinline__ void stage_rc(int b, int& R, int& C) { const int st = b / 1024, sb = b % 1024, swz = sb ^ (((sb >> 9) & 1) << 5); R = (st >> 1) * 16 + swz / 64; C = (st & 1) * 32 + (swz % 64) / 2; }
__host__ __device__ __forceinline__ int perm32(int rho) { const int n = rho >> 4, i = rho & 15; return 8 * (i >> 2) + 4 * n + (i & 3); }
struct Unit { int pm, pn, e, nrow; };

template <bool I8, class Epi, class Sched>
__device__ __forceinline__ void gemm_phase(LAS unsigned char* lds, const void* Abase, const void* Bbase, const int K, const Sched& S, const Epi& E) {
    const int tid = threadIdx.x, wid = __builtin_amdgcn_readfirstlane(tid >> 6), lane = tid & 63, wr = wid >> 2, wc = wid & 3, fr = lane & 15, fq = lane >> 4;
    const int nt = K / BK;
    int Rr[2], Cc[2]; unsigned voffB[2];
#pragma unroll
    for (int i = 0; i < 2; ++i) { int R, C; stage_rc(tid * 16 + i * 8192, R, C); Rr[i] = R; Cc[i] = C; const int Rb = (R & ~31) + perm32(R & 31); voffB[i] = (unsigned)(Rb * K + C) * 2u; }
    const size_t kstep = (size_t)(BK * 2);
    const size_t hstepB = (size_t)HALF * K * 2;
    const unsigned ldsw = (unsigned)wid * 1024u;
    const int aoff = lds_byte(wr * 64 + fr, fq * 8), boff = lds_byte(wc * 32 + fr, fq * 8);
#define PG8_SA(b, h) (((b) * 2 + (h)) * HTB)
#define PG8_SB(b, h) ((4 + (b) * 2 + (h)) * HTB)
#define PG8_STAGEB(bufoff, gbase) do { _Pragma("unroll") for (int _i = 0; _i < 2; ++_i) \
        __builtin_amdgcn_global_load_lds((const unsigned*)((const char*)(gbase) + voffB[_i]), (LAS unsigned*)(lds + (bufoff) + ldsw + _i * 8192), 16, 0, 0); } while (0)
#define PG8_STAGEA(bufoff, o0, o1, ktb) do { const char* _p = (const char*)Abase + (ktb); \
        __builtin_amdgcn_global_load_lds((const unsigned*)(_p + (o0)), (LAS unsigned*)(lds + (bufoff) + ldsw), 16, 0, 0); \
        __builtin_amdgcn_global_load_lds((const unsigned*)(_p + (o1)), (LAS unsigned*)(lds + (bufoff) + ldsw + 8192), 16, 0, 0); } while (0)
#define PG8_LDA(dst, b, h) do { _Pragma("unroll") for (int m = 0; m < 4; ++m) _Pragma("unroll") for (int k = 0; k < 2; ++k) dst[m][k] = *(const LAS bf16x8*)(lds + PG8_SA(b, h) + aoff + m * 2048 + k * 1024); } while (0)
#define PG8_LDB(dst, b, h) do { _Pragma("unroll") for (int n = 0; n < 2; ++n) _Pragma("unroll") for (int k = 0; k < 2; ++k) dst[n][k] = *(const LAS bf16x8*)(lds + PG8_SB(b, h) + boff + n * 2048 + k * 1024); } while (0)
#define PG8_MMA(ai, bj, At, Bt) do { __builtin_amdgcn_s_setprio(1); _Pragma("unroll") for (int m = 0; m < 4; ++m) _Pragma("unroll") for (int n = 0; n < 2; ++n) _Pragma("unroll") for (int k = 0; k < 2; ++k) { \
        if constexpr (I8) acc[ai][bj][m][n] = __builtin_bit_cast(acc_t, __builtin_amdgcn_mfma_i32_16x16x64_i8(__builtin_bit_cast(i32x4, Bt[n][k]), __builtin_bit_cast(i32x4, At[m][k]), __builtin_bit_cast(i32x4, acc[ai][bj][m][n]), 0, 0, 0)); \
        else acc[ai][bj][m][n] = __builtin_bit_cast(acc_t, __builtin_amdgcn_mfma_f32_16x16x32_bf16(Bt[n][k], At[m][k], __builtin_bit_cast(f32x4, acc[ai][bj][m][n]), 0, 0, 0)); } __builtin_amdgcn_s_setprio(0); } while (0)
#define PG8_WAIT_V(n) asm volatile("s_waitcnt vmcnt(" #n ")" ::: "memory")
#define PG8_WAIT_L(n) asm volatile("s_waitcnt lgkmcnt(" #n ")" ::: "memory")
#define PG8_BAR __builtin_amdgcn_s_barrier()
#define PG8_SCHED __builtin_amdgcn_sched_barrier(0)
    Unit cur, nxt; int ui = 0;
    if (!S.next(0, cur)) return;
    using acc_t = typename std::conditional<I8, i32x4, f32x4>::type;
    acc_t acc[2][2][4][2];
#pragma unroll
    for (int a = 0; a < 2; ++a)
#pragma unroll
        for (int b = 0; b < 2; ++b)
#pragma unroll
            for (int m = 0; m < 4; ++m)
#pragma unroll
                for (int n = 0; n < 2; ++n) acc[a][b][m][n] = __builtin_bit_cast(acc_t, (u32x4){0u, 0u, 0u, 0u});
    bf16x8 At[4][2], B0[2][2], B1[2][2];
    unsigned oc00, oc01, oc10, oc11; int kn00, kn01, kn10, kn11;
    oc00 = S.a_conv(S.a_key(cur, Rr[0])) + Cc[0] * 2; oc01 = S.a_conv(S.a_key(cur, Rr[1])) + Cc[1] * 2; oc10 = S.a_conv(S.a_key(cur, HALF + Rr[0])) + Cc[0] * 2; oc11 = S.a_conv(S.a_key(cur, HALF + Rr[1])) + Cc[1] * 2;
    const char* cB = (const char*)Bbase + S.b_off(cur);
    PG8_STAGEB(PG8_SB(0, 0), cB); PG8_STAGEA(PG8_SA(0, 0), oc00, oc01, 0); PG8_STAGEB(PG8_SB(0, 1), cB + hstepB); PG8_STAGEA(PG8_SA(0, 1), oc10, oc11, 0);
    if (wr == 1) PG8_BAR;
    PG8_WAIT_V(4); PG8_BAR;
    PG8_STAGEB(PG8_SB(1, 0), cB + kstep); PG8_STAGEA(PG8_SA(1, 0), oc00, oc01, kstep); PG8_STAGEB(PG8_SB(1, 1), cB + hstepB + kstep);
    PG8_WAIT_V(6); PG8_BAR;
    for (;;) {
        E.pre(cur, lds, wid, lane, ui & 1);
        const bool has_next = S.next(ui + 1, nxt);
        const char* nB = cB;
        if (has_next) { kn00 = S.a_key(nxt, Rr[0]); kn01 = S.a_key(nxt, Rr[1]); kn10 = S.a_key(nxt, HALF + Rr[0]); kn11 = S.a_key(nxt, HALF + Rr[1]); nB = (const char*)Bbase + S.b_off(nxt); }
        else { kn00 = 0; kn01 = 0; kn10 = 0; kn11 = 0; }
        for (int t = 0; t < nt; t += 2) {
            const bool last = (t == nt - 2);
            const size_t k1 = (size_t)(t + 1) * kstep;
            const size_t k2 = last ? 0 : (size_t)(t + 2) * kstep, k3 = k2 + kstep;
            const unsigned o200 = (last && has_next) ? S.a_conv(kn00) + Cc[0] * 2 : oc00, o201 = (last && has_next) ? S.a_conv(kn01) + Cc[1] * 2 : oc01, o210 = (last && has_next) ? S.a_conv(kn10) + Cc[0] * 2 : oc10, o211 = (last && has_next) ? S.a_conv(kn11) + Cc[1] * 2 : oc11;
            const char* b2 = last ? nB : cB + (size_t)(t + 2) * kstep; const char* b3 = b2 + kstep;
            PG8_LDB(B0, 0, 0); PG8_SCHED; PG8_LDA(At, 0, 0); PG8_STAGEA(PG8_SA(1, 1), oc10, oc11, k1);
            PG8_WAIT_L(8); PG8_BAR; PG8_WAIT_L(0); PG8_MMA(0, 0, At, B0); PG8_BAR; PG8_SCHED;
            PG8_LDB(B1, 0, 1); PG8_STAGEB(PG8_SB(0, 0), b2);
            PG8_BAR; PG8_WAIT_L(0); PG8_MMA(0, 1, At, B1); PG8_BAR;
            PG8_LDA(At, 0, 1); PG8_STAGEA(PG8_SA(0, 0), o200, o201, k2);
            PG8_BAR; PG8_WAIT_L(0); PG8_MMA(1, 0, At, B0); PG8_BAR; PG8_SCHED;
            PG8_STAGEB(PG8_SB(0, 1), b2 + hstepB);
            PG8_WAIT_V(6); PG8_BAR; PG8_MMA(1, 1, At, B1); PG8_BAR;
            PG8_LDB(B0, 1, 0); PG8_SCHED; PG8_LDA(At, 1, 0); PG8_STAGEA(PG8_SA(0, 1), o210, o211, k2);
            PG8_WAIT_L(8); PG8_BAR; PG8_WAIT_L(0); PG8_MMA(0, 0, At, B0); PG8_BAR; PG8_SCHED;
            PG8_LDB(B1, 1, 1); PG8_STAGEB(PG8_SB(1, 0), b3);
            PG8_BAR; PG8_WAIT_L(0); PG8_MMA(0, 1, At, B1); PG8_BAR;
            PG8_LDA(At, 1, 1); PG8_STAGEA(PG8_SA(1, 0), o200, o201, k3);
            PG8_BAR; PG8_WAIT_L(0); PG8_MMA(1, 0, At, B0); PG8_BAR; PG8_SCHED;
            PG8_STAGEB(PG8_SB(1, 1), b3 + hstepB);
            PG8_WAIT_V(6); PG8_BAR; PG8_MMA(1, 1, At, B1); PG8_BAR;
        }
        E(acc, cur, wr, wc, fr, fq, ui & 1);
        if (!has_next) break;
#pragma unroll
        for (int a = 0; a < 2; ++a)
#pragma unroll
            for (int b = 0; b < 2; ++b)
#pragma unroll
                for (int m = 0; m < 4; ++m)
#pragma unroll
                    for (int n = 0; n < 2; ++n) acc[a][b][m][n] = __builtin_bit_cast(acc_t, (u32x4){0u, 0u, 0u, 0u});
        cur = nxt; cB = nB; oc00 = S.a_conv(kn00) + Cc[0] * 2; oc01 = S.a_conv(kn01) + Cc[1] * 2; oc10 = S.a_conv(kn10) + Cc[0] * 2; oc11 = S.a_conv(kn11) + Cc[1] * 2; ++ui;
    }
    PG8_WAIT_V(0);
    if (wr == 0) PG8_BAR;
    PG8_BAR;
#undef PG8_SA
#undef PG8_SB
#undef PG8_STAGEA
#undef PG8_STAGEB
#undef PG8_LDA
#undef PG8_LDB
#undef PG8_MMA
#undef PG8_WAIT_V
#undef PG8_WAIT_L
#undef PG8_BAR
#undef PG8_SCHED
}

struct DenseOrder {
    int nM, nN, nwg, G, c, K;
    __device__ void init(int M, int N, int K_, int G_, int c_) { nM = M / BM; nN = N / BM; nwg = nM * nN; G = G_; c = c_; K = K_; }
    __device__ __forceinline__ bool next(int i, Unit& u) const {
        const long L = (long)i * G + c; if (L >= nwg) return false;
        int wgid = (int)L; { const int q = nwg / NXCD, r = nwg % NXCD, xcd = wgid % NXCD, off = wgid / NXCD; wgid = (xcd < r ? xcd * (q + 1) : r * (q + 1) + (xcd - r) * q) + off; }
        const int nig = WGM * nN, gid = wgid / nig, fm = gid * WGM, gsz = (nM - fm) < WGM ? (nM - fm) : WGM;
        u.pm = fm + ((wgid % nig) % gsz); u.pn = (wgid % nig) / gsz; u.e = 0; u.nrow = 256; return true;
    }
    __device__ __forceinline__ int a_key(const Unit& u, int R) const { return u.pm * BM + R; }
    __device__ __forceinline__ unsigned a_conv(int key) const { return (unsigned)(key * K) * 2u; }
    __device__ __forceinline__ size_t b_off(const Unit& u) const { return (size_t)u.pn * BM * K * 2; }
};
struct MoeOrder {
    const LAS int* tstart; const LAS int* cnt; const LAS unsigned char* etile; const int* list; int G, c, K; bool gather;
    static constexpr int npn = 4;
    __device__ __forceinline__ bool next(int i, Unit& u) const {
        const int L = i * G + c; const int tt = tstart[32];
        if (L >= tt * npn) return false;
        const int tile = L / npn; u.pn = L % npn; u.pm = tile;
        const int e = etile[tile];
        u.e = e; u.nrow = cnt[e] - (tile - tstart[e]) * 256; return true;
    }
    __device__ __forceinline__ int a_key(const Unit& u, int R) const {
        if (gather) { const int mt = u.pm - tstart[u.e]; const int r = mt * 256 + R; return list[(size_t)u.e * 65536 + (R < u.nrow ? r : 0)]; }
        return u.pm * BM + R;
    }
    __device__ __forceinline__ unsigned a_conv(int key) const { return (unsigned)(key * K) * 2u; }
    __device__ __forceinline__ size_t b_off(const Unit& u) const { return ((size_t)u.e * 1024 + (size_t)u.pn * BM) * K * 2; }
};
}

constexpr int EPI_SC = MISC_OFF + 24576;
struct EpiIn {
    unsigned char* ws; const float* gate_b;
    __device__ __forceinline__ void pre(const pg8::Unit& u, LAS unsigned char* lds, int wid, int lane, int par) const {
        if (wid == 0) { __builtin_amdgcn_global_load_lds((const unsigned*)((const float*)(ws + WS_SA1) + u.pm * 256 + lane * 4), (LAS unsigned*)(lds + EPI_SC + par * 2048), 16, 0, 0);
                        __builtin_amdgcn_global_load_lds((const unsigned*)((const float*)(ws + WS_SBW) + u.pn * 256 + lane * 4), (LAS unsigned*)(lds + EPI_SC + par * 2048 + 1024), 16, 0, 0); } }
    LAS unsigned char* lds;
    __device__ __forceinline__ void operator()(const i32x4 (&acc)[2][2][4][2], const pg8::Unit& u, int wr, int wc, int fr, int fq, int par) const {
        asm volatile("" : "+v"(fr), "+v"(fq));
        const int pn = u.pn, row0 = u.pm * 256 + wr * 64 + fr;
        float sa[2][4]; f32x4 sb[2][2];
        { LAS const float* SA1 = (LAS const float*)(lds + EPI_SC + par * 2048); LAS const float* SBW = SA1 + 256;
#pragma unroll
          for (int ai = 0; ai < 2; ++ai)
#pragma unroll
              for (int m = 0; m < 4; ++m) sa[ai][m] = SA1[wr * 64 + fr + ai * 128 + m * 16];
#pragma unroll
          for (int bj = 0; bj < 2; ++bj)
#pragma unroll
              for (int n = 0; n < 2; ++n) sb[bj][n] = *(LAS const f32x4*)(SBW + bj * 128 + wc * 32 + 8 * fq + 4 * n); }
#define ACCF(ai, bj, m, n) (__builtin_convertvector(acc[ai][bj][m][n], f32x4) * sa[ai][m] * sb[bj][n])
        if (pn < 8) {
            bf16_t* dst = (bf16_t*)(ws + (pn < 2 ? WS_MQ : pn < 4 ? WS_MK : pn < 6 ? WS_MV : WS_MO));
            const int col0 = (pn & 1) * 256 + wc * 32 + 8 * fq;
#pragma unroll
            for (int ai = 0; ai < 2; ++ai)
#pragma unroll
                for (int m = 0; m < 4; ++m) { bf16_t* rp = dst + (size_t)(row0 + ai * 128 + m * 16) * 512 + col0;
#pragma unroll
                    for (int bj = 0; bj < 2; ++bj) { const f32x4 v0 = ACCF(ai, bj, m, 0), v1 = ACCF(ai, bj, m, 1);
                        u32x4 w; w.x = cvtpk(v0[0], v0[1]); w.y = cvtpk(v0[2], v0[3]); w.z = cvtpk(v1[0], v1[1]); w.w = cvtpk(v1[2], v1[3]);
                        *(u32x4*)(rp + bj * 128) = w; } }
        } else if (pn < 10) {
            const int g8 = 4 * (wc & 1) + fq; const float* COS = (const float*)(ws + WS_COS); const float* SIN = (const float*)(ws + WS_SIN); bf16_t* NQ = (bf16_t*)(ws + WS_NQ);
#pragma unroll
            for (int ai = 0; ai < 2; ++ai)
#pragma unroll
                for (int m = 0; m < 4; ++m) { const int row = row0 + ai * 128 + m * 16;
                    const f32x4 cs = *(const f32x4*)(COS + (size_t)row * 32 + 4 * g8), sn = *(const f32x4*)(SIN + (size_t)row * 32 + 4 * g8);
#pragma unroll
                    for (int bj = 0; bj < 2; ++bj) { const int head = (pn - 8) * 4 + bj * 2 + (wc >> 1);
                        const f32x4 x1 = ACCF(ai, bj, m, 0), x2 = ACCF(ai, bj, m, 1);
                        const f32x4 o1 = (x1 * cs - x2 * sn) * QSCALE, o2 = (x2 * cs + x1 * sn) * QSCALE;
                        bf16_t* rp = NQ + (size_t)row * 512 + head * 64 + 4 * (g8 & ~1) + 32 * (fq & 1);
                        u32x2 a; a.x = cvtpk(o1[0], o1[1]); a.y = cvtpk(o1[2], o1[3]);
                        u32x2 b; b.x = cvtpk(o2[0], o2[1]); b.y = cvtpk(o2[2], o2[3]); *(u32x4*)rp = widen_rows16(a, b); } }
        } else if (pn < 13) {
            bf16_t* kd = (bf16_t*)(ws + (pn == 10 ? WS_KC : pn == 11 ? WS_KSL : WS_KWN)); bf16_t* vd = (bf16_t*)(ws + (pn == 10 ? WS_VC : pn == 11 ? WS_VSL : WS_VWN));
            const float* COS = (const float*)(ws + WS_COS); const float* SIN = (const float*)(ws + WS_SIN);
            const int g8 = 4 * (wc & 1) + fq, grp = wc >> 1;
#pragma unroll
            for (int ai = 0; ai < 2; ++ai)
#pragma unroll
                for (int m = 0; m < 4; ++m) { const int row = row0 + ai * 128 + m * 16; const int b = row >> 12, s = row & 4095;
                    const f32x4 cs = *(const f32x4*)(COS + (size_t)row * 32 + 4 * g8), sn = *(const f32x4*)(SIN + (size_t)row * 32 + 4 * g8);
                    const size_t rbase = ((size_t)(b * 2 + grp) * SEQ + s) * 64;
                    { const f32x4 x1 = ACCF(ai, 0, m, 0), x2 = ACCF(ai, 0, m, 1);
                      const f32x4 o1 = x1 * cs - x2 * sn, o2 = x2 * cs + x1 * sn;
                      bf16_t* rp = kd + rbase + 4 * (g8 & ~1) + 32 * (fq & 1);
                      u32x2 a; a.x = cvtpk(o1[0], o1[1]); a.y = cvtpk(o1[2], o1[3]);
                      u32x2 c; c.x = cvtpk(o2[0], o2[1]); c.y = cvtpk(o2[2], o2[3]); *(u32x4*)rp = widen_rows16(a, c); }
                    { const f32x4 v0 = ACCF(ai, 1, m, 0), v1 = ACCF(ai, 1, m, 1);
                      u32x4 w; w.x = cvtpk(v0[0], v0[1]); w.y = cvtpk(v0[2], v0[3]); w.z = cvtpk(v1[0], v1[1]); w.w = cvtpk(v1[2], v1[3]);
                      *(u32x4*)(vd + rbase + (wc & 1) * 32 + 8 * fq) = w; } }
        } else {
            if (wc == 0) { float* GI = (float*)(ws + WS_GI); float* GF = (float*)(ws + WS_GF); float* NGT = (float*)(ws + WS_NGT);
#pragma unroll
                for (int ai = 0; ai < 2; ++ai)
#pragma unroll
                    for (int m = 0; m < 4; ++m) { const int row = row0 + ai * 128 + m * 16; const int b = row >> 12, s = row & 4095;
#pragma unroll
                        for (int n = 0; n < 2; ++n) { const f32x4 v = ACCF(ai, 0, m, n);
                            if (fq == 0) {
#pragma unroll
                                for (int i = 0; i < 4; ++i) { const float z = v[i] + gate_b[4 * n + i];
                                    if (n == 0) GI[(size_t)(b * 4 + i) * SEQ + s] = z; else GF[(size_t)(b * 4 + i) * SEQ + s] = logsigmoid_f(z); }
                            } else {
                                f32x4 o; o[0] = sigmoid_f(v[0]); o[1] = sigmoid_f(v[1]); o[2] = sigmoid_f(v[2]); o[3] = sigmoid_f(v[3]);
                                *(f32x4*)(NGT + (size_t)row * 24 + 8 * fq + 4 * n - 8) = o; } } }
            }
        }
    }
};
#undef ACCF
struct EpiBf16 {
    bf16_t* O; int ldc;
    __device__ __forceinline__ void pre(const pg8::Unit&, LAS unsigned char*, int, int, int) const {}
    __device__ __forceinline__ void operator()(const f32x4 (&acc)[2][2][4][2], const pg8::Unit& u, int wr, int wc, int fr, int fq, int par) const {
        asm volatile("" : "+v"(fr), "+v"(fq));
        const int row0 = u.pm * 256 + wr * 64 + fr, col0 = u.pn * 256 + wc * 32 + 8 * fq;
#pragma unroll
        for (int ai = 0; ai < 2; ++ai)
#pragma unroll
            for (int m = 0; m < 4; ++m) { bf16_t* rp = O + (size_t)(row0 + ai * 128 + m * 16) * ldc + col0;
#pragma unroll
                for (int bj = 0; bj < 2; ++bj) { const f32x4 v0 = acc[ai][bj][m][0], v1 = acc[ai][bj][m][1];
                    u32x4 w; w.x = cvtpk(v0[0], v0[1]); w.y = cvtpk(v0[2], v0[3]); w.z = cvtpk(v1[0], v1[1]); w.w = cvtpk(v1[2], v1[3]);
                    *(u32x4*)(rp + bj * 128) = w; } }
    }
};
struct EpiUp {
    bf16_t* HB;
    __device__ __forceinline__ void pre(const pg8::Unit&, LAS unsigned char*, int, int, int) const {}
    __device__ __forceinline__ void operator()(const f32x4 (&acc)[2][2][4][2], const pg8::Unit& u, int wr, int wc, int fr, int fq, int par) const {
        asm volatile("" : "+v"(fr), "+v"(fq));
        const int row0 = u.pm * 256 + wr * 64 + fr, col0 = (u.pn * 256 + wc * 32 + 8 * fq) >> 1;
#pragma unroll
        for (int ai = 0; ai < 2; ++ai)
#pragma unroll
            for (int m = 0; m < 4; ++m) { bf16_t* rp = HB + (size_t)(row0 + ai * 128 + m * 16) * EFF + col0;
#pragma unroll
                for (int bj = 0; bj < 2; ++bj) { const f32x4 a1 = acc[ai][bj][m][0], a3 = acc[ai][bj][m][1];
                    u32x2 w; w.x = cvtpk(silu_f(a1[0]) * a3[0], silu_f(a1[1]) * a3[1]); w.y = cvtpk(silu_f(a1[2]) * a3[2], silu_f(a1[3]) * a3[3]);
                    *(u32x2*)(rp + bj * 64) = w; } }
    }
};

struct EpiUpI8 {
    bf16_t* HB; const float* SAL; const float* SB; const LAS int* tstart; LAS unsigned char* lds;
    __device__ __forceinline__ void pre(const pg8::Unit& u, LAS unsigned char* l, int wid, int lane, int par) const {
        if (wid == 0) { const int mt = u.pm - tstart[u.e];
            __builtin_amdgcn_global_load_lds((const unsigned*)(SAL + (size_t)u.e * 65536 + mt * 256 + lane * 4), (LAS unsigned*)(l + EPI_SC + par * 2048), 16, 0, 0);
            __builtin_amdgcn_global_load_lds((const unsigned*)(SB + (size_t)u.e * 1024 + u.pn * 256 + lane * 4), (LAS unsigned*)(l + EPI_SC + par * 2048 + 1024), 16, 0, 0); } }
    __device__ __forceinline__ void operator()(const i32x4 (&acc)[2][2][4][2], const pg8::Unit& u, int wr, int wc, int fr, int fq, int par) const {
        asm volatile("" : "+v"(fr), "+v"(fq));
        const int rl0 = wr * 64 + fr, row0 = u.pm * 256 + rl0, colp = u.pn * 256 + wc * 32 + 8 * fq, col0 = colp >> 1;
        LAS const float* LSA = (LAS const float*)(lds + EPI_SC + par * 2048); LAS const float* LSB = LSA + 256;
        f32x4 sb[2][2];
#pragma unroll
        for (int bj = 0; bj < 2; ++bj)
#pragma unroll
            for (int n = 0; n < 2; ++n) sb[bj][n] = *(LAS const f32x4*)(LSB + wc * 32 + 8 * fq + bj * 128 + 4 * n);
#pragma unroll
        for (int ai = 0; ai < 2; ++ai)
#pragma unroll
            for (int m = 0; m < 4; ++m) { const int R = rl0 + ai * 128 + m * 16; const float sa = LSA[R];
                bf16_t* rp = HB + (size_t)(row0 + ai * 128 + m * 16) * EFF + (col0 & ~7) + 64 * (fq & 1);
                u32x2 wv[2];
#pragma unroll
                for (int bj = 0; bj < 2; ++bj) { const i32x4 i1 = acc[ai][bj][m][0], i3 = acc[ai][bj][m][1];
                    f32x4 a1, a3;
#pragma unroll
                    for (int i = 0; i < 4; ++i) { a1[i] = (float)i1[i] * sa * sb[bj][0][i]; a3[i] = (float)i3[i] * sa * sb[bj][1][i]; }
                    wv[bj].x = cvtpk(silu_f(a1[0]) * a3[0], silu_f(a1[1]) * a3[1]); wv[bj].y = cvtpk(silu_f(a1[2]) * a3[2], silu_f(a1[3]) * a3[3]); }
                *(u32x4*)rp = widen_rows16(wv[0], wv[1]); }
    }
};

template <class RM>
__device__ __forceinline__ void transpose_item(const float* W, int N, bf16_t* WT, int Kd, LAS float* scr, int k0, int n0, int lane, const RM& rm) {
#pragma unroll
    for (int i = 0; i < 8; ++i) { const int kk = 8 * i + (lane >> 3); const f32x4 w4 = *(const f32x4*)(W + (size_t)(k0 + kk) * N + n0 + 4 * (lane & 7));
        LAS float* d = scr + kk * 33 + 4 * (lane & 7); d[0] = w4[0]; d[1] = w4[1]; d[2] = w4[2]; d[3] = w4[3]; }
    asm volatile("s_waitcnt lgkmcnt(0)" ::: "memory");
    const int c = lane & 7;
#pragma unroll
    for (int j = 0; j < 4; ++j) { const int n = (lane >> 3) + 8 * j; const LAS float* s = scr + (8 * c) * 33 + n;
        u32x4 o; o.x = cvtpk(s[0 * 33], s[1 * 33]); o.y = cvtpk(s[2 * 33], s[3 * 33]); o.z = cvtpk(s[4 * 33], s[5 * 33]); o.w = cvtpk(s[6 * 33], s[7 * 33]);
        *(u32x4*)(WT + (size_t)rm(n0 + n) * Kd + k0 + 8 * c) = o; }
    asm volatile("s_waitcnt lgkmcnt(0)" ::: "memory");
}
struct RmId { int off; __device__ __forceinline__ int operator()(int n) const { return off + n; } };
__device__ __forceinline__ int rope_pl(int d) { return 8 * ((d & 31) >> 2) + 4 * (d >> 5) + (d & 3); }
struct RmWin {
    __device__ __forceinline__ int operator()(int c) const {
        if (c < 2048) return c;
        if (c < 2052) return 3328 + (c - 2048);
        if (c < 2056) return 3332 + (c - 2052);
        if (c < 2568) { const int x = c - 2056; return 2048 + (x & ~63) + rope_pl(x & 63); }
        if (c < 2696) { const int x = c - 2568; return 2560 + (x & ~63) + rope_pl(x & 63); }
        if (c < 2824) return 2688 + (c - 2696);
        if (c < 2952) { const int x = c - 2824; return 2816 + (x & ~63) + rope_pl(x & 63); }
        if (c < 3080) return 2944 + (c - 2952);
        if (c < 3208) { const int x = c - 3080; return 3072 + (x & ~63) + rope_pl(x & 63); }
        if (c < 3336) return 3200 + (c - 3208);
        return c;
    }
};
struct RmW13 { int sel; __device__ __forceinline__ int operator()(int j) const { return 8 * (j >> 2) + 4 * sel + (j & 3); } };

__device__ __forceinline__ void p0_phase(Frame& F) {
    const int tid = F.tid, lane = F.lane;
    const int NA = F.G > 64 ? 64 : F.G;
    const bool split = F.G > NA;
    if (F.vcu < NA) {
        LAS float* sc = (LAS float*)F.lds; LAS float* red = (LAS float*)(F.lds + 32768);
        const float* c = IN_F(1);
        for (int i = tid; i < 8192; i += NTHR) sc[i] = silu_f(c[i]);
        __syncthreads();
        const float* W = IN_F(3); const float* bia = IN_F(4); float* mod = WSP(float, WS_MOD);
        for (int cg = F.vcu; cg < 64; cg += NA) {
            const int col0 = cg * 96;
            const int kq = tid / 24, cq = tid % 24;
            f32x4 a[8];
#pragma unroll
            for (int b = 0; b < 8; ++b) a[b] = (f32x4){0.f, 0.f, 0.f, 0.f};
            if (tid < 504) {
#pragma unroll 4
                for (int k = kq; k < 1024; k += 21) { const f32x4 w = *(const f32x4*)(W + (size_t)k * 6144 + col0 + 4 * cq);
#pragma unroll
                    for (int b = 0; b < 8; ++b) a[b] += w * sc[b * 1024 + k]; }
#pragma unroll
                for (int b = 0; b < 8; ++b) *(LAS f32x4*)(red + (size_t)(tid * 8 + b) * 4) = a[b];
            }
            __syncthreads();
            for (int o = tid; o < 768; o += NTHR) { const int cq2 = o >> 5, bj = o & 31;
                float sacc = 0.f;
                for (int q = 0; q < 21; ++q) sacc += red[(size_t)((q * 24 + cq2) * 8) * 4 + bj];
                const int col = col0 + 4 * cq2 + (bj & 3);
                mod[(bj >> 2) * 6144 + col] = sacc + bia[col]; }
            __syncthreads();
        }
    }
    if (!split || F.vcu >= NA) {
        LAS float* scr = (LAS float*)(F.lds + F.wave * 8448);
        const int gw = (split ? F.vcu - NA : F.vcu) * NWAVES + F.wave, NGW = (split ? F.G - NA : F.G) * NWAVES;
        constexpr int I_WOUT = 16 * 32, I_C1 = 32 * 4, I_C2 = 2 * 2;
        constexpr int NITEMS = I_WOUT + 2 * I_C1 + 2 * I_C2;
        for (int it = gw; it < NITEMS; it += NGW) {
            int r = it;
            if (r < I_WOUT) { transpose_item(IN_F(19), 1024, WSP(bf16_t, WS_WOUTT), 1024, scr, (r / 32) * 64, (r % 32) * 32, lane, RmId{0}); continue; } r -= I_WOUT;
            if (r < I_C1) { transpose_item(IN_F(14), 128, WSP(bf16_t, WS_CW1K), 2048, scr, (r / 4) * 64, (r % 4) * 32, lane, RmId{0}); continue; } r -= I_C1;
            if (r < I_C1) { transpose_item(IN_F(17), 128, WSP(bf16_t, WS_CW1V), 2048, scr, (r / 4) * 64, (r % 4) * 32, lane, RmId{0}); continue; } r -= I_C1;
            if (r < I_C2) { transpose_item(IN_F(15), 64, WSP(bf16_t, WS_CW2K), 128, scr, (r / 2) * 64, (r % 2) * 32, lane, RmId{0}); continue; } r -= I_C2;
            transpose_item(IN_F(18), 64, WSP(bf16_t, WS_CW2V), 128, scr, (r / 2) * 64, (r % 2) * 32, lane, RmId{0});
        }
    }
    __syncthreads();
    {
        LAS unsigned* AM = (LAS unsigned*)F.lds; const int n4 = tid & 7, kq = tid >> 3; const RmWin rmw{};
        for (int it = (F.vcu + F.G - (split ? NA : 0)) % F.G; it < 105; it += F.G) {
            const int c0 = 32 * it + 4 * n4; const float* W = IN_F(9) + (size_t)(16 * kq) * INW + c0;
            if (tid < 32) AM[tid] = 0u;
            __syncthreads();
            f32x4 v[16]; f32x4 am = {0.f, 0.f, 0.f, 0.f};
#pragma unroll
            for (int i = 0; i < 16; ++i) { v[i] = *(const f32x4*)(W + (size_t)i * INW);
#pragma unroll
                for (int c = 0; c < 4; ++c) am[c] = fmaxf(am[c], fabsf(v[i][c])); }
#pragma unroll
            for (int o = 8; o < 64; o <<= 1) {
#pragma unroll
                for (int c = 0; c < 4; ++c) am[c] = fmaxf(am[c], __shfl_xor(am[c], o)); }
            if ((tid & 63) < 8) {
#pragma unroll
                for (int c = 0; c < 4; ++c) atomicMax((unsigned*)&AM[4 * n4 + c], __float_as_uint(am[c])); }
            __syncthreads();
            const f32x4 amax = *(LAS const f32x4*)((LAS const float*)AM + 4 * n4);
#pragma unroll
            for (int c = 0; c < 4; ++c) { const float inv = amax[c] > 0.f ? 127.f / amax[c] : 0.f; const int prow = rmw(c0 + c); u32x4 o;
#pragma unroll
                for (int d = 0; d < 4; ++d) {
                    const int q0 = (int)rintf(v[4 * d][c] * inv), q1 = (int)rintf(v[4 * d + 1][c] * inv), q2 = (int)rintf(v[4 * d + 2][c] * inv), q3 = (int)rintf(v[4 * d + 3][c] * inv);
                    o[d] = (unsigned)(q0 & 0xff) | ((unsigned)(q1 & 0xff) << 8) | ((unsigned)(q2 & 0xff) << 16) | ((unsigned)(q3 & 0xff) << 24); }
                *(u32x4*)((unsigned char*)(F.ws + WS_WINT) + (size_t)prow * 1024 + 16 * kq) = o;
                if (kq == 0) WSP(float, WS_SBW)[prow] = amax[c] * (1.f / 127.f); }
            __syncthreads();
        }
    }
    if (!split || F.vcu >= NA) {
        const size_t gt = (size_t)(split ? F.vcu - NA : F.vcu) * NTHR + tid, NGT_ = (size_t)(split ? F.G - NA : F.G) * NTHR;
        const int* pos = (const int*)F.in[2]; float* COS = WSP(float, WS_COS); float* SIN = WSP(float, WS_SIN);
        {
            const int d = (int)(gt & 31); const float inv = powf(10000.f, -(float)d / 32.f);
            for (size_t i = gt; i < (size_t)NTOK * 32; i += NGT_) { const int row = (int)(i >> 5);
                const float ang = (float)pos[row] * inv; const float kk = rintf(ang * 0.15915494309189535f);
                float r = fmaf(-kk, 6.28125f, ang); r = fmaf(-kk, 1.9353071795864769e-3f, r);
                const float sn = __sinf(r), cs = __cosf(r); COS[i] = cs; SIN[i] = sn; } }
        { unsigned* z = (unsigned*)(F.ws + WS_WINT + (size_t)3360 * 1024); for (size_t i = gt; i < (size_t)224 * 256; i += NGT_) z[i] = 0u;
          for (size_t i = gt; i < 224; i += NGT_) WSP(float, WS_SBW)[3360 + i] = 0.f; }
        { const float* wg = IN_F(20); const float* we = IN_F(22); _Float16* RWT = WSP(_Float16, WS_RWT);
          for (size_t i = gt; i < 48 * 1024; i += NGT_) { const int n = (int)(i >> 10), k = (int)(i & 1023);
              const float w = n < 4 ? wg[k * 4 + n] : n < 36 ? we[k * 32 + n - 4] : 0.f; RWT[i] = (_Float16)w; } }
        { bf16_t* kc = WSP(bf16_t, WS_KCMP); bf16_t* vc = WSP(bf16_t, WS_VCMP);
          for (size_t i = gt; i < 16 * 64; i += NGT_) { const size_t o = ((i >> 6) * 256 + 255) * 64 + (i & 63); kc[o] = 0; vc[o] = 0; } }
    }
    __syncthreads();
    if (F.vcu >= F.G - 16) {
        const int bi = F.vcu - (F.G - 16), kv = bi >> 3, cg = bi & 7;
        const float* pe = IN_F(kv == 0 ? 13 : 16); const float* w1 = IN_F(kv == 0 ? 14 : 17);
        LAS float* red = (LAS float*)F.lds;
        const int col = cg * 16 + (tid & 15), sl = tid >> 4; float sacc = 0.f;
#pragma unroll 8
        for (int k = sl * 64; k < sl * 64 + 64; ++k) sacc += pe[k] * w1[(size_t)k * 128 + col];
        red[tid] = sacc; __syncthreads();
        if (tid < 16) { float t2 = 0.f; for (int q = 0; q < 32; ++q) t2 += red[q * 16 + tid]; WSP(float, WS_C1B)[kv * 128 + cg * 16 + tid] = t2; }
    }
    __syncthreads();
}

__device__ __forceinline__ void p1a_phase(Frame& F) {
    const int gw = F.vcu * NWAVES + F.wave, NGW = F.G * NWAVES, lane = F.lane;
    const float* x = IN_F(0); const float* nw = IN_F(5); const float* mod = WSP(float, WS_MOD); signed char* H1Q = (signed char*)(F.ws + WS_H1);
    for (int row0 = gw * 4; row0 < NTOK; row0 += NGW * 4) {
        f32x4 v[4][4]; float ss[4];
#pragma unroll
        for (int r = 0; r < 4; ++r) { const f32x4* xr = (const f32x4*)(x + (size_t)(row0 + r) * DM) + lane;
#pragma unroll
            for (int j = 0; j < 4; ++j) v[r][j] = __builtin_nontemporal_load(xr + 64 * j); }
#pragma unroll
        for (int r = 0; r < 4; ++r) { float a = 0.f;
#pragma unroll
            for (int j = 0; j < 4; ++j) a += v[r][j][0] * v[r][j][0] + v[r][j][1] * v[r][j][1] + v[r][j][2] * v[r][j][2] + v[r][j][3] * v[r][j][3];
            ss[r] = a; }
#pragma unroll
        for (int o = 1; o < 64; o <<= 1) {
#pragma unroll
            for (int r = 0; r < 4; ++r) ss[r] += __shfl_xor(ss[r], o); }
        const int b = row0 >> 12; float am[4] = {0.f, 0.f, 0.f, 0.f};
#pragma unroll
        for (int j = 0; j < 4; ++j) { const int k = 4 * lane + 256 * j;
            const f32x4 w = *(const f32x4*)(nw + k), sh = *(const f32x4*)(mod + b * 6144 + k), sc = *(const f32x4*)(mod + b * 6144 + 1024 + k);
            const f32x4 ws = w * (sc + 1.f);
#pragma unroll
            for (int r = 0; r < 4; ++r) { const float rr = rsqrtf(ss[r] * (1.f / DM) + RMS_EPS);
                const f32x4 h = v[r][j] * rr * ws + sh; v[r][j] = h;
                am[r] = fmaxf(am[r], fmaxf(fmaxf(fabsf(h[0]), fabsf(h[1])), fmaxf(fabsf(h[2]), fabsf(h[3])))); } }
#pragma unroll
        for (int o = 1; o < 64; o <<= 1) {
#pragma unroll
            for (int r = 0; r < 4; ++r) am[r] = fmaxf(am[r], __shfl_xor(am[r], o)); }
#pragma unroll
        for (int r = 0; r < 4; ++r) { const float inv = am[r] > 0.f ? 127.f / am[r] : 0.f;
            if (lane == 0) WSP(float, WS_SA1)[row0 + r] = am[r] * (1.f / 127.f);
            u32x4 pk;
#pragma unroll
            for (int j = 0; j < 4; ++j) { const f32x4 q = v[r][j] * inv;
                const int q0 = (int)rintf(q[0]), q1 = (int)rintf(q[1]), q2 = (int)rintf(q[2]), q3 = (int)rintf(q[3]);
                pk[j] = (unsigned)(q0 & 0xff) | ((unsigned)(q1 & 0xff) << 8) | ((unsigned)(q2 & 0xff) << 16) | ((unsigned)(q3 & 0xff) << 24); }
            *(u32x4*)(H1Q + (size_t)(row0 + r) * DM + 256 * (lane & 3) + 16 * (lane >> 2)) = quad_transpose(pk, lane); }
    }
}

__device__ __forceinline__ void conv_silu16(const bf16_t* src  , const float* cw  , int b, int s, int ch0  , float scale, float (&o)[16]) {
#pragma unroll
    for (int i = 0; i < 16; ++i) o[i] = 0.f;
#pragma unroll
    for (int j = 0; j < 4; ++j) { const int ss = s - 3 + j;
        if (ss >= 0) { const bf16_t* rp = src + ((size_t)b * SEQ + ss) * 512 + ch0;
            const u32x4 a = *(const u32x4*)rp, c = *(const u32x4*)(rp + 8);
            const float* w = cw + j * 1024;
            const f32x4 w0 = *(const f32x4*)w, w1 = *(const f32x4*)(w + 4), w2 = *(const f32x4*)(w + 8), w3 = *(const f32x4*)(w + 12);
            o[0] += bflo(a.x) * w0[0]; o[1] += bfhi(a.x) * w0[1]; o[2] += bflo(a.y) * w0[2]; o[3] += bfhi(a.y) * w0[3];
            o[4] += bflo(a.z) * w1[0]; o[5] += bfhi(a.z) * w1[1]; o[6] += bflo(a.w) * w1[2]; o[7] += bfhi(a.w) * w1[3];
            o[8] += bflo(c.x) * w2[0]; o[9] += bfhi(c.x) * w2[1]; o[10] += bflo(c.y) * w2[2]; o[11] += bfhi(c.y) * w2[3];
            o[12] += bflo(c.z) * w3[0]; o[13] += bfhi(c.z) * w3[1]; o[14] += bflo(c.w) * w3[2]; o[15] += bfhi(c.w) * w3[3]; } }
#pragma unroll
    for (int i = 0; i < 16; ++i) o[i] = silu_f(o[i]) * scale;
}
constexpr int RAWS = 272, RAWIMG = 67 * RAWS + 208;
__device__ __forceinline__ void stage_raw(const bf16_t* src, int b, int s0, int h, LAS unsigned char* RAW, int tid) {
    const int s = tid >> 3, chg = tid & 7;
    const bf16_t* rp = src + ((size_t)b * SEQ + s0 + s) * 512 + h * 128 + chg * 16;
    *(LAS u32x4*)(RAW + (s + 3) * RAWS + chg * 32) = *(const u32x4*)rp; *(LAS u32x4*)(RAW + (s + 3) * RAWS + chg * 32 + 16) = *(const u32x4*)(rp + 8);
    if (s < 3) { u32x4 a = {0u, 0u, 0u, 0u}, c = a; const int ss = s0 - 3 + s;
        if (ss >= 0) { const bf16_t* hp = src + ((size_t)b * SEQ + ss) * 512 + h * 128 + chg * 16; a = *(const u32x4*)hp; c = *(const u32x4*)(hp + 8); }
        *(LAS u32x4*)(RAW + s * RAWS + chg * 32) = a; *(LAS u32x4*)(RAW + s * RAWS + chg * 32 + 16) = c; }
}
__device__ __forceinline__ void conv_lds16(LAS const unsigned char* RAW, LAS const float* WL, int s, int ch0, float scale, float (&o)[16]) {
#pragma unroll
    for (int i = 0; i < 16; ++i) o[i] = 0.f;
#pragma unroll
    for (int j = 0; j < 4; ++j) { const u32x4 a = *(LAS const u32x4*)(RAW + (s + j) * RAWS + ch0 * 2), c = *(LAS const u32x4*)(RAW + (s + j) * RAWS + ch0 * 2 + 16);
        const LAS float* w = WL + j * 128 + ch0;
        const f32x4 w0 = *(LAS const f32x4*)w, w1 = *(LAS const f32x4*)(w + 4), w2 = *(LAS const f32x4*)(w + 8), w3 = *(LAS const f32x4*)(w + 12);
        o[0] += bflo(a.x) * w0[0]; o[1] += bfhi(a.x) * w0[1]; o[2] += bflo(a.y) * w0[2]; o[3] += bfhi(a.y) * w0[3];
        o[4] += bflo(a.z) * w1[0]; o[5] += bfhi(a.z) * w1[1]; o[6] += bflo(a.w) * w1[2]; o[7] += bfhi(a.w) * w1[3];
        o[8] += bflo(c.x) * w2[0]; o[9] += bfhi(c.x) * w2[1]; o[10] += bflo(c.y) * w2[2]; o[11] += bfhi(c.y) * w2[3];
        o[12] += bflo(c.z) * w3[0]; o[13] += bfhi(c.z) * w3[1]; o[14] += bflo(c.w) * w3[2]; o[15] += bfhi(c.w) * w3[3]; }
#pragma unroll
    for (int i = 0; i < 16; ++i) o[i] = silu_f(o[i]) * scale;
}
constexpr int TRT = 4096 + 64, RCH = 1024 + 16;
constexpr int TRIMG = 4 * TRT, ROWIMG = 16 * RCH;
__device__ __forceinline__ unsigned tr_lane_off(int lane) { const int hi = lane >> 5; return ((lane >> 4) & 1) * 32 + (lane & 3) * 8 + (4 * hi + ((lane & 15) >> 2)) * 64; }

#if DBG_CHECK == 2
#define DBGF(code, val) do { const float _v = (val); if ((__float_as_uint(_v) & 0x7f800000u) == 0x7f800000u) atomicMin((unsigned*)(F.ws + WS_CTL) + CW_DBG, (unsigned)(code)); } while (0)
#else
#define DBGF(code, val) do {} while (0)
#endif
struct MaPF { u32x4 k0, k1, v0, v1, hk0, hk1; float wk, g0, g1; };
__device__ __forceinline__ void mlstm_a_load(Frame& F, int job, int tid, MaPF& pf) {
    const int lane = tid & 63, w = F.wave;
    const int bh = job >> 6, c = job & 63, b = bh >> 2, h = bh & 3, s0 = c * 64, s = tid >> 3, chg = tid & 7;
    const size_t ro = ((size_t)b * SEQ + s0 + s) * 512 + h * 128 + chg * 16;
    const bf16_t* kp = WSP(bf16_t, WS_MK) + ro; const bf16_t* vp = WSP(bf16_t, WS_MV) + ro;
    pf.k0 = *(const u32x4*)kp; pf.k1 = *(const u32x4*)(kp + 8); pf.v0 = *(const u32x4*)vp; pf.v1 = *(const u32x4*)(vp + 8);
    pf.hk0 = (u32x4){0u, 0u, 0u, 0u}; pf.hk1 = pf.hk0;
    if (s < 3 && s0 - 3 + s >= 0) { const bf16_t* hp = WSP(bf16_t, WS_MK) + ((size_t)b * SEQ + s0 - 3 + s) * 512 + h * 128 + chg * 16; pf.hk0 = *(const u32x4*)hp; pf.hk1 = *(const u32x4*)(hp + 8); }
    pf.wk = IN_F(10)[(tid >> 7) * 1024 + 512 + h * 128 + (tid & 127)];
    pf.g0 = 0.f; pf.g1 = 0.f;
    if (w == 0) { pf.g0 = WSP(float, WS_GF)[(size_t)bh * SEQ + s0 + lane]; pf.g1 = WSP(float, WS_GI)[(size_t)bh * SEQ + s0 + lane]; }
}
__device__ __forceinline__ void mlstm_a_phase(Frame& F) {
    int tid = F.tid; asm volatile("" : "+v"(tid));
    const int lane = tid & 63, w = F.wave, r32 = lane & 31, hi = lane >> 5;
    LAS unsigned char* kimg = F.lds; LAS unsigned char* vimg = F.lds + TRIMG; LAS float* wS = (LAS float*)(F.lds + 2 * TRIMG);
    LAS unsigned char* RAWK = F.lds + 2 * TRIMG + 1024; LAS float* WLK = (LAS float*)(RAWK + RAWIMG);
    LAS bf16_t* OST = (LAS bf16_t*)(F.lds + 2 * TRIMG + 1024 + RAWIMG + 2048) + w * 2048;
    MaPF pf; int job = F.vcu;
    if (job < 2048) mlstm_a_load(F, job, tid, pf);
    for (; job < 2048; job += F.G) {
        {
            const int s = tid >> 3, chg = tid & 7;
            *(LAS u32x4*)(RAWK + (s + 3) * RAWS + chg * 32) = pf.k0; *(LAS u32x4*)(RAWK + (s + 3) * RAWS + chg * 32 + 16) = pf.k1;
            if (s < 3) { *(LAS u32x4*)(RAWK + s * RAWS + chg * 32) = pf.hk0; *(LAS u32x4*)(RAWK + s * RAWS + chg * 32 + 16) = pf.hk1; }
            WLK[tid] = pf.wk;
            if (w == 0) {
                float bs = pf.g0;
#pragma unroll
                for (int o = 1; o < 64; o <<= 1) { const float x = __shfl_up(bs, o); if (lane >= o) bs += x; }
                const float g = __shfl(bs, 63);
                const float a = g - bs + pf.g1; const float ml = wave_max(a);
                wS[lane] = __expf(a - ml);
                if (lane == 0) { WSP(float, WS_GSUM)[job] = g; WSP(float, WS_MLOC)[job] = ml; }
            }
        }
        const u32x4 va = pf.v0, vd = pf.v1;
        __syncthreads();
        if (job + F.G < 2048) mlstm_a_load(F, job + F.G, tid, pf);
        {
            const int s = tid >> 3, chg = tid & 7, ch0 = chg * 16;
            float kf[16]; conv_lds16(RAWK, WLK, s, ch0, 0.08838834764831845f, kf);
            const unsigned off = (ch0 >> 5) * TRT + s * 64 + (ch0 & 31) * 2;
            u32x4 k0, k1; k0.x = cvtpk(kf[0], kf[1]); k0.y = cvtpk(kf[2], kf[3]); k0.z = cvtpk(kf[4], kf[5]); k0.w = cvtpk(kf[6], kf[7]);
            k1.x = cvtpk(kf[8], kf[9]); k1.y = cvtpk(kf[10], kf[11]); k1.z = cvtpk(kf[12], kf[13]); k1.w = cvtpk(kf[14], kf[15]);
            *(LAS u32x4*)(kimg + off) = k0; *(LAS u32x4*)(kimg + off + 16) = k1;
            const float ws = wS[s];
            u32x4 v0, v1;
            v0.x = cvtpk(bflo(va.x) * ws, bfhi(va.x) * ws); v0.y = cvtpk(bflo(va.y) * ws, bfhi(va.y) * ws); v0.z = cvtpk(bflo(va.z) * ws, bfhi(va.z) * ws); v0.w = cvtpk(bflo(va.w) * ws, bfhi(va.w) * ws);
            v1.x = cvtpk(bflo(vd.x) * ws, bfhi(vd.x) * ws); v1.y = cvtpk(bflo(vd.y) * ws, bfhi(vd.y) * ws); v1.z = cvtpk(bflo(vd.z) * ws, bfhi(vd.z) * ws); v1.w = cvtpk(bflo(vd.w) * ws, bfhi(vd.w) * ws);
            *(LAS u32x4*)(vimg + off) = v0; *(LAS u32x4*)(vimg + off + 16) = v1;
        }
        __syncthreads();
        {
            const int et = w >> 1, dt0 = 2 * (w & 1); const unsigned lo = tr_lane_off(lane);
            f32x16 acc0 = {0}, acc1 = {0};
#pragma unroll
            for (int ks = 0; ks < 4; ++ks) {
                const bf16x8 a = mk8(vtr(vimg + et * TRT + ks * 1024 + lo), vtr(vimg + et * TRT + ks * 1024 + lo + 512));
                const bf16x8 b0 = mk8(vtr(kimg + dt0 * TRT + ks * 1024 + lo), vtr(kimg + dt0 * TRT + ks * 1024 + lo + 512));
                const bf16x8 b1 = mk8(vtr(kimg + (dt0 + 1) * TRT + ks * 1024 + lo), vtr(kimg + (dt0 + 1) * TRT + ks * 1024 + lo + 512));
                acc0 = MFMA32(a, b0, acc0); acc1 = MFMA32(a, b1, acc1);
            }
#pragma unroll
            for (int r = 0; r < 16; ++r) { const int el = crow(r, hi); OST[el * 64 + r32] = f2bf(acc0[r]); OST[el * 64 + 32 + r32] = f2bf(acc1[r]); }
            asm volatile("s_waitcnt lgkmcnt(0)" ::: "memory");
            bf16_t* dst = WSP(bf16_t, WS_KVC) + (size_t)job * 16384 + (size_t)(et * 32) * 128 + dt0 * 32;
#pragma unroll
            for (int i = 0; i < 4; ++i) { const int rw = i * 8 + (lane >> 3), ch = lane & 7; *(u32x4*)(dst + (size_t)rw * 128 + ch * 8) = *(LAS const u32x4*)(OST + rw * 64 + ch * 8); }
        }
        if (tid < 128) {
            float sacc = 0.f; const int d = tid;
            for (int ss = 0; ss < 64; ++ss) sacc += wS[ss] * bf2f(*(LAS const bf16_t*)(kimg + (d >> 5) * TRT + ss * 64 + (d & 31) * 2));
            WSP(float, WS_NC)[(size_t)job * 128 + d] = sacc;
        }
        __syncthreads();
    }
}

__device__ __forceinline__ void mlstm_scan_job(Frame& F, int job) {
    int tid = F.tid; asm volatile("" : "+v"(tid));
    const int bh = job >> 3, sl = job & 7;
    LAS float* aold = (LAS float*)F.lds; LAS float* anew = aold + 64; LAS float* gS = aold + 128; LAS float* mS = aold + 192;
    if (tid < 64) { gS[tid] = WSP(float, WS_GSUM)[bh * 64 + tid]; mS[tid] = WSP(float, WS_MLOC)[bh * 64 + tid]; }
    __syncthreads();
    if (tid == 0) {
        float m = 0.f;
        for (int c = 0; c < 64; ++c) { const float g = gS[c], ml = mS[c];
            const float mn = fmaxf(g + m, ml); aold[c] = __expf(g + m - mn); anew[c] = __expf(ml - mn);
            gS[c] = m;
            m = mn; }
    }
    __syncthreads();
    if (sl == 0 && tid < 64) WSP(float, WS_MPREV)[bh * 64 + tid] = gS[tid];
    const size_t base = (size_t)bh * 64 * 16384 + (size_t)sl * 2048 + tid * 4;
    const bf16_t* kv = WSP(bf16_t, WS_KVC) + base; bf16_t* cp = WSP(bf16_t, WS_CPREV) + base;
    f32x4 C = {0.f, 0.f, 0.f, 0.f};
#pragma unroll 8
    for (int c = 0; c < 64; ++c) {
        const u32x2 k = *(const u32x2*)(kv + (size_t)c * 16384);
        u32x2 o; o.x = cvtpk(C[0], C[1]); o.y = cvtpk(C[2], C[3]); *(u32x2*)(cp + (size_t)c * 16384) = o;
        const float ao = aold[c], an = anew[c]; DBGF(22, ao); DBGF(23, an); DBGF(24, bflo(k.x)); DBGF(24, bfhi(k.x)); DBGF(24, bflo(k.y)); DBGF(24, bfhi(k.y)); DBGF(25, C[0]);
        C[0] = ao * C[0] + an * bflo(k.x); C[1] = ao * C[1] + an * bfhi(k.x); C[2] = ao * C[2] + an * bflo(k.y); C[3] = ao * C[3] + an * bfhi(k.y);
    }
    if (sl == 0 && tid < 128) {
        float n = 0.f;
        for (int c0 = 0; c0 < 64; c0 += 16) { float nc[16];
#pragma unroll
            for (int i = 0; i < 16; ++i) nc[i] = WSP(float, WS_NC)[(size_t)(bh * 64 + c0 + i) * 128 + tid];
#pragma unroll
            for (int i = 0; i < 16; ++i) { WSP(float, WS_NPREV)[(size_t)(bh * 64 + c0 + i) * 128 + tid] = n; n = aold[c0 + i] * n + anew[c0 + i] * nc[i]; } }
    }
    __syncthreads();
}

struct McPF { u32x4 q0, q1, k0, k1, v0, v1, hq0, hq1, hk0, hk1; float wq, wk, g0, g1, mprev; u32x2 mo[4]; };
__device__ __forceinline__ void mlstm_c_load(Frame& F, int job, int tid, McPF& pf) {
    const int lane = tid & 63, w = F.wave, r32 = lane & 31, hi = lane >> 5;
    const int bh = job >> 6, c = job & 63, b = bh >> 2, h = bh & 3, s0 = c * 64, s = tid >> 3, chg = tid & 7;
    const size_t ro = ((size_t)b * SEQ + s0 + s) * 512 + h * 128 + chg * 16;
    const bf16_t* qp = WSP(bf16_t, WS_MQ) + ro; const bf16_t* kp = WSP(bf16_t, WS_MK) + ro; const bf16_t* vp = WSP(bf16_t, WS_MV) + ro;
    pf.q0 = *(const u32x4*)qp; pf.q1 = *(const u32x4*)(qp + 8); pf.k0 = *(const u32x4*)kp; pf.k1 = *(const u32x4*)(kp + 8); pf.v0 = *(const u32x4*)vp; pf.v1 = *(const u32x4*)(vp + 8);
    pf.hq0 = (u32x4){0u, 0u, 0u, 0u}; pf.hq1 = pf.hq0; pf.hk0 = pf.hq0; pf.hk1 = pf.hq0;
    if (s < 3 && s0 - 3 + s >= 0) { const size_t ho = ((size_t)b * SEQ + s0 - 3 + s) * 512 + h * 128 + chg * 16;
        pf.hq0 = *(const u32x4*)(WSP(bf16_t, WS_MQ) + ho); pf.hq1 = *(const u32x4*)(WSP(bf16_t, WS_MQ) + ho + 8); pf.hk0 = *(const u32x4*)(WSP(bf16_t, WS_MK) + ho); pf.hk1 = *(const u32x4*)(WSP(bf16_t, WS_MK) + ho + 8); }
    pf.wq = IN_F(10)[(tid >> 7) * 1024 + h * 128 + (tid & 127)]; pf.wk = IN_F(10)[(tid >> 7) * 1024 + 512 + h * 128 + (tid & 127)];
    pf.g0 = 0.f; pf.g1 = 0.f;
    if (w == 0) { pf.g0 = WSP(float, WS_GF)[(size_t)bh * SEQ + s0 + lane]; pf.g1 = WSP(float, WS_GI)[(size_t)bh * SEQ + s0 + lane]; }
    if (w == 1) { pf.g0 = WSP(float, WS_NPREV)[(size_t)job * 128 + lane]; pf.g1 = WSP(float, WS_NPREV)[(size_t)job * 128 + 64 + lane]; }
    pf.mprev = WSP(float, WS_MPREV)[job];
    const int tw = w & 1, ew = w >> 1, t = 32 * tw + r32;
    const bf16_t* mo = WSP(bf16_t, WS_MO) + ((size_t)b * SEQ + s0 + t) * 512 + h * 128 + 32 * ew + 4 * hi;
#pragma unroll
    for (int q4 = 0; q4 < 4; ++q4) pf.mo[q4] = *(const u32x2*)(mo + 8 * q4);
}
__device__ __forceinline__ void mlstm_c_phase(Frame& F) {
    int tid = F.tid; asm volatile("" : "+v"(tid));
    const int lane = tid & 63, w = F.wave, r32 = lane & 31, hi = lane >> 5;
    LAS unsigned char* qimg = F.lds; LAS unsigned char* kimg = F.lds + ROWIMG; LAS unsigned char* vimg = F.lds + 2 * ROWIMG;
    LAS float* uS = (LAS float*)(F.lds + 2 * ROWIMG + TRIMG); LAS float* MS = uS + 64; LAS float* bS = uS + 128; LAS float* nS = uS + 192; LAS float* ssq = uS + 320;
    LAS unsigned char* RAWQ = F.lds + 2 * ROWIMG + TRIMG + 4096; LAS unsigned char* RAWK = RAWQ + RAWIMG; LAS float* WLQ = (LAS float*)(RAWK + RAWIMG); LAS float* WLK = WLQ + 512;
    LAS float* HNL = (LAS float*)(F.lds + MISC_OFF + 2048);
    HNL[tid] = IN_F(12)[tid];
    const int tw = w & 1, ew = w >> 1, t = 32 * tw + r32;
    McPF pf;
    int job = F.vcu;
    if (job < 2048) mlstm_c_load(F, job, tid, pf);
    for (; job < 2048; job += F.G) {
        const int bh = job >> 6, c = job & 63, b = bh >> 2, h = bh & 3, s0 = c * 64;
        const float mprev = pf.mprev; u32x2 moc[4];
#pragma unroll
        for (int q4 = 0; q4 < 4; ++q4) moc[q4] = pf.mo[q4];
        {
            const int s = tid >> 3, chg = tid & 7, ch0 = chg * 16;
            *(LAS u32x4*)(RAWQ + (s + 3) * RAWS + chg * 32) = pf.q0; *(LAS u32x4*)(RAWQ + (s + 3) * RAWS + chg * 32 + 16) = pf.q1;
            *(LAS u32x4*)(RAWK + (s + 3) * RAWS + chg * 32) = pf.k0; *(LAS u32x4*)(RAWK + (s + 3) * RAWS + chg * 32 + 16) = pf.k1;
            if (s < 3) { *(LAS u32x4*)(RAWQ + s * RAWS + chg * 32) = pf.hq0; *(LAS u32x4*)(RAWQ + s * RAWS + chg * 32 + 16) = pf.hq1;
                         *(LAS u32x4*)(RAWK + s * RAWS + chg * 32) = pf.hk0; *(LAS u32x4*)(RAWK + s * RAWS + chg * 32 + 16) = pf.hk1; }
            WLQ[tid] = pf.wq; WLK[tid] = pf.wk;
            const unsigned off = (ch0 >> 5) * TRT + s * 64 + (ch0 & 31) * 2;
            *(LAS u32x4*)(vimg + off) = pf.v0; *(LAS u32x4*)(vimg + off + 16) = pf.v1;
            if (w == 0) {
                float bs = pf.g0;
#pragma unroll
                for (int o = 1; o < 64; o <<= 1) { const float x = __shfl_up(bs, o); if (lane >= o) bs += x; }
                const float u = pf.g1 - bs; float cm = u;
#pragma unroll
                for (int o = 1; o < 64; o <<= 1) { const float x = __shfl_up(cm, o); if (lane >= o) cm = fmaxf(cm, x); }
                uS[lane] = u; MS[lane] = fmaxf(mprev, cm); bS[lane] = bs;
            }
            if (w == 1) { nS[lane] = pf.g0; nS[64 + lane] = pf.g1; }
        }
        __syncthreads();
        bf16x8 cf[8];
        { const bf16_t* cp = WSP(bf16_t, WS_CPREV) + (size_t)job * 16384 + (size_t)(32 * ew + r32) * 128 + 8 * hi;
#pragma unroll
          for (int ks = 0; ks < 8; ++ks) cf[ks] = *(const bf16x8*)(cp + 16 * ks); }
        if (job + F.G < 2048) mlstm_c_load(F, job + F.G, tid, pf);
        {
            const int s = tid >> 3, chg = tid & 7, ch0 = chg * 16;
            float qf[16]; conv_lds16(RAWQ, WLQ, s, ch0, 1.f, qf);
            u32x4 q0, q1; q0.x = cvtpk(qf[0], qf[1]); q0.y = cvtpk(qf[2], qf[3]); q0.z = cvtpk(qf[4], qf[5]); q0.w = cvtpk(qf[6], qf[7]);
            q1.x = cvtpk(qf[8], qf[9]); q1.y = cvtpk(qf[10], qf[11]); q1.z = cvtpk(qf[12], qf[13]); q1.w = cvtpk(qf[14], qf[15]);
            *(LAS u32x4*)(qimg + (2 * chg) * RCH + s * 16) = q0; *(LAS u32x4*)(qimg + (2 * chg + 1) * RCH + s * 16) = q1;
            float kf[16]; conv_lds16(RAWK, WLK, s, ch0, 0.08838834764831845f, kf);
            u32x4 k0, k1; k0.x = cvtpk(kf[0], kf[1]); k0.y = cvtpk(kf[2], kf[3]); k0.z = cvtpk(kf[4], kf[5]); k0.w = cvtpk(kf[6], kf[7]);
            k1.x = cvtpk(kf[8], kf[9]); k1.y = cvtpk(kf[10], kf[11]); k1.z = cvtpk(kf[12], kf[13]); k1.w = cvtpk(kf[14], kf[15]);
            *(LAS u32x4*)(kimg + (2 * chg) * RCH + s * 16) = k0; *(LAS u32x4*)(kimg + (2 * chg + 1) * RCH + s * 16) = k1;
        }
        __syncthreads();
        const float Mt = MS[t], bt = bS[t];
        const float dec = __expf(mprev - Mt), mt = bt + Mt;
        bf16x8 qf[8];
#pragma unroll
        for (int ks = 0; ks < 8; ++ks) qf[ks] = *(LAS const bf16x8*)(qimg + (2 * ks + hi) * RCH + t * 16);
        f32x16 p[2]; p[0] = (f32x16){0}; p[1] = (f32x16){0};
#pragma unroll
        for (int st = 0; st < 2; ++st) {
            if (st <= tw) {
#pragma unroll
                for (int ks = 0; ks < 8; ++ks) { const bf16x8 kf = *(LAS const bf16x8*)(kimg + (2 * ks + hi) * RCH + (32 * st + r32) * 16); p[st] = MFMA32(kf, qf[ks], p[st]); }
            }
        }
        float rs = 0.f;
#pragma unroll
        for (int st = 0; st < 2; ++st)
#pragma unroll
            for (int r = 0; r < 16; ++r) { const int s = 32 * st + crow(r, hi);
                const float wv = (s <= t) ? __expf(uS[s] - Mt) * p[st][r] : 0.f; p[st][r] = wv; rs += wv; }
        rs += __shfl_xor(rs, 32);
        float qn = 0.f;
#pragma unroll
        for (int ks = 0; ks < 8; ++ks)
#pragma unroll
            for (int j = 0; j < 8; ++j) qn += bf2f((bf16_t)qf[ks][j]) * nS[16 * ks + 8 * hi + j];
        qn += __shfl_xor(qn, 32);
        const float den = rs + dec * qn;
        const float hden = fmaxf(fabsf(den), __expf(-mt));
        f32x16 ai = {0}, ae = {0};
        const unsigned lo = tr_lane_off(lane);
#pragma unroll
        for (int st = 0; st < 2; ++st) {
            if (st <= tw) {
#pragma unroll
                for (int s2 = 0; s2 < 2; ++s2) { const int ks = 2 * st + s2;
                    const bf16x8 vf = mk8(vtr(vimg + ew * TRT + ks * 1024 + lo), vtr(vimg + ew * TRT + ks * 1024 + lo + 512));
                    u32x4 pw; pw.x = cvtpk(p[st][8 * s2 + 0], p[st][8 * s2 + 1]); pw.y = cvtpk(p[st][8 * s2 + 2], p[st][8 * s2 + 3]); pw.z = cvtpk(p[st][8 * s2 + 4], p[st][8 * s2 + 5]); pw.w = cvtpk(p[st][8 * s2 + 6], p[st][8 * s2 + 7]);
                    ai = MFMA32(vf, __builtin_bit_cast(bf16x8, pw), ai); }
            }
        }
#pragma unroll
        for (int ks = 0; ks < 8; ++ks) ae = MFMA32(cf[ks], qf[ks], ae);
        float hv[16]; float ss = 0.f; const float rden = 1.f / hden;
#pragma unroll
        for (int r = 0; r < 16; ++r) { hv[r] = (ai[r] + dec * ae[r]) * rden; ss += hv[r] * hv[r]; }
        ss += __shfl_xor(ss, 32);
        if (hi == 0) ssq[ew * 64 + t] = ss;
        __syncthreads();
        const float tot = ssq[t] + ssq[64 + t] + ssq[128 + t] + ssq[192 + t];
        const float rn = rsqrtf(tot * (1.f / 128.f) + RMS_EPS);
        LAS const float* hn = HNL + h * 128 + 32 * ew;
        bf16_t* yo = WSP(bf16_t, WS_YCAT) + ((size_t)b * SEQ + s0 + t) * 1024 + h * 128 + 32 * ew;
#pragma unroll
        for (int p2 = 0; p2 < 2; ++p2) { u32x2 ov[2];
#pragma unroll
            for (int e = 0; e < 2; ++e) { const int q4 = 2 * p2 + e; const int e0 = 8 * q4 + 4 * hi;
                const u32x2 om = moc[q4]; const f32x4 wn = *(LAS const f32x4*)(hn + e0);
                const float y0 = hv[4 * q4 + 0] * rn * wn[0] * sigmoid_f(bflo(om.x)), y1 = hv[4 * q4 + 1] * rn * wn[1] * sigmoid_f(bfhi(om.x));
                const float y2 = hv[4 * q4 + 2] * rn * wn[2] * sigmoid_f(bflo(om.y)), y3 = hv[4 * q4 + 3] * rn * wn[3] * sigmoid_f(bfhi(om.y));
                ov[e].x = cvtpk(y0, y1); ov[e].y = cvtpk(y2, y3); }
            *(u32x4*)(yo + 16 * p2 + 8 * hi) = widen_pair(ov[0], ov[1]); }
        __syncthreads();
    }
}

__device__ __forceinline__ void compress_job(Frame& F, int job) {
    int lane = F.lane; asm volatile("" : "+v"(lane));
    const int w = F.wave, r32 = lane & 31, hi = lane >> 5;
    const int kv = job >> 7, bg = (job >> 3) & 15, i0 = (job & 7) * 32;
    const bf16_t* X = WSP(bf16_t, kv ? WS_VC : WS_KC) + (size_t)bg * SEQ * 64;
    const bf16_t* W1 = WSP(bf16_t, kv ? WS_CW1V : WS_CW1K); const bf16_t* W2 = WSP(bf16_t, kv ? WS_CW2V : WS_CW2K);
    const float* c1 = WSP(float, WS_C1B) + kv * 128;
    bf16_t* O = WSP(bf16_t, kv ? WS_VCMP : WS_KCMP) + (size_t)bg * 256 * 64;
    LAS unsigned char* himg = F.lds;
    LAS float* part = (LAS float*)(F.lds + ROWIMG);
    const int nt = w & 3, kh = w >> 2;
    f32x16 acc = {0};
    {
        int i = i0 + r32; if (i > 254) i = 254;
        const bf16_t* ap = X + (size_t)i * 1024 + kh * 1024 + 8 * hi; const bf16_t* bp = W1 + (size_t)(32 * nt + r32) * 2048 + kh * 1024 + 8 * hi;
#pragma unroll 16
        for (int ks = 0; ks < 64; ++ks) { const bf16x8 a = *(const bf16x8*)(ap + 16 * ks), bb = *(const bf16x8*)(bp + 16 * ks); acc = MFMA32(a, bb, acc); }
    }
    if (kh == 1) {
#pragma unroll
        for (int r = 0; r < 16; ++r) part[(nt * 16 + r) * 64 + lane] = acc[r];
    }
    __syncthreads();
    if (kh == 0) {
        const int n = 32 * nt + r32; const float cb = c1[n];
#pragma unroll
        for (int r = 0; r < 16; ++r) { const int rowl = crow(r, hi); const float v = acc[r] + part[(nt * 16 + r) * 64 + lane] + cb;
            *(LAS bf16_t*)(himg + (n >> 3) * RCH + rowl * 16 + (n & 7) * 2) = f2bf(silu_f(v)); }
    }
    __syncthreads();
    if (w < 2) {
        f32x16 a2 = {0};
#pragma unroll
        for (int ks = 0; ks < 8; ++ks) { const bf16x8 a = *(LAS const bf16x8*)(himg + (2 * ks + hi) * RCH + r32 * 16);
            const bf16x8 bb = *(const bf16x8*)(W2 + (size_t)(32 * w + r32) * 128 + 16 * ks + 8 * hi); a2 = MFMA32(a, bb, a2); }
#pragma unroll
        for (int r = 0; r < 16; ++r) { const int i = i0 + crow(r, hi); if (i < 255) O[(size_t)i * 64 + 32 * w + r32] = f2bf(a2[r]); }
    }
    __syncthreads();
}

constexpr int NSA_KCH = 1024 + 16, NSA_VDH = 4096 + 64, NSA_KIMG = 8 * NSA_KCH, NSA_VIMG = 2 * NSA_VDH, NSA_BUF = NSA_KIMG + NSA_VIMG;
constexpr int NSA_IMP = 2 * NSA_BUF, NSA_IST = 65, NSA_TOT = NSA_IMP + 256 * NSA_IST * 4,
              NSA_SELB = MISC_OFF + 1024, NSA_UNI = NSA_SELB + 512;
constexpr int NSA_FAC = NSA_TOT + 64 * NSA_IST * 4;
constexpr int NSA_STASH = 96 * 1024;
static_assert(4 * NSA_BUF <= NSA_STASH && NSA_FAC + 4096 <= MISC_OFF && NSA_STASH + 8 * 4096 <= MISC_OFF, "NSA LDS map");

__device__ __forceinline__ void nsa_qk(LAS const unsigned char* kimg, const bf16x8 (&qr)[4], unsigned kfo, f32x16& p0, f32x16& p1) {
    bf16x8 kf[8];
#pragma unroll
    for (int d0 = 0; d0 < 4; ++d0) { kf[2 * d0] = *(LAS const bf16x8*)(kimg + kfo + d0 * (2 * NSA_KCH)); kf[2 * d0 + 1] = *(LAS const bf16x8*)(kimg + kfo + d0 * (2 * NSA_KCH) + 512); }
    __builtin_amdgcn_sched_barrier(0);
    p0 = (f32x16){0}; p1 = (f32x16){0};
#pragma unroll
    for (int d0 = 0; d0 < 4; ++d0) { p0 = MFMA32(kf[2 * d0], qr[d0], p0); p1 = MFMA32(kf[2 * d0 + 1], qr[d0], p1); }
}
constexpr float NSA_THR = 8.f;
template <int KIND>
__device__ __forceinline__ void nsa_tile(LAS const unsigned char* kimg, LAS const unsigned char* vimg, const bf16x8 (&qr)[4], int kbase, int t, bool edge, bool rowvalid,
                                         float& m, float& l, f32x16& o0, f32x16& o1, unsigned kfo, unsigned vfo, int hi) {
    f32x16 p0, p1; nsa_qk(kimg, qr, kfo, p0, p1);
    if (edge) {
#pragma unroll
        for (int r = 0; r < 16; ++r) { const int k0 = kbase + crow(r, hi), k1 = k0 + 32; bool v0, v1;
            if (KIND == 1) { v0 = k0 <= t; v1 = k1 <= t; } else { v0 = k0 <= t && k0 >= t - 511; v1 = k1 <= t && k1 >= t - 511; }
            p0[r] = v0 ? p0[r] : -INFINITY; p1[r] = v1 ? p1[r] : -INFINITY; }
    }
    float mx = fmaxf(p0[0], p1[0]);
#pragma unroll
    for (int r = 1; r < 16; ++r) mx = fmaxf(mx, fmaxf(p0[r], p1[r]));
    mx = rowvalid ? mx : -INFINITY;
    mx = fmaxf(mx, __shfl_xor(mx, 32));
    if (__any(mx - m > NSA_THR)) {
        const float mn = fmaxf(m, mx); const float alpha = ex2(m - mn); m = mn; l *= alpha;
#pragma unroll
        for (int r = 0; r < 16; ++r) { o0[r] *= alpha; o1[r] *= alpha; }
    }
    const float me = rowvalid ? m : INFINITY;
    float rs = 0.f;
#pragma unroll
    for (int r = 0; r < 16; ++r) { p0[r] = ex2(p0[r] - me); p1[r] = ex2(p1[r] - me); rs += p0[r] + p1[r]; }
    l += rs;
    u32x4 pw[4];
#pragma unroll
    for (int s = 0; s < 2; ++s) {
        pw[s].x = cvtpk(p0[8 * s + 0], p0[8 * s + 1]); pw[s].y = cvtpk(p0[8 * s + 2], p0[8 * s + 3]); pw[s].z = cvtpk(p0[8 * s + 4], p0[8 * s + 5]); pw[s].w = cvtpk(p0[8 * s + 6], p0[8 * s + 7]);
        pw[2 + s].x = cvtpk(p1[8 * s + 0], p1[8 * s + 1]); pw[2 + s].y = cvtpk(p1[8 * s + 2], p1[8 * s + 3]); pw[2 + s].z = cvtpk(p1[8 * s + 4], p1[8 * s + 5]); pw[2 + s].w = cvtpk(p1[8 * s + 6], p1[8 * s + 7]);
    }
    bf16x8 vf[8];
#pragma unroll
    for (int ks = 0; ks < 4; ++ks) { vf[2 * ks] = mk8(vtr(vimg + vfo + ks * 1024), vtr(vimg + vfo + ks * 1024 + 512)); vf[2 * ks + 1] = mk8(vtr(vimg + vfo + NSA_VDH + ks * 1024), vtr(vimg + vfo + NSA_VDH + ks * 1024 + 512)); }
    __builtin_amdgcn_sched_barrier(0);
#pragma unroll
    for (int ks = 0; ks < 4; ++ks) { o0 = MFMA32(vf[2 * ks], __builtin_bit_cast(bf16x8, pw[ks]), o0); o1 = MFMA32(vf[2 * ks + 1], __builtin_bit_cast(bf16x8, pw[ks]), o1); }
}

template <int KIND>
__device__ __forceinline__ void nsa_tile2(LAS const unsigned char* kA, LAS const unsigned char* vA, LAS const unsigned char* kB, LAS const unsigned char* vB, bool hasB,
                                          const bf16x8 (&qr)[4], int kbA, int kbB, int t, bool edgeA, bool edgeB, bool rvA, bool rvB,
                                          float& m, float& l, f32x16& o0, f32x16& o1, unsigned kfo, unsigned vfo, int hi) {
    f32x16 a0, a1, b0, b1;
    nsa_qk(kA, qr, kfo, a0, a1);
    __builtin_amdgcn_sched_barrier(0);
    if (hasB) nsa_qk(kB, qr, kfo, b0, b1);
    else {
#pragma unroll
        for (int r = 0; r < 16; ++r) { b0[r] = -INFINITY; b1[r] = -INFINITY; } }
    if (edgeA) {
#pragma unroll
        for (int r = 0; r < 16; ++r) { const int k0 = kbA + crow(r, hi), k1 = k0 + 32; bool v0, v1;
            if (KIND == 1) { v0 = k0 <= t; v1 = k1 <= t; } else { v0 = k0 <= t && k0 >= t - 511; v1 = k1 <= t && k1 >= t - 511; }
            a0[r] = v0 ? a0[r] : -INFINITY; a1[r] = v1 ? a1[r] : -INFINITY; } }
    if (edgeB) {
#pragma unroll
        for (int r = 0; r < 16; ++r) { const int k0 = kbB + crow(r, hi), k1 = k0 + 32; bool v0, v1;
            if (KIND == 1) { v0 = k0 <= t; v1 = k1 <= t; } else { v0 = k0 <= t && k0 >= t - 511; v1 = k1 <= t && k1 >= t - 511; }
            b0[r] = v0 ? b0[r] : -INFINITY; b1[r] = v1 ? b1[r] : -INFINITY; } }
    __builtin_amdgcn_sched_barrier(0);
    const bool fresh = m < -1e29f; const float mb = fresh ? 0.f : m;
    const float meA = rvA ? mb : INFINITY, meB = rvB ? mb : INFINITY;
#pragma unroll
    for (int r = 0; r < 16; ++r) { a0[r] -= meA; a1[r] -= meA; b0[r] -= meB; b1[r] -= meB; }
    float mx = fmaxf(fmaxf(a0[0], a1[0]), fmaxf(b0[0], b1[0]));
#pragma unroll
    for (int r = 1; r < 16; ++r) mx = fmaxf(mx, fmaxf(fmaxf(a0[r], a1[r]), fmaxf(b0[r], b1[r])));
    mx = fmaxf(mx, __shfl_xor(mx, 32));
    const bool has = mx > -INFINITY;
    const float delta = fresh ? (has ? mx : 0.f) : (mx > NSA_THR ? mx : 0.f);
    if (__any(delta != 0.f)) {
        const float alpha = fresh ? 1.f : ex2(-delta); l *= alpha;
#pragma unroll
        for (int r = 0; r < 16; ++r) { o0[r] *= alpha; o1[r] *= alpha; a0[r] -= delta; a1[r] -= delta; b0[r] -= delta; b1[r] -= delta; }
    }
    m = fresh ? (has ? mx : m) : m + delta;
    float rs = 0.f;
#pragma unroll
    for (int r = 0; r < 16; ++r) { a0[r] = ex2(a0[r]); a1[r] = ex2(a1[r]); b0[r] = ex2(b0[r]); b1[r] = ex2(b1[r]); rs += (a0[r] + a1[r]) + (b0[r] + b1[r]); }
    l += rs;
    __builtin_amdgcn_sched_barrier(0);
    {
        u32x4 pw[4];
#pragma unroll
        for (int s = 0; s < 2; ++s) {
            pw[s].x = cvtpk(a0[8 * s + 0], a0[8 * s + 1]); pw[s].y = cvtpk(a0[8 * s + 2], a0[8 * s + 3]); pw[s].z = cvtpk(a0[8 * s + 4], a0[8 * s + 5]); pw[s].w = cvtpk(a0[8 * s + 6], a0[8 * s + 7]);
            pw[2 + s].x = cvtpk(a1[8 * s + 0], a1[8 * s + 1]); pw[2 + s].y = cvtpk(a1[8 * s + 2], a1[8 * s + 3]); pw[2 + s].z = cvtpk(a1[8 * s + 4], a1[8 * s + 5]); pw[2 + s].w = cvtpk(a1[8 * s + 6], a1[8 * s + 7]); }
        bf16x8 vf[8];
#pragma unroll
        for (int ks = 0; ks < 4; ++ks) { vf[2 * ks] = mk8(vtr(vA + vfo + ks * 1024), vtr(vA + vfo + ks * 1024 + 512)); vf[2 * ks + 1] = mk8(vtr(vA + vfo + NSA_VDH + ks * 1024), vtr(vA + vfo + NSA_VDH + ks * 1024 + 512)); }
        __builtin_amdgcn_sched_barrier(0);
#pragma unroll
        for (int ks = 0; ks < 4; ++ks) { o0 = MFMA32(vf[2 * ks], __builtin_bit_cast(bf16x8, pw[ks]), o0); o1 = MFMA32(vf[2 * ks + 1], __builtin_bit_cast(bf16x8, pw[ks]), o1); }
    }
    __builtin_amdgcn_sched_barrier(0);
    if (hasB) {
        u32x4 pw[4];
#pragma unroll
        for (int s = 0; s < 2; ++s) {
            pw[s].x = cvtpk(b0[8 * s + 0], b0[8 * s + 1]); pw[s].y = cvtpk(b0[8 * s + 2], b0[8 * s + 3]); pw[s].z = cvtpk(b0[8 * s + 4], b0[8 * s + 5]); pw[s].w = cvtpk(b0[8 * s + 6], b0[8 * s + 7]);
            pw[2 + s].x = cvtpk(b1[8 * s + 0], b1[8 * s + 1]); pw[2 + s].y = cvtpk(b1[8 * s + 2], b1[8 * s + 3]); pw[2 + s].z = cvtpk(b1[8 * s + 4], b1[8 * s + 5]); pw[2 + s].w = cvtpk(b1[8 * s + 6], b1[8 * s + 7]); }
        bf16x8 vf[8];
#pragma unroll
        for (int ks = 0; ks < 4; ++ks) { vf[2 * ks] = mk8(vtr(vB + vfo + ks * 1024), vtr(vB + vfo + ks * 1024 + 512)); vf[2 * ks + 1] = mk8(vtr(vB + vfo + NSA_VDH + ks * 1024), vtr(vB + vfo + NSA_VDH + ks * 1024 + 512)); }
        __builtin_amdgcn_sched_barrier(0);
#pragma unroll
        for (int ks = 0; ks < 4; ++ks) { o0 = MFMA32(vf[2 * ks], __builtin_bit_cast(bf16x8, pw[ks]), o0); o1 = MFMA32(vf[2 * ks + 1], __builtin_bit_cast(bf16x8, pw[ks]), o1); }
    }
}

#define NPIN(x) asm volatile("" : "+v"(x))
__device__ __forceinline__ void glds16(const void* g, unsigned lds_base) {
    unsigned sv; asm volatile("s_mov_b32 %0, m0\n\ts_mov_b32 m0, %2\n\ts_nop 0\n\tglobal_load_lds_dwordx4 %1, off\n\ts_mov_b32 m0, %0" : "=&s"(sv) : "v"(g), "s"(lds_base) : "memory"); }
#define NSB() __builtin_amdgcn_sched_barrier(0)
#define NMX3(a, b, c) fmaxf(fmaxf((a), (b)), (c))
__device__ __forceinline__ float nsa_rowmax(const f32x16& p0, const f32x16& p1) {
    float a = NMX3(p0[0], p0[1], p1[0]), b = NMX3(p0[2], p0[3], p1[1]); a = NMX3(a, p1[2], p1[3]);
#pragma unroll
    for (int r = 4; r < 16; r += 4) { a = NMX3(a, p0[r], p0[r + 1]); b = NMX3(b, p0[r + 2], p0[r + 3]); a = NMX3(a, p1[r], p1[r + 1]); b = NMX3(b, p1[r + 2], p1[r + 3]); }
    const float m = fmaxf(a, b); const auto rr = __builtin_amdgcn_permlane32_swap(__float_as_uint(m), __float_as_uint(m), false, false);
    return fmaxf(__uint_as_float(rr[0]), __uint_as_float(rr[1])); }
template <int KIND>
__device__ __forceinline__ void nsa_mask(f32x16& p0, f32x16& p1, int kbase, int t, int hi) {
#pragma unroll
    for (int r = 0; r < 16; ++r) { const int k0 = kbase + crow(r, hi), k1 = k0 + 32; bool v0, v1;
        if (KIND == 1) { v0 = k0 <= t; v1 = k1 <= t; } else { v0 = k0 <= t && k0 >= t - 511; v1 = k1 <= t && k1 >= t - 511; }
        p0[r] = v0 ? p0[r] : -INFINITY; p1[r] = v1 ? p1[r] : -INFINITY; } }
template <int KIND>
__device__ __forceinline__ void nsa_pipe(LAS unsigned char* L, const bf16_t* Kp, const bf16_t* Vp, unsigned mlo, unsigned mhi, unsigned sel0, unsigned sel1,
                                         const bf16x8 (&qr)[4], int t, int lane, int w, int hi, unsigned kfo, unsigned vfo,
                                         float& lsum, f32x16& o0, f32x16& o1,
                                         int& sbase, bool pre, const bf16_t* Kn, const bf16_t* Vn, unsigned nlo, unsigned nhi) {
    unsigned ulo = mlo, uhi = mhi;
    const bf16_t* ksrc = Kp + lane * 64 + w * 8; const bf16_t* vsrc = Vp + (16 * (w & 3) + (lane >> 2)) * 64 + (w >> 2) * 32 + (lane & 3) * 8;
    const unsigned kdst = (unsigned)(uintptr_t)L + w * NSA_KCH, vdst = (unsigned)(uintptr_t)L + NSA_KIMG + (w >> 2) * NSA_VDH + (w & 3) * 1024;
#define NP_DMAS(KS, VS, j, sl) do { const int ps_ = ((sl) + sbase) & 3; glds16((KS) + (size_t)(j) * 4096, (unsigned)__builtin_amdgcn_readfirstlane(kdst + ps_ * NSA_BUF)); glds16((VS) + (size_t)(j) * 4096, (unsigned)__builtin_amdgcn_readfirstlane(vdst + ps_ * NSA_BUF)); } while (0)
#define NP_DMA(j, sl) NP_DMAS(ksrc, vsrc, j, sl)
#define NP_DMAWAIT() asm volatile("s_waitcnt vmcnt(0)" ::: "memory")
    const int n = __builtin_popcount(ulo) + __builtin_popcount(uhi);
#define NP_NEXT(jv) do { jv = -1; if (ulo | uhi) { jv = ulo ? __builtin_ctz(ulo) : 32 + __builtin_ctz(uhi); if (ulo) ulo &= ulo - 1; else uhi &= uhi - 1; } } while (0)
#define NP_SELBIT(j) ((((j) < 32 ? (sel0 >> ((j) & 31)) : (sel1 >> (((j) - 32) & 31))) & 1u) != 0u)
#define NP_KIMG(sl) (L + (((sl) + sbase) & 3) * NSA_BUF)
#define NP_VIMG(sl) (L + (((sl) + sbase) & 3) * NSA_BUF + NSA_KIMG)
    int jc, jn1, jn2;
    NP_NEXT(jc); NP_NEXT(jn1); NP_NEXT(jn2);
    if (!pre) { NP_DMA(jc, 0); if (jn1 >= 0) NP_DMA(jn1, 1); if (jn2 >= 0) NP_DMA(jn2, 2); }
    NP_DMAWAIT();
    __syncthreads();
    float m = -1e30f, cin = 0.f, l = 0.f, fsc = 1.f; bool resc = false;
    o0 = (f32x16){0}; o1 = (f32x16){0};
    f32x16 pA0, pA1, pB0, pB1, ci16; bf16x8 kf[8]; s16x4 vlo[8], vhi[8]; u32x4 pw0, pw1, pw2, pw3;
#define NP_KLOAD2(sl, d0) do { kf[2 * (d0)] = *(LAS const bf16x8*)(NP_KIMG(sl) + kfo + (d0) * (2 * NSA_KCH)); kf[2 * (d0) + 1] = *(LAS const bf16x8*)(NP_KIMG(sl) + kfo + (d0) * (2 * NSA_KCH) + 512); } while (0)
#define NP_SPLAT(v) do { _Pragma("unroll") for (int r = 0; r < 16; ++r) ci16[r] = (v); } while (0)
#define NP_CINIT(jt) do { if (KIND == 1) { const float c_ = NP_SELBIT(jt) ? cin : -INFINITY; NP_SPLAT(c_); } } while (0)
#define NP_DECIDE(C0, C1) do { const float rm_ = nsa_rowmax(C0, C1); const bool fresh_ = m < -1e29f; \
        const bool grow_ = fresh_ ? (rm_ > -INFINITY) : (rm_ > NSA_THR); resc = false; \
        if (__any(grow_)) { const float dl_ = grow_ ? rm_ : 0.f; fsc = (grow_ && !fresh_) ? ex2(-rm_) : 1.f; m = grow_ ? (fresh_ ? rm_ : m + rm_) : m; cin = grow_ ? -m : cin; l *= fsc; resc = true; \
            _Pragma("unroll") for (int r = 0; r < 16; ++r) { C0[r] -= dl_; C1[r] -= dl_; } \
            if (KIND == 2) NP_SPLAT(cin); } } while (0)
    { _Pragma("unroll") for (int d0 = 0; d0 < 4; ++d0) NP_KLOAD2(0, d0);
      if (KIND == 2) NP_SPLAT(0.f); else NP_CINIT(jc);
      NSB();
      pA0 = MFMA32(kf[0], qr[0], ci16); pA1 = MFMA32(kf[1], qr[0], ci16);
      _Pragma("unroll") for (int d0 = 1; d0 < 4; ++d0) { pA0 = MFMA32(kf[2 * d0], qr[d0], pA0); pA1 = MFMA32(kf[2 * d0 + 1], qr[d0], pA1); }
      nsa_mask<KIND>(pA0, pA1, 64 * jc, t, hi);
      NP_DECIDE(pA0, pA1);
      _Pragma("unroll") for (int r = 0; r < 16; ++r) { pA0[r] = ex2(pA0[r]); pA1[r] = ex2(pA1[r]); }
      if (jn1 >= 0) { _Pragma("unroll") for (int d0 = 0; d0 < 4; ++d0) NP_KLOAD2(1, d0); }
      jc = jn1; jn1 = jn2; NP_NEXT(jn2); }
    int s = 1;
#define NP_PKW(P, i) cvtpk(P[i], P[(i) + 1])
#define NP_VFR(i) mk8(vlo[i], vhi[i])
#define NP_VRD(i) do { LAS const unsigned char* a_ = vp_ + ((i) >> 1) * 1024 + ((i) & 1) * NSA_VDH; vlo[i] = vtr(a_); vhi[i] = vtr(a_ + 512); } while (0)
#define NP_GAPA(MF, a0, a1, a2, a3, W0, W1, PW) do { MF; sacc += a0; sacc += a1; sacc += a2; sacc += a3; W0; W1; NPIN(PW); NPIN(sacc); NSB(); } while (0)
#define NP_GAPB(MF, X, i) do { MF; X[i] = ex2(X[i]); X[(i) + 1] = ex2(X[(i) + 1]); X[(i) + 2] = ex2(X[(i) + 2]); X[(i) + 3] = ex2(X[(i) + 3]); NPIN(X); NSB(); } while (0)
#define NP_KRD(GL, d0) do { if (GL) { NP_KLOAD2(sn_, d0); NSB(); } } while (0)
#define NP_STEP(C0, C1, P0, P1, LAST) do { NSB(); \
    const int sp_ = (s - 1) & 3, sn_ = (s + 1) & 3, sw_ = (s + 2) & 3; \
    if (!(LAST) && jn2 >= 0) NP_DMA(jn2, sw_);     \
    LAS const unsigned char* vp_ = NP_VIMG(sp_) + vfo; \
    NP_CINIT(jc); \
    float sacc = P0[0] + P0[1]; NSB(); \
    NP_GAPA(C0 = MFMA32(kf[0], qr[0], ci16), P0[2], P0[3], P0[4], P0[5],     pw0[0] = NP_PKW(P0, 0),  pw0[1] = NP_PKW(P0, 2),  pw0); \
    NP_GAPA(C1 = MFMA32(kf[1], qr[0], ci16), P0[6], P0[7], P0[8], P0[9],     pw0[2] = NP_PKW(P0, 4),  pw0[3] = NP_PKW(P0, 6),  pw0); \
    NP_GAPA(C0 = MFMA32(kf[2], qr[1], C0),            P0[10], P0[11], P0[12], P0[13], pw1[0] = NP_PKW(P0, 8),  pw1[1] = NP_PKW(P0, 10), pw1); \
    NP_GAPA(C1 = MFMA32(kf[3], qr[1], C1),            P0[14], P0[15], P1[0], P1[1],   pw1[2] = NP_PKW(P0, 12), pw1[3] = NP_PKW(P0, 14), pw1); \
    NP_GAPA(C0 = MFMA32(kf[4], qr[2], C0),            P1[2], P1[3], P1[4], P1[5],     pw2[0] = NP_PKW(P1, 0),  pw2[1] = NP_PKW(P1, 2),  pw2); \
    NP_GAPA(C1 = MFMA32(kf[5], qr[2], C1),            P1[6], P1[7], P1[8], P1[9],     pw2[2] = NP_PKW(P1, 4),  pw2[3] = NP_PKW(P1, 6),  pw2); \
    NP_GAPA(C0 = MFMA32(kf[6], qr[3], C0),            P1[10], P1[11], P1[12], P1[13], pw3[0] = NP_PKW(P1, 8),  pw3[1] = NP_PKW(P1, 10), pw3); \
    NP_GAPA(C1 = MFMA32(kf[7], qr[3], C1),            P1[14], P1[15], 0.f, 0.f,       pw3[2] = NP_PKW(P1, 12), pw3[3] = NP_PKW(P1, 14), pw3); \
    l += sacc; \
    NP_VRD(0); NP_VRD(1); NP_VRD(2); NP_VRD(3); NSB();     \
    if (LAST) nsa_mask<KIND>(C0, C1, 64 * jc, t, hi); \
    NP_DECIDE(C0, C1); NSB(); \
    NP_VRD(4); NSB(); NP_GAPB(o0 = MFMA32(NP_VFR(0), __builtin_bit_cast(bf16x8, pw0), o0), C0, 0); \
    NP_VRD(5); NSB(); NP_GAPB(o1 = MFMA32(NP_VFR(1), __builtin_bit_cast(bf16x8, pw0), o1), C0, 4); \
    NP_VRD(6); NSB(); NP_KRD(!(LAST), 0); NP_GAPB(o0 = MFMA32(NP_VFR(2), __builtin_bit_cast(bf16x8, pw1), o0), C0, 8); \
    NP_VRD(7); NSB(); NP_KRD(!(LAST), 1); NP_GAPB(o1 = MFMA32(NP_VFR(3), __builtin_bit_cast(bf16x8, pw1), o1), C0, 12); \
    NP_KRD(!(LAST), 2); NP_GAPB(o0 = MFMA32(NP_VFR(4), __builtin_bit_cast(bf16x8, pw2), o0), C1, 0); \
    NP_KRD(!(LAST), 3); NP_GAPB(o1 = MFMA32(NP_VFR(5), __builtin_bit_cast(bf16x8, pw2), o1), C1, 4); \
    NP_GAPB(o0 = MFMA32(NP_VFR(6), __builtin_bit_cast(bf16x8, pw3), o0), C1, 8);  NP_GAPB(o1 = MFMA32(NP_VFR(7), __builtin_bit_cast(bf16x8, pw3), o1), C1, 12); \
    NP_DMAWAIT(); \
    __syncthreads(); \
    if (resc) { _Pragma("unroll") for (int r = 0; r < 16; ++r) { o0[r] *= fsc; o1[r] *= fsc; } } \
    jc = jn1; jn1 = jn2; NP_NEXT(jn2); ++s; } while (0)
    int rem = n - 1;
    if (n & 1) { pB0 = pA0; pB1 = pA1; if (rem > 0) { NP_STEP(pA0, pA1, pB0, pB1, false); --rem; } }
    while (rem >= 3) { NP_STEP(pB0, pB1, pA0, pA1, false); NP_STEP(pA0, pA1, pB0, pB1, false); rem -= 2; }
    if (rem == 1) { NP_STEP(pB0, pB1, pA0, pA1, true); }
    if (Kn) {
        unsigned vlo_ = nlo, vhi_ = nhi; const bf16_t* ks2 = Kn + lane * 64 + w * 8; const bf16_t* vs2 = Vn + (16 * (w & 3) + (lane >> 2)) * 64 + (w >> 2) * 32 + (lane & 3) * 8;
        _Pragma("unroll") for (int i = 0; i < 3; ++i) { if (vlo_ | vhi_) { const int j2 = vlo_ ? __builtin_ctz(vlo_) : 32 + __builtin_ctz(vhi_); if (vlo_) vlo_ &= vlo_ - 1; else vhi_ &= vhi_ - 1;
            NP_DMAS(ks2, vs2, j2, n + i); } } }
    { float sacc = pB0[0] + pB0[1];
      _Pragma("unroll") for (int r = 2; r < 16; ++r) sacc += pB0[r];
      _Pragma("unroll") for (int r = 0; r < 16; ++r) sacc += pB1[r];
      l += sacc;
      pw0 = (u32x4){NP_PKW(pB0, 0), NP_PKW(pB0, 2), NP_PKW(pB0, 4), NP_PKW(pB0, 6)}; pw1 = (u32x4){NP_PKW(pB0, 8), NP_PKW(pB0, 10), NP_PKW(pB0, 12), NP_PKW(pB0, 14)};
      pw2 = (u32x4){NP_PKW(pB1, 0), NP_PKW(pB1, 2), NP_PKW(pB1, 4), NP_PKW(pB1, 6)}; pw3 = (u32x4){NP_PKW(pB1, 8), NP_PKW(pB1, 10), NP_PKW(pB1, 12), NP_PKW(pB1, 14)};
      LAS const unsigned char* vp_ = NP_VIMG((n - 1) & 3) + vfo;
      _Pragma("unroll") for (int i = 0; i < 8; ++i) NP_VRD(i);
      NSB();
      o0 = MFMA32(NP_VFR(0), __builtin_bit_cast(bf16x8, pw0), o0); o1 = MFMA32(NP_VFR(1), __builtin_bit_cast(bf16x8, pw0), o1);
      o0 = MFMA32(NP_VFR(2), __builtin_bit_cast(bf16x8, pw1), o0); o1 = MFMA32(NP_VFR(3), __builtin_bit_cast(bf16x8, pw1), o1);
      o0 = MFMA32(NP_VFR(4), __builtin_bit_cast(bf16x8, pw2), o0); o1 = MFMA32(NP_VFR(5), __builtin_bit_cast(bf16x8, pw2), o1);
      o0 = MFMA32(NP_VFR(6), __builtin_bit_cast(bf16x8, pw3), o0); o1 = MFMA32(NP_VFR(7), __builtin_bit_cast(bf16x8, pw3), o1); }
    __syncthreads();
    lsum = l; sbase = (sbase + n) & 3;
#undef NP_DMA
#undef NP_DMAS
#undef NP_DMAWAIT
#undef NP_NEXT
#undef NP_SELBIT
#undef NP_KIMG
#undef NP_VIMG
#undef NP_KLOAD2
#undef NP_SPLAT
#undef NP_CINIT
#undef NP_DECIDE
#undef NP_PKW
#undef NP_VFR
#undef NP_VRD
#undef NP_GAPA
#undef NP_GAPB
#undef NP_KRD
#undef NP_STEP
}

__device__ __forceinline__ void nsa_unit(Frame& F, int b, int g, int qb) {
    int tid = F.tid; asm volatile("" : "+v"(tid));
    const int lane = tid & 63, w = F.wave, r32 = lane & 31, hi = lane >> 5;
    const int hh = 4 * g + (w & 3), th = w >> 2, cur = qb, T0 = qb * 64, tokl = 32 * th + r32, t = T0 + tokl;
    const size_t row = (size_t)b * SEQ + t; const int bg = b * 2 + g;
    LAS unsigned char* L = F.lds;
    bf16x8 qr[4];
    { const bf16_t* qp = WSP(bf16_t, WS_NQ) + row * 512 + hh * 64 + 8 * hi;
#pragma unroll
      for (int d0 = 0; d0 < 4; ++d0) qr[d0] = *(const bf16x8*)(qp + 16 * d0); }
    const float* gp = WSP(float, WS_NGT) + row * 24 + hh * 3; const float gate_c = gp[0], gate_s = gp[1], gate_w = gp[2];
    unsigned outp0[8], outp1[8];
    const unsigned kst = (tid & 7) * NSA_KCH + (tid >> 3) * 16, vst = ((tid & 7) >> 2) * NSA_VDH + (tid >> 3) * 64 + (tid & 3) * 16;
    const unsigned kfo = hi * NSA_KCH + r32 * 16, vfo = tr_lane_off(lane);
    float m, l; f32x16 o0, o1;
    u32x4 rk, rv;
#define NSA_LOAD(Kp, Vp, tile) do { rk = *(const u32x4*)((Kp) + (size_t)(tile) * 4096 + tid * 8); rv = *(const u32x4*)((Vp) + (size_t)(tile) * 4096 + tid * 8); } while (0)
#define NSA_WRITE(buf) do { *(LAS u32x4*)(L + (buf) * NSA_BUF + kst) = rk; *(LAS u32x4*)(L + (buf) * NSA_BUF + NSA_KIMG + vst) = rv; } while (0)
#define NSA_NEXT(jv) do { jv = -1; if (ulo | uhi) { jv = ulo ? __builtin_ctz(ulo) : 32 + __builtin_ctz(uhi); if (ulo) ulo &= ulo - 1; else uhi &= uhi - 1; } } while (0)
#define NSA_RUN(Kp, Vp, MLO, MHI, ...) do { unsigned ulo = (MLO), uhi = (MHI); int j, j1, j2; u32x4 rk2, rv2; \
        NSA_NEXT(j); NSA_LOAD(Kp, Vp, j); NSA_WRITE(0); NSA_NEXT(j1); if (j1 >= 0) NSA_LOAD(Kp, Vp, j1); __syncthreads(); int buf = 0; \
        for (;;) { NSA_NEXT(j2); if (j2 >= 0) { rk2 = *(const u32x4*)((Kp) + (size_t)j2 * 4096 + tid * 8); rv2 = *(const u32x4*)((Vp) + (size_t)j2 * 4096 + tid * 8); } \
            { LAS const unsigned char* KI = L + buf * NSA_BUF; LAS const unsigned char* VI = KI + NSA_KIMG; __VA_ARGS__ } \
            if (j1 >= 0) NSA_WRITE(buf ^ 1); __syncthreads(); if (j1 < 0) break; j = j1; j1 = j2; rk = rk2; rv = rv2; buf ^= 1; } } while (0)
#define NSA_LOAD2(Kp, Vp, ja, jb) do { rk = *(const u32x4*)((Kp) + (size_t)(ja) * 4096 + tid * 8); rv = *(const u32x4*)((Vp) + (size_t)(ja) * 4096 + tid * 8); \
        if ((jb) >= 0) { rkB = *(const u32x4*)((Kp) + (size_t)(jb) * 4096 + tid * 8); rvB = *(const u32x4*)((Vp) + (size_t)(jb) * 4096 + tid * 8); } } while (0)
#define NSA_WRITE2(pb, jb) do { LAS unsigned char* P_ = L + (pb) * (2 * NSA_BUF); *(LAS u32x4*)(P_ + kst) = rk; *(LAS u32x4*)(P_ + NSA_KIMG + vst) = rv; \
        if ((jb) >= 0) { *(LAS u32x4*)(P_ + NSA_BUF + kst) = rkB; *(LAS u32x4*)(P_ + NSA_BUF + NSA_KIMG + vst) = rvB; } } while (0)
#define NSA_RUN2(Kp, Vp, MLO, MHI, ...) do { unsigned ulo = (MLO), uhi = (MHI); int ja, jb, na, nb; u32x4 rkB, rvB; \
        NSA_NEXT(ja); NSA_NEXT(jb); NSA_LOAD2(Kp, Vp, ja, jb); NSA_WRITE2(0, jb); __syncthreads(); int pbuf = 0; \
        for (;;) { NSA_NEXT(na); NSA_NEXT(nb); if (na >= 0) NSA_LOAD2(Kp, Vp, na, nb); \
            { LAS const unsigned char* KA = L + pbuf * (2 * NSA_BUF); LAS const unsigned char* VA = KA + NSA_KIMG; LAS const unsigned char* KB = KA + NSA_BUF; LAS const unsigned char* VB = KB + NSA_KIMG; __VA_ARGS__ } \
            if (na >= 0) NSA_WRITE2(pbuf ^ 1, nb); __syncthreads(); if (na < 0) break; ja = na; jb = nb; pbuf ^= 1; } } while (0)
#define NSA_LT(lv) ({ const auto rr_ = __builtin_amdgcn_permlane32_swap(__float_as_uint(lv), __float_as_uint(lv), false, false); __uint_as_float(rr_[0]) + __uint_as_float(rr_[1]); })
#define NSA_RESET() do { m = -1e30f; l = 0.f; o0 = (f32x16){0}; o1 = (f32x16){0}; } while (0)

    const bf16_t* Kc = WSP(bf16_t, WS_KCMP) + (size_t)bg * 256 * 64; const bf16_t* Vc = WSP(bf16_t, WS_VCMP) + (size_t)bg * 256 * 64;
    const int ntc = ((4 * cur + 2) >> 6) + 1; const int lim = (t >= 31) ? ((t - 31) >> 4) : -1;
    const int tmin_w = T0 + 32 * th; const int lim_min = (tmin_w >= 31) ? ((tmin_w - 31) >> 4) : -1;
    unsigned sel0, sel1, un0, un1;
    {
        LAS float* IMP = (LAS float*)(L + NSA_IMP); LAS float* FAC = (LAS float*)(L + NSA_FAC);
        float carry = 0.f; const bool need_imp = cur >= 16;
        float mt0 = 0.f, mt1 = 0.f, mt2 = 0.f, mt3 = 0.f;
        m = -1e30f; l = 0.f; o0 = (f32x16){0}; o1 = (f32x16){0};
        NSA_RUN(Kc, Vc, (1u << ntc) - 1u, 0u, {
            f32x16 p0, p1; nsa_qk(KI, qr, kfo, p0, p1);
            if (64 * j + 63 > lim_min) {
                _Pragma("unroll") for (int r = 0; r < 16; ++r) { const int k0 = 64 * j + crow(r, hi);
                    p0[r] = (k0 <= lim) ? p0[r] : -INFINITY; p1[r] = (k0 + 32 <= lim) ? p1[r] : -INFINITY; } }
            { const float rm = nsa_rowmax(p0, p1); const bool fresh = m < -1e29f; const bool grow = fresh ? (rm > -INFINITY) : (rm - m > NSA_THR);
              if (__any(grow)) { const float mn = grow ? rm : m; const float f = (grow && !fresh) ? ex2(m - mn) : 1.f; m = mn; l *= f; carry *= f;
                  _Pragma("unroll") for (int r = 0; r < 16; ++r) { o0[r] *= f; o1[r] *= f; } } }
            if (j == 0) mt0 = m; else if (j == 1) mt1 = m; else if (j == 2) mt2 = m; else mt3 = m;
            { float rs = 0.f;
              _Pragma("unroll") for (int r = 0; r < 16; ++r) { p0[r] = ex2(p0[r] - m); p1[r] = ex2(p1[r] - m); rs += p0[r] + p1[r]; }
              l += rs; }
            if (need_imp) {
                _Pragma("unroll") for (int n = 0; n < 2; ++n) {
                    float a[4], bq[4], pb[4];
                    _Pragma("unroll") for (int q4 = 0; q4 < 4; ++q4) { const float x0 = n ? p1[4 * q4] : p0[4 * q4], x1 = n ? p1[4 * q4 + 1] : p0[4 * q4 + 1], x2 = n ? p1[4 * q4 + 2] : p0[4 * q4 + 2], x3 = n ? p1[4 * q4 + 3] : p0[4 * q4 + 3];
                        a[q4] = 2.f * (x0 + x1 + x2) + x3; bq[q4] = x3; }
                    _Pragma("unroll") for (int q4 = 0; q4 < 4; ++q4) pb[q4] = __shfl_xor(bq[q4], 32);
                    _Pragma("unroll") for (int q4 = 0; q4 < 4; ++q4) { const float prevb = hi ? pb[q4] : (q4 ? pb[q4 > 0 ? q4 - 1 : 0] : carry);
                        IMP[((w & 3) * 64 + tokl) * NSA_IST + 16 * j + 8 * n + 2 * q4 + hi] = a[q4] + prevb; }
                    carry = pb[3];
                } }
            u32x4 pw[4];
            _Pragma("unroll") for (int s = 0; s < 2; ++s) {
                pw[s].x = cvtpk(p0[8 * s + 0], p0[8 * s + 1]); pw[s].y = cvtpk(p0[8 * s + 2], p0[8 * s + 3]); pw[s].z = cvtpk(p0[8 * s + 4], p0[8 * s + 5]); pw[s].w = cvtpk(p0[8 * s + 6], p0[8 * s + 7]);
                pw[2 + s].x = cvtpk(p1[8 * s + 0], p1[8 * s + 1]); pw[2 + s].y = cvtpk(p1[8 * s + 2], p1[8 * s + 3]); pw[2 + s].z = cvtpk(p1[8 * s + 4], p1[8 * s + 5]); pw[2 + s].w = cvtpk(p1[8 * s + 6], p1[8 * s + 7]); }
            _Pragma("unroll") for (int ks = 0; ks < 4; ++ks) {
                const bf16x8 v0 = mk8(vtr(VI + vfo + ks * 1024), vtr(VI + vfo + ks * 1024 + 512));
                const bf16x8 v1 = mk8(vtr(VI + vfo + NSA_VDH + ks * 1024), vtr(VI + vfo + NSA_VDH + ks * 1024 + 512));
                o0 = MFMA32(v0, __builtin_bit_cast(bf16x8, pw[ks]), o0); o1 = MFMA32(v1, __builtin_bit_cast(bf16x8, pw[ks]), o1); } });
        const float inv_c = 1.f / fmaxf(NSA_LT(l), 1e-30f); const float gs_ = gate_c * inv_c;
        _Pragma("unroll") for (int r = 0; r < 8; ++r) { outp0[r] = cvtpk(gs_ * o0[2 * r], gs_ * o0[2 * r + 1]); outp1[r] = cvtpk(gs_ * o1[2 * r], gs_ * o1[2 * r + 1]); }
        if (need_imp) {
            if (hi == 0) { f32x4 fc; fc[0] = ex2(mt0 - m) * inv_c; fc[1] = ntc > 1 ? ex2(mt1 - m) * inv_c : 0.f; fc[2] = ntc > 2 ? ex2(mt2 - m) * inv_c : 0.f; fc[3] = ntc > 3 ? ex2(mt3 - m) * inv_c : 0.f;
                *(LAS f32x4*)(FAC + ((w & 3) * 64 + tokl) * 4) = fc; }
            __syncthreads(); }
    }
    if (cur >= 16) {
        LAS float* IMP = (LAS float*)(L + NSA_IMP);
        LAS unsigned* TOT = (LAS unsigned*)(L + NSA_TOT); LAS unsigned char* SELB = L + NSA_SELB; LAS unsigned* UNI = (LAS unsigned*)(L + NSA_UNI);
        { const int tk = tid >> 3, jg = tid & 7; LAS const float* FAC = (LAS const float*)(L + NSA_FAC);
          float fq[4];
#pragma unroll
          for (int h4 = 0; h4 < 4; ++h4) fq[h4] = FAC[(h4 * 64 + tk) * 4 + (jg >> 1)];
#pragma unroll
          for (int jj = 0; jj < 8; ++jj) { const int jx = 8 * jg + jj;
              const float tot = ((IMP[tk * NSA_IST + jx] * fq[0] + IMP[(64 + tk) * NSA_IST + jx] * fq[1]) + IMP[(128 + tk) * NSA_IST + jx] * fq[2]) + IMP[(192 + tk) * NSA_IST + jx] * fq[3];
              TOT[tk * NSA_IST + jx] = (__float_as_uint(tot) & ~63u) | (unsigned)(63 - jx); }
          if (tid < 2) UNI[tid] = 0u; }
        __syncthreads();
        { const int tk = tid >> 3, jg = tid & 7; unsigned bits = 0u;
          unsigned v[8]; int rank[8];
#pragma unroll
          for (int jj = 0; jj < 8; ++jj) { v[jj] = TOT[tk * NSA_IST + 8 * jg + jj]; rank[jj] = 0; }
#pragma unroll 4
          for (int k2 = 1; k2 <= cur - 2; ++k2) { const unsigned v2 = TOT[tk * NSA_IST + k2];
#pragma unroll
              for (int jj = 0; jj < 8; ++jj) rank[jj] += (int)(v2 > v[jj]); }
#pragma unroll
          for (int jj = 0; jj < 8; ++jj) { const int jx = 8 * jg + jj;
              const bool s = (jx == 0 || jx == cur || jx == cur - 1) || (jx < cur - 1 && rank[jj] < 13);
              bits |= s ? (1u << jj) : 0u; }
          SELB[tk * 8 + jg] = (unsigned char)bits;
          atomicOr((unsigned*)&UNI[jg >> 2], bits << (8 * (jg & 3))); }
        __syncthreads();
        sel0 = *(LAS const unsigned*)(SELB + tokl * 8); sel1 = *(LAS const unsigned*)(SELB + tokl * 8 + 4);
        un0 = __builtin_amdgcn_readfirstlane(UNI[0]); un1 = __builtin_amdgcn_readfirstlane(UNI[1]);
    } else {
        sel0 = (1u << (cur + 1)) - 1u; sel1 = 0u; un0 = sel0; un1 = 0u;
    }
    LAS unsigned* ST = (LAS unsigned*)(L + NSA_STASH + w * 4096) + lane;
#pragma unroll
    for (int r = 0; r < 8; ++r) { ST[r * 64] = outp0[r]; ST[(8 + r) * 64] = outp1[r]; }
    const bf16_t* Ks = WSP(bf16_t, WS_KSL) + (size_t)bg * SEQ * 64; const bf16_t* Vs = WSP(bf16_t, WS_VSL) + (size_t)bg * SEQ * 64;
    const bf16_t* Kw = WSP(bf16_t, WS_KWN) + (size_t)bg * SEQ * 64; const bf16_t* Vw = WSP(bf16_t, WS_VWN) + (size_t)bg * SEQ * 64;
    const int jlo = cur >= 8 ? cur - 8 : 0;
    const unsigned long long wm = ((cur == 63) ? ~0ull : ((1ull << (cur + 1)) - 1ull)) & ~((1ull << jlo) - 1ull);
    int sbase = 0;
    nsa_pipe<1>(L, Ks, Vs, un0, un1, sel0, sel1, qr, t, lane, w, hi, kfo, vfo, l, o0, o1, sbase, false, Kw, Vw, (unsigned)wm, (unsigned)(wm >> 32));
    { const float sc = gate_s / fmaxf(NSA_LT(l), 1e-30f);
#pragma unroll
      for (int r = 0; r < 8; ++r) { const unsigned a = ST[r * 64], c = ST[(8 + r) * 64];
          ST[r * 64] = cvtpk(bflo(a) + sc * o0[2 * r], bfhi(a) + sc * o0[2 * r + 1]); ST[(8 + r) * 64] = cvtpk(bflo(c) + sc * o1[2 * r], bfhi(c) + sc * o1[2 * r + 1]); } }
    nsa_pipe<2>(L, Kw, Vw, (unsigned)wm, (unsigned)(wm >> 32), 0u, 0u, qr, t, lane, w, hi, kfo, vfo, l, o0, o1, sbase, true, nullptr, nullptr, 0u, 0u);
    { const float sc = gate_w / fmaxf(NSA_LT(l), 1e-30f);
      bf16_t* yo = WSP(bf16_t, WS_YCAT) + row * 1024 + 512 + hh * 64;
#pragma unroll
      for (int p2 = 0; p2 < 2; ++p2) { u32x2 av[2], cv[2];
#pragma unroll
          for (int e = 0; e < 2; ++e) { const int q4 = 2 * p2 + e;
              const unsigned a0 = ST[(2 * q4) * 64], a1 = ST[(2 * q4 + 1) * 64], c0 = ST[(8 + 2 * q4) * 64], c1 = ST[(9 + 2 * q4) * 64];
              av[e].x = cvtpk(bflo(a0) + sc * o0[4 * q4], bfhi(a0) + sc * o0[4 * q4 + 1]); av[e].y = cvtpk(bflo(a1) + sc * o0[4 * q4 + 2], bfhi(a1) + sc * o0[4 * q4 + 3]);
              cv[e].x = cvtpk(bflo(c0) + sc * o1[4 * q4], bfhi(c0) + sc * o1[4 * q4 + 1]); cv[e].y = cvtpk(bflo(c1) + sc * o1[4 * q4 + 2], bfhi(c1) + sc * o1[4 * q4 + 3]); }
          *(u32x4*)(yo + 16 * p2 + 8 * hi) = widen_pair(av[0], av[1]); *(u32x4*)(yo + 32 + 16 * p2 + 8 * hi) = widen_pair(cv[0], cv[1]); } }
#undef NSA_LOAD
#undef NSA_WRITE
#undef NSA_RUN
#undef NSA_RUN2
#undef NSA_LOAD2
#undef NSA_WRITE2
#undef NSA_LT
#undef NSA_RESET
}

__device__ __forceinline__ void s6_phase(Frame& F) {
    int tid = F.tid; asm volatile("" : "+v"(tid));
    const int lane = tid & 63, w = F.wave;
    LAS unsigned char* TILE = F.lds + w * 16384;
    LAS float* LG = (LAS float*)(F.lds + MISC_OFF + 4096) + w * (8 * 48);
    LAS int* REC_E = (LAS int*)(F.lds + MISC_OFF + 16384);
    LAS float* REC_G = (LAS float*)(F.lds + MISC_OFF + 16384 + 1024);
    LAS int* REC_P = (LAS int*)(F.lds + MISC_OFF + 16384 + 2048);
    LAS int* CNTL = (LAS int*)(F.lds + MISC_OFF + 16384 + 3072);
    LAS float* SAW = (LAS float*)(F.lds + MISC_OFF + 16384 + 3584);
    const float* x = IN_F(0); const float* wpost = IN_F(6); const float* wffn = IN_F(7); const float* mod = WSP(float, WS_MOD);
    const bf16_t* Y = WSP(bf16_t, WS_Y); bf16_t* X1B = WSP(bf16_t, WS_X1B); signed char* H2Q = (signed char*)(F.ws + WS_H2Q); float* SAv = WSP(float, WS_SA); const _Float16* RWT = WSP(_Float16, WS_RWT);
    const float* bgp = IN_F(21); const float* bep = IN_F(23);
    unsigned* cntg = (unsigned*)(F.ws + WS_CTL) + CW_CNT;
    for (int rb = F.vcu; rb < NTOK / 128; rb += F.G) {
        if (tid < 64) CNTL[tid] = 0;
        __syncthreads();
        const int rbase = rb * 128 + w * 16, b = rbase >> 12;
        f32x4 xv[4][4]; u32x4 yw[4][2];
#define S6_LOAD(g) do { _Pragma("unroll") for (int r = 0; r < 4; ++r) { const size_t ro_ = (size_t)(rbase + 4 * (g) + r) * DM; \
            _Pragma("unroll") for (int j = 0; j < 4; ++j) xv[r][j] = __builtin_nontemporal_load((const f32x4*)(x + ro_ + 4 * lane + 256 * j)); \
            _Pragma("unroll") for (int jp = 0; jp < 2; ++jp) yw[r][jp] = __builtin_nontemporal_load((const u32x4*)(Y + ro_ + 4 * (lane & ~1) + 256 * (2 * jp + (lane & 1)))); } } while (0)
#define S6_Y(r, j) ((f32x4){bflo(yr[r][j].x), bfhi(yr[r][j].x), bflo(yr[r][j].y), bfhi(yr[r][j].y)})
        S6_LOAD(0);
#pragma nounroll
        for (int g = 0; g < 4; ++g) {
            u32x2 yr[4][4];
#pragma unroll
            for (int r = 0; r < 4; ++r)
#pragma unroll
                for (int jp = 0; jp < 2; ++jp) pair_narrow(yw[r][jp], lane, yr[r][2 * jp], yr[r][2 * jp + 1]);
            int l4 = 4 * lane; asm volatile("" : "+v"(l4));
            float ss[4];
#pragma unroll
            for (int r = 0; r < 4; ++r) { float a2 = 0.f;
#pragma unroll
                for (int j = 0; j < 4; ++j) { const f32x4 y = S6_Y(r, j); a2 += y[0] * y[0] + y[1] * y[1] + y[2] * y[2] + y[3] * y[3]; }
                ss[r] = a2; }
#pragma unroll
            for (int o = 1; o < 64; o <<= 1) {
#pragma unroll
                for (int r = 0; r < 4; ++r) ss[r] += __shfl_xor(ss[r], o); }
            float s2[4] = {0.f, 0.f, 0.f, 0.f};
#pragma unroll
            for (int j = 0; j < 4; ++j) { const int k = l4 + 256 * j;
                const f32x4 wp = *(const f32x4*)(wpost + k), gm = *(const f32x4*)(mod + b * 6144 + 2048 + k); const f32x4 gw2 = gm * wp;
#pragma unroll
                for (int r = 0; r < 4; ++r) { const float r1 = rsqrtf(ss[r] * (1.f / DM) + RMS_EPS);
                    xv[r][j] = xv[r][j] + gw2 * (S6_Y(r, j) * r1);
                    s2[r] += xv[r][j][0] * xv[r][j][0] + xv[r][j][1] * xv[r][j][1] + xv[r][j][2] * xv[r][j][2] + xv[r][j][3] * xv[r][j][3]; } }
#pragma unroll
            for (int r = 0; r < 4; ++r)
#pragma unroll
                for (int jp = 0; jp < 2; ++jp) { u32x2 pa, pb; pa.x = cvtpk(xv[r][2 * jp][0], xv[r][2 * jp][1]); pa.y = cvtpk(xv[r][2 * jp][2], xv[r][2 * jp][3]);
                    pb.x = cvtpk(xv[r][2 * jp + 1][0], xv[r][2 * jp + 1][1]); pb.y = cvtpk(xv[r][2 * jp + 1][2], xv[r][2 * jp + 1][3]);
                    __builtin_nontemporal_store(pair_widen(pa, pb, lane), (u32x4*)(X1B + (size_t)(rbase + 4 * g + r) * DM + 4 * (lane & ~1) + 256 * (2 * jp + (lane & 1)))); }
#pragma unroll
            for (int o = 1; o < 64; o <<= 1) {
#pragma unroll
                for (int r = 0; r < 4; ++r) s2[r] += __shfl_xor(s2[r], o); }
#pragma unroll
            for (int j = 0; j < 4; ++j) { const int k = l4 + 256 * j;
                const f32x4 wf = *(const f32x4*)(wffn + k), sh = *(const f32x4*)(mod + b * 6144 + 3072 + k), sc = *(const f32x4*)(mod + b * 6144 + 4096 + k); const f32x4 ws = wf * (sc + 1.f);
#pragma unroll
                for (int r = 0; r < 4; ++r) { const float r2 = rsqrtf(s2[r] * (1.f / DM) + RMS_EPS);
                    const f32x4 h = xv[r][j] * r2 * ws + sh;
                    { const int rt = 4 * (g & 1) + r; const f16x4 hh = {(_Float16)h[0], (_Float16)h[1], (_Float16)h[2], (_Float16)h[3]};
                      *(LAS f16x4*)(TILE + rt * 2048 + (((lane >> 1) ^ rt) << 4) + (lane & 1) * 8 + 512 * j) = hh; }
                    xv[r][j] = h; } }
            float am[4];
#pragma unroll
            for (int r = 0; r < 4; ++r) { float a = 0.f;
#pragma unroll
                for (int j = 0; j < 4; ++j) a = fmaxf(a, fmaxf(fmaxf(fabsf(xv[r][j][0]), fabsf(xv[r][j][1])), fmaxf(fabsf(xv[r][j][2]), fabsf(xv[r][j][3]))));
                am[r] = a; }
#pragma unroll
            for (int o = 1; o < 64; o <<= 1) {
#pragma unroll
                for (int r = 0; r < 4; ++r) am[r] = fmaxf(am[r], __shfl_xor(am[r], o)); }
#pragma unroll
            for (int r = 0; r < 4; ++r) { const float inv = am[r] > 0.f ? 127.f / am[r] : 0.f; const size_t ro = (size_t)(rbase + 4 * g + r) * DM;
                if (lane == 0) { SAv[rbase + 4 * g + r] = am[r] * (1.f / 127.f); SAW[(w * 16 + 4 * g + r)] = am[r] * (1.f / 127.f); }
                u32x4 pk;
#pragma unroll
                for (int j = 0; j < 4; ++j) { const f32x4 q = xv[r][j] * inv;
                    const int q0 = (int)rintf(q[0]), q1 = (int)rintf(q[1]), q2 = (int)rintf(q[2]), q3 = (int)rintf(q[3]);
                    pk[j] = (unsigned)(q0 & 0xff) | ((unsigned)(q1 & 0xff) << 8) | ((unsigned)(q2 & 0xff) << 16) | ((unsigned)(q3 & 0xff) << 24); }
                *(u32x4*)(H2Q + ro + 256 * (lane & 3) + 16 * (lane >> 2)) = quad_transpose(pk, lane); }
            __builtin_amdgcn_sched_barrier(0);
            if (g < 3) S6_LOAD(g + 1);
            __builtin_amdgcn_sched_barrier(0);
            if (g & 1) {
                const int r16 = lane & 15, q = lane >> 4, rt = r16 & 7;
                f32x4 a0 = {0.f, 0.f, 0.f, 0.f}, a1 = a0, a2 = a0;
                LAS const unsigned char* ae = TILE + rt * 2048 + ((q ^ rt) << 4); LAS const unsigned char* ao = TILE + rt * 2048 + (((q ^ rt) ^ 4) << 4);
                const _Float16* bp = RWT + (size_t)r16 * DM + 8 * q;
#pragma unroll 4
                for (int k2 = 0; k2 < 16; ++k2) {
                    const f16x8 ah0 = *(LAS const f16x8*)(ae + 128 * k2), ah1 = *(LAS const f16x8*)(ao + 128 * k2);
                    const f16x8 b00 = *(const f16x8*)(bp + 64 * k2), b01 = *(const f16x8*)(bp + 64 * k2 + 16 * DM), b02 = *(const f16x8*)(bp + 64 * k2 + 32 * DM);
                    const f16x8 b10 = *(const f16x8*)(bp + 64 * k2 + 32), b11 = *(const f16x8*)(bp + 64 * k2 + 32 + 16 * DM), b12 = *(const f16x8*)(bp + 64 * k2 + 32 + 32 * DM);
                    a0 = __builtin_amdgcn_mfma_f32_16x16x32_f16(ah0, b00, a0, 0, 0, 0); a1 = __builtin_amdgcn_mfma_f32_16x16x32_f16(ah0, b01, a1, 0, 0, 0); a2 = __builtin_amdgcn_mfma_f32_16x16x32_f16(ah0, b02, a2, 0, 0, 0);
                    a0 = __builtin_amdgcn_mfma_f32_16x16x32_f16(ah1, b10, a0, 0, 0, 0); a1 = __builtin_amdgcn_mfma_f32_16x16x32_f16(ah1, b11, a1, 0, 0, 0); a2 = __builtin_amdgcn_mfma_f32_16x16x32_f16(ah1, b12, a2, 0, 0, 0); }
                if (q < 2) {
#pragma unroll
                    for (int i = 0; i < 4; ++i) { LG[(4 * q + i) * 48 + r16] = a0[i]; LG[(4 * q + i) * 48 + 16 + r16] = a1[i]; LG[(4 * q + i) * 48 + 32 + r16] = a2[i]; } }
                asm volatile("s_waitcnt lgkmcnt(0)" ::: "memory");
                if (lane < 8) {
                    const LAS float* lg = LG + lane * 48;
                    float gl[4]; int gi = 0; float gmx = -INFINITY;
#pragma unroll
                    for (int i = 0; i < 4; ++i) { gl[i] = lg[i] + bgp[i]; if (gl[i] > gmx) { gmx = gl[i]; gi = i; } }
                    float gs = 0.f;
#pragma unroll
                    for (int i = 0; i < 4; ++i) gs += __expf(gl[i] - gmx);
                    const float pg = 1.f / gs;
                    float el[8]; float emx = -INFINITY;
#pragma unroll
                    for (int i = 0; i < 8; ++i) { el[i] = lg[4 + gi * 8 + i] + bep[gi * 8 + i]; emx = fmaxf(emx, el[i]); }
                    int e0 = 0; float v0 = -INFINITY;
#pragma unroll
                    for (int i = 0; i < 8; ++i) if (el[i] > v0) { v0 = el[i]; e0 = i; }
                    int e1 = 0; float v1 = -INFINITY;
#pragma unroll
                    for (int i = 0; i < 8; ++i) if (i != e0 && el[i] > v1) { v1 = el[i]; e1 = i; }
                    const float p0 = __expf(v0 - emx), p1 = __expf(v1 - emx);
                    const float g0 = pg * p0 / (p0 + p1), g1 = pg * p1 / (p0 + p1);
                    const int rl = w * 16 + 8 * (g >> 1) + lane; const int E0 = gi * 8 + e0, E1 = gi * 8 + e1;
                    REC_E[rl * 2] = E0; REC_E[rl * 2 + 1] = E1; REC_G[rl * 2] = g0; REC_G[rl * 2 + 1] = g1;
                    REC_P[rl * 2] = atomicAdd((int*)&CNTL[E0], 1); REC_P[rl * 2 + 1] = atomicAdd((int*)&CNTL[E1], 1);
                }
                asm volatile("s_waitcnt lgkmcnt(0)" ::: "memory");
            }
        }
#undef S6_LOAD
#undef S6_Y
        __syncthreads();
        if (tid < 32) { const int c = CNTL[tid]; CNTL[32 + tid] = c ? (int)__hip_atomic_fetch_add(cntg + tid, (unsigned)c, __ATOMIC_RELAXED, __HIP_MEMORY_SCOPE_AGENT) : 0; }
        __syncthreads();
        if (tid < 256) { const int rl = tid >> 1, k = tid & 1; const int row = rb * 128 + rl; const int e = REC_E[tid]; const int p = CNTL[32 + e] + REC_P[tid];
            WSP(int, WS_TOKE)[row * 2 + k] = e; WSP(int, WS_TOKP)[row * 2 + k] = p; WSP(float, WS_TOKG)[row * 2 + k] = REC_G[tid];
            WSP(int, WS_LIST)[(size_t)e * 65536 + p] = row; WSP(float, WS_SAL)[(size_t)e * 65536 + p] = SAW[rl]; }
        __syncthreads();
    }
}

__device__ __forceinline__ void expert_convert(Frame& F) {
    {
        int tid = F.tid; asm volatile("" : "+v"(tid));
        LAS unsigned* AM = (LAS unsigned*)F.lds;
        const int n4 = tid & 7, kq = tid >> 3;
        for (int it = F.vcu; it < 1024; it += F.G) {
            const int e = it >> 5, sel = (it >> 4) & 1, j0 = (it & 15) * 32;
            const float* W = IN_F(sel ? 25 : 24) + (size_t)e * 1024 * 512 + (size_t)(16 * kq) * 512 + j0 + 4 * n4;
            if (tid < 32) AM[tid] = 0u;
            __syncthreads();
            f32x4 v[16]; f32x4 am = {0.f, 0.f, 0.f, 0.f};
#pragma unroll
            for (int i = 0; i < 16; ++i) { v[i] = *(const f32x4*)(W + (size_t)i * 512);
#pragma unroll
                for (int c = 0; c < 4; ++c) am[c] = fmaxf(am[c], fabsf(v[i][c])); }
#pragma unroll
            for (int o = 8; o < 64; o <<= 1) {
#pragma unroll
                for (int c = 0; c < 4; ++c) am[c] = fmaxf(am[c], __shfl_xor(am[c], o)); }
            if ((tid & 63) < 8) {
#pragma unroll
                for (int c = 0; c < 4; ++c) atomicMax((unsigned*)&AM[4 * n4 + c], __float_as_uint(am[c])); }
            __syncthreads();
            const f32x4 amax = *(LAS const f32x4*)((LAS const float*)AM + 4 * n4);
            unsigned char* dst = (unsigned char*)(F.ws + WS_W13T) + ((size_t)e * 1024 + 8 * ((j0 >> 2) + n4) + 4 * sel) * 1024 + 16 * kq;
#pragma unroll
            for (int c = 0; c < 4; ++c) { const float inv = amax[c] > 0.f ? 127.f / amax[c] : 0.f; u32x4 o;
#pragma unroll
                for (int d = 0; d < 4; ++d) {
                    const int q0 = (int)rintf(v[4 * d][c] * inv), q1 = (int)rintf(v[4 * d + 1][c] * inv), q2 = (int)rintf(v[4 * d + 2][c] * inv), q3 = (int)rintf(v[4 * d + 3][c] * inv);
                    o[d] = (unsigned)(q0 & 0xff) | ((unsigned)(q1 & 0xff) << 8) | ((unsigned)(q2 & 0xff) << 16) | ((unsigned)(q3 & 0xff) << 24); }
                *(u32x4*)(dst + (size_t)c * 1024) = o;
                if (kq == 0) WSP(float, WS_SB13)[e * 1024 + 8 * ((j0 >> 2) + n4) + 4 * sel + c] = amax[c] * (1.f / 127.f); }
            __syncthreads();
        }
    }
}
__device__ __forceinline__ void w2_convert(Frame& F, int rk, int nsh) {
    LAS float* scr = (LAS float*)(F.lds + F.wave * 8448);
    const int gw = rk * NWAVES + F.wave, NGW = nsh * NWAVES;
    for (int it = gw; it < 32 * 256; it += NGW) {
        const int e = it >> 8, r = it & 255;
        transpose_item(IN_F(26) + (size_t)e * 512 * 1024, 1024, WSP(bf16_t, WS_W2T) + (size_t)e * 1024 * 512, 512, scr, (r / 32) * 64, (r % 32) * 32, F.lane, RmId{0});
    }
    __syncthreads();
}

__device__ __forceinline__ void moe_tables(Frame& F, LAS int* tstart, LAS int* cnt) {
    if (F.tid < 64) {
        const int lane = F.tid; const unsigned* cg = (const unsigned*)(F.ws + WS_CTL) + CW_CNT;
        const int c = lane < 32 ? (int)__hip_atomic_load(cg + lane, __ATOMIC_RELAXED, __HIP_MEMORY_SCOPE_AGENT) : 0;
        const int tl = (c + 255) >> 8; int incl = tl;
#pragma unroll
        for (int o = 1; o < 32; o <<= 1) { const int x = __shfl_up(incl, o); if (lane >= o) incl += x; }
        if (lane < 32) { cnt[lane] = c; tstart[lane] = incl - tl; LAS unsigned char* et = (LAS unsigned char*)(tstart + 96);
            for (int t2 = incl - tl; t2 < incl; ++t2) et[t2] = (unsigned char)lane; }
        if (lane == 31) tstart[32] = incl; }
    __syncthreads();
}

__device__ __forceinline__ void s10_phase(Frame& F, LAS int* tstart) {
    const int gw = F.vcu * NWAVES + F.wave, NGW = F.G * NWAVES, lane = F.lane;
    const float* wpost = IN_F(8); const float* mod = WSP(float, WS_MOD); const bf16_t* YB = WSP(bf16_t, WS_YB); const bf16_t* X1B = WSP(bf16_t, WS_X1B);
    int ne0[4], ne1[4], np0[4], np1[4]; float ng0[4], ng1[4];
#define S10_TAB(rw) do { _Pragma("unroll") for (int r = 0; r < 4; ++r) { const int row_ = (rw) + r; \
        ne0[r] = WSP(int, WS_TOKE)[row_ * 2]; ne1[r] = WSP(int, WS_TOKE)[row_ * 2 + 1]; np0[r] = WSP(int, WS_TOKP)[row_ * 2]; np1[r] = WSP(int, WS_TOKP)[row_ * 2 + 1]; \
        ng0[r] = WSP(float, WS_TOKG)[row_ * 2]; ng1[r] = WSP(float, WS_TOKG)[row_ * 2 + 1]; } } while (0)
    if (gw * 4 < NTOK) S10_TAB(gw * 4);
    for (int row0 = gw * 4; row0 < NTOK; row0 += NGW * 4) {
        const int b = row0 >> 12;
        size_t r0[4], r1[4]; float g0[4], g1[4];
#pragma unroll
        for (int r = 0; r < 4; ++r) { r0[r] = (size_t)tstart[ne0[r]] * 256 + np0[r]; r1[r] = (size_t)tstart[ne1[r]] * 256 + np1[r]; g0[r] = ng0[r]; g1[r] = ng1[r]; }
        if (row0 + NGW * 4 < NTOK) S10_TAB(row0 + NGW * 4);
        f32x4 yv[4][4]; float ss[4];
        u32x4 xw[4][2];
#pragma unroll
        for (int r = 0; r < 4; ++r) { float a2 = 0.f;
            u32x4 wa[2], wc[2];
#pragma unroll
            for (int jp = 0; jp < 2; ++jp) { const int ko = 4 * (lane & ~1) + 256 * (2 * jp + (lane & 1));
                wa[jp] = __builtin_nontemporal_load((const u32x4*)(YB + r0[r] * DM + ko)); wc[jp] = __builtin_nontemporal_load((const u32x4*)(YB + r1[r] * DM + ko));
                xw[r][jp] = __builtin_nontemporal_load((const u32x4*)(X1B + (size_t)(row0 + r) * DM + ko)); }
#pragma unroll
            for (int jp = 0; jp < 2; ++jp) { u32x2 a[2], c[2]; pair_narrow(wa[jp], lane, a[0], a[1]); pair_narrow(wc[jp], lane, c[0], c[1]);
#pragma unroll
                for (int e = 0; e < 2; ++e) { const int j = 2 * jp + e;
                    yv[r][j] = (f32x4){bflo(a[e].x), bfhi(a[e].x), bflo(a[e].y), bfhi(a[e].y)} * g0[r] + (f32x4){bflo(c[e].x), bfhi(c[e].x), bflo(c[e].y), bfhi(c[e].y)} * g1[r];
                    a2 += yv[r][j][0] * yv[r][j][0] + yv[r][j][1] * yv[r][j][1] + yv[r][j][2] * yv[r][j][2] + yv[r][j][3] * yv[r][j][3]; } }
            ss[r] = a2; }
#pragma unroll
        for (int o = 1; o < 64; o <<= 1) {
#pragma unroll
            for (int r = 0; r < 4; ++r) ss[r] += __shfl_xor(ss[r], o); }
#pragma unroll
        for (int jp = 0; jp < 2; ++jp) {
#pragma unroll
            for (int r = 0; r < 4; ++r) { const float rr = rsqrtf(ss[r] * (1.f / DM) + RMS_EPS);
                u32x2 xb[2]; pair_narrow(xw[r][jp], lane, xb[0], xb[1]);
#pragma unroll
                for (int e = 0; e < 2; ++e) { const int j = 2 * jp + e, k = 4 * lane + 256 * j;
                    const f32x4 wp = *(const f32x4*)(wpost + k), gf = *(const f32x4*)(mod + b * 6144 + 5120 + k); const f32x4 gw2 = gf * wp;
                    const f32x4 x1 = (f32x4){bflo(xb[e].x), bfhi(xb[e].x), bflo(xb[e].y), bfhi(xb[e].y)};
                    __builtin_nontemporal_store(x1 + gw2 * (yv[r][j] * rr), (f32x4*)(F.out + (size_t)(row0 + r) * DM + k)); } } }
    }
}

#undef S10_TAB
#ifndef DBG_STOP
#define DBG_STOP -1
#endif
#if DBG_STOP >= 0
struct DbgBuf { size_t off, n; int f32, ph; };
__device__ __forceinline__ void dbg_phase(Frame& F, const XcdBarrier& bar) {
    const DbgBuf bufs[] = {
        {WS_MOD, 8 * 6144, 1, 0}, {WS_COS, (size_t)NTOK * 32, 1, 0}, {WS_SIN, (size_t)NTOK * 32, 1, 0}, {WS_WINT, (size_t)INWP * 1024, 0, 0}, {WS_WOUTT, 1024 * 1024, 0, 0},
        {WS_CW1K, 128 * 2048, 0, 0}, {WS_CW2K, 64 * 128, 0, 0}, {WS_RWT, 48 * 1024, 0, 0}, {WS_C1B, 256, 1, 0},
        {WS_H1, (size_t)NTOK * 1024, 0, 1},
        {WS_MQ, (size_t)NTOK * 2048, 0, 2}, {WS_NQ, (size_t)NTOK * 512, 0, 2}, {WS_KC, (size_t)NTOK * 128 * 6, 0, 2}, {WS_GI, 2 * 8 * 4 * 4096, 1, 2}, {WS_NGT, (size_t)NTOK * 24, 1, 2},
        {WS_KVC, (size_t)2048 * 16384, 0, 3}, {WS_NC, 2048 * 128, 1, 3}, {WS_GSUM, 4096, 1, 3}, {WS_KCMP, 2 * 16 * 256 * 64, 0, 3},
        {WS_CPREV, (size_t)2048 * 16384, 0, 4}, {WS_NPREV, 2048 * 128, 1, 4}, {WS_MPREV, 2048, 1, 4},
        {WS_YCAT, (size_t)NTOK * 1024, 0, 5}, {WS_W13T, (size_t)32 * 1024 * 1024, 0, 5}, {WS_W2T, (size_t)32 * 1024 * 512, 0, 5},
        {WS_Y, (size_t)NTOK * 1024, 0, 6}, {WS_H2, (size_t)NTOK * 1024, 0, 7}, {WS_TOKG, (size_t)NTOK * 2, 1, 7},
        {WS_HB, (size_t)65536 * 512, 0, 8}, {WS_YB, (size_t)65536 * 1024, 0, 9} };
    constexpr int NBUF = sizeof(bufs) / sizeof(bufs[0]);
    unsigned* flag = (unsigned*)(F.ws + WS_CTL) + CW_DBG;
    const size_t gt = (size_t)blockIdx.x * NTHR + F.tid, NG = (size_t)F.G * NTHR;
    for (int i = 0; i < NBUF; ++i) {
        if (bufs[i].ph > DBG_STOP) continue;
        if ((bufs[i].off == WS_H1 && DBG_STOP >= 3) || (bufs[i].off == WS_WINT && DBG_STOP >= 4) || (bufs[i].off == WS_KVC && DBG_STOP >= 5) || (bufs[i].off == WS_NQ && DBG_STOP >= 5) || (bufs[i].off == WS_KC && DBG_STOP >= 9) ||
            (bufs[i].off == WS_MQ && DBG_STOP >= 6) || (bufs[i].off == WS_CPREV && DBG_STOP >= 8) || (bufs[i].off == WS_Y && DBG_STOP >= 9) || (bufs[i].off == WS_H2 && DBG_STOP >= 9) || (bufs[i].off == WS_W13T && DBG_STOP < 5)) continue;
        bool bad = false;
        if (bufs[i].f32) { const unsigned* p = (const unsigned*)(F.ws + bufs[i].off); for (size_t k = gt; k < bufs[i].n; k += NG) bad |= ((p[k] & 0x7f800000u) == 0x7f800000u); }
        else { const unsigned* p = (const unsigned*)(F.ws + bufs[i].off); for (size_t k = gt; k < bufs[i].n / 2; k += NG) { const unsigned v = p[k]; bad |= ((v & 0x7f80u) == 0x7f80u) || ((v & 0x7f800000u) == 0x7f800000u); } }
        if (bufs[i].off == WS_YCAT) { bool bm = false, bn = false; const unsigned* p = (const unsigned*)(F.ws + WS_YCAT);
            for (size_t k = gt; k < bufs[i].n / 2; k += NG) { const unsigned v = p[k]; const bool b2 = ((v & 0x7f80u) == 0x7f80u) || ((v & 0x7f800000u) == 0x7f800000u); if ((k & 511) < 256) bm |= b2; else bn |= b2; }
            if (__any(bm) && F.lane == 0) atomicMin(flag, 23u); if (__any(bn) && F.lane == 0) atomicMin(flag, 33u); continue; }
        if (__any(bad) && F.lane == 0) atomicMin(flag, (unsigned)(i + 1));
    }
    if (DBG_STOP >= 7) { bool bad = false; const unsigned* p = (const unsigned*)F.out; for (size_t k = gt; k < (size_t)NTOK * DM; k += NG) bad |= ((p[k] & 0x7f800000u) == 0x7f800000u); if (__any(bad) && F.lane == 0) atomicMin(flag, 40u); }
    xcd_barrier(bar);
    const unsigned id = __hip_atomic_load(flag, __ATOMIC_RELAXED, __HIP_MEMORY_SCOPE_AGENT);
    const float sc = (id >= 1000u) ? 1.f : 1.f + (float)id;
    const float* x = IN_F(0);
    for (size_t k = gt; k < (size_t)NTOK * DM; k += NG) F.out[k] = x[k] * sc;
}
#endif


#if DBG_STOP >= 0
__device__ __forceinline__ unsigned dbg_hash(unsigned x) { x ^= x >> 16; x *= 0x7feb352du; x ^= x >> 15; x *= 0x846ca68bu; x ^= x >> 16; return x; }
__device__ __forceinline__ float dbg_bfr(float f) { return bf2f(f2bf(f)); }
__device__ float dbg_z(Frame& F, int row, int c) { const signed char* h = (const signed char*)(F.ws + WS_H1) + (size_t)row * 1024; const float* w = IN_F(9); float am = 0.f;
    for (int k = 0; k < 1024; ++k) am = fmaxf(am, fabsf(w[(size_t)k * INW + c]));
    const float inv = am > 0.f ? 127.f / am : 0.f; float s = 0.f; for (int k = 0; k < 1024; ++k) s += (float)h[k] * rintf(w[(size_t)k * INW + c] * inv);
    return s * WSP(float, WS_SA1)[row] * (am * (1.f / 127.f)); }
__device__ __forceinline__ bool dbg_close(float a, float b) { return fabsf(a - b) <= 0.02f * fabsf(b) + 0.02f; }
__device__ void dbg_check_p1(Frame& F, unsigned* cnt) {
    const int gt = blockIdx.x * NTHR + F.tid; if (gt >= 8192) return;
    const int row = dbg_hash(gt * 2 + 1) % NTOK; int c = dbg_hash(gt * 2 + 2) % INW; if (gt < 64) c = 2048 + (gt & 7); if (gt >= 64 && gt < 256) c = 3336 + (gt % 24);
    const int b = row >> 12, sq = row & 4095; const float* COS = WSP(float, WS_COS); const float* SIN = WSP(float, WS_SIN);
    float ref, got;
    if (c < 2048) { ref = dbg_z(F, row, c); got = bf2f(WSP(bf16_t, c < 512 ? WS_MQ : c < 1024 ? WS_MK : c < 1536 ? WS_MV : WS_MO)[(size_t)row * 512 + (c & 511)]); }
    else if (c < 2052) { ref = dbg_z(F, row, c) + IN_F(11)[c - 2048]; got = WSP(float, WS_GI)[(size_t)(b * 4 + c - 2048) * SEQ + sq]; }
    else if (c < 2056) { ref = logsigmoid_f(dbg_z(F, row, c) + IN_F(11)[4 + c - 2052]); got = WSP(float, WS_GF)[(size_t)(b * 4 + c - 2052) * SEQ + sq]; }
    else if (c >= 3336) { ref = sigmoid_f(dbg_z(F, row, c)); got = WSP(float, WS_NGT)[(size_t)row * 24 + c - 3336]; }
    else {
        int base, x; size_t ws_off; bool rope, isq = false;
        if (c < 2568) { base = 2056; x = c - base; rope = true; isq = true; ws_off = WS_NQ; }
        else if (c < 2696) { base = 2568; x = c - base; rope = true; ws_off = WS_KC; }
        else if (c < 2824) { base = 2696; x = c - base; rope = false; ws_off = WS_VC; }
        else if (c < 2952) { base = 2824; x = c - base; rope = true; ws_off = WS_KSL; }
        else if (c < 3080) { base = 2952; x = c - base; rope = false; ws_off = WS_VSL; }
        else if (c < 3208) { base = 3080; x = c - base; rope = true; ws_off = WS_KWN; }
        else { base = 3208; x = c - base; rope = false; ws_off = WS_VWN; }
        const int hd = x >> 6, d = x & 63;
        if (rope) { const float z0 = dbg_z(F, row, c), z1 = dbg_z(F, row, base + hd * 64 + (d ^ 32)); const float cs = COS[(size_t)row * 32 + (d & 31)], sn = SIN[(size_t)row * 32 + (d & 31)];
            ref = d < 32 ? z0 * cs - z1 * sn : z0 * cs + z1 * sn; if (isq) ref *= QSCALE; }
        else ref = dbg_z(F, row, c);
        got = isq ? bf2f(WSP(bf16_t, ws_off)[(size_t)row * 512 + hd * 64 + d]) : bf2f(WSP(bf16_t, ws_off)[((size_t)(b * 2 + hd) * SEQ + sq) * 64 + d]);
    }
    if (!dbg_close(got, ref)) atomicAdd(cnt, 1u);
}
#endif


#if DBG_STOP >= 0
__device__ void dbg_check_nsa(Frame& F, unsigned* cnt) {
    const int lane = F.lane, gw = blockIdx.x * NWAVES + F.wave;
    LAS float* P = (LAS float*)(F.lds + F.wave * 2048);
    const unsigned hsh = dbg_hash(gw * 7 + 3);
    const int b = hsh & 7, hh = (hsh >> 3) & 7, g = hh >> 2;
    int t; { const int cls = gw & 7; const unsigned r = dbg_hash(gw * 13 + 5);
        t = cls == 0 ? (int)(r % 31) : cls == 1 ? 31 + (int)(r % 33) : cls == 2 ? 64 + (int)(r % 960) : cls == 3 ? 1024 + (int)(r % 64) : cls == 4 ? 4032 + (int)(r % 64) : 1024 + (int)(r % 3072); }
    const size_t row = (size_t)b * SEQ + t; const int bg = b * 2 + g, cur = t >> 6;
    const bf16_t* Kc = WSP(bf16_t, WS_KCMP) + (size_t)bg * 256 * 64; const bf16_t* Vc = WSP(bf16_t, WS_VCMP) + (size_t)bg * 256 * 64;
    const int lim = t >= 31 ? (t - 31) >> 4 : -1;
    float imp = 0.f, oc = 0.f;
    for (int hd = 0; hd < 4; ++hd) {
        const bf16_t* q = WSP(bf16_t, WS_NQ) + row * 512 + (4 * g + hd) * 64;
        float sc[4]; float mx = -INFINITY;
        for (int k = 0; k < 4; ++k) { const int i = lane + 64 * k; float s = 0.f; for (int d = 0; d < 64; ++d) s += bf2f(q[d]) * bf2f(Kc[(size_t)i * 64 + d]); sc[k] = (i <= lim) ? s : -INFINITY; mx = fmaxf(mx, sc[k]); }
        mx = wave_max(mx); const float mref = (mx == -INFINITY) ? 0.f : mx; float l = 0.f;
        for (int k = 0; k < 4; ++k) { sc[k] = ex2(sc[k] - mref); l += sc[k]; }
        l = wave_sum(l); const float il = 1.f / fmaxf(l, 1e-30f);
        for (int k = 0; k < 4; ++k) P[lane + 64 * k] = sc[k] * il;
        asm volatile("s_waitcnt lgkmcnt(0)" ::: "memory");
        { const int j = lane; float a = 0.f; for (int x = 0; x < 3; ++x) a += 2.f * P[4 * j + x]; a += P[4 * j + 3]; if (j > 0) a += P[4 * j - 1]; imp += a; }
        if (4 * g + hd == hh) { for (int i = 0; i < 255; ++i) oc += P[i] * bf2f(Vc[(size_t)i * 64 + lane]); }
        asm volatile("s_waitcnt lgkmcnt(0)" ::: "memory");
    }
    float score = imp; { const int j = lane; if (j == 0 || j == cur || j == cur - 1) score = INFINITY; else if (64 * j > t) score = -INFINITY; }
    int rank = 0; for (int j2 = 0; j2 < 64; ++j2) { const float s2 = __shfl(score, j2); rank += (s2 > score || (s2 == score && j2 < lane)) ? 1 : 0; }
    const unsigned long long selm = __ballot(rank < 16);
    const bf16_t* q = WSP(bf16_t, WS_NQ) + row * 512 + hh * 64;
    float os = 0.f, ow = 0.f;
    for (int br = 0; br < 2; ++br) {
        const bf16_t* K = WSP(bf16_t, br ? WS_KWN : WS_KSL) + (size_t)bg * SEQ * 64; const bf16_t* V = WSP(bf16_t, br ? WS_VWN : WS_VSL) + (size_t)bg * SEQ * 64;
        float m = -INFINITY, l = 0.f, o = 0.f;
        for (int j = 0; j < 64; ++j) {
            if (br == 0 && !((selm >> j) & 1ull)) continue;
            const int kp = 64 * j + lane; bool valid = kp <= t; if (br == 1) valid = valid && kp > t - 512;
            if (!__any(valid)) continue;
            float s = 0.f; for (int d = 0; d < 64; ++d) s += bf2f(q[d]) * bf2f(K[(size_t)kp * 64 + d]);
            s = valid ? s : -INFINITY;
            const float mn = fmaxf(m, wave_max(s)); const float alpha = (m == -INFINITY) ? 0.f : ex2(m - mn); const float pp = ex2(s - mn);
            l = l * alpha + wave_sum(pp); o *= alpha;
            for (int x = 0; x < 64; ++x) o += __shfl(pp, x) * bf2f(V[(size_t)(64 * j + x) * 64 + lane]);
            m = mn;
        }
        const float r = o / fmaxf(l, 1e-30f); if (br) ow = r; else os = r;
    }
    const float* gp = WSP(float, WS_NGT) + row * 24 + hh * 3;
    const float ref = gp[0] * oc + gp[1] * os + gp[2] * ow;
    const float got = bf2f(WSP(bf16_t, WS_YCAT)[row * 1024 + 512 + hh * 64 + lane]);
    const float sq = wave_sum(ref * ref); const float tol = 0.03f * fabsf(ref) + 0.03f * sqrtf(sq * (1.f / 64.f)) + 1e-4f;
    const bool bad = !(fabsf(got - ref) <= tol);
    if (__any(bad) && lane == 0) atomicAdd(cnt, 1u);
}
#endif


#if DBG_STOP >= 0
__device__ void dbg_check_mlstm(Frame& F, unsigned* cnt) {
    const int lane = F.lane, gw = blockIdx.x * NWAVES + F.wave;
    const unsigned hsh = dbg_hash(gw * 11 + 1);
    const int b = hsh & 7, h = (hsh >> 3) & 3;
    int t; { const int cls = gw & 7; const unsigned r = dbg_hash(gw * 17 + 9);
        t = cls == 0 ? (int)(r % 4) : cls == 1 ? 60 + (int)(r % 8) : cls == 2 ? 64 * (1 + (int)(r % 60)) + (int)((r >> 8) % 3) : cls == 3 ? 64 * (1 + (int)(r % 60)) + 63 : cls == 4 ? 4000 + (int)(r % 96) : (int)(r % 4096); }
    const int bh = b * 4 + h; const float* GI = WSP(float, WS_GI) + (size_t)bh * SEQ; const float* GF = WSP(float, WS_GF) + (size_t)bh * SEQ;
    const bf16_t* MQ = WSP(bf16_t, WS_MQ); const bf16_t* MK = WSP(bf16_t, WS_MK); const bf16_t* MV = WSP(bf16_t, WS_MV); const float* cw = IN_F(10);
    float carry = 0.f, M = 0.f, Bt = 0.f;
    for (int s0 = 0; s0 <= t; s0 += 64) { const int s = s0 + lane; float lf = (s <= t) ? GF[s] : 0.f;
        float bs = lf;
        for (int o = 1; o < 64; o <<= 1) { const float x = __shfl_up(bs, o); if (lane >= o) bs += x; }
        bs += carry; const float u = (s <= t) ? GI[s] - bs : -INFINITY; M = fmaxf(M, wave_max(u));
        if (s0 + 63 >= t) Bt = __shfl(bs, t - s0);
        carry = __shfl(bs, 63); }
    float q0 = 0.f, q1 = 0.f;
    for (int j = 0; j < 4; ++j) { const int ss = t - 3 + j; if (ss >= 0) { const bf16_t* rp = MQ + ((size_t)b * SEQ + ss) * 512 + h * 128;
        q0 += bf2f(rp[lane]) * cw[j * 1024 + h * 128 + lane]; q1 += bf2f(rp[64 + lane]) * cw[j * 1024 + h * 128 + 64 + lane]; } }
    q0 = dbg_bfr(silu_f(q0)); q1 = dbg_bfr(silu_f(q1));
    LAS float* QS = (LAS float*)(F.lds + F.wave * 2048); QS[lane] = q0; QS[64 + lane] = q1;
    asm volatile("s_waitcnt lgkmcnt(0)" ::: "memory");
    float n0 = 0.f, n1 = 0.f, den = 0.f; carry = 0.f;
    for (int s0 = 0; s0 <= t; s0 += 64) { const int s = s0 + lane; const bool act = s <= t; float lf = act ? GF[s] : 0.f;
        float bs = lf;
        for (int o = 1; o < 64; o <<= 1) { const float x = __shfl_up(bs, o); if (lane >= o) bs += x; }
        bs += carry; carry = __shfl(bs, 63);
        float c = 0.f;
        if (act) { float qk = 0.f;
            for (int ch = 0; ch < 128; ++ch) { float kc = 0.f;
                for (int j = 0; j < 4; ++j) { const int ss = s - 3 + j; if (ss >= 0) kc += bf2f(MK[((size_t)b * SEQ + ss) * 512 + h * 128 + ch]) * cw[j * 1024 + 512 + h * 128 + ch]; }
                qk += QS[ch] * dbg_bfr(silu_f(kc) * 0.08838834764831845f); }
            c = __expf(GI[s] - bs - M) * qk; }
        den += c;
        for (int x = 0; x < 64; ++x) { const float cx = __shfl(c, x); if (s0 + x <= t) { const bf16_t* vp = MV + ((size_t)b * SEQ + s0 + x) * 512 + h * 128; n0 += cx * bf2f(vp[lane]); n1 += cx * bf2f(vp[64 + lane]); } } }
    den = wave_sum(den);
    const float hd = fmaxf(fabsf(den), __expf(-(Bt + M)));
    const float h0 = n0 / hd, h1 = n1 / hd;
    const float rn = rsqrtf(wave_sum(h0 * h0 + h1 * h1) * (1.f / 128.f) + RMS_EPS);
    const size_t row = (size_t)b * SEQ + t; const bf16_t* mo = WSP(bf16_t, WS_MO) + row * 512 + h * 128; const float* hn = IN_F(12) + h * 128;
    const float r0 = h0 * rn * hn[lane] * sigmoid_f(bf2f(mo[lane])), r1 = h1 * rn * hn[64 + lane] * sigmoid_f(bf2f(mo[64 + lane]));
    const float g0 = bf2f(WSP(bf16_t, WS_YCAT)[row * 1024 + h * 128 + lane]), g1 = bf2f(WSP(bf16_t, WS_YCAT)[row * 1024 + h * 128 + 64 + lane]);
    const float rms = sqrtf(wave_sum(r0 * r0 + r1 * r1) * (1.f / 128.f));
    const bool bad = !(fabsf(g0 - r0) <= 0.04f * fabsf(r0) + 0.04f * rms + 1e-4f) || !(fabsf(g1 - r1) <= 0.04f * fabsf(r1) + 0.04f * rms + 1e-4f);
    if (__any(bad) && lane == 0) atomicAdd(cnt, 1u);
}
#endif


#if DBG_STOP >= 0
__device__ void dbg_check_cmp(Frame& F, unsigned* cnt) {
    const int lane = F.lane, gw = blockIdx.x * NWAVES + F.wave;
    const unsigned hsh = dbg_hash(gw * 5 + 2);
    const int kv = hsh & 1, bg = (hsh >> 1) & 15; int i = (hsh >> 5) % 255; if ((gw & 15) == 0) i = 254; if ((gw & 15) == 1) i = 0;
    const bf16_t* X = WSP(bf16_t, kv ? WS_VC : WS_KC) + (size_t)bg * SEQ * 64 + (size_t)i * 1024;
    const float* pe = IN_F(kv ? 16 : 13); const float* w1 = IN_F(kv ? 17 : 14); const float* w2 = IN_F(kv ? 18 : 15);
    float h0 = 0.f, h1 = 0.f;
    for (int k = 0; k < 2048; ++k) { const float xv = bf2f(X[k]) + pe[k]; h0 += xv * w1[(size_t)k * 128 + lane]; h1 += xv * w1[(size_t)k * 128 + 64 + lane]; }
    LAS float* H = (LAS float*)(F.lds + F.wave * 2048); H[lane] = silu_f(h0); H[64 + lane] = silu_f(h1);
    asm volatile("s_waitcnt lgkmcnt(0)" ::: "memory");
    float o = 0.f; for (int n = 0; n < 128; ++n) o += H[n] * w2[n * 64 + lane];
    const float got = bf2f(WSP(bf16_t, kv ? WS_VCMP : WS_KCMP)[((size_t)bg * 256 + i) * 64 + lane]);
    const float rms = sqrtf(wave_sum(o * o) * (1.f / 64.f));
    const bool bad = !(fabsf(got - o) <= 0.03f * fabsf(o) + 0.03f * rms + 1e-4f);
    if (__any(bad) && lane == 0) atomicAdd(cnt, 1u);
}
#endif

__device__ __forceinline__ bool phase_tid(Frame& F) { asm volatile("" : "+v"(F.tid)); F.lane = F.tid & 63; return true; }
constexpr int NPHASE = 11;
__global__ void __launch_bounds__(NTHR, 2) mega_fwd(Args args) {
    extern __shared__ __attribute__((aligned(16))) unsigned char lds_raw[];
    Frame F;
    F.lds = (LAS unsigned char*)lds_raw; F.in = args.in; F.out = args.out; F.ws = args.ws;
    F.tid = threadIdx.x; F.lane = F.tid & 63; F.wave = __builtin_amdgcn_readfirstlane(F.tid >> 6);
    F.G = gridDim.x; { const int bx = blockIdx.x; F.vcu = (F.G % 8 == 0) ? (bx % 8) * (F.G / 8) + bx / 8 : bx; }
    volatile LAS unsigned* MISC = (volatile LAS unsigned*)(F.lds + MISC_OFF);
    for (int u = F.tid; u < (LDS_BYTES - MISC_OFF) / 4; u += NTHR) ((LAS unsigned*)(F.lds + MISC_OFF))[u] = 0u;
    __syncthreads();
    unsigned* ctl = (unsigned*)(F.ws + WS_CTL);
    XcdBarrier bar; bar.bar = ctl + CW_BAR; bar.x = 0; bar.st = nullptr;
    const int lo = args.ph_lo, hi = args.ph_hi;
    if (hi - lo > 1) bar = xcd_barrier_post(ctl + CW_BAR, MISC + 8);
#ifndef PHASE_MASK
#define PHASE_MASK 0xFFFF
#endif
#define IN(k) (((PHASE_MASK >> (k)) & 1) && lo <= (k) && (k) < hi && (DBG_STOP < 0 || (k) <= DBG_STOP))
#define SEAM(k) do { if (IN(k) && IN((k) + 1)) xcd_barrier(bar); } while (0)
    LAS int* TST = (LAS int*)(F.lds + MISC_OFF + 256);
    LAS int* CNT = TST + 40;

#define PHASE_TID() if (phase_tid(F))
    if (IN(0)) PHASE_TID() _Pragma("nounroll") for (int rep = 0; rep <= ((REP_MASK >> 0) & 1); ++rep) { p0_phase(F); } SEAM(0);
    if (IN(1)) PHASE_TID() _Pragma("nounroll") for (int rep = 0; rep <= ((REP_MASK >> 1) & 1); ++rep) { p1a_phase(F); } SEAM(1);
    if (IN(2)) PHASE_TID() _Pragma("nounroll") for (int rep = 0; rep <= ((REP_MASK >> 2) & 1); ++rep) {
        pg8::DenseOrder S; S.init(NTOK, INWP, DM / 2, F.G, (int)blockIdx.x);
        EpiIn E{F.ws, IN_F(11), F.lds};
        pg8::gemm_phase<true>(F.lds, WSP(bf16_t, WS_H1), WSP(bf16_t, WS_WINT), DM / 2, S, E);
    } SEAM(2);
    if (IN(3)) PHASE_TID() _Pragma("nounroll") for (int rep = 0; rep <= ((REP_MASK >> 3) & 1); ++rep) {
        REPS(0) mlstm_a_phase(F);
        REPS(1) for (int j = F.vcu; j < 256; j += F.G) compress_job(F, j);
    } SEAM(3);
    if (IN(4)) PHASE_TID() _Pragma("nounroll") for (int rep = 0; rep <= ((REP_MASK >> 4) & 1); ++rep) {
        REPS(2) for (int j = F.vcu; j < 256; j += F.G) mlstm_scan_job(F, j);
        REPS(3) for (int u = F.vcu; u < 512; u += F.G) {
            const int bg = u >> 5, q = u & 31;
            _Pragma("nounroll") for (int hf = 0; hf < 2; ++hf) nsa_unit(F, bg >> 1, bg & 1, hf ? q : 63 - q);
        }
    } SEAM(4);
    if (IN(5)) PHASE_TID() _Pragma("nounroll") for (int rep = 0; rep <= ((REP_MASK >> 5) & 1); ++rep) {
        REPS(4) mlstm_c_phase(F);
        REPS(5) expert_convert(F);
    } SEAM(5);
    if (IN(6)) PHASE_TID() _Pragma("nounroll") for (int rep = 0; rep <= ((REP_MASK >> 6) & 1); ++rep) {
        pg8::DenseOrder S; S.init(NTOK, DM, DM, F.G, (int)blockIdx.x);
        EpiBf16 E{WSP(bf16_t, WS_Y), DM};
        pg8::gemm_phase<false>(F.lds, WSP(bf16_t, WS_YCAT), WSP(bf16_t, WS_WOUTT), DM, S, E);
    } SEAM(6);
    if (IN(7)) PHASE_TID() { s6_phase(F); } SEAM(7);
    if (IN(8)) PHASE_TID() _Pragma("nounroll") for (int rep = 0; rep <= ((REP_MASK >> 8) & 1); ++rep) {
        moe_tables(F, TST, CNT);
        pg8::MoeOrder S{TST, CNT, (const LAS unsigned char*)(TST + 96), WSP(int, WS_LIST), F.G, F.vcu, DM / 2, true};
        EpiUpI8 E{WSP(bf16_t, WS_HB), WSP(float, WS_SAL), WSP(float, WS_SB13), TST, F.lds};
        pg8::gemm_phase<true>(F.lds, WSP(bf16_t, WS_H2Q), WSP(bf16_t, WS_W13T), DM / 2, S, E);
        {
            const int U = TST[32] * 4, full = U / F.G, rem = U % F.G;
            if (rem == 0) w2_convert(F, F.vcu, F.G); else if (F.vcu >= rem) w2_convert(F, F.vcu - rem, F.G - rem);
            (void)full; }
    } SEAM(8);
    if (IN(9)) PHASE_TID() _Pragma("nounroll") for (int rep = 0; rep <= ((REP_MASK >> 9) & 1); ++rep) {
        moe_tables(F, TST, CNT);
        pg8::MoeOrder S{TST, CNT, (const LAS unsigned char*)(TST + 96), WSP(int, WS_LIST), F.G, F.vcu, EFF, false};
        EpiBf16 E{WSP(bf16_t, WS_YB), DM};
        pg8::gemm_phase<false>(F.lds, WSP(bf16_t, WS_HB), WSP(bf16_t, WS_W2T), EFF, S, E);
    } SEAM(9);
    if (IN(10)) PHASE_TID() { moe_tables(F, TST, CNT); s10_phase(F, TST); }
#if DBG_STOP >= 0
    xcd_barrier(bar);
#if DBG_CHECK == 1 || DBG_CHECK == 3 || DBG_CHECK == 4 || DBG_CHECK == 5
    { unsigned* cw = (unsigned*)(F.ws + WS_CTL) + CW_DBG + 1; if (DBG_CHECK == 1) dbg_check_p1(F, cw); else if (DBG_CHECK == 3) dbg_check_nsa(F, cw); else if (DBG_CHECK == 4) dbg_check_mlstm(F, cw); else dbg_check_cmp(F, cw); xcd_barrier(bar);
      const unsigned nb = __hip_atomic_load(cw, __ATOMIC_RELAXED, __HIP_MEMORY_SCOPE_AGENT);
      const float sc = nb == 0 ? 1.f : nb < 4 ? 2.f : nb < 16 ? 3.f : nb < 64 ? 4.f : nb < 256 ? 5.f : nb < 1024 ? 6.f : 7.f;
      const float* x = IN_F(0); for (size_t k = (size_t)blockIdx.x * NTHR + F.tid; k < (size_t)NTOK * DM; k += (size_t)F.G * NTHR) F.out[k] = x[k] * sc; }
#elif DBG_CHECK == 2
    { const unsigned id = __hip_atomic_load((unsigned*)(F.ws + WS_CTL) + CW_DBG, __ATOMIC_RELAXED, __HIP_MEMORY_SCOPE_AGENT);
      float sc = (id >= 1000u) ? 1.f : 1.f + (float)id;
      if (__hip_atomic_load((unsigned*)(F.ws + WS_CTL) + CW_BAR + XB_TMO, __ATOMIC_RELAXED, __HIP_MEMORY_SCOPE_AGENT) != 0u) sc = 61.f;
      const float* x = IN_F(0); for (size_t k = (size_t)blockIdx.x * NTHR + F.tid; k < (size_t)NTOK * DM; k += (size_t)F.G * NTHR) F.out[k] = x[k] * sc; }
#else
    dbg_phase(F, bar);
#endif
#endif
#undef IN
#undef SEAM
}

extern "C" void kernel_launch(void* const* d_in, const int* in_sizes, int n_in, void* d_out, int out_size, void* d_ws, size_t ws_size, hipStream_t stream) {
    static int grid = 0;
    if (grid == 0) {
        int dev = 0, cus = 0;
        if (hipGetDevice(&dev) != hipSuccess || hipDeviceGetAttribute(&cus, hipDeviceAttributeMultiprocessorCount, dev) != hipSuccess) cus = 256;
        if (hipFuncSetAttribute((const void*)mega_fwd, hipFuncAttributeMaxDynamicSharedMemorySize, LDS_BYTES) != hipSuccess) fprintf(stderr, "kernel_launch: hipFuncSetAttribute failed\n");
        (void)hipGetLastError();
        grid = cus > 0 ? cus : 256;
        if (n_in != 27 || ws_size < WS_END) fprintf(stderr, "kernel_launch: unexpected n_in %d / ws_size %zu (need %zu)\n", n_in, ws_size, (size_t)WS_END);
    }
    (void)hipMemsetAsync((char*)d_ws + WS_CTL, 0, 64 * 1024, stream);
#if DBG_STOP >= 0
    (void)hipMemsetAsync((char*)d_ws + WS_CTL + CW_DBG * 4, 0x7F, 4, stream);
#endif
    Args a{};
    for (int i = 0; i < 27; ++i) a.in[i] = d_in[i];
    a.out = (float*)d_out; a.ws = (unsigned char*)d_ws;
#if MK_N_LAUNCHES == 1
    a.ph_lo = 0; a.ph_hi = NPHASE;
    hipLaunchKernelGGL(mega_fwd, dim3(grid), dim3(NTHR), LDS_BYTES, stream, a);
#else
    for (int p = 0; p < NPHASE; ++p) { a.ph_lo = p; a.ph_hi = p + 1; hipLaunchKernelGGL(mega_fwd, dim3(grid), dim3(NTHR), LDS_BYTES, stream, a); }
#endif
}
```

```cpp
#include <hip/hip_runtime.h>
#include <cstdio>
#include <cstdint>
#include <type_traits>

#define LAS __attribute__((address_space(3)))
typedef unsigned short bf16_t;
typedef short bf16x8 __attribute__((ext_vector_type(8)));
typedef short s16x4 __attribute__((ext_vector_type(4)));
typedef float f32x4 __attribute__((ext_vector_type(4)));
typedef float f32x16 __attribute__((ext_vector_type(16)));
typedef unsigned u32x4 __attribute__((ext_vector_type(4)));
typedef unsigned u32x2 __attribute__((ext_vector_type(2)));
typedef int i32x4 __attribute__((ext_vector_type(4)));
typedef _Float16 f16x8 __attribute__((ext_vector_type(8)));
typedef _Float16 f16x4 __attribute__((ext_vector_type(4)));

#ifndef MK_N_LAUNCHES
#define MK_N_LAUNCHES 1
#endif
#ifndef DBG_CHECK
#define DBG_CHECK 0
#endif
#ifndef REP_MASK
#define REP_MASK 0
#endif
#ifndef REP_SUB
#define REP_SUB 0
#endif
#ifndef NSA_DUP
#define NSA_DUP 0
#endif
#define NDUP(b) _Pragma("nounroll") for (int nd_ = 0; nd_ <= ((NSA_DUP >> (b)) & 1); ++nd_)
#define REPS(b) _Pragma("nounroll") for (int rs_ = 0; rs_ <= ((REP_SUB >> (b)) & 1); ++rs_)

constexpr int NB = 8, SEQ = 4096, DM = 1024, NTOK = NB * SEQ;
constexpr int MH = 4, MDH = 128;
constexpr int NHD = 8, NGRP = 2;
constexpr int INW = 3360, INWP = 3584;
constexpr int NEXP = 32, EFF = 512;
constexpr float RMS_EPS = 1e-6f;
constexpr float QSCALE = 0.125f * 1.4426950408889634f;
constexpr int NWAVES = 8, NTHR = 512;
constexpr int LDS_BYTES = 160 * 1024, MISC_OFF = 128 * 1024;
constexpr int MAXROWS = 73728;

constexpr size_t MiB = 1ull << 20, KiB = 1024;
constexpr size_t WS_CTL   = 0;
constexpr size_t WS_MOD   = 64 * KiB;
constexpr size_t WS_C1B   = WS_MOD + 192 * KiB;
constexpr size_t WS_GI    = WS_C1B + 4 * KiB;
constexpr size_t WS_GF    = WS_GI + 512 * KiB;
constexpr size_t WS_NGT   = WS_GF + 512 * KiB;
constexpr size_t WS_GSUM  = WS_NGT + 3 * MiB;
constexpr size_t WS_MLOC  = WS_GSUM + 8 * KiB;
constexpr size_t WS_MPREV = WS_MLOC + 8 * KiB;
constexpr size_t WS_NC    = WS_MPREV + 8 * KiB;
constexpr size_t WS_NPREV = WS_NC + 1 * MiB;
constexpr size_t WS_COS   = WS_NPREV + 1 * MiB;
constexpr size_t WS_SIN   = WS_COS + 4 * MiB;
constexpr size_t WS_WOUTT = WS_SIN + 4 * MiB;
constexpr size_t WS_CW1K  = WS_WOUTT + 2 * MiB;
constexpr size_t WS_CW1V  = WS_CW1K + 512 * KiB;
constexpr size_t WS_CW2K  = WS_CW1V + 512 * KiB;
constexpr size_t WS_CW2V  = WS_CW2K + 16 * KiB;
constexpr size_t WS_RWT   = WS_CW2V + 16 * KiB;
constexpr size_t WS_RWL   = WS_RWT + 96 * KiB;
constexpr size_t WS_KCMP  = WS_RWL + 96 * KiB;
constexpr size_t WS_VCMP  = WS_KCMP + 512 * KiB;
constexpr size_t WS_TOKE  = WS_VCMP + 512 * KiB;
constexpr size_t WS_TOKP  = WS_TOKE + 256 * KiB;
constexpr size_t WS_TOKG  = WS_TOKP + 256 * KiB;
constexpr size_t WS_LIST  = WS_TOKG + 256 * KiB;
constexpr size_t WS_SA    = WS_LIST + 8 * MiB;
constexpr size_t WS_SB13  = WS_SA + 128 * KiB;
constexpr size_t WS_SA1   = WS_SB13 + 128 * KiB;
constexpr size_t WS_SBW   = WS_SA1 + 128 * KiB;
constexpr size_t WS_SMALL_END = WS_SBW + 16 * KiB;
static_assert(WS_SMALL_END <= 32 * MiB, "small region overflow");
constexpr size_t WS_A     = 32 * MiB;
constexpr size_t WS_H1    = WS_A, WS_KVC = WS_A, WS_W13T = WS_A;
constexpr size_t WS_NQ    = 96 * MiB;
constexpr size_t WS_KC    = 128 * MiB, WS_VC = 136 * MiB, WS_KSL = 144 * MiB, WS_VSL = 152 * MiB, WS_KWN = 160 * MiB, WS_VWN = 168 * MiB;
constexpr size_t WS_W2T   = 96 * MiB;
constexpr size_t WS_MQ    = 176 * MiB, WS_MK = 208 * MiB, WS_MV = 240 * MiB, WS_MO = 272 * MiB;
constexpr size_t WS_Y     = 176 * MiB;
constexpr size_t WS_H2    = 240 * MiB;
constexpr size_t WS_CPREV = 304 * MiB;
constexpr size_t WS_WINT  = 304 * MiB;
constexpr size_t WS_HB    = 304 * MiB;
constexpr size_t WS_H2LO  = 304 * MiB;
constexpr size_t WS_YCAT  = 376 * MiB;
constexpr size_t WS_X1B   = 376 * MiB;
constexpr size_t WS_YB    = 128 * MiB;
constexpr size_t WS_H2Q   = 128 * MiB;
constexpr size_t WS_SAL   = 440 * MiB;
constexpr size_t WS_END   = 448 * MiB;

constexpr int CW_BAR = 0;
constexpr int CW_CNT = 4096;
constexpr int CW_DBG = 4200;

typedef __bf16 bf16x2_t __attribute__((ext_vector_type(2)));
typedef float f32x2_t __attribute__((ext_vector_type(2)));
__device__ __forceinline__ unsigned cvtpk(float lo, float hi) { const f32x2_t f = {lo, hi}; const bf16x2_t v = __builtin_convertvector(f, bf16x2_t); return __builtin_bit_cast(unsigned, v); }
__device__ __forceinline__ float bf2f(bf16_t b) { return __uint_as_float(((unsigned)b) << 16); }
__device__ __forceinline__ float bflo(unsigned w) { return __uint_as_float(w << 16); }
__device__ __forceinline__ float bfhi(unsigned w) { return __uint_as_float(w & 0xffff0000u); }
__device__ __forceinline__ bf16_t f2bf(float f) { return (bf16_t)(cvtpk(f, 0.f) & 0xffffu); }
template <int CTRL> __device__ __forceinline__ float dppf(float v) { return __int_as_float(__builtin_amdgcn_mov_dpp(__float_as_int(v), CTRL, 0xF, 0xF, true)); }
__device__ __forceinline__ float wave_sum(float v) {
    v += dppf<0xB1>(v); v += dppf<0x4E>(v); v += dppf<0x141>(v); v += dppf<0x140>(v);
    { const auto r = __builtin_amdgcn_permlane16_swap(__float_as_uint(v), __float_as_uint(v), false, false); v = __uint_as_float(r[0]) + __uint_as_float(r[1]); }
    { const auto r = __builtin_amdgcn_permlane32_swap(__float_as_uint(v), __float_as_uint(v), false, false); v = __uint_as_float(r[0]) + __uint_as_float(r[1]); }
    return v;
}
__device__ __forceinline__ float wave_max(float v) {
    v = fmaxf(v, dppf<0xB1>(v)); v = fmaxf(v, dppf<0x4E>(v)); v = fmaxf(v, dppf<0x141>(v)); v = fmaxf(v, dppf<0x140>(v));
    { const auto r = __builtin_amdgcn_permlane16_swap(__float_as_uint(v), __float_as_uint(v), false, false); v = fmaxf(__uint_as_float(r[0]), __uint_as_float(r[1])); }
    { const auto r = __builtin_amdgcn_permlane32_swap(__float_as_uint(v), __float_as_uint(v), false, false); v = fmaxf(__uint_as_float(r[0]), __uint_as_float(r[1])); }
    return v;
}
template <int CTRL, int RM> __device__ __forceinline__ float dpp_upd(float oldv, float v) { return __int_as_float(__builtin_amdgcn_update_dpp(__float_as_int(oldv), __float_as_int(v), CTRL, RM, 0xF, false)); }
__device__ __forceinline__ float wave_scan_add(float v) {
    v += dpp_upd<0x111, 0xF>(0.f, v); v += dpp_upd<0x112, 0xF>(0.f, v); v += dpp_upd<0x114, 0xF>(0.f, v); v += dpp_upd<0x118, 0xF>(0.f, v);
    v += dpp_upd<0x142, 0xA>(0.f, v); v += dpp_upd<0x143, 0xC>(0.f, v);
    return v; }
__device__ __forceinline__ float wave_scan_max(float v) {
    v = fmaxf(v, dpp_upd<0x111, 0xF>(-INFINITY, v)); v = fmaxf(v, dpp_upd<0x112, 0xF>(-INFINITY, v)); v = fmaxf(v, dpp_upd<0x114, 0xF>(-INFINITY, v)); v = fmaxf(v, dpp_upd<0x118, 0xF>(-INFINITY, v));
    v = fmaxf(v, dpp_upd<0x142, 0xA>(-INFINITY, v)); v = fmaxf(v, dpp_upd<0x143, 0xC>(-INFINITY, v));
    return v; }
__device__ __forceinline__ float sigmoid_f(float x) { return __builtin_amdgcn_rcpf(1.f + __builtin_amdgcn_exp2f(-1.4426950408889634f * x)); }
__device__ __forceinline__ float silu_f(float x) { return x * __builtin_amdgcn_rcpf(1.f + __builtin_amdgcn_exp2f(-1.4426950408889634f * x)); }
__device__ __forceinline__ float logsigmoid_f(float x) { return fminf(x, 0.f) - __logf(1.f + __expf(-fabsf(x))); }
__device__ __forceinline__ float ex2(float x) { return __builtin_amdgcn_exp2f(x); }
#define MFMA32(a, b, c) __builtin_amdgcn_mfma_f32_32x32x16_bf16(a, b, c, 0, 0, 0)
#define MFMA16(a, b, c) __builtin_amdgcn_mfma_f32_16x16x32_bf16(a, b, c, 0, 0, 0)
typedef short v4i16_t __attribute__((ext_vector_type(4)));
__device__ __forceinline__ s16x4 vtr(LAS const unsigned char* p) { return __builtin_bit_cast(s16x4, __builtin_amdgcn_ds_read_tr16_b64_v4i16((LAS v4i16_t*)p)); }
__device__ __forceinline__ int crow(int r, int hi) { return (r & 3) + 8 * (r >> 2) + 4 * hi; }
__device__ __forceinline__ u32x4 widen_pair(u32x2 A, u32x2 B) {
    const auto r0 = __builtin_amdgcn_permlane32_swap(A.x, B.x, false, false); const auto r1 = __builtin_amdgcn_permlane32_swap(A.y, B.y, false, false);
    return (u32x4){r0[0], r1[0], r0[1], r1[1]}; }
__device__ __forceinline__ u32x4 widen_rows16(u32x2 X, u32x2 Y) {
    const auto r0 = __builtin_amdgcn_permlane16_swap(X.x, Y.x, false, false); const auto r1 = __builtin_amdgcn_permlane16_swap(X.y, Y.y, false, false);
    return (u32x4){r0[0], r1[0], r0[1], r1[1]}; }
__device__ __forceinline__ u32x4 quad_transpose(u32x4 d, int lane) {
    const bool b0 = lane & 1, b1 = lane & 2;
    { const unsigned t0 = b0 ? d.x : d.y, t1 = b0 ? d.z : d.w;
      const unsigned r0 = (unsigned)__builtin_amdgcn_mov_dpp((int)t0, 0xB1, 0xF, 0xF, true), r1 = (unsigned)__builtin_amdgcn_mov_dpp((int)t1, 0xB1, 0xF, 0xF, true);
      if (b0) { d.x = r0; d.z = r1; } else { d.y = r0; d.w = r1; } }
    { const unsigned t0 = b1 ? d.x : d.z, t1 = b1 ? d.y : d.w;
      const unsigned r0 = (unsigned)__builtin_amdgcn_mov_dpp((int)t0, 0x4E, 0xF, 0xF, true), r1 = (unsigned)__builtin_amdgcn_mov_dpp((int)t1, 0x4E, 0xF, 0xF, true);
      if (b1) { d.x = r0; d.y = r1; } else { d.z = r0; d.w = r1; } }
    return d; }
__device__ __forceinline__ u32x4 pair_widen(u32x2 A, u32x2 B, int lane) {
    const bool od = lane & 1; const u32x2 t = od ? A : B;
    u32x2 r; r.x = (unsigned)__builtin_amdgcn_mov_dpp((int)t.x, 0xB1, 0xF, 0xF, true); r.y = (unsigned)__builtin_amdgcn_mov_dpp((int)t.y, 0xB1, 0xF, 0xF, true);
    return od ? (u32x4){r.x, r.y, B.x, B.y} : (u32x4){A.x, A.y, r.x, r.y}; }
__device__ __forceinline__ void pair_narrow(u32x4 v, int lane, u32x2& A, u32x2& B) {
    const bool od = lane & 1; const u32x2 lo = {v.x, v.y}, hi = {v.z, v.w}; const u32x2 t = od ? lo : hi;
    u32x2 r; r.x = (unsigned)__builtin_amdgcn_mov_dpp((int)t.x, 0xB1, 0xF, 0xF, true); r.y = (unsigned)__builtin_amdgcn_mov_dpp((int)t.y, 0xB1, 0xF, 0xF, true);
    A = od ? r : lo; B = od ? hi : r; }
__device__ __forceinline__ bf16x8 mk8(s16x4 lo, s16x4 hi) { return (bf16x8){lo[0], lo[1], lo[2], lo[3], hi[0], hi[1], hi[2], hi[3]}; }

#define XB_TMO      128
#define XB_XCNT(j)  (256  + 64 * (j))
#define XB_XSUB(j)  (1280 + 64 * (j))
#define XB_XGEN(j)  (2304 + 64 * (j))
#define XB_TOP      3328
#define XB_TOPGEN   3392
#define XCD_BAR_WORDS 3456
#define XB_SPIN_CAP (1u << 18)
__device__ __forceinline__ unsigned xb_ld(unsigned* p)              { return __hip_atomic_load(p, __ATOMIC_RELAXED, __HIP_MEMORY_SCOPE_AGENT); }
__device__ __forceinline__ unsigned xb_add(unsigned* p, unsigned v) { return __hip_atomic_fetch_add(p, v, __ATOMIC_RELAXED, __HIP_MEMORY_SCOPE_AGENT); }
__device__ __forceinline__ unsigned xb_xcc_id() { return (unsigned)__builtin_amdgcn_s_getreg((3 << 11) | 20) & 0xFu; }
#define XB_SPIN(cond, bar) do { unsigned _sp = 0; while (cond) { __builtin_amdgcn_s_sleep(1); \
    if ((++_sp & 255u) == 0u) { if (xb_ld(&(bar)[XB_TMO])) break; if (_sp > XB_SPIN_CAP) { atomicAdd(&(bar)[XB_TMO], 1u); break; } } } } while (0)
struct XcdBarrier { unsigned* bar; unsigned x; volatile LAS unsigned* st; };
__device__ __forceinline__ XcdBarrier xcd_barrier_post(unsigned* bar, volatile LAS unsigned* st) {
    XcdBarrier b; b.bar = bar; b.x = xb_xcc_id(); b.st = st;
    if (threadIdx.x == 0) (void)xb_add(&bar[XB_XCNT(b.x)], 1u);
    return b;
}
__device__ __forceinline__ void xcd_barrier_complete(unsigned* bar, unsigned x, unsigned& nloc, unsigned& nx) {
    const unsigned G = gridDim.x * gridDim.y * gridDim.z;
    unsigned sum, cnt, mine, sp = 0u;
    for (;;) {
        sum = 0u; cnt = 0u; mine = 0u;
#pragma unroll
        for (unsigned j = 0; j < 16; ++j) { const unsigned c = xb_ld(&bar[XB_XCNT(j)]); sum += c; cnt += (c > 0u) ? 1u : 0u; mine = (j == x) ? c : mine; }
        if (sum == G) break;
        __builtin_amdgcn_s_sleep(1);
        if ((++sp & 255u) == 0u) { if (xb_ld(&bar[XB_TMO])) break; if (sp > XB_SPIN_CAP) { atomicAdd(&bar[XB_TMO], 1u); break; } }
    }
    nloc = mine > 0u ? mine : 1u; nx = cnt > 0u ? cnt : 1u;
}
__device__ __forceinline__ void xcd_barrier(const XcdBarrier& b) {
    asm volatile("s_waitcnt vmcnt(0)" ::: "memory");
    __syncthreads();
    if (threadIdx.x == 0) {
        unsigned* bar = b.bar;
        __builtin_amdgcn_s_waitcnt(0);
        unsigned nloc = b.st[0], nx = b.st[1];
        if (nloc == 0u) { xcd_barrier_complete(bar, b.x, nloc, nx); b.st[0] = nloc; b.st[1] = nx; }
        const unsigned old = xb_add(&bar[XB_XSUB(b.x)], 1u);
        const unsigned gen = old / nloc;
        if (old + 1u == (gen + 1u) * nloc) {
            __builtin_amdgcn_fence(__ATOMIC_RELEASE, "agent");
            asm volatile("s_waitcnt vmcnt(0)" ::: "memory");
            const unsigned og = xb_add(&bar[XB_TOP], 1u);
            const unsigned tg = og / nx;
            if (og + 1u == (tg + 1u) * nx) xb_add(&bar[XB_TOPGEN], 1u);
            else XB_SPIN(xb_ld(&bar[XB_TOPGEN]) == tg, bar);
            __builtin_amdgcn_fence(__ATOMIC_ACQUIRE, "agent");
            xb_add(&bar[XB_XGEN(b.x)], 1u);
            asm volatile("s_waitcnt vmcnt(0)" ::: "memory");
        } else {
            XB_SPIN(xb_ld(&bar[XB_XGEN(b.x)]) == gen, bar);
            __builtin_amdgcn_fence(__ATOMIC_ACQUIRE, "agent");
            asm volatile("s_waitcnt vmcnt(0)" ::: "memory");
        }
    }
    __syncthreads();
}

struct Args { const void* in[27]; float* out; unsigned char* ws; int ph_lo, ph_hi; };
struct Frame {
    LAS unsigned char* lds;
    const void* const* in; float* out; unsigned char* ws;
    int tid, lane, wave, vcu, G;
};
#define IN_F(k) ((const float*)F.in[k])
#define WSP(T, off) ((T*)(F.ws + (off)))

namespace pg8 {
constexpr int BM = 256, BK = 64, HALF = 128, HTB = HALF * BK * 2, STAGE_BYTES = 8 * HTB, NXCD = 8, WGM = 8;
__host__ __device__ __forceinline__ int lds_byte(int r, int c) { const int st = (r >> 4) * 2 + (c >> 5), rr = r & 15, cc = c & 31, ob = rr * 64 + cc * 2; return st * 1024 + (ob ^ (((ob >> 9) & 1) << 5)); }
__host__ __device__ __forceinline__ void stage_rc(int b, int& R, int& C) { const int st = b / 1024, sb = b % 1024, swz = sb ^ (((sb >> 9) & 1) << 5); R = (st >> 1) * 16 + swz / 64; C = (st & 1) * 32 + (swz % 64) / 2; }
__host__ __device__ __forceinline__ int perm32(int rho) { const int n = rho >> 4, i = rho & 15; return 8 * (i >> 2) + 4 * n + (i & 3); }
struct Unit { int pm, pn, e, nrow; };

template <bool I8, class Epi, class Sched>
__device__ __forceinline__ void gemm_phase(LAS unsigned char* lds, const void* Abase, const void* Bbase, const int K, const Sched& S, const Epi& E) {
    const int tid = threadIdx.x, wid = __builtin_amdgcn_readfirstlane(tid >> 6), lane = tid & 63, wr = wid >> 2, wc = wid & 3, fr = lane & 15, fq = lane >> 4;
    const int nt = K / BK;
    int Rr[2], Cc[2]; unsigned voffB[2];
#pragma unroll
    for (int i = 0; i < 2; ++i) { int R, C; stage_rc(tid * 16 + i * 8192, R, C); Rr[i] = R; Cc[i] = C; const int Rb = (R & ~31) + perm32(R & 31); voffB[i] = (unsigned)(Rb * K + C) * 2u; }
    const size_t kstep = (size_t)(BK * 2);
    const size_t hstepB = (size_t)HALF * K * 2;
    const unsigned ldsw = (unsigned)wid * 1024u;
    const int aoff = lds_byte(wr * 64 + fr, fq * 8), boff = lds_byte(wc * 32 + fr, fq * 8);
#define PG8_SA(b, h) (((b) * 2 + (h)) * HTB)
#define PG8_SB(b, h) ((4 + (b) * 2 + (h)) * HTB)
#define PG8_STAGEB(bufoff, gbase) do { _Pragma("unroll") for (int _i = 0; _i < 2; ++_i) \
        __builtin_amdgcn_global_load_lds((const unsigned*)((const char*)(gbase) + voffB[_i]), (LAS unsigned*)(lds + (bufoff) + ldsw + _i * 8192), 16, 0, 0); } while (0)
#define PG8_STAGEA(bufoff, o0, o1, ktb) do { const char* _p = (const char*)Abase + (ktb); \
        __builtin_amdgcn_global_load_lds((const unsigned*)(_p + (o0)), (LAS unsigned*)(lds + (bufoff) + ldsw), 16, 0, 0); \
        __builtin_amdgcn_global_load_lds((const unsigned*)(_p + (o1)), (LAS unsigned*)(lds + (bufoff) + ldsw + 8192), 16, 0, 0); } while (0)
#define PG8_LDA(dst, b, h) do { _Pragma("unroll") for (int m = 0; m < 4; ++m) _Pragma("unroll") for (int k = 0; k < 2; ++k) dst[m][k] = *(const LAS bf16x8*)(lds + PG8_SA(b, h) + aoff + m * 2048 + k * 1024); } while (0)
#define PG8_LDB(dst, b, h) do { _Pragma("unroll") for (int n = 0; n < 2; ++n) _Pragma("unroll") for (int k = 0; k < 2; ++k) dst[n][k] = *(const LAS bf16x8*)(lds + PG8_SB(b, h) + boff + n * 2048 + k * 1024); } while (0)
#define PG8_MMA(ai, bj, At, Bt) do { __builtin_amdgcn_s_setprio(1); _Pragma("unroll") for (int m = 0; m < 4; ++m) _Pragma("unroll") for (int n = 0; n < 2; ++n) _Pragma("unroll") for (int k = 0; k < 2; ++k) { \
        if constexpr (I8) acc[ai][bj][m][n] = __builtin_bit_cast(acc_t, __builtin_amdgcn_mfma_i32_16x16x64_i8(__builtin_bit_cast(i32x4, Bt[n][k]), __builtin_bit_cast(i32x4, At[m][k]), __builtin_bit_cast(i32x4, acc[ai][bj][m][n]), 0, 0, 0)); \
        else acc[ai][bj][m][n] = __builtin_bit_cast(acc_t, __builtin_amdgcn_mfma_f32_16x16x32_bf16(Bt[n][k], At[m][k], __builtin_bit_cast(f32x4, acc[ai][bj][m][n]), 0, 0, 0)); } __builtin_amdgcn_s_setprio(0); } while (0)
#define PG8_WAIT_V(n) asm volatile("s_waitcnt vmcnt(" #n ")" ::: "memory")
#define PG8_WAIT_L(n) asm volatile("s_waitcnt lgkmcnt(" #n ")" ::: "memory")
#define PG8_BAR __builtin_amdgcn_s_barrier()
#define PG8_SCHED __builtin_amdgcn_sched_barrier(0)
    Unit cur, nxt; int ui = 0;
    if (!S.next(0, cur)) return;
    using acc_t = typename std::conditional<I8, i32x4, f32x4>::type;
    acc_t acc[2][2][4][2];
#pragma unroll
    for (int a = 0; a < 2; ++a)
#pragma unroll
        for (int b = 0; b < 2; ++b)
#pragma unroll
            for (int m = 0; m < 4; ++m)
#pragma unroll
                for (int n = 0; n < 2; ++n) acc[a][b][m][n] = __builtin_bit_cast(acc_t, (u32x4){0u, 0u, 0u, 0u});
    bf16x8 At[4][2], B0[2][2], B1[2][2];
    unsigned oc00, oc01, oc10, oc11; int kn00, kn01, kn10, kn11;
    oc00 = S.a_conv(S.a_key(cur, Rr[0])) + Cc[0] * 2; oc01 = S.a_conv(S.a_key(cur, Rr[1])) + Cc[1] * 2; oc10 = S.a_conv(S.a_key(cur, HALF + Rr[0])) + Cc[0] * 2; oc11 = S.a_conv(S.a_key(cur, HALF + Rr[1])) + Cc[1] * 2;
    const char* cB = (const char*)Bbase + S.b_off(cur);
    PG8_STAGEB(PG8_SB(0, 0), cB); PG8_STAGEA(PG8_SA(0, 0), oc00, oc01, 0); PG8_STAGEB(PG8_SB(0, 1), cB + hstepB); PG8_STAGEA(PG8_SA(0, 1), oc10, oc11, 0);
    if (wr == 1) PG8_BAR;
    PG8_WAIT_V(4); PG8_BAR;
    PG8_STAGEB(PG8_SB(1, 0), cB + kstep); PG8_STAGEA(PG8_SA(1, 0), oc00, oc01, kstep); PG8_STAGEB(PG8_SB(1, 1), cB + hstepB + kstep);
    PG8_WAIT_V(6); PG8_BAR;
    for (;;) {
        E.pre(cur, lds, wid, lane, ui & 1);
        const bool has_next = S.next(ui + 1, nxt);
        const char* nB = cB;
        if (has_next) { kn00 = S.a_key(nxt, Rr[0]); kn01 = S.a_key(nxt, Rr[1]); kn10 = S.a_key(nxt, HALF + Rr[0]); kn11 = S.a_key(nxt, HALF + Rr[1]); nB = (const char*)Bbase + S.b_off(nxt); }
        else { kn00 = 0; kn01 = 0; kn10 = 0; kn11 = 0; }
        for (int t = 0; t < nt; t += 2) {
            const bool last = (t == nt - 2);
            const size_t k1 = (size_t)(t + 1) * kstep;
            const size_t k2 = last ? 0 : (size_t)(t + 2) * kstep, k3 = k2 + kstep;
            const unsigned o200 = (last && has_next) ? S.a_conv(kn00) + Cc[0] * 2 : oc00, o201 = (last && has_next) ? S.a_conv(kn01) + Cc[1] * 2 : oc01, o210 = (last && has_next) ? S.a_conv(kn10) + Cc[0] * 2 : oc10, o211 = (last && has_next) ? S.a_conv(kn11) + Cc[1] * 2 : oc11;
            const char* b2 = last ? nB : cB + (size_t)(t + 2) * kstep; const char* b3 = b2 + kstep;
            PG8_LDB(B0, 0, 0); PG8_SCHED; PG8_LDA(At, 0, 0); PG8_STAGEA(PG8_SA(1, 1), oc10, oc11, k1);
            PG8_WAIT_L(8); PG8_BAR; PG8_WAIT_L(0); PG8_MMA(0, 0, At, B0); PG8_BAR; PG8_SCHED;
            PG8_LDB(B1, 0, 1); PG8_STAGEB(PG8_SB(0, 0), b2);
            PG8_BAR; PG8_WAIT_L(0); PG8_MMA(0, 1, At, B1); PG8_BAR;
            PG8_LDA(At, 0, 1); PG8_STAGEA(PG8_SA(0, 0), o200, o201, k2);
            PG8_BAR; PG8_WAIT_L(0); PG8_MMA(1, 0, At, B0); PG8_BAR; PG8_SCHED;
            PG8_STAGEB(PG8_SB(0, 1), b2 + hstepB);
            PG8_WAIT_V(6); PG8_BAR; PG8_MMA(1, 1, At, B1); PG8_BAR;
            PG8_LDB(B0, 1, 0); PG8_SCHED; PG8_LDA(At, 1, 0); PG8_STAGEA(PG8_SA(0, 1), o210, o211, k2);
            PG8_WAIT_L(8); PG8_BAR; PG8_WAIT_L(0); PG8_MMA(0, 0, At, B0); PG8_BAR; PG8_SCHED;
            PG8_LDB(B1, 1, 1); PG8_STAGEB(PG8_SB(1, 0), b3);
            PG8_BAR; PG8_WAIT_L(0); PG8_MMA(0, 1, At, B1); PG8_BAR;
            PG8_LDA(At, 1, 1); PG8_STAGEA(PG8_SA(1, 0), o200, o201, k3);
            PG8_BAR; PG8_WAIT_L(0); PG8_MMA(1, 0, At, B0); PG8_BAR; PG8_SCHED;
            PG8_STAGEB(PG8_SB(1, 1), b3 + hstepB);
            PG8_WAIT_V(6); PG8_BAR; PG8_MMA(1, 1, At, B1); PG8_BAR;
        }
        E(acc, cur, wr, wc, fr, fq, ui & 1);
        if (!has_next) break;
#pragma unroll
        for (int a = 0; a < 2; ++a)
#pragma unroll
            for (int b = 0; b < 2; ++b)
#pragma unroll
                for (int m = 0; m < 4; ++m)
#pragma unroll
                    for (int n = 0; n < 2; ++n) acc[a][b][m][n] = __builtin_bit_cast(acc_t, (u32x4){0u, 0u, 0u, 0u});
        cur = nxt; cB = nB; oc00 = S.a_conv(kn00) + Cc[0] * 2; oc01 = S.a_conv(kn01) + Cc[1] * 2; oc10 = S.a_conv(kn10) + Cc[0] * 2; oc11 = S.a_conv(kn11) + Cc[1] * 2; ++ui;
    }
    PG8_WAIT_V(0);
    if (wr == 0) PG8_BAR;
    PG8_BAR;
#undef PG8_SA
#undef PG8_SB
#undef PG8_STAGEA
#undef PG8_STAGEB
#undef PG8_LDA
#undef PG8_LDB
#undef PG8_MMA
#undef PG8_WAIT_V
#undef PG8_WAIT_L
#undef PG8_BAR
#undef PG8_SCHED
}

struct DenseOrder {
    int nM, nN, nwg, G, c, K;
    __device__ void init(int M, int N, int K_, int G_, int c_) { nM = M / BM; nN = N / BM; nwg = nM * nN; G = G_; c = c_; K = K_; }
    __device__ __forceinline__ bool next(int i, Unit& u) const {
        const long L = (long)i * G + c; if (L >= nwg) return false;
        int wgid = (int)L; { const int q = nwg / NXCD, r = nwg % NXCD, xcd = wgid % NXCD, off = wgid / NXCD; wgid = (xcd < r ? xcd * (q + 1) : r * (q + 1) + (xcd - r) * q) + off; }
        const int nig = WGM * nN, gid = wgid / nig, fm = gid * WGM, gsz = (nM - fm) < WGM ? (nM - fm) : WGM;
        u.pm = fm + ((wgid % nig) % gsz); u.pn = (wgid % nig) / gsz; u.e = 0; u.nrow = 256; return true;
    }
    __device__ __forceinline__ int a_key(const Unit& u, int R) const { return u.pm * BM + R; }
    __device__ __forceinline__ unsigned a_conv(int key) const { return (unsigned)(key * K) * 2u; }
    __device__ __forceinline__ size_t b_off(const Unit& u) const { return (size_t)u.pn * BM * K * 2; }
};
struct MoeOrder {
    const LAS int* tstart; const LAS int* cnt; const LAS unsigned char* etile; const int* list; int G, c, K; bool gather;
    static constexpr int npn = 4;
    __device__ __forceinline__ bool next(int i, Unit& u) const {
        const int L = i * G + c; const int tt = tstart[32];
        if (L >= tt * npn) return false;
        const int tile = L / npn; u.pn = L % npn; u.pm = tile;
        const int e = etile[tile];
        u.e = e; u.nrow = cnt[e] - (tile - tstart[e]) * 256; return true;
    }
    __device__ __forceinline__ int a_key(const Unit& u, int R) const {
        if (gather) { const int mt = u.pm - tstart[u.e]; const int r = mt * 256 + R; return list[(size_t)u.e * 65536 + (R < u.nrow ? r : 0)]; }
        return u.pm * BM + R;
    }
    __device__ __forceinline__ unsigned a_conv(int key) const { return (unsigned)(key * K) * 2u; }
    __device__ __forceinline__ size_t b_off(const Unit& u) const { return ((size_t)u.e * 1024 + (size_t)u.pn * BM) * K * 2; }
};
}

constexpr int EPI_SC = MISC_OFF + 24576;
struct EpiIn {
    unsigned char* ws; const float* gate_b;
    __device__ __forceinline__ void pre(const pg8::Unit& u, LAS unsigned char* lds, int wid, int lane, int par) const {
        if (wid == 0) { __builtin_amdgcn_global_load_lds((const unsigned*)((const float*)(ws + WS_SA1) + u.pm * 256 + lane * 4), (LAS unsigned*)(lds + EPI_SC + par * 2048), 16, 0, 0);
                        __builtin_amdgcn_global_load_lds((const unsigned*)((const float*)(ws + WS_SBW) + u.pn * 256 + lane * 4), (LAS unsigned*)(lds + EPI_SC + par * 2048 + 1024), 16, 0, 0); } }
    LAS unsigned char* lds;
    __device__ __forceinline__ void operator()(const i32x4 (&acc)[2][2][4][2], const pg8::Unit& u, int wr, int wc, int fr, int fq, int par) const {
        asm volatile("" : "+v"(fr), "+v"(fq));
        const int pn = u.pn, row0 = u.pm * 256 + wr * 64 + fr;
        float sa[2][4]; f32x4 sb[2][2];
        { LAS const float* SA1 = (LAS const float*)(lds + EPI_SC + par * 2048); LAS const float* SBW = SA1 + 256;
#pragma unroll
          for (int ai = 0; ai < 2; ++ai)
#pragma unroll
              for (int m = 0; m < 4; ++m) sa[ai][m] = SA1[wr * 64 + fr + ai * 128 + m * 16];
#pragma unroll
          for (int bj = 0; bj < 2; ++bj)
#pragma unroll
              for (int n = 0; n < 2; ++n) sb[bj][n] = *(LAS const f32x4*)(SBW + bj * 128 + wc * 32 + 8 * fq + 4 * n); }
#define ACCF(ai, bj, m, n) (__builtin_convertvector(acc[ai][bj][m][n], f32x4) * sa[ai][m] * sb[bj][n])
        if (pn < 8) {
            bf16_t* dst = (bf16_t*)(ws + (pn < 2 ? WS_MQ : pn < 4 ? WS_MK : pn < 6 ? WS_MV : WS_MO));
            const int col0 = (pn & 1) * 256 + wc * 32 + 8 * fq;
#pragma unroll
            for (int ai = 0; ai < 2; ++ai)
#pragma unroll
                for (int m = 0; m < 4; ++m) { bf16_t* rp = dst + (size_t)(row0 + ai * 128 + m * 16) * 512 + col0;
#pragma unroll
                    for (int bj = 0; bj < 2; ++bj) { const f32x4 v0 = ACCF(ai, bj, m, 0), v1 = ACCF(ai, bj, m, 1);
                        u32x4 w; w.x = cvtpk(v0[0], v0[1]); w.y = cvtpk(v0[2], v0[3]); w.z = cvtpk(v1[0], v1[1]); w.w = cvtpk(v1[2], v1[3]);
                        *(u32x4*)(rp + bj * 128) = w; } }
        } else if (pn < 10) {
            const int g8 = 4 * (wc & 1) + fq; const float* COS = (const float*)(ws + WS_COS); const float* SIN = (const float*)(ws + WS_SIN); bf16_t* NQ = (bf16_t*)(ws + WS_NQ);
#pragma unroll
            for (int ai = 0; ai < 2; ++ai)
#pragma unroll
                for (int m = 0; m < 4; ++m) { const int row = row0 + ai * 128 + m * 16;
                    const f32x4 cs = *(const f32x4*)(COS + (size_t)row * 32 + 4 * g8), sn = *(const f32x4*)(SIN + (size_t)row * 32 + 4 * g8);
#pragma unroll
                    for (int bj = 0; bj < 2; ++bj) { const int head = (pn - 8) * 4 + bj * 2 + (wc >> 1);
                        const f32x4 x1 = ACCF(ai, bj, m, 0), x2 = ACCF(ai, bj, m, 1);
                        const f32x4 o1 = (x1 * cs - x2 * sn) * QSCALE, o2 = (x2 * cs + x1 * sn) * QSCALE;
                        bf16_t* rp = NQ + (size_t)row * 512 + head * 64 + 4 * (g8 & ~1) + 32 * (fq & 1);
                        u32x2 a; a.x = cvtpk(o1[0], o1[1]); a.y = cvtpk(o1[2], o1[3]);
                        u32x2 b; b.x = cvtpk(o2[0], o2[1]); b.y = cvtpk(o2[2], o2[3]); *(u32x4*)rp = widen_rows16(a, b); } }
        } else if (pn < 13) {
            bf16_t* kd = (bf16_t*)(ws + (pn == 10 ? WS_KC : pn == 11 ? WS_KSL : WS_KWN)); bf16_t* vd = (bf16_t*)(ws + (pn == 10 ? WS_VC : pn == 11 ? WS_VSL : WS_VWN));
            const float* COS = (const float*)(ws + WS_COS); const float* SIN = (const float*)(ws + WS_SIN);
            const int g8 = 4 * (wc & 1) + fq, grp = wc >> 1;
#pragma unroll
            for (int ai = 0; ai < 2; ++ai)
#pragma unroll
                for (int m = 0; m < 4; ++m) { const int row = row0 + ai * 128 + m * 16; const int b = row >> 12, s = row & 4095;
                    const f32x4 cs = *(const f32x4*)(COS + (size_t)row * 32 + 4 * g8), sn = *(const f32x4*)(SIN + (size_t)row * 32 + 4 * g8);
                    const size_t rbase = ((size_t)(b * 2 + grp) * SEQ + s) * 64;
                    { const f32x4 x1 = ACCF(ai, 0, m, 0), x2 = ACCF(ai, 0, m, 1);
                      const f32x4 o1 = x1 * cs - x2 * sn, o2 = x2 * cs + x1 * sn;
                      bf16_t* rp = kd + rbase + 4 * (g8 & ~1) + 32 * (fq & 1);
                      u32x2 a; a.x = cvtpk(o1[0], o1[1]); a.y = cvtpk(o1[2], o1[3]);
                      u32x2 c; c.x = cvtpk(o2[0], o2[1]); c.y = cvtpk(o2[2], o2[3]); *(u32x4*)rp = widen_rows16(a, c); }
                    { const f32x4 v0 = ACCF(ai, 1, m, 0), v1 = ACCF(ai, 1, m, 1);
                      u32x4 w; w.x = cvtpk(v0[0], v0[1]); w.y = cvtpk(v0[2], v0[3]); w.z = cvtpk(v1[0], v1[1]); w.w = cvtpk(v1[2], v1[3]);
                      *(u32x4*)(vd + rbase + (wc & 1) * 32 + 8 * fq) = w; } }
        } else {
            if (wc == 0) { float* GI = (float*)(ws + WS_GI); float* GF = (float*)(ws + WS_GF); float* NGT = (float*)(ws + WS_NGT);
#pragma unroll
                for (int ai = 0; ai < 2; ++ai)
#pragma unroll
                    for (int m = 0; m < 4; ++m) { const int row = row0 + ai * 128 + m * 16; const int b = row >> 12, s = row & 4095;
#pragma unroll
                        for (int n = 0; n < 2; ++n) { const f32x4 v = ACCF(ai, 0, m, n);
                            if (fq == 0) {
#pragma unroll
                                for (int i = 0; i < 4; ++i) { const float z = v[i] + gate_b[4 * n + i];
                                    if (n == 0) GI[(size_t)(b * 4 + i) * SEQ + s] = z; else GF[(size_t)(b * 4 + i) * SEQ + s] = logsigmoid_f(z); }
                            } else {
                                f32x4 o; o[0] = sigmoid_f(v[0]); o[1] = sigmoid_f(v[1]); o[2] = sigmoid_f(v[2]); o[3] = sigmoid_f(v[3]);
                                *(f32x4*)(NGT + (size_t)row * 24 + 8 * fq + 4 * n - 8) = o; } } }
            }
        }
    }
};
#undef ACCF
struct EpiBf16 {
    bf16_t* O; int ldc;
    __device__ __forceinline__ void pre(const pg8::Unit&, LAS unsigned char*, int, int, int) const {}
    __device__ __forceinline__ void operator()(const f32x4 (&acc)[2][2][4][2], const pg8::Unit& u, int wr, int wc, int fr, int fq, int par) const {
        asm volatile("" : "+v"(fr), "+v"(fq));
        const int row0 = u.pm * 256 + wr * 64 + fr, col0 = u.pn * 256 + wc * 32 + 8 * fq;
#pragma unroll
        for (int ai = 0; ai < 2; ++ai)
#pragma unroll
            for (int m = 0; m < 4; ++m) { bf16_t* rp = O + (size_t)(row0 + ai * 128 + m * 16) * ldc + col0;
#pragma unroll
                for (int bj = 0; bj < 2; ++bj) { const f32x4 v0 = acc[ai][bj][m][0], v1 = acc[ai][bj][m][1];
                    u32x4 w; w.x = cvtpk(v0[0], v0[1]); w.y = cvtpk(v0[2], v0[3]); w.z = cvtpk(v1[0], v1[1]); w.w = cvtpk(v1[2], v1[3]);
                    *(u32x4*)(rp + bj * 128) = w; } }
    }
};
struct EpiUp {
    bf16_t* HB;
    __device__ __forceinline__ void pre(const pg8::Unit&, LAS unsigned char*, int, int, int) const {}
    __device__ __forceinline__ void operator()(const f32x4 (&acc)[2][2][4][2], const pg8::Unit& u, int wr, int wc, int fr, int fq, int par) const {
        asm volatile("" : "+v"(fr), "+v"(fq));
        const int row0 = u.pm * 256 + wr * 64 + fr, col0 = (u.pn * 256 + wc * 32 + 8 * fq) >> 1;
#pragma unroll
        for (int ai = 0; ai < 2; ++ai)
#pragma unroll
            for (int m = 0; m < 4; ++m) { bf16_t* rp = HB + (size_t)(row0 + ai * 128 + m * 16) * EFF + col0;
#pragma unroll
                for (int bj = 0; bj < 2; ++bj) { const f32x4 a1 = acc[ai][bj][m][0], a3 = acc[ai][bj][m][1];
                    u32x2 w; w.x = cvtpk(silu_f(a1[0]) * a3[0], silu_f(a1[1]) * a3[1]); w.y = cvtpk(silu_f(a1[2]) * a3[2], silu_f(a1[3]) * a3[3]);
                    *(u32x2*)(rp + bj * 64) = w; } }
    }
};

struct EpiUpI8 {
    bf16_t* HB; const float* SAL; const float* SB; const LAS int* tstart; LAS unsigned char* lds;
    __device__ __forceinline__ void pre(const pg8::Unit& u, LAS unsigned char* l, int wid, int lane, int par) const {
        if (wid == 0) { const int mt = u.pm - tstart[u.e];
            __builtin_amdgcn_global_load_lds((const unsigned*)(SAL + (size_t)u.e * 65536 + mt * 256 + lane * 4), (LAS unsigned*)(l + EPI_SC + par * 2048), 16, 0, 0);
            __builtin_amdgcn_global_load_lds((const unsigned*)(SB + (size_t)u.e * 1024 + u.pn * 256 + lane * 4), (LAS unsigned*)(l + EPI_SC + par * 2048 + 1024), 16, 0, 0); } }
    __device__ __forceinline__ void operator()(const i32x4 (&acc)[2][2][4][2], const pg8::Unit& u, int wr, int wc, int fr, int fq, int par) const {
        asm volatile("" : "+v"(fr), "+v"(fq));
        const int rl0 = wr * 64 + fr, row0 = u.pm * 256 + rl0, colp = u.pn * 256 + wc * 32 + 8 * fq, col0 = colp >> 1;
        LAS const float* LSA = (LAS const float*)(lds + EPI_SC + par * 2048); LAS const float* LSB = LSA + 256;
        f32x4 sb[2][2];
#pragma unroll
        for (int bj = 0; bj < 2; ++bj)
#pragma unroll
            for (int n = 0; n < 2; ++n) sb[bj][n] = *(LAS const f32x4*)(LSB + wc * 32 + 8 * fq + bj * 128 + 4 * n);
#pragma unroll
        for (int ai = 0; ai < 2; ++ai)
#pragma unroll
            for (int m = 0; m < 4; ++m) { const int R = rl0 + ai * 128 + m * 16; const float sa = LSA[R];
                bf16_t* rp = HB + (size_t)(row0 + ai * 128 + m * 16) * EFF + (col0 & ~7) + 64 * (fq & 1);
                u32x2 wv[2];
#pragma unroll
                for (int bj = 0; bj < 2; ++bj) { const i32x4 i1 = acc[ai][bj][m][0], i3 = acc[ai][bj][m][1];
                    f32x4 a1, a3;
#pragma unroll
                    for (int i = 0; i < 4; ++i) { a1[i] = (float)i1[i] * sa * sb[bj][0][i]; a3[i] = (float)i3[i] * sa * sb[bj][1][i]; }
                    wv[bj].x = cvtpk(silu_f(a1[0]) * a3[0], silu_f(a1[1]) * a3[1]); wv[bj].y = cvtpk(silu_f(a1[2]) * a3[2], silu_f(a1[3]) * a3[3]); }
                *(u32x4*)rp = widen_rows16(wv[0], wv[1]); }
    }
};

template <class RM>
__device__ __forceinline__ void transpose_item(const float* W, int N, bf16_t* WT, int Kd, LAS float* scr, int k0, int n0, int lane, const RM& rm) {
#pragma unroll
    for (int i = 0; i < 8; ++i) { const int kk = 8 * i + (lane >> 3); const f32x4 w4 = *(const f32x4*)(W + (size_t)(k0 + kk) * N + n0 + 4 * (lane & 7));
        LAS float* d = scr + kk * 33 + 4 * (lane & 7); d[0] = w4[0]; d[1] = w4[1]; d[2] = w4[2]; d[3] = w4[3]; }
    asm volatile("s_waitcnt lgkmcnt(0)" ::: "memory");
    const int c = lane & 7;
#pragma unroll
    for (int j = 0; j < 4; ++j) { const int n = (lane >> 3) + 8 * j; const LAS float* s = scr + (8 * c) * 33 + n;
        u32x4 o; o.x = cvtpk(s[0 * 33], s[1 * 33]); o.y = cvtpk(s[2 * 33], s[3 * 33]); o.z = cvtpk(s[4 * 33], s[5 * 33]); o.w = cvtpk(s[6 * 33], s[7 * 33]);
        *(u32x4*)(WT + (size_t)rm(n0 + n) * Kd + k0 + 8 * c) = o; }
    asm volatile("s_waitcnt lgkmcnt(0)" ::: "memory");
}
struct RmId { int off; __device__ __forceinline__ int operator()(int n) const { return off + n; } };
__device__ __forceinline__ int rope_pl(int d) { return 8 * ((d & 31) >> 2) + 4 * (d >> 5) + (d & 3); }
struct RmWin {
    __device__ __forceinline__ int operator()(int c) const {
        if (c < 2048) return c;
        if (c < 2052) return 3328 + (c - 2048);
        if (c < 2056) return 3332 + (c - 2052);
        if (c < 2568) { const int x = c - 2056; return 2048 + (x & ~63) + rope_pl(x & 63); }
        if (c < 2696) { const int x = c - 2568; return 2560 + (x & ~63) + rope_pl(x & 63); }
        if (c < 2824) return 2688 + (c - 2696);
        if (c < 2952) { const int x = c - 2824; return 2816 + (x & ~63) + rope_pl(x & 63); }
        if (c < 3080) return 2944 + (c - 2952);
        if (c < 3208) { const int x = c - 3080; return 3072 + (x & ~63) + rope_pl(x & 63); }
        if (c < 3336) return 3200 + (c - 3208);
        return c;
    }
};
struct RmW13 { int sel; __device__ __forceinline__ int operator()(int j) const { return 8 * (j >> 2) + 4 * sel + (j & 3); } };

__device__ __forceinline__ void p0_phase(Frame& F) {
    const int tid = F.tid, lane = F.lane;
    const int NA = F.G > 64 ? 64 : F.G;
    const bool split = F.G > NA;
    if (F.vcu < NA) {
        LAS float* sc = (LAS float*)F.lds; LAS float* red = (LAS float*)(F.lds + 32768);
        const float* c = IN_F(1);
        for (int i = tid; i < 8192; i += NTHR) sc[i] = silu_f(c[i]);
        __syncthreads();
        const float* W = IN_F(3); const float* bia = IN_F(4); float* mod = WSP(float, WS_MOD);
        for (int cg = F.vcu; cg < 64; cg += NA) {
            const int col0 = cg * 96;
            const int kq = tid / 24, cq = tid % 24;
            f32x4 a[8];
#pragma unroll
            for (int b = 0; b < 8; ++b) a[b] = (f32x4){0.f, 0.f, 0.f, 0.f};
            if (tid < 504) {
#pragma unroll 4
                for (int k = kq; k < 1024; k += 21) { const f32x4 w = *(const f32x4*)(W + (size_t)k * 6144 + col0 + 4 * cq);
#pragma unroll
                    for (int b = 0; b < 8; ++b) a[b] += w * sc[b * 1024 + k]; }
#pragma unroll
                for (int b = 0; b < 8; ++b) *(LAS f32x4*)(red + (size_t)(tid * 8 + b) * 4) = a[b];
            }
            __syncthreads();
            for (int o = tid; o < 768; o += NTHR) { const int cq2 = o >> 5, bj = o & 31;
                float sacc = 0.f;
                for (int q = 0; q < 21; ++q) sacc += red[(size_t)((q * 24 + cq2) * 8) * 4 + bj];
                const int col = col0 + 4 * cq2 + (bj & 3);
                mod[(bj >> 2) * 6144 + col] = sacc + bia[col]; }
            __syncthreads();
        }
    }
    if (!split || F.vcu >= NA) {
        LAS float* scr = (LAS float*)(F.lds + F.wave * 8448);
        const int gw = (split ? F.vcu - NA : F.vcu) * NWAVES + F.wave, NGW = (split ? F.G - NA : F.G) * NWAVES;
        constexpr int I_WOUT = 16 * 32, I_C1 = 32 * 4, I_C2 = 2 * 2;
        constexpr int NITEMS = I_WOUT + 2 * I_C1 + 2 * I_C2;
        for (int it = gw; it < NITEMS; it += NGW) {
            int r = it;
            if (r < I_WOUT) { transpose_item(IN_F(19), 1024, WSP(bf16_t, WS_WOUTT), 1024, scr, (r / 32) * 64, (r % 32) * 32, lane, RmId{0}); continue; } r -= I_WOUT;
            if (r < I_C1) { transpose_item(IN_F(14), 128, WSP(bf16_t, WS_CW1K), 2048, scr, (r / 4) * 64, (r % 4) * 32, lane, RmId{0}); continue; } r -= I_C1;
            if (r < I_C1) { transpose_item(IN_F(17), 128, WSP(bf16_t, WS_CW1V), 2048, scr, (r / 4) * 64, (r % 4) * 32, lane, RmId{0}); continue; } r -= I_C1;
            if (r < I_C2) { transpose_item(IN_F(15), 64, WSP(bf16_t, WS_CW2K), 128, scr, (r / 2) * 64, (r % 2) * 32, lane, RmId{0}); continue; } r -= I_C2;
            transpose_item(IN_F(18), 64, WSP(bf16_t, WS_CW2V), 128, scr, (r / 2) * 64, (r % 2) * 32, lane, RmId{0});
        }
    }
    __syncthreads();
    {
        LAS unsigned* AM = (LAS unsigned*)F.lds; const int n4 = tid & 7, kq = tid >> 3; const RmWin rmw{};
        for (int it = (F.vcu + F.G - (split ? NA : 0)) % F.G; it < 105; it += F.G) {
            const int c0 = 32 * it + 4 * n4; const float* W = IN_F(9) + (size_t)(16 * kq) * INW + c0;
            if (tid < 32) AM[tid] = 0u;
            __syncthreads();
            f32x4 v[16]; f32x4 am = {0.f, 0.f, 0.f, 0.f};
#pragma unroll
            for (int i = 0; i < 16; ++i) { v[i] = *(const f32x4*)(W + (size_t)i * INW);
#pragma unroll
                for (int c = 0; c < 4; ++c) am[c] = fmaxf(am[c], fabsf(v[i][c])); }
#pragma unroll
            for (int o = 8; o < 64; o <<= 1) {
#pragma unroll
                for (int c = 0; c < 4; ++c) am[c] = fmaxf(am[c], __shfl_xor(am[c], o)); }
            if ((tid & 63) < 8) {
#pragma unroll
                for (int c = 0; c < 4; ++c) atomicMax((unsigned*)&AM[4 * n4 + c], __float_as_uint(am[c])); }
            __syncthreads();
            const f32x4 amax = *(LAS const f32x4*)((LAS const float*)AM + 4 * n4);
#pragma unroll
            for (int c = 0; c < 4; ++c) { const float inv = amax[c] > 0.f ? 127.f / amax[c] : 0.f; const int prow = rmw(c0 + c); u32x4 o;
#pragma unroll
                for (int d = 0; d < 4; ++d) {
                    const int q0 = (int)rintf(v[4 * d][c] * inv), q1 = (int)rintf(v[4 * d + 1][c] * inv), q2 = (int)rintf(v[4 * d + 2][c] * inv), q3 = (int)rintf(v[4 * d + 3][c] * inv);
                    o[d] = (unsigned)(q0 & 0xff) | ((unsigned)(q1 & 0xff) << 8) | ((unsigned)(q2 & 0xff) << 16) | ((unsigned)(q3 & 0xff) << 24); }
                *(u32x4*)((unsigned char*)(F.ws + WS_WINT) + (size_t)prow * 1024 + 16 * kq) = o;
                if (kq == 0) WSP(float, WS_SBW)[prow] = amax[c] * (1.f / 127.f); }
            __syncthreads();
        }
    }
    if (!split || F.vcu >= NA) {
        const size_t gt = (size_t)(split ? F.vcu - NA : F.vcu) * NTHR + tid, NGT_ = (size_t)(split ? F.G - NA : F.G) * NTHR;
        const int* pos = (const int*)F.in[2]; float* COS = WSP(float, WS_COS); float* SIN = WSP(float, WS_SIN);
        {
            const int d = (int)(gt & 31); const float inv = powf(10000.f, -(float)d / 32.f);
            for (size_t i = gt; i < (size_t)NTOK * 32; i += NGT_) { const int row = (int)(i >> 5);
                const float ang = (float)pos[row] * inv; const float kk = rintf(ang * 0.15915494309189535f);
                float r = fmaf(-kk, 6.28125f, ang); r = fmaf(-kk, 1.9353071795864769e-3f, r);
                const float sn = __sinf(r), cs = __cosf(r); COS[i] = cs; SIN[i] = sn; } }
        { unsigned* z = (unsigned*)(F.ws + WS_WINT + (size_t)3360 * 1024); for (size_t i = gt; i < (size_t)224 * 256; i += NGT_) z[i] = 0u;
          for (size_t i = gt; i < 224; i += NGT_) WSP(float, WS_SBW)[3360 + i] = 0.f; }
        { const float* wg = IN_F(20); const float* we = IN_F(22); _Float16* RWT = WSP(_Float16, WS_RWT);
          for (size_t i = gt; i < 48 * 1024; i += NGT_) { const int n = (int)(i >> 10), k = (int)(i & 1023);
              const float w = n < 4 ? wg[k * 4 + n] : n < 36 ? we[k * 32 + n - 4] : 0.f; RWT[i] = (_Float16)w; } }
        { bf16_t* kc = WSP(bf16_t, WS_KCMP); bf16_t* vc = WSP(bf16_t, WS_VCMP);
          for (size_t i = gt; i < 16 * 64; i += NGT_) { const size_t o = ((i >> 6) * 256 + 255) * 64 + (i & 63); kc[o] = 0; vc[o] = 0; } }
    }
    __syncthreads();
    if (F.vcu >= F.G - 16) {
        const int bi = F.vcu - (F.G - 16), kv = bi >> 3, cg = bi & 7;
        const float* pe = IN_F(kv == 0 ? 13 : 16); const float* w1 = IN_F(kv == 0 ? 14 : 17);
        LAS float* red = (LAS float*)F.lds;
        const int col = cg * 16 + (tid & 15), sl = tid >> 4; float sacc = 0.f;
#pragma unroll 8
        for (int k = sl * 64; k < sl * 64 + 64; ++k) sacc += pe[k] * w1[(size_t)k * 128 + col];
        red[tid] = sacc; __syncthreads();
        if (tid < 16) { float t2 = 0.f; for (int q = 0; q < 32; ++q) t2 += red[q * 16 + tid]; WSP(float, WS_C1B)[kv * 128 + cg * 16 + tid] = t2; }
    }
    __syncthreads();
}

__device__ __forceinline__ void p1a_phase(Frame& F) {
    const int gw = F.vcu * NWAVES + F.wave, NGW = F.G * NWAVES, lane = F.lane;
    const float* x = IN_F(0); const float* nw = IN_F(5); const float* mod = WSP(float, WS_MOD); signed char* H1Q = (signed char*)(F.ws + WS_H1);
    for (int row0 = gw * 4; row0 < NTOK; row0 += NGW * 4) {
        f32x4 v[4][4]; float ss[4];
#pragma unroll
        for (int r = 0; r < 4; ++r) { const f32x4* xr = (const f32x4*)(x + (size_t)(row0 + r) * DM) + lane;
#pragma unroll
            for (int j = 0; j < 4; ++j) v[r][j] = __builtin_nontemporal_load(xr + 64 * j); }
#pragma unroll
        for (int r = 0; r < 4; ++r) { float a = 0.f;
#pragma unroll
            for (int j = 0; j < 4; ++j) a += v[r][j][0] * v[r][j][0] + v[r][j][1] * v[r][j][1] + v[r][j][2] * v[r][j][2] + v[r][j][3] * v[r][j][3];
            ss[r] = a; }
#pragma unroll
        for (int o = 1; o < 64; o <<= 1) {
#pragma unroll
            for (int r = 0; r < 4; ++r) ss[r] += __shfl_xor(ss[r], o); }
        const int b = row0 >> 12; float am[4] = {0.f, 0.f, 0.f, 0.f};
#pragma unroll
        for (int j = 0; j < 4; ++j) { const int k = 4 * lane + 256 * j;
            const f32x4 w = *(const f32x4*)(nw + k), sh = *(const f32x4*)(mod + b * 6144 + k), sc = *(const f32x4*)(mod + b * 6144 + 1024 + k);
            const f32x4 ws = w * (sc + 1.f);
#pragma unroll
            for (int r = 0; r < 4; ++r) { const float rr = rsqrtf(ss[r] * (1.f / DM) + RMS_EPS);
                const f32x4 h = v[r][j] * rr * ws + sh; v[r][j] = h;
                am[r] = fmaxf(am[r], fmaxf(fmaxf(fabsf(h[0]), fabsf(h[1])), fmaxf(fabsf(h[2]), fabsf(h[3])))); } }
#pragma unroll
        for (int o = 1; o < 64; o <<= 1) {
#pragma unroll
            for (int r = 0; r < 4; ++r) am[r] = fmaxf(am[r], __shfl_xor(am[r], o)); }
#pragma unroll
        for (int r = 0; r < 4; ++r) { const float inv = am[r] > 0.f ? 127.f / am[r] : 0.f;
            if (lane == 0) WSP(float, WS_SA1)[row0 + r] = am[r] * (1.f / 127.f);
            u32x4 pk;
#pragma unroll
            for (int j = 0; j < 4; ++j) { const f32x4 q = v[r][j] * inv;
                const int q0 = (int)rintf(q[0]), q1 = (int)rintf(q[1]), q2 = (int)rintf(q[2]), q3 = (int)rintf(q[3]);
                pk[j] = (unsigned)(q0 & 0xff) | ((unsigned)(q1 & 0xff) << 8) | ((unsigned)(q2 & 0xff) << 16) | ((unsigned)(q3 & 0xff) << 24); }
            *(u32x4*)(H1Q + (size_t)(row0 + r) * DM + 256 * (lane & 3) + 16 * (lane >> 2)) = quad_transpose(pk, lane); }
    }
}

__device__ __forceinline__ void conv_silu16(const bf16_t* src  , const float* cw  , int b, int s, int ch0  , float scale, float (&o)[16]) {
#pragma unroll
    for (int i = 0; i < 16; ++i) o[i] = 0.f;
#pragma unroll
    for (int j = 0; j < 4; ++j) { const int ss = s - 3 + j;
        if (ss >= 0) { const bf16_t* rp = src + ((size_t)b * SEQ + ss) * 512 + ch0;
            const u32x4 a = *(const u32x4*)rp, c = *(const u32x4*)(rp + 8);
            const float* w = cw + j * 1024;
            const f32x4 w0 = *(const f32x4*)w, w1 = *(const f32x4*)(w + 4), w2 = *(const f32x4*)(w + 8), w3 = *(const f32x4*)(w + 12);
            o[0] += bflo(a.x) * w0[0]; o[1] += bfhi(a.x) * w0[1]; o[2] += bflo(a.y) * w0[2]; o[3] += bfhi(a.y) * w0[3];
            o[4] += bflo(a.z) * w1[0]; o[5] += bfhi(a.z) * w1[1]; o[6] += bflo(a.w) * w1[2]; o[7] += bfhi(a.w) * w1[3];
            o[8] += bflo(c.x) * w2[0]; o[9] += bfhi(c.x) * w2[1]; o[10] += bflo(c.y) * w2[2]; o[11] += bfhi(c.y) * w2[3];
            o[12] += bflo(c.z) * w3[0]; o[13] += bfhi(c.z) * w3[1]; o[14] += bflo(c.w) * w3[2]; o[15] += bfhi(c.w) * w3[3]; } }
#pragma unroll
    for (int i = 0; i < 16; ++i) o[i] = silu_f(o[i]) * scale;
}
constexpr int RAWS = 272, RAWIMG = 67 * RAWS + 208;
__device__ __forceinline__ void stage_raw(const bf16_t* src, int b, int s0, int h, LAS unsigned char* RAW, int tid) {
    const int s = tid >> 3, chg = tid & 7;
    const bf16_t* rp = src + ((size_t)b * SEQ + s0 + s) * 512 + h * 128 + chg * 16;
    *(LAS u32x4*)(RAW + (s + 3) * RAWS + chg * 32) = *(const u32x4*)rp; *(LAS u32x4*)(RAW + (s + 3) * RAWS + chg * 32 + 16) = *(const u32x4*)(rp + 8);
    if (s < 3) { u32x4 a = {0u, 0u, 0u, 0u}, c = a; const int ss = s0 - 3 + s;
        if (ss >= 0) { const bf16_t* hp = src + ((size_t)b * SEQ + ss) * 512 + h * 128 + chg * 16; a = *(const u32x4*)hp; c = *(const u32x4*)(hp + 8); }
        *(LAS u32x4*)(RAW + s * RAWS + chg * 32) = a; *(LAS u32x4*)(RAW + s * RAWS + chg * 32 + 16) = c; }
}
__device__ __forceinline__ void conv_lds16(LAS const unsigned char* RAW, LAS const float* WL, int s, int ch0, float scale, float (&o)[16]) {
#pragma unroll
    for (int i = 0; i < 16; ++i) o[i] = 0.f;
#pragma unroll
    for (int j = 0; j < 4; ++j) { const u32x4 a = *(LAS const u32x4*)(RAW + (s + j) * RAWS + ch0 * 2), c = *(LAS const u32x4*)(RAW + (s + j) * RAWS + ch0 * 2 + 16);
        const LAS float* w = WL + j * 128 + ch0;
        const f32x4 w0 = *(LAS const f32x4*)w, w1 = *(LAS const f32x4*)(w + 4), w2 = *(LAS const f32x4*)(w + 8), w3 = *(LAS const f32x4*)(w + 12);
        o[0] += bflo(a.x) * w0[0]; o[1] += bfhi(a.x) * w0[1]; o[2] += bflo(a.y) * w0[2]; o[3] += bfhi(a.y) * w0[3];
        o[4] += bflo(a.z) * w1[0]; o[5] += bfhi(a.z) * w1[1]; o[6] += bflo(a.w) * w1[2]; o[7] += bfhi(a.w) * w1[3];
        o[8] += bflo(c.x) * w2[0]; o[9] += bfhi(c.x) * w2[1]; o[10] += bflo(c.y) * w2[2]; o[11] += bfhi(c.y) * w2[3];
        o[12] += bflo(c.z) * w3[0]; o[13] += bfhi(c.z) * w3[1]; o[14] += bflo(c.w) * w3[2]; o[15] += bfhi(c.w) * w3[3]; }
#pragma unroll
    for (int i = 0; i < 16; ++i) o[i] = silu_f(o[i]) * scale;
}
constexpr int TRT = 4096 + 64, RCH = 1024 + 16;
constexpr int TRIMG = 4 * TRT, ROWIMG = 16 * RCH;
__device__ __forceinline__ unsigned tr_lane_off(int lane) { const int hi = lane >> 5; return ((lane >> 4) & 1) * 32 + (lane & 3) * 8 + (4 * hi + ((lane & 15) >> 2)) * 64; }

#if DBG_CHECK == 2
#define DBGF(code, val) do { const float _v = (val); if ((__float_as_uint(_v) & 0x7f800000u) == 0x7f800000u) atomicMin((unsigned*)(F.ws + WS_CTL) + CW_DBG, (unsigned)(code)); } while (0)
#else
#define DBGF(code, val) do {} while (0)
#endif
struct MaPF { u32x4 k0, k1, v0, v1, hk0, hk1; float wk, g0, g1; };
__device__ __forceinline__ void mlstm_a_load(Frame& F, int job, int tid, MaPF& pf) {
    const int lane = tid & 63, w = F.wave;
    const int bh = job >> 6, c = job & 63, b = bh >> 2, h = bh & 3, s0 = c * 64, s = tid >> 3, chg = tid & 7;
    const size_t ro = ((size_t)b * SEQ + s0 + s) * 512 + h * 128 + chg * 16;
    const bf16_t* kp = WSP(bf16_t, WS_MK) + ro; const bf16_t* vp = WSP(bf16_t, WS_MV) + ro;
    pf.k0 = *(const u32x4*)kp; pf.k1 = *(const u32x4*)(kp + 8); pf.v0 = *(const u32x4*)vp; pf.v1 = *(const u32x4*)(vp + 8);
    pf.hk0 = (u32x4){0u, 0u, 0u, 0u}; pf.hk1 = pf.hk0;
    if (s < 3 && s0 - 3 + s >= 0) { const bf16_t* hp = WSP(bf16_t, WS_MK) + ((size_t)b * SEQ + s0 - 3 + s) * 512 + h * 128 + chg * 16; pf.hk0 = *(const u32x4*)hp; pf.hk1 = *(const u32x4*)(hp + 8); }
    pf.wk = IN_F(10)[(tid >> 7) * 1024 + 512 + h * 128 + (tid & 127)];
    pf.g0 = 0.f; pf.g1 = 0.f;
    if (w == 0) { pf.g0 = WSP(float, WS_GF)[(size_t)bh * SEQ + s0 + lane]; pf.g1 = WSP(float, WS_GI)[(size_t)bh * SEQ + s0 + lane]; }
}
__device__ __forceinline__ void mlstm_a_phase(Frame& F) {
    int tid = F.tid; asm volatile("" : "+v"(tid));
    const int lane = tid & 63, w = F.wave, r32 = lane & 31, hi = lane >> 5;
    LAS unsigned char* kimg = F.lds; LAS unsigned char* vimg = F.lds + TRIMG; LAS float* wS = (LAS float*)(F.lds + 2 * TRIMG);
    LAS unsigned char* RAWK = F.lds + 2 * TRIMG + 1024; LAS float* WLK = (LAS float*)(RAWK + RAWIMG);
    LAS bf16_t* OST = (LAS bf16_t*)(F.lds + 2 * TRIMG + 1024 + RAWIMG + 2048) + w * 2048;
    MaPF pf; int job = F.vcu;
    if (job < 2048) mlstm_a_load(F, job, tid, pf);
    for (; job < 2048; job += F.G) {
        {
            const int s = tid >> 3, chg = tid & 7;
            *(LAS u32x4*)(RAWK + (s + 3) * RAWS + chg * 32) = pf.k0; *(LAS u32x4*)(RAWK + (s + 3) * RAWS + chg * 32 + 16) = pf.k1;
            if (s < 3) { *(LAS u32x4*)(RAWK + s * RAWS + chg * 32) = pf.hk0; *(LAS u32x4*)(RAWK + s * RAWS + chg * 32 + 16) = pf.hk1; }
            WLK[tid] = pf.wk;
            if (w == 0) {
                const float bs = wave_scan_add(pf.g0);
                const float g = __int_as_float(__builtin_amdgcn_readlane(__float_as_int(bs), 63));
                const float a = g - bs + pf.g1; const float ml = wave_max(a);
                wS[lane] = __expf(a - ml);
                if (lane == 0) { WSP(float, WS_GSUM)[job] = g; WSP(float, WS_MLOC)[job] = ml; }
            }
        }
        const u32x4 va = pf.v0, vd = pf.v1;
        __syncthreads();
        if (job + F.G < 2048) mlstm_a_load(F, job + F.G, tid, pf);
        {
            const int s = tid >> 3, chg = tid & 7, ch0 = chg * 16;
            float kf[16]; conv_lds16(RAWK, WLK, s, ch0, 0.08838834764831845f, kf);
            const unsigned off = (ch0 >> 5) * TRT + s * 64 + (ch0 & 31) * 2;
            u32x4 k0, k1; k0.x = cvtpk(kf[0], kf[1]); k0.y = cvtpk(kf[2], kf[3]); k0.z = cvtpk(kf[4], kf[5]); k0.w = cvtpk(kf[6], kf[7]);
            k1.x = cvtpk(kf[8], kf[9]); k1.y = cvtpk(kf[10], kf[11]); k1.z = cvtpk(kf[12], kf[13]); k1.w = cvtpk(kf[14], kf[15]);
            *(LAS u32x4*)(kimg + off) = k0; *(LAS u32x4*)(kimg + off + 16) = k1;
            const float ws = wS[s];
            u32x4 v0, v1;
            v0.x = cvtpk(bflo(va.x) * ws, bfhi(va.x) * ws); v0.y = cvtpk(bflo(va.y) * ws, bfhi(va.y) * ws); v0.z = cvtpk(bflo(va.z) * ws, bfhi(va.z) * ws); v0.w = cvtpk(bflo(va.w) * ws, bfhi(va.w) * ws);
            v1.x = cvtpk(bflo(vd.x) * ws, bfhi(vd.x) * ws); v1.y = cvtpk(bflo(vd.y) * ws, bfhi(vd.y) * ws); v1.z = cvtpk(bflo(vd.z) * ws, bfhi(vd.z) * ws); v1.w = cvtpk(bflo(vd.w) * ws, bfhi(vd.w) * ws);
            *(LAS u32x4*)(vimg + off) = v0; *(LAS u32x4*)(vimg + off + 16) = v1;
        }
        __syncthreads();
        {
            const int et = w >> 1, dt0 = 2 * (w & 1); const unsigned lo = tr_lane_off(lane);
            f32x16 acc0 = {0}, acc1 = {0};
#pragma unroll
            for (int ks = 0; ks < 4; ++ks) {
                const bf16x8 a = mk8(vtr(vimg + et * TRT + ks * 1024 + lo), vtr(vimg + et * TRT + ks * 1024 + lo + 512));
                const bf16x8 b0 = mk8(vtr(kimg + dt0 * TRT + ks * 1024 + lo), vtr(kimg + dt0 * TRT + ks * 1024 + lo + 512));
                const bf16x8 b1 = mk8(vtr(kimg + (dt0 + 1) * TRT + ks * 1024 + lo), vtr(kimg + (dt0 + 1) * TRT + ks * 1024 + lo + 512));
                acc0 = MFMA32(a, b0, acc0); acc1 = MFMA32(a, b1, acc1);
            }
#pragma unroll
            for (int r = 0; r < 16; ++r) { const int el = crow(r, hi); OST[el * 64 + r32] = f2bf(acc0[r]); OST[el * 64 + 32 + r32] = f2bf(acc1[r]); }
            asm volatile("s_waitcnt lgkmcnt(0)" ::: "memory");
            bf16_t* dst = WSP(bf16_t, WS_KVC) + (size_t)job * 16384 + (size_t)(et * 32) * 128 + dt0 * 32;
#pragma unroll
            for (int i = 0; i < 4; ++i) { const int rw = i * 8 + (lane >> 3), ch = lane & 7; *(u32x4*)(dst + (size_t)rw * 128 + ch * 8) = *(LAS const u32x4*)(OST + rw * 64 + ch * 8); }
        }
        if (tid < 128) {
            float sacc = 0.f; const int d = tid;
            for (int ss = 0; ss < 64; ++ss) sacc += wS[ss] * bf2f(*(LAS const bf16_t*)(kimg + (d >> 5) * TRT + ss * 64 + (d & 31) * 2));
            WSP(float, WS_NC)[(size_t)job * 128 + d] = sacc;
        }
        __syncthreads();
    }
}

__device__ __forceinline__ void mlstm_scan_job(Frame& F, int job) {
    int tid = F.tid; asm volatile("" : "+v"(tid));
    const int bh = job >> 3, sl = job & 7;
    LAS float* aold = (LAS float*)F.lds; LAS float* anew = aold + 64; LAS float* gS = aold + 128; LAS float* mS = aold + 192;
    if (tid < 64) { gS[tid] = WSP(float, WS_GSUM)[bh * 64 + tid]; mS[tid] = WSP(float, WS_MLOC)[bh * 64 + tid]; }
    __syncthreads();
    if (tid == 0) {
        float m = 0.f;
        for (int c = 0; c < 64; ++c) { const float g = gS[c], ml = mS[c];
            const float mn = fmaxf(g + m, ml); aold[c] = __expf(g + m - mn); anew[c] = __expf(ml - mn);
            gS[c] = m;
            m = mn; }
    }
    __syncthreads();
    if (sl == 0 && tid < 64) WSP(float, WS_MPREV)[bh * 64 + tid] = gS[tid];
    const size_t base = (size_t)bh * 64 * 16384 + (size_t)sl * 2048 + tid * 4;
    const bf16_t* kv = WSP(bf16_t, WS_KVC) + base; bf16_t* cp = WSP(bf16_t, WS_CPREV) + base;
    f32x4 C = {0.f, 0.f, 0.f, 0.f};
#pragma unroll 8
    for (int c = 0; c < 64; ++c) {
        const u32x2 k = *(const u32x2*)(kv + (size_t)c * 16384);
        u32x2 o; o.x = cvtpk(C[0], C[1]); o.y = cvtpk(C[2], C[3]); *(u32x2*)(cp + (size_t)c * 16384) = o;
        const float ao = aold[c], an = anew[c]; DBGF(22, ao); DBGF(23, an); DBGF(24, bflo(k.x)); DBGF(24, bfhi(k.x)); DBGF(24, bflo(k.y)); DBGF(24, bfhi(k.y)); DBGF(25, C[0]);
        C[0] = ao * C[0] + an * bflo(k.x); C[1] = ao * C[1] + an * bfhi(k.x); C[2] = ao * C[2] + an * bflo(k.y); C[3] = ao * C[3] + an * bfhi(k.y);
    }
    if (sl == 0 && tid < 128) {
        float n = 0.f;
        for (int c0 = 0; c0 < 64; c0 += 16) { float nc[16];
#pragma unroll
            for (int i = 0; i < 16; ++i) nc[i] = WSP(float, WS_NC)[(size_t)(bh * 64 + c0 + i) * 128 + tid];
#pragma unroll
            for (int i = 0; i < 16; ++i) { WSP(float, WS_NPREV)[(size_t)(bh * 64 + c0 + i) * 128 + tid] = n; n = aold[c0 + i] * n + anew[c0 + i] * nc[i]; } }
    }
    __syncthreads();
}

struct McPF { u32x4 q0, q1, k0, k1, v0, v1, hq0, hq1, hk0, hk1; float wq, wk, g0, g1, mprev; u32x2 mo[4]; };
__device__ __forceinline__ void mlstm_c_load(Frame& F, int job, int tid, McPF& pf) {
    const int lane = tid & 63, w = F.wave, r32 = lane & 31, hi = lane >> 5;
    const int bh = job >> 6, c = job & 63, b = bh >> 2, h = bh & 3, s0 = c * 64, s = tid >> 3, chg = tid & 7;
    const size_t ro = ((size_t)b * SEQ + s0 + s) * 512 + h * 128 + chg * 16;
    const bf16_t* qp = WSP(bf16_t, WS_MQ) + ro; const bf16_t* kp = WSP(bf16_t, WS_MK) + ro; const bf16_t* vp = WSP(bf16_t, WS_MV) + ro;
    pf.q0 = *(const u32x4*)qp; pf.q1 = *(const u32x4*)(qp + 8); pf.k0 = *(const u32x4*)kp; pf.k1 = *(const u32x4*)(kp + 8); pf.v0 = *(const u32x4*)vp; pf.v1 = *(const u32x4*)(vp + 8);
    pf.hq0 = (u32x4){0u, 0u, 0u, 0u}; pf.hq1 = pf.hq0; pf.hk0 = pf.hq0; pf.hk1 = pf.hq0;
    if (s < 3 && s0 - 3 + s >= 0) { const size_t ho = ((size_t)b * SEQ + s0 - 3 + s) * 512 + h * 128 + chg * 16;
        pf.hq0 = *(const u32x4*)(WSP(bf16_t, WS_MQ) + ho); pf.hq1 = *(const u32x4*)(WSP(bf16_t, WS_MQ) + ho + 8); pf.hk0 = *(const u32x4*)(WSP(bf16_t, WS_MK) + ho); pf.hk1 = *(const u32x4*)(WSP(bf16_t, WS_MK) + ho + 8); }
    pf.wq = IN_F(10)[(tid >> 7) * 1024 + h * 128 + (tid & 127)]; pf.wk = IN_F(10)[(tid >> 7) * 1024 + 512 + h * 128 + (tid & 127)];
    pf.g0 = 0.f; pf.g1 = 0.f;
    if (w == 0) { pf.g0 = WSP(float, WS_GF)[(size_t)bh * SEQ + s0 + lane]; pf.g1 = WSP(float, WS_GI)[(size_t)bh * SEQ + s0 + lane]; }
    if (w == 1) { pf.g0 = WSP(float, WS_NPREV)[(size_t)job * 128 + lane]; pf.g1 = WSP(float, WS_NPREV)[(size_t)job * 128 + 64 + lane]; }
    pf.mprev = WSP(float, WS_MPREV)[job];
    const int tw = w & 1, ew = w >> 1, t = 32 * tw + r32;
    const bf16_t* mo = WSP(bf16_t, WS_MO) + ((size_t)b * SEQ + s0 + t) * 512 + h * 128 + 32 * ew + 4 * hi;
#pragma unroll
    for (int q4 = 0; q4 < 4; ++q4) pf.mo[q4] = *(const u32x2*)(mo + 8 * q4);
}
__device__ __forceinline__ void mlstm_c_phase(Frame& F) {
    int tid = F.tid; asm volatile("" : "+v"(tid));
    const int lane = tid & 63, w = F.wave, r32 = lane & 31, hi = lane >> 5;
    LAS unsigned char* qimg = F.lds; LAS unsigned char* kimg = F.lds + ROWIMG; LAS unsigned char* vimg = F.lds + 2 * ROWIMG;
    LAS float* uS = (LAS float*)(F.lds + 2 * ROWIMG + TRIMG); LAS float* MS = uS + 64; LAS float* bS = uS + 128; LAS float* nS = uS + 192; LAS float* ssq = uS + 320;
    LAS unsigned char* RAWQ = F.lds + 2 * ROWIMG + TRIMG + 4096; LAS unsigned char* RAWK = RAWQ + RAWIMG; LAS float* WLQ = (LAS float*)(RAWK + RAWIMG); LAS float* WLK = WLQ + 512;
    LAS float* HNL = (LAS float*)(F.lds + MISC_OFF + 2048);
    HNL[tid] = IN_F(12)[tid];
    const int tw = w & 1, ew = w >> 1, t = 32 * tw + r32;
    McPF pf;
    int job = F.vcu;
    if (job < 2048) mlstm_c_load(F, job, tid, pf);
    for (; job < 2048; job += F.G) {
        const int bh = job >> 6, c = job & 63, b = bh >> 2, h = bh & 3, s0 = c * 64;
        const float mprev = pf.mprev; u32x2 moc[4];
#pragma unroll
        for (int q4 = 0; q4 < 4; ++q4) moc[q4] = pf.mo[q4];
        {
            const int s = tid >> 3, chg = tid & 7, ch0 = chg * 16;
            *(LAS u32x4*)(RAWQ + (s + 3) * RAWS + chg * 32) = pf.q0; *(LAS u32x4*)(RAWQ + (s + 3) * RAWS + chg * 32 + 16) = pf.q1;
            *(LAS u32x4*)(RAWK + (s + 3) * RAWS + chg * 32) = pf.k0; *(LAS u32x4*)(RAWK + (s + 3) * RAWS + chg * 32 + 16) = pf.k1;
            if (s < 3) { *(LAS u32x4*)(RAWQ + s * RAWS + chg * 32) = pf.hq0; *(LAS u32x4*)(RAWQ + s * RAWS + chg * 32 + 16) = pf.hq1;
                         *(LAS u32x4*)(RAWK + s * RAWS + chg * 32) = pf.hk0; *(LAS u32x4*)(RAWK + s * RAWS + chg * 32 + 16) = pf.hk1; }
            WLQ[tid] = pf.wq; WLK[tid] = pf.wk;
            const unsigned off = (ch0 >> 5) * TRT + s * 64 + (ch0 & 31) * 2;
            *(LAS u32x4*)(vimg + off) = pf.v0; *(LAS u32x4*)(vimg + off + 16) = pf.v1;
            if (w == 0) {
                const float bs = wave_scan_add(pf.g0);
                const float u = pf.g1 - bs; const float cm = wave_scan_max(u);
                uS[lane] = u; MS[lane] = fmaxf(mprev, cm); bS[lane] = bs;
            }
            if (w == 1) { nS[lane] = pf.g0; nS[64 + lane] = pf.g1; }
        }
        __syncthreads();
        bf16x8 cf[8];
        { const bf16_t* cp = WSP(bf16_t, WS_CPREV) + (size_t)job * 16384 + (size_t)(32 * ew + r32) * 128 + 8 * hi;
#pragma unroll
          for (int ks = 0; ks < 8; ++ks) cf[ks] = *(const bf16x8*)(cp + 16 * ks); }
        if (job + F.G < 2048) mlstm_c_load(F, job + F.G, tid, pf);
        {
            const int s = tid >> 3, chg = tid & 7, ch0 = chg * 16;
            float qf[16]; conv_lds16(RAWQ, WLQ, s, ch0, 1.f, qf);
            u32x4 q0, q1; q0.x = cvtpk(qf[0], qf[1]); q0.y = cvtpk(qf[2], qf[3]); q0.z = cvtpk(qf[4], qf[5]); q0.w = cvtpk(qf[6], qf[7]);
            q1.x = cvtpk(qf[8], qf[9]); q1.y = cvtpk(qf[10], qf[11]); q1.z = cvtpk(qf[12], qf[13]); q1.w = cvtpk(qf[14], qf[15]);
            *(LAS u32x4*)(qimg + (2 * chg) * RCH + s * 16) = q0; *(LAS u32x4*)(qimg + (2 * chg + 1) * RCH + s * 16) = q1;
            float kf[16]; conv_lds16(RAWK, WLK, s, ch0, 0.08838834764831845f, kf);
            u32x4 k0, k1; k0.x = cvtpk(kf[0], kf[1]); k0.y = cvtpk(kf[2], kf[3]); k0.z = cvtpk(kf[4], kf[5]); k0.w = cvtpk(kf[6], kf[7]);
            k1.x = cvtpk(kf[8], kf[9]); k1.y = cvtpk(kf[10], kf[11]); k1.z = cvtpk(kf[12], kf[13]); k1.w = cvtpk(kf[14], kf[15]);
            *(LAS u32x4*)(kimg + (2 * chg) * RCH + s * 16) = k0; *(LAS u32x4*)(kimg + (2 * chg + 1) * RCH + s * 16) = k1;
        }
        __syncthreads();
        const float Mt = MS[t], bt = bS[t];
        const float dec = __expf(mprev - Mt), mt = bt + Mt;
        bf16x8 qf[8];
#pragma unroll
        for (int ks = 0; ks < 8; ++ks) qf[ks] = *(LAS const bf16x8*)(qimg + (2 * ks + hi) * RCH + t * 16);
        f32x16 p[2]; p[0] = (f32x16){0}; p[1] = (f32x16){0};
#pragma unroll
        for (int st = 0; st < 2; ++st) {
            if (st <= tw) {
#pragma unroll
                for (int ks = 0; ks < 8; ++ks) { const bf16x8 kf = *(LAS const bf16x8*)(kimg + (2 * ks + hi) * RCH + (32 * st + r32) * 16); p[st] = MFMA32(kf, qf[ks], p[st]); }
            }
        }
        float rs = 0.f;
#pragma unroll
        for (int st = 0; st < 2; ++st)
#pragma unroll
            for (int r = 0; r < 16; ++r) { const int s = 32 * st + crow(r, hi);
                const float wv = (s <= t) ? __expf(uS[s] - Mt) * p[st][r] : 0.f; p[st][r] = wv; rs += wv; }
        rs += __shfl_xor(rs, 32);
        float qn = 0.f;
#pragma unroll
        for (int ks = 0; ks < 8; ++ks)
#pragma unroll
            for (int j = 0; j < 8; ++j) qn += bf2f((bf16_t)qf[ks][j]) * nS[16 * ks + 8 * hi + j];
        qn += __shfl_xor(qn, 32);
        const float den = rs + dec * qn;
        const float hden = fmaxf(fabsf(den), __expf(-mt));
        f32x16 ai = {0}, ae = {0};
        const unsigned lo = tr_lane_off(lane);
#pragma unroll
        for (int st = 0; st < 2; ++st) {
            if (st <= tw) {
#pragma unroll
                for (int s2 = 0; s2 < 2; ++s2) { const int ks = 2 * st + s2;
                    const bf16x8 vf = mk8(vtr(vimg + ew * TRT + ks * 1024 + lo), vtr(vimg + ew * TRT + ks * 1024 + lo + 512));
                    u32x4 pw; pw.x = cvtpk(p[st][8 * s2 + 0], p[st][8 * s2 + 1]); pw.y = cvtpk(p[st][8 * s2 + 2], p[st][8 * s2 + 3]); pw.z = cvtpk(p[st][8 * s2 + 4], p[st][8 * s2 + 5]); pw.w = cvtpk(p[st][8 * s2 + 6], p[st][8 * s2 + 7]);
                    ai = MFMA32(vf, __builtin_bit_cast(bf16x8, pw), ai); }
            }
        }
#pragma unroll
        for (int ks = 0; ks < 8; ++ks) ae = MFMA32(cf[ks], qf[ks], ae);
        float hv[16]; float ss = 0.f; const float rden = 1.f / hden;
#pragma unroll
        for (int r = 0; r < 16; ++r) { hv[r] = (ai[r] + dec * ae[r]) * rden; ss += hv[r] * hv[r]; }
        ss += __shfl_xor(ss, 32);
        if (hi == 0) ssq[ew * 64 + t] = ss;
        __syncthreads();
        const float tot = ssq[t] + ssq[64 + t] + ssq[128 + t] + ssq[192 + t];
        const float rn = rsqrtf(tot * (1.f / 128.f) + RMS_EPS);
        LAS const float* hn = HNL + h * 128 + 32 * ew;
        bf16_t* yo = WSP(bf16_t, WS_YCAT) + ((size_t)b * SEQ + s0 + t) * 1024 + h * 128 + 32 * ew;
#pragma unroll
        for (int p2 = 0; p2 < 2; ++p2) { u32x2 ov[2];
#pragma unroll
            for (int e = 0; e < 2; ++e) { const int q4 = 2 * p2 + e; const int e0 = 8 * q4 + 4 * hi;
                const u32x2 om = moc[q4]; const f32x4 wn = *(LAS const f32x4*)(hn + e0);
                const float y0 = hv[4 * q4 + 0] * rn * wn[0] * sigmoid_f(bflo(om.x)), y1 = hv[4 * q4 + 1] * rn * wn[1] * sigmoid_f(bfhi(om.x));
                const float y2 = hv[4 * q4 + 2] * rn * wn[2] * sigmoid_f(bflo(om.y)), y3 = hv[4 * q4 + 3] * rn * wn[3] * sigmoid_f(bfhi(om.y));
                ov[e].x = cvtpk(y0, y1); ov[e].y = cvtpk(y2, y3); }
            *(u32x4*)(yo + 16 * p2 + 8 * hi) = widen_pair(ov[0], ov[1]); }
        __syncthreads();
    }
}

__device__ __forceinline__ void compress_job(Frame& F, int job) {
    int lane = F.lane; asm volatile("" : "+v"(lane));
    const int w = F.wave, r32 = lane & 31, hi = lane >> 5;
    const int kv = job >> 7, bg = (job >> 3) & 15, i0 = (job & 7) * 32;
    const bf16_t* X = WSP(bf16_t, kv ? WS_VC : WS_KC) + (size_t)bg * SEQ * 64;
    const bf16_t* W1 = WSP(bf16_t, kv ? WS_CW1V : WS_CW1K); const bf16_t* W2 = WSP(bf16_t, kv ? WS_CW2V : WS_CW2K);
    const float* c1 = WSP(float, WS_C1B) + kv * 128;
    bf16_t* O = WSP(bf16_t, kv ? WS_VCMP : WS_KCMP) + (size_t)bg * 256 * 64;
    LAS unsigned char* himg = F.lds;
    LAS float* part = (LAS float*)(F.lds + ROWIMG);
    const int nt = w & 3, kh = w >> 2;
    f32x16 acc = {0};
    {
        int i = i0 + r32; if (i > 254) i = 254;
        const bf16_t* ap = X + (size_t)i * 1024 + kh * 1024 + 8 * hi; const bf16_t* bp = W1 + (size_t)(32 * nt + r32) * 2048 + kh * 1024 + 8 * hi;
#pragma unroll 16
        for (int ks = 0; ks < 64; ++ks) { const bf16x8 a = *(const bf16x8*)(ap + 16 * ks), bb = *(const bf16x8*)(bp + 16 * ks); acc = MFMA32(a, bb, acc); }
    }
    if (kh == 1) {
#pragma unroll
        for (int r = 0; r < 16; ++r) part[(nt * 16 + r) * 64 + lane] = acc[r];
    }
    __syncthreads();
    if (kh == 0) {
        const int n = 32 * nt + r32; const float cb = c1[n];
#pragma unroll
        for (int r = 0; r < 16; ++r) { const int rowl = crow(r, hi); const float v = acc[r] + part[(nt * 16 + r) * 64 + lane] + cb;
            *(LAS bf16_t*)(himg + (n >> 3) * RCH + rowl * 16 + (n & 7) * 2) = f2bf(silu_f(v)); }
    }
    __syncthreads();
    if (w < 2) {
        f32x16 a2 = {0};
#pragma unroll
        for (int ks = 0; ks < 8; ++ks) { const bf16x8 a = *(LAS const bf16x8*)(himg + (2 * ks + hi) * RCH + r32 * 16);
            const bf16x8 bb = *(const bf16x8*)(W2 + (size_t)(32 * w + r32) * 128 + 16 * ks + 8 * hi); a2 = MFMA32(a, bb, a2); }
#pragma unroll
        for (int r = 0; r < 16; ++r) { const int i = i0 + crow(r, hi); if (i < 255) O[(size_t)i * 64 + 32 * w + r32] = f2bf(a2[r]); }
    }
    __syncthreads();
}

constexpr int NSA_KCH = 1024 + 16, NSA_VDH = 4096 + 64, NSA_KIMG = 8 * NSA_KCH, NSA_VIMG = 2 * NSA_VDH, NSA_BUF = NSA_KIMG + NSA_VIMG;
constexpr int NSA_IMP = 2 * NSA_BUF, NSA_IST = 65, NSA_TOT = NSA_IMP + 256 * NSA_IST * 4,
              NSA_SELB = MISC_OFF + 1024, NSA_UNI = NSA_SELB + 512;
constexpr int NSA_FAC = NSA_TOT + 64 * NSA_IST * 4;
constexpr int NSA_STASH = 96 * 1024;
static_assert(4 * NSA_BUF <= NSA_STASH && NSA_FAC + 4096 <= MISC_OFF && NSA_STASH + 8 * 4096 <= MISC_OFF, "NSA LDS map");

__device__ __forceinline__ void nsa_qk(LAS const unsigned char* kimg, const bf16x8 (&qr)[4], unsigned kfo, f32x16& p0, f32x16& p1) {
    bf16x8 kf[8];
#pragma unroll
    for (int d0 = 0; d0 < 4; ++d0) { kf[2 * d0] = *(LAS const bf16x8*)(kimg + kfo + d0 * (2 * NSA_KCH)); kf[2 * d0 + 1] = *(LAS const bf16x8*)(kimg + kfo + d0 * (2 * NSA_KCH) + 512); }
    __builtin_amdgcn_sched_barrier(0);
    p0 = (f32x16){0}; p1 = (f32x16){0};
#pragma unroll
    for (int d0 = 0; d0 < 4; ++d0) { p0 = MFMA32(kf[2 * d0], qr[d0], p0); p1 = MFMA32(kf[2 * d0 + 1], qr[d0], p1); }
}
constexpr float NSA_THR = 8.f;
template <int KIND>
__device__ __forceinline__ void nsa_tile(LAS const unsigned char* kimg, LAS const unsigned char* vimg, const bf16x8 (&qr)[4], int kbase, int t, bool edge, bool rowvalid,
                                         float& m, float& l, f32x16& o0, f32x16& o1, unsigned kfo, unsigned vfo, int hi) {
    f32x16 p0, p1; nsa_qk(kimg, qr, kfo, p0, p1);
    if (edge) {
#pragma unroll
        for (int r = 0; r < 16; ++r) { const int k0 = kbase + crow(r, hi), k1 = k0 + 32; bool v0, v1;
            if (KIND == 1) { v0 = k0 <= t; v1 = k1 <= t; } else { v0 = k0 <= t && k0 >= t - 511; v1 = k1 <= t && k1 >= t - 511; }
            p0[r] = v0 ? p0[r] : -INFINITY; p1[r] = v1 ? p1[r] : -INFINITY; }
    }
    float mx = fmaxf(p0[0], p1[0]);
#pragma unroll
    for (int r = 1; r < 16; ++r) mx = fmaxf(mx, fmaxf(p0[r], p1[r]));
    mx = rowvalid ? mx : -INFINITY;
    mx = fmaxf(mx, __shfl_xor(mx, 32));
    if (__any(mx - m > NSA_THR)) {
        const float mn = fmaxf(m, mx); const float alpha = ex2(m - mn); m = mn; l *= alpha;
#pragma unroll
        for (int r = 0; r < 16; ++r) { o0[r] *= alpha; o1[r] *= alpha; }
    }
    const float me = rowvalid ? m : INFINITY;
    float rs = 0.f;
#pragma unroll
    for (int r = 0; r < 16; ++r) { p0[r] = ex2(p0[r] - me); p1[r] = ex2(p1[r] - me); rs += p0[r] + p1[r]; }
    l += rs;
    u32x4 pw[4];
#pragma unroll
    for (int s = 0; s < 2; ++s) {
        pw[s].x = cvtpk(p0[8 * s + 0], p0[8 * s + 1]); pw[s].y = cvtpk(p0[8 * s + 2], p0[8 * s + 3]); pw[s].z = cvtpk(p0[8 * s + 4], p0[8 * s + 5]); pw[s].w = cvtpk(p0[8 * s + 6], p0[8 * s + 7]);
        pw[2 + s].x = cvtpk(p1[8 * s + 0], p1[8 * s + 1]); pw[2 + s].y = cvtpk(p1[8 * s + 2], p1[8 * s + 3]); pw[2 + s].z = cvtpk(p1[8 * s + 4], p1[8 * s + 5]); pw[2 + s].w = cvtpk(p1[8 * s + 6], p1[8 * s + 7]);
    }
    bf16x8 vf[8];
#pragma unroll
    for (int ks = 0; ks < 4; ++ks) { vf[2 * ks] = mk8(vtr(vimg + vfo + ks * 1024), vtr(vimg + vfo + ks * 1024 + 512)); vf[2 * ks + 1] = mk8(vtr(vimg + vfo + NSA_VDH + ks * 1024), vtr(vimg + vfo + NSA_VDH + ks * 1024 + 512)); }
    __builtin_amdgcn_sched_barrier(0);
#pragma unroll
    for (int ks = 0; ks < 4; ++ks) { o0 = MFMA32(vf[2 * ks], __builtin_bit_cast(bf16x8, pw[ks]), o0); o1 = MFMA32(vf[2 * ks + 1], __builtin_bit_cast(bf16x8, pw[ks]), o1); }
}

template <int KIND>
__device__ __forceinline__ void nsa_tile2(LAS const unsigned char* kA, LAS const unsigned char* vA, LAS const unsigned char* kB, LAS const unsigned char* vB, bool hasB,
                                          const bf16x8 (&qr)[4], int kbA, int kbB, int t, bool edgeA, bool edgeB, bool rvA, bool rvB,
                                          float& m, float& l, f32x16& o0, f32x16& o1, unsigned kfo, unsigned vfo, int hi) {
    f32x16 a0, a1, b0, b1;
    nsa_qk(kA, qr, kfo, a0, a1);
    __builtin_amdgcn_sched_barrier(0);
    if (hasB) nsa_qk(kB, qr, kfo, b0, b1);
    else {
#pragma unroll
        for (int r = 0; r < 16; ++r) { b0[r] = -INFINITY; b1[r] = -INFINITY; } }
    if (edgeA) {
#pragma unroll
        for (int r = 0; r < 16; ++r) { const int k0 = kbA + crow(r, hi), k1 = k0 + 32; bool v0, v1;
            if (KIND == 1) { v0 = k0 <= t; v1 = k1 <= t; } else { v0 = k0 <= t && k0 >= t - 511; v1 = k1 <= t && k1 >= t - 511; }
            a0[r] = v0 ? a0[r] : -INFINITY; a1[r] = v1 ? a1[r] : -INFINITY; } }
    if (edgeB) {
#pragma unroll
        for (int r = 0; r < 16; ++r) { const int k0 = kbB + crow(r, hi), k1 = k0 + 32; bool v0, v1;
            if (KIND == 1) { v0 = k0 <= t; v1 = k1 <= t; } else { v0 = k0 <= t && k0 >= t - 511; v1 = k1 <= t && k1 >= t - 511; }
            b0[r] = v0 ? b0[r] : -INFINITY; b1[r] = v1 ? b1[r] : -INFINITY; } }
    __builtin_amdgcn_sched_barrier(0);
    const bool fresh = m < -1e29f; const float mb = fresh ? 0.f : m;
    const float meA = rvA ? mb : INFINITY, meB = rvB ? mb : INFINITY;
#pragma unroll
    for (int r = 0; r < 16; ++r) { a0[r] -= meA; a1[r] -= meA; b0[r] -= meB; b1[r] -= meB; }
    float mx = fmaxf(fmaxf(a0[0], a1[0]), fmaxf(b0[0], b1[0]));
#pragma unroll
    for (int r = 1; r < 16; ++r) mx = fmaxf(mx, fmaxf(fmaxf(a0[r], a1[r]), fmaxf(b0[r], b1[r])));
    mx = fmaxf(mx, __shfl_xor(mx, 32));
    const bool has = mx > -INFINITY;
    const float delta = fresh ? (has ? mx : 0.f) : (mx > NSA_THR ? mx : 0.f);
    if (__any(delta != 0.f)) {
        const float alpha = fresh ? 1.f : ex2(-delta); l *= alpha;
#pragma unroll
        for (int r = 0; r < 16; ++r) { o0[r] *= alpha; o1[r] *= alpha; a0[r] -= delta; a1[r] -= delta; b0[r] -= delta; b1[r] -= delta; }
    }
    m = fresh ? (has ? mx : m) : m + delta;
    float rs = 0.f;
#pragma unroll
    for (int r = 0; r < 16; ++r) { a0[r] = ex2(a0[r]); a1[r] = ex2(a1[r]); b0[r] = ex2(b0[r]); b1[r] = ex2(b1[r]); rs += (a0[r] + a1[r]) + (b0[r] + b1[r]); }
    l += rs;
    __builtin_amdgcn_sched_barrier(0);
    {
        u32x4 pw[4];
#pragma unroll
        for (int s = 0; s < 2; ++s) {
            pw[s].x = cvtpk(a0[8 * s + 0], a0[8 * s + 1]); pw[s].y = cvtpk(a0[8 * s + 2], a0[8 * s + 3]); pw[s].z = cvtpk(a0[8 * s + 4], a0[8 * s + 5]); pw[s].w = cvtpk(a0[8 * s + 6], a0[8 * s + 7]);
            pw[2 + s].x = cvtpk(a1[8 * s + 0], a1[8 * s + 1]); pw[2 + s].y = cvtpk(a1[8 * s + 2], a1[8 * s + 3]); pw[2 + s].z = cvtpk(a1[8 * s + 4], a1[8 * s + 5]); pw[2 + s].w = cvtpk(a1[8 * s + 6], a1[8 * s + 7]); }
        bf16x8 vf[8];
#pragma unroll
        for (int ks = 0; ks < 4; ++ks) { vf[2 * ks] = mk8(vtr(vA + vfo + ks * 1024), vtr(vA + vfo + ks * 1024 + 512)); vf[2 * ks + 1] = mk8(vtr(vA + vfo + NSA_VDH + ks * 1024), vtr(vA + vfo + NSA_VDH + ks * 1024 + 512)); }
        __builtin_amdgcn_sched_barrier(0);
#pragma unroll
        for (int ks = 0; ks < 4; ++ks) { o0 = MFMA32(vf[2 * ks], __builtin_bit_cast(bf16x8, pw[ks]), o0); o1 = MFMA32(vf[2 * ks + 1], __builtin_bit_cast(bf16x8, pw[ks]), o1); }
    }
    __builtin_amdgcn_sched_barrier(0);
    if (hasB) {
        u32x4 pw[4];
#pragma unroll
        for (int s = 0; s < 2; ++s) {
            pw[s].x = cvtpk(b0[8 * s + 0], b0[8 * s + 1]); pw[s].y = cvtpk(b0[8 * s + 2], b0[8 * s + 3]); pw[s].z = cvtpk(b0[8 * s + 4], b0[8 * s + 5]); pw[s].w = cvtpk(b0[8 * s + 6], b0[8 * s + 7]);
            pw[2 + s].x = cvtpk(b1[8 * s + 0], b1[8 * s + 1]); pw[2 + s].y = cvtpk(b1[8 * s + 2], b1[8 * s + 3]); pw[2 + s].z = cvtpk(b1[8 * s + 4], b1[8 * s + 5]); pw[2 + s].w = cvtpk(b1[8 * s + 6], b1[8 * s + 7]); }
        bf16x8 vf[8];
#pragma unroll
        for (int ks = 0; ks < 4; ++ks) { vf[2 * ks] = mk8(vtr(vB + vfo + ks * 1024), vtr(vB + vfo + ks * 1024 + 512)); vf[2 * ks + 1] = mk8(vtr(vB + vfo + NSA_VDH + ks * 1024), vtr(vB + vfo + NSA_VDH + ks * 1024 + 512)); }
        __builtin_amdgcn_sched_barrier(0);
#pragma unroll
        for (int ks = 0; ks < 4; ++ks) { o0 = MFMA32(vf[2 * ks], __builtin_bit_cast(bf16x8, pw[ks]), o0); o1 = MFMA32(vf[2 * ks + 1], __builtin_bit_cast(bf16x8, pw[ks]), o1); }
    }
}

#define NPIN(x) asm volatile("" : "+v"(x))
__device__ __forceinline__ void glds16(const void* g, unsigned lds_base) {
    unsigned sv; asm volatile("s_mov_b32 %0, m0\n\ts_mov_b32 m0, %2\n\ts_nop 0\n\tglobal_load_lds_dwordx4 %1, off\n\ts_mov_b32 m0, %0" : "=&s"(sv) : "v"(g), "s"(lds_base) : "memory"); }
#define NSB() __builtin_amdgcn_sched_barrier(0)
#define NMX3(a, b, c) fmaxf(fmaxf((a), (b)), (c))
__device__ __forceinline__ float nsa_rowmax(const f32x16& p0, const f32x16& p1) {
    float a = NMX3(p0[0], p0[1], p1[0]), b = NMX3(p0[2], p0[3], p1[1]); a = NMX3(a, p1[2], p1[3]);
#pragma unroll
    for (int r = 4; r < 16; r += 4) { a = NMX3(a, p0[r], p0[r + 1]); b = NMX3(b, p0[r + 2], p0[r + 3]); a = NMX3(a, p1[r], p1[r + 1]); b = NMX3(b, p1[r + 2], p1[r + 3]); }
    const float m = fmaxf(a, b); const auto rr = __builtin_amdgcn_permlane32_swap(__float_as_uint(m), __float_as_uint(m), false, false);
    return fmaxf(__uint_as_float(rr[0]), __uint_as_float(rr[1])); }
template <int KIND>
__device__ __forceinline__ void nsa_mask(f32x16& p0, f32x16& p1, int kbase, int t, int hi) {
#pragma unroll
    for (int r = 0; r < 16; ++r) { const int k0 = kbase + crow(r, hi), k1 = k0 + 32; bool v0, v1;
        if (KIND == 1) { v0 = k0 <= t; v1 = k1 <= t; } else { v0 = k0 <= t && k0 >= t - 511; v1 = k1 <= t && k1 >= t - 511; }
        p0[r] = v0 ? p0[r] : -INFINITY; p1[r] = v1 ? p1[r] : -INFINITY; } }
template <int KIND>
__device__ __forceinline__ void nsa_pipe(LAS unsigned char* L, const bf16_t* Kp, const bf16_t* Vp, unsigned mlo, unsigned mhi, unsigned sel0, unsigned sel1,
                                         const bf16x8 (&qr)[4], int t, int lane, int w, int hi, unsigned kfo, unsigned vfo,
                                         float& lsum, f32x16& o0, f32x16& o1,
                                         int& sbase, bool pre, const bf16_t* Kn, const bf16_t* Vn, unsigned nlo, unsigned nhi) {
    unsigned ulo = mlo, uhi = mhi;
    const bf16_t* ksrc = Kp + lane * 64 + w * 8; const bf16_t* vsrc = Vp + (16 * (w & 3) + (lane >> 2)) * 64 + (w >> 2) * 32 + (lane & 3) * 8;
    const unsigned kdst = (unsigned)(uintptr_t)L + w * NSA_KCH, vdst = (unsigned)(uintptr_t)L + NSA_KIMG + (w >> 2) * NSA_VDH + (w & 3) * 1024;
#define NP_DMAS(KS, VS, j, sl) do { const int ps_ = ((sl) + sbase) & 3; glds16((KS) + (size_t)(j) * 4096, (unsigned)__builtin_amdgcn_readfirstlane(kdst + ps_ * NSA_BUF)); glds16((VS) + (size_t)(j) * 4096, (unsigned)__builtin_amdgcn_readfirstlane(vdst + ps_ * NSA_BUF)); } while (0)
#define NP_DMA(j, sl) NP_DMAS(ksrc, vsrc, j, sl)
#define NP_DMAWAIT() asm volatile("s_waitcnt vmcnt(0)" ::: "memory")
    const int n = __builtin_popcount(ulo) + __builtin_popcount(uhi);
#define NP_NEXT(jv) do { jv = -1; if (ulo | uhi) { jv = ulo ? __builtin_ctz(ulo) : 32 + __builtin_ctz(uhi); if (ulo) ulo &= ulo - 1; else uhi &= uhi - 1; } } while (0)
#define NP_SELBIT(j) ((((j) < 32 ? (sel0 >> ((j) & 31)) : (sel1 >> (((j) - 32) & 31))) & 1u) != 0u)
#define NP_KIMG(sl) (L + (((sl) + sbase) & 3) * NSA_BUF)
#define NP_VIMG(sl) (L + (((sl) + sbase) & 3) * NSA_BUF + NSA_KIMG)
    int jc, jn1, jn2;
    NP_NEXT(jc); NP_NEXT(jn1); NP_NEXT(jn2);
    if (!pre) { NP_DMA(jc, 0); if (jn1 >= 0) NP_DMA(jn1, 1); if (jn2 >= 0) NP_DMA(jn2, 2); }
    NP_DMAWAIT();
    __syncthreads();
    float m = -1e30f, cin = 0.f, l = 0.f, fsc = 1.f; bool resc = false;
    o0 = (f32x16){0}; o1 = (f32x16){0};
    f32x16 pA0, pA1, pB0, pB1, ci16; bf16x8 kf[8]; s16x4 vlo[8], vhi[8]; u32x4 pw0, pw1, pw2, pw3;
#define NP_KLOAD2(sl, d0) do { kf[2 * (d0)] = *(LAS const bf16x8*)(NP_KIMG(sl) + kfo + (d0) * (2 * NSA_KCH)); kf[2 * (d0) + 1] = *(LAS const bf16x8*)(NP_KIMG(sl) + kfo + (d0) * (2 * NSA_KCH) + 512); } while (0)
#define NP_SPLAT(v) do { _Pragma("unroll") for (int r = 0; r < 16; ++r) ci16[r] = (v); } while (0)
#define NP_CINIT(jt) do { if (KIND == 1) { const float c_ = NP_SELBIT(jt) ? cin : -INFINITY; NP_SPLAT(c_); } } while (0)
#define NP_DECIDE(C0, C1) do { const float rm_ = nsa_rowmax(C0, C1); const bool fresh_ = m < -1e29f; \
        const bool grow_ = fresh_ ? (rm_ > -INFINITY) : (rm_ > NSA_THR); resc = false; \
        if (__any(grow_)) { const float dl_ = grow_ ? rm_ : 0.f; fsc = (grow_ && !fresh_) ? ex2(-rm_) : 1.f; m = grow_ ? (fresh_ ? rm_ : m + rm_) : m; cin = grow_ ? -m : cin; l *= fsc; resc = true; \
            _Pragma("unroll") for (int r = 0; r < 16; ++r) { C0[r] -= dl_; C1[r] -= dl_; } \
            if (KIND == 2) NP_SPLAT(cin); } } while (0)
    { _Pragma("unroll") for (int d0 = 0; d0 < 4; ++d0) NP_KLOAD2(0, d0);
      if (KIND == 2) NP_SPLAT(0.f); else NP_CINIT(jc);
      NSB();
      pA0 = MFMA32(kf[0], qr[0], ci16); pA1 = MFMA32(kf[1], qr[0], ci16);
      _Pragma("unroll") for (int d0 = 1; d0 < 4; ++d0) { pA0 = MFMA32(kf[2 * d0], qr[d0], pA0); pA1 = MFMA32(kf[2 * d0 + 1], qr[d0], pA1); }
      nsa_mask<KIND>(pA0, pA1, 64 * jc, t, hi);
      NP_DECIDE(pA0, pA1);
      _Pragma("unroll") for (int r = 0; r < 16; ++r) { pA0[r] = ex2(pA0[r]); pA1[r] = ex2(pA1[r]); }
      if (jn1 >= 0) { _Pragma("unroll") for (int d0 = 0; d0 < 4; ++d0) NP_KLOAD2(1, d0); }
      jc = jn1; jn1 = jn2; NP_NEXT(jn2); }
    int s = 1;
#define NP_PKW(P, i) cvtpk(P[i], P[(i) + 1])
#define NP_VFR(i) mk8(vlo[i], vhi[i])
#define NP_VRD(i) do { LAS const unsigned char* a_ = vp_ + ((i) >> 1) * 1024 + ((i) & 1) * NSA_VDH; vlo[i] = vtr(a_); vhi[i] = vtr(a_ + 512); } while (0)
#define NP_GAPA(MF, a0, a1, a2, a3, W0, W1, PW) do { MF; sacc += a0; sacc += a1; sacc += a2; sacc += a3; W0; W1; NPIN(PW); NPIN(sacc); NSB(); } while (0)
#define NP_GAPB(MF, X, i) do { MF; X[i] = ex2(X[i]); X[(i) + 1] = ex2(X[(i) + 1]); X[(i) + 2] = ex2(X[(i) + 2]); X[(i) + 3] = ex2(X[(i) + 3]); NPIN(X); NSB(); } while (0)
#define NP_KRD(GL, d0) do { if (GL) { NP_KLOAD2(sn_, d0); NSB(); } } while (0)
#define NP_STEP(C0, C1, P0, P1, LAST) do { NSB(); \
    const int sp_ = (s - 1) & 3, sn_ = (s + 1) & 3, sw_ = (s + 2) & 3; \
    if (!(LAST) && jn2 >= 0) NP_DMA(jn2, sw_);     \
    LAS const unsigned char* vp_ = NP_VIMG(sp_) + vfo; \
    NP_CINIT(jc); \
    float sacc = P0[0] + P0[1]; NSB(); \
    NP_GAPA(C0 = MFMA32(kf[0], qr[0], ci16), P0[2], P0[3], P0[4], P0[5],     pw0[0] = NP_PKW(P0, 0),  pw0[1] = NP_PKW(P0, 2),  pw0); \
    NP_GAPA(C1 = MFMA32(kf[1], qr[0], ci16), P0[6], P0[7], P0[8], P0[9],     pw0[2] = NP_PKW(P0, 4),  pw0[3] = NP_PKW(P0, 6),  pw0); \
    NP_GAPA(C0 = MFMA32(kf[2], qr[1], C0),            P0[10], P0[11], P0[12], P0[13], pw1[0] = NP_PKW(P0, 8),  pw1[1] = NP_PKW(P0, 10), pw1); \
    NP_GAPA(C1 = MFMA32(kf[3], qr[1], C1),            P0[14], P0[15], P1[0], P1[1],   pw1[2] = NP_PKW(P0, 12), pw1[3] = NP_PKW(P0, 14), pw1); \
    NP_GAPA(C0 = MFMA32(kf[4], qr[2], C0),            P1[2], P1[3], P1[4], P1[5],     pw2[0] = NP_PKW(P1, 0),  pw2[1] = NP_PKW(P1, 2),  pw2); \
    NP_GAPA(C1 = MFMA32(kf[5], qr[2], C1),            P1[6], P1[7], P1[8], P1[9],     pw2[2] = NP_PKW(P1, 4),  pw2[3] = NP_PKW(P1, 6),  pw2); \
    NP_GAPA(C0 = MFMA32(kf[6], qr[3], C0),            P1[10], P1[11], P1[12], P1[13], pw3[0] = NP_PKW(P1, 8),  pw3[1] = NP_PKW(P1, 10), pw3); \
    NP_GAPA(C1 = MFMA32(kf[7], qr[3], C1),            P1[14], P1[15], 0.f, 0.f,       pw3[2] = NP_PKW(P1, 12), pw3[3] = NP_PKW(P1, 14), pw3); \
    l += sacc; \
    NP_VRD(0); NP_VRD(1); NP_VRD(2); NP_VRD(3); NSB();     \
    if (LAST) nsa_mask<KIND>(C0, C1, 64 * jc, t, hi); \
    NP_DECIDE(C0, C1); NSB(); \
    NP_VRD(4); NSB(); NP_GAPB(o0 = MFMA32(NP_VFR(0), __builtin_bit_cast(bf16x8, pw0), o0), C0, 0); \
    NP_VRD(5); NSB(); NP_GAPB(o1 = MFMA32(NP_VFR(1), __builtin_bit_cast(bf16x8, pw0), o1), C0, 4); \
    NP_VRD(6); NSB(); NP_KRD(!(LAST), 0); NP_GAPB(o0 = MFMA32(NP_VFR(2), __builtin_bit_cast(bf16x8, pw1), o0), C0, 8); \
    NP_VRD(7); NSB(); NP_KRD(!(LAST), 1); NP_GAPB(o1 = MFMA32(NP_VFR(3), __builtin_bit_cast(bf16x8, pw1), o1), C0, 12); \
    NP_KRD(!(LAST), 2); NP_GAPB(o0 = MFMA32(NP_VFR(4), __builtin_bit_cast(bf16x8, pw2), o0), C1, 0); \
    NP_KRD(!(LAST), 3); NP_GAPB(o1 = MFMA32(NP_VFR(5), __builtin_bit_cast(bf16x8, pw2), o1), C1, 4); \
    NP_GAPB(o0 = MFMA32(NP_VFR(6), __builtin_bit_cast(bf16x8, pw3), o0), C1, 8);  NP_GAPB(o1 = MFMA32(NP_VFR(7), __builtin_bit_cast(bf16x8, pw3), o1), C1, 12); \
    NP_DMAWAIT(); \
    __syncthreads(); \
    if (resc) { _Pragma("unroll") for (int r = 0; r < 16; ++r) { o0[r] *= fsc; o1[r] *= fsc; } } \
    jc = jn1; jn1 = jn2; NP_NEXT(jn2); ++s; } while (0)
    int rem = n - 1;
    if (n & 1) { pB0 = pA0; pB1 = pA1; if (rem > 0) { NP_STEP(pA0, pA1, pB0, pB1, false); --rem; } }
    while (rem >= 3) { NP_STEP(pB0, pB1, pA0, pA1, false); NP_STEP(pA0, pA1, pB0, pB1, false); rem -= 2; }
    if (rem == 1) { NP_STEP(pB0, pB1, pA0, pA1, true); }
    if (Kn) {
        unsigned vlo_ = nlo, vhi_ = nhi; const bf16_t* ks2 = Kn + lane * 64 + w * 8; const bf16_t* vs2 = Vn + (16 * (w & 3) + (lane >> 2)) * 64 + (w >> 2) * 32 + (lane & 3) * 8;
        _Pragma("unroll") for (int i = 0; i < 3; ++i) { if (vlo_ | vhi_) { const int j2 = vlo_ ? __builtin_ctz(vlo_) : 32 + __builtin_ctz(vhi_); if (vlo_) vlo_ &= vlo_ - 1; else vhi_ &= vhi_ - 1;
            NP_DMAS(ks2, vs2, j2, n + i); } } }
    { float sacc = pB0[0] + pB0[1];
      _Pragma("unroll") for (int r = 2; r < 16; ++r) sacc += pB0[r];
      _Pragma("unroll") for (int r = 0; r < 16; ++r) sacc += pB1[r];
      l += sacc;
      pw0 = (u32x4){NP_PKW(pB0, 0), NP_PKW(pB0, 2), NP_PKW(pB0, 4), NP_PKW(pB0, 6)}; pw1 = (u32x4){NP_PKW(pB0, 8), NP_PKW(pB0, 10), NP_PKW(pB0, 12), NP_PKW(pB0, 14)};
      pw2 = (u32x4){NP_PKW(pB1, 0), NP_PKW(pB1, 2), NP_PKW(pB1, 4), NP_PKW(pB1, 6)}; pw3 = (u32x4){NP_PKW(pB1, 8), NP_PKW(pB1, 10), NP_PKW(pB1, 12), NP_PKW(pB1, 14)};
      LAS const unsigned char* vp_ = NP_VIMG((n - 1) & 3) + vfo;
      _Pragma("unroll") for (int i = 0; i < 8; ++i) NP_VRD(i);
      NSB();
      o0 = MFMA32(NP_VFR(0), __builtin_bit_cast(bf16x8, pw0), o0); o1 = MFMA32(NP_VFR(1), __builtin_bit_cast(bf16x8, pw0), o1);
      o0 = MFMA32(NP_VFR(2), __builtin_bit_cast(bf16x8, pw1), o0); o1 = MFMA32(NP_VFR(3), __builtin_bit_cast(bf16x8, pw1), o1);
      o0 = MFMA32(NP_VFR(4), __builtin_bit_cast(bf16x8, pw2), o0); o1 = MFMA32(NP_VFR(5), __builtin_bit_cast(bf16x8, pw2), o1);
      o0 = MFMA32(NP_VFR(6), __builtin_bit_cast(bf16x8, pw3), o0); o1 = MFMA32(NP_VFR(7), __builtin_bit_cast(bf16x8, pw3), o1); }
    __syncthreads();
    lsum = l; sbase = (sbase + n) & 3;
#undef NP_DMA
#undef NP_DMAS
#undef NP_DMAWAIT
#undef NP_NEXT
#undef NP_SELBIT
#undef NP_KIMG
#undef NP_VIMG
#undef NP_KLOAD2
#undef NP_SPLAT
#undef NP_CINIT
#undef NP_DECIDE
#undef NP_PKW
#undef NP_VFR
#undef NP_VRD
#undef NP_GAPA
#undef NP_GAPB
#undef NP_KRD
#undef NP_STEP
}

__device__ __forceinline__ void nsa_unit(Frame& F, int b, int g, int qb) {
    int tid = F.tid; asm volatile("" : "+v"(tid));
    const int lane = tid & 63, w = F.wave, r32 = lane & 31, hi = lane >> 5;
    const int hh = 4 * g + (w & 3), th = w >> 2, cur = qb, T0 = qb * 64, tokl = 32 * th + r32, t = T0 + tokl;
    const size_t row = (size_t)b * SEQ + t; const int bg = b * 2 + g;
    LAS unsigned char* L = F.lds;
    bf16x8 qr[4];
    { const bf16_t* qp = WSP(bf16_t, WS_NQ) + row * 512 + hh * 64 + 8 * hi;
#pragma unroll
      for (int d0 = 0; d0 < 4; ++d0) qr[d0] = *(const bf16x8*)(qp + 16 * d0); }
    const float* gp = WSP(float, WS_NGT) + row * 24 + hh * 3; const float gate_c = gp[0], gate_s = gp[1], gate_w = gp[2];
    unsigned outp0[8], outp1[8];
    const unsigned kst = (tid & 7) * NSA_KCH + (tid >> 3) * 16, vst = ((tid & 7) >> 2) * NSA_VDH + (tid >> 3) * 64 + (tid & 3) * 16;
    const unsigned kfo = hi * NSA_KCH + r32 * 16, vfo = tr_lane_off(lane);
    float m, l; f32x16 o0, o1;
    u32x4 rk, rv;
#define NSA_LOAD(Kp, Vp, tile) do { rk = *(const u32x4*)((Kp) + (size_t)(tile) * 4096 + tid * 8); rv = *(const u32x4*)((Vp) + (size_t)(tile) * 4096 + tid * 8); } while (0)
#define NSA_WRITE(buf) do { *(LAS u32x4*)(L + (buf) * NSA_BUF + kst) = rk; *(LAS u32x4*)(L + (buf) * NSA_BUF + NSA_KIMG + vst) = rv; } while (0)
#define NSA_NEXT(jv) do { jv = -1; if (ulo | uhi) { jv = ulo ? __builtin_ctz(ulo) : 32 + __builtin_ctz(uhi); if (ulo) ulo &= ulo - 1; else uhi &= uhi - 1; } } while (0)
#define NSA_RUN(Kp, Vp, MLO, MHI, ...) do { unsigned ulo = (MLO), uhi = (MHI); int j, j1, j2; u32x4 rk2, rv2; \
        NSA_NEXT(j); NSA_LOAD(Kp, Vp, j); NSA_WRITE(0); NSA_NEXT(j1); if (j1 >= 0) NSA_LOAD(Kp, Vp, j1); __syncthreads(); int buf = 0; \
        for (;;) { NSA_NEXT(j2); if (j2 >= 0) { rk2 = *(const u32x4*)((Kp) + (size_t)j2 * 4096 + tid * 8); rv2 = *(const u32x4*)((Vp) + (size_t)j2 * 4096 + tid * 8); } \
            { LAS const unsigned char* KI = L + buf * NSA_BUF; LAS const unsigned char* VI = KI + NSA_KIMG; __VA_ARGS__ } \
            if (j1 >= 0) NSA_WRITE(buf ^ 1); __syncthreads(); if (j1 < 0) break; j = j1; j1 = j2; rk = rk2; rv = rv2; buf ^= 1; } } while (0)
#define NSA_LOAD2(Kp, Vp, ja, jb) do { rk = *(const u32x4*)((Kp) + (size_t)(ja) * 4096 + tid * 8); rv = *(const u32x4*)((Vp) + (size_t)(ja) * 4096 + tid * 8); \
        if ((jb) >= 0) { rkB = *(const u32x4*)((Kp) + (size_t)(jb) * 4096 + tid * 8); rvB = *(const u32x4*)((Vp) + (size_t)(jb) * 4096 + tid * 8); } } while (0)
#define NSA_WRITE2(pb, jb) do { LAS unsigned char* P_ = L + (pb) * (2 * NSA_BUF); *(LAS u32x4*)(P_ + kst) = rk; *(LAS u32x4*)(P_ + NSA_KIMG + vst) = rv; \
        if ((jb) >= 0) { *(LAS u32x4*)(P_ + NSA_BUF + kst) = rkB; *(LAS u32x4*)(P_ + NSA_BUF + NSA_KIMG + vst) = rvB; } } while (0)
#define NSA_RUN2(Kp, Vp, MLO, MHI, ...) do { unsigned ulo = (MLO), uhi = (MHI); int ja, jb, na, nb; u32x4 rkB, rvB; \
        NSA_NEXT(ja); NSA_NEXT(jb); NSA_LOAD2(Kp, Vp, ja, jb); NSA_WRITE2(0, jb); __syncthreads(); int pbuf = 0; \
        for (;;) { NSA_NEXT(na); NSA_NEXT(nb); if (na >= 0) NSA_LOAD2(Kp, Vp, na, nb); \
            { LAS const unsigned char* KA = L + pbuf * (2 * NSA_BUF); LAS const unsigned char* VA = KA + NSA_KIMG; LAS const unsigned char* KB = KA + NSA_BUF; LAS const unsigned char* VB = KB + NSA_KIMG; __VA_ARGS__ } \
            if (na >= 0) NSA_WRITE2(pbuf ^ 1, nb); __syncthreads(); if (na < 0) break; ja = na; jb = nb; pbuf ^= 1; } } while (0)
#define NSA_LT(lv) ({ const auto rr_ = __builtin_amdgcn_permlane32_swap(__float_as_uint(lv), __float_as_uint(lv), false, false); __uint_as_float(rr_[0]) + __uint_as_float(rr_[1]); })
#define NSA_RESET() do { m = -1e30f; l = 0.f; o0 = (f32x16){0}; o1 = (f32x16){0}; } while (0)

    const bf16_t* Kc = WSP(bf16_t, WS_KCMP) + (size_t)bg * 256 * 64; const bf16_t* Vc = WSP(bf16_t, WS_VCMP) + (size_t)bg * 256 * 64;
    const int ntc = ((4 * cur + 2) >> 6) + 1; const int lim = (t >= 31) ? ((t - 31) >> 4) : -1;
    const int tmin_w = T0 + 32 * th; const int lim_min = (tmin_w >= 31) ? ((tmin_w - 31) >> 4) : -1;
    unsigned sel0, sel1, un0, un1;
    {
        LAS float* IMP = (LAS float*)(L + NSA_IMP); LAS float* FAC = (LAS float*)(L + NSA_FAC);
        float carry = 0.f; const bool need_imp = cur >= 16;
        float mt0 = 0.f, mt1 = 0.f, mt2 = 0.f, mt3 = 0.f;
        m = -1e30f; l = 0.f; o0 = (f32x16){0}; o1 = (f32x16){0};
        NSA_RUN(Kc, Vc, (1u << ntc) - 1u, 0u, {
            f32x16 p0, p1; nsa_qk(KI, qr, kfo, p0, p1);
            if (64 * j + 63 > lim_min) {
                _Pragma("unroll") for (int r = 0; r < 16; ++r) { const int k0 = 64 * j + crow(r, hi);
                    p0[r] = (k0 <= lim) ? p0[r] : -INFINITY; p1[r] = (k0 + 32 <= lim) ? p1[r] : -INFINITY; } }
            { const float rm = nsa_rowmax(p0, p1); const bool fresh = m < -1e29f; const bool grow = fresh ? (rm > -INFINITY) : (rm - m > NSA_THR);
              if (__any(grow)) { const float mn = grow ? rm : m; const float f = (grow && !fresh) ? ex2(m - mn) : 1.f; m = mn; l *= f; carry *= f;
                  _Pragma("unroll") for (int r = 0; r < 16; ++r) { o0[r] *= f; o1[r] *= f; } } }
            if (j == 0) mt0 = m; else if (j == 1) mt1 = m; else if (j == 2) mt2 = m; else mt3 = m;
            { float rs = 0.f;
              _Pragma("unroll") for (int r = 0; r < 16; ++r) { p0[r] = ex2(p0[r] - m); p1[r] = ex2(p1[r] - m); rs += p0[r] + p1[r]; }
              l += rs; }
            if (need_imp) {
                _Pragma("unroll") for (int n = 0; n < 2; ++n) {
                    float a[4], bq[4], pb[4];
                    _Pragma("unroll") for (int q4 = 0; q4 < 4; ++q4) { const float x0 = n ? p1[4 * q4] : p0[4 * q4], x1 = n ? p1[4 * q4 + 1] : p0[4 * q4 + 1], x2 = n ? p1[4 * q4 + 2] : p0[4 * q4 + 2], x3 = n ? p1[4 * q4 + 3] : p0[4 * q4 + 3];
                        a[q4] = 2.f * (x0 + x1 + x2) + x3; bq[q4] = x3; }
                    _Pragma("unroll") for (int q4 = 0; q4 < 4; ++q4) pb[q4] = __shfl_xor(bq[q4], 32);
                    _Pragma("unroll") for (int q4 = 0; q4 < 4; ++q4) { const float prevb = hi ? pb[q4] : (q4 ? pb[q4 > 0 ? q4 - 1 : 0] : carry);
                        IMP[((w & 3) * 64 + tokl) * NSA_IST + 16 * j + 8 * n + 2 * q4 + hi] = a[q4] + prevb; }
                    carry = pb[3];
                } }
            u32x4 pw[4];
            _Pragma("unroll") for (int s = 0; s < 2; ++s) {
                pw[s].x = cvtpk(p0[8 * s + 0], p0[8 * s + 1]); pw[s].y = cvtpk(p0[8 * s + 2], p0[8 * s + 3]); pw[s].z = cvtpk(p0[8 * s + 4], p0[8 * s + 5]); pw[s].w = cvtpk(p0[8 * s + 6], p0[8 * s + 7]);
                pw[2 + s].x = cvtpk(p1[8 * s + 0], p1[8 * s + 1]); pw[2 + s].y = cvtpk(p1[8 * s + 2], p1[8 * s + 3]); pw[2 + s].z = cvtpk(p1[8 * s + 4], p1[8 * s + 5]); pw[2 + s].w = cvtpk(p1[8 * s + 6], p1[8 * s + 7]); }
            _Pragma("unroll") for (int ks = 0; ks < 4; ++ks) {
                const bf16x8 v0 = mk8(vtr(VI + vfo + ks * 1024), vtr(VI + vfo + ks * 1024 + 512));
                const bf16x8 v1 = mk8(vtr(VI + vfo + NSA_VDH + ks * 1024), vtr(VI + vfo + NSA_VDH + ks * 1024 + 512));
                o0 = MFMA32(v0, __builtin_bit_cast(bf16x8, pw[ks]), o0); o1 = MFMA32(v1, __builtin_bit_cast(bf16x8, pw[ks]), o1); } });
        const float inv_c = 1.f / fmaxf(NSA_LT(l), 1e-30f); const float gs_ = gate_c * inv_c;
        _Pragma("unroll") for (int r = 0; r < 8; ++r) { outp0[r] = cvtpk(gs_ * o0[2 * r], gs_ * o0[2 * r + 1]); outp1[r] = cvtpk(gs_ * o1[2 * r], gs_ * o1[2 * r + 1]); }
        if (need_imp) {
            if (hi == 0) { f32x4 fc; fc[0] = ex2(mt0 - m) * inv_c; fc[1] = ntc > 1 ? ex2(mt1 - m) * inv_c : 0.f; fc[2] = ntc > 2 ? ex2(mt2 - m) * inv_c : 0.f; fc[3] = ntc > 3 ? ex2(mt3 - m) * inv_c : 0.f;
                *(LAS f32x4*)(FAC + ((w & 3) * 64 + tokl) * 4) = fc; }
            __syncthreads(); }
    }
    if (cur >= 16) {
        LAS float* IMP = (LAS float*)(L + NSA_IMP);
        LAS unsigned* TOT = (LAS unsigned*)(L + NSA_TOT); LAS unsigned char* SELB = L + NSA_SELB; LAS unsigned* UNI = (LAS unsigned*)(L + NSA_UNI);
        { const int tk = tid >> 3, jg = tid & 7; LAS const float* FAC = (LAS const float*)(L + NSA_FAC);
          float fq[4];
#pragma unroll
          for (int h4 = 0; h4 < 4; ++h4) fq[h4] = FAC[(h4 * 64 + tk) * 4 + (jg >> 1)];
#pragma unroll
          for (int jj = 0; jj < 8; ++jj) { const int jx = 8 * jg + jj;
              const float tot = ((IMP[tk * NSA_IST + jx] * fq[0] + IMP[(64 + tk) * NSA_IST + jx] * fq[1]) + IMP[(128 + tk) * NSA_IST + jx] * fq[2]) + IMP[(192 + tk) * NSA_IST + jx] * fq[3];
              TOT[tk * NSA_IST + jx] = (__float_as_uint(tot) & ~63u) | (unsigned)(63 - jx); }
          if (tid < 2) UNI[tid] = 0u; }
        __syncthreads();
        { const int tk = tid >> 3, jg = tid & 7; unsigned bits = 0u;
          unsigned v[8]; int rank[8];
#pragma unroll
          for (int jj = 0; jj < 8; ++jj) { v[jj] = TOT[tk * NSA_IST + 8 * jg + jj]; rank[jj] = 0; }
#pragma unroll 4
          for (int k2 = 1; k2 <= cur - 2; ++k2) { const unsigned v2 = TOT[tk * NSA_IST + k2];
#pragma unroll
              for (int jj = 0; jj < 8; ++jj) rank[jj] += (int)(v2 > v[jj]); }
#pragma unroll
          for (int jj = 0; jj < 8; ++jj) { const int jx = 8 * jg + jj;
              const bool s = (jx == 0 || jx == cur || jx == cur - 1) || (jx < cur - 1 && rank[jj] < 13);
              bits |= s ? (1u << jj) : 0u; }
          SELB[tk * 8 + jg] = (unsigned char)bits;
          atomicOr((unsigned*)&UNI[jg >> 2], bits << (8 * (jg & 3))); }
        __syncthreads();
        sel0 = *(LAS const unsigned*)(SELB + tokl * 8); sel1 = *(LAS const unsigned*)(SELB + tokl * 8 + 4);
        un0 = __builtin_amdgcn_readfirstlane(UNI[0]); un1 = __builtin_amdgcn_readfirstlane(UNI[1]);
    } else {
        sel0 = (1u << (cur + 1)) - 1u; sel1 = 0u; un0 = sel0; un1 = 0u;
    }
    LAS unsigned* ST = (LAS unsigned*)(L + NSA_STASH + w * 4096) + lane;
#pragma unroll
    for (int r = 0; r < 8; ++r) { ST[r * 64] = outp0[r]; ST[(8 + r) * 64] = outp1[r]; }
    const bf16_t* Ks = WSP(bf16_t, WS_KSL) + (size_t)bg * SEQ * 64; const bf16_t* Vs = WSP(bf16_t, WS_VSL) + (size_t)bg * SEQ * 64;
    const bf16_t* Kw = WSP(bf16_t, WS_KWN) + (size_t)bg * SEQ * 64; const bf16_t* Vw = WSP(bf16_t, WS_VWN) + (size_t)bg * SEQ * 64;
    const int jlo = cur >= 8 ? cur - 8 : 0;
    const unsigned long long wm = ((cur == 63) ? ~0ull : ((1ull << (cur + 1)) - 1ull)) & ~((1ull << jlo) - 1ull);
    int sbase = 0;
    nsa_pipe<1>(L, Ks, Vs, un0, un1, sel0, sel1, qr, t, lane, w, hi, kfo, vfo, l, o0, o1, sbase, false, Kw, Vw, (unsigned)wm, (unsigned)(wm >> 32));
    { const float sc = gate_s / fmaxf(NSA_LT(l), 1e-30f);
#pragma unroll
      for (int r = 0; r < 8; ++r) { const unsigned a = ST[r * 64], c = ST[(8 + r) * 64];
          ST[r * 64] = cvtpk(bflo(a) + sc * o0[2 * r], bfhi(a) + sc * o0[2 * r + 1]); ST[(8 + r) * 64] = cvtpk(bflo(c) + sc * o1[2 * r], bfhi(c) + sc * o1[2 * r + 1]); } }
    nsa_pipe<2>(L, Kw, Vw, (unsigned)wm, (unsigned)(wm >> 32), 0u, 0u, qr, t, lane, w, hi, kfo, vfo, l, o0, o1, sbase, true, nullptr, nullptr, 0u, 0u);
    { const float sc = gate_w / fmaxf(NSA_LT(l), 1e-30f);
      bf16_t* yo = WSP(bf16_t, WS_YCAT) + row * 1024 + 512 + hh * 64;
#pragma unroll
      for (int p2 = 0; p2 < 2; ++p2) { u32x2 av[2], cv[2];
#pragma unroll
          for (int e = 0; e < 2; ++e) { const int q4 = 2 * p2 + e;
              const unsigned a0 = ST[(2 * q4) * 64], a1 = ST[(2 * q4 + 1) * 64], c0 = ST[(8 + 2 * q4) * 64], c1 = ST[(9 + 2 * q4) * 64];
              av[e].x = cvtpk(bflo(a0) + sc * o0[4 * q4], bfhi(a0) + sc * o0[4 * q4 + 1]); av[e].y = cvtpk(bflo(a1) + sc * o0[4 * q4 + 2], bfhi(a1) + sc * o0[4 * q4 + 3]);
              cv[e].x = cvtpk(bflo(c0) + sc * o1[4 * q4], bfhi(c0) + sc * o1[4 * q4 + 1]); cv[e].y = cvtpk(bflo(c1) + sc * o1[4 * q4 + 2], bfhi(c1) + sc * o1[4 * q4 + 3]); }
          *(u32x4*)(yo + 16 * p2 + 8 * hi) = widen_pair(av[0], av[1]); *(u32x4*)(yo + 32 + 16 * p2 + 8 * hi) = widen_pair(cv[0], cv[1]); } }
#undef NSA_LOAD
#undef NSA_WRITE
#undef NSA_RUN
#undef NSA_RUN2
#undef NSA_LOAD2
#undef NSA_WRITE2
#undef NSA_LT
#undef NSA_RESET
}

__device__ __forceinline__ void s6_phase(Frame& F) {
    int tid = F.tid; asm volatile("" : "+v"(tid));
    const int lane = tid & 63, w = F.wave;
    LAS unsigned char* TILE = F.lds + w * 16384;
    LAS float* LG = (LAS float*)(F.lds + MISC_OFF + 4096) + w * (8 * 48);
    LAS int* REC_E = (LAS int*)(F.lds + MISC_OFF + 16384);
    LAS float* REC_G = (LAS float*)(F.lds + MISC_OFF + 16384 + 1024);
    LAS int* REC_P = (LAS int*)(F.lds + MISC_OFF + 16384 + 2048);
    LAS int* CNTL = (LAS int*)(F.lds + MISC_OFF + 16384 + 3072);
    LAS float* SAW = (LAS float*)(F.lds + MISC_OFF + 16384 + 3584);
    const float* x = IN_F(0); const float* wpost = IN_F(6); const float* wffn = IN_F(7); const float* mod = WSP(float, WS_MOD);
    const bf16_t* Y = WSP(bf16_t, WS_Y); bf16_t* X1B = WSP(bf16_t, WS_X1B); signed char* H2Q = (signed char*)(F.ws + WS_H2Q); float* SAv = WSP(float, WS_SA); const _Float16* RWT = WSP(_Float16, WS_RWT);
    const float* bgp = IN_F(21); const float* bep = IN_F(23);
    unsigned* cntg = (unsigned*)(F.ws + WS_CTL) + CW_CNT;
    for (int rb = F.vcu; rb < NTOK / 128; rb += F.G) {
        if (tid < 64) CNTL[tid] = 0;
        __syncthreads();
        const int rbase = rb * 128 + w * 16, b = rbase >> 12;
        f32x4 xv[4][4]; u32x4 yw[4][2];
#define S6_LOAD(g) do { _Pragma("unroll") for (int r = 0; r < 4; ++r) { const size_t ro_ = (size_t)(rbase + 4 * (g) + r) * DM; \
            _Pragma("unroll") for (int j = 0; j < 4; ++j) xv[r][j] = __builtin_nontemporal_load((const f32x4*)(x + ro_ + 4 * lane + 256 * j)); \
            _Pragma("unroll") for (int jp = 0; jp < 2; ++jp) yw[r][jp] = __builtin_nontemporal_load((const u32x4*)(Y + ro_ + 4 * (lane & ~1) + 256 * (2 * jp + (lane & 1)))); } } while (0)
#define S6_Y(r, j) ((f32x4){bflo(yr[r][j].x), bfhi(yr[r][j].x), bflo(yr[r][j].y), bfhi(yr[r][j].y)})
        S6_LOAD(0);
#pragma nounroll
        for (int g = 0; g < 4; ++g) {
            u32x2 yr[4][4];
#pragma unroll
            for (int r = 0; r < 4; ++r)
#pragma unroll
                for (int jp = 0; jp < 2; ++jp) pair_narrow(yw[r][jp], lane, yr[r][2 * jp], yr[r][2 * jp + 1]);
            int l4 = 4 * lane; asm volatile("" : "+v"(l4));
            float ss[4];
#pragma unroll
            for (int r = 0; r < 4; ++r) { float a2 = 0.f;
#pragma unroll
                for (int j = 0; j < 4; ++j) { const f32x4 y = S6_Y(r, j); a2 += y[0] * y[0] + y[1] * y[1] + y[2] * y[2] + y[3] * y[3]; }
                ss[r] = a2; }
#pragma unroll
            for (int o = 1; o < 64; o <<= 1) {
#pragma unroll
                for (int r = 0; r < 4; ++r) ss[r] += __shfl_xor(ss[r], o); }
            float s2[4] = {0.f, 0.f, 0.f, 0.f};
#pragma unroll
            for (int j = 0; j < 4; ++j) { const int k = l4 + 256 * j;
                const f32x4 wp = *(const f32x4*)(wpost + k), gm = *(const f32x4*)(mod + b * 6144 + 2048 + k); const f32x4 gw2 = gm * wp;
#pragma unroll
                for (int r = 0; r < 4; ++r) { const float r1 = rsqrtf(ss[r] * (1.f / DM) + RMS_EPS);
                    xv[r][j] = xv[r][j] + gw2 * (S6_Y(r, j) * r1);
                    s2[r] += xv[r][j][0] * xv[r][j][0] + xv[r][j][1] * xv[r][j][1] + xv[r][j][2] * xv[r][j][2] + xv[r][j][3] * xv[r][j][3]; } }
#pragma unroll
            for (int r = 0; r < 4; ++r)
#pragma unroll
                for (int jp = 0; jp < 2; ++jp) { u32x2 pa, pb; pa.x = cvtpk(xv[r][2 * jp][0], xv[r][2 * jp][1]); pa.y = cvtpk(xv[r][2 * jp][2], xv[r][2 * jp][3]);
                    pb.x = cvtpk(xv[r][2 * jp + 1][0], xv[r][2 * jp + 1][1]); pb.y = cvtpk(xv[r][2 * jp + 1][2], xv[r][2 * jp + 1][3]);
                    __builtin_nontemporal_store(pair_widen(pa, pb, lane), (u32x4*)(X1B + (size_t)(rbase + 4 * g + r) * DM + 4 * (lane & ~1) + 256 * (2 * jp + (lane & 1)))); }
#pragma unroll
            for (int o = 1; o < 64; o <<= 1) {
#pragma unroll
                for (int r = 0; r < 4; ++r) s2[r] += __shfl_xor(s2[r], o); }
#pragma unroll
            for (int j = 0; j < 4; ++j) { const int k = l4 + 256 * j;
                const f32x4 wf = *(const f32x4*)(wffn + k), sh = *(const f32x4*)(mod + b * 6144 + 3072 + k), sc = *(const f32x4*)(mod + b * 6144 + 4096 + k); const f32x4 ws = wf * (sc + 1.f);
#pragma unroll
                for (int r = 0; r < 4; ++r) { const float r2 = rsqrtf(s2[r] * (1.f / DM) + RMS_EPS);
                    const f32x4 h = xv[r][j] * r2 * ws + sh;
                    { const int rt = 4 * (g & 1) + r; const f16x4 hh = {(_Float16)h[0], (_Float16)h[1], (_Float16)h[2], (_Float16)h[3]};
                      *(LAS f16x4*)(TILE + rt * 2048 + (((lane >> 1) ^ rt) << 4) + (lane & 1) * 8 + 512 * j) = hh; }
                    xv[r][j] = h; } }
            float am[4];
#pragma unroll
            for (int r = 0; r < 4; ++r) { float a = 0.f;
#pragma unroll
                for (int j = 0; j < 4; ++j) a = fmaxf(a, fmaxf(fmaxf(fabsf(xv[r][j][0]), fabsf(xv[r][j][1])), fmaxf(fabsf(xv[r][j][2]), fabsf(xv[r][j][3]))));
                am[r] = a; }
#pragma unroll
            for (int o = 1; o < 64; o <<= 1) {
#pragma unroll
                for (int r = 0; r < 4; ++r) am[r] = fmaxf(am[r], __shfl_xor(am[r], o)); }
#pragma unroll
            for (int r = 0; r < 4; ++r) { const float inv = am[r] > 0.f ? 127.f / am[r] : 0.f; const size_t ro = (size_t)(rbase + 4 * g + r) * DM;
                if (lane == 0) { SAv[rbase + 4 * g + r] = am[r] * (1.f / 127.f); SAW[(w * 16 + 4 * g + r)] = am[r] * (1.f / 127.f); }
                u32x4 pk;
#pragma unroll
                for (int j = 0; j < 4; ++j) { const f32x4 q = xv[r][j] * inv;
                    const int q0 = (int)rintf(q[0]), q1 = (int)rintf(q[1]), q2 = (int)rintf(q[2]), q3 = (int)rintf(q[3]);
                    pk[j] = (unsigned)(q0 & 0xff) | ((unsigned)(q1 & 0xff) << 8) | ((unsigned)(q2 & 0xff) << 16) | ((unsigned)(q3 & 0xff) << 24); }
                *(u32x4*)(H2Q + ro + 256 * (lane & 3) + 16 * (lane >> 2)) = quad_transpose(pk, lane); }
            __builtin_amdgcn_sched_barrier(0);
            if (g < 3) S6_LOAD(g + 1);
            __builtin_amdgcn_sched_barrier(0);
            if (g & 1) {
                const int r16 = lane & 15, q = lane >> 4, rt = r16 & 7;
                f32x4 a0 = {0.f, 0.f, 0.f, 0.f}, a1 = a0, a2 = a0;
                LAS const unsigned char* ae = TILE + rt * 2048 + ((q ^ rt) << 4); LAS const unsigned char* ao = TILE + rt * 2048 + (((q ^ rt) ^ 4) << 4);
                const _Float16* bp = RWT + (size_t)r16 * DM + 8 * q;
#pragma unroll 4
                for (int k2 = 0; k2 < 16; ++k2) {
                    const f16x8 ah0 = *(LAS const f16x8*)(ae + 128 * k2), ah1 = *(LAS const f16x8*)(ao + 128 * k2);
                    const f16x8 b00 = *(const f16x8*)(bp + 64 * k2), b01 = *(const f16x8*)(bp + 64 * k2 + 16 * DM), b02 = *(const f16x8*)(bp + 64 * k2 + 32 * DM);
                    const f16x8 b10 = *(const f16x8*)(bp + 64 * k2 + 32), b11 = *(const f16x8*)(bp + 64 * k2 + 32 + 16 * DM), b12 = *(const f16x8*)(bp + 64 * k2 + 32 + 32 * DM);
                    a0 = __builtin_amdgcn_mfma_f32_16x16x32_f16(ah0, b00, a0, 0, 0, 0); a1 = __builtin_amdgcn_mfma_f32_16x16x32_f16(ah0, b01, a1, 0, 0, 0); a2 = __builtin_amdgcn_mfma_f32_16x16x32_f16(ah0, b02, a2, 0, 0, 0);
                    a0 = __builtin_amdgcn_mfma_f32_16x16x32_f16(ah1, b10, a0, 0, 0, 0); a1 = __builtin_amdgcn_mfma_f32_16x16x32_f16(ah1, b11, a1, 0, 0, 0); a2 = __builtin_amdgcn_mfma_f32_16x16x32_f16(ah1, b12, a2, 0, 0, 0); }
                if (q < 2) {
#pragma unroll
                    for (int i = 0; i < 4; ++i) { LG[(4 * q + i) * 48 + r16] = a0[i]; LG[(4 * q + i) * 48 + 16 + r16] = a1[i]; LG[(4 * q + i) * 48 + 32 + r16] = a2[i]; } }
                asm volatile("s_waitcnt lgkmcnt(0)" ::: "memory");
                if (lane < 8) {
                    const LAS float* lg = LG + lane * 48;
                    float gl[4]; int gi = 0; float gmx = -INFINITY;
#pragma unroll
                    for (int i = 0; i < 4; ++i) { gl[i] = lg[i] + bgp[i]; if (gl[i] > gmx) { gmx = gl[i]; gi = i; } }
                    float gs = 0.f;
#pragma unroll
                    for (int i = 0; i < 4; ++i) gs += __expf(gl[i] - gmx);
                    const float pg = 1.f / gs;
                    float el[8]; float emx = -INFINITY;
#pragma unroll
                    for (int i = 0; i < 8; ++i) { el[i] = lg[4 + gi * 8 + i] + bep[gi * 8 + i]; emx = fmaxf(emx, el[i]); }
                    int e0 = 0; float v0 = -INFINITY;
#pragma unroll
                    for (int i = 0; i < 8; ++i) if (el[i] > v0) { v0 = el[i]; e0 = i; }
                    int e1 = 0; float v1 = -INFINITY;
#pragma unroll
                    for (int i = 0; i < 8; ++i) if (i != e0 && el[i] > v1) { v1 = el[i]; e1 = i; }
                    const float p0 = __expf(v0 - emx), p1 = __expf(v1 - emx);
                    const float g0 = pg * p0 / (p0 + p1), g1 = pg * p1 / (p0 + p1);
                    const int rl = w * 16 + 8 * (g >> 1) + lane; const int E0 = gi * 8 + e0, E1 = gi * 8 + e1;
                    REC_E[rl * 2] = E0; REC_E[rl * 2 + 1] = E1; REC_G[rl * 2] = g0; REC_G[rl * 2 + 1] = g1;
                    REC_P[rl * 2] = atomicAdd((int*)&CNTL[E0], 1); REC_P[rl * 2 + 1] = atomicAdd((int*)&CNTL[E1], 1);
                }
                asm volatile("s_waitcnt lgkmcnt(0)" ::: "memory");
            }
        }
#undef S6_LOAD
#undef S6_Y
        __syncthreads();
        if (tid < 32) { const int c = CNTL[tid]; CNTL[32 + tid] = c ? (int)__hip_atomic_fetch_add(cntg + tid, (unsigned)c, __ATOMIC_RELAXED, __HIP_MEMORY_SCOPE_AGENT) : 0; }
        __syncthreads();
        if (tid < 256) { const int rl = tid >> 1, k = tid & 1; const int row = rb * 128 + rl; const int e = REC_E[tid]; const int p = CNTL[32 + e] + REC_P[tid];
            WSP(int, WS_TOKE)[row * 2 + k] = e; WSP(int, WS_TOKP)[row * 2 + k] = p; WSP(float, WS_TOKG)[row * 2 + k] = REC_G[tid];
            WSP(int, WS_LIST)[(size_t)e * 65536 + p] = row; WSP(float, WS_SAL)[(size_t)e * 65536 + p] = SAW[rl]; }
        __syncthreads();
    }
}

__device__ __forceinline__ void expert_convert(Frame& F) {
    {
        int tid = F.tid; asm volatile("" : "+v"(tid));
        LAS unsigned* AM = (LAS unsigned*)F.lds;
        const int n4 = tid & 7, kq = tid >> 3;
        for (int it = F.vcu; it < 1024; it += F.G) {
            const int e = it >> 5, sel = (it >> 4) & 1, j0 = (it & 15) * 32;
            const float* W = IN_F(sel ? 25 : 24) + (size_t)e * 1024 * 512 + (size_t)(16 * kq) * 512 + j0 + 4 * n4;
            if (tid < 32) AM[tid] = 0u;
            __syncthreads();
            f32x4 v[16]; f32x4 am = {0.f, 0.f, 0.f, 0.f};
#pragma unroll
            for (int i = 0; i < 16; ++i) { v[i] = *(const f32x4*)(W + (size_t)i * 512);
#pragma unroll
                for (int c = 0; c < 4; ++c) am[c] = fmaxf(am[c], fabsf(v[i][c])); }
#pragma unroll
            for (int o = 8; o < 64; o <<= 1) {
#pragma unroll
                for (int c = 0; c < 4; ++c) am[c] = fmaxf(am[c], __shfl_xor(am[c], o)); }
            if ((tid & 63) < 8) {
#pragma unroll
                for (int c = 0; c < 4; ++c) atomicMax((unsigned*)&AM[4 * n4 + c], __float_as_uint(am[c])); }
            __syncthreads();
            const f32x4 amax = *(LAS const f32x4*)((LAS const float*)AM + 4 * n4);
            unsigned char* dst = (unsigned char*)(F.ws + WS_W13T) + ((size_t)e * 1024 + 8 * ((j0 >> 2) + n4) + 4 * sel) * 1024 + 16 * kq;
#pragma unroll
            for (int c = 0; c < 4; ++c) { const float inv = amax[c] > 0.f ? 127.f / amax[c] : 0.f; u32x4 o;
#pragma unroll
                for (int d = 0; d < 4; ++d) {
                    const int q0 = (int)rintf(v[4 * d][c] * inv), q1 = (int)rintf(v[4 * d + 1][c] * inv), q2 = (int)rintf(v[4 * d + 2][c] * inv), q3 = (int)rintf(v[4 * d + 3][c] * inv);
                    o[d] = (unsigned)(q0 & 0xff) | ((unsigned)(q1 & 0xff) << 8) | ((unsigned)(q2 & 0xff) << 16) | ((unsigned)(q3 & 0xff) << 24); }
                *(u32x4*)(dst + (size_t)c * 1024) = o;
                if (kq == 0) WSP(float, WS_SB13)[e * 1024 + 8 * ((j0 >> 2) + n4) + 4 * sel + c] = amax[c] * (1.f / 127.f); }
            __syncthreads();
        }
    }
}
__device__ __forceinline__ void w2_convert(Frame& F, int rk, int nsh) {
    LAS float* scr = (LAS float*)(F.lds + F.wave * 8448);
    const int gw = rk * NWAVES + F.wave, NGW = nsh * NWAVES;
    for (int it = gw; it < 32 * 256; it += NGW) {
        const int e = it >> 8, r = it & 255;
        transpose_item(IN_F(26) + (size_t)e * 512 * 1024, 1024, WSP(bf16_t, WS_W2T) + (size_t)e * 1024 * 512, 512, scr, (r / 32) * 64, (r % 32) * 32, F.lane, RmId{0});
    }
    __syncthreads();
}

__device__ __forceinline__ void moe_tables(Frame& F, LAS int* tstart, LAS int* cnt) {
    if (F.tid < 64) {
        const int lane = F.tid; const unsigned* cg = (const unsigned*)(F.ws + WS_CTL) + CW_CNT;
        const int c = lane < 32 ? (int)__hip_atomic_load(cg + lane, __ATOMIC_RELAXED, __HIP_MEMORY_SCOPE_AGENT) : 0;
        const int tl = (c + 255) >> 8; int incl = tl;
#pragma unroll
        for (int o = 1; o < 32; o <<= 1) { const int x = __shfl_up(incl, o); if (lane >= o) incl += x; }
        if (lane < 32) { cnt[lane] = c; tstart[lane] = incl - tl; LAS unsigned char* et = (LAS unsigned char*)(tstart + 96);
            for (int t2 = incl - tl; t2 < incl; ++t2) et[t2] = (unsigned char)lane; }
        if (lane == 31) tstart[32] = incl; }
    __syncthreads();
}

__device__ __forceinline__ void s10_phase(Frame& F, LAS int* tstart) {
    const int gw = F.vcu * NWAVES + F.wave, NGW = F.G * NWAVES, lane = F.lane;
    const float* wpost = IN_F(8); const float* mod = WSP(float, WS_MOD); const bf16_t* YB = WSP(bf16_t, WS_YB); const bf16_t* X1B = WSP(bf16_t, WS_X1B);
    int ne0[4], ne1[4], np0[4], np1[4]; float ng0[4], ng1[4];
#define S10_TAB(rw) do { _Pragma("unroll") for (int r = 0; r < 4; ++r) { const int row_ = (rw) + r; \
        ne0[r] = WSP(int, WS_TOKE)[row_ * 2]; ne1[r] = WSP(int, WS_TOKE)[row_ * 2 + 1]; np0[r] = WSP(int, WS_TOKP)[row_ * 2]; np1[r] = WSP(int, WS_TOKP)[row_ * 2 + 1]; \
        ng0[r] = WSP(float, WS_TOKG)[row_ * 2]; ng1[r] = WSP(float, WS_TOKG)[row_ * 2 + 1]; } } while (0)
    if (gw * 4 < NTOK) S10_TAB(gw * 4);
    for (int row0 = gw * 4; row0 < NTOK; row0 += NGW * 4) {
        const int b = row0 >> 12;
        size_t r0[4], r1[4]; float g0[4], g1[4];
#pragma unroll
        for (int r = 0; r < 4; ++r) { r0[r] = (size_t)tstart[ne0[r]] * 256 + np0[r]; r1[r] = (size_t)tstart[ne1[r]] * 256 + np1[r]; g0[r] = ng0[r]; g1[r] = ng1[r]; }
        if (row0 + NGW * 4 < NTOK) S10_TAB(row0 + NGW * 4);
        f32x4 yv[4][4]; float ss[4];
        u32x4 xw[4][2];
#pragma unroll
        for (int r = 0; r < 4; ++r) { float a2 = 0.f;
            u32x4 wa[2], wc[2];
#pragma unroll
            for (int jp = 0; jp < 2; ++jp) { const int ko = 4 * (lane & ~1) + 256 * (2 * jp + (lane & 1));
                wa[jp] = __builtin_nontemporal_load((const u32x4*)(YB + r0[r] * DM + ko)); wc[jp] = __builtin_nontemporal_load((const u32x4*)(YB + r1[r] * DM + ko));
                xw[r][jp] = __builtin_nontemporal_load((const u32x4*)(X1B + (size_t)(row0 + r) * DM + ko)); }
#pragma unroll
            for (int jp = 0; jp < 2; ++jp) { u32x2 a[2], c[2]; pair_narrow(wa[jp], lane, a[0], a[1]); pair_narrow(wc[jp], lane, c[0], c[1]);
#pragma unroll
                for (int e = 0; e < 2; ++e) { const int j = 2 * jp + e;
                    yv[r][j] = (f32x4){bflo(a[e].x), bfhi(a[e].x), bflo(a[e].y), bfhi(a[e].y)} * g0[r] + (f32x4){bflo(c[e].x), bfhi(c[e].x), bflo(c[e].y), bfhi(c[e].y)} * g1[r];
                    a2 += yv[r][j][0] * yv[r][j][0] + yv[r][j][1] * yv[r][j][1] + yv[r][j][2] * yv[r][j][2] + yv[r][j][3] * yv[r][j][3]; } }
            ss[r] = a2; }
#pragma unroll
        for (int o = 1; o < 64; o <<= 1) {
#pragma unroll
            for (int r = 0; r < 4; ++r) ss[r] += __shfl_xor(ss[r], o); }
#pragma unroll
        for (int jp = 0; jp < 2; ++jp) {
#pragma unroll
            for (int r = 0; r < 4; ++r) { const float rr = rsqrtf(ss[r] * (1.f / DM) + RMS_EPS);
                u32x2 xb[2]; pair_narrow(xw[r][jp], lane, xb[0], xb[1]);
#pragma unroll
                for (int e = 0; e < 2; ++e) { const int j = 2 * jp + e, k = 4 * lane + 256 * j;
                    const f32x4 wp = *(const f32x4*)(wpost + k), gf = *(const f32x4*)(mod + b * 6144 + 5120 + k); const f32x4 gw2 = gf * wp;
                    const f32x4 x1 = (f32x4){bflo(xb[e].x), bfhi(xb[e].x), bflo(xb[e].y), bfhi(xb[e].y)};
                    __builtin_nontemporal_store(x1 + gw2 * (yv[r][j] * rr), (f32x4*)(F.out + (size_t)(row0 + r) * DM + k)); } } }
    }
}

#undef S10_TAB
#ifndef DBG_STOP
#define DBG_STOP -1
#endif
#if DBG_STOP >= 0
struct DbgBuf { size_t off, n; int f32, ph; };
__device__ __forceinline__ void dbg_phase(Frame& F, const XcdBarrier& bar) {
    const DbgBuf bufs[] = {
        {WS_MOD, 8 * 6144, 1, 0}, {WS_COS, (size_t)NTOK * 32, 1, 0}, {WS_SIN, (size_t)NTOK * 32, 1, 0}, {WS_WINT, (size_t)INWP * 1024, 0, 0}, {WS_WOUTT, 1024 * 1024, 0, 0},
        {WS_CW1K, 128 * 2048, 0, 0}, {WS_CW2K, 64 * 128, 0, 0}, {WS_RWT, 48 * 1024, 0, 0}, {WS_C1B, 256, 1, 0},
        {WS_H1, (size_t)NTOK * 1024, 0, 1},
        {WS_MQ, (size_t)NTOK * 2048, 0, 2}, {WS_NQ, (size_t)NTOK * 512, 0, 2}, {WS_KC, (size_t)NTOK * 128 * 6, 0, 2}, {WS_GI, 2 * 8 * 4 * 4096, 1, 2}, {WS_NGT, (size_t)NTOK * 24, 1, 2},
        {WS_KVC, (size_t)2048 * 16384, 0, 3}, {WS_NC, 2048 * 128, 1, 3}, {WS_GSUM, 4096, 1, 3}, {WS_KCMP, 2 * 16 * 256 * 64, 0, 3},
        {WS_CPREV, (size_t)2048 * 16384, 0, 4}, {WS_NPREV, 2048 * 128, 1, 4}, {WS_MPREV, 2048, 1, 4},
        {WS_YCAT, (size_t)NTOK * 1024, 0, 5}, {WS_W13T, (size_t)32 * 1024 * 1024, 0, 5}, {WS_W2T, (size_t)32 * 1024 * 512, 0, 5},
        {WS_Y, (size_t)NTOK * 1024, 0, 6}, {WS_H2, (size_t)NTOK * 1024, 0, 7}, {WS_TOKG, (size_t)NTOK * 2, 1, 7},
        {WS_HB, (size_t)65536 * 512, 0, 8}, {WS_YB, (size_t)65536 * 1024, 0, 9} };
    constexpr int NBUF = sizeof(bufs) / sizeof(bufs[0]);
    unsigned* flag = (unsigned*)(F.ws + WS_CTL) + CW_DBG;
    const size_t gt = (size_t)blockIdx.x * NTHR + F.tid, NG = (size_t)F.G * NTHR;
    for (int i = 0; i < NBUF; ++i) {
        if (bufs[i].ph > DBG_STOP) continue;
        if ((bufs[i].off == WS_H1 && DBG_STOP >= 3) || (bufs[i].off == WS_WINT && DBG_STOP >= 4) || (bufs[i].off == WS_KVC && DBG_STOP >= 5) || (bufs[i].off == WS_NQ && DBG_STOP >= 5) || (bufs[i].off == WS_KC && DBG_STOP >= 9) ||
            (bufs[i].off == WS_MQ && DBG_STOP >= 6) || (bufs[i].off == WS_CPREV && DBG_STOP >= 8) || (bufs[i].off == WS_Y && DBG_STOP >= 9) || (bufs[i].off == WS_H2 && DBG_STOP >= 9) || (bufs[i].off == WS_W13T && DBG_STOP < 5)) continue;
        bool bad = false;
        if (bufs[i].f32) { const unsigned* p = (const unsigned*)(F.ws + bufs[i].off); for (size_t k = gt; k < bufs[i].n; k += NG) bad |= ((p[k] & 0x7f800000u) == 0x7f800000u); }
        else { const unsigned* p = (const unsigned*)(F.ws + bufs[i].off); for (size_t k = gt; k < bufs[i].n / 2; k += NG) { const unsigned v = p[k]; bad |= ((v & 0x7f80u) == 0x7f80u) || ((v & 0x7f800000u) == 0x7f800000u); } }
        if (bufs[i].off == WS_YCAT) { bool bm = false, bn = false; const unsigned* p = (const unsigned*)(F.ws + WS_YCAT);
            for (size_t k = gt; k < bufs[i].n / 2; k += NG) { const unsigned v = p[k]; const bool b2 = ((v & 0x7f80u) == 0x7f80u) || ((v & 0x7f800000u) == 0x7f800000u); if ((k & 511) < 256) bm |= b2; else bn |= b2; }
            if (__any(bm) && F.lane == 0) atomicMin(flag, 23u); if (__any(bn) && F.lane == 0) atomicMin(flag, 33u); continue; }
        if (__any(bad) && F.lane == 0) atomicMin(flag, (unsigned)(i + 1));
    }
    if (DBG_STOP >= 7) { bool bad = false; const unsigned* p = (const unsigned*)F.out; for (size_t k = gt; k < (size_t)NTOK * DM; k += NG) bad |= ((p[k] & 0x7f800000u) == 0x7f800000u); if (__any(bad) && F.lane == 0) atomicMin(flag, 40u); }
    xcd_barrier(bar);
    const unsigned id = __hip_atomic_load(flag, __ATOMIC_RELAXED, __HIP_MEMORY_SCOPE_AGENT);
    const float sc = (id >= 1000u) ? 1.f : 1.f + (float)id;
    const float* x = IN_F(0);
    for (size_t k = gt; k < (size_t)NTOK * DM; k += NG) F.out[k] = x[k] * sc;
}
#endif


#if DBG_STOP >= 0
__device__ __forceinline__ unsigned dbg_hash(unsigned x) { x ^= x >> 16; x *= 0x7feb352du; x ^= x >> 15; x *= 0x846ca68bu; x ^= x >> 16; return x; }
__device__ __forceinline__ float dbg_bfr(float f) { return bf2f(f2bf(f)); }
__device__ float dbg_z(Frame& F, int row, int c) { const signed char* h = (const signed char*)(F.ws + WS_H1) + (size_t)row * 1024; const float* w = IN_F(9); float am = 0.f;
    for (int k = 0; k < 1024; ++k) am = fmaxf(am, fabsf(w[(size_t)k * INW + c]));
    const float inv = am > 0.f ? 127.f / am : 0.f; float s = 0.f; for (int k = 0; k < 1024; ++k) s += (float)h[k] * rintf(w[(size_t)k * INW + c] * inv);
    return s * WSP(float, WS_SA1)[row] * (am * (1.f / 127.f)); }
__device__ __forceinline__ bool dbg_close(float a, float b) { return fabsf(a - b) <= 0.02f * fabsf(b) + 0.02f; }
__device__ void dbg_check_p1(Frame& F, unsigned* cnt) {
    const int gt = blockIdx.x * NTHR + F.tid; if (gt >= 8192) return;
    const int row = dbg_hash(gt * 2 + 1) % NTOK; int c = dbg_hash(gt * 2 + 2) % INW; if (gt < 64) c = 2048 + (gt & 7); if (gt >= 64 && gt < 256) c = 3336 + (gt % 24);
    const int b = row >> 12, sq = row & 4095; const float* COS = WSP(float, WS_COS); const float* SIN = WSP(float, WS_SIN);
    float ref, got;
    if (c < 2048) { ref = dbg_z(F, row, c); got = bf2f(WSP(bf16_t, c < 512 ? WS_MQ : c < 1024 ? WS_MK : c < 1536 ? WS_MV : WS_MO)[(size_t)row * 512 + (c & 511)]); }
    else if (c < 2052) { ref = dbg_z(F, row, c) + IN_F(11)[c - 2048]; got = WSP(float, WS_GI)[(size_t)(b * 4 + c - 2048) * SEQ + sq]; }
    else if (c < 2056) { ref = logsigmoid_f(dbg_z(F, row, c) + IN_F(11)[4 + c - 2052]); got = WSP(float, WS_GF)[(size_t)(b * 4 + c - 2052) * SEQ + sq]; }
    else if (c >= 3336) { ref = sigmoid_f(dbg_z(F, row, c)); got = WSP(float, WS_NGT)[(size_t)row * 24 + c - 3336]; }
    else {
        int base, x; size_t ws_off; bool rope, isq = false;
        if (c < 2568) { base = 2056; x = c - base; rope = true; isq = true; ws_off = WS_NQ; }
        else if (c < 2696) { base = 2568; x = c - base; rope = true; ws_off = WS_KC; }
        else if (c < 2824) { base = 2696; x = c - base; rope = false; ws_off = WS_VC; }
        else if (c < 2952) { base = 2824; x = c - base; rope = true; ws_off = WS_KSL; }
        else if (c < 3080) { base = 2952; x = c - base; rope = false; ws_off = WS_VSL; }
        else if (c < 3208) { base = 3080; x = c - base; rope = true; ws_off = WS_KWN; }
        else { base = 3208; x = c - base; rope = false; ws_off = WS_VWN; }
        const int hd = x >> 6, d = x & 63;
        if (rope) { const float z0 = dbg_z(F, row, c), z1 = dbg_z(F, row, base + hd * 64 + (d ^ 32)); const float cs = COS[(size_t)row * 32 + (d & 31)], sn = SIN[(size_t)row * 32 + (d & 31)];
            ref = d < 32 ? z0 * cs - z1 * sn : z0 * cs + z1 * sn; if (isq) ref *= QSCALE; }
        else ref = dbg_z(F, row, c);
        got = isq ? bf2f(WSP(bf16_t, ws_off)[(size_t)row * 512 + hd * 64 + d]) : bf2f(WSP(bf16_t, ws_off)[((size_t)(b * 2 + hd) * SEQ + sq) * 64 + d]);
    }
    if (!dbg_close(got, ref)) atomicAdd(cnt, 1u);
}
#endif


#if DBG_STOP >= 0
__device__ void dbg_check_nsa(Frame& F, unsigned* cnt) {
    const int lane = F.lane, gw = blockIdx.x * NWAVES + F.wave;
    LAS float* P = (LAS float*)(F.lds + F.wave * 2048);
    const unsigned hsh = dbg_hash(gw * 7 + 3);
    const int b = hsh & 7, hh = (hsh >> 3) & 7, g = hh >> 2;
    int t; { const int cls = gw & 7; const unsigned r = dbg_hash(gw * 13 + 5);
        t = cls == 0 ? (int)(r % 31) : cls == 1 ? 31 + (int)(r % 33) : cls == 2 ? 64 + (int)(r % 960) : cls == 3 ? 1024 + (int)(r % 64) : cls == 4 ? 4032 + (int)(r % 64) : 1024 + (int)(r % 3072); }
    const size_t row = (size_t)b * SEQ + t; const int bg = b * 2 + g, cur = t >> 6;
    const bf16_t* Kc = WSP(bf16_t, WS_KCMP) + (size_t)bg * 256 * 64; const bf16_t* Vc = WSP(bf16_t, WS_VCMP) + (size_t)bg * 256 * 64;
    const int lim = t >= 31 ? (t - 31) >> 4 : -1;
    float imp = 0.f, oc = 0.f;
    for (int hd = 0; hd < 4; ++hd) {
        const bf16_t* q = WSP(bf16_t, WS_NQ) + row * 512 + (4 * g + hd) * 64;
        float sc[4]; float mx = -INFINITY;
        for (int k = 0; k < 4; ++k) { const int i = lane + 64 * k; float s = 0.f; for (int d = 0; d < 64; ++d) s += bf2f(q[d]) * bf2f(Kc[(size_t)i * 64 + d]); sc[k] = (i <= lim) ? s : -INFINITY; mx = fmaxf(mx, sc[k]); }
        mx = wave_max(mx); const float mref = (mx == -INFINITY) ? 0.f : mx; float l = 0.f;
        for (int k = 0; k < 4; ++k) { sc[k] = ex2(sc[k] - mref); l += sc[k]; }
        l = wave_sum(l); const float il = 1.f / fmaxf(l, 1e-30f);
        for (int k = 0; k < 4; ++k) P[lane + 64 * k] = sc[k] * il;
        asm volatile("s_waitcnt lgkmcnt(0)" ::: "memory");
        { const int j = lane; float a = 0.f; for (int x = 0; x < 3; ++x) a += 2.f * P[4 * j + x]; a += P[4 * j + 3]; if (j > 0) a += P[4 * j - 1]; imp += a; }
        if (4 * g + hd == hh) { for (int i = 0; i < 255; ++i) oc += P[i] * bf2f(Vc[(size_t)i * 64 + lane]); }
        asm volatile("s_waitcnt lgkmcnt(0)" ::: "memory");
    }
    float score = imp; { const int j = lane; if (j == 0 || j == cur || j == cur - 1) score = INFINITY; else if (64 * j > t) score = -INFINITY; }
    int rank = 0; for (int j2 = 0; j2 < 64; ++j2) { const float s2 = __shfl(score, j2); rank += (s2 > score || (s2 == score && j2 < lane)) ? 1 : 0; }
    const unsigned long long selm = __ballot(rank < 16);
    const bf16_t* q = WSP(bf16_t, WS_NQ) + row * 512 + hh * 64;
    float os = 0.f, ow = 0.f;
    for (int br = 0; br < 2; ++br) {
        const bf16_t* K = WSP(bf16_t, br ? WS_KWN : WS_KSL) + (size_t)bg * SEQ * 64; const bf16_t* V = WSP(bf16_t, br ? WS_VWN : WS_VSL) + (size_t)bg * SEQ * 64;
        float m = -INFINITY, l = 0.f, o = 0.f;
        for (int j = 0; j < 64; ++j) {
            if (br == 0 && !((selm >> j) & 1ull)) continue;
            const int kp = 64 * j + lane; bool valid = kp <= t; if (br == 1) valid = valid && kp > t - 512;
            if (!__any(valid)) continue;
            float s = 0.f; for (int d = 0; d < 64; ++d) s += bf2f(q[d]) * bf2f(K[(size_t)kp * 64 + d]);
            s = valid ? s : -INFINITY;
            const float mn = fmaxf(m, wave_max(s)); const float alpha = (m == -INFINITY) ? 0.f : ex2(m - mn); const float pp = ex2(s - mn);
            l = l * alpha + wave_sum(pp); o *= alpha;
            for (int x = 0; x < 64; ++x) o += __shfl(pp, x) * bf2f(V[(size_t)(64 * j + x) * 64 + lane]);
            m = mn;
        }
        const float r = o / fmaxf(l, 1e-30f); if (br) ow = r; else os = r;
    }
    const float* gp = WSP(float, WS_NGT) + row * 24 + hh * 3;
    const float ref = gp[0] * oc + gp[1] * os + gp[2] * ow;
    const float got = bf2f(WSP(bf16_t, WS_YCAT)[row * 1024 + 512 + hh * 64 + lane]);
    const float sq = wave_sum(ref * ref); const float tol = 0.03f * fabsf(ref) + 0.03f * sqrtf(sq * (1.f / 64.f)) + 1e-4f;
    const bool bad = !(fabsf(got - ref) <= tol);
    if (__any(bad) && lane == 0) atomicAdd(cnt, 1u);
}
#endif


#if DBG_STOP >= 0
__device__ void dbg_check_mlstm(Frame& F, unsigned* cnt) {
    const int lane = F.lane, gw = blockIdx.x * NWAVES + F.wave;
    const unsigned hsh = dbg_hash(gw * 11 + 1);
    const int b = hsh & 7, h = (hsh >> 3) & 3;
    int t; { const int cls = gw & 7; const unsigned r = dbg_hash(gw * 17 + 9);
        t = cls == 0 ? (int)(r % 4) : cls == 1 ? 60 + (int)(r % 8) : cls == 2 ? 64 * (1 + (int)(r % 60)) + (int)((r >> 8) % 3) : cls == 3 ? 64 * (1 + (int)(r % 60)) + 63 : cls == 4 ? 4000 + (int)(r % 96) : (int)(r % 4096); }
    const int bh = b * 4 + h; const float* GI = WSP(float, WS_GI) + (size_t)bh * SEQ; const float* GF = WSP(float, WS_GF) + (size_t)bh * SEQ;
    const bf16_t* MQ = WSP(bf16_t, WS_MQ); const bf16_t* MK = WSP(bf16_t, WS_MK); const bf16_t* MV = WSP(bf16_t, WS_MV); const float* cw = IN_F(10);
    float carry = 0.f, M = 0.f, Bt = 0.f;
    for (int s0 = 0; s0 <= t; s0 += 64) { const int s = s0 + lane; float lf = (s <= t) ? GF[s] : 0.f;
        float bs = lf;
        for (int o = 1; o < 64; o <<= 1) { const float x = __shfl_up(bs, o); if (lane >= o) bs += x; }
        bs += carry; const float u = (s <= t) ? GI[s] - bs : -INFINITY; M = fmaxf(M, wave_max(u));
        if (s0 + 63 >= t) Bt = __shfl(bs, t - s0);
        carry = __shfl(bs, 63); }
    float q0 = 0.f, q1 = 0.f;
    for (int j = 0; j < 4; ++j) { const int ss = t - 3 + j; if (ss >= 0) { const bf16_t* rp = MQ + ((size_t)b * SEQ + ss) * 512 + h * 128;
        q0 += bf2f(rp[lane]) * cw[j * 1024 + h * 128 + lane]; q1 += bf2f(rp[64 + lane]) * cw[j * 1024 + h * 128 + 64 + lane]; } }
    q0 = dbg_bfr(silu_f(q0)); q1 = dbg_bfr(silu_f(q1));
    LAS float* QS = (LAS float*)(F.lds + F.wave * 2048); QS[lane] = q0; QS[64 + lane] = q1;
    asm volatile("s_waitcnt lgkmcnt(0)" ::: "memory");
    float n0 = 0.f, n1 = 0.f, den = 0.f; carry = 0.f;
    for (int s0 = 0; s0 <= t; s0 += 64) { const int s = s0 + lane; const bool act = s <= t; float lf = act ? GF[s] : 0.f;
        float bs = lf;
        for (int o = 1; o < 64; o <<= 1) { const float x = __shfl_up(bs, o); if (lane >= o) bs += x; }
        bs += carry; carry = __shfl(bs, 63);
        float c = 0.f;
        if (act) { float qk = 0.f;
            for (int ch = 0; ch < 128; ++ch) { float kc = 0.f;
                for (int j = 0; j < 4; ++j) { const int ss = s - 3 + j; if (ss >= 0) kc += bf2f(MK[((size_t)b * SEQ + ss) * 512 + h * 128 + ch]) * cw[j * 1024 + 512 + h * 128 + ch]; }
                qk += QS[ch] * dbg_bfr(silu_f(kc) * 0.08838834764831845f); }
            c = __expf(GI[s] - bs - M) * qk; }
        den += c;
        for (int x = 0; x < 64; ++x) { const float cx = __shfl(c, x); if (s0 + x <= t) { const bf16_t* vp = MV + ((size_t)b * SEQ + s0 + x) * 512 + h * 128; n0 += cx * bf2f(vp[lane]); n1 += cx * bf2f(vp[64 + lane]); } } }
    den = wave_sum(den);
    const float hd = fmaxf(fabsf(den), __expf(-(Bt + M)));
    const float h0 = n0 / hd, h1 = n1 / hd;
    const float rn = rsqrtf(wave_sum(h0 * h0 + h1 * h1) * (1.f / 128.f) + RMS_EPS);
    const size_t row = (size_t)b * SEQ + t; const bf16_t* mo = WSP(bf16_t, WS_MO) + row * 512 + h * 128; const float* hn = IN_F(12) + h * 128;
    const float r0 = h0 * rn * hn[lane] * sigmoid_f(bf2f(mo[lane])), r1 = h1 * rn * hn[64 + lane] * sigmoid_f(bf2f(mo[64 + lane]));
    const float g0 = bf2f(WSP(bf16_t, WS_YCAT)[row * 1024 + h * 128 + lane]), g1 = bf2f(WSP(bf16_t, WS_YCAT)[row * 1024 + h * 128 + 64 + lane]);
    const float rms = sqrtf(wave_sum(r0 * r0 + r1 * r1) * (1.f / 128.f));
    const bool bad = !(fabsf(g0 - r0) <= 0.04f * fabsf(r0) + 0.04f * rms + 1e-4f) || !(fabsf(g1 - r1) <= 0.04f * fabsf(r1) + 0.04f * rms + 1e-4f);
    if (__any(bad) && lane == 0) atomicAdd(cnt, 1u);
}
#endif


#if DBG_STOP >= 0
__device__ void dbg_check_cmp(Frame& F, unsigned* cnt) {
    const int lane = F.lane, gw = blockIdx.x * NWAVES + F.wave;
    const unsigned hsh = dbg_hash(gw * 5 + 2);
    const int kv = hsh & 1, bg = (hsh >> 1) & 15; int i = (hsh >> 5) % 255; if ((gw & 15) == 0) i = 254; if ((gw & 15) == 1) i = 0;
    const bf16_t* X = WSP(bf16_t, kv ? WS_VC : WS_KC) + (size_t)bg * SEQ * 64 + (size_t)i * 1024;
    const float* pe = IN_F(kv ? 16 : 13); const float* w1 = IN_F(kv ? 17 : 14); const float* w2 = IN_F(kv ? 18 : 15);
    float h0 = 0.f, h1 = 0.f;
    for (int k = 0; k < 2048; ++k) { const float xv = bf2f(X[k]) + pe[k]; h0 += xv * w1[(size_t)k * 128 + lane]; h1 += xv * w1[(size_t)k * 128 + 64 + lane]; }
    LAS float* H = (LAS float*)(F.lds + F.wave * 2048); H[lane] = silu_f(h0); H[64 + lane] = silu_f(h1);
    asm volatile("s_waitcnt lgkmcnt(0)" ::: "memory");
    float o = 0.f; for (int n = 0; n < 128; ++n) o += H[n] * w2[n * 64 + lane];
    const float got = bf2f(WSP(bf16_t, kv ? WS_VCMP : WS_KCMP)[((size_t)bg * 256 + i) * 64 + lane]);
    const float rms = sqrtf(wave_sum(o * o) * (1.f / 64.f));
    const bool bad = !(fabsf(got - o) <= 0.03f * fabsf(o) + 0.03f * rms + 1e-4f);
    if (__any(bad) && lane == 0) atomicAdd(cnt, 1u);
}
#endif

__device__ __forceinline__ bool phase_tid(Frame& F) { asm volatile("" : "+v"(F.tid)); F.lane = F.tid & 63; return true; }
constexpr int NPHASE = 11;
__global__ void __launch_bounds__(NTHR, 2) mega_fwd(Args args) {
    extern __shared__ __attribute__((aligned(16))) unsigned char lds_raw[];
    Frame F;
    F.lds = (LAS unsigned char*)lds_raw; F.in = args.in; F.out = args.out; F.ws = args.ws;
    F.tid = threadIdx.x; F.lane = F.tid & 63; F.wave = __builtin_amdgcn_readfirstlane(F.tid >> 6);
    F.G = gridDim.x; { const int bx = blockIdx.x; F.vcu = (F.G % 8 == 0) ? (bx % 8) * (F.G / 8) + bx / 8 : bx; }
    volatile LAS unsigned* MISC = (volatile LAS unsigned*)(F.lds + MISC_OFF);
    for (int u = F.tid; u < (LDS_BYTES - MISC_OFF) / 4; u += NTHR) ((LAS unsigned*)(F.lds + MISC_OFF))[u] = 0u;
    __syncthreads();
    unsigned* ctl = (unsigned*)(F.ws + WS_CTL);
    XcdBarrier bar; bar.bar = ctl + CW_BAR; bar.x = 0; bar.st = nullptr;
    const int lo = args.ph_lo, hi = args.ph_hi;
    if (hi - lo > 1) bar = xcd_barrier_post(ctl + CW_BAR, MISC + 8);
#ifndef PHASE_MASK
#define PHASE_MASK 0xFFFF
#endif
#define IN(k) (((PHASE_MASK >> (k)) & 1) && lo <= (k) && (k) < hi && (DBG_STOP < 0 || (k) <= DBG_STOP))
#define SEAM(k) do { if (IN(k) && IN((k) + 1)) xcd_barrier(bar); } while (0)
    LAS int* TST = (LAS int*)(F.lds + MISC_OFF + 256);
    LAS int* CNT = TST + 40;

#define PHASE_TID() if (phase_tid(F))
    if (IN(0)) PHASE_TID() _Pragma("nounroll") for (int rep = 0; rep <= ((REP_MASK >> 0) & 1); ++rep) { p0_phase(F); } SEAM(0);
    if (IN(1)) PHASE_TID() _Pragma("nounroll") for (int rep = 0; rep <= ((REP_MASK >> 1) & 1); ++rep) { p1a_phase(F); } SEAM(1);
    if (IN(2)) PHASE_TID() _Pragma("nounroll") for (int rep = 0; rep <= ((REP_MASK >> 2) & 1); ++rep) {
        pg8::DenseOrder S; S.init(NTOK, INWP, DM / 2, F.G, (int)blockIdx.x);
        EpiIn E{F.ws, IN_F(11), F.lds};
        pg8::gemm_phase<true>(F.lds, WSP(bf16_t, WS_H1), WSP(bf16_t, WS_WINT), DM / 2, S, E);
    } SEAM(2);
    if (IN(3)) PHASE_TID() _Pragma("nounroll") for (int rep = 0; rep <= ((REP_MASK >> 3) & 1); ++rep) {
        REPS(0) mlstm_a_phase(F);
        REPS(1) for (int j = F.vcu; j < 256; j += F.G) compress_job(F, j);
    } SEAM(3);
    if (IN(4)) PHASE_TID() _Pragma("nounroll") for (int rep = 0; rep <= ((REP_MASK >> 4) & 1); ++rep) {
        REPS(2) for (int j = F.vcu; j < 256; j += F.G) mlstm_scan_job(F, j);
        REPS(3) for (int u = F.vcu; u < 512; u += F.G) {
            const int bg = u >> 5, q = u & 31;
            _Pragma("nounroll") for (int hf = 0; hf < 2; ++hf) nsa_unit(F, bg >> 1, bg & 1, hf ? q : 63 - q);
        }
    } SEAM(4);
    if (IN(5)) PHASE_TID() _Pragma("nounroll") for (int rep = 0; rep <= ((REP_MASK >> 5) & 1); ++rep) {
        REPS(4) mlstm_c_phase(F);
        REPS(5) expert_convert(F);
    } SEAM(5);
    if (IN(6)) PHASE_TID() _Pragma("nounroll") for (int rep = 0; rep <= ((REP_MASK >> 6) & 1); ++rep) {
        pg8::DenseOrder S; S.init(NTOK, DM, DM, F.G, (int)blockIdx.x);
        EpiBf16 E{WSP(bf16_t, WS_Y), DM};
        pg8::gemm_phase<false>(F.lds, WSP(bf16_t, WS_YCAT), WSP(bf16_t, WS_WOUTT), DM, S, E);
    } SEAM(6);
    if (IN(7)) PHASE_TID() { s6_phase(F); } SEAM(7);
    if (IN(8)) PHASE_TID() _Pragma("nounroll") for (int rep = 0; rep <= ((REP_MASK >> 8) & 1); ++rep) {
        moe_tables(F, TST, CNT);
        pg8::MoeOrder S{TST, CNT, (const LAS unsigned char*)(TST + 96), WSP(int, WS_LIST), F.G, F.vcu, DM / 2, true};
        EpiUpI8 E{WSP(bf16_t, WS_HB), WSP(float, WS_SAL), WSP(float, WS_SB13), TST, F.lds};
        pg8::gemm_phase<true>(F.lds, WSP(bf16_t, WS_H2Q), WSP(bf16_t, WS_W13T), DM / 2, S, E);
        {
            const int U = TST[32] * 4, full = U / F.G, rem = U % F.G;
            if (rem == 0) w2_convert(F, F.vcu, F.G); else if (F.vcu >= rem) w2_convert(F, F.vcu - rem, F.G - rem);
            (void)full; }
    } SEAM(8);
    if (IN(9)) PHASE_TID() _Pragma("nounroll") for (int rep = 0; rep <= ((REP_MASK >> 9) & 1); ++rep) {
        moe_tables(F, TST, CNT);
        pg8::MoeOrder S{TST, CNT, (const LAS unsigned char*)(TST + 96), WSP(int, WS_LIST), F.G, F.vcu, EFF, false};
        EpiBf16 E{WSP(bf16_t, WS_YB), DM};
        pg8::gemm_phase<false>(F.lds, WSP(bf16_t, WS_HB), WSP(bf16_t, WS_W2T), EFF, S, E);
    } SEAM(9);
    if (IN(10)) PHASE_TID() { moe_tables(F, TST, CNT); s10_phase(F, TST); }
#if DBG_STOP >= 0
    xcd_barrier(bar);
#if DBG_CHECK == 1 || DBG_CHECK == 3 || DBG_CHECK == 4 || DBG_CHECK == 5
    { unsigned* cw = (unsigned*)(F.ws + WS_CTL) + CW_DBG + 1; if (DBG_CHECK == 1) dbg_check_p1(F, cw); else if (DBG_CHECK == 3) dbg_check_nsa(F, cw); else if (DBG_CHECK == 4) dbg_check_mlstm(F, cw); else dbg_check_cmp(F, cw); xcd_barrier(bar);
      const unsigned nb = __hip_atomic_load(cw, __ATOMIC_RELAXED, __HIP_MEMORY_SCOPE_AGENT);
      const float sc = nb == 0 ? 1.f : nb < 4 ? 2.f : nb < 16 ? 3.f : nb < 64 ? 4.f : nb < 256 ? 5.f : nb < 1024 ? 6.f : 7.f;
      const float* x = IN_F(0); for (size_t k = (size_t)blockIdx.x * NTHR + F.tid; k < (size_t)NTOK * DM; k += (size_t)F.G * NTHR) F.out[k] = x[k] * sc; }
#elif DBG_CHECK == 2
    { const unsigned id = __hip_atomic_load((unsigned*)(F.ws + WS_CTL) + CW_DBG, __ATOMIC_RELAXED, __HIP_MEMORY_SCOPE_AGENT);
      float sc = (id >= 1000u) ? 1.f : 1.f + (float)id;
      if (__hip_atomic_load((unsigned*)(F.ws + WS_CTL) + CW_BAR + XB_TMO, __ATOMIC_RELAXED, __HIP_MEMORY_SCOPE_AGENT) != 0u) sc = 61.f;
      const float* x = IN_F(0); for (size_t k = (size_t)blockIdx.x * NTHR + F.tid; k < (size_t)NTOK * DM; k += (size_t)F.G * NTHR) F.out[k] = x[k] * sc; }
#else
    dbg_phase(F, bar);
#endif
#endif
#undef IN
#undef SEAM
}

extern "C" void kernel_launch(void* const* d_in, const int* in_sizes, int n_in, void* d_out, int out_size, void* d_ws, size_t ws_size, hipStream_t stream) {
    static int grid = 0;
    if (grid == 0) {
        int dev = 0, cus = 0;
        if (hipGetDevice(&dev) != hipSuccess || hipDeviceGetAttribute(&cus, hipDeviceAttributeMultiprocessorCount, dev) != hipSuccess) cus = 256;
        if (hipFuncSetAttribute((const void*)mega_fwd, hipFuncAttributeMaxDynamicSharedMemorySize, LDS_BYTES) != hipSuccess) fprintf(stderr, "kernel_launch: hipFuncSetAttribute failed\n");
        (void)hipGetLastError();
        grid = cus > 0 ? cus : 256;
        if (n_in != 27 || ws_size < WS_END) fprintf(stderr, "kernel_launch: unexpected n_in %d / ws_size %zu (need %zu)\n", n_in, ws_size, (size_t)WS_END);
    }
    (void)hipMemsetAsync((char*)d_ws + WS_CTL, 0, 64 * 1024, stream);
#if DBG_STOP >= 0
    (void)hipMemsetAsync((char*)d_ws + WS_CTL + CW_DBG * 4, 0x7F, 4, stream);
#endif
    Args a{};
    for (int i = 0; i < 27; ++i) a.in[i] = d_in[i];
    a.out = (float*)d_out; a.ws = (unsigned char*)d_ws;
#if MK_N_LAUNCHES == 1
    a.ph_lo = 0; a.ph_hi = NPHASE;
    hipLaunchKernelGGL(mega_fwd, dim3(grid), dim3(NTHR), LDS_BYTES, stream, a);
#else
    for (int p = 0; p < NPHASE; ++p) { a.ph_lo = p; a.ph_hi = p + 1; hipLaunchKernelGGL(mega_fwd, dim3(grid), dim3(NTHR), LDS_BYTES, stream, a); }
#endif
}
```

```cpp
#include <hip/hip_runtime.h>
#include <cstdio>
#include <cstdint>
#include <type_traits>

#define LAS __attribute__((address_space(3)))
typedef unsigned short bf16_t;
typedef short bf16x8 __attribute__((ext_vector_type(8)));
typedef short s16x4 __attribute__((ext_vector_type(4)));
typedef float f32x4 __attribute__((ext_vector_type(4)));
typedef float f32x16 __attribute__((ext_vector_type(16)));
typedef unsigned u32x4 __attribute__((ext_vector_type(4)));
typedef unsigned u32x2 __attribute__((ext_vector_type(2)));
typedef int i32x4 __attribute__((ext_vector_type(4)));
typedef _Float16 f16x8 __attribute__((ext_vector_type(8)));
typedef _Float16 f16x4 __attribute__((ext_vector_type(4)));

#ifndef MK_N_LAUNCHES
#define MK_N_LAUNCHES 1
#endif
#ifndef DBG_CHECK
#define DBG_CHECK 0
#endif
#ifndef REP_MASK
#define REP_MASK 0
#endif
#ifndef REP_SUB
#define REP_SUB 0
#endif
#ifndef NSA_DUP
#define NSA_DUP 0
#endif
#define NDUP(b) _Pragma("nounroll") for (int nd_ = 0; nd_ <= ((NSA_DUP >> (b)) & 1); ++nd_)
#define REPS(b) _Pragma("nounroll") for (int rs_ = 0; rs_ <= ((REP_SUB >> (b)) & 1); ++rs_)

constexpr int NB = 8, SEQ = 4096, DM = 1024, NTOK = NB * SEQ;
constexpr int MH = 4, MDH = 128;
constexpr int NHD = 8, NGRP = 2;
constexpr int INW = 3360, INWP = 3584;
constexpr int NEXP = 32, EFF = 512;
constexpr float RMS_EPS = 1e-6f;
constexpr float QSCALE = 0.125f * 1.4426950408889634f;
constexpr int NWAVES = 8, NTHR = 512;
constexpr int LDS_BYTES = 160 * 1024, MISC_OFF = 128 * 1024;
constexpr int MAXROWS = 73728;

constexpr size_t MiB = 1ull << 20, KiB = 1024;
constexpr size_t WS_CTL   = 0;
constexpr size_t WS_MOD   = 64 * KiB;
constexpr size_t WS_C1B   = WS_MOD + 192 * KiB;
constexpr size_t WS_GI    = WS_C1B + 4 * KiB;
constexpr size_t WS_GF    = WS_GI + 512 * KiB;
constexpr size_t WS_NGT   = WS_GF + 512 * KiB;
constexpr size_t WS_GSUM  = WS_NGT + 3 * MiB;
constexpr size_t WS_MLOC  = WS_GSUM + 8 * KiB;
constexpr size_t WS_MPREV = WS_MLOC + 8 * KiB;
constexpr size_t WS_NC    = WS_MPREV + 8 * KiB;
constexpr size_t WS_NPREV = WS_NC + 1 * MiB;
constexpr size_t WS_COS   = WS_NPREV + 1 * MiB;
constexpr size_t WS_SIN   = WS_COS + 4 * MiB;
constexpr size_t WS_WOUTT = WS_SIN + 4 * MiB;
constexpr size_t WS_CW1K  = WS_WOUTT + 2 * MiB;
constexpr size_t WS_CW1V  = WS_CW1K + 512 * KiB;
constexpr size_t WS_CW2K  = WS_CW1V + 512 * KiB;
constexpr size_t WS_CW2V  = WS_CW2K + 16 * KiB;
constexpr size_t WS_RWT   = WS_CW2V + 16 * KiB;
constexpr size_t WS_RWL   = WS_RWT + 96 * KiB;
constexpr size_t WS_KCMP  = WS_RWL + 96 * KiB;
constexpr size_t WS_VCMP  = WS_KCMP + 512 * KiB;
constexpr size_t WS_TOKE  = WS_VCMP + 512 * KiB;
constexpr size_t WS_TOKP  = WS_TOKE + 256 * KiB;
constexpr size_t WS_TOKG  = WS_TOKP + 256 * KiB;
constexpr size_t WS_LIST  = WS_TOKG + 256 * KiB;
constexpr size_t WS_SA    = WS_LIST + 8 * MiB;
constexpr size_t WS_SB13  = WS_SA + 128 * KiB;
constexpr size_t WS_SA1   = WS_SB13 + 128 * KiB;
constexpr size_t WS_SBW   = WS_SA1 + 128 * KiB;
constexpr size_t WS_SMALL_END = WS_SBW + 16 * KiB;
static_assert(WS_SMALL_END <= 32 * MiB, "small region overflow");
constexpr size_t WS_A     = 32 * MiB;
constexpr size_t WS_H1    = WS_A, WS_KVC = WS_A, WS_W13T = WS_A;
constexpr size_t WS_NQ    = 96 * MiB;
constexpr size_t WS_KC    = 128 * MiB, WS_VC = 136 * MiB, WS_KSL = 144 * MiB, WS_VSL = 152 * MiB, WS_KWN = 160 * MiB, WS_VWN = 168 * MiB;
constexpr size_t WS_W2T   = 96 * MiB;
constexpr size_t WS_MQ    = 176 * MiB, WS_MK = 208 * MiB, WS_MV = 240 * MiB, WS_MO = 272 * MiB;
constexpr size_t WS_Y     = 176 * MiB;
constexpr size_t WS_H2    = 240 * MiB;
constexpr size_t WS_CPREV = 304 * MiB;
constexpr size_t WS_WINT  = 304 * MiB;
constexpr size_t WS_HB    = 304 * MiB;
constexpr size_t WS_H2LO  = 304 * MiB;
constexpr size_t WS_YCAT  = 376 * MiB;
constexpr size_t WS_X1B   = 376 * MiB;
constexpr size_t WS_YB    = 128 * MiB;
constexpr size_t WS_H2Q   = 128 * MiB;
constexpr size_t WS_SAL   = 440 * MiB;
constexpr size_t WS_END   = 448 * MiB;

constexpr int CW_BAR = 0;
constexpr int CW_CNT = 4096;
constexpr int CW_DBG = 4200;

typedef __bf16 bf16x2_t __attribute__((ext_vector_type(2)));
typedef float f32x2_t __attribute__((ext_vector_type(2)));
__device__ __forceinline__ unsigned cvtpk(float lo, float hi) { const f32x2_t f = {lo, hi}; const bf16x2_t v = __builtin_convertvector(f, bf16x2_t); return __builtin_bit_cast(unsigned, v); }
__device__ __forceinline__ float bf2f(bf16_t b) { return __uint_as_float(((unsigned)b) << 16); }
__device__ __forceinline__ float bflo(unsigned w) { return __uint_as_float(w << 16); }
__device__ __forceinline__ float bfhi(unsigned w) { return __uint_as_float(w & 0xffff0000u); }
__device__ __forceinline__ bf16_t f2bf(float f) { return (bf16_t)(cvtpk(f, 0.f) & 0xffffu); }
template <int CTRL> __device__ __forceinline__ float dppf(float v) { return __int_as_float(__builtin_amdgcn_mov_dpp(__float_as_int(v), CTRL, 0xF, 0xF, true)); }
__device__ __forceinline__ float wave_sum(float v) {
    v += dppf<0xB1>(v); v += dppf<0x4E>(v); v += dppf<0x141>(v); v += dppf<0x140>(v);
    { const auto r = __builtin_amdgcn_permlane16_swap(__float_as_uint(v), __float_as_uint(v), false, false); v = __uint_as_float(r[0]) + __uint_as_float(r[1]); }
    { const auto r = __builtin_amdgcn_permlane32_swap(__float_as_uint(v), __float_as_uint(v), false, false); v = __uint_as_float(r[0]) + __uint_as_float(r[1]); }
    return v;
}
__device__ __forceinline__ float wave_max(float v) {
    v = fmaxf(v, dppf<0xB1>(v)); v = fmaxf(v, dppf<0x4E>(v)); v = fmaxf(v, dppf<0x141>(v)); v = fmaxf(v, dppf<0x140>(v));
    { const auto r = __builtin_amdgcn_permlane16_swap(__float_as_uint(v), __float_as_uint(v), false, false); v = fmaxf(__uint_as_float(r[0]), __uint_as_float(r[1])); }
    { const auto r = __builtin_amdgcn_permlane32_swap(__float_as_uint(v), __float_as_uint(v), false, false); v = fmaxf(__uint_as_float(r[0]), __uint_as_float(r[1])); }
    return v;
}
template <int CTRL, int RM> __device__ __forceinline__ float dpp_upd(float oldv, float v) { return __int_as_float(__builtin_amdgcn_update_dpp(__float_as_int(oldv), __float_as_int(v), CTRL, RM, 0xF, false)); }
__device__ __forceinline__ float wave_scan_add(float v) {
    v += dpp_upd<0x111, 0xF>(0.f, v); v += dpp_upd<0x112, 0xF>(0.f, v); v += dpp_upd<0x114, 0xF>(0.f, v); v += dpp_upd<0x118, 0xF>(0.f, v);
    v += dpp_upd<0x142, 0xA>(0.f, v); v += dpp_upd<0x143, 0xC>(0.f, v);
    return v; }
__device__ __forceinline__ float wave_scan_max(float v) {
    v = fmaxf(v, dpp_upd<0x111, 0xF>(-INFINITY, v)); v = fmaxf(v, dpp_upd<0x112, 0xF>(-INFINITY, v)); v = fmaxf(v, dpp_upd<0x114, 0xF>(-INFINITY, v)); v = fmaxf(v, dpp_upd<0x118, 0xF>(-INFINITY, v));
    v = fmaxf(v, dpp_upd<0x142, 0xA>(-INFINITY, v)); v = fmaxf(v, dpp_upd<0x143, 0xC>(-INFINITY, v));
    return v; }
__device__ __forceinline__ float sigmoid_f(float x) { return __builtin_amdgcn_rcpf(1.f + __builtin_amdgcn_exp2f(-1.4426950408889634f * x)); }
__device__ __forceinline__ float silu_f(float x) { return x * __builtin_amdgcn_rcpf(1.f + __builtin_amdgcn_exp2f(-1.4426950408889634f * x)); }
__device__ __forceinline__ float logsigmoid_f(float x) { return fminf(x, 0.f) - __logf(1.f + __expf(-fabsf(x))); }
__device__ __forceinline__ float ex2(float x) { return __builtin_amdgcn_exp2f(x); }
#define MFMA32(a, b, c) __builtin_amdgcn_mfma_f32_32x32x16_bf16(a, b, c, 0, 0, 0)
#define MFMA16(a, b, c) __builtin_amdgcn_mfma_f32_16x16x32_bf16(a, b, c, 0, 0, 0)
typedef short v4i16_t __attribute__((ext_vector_type(4)));
__device__ __forceinline__ s16x4 vtr(LAS const unsigned char* p) { return __builtin_bit_cast(s16x4, __builtin_amdgcn_ds_read_tr16_b64_v4i16((LAS v4i16_t*)p)); }
__device__ __forceinline__ int crow(int r, int hi) { return (r & 3) + 8 * (r >> 2) + 4 * hi; }
__device__ __forceinline__ u32x4 widen_pair(u32x2 A, u32x2 B) {
    const auto r0 = __builtin_amdgcn_permlane32_swap(A.x, B.x, false, false); const auto r1 = __builtin_amdgcn_permlane32_swap(A.y, B.y, false, false);
    return (u32x4){r0[0], r1[0], r0[1], r1[1]}; }
__device__ __forceinline__ u32x4 widen_rows16(u32x2 X, u32x2 Y) {
    const auto r0 = __builtin_amdgcn_permlane16_swap(X.x, Y.x, false, false); const auto r1 = __builtin_amdgcn_permlane16_swap(X.y, Y.y, false, false);
    return (u32x4){r0[0], r1[0], r0[1], r1[1]}; }
__device__ __forceinline__ u32x4 quad_transpose(u32x4 d, int lane) {
    const bool b0 = lane & 1, b1 = lane & 2;
    { const unsigned t0 = b0 ? d.x : d.y, t1 = b0 ? d.z : d.w;
      const unsigned r0 = (unsigned)__builtin_amdgcn_mov_dpp((int)t0, 0xB1, 0xF, 0xF, true), r1 = (unsigned)__builtin_amdgcn_mov_dpp((int)t1, 0xB1, 0xF, 0xF, true);
      if (b0) { d.x = r0; d.z = r1; } else { d.y = r0; d.w = r1; } }
    { const unsigned t0 = b1 ? d.x : d.z, t1 = b1 ? d.y : d.w;
      const unsigned r0 = (unsigned)__builtin_amdgcn_mov_dpp((int)t0, 0x4E, 0xF, 0xF, true), r1 = (unsigned)__builtin_amdgcn_mov_dpp((int)t1, 0x4E, 0xF, 0xF, true);
      if (b1) { d.x = r0; d.y = r1; } else { d.z = r0; d.w = r1; } }
    return d; }
__device__ __forceinline__ u32x4 pair_widen(u32x2 A, u32x2 B, int lane) {
    const bool od = lane & 1; const u32x2 t = od ? A : B;
    u32x2 r; r.x = (unsigned)__builtin_amdgcn_mov_dpp((int)t.x, 0xB1, 0xF, 0xF, true); r.y = (unsigned)__builtin_amdgcn_mov_dpp((int)t.y, 0xB1, 0xF, 0xF, true);
    return od ? (u32x4){r.x, r.y, B.x, B.y} : (u32x4){A.x, A.y, r.x, r.y}; }
__device__ __forceinline__ void pair_narrow(u32x4 v, int lane, u32x2& A, u32x2& B) {
    const bool od = lane & 1; const u32x2 lo = {v.x, v.y}, hi = {v.z, v.w}; const u32x2 t = od ? lo : hi;
    u32x2 r; r.x = (unsigned)__builtin_amdgcn_mov_dpp((int)t.x, 0xB1, 0xF, 0xF, true); r.y = (unsigned)__builtin_amdgcn_mov_dpp((int)t.y, 0xB1, 0xF, 0xF, true);
    A = od ? r : lo; B = od ? hi : r; }
__device__ __forceinline__ bf16x8 mk8(s16x4 lo, s16x4 hi) { return (bf16x8){lo[0], lo[1], lo[2], lo[3], hi[0], hi[1], hi[2], hi[3]}; }

#define XB_TMO      128
#define XB_XCNT(j)  (256  + 64 * (j))
#define XB_XSUB(j)  (1280 + 64 * (j))
#define XB_XGEN(j)  (2304 + 64 * (j))
#define XB_TOP      3328
#define XB_TOPGEN   3392
#define XCD_BAR_WORDS 3456
#define XB_SPIN_CAP (1u << 18)
__device__ __forceinline__ unsigned xb_ld(unsigned* p)              { return __hip_atomic_load(p, __ATOMIC_RELAXED, __HIP_MEMORY_SCOPE_AGENT); }
__device__ __forceinline__ unsigned xb_add(unsigned* p, unsigned v) { return __hip_atomic_fetch_add(p, v, __ATOMIC_RELAXED, __HIP_MEMORY_SCOPE_AGENT); }
__device__ __forceinline__ unsigned xb_xcc_id() { return (unsigned)__builtin_amdgcn_s_getreg((3 << 11) | 20) & 0xFu; }
#define XB_SPIN(cond, bar) do { unsigned _sp = 0; while (cond) { __builtin_amdgcn_s_sleep(1); \
    if ((++_sp & 255u) == 0u) { if (xb_ld(&(bar)[XB_TMO])) break; if (_sp > XB_SPIN_CAP) { atomicAdd(&(bar)[XB_TMO], 1u); break; } } } } while (0)
struct XcdBarrier { unsigned* bar; unsigned x; volatile LAS unsigned* st; };
__device__ __forceinline__ XcdBarrier xcd_barrier_post(unsigned* bar, volatile LAS unsigned* st) {
    XcdBarrier b; b.bar = bar; b.x = xb_xcc_id(); b.st = st;
    if (threadIdx.x == 0) (void)xb_add(&bar[XB_XCNT(b.x)], 1u);
    return b;
}
__device__ __forceinline__ void xcd_barrier_complete(unsigned* bar, unsigned x, unsigned& nloc, unsigned& nx) {
    const unsigned G = gridDim.x * gridDim.y * gridDim.z;
    unsigned sum, cnt, mine, sp = 0u;
    for (;;) {
        sum = 0u; cnt = 0u; mine = 0u;
#pragma unroll
        for (unsigned j = 0; j < 16; ++j) { const unsigned c = xb_ld(&bar[XB_XCNT(j)]); sum += c; cnt += (c > 0u) ? 1u : 0u; mine = (j == x) ? c : mine; }
        if (sum == G) break;
        __builtin_amdgcn_s_sleep(1);
        if ((++sp & 255u) == 0u) { if (xb_ld(&bar[XB_TMO])) break; if (sp > XB_SPIN_CAP) { atomicAdd(&bar[XB_TMO], 1u); break; } }
    }
    nloc = mine > 0u ? mine : 1u; nx = cnt > 0u ? cnt : 1u;
}
__device__ __forceinline__ void xcd_barrier(const XcdBarrier& b) {
    asm volatile("s_waitcnt vmcnt(0)" ::: "memory");
    __syncthreads();
    if (threadIdx.x == 0) {
        unsigned* bar = b.bar;
        __builtin_amdgcn_s_waitcnt(0);
        unsigned nloc = b.st[0], nx = b.st[1];
        if (nloc == 0u) { xcd_barrier_complete(bar, b.x, nloc, nx); b.st[0] = nloc; b.st[1] = nx; }
        const unsigned old = xb_add(&bar[XB_XSUB(b.x)], 1u);
        const unsigned gen = old / nloc;
        if (old + 1u == (gen + 1u) * nloc) {
            __builtin_amdgcn_fence(__ATOMIC_RELEASE, "agent");
            asm volatile("s_waitcnt vmcnt(0)" ::: "memory");
            const unsigned og = xb_add(&bar[XB_TOP], 1u);
            const unsigned tg = og / nx;
            if (og + 1u == (tg + 1u) * nx) xb_add(&bar[XB_TOPGEN], 1u);
            else XB_SPIN(xb_ld(&bar[XB_TOPGEN]) == tg, bar);
            __builtin_amdgcn_fence(__ATOMIC_ACQUIRE, "agent");
            xb_add(&bar[XB_XGEN(b.x)], 1u);
            asm volatile("s_waitcnt vmcnt(0)" ::: "memory");
        } else {
            XB_SPIN(xb_ld(&bar[XB_XGEN(b.x)]) == gen, bar);
            __builtin_amdgcn_fence(__ATOMIC_ACQUIRE, "agent");
            asm volatile("s_waitcnt vmcnt(0)" ::: "memory");
        }
    }
    __syncthreads();
}

struct Args { const void* in[27]; float* out; unsigned char* ws; int ph_lo, ph_hi; };
struct Frame {
    LAS unsigned char* lds;
    const void* const* in; float* out; unsigned char* ws;
    int tid, lane, wave, vcu, G;
};
#define IN_F(k) ((const float*)F.in[k])
#define WSP(T, off) ((T*)(F.ws + (off)))

namespace pg8 {
constexpr int BM = 256, BK = 64, HALF = 128, HTB = HALF * BK * 2, STAGE_BYTES = 8 * HTB, NXCD = 8, WGM = 8;
__host__ __device__ __forceinline__ int lds_byte(int r, int c) { const int st = (r >> 4) * 2 + (c >> 5), rr = r & 15, cc = c & 31, ob = rr * 64 + cc * 2; return st * 1024 + (ob ^ (((ob >> 9) & 1) << 5)); }
__host__ __device__ __forceinline__ void stage_rc(int b, int& R, int& C) { const int st = b / 1024, sb = b % 1024, swz = sb ^ (((sb >> 9) & 1) << 5); R = (st >> 1) * 16 + swz / 64; C = (st & 1) * 32 + (swz % 64) / 2; }
__host__ __device__ __forceinline__ int perm32(int rho) { const int n = rho >> 4, i = rho & 15; return 8 * (i >> 2) + 4 * n + (i & 3); }
struct Unit { int pm, pn, e, nrow; };

template <bool I8, class Epi, class Sched>
__device__ __forceinline__ void gemm_phase(LAS unsigned char* lds, const void* Abase, const void* Bbase, const int K, const Sched& S, const Epi& E) {
    const int tid = threadIdx.x, wid = __builtin_amdgcn_readfirstlane(tid >> 6), lane = tid & 63, wr = wid >> 2, wc = wid & 3, fr = lane & 15, fq = lane >> 4;
    const int nt = K / BK;
    int Rr[2], Cc[2]; unsigned voffB[2];
#pragma unroll
    for (int i = 0; i < 2; ++i) { int R, C; stage_rc(tid * 16 + i * 8192, R, C); Rr[i] = R; Cc[i] = C; const int Rb = (R & ~31) + perm32(R & 31); voffB[i] = (unsigned)(Rb * K + C) * 2u; }
    const size_t kstep = (size_t)(BK * 2);
    const size_t hstepB = (size_t)HALF * K * 2;
    const unsigned ldsw = (unsigned)wid * 1024u;
    const int aoff = lds_byte(wr * 64 + fr, fq * 8), boff = lds_byte(wc * 32 + fr, fq * 8);
#define PG8_SA(b, h) (((b) * 2 + (h)) * HTB)
#define PG8_SB(b, h) ((4 + (b) * 2 + (h)) * HTB)
#define PG8_STAGEB(bufoff, gbase) do { _Pragma("unroll") for (int _i = 0; _i < 2; ++_i) \
        __builtin_amdgcn_global_load_lds((const unsigned*)((const char*)(gbase) + voffB[_i]), (LAS unsigned*)(lds + (bufoff) + ldsw + _i * 8192), 16, 0, 0); } while (0)
#define PG8_STAGEA(bufoff, o0, o1, ktb) do { const char* _p = (const char*)Abase + (ktb); \
        __builtin_amdgcn_global_load_lds((const unsigned*)(_p + (o0)), (LAS unsigned*)(lds + (bufoff) + ldsw), 16, 0, 0); \
        __builtin_amdgcn_global_load_lds((const unsigned*)(_p + (o1)), (LAS unsigned*)(lds + (bufoff) + ldsw + 8192), 16, 0, 0); } while (0)
#define PG8_LDA(dst, b, h) do { _Pragma("unroll") for (int m = 0; m < 4; ++m) _Pragma("unroll") for (int k = 0; k < 2; ++k) dst[m][k] = *(const LAS bf16x8*)(lds + PG8_SA(b, h) + aoff + m * 2048 + k * 1024); } while (0)
#define PG8_LDB(dst, b, h) do { _Pragma("unroll") for (int n = 0; n < 2; ++n) _Pragma("unroll") for (int k = 0; k < 2; ++k) dst[n][k] = *(const LAS bf16x8*)(lds + PG8_SB(b, h) + boff + n * 2048 + k * 1024); } while (0)
#define PG8_MMA(ai, bj, At, Bt) do { __builtin_amdgcn_s_setprio(1); _Pragma("unroll") for (int m = 0; m < 4; ++m) _Pragma("unroll") for (int n = 0; n < 2; ++n) _Pragma("unroll") for (int k = 0; k < 2; ++k) { \
        if constexpr (I8) acc[ai][bj][m][n] = __builtin_bit_cast(acc_t, __builtin_amdgcn_mfma_i32_16x16x64_i8(__builtin_bit_cast(i32x4, Bt[n][k]), __builtin_bit_cast(i32x4, At[m][k]), __builtin_bit_cast(i32x4, acc[ai][bj][m][n]), 0, 0, 0)); \
        else acc[ai][bj][m][n] = __builtin_bit_cast(acc_t, __builtin_amdgcn_mfma_f32_16x16x32_bf16(Bt[n][k], At[m][k], __builtin_bit_cast(f32x4, acc[ai][bj][m][n]), 0, 0, 0)); } __builtin_amdgcn_s_setprio(0); } while (0)
#define PG8_WAIT_V(n) asm volatile("s_waitcnt vmcnt(" #n ")" ::: "memory")
#define PG8_WAIT_L(n) asm volatile("s_waitcnt lgkmcnt(" #n ")" ::: "memory")
#define PG8_BAR __builtin_amdgcn_s_barrier()
#define PG8_SCHED __builtin_amdgcn_sched_barrier(0)
    Unit cur, nxt; int ui = 0;
    if (!S.next(0, cur)) return;
    using acc_t = typename std::conditional<I8, i32x4, f32x4>::type;
    acc_t acc[2][2][4][2];
#pragma unroll
    for (int a = 0; a < 2; ++a)
#pragma unroll
        for (int b = 0; b < 2; ++b)
#pragma unroll
            for (int m = 0; m < 4; ++m)
#pragma unroll
                for (int n = 0; n < 2; ++n) acc[a][b][m][n] = __builtin_bit_cast(acc_t, (u32x4){0u, 0u, 0u, 0u});
    bf16x8 At[4][2], B0[2][2], B1[2][2];
    unsigned oc00, oc01, oc10, oc11; int kn00, kn01, kn10, kn11;
    oc00 = S.a_conv(S.a_key(cur, Rr[0])) + Cc[0] * 2; oc01 = S.a_conv(S.a_key(cur, Rr[1])) + Cc[1] * 2; oc10 = S.a_conv(S.a_key(cur, HALF + Rr[0])) + Cc[0] * 2; oc11 = S.a_conv(S.a_key(cur, HALF + Rr[1])) + Cc[1] * 2;
    const char* cB = (const char*)Bbase + S.b_off(cur);
    PG8_STAGEB(PG8_SB(0, 0), cB); PG8_STAGEA(PG8_SA(0, 0), oc00, oc01, 0); PG8_STAGEB(PG8_SB(0, 1), cB + hstepB); PG8_STAGEA(PG8_SA(0, 1), oc10, oc11, 0);
    if (wr == 1) PG8_BAR;
    PG8_WAIT_V(4); PG8_BAR;
    PG8_STAGEB(PG8_SB(1, 0), cB + kstep); PG8_STAGEA(PG8_SA(1, 0), oc00, oc01, kstep); PG8_STAGEB(PG8_SB(1, 1), cB + hstepB + kstep);
    PG8_WAIT_V(6); PG8_BAR;
    for (;;) {
        E.pre(cur, lds, wid, lane, ui & 1);
        const bool has_next = S.next(ui + 1, nxt);
        const char* nB = cB;
        if (has_next) { kn00 = S.a_key(nxt, Rr[0]); kn01 = S.a_key(nxt, Rr[1]); kn10 = S.a_key(nxt, HALF + Rr[0]); kn11 = S.a_key(nxt, HALF + Rr[1]); nB = (const char*)Bbase + S.b_off(nxt); }
        else { kn00 = 0; kn01 = 0; kn10 = 0; kn11 = 0; }
        for (int t = 0; t < nt; t += 2) {
            const bool last = (t == nt - 2);
            const size_t k1 = (size_t)(t + 1) * kstep;
            const size_t k2 = last ? 0 : (size_t)(t + 2) * kstep, k3 = k2 + kstep;
            const unsigned o200 = (last && has_next) ? S.a_conv(kn00) + Cc[0] * 2 : oc00, o201 = (last && has_next) ? S.a_conv(kn01) + Cc[1] * 2 : oc01, o210 = (last && has_next) ? S.a_conv(kn10) + Cc[0] * 2 : oc10, o211 = (last && has_next) ? S.a_conv(kn11) + Cc[1] * 2 : oc11;
            const char* b2 = last ? nB : cB + (size_t)(t + 2) * kstep; const char* b3 = b2 + kstep;
            PG8_LDB(B0, 0, 0); PG8_SCHED; PG8_LDA(At, 0, 0); PG8_STAGEA(PG8_SA(1, 1), oc10, oc11, k1);
            PG8_WAIT_L(8); PG8_BAR; PG8_WAIT_L(0); PG8_MMA(0, 0, At, B0); PG8_BAR; PG8_SCHED;
            PG8_LDB(B1, 0, 1); PG8_STAGEB(PG8_SB(0, 0), b2);
            PG8_BAR; PG8_WAIT_L(0); PG8_MMA(0, 1, At, B1); PG8_BAR;
            PG8_LDA(At, 0, 1); PG8_STAGEA(PG8_SA(0, 0), o200, o201, k2);
            PG8_BAR; PG8_WAIT_L(0); PG8_MMA(1, 0, At, B0); PG8_BAR; PG8_SCHED;
            PG8_STAGEB(PG8_SB(0, 1), b2 + hstepB);
            PG8_WAIT_V(6); PG8_BAR; PG8_MMA(1, 1, At, B1); PG8_BAR;
            PG8_LDB(B0, 1, 0); PG8_SCHED; PG8_LDA(At, 1, 0); PG8_STAGEA(PG8_SA(0, 1), o210, o211, k2);
            PG8_WAIT_L(8); PG8_BAR; PG8_WAIT_L(0); PG8_MMA(0, 0, At, B0); PG8_BAR; PG8_SCHED;
            PG8_LDB(B1, 1, 1); PG8_STAGEB(PG8_SB(1, 0), b3);
            PG8_BAR; PG8_WAIT_L(0); PG8_MMA(0, 1, At, B1); PG8_BAR;
            PG8_LDA(At, 1, 1); PG8_STAGEA(PG8_SA(1, 0), o200, o201, k3);
            PG8_BAR; PG8_WAIT_L(0); PG8_MMA(1, 0, At, B0); PG8_BAR; PG8_SCHED;
            PG8_STAGEB(PG8_SB(1, 1), b3 + hstepB);
            PG8_WAIT_V(6); PG8_BAR; PG8_MMA(1, 1, At, B1); PG8_BAR;
        }
        E(acc, cur, wr, wc, fr, fq, ui & 1);
        if (!has_next) break;
#pragma unroll
        for (int a = 0; a < 2; ++a)
#pragma unroll
            for (int b = 0; b < 2; ++b)
#pragma unroll
                for (int m = 0; m < 4; ++m)
#pragma unroll
                    for (int n = 0; n < 2; ++n) acc[a][b][m][n] = __builtin_bit_cast(acc_t, (u32x4){0u, 0u, 0u, 0u});
        cur = nxt; cB = nB; oc00 = S.a_conv(kn00) + Cc[0] * 2; oc01 = S.a_conv(kn01) + Cc[1] * 2; oc10 = S.a_conv(kn10) + Cc[0] * 2; oc11 = S.a_conv(kn11) + Cc[1] * 2; ++ui;
    }
    PG8_WAIT_V(0);
    if (wr == 0) PG8_BAR;
    PG8_BAR;
#undef PG8_SA
#undef PG8_SB
#undef PG8_STAGEA
#undef PG8_STAGEB
#undef PG8_LDA
#undef PG8_LDB
#undef PG8_MMA
#undef PG8_WAIT_V
#undef PG8_WAIT_L
#undef PG8_BAR
#undef PG8_SCHED
}

struct DenseOrder {
    int nM, nN, nwg, G, c, K;
    __device__ void init(int M, int N, int K_, int G_, int c_) { nM = M / BM; nN = N / BM; nwg = nM * nN; G = G_; c = c_; K = K_; }
    __device__ __forceinline__ bool next(int i, Unit& u) const {
        const long L = (long)i * G + c; if (L >= nwg) return false;
        int wgid = (int)L; { const int q = nwg / NXCD, r = nwg % NXCD, xcd = wgid % NXCD, off = wgid / NXCD; wgid = (xcd < r ? xcd * (q + 1) : r * (q + 1) + (xcd - r) * q) + off; }
        const int nig = WGM * nN, gid = wgid / nig, fm = gid * WGM, gsz = (nM - fm) < WGM ? (nM - fm) : WGM;
        u.pm = fm + ((wgid % nig) % gsz); u.pn = (wgid % nig) / gsz; u.e = 0; u.nrow = 256; return true;
    }
    __device__ __forceinline__ int a_key(const Unit& u, int R) const { return u.pm * BM + R; }
    __device__ __forceinline__ unsigned a_conv(int key) const { return (unsigned)(key * K) * 2u; }
    __device__ __forceinline__ size_t b_off(const Unit& u) const { return (size_t)u.pn * BM * K * 2; }
};
struct MoeOrder {
    const LAS int* tstart; const LAS int* cnt; const LAS unsigned char* etile; const int* list; int G, c, K; bool gather;
    static constexpr int npn = 4;
    __device__ __forceinline__ bool next(int i, Unit& u) const {
        const int L = i * G + c; const int tt = tstart[32];
        if (L >= tt * npn) return false;
        const int tile = L / npn; u.pn = L % npn; u.pm = tile;
        const int e = etile[tile];
        u.e = e; u.nrow = cnt[e] - (tile - tstart[e]) * 256; return true;
    }
    __device__ __forceinline__ int a_key(const Unit& u, int R) const {
        if (gather) { const int mt = u.pm - tstart[u.e]; const int r = mt * 256 + R; return list[(size_t)u.e * 65536 + (R < u.nrow ? r : 0)]; }
        return u.pm * BM + R;
    }
    __device__ __forceinline__ unsigned a_conv(int key) const { return (unsigned)(key * K) * 2u; }
    __device__ __forceinline__ size_t b_off(const Unit& u) const { return ((size_t)u.e * 1024 + (size_t)u.pn * BM) * K * 2; }
};
}

constexpr int EPI_SC = MISC_OFF + 24576;
struct EpiIn {
    unsigned char* ws; const float* gate_b;
    __device__ __forceinline__ void pre(const pg8::Unit& u, LAS unsigned char* lds, int wid, int lane, int par) const {
        if (wid == 0) { __builtin_amdgcn_global_load_lds((const unsigned*)((const float*)(ws + WS_SA1) + u.pm * 256 + lane * 4), (LAS unsigned*)(lds + EPI_SC + par * 2048), 16, 0, 0);
                        __builtin_amdgcn_global_load_lds((const unsigned*)((const float*)(ws + WS_SBW) + u.pn * 256 + lane * 4), (LAS unsigned*)(lds + EPI_SC + par * 2048 + 1024), 16, 0, 0); } }
    LAS unsigned char* lds;
    __device__ __forceinline__ void operator()(const i32x4 (&acc)[2][2][4][2], const pg8::Unit& u, int wr, int wc, int fr, int fq, int par) const {
        asm volatile("" : "+v"(fr), "+v"(fq));
        const int pn = u.pn, row0 = u.pm * 256 + wr * 64 + fr;
        float sa[2][4]; f32x4 sb[2][2];
        { LAS const float* SA1 = (LAS const float*)(lds + EPI_SC + par * 2048); LAS const float* SBW = SA1 + 256;
#pragma unroll
          for (int ai = 0; ai < 2; ++ai)
#pragma unroll
              for (int m = 0; m < 4; ++m) sa[ai][m] = SA1[wr * 64 + fr + ai * 128 + m * 16];
#pragma unroll
          for (int bj = 0; bj < 2; ++bj)
#pragma unroll
              for (int n = 0; n < 2; ++n) sb[bj][n] = *(LAS const f32x4*)(SBW + bj * 128 + wc * 32 + 8 * fq + 4 * n); }
#define ACCF(ai, bj, m, n) (__builtin_convertvector(acc[ai][bj][m][n], f32x4) * sa[ai][m] * sb[bj][n])
        if (pn < 8) {
            bf16_t* dst = (bf16_t*)(ws + (pn < 2 ? WS_MQ : pn < 4 ? WS_MK : pn < 6 ? WS_MV : WS_MO));
            const int col0 = (pn & 1) * 256 + wc * 32 + 8 * fq;
#pragma unroll
            for (int ai = 0; ai < 2; ++ai)
#pragma unroll
                for (int m = 0; m < 4; ++m) { bf16_t* rp = dst + (size_t)(row0 + ai * 128 + m * 16) * 512 + col0;
#pragma unroll
                    for (int bj = 0; bj < 2; ++bj) { const f32x4 v0 = ACCF(ai, bj, m, 0), v1 = ACCF(ai, bj, m, 1);
                        u32x4 w; w.x = cvtpk(v0[0], v0[1]); w.y = cvtpk(v0[2], v0[3]); w.z = cvtpk(v1[0], v1[1]); w.w = cvtpk(v1[2], v1[3]);
                        *(u32x4*)(rp + bj * 128) = w; } }
        } else if (pn < 10) {
            const int g8 = 4 * (wc & 1) + fq; const float* COS = (const float*)(ws + WS_COS); const float* SIN = (const float*)(ws + WS_SIN); bf16_t* NQ = (bf16_t*)(ws + WS_NQ);
#pragma unroll
            for (int ai = 0; ai < 2; ++ai)
#pragma unroll
                for (int m = 0; m < 4; ++m) { const int row = row0 + ai * 128 + m * 16;
                    const f32x4 cs = *(const f32x4*)(COS + (size_t)row * 32 + 4 * g8), sn = *(const f32x4*)(SIN + (size_t)row * 32 + 4 * g8);
#pragma unroll
                    for (int bj = 0; bj < 2; ++bj) { const int head = (pn - 8) * 4 + bj * 2 + (wc >> 1);
                        const f32x4 x1 = ACCF(ai, bj, m, 0), x2 = ACCF(ai, bj, m, 1);
                        const f32x4 o1 = (x1 * cs - x2 * sn) * QSCALE, o2 = (x2 * cs + x1 * sn) * QSCALE;
                        bf16_t* rp = NQ + (size_t)row * 512 + head * 64 + 4 * (g8 & ~1) + 32 * (fq & 1);
                        u32x2 a; a.x = cvtpk(o1[0], o1[1]); a.y = cvtpk(o1[2], o1[3]);
                        u32x2 b; b.x = cvtpk(o2[0], o2[1]); b.y = cvtpk(o2[2], o2[3]); *(u32x4*)rp = widen_rows16(a, b); } }
        } else if (pn < 13) {
            bf16_t* kd = (bf16_t*)(ws + (pn == 10 ? WS_KC : pn == 11 ? WS_KSL : WS_KWN)); bf16_t* vd = (bf16_t*)(ws + (pn == 10 ? WS_VC : pn == 11 ? WS_VSL : WS_VWN));
            const float* COS = (const float*)(ws + WS_COS); const float* SIN = (const float*)(ws + WS_SIN);
            const int g8 = 4 * (wc & 1) + fq, grp = wc >> 1;
#pragma unroll
            for (int ai = 0; ai < 2; ++ai)
#pragma unroll
                for (int m = 0; m < 4; ++m) { const int row = row0 + ai * 128 + m * 16; const int b = row >> 12, s = row & 4095;
                    const f32x4 cs = *(const f32x4*)(COS + (size_t)row * 32 + 4 * g8), sn = *(const f32x4*)(SIN + (size_t)row * 32 + 4 * g8);
                    const size_t rbase = ((size_t)(b * 2 + grp) * SEQ + s) * 64;
                    { const f32x4 x1 = ACCF(ai, 0, m, 0), x2 = ACCF(ai, 0, m, 1);
                      const f32x4 o1 = x1 * cs - x2 * sn, o2 = x2 * cs + x1 * sn;
                      bf16_t* rp = kd + rbase + 4 * (g8 & ~1) + 32 * (fq & 1);
                      u32x2 a; a.x = cvtpk(o1[0], o1[1]); a.y = cvtpk(o1[2], o1[3]);
                      u32x2 c; c.x = cvtpk(o2[0], o2[1]); c.y = cvtpk(o2[2], o2[3]); *(u32x4*)rp = widen_rows16(a, c); }
                    { const f32x4 v0 = ACCF(ai, 1, m, 0), v1 = ACCF(ai, 1, m, 1);
                      u32x4 w; w.x = cvtpk(v0[0], v0[1]); w.y = cvtpk(v0[2], v0[3]); w.z = cvtpk(v1[0], v1[1]); w.w = cvtpk(v1[2], v1[3]);
                      *(u32x4*)(vd + rbase + (wc & 1) * 32 + 8 * fq) = w; } }
        } else {
            if (wc == 0) { float* GI = (float*)(ws + WS_GI); float* GF = (float*)(ws + WS_GF); float* NGT = (float*)(ws + WS_NGT);
#pragma unroll
                for (int ai = 0; ai < 2; ++ai)
#pragma unroll
                    for (int m = 0; m < 4; ++m) { const int row = row0 + ai * 128 + m * 16; const int b = row >> 12, s = row & 4095;
#pragma unroll
                        for (int n = 0; n < 2; ++n) { const f32x4 v = ACCF(ai, 0, m, n);
                            if (fq == 0) {
#pragma unroll
                                for (int i = 0; i < 4; ++i) { const float z = v[i] + gate_b[4 * n + i];
                                    if (n == 0) GI[(size_t)(b * 4 + i) * SEQ + s] = z; else GF[(size_t)(b * 4 + i) * SEQ + s] = logsigmoid_f(z); }
                            } else {
                                f32x4 o; o[0] = sigmoid_f(v[0]); o[1] = sigmoid_f(v[1]); o[2] = sigmoid_f(v[2]); o[3] = sigmoid_f(v[3]);
                                *(f32x4*)(NGT + (size_t)row * 24 + 8 * fq + 4 * n - 8) = o; } } }
            }
        }
    }
};
#undef ACCF
struct EpiBf16 {
    bf16_t* O; int ldc;
    __device__ __forceinline__ void pre(const pg8::Unit&, LAS unsigned char*, int, int, int) const {}
    __device__ __forceinline__ void operator()(const f32x4 (&acc)[2][2][4][2], const pg8::Unit& u, int wr, int wc, int fr, int fq, int par) const {
        asm volatile("" : "+v"(fr), "+v"(fq));
        const int row0 = u.pm * 256 + wr * 64 + fr, col0 = u.pn * 256 + wc * 32 + 8 * fq;
#pragma unroll
        for (int ai = 0; ai < 2; ++ai)
#pragma unroll
            for (int m = 0; m < 4; ++m) { bf16_t* rp = O + (size_t)(row0 + ai * 128 + m * 16) * ldc + col0;
#pragma unroll
                for (int bj = 0; bj < 2; ++bj) { const f32x4 v0 = acc[ai][bj][m][0], v1 = acc[ai][bj][m][1];
                    u32x4 w; w.x = cvtpk(v0[0], v0[1]); w.y = cvtpk(v0[2], v0[3]); w.z = cvtpk(v1[0], v1[1]); w.w = cvtpk(v1[2], v1[3]);
                    *(u32x4*)(rp + bj * 128) = w; } }
    }
};
struct EpiUp {
    bf16_t* HB;
    __device__ __forceinline__ void pre(const pg8::Unit&, LAS unsigned char*, int, int, int) const {}
    __device__ __forceinline__ void operator()(const f32x4 (&acc)[2][2][4][2], const pg8::Unit& u, int wr, int wc, int fr, int fq, int par) const {
        asm volatile("" : "+v"(fr), "+v"(fq));
        const int row0 = u.pm * 256 + wr * 64 + fr, col0 = (u.pn * 256 + wc * 32 + 8 * fq) >> 1;
#pragma unroll
        for (int ai = 0; ai < 2; ++ai)
#pragma unroll
            for (int m = 0; m < 4; ++m) { bf16_t* rp = HB + (size_t)(row0 + ai * 128 + m * 16) * EFF + col0;
#pragma unroll
                for (int bj = 0; bj < 2; ++bj) { const f32x4 a1 = acc[ai][bj][m][0], a3 = acc[ai][bj][m][1];
                    u32x2 w; w.x = cvtpk(silu_f(a1[0]) * a3[0], silu_f(a1[1]) * a3[1]); w.y = cvtpk(silu_f(a1[2]) * a3[2], silu_f(a1[3]) * a3[3]);
                    *(u32x2*)(rp + bj * 64) = w; } }
    }
};

struct EpiUpI8 {
    bf16_t* HB; const float* SAL; const float* SB; const LAS int* tstart; LAS unsigned char* lds;
    __device__ __forceinline__ void pre(const pg8::Unit& u, LAS unsigned char* l, int wid, int lane, int par) const {
        if (wid == 0) { const int mt = u.pm - tstart[u.e];
            __builtin_amdgcn_global_load_lds((const unsigned*)(SAL + (size_t)u.e * 65536 + mt * 256 + lane * 4), (LAS unsigned*)(l + EPI_SC + par * 2048), 16, 0, 0);
            __builtin_amdgcn_global_load_lds((const unsigned*)(SB + (size_t)u.e * 1024 + u.pn * 256 + lane * 4), (LAS unsigned*)(l + EPI_SC + par * 2048 + 1024), 16, 0, 0); } }
    __device__ __forceinline__ void operator()(const i32x4 (&acc)[2][2][4][2], const pg8::Unit& u, int wr, int wc, int fr, int fq, int par) const {
        asm volatile("" : "+v"(fr), "+v"(fq));
        const int rl0 = wr * 64 + fr, row0 = u.pm * 256 + rl0, colp = u.pn * 256 + wc * 32 + 8 * fq, col0 = colp >> 1;
        LAS const float* LSA = (LAS const float*)(lds + EPI_SC + par * 2048); LAS const float* LSB = LSA + 256;
        f32x4 sb[2][2];
#pragma unroll
        for (int bj = 0; bj < 2; ++bj)
#pragma unroll
            for (int n = 0; n < 2; ++n) sb[bj][n] = *(LAS const f32x4*)(LSB + wc * 32 + 8 * fq + bj * 128 + 4 * n);
#pragma unroll
        for (int ai = 0; ai < 2; ++ai)
#pragma unroll
            for (int m = 0; m < 4; ++m) { const int R = rl0 + ai * 128 + m * 16; const float sa = LSA[R];
                bf16_t* rp = HB + (size_t)(row0 + ai * 128 + m * 16) * EFF + (col0 & ~7) + 64 * (fq & 1);
                u32x2 wv[2];
#pragma unroll
                for (int bj = 0; bj < 2; ++bj) { const i32x4 i1 = acc[ai][bj][m][0], i3 = acc[ai][bj][m][1];
                    f32x4 a1, a3;
#pragma unroll
                    for (int i = 0; i < 4; ++i) { a1[i] = (float)i1[i] * sa * sb[bj][0][i]; a3[i] = (float)i3[i] * sa * sb[bj][1][i]; }
                    wv[bj].x = cvtpk(silu_f(a1[0]) * a3[0], silu_f(a1[1]) * a3[1]); wv[bj].y = cvtpk(silu_f(a1[2]) * a3[2], silu_f(a1[3]) * a3[3]); }
                *(u32x4*)rp = widen_rows16(wv[0], wv[1]); }
    }
};

template <class RM>
__device__ __forceinline__ void transpose_item(const float* W, int N, bf16_t* WT, int Kd, LAS float* scr, int k0, int n0, int lane, const RM& rm) {
#pragma unroll
    for (int i = 0; i < 8; ++i) { const int kk = 8 * i + (lane >> 3); const f32x4 w4 = *(const f32x4*)(W + (size_t)(k0 + kk) * N + n0 + 4 * (lane & 7));
        LAS float* d = scr + kk * 33 + 4 * (lane & 7); d[0] = w4[0]; d[1] = w4[1]; d[2] = w4[2]; d[3] = w4[3]; }
    asm volatile("s_waitcnt lgkmcnt(0)" ::: "memory");
    const int c = lane & 7;
#pragma unroll
    for (int j = 0; j < 4; ++j) { const int n = (lane >> 3) + 8 * j; const LAS float* s = scr + (8 * c) * 33 + n;
        u32x4 o; o.x = cvtpk(s[0 * 33], s[1 * 33]); o.y = cvtpk(s[2 * 33], s[3 * 33]); o.z = cvtpk(s[4 * 33], s[5 * 33]); o.w = cvtpk(s[6 * 33], s[7 * 33]);
        *(u32x4*)(WT + (size_t)rm(n0 + n) * Kd + k0 + 8 * c) = o; }
    asm volatile("s_waitcnt lgkmcnt(0)" ::: "memory");
}
struct RmId { int off; __device__ __forceinline__ int operator()(int n) const { return off + n; } };
__device__ __forceinline__ int rope_pl(int d) { return 8 * ((d & 31) >> 2) + 4 * (d >> 5) + (d & 3); }
struct RmWin {
    __device__ __forceinline__ int operator()(int c) const {
        if (c < 2048) return c;
        if (c < 2052) return 3328 + (c - 2048);
        if (c < 2056) return 3332 + (c - 2052);
        if (c < 2568) { const int x = c - 2056; return 2048 + (x & ~63) + rope_pl(x & 63); }
        if (c < 2696) { const int x = c - 2568; return 2560 + (x & ~63) + rope_pl(x & 63); }
        if (c < 2824) return 2688 + (c - 2696);
        if (c < 2952) { const int x = c - 2824; return 2816 + (x & ~63) + rope_pl(x & 63); }
        if (c < 3080) return 2944 + (c - 2952);
        if (c < 3208) { const int x = c - 3080; return 3072 + (x & ~63) + rope_pl(x & 63); }
        if (c < 3336) return 3200 + (c - 3208);
        return c;
    }
};
struct RmW13 { int sel; __device__ __forceinline__ int operator()(int j) const { return 8 * (j >> 2) + 4 * sel + (j & 3); } };

__device__ __forceinline__ void p0_phase(Frame& F) {
    const int tid = F.tid, lane = F.lane;
    const int NA = F.G > 64 ? 64 : F.G;
    const bool split = F.G > NA;
    if (F.vcu < NA) {
        LAS float* sc = (LAS float*)F.lds; LAS float* red = (LAS float*)(F.lds + 32768);
        const float* c = IN_F(1);
        for (int i = tid; i < 8192; i += NTHR) sc[i] = silu_f(c[i]);
        __syncthreads();
        const float* W = IN_F(3); const float* bia = IN_F(4); float* mod = WSP(float, WS_MOD);
        for (int cg = F.vcu; cg < 64; cg += NA) {
            const int col0 = cg * 96;
            const int kq = tid / 24, cq = tid % 24;
            f32x4 a[8];
#pragma unroll
            for (int b = 0; b < 8; ++b) a[b] = (f32x4){0.f, 0.f, 0.f, 0.f};
            if (tid < 504) {
#pragma unroll 4
                for (int k = kq; k < 1024; k += 21) { const f32x4 w = *(const f32x4*)(W + (size_t)k * 6144 + col0 + 4 * cq);
#pragma unroll
                    for (int b = 0; b < 8; ++b) a[b] += w * sc[b * 1024 + k]; }
#pragma unroll
                for (int b = 0; b < 8; ++b) *(LAS f32x4*)(red + (size_t)(tid * 8 + b) * 4) = a[b];
            }
            __syncthreads();
            for (int o = tid; o < 768; o += NTHR) { const int cq2 = o >> 5, bj = o & 31;
                float sacc = 0.f;
                for (int q = 0; q < 21; ++q) sacc += red[(size_t)((q * 24 + cq2) * 8) * 4 + bj];
                const int col = col0 + 4 * cq2 + (bj & 3);
                mod[(bj >> 2) * 6144 + col] = sacc + bia[col]; }
            __syncthreads();
        }
    }
    if (!split || F.vcu >= NA) {
        LAS float* scr = (LAS float*)(F.lds + F.wave * 8448);
        const int gw = (split ? F.vcu - NA : F.vcu) * NWAVES + F.wave, NGW = (split ? F.G - NA : F.G) * NWAVES;
        constexpr int I_WOUT = 16 * 32, I_C1 = 32 * 4, I_C2 = 2 * 2;
        constexpr int NITEMS = I_WOUT + 2 * I_C1 + 2 * I_C2;
        for (int it = gw; it < NITEMS; it += NGW) {
            int r = it;
            if (r < I_WOUT) { transpose_item(IN_F(19), 1024, WSP(bf16_t, WS_WOUTT), 1024, scr, (r / 32) * 64, (r % 32) * 32, lane, RmId{0}); continue; } r -= I_WOUT;
            if (r < I_C1) { transpose_item(IN_F(14), 128, WSP(bf16_t, WS_CW1K), 2048, scr, (r / 4) * 64, (r % 4) * 32, lane, RmId{0}); continue; } r -= I_C1;
            if (r < I_C1) { transpose_item(IN_F(17), 128, WSP(bf16_t, WS_CW1V), 2048, scr, (r / 4) * 64, (r % 4) * 32, lane, RmId{0}); continue; } r -= I_C1;
            if (r < I_C2) { transpose_item(IN_F(15), 64, WSP(bf16_t, WS_CW2K), 128, scr, (r / 2) * 64, (r % 2) * 32, lane, RmId{0}); continue; } r -= I_C2;
            transpose_item(IN_F(18), 64, WSP(bf16_t, WS_CW2V), 128, scr, (r / 2) * 64, (r % 2) * 32, lane, RmId{0});
        }
    }
    __syncthreads();
    {
        LAS unsigned* AM = (LAS unsigned*)F.lds; const int n4 = tid & 7, kq = tid >> 3; const RmWin rmw{};
        for (int it = (F.vcu + F.G - (split ? NA : 0)) % F.G; it < 105; it += F.G) {
            const int c0 = 32 * it + 4 * n4; const float* W = IN_F(9) + (size_t)(16 * kq) * INW + c0;
            if (tid < 32) AM[tid] = 0u;
            __syncthreads();
            f32x4 v[16]; f32x4 am = {0.f, 0.f, 0.f, 0.f};
#pragma unroll
            for (int i = 0; i < 16; ++i) { v[i] = *(const f32x4*)(W + (size_t)i * INW);
#pragma unroll
                for (int c = 0; c < 4; ++c) am[c] = fmaxf(am[c], fabsf(v[i][c])); }
#pragma unroll
            for (int o = 8; o < 64; o <<= 1) {
#pragma unroll
                for (int c = 0; c < 4; ++c) am[c] = fmaxf(am[c], __shfl_xor(am[c], o)); }
            if ((tid & 63) < 8) {
#pragma unroll
                for (int c = 0; c < 4; ++c) atomicMax((unsigned*)&AM[4 * n4 + c], __float_as_uint(am[c])); }
            __syncthreads();
            const f32x4 amax = *(LAS const f32x4*)((LAS const float*)AM + 4 * n4);
#pragma unroll
            for (int c = 0; c < 4; ++c) { const float inv = amax[c] > 0.f ? 127.f / amax[c] : 0.f; const int prow = rmw(c0 + c); u32x4 o;
#pragma unroll
                for (int d = 0; d < 4; ++d) {
                    const int q0 = (int)rintf(v[4 * d][c] * inv), q1 = (int)rintf(v[4 * d + 1][c] * inv), q2 = (int)rintf(v[4 * d + 2][c] * inv), q3 = (int)rintf(v[4 * d + 3][c] * inv);
                    o[d] = (unsigned)(q0 & 0xff) | ((unsigned)(q1 & 0xff) << 8) | ((unsigned)(q2 & 0xff) << 16) | ((unsigned)(q3 & 0xff) << 24); }
                *(u32x4*)((unsigned char*)(F.ws + WS_WINT) + (size_t)prow * 1024 + 16 * kq) = o;
                if (kq == 0) WSP(float, WS_SBW)[prow] = amax[c] * (1.f / 127.f); }
            __syncthreads();
        }
    }
    if (!split || F.vcu >= NA) {
        const size_t gt = (size_t)(split ? F.vcu - NA : F.vcu) * NTHR + tid, NGT_ = (size_t)(split ? F.G - NA : F.G) * NTHR;
        const int* pos = (const int*)F.in[2]; float* COS = WSP(float, WS_COS); float* SIN = WSP(float, WS_SIN);
        {
            const int d = (int)(gt & 31); const float inv = powf(10000.f, -(float)d / 32.f);
            for (size_t i = gt; i < (size_t)NTOK * 32; i += NGT_) { const int row = (int)(i >> 5);
                const float ang = (float)pos[row] * inv; const float kk = rintf(ang * 0.15915494309189535f);
                float r = fmaf(-kk, 6.28125f, ang); r = fmaf(-kk, 1.9353071795864769e-3f, r);
                const float sn = __sinf(r), cs = __cosf(r); COS[i] = cs; SIN[i] = sn; } }
        { unsigned* z = (unsigned*)(F.ws + WS_WINT + (size_t)3360 * 1024); for (size_t i = gt; i < (size_t)224 * 256; i += NGT_) z[i] = 0u;
          for (size_t i = gt; i < 224; i += NGT_) WSP(float, WS_SBW)[3360 + i] = 0.f; }
        { const float* wg = IN_F(20); const float* we = IN_F(22); _Float16* RWT = WSP(_Float16, WS_RWT);
          for (size_t i = gt; i < 48 * 1024; i += NGT_) { const int n = (int)(i >> 10), k = (int)(i & 1023);
              const float w = n < 4 ? wg[k * 4 + n] : n < 36 ? we[k * 32 + n - 4] : 0.f; RWT[i] = (_Float16)w; } }
        { bf16_t* kc = WSP(bf16_t, WS_KCMP); bf16_t* vc = WSP(bf16_t, WS_VCMP);
          for (size_t i = gt; i < 16 * 64; i += NGT_) { const size_t o = ((i >> 6) * 256 + 255) * 64 + (i & 63); kc[o] = 0; vc[o] = 0; } }
    }
    __syncthreads();
    if (F.vcu >= F.G - 16) {
        const int bi = F.vcu - (F.G - 16), kv = bi >> 3, cg = bi & 7;
        const float* pe = IN_F(kv == 0 ? 13 : 16); const float* w1 = IN_F(kv == 0 ? 14 : 17);
        LAS float* red = (LAS float*)F.lds;
        const int col = cg * 16 + (tid & 15), sl = tid >> 4; float sacc = 0.f;
#pragma unroll 8
        for (int k = sl * 64; k < sl * 64 + 64; ++k) sacc += pe[k] * w1[(size_t)k * 128 + col];
        red[tid] = sacc; __syncthreads();
        if (tid < 16) { float t2 = 0.f; for (int q = 0; q < 32; ++q) t2 += red[q * 16 + tid]; WSP(float, WS_C1B)[kv * 128 + cg * 16 + tid] = t2; }
    }
    __syncthreads();
}

__device__ __forceinline__ void p1a_phase(Frame& F) {
    const int gw = F.vcu * NWAVES + F.wave, NGW = F.G * NWAVES, lane = F.lane;
    const float* x = IN_F(0); const float* nw = IN_F(5); const float* mod = WSP(float, WS_MOD); signed char* H1Q = (signed char*)(F.ws + WS_H1);
    for (int row0 = gw * 4; row0 < NTOK; row0 += NGW * 4) {
        f32x4 v[4][4]; float ss[4];
#pragma unroll
        for (int r = 0; r < 4; ++r) { const f32x4* xr = (const f32x4*)(x + (size_t)(row0 + r) * DM) + lane;
#pragma unroll
            for (int j = 0; j < 4; ++j) v[r][j] = __builtin_nontemporal_load(xr + 64 * j); }
#pragma unroll
        for (int r = 0; r < 4; ++r) { float a = 0.f;
#pragma unroll
            for (int j = 0; j < 4; ++j) a += v[r][j][0] * v[r][j][0] + v[r][j][1] * v[r][j][1] + v[r][j][2] * v[r][j][2] + v[r][j][3] * v[r][j][3];
            ss[r] = a; }
#pragma unroll
        for (int o = 1; o < 64; o <<= 1) {
#pragma unroll
            for (int r = 0; r < 4; ++r) ss[r] += __shfl_xor(ss[r], o); }
        const int b = row0 >> 12; float am[4] = {0.f, 0.f, 0.f, 0.f};
#pragma unroll
        for (int j = 0; j < 4; ++j) { const int k = 4 * lane + 256 * j;
            const f32x4 w = *(const f32x4*)(nw + k), sh = *(const f32x4*)(mod + b * 6144 + k), sc = *(const f32x4*)(mod + b * 6144 + 1024 + k);
            const f32x4 ws = w * (sc + 1.f);
#pragma unroll
            for (int r = 0; r < 4; ++r) { const float rr = rsqrtf(ss[r] * (1.f / DM) + RMS_EPS);
                const f32x4 h = v[r][j] * rr * ws + sh; v[r][j] = h;
                am[r] = fmaxf(am[r], fmaxf(fmaxf(fabsf(h[0]), fabsf(h[1])), fmaxf(fabsf(h[2]), fabsf(h[3])))); } }
#pragma unroll
        for (int o = 1; o < 64; o <<= 1) {
#pragma unroll
            for (int r = 0; r < 4; ++r) am[r] = fmaxf(am[r], __shfl_xor(am[r], o)); }
#pragma unroll
        for (int r = 0; r < 4; ++r) { const float inv = am[r] > 0.f ? 127.f / am[r] : 0.f;
            if (lane == 0) WSP(float, WS_SA1)[row0 + r] = am[r] * (1.f / 127.f);
            u32x4 pk;
#pragma unroll
            for (int j = 0; j < 4; ++j) { const f32x4 q = v[r][j] * inv;
                const int q0 = (int)rintf(q[0]), q1 = (int)rintf(q[1]), q2 = (int)rintf(q[2]), q3 = (int)rintf(q[3]);
                pk[j] = (unsigned)(q0 & 0xff) | ((unsigned)(q1 & 0xff) << 8) | ((unsigned)(q2 & 0xff) << 16) | ((unsigned)(q3 & 0xff) << 24); }
            *(u32x4*)(H1Q + (size_t)(row0 + r) * DM + 256 * (lane & 3) + 16 * (lane >> 2)) = quad_transpose(pk, lane); }
    }
}

__device__ __forceinline__ void conv_silu16(const bf16_t* src  , const float* cw  , int b, int s, int ch0  , float scale, float (&o)[16]) {
#pragma unroll
    for (int i = 0; i < 16; ++i) o[i] = 0.f;
#pragma unroll
    for (int j = 0; j < 4; ++j) { const int ss = s - 3 + j;
        if (ss >= 0) { const bf16_t* rp = src + ((size_t)b * SEQ + ss) * 512 + ch0;
            const u32x4 a = *(const u32x4*)rp, c = *(const u32x4*)(rp + 8);
            const float* w = cw + j * 1024;
            const f32x4 w0 = *(const f32x4*)w, w1 = *(const f32x4*)(w + 4), w2 = *(const f32x4*)(w + 8), w3 = *(const f32x4*)(w + 12);
            o[0] += bflo(a.x) * w0[0]; o[1] += bfhi(a.x) * w0[1]; o[2] += bflo(a.y) * w0[2]; o[3] += bfhi(a.y) * w0[3];
            o[4] += bflo(a.z) * w1[0]; o[5] += bfhi(a.z) * w1[1]; o[6] += bflo(a.w) * w1[2]; o[7] += bfhi(a.w) * w1[3];
            o[8] += bflo(c.x) * w2[0]; o[9] += bfhi(c.x) * w2[1]; o[10] += bflo(c.y) * w2[2]; o[11] += bfhi(c.y) * w2[3];
            o[12] += bflo(c.z) * w3[0]; o[13] += bfhi(c.z) * w3[1]; o[14] += bflo(c.w) * w3[2]; o[15] += bfhi(c.w) * w3[3]; } }
#pragma unroll
    for (int i = 0; i < 16; ++i) o[i] = silu_f(o[i]) * scale;
}
constexpr int RAWS = 272, RAWIMG = 67 * RAWS + 208;
__device__ __forceinline__ void stage_raw(const bf16_t* src, int b, int s0, int h, LAS unsigned char* RAW, int tid) {
    const int s = tid >> 3, chg = tid & 7;
    const bf16_t* rp = src + ((size_t)b * SEQ + s0 + s) * 512 + h * 128 + chg * 16;
    *(LAS u32x4*)(RAW + (s + 3) * RAWS + chg * 32) = *(const u32x4*)rp; *(LAS u32x4*)(RAW + (s + 3) * RAWS + chg * 32 + 16) = *(const u32x4*)(rp + 8);
    if (s < 3) { u32x4 a = {0u, 0u, 0u, 0u}, c = a; const int ss = s0 - 3 + s;
        if (ss >= 0) { const bf16_t* hp = src + ((size_t)b * SEQ + ss) * 512 + h * 128 + chg * 16; a = *(const u32x4*)hp; c = *(const u32x4*)(hp + 8); }
        *(LAS u32x4*)(RAW + s * RAWS + chg * 32) = a; *(LAS u32x4*)(RAW + s * RAWS + chg * 32 + 16) = c; }
}
__device__ __forceinline__ void conv_lds16(LAS const unsigned char* RAW, LAS const float* WL, int s, int ch0, float scale, float (&o)[16]) {
#pragma unroll
    for (int i = 0; i < 16; ++i) o[i] = 0.f;
#pragma unroll
    for (int j = 0; j < 4; ++j) { const u32x4 a = *(LAS const u32x4*)(RAW + (s + j) * RAWS + ch0 * 2), c = *(LAS const u32x4*)(RAW + (s + j) * RAWS + ch0 * 2 + 16);
        const LAS float* w = WL + j * 128 + ch0;
        const f32x4 w0 = *(LAS const f32x4*)w, w1 = *(LAS const f32x4*)(w + 4), w2 = *(LAS const f32x4*)(w + 8), w3 = *(LAS const f32x4*)(w + 12);
        o[0] += bflo(a.x) * w0[0]; o[1] += bfhi(a.x) * w0[1]; o[2] += bflo(a.y) * w0[2]; o[3] += bfhi(a.y) * w0[3];
        o[4] += bflo(a.z) * w1[0]; o[5] += bfhi(a.z) * w1[1]; o[6] += bflo(a.w) * w1[2]; o[7] += bfhi(a.w) * w1[3];
        o[8] += bflo(c.x) * w2[0]; o[9] += bfhi(c.x) * w2[1]; o[10] += bflo(c.y) * w2[2]; o[11] += bfhi(c.y) * w2[3];
        o[12] += bflo(c.z) * w3[0]; o[13] += bfhi(c.z) * w3[1]; o[14] += bflo(c.w) * w3[2]; o[15] += bfhi(c.w) * w3[3]; }
#pragma unroll
    for (int i = 0; i < 16; ++i) o[i] = silu_f(o[i]) * scale;
}
constexpr int TRT = 4096 + 64, RCH = 1024 + 16;
constexpr int TRIMG = 4 * TRT, ROWIMG = 16 * RCH;
__device__ __forceinline__ unsigned tr_lane_off(int lane) { const int hi = lane >> 5; return ((lane >> 4) & 1) * 32 + (lane & 3) * 8 + (4 * hi + ((lane & 15) >> 2)) * 64; }

#if DBG_CHECK == 2
#define DBGF(code, val) do { const float _v = (val); if ((__float_as_uint(_v) & 0x7f800000u) == 0x7f800000u) atomicMin((unsigned*)(F.ws + WS_CTL) + CW_DBG, (unsigned)(code)); } while (0)
#else
#define DBGF(code, val) do {} while (0)
#endif
struct MaPF { u32x4 k0, k1, v0, v1, hk0, hk1; float wk, g0, g1; };
__device__ __forceinline__ void mlstm_a_load(Frame& F, int job, int tid, MaPF& pf) {
    const int lane = tid & 63, w = F.wave;
    const int bh = job >> 6, c = job & 63, b = bh >> 2, h = bh & 3, s0 = c * 64, s = tid >> 3, chg = tid & 7;
    const size_t ro = ((size_t)b * SEQ + s0 + s) * 512 + h * 128 + chg * 16;
    const bf16_t* kp = WSP(bf16_t, WS_MK) + ro; const bf16_t* vp = WSP(bf16_t, WS_MV) + ro;
    pf.k0 = *(const u32x4*)kp; pf.k1 = *(const u32x4*)(kp + 8); pf.v0 = *(const u32x4*)vp; pf.v1 = *(const u32x4*)(vp + 8);
    pf.hk0 = (u32x4){0u, 0u, 0u, 0u}; pf.hk1 = pf.hk0;
    if (s < 3 && s0 - 3 + s >= 0) { const bf16_t* hp = WSP(bf16_t, WS_MK) + ((size_t)b * SEQ + s0 - 3 + s) * 512 + h * 128 + chg * 16; pf.hk0 = *(const u32x4*)hp; pf.hk1 = *(const u32x4*)(hp + 8); }
    pf.wk = IN_F(10)[(tid >> 7) * 1024 + 512 + h * 128 + (tid & 127)];
    pf.g0 = 0.f; pf.g1 = 0.f;
    if (w == 0) { pf.g0 = WSP(float, WS_GF)[(size_t)bh * SEQ + s0 + lane]; pf.g1 = WSP(float, WS_GI)[(size_t)bh * SEQ + s0 + lane]; }
}
__device__ __forceinline__ void mlstm_a_phase(Frame& F) {
    int tid = F.tid; asm volatile("" : "+v"(tid));
    const int lane = tid & 63, w = F.wave, r32 = lane & 31, hi = lane >> 5;
    LAS unsigned char* kimg = F.lds; LAS unsigned char* vimg = F.lds + TRIMG; LAS float* wS = (LAS float*)(F.lds + 2 * TRIMG);
    LAS unsigned char* RAWK = F.lds + 2 * TRIMG + 1024; LAS float* WLK = (LAS float*)(RAWK + RAWIMG);
    LAS bf16_t* OST = (LAS bf16_t*)(F.lds + 2 * TRIMG + 1024 + RAWIMG + 2048) + w * 2048;
    MaPF pf; int job = F.vcu;
    if (job < 2048) mlstm_a_load(F, job, tid, pf);
    for (; job < 2048; job += F.G) {
        {
            const int s = tid >> 3, chg = tid & 7;
            *(LAS u32x4*)(RAWK + (s + 3) * RAWS + chg * 32) = pf.k0; *(LAS u32x4*)(RAWK + (s + 3) * RAWS + chg * 32 + 16) = pf.k1;
            if (s < 3) { *(LAS u32x4*)(RAWK + s * RAWS + chg * 32) = pf.hk0; *(LAS u32x4*)(RAWK + s * RAWS + chg * 32 + 16) = pf.hk1; }
            WLK[tid] = pf.wk;
            if (w == 0) {
                const float bs = wave_scan_add(pf.g0);
                const float g = __int_as_float(__builtin_amdgcn_readlane(__float_as_int(bs), 63));
                const float a = g - bs + pf.g1; const float ml = wave_max(a);
                wS[lane] = __expf(a - ml);
                if (lane == 0) { WSP(float, WS_GSUM)[job] = g; WSP(float, WS_MLOC)[job] = ml; }
            }
        }
        const u32x4 va = pf.v0, vd = pf.v1;
        __syncthreads();
        if (job + F.G < 2048) mlstm_a_load(F, job + F.G, tid, pf);
        {
            const int s = tid >> 3, chg = tid & 7, ch0 = chg * 16;
            float kf[16]; conv_lds16(RAWK, WLK, s, ch0, 0.08838834764831845f, kf);
            const unsigned off = (ch0 >> 5) * TRT + s * 64 + (ch0 & 31) * 2;
            u32x4 k0, k1; k0.x = cvtpk(kf[0], kf[1]); k0.y = cvtpk(kf[2], kf[3]); k0.z = cvtpk(kf[4], kf[5]); k0.w = cvtpk(kf[6], kf[7]);
            k1.x = cvtpk(kf[8], kf[9]); k1.y = cvtpk(kf[10], kf[11]); k1.z = cvtpk(kf[12], kf[13]); k1.w = cvtpk(kf[14], kf[15]);
            *(LAS u32x4*)(kimg + off) = k0; *(LAS u32x4*)(kimg + off + 16) = k1;
            const float ws = wS[s];
            u32x4 v0, v1;
            v0.x = cvtpk(bflo(va.x) * ws, bfhi(va.x) * ws); v0.y = cvtpk(bflo(va.y) * ws, bfhi(va.y) * ws); v0.z = cvtpk(bflo(va.z) * ws, bfhi(va.z) * ws); v0.w = cvtpk(bflo(va.w) * ws, bfhi(va.w) * ws);
            v1.x = cvtpk(bflo(vd.x) * ws, bfhi(vd.x) * ws); v1.y = cvtpk(bflo(vd.y) * ws, bfhi(vd.y) * ws); v1.z = cvtpk(bflo(vd.z) * ws, bfhi(vd.z) * ws); v1.w = cvtpk(bflo(vd.w) * ws, bfhi(vd.w) * ws);
            *(LAS u32x4*)(vimg + off) = v0; *(LAS u32x4*)(vimg + off + 16) = v1;
        }
        __syncthreads();
        {
            const int et = w >> 1, dt0 = 2 * (w & 1); const unsigned lo = tr_lane_off(lane);
            f32x16 acc0 = {0}, acc1 = {0};
#pragma unroll
            for (int ks = 0; ks < 4; ++ks) {
                const bf16x8 a = mk8(vtr(vimg + et * TRT + ks * 1024 + lo), vtr(vimg + et * TRT + ks * 1024 + lo + 512));
                const bf16x8 b0 = mk8(vtr(kimg + dt0 * TRT + ks * 1024 + lo), vtr(kimg + dt0 * TRT + ks * 1024 + lo + 512));
                const bf16x8 b1 = mk8(vtr(kimg + (dt0 + 1) * TRT + ks * 1024 + lo), vtr(kimg + (dt0 + 1) * TRT + ks * 1024 + lo + 512));
                acc0 = MFMA32(a, b0, acc0); acc1 = MFMA32(a, b1, acc1);
            }
#pragma unroll
            for (int r = 0; r < 16; ++r) { const int el = crow(r, hi); OST[el * 64 + r32] = f2bf(acc0[r]); OST[el * 64 + 32 + r32] = f2bf(acc1[r]); }
            asm volatile("s_waitcnt lgkmcnt(0)" ::: "memory");
            bf16_t* dst = WSP(bf16_t, WS_KVC) + (size_t)job * 16384 + (size_t)(et * 32) * 128 + dt0 * 32;
#pragma unroll
            for (int i = 0; i < 4; ++i) { const int rw = i * 8 + (lane >> 3), ch = lane & 7; *(u32x4*)(dst + (size_t)rw * 128 + ch * 8) = *(LAS const u32x4*)(OST + rw * 64 + ch * 8); }
        }
        if (tid < 128) {
            float sacc = 0.f; const int d = tid;
            for (int ss = 0; ss < 64; ++ss) sacc += wS[ss] * bf2f(*(LAS const bf16_t*)(kimg + (d >> 5) * TRT + ss * 64 + (d & 31) * 2));
            WSP(float, WS_NC)[(size_t)job * 128 + d] = sacc;
        }
        __syncthreads();
    }
}

__device__ __forceinline__ void mlstm_scan_job(Frame& F, int job) {
    int tid = F.tid; asm volatile("" : "+v"(tid));
    const int bh = job >> 3, sl = job & 7;
    LAS float* aold = (LAS float*)F.lds; LAS float* anew = aold + 64; LAS float* gS = aold + 128; LAS float* mS = aold + 192;
    if (tid < 64) { gS[tid] = WSP(float, WS_GSUM)[bh * 64 + tid]; mS[tid] = WSP(float, WS_MLOC)[bh * 64 + tid]; }
    __syncthreads();
    if (tid == 0) {
        float m = 0.f;
        for (int c = 0; c < 64; ++c) { const float g = gS[c], ml = mS[c];
            const float mn = fmaxf(g + m, ml); aold[c] = __expf(g + m - mn); anew[c] = __expf(ml - mn);
            gS[c] = m;
            m = mn; }
    }
    __syncthreads();
    if (sl == 0 && tid < 64) WSP(float, WS_MPREV)[bh * 64 + tid] = gS[tid];
    const size_t base = (size_t)bh * 64 * 16384 + (size_t)sl * 2048 + tid * 4;
    const bf16_t* kv = WSP(bf16_t, WS_KVC) + base; bf16_t* cp = WSP(bf16_t, WS_CPREV) + base;
    f32x4 C = {0.f, 0.f, 0.f, 0.f};
#pragma unroll 8
    for (int c = 0; c < 64; ++c) {
        const u32x2 k = *(const u32x2*)(kv + (size_t)c * 16384);
        u32x2 o; o.x = cvtpk(C[0], C[1]); o.y = cvtpk(C[2], C[3]); *(u32x2*)(cp + (size_t)c * 16384) = o;
        const float ao = aold[c], an = anew[c]; DBGF(22, ao); DBGF(23, an); DBGF(24, bflo(k.x)); DBGF(24, bfhi(k.x)); DBGF(24, bflo(k.y)); DBGF(24, bfhi(k.y)); DBGF(25, C[0]);
        C[0] = ao * C[0] + an * bflo(k.x); C[1] = ao * C[1] + an * bfhi(k.x); C[2] = ao * C[2] + an * bflo(k.y); C[3] = ao * C[3] + an * bfhi(k.y);
    }
    if (sl == 0 && tid < 128) {
        float n = 0.f;
        for (int c0 = 0; c0 < 64; c0 += 16) { float nc[16];
#pragma unroll
            for (int i = 0; i < 16; ++i) nc[i] = WSP(float, WS_NC)[(size_t)(bh * 64 + c0 + i) * 128 + tid];
#pragma unroll
            for (int i = 0; i < 16; ++i) { WSP(float, WS_NPREV)[(size_t)(bh * 64 + c0 + i) * 128 + tid] = n; n = aold[c0 + i] * n + anew[c0 + i] * nc[i]; } }
    }
    __syncthreads();
}

struct McPF { u32x4 q0, q1, k0, k1, v0, v1, hq0, hq1, hk0, hk1; float wq, wk, g0, g1, mprev; u32x2 mo[4]; };
__device__ __forceinline__ void mlstm_c_load(Frame& F, int job, int tid, McPF& pf) {
    const int lane = tid & 63, w = F.wave, r32 = lane & 31, hi = lane >> 5;
    const int bh = job >> 6, c = job & 63, b = bh >> 2, h = bh & 3, s0 = c * 64, s = tid >> 3, chg = tid & 7;
    const size_t ro = ((size_t)b * SEQ + s0 + s) * 512 + h * 128 + chg * 16;
    const bf16_t* qp = WSP(bf16_t, WS_MQ) + ro; const bf16_t* kp = WSP(bf16_t, WS_MK) + ro; const bf16_t* vp = WSP(bf16_t, WS_MV) + ro;
    pf.q0 = *(const u32x4*)qp; pf.q1 = *(const u32x4*)(qp + 8); pf.k0 = *(const u32x4*)kp; pf.k1 = *(const u32x4*)(kp + 8); pf.v0 = *(const u32x4*)vp; pf.v1 = *(const u32x4*)(vp + 8);
    pf.hq0 = (u32x4){0u, 0u, 0u, 0u}; pf.hq1 = pf.hq0; pf.hk0 = pf.hq0; pf.hk1 = pf.hq0;
    if (s < 3 && s0 - 3 + s >= 0) { const size_t ho = ((size_t)b * SEQ + s0 - 3 + s) * 512 + h * 128 + chg * 16;
        pf.hq0 = *(const u32x4*)(WSP(bf16_t, WS_MQ) + ho); pf.hq1 = *(const u32x4*)(WSP(bf16_t, WS_MQ) + ho + 8); pf.hk0 = *(const u32x4*)(WSP(bf16_t, WS_MK) + ho); pf.hk1 = *(const u32x4*)(WSP(bf16_t, WS_MK) + ho + 8); }
    pf.wq = IN_F(10)[(tid >> 7) * 1024 + h * 128 + (tid & 127)]; pf.wk = IN_F(10)[(tid >> 7) * 1024 + 512 + h * 128 + (tid & 127)];
    pf.g0 = 0.f; pf.g1 = 0.f;
    if (w == 0) { pf.g0 = WSP(float, WS_GF)[(size_t)bh * SEQ + s0 + lane]; pf.g1 = WSP(float, WS_GI)[(size_t)bh * SEQ + s0 + lane]; }
    if (w == 1) { pf.g0 = WSP(float, WS_NPREV)[(size_t)job * 128 + lane]; pf.g1 = WSP(float, WS_NPREV)[(size_t)job * 128 + 64 + lane]; }
    pf.mprev = WSP(float, WS_MPREV)[job];
    const int tw = w & 1, ew = w >> 1, t = 32 * tw + r32;
    const bf16_t* mo = WSP(bf16_t, WS_MO) + ((size_t)b * SEQ + s0 + t) * 512 + h * 128 + 32 * ew + 4 * hi;
#pragma unroll
    for (int q4 = 0; q4 < 4; ++q4) pf.mo[q4] = *(const u32x2*)(mo + 8 * q4);
}
__device__ __forceinline__ void mlstm_c_phase(Frame& F) {
    int tid = F.tid; asm volatile("" : "+v"(tid));
    const int lane = tid & 63, w = F.wave, r32 = lane & 31, hi = lane >> 5;
    LAS unsigned char* qimg = F.lds; LAS unsigned char* kimg = F.lds + ROWIMG; LAS unsigned char* vimg = F.lds + 2 * ROWIMG;
    LAS float* uS = (LAS float*)(F.lds + 2 * ROWIMG + TRIMG); LAS float* MS = uS + 64; LAS float* bS = uS + 128; LAS float* nS = uS + 192; LAS float* ssq = uS + 320;
    LAS unsigned char* RAWQ = F.lds + 2 * ROWIMG + TRIMG + 4096; LAS unsigned char* RAWK = RAWQ + RAWIMG; LAS float* WLQ = (LAS float*)(RAWK + RAWIMG); LAS float* WLK = WLQ + 512;
    LAS float* HNL = (LAS float*)(F.lds + MISC_OFF + 2048);
    HNL[tid] = IN_F(12)[tid];
    const int tw = w & 1, ew = w >> 1, t = 32 * tw + r32;
    McPF pf;
    int job = F.vcu;
    if (job < 2048) mlstm_c_load(F, job, tid, pf);
    for (; job < 2048; job += F.G) {
        const int bh = job >> 6, c = job & 63, b = bh >> 2, h = bh & 3, s0 = c * 64;
        const float mprev = pf.mprev; u32x2 moc[4];
#pragma unroll
        for (int q4 = 0; q4 < 4; ++q4) moc[q4] = pf.mo[q4];
        {
            const int s = tid >> 3, chg = tid & 7, ch0 = chg * 16;
            *(LAS u32x4*)(RAWQ + (s + 3) * RAWS + chg * 32) = pf.q0; *(LAS u32x4*)(RAWQ + (s + 3) * RAWS + chg * 32 + 16) = pf.q1;
            *(LAS u32x4*)(RAWK + (s + 3) * RAWS + chg * 32) = pf.k0; *(LAS u32x4*)(RAWK + (s + 3) * RAWS + chg * 32 + 16) = pf.k1;
            if (s < 3) { *(LAS u32x4*)(RAWQ + s * RAWS + chg * 32) = pf.hq0; *(LAS u32x4*)(RAWQ + s * RAWS + chg * 32 + 16) = pf.hq1;
                         *(LAS u32x4*)(RAWK + s * RAWS + chg * 32) = pf.hk0; *(LAS u32x4*)(RAWK + s * RAWS + chg * 32 + 16) = pf.hk1; }
            WLQ[tid] = pf.wq; WLK[tid] = pf.wk;
            const unsigned off = (ch0 >> 5) * TRT + s * 64 + (ch0 & 31) * 2;
            *(LAS u32x4*)(vimg + off) = pf.v0; *(LAS u32x4*)(vimg + off + 16) = pf.v1;
            if (w == 0) {
                const float bs = wave_scan_add(pf.g0);
                const float u = pf.g1 - bs; const float cm = wave_scan_max(u);
                uS[lane] = u; MS[lane] = fmaxf(mprev, cm); bS[lane] = bs;
            }
            if (w == 1) { nS[lane] = pf.g0; nS[64 + lane] = pf.g1; }
        }
        __syncthreads();
        bf16x8 cf[8];
        { const bf16_t* cp = WSP(bf16_t, WS_CPREV) + (size_t)job * 16384 + (size_t)(32 * ew + r32) * 128 + 8 * hi;
#pragma unroll
          for (int ks = 0; ks < 8; ++ks) cf[ks] = *(const bf16x8*)(cp + 16 * ks); }
        if (job + F.G < 2048) mlstm_c_load(F, job + F.G, tid, pf);
        {
            const int s = tid >> 3, chg = tid & 7, ch0 = chg * 16;
            float qf[16]; conv_lds16(RAWQ, WLQ, s, ch0, 1.f, qf);
            u32x4 q0, q1; q0.x = cvtpk(qf[0], qf[1]); q0.y = cvtpk(qf[2], qf[3]); q0.z = cvtpk(qf[4], qf[5]); q0.w = cvtpk(qf[6], qf[7]);
            q1.x = cvtpk(qf[8], qf[9]); q1.y = cvtpk(qf[10], qf[11]); q1.z = cvtpk(qf[12], qf[13]); q1.w = cvtpk(qf[14], qf[15]);
            *(LAS u32x4*)(qimg + (2 * chg) * RCH + s * 16) = q0; *(LAS u32x4*)(qimg + (2 * chg + 1) * RCH + s * 16) = q1;
            float kf[16]; conv_lds16(RAWK, WLK, s, ch0, 0.08838834764831845f, kf);
            u32x4 k0, k1; k0.x = cvtpk(kf[0], kf[1]); k0.y = cvtpk(kf[2], kf[3]); k0.z = cvtpk(kf[4], kf[5]); k0.w = cvtpk(kf[6], kf[7]);
            k1.x = cvtpk(kf[8], kf[9]); k1.y = cvtpk(kf[10], kf[11]); k1.z = cvtpk(kf[12], kf[13]); k1.w = cvtpk(kf[14], kf[15]);
            *(LAS u32x4*)(kimg + (2 * chg) * RCH + s * 16) = k0; *(LAS u32x4*)(kimg + (2 * chg + 1) * RCH + s * 16) = k1;
        }
        __syncthreads();
        const float Mt = MS[t], bt = bS[t];
        const float dec = __expf(mprev - Mt), mt = bt + Mt;
        bf16x8 qf[8];
#pragma unroll
        for (int ks = 0; ks < 8; ++ks) qf[ks] = *(LAS const bf16x8*)(qimg + (2 * ks + hi) * RCH + t * 16);
        f32x16 p[2]; p[0] = (f32x16){0}; p[1] = (f32x16){0};
#pragma unroll
        for (int st = 0; st < 2; ++st) {
            if (st <= tw) {
#pragma unroll
                for (int ks = 0; ks < 8; ++ks) { const bf16x8 kf = *(LAS const bf16x8*)(kimg + (2 * ks + hi) * RCH + (32 * st + r32) * 16); p[st] = MFMA32(kf, qf[ks], p[st]); }
            }
        }
        float rs = 0.f;
#pragma unroll
        for (int st = 0; st < 2; ++st)
#pragma unroll
            for (int r = 0; r < 16; ++r) { const int s = 32 * st + crow(r, hi);
                const float wv = (s <= t) ? __expf(uS[s] - Mt) * p[st][r] : 0.f; p[st][r] = wv; rs += wv; }
        rs += __shfl_xor(rs, 32);
        float qn = 0.f;
#pragma unroll
        for (int ks = 0; ks < 8; ++ks)
#pragma unroll
            for (int j = 0; j < 8; ++j) qn += bf2f((bf16_t)qf[ks][j]) * nS[16 * ks + 8 * hi + j];
        qn += __shfl_xor(qn, 32);
        const float den = rs + dec * qn;
        const float hden = fmaxf(fabsf(den), __expf(-mt));
        f32x16 ai = {0}, ae = {0};
        const unsigned lo = tr_lane_off(lane);
#pragma unroll
        for (int st = 0; st < 2; ++st) {
            if (st <= tw) {
#pragma unroll
                for (int s2 = 0; s2 < 2; ++s2) { const int ks = 2 * st + s2;
                    const bf16x8 vf = mk8(vtr(vimg + ew * TRT + ks * 1024 + lo), vtr(vimg + ew * TRT + ks * 1024 + lo + 512));
                    u32x4 pw; pw.x = cvtpk(p[st][8 * s2 + 0], p[st][8 * s2 + 1]); pw.y = cvtpk(p[st][8 * s2 + 2], p[st][8 * s2 + 3]); pw.z = cvtpk(p[st][8 * s2 + 4], p[st][8 * s2 + 5]); pw.w = cvtpk(p[st][8 * s2 + 6], p[st][8 * s2 + 7]);
                    ai = MFMA32(vf, __builtin_bit_cast(bf16x8, pw), ai); }
            }
        }
#pragma unroll
        for (int ks = 0; ks < 8; ++ks) ae = MFMA32(cf[ks], qf[ks], ae);
        float hv[16]; float ss = 0.f; const float rden = 1.f / hden;
#pragma unroll
        for (int r = 0; r < 16; ++r) { hv[r] = (ai[r] + dec * ae[r]) * rden; ss += hv[r] * hv[r]; }
        ss += __shfl_xor(ss, 32);
        if (hi == 0) ssq[ew * 64 + t] = ss;
        __syncthreads();
        const float tot = ssq[t] + ssq[64 + t] + ssq[128 + t] + ssq[192 + t];
        const float rn = rsqrtf(tot * (1.f / 128.f) + RMS_EPS);
        LAS const float* hn = HNL + h * 128 + 32 * ew;
        bf16_t* yo = WSP(bf16_t, WS_YCAT) + ((size_t)b * SEQ + s0 + t) * 1024 + h * 128 + 32 * ew;
#pragma unroll
        for (int p2 = 0; p2 < 2; ++p2) { u32x2 ov[2];
#pragma unroll
            for (int e = 0; e < 2; ++e) { const int q4 = 2 * p2 + e; const int e0 = 8 * q4 + 4 * hi;
                const u32x2 om = moc[q4]; const f32x4 wn = *(LAS const f32x4*)(hn + e0);
                const float y0 = hv[4 * q4 + 0] * rn * wn[0] * sigmoid_f(bflo(om.x)), y1 = hv[4 * q4 + 1] * rn * wn[1] * sigmoid_f(bfhi(om.x));
                const float y2 = hv[4 * q4 + 2] * rn * wn[2] * sigmoid_f(bflo(om.y)), y3 = hv[4 * q4 + 3] * rn * wn[3] * sigmoid_f(bfhi(om.y));
                ov[e].x = cvtpk(y0, y1); ov[e].y = cvtpk(y2, y3); }
            *(u32x4*)(yo + 16 * p2 + 8 * hi) = widen_pair(ov[0], ov[1]); }
        __syncthreads();
    }
}

__device__ __forceinline__ void compress_job(Frame& F, int job) {
    int lane = F.lane; asm volatile("" : "+v"(lane));
    const int w = F.wave, r32 = lane & 31, hi = lane >> 5;
    const int kv = job >> 7, bg = (job >> 3) & 15, i0 = (job & 7) * 32;
    const bf16_t* X = WSP(bf16_t, kv ? WS_VC : WS_KC) + (size_t)bg * SEQ * 64;
    const bf16_t* W1 = WSP(bf16_t, kv ? WS_CW1V : WS_CW1K); const bf16_t* W2 = WSP(bf16_t, kv ? WS_CW2V : WS_CW2K);
    const float* c1 = WSP(float, WS_C1B) + kv * 128;
    bf16_t* O = WSP(bf16_t, kv ? WS_VCMP : WS_KCMP) + (size_t)bg * 256 * 64;
    LAS unsigned char* himg = F.lds;
    LAS float* part = (LAS float*)(F.lds + ROWIMG);
    const int nt = w & 3, kh = w >> 2;
    f32x16 acc = {0};
    {
        const int tid = F.tid; constexpr int CS = 528;
        LAS unsigned char* AB = F.lds + 40960;
        u32x4 ra0[2], rb0[8], ra1[2], rb1[8];
#define CJ_LOAD(RA, RB, ch) do { _Pragma("unroll") for (int i = 0; i < 2; ++i) { const int q = tid + 512 * i; int ii = i0 + (q >> 5); if (ii > 254) ii = 254; \
            RA[i] = *(const u32x4*)(X + (size_t)ii * 1024 + (ch) * 256 + (q & 31) * 8); } \
        _Pragma("unroll") for (int i = 0; i < 8; ++i) { const int q = tid + 512 * i; RB[i] = *(const u32x4*)(W1 + (size_t)(q >> 5) * 2048 + (ch) * 256 + (q & 31) * 8); } } while (0)
#define CJ_STEP(RA, RB, ch) do { __syncthreads();     \
            _Pragma("unroll") for (int i = 0; i < 2; ++i) { const int q = tid + 512 * i; *(LAS u32x4*)(AB + (q >> 5) * CS + (q & 31) * 16) = RA[i]; } \
            _Pragma("unroll") for (int i = 0; i < 8; ++i) { const int q = tid + 512 * i; *(LAS u32x4*)(AB + (32 + (q >> 5)) * CS + (q & 31) * 16) = RB[i]; } \
            if ((ch) + 2 < 8) CJ_LOAD(RA, RB, (ch) + 2); \
            __syncthreads(); \
            bf16x8 af[8], bf[8]; \
            _Pragma("unroll") for (int ks = 0; ks < 8; ++ks) { af[ks] = *(LAS const bf16x8*)(ap + 32 * ks); bf[ks] = *(LAS const bf16x8*)(bp + 32 * ks); } \
            _Pragma("unroll") for (int ks = 0; ks < 8; ++ks) acc = MFMA32(af[ks], bf[ks], acc); } while (0)
        LAS const unsigned char* ap = AB + r32 * CS + (kh * 128 + 8 * hi) * 2; LAS const unsigned char* bp = AB + (32 + 32 * nt + r32) * CS + (kh * 128 + 8 * hi) * 2;
        CJ_LOAD(ra0, rb0, 0); CJ_LOAD(ra1, rb1, 1);
#pragma nounroll
        for (int ch = 0; ch < 8; ch += 2) { CJ_STEP(ra0, rb0, ch); CJ_STEP(ra1, rb1, ch + 1); }
#undef CJ_STEP
#undef CJ_LOAD
    }
    if (kh == 1) {
#pragma unroll
        for (int r = 0; r < 16; ++r) part[(nt * 16 + r) * 64 + lane] = acc[r];
    }
    __syncthreads();
    if (kh == 0) {
        const int n = 32 * nt + r32; const float cb = c1[n];
#pragma unroll
        for (int r = 0; r < 16; ++r) { const int rowl = crow(r, hi); const float v = acc[r] + part[(nt * 16 + r) * 64 + lane] + cb;
            *(LAS bf16_t*)(himg + (n >> 3) * RCH + rowl * 16 + (n & 7) * 2) = f2bf(silu_f(v)); }
    }
    __syncthreads();
    if (w < 2) {
        f32x16 a2 = {0};
#pragma unroll
        for (int ks = 0; ks < 8; ++ks) { const bf16x8 a = *(LAS const bf16x8*)(himg + (2 * ks + hi) * RCH + r32 * 16);
            const bf16x8 bb = *(const bf16x8*)(W2 + (size_t)(32 * w + r32) * 128 + 16 * ks + 8 * hi); a2 = MFMA32(a, bb, a2); }
#pragma unroll
        for (int r = 0; r < 16; ++r) { const int i = i0 + crow(r, hi); if (i < 255) O[(size_t)i * 64 + 32 * w + r32] = f2bf(a2[r]); }
    }
    __syncthreads();
}

constexpr int NSA_KCH = 1024 + 16, NSA_VDH = 4096 + 64, NSA_KIMG = 8 * NSA_KCH, NSA_VIMG = 2 * NSA_VDH, NSA_BUF = NSA_KIMG + NSA_VIMG;
constexpr int NSA_IMP = 2 * NSA_BUF, NSA_IST = 65, NSA_TOT = NSA_IMP + 256 * NSA_IST * 4,
              NSA_SELB = MISC_OFF + 1024, NSA_UNI = NSA_SELB + 512;
constexpr int NSA_FAC = NSA_TOT + 64 * NSA_IST * 4;
constexpr int NSA_STASH = 96 * 1024;
static_assert(4 * NSA_BUF <= NSA_STASH && NSA_FAC + 4096 <= MISC_OFF && NSA_STASH + 8 * 4096 <= MISC_OFF, "NSA LDS map");

__device__ __forceinline__ void nsa_qk(LAS const unsigned char* kimg, const bf16x8 (&qr)[4], unsigned kfo, f32x16& p0, f32x16& p1) {
    bf16x8 kf[8];
#pragma unroll
    for (int d0 = 0; d0 < 4; ++d0) { kf[2 * d0] = *(LAS const bf16x8*)(kimg + kfo + d0 * (2 * NSA_KCH)); kf[2 * d0 + 1] = *(LAS const bf16x8*)(kimg + kfo + d0 * (2 * NSA_KCH) + 512); }
    __builtin_amdgcn_sched_barrier(0);
    p0 = (f32x16){0}; p1 = (f32x16){0};
#pragma unroll
    for (int d0 = 0; d0 < 4; ++d0) { p0 = MFMA32(kf[2 * d0], qr[d0], p0); p1 = MFMA32(kf[2 * d0 + 1], qr[d0], p1); }
}
constexpr float NSA_THR = 8.f;
template <int KIND>
__device__ __forceinline__ void nsa_tile(LAS const unsigned char* kimg, LAS const unsigned char* vimg, const bf16x8 (&qr)[4], int kbase, int t, bool edge, bool rowvalid,
                                         float& m, float& l, f32x16& o0, f32x16& o1, unsigned kfo, unsigned vfo, int hi) {
    f32x16 p0, p1; nsa_qk(kimg, qr, kfo, p0, p1);
    if (edge) {
#pragma unroll
        for (int r = 0; r < 16; ++r) { const int k0 = kbase + crow(r, hi), k1 = k0 + 32; bool v0, v1;
            if (KIND == 1) { v0 = k0 <= t; v1 = k1 <= t; } else { v0 = k0 <= t && k0 >= t - 511; v1 = k1 <= t && k1 >= t - 511; }
            p0[r] = v0 ? p0[r] : -INFINITY; p1[r] = v1 ? p1[r] : -INFINITY; }
    }
    float mx = fmaxf(p0[0], p1[0]);
#pragma unroll
    for (int r = 1; r < 16; ++r) mx = fmaxf(mx, fmaxf(p0[r], p1[r]));
    mx = rowvalid ? mx : -INFINITY;
    mx = fmaxf(mx, __shfl_xor(mx, 32));
    if (__any(mx - m > NSA_THR)) {
        const float mn = fmaxf(m, mx); const float alpha = ex2(m - mn); m = mn; l *= alpha;
#pragma unroll
        for (int r = 0; r < 16; ++r) { o0[r] *= alpha; o1[r] *= alpha; }
    }
    const float me = rowvalid ? m : INFINITY;
    float rs = 0.f;
#pragma unroll
    for (int r = 0; r < 16; ++r) { p0[r] = ex2(p0[r] - me); p1[r] = ex2(p1[r] - me); rs += p0[r] + p1[r]; }
    l += rs;
    u32x4 pw[4];
#pragma unroll
    for (int s = 0; s < 2; ++s) {
        pw[s].x = cvtpk(p0[8 * s + 0], p0[8 * s + 1]); pw[s].y = cvtpk(p0[8 * s + 2], p0[8 * s + 3]); pw[s].z = cvtpk(p0[8 * s + 4], p0[8 * s + 5]); pw[s].w = cvtpk(p0[8 * s + 6], p0[8 * s + 7]);
        pw[2 + s].x = cvtpk(p1[8 * s + 0], p1[8 * s + 1]); pw[2 + s].y = cvtpk(p1[8 * s + 2], p1[8 * s + 3]); pw[2 + s].z = cvtpk(p1[8 * s + 4], p1[8 * s + 5]); pw[2 + s].w = cvtpk(p1[8 * s + 6], p1[8 * s + 7]);
    }
    bf16x8 vf[8];
#pragma unroll
    for (int ks = 0; ks < 4; ++ks) { vf[2 * ks] = mk8(vtr(vimg + vfo + ks * 1024), vtr(vimg + vfo + ks * 1024 + 512)); vf[2 * ks + 1] = mk8(vtr(vimg + vfo + NSA_VDH + ks * 1024), vtr(vimg + vfo + NSA_VDH + ks * 1024 + 512)); }
    __builtin_amdgcn_sched_barrier(0);
#pragma unroll
    for (int ks = 0; ks < 4; ++ks) { o0 = MFMA32(vf[2 * ks], __builtin_bit_cast(bf16x8, pw[ks]), o0); o1 = MFMA32(vf[2 * ks + 1], __builtin_bit_cast(bf16x8, pw[ks]), o1); }
}

template <int KIND>
__device__ __forceinline__ void nsa_tile2(LAS const unsigned char* kA, LAS const unsigned char* vA, LAS const unsigned char* kB, LAS const unsigned char* vB, bool hasB,
                                          const bf16x8 (&qr)[4], int kbA, int kbB, int t, bool edgeA, bool edgeB, bool rvA, bool rvB,
                                          float& m, float& l, f32x16& o0, f32x16& o1, unsigned kfo, unsigned vfo, int hi) {
    f32x16 a0, a1, b0, b1;
    nsa_qk(kA, qr, kfo, a0, a1);
    __builtin_amdgcn_sched_barrier(0);
    if (hasB) nsa_qk(kB, qr, kfo, b0, b1);
    else {
#pragma unroll
        for (int r = 0; r < 16; ++r) { b0[r] = -INFINITY; b1[r] = -INFINITY; } }
    if (edgeA) {
#pragma unroll
        for (int r = 0; r < 16; ++r) { const int k0 = kbA + crow(r, hi), k1 = k0 + 32; bool v0, v1;
            if (KIND == 1) { v0 = k0 <= t; v1 = k1 <= t; } else { v0 = k0 <= t && k0 >= t - 511; v1 = k1 <= t && k1 >= t - 511; }
            a0[r] = v0 ? a0[r] : -INFINITY; a1[r] = v1 ? a1[r] : -INFINITY; } }
    if (edgeB) {
#pragma unroll
        for (int r = 0; r < 16; ++r) { const int k0 = kbB + crow(r, hi), k1 = k0 + 32; bool v0, v1;
            if (KIND == 1) { v0 = k0 <= t; v1 = k1 <= t; } else { v0 = k0 <= t && k0 >= t - 511; v1 = k1 <= t && k1 >= t - 511; }
            b0[r] = v0 ? b0[r] : -INFINITY; b1[r] = v1 ? b1[r] : -INFINITY; } }
    __builtin_amdgcn_sched_barrier(0);
    const bool fresh = m < -1e29f; const float mb = fresh ? 0.f : m;
    const float meA = rvA ? mb : INFINITY, meB = rvB ? mb : INFINITY;
#pragma unroll
    for (int r = 0; r < 16; ++r) { a0[r] -= meA; a1[r] -= meA; b0[r] -= meB; b1[r] -= meB; }
    float mx = fmaxf(fmaxf(a0[0], a1[0]), fmaxf(b0[0], b1[0]));
#pragma unroll
    for (int r = 1; r < 16; ++r) mx = fmaxf(mx, fmaxf(fmaxf(a0[r], a1[r]), fmaxf(b0[r], b1[r])));
    mx = fmaxf(mx, __shfl_xor(mx, 32));
    const bool has = mx > -INFINITY;
    const float delta = fresh ? (has ? mx : 0.f) : (mx > NSA_THR ? mx : 0.f);
    if (__any(delta != 0.f)) {
        const float alpha = fresh ? 1.f : ex2(-delta); l *= alpha;
#pragma unroll
        for (int r = 0; r < 16; ++r) { o0[r] *= alpha; o1[r] *= alpha; a0[r] -= delta; a1[r] -= delta; b0[r] -= delta; b1[r] -= delta; }
    }
    m = fresh ? (has ? mx : m) : m + delta;
    float rs = 0.f;
#pragma unroll
    for (int r = 0; r < 16; ++r) { a0[r] = ex2(a0[r]); a1[r] = ex2(a1[r]); b0[r] = ex2(b0[r]); b1[r] = ex2(b1[r]); rs += (a0[r] + a1[r]) + (b0[r] + b1[r]); }
    l += rs;
    __builtin_amdgcn_sched_barrier(0);
    {
        u32x4 pw[4];
#pragma unroll
        for (int s = 0; s < 2; ++s) {
            pw[s].x = cvtpk(a0[8 * s + 0], a0[8 * s + 1]); pw[s].y = cvtpk(a0[8 * s + 2], a0[8 * s + 3]); pw[s].z = cvtpk(a0[8 * s + 4], a0[8 * s + 5]); pw[s].w = cvtpk(a0[8 * s + 6], a0[8 * s + 7]);
            pw[2 + s].x = cvtpk(a1[8 * s + 0], a1[8 * s + 1]); pw[2 + s].y = cvtpk(a1[8 * s + 2], a1[8 * s + 3]); pw[2 + s].z = cvtpk(a1[8 * s + 4], a1[8 * s + 5]); pw[2 + s].w = cvtpk(a1[8 * s + 6], a1[8 * s + 7]); }
        bf16x8 vf[8];
#pragma unroll
        for (int ks = 0; ks < 4; ++ks) { vf[2 * ks] = mk8(vtr(vA + vfo + ks * 1024), vtr(vA + vfo + ks * 1024 + 512)); vf[2 * ks + 1] = mk8(vtr(vA + vfo + NSA_VDH + ks * 1024), vtr(vA + vfo + NSA_VDH + ks * 1024 + 512)); }
        __builtin_amdgcn_sched_barrier(0);
#pragma unroll
        for (int ks = 0; ks < 4; ++ks) { o0 = MFMA32(vf[2 * ks], __builtin_bit_cast(bf16x8, pw[ks]), o0); o1 = MFMA32(vf[2 * ks + 1], __builtin_bit_cast(bf16x8, pw[ks]), o1); }
    }
    __builtin_amdgcn_sched_barrier(0);
    if (hasB) {
        u32x4 pw[4];
#pragma unroll
        for (int s = 0; s < 2; ++s) {
            pw[s].x = cvtpk(b0[8 * s + 0], b0[8 * s + 1]); pw[s].y = cvtpk(b0[8 * s + 2], b0[8 * s + 3]); pw[s].z = cvtpk(b0[8 * s + 4], b0[8 * s + 5]); pw[s].w = cvtpk(b0[8 * s + 6], b0[8 * s + 7]);
            pw[2 + s].x = cvtpk(b1[8 * s + 0], b1[8 * s + 1]); pw[2 + s].y = cvtpk(b1[8 * s + 2], b1[8 * s + 3]); pw[2 + s].z = cvtpk(b1[8 * s + 4], b1[8 * s + 5]); pw[2 + s].w = cvtpk(b1[8 * s + 6], b1[8 * s + 7]); }
        bf16x8 vf[8];
#pragma unroll
        for (int ks = 0; ks < 4; ++ks) { vf[2 * ks] = mk8(vtr(vB + vfo + ks * 1024), vtr(vB + vfo + ks * 1024 + 512)); vf[2 * ks + 1] = mk8(vtr(vB + vfo + NSA_VDH + ks * 1024), vtr(vB + vfo + NSA_VDH + ks * 1024 + 512)); }
        __builtin_amdgcn_sched_barrier(0);
#pragma unroll
        for (int ks = 0; ks < 4; ++ks) { o0 = MFMA32(vf[2 * ks], __builtin_bit_cast(bf16x8, pw[ks]), o0); o1 = MFMA32(vf[2 * ks + 1], __builtin_bit_cast(bf16x8, pw[ks]), o1); }
    }
}

#define NPIN(x) asm volatile("" : "+v"(x))
__device__ __forceinline__ void glds16(const void* g, unsigned lds_base) {
    unsigned sv; asm volatile("s_mov_b32 %0, m0\n\ts_mov_b32 m0, %2\n\ts_nop 0\n\tglobal_load_lds_dwordx4 %1, off\n\ts_mov_b32 m0, %0" : "=&s"(sv) : "v"(g), "s"(lds_base) : "memory"); }
#define NSB() __builtin_amdgcn_sched_barrier(0)
#define NMX3(a, b, c) fmaxf(fmaxf((a), (b)), (c))
__device__ __forceinline__ float nsa_rowmax(const f32x16& p0, const f32x16& p1) {
    float a = NMX3(p0[0], p0[1], p1[0]), b = NMX3(p0[2], p0[3], p1[1]); a = NMX3(a, p1[2], p1[3]);
#pragma unroll
    for (int r = 4; r < 16; r += 4) { a = NMX3(a, p0[r], p0[r + 1]); b = NMX3(b, p0[r + 2], p0[r + 3]); a = NMX3(a, p1[r], p1[r + 1]); b = NMX3(b, p1[r + 2], p1[r + 3]); }
    const float m = fmaxf(a, b); const auto rr = __builtin_amdgcn_permlane32_swap(__float_as_uint(m), __float_as_uint(m), false, false);
    return fmaxf(__uint_as_float(rr[0]), __uint_as_float(rr[1])); }
template <int KIND>
__device__ __forceinline__ void nsa_mask(f32x16& p0, f32x16& p1, int kbase, int t, int hi) {
#pragma unroll
    for (int r = 0; r < 16; ++r) { const int k0 = kbase + crow(r, hi), k1 = k0 + 32; bool v0, v1;
        if (KIND == 1) { v0 = k0 <= t; v1 = k1 <= t; } else { v0 = k0 <= t && k0 >= t - 511; v1 = k1 <= t && k1 >= t - 511; }
        p0[r] = v0 ? p0[r] : -INFINITY; p1[r] = v1 ? p1[r] : -INFINITY; } }
template <int KIND>
__device__ __forceinline__ void nsa_pipe(LAS unsigned char* L, const bf16_t* Kp, const bf16_t* Vp, unsigned mlo, unsigned mhi, unsigned sel0, unsigned sel1,
                                         const bf16x8 (&qr)[4], int t, int lane, int w, int hi, unsigned kfo, unsigned vfo,
                                         float& lsum, f32x16& o0, f32x16& o1,
                                         int& sbase, bool pre, const bf16_t* Kn, const bf16_t* Vn, unsigned nlo, unsigned nhi) {
    unsigned ulo = mlo, uhi = mhi;
    const bf16_t* ksrc = Kp + lane * 64 + w * 8; const bf16_t* vsrc = Vp + (16 * (w & 3) + (lane >> 2)) * 64 + (w >> 2) * 32 + (lane & 3) * 8;
    const unsigned kdst = (unsigned)(uintptr_t)L + w * NSA_KCH, vdst = (unsigned)(uintptr_t)L + NSA_KIMG + (w >> 2) * NSA_VDH + (w & 3) * 1024;
#define NP_DMAS(KS, VS, j, sl) do { const int ps_ = ((sl) + sbase) & 3; glds16((KS) + (size_t)(j) * 4096, (unsigned)__builtin_amdgcn_readfirstlane(kdst + ps_ * NSA_BUF)); glds16((VS) + (size_t)(j) * 4096, (unsigned)__builtin_amdgcn_readfirstlane(vdst + ps_ * NSA_BUF)); } while (0)
#define NP_DMA(j, sl) NP_DMAS(ksrc, vsrc, j, sl)
#define NP_DMAWAIT() asm volatile("s_waitcnt vmcnt(0)" ::: "memory")
    const int n = __builtin_popcount(ulo) + __builtin_popcount(uhi);
#define NP_NEXT(jv) do { jv = -1; if (ulo | uhi) { jv = ulo ? __builtin_ctz(ulo) : 32 + __builtin_ctz(uhi); if (ulo) ulo &= ulo - 1; else uhi &= uhi - 1; } } while (0)
#define NP_SELBIT(j) ((((j) < 32 ? (sel0 >> ((j) & 31)) : (sel1 >> (((j) - 32) & 31))) & 1u) != 0u)
#define NP_KIMG(sl) (L + (((sl) + sbase) & 3) * NSA_BUF)
#define NP_VIMG(sl) (L + (((sl) + sbase) & 3) * NSA_BUF + NSA_KIMG)
    int jc, jn1, jn2;
    NP_NEXT(jc); NP_NEXT(jn1); NP_NEXT(jn2);
    if (!pre) { NP_DMA(jc, 0); if (jn1 >= 0) NP_DMA(jn1, 1); if (jn2 >= 0) NP_DMA(jn2, 2); }
    NP_DMAWAIT();
    __syncthreads();
    float m = -1e30f, cin = 0.f, l = 0.f, fsc = 1.f; bool resc = false;
    o0 = (f32x16){0}; o1 = (f32x16){0};
    f32x16 pA0, pA1, pB0, pB1, ci16; bf16x8 kf[8]; s16x4 vlo[8], vhi[8]; u32x4 pw0, pw1, pw2, pw3;
#define NP_KLOAD2(sl, d0) do { kf[2 * (d0)] = *(LAS const bf16x8*)(NP_KIMG(sl) + kfo + (d0) * (2 * NSA_KCH)); kf[2 * (d0) + 1] = *(LAS const bf16x8*)(NP_KIMG(sl) + kfo + (d0) * (2 * NSA_KCH) + 512); } while (0)
#define NP_SPLAT(v) do { _Pragma("unroll") for (int r = 0; r < 16; ++r) ci16[r] = (v); } while (0)
#define NP_CINIT(jt) do { if (KIND == 1) { const float c_ = NP_SELBIT(jt) ? cin : -INFINITY; NP_SPLAT(c_); } } while (0)
#define NP_DECIDE(C0, C1) do { const float rm_ = nsa_rowmax(C0, C1); const bool fresh_ = m < -1e29f; \
        const bool grow_ = fresh_ ? (rm_ > -INFINITY) : (rm_ > NSA_THR); resc = false; \
        if (__any(grow_)) { const float dl_ = grow_ ? rm_ : 0.f; fsc = (grow_ && !fresh_) ? ex2(-rm_) : 1.f; m = grow_ ? (fresh_ ? rm_ : m + rm_) : m; cin = grow_ ? -m : cin; l *= fsc; resc = true; \
            _Pragma("unroll") for (int r = 0; r < 16; ++r) { C0[r] -= dl_; C1[r] -= dl_; } \
            if (KIND == 2) NP_SPLAT(cin); } } while (0)
    { _Pragma("unroll") for (int d0 = 0; d0 < 4; ++d0) NP_KLOAD2(0, d0);
      if (KIND == 2) NP_SPLAT(0.f); else NP_CINIT(jc);
      NSB();
      pA0 = MFMA32(kf[0], qr[0], ci16); pA1 = MFMA32(kf[1], qr[0], ci16);
      _Pragma("unroll") for (int d0 = 1; d0 < 4; ++d0) { pA0 = MFMA32(kf[2 * d0], qr[d0], pA0); pA1 = MFMA32(kf[2 * d0 + 1], qr[d0], pA1); }
      nsa_mask<KIND>(pA0, pA1, 64 * jc, t, hi);
      NP_DECIDE(pA0, pA1);
      _Pragma("unroll") for (int r = 0; r < 16; ++r) { pA0[r] = ex2(pA0[r]); pA1[r] = ex2(pA1[r]); }
      if (jn1 >= 0) { _Pragma("unroll") for (int d0 = 0; d0 < 4; ++d0) NP_KLOAD2(1, d0); }
      jc = jn1; jn1 = jn2; NP_NEXT(jn2); }
    int s = 1;
#define NP_PKW(P, i) cvtpk(P[i], P[(i) + 1])
#define NP_VFR(i) mk8(vlo[i], vhi[i])
#define NP_VRD(i) do { LAS const unsigned char* a_ = vp_ + ((i) >> 1) * 1024 + ((i) & 1) * NSA_VDH; vlo[i] = vtr(a_); vhi[i] = vtr(a_ + 512); } while (0)
#define NP_GAPA(MF, a0, a1, a2, a3, W0, W1, PW) do { MF; sacc += a0; sacc += a1; sacc += a2; sacc += a3; W0; W1; NPIN(PW); NPIN(sacc); NSB(); } while (0)
#define NP_GAPB(MF, X, i) do { MF; X[i] = ex2(X[i]); X[(i) + 1] = ex2(X[(i) + 1]); X[(i) + 2] = ex2(X[(i) + 2]); X[(i) + 3] = ex2(X[(i) + 3]); NPIN(X); NSB(); } while (0)
#define NP_KRD(GL, d0) do { if (GL) { NP_KLOAD2(sn_, d0); NSB(); } } while (0)
#define NP_STEP(C0, C1, P0, P1, LAST) do { NSB(); \
    const int sp_ = (s - 1) & 3, sn_ = (s + 1) & 3, sw_ = (s + 2) & 3; \
    if (!(LAST) && jn2 >= 0) NP_DMA(jn2, sw_);     \
    LAS const unsigned char* vp_ = NP_VIMG(sp_) + vfo; \
    NP_CINIT(jc); \
    float sacc = P0[0] + P0[1]; NSB(); \
    NP_GAPA(C0 = MFMA32(kf[0], qr[0], ci16), P0[2], P0[3], P0[4], P0[5],     pw0[0] = NP_PKW(P0, 0),  pw0[1] = NP_PKW(P0, 2),  pw0); \
    NP_GAPA(C1 = MFMA32(kf[1], qr[0], ci16), P0[6], P0[7], P0[8], P0[9],     pw0[2] = NP_PKW(P0, 4),  pw0[3] = NP_PKW(P0, 6),  pw0); \
    NP_GAPA(C0 = MFMA32(kf[2], qr[1], C0),            P0[10], P0[11], P0[12], P0[13], pw1[0] = NP_PKW(P0, 8),  pw1[1] = NP_PKW(P0, 10), pw1); \
    NP_GAPA(C1 = MFMA32(kf[3], qr[1], C1),            P0[14], P0[15], P1[0], P1[1],   pw1[2] = NP_PKW(P0, 12), pw1[3] = NP_PKW(P0, 14), pw1); \
    NP_GAPA(C0 = MFMA32(kf[4], qr[2], C0),            P1[2], P1[3], P1[4], P1[5],     pw2[0] = NP_PKW(P1, 0),  pw2[1] = NP_PKW(P1, 2),  pw2); \
    NP_GAPA(C1 = MFMA32(kf[5], qr[2], C1),            P1[6], P1[7], P1[8], P1[9],     pw2[2] = NP_PKW(P1, 4),  pw2[3] = NP_PKW(P1, 6),  pw2); \
    NP_GAPA(C0 = MFMA32(kf[6], qr[3], C0),            P1[10], P1[11], P1[12], P1[13], pw3[0] = NP_PKW(P1, 8),  pw3[1] = NP_PKW(P1, 10), pw3); \
    NP_GAPA(C1 = MFMA32(kf[7], qr[3], C1),            P1[14], P1[15], 0.f, 0.f,       pw3[2] = NP_PKW(P1, 12), pw3[3] = NP_PKW(P1, 14), pw3); \
    l += sacc; \
    NP_VRD(0); NP_VRD(1); NP_VRD(2); NP_VRD(3); NSB();     \
    if (LAST) nsa_mask<KIND>(C0, C1, 64 * jc, t, hi); \
    NP_DECIDE(C0, C1); NSB(); \
    NP_VRD(4); NSB(); NP_GAPB(o0 = MFMA32(NP_VFR(0), __builtin_bit_cast(bf16x8, pw0), o0), C0, 0); \
    NP_VRD(5); NSB(); NP_GAPB(o1 = MFMA32(NP_VFR(1), __builtin_bit_cast(bf16x8, pw0), o1), C0, 4); \
    NP_VRD(6); NSB(); NP_KRD(!(LAST), 0); NP_GAPB(o0 = MFMA32(NP_VFR(2), __builtin_bit_cast(bf16x8, pw1), o0), C0, 8); \
    NP_VRD(7); NSB(); NP_KRD(!(LAST), 1); NP_GAPB(o1 = MFMA32(NP_VFR(3), __builtin_bit_cast(bf16x8, pw1), o1), C0, 12); \
    NP_KRD(!(LAST), 2); NP_GAPB(o0 = MFMA32(NP_VFR(4), __builtin_bit_cast(bf16x8, pw2), o0), C1, 0); \
    NP_KRD(!(LAST), 3); NP_GAPB(o1 = MFMA32(NP_VFR(5), __builtin_bit_cast(bf16x8, pw2), o1), C1, 4); \
    NP_GAPB(o0 = MFMA32(NP_VFR(6), __builtin_bit_cast(bf16x8, pw3), o0), C1, 8);  NP_GAPB(o1 = MFMA32(NP_VFR(7), __builtin_bit_cast(bf16x8, pw3), o1), C1, 12); \
    NP_DMAWAIT(); \
    __syncthreads(); \
    if (resc) { _Pragma("unroll") for (int r = 0; r < 16; ++r) { o0[r] *= fsc; o1[r] *= fsc; } } \
    jc = jn1; jn1 = jn2; NP_NEXT(jn2); ++s; } while (0)
    int rem = n - 1;
    if (n & 1) { pB0 = pA0; pB1 = pA1; if (rem > 0) { NP_STEP(pA0, pA1, pB0, pB1, false); --rem; } }
    while (rem >= 3) { NP_STEP(pB0, pB1, pA0, pA1, false); NP_STEP(pA0, pA1, pB0, pB1, false); rem -= 2; }
    if (rem == 1) { NP_STEP(pB0, pB1, pA0, pA1, true); }
    if (Kn) {
        unsigned vlo_ = nlo, vhi_ = nhi; const bf16_t* ks2 = Kn + lane * 64 + w * 8; const bf16_t* vs2 = Vn + (16 * (w & 3) + (lane >> 2)) * 64 + (w >> 2) * 32 + (lane & 3) * 8;
        _Pragma("unroll") for (int i = 0; i < 3; ++i) { if (vlo_ | vhi_) { const int j2 = vlo_ ? __builtin_ctz(vlo_) : 32 + __builtin_ctz(vhi_); if (vlo_) vlo_ &= vlo_ - 1; else vhi_ &= vhi_ - 1;
            NP_DMAS(ks2, vs2, j2, n + i); } } }
    { float sacc = pB0[0] + pB0[1];
      _Pragma("unroll") for (int r = 2; r < 16; ++r) sacc += pB0[r];
      _Pragma("unroll") for (int r = 0; r < 16; ++r) sacc += pB1[r];
      l += sacc;
      pw0 = (u32x4){NP_PKW(pB0, 0), NP_PKW(pB0, 2), NP_PKW(pB0, 4), NP_PKW(pB0, 6)}; pw1 = (u32x4){NP_PKW(pB0, 8), NP_PKW(pB0, 10), NP_PKW(pB0, 12), NP_PKW(pB0, 14)};
      pw2 = (u32x4){NP_PKW(pB1, 0), NP_PKW(pB1, 2), NP_PKW(pB1, 4), NP_PKW(pB1, 6)}; pw3 = (u32x4){NP_PKW(pB1, 8), NP_PKW(pB1, 10), NP_PKW(pB1, 12), NP_PKW(pB1, 14)};
      LAS const unsigned char* vp_ = NP_VIMG((n - 1) & 3) + vfo;
      _Pragma("unroll") for (int i = 0; i < 8; ++i) NP_VRD(i);
      NSB();
      o0 = MFMA32(NP_VFR(0), __builtin_bit_cast(bf16x8, pw0), o0); o1 = MFMA32(NP_VFR(1), __builtin_bit_cast(bf16x8, pw0), o1);
      o0 = MFMA32(NP_VFR(2), __builtin_bit_cast(bf16x8, pw1), o0); o1 = MFMA32(NP_VFR(3), __builtin_bit_cast(bf16x8, pw1), o1);
      o0 = MFMA32(NP_VFR(4), __builtin_bit_cast(bf16x8, pw2), o0); o1 = MFMA32(NP_VFR(5), __builtin_bit_cast(bf16x8, pw2), o1);
      o0 = MFMA32(NP_VFR(6), __builtin_bit_cast(bf16x8, pw3), o0); o1 = MFMA32(NP_VFR(7), __builtin_bit_cast(bf16x8, pw3), o1); }
    __syncthreads();
    lsum = l; sbase = (sbase + n) & 3;
#undef NP_DMA
#undef NP_DMAS
#undef NP_DMAWAIT
#undef NP_NEXT
#undef NP_SELBIT
#undef NP_KIMG
#undef NP_VIMG
#undef NP_KLOAD2
#undef NP_SPLAT
#undef NP_CINIT
#undef NP_DECIDE
#undef NP_PKW
#undef NP_VFR
#undef NP_VRD
#undef NP_GAPA
#undef NP_GAPB
#undef NP_KRD
#undef NP_STEP
}

__device__ __forceinline__ void nsa_unit(Frame& F, int b, int g, int qb) {
    int tid = F.tid; asm volatile("" : "+v"(tid));
    const int lane = tid & 63, w = F.wave, r32 = lane & 31, hi = lane >> 5;
    const int hh = 4 * g + (w & 3), th = w >> 2, cur = qb, T0 = qb * 64, tokl = 32 * th + r32, t = T0 + tokl;
    const size_t row = (size_t)b * SEQ + t; const int bg = b * 2 + g;
    LAS unsigned char* L = F.lds;
    bf16x8 qr[4];
    { const bf16_t* qp = WSP(bf16_t, WS_NQ) + row * 512 + hh * 64 + 8 * hi;
#pragma unroll
      for (int d0 = 0; d0 < 4; ++d0) qr[d0] = *(const bf16x8*)(qp + 16 * d0); }
    const float* gp = WSP(float, WS_NGT) + row * 24 + hh * 3; const float gate_c = gp[0], gate_s = gp[1], gate_w = gp[2];
    unsigned outp0[8], outp1[8];
    const unsigned kst = (tid & 7) * NSA_KCH + (tid >> 3) * 16, vst = ((tid & 7) >> 2) * NSA_VDH + (tid >> 3) * 64 + (tid & 3) * 16;
    const unsigned kfo = hi * NSA_KCH + r32 * 16, vfo = tr_lane_off(lane);
    float m, l; f32x16 o0, o1;
    u32x4 rk, rv;
#define NSA_LOAD(Kp, Vp, tile) do { rk = *(const u32x4*)((Kp) + (size_t)(tile) * 4096 + tid * 8); rv = *(const u32x4*)((Vp) + (size_t)(tile) * 4096 + tid * 8); } while (0)
#define NSA_WRITE(buf) do { *(LAS u32x4*)(L + (buf) * NSA_BUF + kst) = rk; *(LAS u32x4*)(L + (buf) * NSA_BUF + NSA_KIMG + vst) = rv; } while (0)
#define NSA_NEXT(jv) do { jv = -1; if (ulo | uhi) { jv = ulo ? __builtin_ctz(ulo) : 32 + __builtin_ctz(uhi); if (ulo) ulo &= ulo - 1; else uhi &= uhi - 1; } } while (0)
#define NSA_RUN(Kp, Vp, MLO, MHI, ...) do { unsigned ulo = (MLO), uhi = (MHI); int j, j1, j2; u32x4 rk2, rv2; \
        NSA_NEXT(j); NSA_LOAD(Kp, Vp, j); NSA_WRITE(0); NSA_NEXT(j1); if (j1 >= 0) NSA_LOAD(Kp, Vp, j1); __syncthreads(); int buf = 0; \
        for (;;) { NSA_NEXT(j2); if (j2 >= 0) { rk2 = *(const u32x4*)((Kp) + (size_t)j2 * 4096 + tid * 8); rv2 = *(const u32x4*)((Vp) + (size_t)j2 * 4096 + tid * 8); } \
            { LAS const unsigned char* KI = L + buf * NSA_BUF; LAS const unsigned char* VI = KI + NSA_KIMG; __VA_ARGS__ } \
            if (j1 >= 0) NSA_WRITE(buf ^ 1); __syncthreads(); if (j1 < 0) break; j = j1; j1 = j2; rk = rk2; rv = rv2; buf ^= 1; } } while (0)
#define NSA_LOAD2(Kp, Vp, ja, jb) do { rk = *(const u32x4*)((Kp) + (size_t)(ja) * 4096 + tid * 8); rv = *(const u32x4*)((Vp) + (size_t)(ja) * 4096 + tid * 8); \
        if ((jb) >= 0) { rkB = *(const u32x4*)((Kp) + (size_t)(jb) * 4096 + tid * 8); rvB = *(const u32x4*)((Vp) + (size_t)(jb) * 4096 + tid * 8); } } while (0)
#define NSA_WRITE2(pb, jb) do { LAS unsigned char* P_ = L + (pb) * (2 * NSA_BUF); *(LAS u32x4*)(P_ + kst) = rk; *(LAS u32x4*)(P_ + NSA_KIMG + vst) = rv; \
        if ((jb) >= 0) { *(LAS u32x4*)(P_ + NSA_BUF + kst) = rkB; *(LAS u32x4*)(P_ + NSA_BUF + NSA_KIMG + vst) = rvB; } } while (0)
#define NSA_RUN2(Kp, Vp, MLO, MHI, ...) do { unsigned ulo = (MLO), uhi = (MHI); int ja, jb, na, nb; u32x4 rkB, rvB; \
        NSA_NEXT(ja); NSA_NEXT(jb); NSA_LOAD2(Kp, Vp, ja, jb); NSA_WRITE2(0, jb); __syncthreads(); int pbuf = 0; \
        for (;;) { NSA_NEXT(na); NSA_NEXT(nb); if (na >= 0) NSA_LOAD2(Kp, Vp, na, nb); \
            { LAS const unsigned char* KA = L + pbuf * (2 * NSA_BUF); LAS const unsigned char* VA = KA + NSA_KIMG; LAS const unsigned char* KB = KA + NSA_BUF; LAS const unsigned char* VB = KB + NSA_KIMG; __VA_ARGS__ } \
            if (na >= 0) NSA_WRITE2(pbuf ^ 1, nb); __syncthreads(); if (na < 0) break; ja = na; jb = nb; pbuf ^= 1; } } while (0)
#define NSA_LT(lv) ({ const auto rr_ = __builtin_amdgcn_permlane32_swap(__float_as_uint(lv), __float_as_uint(lv), false, false); __uint_as_float(rr_[0]) + __uint_as_float(rr_[1]); })
#define NSA_RESET() do { m = -1e30f; l = 0.f; o0 = (f32x16){0}; o1 = (f32x16){0}; } while (0)

    const bf16_t* Kc = WSP(bf16_t, WS_KCMP) + (size_t)bg * 256 * 64; const bf16_t* Vc = WSP(bf16_t, WS_VCMP) + (size_t)bg * 256 * 64;
    const int ntc = ((4 * cur + 2) >> 6) + 1; const int lim = (t >= 31) ? ((t - 31) >> 4) : -1;
    const int tmin_w = T0 + 32 * th; const int lim_min = (tmin_w >= 31) ? ((tmin_w - 31) >> 4) : -1;
    unsigned sel0, sel1, un0, un1;
    {
        LAS float* IMP = (LAS float*)(L + NSA_IMP); LAS float* FAC = (LAS float*)(L + NSA_FAC);
        float carry = 0.f; const bool need_imp = cur >= 16;
        float mt0 = 0.f, mt1 = 0.f, mt2 = 0.f, mt3 = 0.f;
        m = -1e30f; l = 0.f; o0 = (f32x16){0}; o1 = (f32x16){0};
        NSA_RUN(Kc, Vc, (1u << ntc) - 1u, 0u, {
            f32x16 p0, p1; nsa_qk(KI, qr, kfo, p0, p1);
            if (64 * j + 63 > lim_min) {
                _Pragma("unroll") for (int r = 0; r < 16; ++r) { const int k0 = 64 * j + crow(r, hi);
                    p0[r] = (k0 <= lim) ? p0[r] : -INFINITY; p1[r] = (k0 + 32 <= lim) ? p1[r] : -INFINITY; } }
            { const float rm = nsa_rowmax(p0, p1); const bool fresh = m < -1e29f; const bool grow = fresh ? (rm > -INFINITY) : (rm - m > NSA_THR);
              if (__any(grow)) { const float mn = grow ? rm : m; const float f = (grow && !fresh) ? ex2(m - mn) : 1.f; m = mn; l *= f; carry *= f;
                  _Pragma("unroll") for (int r = 0; r < 16; ++r) { o0[r] *= f; o1[r] *= f; } } }
            if (j == 0) mt0 = m; else if (j == 1) mt1 = m; else if (j == 2) mt2 = m; else mt3 = m;
            { float rs = 0.f;
              _Pragma("unroll") for (int r = 0; r < 16; ++r) { p0[r] = ex2(p0[r] - m); p1[r] = ex2(p1[r] - m); rs += p0[r] + p1[r]; }
              l += rs; }
            if (need_imp) {
                _Pragma("unroll") for (int n = 0; n < 2; ++n) {
                    float a[4], bq[4], pb[4];
                    _Pragma("unroll") for (int q4 = 0; q4 < 4; ++q4) { const float x0 = n ? p1[4 * q4] : p0[4 * q4], x1 = n ? p1[4 * q4 + 1] : p0[4 * q4 + 1], x2 = n ? p1[4 * q4 + 2] : p0[4 * q4 + 2], x3 = n ? p1[4 * q4 + 3] : p0[4 * q4 + 3];
                        a[q4] = 2.f * (x0 + x1 + x2) + x3; bq[q4] = x3; }
                    _Pragma("unroll") for (int q4 = 0; q4 < 4; ++q4) pb[q4] = __shfl_xor(bq[q4], 32);
                    _Pragma("unroll") for (int q4 = 0; q4 < 4; ++q4) { const float prevb = hi ? pb[q4] : (q4 ? pb[q4 > 0 ? q4 - 1 : 0] : carry);
                        IMP[((w & 3) * 64 + tokl) * NSA_IST + 16 * j + 8 * n + 2 * q4 + hi] = a[q4] + prevb; }
                    carry = pb[3];
                } }
            u32x4 pw[4];
            _Pragma("unroll") for (int s = 0; s < 2; ++s) {
                pw[s].x = cvtpk(p0[8 * s + 0], p0[8 * s + 1]); pw[s].y = cvtpk(p0[8 * s + 2], p0[8 * s + 3]); pw[s].z = cvtpk(p0[8 * s + 4], p0[8 * s + 5]); pw[s].w = cvtpk(p0[8 * s + 6], p0[8 * s + 7]);
                pw[2 + s].x = cvtpk(p1[8 * s + 0], p1[8 * s + 1]); pw[2 + s].y = cvtpk(p1[8 * s + 2], p1[8 * s + 3]); pw[2 + s].z = cvtpk(p1[8 * s + 4], p1[8 * s + 5]); pw[2 + s].w = cvtpk(p1[8 * s + 6], p1[8 * s + 7]); }
            _Pragma("unroll") for (int ks = 0; ks < 4; ++ks) {
                const bf16x8 v0 = mk8(vtr(VI + vfo + ks * 1024), vtr(VI + vfo + ks * 1024 + 512));
                const bf16x8 v1 = mk8(vtr(VI + vfo + NSA_VDH + ks * 1024), vtr(VI + vfo + NSA_VDH + ks * 1024 + 512));
                o0 = MFMA32(v0, __builtin_bit_cast(bf16x8, pw[ks]), o0); o1 = MFMA32(v1, __builtin_bit_cast(bf16x8, pw[ks]), o1); } });
        const float inv_c = 1.f / fmaxf(NSA_LT(l), 1e-30f); const float gs_ = gate_c * inv_c;
        _Pragma("unroll") for (int r = 0; r < 8; ++r) { outp0[r] = cvtpk(gs_ * o0[2 * r], gs_ * o0[2 * r + 1]); outp1[r] = cvtpk(gs_ * o1[2 * r], gs_ * o1[2 * r + 1]); }
        if (need_imp) {
            if (hi == 0) { f32x4 fc; fc[0] = ex2(mt0 - m) * inv_c; fc[1] = ntc > 1 ? ex2(mt1 - m) * inv_c : 0.f; fc[2] = ntc > 2 ? ex2(mt2 - m) * inv_c : 0.f; fc[3] = ntc > 3 ? ex2(mt3 - m) * inv_c : 0.f;
                *(LAS f32x4*)(FAC + ((w & 3) * 64 + tokl) * 4) = fc; }
            __syncthreads(); }
    }
    if (cur >= 16) {
        LAS float* IMP = (LAS float*)(L + NSA_IMP);
        LAS unsigned* TOT = (LAS unsigned*)(L + NSA_TOT); LAS unsigned char* SELB = L + NSA_SELB; LAS unsigned* UNI = (LAS unsigned*)(L + NSA_UNI);
        { const int tk = tid >> 3, jg = tid & 7; LAS const float* FAC = (LAS const float*)(L + NSA_FAC);
          float fq[4];
#pragma unroll
          for (int h4 = 0; h4 < 4; ++h4) fq[h4] = FAC[(h4 * 64 + tk) * 4 + (jg >> 1)];
#pragma unroll
          for (int jj = 0; jj < 8; ++jj) { const int jx = 8 * jg + jj;
              const float tot = ((IMP[tk * NSA_IST + jx] * fq[0] + IMP[(64 + tk) * NSA_IST + jx] * fq[1]) + IMP[(128 + tk) * NSA_IST + jx] * fq[2]) + IMP[(192 + tk) * NSA_IST + jx] * fq[3];
              TOT[tk * NSA_IST + jx] = (__float_as_uint(tot) & ~63u) | (unsigned)(63 - jx); }
          if (tid < 2) UNI[tid] = 0u; }
        __syncthreads();
        { const int tk = tid >> 3, jg = tid & 7; unsigned bits = 0u;
          unsigned v[8]; int rank[8];
#pragma unroll
          for (int jj = 0; jj < 8; ++jj) { v[jj] = TOT[tk * NSA_IST + 8 * jg + jj]; rank[jj] = 0; }
#pragma unroll 4
          for (int k2 = 1; k2 <= cur - 2; ++k2) { const unsigned v2 = TOT[tk * NSA_IST + k2];
#pragma unroll
              for (int jj = 0; jj < 8; ++jj) rank[jj] += (int)(v2 > v[jj]); }
#pragma unroll
          for (int jj = 0; jj < 8; ++jj) { const int jx = 8 * jg + jj;
              const bool s = (jx == 0 || jx == cur || jx == cur - 1) || (jx < cur - 1 && rank[jj] < 13);
              bits |= s ? (1u << jj) : 0u; }
          SELB[tk * 8 + jg] = (unsigned char)bits;
          atomicOr((unsigned*)&UNI[jg >> 2], bits << (8 * (jg & 3))); }
        __syncthreads();
        sel0 = *(LAS const unsigned*)(SELB + tokl * 8); sel1 = *(LAS const unsigned*)(SELB + tokl * 8 + 4);
        un0 = __builtin_amdgcn_readfirstlane(UNI[0]); un1 = __builtin_amdgcn_readfirstlane(UNI[1]);
    } else {
        sel0 = (1u << (cur + 1)) - 1u; sel1 = 0u; un0 = sel0; un1 = 0u;
    }
    LAS unsigned* ST = (LAS unsigned*)(L + NSA_STASH + w * 4096) + lane;
#pragma unroll
    for (int r = 0; r < 8; ++r) { ST[r * 64] = outp0[r]; ST[(8 + r) * 64] = outp1[r]; }
    const bf16_t* Ks = WSP(bf16_t, WS_KSL) + (size_t)bg * SEQ * 64; const bf16_t* Vs = WSP(bf16_t, WS_VSL) + (size_t)bg * SEQ * 64;
    const bf16_t* Kw = WSP(bf16_t, WS_KWN) + (size_t)bg * SEQ * 64; const bf16_t* Vw = WSP(bf16_t, WS_VWN) + (size_t)bg * SEQ * 64;
    const int jlo = cur >= 8 ? cur - 8 : 0;
    const unsigned long long wm = ((cur == 63) ? ~0ull : ((1ull << (cur + 1)) - 1ull)) & ~((1ull << jlo) - 1ull);
    int sbase = 0;
    nsa_pipe<1>(L, Ks, Vs, un0, un1, sel0, sel1, qr, t, lane, w, hi, kfo, vfo, l, o0, o1, sbase, false, Kw, Vw, (unsigned)wm, (unsigned)(wm >> 32));
    { const float sc = gate_s / fmaxf(NSA_LT(l), 1e-30f);
#pragma unroll
      for (int r = 0; r < 8; ++r) { const unsigned a = ST[r * 64], c = ST[(8 + r) * 64];
          ST[r * 64] = cvtpk(bflo(a) + sc * o0[2 * r], bfhi(a) + sc * o0[2 * r + 1]); ST[(8 + r) * 64] = cvtpk(bflo(c) + sc * o1[2 * r], bfhi(c) + sc * o1[2 * r + 1]); } }
    nsa_pipe<2>(L, Kw, Vw, (unsigned)wm, (unsigned)(wm >> 32), 0u, 0u, qr, t, lane, w, hi, kfo, vfo, l, o0, o1, sbase, true, nullptr, nullptr, 0u, 0u);
    { const float sc = gate_w / fmaxf(NSA_LT(l), 1e-30f);
      bf16_t* yo = WSP(bf16_t, WS_YCAT) + row * 1024 + 512 + hh * 64;
#pragma unroll
      for (int p2 = 0; p2 < 2; ++p2) { u32x2 av[2], cv[2];
#pragma unroll
          for (int e = 0; e < 2; ++e) { const int q4 = 2 * p2 + e;
              const unsigned a0 = ST[(2 * q4) * 64], a1 = ST[(2 * q4 + 1) * 64], c0 = ST[(8 + 2 * q4) * 64], c1 = ST[(9 + 2 * q4) * 64];
              av[e].x = cvtpk(bflo(a0) + sc * o0[4 * q4], bfhi(a0) + sc * o0[4 * q4 + 1]); av[e].y = cvtpk(bflo(a1) + sc * o0[4 * q4 + 2], bfhi(a1) + sc * o0[4 * q4 + 3]);
              cv[e].x = cvtpk(bflo(c0) + sc * o1[4 * q4], bfhi(c0) + sc * o1[4 * q4 + 1]); cv[e].y = cvtpk(bflo(c1) + sc * o1[4 * q4 + 2], bfhi(c1) + sc * o1[4 * q4 + 3]); }
          *(u32x4*)(yo + 16 * p2 + 8 * hi) = widen_pair(av[0], av[1]); *(u32x4*)(yo + 32 + 16 * p2 + 8 * hi) = widen_pair(cv[0], cv[1]); } }
#undef NSA_LOAD
#undef NSA_WRITE
#undef NSA_RUN
#undef NSA_RUN2
#undef NSA_LOAD2
#undef NSA_WRITE2
#undef NSA_LT
#undef NSA_RESET
}

__device__ __forceinline__ void s6_phase(Frame& F) {
    int tid = F.tid; asm volatile("" : "+v"(tid));
    const int lane = tid & 63, w = F.wave;
    LAS unsigned char* TILE = F.lds + w * 16384;
    LAS float* LG = (LAS float*)(F.lds + MISC_OFF + 4096) + w * (8 * 48);
    LAS int* REC_E = (LAS int*)(F.lds + MISC_OFF + 16384);
    LAS float* REC_G = (LAS float*)(F.lds + MISC_OFF + 16384 + 1024);
    LAS int* REC_P = (LAS int*)(F.lds + MISC_OFF + 16384 + 2048);
    LAS int* CNTL = (LAS int*)(F.lds + MISC_OFF + 16384 + 3072);
    LAS float* SAW = (LAS float*)(F.lds + MISC_OFF + 16384 + 3584);
    const float* x = IN_F(0); const float* wpost = IN_F(6); const float* wffn = IN_F(7); const float* mod = WSP(float, WS_MOD);
    const bf16_t* Y = WSP(bf16_t, WS_Y); bf16_t* X1B = WSP(bf16_t, WS_X1B); signed char* H2Q = (signed char*)(F.ws + WS_H2Q); float* SAv = WSP(float, WS_SA); const _Float16* RWT = WSP(_Float16, WS_RWT);
    const float* bgp = IN_F(21); const float* bep = IN_F(23);
    unsigned* cntg = (unsigned*)(F.ws + WS_CTL) + CW_CNT;
    for (int rb = F.vcu; rb < NTOK / 128; rb += F.G) {
        if (tid < 64) CNTL[tid] = 0;
        __syncthreads();
        const int rbase = rb * 128 + w * 16, b = rbase >> 12;
        f32x4 xv[4][4]; u32x4 yw[4][2];
#define S6_LOAD(g) do { _Pragma("unroll") for (int r = 0; r < 4; ++r) { const size_t ro_ = (size_t)(rbase + 4 * (g) + r) * DM; \
            _Pragma("unroll") for (int j = 0; j < 4; ++j) xv[r][j] = __builtin_nontemporal_load((const f32x4*)(x + ro_ + 4 * lane + 256 * j)); \
            _Pragma("unroll") for (int jp = 0; jp < 2; ++jp) yw[r][jp] = __builtin_nontemporal_load((const u32x4*)(Y + ro_ + 4 * (lane & ~1) + 256 * (2 * jp + (lane & 1)))); } } while (0)
#define S6_Y(r, j) ((f32x4){bflo(yr[r][j].x), bfhi(yr[r][j].x), bflo(yr[r][j].y), bfhi(yr[r][j].y)})
        S6_LOAD(0);
#pragma nounroll
        for (int g = 0; g < 4; ++g) {
            u32x2 yr[4][4];
#pragma unroll
            for (int r = 0; r < 4; ++r)
#pragma unroll
                for (int jp = 0; jp < 2; ++jp) pair_narrow(yw[r][jp], lane, yr[r][2 * jp], yr[r][2 * jp + 1]);
            int l4 = 4 * lane; asm volatile("" : "+v"(l4));
            float ss[4];
#pragma unroll
            for (int r = 0; r < 4; ++r) { float a2 = 0.f;
#pragma unroll
                for (int j = 0; j < 4; ++j) { const f32x4 y = S6_Y(r, j); a2 += y[0] * y[0] + y[1] * y[1] + y[2] * y[2] + y[3] * y[3]; }
                ss[r] = a2; }
#pragma unroll
            for (int o = 1; o < 64; o <<= 1) {
#pragma unroll
                for (int r = 0; r < 4; ++r) ss[r] += __shfl_xor(ss[r], o); }
            float s2[4] = {0.f, 0.f, 0.f, 0.f};
#pragma unroll
            for (int j = 0; j < 4; ++j) { const int k = l4 + 256 * j;
                const f32x4 wp = *(const f32x4*)(wpost + k), gm = *(const f32x4*)(mod + b * 6144 + 2048 + k); const f32x4 gw2 = gm * wp;
#pragma unroll
                for (int r = 0; r < 4; ++r) { const float r1 = rsqrtf(ss[r] * (1.f / DM) + RMS_EPS);
                    xv[r][j] = xv[r][j] + gw2 * (S6_Y(r, j) * r1);
                    s2[r] += xv[r][j][0] * xv[r][j][0] + xv[r][j][1] * xv[r][j][1] + xv[r][j][2] * xv[r][j][2] + xv[r][j][3] * xv[r][j][3]; } }
#pragma unroll
            for (int r = 0; r < 4; ++r)
#pragma unroll
                for (int jp = 0; jp < 2; ++jp) { u32x2 pa, pb; pa.x = cvtpk(xv[r][2 * jp][0], xv[r][2 * jp][1]); pa.y = cvtpk(xv[r][2 * jp][2], xv[r][2 * jp][3]);
                    pb.x = cvtpk(xv[r][2 * jp + 1][0], xv[r][2 * jp + 1][1]); pb.y = cvtpk(xv[r][2 * jp + 1][2], xv[r][2 * jp + 1][3]);
                    __builtin_nontemporal_store(pair_widen(pa, pb, lane), (u32x4*)(X1B + (size_t)(rbase + 4 * g + r) * DM + 4 * (lane & ~1) + 256 * (2 * jp + (lane & 1)))); }
#pragma unroll
            for (int o = 1; o < 64; o <<= 1) {
#pragma unroll
                for (int r = 0; r < 4; ++r) s2[r] += __shfl_xor(s2[r], o); }
#pragma unroll
            for (int j = 0; j < 4; ++j) { const int k = l4 + 256 * j;
                const f32x4 wf = *(const f32x4*)(wffn + k), sh = *(const f32x4*)(mod + b * 6144 + 3072 + k), sc = *(const f32x4*)(mod + b * 6144 + 4096 + k); const f32x4 ws = wf * (sc + 1.f);
#pragma unroll
                for (int r = 0; r < 4; ++r) { const float r2 = rsqrtf(s2[r] * (1.f / DM) + RMS_EPS);
                    const f32x4 h = xv[r][j] * r2 * ws + sh;
                    { const int rt = 4 * (g & 1) + r; const f16x4 hh = {(_Float16)h[0], (_Float16)h[1], (_Float16)h[2], (_Float16)h[3]};
                      *(LAS f16x4*)(TILE + rt * 2048 + (((lane >> 1) ^ rt) << 4) + (lane & 1) * 8 + 512 * j) = hh; }
                    xv[r][j] = h; } }
            float am[4];
#pragma unroll
            for (int r = 0; r < 4; ++r) { float a = 0.f;
#pragma unroll
                for (int j = 0; j < 4; ++j) a = fmaxf(a, fmaxf(fmaxf(fabsf(xv[r][j][0]), fabsf(xv[r][j][1])), fmaxf(fabsf(xv[r][j][2]), fabsf(xv[r][j][3]))));
                am[r] = a; }
#pragma unroll
            for (int o = 1; o < 64; o <<= 1) {
#pragma unroll
                for (int r = 0; r < 4; ++r) am[r] = fmaxf(am[r], __shfl_xor(am[r], o)); }
#pragma unroll
            for (int r = 0; r < 4; ++r) { const float inv = am[r] > 0.f ? 127.f / am[r] : 0.f; const size_t ro = (size_t)(rbase + 4 * g + r) * DM;
                if (lane == 0) { SAv[rbase + 4 * g + r] = am[r] * (1.f / 127.f); SAW[(w * 16 + 4 * g + r)] = am[r] * (1.f / 127.f); }
                u32x4 pk;
#pragma unroll
                for (int j = 0; j < 4; ++j) { const f32x4 q = xv[r][j] * inv;
                    const int q0 = (int)rintf(q[0]), q1 = (int)rintf(q[1]), q2 = (int)rintf(q[2]), q3 = (int)rintf(q[3]);
                    pk[j] = (unsigned)(q0 & 0xff) | ((unsigned)(q1 & 0xff) << 8) | ((unsigned)(q2 & 0xff) << 16) | ((unsigned)(q3 & 0xff) << 24); }
                *(u32x4*)(H2Q + ro + 256 * (lane & 3) + 16 * (lane >> 2)) = quad_transpose(pk, lane); }
            __builtin_amdgcn_sched_barrier(0);
            if (g < 3) S6_LOAD(g + 1);
            __builtin_amdgcn_sched_barrier(0);
            if (g & 1) {
                const int r16 = lane & 15, q = lane >> 4, rt = r16 & 7;
                f32x4 a0 = {0.f, 0.f, 0.f, 0.f}, a1 = a0, a2 = a0;
                LAS const unsigned char* ae = TILE + rt * 2048 + ((q ^ rt) << 4); LAS const unsigned char* ao = TILE + rt * 2048 + (((q ^ rt) ^ 4) << 4);
                const _Float16* bp = RWT + (size_t)r16 * DM + 8 * q;
#pragma unroll 4
                for (int k2 = 0; k2 < 16; ++k2) {
                    const f16x8 ah0 = *(LAS const f16x8*)(ae + 128 * k2), ah1 = *(LAS const f16x8*)(ao + 128 * k2);
                    const f16x8 b00 = *(const f16x8*)(bp + 64 * k2), b01 = *(const f16x8*)(bp + 64 * k2 + 16 * DM), b02 = *(const f16x8*)(bp + 64 * k2 + 32 * DM);
                    const f16x8 b10 = *(const f16x8*)(bp + 64 * k2 + 32), b11 = *(const f16x8*)(bp + 64 * k2 + 32 + 16 * DM), b12 = *(const f16x8*)(bp + 64 * k2 + 32 + 32 * DM);
                    a0 = __builtin_amdgcn_mfma_f32_16x16x32_f16(ah0, b00, a0, 0, 0, 0); a1 = __builtin_amdgcn_mfma_f32_16x16x32_f16(ah0, b01, a1, 0, 0, 0); a2 = __builtin_amdgcn_mfma_f32_16x16x32_f16(ah0, b02, a2, 0, 0, 0);
                    a0 = __builtin_amdgcn_mfma_f32_16x16x32_f16(ah1, b10, a0, 0, 0, 0); a1 = __builtin_amdgcn_mfma_f32_16x16x32_f16(ah1, b11, a1, 0, 0, 0); a2 = __builtin_amdgcn_mfma_f32_16x16x32_f16(ah1, b12, a2, 0, 0, 0); }
                if (q < 2) {
#pragma unroll
                    for (int i = 0; i < 4; ++i) { LG[(4 * q + i) * 48 + r16] = a0[i]; LG[(4 * q + i) * 48 + 16 + r16] = a1[i]; LG[(4 * q + i) * 48 + 32 + r16] = a2[i]; } }
                asm volatile("s_waitcnt lgkmcnt(0)" ::: "memory");
                if (lane < 8) {
                    const LAS float* lg = LG + lane * 48;
                    float gl[4]; int gi = 0; float gmx = -INFINITY;
#pragma unroll
                    for (int i = 0; i < 4; ++i) { gl[i] = lg[i] + bgp[i]; if (gl[i] > gmx) { gmx = gl[i]; gi = i; } }
                    float gs = 0.f;
#pragma unroll
                    for (int i = 0; i < 4; ++i) gs += __expf(gl[i] - gmx);
                    const float pg = 1.f / gs;
                    float el[8]; float emx = -INFINITY;
#pragma unroll
                    for (int i = 0; i < 8; ++i) { el[i] = lg[4 + gi * 8 + i] + bep[gi * 8 + i]; emx = fmaxf(emx, el[i]); }
                    int e0 = 0; float v0 = -INFINITY;
#pragma unroll
                    for (int i = 0; i < 8; ++i) if (el[i] > v0) { v0 = el[i]; e0 = i; }
                    int e1 = 0; float v1 = -INFINITY;
#pragma unroll
                    for (int i = 0; i < 8; ++i) if (i != e0 && el[i] > v1) { v1 = el[i]; e1 = i; }
                    const float p0 = __expf(v0 - emx), p1 = __expf(v1 - emx);
                    const float g0 = pg * p0 / (p0 + p1), g1 = pg * p1 / (p0 + p1);
                    const int rl = w * 16 + 8 * (g >> 1) + lane; const int E0 = gi * 8 + e0, E1 = gi * 8 + e1;
                    REC_E[rl * 2] = E0; REC_E[rl * 2 + 1] = E1; REC_G[rl * 2] = g0; REC_G[rl * 2 + 1] = g1;
                    REC_P[rl * 2] = atomicAdd((int*)&CNTL[E0], 1); REC_P[rl * 2 + 1] = atomicAdd((int*)&CNTL[E1], 1);
                }
                asm volatile("s_waitcnt lgkmcnt(0)" ::: "memory");
            }
        }
#undef S6_LOAD
#undef S6_Y
        __syncthreads();
        if (tid < 32) { const int c = CNTL[tid]; CNTL[32 + tid] = c ? (int)__hip_atomic_fetch_add(cntg + tid, (unsigned)c, __ATOMIC_RELAXED, __HIP_MEMORY_SCOPE_AGENT) : 0; }
        __syncthreads();
        if (tid < 256) { const int rl = tid >> 1, k = tid & 1; const int row = rb * 128 + rl; const int e = REC_E[tid]; const int p = CNTL[32 + e] + REC_P[tid];
            WSP(int, WS_TOKE)[row * 2 + k] = e; WSP(int, WS_TOKP)[row * 2 + k] = p; WSP(float, WS_TOKG)[row * 2 + k] = REC_G[tid];
            WSP(int, WS_LIST)[(size_t)e * 65536 + p] = row; WSP(float, WS_SAL)[(size_t)e * 65536 + p] = SAW[rl]; }
        __syncthreads();
    }
}

__device__ __forceinline__ void expert_convert(Frame& F) {
    {
        int tid = F.tid; asm volatile("" : "+v"(tid));
        LAS unsigned* AM = (LAS unsigned*)F.lds;
        const int n4 = tid & 7, kq = tid >> 3;
        for (int it = F.vcu; it < 1024; it += F.G) {
            const int e = it >> 5, sel = (it >> 4) & 1, j0 = (it & 15) * 32;
            const float* W = IN_F(sel ? 25 : 24) + (size_t)e * 1024 * 512 + (size_t)(16 * kq) * 512 + j0 + 4 * n4;
            if (tid < 32) AM[tid] = 0u;
            __syncthreads();
            f32x4 v[16]; f32x4 am = {0.f, 0.f, 0.f, 0.f};
#pragma unroll
            for (int i = 0; i < 16; ++i) { v[i] = *(const f32x4*)(W + (size_t)i * 512);
#pragma unroll
                for (int c = 0; c < 4; ++c) am[c] = fmaxf(am[c], fabsf(v[i][c])); }
#pragma unroll
            for (int o = 8; o < 64; o <<= 1) {
#pragma unroll
                for (int c = 0; c < 4; ++c) am[c] = fmaxf(am[c], __shfl_xor(am[c], o)); }
            if ((tid & 63) < 8) {
#pragma unroll
                for (int c = 0; c < 4; ++c) atomicMax((unsigned*)&AM[4 * n4 + c], __float_as_uint(am[c])); }
            __syncthreads();
            const f32x4 amax = *(LAS const f32x4*)((LAS const float*)AM + 4 * n4);
            unsigned char* dst = (unsigned char*)(F.ws + WS_W13T) + ((size_t)e * 1024 + 8 * ((j0 >> 2) + n4) + 4 * sel) * 1024 + 16 * kq;
#pragma unroll
            for (int c = 0; c < 4; ++c) { const float inv = amax[c] > 0.f ? 127.f / amax[c] : 0.f; u32x4 o;
#pragma unroll
                for (int d = 0; d < 4; ++d) {
                    const int q0 = (int)rintf(v[4 * d][c] * inv), q1 = (int)rintf(v[4 * d + 1][c] * inv), q2 = (int)rintf(v[4 * d + 2][c] * inv), q3 = (int)rintf(v[4 * d + 3][c] * inv);
                    o[d] = (unsigned)(q0 & 0xff) | ((unsigned)(q1 & 0xff) << 8) | ((unsigned)(q2 & 0xff) << 16) | ((unsigned)(q3 & 0xff) << 24); }
                *(u32x4*)(dst + (size_t)c * 1024) = o;
                if (kq == 0) WSP(float, WS_SB13)[e * 1024 + 8 * ((j0 >> 2) + n4) + 4 * sel + c] = amax[c] * (1.f / 127.f); }
            __syncthreads();
        }
    }
}
__device__ __forceinline__ void w2_convert(Frame& F, int rk, int nsh) {
    LAS float* scr = (LAS float*)(F.lds + F.wave * 8448);
    const int gw = rk * NWAVES + F.wave, NGW = nsh * NWAVES;
    for (int it = gw; it < 32 * 256; it += NGW) {
        const int e = it >> 8, r = it & 255;
        transpose_item(IN_F(26) + (size_t)e * 512 * 1024, 1024, WSP(bf16_t, WS_W2T) + (size_t)e * 1024 * 512, 512, scr, (r / 32) * 64, (r % 32) * 32, F.lane, RmId{0});
    }
    __syncthreads();
}

__device__ __forceinline__ void moe_tables(Frame& F, LAS int* tstart, LAS int* cnt) {
    if (F.tid < 64) {
        const int lane = F.tid; const unsigned* cg = (const unsigned*)(F.ws + WS_CTL) + CW_CNT;
        const int c = lane < 32 ? (int)__hip_atomic_load(cg + lane, __ATOMIC_RELAXED, __HIP_MEMORY_SCOPE_AGENT) : 0;
        const int tl = (c + 255) >> 8; int incl = tl;
#pragma unroll
        for (int o = 1; o < 32; o <<= 1) { const int x = __shfl_up(incl, o); if (lane >= o) incl += x; }
        if (lane < 32) { cnt[lane] = c; tstart[lane] = incl - tl; LAS unsigned char* et = (LAS unsigned char*)(tstart + 96);
            for (int t2 = incl - tl; t2 < incl; ++t2) et[t2] = (unsigned char)lane; }
        if (lane == 31) tstart[32] = incl; }
    __syncthreads();
}

__device__ __forceinline__ void s10_phase(Frame& F, LAS int* tstart) {
    const int gw = F.vcu * NWAVES + F.wave, NGW = F.G * NWAVES, lane = F.lane;
    const float* wpost = IN_F(8); const float* mod = WSP(float, WS_MOD); const bf16_t* YB = WSP(bf16_t, WS_YB); const bf16_t* X1B = WSP(bf16_t, WS_X1B);
    int ne0[4], ne1[4], np0[4], np1[4]; float ng0[4], ng1[4];
#define S10_TAB(rw) do { _Pragma("unroll") for (int r = 0; r < 4; ++r) { const int row_ = (rw) + r; \
        ne0[r] = WSP(int, WS_TOKE)[row_ * 2]; ne1[r] = WSP(int, WS_TOKE)[row_ * 2 + 1]; np0[r] = WSP(int, WS_TOKP)[row_ * 2]; np1[r] = WSP(int, WS_TOKP)[row_ * 2 + 1]; \
        ng0[r] = WSP(float, WS_TOKG)[row_ * 2]; ng1[r] = WSP(float, WS_TOKG)[row_ * 2 + 1]; } } while (0)
    if (gw * 4 < NTOK) S10_TAB(gw * 4);
    for (int row0 = gw * 4; row0 < NTOK; row0 += NGW * 4) {
        const int b = row0 >> 12;
        size_t r0[4], r1[4]; float g0[4], g1[4];
#pragma unroll
        for (int r = 0; r < 4; ++r) { r0[r] = (size_t)tstart[ne0[r]] * 256 + np0[r]; r1[r] = (size_t)tstart[ne1[r]] * 256 + np1[r]; g0[r] = ng0[r]; g1[r] = ng1[r]; }
        if (row0 + NGW * 4 < NTOK) S10_TAB(row0 + NGW * 4);
        f32x4 yv[4][4]; float ss[4];
        u32x4 xw[4][2];
#pragma unroll
        for (int r = 0; r < 4; ++r) { float a2 = 0.f;
            u32x4 wa[2], wc[2];
#pragma unroll
            for (int jp = 0; jp < 2; ++jp) { const int ko = 4 * (lane & ~1) + 256 * (2 * jp + (lane & 1));
                wa[jp] = __builtin_nontemporal_load((const u32x4*)(YB + r0[r] * DM + ko)); wc[jp] = __builtin_nontemporal_load((const u32x4*)(YB + r1[r] * DM + ko));
                xw[r][jp] = __builtin_nontemporal_load((const u32x4*)(X1B + (size_t)(row0 + r) * DM + ko)); }
#pragma unroll
            for (int jp = 0; jp < 2; ++jp) { u32x2 a[2], c[2]; pair_narrow(wa[jp], lane, a[0], a[1]); pair_narrow(wc[jp], lane, c[0], c[1]);
#pragma unroll
                for (int e = 0; e < 2; ++e) { const int j = 2 * jp + e;
                    yv[r][j] = (f32x4){bflo(a[e].x), bfhi(a[e].x), bflo(a[e].y), bfhi(a[e].y)} * g0[r] + (f32x4){bflo(c[e].x), bfhi(c[e].x), bflo(c[e].y), bfhi(c[e].y)} * g1[r];
                    a2 += yv[r][j][0] * yv[r][j][0] + yv[r][j][1] * yv[r][j][1] + yv[r][j][2] * yv[r][j][2] + yv[r][j][3] * yv[r][j][3]; } }
            ss[r] = a2; }
#pragma unroll
        for (int o = 1; o < 64; o <<= 1) {
#pragma unroll
            for (int r = 0; r < 4; ++r) ss[r] += __shfl_xor(ss[r], o); }
#pragma unroll
        for (int jp = 0; jp < 2; ++jp) {
#pragma unroll
            for (int r = 0; r < 4; ++r) { const float rr = rsqrtf(ss[r] * (1.f / DM) + RMS_EPS);
                u32x2 xb[2]; pair_narrow(xw[r][jp], lane, xb[0], xb[1]);
#pragma unroll
                for (int e = 0; e < 2; ++e) { const int j = 2 * jp + e, k = 4 * lane + 256 * j;
                    const f32x4 wp = *(const f32x4*)(wpost + k), gf = *(const f32x4*)(mod + b * 6144 + 5120 + k); const f32x4 gw2 = gf * wp;
                    const f32x4 x1 = (f32x4){bflo(xb[e].x), bfhi(xb[e].x), bflo(xb[e].y), bfhi(xb[e].y)};
                    __builtin_nontemporal_store(x1 + gw2 * (yv[r][j] * rr), (f32x4*)(F.out + (size_t)(row0 + r) * DM + k)); } } }
    }
}

#undef S10_TAB
#ifndef DBG_STOP
#define DBG_STOP -1
#endif
#if DBG_STOP >= 0
struct DbgBuf { size_t off, n; int f32, ph; };
__device__ __forceinline__ void dbg_phase(Frame& F, const XcdBarrier& bar) {
    const DbgBuf bufs[] = {
        {WS_MOD, 8 * 6144, 1, 0}, {WS_COS, (size_t)NTOK * 32, 1, 0}, {WS_SIN, (size_t)NTOK * 32, 1, 0}, {WS_WINT, (size_t)INWP * 1024, 0, 0}, {WS_WOUTT, 1024 * 1024, 0, 0},
        {WS_CW1K, 128 * 2048, 0, 0}, {WS_CW2K, 64 * 128, 0, 0}, {WS_RWT, 48 * 1024, 0, 0}, {WS_C1B, 256, 1, 0},
        {WS_H1, (size_t)NTOK * 1024, 0, 1},
        {WS_MQ, (size_t)NTOK * 2048, 0, 2}, {WS_NQ, (size_t)NTOK * 512, 0, 2}, {WS_KC, (size_t)NTOK * 128 * 6, 0, 2}, {WS_GI, 2 * 8 * 4 * 4096, 1, 2}, {WS_NGT, (size_t)NTOK * 24, 1, 2},
        {WS_KVC, (size_t)2048 * 16384, 0, 3}, {WS_NC, 2048 * 128, 1, 3}, {WS_GSUM, 4096, 1, 3}, {WS_KCMP, 2 * 16 * 256 * 64, 0, 3},
        {WS_CPREV, (size_t)2048 * 16384, 0, 4}, {WS_NPREV, 2048 * 128, 1, 4}, {WS_MPREV, 2048, 1, 4},
        {WS_YCAT, (size_t)NTOK * 1024, 0, 5}, {WS_W13T, (size_t)32 * 1024 * 1024, 0, 5}, {WS_W2T, (size_t)32 * 1024 * 512, 0, 5},
        {WS_Y, (size_t)NTOK * 1024, 0, 6}, {WS_H2, (size_t)NTOK * 1024, 0, 7}, {WS_TOKG, (size_t)NTOK * 2, 1, 7},
        {WS_HB, (size_t)65536 * 512, 0, 8}, {WS_YB, (size_t)65536 * 1024, 0, 9} };
    constexpr int NBUF = sizeof(bufs) / sizeof(bufs[0]);
    unsigned* flag = (unsigned*)(F.ws + WS_CTL) + CW_DBG;
    const size_t gt = (size_t)blockIdx.x * NTHR + F.tid, NG = (size_t)F.G * NTHR;
    for (int i = 0; i < NBUF; ++i) {
        if (bufs[i].ph > DBG_STOP) continue;
        if ((bufs[i].off == WS_H1 && DBG_STOP >= 3) || (bufs[i].off == WS_WINT && DBG_STOP >= 4) || (bufs[i].off == WS_KVC && DBG_STOP >= 5) || (bufs[i].off == WS_NQ && DBG_STOP >= 5) || (bufs[i].off == WS_KC && DBG_STOP >= 9) ||
            (bufs[i].off == WS_MQ && DBG_STOP >= 6) || (bufs[i].off == WS_CPREV && DBG_STOP >= 8) || (bufs[i].off == WS_Y && DBG_STOP >= 9) || (bufs[i].off == WS_H2 && DBG_STOP >= 9) || (bufs[i].off == WS_W13T && DBG_STOP < 5)) continue;
        bool bad = false;
        if (bufs[i].f32) { const unsigned* p = (const unsigned*)(F.ws + bufs[i].off); for (size_t k = gt; k < bufs[i].n; k += NG) bad |= ((p[k] & 0x7f800000u) == 0x7f800000u); }
        else { const unsigned* p = (const unsigned*)(F.ws + bufs[i].off); for (size_t k = gt; k < bufs[i].n / 2; k += NG) { const unsigned v = p[k]; bad |= ((v & 0x7f80u) == 0x7f80u) || ((v & 0x7f800000u) == 0x7f800000u); } }
        if (bufs[i].off == WS_YCAT) { bool bm = false, bn = false; const unsigned* p = (const unsigned*)(F.ws + WS_YCAT);
            for (size_t k = gt; k < bufs[i].n / 2; k += NG) { const unsigned v = p[k]; const bool b2 = ((v & 0x7f80u) == 0x7f80u) || ((v & 0x7f800000u) == 0x7f800000u); if ((k & 511) < 256) bm |= b2; else bn |= b2; }
            if (__any(bm) && F.lane == 0) atomicMin(flag, 23u); if (__any(bn) && F.lane == 0) atomicMin(flag, 33u); continue; }
        if (__any(bad) && F.lane == 0) atomicMin(flag, (unsigned)(i + 1));
    }
    if (DBG_STOP >= 7) { bool bad = false; const unsigned* p = (const unsigned*)F.out; for (size_t k = gt; k < (size_t)NTOK * DM; k += NG) bad |= ((p[k] & 0x7f800000u) == 0x7f800000u); if (__any(bad) && F.lane == 0) atomicMin(flag, 40u); }
    xcd_barrier(bar);
    const unsigned id = __hip_atomic_load(flag, __ATOMIC_RELAXED, __HIP_MEMORY_SCOPE_AGENT);
    const float sc = (id >= 1000u) ? 1.f : 1.f + (float)id;
    const float* x = IN_F(0);
    for (size_t k = gt; k < (size_t)NTOK * DM; k += NG) F.out[k] = x[k] * sc;
}
#endif


#if DBG_STOP >= 0
__device__ __forceinline__ unsigned dbg_hash(unsigned x) { x ^= x >> 16; x *= 0x7feb352du; x ^= x >> 15; x *= 0x846ca68bu; x ^= x >> 16; return x; }
__device__ __forceinline__ float dbg_bfr(float f) { return bf2f(f2bf(f)); }
__device__ float dbg_z(Frame& F, int row, int c) { const signed char* h = (const signed char*)(F.ws + WS_H1) + (size_t)row * 1024; const float* w = IN_F(9); float am = 0.f;
    for (int k = 0; k < 1024; ++k) am = fmaxf(am, fabsf(w[(size_t)k * INW + c]));
    const float inv = am > 0.f ? 127.f / am : 0.f; float s = 0.f; for (int k = 0; k < 1024; ++k) s += (float)h[k] * rintf(w[(size_t)k * INW + c] * inv);
    return s * WSP(float, WS_SA1)[row] * (am * (1.f / 127.f)); }
__device__ __forceinline__ bool dbg_close(float a, float b) { return fabsf(a - b) <= 0.02f * fabsf(b) + 0.02f; }
__device__ void dbg_check_p1(Frame& F, unsigned* cnt) {
    const int gt = blockIdx.x * NTHR + F.tid; if (gt >= 8192) return;
    const int row = dbg_hash(gt * 2 + 1) % NTOK; int c = dbg_hash(gt * 2 + 2) % INW; if (gt < 64) c = 2048 + (gt & 7); if (gt >= 64 && gt < 256) c = 3336 + (gt % 24);
    const int b = row >> 12, sq = row & 4095; const float* COS = WSP(float, WS_COS); const float* SIN = WSP(float, WS_SIN);
    float ref, got;
    if (c < 2048) { ref = dbg_z(F, row, c); got = bf2f(WSP(bf16_t, c < 512 ? WS_MQ : c < 1024 ? WS_MK : c < 1536 ? WS_MV : WS_MO)[(size_t)row * 512 + (c & 511)]); }
    else if (c < 2052) { ref = dbg_z(F, row, c) + IN_F(11)[c - 2048]; got = WSP(float, WS_GI)[(size_t)(b * 4 + c - 2048) * SEQ + sq]; }
    else if (c < 2056) { ref = logsigmoid_f(dbg_z(F, row, c) + IN_F(11)[4 + c - 2052]); got = WSP(float, WS_GF)[(size_t)(b * 4 + c - 2052) * SEQ + sq]; }
    else if (c >= 3336) { ref = sigmoid_f(dbg_z(F, row, c)); got = WSP(float, WS_NGT)[(size_t)row * 24 + c - 3336]; }
    else {
        int base, x; size_t ws_off; bool rope, isq = false;
        if (c < 2568) { base = 2056; x = c - base; rope = true; isq = true; ws_off = WS_NQ; }
        else if (c < 2696) { base = 2568; x = c - base; rope = true; ws_off = WS_KC; }
        else if (c < 2824) { base = 2696; x = c - base; rope = false; ws_off = WS_VC; }
        else if (c < 2952) { base = 2824; x = c - base; rope = true; ws_off = WS_KSL; }
        else if (c < 3080) { base = 2952; x = c - base; rope = false; ws_off = WS_VSL; }
        else if (c < 3208) { base = 3080; x = c - base; rope = true; ws_off = WS_KWN; }
        else { base = 3208; x = c - base; rope = false; ws_off = WS_VWN; }
        const int hd = x >> 6, d = x & 63;
        if (rope) { const float z0 = dbg_z(F, row, c), z1 = dbg_z(F, row, base + hd * 64 + (d ^ 32)); const float cs = COS[(size_t)row * 32 + (d & 31)], sn = SIN[(size_t)row * 32 + (d & 31)];
            ref = d < 32 ? z0 * cs - z1 * sn : z0 * cs + z1 * sn; if (isq) ref *= QSCALE; }
        else ref = dbg_z(F, row, c);
        got = isq ? bf2f(WSP(bf16_t, ws_off)[(size_t)row * 512 + hd * 64 + d]) : bf2f(WSP(bf16_t, ws_off)[((size_t)(b * 2 + hd) * SEQ + sq) * 64 + d]);
    }
    if (!dbg_close(got, ref)) atomicAdd(cnt, 1u);
}
#endif


#if DBG_STOP >= 0
__device__ void dbg_check_nsa(Frame& F, unsigned* cnt) {
    const int lane = F.lane, gw = blockIdx.x * NWAVES + F.wave;
    LAS float* P = (LAS float*)(F.lds + F.wave * 2048);
    const unsigned hsh = dbg_hash(gw * 7 + 3);
    const int b = hsh & 7, hh = (hsh >> 3) & 7, g = hh >> 2;
    int t; { const int cls = gw & 7; const unsigned r = dbg_hash(gw * 13 + 5);
        t = cls == 0 ? (int)(r % 31) : cls == 1 ? 31 + (int)(r % 33) : cls == 2 ? 64 + (int)(r % 960) : cls == 3 ? 1024 + (int)(r % 64) : cls == 4 ? 4032 + (int)(r % 64) : 1024 + (int)(r % 3072); }
    const size_t row = (size_t)b * SEQ + t; const int bg = b * 2 + g, cur = t >> 6;
    const bf16_t* Kc = WSP(bf16_t, WS_KCMP) + (size_t)bg * 256 * 64; const bf16_t* Vc = WSP(bf16_t, WS_VCMP) + (size_t)bg * 256 * 64;
    const int lim = t >= 31 ? (t - 31) >> 4 : -1;
    float imp = 0.f, oc = 0.f;
    for (int hd = 0; hd < 4; ++hd) {
        const bf16_t* q = WSP(bf16_t, WS_NQ) + row * 512 + (4 * g + hd) * 64;
        float sc[4]; float mx = -INFINITY;
        for (int k = 0; k < 4; ++k) { const int i = lane + 64 * k; float s = 0.f; for (int d = 0; d < 64; ++d) s += bf2f(q[d]) * bf2f(Kc[(size_t)i * 64 + d]); sc[k] = (i <= lim) ? s : -INFINITY; mx = fmaxf(mx, sc[k]); }
        mx = wave_max(mx); const float mref = (mx == -INFINITY) ? 0.f : mx; float l = 0.f;
        for (int k = 0; k < 4; ++k) { sc[k] = ex2(sc[k] - mref); l += sc[k]; }
        l = wave_sum(l); const float il = 1.f / fmaxf(l, 1e-30f);
        for (int k = 0; k < 4; ++k) P[lane + 64 * k] = sc[k] * il;
        asm volatile("s_waitcnt lgkmcnt(0)" ::: "memory");
        { const int j = lane; float a = 0.f; for (int x = 0; x < 3; ++x) a += 2.f * P[4 * j + x]; a += P[4 * j + 3]; if (j > 0) a += P[4 * j - 1]; imp += a; }
        if (4 * g + hd == hh) { for (int i = 0; i < 255; ++i) oc += P[i] * bf2f(Vc[(size_t)i * 64 + lane]); }
        asm volatile("s_waitcnt lgkmcnt(0)" ::: "memory");
    }
    float score = imp; { const int j = lane; if (j == 0 || j == cur || j == cur - 1) score = INFINITY; else if (64 * j > t) score = -INFINITY; }
    int rank = 0; for (int j2 = 0; j2 < 64; ++j2) { const float s2 = __shfl(score, j2); rank += (s2 > score || (s2 == score && j2 < lane)) ? 1 : 0; }
    const unsigned long long selm = __ballot(rank < 16);
    const bf16_t* q = WSP(bf16_t, WS_NQ) + row * 512 + hh * 64;
    float os = 0.f, ow = 0.f;
    for (int br = 0; br < 2; ++br) {
        const bf16_t* K = WSP(bf16_t, br ? WS_KWN : WS_KSL) + (size_t)bg * SEQ * 64; const bf16_t* V = WSP(bf16_t, br ? WS_VWN : WS_VSL) + (size_t)bg * SEQ * 64;
        float m = -INFINITY, l = 0.f, o = 0.f;
        for (int j = 0; j < 64; ++j) {
            if (br == 0 && !((selm >> j) & 1ull)) continue;
            const int kp = 64 * j + lane; bool valid = kp <= t; if (br == 1) valid = valid && kp > t - 512;
            if (!__any(valid)) continue;
            float s = 0.f; for (int d = 0; d < 64; ++d) s += bf2f(q[d]) * bf2f(K[(size_t)kp * 64 + d]);
            s = valid ? s : -INFINITY;
            const float mn = fmaxf(m, wave_max(s)); const float alpha = (m == -INFINITY) ? 0.f : ex2(m - mn); const float pp = ex2(s - mn);
            l = l * alpha + wave_sum(pp); o *= alpha;
            for (int x = 0; x < 64; ++x) o += __shfl(pp, x) * bf2f(V[(size_t)(64 * j + x) * 64 + lane]);
            m = mn;
        }
        const float r = o / fmaxf(l, 1e-30f); if (br) ow = r; else os = r;
    }
    const float* gp = WSP(float, WS_NGT) + row * 24 + hh * 3;
    const float ref = gp[0] * oc + gp[1] * os + gp[2] * ow;
    const float got = bf2f(WSP(bf16_t, WS_YCAT)[row * 1024 + 512 + hh * 64 + lane]);
    const float sq = wave_sum(ref * ref); const float tol = 0.03f * fabsf(ref) + 0.03f * sqrtf(sq * (1.f / 64.f)) + 1e-4f;
    const bool bad = !(fabsf(got - ref) <= tol);
    if (__any(bad) && lane == 0) atomicAdd(cnt, 1u);
}
#endif


#if DBG_STOP >= 0
__device__ void dbg_check_mlstm(Frame& F, unsigned* cnt) {
    const int lane = F.lane, gw = blockIdx.x * NWAVES + F.wave;
    const unsigned hsh = dbg_hash(gw * 11 + 1);
    const int b = hsh & 7, h = (hsh >> 3) & 3;
    int t; { const int cls = gw & 7; const unsigned r = dbg_hash(gw * 17 + 9);
        t = cls == 0 ? (int)(r % 4) : cls == 1 ? 60 + (int)(r % 8) : cls == 2 ? 64 * (1 + (int)(r % 60)) + (int)((r >> 8) % 3) : cls == 3 ? 64 * (1 + (int)(r % 60)) + 63 : cls == 4 ? 4000 + (int)(r % 96) : (int)(r % 4096); }
    const int bh = b * 4 + h; const float* GI = WSP(float, WS_GI) + (size_t)bh * SEQ; const float* GF = WSP(float, WS_GF) + (size_t)bh * SEQ;
    const bf16_t* MQ = WSP(bf16_t, WS_MQ); const bf16_t* MK = WSP(bf16_t, WS_MK); const bf16_t* MV = WSP(bf16_t, WS_MV); const float* cw = IN_F(10);
    float carry = 0.f, M = 0.f, Bt = 0.f;
    for (int s0 = 0; s0 <= t; s0 += 64) { const int s = s0 + lane; float lf = (s <= t) ? GF[s] : 0.f;
        float bs = lf;
        for (int o = 1; o < 64; o <<= 1) { const float x = __shfl_up(bs, o); if (lane >= o) bs += x; }
        bs += carry; const float u = (s <= t) ? GI[s] - bs : -INFINITY; M = fmaxf(M, wave_max(u));
        if (s0 + 63 >= t) Bt = __shfl(bs, t - s0);
        carry = __shfl(bs, 63); }
    float q0 = 0.f, q1 = 0.f;
    for (int j = 0; j < 4; ++j) { const int ss = t - 3 + j; if (ss >= 0) { const bf16_t* rp = MQ + ((size_t)b * SEQ + ss) * 512 + h * 128;
        q0 += bf2f(rp[lane]) * cw[j * 1024 + h * 128 + lane]; q1 += bf2f(rp[64 + lane]) * cw[j * 1024 + h * 128 + 64 + lane]; } }
    q0 = dbg_bfr(silu_f(q0)); q1 = dbg_bfr(silu_f(q1));
    LAS float* QS = (LAS float*)(F.lds + F.wave * 2048); QS[lane] = q0; QS[64 + lane] = q1;
    asm volatile("s_waitcnt lgkmcnt(0)" ::: "memory");
    float n0 = 0.f, n1 = 0.f, den = 0.f; carry = 0.f;
    for (int s0 = 0; s0 <= t; s0 += 64) { const int s = s0 + lane; const bool act = s <= t; float lf = act ? GF[s] : 0.f;
        float bs = lf;
        for (int o = 1; o < 64; o <<= 1) { const float x = __shfl_up(bs, o); if (lane >= o) bs += x; }
        bs += carry; carry = __shfl(bs, 63);
        float c = 0.f;
        if (act) { float qk = 0.f;
            for (int ch = 0; ch < 128; ++ch) { float kc = 0.f;
                for (int j = 0; j < 4; ++j) { const int ss = s - 3 + j; if (ss >= 0) kc += bf2f(MK[((size_t)b * SEQ + ss) * 512 + h * 128 + ch]) * cw[j * 1024 + 512 + h * 128 + ch]; }
                qk += QS[ch] * dbg_bfr(silu_f(kc) * 0.08838834764831845f); }
            c = __expf(GI[s] - bs - M) * qk; }
        den += c;
        for (int x = 0; x < 64; ++x) { const float cx = __shfl(c, x); if (s0 + x <= t) { const bf16_t* vp = MV + ((size_t)b * SEQ + s0 + x) * 512 + h * 128; n0 += cx * bf2f(vp[lane]); n1 += cx * bf2f(vp[64 + lane]); } } }
    den = wave_sum(den);
    const float hd = fmaxf(fabsf(den), __expf(-(Bt + M)));
    const float h0 = n0 / hd, h1 = n1 / hd;
    const float rn = rsqrtf(wave_sum(h0 * h0 + h1 * h1) * (1.f / 128.f) + RMS_EPS);
    const size_t row = (size_t)b * SEQ + t; const bf16_t* mo = WSP(bf16_t, WS_MO) + row * 512 + h * 128; const float* hn = IN_F(12) + h * 128;
    const float r0 = h0 * rn * hn[lane] * sigmoid_f(bf2f(mo[lane])), r1 = h1 * rn * hn[64 + lane] * sigmoid_f(bf2f(mo[64 + lane]));
    const float g0 = bf2f(WSP(bf16_t, WS_YCAT)[row * 1024 + h * 128 + lane]), g1 = bf2f(WSP(bf16_t, WS_YCAT)[row * 1024 + h * 128 + 64 + lane]);
    const float rms = sqrtf(wave_sum(r0 * r0 + r1 * r1) * (1.f / 128.f));
    const bool bad = !(fabsf(g0 - r0) <= 0.04f * fabsf(r0) + 0.04f * rms + 1e-4f) || !(fabsf(g1 - r1) <= 0.04f * fabsf(r1) + 0.04f * rms + 1e-4f);
    if (__any(bad) && lane == 0) atomicAdd(cnt, 1u);
}
#endif


#if DBG_STOP >= 0
__device__ void dbg_check_cmp(Frame& F, unsigned* cnt) {
    const int lane = F.lane, gw = blockIdx.x * NWAVES + F.wave;
    const unsigned hsh = dbg_hash(gw * 5 + 2);
    const int kv = hsh & 1, bg = (hsh >> 1) & 15; int i = (hsh >> 5) % 255; if ((gw & 15) == 0) i = 254; if ((gw & 15) == 1) i = 0;
    const bf16_t* X = WSP(bf16_t, kv ? WS_VC : WS_KC) + (size_t)bg * SEQ * 64 + (size_t)i * 1024;
    const float* pe = IN_F(kv ? 16 : 13); const float* w1 = IN_F(kv ? 17 : 14); const float* w2 = IN_F(kv ? 18 : 15);
    float h0 = 0.f, h1 = 0.f;
    for (int k = 0; k < 2048; ++k) { const float xv = bf2f(X[k]) + pe[k]; h0 += xv * w1[(size_t)k * 128 + lane]; h1 += xv * w1[(size_t)k * 128 + 64 + lane]; }
    LAS float* H = (LAS float*)(F.lds + F.wave * 2048); H[lane] = silu_f(h0); H[64 + lane] = silu_f(h1);
    asm volatile("s_waitcnt lgkmcnt(0)" ::: "memory");
    float o = 0.f; for (int n = 0; n < 128; ++n) o += H[n] * w2[n * 64 + lane];
    const float got = bf2f(WSP(bf16_t, kv ? WS_VCMP : WS_KCMP)[((size_t)bg * 256 + i) * 64 + lane]);
    const float rms = sqrtf(wave_sum(o * o) * (1.f / 64.f));
    const bool bad = !(fabsf(got - o) <= 0.03f * fabsf(o) + 0.03f * rms + 1e-4f);
    if (__any(bad) && lane == 0) atomicAdd(cnt, 1u);
}
#endif

__device__ __forceinline__ bool phase_tid(Frame& F) { asm volatile("" : "+v"(F.tid)); F.lane = F.tid & 63; return true; }
constexpr int NPHASE = 11;
__global__ void __launch_bounds__(NTHR, 2) mega_fwd(Args args) {
    extern __shared__ __attribute__((aligned(16))) unsigned char lds_raw[];
    Frame F;
    F.lds = (LAS unsigned char*)lds_raw; F.in = args.in; F.out = args.out; F.ws = args.ws;
    F.tid = threadIdx.x; F.lane = F.tid & 63; F.wave = __builtin_amdgcn_readfirstlane(F.tid >> 6);
    F.G = gridDim.x; { const int bx = blockIdx.x; F.vcu = (F.G % 8 == 0) ? (bx % 8) * (F.G / 8) + bx / 8 : bx; }
    volatile LAS unsigned* MISC = (volatile LAS unsigned*)(F.lds + MISC_OFF);
    for (int u = F.tid; u < (LDS_BYTES - MISC_OFF) / 4; u += NTHR) ((LAS unsigned*)(F.lds + MISC_OFF))[u] = 0u;
    __syncthreads();
    unsigned* ctl = (unsigned*)(F.ws + WS_CTL);
    XcdBarrier bar; bar.bar = ctl + CW_BAR; bar.x = 0; bar.st = nullptr;
    const int lo = args.ph_lo, hi = args.ph_hi;
    if (hi - lo > 1) bar = xcd_barrier_post(ctl + CW_BAR, MISC + 8);
#ifndef PHASE_MASK
#define PHASE_MASK 0xFFFF
#endif
#define IN(k) (((PHASE_MASK >> (k)) & 1) && lo <= (k) && (k) < hi && (DBG_STOP < 0 || (k) <= DBG_STOP))
#define SEAM(k) do { if (IN(k) && IN((k) + 1)) xcd_barrier(bar); } while (0)
    LAS int* TST = (LAS int*)(F.lds + MISC_OFF + 256);
    LAS int* CNT = TST + 40;

#define PHASE_TID() if (phase_tid(F))
    if (IN(0)) PHASE_TID() _Pragma("nounroll") for (int rep = 0; rep <= ((REP_MASK >> 0) & 1); ++rep) { p0_phase(F); } SEAM(0);
    if (IN(1)) PHASE_TID() _Pragma("nounroll") for (int rep = 0; rep <= ((REP_MASK >> 1) & 1); ++rep) { p1a_phase(F); } SEAM(1);
    if (IN(2)) PHASE_TID() _Pragma("nounroll") for (int rep = 0; rep <= ((REP_MASK >> 2) & 1); ++rep) {
        pg8::DenseOrder S; S.init(NTOK, INWP, DM / 2, F.G, (int)blockIdx.x);
        EpiIn E{F.ws, IN_F(11), F.lds};
        pg8::gemm_phase<true>(F.lds, WSP(bf16_t, WS_H1), WSP(bf16_t, WS_WINT), DM / 2, S, E);
    } SEAM(2);
    if (IN(3)) PHASE_TID() _Pragma("nounroll") for (int rep = 0; rep <= ((REP_MASK >> 3) & 1); ++rep) {
        REPS(0) mlstm_a_phase(F);
        REPS(1) for (int j = F.vcu; j < 256; j += F.G) compress_job(F, j);
    } SEAM(3);
    if (IN(4)) PHASE_TID() _Pragma("nounroll") for (int rep = 0; rep <= ((REP_MASK >> 4) & 1); ++rep) {
        REPS(2) for (int j = F.vcu; j < 256; j += F.G) mlstm_scan_job(F, j);
        REPS(3) for (int u = F.vcu; u < 512; u += F.G) {
            const int bg = u >> 5, q = u & 31;
            _Pragma("nounroll") for (int hf = 0; hf < 2; ++hf) nsa_unit(F, bg >> 1, bg & 1, hf ? q : 63 - q);
        }
    } SEAM(4);
    if (IN(5)) PHASE_TID() _Pragma("nounroll") for (int rep = 0; rep <= ((REP_MASK >> 5) & 1); ++rep) {
        REPS(4) mlstm_c_phase(F);
        REPS(5) expert_convert(F);
    } SEAM(5);
    if (IN(6)) PHASE_TID() _Pragma("nounroll") for (int rep = 0; rep <= ((REP_MASK >> 6) & 1); ++rep) {
        pg8::DenseOrder S; S.init(NTOK, DM, DM, F.G, (int)blockIdx.x);
        EpiBf16 E{WSP(bf16_t, WS_Y), DM};
        pg8::gemm_phase<false>(F.lds, WSP(bf16_t, WS_YCAT), WSP(bf16_t, WS_WOUTT), DM, S, E);
    } SEAM(6);
    if (IN(7)) PHASE_TID() { s6_phase(F); } SEAM(7);
    if (IN(8)) PHASE_TID() _Pragma("nounroll") for (int rep = 0; rep <= ((REP_MASK >> 8) & 1); ++rep) {
        moe_tables(F, TST, CNT);
        pg8::MoeOrder S{TST, CNT, (const LAS unsigned char*)(TST + 96), WSP(int, WS_LIST), F.G, F.vcu, DM / 2, true};
        EpiUpI8 E{WSP(bf16_t, WS_HB), WSP(float, WS_SAL), WSP(float, WS_SB13), TST, F.lds};
        pg8::gemm_phase<true>(F.lds, WSP(bf16_t, WS_H2Q), WSP(bf16_t, WS_W13T), DM / 2, S, E);
        {
            const int U = TST[32] * 4, full = U / F.G, rem = U % F.G;
            if (rem == 0) w2_convert(F, F.vcu, F.G); else if (F.vcu >= rem) w2_convert(F, F.vcu - rem, F.G - rem);
            (void)full; }
    } SEAM(8);
    if (IN(9)) PHASE_TID() _Pragma("nounroll") for (int rep = 0; rep <= ((REP_MASK >> 9) & 1); ++rep) {
        moe_tables(F, TST, CNT);
        pg8::MoeOrder S{TST, CNT, (const LAS unsigned char*)(TST + 96), WSP(int, WS_LIST), F.G, F.vcu, EFF, false};
        EpiBf16 E{WSP(bf16_t, WS_YB), DM};
        pg8::gemm_phase<false>(F.lds, WSP(bf16_t, WS_HB), WSP(bf16_t, WS_W2T), EFF, S, E);
    } SEAM(9);
    if (IN(10)) PHASE_TID() { moe_tables(F, TST, CNT); s10_phase(F, TST); }
#if DBG_STOP >= 0
    xcd_barrier(bar);
#if DBG_CHECK == 1 || DBG_CHECK == 3 || DBG_CHECK == 4 || DBG_CHECK == 5
    { unsigned* cw = (unsigned*)(F.ws + WS_CTL) + CW_DBG + 1; if (DBG_CHECK == 1) dbg_check_p1(F, cw); else if (DBG_CHECK == 3) dbg_check_nsa(F, cw); else if (DBG_CHECK == 4) dbg_check_mlstm(F, cw); else dbg_check_cmp(F, cw); xcd_barrier(bar);
      const unsigned nb = __hip_atomic_load(cw, __ATOMIC_RELAXED, __HIP_MEMORY_SCOPE_AGENT);
      const float sc = nb == 0 ? 1.f : nb < 4 ? 2.f : nb < 16 ? 3.f : nb < 64 ? 4.f : nb < 256 ? 5.f : nb < 1024 ? 6.f : 7.f;
      const float* x = IN_F(0); for (size_t k = (size_t)blockIdx.x * NTHR + F.tid; k < (size_t)NTOK * DM; k += (size_t)F.G * NTHR) F.out[k] = x[k] * sc; }
#elif DBG_CHECK == 2
    { const unsigned id = __hip_atomic_load((unsigned*)(F.ws + WS_CTL) + CW_DBG, __ATOMIC_RELAXED, __HIP_MEMORY_SCOPE_AGENT);
      float sc = (id >= 1000u) ? 1.f : 1.f + (float)id;
      if (__hip_atomic_load((unsigned*)(F.ws + WS_CTL) + CW_BAR + XB_TMO, __ATOMIC_RELAXED, __HIP_MEMORY_SCOPE_AGENT) != 0u) sc = 61.f;
      const float* x = IN_F(0); for (size_t k = (size_t)blockIdx.x * NTHR + F.tid; k < (size_t)NTOK * DM; k += (size_t)F.G * NTHR) F.out[k] = x[k] * sc; }
#else
    dbg_phase(F, bar);
#endif
#endif
#undef IN
#undef SEAM
}

extern "C" void kernel_launch(void* const* d_in, const int* in_sizes, int n_in, void* d_out, int out_size, void* d_ws, size_t ws_size, hipStream_t stream) {
    static int grid = 0;
    if (grid == 0) {
        int dev = 0, cus = 0;
        if (hipGetDevice(&dev) != hipSuccess || hipDeviceGetAttribute(&cus, hipDeviceAttributeMultiprocessorCount, dev) != hipSuccess) cus = 256;
        if (hipFuncSetAttribute((const void*)mega_fwd, hipFuncAttributeMaxDynamicSharedMemorySize, LDS_BYTES) != hipSuccess) fprintf(stderr, "kernel_launch: hipFuncSetAttribute failed\n");
        (void)hipGetLastError();
        grid = cus > 0 ? cus : 256;
        if (n_in != 27 || ws_size < WS_END) fprintf(stderr, "kernel_launch: unexpected n_in %d / ws_size %zu (need %zu)\n", n_in, ws_size, (size_t)WS_END);
    }
    (void)hipMemsetAsync((char*)d_ws + WS_CTL, 0, 64 * 1024, stream);
#if DBG_STOP >= 0
    (void)hipMemsetAsync((char*)d_ws + WS_CTL + CW_DBG * 4, 0x7F, 4, stream);
#endif
    Args a{};
    for (int i = 0; i < 27; ++i) a.in[i] = d_in[i];
    a.out = (float*)d_out; a.ws = (unsigned char*)d_ws;
#if MK_N_LAUNCHES == 1
    a.ph_lo = 0; a.ph_hi = NPHASE;
    hipLaunchKernelGGL(mega_fwd, dim3(grid), dim3(NTHR), LDS_BYTES, stream, a);
#else
    for (int p = 0; p < NPHASE; ++p) { a.ph_lo = p; a.ph_hi = p + 1; hipLaunchKernelGGL(mega_fwd, dim3(grid), dim3(NTHR), LDS_BYTES, stream, a); }
#endif
}
```
